# Optimizing an MI355X kernel written in HIP

```python
import math
import jax, jax.numpy as jnp
from jax import lax
import numpy as np

D_MODEL = 1024
BATCH = 8
SEQ = 2048
DEPTH = 2

N_BRANCH = 4
BRANCH_WIDTH = D_MODEL // N_BRANCH
GLA_HEADS = 4
GLA_DK = BRANCH_WIDTH // (2 * GLA_HEADS)
GLA_DV = BRANCH_WIDTH // GLA_HEADS
GLA_GATE_RANK = 16
GLA_GATE_NORMALIZER = 16.0
GLA_CHUNK = 32
DIFF_HEADS = 4
DIFF_DQK = BRANCH_WIDTH // (2 * DIFF_HEADS)
DIFF_DV = 2 * DIFF_DQK
DIFF_QBLOCK = 128
ROPE_THETA = 10000.0
CONV_CH = BRANCH_WIDTH
CONV_WIDTH = 31
RWKV_HEADS = 4
RWKV_HEAD = BRANCH_WIDTH // RWKV_HEADS
RWKV_DECAY_RANK = 64
RWKV_AAA_RANK = 64
RWKV_GATE_RANK = 128
RWKV_SIZES = (BRANCH_WIDTH, BRANCH_WIDTH, BRANCH_WIDTH, RWKV_DECAY_RANK, RWKV_AAA_RANK, RWKV_GATE_RANK)
RWKV_COLS = sum(RWKV_SIZES)
IN_SIZES = (GLA_HEADS * GLA_DK, GLA_HEADS * GLA_DK, GLA_HEADS * GLA_DV, GLA_HEADS * GLA_DV, GLA_GATE_RANK,
            DIFF_HEADS * 2 * DIFF_DQK, DIFF_HEADS * 2 * DIFF_DQK, DIFF_HEADS * DIFF_DV,
            CONV_CH, CONV_CH,
            RWKV_COLS,
            N_BRANCH * D_MODEL)
N_IN = sum(IN_SIZES)
D_FF = ((8 * D_MODEL // 3 + 255) // 256) * 256
N_EXPERTS = 8
TOP_K = 2
D_EXPERT = 7 * D_MODEL // 2
N_DENSE = (DEPTH + 1) // 2
N_MOE = DEPTH // 2
RMS_EPS = 1e-6
LN_EPS = 1e-5
RWKV_GN_EPS = 64e-5

kernel_name = "hybrid_gated_gla_diff_conv_rwkv7_moe_block"

F32 = jnp.float32


def _split(t, sizes):
    idx = [int(i) for i in np.cumsum(sizes)[:-1]]
    return jnp.split(t, idx, axis=-1)


def rms_norm(x, g, eps=RMS_EPS):
    xf = x.astype(F32)
    y = xf * lax.rsqrt(jnp.mean(xf * xf, axis=-1, keepdims=True) + eps)
    return (y * g.astype(F32)).astype(x.dtype)


def layer_norm(x, g, b, eps=LN_EPS):
    xf = x.astype(F32)
    mu = jnp.mean(xf, axis=-1, keepdims=True)
    xc = xf - mu
    var = jnp.mean(xc * xc, axis=-1, keepdims=True)
    return (xc * lax.rsqrt(var + eps) * g.astype(F32) + b.astype(F32)).astype(x.dtype)


def rope_tables(positions):
    inv = 1.0 / (ROPE_THETA ** (jnp.arange(0, DIFF_DQK, 2, dtype=F32) / DIFF_DQK))
    ang = positions.astype(F32)[..., None] * inv
    return jnp.cos(ang), jnp.sin(ang)


def apply_rope(t, cos, sin):
    tf = t.astype(F32)
    t1, t2 = jnp.split(tf, 2, axis=-1)
    c = cos[:, :, None, None, :]
    s = sin[:, :, None, None, :]
    return jnp.concatenate([t1 * c - t2 * s, t1 * s + t2 * c], axis=-1)


def gla_mixer(q, k, v, og, gz, gate_w2, gate_b, norm_g):
    B, T, _ = q.shape
    n = T // GLA_CHUNK

    def heads(t, d):
        return t.astype(F32).reshape(B, n, GLA_CHUNK, GLA_HEADS, d).transpose(0, 3, 1, 2, 4)

    gk = jax.nn.log_sigmoid(gz.astype(F32) @ gate_w2.astype(F32) + gate_b.astype(F32)) / GLA_GATE_NORMALIZER
    qh = heads(q, GLA_DK) * (GLA_DK ** -0.5)
    kh = heads(k, GLA_DK)
    vh = heads(v, GLA_DV)
    G = jnp.cumsum(heads(gk, GLA_DK), axis=3)
    idx = jnp.arange(GLA_CHUNK)
    causal = idx[:, None] >= idx[None, :]
    gdiff = G[..., :, None, :] - G[..., None, :, :]
    decay = jnp.exp(jnp.where(causal[..., None], gdiff, -jnp.inf))
    A = jnp.einsum('bhnid,bhnjd,bhnijd->bhnij', qh, kh, decay)
    o_intra = jnp.einsum('bhnij,bhnjv->bhniv', A, vh)
    G_last = G[..., -1:, :]
    q_dec = qh * jnp.exp(G)
    k_dec = kh * jnp.exp(G_last - G)
    chunk_decay = jnp.exp(G_last[..., 0, :])

    def step(S, inp):
        qd, kd, vc, cd = inp
        o = jnp.einsum('bhid,bhdv->bhiv', qd, S)
        S = cd[..., None] * S + jnp.einsum('bhjd,bhjv->bhdv', kd, vc)
        return S, o

    S0 = jnp.zeros((B, GLA_HEADS, GLA_DK, GLA_DV), F32)
    mv = lambda t: jnp.moveaxis(t, 2, 0)
    _, o_inter = lax.scan(step, S0, (mv(q_dec), mv(k_dec), mv(vh), mv(chunk_decay)))
    o = o_intra + jnp.moveaxis(o_inter, 0, 2)
    o = o.transpose(0, 2, 3, 1, 4).reshape(B, T, GLA_HEADS, GLA_DV)
    o = rms_norm(o, norm_g) * jax.nn.silu(og.astype(F32)).reshape(B, T, GLA_HEADS, GLA_DV)
    return o.reshape(B, T, GLA_HEADS * GLA_DV).astype(q.dtype)


def diff_attention(q, k, v, cos, sin, lam_params, subln_g, layer_idx):
    B, T, _ = q.shape
    H, d = DIFF_HEADS, DIFF_DQK
    qh = apply_rope(q.reshape(B, T, H, 2, d), cos, sin).transpose(0, 2, 3, 1, 4) * (d ** -0.5)
    kh = apply_rope(k.reshape(B, T, H, 2, d), cos, sin).transpose(0, 2, 3, 1, 4)
    vh = v.astype(F32).reshape(B, T, H, DIFF_DV).transpose(0, 2, 1, 3)
    lam_init = 0.8 - 0.6 * math.exp(-0.3 * layer_idx)
    lp = lam_params.astype(F32)
    lam = jnp.exp(jnp.sum(lp[0] * lp[1])) - jnp.exp(jnp.sum(lp[2] * lp[3])) + lam_init
    outs = []
    for blk in range(T // DIFF_QBLOCK):
        start = blk * DIFF_QBLOCK
        end = start + DIFF_QBLOCK
        s = jnp.einsum('bhcqd,bhckd->bhcqk', qh[:, :, :, start:end], kh[:, :, :, :end])
        qpos = start + jnp.arange(DIFF_QBLOCK)
        kpos = jnp.arange(end)
        s = jnp.where(kpos[None, :] <= qpos[:, None], s, -jnp.inf)
        p = jax.nn.softmax(s, axis=-1)
        attn = p[:, :, 0] - lam * p[:, :, 1]
        outs.append(jnp.einsum('bhqk,bhkv->bhqv', attn, vh[:, :, :end]))
    o = jnp.concatenate(outs, axis=2)
    o = rms_norm(o, subln_g) * (1.0 - lam_init)
    return o.transpose(0, 2, 1, 3).reshape(B, T, H * DIFF_DV).astype(v.dtype)


def conformer_conv(a, b, conv_w, conv_b, ln_g, ln_b):
    u = a.astype(F32) * jax.nn.sigmoid(b.astype(F32))
    y = lax.conv_general_dilated(u, conv_w.astype(F32)[:, None, :], window_strides=(1,),
                                 padding=[(CONV_WIDTH - 1, 0)],
                                 dimension_numbers=('NWC', 'WIO', 'NWC'),
                                 feature_group_count=CONV_CH) + conv_b.astype(F32)
    y = layer_norm(y, ln_g, ln_b)
    return jax.nn.silu(y).astype(a.dtype)


def rwkv7_time_mix(cols, mu, w0, w2, a0, a2, g2, k_k, k_a, r_k, ln_g, ln_b):
    B, T, _ = cols.shape
    H, N = RWKV_HEADS, RWKV_HEAD
    xf = cols.astype(F32)
    prev = jnp.pad(xf, ((0, 0), (1, 0), (0, 0)))[:, :-1]
    xm = xf + (prev - xf) * mu.astype(F32)
    r, k, v, zw, za, zg = _split(xm, RWKV_SIZES)
    w = -jax.nn.softplus(-(w0.astype(F32) + jnp.tanh(zw) @ w2.astype(F32))) - 0.5
    decay = jnp.exp(-jnp.exp(w))
    a = jax.nn.sigmoid(a0.astype(F32) + za @ a2.astype(F32))
    g = jax.nn.sigmoid(zg) @ g2.astype(F32)
    hd = lambda t: t.reshape(B, T, H, N)
    kk = hd(k * k_k.astype(F32))
    kk = kk / jnp.maximum(jnp.sqrt(jnp.sum(kk * kk, axis=-1, keepdims=True)), 1e-12)
    k = k * (1.0 + (a - 1.0) * k_a.astype(F32))
    rh, wh, kh, vh, ah = hd(r), hd(decay), hd(k), hd(v), hd(a)

    def step(S, inp):
        rt, wt, kt, vt, kkt, at = inp
        sa = jnp.einsum('bhvk,bhk->bhv', S, -kkt)
        S = S * wt[:, :, None, :] + sa[..., None] * (kkt * at)[:, :, None, :] + vt[..., None] * kt[:, :, None, :]
        return S, jnp.einsum('bhvk,bhk->bhv', S, rt)

    seq_first = tuple(jnp.moveaxis(t, 1, 0) for t in (rh, wh, kh, vh, kk, ah))
    S0 = jnp.zeros((B, H, N, N), F32)
    _, y = lax.scan(step, S0, seq_first)
    y = jnp.moveaxis(y, 0, 1)
    y = layer_norm(y, ln_g.reshape(H, N), ln_b.reshape(H, N), eps=RWKV_GN_EPS)
    bonus = jnp.sum(rh * kh * r_k.astype(F32), axis=-1, keepdims=True) * vh
    y = (y + bonus).reshape(B, T, H * N) * g
    return y.astype(cols.dtype)


def swiglu(h, wg, wu, wd):
    return (jax.nn.silu(h @ wg) * (h @ wu)) @ wd


def moe_swiglu(h, router_w, router_b, wg, wu, wd):
    logits = h.astype(F32) @ router_w.astype(F32) + router_b.astype(F32)
    top_v, top_i = lax.top_k(logits, TOP_K)
    top_p = jax.nn.softmax(top_v, axis=-1)
    combine = jnp.sum(jax.nn.one_hot(top_i, N_EXPERTS, dtype=F32) * top_p[..., None], axis=-2)
    out = jnp.zeros(h.shape, F32)
    for e in range(N_EXPERTS):
        out = out + combine[..., e:e + 1] * swiglu(h, wg[e], wu[e], wd[e]).astype(F32)
    return out.astype(h.dtype)


def setup_inputs(seed: int = 0) -> dict:
    key = jax.random.key(seed)
    keys = jax.random.split(key, 48)
    counter = [0]

    def nk():
        kk = keys[counter[0]]
        counter[0] += 1
        return kk

    def nrm(shape, scale):
        return jax.random.normal(nk(), shape, F32) * scale

    def gain(shape):
        return 1.0 + nrm(shape, 0.02)

    D, L = D_MODEL, DEPTH
    W = BRANCH_WIDTH
    x = nrm((BATCH, SEQ, D), 1.0)
    c = nrm((BATCH, D), 1.0)
    positions = (jax.random.randint(nk(), (BATCH, 1), 0, 1024, dtype=jnp.int32)
                 + jnp.arange(SEQ, dtype=jnp.int32)[None, :])
    return {
        "x": x,
        "c": c,
        "positions": positions,
        "ada_w": nrm((L, D, 6 * D), 0.5 * D ** -0.5),
        "ada_b": nrm((L, 6 * D), 0.02),
        "norm_mix_pre": gain((L, D)),
        "norm_mix_post": gain((L, D)),
        "norm_ffn_pre": gain((L, D)),
        "norm_ffn_post": gain((L, D)),
        "w_in": nrm((L, D, N_IN), D ** -0.5),
        "gla_gate_w2": nrm((L, GLA_GATE_RANK, GLA_HEADS * GLA_DK), GLA_GATE_RANK ** -0.5),
        "gla_gate_b": 1.0 + nrm((L, GLA_HEADS * GLA_DK), 0.5),
        "gla_norm": gain((L, GLA_DV)),
        "diff_lambda": nrm((L, 4, DIFF_DQK), 0.1),
        "diff_subln": gain((L, DIFF_DV)),
        "conv_w": nrm((L, CONV_WIDTH, CONV_CH), CONV_WIDTH ** -0.5),
        "conv_b": nrm((L, CONV_CH), 0.02),
        "conv_ln_g": gain((L, CONV_CH)),
        "conv_ln_b": nrm((L, CONV_CH), 0.02),
        "rwkv_mu": jax.random.uniform(nk(), (L, RWKV_COLS), F32),
        "rwkv_w0": jax.random.uniform(nk(), (L, W), F32, minval=-3.0, maxval=1.0),
        "rwkv_w2": nrm((L, RWKV_DECAY_RANK, W), 0.5 * RWKV_DECAY_RANK ** -0.5),
        "rwkv_a0": nrm((L, W), 0.5),
        "rwkv_a2": nrm((L, RWKV_AAA_RANK, W), 0.5 * RWKV_AAA_RANK ** -0.5),
        "rwkv_g2": nrm((L, RWKV_GATE_RANK, W), RWKV_GATE_RANK ** -0.5),
        "rwkv_k_k": 0.85 + nrm((L, W), 0.05),
        "rwkv_k_a": 1.0 + nrm((L, W), 0.05),
        "rwkv_r_k": nrm((L, RWKV_HEADS, RWKV_HEAD), 0.1),
        "rwkv_ln_g": gain((L, W)),
        "rwkv_ln_b": nrm((L, W), 0.02),
        "w_branch": nrm((L, N_BRANCH, W, D), W ** -0.5),
        "w_out": nrm((L, D, D), D ** -0.5),
        "ffn_w_gate": nrm((N_DENSE, D, D_FF), D ** -0.5),
        "ffn_w_up": nrm((N_DENSE, D, D_FF), D ** -0.5),
        "ffn_w_down": nrm((N_DENSE, D_FF, D), D_FF ** -0.5),
        "router_w": nrm((N_MOE, D, N_EXPERTS), D ** -0.5),
        "router_b": nrm((N_MOE, N_EXPERTS), 0.01),
        "moe_w_gate": nrm((N_MOE, N_EXPERTS, D, D_EXPERT), D ** -0.5),
        "moe_w_up": nrm((N_MOE, N_EXPERTS, D, D_EXPERT), D ** -0.5),
        "moe_w_down": nrm((N_MOE, N_EXPERTS, D_EXPERT, D), D_EXPERT ** -0.5),
    }


def reference(x, c, positions, ada_w, ada_b, norm_mix_pre, norm_mix_post, norm_ffn_pre, norm_ffn_post,
              w_in, gla_gate_w2, gla_gate_b, gla_norm, diff_lambda, diff_subln,
              conv_w, conv_b, conv_ln_g, conv_ln_b,
              rwkv_mu, rwkv_w0, rwkv_w2, rwkv_a0, rwkv_a2, rwkv_g2, rwkv_k_k, rwkv_k_a, rwkv_r_k,
              rwkv_ln_g, rwkv_ln_b, w_branch, w_out,
              ffn_w_gate, ffn_w_up, ffn_w_down,
              router_w, router_b, moe_w_gate, moe_w_up, moe_w_down):
    B, T, D = x.shape
    cos, sin = rope_tables(positions)
    c_act = jax.nn.silu(c)
    for l in range(DEPTH):
        mod = (c_act @ ada_w[l] + ada_b[l])[:, None, :]
        sh_m, sc_m, gt_m, sh_f, sc_f, gt_f = jnp.split(mod, 6, axis=-1)

        h = rms_norm(x, norm_mix_pre[l]) * (1.0 + sc_m) + sh_m
        proj = h @ w_in[l]
        (g_q, g_k, g_v, g_o, g_z, d_q, d_k, d_v, c_a, c_b, r_cols, gate_cols) = _split(proj, IN_SIZES)
        o_gla = gla_mixer(g_q, g_k, g_v, g_o, g_z, gla_gate_w2[l], gla_gate_b[l], gla_norm[l])
        o_diff = diff_attention(d_q, d_k, d_v, cos, sin, diff_lambda[l], diff_subln[l], l)
        o_conv = conformer_conv(c_a, c_b, conv_w[l], conv_b[l], conv_ln_g[l], conv_ln_b[l])
        o_rwkv = rwkv7_time_mix(r_cols, rwkv_mu[l], rwkv_w0[l], rwkv_w2[l], rwkv_a0[l], rwkv_a2[l],
                                rwkv_g2[l], rwkv_k_k[l], rwkv_k_a[l], rwkv_r_k[l],
                                rwkv_ln_g[l], rwkv_ln_b[l])
        branches = jnp.stack([o_gla.astype(h.dtype), o_diff.astype(h.dtype),
                              o_conv.astype(h.dtype), o_rwkv.astype(h.dtype)], axis=2)
        branch_d = jnp.einsum('btgc,gcd->btgd', branches, w_branch[l])
        gates = jax.nn.sigmoid(gate_cols.reshape(B, T, N_BRANCH, D))
        merged = jnp.sum(gates * branch_d, axis=2)
        y = merged @ w_out[l]
        x = (x + gt_m * rms_norm(y, norm_mix_post[l])).astype(x.dtype)

        h = rms_norm(x, norm_ffn_pre[l]) * (1.0 + sc_f) + sh_f
        if l % 2 == 0:
            i = l // 2
            y = swiglu(h, ffn_w_gate[i], ffn_w_up[i], ffn_w_down[i])
        else:
            i = l // 2
            y = moe_swiglu(h, router_w[i], router_b[i], moe_w_gate[i], moe_w_up[i], moe_w_down[i])
        x = (x + gt_f * rms_norm(y, norm_ffn_post[l])).astype(x.dtype)
    return x
```

```cpp
#include <hip/hip_runtime.h>
#include <hip/hip_bf16.h>
#include <cstdint>
#include <cstdio>

typedef __hip_bfloat16 bf16;
typedef unsigned short bf16_t;
#define GAS __attribute__((address_space(1)))
#define LAS __attribute__((address_space(3)))

constexpr int D = 1024, NB = 8, T = 2048, M = NB * T, NL = 2;
constexpr int NIN = 7184;
constexpr int PW = 7424;
constexpr int P_GQ = 0, P_GK = 128, P_GV = 256, P_GO = 512, P_DQ = 768, P_DK = 1024, P_DV = 1280, P_CA = 1536, P_CB = 1792, P_R = 2048, P_GATE = 3072, P_GZ = 7168;
constexpr int DFF = 2816, NE = 8, DEX = 3584;
constexpr int NWAVES = 8, NTHR = 512;
constexpr size_t MiB = 1u << 20;
constexpr size_t WS_CTL = 0;
constexpr size_t CTL_ZERO_BYTES = 64 * 1024;
constexpr size_t WS_MOD = 1 * MiB;
constexpr size_t WS_ROUTE = 1 * MiB + 512 * 1024;
constexpr size_t WS_WIN = 4 * MiB;
constexpr size_t WS_WB = 33 * MiB;
constexpr size_t WS_WO = 37 * MiB;
constexpr size_t WS_WF1 = 41 * MiB;
constexpr size_t WS_WF2 = 52 * MiB;
constexpr size_t WS_HB = 58 * MiB;
constexpr size_t WS_PROJ = 90 * MiB;
constexpr size_t WS_SCR = 322 * MiB;
constexpr size_t WS_H2L1 = 508 * MiB;
constexpr size_t WS_END = 540 * MiB;
constexpr size_t WS_HG = 4 * MiB;
constexpr size_t WS_WM1 = 72 * MiB;
constexpr size_t WS_WM2 = 184 * MiB;
constexpr size_t WS_HID = 240 * MiB;
static_assert(WS_HID + (size_t)34816 * 3584 * 2 <= WS_H2L1, "moe overlay");
constexpr size_t SCR_MP = WS_SCR;
constexpr size_t SCR_MB = WS_SCR + 64 * MiB;
constexpr size_t SCR_Y = WS_SCR + 96 * MiB;
constexpr size_t SCR_RW = WS_SCR;
constexpr size_t SCR_GK = WS_SCR + 112 * MiB;
constexpr size_t SCR_QR = WS_SCR + 120 * MiB;
constexpr size_t SCR_KR = WS_SCR + 136 * MiB;
constexpr size_t SCR_VEC6 = WS_SCR;
constexpr size_t SCR_SC = WS_SCR + 96 * MiB;
constexpr size_t SCR_YR = WS_SCR + 97 * MiB;
constexpr size_t SCR_GR = WS_SCR + 113 * MiB;
constexpr size_t SCR_VT = WS_SCR + 121 * MiB;
constexpr size_t SCR_GU = WS_SCR + 129 * MiB;
constexpr size_t SCR_GS = WS_SCR + 145 * MiB;
constexpr size_t SCR_QK = WS_SCR + 161 * MiB;
constexpr size_t SCR_EG = WS_SCR + 177 * MiB;
constexpr int CW_TMO = 0;
constexpr int CW_BAR = 1024;
constexpr int CW_CNT = 8192;
constexpr size_t RT_LIST = 0;
constexpr size_t RT_TOKE = 512 * 1024;
constexpr size_t RT_TOKS = 640 * 1024;
constexpr size_t RT_TOKP = 768 * 1024;

__device__ __forceinline__ float sigm(float x) { return 1.0f / (1.0f + __expf(-x)); }
__device__ __forceinline__ float siluf(float x) { return x * sigm(x); }
__device__ __forceinline__ float softplusf(float x) { return fmaxf(x, 0.f) + log1pf(__expf(-fabsf(x))); }
__device__ __forceinline__ float wave_sum(float v) {
#pragma unroll
    for (int o = 32; o > 0; o >>= 1) v += __shfl_xor(v, o);
    return v;
}
__device__ __forceinline__ float wave_max(float v) {
#pragma unroll
    for (int o = 32; o > 0; o >>= 1) v = fmaxf(v, __shfl_xor(v, o));
    return v;
}
__device__ __forceinline__ float ldf(const float* p) { return *p; }
__device__ __forceinline__ float ldf(const bf16* p) { return __bfloat162float(*p); }
__device__ __forceinline__ float bf2f(bf16_t u) { return __builtin_bit_cast(float, (unsigned)u << 16); }
__device__ __forceinline__ unsigned f2bf(float f) { unsigned u = __builtin_bit_cast(unsigned, f); return (u + 0x7fffu + ((u >> 16) & 1u)) >> 16; }
__device__ __forceinline__ unsigned pk2(float lo, float hi) { return f2bf(lo) | (f2bf(hi) << 16); }
namespace pg8 {
#define PG8_LAS __attribute__((address_space(3)))
typedef short bf16x8 __attribute__((ext_vector_type(8)));
typedef float f32x4 __attribute__((ext_vector_type(4)));
typedef float f32x2 __attribute__((ext_vector_type(2)));
typedef unsigned u32x4 __attribute__((ext_vector_type(4)));
typedef unsigned u32x2 __attribute__((ext_vector_type(2)));
constexpr int BM = 256, BK = 64, HALF = 128, HTB = HALF * BK * 2  , STAGE_BYTES = 8 * HTB, NXCD = 8, WGM = 8;

__host__ __device__ __forceinline__ int lds_byte(int r, int c) { const int st = (r >> 4) * 2 + (c >> 5), rr = r & 15, cc = c & 31, ob = rr * 64 + cc * 2; return st * 1024 + (ob ^ (((ob >> 9) & 1) << 5)); }
__host__ __device__ __forceinline__ void stage_rc(int b, int& R, int& C) { const int st = b / 1024, sb = b % 1024, swz = sb ^ (((sb >> 9) & 1) << 5); R = (st >> 1) * 16 + swz / 64; C = (st & 1) * 32 + (swz % 64) / 2; }
__host__ __device__ __forceinline__ int perm32(int rho) { const int n = rho >> 4, i = rho & 15; return 8 * (i >> 2) + 4 * n + (i & 3); }

struct Unit { int pm, pn, aoff, tag; };
struct Gemm { const bf16_t* A; const bf16_t* Bt; int lda, ldb, K, pad; };

struct StaticOrder {
    int nM, nN, nwg, G, c;
    __host__ __device__ void init(int M_, int N_, int G_, int c_) { nM = M_ / BM; nN = N_ / BM; nwg = nM * nN; G = G_; c = c_; }
    __host__ __device__ bool next(int i, Unit& u) const {
        const long L = (long)i * G + c; if (L >= nwg) return false;
        int wgid = (int)L; { const int q = nwg / NXCD, r = nwg % NXCD, xcd = wgid % NXCD, off = wgid / NXCD; wgid = (xcd < r ? xcd * (q + 1) : r * (q + 1) + (xcd - r) * q) + off; }
        const int nig = WGM * nN, gid = wgid / nig, fm = gid * WGM, gsz = (nM - fm) < WGM ? (nM - fm) : WGM;
        u.pm = fm + ((wgid % nig) % gsz); u.pn = (wgid % nig) / gsz; u.aoff = 0; u.tag = 0; return true;
    }
};

__device__ __forceinline__ unsigned cvt_pk_bf16(float lo, float hi) { unsigned r; asm volatile("v_cvt_pk_bf16_f32 %0, %1, %2" : "=v"(r) : "v"(lo), "v"(hi)); return r; }


template <class Epi, class Sched, bool ALIGN_EPI>
__device__ __forceinline__ void gemm_phase(PG8_LAS unsigned char* lds, const Gemm g, const Sched& S, const Epi& E, int wave_s) {
    unsigned z_ = 0u; asm volatile("" : "+v"(z_));
    int tid_ = wave_s * 64 + (int)__builtin_amdgcn_mbcnt_hi(~0u, __builtin_amdgcn_mbcnt_lo(~0u, z_)); asm volatile("" : "+v"(tid_));
    const int tid = tid_, wid = __builtin_amdgcn_readfirstlane(tid >> 6), lane = tid & 63, wr = wid >> 2, wc = wid & 3, fr = lane & 15, fq = lane >> 4;
    const int K = g.K, nt = K / BK;
    unsigned voffA[2], voffB[2];
#pragma unroll
    for (int i = 0; i < 2; ++i) { int R, C; stage_rc(tid * 16 + i * 8192, R, C); const int Rb = Epi::PERM ? ((R & ~31) + perm32(R & 31)) : R;
        voffA[i] = (unsigned)(R * g.lda + C) * 2u; voffB[i] = (unsigned)(Rb * g.ldb + C) * 2u; }
    const size_t kstep = (size_t)(BK * 2);
    const size_t hstepA = (size_t)HALF * g.lda * 2, hstepB = (size_t)HALF * g.ldb * 2;
    const size_t tstepA = 2 * hstepA, tstepB = 2 * hstepB;
    const unsigned ldsw = (unsigned)wid * 1024u;
    const int aoff = lds_byte(wr * 64 + fr, fq * 8), boff = lds_byte(wc * 32 + fr, fq * 8);
#define PG8_SA(b, h) (((b) * 2 + (h)) * HTB)
#define PG8_SB(b, h) ((4 + (b) * 2 + (h)) * HTB)
#define PG8_STAGE(bufoff, gbase, voff) do { _Pragma("unroll") for (int _i = 0; _i < 2; ++_i) \
        __builtin_amdgcn_global_load_lds((const unsigned*)((const char*)(gbase) + (voff)[_i]), (PG8_LAS unsigned*)(lds + (bufoff) + ldsw + _i * 8192), 16, 0, 0); } while (0)
#define PG8_LDA(dst, b, h) do { _Pragma("unroll") for (int m = 0; m < 4; ++m) _Pragma("unroll") for (int k = 0; k < 2; ++k) dst[m][k] = *(const PG8_LAS bf16x8*)(lds + PG8_SA(b, h) + aoff + m * 2048 + k * 1024); } while (0)
#define PG8_LDB(dst, b, h) do { _Pragma("unroll") for (int n = 0; n < 2; ++n) _Pragma("unroll") for (int k = 0; k < 2; ++k) dst[n][k] = *(const PG8_LAS bf16x8*)(lds + PG8_SB(b, h) + boff + n * 2048 + k * 1024); } while (0)
#define PG8_MMA(ai, bj, At, Bt) do { __builtin_amdgcn_s_setprio(1); _Pragma("unroll") for (int m = 0; m < 4; ++m) _Pragma("unroll") for (int n = 0; n < 2; ++n) _Pragma("unroll") for (int k = 0; k < 2; ++k) \
        acc[ai][bj][m][n] = __builtin_amdgcn_mfma_f32_16x16x32_bf16(Bt[n][k], At[m][k], acc[ai][bj][m][n], 0, 0, 0); __builtin_amdgcn_s_setprio(0); } while (0)
#define PG8_WAIT_V(n) asm volatile("s_waitcnt vmcnt(" #n ")" ::: "memory")
#define PG8_WAIT_L(n) asm volatile("s_waitcnt lgkmcnt(" #n ")" ::: "memory")
#define PG8_BAR __builtin_amdgcn_s_barrier()
#define PG8_SCHED __builtin_amdgcn_sched_barrier(0)
    Unit cur, nxt; int ui = 0;
    if (!S.next(0, cur)) return;
    f32x4 acc[2][2][4][2];
#pragma unroll
    for (int a = 0; a < 2; ++a)
#pragma unroll
        for (int b = 0; b < 2; ++b)
#pragma unroll
            for (int m = 0; m < 4; ++m)
#pragma unroll
                for (int n = 0; n < 2; ++n) acc[a][b][m][n] = (f32x4){0.f, 0.f, 0.f, 0.f};
    bf16x8 At[4][2], B0[2][2], B1[2][2];
    const char* cA = (const char*)g.A + (size_t)cur.pm * tstepA + (size_t)cur.aoff * 2; const char* cB = (const char*)g.Bt + (size_t)cur.pn * tstepB;
    PG8_STAGE(PG8_SB(0, 0), cB, voffB); PG8_STAGE(PG8_SB(0, 1), cB + hstepB, voffB); PG8_STAGE(PG8_SA(0, 0), cA, voffA); PG8_STAGE(PG8_SA(0, 1), cA + hstepA, voffA);
    if (wr == 1) PG8_BAR;
    PG8_WAIT_V(2); PG8_BAR;
    PG8_STAGE(PG8_SB(1, 0), cB + kstep, voffB); PG8_STAGE(PG8_SA(1, 0), cA + kstep, voffA); PG8_STAGE(PG8_SB(1, 1), cB + hstepB + kstep, voffB);
    PG8_WAIT_V(6); PG8_BAR;
    for (;;) {
        const bool has_next = S.next(ui + 1, nxt);
        const char* nA = has_next ? (const char*)g.A + (size_t)nxt.pm * tstepA + (size_t)nxt.aoff * 2 : cA; const char* nB = has_next ? (const char*)g.Bt + (size_t)nxt.pn * tstepB : cB;
        for (int t = 0; t < nt; t += 2) {
            const bool last = (t == nt - 2);
            const char* a1 = cA + (size_t)(t + 1) * kstep;
            const char* a2 = last ? nA : cA + (size_t)(t + 2) * kstep; const char* b2 = last ? nB : cB + (size_t)(t + 2) * kstep;
            const char* a3 = a2 + kstep; const char* b3 = b2 + kstep;
            PG8_LDB(B0, 0, 0); PG8_LDB(B1, 0, 1); PG8_SCHED; PG8_LDA(At, 0, 0); PG8_STAGE(PG8_SA(1, 1), a1 + hstepA, voffA);
            PG8_WAIT_V(8); PG8_WAIT_L(0); PG8_BAR; PG8_MMA(0, 0, At, B0); PG8_MMA(0, 1, At, B1); PG8_BAR; PG8_SCHED;
            PG8_LDA(At, 0, 1); PG8_STAGE(PG8_SB(0, 0), b2, voffB); PG8_STAGE(PG8_SB(0, 1), b2 + hstepB, voffB); PG8_STAGE(PG8_SA(0, 0), a2, voffA);
            PG8_WAIT_V(8); PG8_WAIT_L(0); PG8_BAR; PG8_MMA(1, 0, At, B0); PG8_MMA(1, 1, At, B1); PG8_BAR; PG8_SCHED;
            PG8_LDB(B0, 1, 0); PG8_LDB(B1, 1, 1); PG8_SCHED; PG8_LDA(At, 1, 0); PG8_STAGE(PG8_SA(0, 1), a2 + hstepA, voffA);
            PG8_WAIT_V(8); PG8_WAIT_L(0); PG8_BAR; PG8_MMA(0, 0, At, B0); PG8_MMA(0, 1, At, B1); PG8_BAR; PG8_SCHED;
            PG8_LDA(At, 1, 1); PG8_STAGE(PG8_SB(1, 0), b3, voffB); PG8_STAGE(PG8_SB(1, 1), b3 + hstepB, voffB); PG8_STAGE(PG8_SA(1, 0), a3, voffA);
            PG8_WAIT_V(8); PG8_WAIT_L(0); PG8_BAR; PG8_MMA(1, 0, At, B0); PG8_MMA(1, 1, At, B1); PG8_BAR; PG8_SCHED;
        }
        if constexpr (ALIGN_EPI) { if (wr == 0) PG8_BAR; }
        { unsigned z2_ = 0u; asm volatile("" : "+v"(z2_)); const int l2_ = (int)__builtin_amdgcn_mbcnt_hi(~0u, __builtin_amdgcn_mbcnt_lo(~0u, z2_));
          E(acc, cur, wr, wc, l2_ & 15, l2_ >> 4); }
        if (!has_next) break;
#pragma unroll
        for (int a = 0; a < 2; ++a)
#pragma unroll
            for (int b = 0; b < 2; ++b)
#pragma unroll
                for (int m = 0; m < 4; ++m)
#pragma unroll
                    for (int n = 0; n < 2; ++n) acc[a][b][m][n] = (f32x4){0.f, 0.f, 0.f, 0.f};
        cur = nxt; cA = nA; cB = nB; ++ui;
        if constexpr (ALIGN_EPI) { if (wr == 1) PG8_BAR; }
    }
    PG8_WAIT_V(0);
    if constexpr (!ALIGN_EPI) { if (wr == 0) PG8_BAR; }
    PG8_BAR;
#undef PG8_SA
#undef PG8_SB
#undef PG8_STAGE
#undef PG8_LDA
#undef PG8_LDB
#undef PG8_MMA
#undef PG8_WAIT_V
#undef PG8_WAIT_L
#undef PG8_BAR
#undef PG8_SCHED
}

struct EpiBf16 {
    static constexpr bool PERM = true;
    bf16_t* O; int ldc; int ntn;
    __device__ __forceinline__ void operator()(const f32x4 (&acc)[2][2][4][2], const Unit& u, int wr, int wc, int fr, int fq) const {
        const int row0 = u.pm * BM + wr * 64 + fr, col0 = (u.pn % ntn) * BM + wc * 32 + 8 * fq;
#pragma unroll
        for (int ai = 0; ai < 2; ++ai)
#pragma unroll
            for (int m = 0; m < 4; ++m) { bf16_t* rowp = O + (size_t)(row0 + ai * HALF + m * 16) * ldc + col0;
#pragma unroll
                for (int bj = 0; bj < 2; ++bj) { const f32x4 v0 = acc[ai][bj][m][0], v1 = acc[ai][bj][m][1];
                    u32x4 w; w.x = cvt_pk_bf16(v0[0], v0[1]); w.y = cvt_pk_bf16(v0[2], v0[3]); w.z = cvt_pk_bf16(v1[0], v1[1]); w.w = cvt_pk_bf16(v1[2], v1[3]);
                    *(u32x4*)(rowp + bj * HALF) = w; } }
    }
};
struct EpiF32 {
    static constexpr bool PERM = false;
    float* C; int ldc; int ntn;
    __device__ __forceinline__ void operator()(const f32x4 (&acc)[2][2][4][2], const Unit& u, int wr, int wc, int fr, int fq) const {
        const int row0 = u.pm * BM + wr * 64 + fr, col0 = (u.pn % ntn) * BM + wc * 32 + 4 * fq;
#pragma unroll
        for (int ai = 0; ai < 2; ++ai)
#pragma unroll
            for (int m = 0; m < 4; ++m) { float* rowp = C + (size_t)(row0 + ai * HALF + m * 16) * ldc + col0;
#pragma unroll
                for (int bj = 0; bj < 2; ++bj)
#pragma unroll
                    for (int n = 0; n < 2; ++n) *(f32x4*)(rowp + bj * HALF + n * 16) = acc[ai][bj][m][n]; }
    }
};
struct EpiSwiglu {
    static constexpr bool PERM = true;
    bf16_t* O; int ldc; int ntn;
    __device__ __forceinline__ void operator()(const f32x4 (&acc)[2][2][4][2], const Unit& u, int wr, int wc, int fr, int fq) const {
        const int row0 = u.pm * BM + wr * 64 + fr, col0 = (u.pn % ntn) * 128 + wc * 16 + 4 * fq;
#pragma unroll
        for (int ai = 0; ai < 2; ++ai)
#pragma unroll
            for (int m = 0; m < 4; ++m) { bf16_t* rowp = O + (size_t)(row0 + ai * HALF + m * 16) * ldc + col0;
#pragma unroll
                for (int bj = 0; bj < 2; ++bj) { const f32x4 gt = acc[ai][bj][m][0], up = acc[ai][bj][m][1];
                    float h[4];
#pragma unroll
                    for (int e = 0; e < 4; ++e) h[e] = gt[e] * __builtin_amdgcn_rcpf(1.0f + __expf(-gt[e])) * up[e];
                    u32x2 w; w.x = cvt_pk_bf16(h[0], h[1]); w.y = cvt_pk_bf16(h[2], h[3]);
                    *(u32x2*)(rowp + bj * 64) = w; } }
    }
};
struct EpiBranch {
    static constexpr bool PERM = true;
    const bf16_t* proj; float* MP; bf16_t* MB;
    __device__ __forceinline__ void operator()(const f32x4 (&acc)[2][2][4][2], const Unit& u, int wr, int wc, int fr, int fq) const {
        const int g = u.tag; const int row0 = u.pm * BM + wr * 64 + fr, col0 = (u.pn & 3) * BM + wc * 32 + 8 * fq;
#pragma unroll
        for (int ai = 0; ai < 2; ++ai)
#pragma unroll
            for (int m = 0; m < 4; ++m) { const size_t row = (size_t)(row0 + ai * HALF + m * 16);
#pragma unroll
                for (int bj = 0; bj < 2; ++bj) { const int col = col0 + bj * HALF;
                    const u32x4 gw = *(const u32x4*)(proj + row * PW + P_GATE + g * 1024 + col);
                    float gv[8];
#pragma unroll
                    for (int e = 0; e < 4; ++e) { const unsigned w = gw[e]; gv[2 * e] = __builtin_bit_cast(float, w << 16); gv[2 * e + 1] = __builtin_bit_cast(float, w & 0xffff0000u); }
                    f32x4 v0 = acc[ai][bj][m][0], v1 = acc[ai][bj][m][1];
#pragma unroll
                    for (int e = 0; e < 4; ++e) { v0[e] *= __builtin_amdgcn_rcpf(1.0f + __expf(-gv[e])); v1[e] *= __builtin_amdgcn_rcpf(1.0f + __expf(-gv[4 + e])); }
                    float* mp = MP + row * D + col;
                    if (g > 0) { v0 += *(const f32x4*)mp; v1 += *(const f32x4*)(mp + 4); }
                    if (g < 3) { *(f32x4*)mp = v0; *(f32x4*)(mp + 4) = v1; }
                    else { u32x4 w; w.x = cvt_pk_bf16(v0[0], v0[1]); w.y = cvt_pk_bf16(v0[2], v0[3]); w.z = cvt_pk_bf16(v1[0], v1[1]); w.w = cvt_pk_bf16(v1[2], v1[3]);
                        *(u32x4*)(MB + row * D + col) = w; } } }
    }
};
struct BranchOrder {
    int G, c;
    __device__ bool next(int i, Unit& u) const {
        const int tile = (i >> 2) * G + c; if (tile >= 256) return false;
        const int g = i & 3; u.pm = tile >> 2; u.pn = g * 4 + (tile & 3); u.aoff = g * 256; u.tag = g; return true;
    }
};
struct MoeOrder {
    int G, c, ntiles, NT; int toff[9];
    __device__ void init(const unsigned* cnt, int G_, int c_, int NT_) { G = G_; c = c_; NT = NT_; int o = 0;
#pragma unroll
        for (int e = 0; e < 8; ++e) { toff[e] = o; o += ((int)cnt[e] + 255) >> 8; } toff[8] = o; ntiles = o; }
    __device__ bool next(int i, Unit& u) const {
        const int L = i * G + c; if (L >= ntiles * NT) return false;
        const int tau = L % ntiles, pn = L / ntiles; int e = 0;
#pragma unroll
        for (int q = 1; q < 8; ++q) e += (tau >= toff[q]) ? 1 : 0;
        u.pm = tau; u.pn = e * NT + pn; u.aoff = 0; u.tag = e; return true;
    }
};
}
typedef GAS unsigned gu32;
#define RLX_AGENT __ATOMIC_RELAXED, __HIP_MEMORY_SCOPE_AGENT
#define XB_TMO      128
#define XB_XCNT(j)  (256  + 64 * (j))
#define XB_XSUB(j)  (1280 + 64 * (j))
#define XB_XGEN(j)  (2304 + 64 * (j))
#define XB_TOP      3328
#define XB_TOPGEN   3392
#define XCD_BAR_WORDS 3456
#define XB_SPIN_CAP (1u << 18)

__device__ __forceinline__ unsigned xb_ld(unsigned* p)              { return __hip_atomic_load(p, __ATOMIC_RELAXED, __HIP_MEMORY_SCOPE_AGENT); }
__device__ __forceinline__ unsigned xb_add(unsigned* p, unsigned v) { return __hip_atomic_fetch_add(p, v, __ATOMIC_RELAXED, __HIP_MEMORY_SCOPE_AGENT); }
__device__ __forceinline__ unsigned xb_xcc_id() { return (unsigned)__builtin_amdgcn_s_getreg((3 << 11) | 20) & 0xFu; }
#define XB_SPIN(cond, bar) do { unsigned _sp = 0; while (cond) { __builtin_amdgcn_s_sleep(1); \
    if ((++_sp & 255u) == 0u) { if (xb_ld(&(bar)[XB_TMO])) break; if (_sp > XB_SPIN_CAP) { atomicAdd(&(bar)[XB_TMO], 1u); break; } } } } while (0)

struct XcdBarrier {
    unsigned* bar; unsigned x;
    volatile LAS unsigned* st;
};

__device__ __forceinline__ XcdBarrier xcd_barrier_post(unsigned* bar, volatile LAS unsigned* st) {
    XcdBarrier b; b.bar = bar; b.x = xb_xcc_id(); b.st = st;
    if (threadIdx.x == 0) (void)xb_add(&bar[XB_XCNT(b.x)], 1u);
    return b;
}
__device__ __forceinline__ void xcd_barrier_complete(unsigned* bar, unsigned x, unsigned& nloc, unsigned& nx) {
    const unsigned G = gridDim.x * gridDim.y * gridDim.z;
    unsigned sum, cnt, mine, sp = 0u;
    for (;;) {
        sum = 0u; cnt = 0u; mine = 0u;
#pragma unroll
        for (unsigned j = 0; j < 16; ++j) { const unsigned c = xb_ld(&bar[XB_XCNT(j)]); sum += c; cnt += (c > 0u) ? 1u : 0u; mine = (j == x) ? c : mine; }
        if (sum == G) break;
        __builtin_amdgcn_s_sleep(1);
        if ((++sp & 255u) == 0u) { if (xb_ld(&bar[XB_TMO])) break; if (sp > XB_SPIN_CAP) { atomicAdd(&bar[XB_TMO], 1u); break; } }
    }
    nloc = mine > 0u ? mine : 1u; nx = cnt > 0u ? cnt : 1u;
}

__device__ __forceinline__ void xcd_barrier(const XcdBarrier& b) {
    asm volatile("s_waitcnt vmcnt(0)" ::: "memory");
    __syncthreads();
    if (threadIdx.x == 0) {
        unsigned* bar = b.bar;
        __builtin_amdgcn_s_waitcnt(0);
        unsigned nloc = b.st[0], nx = b.st[1];
        if (nloc == 0u) { xcd_barrier_complete(bar, b.x, nloc, nx); b.st[0] = nloc; b.st[1] = nx; }
        const unsigned old = xb_add(&bar[XB_XSUB(b.x)], 1u);
        const unsigned gen = old / nloc;
        if (old + 1u == (gen + 1u) * nloc) {
            __builtin_amdgcn_fence(__ATOMIC_RELEASE, "agent");
            asm volatile("s_waitcnt vmcnt(0)" ::: "memory");
            const unsigned og = xb_add(&bar[XB_TOP], 1u);
            const unsigned tg = og / nx;
            if (og + 1u == (tg + 1u) * nx) xb_add(&bar[XB_TOPGEN], 1u);
            else XB_SPIN(xb_ld(&bar[XB_TOPGEN]) == tg, bar);
            __builtin_amdgcn_fence(__ATOMIC_ACQUIRE, "agent");
            xb_add(&bar[XB_XGEN(b.x)], 1u);
            asm volatile("s_waitcnt vmcnt(0)" ::: "memory");
        } else {
            XB_SPIN(xb_ld(&bar[XB_XGEN(b.x)]) == gen, bar);
            __builtin_amdgcn_fence(__ATOMIC_ACQUIRE, "agent");
            asm volatile("s_waitcnt vmcnt(0)" ::: "memory");
        }
    }
    __syncthreads();
}
struct Args { const void* in[40]; float* out; unsigned char* ws; int ph_lo, ph_hi; };

struct Frame {
    LAS unsigned char* lds;
    int wave, G, gw, NGW;
    __device__ __forceinline__ int lane() const { unsigned z = 0u; asm volatile("" : "+v"(z)); return (int)__builtin_amdgcn_mbcnt_hi(~0u, __builtin_amdgcn_mbcnt_lo(~0u, z)); }
};

#define LDS_WAIT() asm volatile("s_waitcnt lgkmcnt(0)" ::: "memory")

__device__ __forceinline__ void p0_mod_items(Frame& F, const float* c, const float* ada_w, const float* ada_b, float* mod) {
    LAS float* part = (LAS float*)F.lds;
    int tid_ = F.wave * 64 + F.lane(); asm volatile("" : "+v"(tid_)); const int lane_ = tid_ & 63;
    for (int it = blockIdx.x; it < 192; it += F.G) {
        const int l = it / 96, j0 = (it % 96) * 64;
        float acc[8];
#pragma unroll
        for (int b = 0; b < 8; ++b) acc[b] = 0.f;
        const float* w = ada_w + (size_t)l * 1024 * 6144 + j0 + lane_;
        const int k0 = F.wave * 128;
        for (int k = k0; k < k0 + 128; ++k) { const float wv = w[(size_t)k * 6144];
#pragma unroll
            for (int b = 0; b < 8; ++b) { const float cv = c[b * 1024 + k]; acc[b] += siluf(cv) * wv; } }
#pragma unroll
        for (int b = 0; b < 8; ++b) part[(F.wave * 8 + b) * 64 + lane_] = acc[b];
        __syncthreads();
        { const int b = tid_ >> 6, col = tid_ & 63; float s = 0.f;
#pragma unroll
          for (int w8 = 0; w8 < 8; ++w8) s += part[(w8 * 8 + b) * 64 + col];
          mod[(size_t)(l * 8 + b) * 6144 + j0 + col] = s + ada_b[l * 6144 + j0 + col]; }
        __syncthreads();
    }
}
__device__ __forceinline__ void cvt_item(const float* colp, size_t Ns, bf16_t* WT, int Kd, int n0, int k0, LAS float* scr, int lane) {
#pragma unroll 8
    for (int i = 0; i < 32; ++i) { const int kk = 2 * i + (lane >> 5); scr[kk * 33 + (lane & 31)] = colp ? colp[(size_t)(k0 + kk) * Ns] : 0.f; }
    LDS_WAIT(); asm volatile("" ::: "memory");
    const int cidx = lane & 7;
#pragma unroll
    for (int j = 0; j < 4; ++j) { const int n = (lane >> 3) + 8 * j; const LAS float* s = scr + (8 * cidx) * 33 + n;
        pg8::u32x4 o; o.x = pk2(s[0 * 33], s[1 * 33]); o.y = pk2(s[2 * 33], s[3 * 33]); o.z = pk2(s[4 * 33], s[5 * 33]); o.w = pk2(s[6 * 33], s[7 * 33]);
        *(pg8::u32x4*)(WT + (size_t)(n0 + n) * Kd + k0 + 8 * cidx) = o; }
    LDS_WAIT(); asm volatile("" ::: "memory");
}
__device__ __forceinline__ int win_src_col(int v) { return v < 768 ? v : (v < 7168 ? v + 16 : (v < 7184 ? v - 6400 : -1)); }

__device__ __forceinline__ void p0_convert(Frame& F, const Args& a) {
    LAS float* scr = (LAS float*)(F.lds + 16384 + F.wave * 8704);
    const float* w_in = (const float*)a.in[9]; const float* w_branch = (const float*)a.in[30]; const float* w_out = (const float*)a.in[31];
    const float* wg = (const float*)a.in[32]; const float* wu = (const float*)a.in[33]; const float* wd = (const float*)a.in[34];
    bf16_t* WIN = (bf16_t*)(a.ws + WS_WIN); bf16_t* WB = (bf16_t*)(a.ws + WS_WB); bf16_t* WO = (bf16_t*)(a.ws + WS_WO); bf16_t* WF1 = (bf16_t*)(a.ws + WS_WF1); bf16_t* WF2 = (bf16_t*)(a.ws + WS_WF2);
    constexpr int I_IN = 2 * 232 * 16, I_B = 2 * 4 * 32 * 4, I_O = 2 * 32 * 16, I_F1 = 176 * 16, I_F2 = 32 * 44;
    constexpr int NITEMS = I_IN + I_B + I_O + I_F1 + I_F2;
    int lane_ = F.lane(); asm volatile("" : "+v"(lane_));
    const int n = lane_ & 31;
    for (int it = F.gw; it < NITEMS; it += F.NGW) {
        int r = it;
        if (r < I_IN) { const int l = r / (232 * 16), q = r % (232 * 16), nb = q / 16, kb = q % 16; const int sc = win_src_col(nb * 32 + n);
            cvt_item(sc >= 0 ? w_in + (size_t)l * 1024 * NIN + sc : nullptr, NIN, WIN + (size_t)l * PW * 1024, 1024, nb * 32, kb * 64, scr, lane_); continue; } r -= I_IN;
        if (r < I_B) { const int lg = r / 128, q = r % 128, nb = q / 4, kb = q % 4;
            cvt_item(w_branch + (size_t)lg * 256 * 1024 + nb * 32 + n, 1024, WB + (size_t)lg * 1024 * 256, 256, nb * 32, kb * 64, scr, lane_); continue; } r -= I_B;
        if (r < I_O) { const int l = r / 512, q = r % 512, nb = q / 16, kb = q % 16;
            cvt_item(w_out + (size_t)l * 1024 * 1024 + nb * 32 + n, 1024, WO + (size_t)l * 1024 * 1024, 1024, nb * 32, kb * 64, scr, lane_); continue; } r -= I_O;
        if (r < I_F1) { const int nb = r / 16, kb = r % 16; const int v = nb * 32 + n; const int up = (v >> 2) & 1, j = (v >> 3) * 4 + (v & 3);
            cvt_item((up ? wu : wg) + j, DFF, WF1, 1024, nb * 32, kb * 64, scr, lane_); continue; } r -= I_F1;
        { const int nb = r / 44, kb = r % 44;
            cvt_item(wd + nb * 32 + n, 1024, WF2, DFF, nb * 32, kb * 64, scr, lane_); }
    }
}

__device__ __forceinline__ void row_load(const float* p, pg8::f32x4 (&v)[4], int lane) {
#pragma unroll
    for (int j = 0; j < 4; ++j) v[j] = *(const pg8::f32x4*)(p + 4 * lane + 256 * j);
}
__device__ __forceinline__ float row_ss(const pg8::f32x4 (&v)[4]) {
    float s = 0.f;
#pragma unroll
    for (int j = 0; j < 4; ++j) s += (v[j][0] * v[j][0] + v[j][1] * v[j][1]) + (v[j][2] * v[j][2] + v[j][3] * v[j][3]);
    return wave_sum(s);
}
__device__ __forceinline__ void row_normmod(const pg8::f32x4 (&x)[4], const float* g, const float* mb, int sh_off, int sc_off, bf16_t* hrow, pg8::f32x4 (&hv)[4], int lane) {
    const float rstd = rsqrtf(row_ss(x) * (1.0f / D) + 1e-6f);
#pragma unroll
    for (int j = 0; j < 4; ++j) { const int d = 4 * lane + 256 * j;
        const pg8::f32x4 gg = *(const pg8::f32x4*)(g + d), sc = *(const pg8::f32x4*)(mb + sc_off + d), sh = *(const pg8::f32x4*)(mb + sh_off + d);
        hv[j] = x[j] * rstd * gg * (1.0f + sc) + sh;
        pg8::u32x2 w; w.x = pk2(hv[j][0], hv[j][1]); w.y = pk2(hv[j][2], hv[j][3]);
        *(pg8::u32x2*)(hrow + d) = w; }
}
__device__ __forceinline__ void ph_h0(Frame& F, const Args& a) {
    const float* x = (const float*)a.in[0]; const float* g = (const float*)a.in[5]; const float* mod = (const float*)(a.ws + WS_MOD); bf16_t* H = (bf16_t*)(a.ws + WS_HB);
    for (int row = F.gw; row < M; row += F.NGW) { int lane = F.lane(); asm volatile("" : "+v"(lane)); pg8::f32x4 xv[4], hv[4]; row_load(x + (size_t)row * D, xv, lane);
        row_normmod(xv, g, mod + (size_t)(row / T) * 6144, 0, 1024, H + (size_t)row * D, hv, lane); }
}
__device__ __forceinline__ void ph_row(Frame& F, const Args& a, const float* xold, const float* y, const float* gpost, const float* modl, int gt_off,
                                       const float* gpre, const float* modn, int sh_off, int sc_off, bf16_t* hdst, bool route, const bf16_t* eout = nullptr) {
    float* out = a.out;
    const float* rw = (const float*)a.in[35]; const float* rb = (const float*)a.in[36];
    unsigned* cnt = (unsigned*)(a.ws + WS_CTL) + CW_CNT;
    int* list = (int*)(a.ws + WS_ROUTE + RT_LIST); int* toke = (int*)(a.ws + WS_ROUTE + RT_TOKE); int* toks = (int*)(a.ws + WS_ROUTE + RT_TOKS); float* tokp = (float*)(a.ws + WS_ROUTE + RT_TOKP);
    for (int row = F.gw; row < M; row += F.NGW) {
        int lane = F.lane(); asm volatile("" : "+v"(lane));
        const int b = row / T; pg8::f32x4 yv[4], xv[4], hv[4];
        if (eout) {
            int roff[8]; { int o = 0;
#pragma unroll
                for (int e = 0; e < 8; ++e) { roff[e] = o; o += (((int)cnt[e] + 255) >> 8) << 8; } }
            const int e1 = toke[row * 2], e2 = toke[row * 2 + 1]; int g1 = toks[row * 2], g2 = toks[row * 2 + 1];
#pragma unroll
            for (int q = 0; q < 8; ++q) { if (q == e1) g1 += roff[q]; if (q == e2) g2 += roff[q]; }
            const float p1 = tokp[row * 2], p2 = tokp[row * 2 + 1];
#pragma unroll
            for (int j = 0; j < 4; ++j) { const pg8::u32x2 a1 = *(const pg8::u32x2*)(eout + (size_t)g1 * D + 4 * lane + 256 * j), a2 = *(const pg8::u32x2*)(eout + (size_t)g2 * D + 4 * lane + 256 * j);
                yv[j][0] = p1 * __builtin_bit_cast(float, a1.x << 16) + p2 * __builtin_bit_cast(float, a2.x << 16); yv[j][1] = p1 * __builtin_bit_cast(float, a1.x & 0xffff0000u) + p2 * __builtin_bit_cast(float, a2.x & 0xffff0000u);
                yv[j][2] = p1 * __builtin_bit_cast(float, a1.y << 16) + p2 * __builtin_bit_cast(float, a2.y << 16); yv[j][3] = p1 * __builtin_bit_cast(float, a1.y & 0xffff0000u) + p2 * __builtin_bit_cast(float, a2.y & 0xffff0000u); }
        } else row_load(y + (size_t)row * D, yv, lane);
        row_load(xold + (size_t)row * D, xv, lane);
        const float rstd = rsqrtf(row_ss(yv) * (1.0f / D) + 1e-6f);
        const float* mb = modl + (size_t)b * 6144;
#pragma unroll
        for (int j = 0; j < 4; ++j) { const int d = 4 * lane + 256 * j;
            const pg8::f32x4 gp = *(const pg8::f32x4*)(gpost + d), gt = *(const pg8::f32x4*)(mb + gt_off + d);
            xv[j] = xv[j] + gt * (yv[j] * rstd * gp);
            *(pg8::f32x4*)(out + (size_t)row * D + d) = xv[j]; }
        if (hdst) {
            row_normmod(xv, gpre, modn + (size_t)b * 6144, sh_off, sc_off, hdst + (size_t)row * D, hv, lane);
            if (route) {
                float lg[8];
#pragma unroll
                for (int e = 0; e < 8; ++e) lg[e] = 0.f;
#pragma unroll
                for (int j = 0; j < 4; ++j)
#pragma unroll
                    for (int q = 0; q < 4; ++q) { const int d = 4 * lane + 256 * j + q; const pg8::f32x4 w0 = *(const pg8::f32x4*)(rw + d * 8), w1 = *(const pg8::f32x4*)(rw + d * 8 + 4); const float hq = hv[j][q];
                        lg[0] += hq * w0[0]; lg[1] += hq * w0[1]; lg[2] += hq * w0[2]; lg[3] += hq * w0[3]; lg[4] += hq * w1[0]; lg[5] += hq * w1[1]; lg[6] += hq * w1[2]; lg[7] += hq * w1[3]; }
#pragma unroll
                for (int e = 0; e < 8; ++e) lg[e] = wave_sum(lg[e]) + rb[e];
                if (lane == 0) {
                    int e1 = 0; float v1 = lg[0];
#pragma unroll
                    for (int e = 1; e < 8; ++e) if (lg[e] > v1) { v1 = lg[e]; e1 = e; }
                    int e2 = -1; float v2 = -3.0e38f;
#pragma unroll
                    for (int e = 0; e < 8; ++e) if (e != e1 && lg[e] > v2) { v2 = lg[e]; e2 = e; }
                    const float p1 = 1.0f / (1.0f + __expf(v2 - v1)), p2 = 1.0f - p1;
                    const int s1 = (int)atomicAdd(&cnt[e1], 1u), s2 = (int)atomicAdd(&cnt[e2], 1u);
                    list[e1 * M + s1] = row; list[e2 * M + s2] = row;
                    toke[row * 2] = e1; toke[row * 2 + 1] = e2; toks[row * 2] = s1; toks[row * 2 + 1] = s2; tokp[row * 2] = p1; tokp[row * 2 + 1] = p2;
                }
            }
        }
    }
}

__device__ __forceinline__ void ph_moe_prep(Frame& F, const Args& a) {
    LAS float* scr = (LAS float*)(F.lds + F.wave * 8704);
    const float* mg = (const float*)a.in[37]; const float* mu = (const float*)a.in[38]; const float* md = (const float*)a.in[39];
    bf16_t* WM1 = (bf16_t*)(a.ws + WS_WM1); bf16_t* WM2 = (bf16_t*)(a.ws + WS_WM2);
    constexpr int I_1 = 8 * 224 * 16, I_2 = 8 * 32 * 56;
    int lane_ = F.lane(); asm volatile("" : "+v"(lane_));
    const int n = lane_ & 31;
    for (int it = F.gw; it < I_1 + I_2; it += F.NGW) {
        int r = it;
        if (r < I_1) { const int e = r / 3584, q = r % 3584, nb = q / 16, kb = q % 16; const int v = nb * 32 + n; const int up = (v >> 2) & 1, j = (v >> 3) * 4 + (v & 3);
            cvt_item((up ? mu : mg) + (size_t)e * 1024 * DEX + j, DEX, WM1 + (size_t)e * 7168 * 1024, 1024, nb * 32, kb * 64, scr, lane_); continue; } r -= I_1;
        { const int e = r / 1792, q = r % 1792, nb = q / 56, kb = q % 56;
            cvt_item(md + (size_t)e * DEX * 1024 + nb * 32 + n, 1024, WM2 + (size_t)e * 1024 * DEX, DEX, nb * 32, kb * 64, scr, lane_); }
    }
    const unsigned* cnt = (const unsigned*)(a.ws + WS_CTL) + CW_CNT;
    const int* list = (const int*)(a.ws + WS_ROUTE + RT_LIST);
    const bf16_t* h2 = (const bf16_t*)(a.ws + WS_H2L1); bf16_t* hg = (bf16_t*)(a.ws + WS_HG);
    int roff[9]; { int o = 0;
#pragma unroll
        for (int e = 0; e < 8; ++e) { roff[e] = o; o += (((int)cnt[e] + 255) >> 8) << 8; } roff[8] = o; }
    for (int slot = F.gw; slot < roff[8]; slot += F.NGW) {
        int e = 0;
#pragma unroll
        for (int q = 1; q < 8; ++q) e += (slot >= roff[q]) ? 1 : 0;
        int base = 0, ce = 0;
#pragma unroll
        for (int q = 0; q < 8; ++q) if (q == e) { base = roff[q]; ce = (int)cnt[q]; }
        const int s = slot - base;
        pg8::u32x4 v0 = {0u, 0u, 0u, 0u}, v1 = {0u, 0u, 0u, 0u};
        if (s < ce) { const int src = list[e * M + s]; const pg8::u32x4* sp = (const pg8::u32x4*)(h2 + (size_t)src * D) + 2 * lane_; v0 = sp[0]; v1 = sp[1]; }
        pg8::u32x4* dp = (pg8::u32x4*)(hg + (size_t)slot * D) + 2 * lane_; dp[0] = v0; dp[1] = v1;
    }
}
template <int CTRL, int ROWMASK> __device__ __forceinline__ float dpp_mov(float old, float x) {
    return __builtin_bit_cast(float, __builtin_amdgcn_update_dpp(__builtin_bit_cast(int, old), __builtin_bit_cast(int, x), CTRL, ROWMASK, 0xF, false));
}
__device__ __forceinline__ float rdlane(float x, int l) { return __builtin_bit_cast(float, __builtin_amdgcn_readlane(__builtin_bit_cast(int, x), l)); }
__device__ __forceinline__ float wave_sum63(float x) {
    x += dpp_mov<0xB1, 0xF>(0.f, x);
    x += dpp_mov<0x4E, 0xF>(0.f, x);
    x += dpp_mov<0x141, 0xF>(0.f, x);
    x += dpp_mov<0x140, 0xF>(0.f, x);
    x += dpp_mov<0x142, 0xA>(0.f, x);
    x += dpp_mov<0x143, 0xC>(0.f, x);
    return x;
}
__device__ __forceinline__ float row16_sum(float x) {
    x += dpp_mov<0xB1, 0xF>(0.f, x); x += dpp_mov<0x4E, 0xF>(0.f, x); x += dpp_mov<0x141, 0xF>(0.f, x); x += dpp_mov<0x140, 0xF>(0.f, x);
    return x;
}
__device__ __forceinline__ pg8::f32x4 ld_bf16x4(const bf16_t* p) { const pg8::u32x2 w = *(const pg8::u32x2*)p;
    return (pg8::f32x4){__builtin_bit_cast(float, w.x << 16), __builtin_bit_cast(float, w.x & 0xffff0000u), __builtin_bit_cast(float, w.y << 16), __builtin_bit_cast(float, w.y & 0xffff0000u)}; }
__device__ __forceinline__ void st_bf16x4(bf16_t* p, pg8::f32x4 v) { pg8::u32x2 w; w.x = pk2(v[0], v[1]); w.y = pk2(v[2], v[3]); *(pg8::u32x2*)p = w; }

__device__ __forceinline__ void ph_conv(Frame& F, const Args& a, int l) {
    const bf16_t* proj = (const bf16_t*)(a.ws + WS_PROJ); bf16_t* br = (bf16_t*)(a.ws + WS_HB);
    const float* cw = (const float*)a.in[15] + l * 31 * 256; const float* cb = (const float*)a.in[16] + l * 256; const float* lg = (const float*)a.in[17] + l * 256; const float* lb = (const float*)a.in[18] + l * 256;
    LAS float* u = (LAS float*)F.lds;
    int tid = F.wave * 64 + F.lane(); asm volatile("" : "+v"(tid)); const int lane = tid & 63;
    for (int it = blockIdx.x; it < M / 64; it += F.G) {
        const int row0 = it * 64, t0 = row0 % T;
        for (int idx = tid; idx < 94 * 32; idx += NTHR) { const int r = idx >> 5, c8 = (idx & 31) * 8; float uv[8];
#pragma unroll
            for (int e = 0; e < 8; ++e) uv[e] = 0.f;
            if (t0 - 30 + r >= 0) { const bf16_t* pr = proj + (size_t)(row0 - 30 + r) * PW;
                const pg8::f32x4 a0 = ld_bf16x4(pr + P_CA + c8), a1 = ld_bf16x4(pr + P_CA + c8 + 4), b0 = ld_bf16x4(pr + P_CB + c8), b1 = ld_bf16x4(pr + P_CB + c8 + 4);
#pragma unroll
                for (int e = 0; e < 4; ++e) { uv[e] = a0[e] * sigm(b0[e]); uv[4 + e] = a1[e] * sigm(b1[e]); } }
            *(LAS pg8::f32x4*)(u + r * 256 + c8) = (pg8::f32x4){uv[0], uv[1], uv[2], uv[3]}; *(LAS pg8::f32x4*)(u + r * 256 + c8 + 4) = (pg8::f32x4){uv[4], uv[5], uv[6], uv[7]}; }
        __syncthreads();
        const int c = tid & 255, half = tid >> 8;
        float acc[32];
        { float w[31], ur[62];
#pragma unroll
          for (int j = 0; j < 31; ++j) w[j] = cw[j * 256 + c];
#pragma unroll
          for (int q = 0; q < 62; ++q) ur[q] = u[(half * 32 + q) * 256 + c];
          const float bias = cb[c];
#pragma unroll
          for (int i = 0; i < 32; ++i) { float s = bias;
#pragma unroll
              for (int j = 0; j < 31; ++j) s += w[j] * ur[i + j];
              acc[i] = s; } }
        __syncthreads();
#pragma unroll
        for (int i = 0; i < 32; ++i) u[(half * 32 + i) * 256 + c] = acc[i];
        __syncthreads();
        const pg8::f32x4 g4 = *(const pg8::f32x4*)(lg + 4 * lane), b4 = *(const pg8::f32x4*)(lb + 4 * lane);
#pragma unroll 2
        for (int q = 0; q < 8; ++q) { const int t = F.wave * 8 + q; const pg8::f32x4 yv = *(const LAS pg8::f32x4*)(u + t * 256 + 4 * lane);
            const float mu = wave_sum((yv[0] + yv[1]) + (yv[2] + yv[3])) * (1.0f / 256.0f); const pg8::f32x4 d = yv - mu;
            const float var = wave_sum((d[0] * d[0] + d[1] * d[1]) + (d[2] * d[2] + d[3] * d[3])) * (1.0f / 256.0f);
            pg8::f32x4 o = d * rsqrtf(var + 1e-5f) * g4 + b4;
#pragma unroll
            for (int e = 0; e < 4; ++e) o[e] = siluf(o[e]);
            st_bf16x4(br + (size_t)(row0 + t) * D + 512 + 4 * lane, o); }
        __syncthreads();
    }
}

__device__ __forceinline__ void ph_rwkv_prep(Frame& F, const Args& a, int l) {
    const bf16_t* proj = (const bf16_t*)(a.ws + WS_PROJ);
    const float* mu = (const float*)a.in[19] + l * 1024; const float* w0 = (const float*)a.in[20] + l * 256; const float* w2 = (const float*)a.in[21] + l * 64 * 256;
    const float* a0 = (const float*)a.in[22] + l * 256; const float* a2 = (const float*)a.in[23] + l * 64 * 256; const float* g2 = (const float*)a.in[24] + l * 128 * 256;
    const float* kkw = (const float*)a.in[25] + l * 256; const float* kaw = (const float*)a.in[26] + l * 256; const float* rkw = (const float*)a.in[27] + l * 256;
    float* VEC = (float*)(a.ws + SCR_VEC6); float* SC = (float*)(a.ws + SCR_SC); bf16_t* GR = (bf16_t*)(a.ws + SCR_GR);
    LAS float* zl = (LAS float*)F.lds;
    int tid = F.wave * 64 + F.lane(); asm volatile("" : "+v"(tid));
    for (int it = blockIdx.x; it < M / 32; it += F.G) {
        const int row0 = it * 32, b = row0 / T, t0 = row0 % T;
        for (int idx = tid; idx < 32 * 256; idx += NTHR) { const int cc = idx & 255, tok = idx >> 8; const int col = 768 + cc;
            const bf16_t* pc = proj + (size_t)(row0 + tok) * PW + P_R + col; const float xc = bf2f(pc[0]); const float xp = (t0 + tok > 0) ? bf2f(pc[-PW]) : 0.f;
            const float xm = xc + (xp - xc) * mu[col];
            zl[cc * 36 + tok] = cc < 64 ? tanhf(xm) : (cc < 128 ? xm : sigm(xm)); }
        __syncthreads();
        const int c = tid & 255, th = tid >> 8;
        float wacc[16], aacc[16], gacc[16];
        { const float w0c = w0[c], a0c = a0[c];
#pragma unroll
          for (int q = 0; q < 16; ++q) { wacc[q] = w0c; aacc[q] = a0c; gacc[q] = 0.f; } }
#pragma unroll 2
        for (int i = 0; i < 64; ++i) { const float w2v = w2[i * 256 + c], a2v = a2[i * 256 + c];
#pragma unroll
            for (int q4 = 0; q4 < 4; ++q4) { const pg8::f32x4 tz = *(const LAS pg8::f32x4*)(zl + i * 36 + th * 16 + q4 * 4), za = *(const LAS pg8::f32x4*)(zl + (64 + i) * 36 + th * 16 + q4 * 4);
#pragma unroll
                for (int e = 0; e < 4; ++e) { wacc[q4 * 4 + e] += tz[e] * w2v; aacc[q4 * 4 + e] += za[e] * a2v; } } }
#pragma unroll 2
        for (int i = 0; i < 128; ++i) { const float g2v = g2[i * 256 + c];
#pragma unroll
            for (int q4 = 0; q4 < 4; ++q4) { const pg8::f32x4 sg = *(const LAS pg8::f32x4*)(zl + (128 + i) * 36 + th * 16 + q4 * 4);
#pragma unroll
                for (int e = 0; e < 4; ++e) gacc[q4 * 4 + e] += sg[e] * g2v; } }
        const float mur = mu[c], muk = mu[256 + c], muv = mu[512 + c], kkc = kkw[c], kac = kaw[c], rkc = rkw[c];
        const int h = c >> 6, kx = c & 63;
#pragma unroll
        for (int q = 0; q < 16; ++q) { const int tok = th * 16 + q, t = t0 + tok; const size_t row = (size_t)row0 + tok;
            const bf16_t* pc = proj + row * PW + P_R + c; const bool hp = t > 0;
            const float rc = bf2f(pc[0]), kc = bf2f(pc[256]), vc = bf2f(pc[512]);
            const float rp = hp ? bf2f(pc[-PW]) : 0.f, kp = hp ? bf2f(pc[256 - PW]) : 0.f, vp = hp ? bf2f(pc[512 - PW]) : 0.f;
            const float r = rc + (rp - rc) * mur, k = kc + (kp - kc) * muk, v = vc + (vp - vc) * muv;
            const float wl = -softplusf(-wacc[q]) - 0.5f; const float decay = __expf(-__expf(wl)); const float av = sigm(aacc[q]);
            float kk = k * kkc; const float ss = wave_sum(kk * kk); kk = kk / fmaxf(sqrtf(ss), 1e-12f);
            const float k2 = k * (1.0f + (av - 1.0f) * kac); const float kka = kk * av;
            const float c1 = wave_sum(kka * r), c2 = wave_sum(k2 * r), bn = wave_sum(r * k2 * rkc);
            const size_t st = ((size_t)(b * 4 + h) * T + t);
            float* vb = VEC + st * 384 + kx;
            vb[0] = decay; vb[64] = -kk; vb[128] = kka; vb[192] = k2; vb[256] = r; vb[320] = v;
            if (kx == 0) *(pg8::f32x4*)(SC + st * 4) = (pg8::f32x4){c1, c2, bn, 0.f};
            GR[row * 256 + c] = (bf16_t)f2bf(gacc[q]); }
        __syncthreads();
    }
}

__device__ __forceinline__ void ph_rwkv_scan(Frame& F, const Args& a) {
    const float* VEC = (const float*)(a.ws + SCR_VEC6); float* YR = (float*)(a.ws + SCR_YR);
    int lane = F.lane(); asm volatile("" : "+v"(lane));
    constexpr int CH = 32, CHB = CH * 6 * 64 * 4;
    for (int it = blockIdx.x; it < 256; it += F.G) {
        const int bh = it >> 3, rg = it & 7, vrow = rg * 8 + F.wave, b = bh >> 2, h = bh & 3;
        const char* src = (const char*)(VEC + (size_t)bh * T * 384) + lane * 16;
        float S = 0.f;
#define RW_STAGE(cidx) do { _Pragma("unroll") for (int p_ = 0; p_ < 6; ++p_) \
            __builtin_amdgcn_global_load_lds((const unsigned*)(src + (size_t)(cidx) * CHB + (F.wave * 6 + p_) * 1024), (LAS unsigned*)(F.lds + ((cidx) & 1) * CHB + (F.wave * 6 + p_) * 1024), 16, 0, 0); } while (0)
        RW_STAGE(0);
        for (int c = 0; c < T / CH; ++c) {
            asm volatile("s_waitcnt vmcnt(0)" ::: "memory"); __builtin_amdgcn_s_barrier(); asm volatile("" ::: "memory");
            if (c + 1 < T / CH) RW_STAGE(c + 1);
            const LAS float* bufl = (const LAS float*)(F.lds + (c & 1) * CHB) + lane;
            const LAS float* bufv = (const LAS float*)(F.lds + (c & 1) * CHB) + 320 + vrow;
            float yacc = 0.f;
#pragma unroll 8
            for (int s = 0; s < CH; ++s) {
                const float w_ = bufl[s * 384], nkk = bufl[s * 384 + 64], kka = bufl[s * 384 + 128], k2 = bufl[s * 384 + 192], rr = bufl[s * 384 + 256], v = bufv[s * 384];
                const float sa = rdlane(wave_sum63(S * nkk), 63);
                S = S * w_ + (sa * kka + v * k2);
                const float y = rdlane(wave_sum63(S * rr), 63);
                yacc = (lane == s) ? y : yacc;
            }
            if (lane < CH) YR[((size_t)b * T + c * CH + lane) * 256 + h * 64 + vrow] = yacc;
        }
#undef RW_STAGE
        asm volatile("s_waitcnt vmcnt(0)" ::: "memory"); __builtin_amdgcn_s_barrier(); asm volatile("" ::: "memory");
    }
}

__device__ __forceinline__ void ph_rwkv_post(Frame& F, const Args& a, int l) {
    const float* VEC = (const float*)(a.ws + SCR_VEC6); const float* SC = (const float*)(a.ws + SCR_SC); const float* YR = (const float*)(a.ws + SCR_YR); const bf16_t* GR = (const bf16_t*)(a.ws + SCR_GR);
    const float* lng = (const float*)a.in[28] + l * 256; const float* lnb = (const float*)a.in[29] + l * 256;
    bf16_t* br = (bf16_t*)(a.ws + WS_HB);
    int lane = F.lane(); asm volatile("" : "+v"(lane));
    const int c = 4 * lane, h = lane >> 4;
    const pg8::f32x4 g4 = *(const pg8::f32x4*)(lng + c), b4 = *(const pg8::f32x4*)(lnb + c);
    for (int row = F.gw; row < M; row += F.NGW) {
        const int b = row / T, t = row % T; const size_t st = (size_t)(b * 4 + h) * T + t;
        const pg8::f32x4 y = *(const pg8::f32x4*)(YR + (size_t)row * 256 + c);
        const float mu = row16_sum((y[0] + y[1]) + (y[2] + y[3])) * (1.0f / 64.0f); const pg8::f32x4 d = y - mu;
        const float var = row16_sum((d[0] * d[0] + d[1] * d[1]) + (d[2] * d[2] + d[3] * d[3])) * (1.0f / 64.0f);
        const pg8::f32x4 yn = d * rsqrtf(var + 64e-5f) * g4 + b4;
        const float bonus = SC[st * 4 + 2];
        const pg8::f32x4 v = *(const pg8::f32x4*)(VEC + st * 384 + 320 + (c & 63));
        const pg8::f32x4 g = ld_bf16x4(GR + (size_t)row * 256 + c);
        st_bf16x4(br + (size_t)row * D + 768 + c, (yn + bonus * v) * g);
    }
}

__device__ __forceinline__ void ph_gla_p1(Frame& F, const Args& a, int l) {
    const bf16_t* proj = (const bf16_t*)(a.ws + WS_PROJ); const float* w2 = (const float*)a.in[10] + l * 16 * 128; const float* gb = (const float*)a.in[11] + l * 128;
    float* EG = (float*)(a.ws + SCR_EG); float* CDp = EG + (size_t)M * 128; float* GU = (float*)(a.ws + SCR_GU);
    LAS float* el = (LAS float*)(F.lds + F.wave * 8192); LAS float* kl = el + 1024;
    int lane = F.lane(); asm volatile("" : "+v"(lane));
    const int d = lane & 31;
    for (int it = F.gw; it < 2048; it += F.NGW) {
        const int bh = it >> 6, n = it & 63, b = bh >> 2, h = bh & 3; const size_t row0 = (size_t)b * T + n * 32;
        float wc[16];
#pragma unroll
        for (int r = 0; r < 16; ++r) wc[r] = w2[r * 128 + h * 32 + d];
        const float gbv = gb[h * 32 + d];
#pragma unroll 4
        for (int i = 0; i < 16; ++i) { const int tok = 2 * i + (lane >> 5); const bf16_t* pr = proj + (row0 + tok) * PW;
            const pg8::f32x4 z0 = ld_bf16x4(pr + P_GZ), z1 = ld_bf16x4(pr + P_GZ + 4), z2 = ld_bf16x4(pr + P_GZ + 8), z3 = ld_bf16x4(pr + P_GZ + 12);
            float acc = gbv;
#pragma unroll
            for (int e = 0; e < 4; ++e) acc += z0[e] * wc[e] + z1[e] * wc[4 + e] + z2[e] * wc[8 + e] + z3[e] * wc[12 + e];
            const float ev = __expf(-softplusf(-acc) * (1.0f / 16.0f));
            el[tok * 32 + d] = ev; EG[(row0 + tok) * 128 + h * 32 + d] = ev;
            kl[tok * 32 + d] = bf2f(pr[P_GK + h * 32 + d]); }
        float S[32];
#pragma unroll
        for (int q = 0; q < 32; ++q) S[q] = 0.f;
        for (int tok = 0; tok < 32; ++tok) { const float vv = bf2f(proj[(row0 + tok) * PW + P_GV + h * 64 + lane]);
#pragma unroll
            for (int j = 0; j < 8; ++j) { const pg8::f32x4 e4 = *(const LAS pg8::f32x4*)(el + tok * 32 + 4 * j), k4 = *(const LAS pg8::f32x4*)(kl + tok * 32 + 4 * j);
#pragma unroll
                for (int e = 0; e < 4; ++e) S[4 * j + e] = e4[e] * S[4 * j + e] + k4[e] * vv; } }
#pragma unroll
        for (int q = 0; q < 32; ++q) GU[((size_t)it * 32 + q) * 64 + lane] = S[q];
        if (lane < 32) { float cd = 1.f; for (int tok = 0; tok < 32; ++tok) cd *= el[tok * 32 + lane]; CDp[it * 32 + lane] = cd; }
        asm volatile("s_waitcnt lgkmcnt(0)" ::: "memory");
    }
}
__device__ __forceinline__ void ph_gla_prefix(Frame& F, const Args& a) {
    const float* CDp = (const float*)(a.ws + SCR_EG) + (size_t)M * 128; const float* GU = (const float*)(a.ws + SCR_GU); float* GS = (float*)(a.ws + SCR_GS);
    int lane = F.lane(); asm volatile("" : "+v"(lane));
    for (int it = F.gw; it < 1024; it += F.NGW) { const int bh = it >> 5, d = it & 31; float S = 0.f;
#pragma unroll 8
        for (int n = 0; n < 64; ++n) { const size_t ch = (size_t)bh * 64 + n; GS[(ch * 32 + d) * 64 + lane] = S; S = CDp[ch * 32 + d] * S + GU[(ch * 32 + d) * 64 + lane]; } }
}
__device__ __forceinline__ void ph_gla_p2(Frame& F, const Args& a, int l) {
    const bf16_t* proj = (const bf16_t*)(a.ws + WS_PROJ); const float* gnorm = (const float*)a.in[12] + l * 64;
    const float* EG = (const float*)(a.ws + SCR_EG); const float* GS = (const float*)(a.ws + SCR_GS); bf16_t* br = (bf16_t*)(a.ws + WS_HB);
    LAS float* el = (LAS float*)(F.lds + F.wave * 12288); LAS float* kl = el + 1024; LAS float* ql = el + 2048;
    int lane = F.lane(); asm volatile("" : "+v"(lane));
    const int d = lane & 31; const float gn = gnorm[lane];
    for (int it = F.gw; it < 2048; it += F.NGW) {
        const int bh = it >> 6, n = it & 63, b = bh >> 2, h = bh & 3; const size_t row0 = (size_t)b * T + n * 32;
#pragma unroll 4
        for (int i = 0; i < 16; ++i) { const int tok = 2 * i + (lane >> 5); const bf16_t* pr = proj + (row0 + tok) * PW;
            el[tok * 32 + d] = EG[(row0 + tok) * 128 + h * 32 + d]; kl[tok * 32 + d] = bf2f(pr[P_GK + h * 32 + d]); ql[tok * 32 + d] = bf2f(pr[P_GQ + h * 32 + d]) * 0.17677669529663687f; }
        float S[32];
#pragma unroll
        for (int q = 0; q < 32; ++q) S[q] = GS[((size_t)it * 32 + q) * 64 + lane];
        for (int tok = 0; tok < 32; ++tok) { const bf16_t* pr = proj + (row0 + tok) * PW; const float vv = bf2f(pr[P_GV + h * 64 + lane]); float o = 0.f;
#pragma unroll
            for (int j = 0; j < 8; ++j) { const pg8::f32x4 e4 = *(const LAS pg8::f32x4*)(el + tok * 32 + 4 * j), k4 = *(const LAS pg8::f32x4*)(kl + tok * 32 + 4 * j), q4 = *(const LAS pg8::f32x4*)(ql + tok * 32 + 4 * j);
#pragma unroll
                for (int e = 0; e < 4; ++e) { S[4 * j + e] = e4[e] * S[4 * j + e] + k4[e] * vv; o += q4[e] * S[4 * j + e]; } }
            const float ss = rdlane(wave_sum63(o * o), 63); const float rstd = rsqrtf(ss * (1.0f / 64.0f) + 1e-6f);
            const float og = bf2f(pr[P_GO + h * 64 + lane]);
            br[(row0 + tok) * D + h * 64 + lane] = (bf16_t)f2bf(o * rstd * gn * siluf(og)); }
        asm volatile("s_waitcnt lgkmcnt(0)" ::: "memory");
    }
}

typedef float f32x16 __attribute__((ext_vector_type(16)));
__device__ __forceinline__ void ph_attn_prep(Frame& F, const Args& a) {
    const bf16_t* proj = (const bf16_t*)(a.ws + WS_PROJ); const int* pos = (const int*)a.in[2];
    bf16_t* QR = (bf16_t*)(a.ws + SCR_QK); bf16_t* KR = QR + (size_t)M * 256; bf16_t* VT = (bf16_t*)(a.ws + SCR_VT);
    int lane = F.lane(); asm volatile("" : "+v"(lane));
    for (int idx = F.gw * 64 + lane; idx < M * 8; idx += F.NGW * 64) { const int row = idx >> 3, hc = idx & 7; const float p = (float)pos[row];
        const bf16_t* qs = proj + (size_t)row * PW + P_DQ + hc * 32; const bf16_t* ks = proj + (size_t)row * PW + P_DK + hc * 32;
        float qv[32], kv[32];
#pragma unroll
        for (int j = 0; j < 8; ++j) { const pg8::f32x4 q4 = ld_bf16x4(qs + 4 * j), k4 = ld_bf16x4(ks + 4 * j);
#pragma unroll
            for (int e = 0; e < 4; ++e) { qv[4 * j + e] = q4[e]; kv[4 * j + e] = k4[e]; } }
        float qo[32], ko[32];
#pragma unroll
        for (int i = 0; i < 16; ++i) { const float inv = exp2f(-(float)i * 0.8304820237218406f);
            float sn, cs; sincosf(p * inv, &sn, &cs);
            qo[i] = qv[i] * cs - qv[i + 16] * sn; qo[i + 16] = qv[i] * sn + qv[i + 16] * cs;
            ko[i] = kv[i] * cs - kv[i + 16] * sn; ko[i + 16] = kv[i] * sn + kv[i + 16] * cs; }
        const float qsc = 0.17677669529663687f * 1.4426950408889634f;
        bf16_t* qd = QR + (size_t)row * 256 + hc * 32; bf16_t* kd = KR + (size_t)row * 256 + hc * 32;
#pragma unroll
        for (int j = 0; j < 8; ++j) { st_bf16x4(qd + 4 * j, (pg8::f32x4){qo[4 * j] * qsc, qo[4 * j + 1] * qsc, qo[4 * j + 2] * qsc, qo[4 * j + 3] * qsc});
            st_bf16x4(kd + 4 * j, (pg8::f32x4){ko[4 * j], ko[4 * j + 1], ko[4 * j + 2], ko[4 * j + 3]}); } }
    for (int it = F.gw; it < 1024; it += F.NGW) { const int bh = it >> 5, tt = it & 31, b = bh >> 2, h = bh & 3;
        const bf16_t* vs = proj + ((size_t)b * T + tt * 64 + lane) * PW + P_DV + h * 64;
        pg8::u32x4 v[8];
#pragma unroll
        for (int j = 0; j < 8; ++j) v[j] = *(const pg8::u32x4*)(vs + 8 * j);
        bf16_t* vd = VT + (size_t)bh * 64 * T + tt * 64 + lane;
#pragma unroll
        for (int j = 0; j < 8; ++j)
#pragma unroll
            for (int e = 0; e < 4; ++e) { const unsigned w = v[j][e]; vd[(size_t)(8 * j + 2 * e) * T] = (bf16_t)(w & 0xffffu); vd[(size_t)(8 * j + 2 * e + 1) * T] = (bf16_t)(w >> 16); } }
}
__device__ __forceinline__ void ph_attn(Frame& F, const Args& a, int l) {
    const bf16_t* QR = (const bf16_t*)(a.ws + SCR_QK); const bf16_t* KR = QR + (size_t)M * 256; const bf16_t* VT = (const bf16_t*)(a.ws + SCR_VT);
    const float* lp = (const float*)a.in[13] + l * 128; const float* subln = (const float*)a.in[14] + l * 64; bf16_t* br = (bf16_t*)(a.ws + WS_HB);
    int tid = F.wave * 64 + F.lane(); asm volatile("" : "+v"(tid)); const int lane = tid & 63;
    const int r = lane & 31, hg = lane >> 5, comp = F.wave & 1, qs = F.wave >> 1;
    constexpr int RS = 72;
    LAS bf16_t* Kt = (LAS bf16_t*)F.lds;
    LAS bf16_t* Vt = Kt + 2 * 64 * RS;
    LAS float* Xl = (LAS float*)(F.lds + 4 * 64 * RS * 2);
    float lam, lam_init;
    { float d01 = 0.f, d23 = 0.f;
      for (int i = 0; i < 32; ++i) { d01 += lp[i] * lp[32 + i]; d23 += lp[64 + i] * lp[96 + i]; }
      lam_init = 0.8f - 0.6f * __expf(-0.3f * (float)l); lam = __expf(d01) - __expf(d23) + lam_init; }
    const int ldrow = tid >> 3, ldch = tid & 7;
    for (int pi = blockIdx.x; pi < 256; pi += F.G) {
#pragma unroll 1
        for (int half = 0; half < 2; ++half) {
            const int bh = pi >> 3, j = pi & 7, qb = half == 0 ? 15 - j : j, b = bh >> 2, h = bh & 3;
            const int q0 = qb * 128 + qs * 32, nkw = q0 / 64 + 1, nkb = 2 * qb + 2;
            const size_t rowb = (size_t)b * T;
            pg8::bf16x8 qf[2];
#pragma unroll
            for (int s = 0; s < 2; ++s) qf[s] = *(const pg8::bf16x8*)(QR + (rowb + q0 + r) * 256 + h * 64 + comp * 32 + 16 * s + 8 * hg);
            f32x16 ot[2];
#pragma unroll
            for (int e = 0; e < 16; ++e) { ot[0][e] = 0.f; ot[1][e] = 0.f; }
            float mrun = -1e30f, lrun = 0.f;
            const bf16_t* kg = KR + (rowb + ldrow) * 256 + h * 64 + ldch * 8; const bf16_t* vg = VT + ((size_t)bh * 64 + ldrow) * T + ldch * 8;
            pg8::u32x4 kreg = *(const pg8::u32x4*)kg, vreg = *(const pg8::u32x4*)vg;
            for (int kt = 0; kt < nkb; ++kt) {
                const int bo = (kt & 1) * 64 * RS;
                *(LAS pg8::u32x4*)(Kt + bo + ldrow * RS + ldch * 8) = kreg; *(LAS pg8::u32x4*)(Vt + bo + ldrow * RS + ldch * 8) = vreg;
                __syncthreads();
                if (kt + 1 < nkb) { kreg = *(const pg8::u32x4*)(kg + (size_t)(kt + 1) * 64 * 256); vreg = *(const pg8::u32x4*)(vg + (kt + 1) * 64); }
                if (kt < nkw) {
                    f32x16 st[2];
#pragma unroll
                    for (int kb = 0; kb < 2; ++kb) {
#pragma unroll
                        for (int e = 0; e < 16; ++e) st[kb][e] = 0.f;
#pragma unroll
                        for (int s = 0; s < 2; ++s) { const pg8::bf16x8 kf = *(const LAS pg8::bf16x8*)(Kt + bo + (kb * 32 + r) * RS + comp * 32 + 16 * s + 8 * hg);
                            st[kb] = __builtin_amdgcn_mfma_f32_32x32x16_bf16(kf, qf[s], st[kb], 0, 0, 0); } }
                    if (kt == nkw - 1) {
                        const int qi = q0 + r;
#pragma unroll
                        for (int kb = 0; kb < 2; ++kb)
#pragma unroll
                            for (int e = 0; e < 16; ++e) { const int ki = kt * 64 + kb * 32 + (e & 3) + 8 * (e >> 2) + 4 * hg; if (ki > qi) st[kb][e] = -1e30f; } }
                    float tm = st[0][0];
#pragma unroll
                    for (int e = 1; e < 16; ++e) tm = fmaxf(tm, st[0][e]);
#pragma unroll
                    for (int e = 0; e < 16; ++e) tm = fmaxf(tm, st[1][e]);
                    tm = fmaxf(tm, __shfl_xor(tm, 32));
                    const float mn = fmaxf(mrun, tm), alpha = exp2f(mrun - mn); mrun = mn;
                    float ps = 0.f;
#pragma unroll
                    for (int kb = 0; kb < 2; ++kb)
#pragma unroll
                        for (int e = 0; e < 16; ++e) { st[kb][e] = exp2f(st[kb][e] - mn); ps += st[kb][e]; }
                    lrun = lrun * alpha + ps;
#pragma unroll
                    for (int e = 0; e < 16; ++e) { ot[0][e] *= alpha; ot[1][e] *= alpha; }
#pragma unroll
                    for (int kb = 0; kb < 2; ++kb)
#pragma unroll
                        for (int s = 0; s < 2; ++s) {
                            pg8::u32x4 pw; pw.x = pk2(st[kb][8 * s], st[kb][8 * s + 1]); pw.y = pk2(st[kb][8 * s + 2], st[kb][8 * s + 3]); pw.z = pk2(st[kb][8 * s + 4], st[kb][8 * s + 5]); pw.w = pk2(st[kb][8 * s + 6], st[kb][8 * s + 7]);
                            const pg8::bf16x8 pf = __builtin_bit_cast(pg8::bf16x8, pw);
#pragma unroll
                            for (int dvb = 0; dvb < 2; ++dvb) { const LAS bf16_t* vp = Vt + bo + (dvb * 32 + r) * RS + kb * 32 + 16 * s + 4 * hg;
                                const pg8::u32x2 v0 = *(const LAS pg8::u32x2*)vp, v1 = *(const LAS pg8::u32x2*)(vp + 8);
                                pg8::u32x4 vw; vw.x = v0.x; vw.y = v0.y; vw.z = v1.x; vw.w = v1.y;
                                ot[dvb] = __builtin_amdgcn_mfma_f32_32x32x16_bf16(__builtin_bit_cast(pg8::bf16x8, vw), pf, ot[dvb], 0, 0, 0); } }
                }
            }
            const float ltot = lrun + __shfl_xor(lrun, 32); const float il = 1.0f / ltot;
            __syncthreads();
            if (comp == 1) {
#pragma unroll
                for (int dvb = 0; dvb < 2; ++dvb)
#pragma unroll
                    for (int e = 0; e < 16; ++e) Xl[(qs * 32 + dvb * 16 + e) * 64 + lane] = ot[dvb][e] * il; }
            __syncthreads();
            if (comp == 0) {
                float o[32]; float ss = 0.f;
#pragma unroll
                for (int dvb = 0; dvb < 2; ++dvb)
#pragma unroll
                    for (int e = 0; e < 16; ++e) { const float v = ot[dvb][e] * il - lam * Xl[(qs * 32 + dvb * 16 + e) * 64 + lane]; o[dvb * 16 + e] = v; ss += v * v; }
                ss += __shfl_xor(ss, 32);
                const float sc = rsqrtf(ss * (1.0f / 64.0f) + 1e-6f) * (1.0f - lam_init);
                bf16_t* od = br + (rowb + q0 + r) * D + 256 + h * 64;
#pragma unroll
                for (int dvb = 0; dvb < 2; ++dvb)
#pragma unroll
                    for (int g4 = 0; g4 < 4; ++g4) { const int dv0 = dvb * 32 + 8 * g4 + 4 * hg; const pg8::f32x4 sl = *(const pg8::f32x4*)(subln + dv0);
                        st_bf16x4(od + dv0, (pg8::f32x4){o[dvb * 16 + 4 * g4] * sc * sl[0], o[dvb * 16 + 4 * g4 + 1] * sc * sl[1], o[dvb * 16 + 4 * g4 + 2] * sc * sl[2], o[dvb * 16 + 4 * g4 + 3] * sc * sl[3]}); }
            }
            __syncthreads();
        }
    }
}
constexpr int RING_BYTES = 131072, LDSCTL_OFF = RING_BYTES, MISC_OFF = LDSCTL_OFF + 320, LDS_BYTES = 147456;
constexpr int PH_PRO = 0, PH_H0 = 1, PH_L0 = 2, PH_PER_LAYER = 12, PH_END = PH_L0 + 2 * PH_PER_LAYER;
constexpr int PL_PROJ = 0, PL_MIXA = 1, PL_MIXB = 2, PL_MIXC = 3, PL_BRANCH = 4, PL_OUT = 5, PL_ROWMIX = 6, PL_FFN1 = 7, PL_FFN2 = 8, PL_FFN3 = 9, PL_ROWFFN = 10;

__global__ void __launch_bounds__(NTHR, 2) mk_fwd(Args a) {
    extern __shared__ __attribute__((aligned(16))) unsigned char lds_raw[];
    Frame F;
    F.lds = (LAS unsigned char*)lds_raw;
    F.wave = __builtin_amdgcn_readfirstlane(threadIdx.x >> 6);
    F.G = gridDim.x; F.gw = blockIdx.x * NWAVES + F.wave; F.NGW = F.G * NWAVES;
    volatile LAS unsigned* MISC = (volatile LAS unsigned*)(F.lds + MISC_OFF);
    for (int u = threadIdx.x; u < (LDS_BYTES - LDSCTL_OFF) / 4; u += NTHR) ((LAS unsigned*)(F.lds + LDSCTL_OFF))[u] = 0u;
    __syncthreads();
    unsigned* ctl = (unsigned*)(a.ws + WS_CTL);
    const int lo = a.ph_lo, hi = a.ph_hi;
    XcdBarrier bar; bar.bar = ctl + CW_BAR; bar.x = 0; bar.st = nullptr;
    if (hi - lo > 1) bar = xcd_barrier_post(ctl + CW_BAR, MISC + 8);
#define IN(k) (lo <= (k) && (k) < hi)
#define SEAM(k) do { if (IN(k) && IN((k) + 1)) xcd_barrier(bar); } while (0)
    unsigned char* ws = a.ws;
    float* mod = (float*)(ws + WS_MOD);
    bf16_t* HB = (bf16_t*)(ws + WS_HB); bf16_t* PROJ = (bf16_t*)(ws + WS_PROJ); bf16_t* H2L1 = (bf16_t*)(ws + WS_H2L1);
    float* MP = (float*)(ws + SCR_MP); bf16_t* MB = (bf16_t*)(ws + SCR_MB); float* Y = (float*)(ws + SCR_Y);

    if (IN(PH_PRO)) { p0_mod_items(F, (const float*)a.in[1], (const float*)a.in[3], (const float*)a.in[4], mod); p0_convert(F, a); }
    SEAM(PH_PRO);
    if (IN(PH_H0)) ph_h0(F, a);
    SEAM(PH_H0);
#pragma unroll
    for (int l = 0; l < NL; ++l) {
        const int base = PH_L0 + l * PH_PER_LAYER;
        const float* modl = mod + (size_t)l * 8 * 6144;
        if (IN(base + PL_PROJ)) {
            pg8::Gemm g{HB, (const bf16_t*)(ws + WS_WIN) + (size_t)l * PW * 1024, 1024, 1024, 1024, 0}; pg8::StaticOrder S; S.init(M, PW, F.G, (int)blockIdx.x);
            pg8::EpiBf16 E{PROJ, PW, 29};
            pg8::gemm_phase<pg8::EpiBf16, pg8::StaticOrder, true>(F.lds, g, S, E, F.wave);
        }
        SEAM(base + PL_PROJ);
        if (IN(base + PL_MIXA)) { ph_conv(F, a, l); ph_rwkv_prep(F, a, l); ph_gla_p1(F, a, l); ph_attn_prep(F, a); }
        SEAM(base + PL_MIXA);
        if (IN(base + PL_MIXB)) { ph_gla_prefix(F, a); ph_rwkv_scan(F, a); ph_attn(F, a, l); }
        SEAM(base + PL_MIXB);
        if (IN(base + PL_MIXC)) { ph_rwkv_post(F, a, l); ph_gla_p2(F, a, l); }
        SEAM(base + PL_MIXC);
        if (IN(base + PL_BRANCH)) {
            int Kb = 256; asm volatile("" : "+s"(Kb));
            pg8::Gemm g{HB, (const bf16_t*)(ws + WS_WB) + (size_t)l * 4096 * 256, 1024, 256, Kb, 0}; pg8::BranchOrder S{F.G, (int)blockIdx.x};
            pg8::EpiBranch E{PROJ, MP, MB};
            pg8::gemm_phase<pg8::EpiBranch, pg8::BranchOrder, true>(F.lds, g, S, E, F.wave);
        }
        SEAM(base + PL_BRANCH);
        if (IN(base + PL_OUT)) {
            pg8::Gemm g{MB, (const bf16_t*)(ws + WS_WO) + (size_t)l * 1024 * 1024, 1024, 1024, 1024, 0}; pg8::StaticOrder S; S.init(M, 1024, F.G, (int)blockIdx.x);
            pg8::EpiF32 E{Y, 1024, 4};
            pg8::gemm_phase<pg8::EpiF32, pg8::StaticOrder, false>(F.lds, g, S, E, F.wave);
        }
        SEAM(base + PL_OUT);
        if (IN(base + PL_ROWMIX))
            ph_row(F, a, l == 0 ? (const float*)a.in[0] : a.out, Y, (const float*)a.in[6] + l * D, modl, 2048, (const float*)a.in[7] + l * D, modl, 3072, 4096, l == 0 ? HB : H2L1, l == 1);
        SEAM(base + PL_ROWMIX);
        if (l == 0) {
            if (IN(base + PL_FFN1)) {
                pg8::Gemm g{HB, (const bf16_t*)(ws + WS_WF1), 1024, 1024, 1024, 0}; pg8::StaticOrder S; S.init(M, 2 * DFF, F.G, (int)blockIdx.x);
                pg8::EpiSwiglu E{PROJ, DFF, 2 * DFF / 256};
                pg8::gemm_phase<pg8::EpiSwiglu, pg8::StaticOrder, true>(F.lds, g, S, E, F.wave);
            }
            SEAM(base + PL_FFN1);
            if (IN(base + PL_FFN2)) {
                pg8::Gemm g{PROJ, (const bf16_t*)(ws + WS_WF2), DFF, DFF, DFF, 0}; pg8::StaticOrder S; S.init(M, 1024, F.G, (int)blockIdx.x);
                pg8::EpiF32 E{Y, 1024, 4};
                pg8::gemm_phase<pg8::EpiF32, pg8::StaticOrder, false>(F.lds, g, S, E, F.wave);
            }
            SEAM(base + PL_FFN2);
        } else {
            const unsigned* cnt = (const unsigned*)(ws + WS_CTL) + CW_CNT;
            if (IN(base + PL_FFN1)) ph_moe_prep(F, a);
            SEAM(base + PL_FFN1);
            if (IN(base + PL_FFN2)) {
                pg8::Gemm g{(const bf16_t*)(ws + WS_HG), (const bf16_t*)(ws + WS_WM1), 1024, 1024, 1024, 0}; pg8::MoeOrder S; S.init(cnt, F.G, (int)blockIdx.x, 28);
                pg8::EpiSwiglu E{(bf16_t*)(ws + WS_HID), DEX, 28};
                pg8::gemm_phase<pg8::EpiSwiglu, pg8::MoeOrder, true>(F.lds, g, S, E, F.wave);
            }
            SEAM(base + PL_FFN2);
            if (IN(base + PL_FFN3)) {
                pg8::Gemm g{(const bf16_t*)(ws + WS_HID), (const bf16_t*)(ws + WS_WM2), DEX, DEX, DEX, 0}; pg8::MoeOrder S; S.init(cnt, F.G, (int)blockIdx.x, 4);
                pg8::EpiBf16 E{(bf16_t*)(ws + WS_HG), 1024, 4};
                pg8::gemm_phase<pg8::EpiBf16, pg8::MoeOrder, true>(F.lds, g, S, E, F.wave);
            }
            SEAM(base + PL_FFN3);
        }
        if (IN(base + PL_ROWFFN)) {
            const bool last = (l == NL - 1);
            ph_row(F, a, a.out, Y, (const float*)a.in[8] + l * D, modl, 5120, last ? nullptr : (const float*)a.in[5] + (l + 1) * D, modl + 8 * 6144, 0, 1024, last ? nullptr : HB, false, l == 0 ? nullptr : (const bf16_t*)(ws + WS_HG));
        }
        SEAM(base + PL_ROWFFN);
    }
#undef IN
#undef SEAM
}

extern "C" void kernel_launch(void* const* d_in, const int* in_sizes, int n_in, void* d_out, int out_size, void* d_ws, size_t ws_size, hipStream_t stream) {
    static int grid = 0;
    if (grid == 0) {
        if (n_in != 40 || ws_size < WS_END) { fprintf(stderr, "kernel_launch: need 40 inputs and >= %zu bytes of workspace (got %d, %zu)\n", (size_t)WS_END, n_in, ws_size); grid = -1; return; }
        int dev = 0, cus = 0, per_cu = 0;
        (void)hipGetDevice(&dev); (void)hipDeviceGetAttribute(&cus, hipDeviceAttributeMultiprocessorCount, dev);
        (void)hipFuncSetAttribute((const void*)mk_fwd, hipFuncAttributeMaxDynamicSharedMemorySize, LDS_BYTES);
        (void)hipOccupancyMaxActiveBlocksPerMultiprocessor(&per_cu, (const void*)mk_fwd, NTHR, LDS_BYTES);
        (void)hipGetLastError();
        grid = cus > 0 ? cus : 256;
        if (per_cu < 1) fprintf(stderr, "kernel_launch: occupancy query says %d blocks per CU\n", per_cu);
    }
    if (grid < 0) return;
    unsigned char* ws = (unsigned char*)d_ws;
    (void)hipMemsetAsync(ws + WS_CTL, 0, CTL_ZERO_BYTES, stream);
    Args a{};
    for (int i = 0; i < 40; ++i) a.in[i] = d_in[i];
    a.out = (float*)d_out; a.ws = ws;
    a.ph_lo = 0; a.ph_hi = PH_L0 + (NL - 1) * PH_PER_LAYER + PL_ROWFFN + 1;
    hipLaunchKernelGGL(mk_fwd, dim3(grid), dim3(NTHR), LDS_BYTES, stream, a);
}
```

```cpp
#include <hip/hip_runtime.h>
#include <hip/hip_bf16.h>
#include <cstdint>
#include <cstdio>

typedef __hip_bfloat16 bf16;
typedef unsigned short bf16_t;
#define GAS __attribute__((address_space(1)))
#define LAS __attribute__((address_space(3)))

constexpr int D = 1024, NB = 8, T = 2048, M = NB * T, NL = 2;
constexpr int NIN = 7184;
constexpr int PW = 7424;
constexpr int P_GQ = 0, P_GK = 128, P_GV = 256, P_GO = 512, P_DQ = 768, P_DK = 1024, P_DV = 1280, P_CA = 1536, P_CB = 1792, P_R = 2048, P_GATE = 3072, P_GZ = 7168;
constexpr int DFF = 2816, NE = 8, DEX = 3584;
constexpr int NWAVES = 8, NTHR = 512;
constexpr size_t MiB = 1u << 20;
constexpr size_t WS_CTL = 0;
constexpr size_t CTL_ZERO_BYTES = 64 * 1024;
constexpr size_t WS_MOD = 1 * MiB;
constexpr size_t WS_ROUTE = 1 * MiB + 512 * 1024;
constexpr size_t WS_WIN = 4 * MiB;
constexpr size_t WS_WB = 33 * MiB;
constexpr size_t WS_WO = 37 * MiB;
constexpr size_t WS_WF1 = 41 * MiB;
constexpr size_t WS_WF2 = 52 * MiB;
constexpr size_t WS_HB = 58 * MiB;
constexpr size_t WS_PROJ = 90 * MiB;
constexpr size_t WS_SCR = 322 * MiB;
constexpr size_t WS_H2L1 = 508 * MiB;
constexpr size_t WS_END = 540 * MiB;
constexpr size_t WS_HG = 4 * MiB;
constexpr size_t WS_WM1 = 72 * MiB;
constexpr size_t WS_WM2 = 184 * MiB;
constexpr size_t WS_HID = 240 * MiB;
static_assert(WS_HID + (size_t)34816 * 3584 * 2 <= WS_H2L1, "moe overlay");
constexpr size_t SCR_MP = WS_SCR;
constexpr size_t SCR_MB = WS_SCR + 64 * MiB;
constexpr size_t SCR_Y = WS_SCR + 96 * MiB;
constexpr size_t SCR_RW = WS_SCR;
constexpr size_t SCR_GK = WS_SCR + 112 * MiB;
constexpr size_t SCR_QR = WS_SCR + 120 * MiB;
constexpr size_t SCR_KR = WS_SCR + 136 * MiB;
constexpr size_t SCR_VEC6 = WS_SCR;
constexpr size_t SCR_SC = WS_SCR + 112 * MiB;
constexpr size_t SCR_YR = WS_SCR + 113 * MiB;
constexpr size_t SCR_GR = WS_SCR + 129 * MiB;
constexpr size_t SCR_VT = WS_SCR + 137 * MiB;
constexpr size_t SCR_GU = WS_SCR + 145 * MiB;
constexpr size_t SCR_GS = SCR_GU;
constexpr size_t SCR_QK = WS_SCR + 161 * MiB;
constexpr size_t SCR_EG = WS_SCR + 177 * MiB;
constexpr int VSTEP = 448;
constexpr int CW_TMO = 0;
constexpr int CW_BAR = 1024;
constexpr int CW_CNT = 8192;
constexpr size_t RT_LIST = 0;
constexpr size_t RT_TOKE = 512 * 1024;
constexpr size_t RT_TOKS = 640 * 1024;
constexpr size_t RT_TOKP = 768 * 1024;

__device__ __forceinline__ float sigm(float x) { return 1.0f / (1.0f + __expf(-x)); }
__device__ __forceinline__ float siluf(float x) { return x * sigm(x); }
__device__ __forceinline__ float softplusf(float x) { return fmaxf(x, 0.f) + log1pf(__expf(-fabsf(x))); }
__device__ __forceinline__ float wave_sum(float v) {
#pragma unroll
    for (int o = 32; o > 0; o >>= 1) v += __shfl_xor(v, o);
    return v;
}
__device__ __forceinline__ float wave_max(float v) {
#pragma unroll
    for (int o = 32; o > 0; o >>= 1) v = fmaxf(v, __shfl_xor(v, o));
    return v;
}
__device__ __forceinline__ float ldf(const float* p) { return *p; }
__device__ __forceinline__ float ldf(const bf16* p) { return __bfloat162float(*p); }
__device__ __forceinline__ float bf2f(bf16_t u) { return __builtin_bit_cast(float, (unsigned)u << 16); }
__device__ __forceinline__ unsigned f2bf(float f) { unsigned u = __builtin_bit_cast(unsigned, f); return (u + 0x7fffu + ((u >> 16) & 1u)) >> 16; }
__device__ __forceinline__ unsigned pk2(float lo, float hi) { return f2bf(lo) | (f2bf(hi) << 16); }
namespace pg8 {
#define PG8_LAS __attribute__((address_space(3)))
typedef short bf16x8 __attribute__((ext_vector_type(8)));
typedef float f32x4 __attribute__((ext_vector_type(4)));
typedef float f32x2 __attribute__((ext_vector_type(2)));
typedef unsigned u32x4 __attribute__((ext_vector_type(4)));
typedef unsigned u32x2 __attribute__((ext_vector_type(2)));
constexpr int BM = 256, BK = 64, HALF = 128, HTB = HALF * BK * 2  , STAGE_BYTES = 8 * HTB, NXCD = 8, WGM = 8;

__host__ __device__ __forceinline__ int lds_byte(int r, int c) { const int st = (r >> 4) * 2 + (c >> 5), rr = r & 15, cc = c & 31, ob = rr * 64 + cc * 2; return st * 1024 + (ob ^ (((ob >> 9) & 1) << 5)); }
__host__ __device__ __forceinline__ void stage_rc(int b, int& R, int& C) { const int st = b / 1024, sb = b % 1024, swz = sb ^ (((sb >> 9) & 1) << 5); R = (st >> 1) * 16 + swz / 64; C = (st & 1) * 32 + (swz % 64) / 2; }
__host__ __device__ __forceinline__ int perm32(int rho) { const int n = rho >> 4, i = rho & 15; return 8 * (i >> 2) + 4 * n + (i & 3); }

struct Unit { int pm, pn, aoff, tag; };
struct Gemm { const bf16_t* A; const bf16_t* Bt; int lda, ldb, K, pad; };

struct StaticOrder {
    int nM, nN, nwg, G, c;
    __host__ __device__ void init(int M_, int N_, int G_, int c_) { nM = M_ / BM; nN = N_ / BM; nwg = nM * nN; G = G_; c = c_; }
    __host__ __device__ bool next(int i, Unit& u) const {
        const long L = (long)i * G + c; if (L >= nwg) return false;
        int wgid = (int)L; { const int q = nwg / NXCD, r = nwg % NXCD, xcd = wgid % NXCD, off = wgid / NXCD; wgid = (xcd < r ? xcd * (q + 1) : r * (q + 1) + (xcd - r) * q) + off; }
        const int nig = WGM * nN, gid = wgid / nig, fm = gid * WGM, gsz = (nM - fm) < WGM ? (nM - fm) : WGM;
        u.pm = fm + ((wgid % nig) % gsz); u.pn = (wgid % nig) / gsz; u.aoff = 0; u.tag = 0; return true;
    }
};

__device__ __forceinline__ unsigned cvt_pk_bf16(float lo, float hi) { unsigned r; asm volatile("v_cvt_pk_bf16_f32 %0, %1, %2" : "=v"(r) : "v"(lo), "v"(hi)); return r; }


template <class Epi, class Sched, bool ALIGN_EPI>
__device__ __forceinline__ void gemm_phase(PG8_LAS unsigned char* lds, const Gemm g, const Sched& S, const Epi& E, int wave_s) {
    unsigned z_ = 0u; asm volatile("" : "+v"(z_));
    int tid_ = wave_s * 64 + (int)__builtin_amdgcn_mbcnt_hi(~0u, __builtin_amdgcn_mbcnt_lo(~0u, z_)); asm volatile("" : "+v"(tid_));
    const int tid = tid_, wid = __builtin_amdgcn_readfirstlane(tid >> 6), lane = tid & 63, wr = wid >> 2, wc = wid & 3, fr = lane & 15, fq = lane >> 4;
    const int K = g.K, nt = K / BK;
    unsigned voffA[2], voffB[2];
#pragma unroll
    for (int i = 0; i < 2; ++i) { int R, C; stage_rc(tid * 16 + i * 8192, R, C); const int Rb = Epi::PERM ? ((R & ~31) + perm32(R & 31)) : R;
        voffA[i] = (unsigned)(R * g.lda + C) * 2u; voffB[i] = (unsigned)(Rb * g.ldb + C) * 2u; }
    const size_t kstep = (size_t)(BK * 2);
    const size_t hstepA = (size_t)HALF * g.lda * 2, hstepB = (size_t)HALF * g.ldb * 2;
    const size_t tstepA = 2 * hstepA, tstepB = 2 * hstepB;
    const unsigned ldsw = (unsigned)wid * 1024u;
    const int aoff = lds_byte(wr * 64 + fr, fq * 8), boff = lds_byte(wc * 32 + fr, fq * 8);
#define PG8_SA(b, h) (((b) * 2 + (h)) * HTB)
#define PG8_SB(b, h) ((4 + (b) * 2 + (h)) * HTB)
#define PG8_STAGE(bufoff, gbase, voff) do { _Pragma("unroll") for (int _i = 0; _i < 2; ++_i) \
        __builtin_amdgcn_global_load_lds((const unsigned*)((const char*)(gbase) + (voff)[_i]), (PG8_LAS unsigned*)(lds + (bufoff) + ldsw + _i * 8192), 16, 0, 0); } while (0)
#define PG8_LDA(dst, b, h) do { _Pragma("unroll") for (int m = 0; m < 4; ++m) _Pragma("unroll") for (int k = 0; k < 2; ++k) dst[m][k] = *(const PG8_LAS bf16x8*)(lds + PG8_SA(b, h) + aoff + m * 2048 + k * 1024); } while (0)
#define PG8_LDB(dst, b, h) do { _Pragma("unroll") for (int n = 0; n < 2; ++n) _Pragma("unroll") for (int k = 0; k < 2; ++k) dst[n][k] = *(const PG8_LAS bf16x8*)(lds + PG8_SB(b, h) + boff + n * 2048 + k * 1024); } while (0)
#define PG8_MMA(ai, bj, At, Bt) do { __builtin_amdgcn_s_setprio(1); _Pragma("unroll") for (int m = 0; m < 4; ++m) _Pragma("unroll") for (int n = 0; n < 2; ++n) _Pragma("unroll") for (int k = 0; k < 2; ++k) \
        acc[ai][bj][m][n] = __builtin_amdgcn_mfma_f32_16x16x32_bf16(Bt[n][k], At[m][k], acc[ai][bj][m][n], 0, 0, 0); __builtin_amdgcn_s_setprio(0); } while (0)
#define PG8_WAIT_V(n) asm volatile("s_waitcnt vmcnt(" #n ")" ::: "memory")
#define PG8_WAIT_L(n) asm volatile("s_waitcnt lgkmcnt(" #n ")" ::: "memory")
#define PG8_BAR __builtin_amdgcn_s_barrier()
#define PG8_SCHED __builtin_amdgcn_sched_barrier(0)
    Unit cur, nxt; int ui = 0;
    if (!S.next(0, cur)) return;
    f32x4 acc[2][2][4][2];
#pragma unroll
    for (int a = 0; a < 2; ++a)
#pragma unroll
        for (int b = 0; b < 2; ++b)
#pragma unroll
            for (int m = 0; m < 4; ++m)
#pragma unroll
                for (int n = 0; n < 2; ++n) acc[a][b][m][n] = (f32x4){0.f, 0.f, 0.f, 0.f};
    bf16x8 At[4][2], B0[2][2], B1[2][2];
    const char* cA = (const char*)g.A + (size_t)cur.pm * tstepA + (size_t)cur.aoff * 2; const char* cB = (const char*)g.Bt + (size_t)cur.pn * tstepB;
    PG8_STAGE(PG8_SB(0, 0), cB, voffB); PG8_STAGE(PG8_SB(0, 1), cB + hstepB, voffB); PG8_STAGE(PG8_SA(0, 0), cA, voffA); PG8_STAGE(PG8_SA(0, 1), cA + hstepA, voffA);
    if (wr == 1) PG8_BAR;
    PG8_WAIT_V(2); PG8_BAR;
    PG8_STAGE(PG8_SB(1, 0), cB + kstep, voffB); PG8_STAGE(PG8_SA(1, 0), cA + kstep, voffA); PG8_STAGE(PG8_SB(1, 1), cB + hstepB + kstep, voffB);
    PG8_WAIT_V(6); PG8_BAR;
    for (;;) {
        const bool has_next = S.next(ui + 1, nxt);
        const char* nA = has_next ? (const char*)g.A + (size_t)nxt.pm * tstepA + (size_t)nxt.aoff * 2 : cA; const char* nB = has_next ? (const char*)g.Bt + (size_t)nxt.pn * tstepB : cB;
        for (int t = 0; t < nt; t += 2) {
            const bool last = (t == nt - 2);
            const char* a1 = cA + (size_t)(t + 1) * kstep;
            const char* a2 = last ? nA : cA + (size_t)(t + 2) * kstep; const char* b2 = last ? nB : cB + (size_t)(t + 2) * kstep;
            const char* a3 = a2 + kstep; const char* b3 = b2 + kstep;
            PG8_LDB(B0, 0, 0); PG8_LDB(B1, 0, 1); PG8_SCHED; PG8_LDA(At, 0, 0); PG8_STAGE(PG8_SA(1, 1), a1 + hstepA, voffA);
            PG8_WAIT_V(8); PG8_WAIT_L(0); PG8_BAR; PG8_MMA(0, 0, At, B0); PG8_MMA(0, 1, At, B1); PG8_BAR; PG8_SCHED;
            PG8_LDA(At, 0, 1); PG8_STAGE(PG8_SB(0, 0), b2, voffB); PG8_STAGE(PG8_SB(0, 1), b2 + hstepB, voffB); PG8_STAGE(PG8_SA(0, 0), a2, voffA);
            PG8_WAIT_V(8); PG8_WAIT_L(0); PG8_BAR; PG8_MMA(1, 0, At, B0); PG8_MMA(1, 1, At, B1); PG8_BAR; PG8_SCHED;
            PG8_LDB(B0, 1, 0); PG8_LDB(B1, 1, 1); PG8_SCHED; PG8_LDA(At, 1, 0); PG8_STAGE(PG8_SA(0, 1), a2 + hstepA, voffA);
            PG8_WAIT_V(8); PG8_WAIT_L(0); PG8_BAR; PG8_MMA(0, 0, At, B0); PG8_MMA(0, 1, At, B1); PG8_BAR; PG8_SCHED;
            PG8_LDA(At, 1, 1); PG8_STAGE(PG8_SB(1, 0), b3, voffB); PG8_STAGE(PG8_SB(1, 1), b3 + hstepB, voffB); PG8_STAGE(PG8_SA(1, 0), a3, voffA);
            PG8_WAIT_V(8); PG8_WAIT_L(0); PG8_BAR; PG8_MMA(1, 0, At, B0); PG8_MMA(1, 1, At, B1); PG8_BAR; PG8_SCHED;
        }
        if constexpr (ALIGN_EPI) { if (wr == 0) PG8_BAR; }
        { unsigned z2_ = 0u; asm volatile("" : "+v"(z2_)); const int l2_ = (int)__builtin_amdgcn_mbcnt_hi(~0u, __builtin_amdgcn_mbcnt_lo(~0u, z2_));
          E(acc, cur, wr, wc, l2_ & 15, l2_ >> 4); }
        if (!has_next) break;
#pragma unroll
        for (int a = 0; a < 2; ++a)
#pragma unroll
            for (int b = 0; b < 2; ++b)
#pragma unroll
                for (int m = 0; m < 4; ++m)
#pragma unroll
                    for (int n = 0; n < 2; ++n) acc[a][b][m][n] = (f32x4){0.f, 0.f, 0.f, 0.f};
        cur = nxt; cA = nA; cB = nB; ++ui;
        if constexpr (ALIGN_EPI) { if (wr == 1) PG8_BAR; }
    }
    PG8_WAIT_V(0);
    if constexpr (!ALIGN_EPI) { if (wr == 0) PG8_BAR; }
    PG8_BAR;
#undef PG8_SA
#undef PG8_SB
#undef PG8_STAGE
#undef PG8_LDA
#undef PG8_LDB
#undef PG8_MMA
#undef PG8_WAIT_V
#undef PG8_WAIT_L
#undef PG8_BAR
#undef PG8_SCHED
}

struct EpiBf16 {
    static constexpr bool PERM = true;
    bf16_t* O; int ldc; int ntn;
    __device__ __forceinline__ void operator()(const f32x4 (&acc)[2][2][4][2], const Unit& u, int wr, int wc, int fr, int fq) const {
        const int row0 = u.pm * BM + wr * 64 + fr, col0 = (u.pn % ntn) * BM + wc * 32 + 8 * fq;
#pragma unroll
        for (int ai = 0; ai < 2; ++ai)
#pragma unroll
            for (int m = 0; m < 4; ++m) { bf16_t* rowp = O + (size_t)(row0 + ai * HALF + m * 16) * ldc + col0;
#pragma unroll
                for (int bj = 0; bj < 2; ++bj) { const f32x4 v0 = acc[ai][bj][m][0], v1 = acc[ai][bj][m][1];
                    u32x4 w; w.x = cvt_pk_bf16(v0[0], v0[1]); w.y = cvt_pk_bf16(v0[2], v0[3]); w.z = cvt_pk_bf16(v1[0], v1[1]); w.w = cvt_pk_bf16(v1[2], v1[3]);
                    *(u32x4*)(rowp + bj * HALF) = w; } }
    }
};
struct EpiF32 {
    static constexpr bool PERM = false;
    float* C; int ldc; int ntn;
    __device__ __forceinline__ void operator()(const f32x4 (&acc)[2][2][4][2], const Unit& u, int wr, int wc, int fr, int fq) const {
        const int row0 = u.pm * BM + wr * 64 + fr, col0 = (u.pn % ntn) * BM + wc * 32 + 4 * fq;
#pragma unroll
        for (int ai = 0; ai < 2; ++ai)
#pragma unroll
            for (int m = 0; m < 4; ++m) { float* rowp = C + (size_t)(row0 + ai * HALF + m * 16) * ldc + col0;
#pragma unroll
                for (int bj = 0; bj < 2; ++bj)
#pragma unroll
                    for (int n = 0; n < 2; ++n) *(f32x4*)(rowp + bj * HALF + n * 16) = acc[ai][bj][m][n]; }
    }
};
struct EpiSwiglu {
    static constexpr bool PERM = true;
    bf16_t* O; int ldc; int ntn;
    __device__ __forceinline__ void operator()(const f32x4 (&acc)[2][2][4][2], const Unit& u, int wr, int wc, int fr, int fq) const {
        const int row0 = u.pm * BM + wr * 64 + fr, col0 = (u.pn % ntn) * 128 + wc * 16 + 4 * fq;
#pragma unroll
        for (int ai = 0; ai < 2; ++ai)
#pragma unroll
            for (int m = 0; m < 4; ++m) { bf16_t* rowp = O + (size_t)(row0 + ai * HALF + m * 16) * ldc + col0;
#pragma unroll
                for (int bj = 0; bj < 2; ++bj) { const f32x4 gt = acc[ai][bj][m][0], up = acc[ai][bj][m][1];
                    float h[4];
#pragma unroll
                    for (int e = 0; e < 4; ++e) h[e] = gt[e] * __builtin_amdgcn_rcpf(1.0f + __expf(-gt[e])) * up[e];
                    u32x2 w; w.x = cvt_pk_bf16(h[0], h[1]); w.y = cvt_pk_bf16(h[2], h[3]);
                    *(u32x2*)(rowp + bj * 64) = w; } }
    }
};
struct EpiBranch {
    static constexpr bool PERM = true;
    const bf16_t* proj; float* MP; bf16_t* MB;
    __device__ __forceinline__ void operator()(const f32x4 (&acc)[2][2][4][2], const Unit& u, int wr, int wc, int fr, int fq) const {
        const int g = u.tag; const int row0 = u.pm * BM + wr * 64 + fr, col0 = (u.pn & 3) * BM + wc * 32 + 8 * fq;
#pragma unroll
        for (int ai = 0; ai < 2; ++ai)
#pragma unroll
            for (int m = 0; m < 4; ++m) { const size_t row = (size_t)(row0 + ai * HALF + m * 16);
#pragma unroll
                for (int bj = 0; bj < 2; ++bj) { const int col = col0 + bj * HALF;
                    const u32x4 gw = *(const u32x4*)(proj + row * PW + P_GATE + g * 1024 + col);
                    float gv[8];
#pragma unroll
                    for (int e = 0; e < 4; ++e) { const unsigned w = gw[e]; gv[2 * e] = __builtin_bit_cast(float, w << 16); gv[2 * e + 1] = __builtin_bit_cast(float, w & 0xffff0000u); }
                    f32x4 v0 = acc[ai][bj][m][0], v1 = acc[ai][bj][m][1];
#pragma unroll
                    for (int e = 0; e < 4; ++e) { v0[e] *= __builtin_amdgcn_rcpf(1.0f + __expf(-gv[e])); v1[e] *= __builtin_amdgcn_rcpf(1.0f + __expf(-gv[4 + e])); }
                    float* mp = MP + row * D + col;
                    if (g > 0) { v0 += *(const f32x4*)mp; v1 += *(const f32x4*)(mp + 4); }
                    if (g < 3) { *(f32x4*)mp = v0; *(f32x4*)(mp + 4) = v1; }
                    else { u32x4 w; w.x = cvt_pk_bf16(v0[0], v0[1]); w.y = cvt_pk_bf16(v0[2], v0[3]); w.z = cvt_pk_bf16(v1[0], v1[1]); w.w = cvt_pk_bf16(v1[2], v1[3]);
                        *(u32x4*)(MB + row * D + col) = w; } } }
    }
};
struct BranchOrder {
    int G, c;
    __device__ bool next(int i, Unit& u) const {
        const int tile = (i >> 2) * G + c; if (tile >= 256) return false;
        const int g = i & 3; u.pm = tile >> 2; u.pn = g * 4 + (tile & 3); u.aoff = g * 256; u.tag = g; return true;
    }
};
struct MoeOrder {
    int G, c, ntiles, NT; int toff[9];
    __device__ void init(const unsigned* cnt, int G_, int c_, int NT_) { G = G_; c = c_; NT = NT_; int o = 0;
#pragma unroll
        for (int e = 0; e < 8; ++e) { toff[e] = o; o += ((int)cnt[e] + 255) >> 8; } toff[8] = o; ntiles = o; }
    __device__ bool next(int i, Unit& u) const {
        const int L = i * G + c; if (L >= ntiles * NT) return false;
        const int tau = L % ntiles, pn = L / ntiles; int e = 0;
#pragma unroll
        for (int q = 1; q < 8; ++q) e += (tau >= toff[q]) ? 1 : 0;
        u.pm = tau; u.pn = e * NT + pn; u.aoff = 0; u.tag = e; return true;
    }
};
}
typedef GAS unsigned gu32;
#define RLX_AGENT __ATOMIC_RELAXED, __HIP_MEMORY_SCOPE_AGENT
#define XB_TMO      128
#define XB_XCNT(j)  (256  + 64 * (j))
#define XB_XSUB(j)  (1280 + 64 * (j))
#define XB_XGEN(j)  (2304 + 64 * (j))
#define XB_TOP      3328
#define XB_TOPGEN   3392
#define XCD_BAR_WORDS 3456
#define XB_SPIN_CAP (1u << 18)

__device__ __forceinline__ unsigned xb_ld(unsigned* p)              { return __hip_atomic_load(p, __ATOMIC_RELAXED, __HIP_MEMORY_SCOPE_AGENT); }
__device__ __forceinline__ unsigned xb_add(unsigned* p, unsigned v) { return __hip_atomic_fetch_add(p, v, __ATOMIC_RELAXED, __HIP_MEMORY_SCOPE_AGENT); }
__device__ __forceinline__ unsigned xb_xcc_id() { return (unsigned)__builtin_amdgcn_s_getreg((3 << 11) | 20) & 0xFu; }
#define XB_SPIN(cond, bar) do { unsigned _sp = 0; while (cond) { __builtin_amdgcn_s_sleep(1); \
    if ((++_sp & 255u) == 0u) { if (xb_ld(&(bar)[XB_TMO])) break; if (_sp > XB_SPIN_CAP) { atomicAdd(&(bar)[XB_TMO], 1u); break; } } } } while (0)

struct XcdBarrier {
    unsigned* bar; unsigned x;
    volatile LAS unsigned* st;
};

__device__ __forceinline__ XcdBarrier xcd_barrier_post(unsigned* bar, volatile LAS unsigned* st) {
    XcdBarrier b; b.bar = bar; b.x = xb_xcc_id(); b.st = st;
    if (threadIdx.x == 0) (void)xb_add(&bar[XB_XCNT(b.x)], 1u);
    return b;
}
__device__ __forceinline__ void xcd_barrier_complete(unsigned* bar, unsigned x, unsigned& nloc, unsigned& nx) {
    const unsigned G = gridDim.x * gridDim.y * gridDim.z;
    unsigned sum, cnt, mine, sp = 0u;
    for (;;) {
        sum = 0u; cnt = 0u; mine = 0u;
#pragma unroll
        for (unsigned j = 0; j < 16; ++j) { const unsigned c = xb_ld(&bar[XB_XCNT(j)]); sum += c; cnt += (c > 0u) ? 1u : 0u; mine = (j == x) ? c : mine; }
        if (sum == G) break;
        __builtin_amdgcn_s_sleep(1);
        if ((++sp & 255u) == 0u) { if (xb_ld(&bar[XB_TMO])) break; if (sp > XB_SPIN_CAP) { atomicAdd(&bar[XB_TMO], 1u); break; } }
    }
    nloc = mine > 0u ? mine : 1u; nx = cnt > 0u ? cnt : 1u;
}

__device__ __forceinline__ void xcd_barrier(const XcdBarrier& b) {
    asm volatile("s_waitcnt vmcnt(0)" ::: "memory");
    __syncthreads();
    if (threadIdx.x == 0) {
        unsigned* bar = b.bar;
        __builtin_amdgcn_s_waitcnt(0);
        unsigned nloc = b.st[0], nx = b.st[1];
        if (nloc == 0u) { xcd_barrier_complete(bar, b.x, nloc, nx); b.st[0] = nloc; b.st[1] = nx; }
        const unsigned old = xb_add(&bar[XB_XSUB(b.x)], 1u);
        const unsigned gen = old / nloc;
        if (old + 1u == (gen + 1u) * nloc) {
            __builtin_amdgcn_fence(__ATOMIC_RELEASE, "agent");
            asm volatile("s_waitcnt vmcnt(0)" ::: "memory");
            const unsigned og = xb_add(&bar[XB_TOP], 1u);
            const unsigned tg = og / nx;
            if (og + 1u == (tg + 1u) * nx) xb_add(&bar[XB_TOPGEN], 1u);
            else XB_SPIN(xb_ld(&bar[XB_TOPGEN]) == tg, bar);
            __builtin_amdgcn_fence(__ATOMIC_ACQUIRE, "agent");
            xb_add(&bar[XB_XGEN(b.x)], 1u);
            asm volatile("s_waitcnt vmcnt(0)" ::: "memory");
        } else {
            XB_SPIN(xb_ld(&bar[XB_XGEN(b.x)]) == gen, bar);
            __builtin_amdgcn_fence(__ATOMIC_ACQUIRE, "agent");
            asm volatile("s_waitcnt vmcnt(0)" ::: "memory");
        }
    }
    __syncthreads();
}
struct Args { const void* in[40]; float* out; unsigned char* ws; int ph_lo, ph_hi; };
typedef const __attribute__((address_space(4))) Args* ArgsP;
__device__ __forceinline__ ArgsP fresh_args() { ArgsP p = (ArgsP)__builtin_amdgcn_kernarg_segment_ptr(); asm volatile("" : "+s"(p)); return p; }

struct Frame {
    LAS unsigned char* lds;
    int wave, G, gw, NGW;
    __device__ __forceinline__ int lane() const { unsigned z = 0u; asm volatile("" : "+v"(z)); return (int)__builtin_amdgcn_mbcnt_hi(~0u, __builtin_amdgcn_mbcnt_lo(~0u, z)); }
};

__device__ __forceinline__ Frame fresh(const Frame& F) { Frame R = F; asm volatile("" : "+s"(R.wave), "+s"(R.G), "+s"(R.gw), "+s"(R.NGW)); return R; }
#define LDS_WAIT() asm volatile("s_waitcnt lgkmcnt(0)" ::: "memory")

__device__ __forceinline__ void p0_mod_items(Frame& F, const float* c, const float* ada_w, const float* ada_b, float* mod) {
    LAS float* part = (LAS float*)F.lds;
    int tid_ = F.wave * 64 + F.lane(); asm volatile("" : "+v"(tid_)); const int lane_ = tid_ & 63;
    for (int it = blockIdx.x; it < 192; it += F.G) {
        const int l = it / 96, j0 = (it % 96) * 64;
        float acc[8];
#pragma unroll
        for (int b = 0; b < 8; ++b) acc[b] = 0.f;
        const float* w = ada_w + (size_t)l * 1024 * 6144 + j0 + lane_;
        const int k0 = F.wave * 128;
        for (int k = k0; k < k0 + 128; ++k) { const float wv = w[(size_t)k * 6144];
#pragma unroll
            for (int b = 0; b < 8; ++b) { const float cv = c[b * 1024 + k]; acc[b] += siluf(cv) * wv; } }
#pragma unroll
        for (int b = 0; b < 8; ++b) part[(F.wave * 8 + b) * 64 + lane_] = acc[b];
        __syncthreads();
        { const int b = tid_ >> 6, col = tid_ & 63; float s = 0.f;
#pragma unroll
          for (int w8 = 0; w8 < 8; ++w8) s += part[(w8 * 8 + b) * 64 + col];
          mod[(size_t)(l * 8 + b) * 6144 + j0 + col] = s + ada_b[l * 6144 + j0 + col]; }
        __syncthreads();
    }
}
__device__ __forceinline__ void cvt_item(const float* colp, size_t Ns, bf16_t* WT, int Kd, int n0, int k0, LAS float* scr, int lane) {
    const int q4 = 4 * (lane & 7), kr = lane >> 3;
    pg8::f32x4 v[8];
#pragma unroll
    for (int i = 0; i < 8; ++i) v[i] = colp ? *(const pg8::f32x4*)(colp + (size_t)(k0 + 8 * i + kr) * Ns) : (pg8::f32x4){0.f, 0.f, 0.f, 0.f};
#pragma unroll
    for (int i = 0; i < 8; ++i)
#pragma unroll
        for (int e = 0; e < 4; ++e) scr[(8 * i + kr) * 33 + q4 + e] = v[i][e];
    LDS_WAIT(); asm volatile("" ::: "memory");
    const int cidx = lane & 7;
#pragma unroll
    for (int j = 0; j < 4; ++j) { const int n = (lane >> 3) + 8 * j; const LAS float* s = scr + (8 * cidx) * 33 + n;
        pg8::u32x4 o; o.x = pk2(s[0 * 33], s[1 * 33]); o.y = pk2(s[2 * 33], s[3 * 33]); o.z = pk2(s[4 * 33], s[5 * 33]); o.w = pk2(s[6 * 33], s[7 * 33]);
        *(pg8::u32x4*)(WT + (size_t)(n0 + n) * Kd + k0 + 8 * cidx) = o; }
    LDS_WAIT(); asm volatile("" ::: "memory");
}
__device__ __forceinline__ int win_src_col(int v) { return v < 768 ? v : (v < 7168 ? v + 16 : (v < 7184 ? v - 6400 : -1)); }

__device__ __forceinline__ void p0_convert(Frame& F, ArgsP a) {
    LAS float* scr = (LAS float*)(F.lds + 16384 + F.wave * 8704);
    const float* w_in = (const float*)a->in[9]; const float* w_branch = (const float*)a->in[30]; const float* w_out = (const float*)a->in[31];
    const float* wg = (const float*)a->in[32]; const float* wu = (const float*)a->in[33]; const float* wd = (const float*)a->in[34];
    bf16_t* WIN = (bf16_t*)(a->ws + WS_WIN); bf16_t* WB = (bf16_t*)(a->ws + WS_WB); bf16_t* WO = (bf16_t*)(a->ws + WS_WO); bf16_t* WF1 = (bf16_t*)(a->ws + WS_WF1); bf16_t* WF2 = (bf16_t*)(a->ws + WS_WF2);
    constexpr int I_IN = 2 * 232 * 16, I_B = 2 * 4 * 32 * 4, I_O = 2 * 32 * 16, I_F1 = 176 * 16, I_F2 = 32 * 44;
    constexpr int NITEMS = I_IN + I_B + I_O + I_F1 + I_F2;
    int lane_ = F.lane(); asm volatile("" : "+v"(lane_));
    const int n = 4 * (lane_ & 7);
    for (int it = F.gw; it < NITEMS; it += F.NGW) {
        int r = it;
        if (r < I_IN) { const int l = r / (232 * 16), q = r % (232 * 16), nb = q / 16, kb = q % 16; const int sc = win_src_col(nb * 32 + n);
            cvt_item(sc >= 0 ? w_in + (size_t)l * 1024 * NIN + sc : nullptr, NIN, WIN + (size_t)l * PW * 1024, 1024, nb * 32, kb * 64, scr, lane_); continue; } r -= I_IN;
        if (r < I_B) { const int lg = r / 128, q = r % 128, nb = q / 4, kb = q % 4;
            cvt_item(w_branch + (size_t)lg * 256 * 1024 + nb * 32 + n, 1024, WB + (size_t)lg * 1024 * 256, 256, nb * 32, kb * 64, scr, lane_); continue; } r -= I_B;
        if (r < I_O) { const int l = r / 512, q = r % 512, nb = q / 16, kb = q % 16;
            cvt_item(w_out + (size_t)l * 1024 * 1024 + nb * 32 + n, 1024, WO + (size_t)l * 1024 * 1024, 1024, nb * 32, kb * 64, scr, lane_); continue; } r -= I_O;
        if (r < I_F1) { const int nb = r / 16, kb = r % 16; const int v = nb * 32 + n; const int up = (v >> 2) & 1, j = (v >> 3) * 4 + (v & 3);
            cvt_item((up ? wu : wg) + j, DFF, WF1, 1024, nb * 32, kb * 64, scr, lane_); continue; } r -= I_F1;
        { const int nb = r / 44, kb = r % 44;
            cvt_item(wd + nb * 32 + n, 1024, WF2, DFF, nb * 32, kb * 64, scr, lane_); }
    }
}

__device__ __forceinline__ void row_load(const float* p, pg8::f32x4 (&v)[4], int lane) {
#pragma unroll
    for (int j = 0; j < 4; ++j) v[j] = *(const pg8::f32x4*)(p + 4 * lane + 256 * j);
}
__device__ __forceinline__ float row_ss(const pg8::f32x4 (&v)[4]) {
    float s = 0.f;
#pragma unroll
    for (int j = 0; j < 4; ++j) s += (v[j][0] * v[j][0] + v[j][1] * v[j][1]) + (v[j][2] * v[j][2] + v[j][3] * v[j][3]);
    return wave_sum(s);
}
__device__ __forceinline__ void row_normmod(const pg8::f32x4 (&x)[4], const float* g, const float* mb, int sh_off, int sc_off, bf16_t* hrow, pg8::f32x4 (&hv)[4], int lane) {
    const float rstd = rsqrtf(row_ss(x) * (1.0f / D) + 1e-6f);
#pragma unroll
    for (int j = 0; j < 4; ++j) { const int d = 4 * lane + 256 * j;
        const pg8::f32x4 gg = *(const pg8::f32x4*)(g + d), sc = *(const pg8::f32x4*)(mb + sc_off + d), sh = *(const pg8::f32x4*)(mb + sh_off + d);
        hv[j] = x[j] * rstd * gg * (1.0f + sc) + sh;
        pg8::u32x2 w; w.x = pk2(hv[j][0], hv[j][1]); w.y = pk2(hv[j][2], hv[j][3]);
        *(pg8::u32x2*)(hrow + d) = w; }
}
__device__ __forceinline__ void ph_h0(Frame& F, ArgsP a) {
    const float* x = (const float*)a->in[0]; const float* g = (const float*)a->in[5]; const float* mod = (const float*)(a->ws + WS_MOD); bf16_t* H = (bf16_t*)(a->ws + WS_HB);
    for (int row = F.gw; row < M; row += F.NGW) { int lane = F.lane(); asm volatile("" : "+v"(lane)); pg8::f32x4 xv[4], hv[4]; row_load(x + (size_t)row * D, xv, lane);
        row_normmod(xv, g, mod + (size_t)(row / T) * 6144, 0, 1024, H + (size_t)row * D, hv, lane); }
}
__device__ __forceinline__ void ph_row(Frame& F, ArgsP a, const float* xold, const float* y, const float* gpost, const float* modl, int gt_off,
                                       const float* gpre, const float* modn, int sh_off, int sc_off, bf16_t* hdst, bool route, const bf16_t* eout = nullptr) {
    float* out = a->out;
    const float* rw = (const float*)a->in[35]; const float* rb = (const float*)a->in[36];
    unsigned* cnt = (unsigned*)(a->ws + WS_CTL) + CW_CNT;
    int* list = (int*)(a->ws + WS_ROUTE + RT_LIST); int* toke = (int*)(a->ws + WS_ROUTE + RT_TOKE); int* toks = (int*)(a->ws + WS_ROUTE + RT_TOKS); float* tokp = (float*)(a->ws + WS_ROUTE + RT_TOKP);
    for (int row = F.gw; row < M; row += F.NGW) {
        int lane = F.lane(); asm volatile("" : "+v"(lane));
        const int b = row / T; pg8::f32x4 yv[4], xv[4], hv[4];
        if (eout) {
            int roff[8]; { int o = 0;
#pragma unroll
                for (int e = 0; e < 8; ++e) { roff[e] = o; o += (((int)cnt[e] + 255) >> 8) << 8; } }
            const int e1 = toke[row * 2], e2 = toke[row * 2 + 1]; int g1 = toks[row * 2], g2 = toks[row * 2 + 1];
#pragma unroll
            for (int q = 0; q < 8; ++q) { if (q == e1) g1 += roff[q]; if (q == e2) g2 += roff[q]; }
            const float p1 = tokp[row * 2], p2 = tokp[row * 2 + 1];
#pragma unroll
            for (int j = 0; j < 4; ++j) { const pg8::u32x2 a1 = *(const pg8::u32x2*)(eout + (size_t)g1 * D + 4 * lane + 256 * j), a2 = *(const pg8::u32x2*)(eout + (size_t)g2 * D + 4 * lane + 256 * j);
                yv[j][0] = p1 * __builtin_bit_cast(float, a1.x << 16) + p2 * __builtin_bit_cast(float, a2.x << 16); yv[j][1] = p1 * __builtin_bit_cast(float, a1.x & 0xffff0000u) + p2 * __builtin_bit_cast(float, a2.x & 0xffff0000u);
                yv[j][2] = p1 * __builtin_bit_cast(float, a1.y << 16) + p2 * __builtin_bit_cast(float, a2.y << 16); yv[j][3] = p1 * __builtin_bit_cast(float, a1.y & 0xffff0000u) + p2 * __builtin_bit_cast(float, a2.y & 0xffff0000u); }
        } else row_load(y + (size_t)row * D, yv, lane);
        row_load(xold + (size_t)row * D, xv, lane);
        const float rstd = rsqrtf(row_ss(yv) * (1.0f / D) + 1e-6f);
        const float* mb = modl + (size_t)b * 6144;
#pragma unroll
        for (int j = 0; j < 4; ++j) { const int d = 4 * lane + 256 * j;
            const pg8::f32x4 gp = *(const pg8::f32x4*)(gpost + d), gt = *(const pg8::f32x4*)(mb + gt_off + d);
            xv[j] = xv[j] + gt * (yv[j] * rstd * gp);
            *(pg8::f32x4*)(out + (size_t)row * D + d) = xv[j]; }
        if (hdst) {
            row_normmod(xv, gpre, modn + (size_t)b * 6144, sh_off, sc_off, hdst + (size_t)row * D, hv, lane);
            if (route) {
                float lg[8];
#pragma unroll
                for (int e = 0; e < 8; ++e) lg[e] = 0.f;
#pragma unroll
                for (int j = 0; j < 4; ++j)
#pragma unroll
                    for (int q = 0; q < 4; ++q) { const int d = 4 * lane + 256 * j + q; const pg8::f32x4 w0 = *(const pg8::f32x4*)(rw + d * 8), w1 = *(const pg8::f32x4*)(rw + d * 8 + 4); const float hq = hv[j][q];
                        lg[0] += hq * w0[0]; lg[1] += hq * w0[1]; lg[2] += hq * w0[2]; lg[3] += hq * w0[3]; lg[4] += hq * w1[0]; lg[5] += hq * w1[1]; lg[6] += hq * w1[2]; lg[7] += hq * w1[3]; }
#pragma unroll
                for (int e = 0; e < 8; ++e) lg[e] = wave_sum(lg[e]) + rb[e];
                if (lane == 0) {
                    int e1 = 0; float v1 = lg[0];
#pragma unroll
                    for (int e = 1; e < 8; ++e) if (lg[e] > v1) { v1 = lg[e]; e1 = e; }
                    int e2 = -1; float v2 = -3.0e38f;
#pragma unroll
                    for (int e = 0; e < 8; ++e) if (e != e1 && lg[e] > v2) { v2 = lg[e]; e2 = e; }
                    const float p1 = 1.0f / (1.0f + __expf(v2 - v1)), p2 = 1.0f - p1;
                    const int s1 = (int)atomicAdd(&cnt[e1], 1u), s2 = (int)atomicAdd(&cnt[e2], 1u);
                    list[e1 * M + s1] = row; list[e2 * M + s2] = row;
                    toke[row * 2] = e1; toke[row * 2 + 1] = e2; toks[row * 2] = s1; toks[row * 2 + 1] = s2; tokp[row * 2] = p1; tokp[row * 2 + 1] = p2;
                }
            }
        }
    }
}

__device__ __forceinline__ void ph_moe_prep(Frame& F, ArgsP a) {
    LAS float* scr = (LAS float*)(F.lds + F.wave * 8704);
    const float* mg = (const float*)a->in[37]; const float* mu = (const float*)a->in[38]; const float* md = (const float*)a->in[39];
    bf16_t* WM1 = (bf16_t*)(a->ws + WS_WM1); bf16_t* WM2 = (bf16_t*)(a->ws + WS_WM2);
    constexpr int I_1 = 8 * 224 * 16, I_2 = 8 * 32 * 56;
    int lane_ = F.lane(); asm volatile("" : "+v"(lane_));
    const int n = 4 * (lane_ & 7);
    for (int it = F.gw; it < I_1 + I_2; it += F.NGW) {
        int r = it;
        if (r < I_1) { const int e = r / 3584, q = r % 3584, nb = q / 16, kb = q % 16; const int v = nb * 32 + n; const int up = (v >> 2) & 1, j = (v >> 3) * 4 + (v & 3);
            cvt_item((up ? mu : mg) + (size_t)e * 1024 * DEX + j, DEX, WM1 + (size_t)e * 7168 * 1024, 1024, nb * 32, kb * 64, scr, lane_); continue; } r -= I_1;
        { const int e = r / 1792, q = r % 1792, nb = q / 56, kb = q % 56;
            cvt_item(md + (size_t)e * DEX * 1024 + nb * 32 + n, 1024, WM2 + (size_t)e * 1024 * DEX, DEX, nb * 32, kb * 64, scr, lane_); }
    }
    const unsigned* cnt = (const unsigned*)(a->ws + WS_CTL) + CW_CNT;
    const int* list = (const int*)(a->ws + WS_ROUTE + RT_LIST);
    const bf16_t* h2 = (const bf16_t*)(a->ws + WS_H2L1); bf16_t* hg = (bf16_t*)(a->ws + WS_HG);
    int roff[9]; { int o = 0;
#pragma unroll
        for (int e = 0; e < 8; ++e) { roff[e] = o; o += (((int)cnt[e] + 255) >> 8) << 8; } roff[8] = o; }
    for (int slot = F.gw; slot < roff[8]; slot += F.NGW) {
        int e = 0;
#pragma unroll
        for (int q = 1; q < 8; ++q) e += (slot >= roff[q]) ? 1 : 0;
        int base = 0, ce = 0;
#pragma unroll
        for (int q = 0; q < 8; ++q) if (q == e) { base = roff[q]; ce = (int)cnt[q]; }
        const int s = slot - base;
        pg8::u32x4 v0 = {0u, 0u, 0u, 0u}, v1 = {0u, 0u, 0u, 0u};
        if (s < ce) { const int src = list[e * M + s]; const pg8::u32x4* sp = (const pg8::u32x4*)(h2 + (size_t)src * D) + 2 * lane_; v0 = sp[0]; v1 = sp[1]; }
        pg8::u32x4* dp = (pg8::u32x4*)(hg + (size_t)slot * D) + 2 * lane_; dp[0] = v0; dp[1] = v1;
    }
}
template <int CTRL, int ROWMASK> __device__ __forceinline__ float dpp_mov(float old, float x) {
    return __builtin_bit_cast(float, __builtin_amdgcn_update_dpp(__builtin_bit_cast(int, old), __builtin_bit_cast(int, x), CTRL, ROWMASK, 0xF, false));
}
__device__ __forceinline__ float rdlane(float x, int l) { return __builtin_bit_cast(float, __builtin_amdgcn_readlane(__builtin_bit_cast(int, x), l)); }
__device__ __forceinline__ float wave_sum63(float x) {
    x += dpp_mov<0xB1, 0xF>(0.f, x);
    x += dpp_mov<0x4E, 0xF>(0.f, x);
    x += dpp_mov<0x141, 0xF>(0.f, x);
    x += dpp_mov<0x140, 0xF>(0.f, x);
    x += dpp_mov<0x142, 0xA>(0.f, x);
    x += dpp_mov<0x143, 0xC>(0.f, x);
    return x;
}
__device__ __forceinline__ float row16_sum(float x) {
    x += dpp_mov<0xB1, 0xF>(0.f, x); x += dpp_mov<0x4E, 0xF>(0.f, x); x += dpp_mov<0x141, 0xF>(0.f, x); x += dpp_mov<0x140, 0xF>(0.f, x);
    return x;
}
__device__ __forceinline__ pg8::f32x4 ld_bf16x4(const bf16_t* p) { const pg8::u32x2 w = *(const pg8::u32x2*)p;
    return (pg8::f32x4){__builtin_bit_cast(float, w.x << 16), __builtin_bit_cast(float, w.x & 0xffff0000u), __builtin_bit_cast(float, w.y << 16), __builtin_bit_cast(float, w.y & 0xffff0000u)}; }
__device__ __forceinline__ void st_bf16x4(bf16_t* p, pg8::f32x4 v) { pg8::u32x2 w; w.x = pk2(v[0], v[1]); w.y = pk2(v[2], v[3]); *(pg8::u32x2*)p = w; }

__device__ __forceinline__ void ph_conv(Frame& F, ArgsP a, int l) {
    const bf16_t* proj = (const bf16_t*)(a->ws + WS_PROJ); bf16_t* br = (bf16_t*)(a->ws + WS_HB);
    const float* cw = (const float*)a->in[15] + l * 31 * 256; const float* cb = (const float*)a->in[16] + l * 256; const float* lg = (const float*)a->in[17] + l * 256; const float* lb = (const float*)a->in[18] + l * 256;
    LAS float* u = (LAS float*)F.lds;
    int tid = F.wave * 64 + F.lane(); asm volatile("" : "+v"(tid)); const int lane = tid & 63;
    for (int it = blockIdx.x; it < M / 64; it += F.G) {
        const int row0 = it * 64, t0 = row0 % T;
        for (int idx = tid; idx < 94 * 32; idx += NTHR) { const int r = idx >> 5, c8 = (idx & 31) * 8; float uv[8];
#pragma unroll
            for (int e = 0; e < 8; ++e) uv[e] = 0.f;
            if (t0 - 30 + r >= 0) { const bf16_t* pr = proj + (size_t)(row0 - 30 + r) * PW;
                const pg8::f32x4 a0 = ld_bf16x4(pr + P_CA + c8), a1 = ld_bf16x4(pr + P_CA + c8 + 4), b0 = ld_bf16x4(pr + P_CB + c8), b1 = ld_bf16x4(pr + P_CB + c8 + 4);
#pragma unroll
                for (int e = 0; e < 4; ++e) { uv[e] = a0[e] * sigm(b0[e]); uv[4 + e] = a1[e] * sigm(b1[e]); } }
            *(LAS pg8::f32x4*)(u + r * 256 + c8) = (pg8::f32x4){uv[0], uv[1], uv[2], uv[3]}; *(LAS pg8::f32x4*)(u + r * 256 + c8 + 4) = (pg8::f32x4){uv[4], uv[5], uv[6], uv[7]}; }
        __syncthreads();
        const int c = tid & 255, half = tid >> 8;
        float acc[32];
        { float w[31], ur[62];
#pragma unroll
          for (int j = 0; j < 31; ++j) w[j] = cw[j * 256 + c];
#pragma unroll
          for (int q = 0; q < 62; ++q) ur[q] = u[(half * 32 + q) * 256 + c];
          const float bias = cb[c];
#pragma unroll
          for (int i = 0; i < 32; ++i) { float s = bias;
#pragma unroll
              for (int j = 0; j < 31; ++j) s += w[j] * ur[i + j];
              acc[i] = s; } }
        __syncthreads();
#pragma unroll
        for (int i = 0; i < 32; ++i) u[(half * 32 + i) * 256 + c] = acc[i];
        __syncthreads();
        const pg8::f32x4 g4 = *(const pg8::f32x4*)(lg + 4 * lane), b4 = *(const pg8::f32x4*)(lb + 4 * lane);
#pragma unroll 2
        for (int q = 0; q < 8; ++q) { const int t = F.wave * 8 + q; const pg8::f32x4 yv = *(const LAS pg8::f32x4*)(u + t * 256 + 4 * lane);
            const float mu = wave_sum((yv[0] + yv[1]) + (yv[2] + yv[3])) * (1.0f / 256.0f); const pg8::f32x4 d = yv - mu;
            const float var = wave_sum((d[0] * d[0] + d[1] * d[1]) + (d[2] * d[2] + d[3] * d[3])) * (1.0f / 256.0f);
            pg8::f32x4 o = d * rsqrtf(var + 1e-5f) * g4 + b4;
#pragma unroll
            for (int e = 0; e < 4; ++e) o[e] = siluf(o[e]);
            st_bf16x4(br + (size_t)(row0 + t) * D + 512 + 4 * lane, o); }
        __syncthreads();
    }
}

__device__ __forceinline__ void ph_rwkv_prep(Frame& F, ArgsP a, int l) {
    const bf16_t* proj = (const bf16_t*)(a->ws + WS_PROJ);
    const float* mu = (const float*)a->in[19] + l * 1024; const float* w0 = (const float*)a->in[20] + l * 256; const float* w2 = (const float*)a->in[21] + l * 64 * 256;
    const float* a0 = (const float*)a->in[22] + l * 256; const float* a2 = (const float*)a->in[23] + l * 64 * 256; const float* g2 = (const float*)a->in[24] + l * 128 * 256;
    const float* kkw = (const float*)a->in[25] + l * 256; const float* kaw = (const float*)a->in[26] + l * 256; const float* rkw = (const float*)a->in[27] + l * 256;
    float* VEC = (float*)(a->ws + SCR_VEC6); float* SC = (float*)(a->ws + SCR_SC); bf16_t* GR = (bf16_t*)(a->ws + SCR_GR);
    LAS float* zl = (LAS float*)F.lds;
    int tid = F.wave * 64 + F.lane(); asm volatile("" : "+v"(tid));
    for (int it = blockIdx.x; it < M / 32; it += F.G) {
        const int row0 = it * 32, b = row0 / T, t0 = row0 % T;
#pragma unroll 4
        for (int i_ = 0; i_ < 16; ++i_) { const int idx = tid + i_ * NTHR; const int cc = idx & 255, tok = idx >> 8; const int col = 768 + cc;
            const bf16_t* pc = proj + (size_t)(row0 + tok) * PW + P_R + col; const float xc = bf2f(pc[0]); const float xp = (t0 + tok > 0) ? bf2f(pc[-PW]) : 0.f;
            const float xm = xc + (xp - xc) * mu[col];
            zl[cc * 36 + tok] = cc < 64 ? tanhf(xm) : (cc < 128 ? xm : sigm(xm)); }
        __syncthreads();
        int tid2 = tid; asm volatile("" : "+v"(tid2));
        const int c = tid2 & 255, th = tid2 >> 8;
        float wacc[16], aacc[16], gacc[16];
        { const float w0c = w0[c], a0c = a0[c];
#pragma unroll
          for (int q = 0; q < 16; ++q) { wacc[q] = w0c; aacc[q] = a0c; gacc[q] = 0.f; } }
        { float wq0 = w2[0 * 256 + c], wq1 = w2[1 * 256 + c], wq2 = w2[2 * 256 + c], wq3 = w2[3 * 256 + c];
          float aq0 = a2[0 * 256 + c], aq1 = a2[1 * 256 + c], aq2 = a2[2 * 256 + c], aq3 = a2[3 * 256 + c];
#pragma unroll 1
          for (int i = 0; i < 64; ++i) { const float w2v = wq0, a2v = aq0; wq0 = wq1; wq1 = wq2; wq2 = wq3; aq0 = aq1; aq1 = aq2; aq2 = aq3;
              { const int in = (i + 4 < 64 ? i + 4 : 63) * 256 + c; wq3 = w2[in]; aq3 = a2[in]; }
#pragma unroll
              for (int q4 = 0; q4 < 4; ++q4) { const pg8::f32x4 tz = *(const LAS pg8::f32x4*)(zl + i * 36 + th * 16 + q4 * 4), za = *(const LAS pg8::f32x4*)(zl + (64 + i) * 36 + th * 16 + q4 * 4);
#pragma unroll
                  for (int e = 0; e < 4; ++e) { wacc[q4 * 4 + e] += tz[e] * w2v; aacc[q4 * 4 + e] += za[e] * a2v; } } } }
        { float gq0 = g2[0 * 256 + c], gq1 = g2[1 * 256 + c], gq2 = g2[2 * 256 + c], gq3 = g2[3 * 256 + c];
#pragma unroll 1
          for (int i = 0; i < 128; ++i) { const float g2v = gq0; gq0 = gq1; gq1 = gq2; gq2 = gq3; gq3 = g2[(i + 4 < 128 ? i + 4 : 127) * 256 + c];
#pragma unroll
              for (int q4 = 0; q4 < 4; ++q4) { const pg8::f32x4 sg = *(const LAS pg8::f32x4*)(zl + (128 + i) * 36 + th * 16 + q4 * 4);
#pragma unroll
                  for (int e = 0; e < 4; ++e) gacc[q4 * 4 + e] += sg[e] * g2v; } } }
        int tid3 = tid; asm volatile("" : "+v"(tid3)); const int c3 = tid3 & 255, th3 = tid3 >> 8;
        const float mur = mu[c3], muk = mu[256 + c3], muv = mu[512 + c3], kkc = kkw[c3], kac = kaw[c3], rkc = rkw[c3];
        const int h = c3 >> 6, kx = c3 & 63;
#pragma unroll
        for (int q = 0; q < 16; ++q) { const int tok = th3 * 16 + q, t = t0 + tok; const size_t row = (size_t)row0 + tok;
            const bf16_t* pc = proj + row * PW + P_R + c3; const bool hp = t > 0;
            const float rc = bf2f(pc[0]), kc = bf2f(pc[256]), vc = bf2f(pc[512]);
            const float rp = hp ? bf2f(pc[-PW]) : 0.f, kp = hp ? bf2f(pc[256 - PW]) : 0.f, vp = hp ? bf2f(pc[512 - PW]) : 0.f;
            const float r = rc + (rp - rc) * mur, k = kc + (kp - kc) * muk, v = vc + (vp - vc) * muv;
            const float wl = -softplusf(-wacc[q]) - 0.5f; const float decay = __expf(-__expf(wl)); const float av = sigm(aacc[q]);
            float kk = k * kkc; const float ss = rdlane(wave_sum63(kk * kk), 63); kk = kk / fmaxf(sqrtf(ss), 1e-12f);
            const float k2 = k * (1.0f + (av - 1.0f) * kac); const float kka = kk * av;
            const float c1 = rdlane(wave_sum63(kka * r), 63), c2 = rdlane(wave_sum63(k2 * r), 63), bn = rdlane(wave_sum63(r * k2 * rkc), 63);
            const size_t st = ((size_t)(b * 4 + h) * T + t);
            float* vb = VEC + st * VSTEP + kx;
            vb[0] = decay; vb[64] = -kk; vb[128] = kka; vb[192] = k2; vb[256] = decay * r; vb[320] = v;
            if (kx == 0) { *(pg8::f32x4*)(SC + st * 4) = (pg8::f32x4){c1, c2, bn, 0.f}; *(pg8::f32x2*)(vb + 384) = (pg8::f32x2){c1, c2}; }
            GR[row * 256 + c3] = (bf16_t)f2bf(gacc[q]);
            asm volatile("" ::: "memory"); }
        __syncthreads();
    }
}

__device__ __forceinline__ void ph_rwkv_scan(Frame& F, ArgsP a) {
    const float* VEC = (const float*)(a->ws + SCR_VEC6); float* YR = (float*)(a->ws + SCR_YR);
    int lane = F.lane(); asm volatile("" : "+v"(lane));
    constexpr int CH = 32, CHB = CH * VSTEP * 4, NP = CHB / 1024 / 8;
    for (int it = blockIdx.x; it < 256; it += F.G) {
        const int bh = it >> 3, rg = it & 7, vrow = rg * 8 + F.wave, b = bh >> 2, h = bh & 3;
        const char* src = (const char*)(VEC + (size_t)bh * T * VSTEP) + lane * 16;
        float S = 0.f;
#define RW_STAGE(cidx) do { _Pragma("unroll") for (int p_ = 0; p_ < NP; ++p_) \
            __builtin_amdgcn_global_load_lds((const unsigned*)(src + (size_t)(cidx) * CHB + (F.wave * NP + p_) * 1024), (LAS unsigned*)(F.lds + ((cidx) & 1) * CHB + (F.wave * NP + p_) * 1024), 16, 0, 0); } while (0)
        RW_STAGE(0);
        for (int c = 0; c < T / CH; ++c) {
            asm volatile("s_waitcnt vmcnt(0)" ::: "memory"); __builtin_amdgcn_s_barrier(); asm volatile("" ::: "memory");
            if (c + 1 < T / CH) RW_STAGE(c + 1);
            const LAS float* bufl = (const LAS float*)(F.lds + (c & 1) * CHB) + lane;
            const LAS float* bufv = (const LAS float*)(F.lds + (c & 1) * CHB) + 320 + vrow;
            const LAS float* bufc = (const LAS float*)(F.lds + (c & 1) * CHB) + 384;
            float yacc = 0.f;
            float nw = bufl[0], nnkk = bufl[64], nkka = bufl[128], nk2 = bufl[192], nwr = bufl[256], nv = bufv[0]; pg8::f32x2 ncc = *(const LAS pg8::f32x2*)bufc;
#pragma unroll 4
            for (int s = 0; s < CH; ++s) {
                const float w_ = nw, nkk = nnkk, kka = nkka, k2 = nk2, wr = nwr, v = nv; const pg8::f32x2 cc = ncc;
                { const int s1 = (s + 1 < CH ? s + 1 : s) * VSTEP;
                  nw = bufl[s1]; nnkk = bufl[s1 + 64]; nkka = bufl[s1 + 128]; nk2 = bufl[s1 + 192]; nwr = bufl[s1 + 256]; nv = bufv[s1]; ncc = *(const LAS pg8::f32x2*)(bufc + s1); }
                const float p1 = S * nkk, p2 = S * wr;
                const auto sw = __builtin_amdgcn_permlane32_swap(__builtin_bit_cast(unsigned, p1), __builtin_bit_cast(unsigned, p2), false, false);
                float x = __builtin_bit_cast(float, (unsigned)sw[0]) + __builtin_bit_cast(float, (unsigned)sw[1]);
                x += dpp_mov<0xB1, 0xF>(0.f, x); x += dpp_mov<0x4E, 0xF>(0.f, x); x += dpp_mov<0x141, 0xF>(0.f, x); x += dpp_mov<0x140, 0xF>(0.f, x);
                x += dpp_mov<0x142, 0xA>(0.f, x);
                const float sa = rdlane(x, 31), z = rdlane(x, 63);
                const float vk = v * k2;
                S = S * w_ + (sa * kka + vk);
                const float y = z + sa * cc[0] + v * cc[1];
                yacc = (lane == s) ? y : yacc;
            }
            if (lane < CH) YR[((size_t)b * T + c * CH + lane) * 256 + h * 64 + vrow] = yacc;
        }
#undef RW_STAGE
        asm volatile("s_waitcnt vmcnt(0)" ::: "memory"); __builtin_amdgcn_s_barrier(); asm volatile("" ::: "memory");
    }
}

__device__ __forceinline__ void ph_rwkv_post(Frame& F, ArgsP a, int l) {
    const float* VEC = (const float*)(a->ws + SCR_VEC6); const float* SC = (const float*)(a->ws + SCR_SC); const float* YR = (const float*)(a->ws + SCR_YR); const bf16_t* GR = (const bf16_t*)(a->ws + SCR_GR);
    const float* lng = (const float*)a->in[28] + l * 256; const float* lnb = (const float*)a->in[29] + l * 256;
    bf16_t* br = (bf16_t*)(a->ws + WS_HB);
    int lane = F.lane(); asm volatile("" : "+v"(lane));
    const int c = 4 * lane, h = lane >> 4;
    const pg8::f32x4 g4 = *(const pg8::f32x4*)(lng + c), b4 = *(const pg8::f32x4*)(lnb + c);
    for (int row = F.gw; row < M; row += F.NGW) {
        const int b = row / T, t = row % T; const size_t st = (size_t)(b * 4 + h) * T + t;
        const pg8::f32x4 y = *(const pg8::f32x4*)(YR + (size_t)row * 256 + c);
        const float mu = row16_sum((y[0] + y[1]) + (y[2] + y[3])) * (1.0f / 64.0f); const pg8::f32x4 d = y - mu;
        const float var = row16_sum((d[0] * d[0] + d[1] * d[1]) + (d[2] * d[2] + d[3] * d[3])) * (1.0f / 64.0f);
        const pg8::f32x4 yn = d * rsqrtf(var + 64e-5f) * g4 + b4;
        const float bonus = SC[st * 4 + 2];
        const pg8::f32x4 v = *(const pg8::f32x4*)(VEC + st * VSTEP + 320 + (c & 63));
        const pg8::f32x4 g = ld_bf16x4(GR + (size_t)row * 256 + c);
        st_bf16x4(br + (size_t)row * D + 768 + c, (yn + bonus * v) * g);
    }
}

__device__ __forceinline__ void ph_gla_p1(Frame& F, ArgsP a, int l) {
    const bf16_t* proj = (const bf16_t*)(a->ws + WS_PROJ); const float* w2 = (const float*)a->in[10] + l * 16 * 128; const float* gb = (const float*)a->in[11] + l * 128;
    float* EG = (float*)(a->ws + SCR_EG); float* CDp = EG + (size_t)M * 128; float* GU = (float*)(a->ws + SCR_GU);
    LAS float* el = (LAS float*)(F.lds + F.wave * 8192); LAS float* kl = el + 1024;
    int lane = F.lane(); asm volatile("" : "+v"(lane));
    const int d = lane & 31;
    for (int it = F.gw; it < 2048; it += F.NGW) {
        const int bh = it >> 6, n = it & 63, b = bh >> 2, h = bh & 3; const size_t row0 = (size_t)b * T + n * 32;
        float wc[16];
#pragma unroll
        for (int r = 0; r < 16; ++r) wc[r] = w2[r * 128 + h * 32 + d];
        const float gbv = gb[h * 32 + d];
#pragma unroll 4
        for (int i = 0; i < 16; ++i) { const int tok = 2 * i + (lane >> 5); const bf16_t* pr = proj + (row0 + tok) * PW;
            const pg8::f32x4 z0 = ld_bf16x4(pr + P_GZ), z1 = ld_bf16x4(pr + P_GZ + 4), z2 = ld_bf16x4(pr + P_GZ + 8), z3 = ld_bf16x4(pr + P_GZ + 12);
            float acc = gbv;
#pragma unroll
            for (int e = 0; e < 4; ++e) acc += z0[e] * wc[e] + z1[e] * wc[4 + e] + z2[e] * wc[8 + e] + z3[e] * wc[12 + e];
            const float ev = __expf(-softplusf(-acc) * (1.0f / 16.0f));
            el[tok * 32 + d] = ev; EG[(row0 + tok) * 128 + h * 32 + d] = ev;
            kl[tok * 32 + d] = bf2f(pr[P_GK + h * 32 + d]); }
        float S[32];
#pragma unroll
        for (int q = 0; q < 32; ++q) S[q] = 0.f;
        { const bf16_t* vp = proj + row0 * PW + P_GV + h * 64 + lane;
          float v0 = bf2f(vp[0]), v1 = bf2f(vp[(size_t)PW]), v2 = bf2f(vp[(size_t)2 * PW]), v3 = bf2f(vp[(size_t)3 * PW]);
#pragma unroll 1
          for (int tok = 0; tok < 32; ++tok) { const float vv = v0; v0 = v1; v1 = v2; v2 = v3; v3 = bf2f(vp[(size_t)(tok + 4 < 32 ? tok + 4 : 31) * PW]);
#pragma unroll
              for (int j = 0; j < 8; ++j) { const pg8::f32x4 e4 = *(const LAS pg8::f32x4*)(el + tok * 32 + 4 * j), k4 = *(const LAS pg8::f32x4*)(kl + tok * 32 + 4 * j);
#pragma unroll
                  for (int e = 0; e < 4; ++e) S[4 * j + e] = e4[e] * S[4 * j + e] + k4[e] * vv; } } }
#pragma unroll
        for (int q = 0; q < 32; ++q) GU[((size_t)it * 32 + q) * 64 + lane] = S[q];
        if (lane < 32) { float cd = 1.f; for (int tok = 0; tok < 32; ++tok) cd *= el[tok * 32 + lane]; CDp[it * 32 + lane] = cd; }
        asm volatile("s_waitcnt lgkmcnt(0)" ::: "memory");
    }
}
__device__ __forceinline__ void ph_gla_prefix(Frame& F, ArgsP a) {
    const float* CDp = (const float*)(a->ws + SCR_EG) + (size_t)M * 128; float* GU = (float*)(a->ws + SCR_GU); float* GS = GU;
    int lane = F.lane(); asm volatile("" : "+v"(lane));
    for (int it = F.gw; it < 1024; it += F.NGW) { const int bh = it >> 5, d = it & 31; float S = 0.f;
#pragma unroll 8
        for (int n = 0; n < 64; ++n) { const size_t ch = (size_t)bh * 64 + n; const float u = GU[(ch * 32 + d) * 64 + lane]; GS[(ch * 32 + d) * 64 + lane] = S; S = CDp[ch * 32 + d] * S + u; } }
}
__device__ __forceinline__ void ph_gla_p2(Frame& F, ArgsP a, int l) {
    const bf16_t* proj = (const bf16_t*)(a->ws + WS_PROJ); const float* gnorm = (const float*)a->in[12] + l * 64;
    const float* EG = (const float*)(a->ws + SCR_EG); const float* GS = (const float*)(a->ws + SCR_GS); bf16_t* br = (bf16_t*)(a->ws + WS_HB);
    LAS float* el = (LAS float*)(F.lds + F.wave * 12288); LAS float* kl = el + 1024; LAS float* ql = el + 2048;
    int lane = F.lane(); asm volatile("" : "+v"(lane));
    const int d = lane & 31; const float gn = gnorm[lane];
    for (int it = F.gw; it < 2048; it += F.NGW) {
        const int bh = it >> 6, n = it & 63, b = bh >> 2, h = bh & 3; const size_t row0 = (size_t)b * T + n * 32;
#pragma unroll 4
        for (int i = 0; i < 16; ++i) { const int tok = 2 * i + (lane >> 5); const bf16_t* pr = proj + (row0 + tok) * PW;
            el[tok * 32 + d] = EG[(row0 + tok) * 128 + h * 32 + d]; kl[tok * 32 + d] = bf2f(pr[P_GK + h * 32 + d]); ql[tok * 32 + d] = bf2f(pr[P_GQ + h * 32 + d]) * 0.17677669529663687f; }
        float S[32];
#pragma unroll
        for (int q = 0; q < 32; ++q) S[q] = GS[((size_t)it * 32 + q) * 64 + lane];
        { const bf16_t* vp = proj + row0 * PW + P_GV + h * 64 + lane; const bf16_t* op = proj + row0 * PW + P_GO + h * 64 + lane;
          float v0 = bf2f(vp[0]), v1 = bf2f(vp[(size_t)PW]), v2 = bf2f(vp[(size_t)2 * PW]), v3 = bf2f(vp[(size_t)3 * PW]);
          float o0 = bf2f(op[0]), o1 = bf2f(op[(size_t)PW]), o2 = bf2f(op[(size_t)2 * PW]), o3 = bf2f(op[(size_t)3 * PW]);
#pragma unroll 1
          for (int tok = 0; tok < 32; ++tok) { const float vv = v0, og = o0; v0 = v1; v1 = v2; v2 = v3; o0 = o1; o1 = o2; o2 = o3;
              { const size_t nx = (size_t)(tok + 4 < 32 ? tok + 4 : 31) * PW; v3 = bf2f(vp[nx]); o3 = bf2f(op[nx]); }
              float o = 0.f;
#pragma unroll
              for (int j = 0; j < 8; ++j) { const pg8::f32x4 e4 = *(const LAS pg8::f32x4*)(el + tok * 32 + 4 * j), k4 = *(const LAS pg8::f32x4*)(kl + tok * 32 + 4 * j), q4 = *(const LAS pg8::f32x4*)(ql + tok * 32 + 4 * j);
#pragma unroll
                  for (int e = 0; e < 4; ++e) { S[4 * j + e] = e4[e] * S[4 * j + e] + k4[e] * vv; o += q4[e] * S[4 * j + e]; } }
              const float ss = rdlane(wave_sum63(o * o), 63); const float rstd = rsqrtf(ss * (1.0f / 64.0f) + 1e-6f);
              br[(row0 + tok) * D + h * 64 + lane] = (bf16_t)f2bf(o * rstd * gn * siluf(og)); } }
        asm volatile("s_waitcnt lgkmcnt(0)" ::: "memory");
    }
}

typedef float f32x16 __attribute__((ext_vector_type(16)));
__device__ __forceinline__ void ph_attn_prep(Frame& F, ArgsP a) {
    const bf16_t* proj = (const bf16_t*)(a->ws + WS_PROJ); const int* pos = (const int*)a->in[2];
    bf16_t* QR = (bf16_t*)(a->ws + SCR_QK); bf16_t* KR = QR + (size_t)M * 256; bf16_t* VT = (bf16_t*)(a->ws + SCR_VT);
    int lane = F.lane(); asm volatile("" : "+v"(lane));
    for (int idx = F.gw * 64 + lane; idx < M * 8; idx += F.NGW * 64) { const int row = idx >> 3, hc = idx & 7; const float p = (float)pos[row];
        const bf16_t* qs = proj + (size_t)row * PW + P_DQ + hc * 32; const bf16_t* ks = proj + (size_t)row * PW + P_DK + hc * 32;
        float qv[32], kv[32];
#pragma unroll
        for (int j = 0; j < 8; ++j) { const pg8::f32x4 q4 = ld_bf16x4(qs + 4 * j), k4 = ld_bf16x4(ks + 4 * j);
#pragma unroll
            for (int e = 0; e < 4; ++e) { qv[4 * j + e] = q4[e]; kv[4 * j + e] = k4[e]; } }
        float qo[32], ko[32];
#pragma unroll
        for (int i = 0; i < 16; ++i) { const float inv = exp2f(-(float)i * 0.8304820237218406f);
            float sn, cs; sincosf(p * inv, &sn, &cs);
            qo[i] = qv[i] * cs - qv[i + 16] * sn; qo[i + 16] = qv[i] * sn + qv[i + 16] * cs;
            ko[i] = kv[i] * cs - kv[i + 16] * sn; ko[i + 16] = kv[i] * sn + kv[i + 16] * cs; }
        const float qsc = 0.17677669529663687f * 1.4426950408889634f;
        bf16_t* qd = QR + (size_t)row * 256 + hc * 32; bf16_t* kd = KR + (size_t)row * 256 + hc * 32;
#pragma unroll
        for (int j = 0; j < 8; ++j) { st_bf16x4(qd + 4 * j, (pg8::f32x4){qo[4 * j] * qsc, qo[4 * j + 1] * qsc, qo[4 * j + 2] * qsc, qo[4 * j + 3] * qsc});
            st_bf16x4(kd + 4 * j, (pg8::f32x4){ko[4 * j], ko[4 * j + 1], ko[4 * j + 2], ko[4 * j + 3]}); } }
    for (int it = F.gw; it < 1024; it += F.NGW) { const int bh = it >> 5, tt = it & 31, b = bh >> 2, h = bh & 3;
        const bf16_t* vs = proj + ((size_t)b * T + tt * 64 + lane) * PW + P_DV + h * 64;
        pg8::u32x4 v[8];
#pragma unroll
        for (int j = 0; j < 8; ++j) v[j] = *(const pg8::u32x4*)(vs + 8 * j);
        bf16_t* vd = VT + (size_t)bh * 64 * T + tt * 64 + lane;
#pragma unroll
        for (int j = 0; j < 8; ++j)
#pragma unroll
            for (int e = 0; e < 4; ++e) { const unsigned w = v[j][e]; vd[(size_t)(8 * j + 2 * e) * T] = (bf16_t)(w & 0xffffu); vd[(size_t)(8 * j + 2 * e + 1) * T] = (bf16_t)(w >> 16); } }
}
__device__ __forceinline__ void ph_attn(Frame& F, ArgsP a, int l) {
    const bf16_t* QR = (const bf16_t*)(a->ws + SCR_QK); const bf16_t* KR = QR + (size_t)M * 256; const bf16_t* VT = (const bf16_t*)(a->ws + SCR_VT);
    const float* lp = (const float*)a->in[13] + l * 128; const float* subln = (const float*)a->in[14] + l * 64; bf16_t* br = (bf16_t*)(a->ws + WS_HB);
    int tid = F.wave * 64 + F.lane(); asm volatile("" : "+v"(tid)); const int lane = tid & 63;
    const int r = lane & 31, hg = lane >> 5, comp = F.wave & 1, qs = F.wave >> 1;
    constexpr int RS = 72;
    LAS bf16_t* Kt = (LAS bf16_t*)F.lds;
    LAS bf16_t* Vt = Kt + 2 * 64 * RS;
    LAS float* Xl = (LAS float*)(F.lds + 4 * 64 * RS * 2);
    float lam, lam_init;
    { float d01 = 0.f, d23 = 0.f;
      for (int i = 0; i < 32; ++i) { d01 += lp[i] * lp[32 + i]; d23 += lp[64 + i] * lp[96 + i]; }
      lam_init = 0.8f - 0.6f * __expf(-0.3f * (float)l); lam = __expf(d01) - __expf(d23) + lam_init; }
    const int ldrow = tid >> 3, ldch = tid & 7;
    for (int pi = blockIdx.x; pi < 256; pi += F.G) {
#pragma unroll 1
        for (int half = 0; half < 2; ++half) {
            const int bh = pi >> 3, j = pi & 7, qb = half == 0 ? 15 - j : j, b = bh >> 2, h = bh & 3;
            const int q0 = qb * 128 + qs * 32, nkw = q0 / 64 + 1, nkb = 2 * qb + 2;
            const size_t rowb = (size_t)b * T;
            pg8::bf16x8 qf[2];
#pragma unroll
            for (int s = 0; s < 2; ++s) qf[s] = *(const pg8::bf16x8*)(QR + (rowb + q0 + r) * 256 + h * 64 + comp * 32 + 16 * s + 8 * hg);
            f32x16 ot[2];
#pragma unroll
            for (int e = 0; e < 16; ++e) { ot[0][e] = 0.f; ot[1][e] = 0.f; }
            float mrun = -1e30f, lrun = 0.f;
            const bf16_t* kg = KR + (rowb + ldrow) * 256 + h * 64 + ldch * 8; const bf16_t* vg = VT + ((size_t)bh * 64 + ldrow) * T + ldch * 8;
            pg8::u32x4 kreg = *(const pg8::u32x4*)kg, vreg = *(const pg8::u32x4*)vg;
            for (int kt = 0; kt < nkb; ++kt) {
                const int bo = (kt & 1) * 64 * RS;
                *(LAS pg8::u32x4*)(Kt + bo + ldrow * RS + ldch * 8) = kreg; *(LAS pg8::u32x4*)(Vt + bo + ldrow * RS + ldch * 8) = vreg;
                __syncthreads();
                if (kt + 1 < nkb) { kreg = *(const pg8::u32x4*)(kg + (size_t)(kt + 1) * 64 * 256); vreg = *(const pg8::u32x4*)(vg + (kt + 1) * 64); }
                if (kt < nkw) {
                    f32x16 st[2];
#pragma unroll
                    for (int kb = 0; kb < 2; ++kb) {
#pragma unroll
                        for (int e = 0; e < 16; ++e) st[kb][e] = 0.f;
#pragma unroll
                        for (int s = 0; s < 2; ++s) { const pg8::bf16x8 kf = *(const LAS pg8::bf16x8*)(Kt + bo + (kb * 32 + r) * RS + comp * 32 + 16 * s + 8 * hg);
                            st[kb] = __builtin_amdgcn_mfma_f32_32x32x16_bf16(kf, qf[s], st[kb], 0, 0, 0); } }
                    if (kt == nkw - 1) {
                        const int qi = q0 + r;
#pragma unroll
                        for (int kb = 0; kb < 2; ++kb)
#pragma unroll
                            for (int e = 0; e < 16; ++e) { const int ki = kt * 64 + kb * 32 + (e & 3) + 8 * (e >> 2) + 4 * hg; if (ki > qi) st[kb][e] = -1e30f; } }
                    float tm = st[0][0];
#pragma unroll
                    for (int e = 1; e < 16; ++e) tm = fmaxf(tm, st[0][e]);
#pragma unroll
                    for (int e = 0; e < 16; ++e) tm = fmaxf(tm, st[1][e]);
                    tm = fmaxf(tm, __shfl_xor(tm, 32));
                    const float mn = fmaxf(mrun, tm), alpha = exp2f(mrun - mn); mrun = mn;
                    float ps = 0.f;
#pragma unroll
                    for (int kb = 0; kb < 2; ++kb)
#pragma unroll
                        for (int e = 0; e < 16; ++e) { st[kb][e] = exp2f(st[kb][e] - mn); ps += st[kb][e]; }
                    lrun = lrun * alpha + ps;
#pragma unroll
                    for (int e = 0; e < 16; ++e) { ot[0][e] *= alpha; ot[1][e] *= alpha; }
#pragma unroll
                    for (int kb = 0; kb < 2; ++kb)
#pragma unroll
                        for (int s = 0; s < 2; ++s) {
                            pg8::u32x4 pw; pw.x = pk2(st[kb][8 * s], st[kb][8 * s + 1]); pw.y = pk2(st[kb][8 * s + 2], st[kb][8 * s + 3]); pw.z = pk2(st[kb][8 * s + 4], st[kb][8 * s + 5]); pw.w = pk2(st[kb][8 * s + 6], st[kb][8 * s + 7]);
                            const pg8::bf16x8 pf = __builtin_bit_cast(pg8::bf16x8, pw);
#pragma unroll
                            for (int dvb = 0; dvb < 2; ++dvb) { const LAS bf16_t* vp = Vt + bo + (dvb * 32 + r) * RS + kb * 32 + 16 * s + 4 * hg;
                                const pg8::u32x2 v0 = *(const LAS pg8::u32x2*)vp, v1 = *(const LAS pg8::u32x2*)(vp + 8);
                                pg8::u32x4 vw; vw.x = v0.x; vw.y = v0.y; vw.z = v1.x; vw.w = v1.y;
                                ot[dvb] = __builtin_amdgcn_mfma_f32_32x32x16_bf16(__builtin_bit_cast(pg8::bf16x8, vw), pf, ot[dvb], 0, 0, 0); } }
                }
            }
            const float ltot = lrun + __shfl_xor(lrun, 32); const float il = 1.0f / ltot;
            __syncthreads();
            if (comp == 1) {
#pragma unroll
                for (int dvb = 0; dvb < 2; ++dvb)
#pragma unroll
                    for (int e = 0; e < 16; ++e) Xl[(qs * 32 + dvb * 16 + e) * 64 + lane] = ot[dvb][e] * il; }
            __syncthreads();
            if (comp == 0) {
                float o[32]; float ss = 0.f;
#pragma unroll
                for (int dvb = 0; dvb < 2; ++dvb)
#pragma unroll
                    for (int e = 0; e < 16; ++e) { const float v = ot[dvb][e] * il - lam * Xl[(qs * 32 + dvb * 16 + e) * 64 + lane]; o[dvb * 16 + e] = v; ss += v * v; }
                ss += __shfl_xor(ss, 32);
                const float sc = rsqrtf(ss * (1.0f / 64.0f) + 1e-6f) * (1.0f - lam_init);
                bf16_t* od = br + (rowb + q0 + r) * D + 256 + h * 64;
#pragma unroll
                for (int dvb = 0; dvb < 2; ++dvb)
#pragma unroll
                    for (int g4 = 0; g4 < 4; ++g4) { const int dv0 = dvb * 32 + 8 * g4 + 4 * hg; const pg8::f32x4 sl = *(const pg8::f32x4*)(subln + dv0);
                        st_bf16x4(od + dv0, (pg8::f32x4){o[dvb * 16 + 4 * g4] * sc * sl[0], o[dvb * 16 + 4 * g4 + 1] * sc * sl[1], o[dvb * 16 + 4 * g4 + 2] * sc * sl[2], o[dvb * 16 + 4 * g4 + 3] * sc * sl[3]}); }
            }
            __syncthreads();
        }
    }
}
constexpr int RING_BYTES = 131072, LDSCTL_OFF = RING_BYTES, MISC_OFF = LDSCTL_OFF + 320, LDS_BYTES = 147456;
constexpr int PH_PRO = 0, PH_H0 = 1, PH_L0 = 2, PH_PER_LAYER = 12, PH_END = PH_L0 + 2 * PH_PER_LAYER;
constexpr int PL_PROJ = 0, PL_MIXA = 1, PL_MIXB = 2, PL_MIXC = 3, PL_BRANCH = 4, PL_OUT = 5, PL_ROWMIX = 6, PL_FFN1 = 7, PL_FFN2 = 8, PL_FFN3 = 9, PL_ROWFFN = 10;

#ifndef DUPMASK
#define DUPMASK 0
#endif
#define DUP(bit) for (int dup_ = 0; dup_ < (((DUPMASK) >> (bit)) & 1) + 1; ++dup_)
__global__ void __launch_bounds__(NTHR, 2) mk_fwd(Args a) {
    extern __shared__ __attribute__((aligned(16))) unsigned char lds_raw[];
    Frame F0;
    F0.lds = (LAS unsigned char*)lds_raw;
    F0.wave = __builtin_amdgcn_readfirstlane(threadIdx.x >> 6);
    F0.G = gridDim.x; F0.gw = blockIdx.x * NWAVES + F0.wave; F0.NGW = F0.G * NWAVES;
    volatile LAS unsigned* MISC = (volatile LAS unsigned*)(F0.lds + MISC_OFF);
    for (int u = threadIdx.x; u < (LDS_BYTES - LDSCTL_OFF) / 4; u += NTHR) ((LAS unsigned*)(F0.lds + LDSCTL_OFF))[u] = 0u;
    __syncthreads();
    unsigned* ctl = (unsigned*)(a.ws + WS_CTL);
    const int lo = a.ph_lo, hi = a.ph_hi;
    XcdBarrier bar; bar.bar = ctl + CW_BAR; bar.x = 0; bar.st = nullptr;
    if (hi - lo > 1) bar = xcd_barrier_post(ctl + CW_BAR, MISC + 8);
#define IN(k) (lo <= (k) && (k) < hi)
#define SEAM(k) do { if (IN(k) && IN((k) + 1)) xcd_barrier(bar); } while (0)
    if (IN(PH_PRO)) DUP(0) { ArgsP A = fresh_args(); Frame F = fresh(F0); p0_mod_items(F, (const float*)A->in[1], (const float*)A->in[3], (const float*)A->in[4], (float*)(A->ws + WS_MOD)); p0_convert(F, A); }
    SEAM(PH_PRO);
    if (IN(PH_H0)) { Frame F = fresh(F0); ph_h0(F, fresh_args()); }
    SEAM(PH_H0);
    for (int l = 0; l < NL; ++l) {
        const int base = PH_L0 + l * PH_PER_LAYER;
        if (IN(base + PL_PROJ)) DUP(1) { ArgsP A = fresh_args(); Frame F = fresh(F0); unsigned char* ws = A->ws;
            pg8::Gemm g{(const bf16_t*)(ws + WS_HB), (const bf16_t*)(ws + WS_WIN) + (size_t)l * PW * 1024, 1024, 1024, 1024, 0}; pg8::StaticOrder S; S.init(M, PW, F.G, (int)blockIdx.x);
            pg8::EpiBf16 E{(bf16_t*)(ws + WS_PROJ), PW, 29};
            pg8::gemm_phase<pg8::EpiBf16, pg8::StaticOrder, true>(F.lds, g, S, E, F.wave);
        }
        SEAM(base + PL_PROJ);
        if (IN(base + PL_MIXA)) DUP(2) { { Frame F = fresh(F0); ph_conv(F, fresh_args(), l); } { Frame F = fresh(F0); ph_rwkv_prep(F, fresh_args(), l); } { Frame F = fresh(F0); ph_gla_p1(F, fresh_args(), l); } { Frame F = fresh(F0); ph_attn_prep(F, fresh_args()); } }
        SEAM(base + PL_MIXA);
        if (IN(base + PL_MIXB)) { { Frame F = fresh(F0); ph_gla_prefix(F, fresh_args()); } DUP(3) { Frame F = fresh(F0); ph_rwkv_scan(F, fresh_args()); } DUP(4) { Frame F = fresh(F0); ph_attn(F, fresh_args(), l); } }
        SEAM(base + PL_MIXB);
        if (IN(base + PL_MIXC)) DUP(5) { { Frame F = fresh(F0); ph_rwkv_post(F, fresh_args(), l); } { Frame F = fresh(F0); ph_gla_p2(F, fresh_args(), l); } }
        SEAM(base + PL_MIXC);
        if (IN(base + PL_BRANCH)) DUP(1) { ArgsP A = fresh_args(); Frame F = fresh(F0); unsigned char* ws = A->ws;
            int Kb = 256; asm volatile("" : "+s"(Kb));
            pg8::Gemm g{(const bf16_t*)(ws + WS_HB), (const bf16_t*)(ws + WS_WB) + (size_t)l * 4096 * 256, 1024, 256, Kb, 0}; pg8::BranchOrder S{F.G, (int)blockIdx.x};
            pg8::EpiBranch E{(const bf16_t*)(ws + WS_PROJ), (float*)(ws + SCR_MP), (bf16_t*)(ws + SCR_MB)};
            pg8::gemm_phase<pg8::EpiBranch, pg8::BranchOrder, true>(F.lds, g, S, E, F.wave);
        }
        SEAM(base + PL_BRANCH);
        if (IN(base + PL_OUT)) DUP(1) { ArgsP A = fresh_args(); Frame F = fresh(F0); unsigned char* ws = A->ws;
            pg8::Gemm g{(const bf16_t*)(ws + SCR_MB), (const bf16_t*)(ws + WS_WO) + (size_t)l * 1024 * 1024, 1024, 1024, 1024, 0}; pg8::StaticOrder S; S.init(M, 1024, F.G, (int)blockIdx.x);
            pg8::EpiF32 E{(float*)(ws + SCR_Y), 1024, 4};
            pg8::gemm_phase<pg8::EpiF32, pg8::StaticOrder, false>(F.lds, g, S, E, F.wave);
        }
        SEAM(base + PL_OUT);
        if (IN(base + PL_ROWMIX)) { ArgsP A = fresh_args(); Frame F = fresh(F0); unsigned char* ws = A->ws; const float* modl = (const float*)(ws + WS_MOD) + (size_t)l * 8 * 6144;
            ph_row(F, A, l == 0 ? (const float*)A->in[0] : A->out, (const float*)(ws + SCR_Y), (const float*)A->in[6] + l * D, modl, 2048, (const float*)A->in[7] + l * D, modl, 3072, 4096, (bf16_t*)(ws + (l == 0 ? WS_HB : WS_H2L1)), l == 1); }
        SEAM(base + PL_ROWMIX);
        if (l == 0) {
            if (IN(base + PL_FFN1)) DUP(1) { ArgsP A = fresh_args(); Frame F = fresh(F0); unsigned char* ws = A->ws;
                pg8::Gemm g{(const bf16_t*)(ws + WS_HB), (const bf16_t*)(ws + WS_WF1), 1024, 1024, 1024, 0}; pg8::StaticOrder S; S.init(M, 2 * DFF, F.G, (int)blockIdx.x);
                pg8::EpiSwiglu E{(bf16_t*)(ws + WS_PROJ), DFF, 2 * DFF / 256};
                pg8::gemm_phase<pg8::EpiSwiglu, pg8::StaticOrder, true>(F.lds, g, S, E, F.wave);
            }
            SEAM(base + PL_FFN1);
            if (IN(base + PL_FFN2)) DUP(1) { ArgsP A = fresh_args(); Frame F = fresh(F0); unsigned char* ws = A->ws;
                pg8::Gemm g{(const bf16_t*)(ws + WS_PROJ), (const bf16_t*)(ws + WS_WF2), DFF, DFF, DFF, 0}; pg8::StaticOrder S; S.init(M, 1024, F.G, (int)blockIdx.x);
                pg8::EpiF32 E{(float*)(ws + SCR_Y), 1024, 4};
                pg8::gemm_phase<pg8::EpiF32, pg8::StaticOrder, false>(F.lds, g, S, E, F.wave);
            }
            SEAM(base + PL_FFN2);
        } else {
            if (IN(base + PL_FFN1)) DUP(0) { Frame F = fresh(F0); ph_moe_prep(F, fresh_args()); }
            SEAM(base + PL_FFN1);
            if (IN(base + PL_FFN2)) DUP(1) { ArgsP A = fresh_args(); Frame F = fresh(F0); unsigned char* ws = A->ws; const unsigned* cnt = (const unsigned*)(ws + WS_CTL) + CW_CNT;
                pg8::Gemm g{(const bf16_t*)(ws + WS_HG), (const bf16_t*)(ws + WS_WM1), 1024, 1024, 1024, 0}; pg8::MoeOrder S; S.init(cnt, F.G, (int)blockIdx.x, 28);
                pg8::EpiSwiglu E{(bf16_t*)(ws + WS_HID), DEX, 28};
                pg8::gemm_phase<pg8::EpiSwiglu, pg8::MoeOrder, true>(F.lds, g, S, E, F.wave);
            }
            SEAM(base + PL_FFN2);
            if (IN(base + PL_FFN3)) DUP(1) { ArgsP A = fresh_args(); Frame F = fresh(F0); unsigned char* ws = A->ws; const unsigned* cnt = (const unsigned*)(ws + WS_CTL) + CW_CNT;
                pg8::Gemm g{(const bf16_t*)(ws + WS_HID), (const bf16_t*)(ws + WS_WM2), DEX, DEX, DEX, 0}; pg8::MoeOrder S; S.init(cnt, F.G, (int)blockIdx.x, 4);
                pg8::EpiBf16 E{(bf16_t*)(ws + WS_HG), 1024, 4};
                pg8::gemm_phase<pg8::EpiBf16, pg8::MoeOrder, true>(F.lds, g, S, E, F.wave);
            }
            SEAM(base + PL_FFN3);
        }
        if (IN(base + PL_ROWFFN)) { ArgsP A = fresh_args(); Frame F = fresh(F0); unsigned char* ws = A->ws; const float* modl = (const float*)(ws + WS_MOD) + (size_t)l * 8 * 6144;
            const bool last = (l == NL - 1);
            ph_row(F, A, A->out, (const float*)(ws + SCR_Y), (const float*)A->in[8] + l * D, modl, 5120, last ? nullptr : (const float*)A->in[5] + (l + 1) * D, modl + 8 * 6144, 0, 1024, last ? nullptr : (bf16_t*)(ws + WS_HB), false, l == 0 ? nullptr : (const bf16_t*)(ws + WS_HG));
        }
        SEAM(base + PL_ROWFFN);
    }
#undef IN
#undef SEAM
}

extern "C" void kernel_launch(void* const* d_in, const int* in_sizes, int n_in, void* d_out, int out_size, void* d_ws, size_t ws_size, hipStream_t stream) {
    static int grid = 0;
    if (grid == 0) {
        if (n_in != 40 || ws_size < WS_END) { fprintf(stderr, "kernel_launch: need 40 inputs and >= %zu bytes of workspace (got %d, %zu)\n", (size_t)WS_END, n_in, ws_size); grid = -1; return; }
        int dev = 0, cus = 0, per_cu = 0;
        (void)hipGetDevice(&dev); (void)hipDeviceGetAttribute(&cus, hipDeviceAttributeMultiprocessorCount, dev);
        (void)hipFuncSetAttribute((const void*)mk_fwd, hipFuncAttributeMaxDynamicSharedMemorySize, LDS_BYTES);
        (void)hipOccupancyMaxActiveBlocksPerMultiprocessor(&per_cu, (const void*)mk_fwd, NTHR, LDS_BYTES);
        (void)hipGetLastError();
        grid = cus > 0 ? cus : 256;
        if (per_cu < 1) fprintf(stderr, "kernel_launch: occupancy query says %d blocks per CU\n", per_cu);
    }
    if (grid < 0) return;
    unsigned char* ws = (unsigned char*)d_ws;
    (void)hipMemsetAsync(ws + WS_CTL, 0, CTL_ZERO_BYTES, stream);
    Args a{};
    for (int i = 0; i < 40; ++i) a.in[i] = d_in[i];
    a.out = (float*)d_out; a.ws = ws;
    a.ph_lo = 0; a.ph_hi = PH_L0 + (NL - 1) * PH_PER_LAYER + PL_ROWFFN + 1;
    hipLaunchKernelGGL(mk_fwd, dim3(grid), dim3(NTHR), LDS_BYTES, stream, a);
}
```

```cpp
#include <hip/hip_runtime.h>
#include <hip/hip_bf16.h>
#include <cstdint>
#include <cstdio>

typedef __hip_bfloat16 bf16;
typedef unsigned short bf16_t;
#define GAS __attribute__((address_space(1)))
#define LAS __attribute__((address_space(3)))

constexpr int D = 1024, NB = 8, T = 2048, M = NB * T, NL = 2;
constexpr int NIN = 7184;
constexpr int PW = 7424;
constexpr int P_GQ = 0, P_GK = 128, P_GV = 256, P_GO = 512, P_DQ = 768, P_DK = 1024, P_DV = 1280, P_CA = 1536, P_CB = 1792, P_R = 2048, P_GATE = 3072, P_GZ = 7168;
constexpr int DFF = 2816, NE = 8, DEX = 3584;
constexpr int NWAVES = 8, NTHR = 512;
constexpr size_t MiB = 1u << 20;
constexpr size_t WS_CTL = 0;
constexpr size_t CTL_ZERO_BYTES = 64 * 1024;
constexpr size_t WS_MOD = 1 * MiB;
constexpr size_t WS_ROUTE = 1 * MiB + 512 * 1024;
constexpr size_t WS_LR = 3 * MiB;
constexpr size_t WS_WIN = 4 * MiB;
constexpr size_t WS_WB = 33 * MiB;
constexpr size_t WS_WO = 37 * MiB;
constexpr size_t WS_WF1 = 41 * MiB;
constexpr size_t WS_WF2 = 52 * MiB;
constexpr size_t WS_HB = 58 * MiB;
constexpr size_t WS_PROJ = 90 * MiB;
constexpr size_t WS_SCR = 322 * MiB;
constexpr size_t WS_H2L1 = 508 * MiB;
constexpr size_t WS_END = 540 * MiB;
constexpr size_t WS_HG = 4 * MiB;
constexpr size_t WS_WM1 = 72 * MiB;
constexpr size_t WS_WM2 = 184 * MiB;
constexpr size_t WS_HID = 240 * MiB;
static_assert(WS_HID + (size_t)34816 * 3584 * 2 <= WS_H2L1, "moe overlay");
constexpr size_t SCR_MP = WS_SCR;
constexpr size_t SCR_MB = WS_SCR + 64 * MiB;
constexpr size_t SCR_Y = WS_SCR + 96 * MiB;
constexpr size_t SCR_RW = WS_SCR;
constexpr size_t SCR_GK = WS_SCR + 112 * MiB;
constexpr size_t SCR_QR = WS_SCR + 120 * MiB;
constexpr size_t SCR_KR = WS_SCR + 136 * MiB;
constexpr size_t SCR_VEC6 = WS_SCR;
constexpr size_t SCR_SC = WS_SCR + 112 * MiB;
constexpr size_t SCR_YR = WS_SCR + 113 * MiB;
constexpr size_t SCR_GR = WS_SCR + 129 * MiB;
constexpr size_t SCR_VT = WS_SCR + 137 * MiB;
constexpr size_t SCR_GU = WS_SCR + 145 * MiB;
constexpr size_t SCR_GS = SCR_GU;
constexpr size_t SCR_QK = WS_SCR + 161 * MiB;
constexpr size_t SCR_EG = WS_SCR + 177 * MiB;
constexpr int VSTEP = 448;
constexpr int CW_TMO = 0;
constexpr int CW_BAR = 1024;
constexpr int CW_CNT = 8192;
constexpr size_t RT_LIST = 0;
constexpr size_t RT_TOKE = 512 * 1024;
constexpr size_t RT_TOKS = 640 * 1024;
constexpr size_t RT_TOKP = 768 * 1024;

__device__ __forceinline__ float sigm(float x) { return 1.0f / (1.0f + __expf(-x)); }
__device__ __forceinline__ float siluf(float x) { return x * sigm(x); }
__device__ __forceinline__ float softplusf(float x) { return fmaxf(x, 0.f) + log1pf(__expf(-fabsf(x))); }
__device__ __forceinline__ float wave_sum(float v) {
#pragma unroll
    for (int o = 32; o > 0; o >>= 1) v += __shfl_xor(v, o);
    return v;
}
__device__ __forceinline__ float wave_max(float v) {
#pragma unroll
    for (int o = 32; o > 0; o >>= 1) v = fmaxf(v, __shfl_xor(v, o));
    return v;
}
__device__ __forceinline__ float ldf(const float* p) { return *p; }
__device__ __forceinline__ float ldf(const bf16* p) { return __bfloat162float(*p); }
__device__ __forceinline__ float bf2f(bf16_t u) { return __builtin_bit_cast(float, (unsigned)u << 16); }
__device__ __forceinline__ unsigned f2bf(float f) { unsigned u = __builtin_bit_cast(unsigned, f); return (u + 0x7fffu + ((u >> 16) & 1u)) >> 16; }
__device__ __forceinline__ unsigned pk2(float lo, float hi) { return f2bf(lo) | (f2bf(hi) << 16); }
namespace pg8 {
#define PG8_LAS __attribute__((address_space(3)))
typedef short bf16x8 __attribute__((ext_vector_type(8)));
typedef float f32x4 __attribute__((ext_vector_type(4)));
typedef float f32x2 __attribute__((ext_vector_type(2)));
typedef unsigned u32x4 __attribute__((ext_vector_type(4)));
typedef unsigned u32x2 __attribute__((ext_vector_type(2)));
constexpr int BM = 256, BK = 64, HALF = 128, HTB = HALF * BK * 2  , STAGE_BYTES = 8 * HTB, NXCD = 8, WGM = 8;

__host__ __device__ __forceinline__ int lds_byte(int r, int c) { const int st = (r >> 4) * 2 + (c >> 5), rr = r & 15, cc = c & 31, ob = rr * 64 + cc * 2; return st * 1024 + (ob ^ (((ob >> 9) & 1) << 5)); }
__host__ __device__ __forceinline__ void stage_rc(int b, int& R, int& C) { const int st = b / 1024, sb = b % 1024, swz = sb ^ (((sb >> 9) & 1) << 5); R = (st >> 1) * 16 + swz / 64; C = (st & 1) * 32 + (swz % 64) / 2; }
__host__ __device__ __forceinline__ int perm32(int rho) { const int n = rho >> 4, i = rho & 15; return 8 * (i >> 2) + 4 * n + (i & 3); }

struct Unit { int pm, pn, aoff, tag; };
struct Gemm { const bf16_t* A; const bf16_t* Bt; int lda, ldb, K, pad; };

struct StaticOrder {
    int nM, nN, nwg, G, c;
    __host__ __device__ void init(int M_, int N_, int G_, int c_) { nM = M_ / BM; nN = N_ / BM; nwg = nM * nN; G = G_; c = c_; }
    __host__ __device__ bool next(int i, Unit& u) const {
        const long L = (long)i * G + c; if (L >= nwg) return false;
        int wgid = (int)L; { const int q = nwg / NXCD, r = nwg % NXCD, xcd = wgid % NXCD, off = wgid / NXCD; wgid = (xcd < r ? xcd * (q + 1) : r * (q + 1) + (xcd - r) * q) + off; }
        const int nig = WGM * nN, gid = wgid / nig, fm = gid * WGM, gsz = (nM - fm) < WGM ? (nM - fm) : WGM;
        u.pm = fm + ((wgid % nig) % gsz); u.pn = (wgid % nig) / gsz; u.aoff = 0; u.tag = 0; return true;
    }
};

__device__ __forceinline__ unsigned cvt_pk_bf16(float lo, float hi) { unsigned r; asm volatile("v_cvt_pk_bf16_f32 %0, %1, %2" : "=v"(r) : "v"(lo), "v"(hi)); return r; }


template <class Epi, class Sched, bool ALIGN_EPI>
__device__ __forceinline__ void gemm_phase(PG8_LAS unsigned char* lds, const Gemm g, const Sched& S, const Epi& E, int wave_s) {
    unsigned z_ = 0u; asm volatile("" : "+v"(z_));
    int tid_ = wave_s * 64 + (int)__builtin_amdgcn_mbcnt_hi(~0u, __builtin_amdgcn_mbcnt_lo(~0u, z_)); asm volatile("" : "+v"(tid_));
    const int tid = tid_, wid = __builtin_amdgcn_readfirstlane(tid >> 6), lane = tid & 63, wr = wid >> 2, wc = wid & 3, fr = lane & 15, fq = lane >> 4;
    const int K = g.K, nt = K / BK;
    unsigned voffA[2], voffB[2];
#pragma unroll
    for (int i = 0; i < 2; ++i) { int R, C; stage_rc(tid * 16 + i * 8192, R, C); const int Rb = Epi::PERM ? ((R & ~31) + perm32(R & 31)) : R;
        voffA[i] = (unsigned)(R * g.lda + C) * 2u; voffB[i] = (unsigned)(Rb * g.ldb + C) * 2u; }
    const size_t kstep = (size_t)(BK * 2);
    const size_t hstepA = (size_t)HALF * g.lda * 2, hstepB = (size_t)HALF * g.ldb * 2;
    const size_t tstepA = 2 * hstepA, tstepB = 2 * hstepB;
    const unsigned ldsw = (unsigned)wid * 1024u;
    const int aoff = lds_byte(wr * 64 + fr, fq * 8), boff = lds_byte(wc * 32 + fr, fq * 8);
#define PG8_SA(b, h) (((b) * 2 + (h)) * HTB)
#define PG8_SB(b, h) ((4 + (b) * 2 + (h)) * HTB)
#define PG8_STAGE(bufoff, gbase, voff) do { _Pragma("unroll") for (int _i = 0; _i < 2; ++_i) \
        __builtin_amdgcn_global_load_lds((const unsigned*)((const char*)(gbase) + (voff)[_i]), (PG8_LAS unsigned*)(lds + (bufoff) + ldsw + _i * 8192), 16, 0, 0); } while (0)
#define PG8_LDA(dst, b, h) do { _Pragma("unroll") for (int m = 0; m < 4; ++m) _Pragma("unroll") for (int k = 0; k < 2; ++k) dst[m][k] = *(const PG8_LAS bf16x8*)(lds + PG8_SA(b, h) + aoff + m * 2048 + k * 1024); } while (0)
#define PG8_LDB(dst, b, h) do { _Pragma("unroll") for (int n = 0; n < 2; ++n) _Pragma("unroll") for (int k = 0; k < 2; ++k) dst[n][k] = *(const PG8_LAS bf16x8*)(lds + PG8_SB(b, h) + boff + n * 2048 + k * 1024); } while (0)
#define PG8_MMA(ai, bj, At, Bt) do { __builtin_amdgcn_s_setprio(1); _Pragma("unroll") for (int m = 0; m < 4; ++m) _Pragma("unroll") for (int n = 0; n < 2; ++n) _Pragma("unroll") for (int k = 0; k < 2; ++k) \
        acc[ai][bj][m][n] = __builtin_amdgcn_mfma_f32_16x16x32_bf16(Bt[n][k], At[m][k], acc[ai][bj][m][n], 0, 0, 0); __builtin_amdgcn_s_setprio(0); } while (0)
#define PG8_WAIT_V(n) asm volatile("s_waitcnt vmcnt(" #n ")" ::: "memory")
#define PG8_WAIT_L(n) asm volatile("s_waitcnt lgkmcnt(" #n ")" ::: "memory")
#define PG8_BAR __builtin_amdgcn_s_barrier()
#define PG8_SCHED __builtin_amdgcn_sched_barrier(0)
    Unit cur, nxt; int ui = 0;
    if (!S.next(0, cur)) return;
    f32x4 acc[2][2][4][2];
#pragma unroll
    for (int a = 0; a < 2; ++a)
#pragma unroll
        for (int b = 0; b < 2; ++b)
#pragma unroll
            for (int m = 0; m < 4; ++m)
#pragma unroll
                for (int n = 0; n < 2; ++n) acc[a][b][m][n] = (f32x4){0.f, 0.f, 0.f, 0.f};
    bf16x8 At[4][2], B0[2][2], B1[2][2];
    const char* cA = (const char*)g.A + (size_t)cur.pm * tstepA + (size_t)cur.aoff * 2; const char* cB = (const char*)g.Bt + (size_t)cur.pn * tstepB;
    PG8_STAGE(PG8_SB(0, 0), cB, voffB); PG8_STAGE(PG8_SB(0, 1), cB + hstepB, voffB); PG8_STAGE(PG8_SA(0, 0), cA, voffA); PG8_STAGE(PG8_SA(0, 1), cA + hstepA, voffA);
    if (wr == 1) PG8_BAR;
    PG8_WAIT_V(2); PG8_BAR;
    PG8_STAGE(PG8_SB(1, 0), cB + kstep, voffB); PG8_STAGE(PG8_SA(1, 0), cA + kstep, voffA); PG8_STAGE(PG8_SB(1, 1), cB + hstepB + kstep, voffB);
    PG8_WAIT_V(6); PG8_BAR;
    for (;;) {
        const bool has_next = S.next(ui + 1, nxt);
        const char* nA = has_next ? (const char*)g.A + (size_t)nxt.pm * tstepA + (size_t)nxt.aoff * 2 : cA; const char* nB = has_next ? (const char*)g.Bt + (size_t)nxt.pn * tstepB : cB;
        for (int t = 0; t < nt; t += 2) {
            const bool last = (t == nt - 2);
            const char* a1 = cA + (size_t)(t + 1) * kstep;
            const char* a2 = last ? nA : cA + (size_t)(t + 2) * kstep; const char* b2 = last ? nB : cB + (size_t)(t + 2) * kstep;
            const char* a3 = a2 + kstep; const char* b3 = b2 + kstep;
            PG8_LDB(B0, 0, 0); PG8_LDB(B1, 0, 1); PG8_SCHED; PG8_LDA(At, 0, 0); PG8_STAGE(PG8_SA(1, 1), a1 + hstepA, voffA);
            PG8_WAIT_V(8); PG8_WAIT_L(0); PG8_BAR; PG8_MMA(0, 0, At, B0); PG8_MMA(0, 1, At, B1); PG8_BAR; PG8_SCHED;
            PG8_LDA(At, 0, 1); PG8_STAGE(PG8_SB(0, 0), b2, voffB); PG8_STAGE(PG8_SB(0, 1), b2 + hstepB, voffB); PG8_STAGE(PG8_SA(0, 0), a2, voffA);
            PG8_WAIT_V(8); PG8_WAIT_L(0); PG8_BAR; PG8_MMA(1, 0, At, B0); PG8_MMA(1, 1, At, B1); PG8_BAR; PG8_SCHED;
            PG8_LDB(B0, 1, 0); PG8_LDB(B1, 1, 1); PG8_SCHED; PG8_LDA(At, 1, 0); PG8_STAGE(PG8_SA(0, 1), a2 + hstepA, voffA);
            PG8_WAIT_V(8); PG8_WAIT_L(0); PG8_BAR; PG8_MMA(0, 0, At, B0); PG8_MMA(0, 1, At, B1); PG8_BAR; PG8_SCHED;
            PG8_LDA(At, 1, 1); PG8_STAGE(PG8_SB(1, 0), b3, voffB); PG8_STAGE(PG8_SB(1, 1), b3 + hstepB, voffB); PG8_STAGE(PG8_SA(1, 0), a3, voffA);
            PG8_WAIT_V(8); PG8_WAIT_L(0); PG8_BAR; PG8_MMA(1, 0, At, B0); PG8_MMA(1, 1, At, B1); PG8_BAR; PG8_SCHED;
        }
        if constexpr (ALIGN_EPI) { if (wr == 0) PG8_BAR; }
        { unsigned z2_ = 0u; asm volatile("" : "+v"(z2_)); const int l2_ = (int)__builtin_amdgcn_mbcnt_hi(~0u, __builtin_amdgcn_mbcnt_lo(~0u, z2_));
          E(acc, cur, wr, wc, l2_ & 15, l2_ >> 4); }
        if (!has_next) break;
#pragma unroll
        for (int a = 0; a < 2; ++a)
#pragma unroll
            for (int b = 0; b < 2; ++b)
#pragma unroll
                for (int m = 0; m < 4; ++m)
#pragma unroll
                    for (int n = 0; n < 2; ++n) acc[a][b][m][n] = (f32x4){0.f, 0.f, 0.f, 0.f};
        cur = nxt; cA = nA; cB = nB; ++ui;
        if constexpr (ALIGN_EPI) { if (wr == 1) PG8_BAR; }
    }
    PG8_WAIT_V(0);
    if constexpr (!ALIGN_EPI) { if (wr == 0) PG8_BAR; }
    PG8_BAR;
#undef PG8_SA
#undef PG8_SB
#undef PG8_STAGE
#undef PG8_LDA
#undef PG8_LDB
#undef PG8_MMA
#undef PG8_WAIT_V
#undef PG8_WAIT_L
#undef PG8_BAR
#undef PG8_SCHED
}

struct EpiBf16 {
    static constexpr bool PERM = true;
    bf16_t* O; int ldc; int ntn;
    __device__ __forceinline__ void operator()(const f32x4 (&acc)[2][2][4][2], const Unit& u, int wr, int wc, int fr, int fq) const {
        const int row0 = u.pm * BM + wr * 64 + fr, col0 = (u.pn % ntn) * BM + wc * 32 + 8 * fq;
#pragma unroll
        for (int ai = 0; ai < 2; ++ai)
#pragma unroll
            for (int m = 0; m < 4; ++m) { bf16_t* rowp = O + (size_t)(row0 + ai * HALF + m * 16) * ldc + col0;
#pragma unroll
                for (int bj = 0; bj < 2; ++bj) { const f32x4 v0 = acc[ai][bj][m][0], v1 = acc[ai][bj][m][1];
                    u32x4 w; w.x = cvt_pk_bf16(v0[0], v0[1]); w.y = cvt_pk_bf16(v0[2], v0[3]); w.z = cvt_pk_bf16(v1[0], v1[1]); w.w = cvt_pk_bf16(v1[2], v1[3]);
                    *(u32x4*)(rowp + bj * HALF) = w; } }
    }
};
struct EpiF32 {
    static constexpr bool PERM = false;
    float* C; int ldc; int ntn;
    __device__ __forceinline__ void operator()(const f32x4 (&acc)[2][2][4][2], const Unit& u, int wr, int wc, int fr, int fq) const {
        const int row0 = u.pm * BM + wr * 64 + fr, col0 = (u.pn % ntn) * BM + wc * 32 + 4 * fq;
#pragma unroll
        for (int ai = 0; ai < 2; ++ai)
#pragma unroll
            for (int m = 0; m < 4; ++m) { float* rowp = C + (size_t)(row0 + ai * HALF + m * 16) * ldc + col0;
#pragma unroll
                for (int bj = 0; bj < 2; ++bj)
#pragma unroll
                    for (int n = 0; n < 2; ++n) *(f32x4*)(rowp + bj * HALF + n * 16) = acc[ai][bj][m][n]; }
    }
};
struct EpiSwiglu {
    static constexpr bool PERM = true;
    bf16_t* O; int ldc; int ntn;
    __device__ __forceinline__ void operator()(const f32x4 (&acc)[2][2][4][2], const Unit& u, int wr, int wc, int fr, int fq) const {
        const int row0 = u.pm * BM + wr * 64 + fr, col0 = (u.pn % ntn) * 128 + wc * 16 + 4 * fq;
#pragma unroll
        for (int ai = 0; ai < 2; ++ai)
#pragma unroll
            for (int m = 0; m < 4; ++m) { bf16_t* rowp = O + (size_t)(row0 + ai * HALF + m * 16) * ldc + col0;
#pragma unroll
                for (int bj = 0; bj < 2; ++bj) { const f32x4 gt = acc[ai][bj][m][0], up = acc[ai][bj][m][1];
                    float h[4];
#pragma unroll
                    for (int e = 0; e < 4; ++e) h[e] = gt[e] * __builtin_amdgcn_rcpf(1.0f + __expf(-gt[e])) * up[e];
                    u32x2 w; w.x = cvt_pk_bf16(h[0], h[1]); w.y = cvt_pk_bf16(h[2], h[3]);
                    *(u32x2*)(rowp + bj * 64) = w; } }
    }
};
struct EpiBranch {
    static constexpr bool PERM = true;
    const bf16_t* proj; float* MP; bf16_t* MB;
    __device__ __forceinline__ void operator()(const f32x4 (&acc)[2][2][4][2], const Unit& u, int wr, int wc, int fr, int fq) const {
        const int g = u.tag; const int row0 = u.pm * BM + wr * 64 + fr, col0 = (u.pn & 3) * BM + wc * 32 + 8 * fq;
#pragma unroll
        for (int ai = 0; ai < 2; ++ai)
#pragma unroll
            for (int m = 0; m < 4; ++m) { const size_t row = (size_t)(row0 + ai * HALF + m * 16);
#pragma unroll
                for (int bj = 0; bj < 2; ++bj) { const int col = col0 + bj * HALF;
                    const u32x4 gw = *(const u32x4*)(proj + row * PW + P_GATE + g * 1024 + col);
                    float gv[8];
#pragma unroll
                    for (int e = 0; e < 4; ++e) { const unsigned w = gw[e]; gv[2 * e] = __builtin_bit_cast(float, w << 16); gv[2 * e + 1] = __builtin_bit_cast(float, w & 0xffff0000u); }
                    f32x4 v0 = acc[ai][bj][m][0], v1 = acc[ai][bj][m][1];
#pragma unroll
                    for (int e = 0; e < 4; ++e) { v0[e] *= __builtin_amdgcn_rcpf(1.0f + __expf(-gv[e])); v1[e] *= __builtin_amdgcn_rcpf(1.0f + __expf(-gv[4 + e])); }
                    float* mp = MP + row * D + col;
                    if (g > 0) { v0 += *(const f32x4*)mp; v1 += *(const f32x4*)(mp + 4); }
                    if (g < 3) { *(f32x4*)mp = v0; *(f32x4*)(mp + 4) = v1; }
                    else { u32x4 w; w.x = cvt_pk_bf16(v0[0], v0[1]); w.y = cvt_pk_bf16(v0[2], v0[3]); w.z = cvt_pk_bf16(v1[0], v1[1]); w.w = cvt_pk_bf16(v1[2], v1[3]);
                        *(u32x4*)(MB + row * D + col) = w; } } }
    }
};
struct BranchOrder {
    int G, c;
    __device__ bool next(int i, Unit& u) const {
        const int tile = (i >> 2) * G + c; if (tile >= 256) return false;
        const int g = i & 3; u.pm = tile >> 2; u.pn = g * 4 + (tile & 3); u.aoff = g * 256; u.tag = g; return true;
    }
};
struct MoeOrder {
    int G, c, ntiles, NT; int toff[9];
    __device__ void init(const unsigned* cnt, int G_, int c_, int NT_) { G = G_; c = c_; NT = NT_; int o = 0;
#pragma unroll
        for (int e = 0; e < 8; ++e) { toff[e] = o; o += ((int)cnt[e] + 255) >> 8; } toff[8] = o; ntiles = o; }
    __device__ bool next(int i, Unit& u) const {
        const int L = i * G + c; if (L >= ntiles * NT) return false;
        const int tau = L % ntiles, pn = L / ntiles; int e = 0;
#pragma unroll
        for (int q = 1; q < 8; ++q) e += (tau >= toff[q]) ? 1 : 0;
        u.pm = tau; u.pn = e * NT + pn; u.aoff = 0; u.tag = e; return true;
    }
};
}
typedef GAS unsigned gu32;
#define RLX_AGENT __ATOMIC_RELAXED, __HIP_MEMORY_SCOPE_AGENT
#define XB_TMO      128
#define XB_XCNT(j)  (256  + 64 * (j))
#define XB_XSUB(j)  (1280 + 64 * (j))
#define XB_XGEN(j)  (2304 + 64 * (j))
#define XB_TOP      3328
#define XB_TOPGEN   3392
#define XCD_BAR_WORDS 3456
#define XB_SPIN_CAP (1u << 18)

__device__ __forceinline__ unsigned xb_ld(unsigned* p)              { return __hip_atomic_load(p, __ATOMIC_RELAXED, __HIP_MEMORY_SCOPE_AGENT); }
__device__ __forceinline__ unsigned xb_add(unsigned* p, unsigned v) { return __hip_atomic_fetch_add(p, v, __ATOMIC_RELAXED, __HIP_MEMORY_SCOPE_AGENT); }
__device__ __forceinline__ unsigned xb_xcc_id() { return (unsigned)__builtin_amdgcn_s_getreg((3 << 11) | 20) & 0xFu; }
#define XB_SPIN(cond, bar) do { unsigned _sp = 0; while (cond) { __builtin_amdgcn_s_sleep(1); \
    if ((++_sp & 255u) == 0u) { if (xb_ld(&(bar)[XB_TMO])) break; if (_sp > XB_SPIN_CAP) { atomicAdd(&(bar)[XB_TMO], 1u); break; } } } } while (0)

struct XcdBarrier {
    unsigned* bar; unsigned x;
    volatile LAS unsigned* st;
};

__device__ __forceinline__ XcdBarrier xcd_barrier_post(unsigned* bar, volatile LAS unsigned* st) {
    XcdBarrier b; b.bar = bar; b.x = xb_xcc_id(); b.st = st;
    if (threadIdx.x == 0) (void)xb_add(&bar[XB_XCNT(b.x)], 1u);
    return b;
}
__device__ __forceinline__ void xcd_barrier_complete(unsigned* bar, unsigned x, unsigned& nloc, unsigned& nx) {
    const unsigned G = gridDim.x * gridDim.y * gridDim.z;
    unsigned sum, cnt, mine, sp = 0u;
    for (;;) {
        sum = 0u; cnt = 0u; mine = 0u;
#pragma unroll
        for (unsigned j = 0; j < 16; ++j) { const unsigned c = xb_ld(&bar[XB_XCNT(j)]); sum += c; cnt += (c > 0u) ? 1u : 0u; mine = (j == x) ? c : mine; }
        if (sum == G) break;
        __builtin_amdgcn_s_sleep(1);
        if ((++sp & 255u) == 0u) { if (xb_ld(&bar[XB_TMO])) break; if (sp > XB_SPIN_CAP) { atomicAdd(&bar[XB_TMO], 1u); break; } }
    }
    nloc = mine > 0u ? mine : 1u; nx = cnt > 0u ? cnt : 1u;
}

__device__ __forceinline__ void xcd_barrier(const XcdBarrier& b) {
    asm volatile("s_waitcnt vmcnt(0)" ::: "memory");
    __syncthreads();
    if (threadIdx.x == 0) {
        unsigned* bar = b.bar;
        __builtin_amdgcn_s_waitcnt(0);
        unsigned nloc = b.st[0], nx = b.st[1];
        if (nloc == 0u) { xcd_barrier_complete(bar, b.x, nloc, nx); b.st[0] = nloc; b.st[1] = nx; }
        const unsigned old = xb_add(&bar[XB_XSUB(b.x)], 1u);
        const unsigned gen = old / nloc;
        if (old + 1u == (gen + 1u) * nloc) {
            __builtin_amdgcn_fence(__ATOMIC_RELEASE, "agent");
            asm volatile("s_waitcnt vmcnt(0)" ::: "memory");
            const unsigned og = xb_add(&bar[XB_TOP], 1u);
            const unsigned tg = og / nx;
            if (og + 1u == (tg + 1u) * nx) xb_add(&bar[XB_TOPGEN], 1u);
            else XB_SPIN(xb_ld(&bar[XB_TOPGEN]) == tg, bar);
            __builtin_amdgcn_fence(__ATOMIC_ACQUIRE, "agent");
            xb_add(&bar[XB_XGEN(b.x)], 1u);
            asm volatile("s_waitcnt vmcnt(0)" ::: "memory");
        } else {
            XB_SPIN(xb_ld(&bar[XB_XGEN(b.x)]) == gen, bar);
            __builtin_amdgcn_fence(__ATOMIC_ACQUIRE, "agent");
            asm volatile("s_waitcnt vmcnt(0)" ::: "memory");
        }
    }
    __syncthreads();
}
struct Args { const void* in[40]; float* out; unsigned char* ws; int ph_lo, ph_hi; };
typedef const __attribute__((address_space(4))) Args* ArgsP;
__device__ __forceinline__ ArgsP fresh_args() { ArgsP p = (ArgsP)__builtin_amdgcn_kernarg_segment_ptr(); asm volatile("" : "+s"(p)); return p; }

struct Frame {
    LAS unsigned char* lds;
    int wave, G, gw, NGW;
    __device__ __forceinline__ int lane() const { unsigned z = 0u; asm volatile("" : "+v"(z)); return (int)__builtin_amdgcn_mbcnt_hi(~0u, __builtin_amdgcn_mbcnt_lo(~0u, z)); }
};

__device__ __forceinline__ Frame fresh(const Frame& F) { Frame R = F; asm volatile("" : "+s"(R.wave), "+s"(R.G), "+s"(R.gw), "+s"(R.NGW)); return R; }
#define LDS_WAIT() asm volatile("s_waitcnt lgkmcnt(0)" ::: "memory")

__device__ __forceinline__ void p0_mod_items(Frame& F, const float* c, const float* ada_w, const float* ada_b, float* mod) {
    LAS float* part = (LAS float*)F.lds;
    int tid_ = F.wave * 64 + F.lane(); asm volatile("" : "+v"(tid_)); const int lane_ = tid_ & 63;
    for (int it = blockIdx.x; it < 192; it += F.G) {
        const int l = it / 96, j0 = (it % 96) * 64;
        float acc[8];
#pragma unroll
        for (int b = 0; b < 8; ++b) acc[b] = 0.f;
        const float* w = ada_w + (size_t)l * 1024 * 6144 + j0 + lane_;
        const int k0 = F.wave * 128;
        for (int k = k0; k < k0 + 128; ++k) { const float wv = w[(size_t)k * 6144];
#pragma unroll
            for (int b = 0; b < 8; ++b) { const float cv = c[b * 1024 + k]; acc[b] += siluf(cv) * wv; } }
#pragma unroll
        for (int b = 0; b < 8; ++b) part[(F.wave * 8 + b) * 64 + lane_] = acc[b];
        __syncthreads();
        { const int b = tid_ >> 6, col = tid_ & 63; float s = 0.f;
#pragma unroll
          for (int w8 = 0; w8 < 8; ++w8) s += part[(w8 * 8 + b) * 64 + col];
          mod[(size_t)(l * 8 + b) * 6144 + j0 + col] = s + ada_b[l * 6144 + j0 + col]; }
        __syncthreads();
    }
}
__device__ __forceinline__ void cvt_item(const float* colp, size_t Ns, bf16_t* WT, int Kd, int n0, int k0, LAS float* scr, int lane) {
    const int q4 = 4 * (lane & 7), kr = lane >> 3;
    pg8::f32x4 v[8];
#pragma unroll
    for (int i = 0; i < 8; ++i) v[i] = colp ? *(const pg8::f32x4*)(colp + (size_t)(k0 + 8 * i + kr) * Ns) : (pg8::f32x4){0.f, 0.f, 0.f, 0.f};
#pragma unroll
    for (int i = 0; i < 8; ++i)
#pragma unroll
        for (int e = 0; e < 4; ++e) scr[(8 * i + kr) * 33 + q4 + e] = v[i][e];
    LDS_WAIT(); asm volatile("" ::: "memory");
    const int cidx = lane & 7;
#pragma unroll
    for (int j = 0; j < 4; ++j) { const int n = (lane >> 3) + 8 * j; const LAS float* s = scr + (8 * cidx) * 33 + n;
        pg8::u32x4 o; o.x = pk2(s[0 * 33], s[1 * 33]); o.y = pk2(s[2 * 33], s[3 * 33]); o.z = pk2(s[4 * 33], s[5 * 33]); o.w = pk2(s[6 * 33], s[7 * 33]);
        *(pg8::u32x4*)(WT + (size_t)(n0 + n) * Kd + k0 + 8 * cidx) = o; }
    LDS_WAIT(); asm volatile("" ::: "memory");
}
__device__ __forceinline__ int win_src_col(int v) { return v < 768 ? v : (v < 7168 ? v + 16 : (v < 7184 ? v - 6400 : -1)); }

__device__ __forceinline__ void p0_convert(Frame& F, ArgsP a) {
    LAS float* scr = (LAS float*)(F.lds + 16384 + F.wave * 8704);
    const float* w_in = (const float*)a->in[9]; const float* w_branch = (const float*)a->in[30]; const float* w_out = (const float*)a->in[31];
    const float* wg = (const float*)a->in[32]; const float* wu = (const float*)a->in[33]; const float* wd = (const float*)a->in[34];
    bf16_t* WIN = (bf16_t*)(a->ws + WS_WIN); bf16_t* WB = (bf16_t*)(a->ws + WS_WB); bf16_t* WO = (bf16_t*)(a->ws + WS_WO); bf16_t* WF1 = (bf16_t*)(a->ws + WS_WF1); bf16_t* WF2 = (bf16_t*)(a->ws + WS_WF2);
    constexpr int I_IN = 2 * 232 * 16, I_B = 2 * 4 * 32 * 4, I_O = 2 * 32 * 16, I_F1 = 176 * 16, I_F2 = 32 * 44, I_LR = 16 + 16 + 32;
    constexpr int NITEMS = I_IN + I_B + I_O + I_F1 + I_F2 + I_LR;
    bf16_t* LR = (bf16_t*)(a->ws + WS_LR);
    int lane_ = F.lane(); asm volatile("" : "+v"(lane_));
    const int n = 4 * (lane_ & 7);
    for (int it = F.gw; it < NITEMS; it += F.NGW) {
        int r = it;
        if (r < I_IN) { const int l = r / (232 * 16), q = r % (232 * 16), nb = q / 16, kb = q % 16; const int sc = win_src_col(nb * 32 + n);
            cvt_item(sc >= 0 ? w_in + (size_t)l * 1024 * NIN + sc : nullptr, NIN, WIN + (size_t)l * PW * 1024, 1024, nb * 32, kb * 64, scr, lane_); continue; } r -= I_IN;
        if (r < I_B) { const int lg = r / 128, q = r % 128, nb = q / 4, kb = q % 4;
            cvt_item(w_branch + (size_t)lg * 256 * 1024 + nb * 32 + n, 1024, WB + (size_t)lg * 1024 * 256, 256, nb * 32, kb * 64, scr, lane_); continue; } r -= I_B;
        if (r < I_O) { const int l = r / 512, q = r % 512, nb = q / 16, kb = q % 16;
            cvt_item(w_out + (size_t)l * 1024 * 1024 + nb * 32 + n, 1024, WO + (size_t)l * 1024 * 1024, 1024, nb * 32, kb * 64, scr, lane_); continue; } r -= I_O;
        if (r < I_F1) { const int nb = r / 16, kb = r % 16; const int v = nb * 32 + n; const int up = (v >> 2) & 1, j = (v >> 3) * 4 + (v & 3);
            cvt_item((up ? wu : wg) + j, DFF, WF1, 1024, nb * 32, kb * 64, scr, lane_); continue; } r -= I_F1;
        if (r < I_F2) { const int nb = r / 44, kb = r % 44;
            cvt_item(wd + nb * 32 + n, 1024, WF2, DFF, nb * 32, kb * 64, scr, lane_); continue; } r -= I_F2;
        if (r < 16) { const int l = r >> 3, nb = r & 7; cvt_item((const float*)a->in[21] + l * 64 * 256 + nb * 32 + n, 256, LR + l * 256 * 64, 64, nb * 32, 0, scr, lane_); continue; } r -= 16;
        if (r < 16) { const int l = r >> 3, nb = r & 7; cvt_item((const float*)a->in[23] + l * 64 * 256 + nb * 32 + n, 256, LR + 2 * 256 * 64 + l * 256 * 64, 64, nb * 32, 0, scr, lane_); continue; } r -= 16;
        { const int l = r >> 4, nb = (r >> 1) & 7, kb = r & 1; cvt_item((const float*)a->in[24] + l * 128 * 256 + nb * 32 + n, 256, LR + 4 * 256 * 64 + l * 256 * 128, 128, nb * 32, kb * 64, scr, lane_); }
    }
}

__device__ __forceinline__ void row_load(const float* p, pg8::f32x4 (&v)[4], int lane) {
#pragma unroll
    for (int j = 0; j < 4; ++j) v[j] = *(const pg8::f32x4*)(p + 4 * lane + 256 * j);
}
__device__ __forceinline__ float row_ss(const pg8::f32x4 (&v)[4]) {
    float s = 0.f;
#pragma unroll
    for (int j = 0; j < 4; ++j) s += (v[j][0] * v[j][0] + v[j][1] * v[j][1]) + (v[j][2] * v[j][2] + v[j][3] * v[j][3]);
    return wave_sum(s);
}
__device__ __forceinline__ void row_normmod(const pg8::f32x4 (&x)[4], const float* g, const float* mb, int sh_off, int sc_off, bf16_t* hrow, pg8::f32x4 (&hv)[4], int lane) {
    const float rstd = rsqrtf(row_ss(x) * (1.0f / D) + 1e-6f);
#pragma unroll
    for (int j = 0; j < 4; ++j) { const int d = 4 * lane + 256 * j;
        const pg8::f32x4 gg = *(const pg8::f32x4*)(g + d), sc = *(const pg8::f32x4*)(mb + sc_off + d), sh = *(const pg8::f32x4*)(mb + sh_off + d);
        hv[j] = x[j] * rstd * gg * (1.0f + sc) + sh;
        pg8::u32x2 w; w.x = pk2(hv[j][0], hv[j][1]); w.y = pk2(hv[j][2], hv[j][3]);
        *(pg8::u32x2*)(hrow + d) = w; }
}
__device__ __forceinline__ void ph_h0(Frame& F, ArgsP a) {
    const float* x = (const float*)a->in[0]; const float* g = (const float*)a->in[5]; const float* mod = (const float*)(a->ws + WS_MOD); bf16_t* H = (bf16_t*)(a->ws + WS_HB);
    for (int row = F.gw; row < M; row += F.NGW) { int lane = F.lane(); asm volatile("" : "+v"(lane)); pg8::f32x4 xv[4], hv[4]; row_load(x + (size_t)row * D, xv, lane);
        row_normmod(xv, g, mod + (size_t)(row / T) * 6144, 0, 1024, H + (size_t)row * D, hv, lane); }
}
__device__ __forceinline__ void ph_row(Frame& F, ArgsP a, const float* xold, const float* y, const float* gpost, const float* modl, int gt_off,
                                       const float* gpre, const float* modn, int sh_off, int sc_off, bf16_t* hdst, bool route, const bf16_t* eout = nullptr) {
    float* out = a->out;
    const float* rw = (const float*)a->in[35]; const float* rb = (const float*)a->in[36];
    unsigned* cnt = (unsigned*)(a->ws + WS_CTL) + CW_CNT;
    int* list = (int*)(a->ws + WS_ROUTE + RT_LIST); int* toke = (int*)(a->ws + WS_ROUTE + RT_TOKE); int* toks = (int*)(a->ws + WS_ROUTE + RT_TOKS); float* tokp = (float*)(a->ws + WS_ROUTE + RT_TOKP);
    for (int row = F.gw; row < M; row += F.NGW) {
        int lane = F.lane(); asm volatile("" : "+v"(lane));
        const int b = row / T; pg8::f32x4 yv[4], xv[4], hv[4];
        if (eout) {
            int roff[8]; { int o = 0;
#pragma unroll
                for (int e = 0; e < 8; ++e) { roff[e] = o; o += (((int)cnt[e] + 255) >> 8) << 8; } }
            const int e1 = toke[row * 2], e2 = toke[row * 2 + 1]; int g1 = toks[row * 2], g2 = toks[row * 2 + 1];
#pragma unroll
            for (int q = 0; q < 8; ++q) { if (q == e1) g1 += roff[q]; if (q == e2) g2 += roff[q]; }
            const float p1 = tokp[row * 2], p2 = tokp[row * 2 + 1];
#pragma unroll
            for (int j = 0; j < 4; ++j) { const pg8::u32x2 a1 = *(const pg8::u32x2*)(eout + (size_t)g1 * D + 4 * lane + 256 * j), a2 = *(const pg8::u32x2*)(eout + (size_t)g2 * D + 4 * lane + 256 * j);
                yv[j][0] = p1 * __builtin_bit_cast(float, a1.x << 16) + p2 * __builtin_bit_cast(float, a2.x << 16); yv[j][1] = p1 * __builtin_bit_cast(float, a1.x & 0xffff0000u) + p2 * __builtin_bit_cast(float, a2.x & 0xffff0000u);
                yv[j][2] = p1 * __builtin_bit_cast(float, a1.y << 16) + p2 * __builtin_bit_cast(float, a2.y << 16); yv[j][3] = p1 * __builtin_bit_cast(float, a1.y & 0xffff0000u) + p2 * __builtin_bit_cast(float, a2.y & 0xffff0000u); }
        } else row_load(y + (size_t)row * D, yv, lane);
        row_load(xold + (size_t)row * D, xv, lane);
        const float rstd = rsqrtf(row_ss(yv) * (1.0f / D) + 1e-6f);
        const float* mb = modl + (size_t)b * 6144;
#pragma unroll
        for (int j = 0; j < 4; ++j) { const int d = 4 * lane + 256 * j;
            const pg8::f32x4 gp = *(const pg8::f32x4*)(gpost + d), gt = *(const pg8::f32x4*)(mb + gt_off + d);
            xv[j] = xv[j] + gt * (yv[j] * rstd * gp);
            *(pg8::f32x4*)(out + (size_t)row * D + d) = xv[j]; }
        if (hdst) {
            row_normmod(xv, gpre, modn + (size_t)b * 6144, sh_off, sc_off, hdst + (size_t)row * D, hv, lane);
            if (route) {
                float lg[8];
#pragma unroll
                for (int e = 0; e < 8; ++e) lg[e] = 0.f;
#pragma unroll
                for (int j = 0; j < 4; ++j)
#pragma unroll
                    for (int q = 0; q < 4; ++q) { const int d = 4 * lane + 256 * j + q; const pg8::f32x4 w0 = *(const pg8::f32x4*)(rw + d * 8), w1 = *(const pg8::f32x4*)(rw + d * 8 + 4); const float hq = hv[j][q];
                        lg[0] += hq * w0[0]; lg[1] += hq * w0[1]; lg[2] += hq * w0[2]; lg[3] += hq * w0[3]; lg[4] += hq * w1[0]; lg[5] += hq * w1[1]; lg[6] += hq * w1[2]; lg[7] += hq * w1[3]; }
#pragma unroll
                for (int e = 0; e < 8; ++e) lg[e] = wave_sum(lg[e]) + rb[e];
                if (lane == 0) {
                    int e1 = 0; float v1 = lg[0];
#pragma unroll
                    for (int e = 1; e < 8; ++e) if (lg[e] > v1) { v1 = lg[e]; e1 = e; }
                    int e2 = -1; float v2 = -3.0e38f;
#pragma unroll
                    for (int e = 0; e < 8; ++e) if (e != e1 && lg[e] > v2) { v2 = lg[e]; e2 = e; }
                    const float p1 = 1.0f / (1.0f + __expf(v2 - v1)), p2 = 1.0f - p1;
                    const int s1 = (int)atomicAdd(&cnt[e1], 1u), s2 = (int)atomicAdd(&cnt[e2], 1u);
                    list[e1 * M + s1] = row; list[e2 * M + s2] = row;
                    toke[row * 2] = e1; toke[row * 2 + 1] = e2; toks[row * 2] = s1; toks[row * 2 + 1] = s2; tokp[row * 2] = p1; tokp[row * 2 + 1] = p2;
                }
            }
        }
    }
}

__device__ __forceinline__ void ph_moe_prep(Frame& F, ArgsP a) {
    LAS float* scr = (LAS float*)(F.lds + F.wave * 8704);
    const float* mg = (const float*)a->in[37]; const float* mu = (const float*)a->in[38]; const float* md = (const float*)a->in[39];
    bf16_t* WM1 = (bf16_t*)(a->ws + WS_WM1); bf16_t* WM2 = (bf16_t*)(a->ws + WS_WM2);
    constexpr int I_1 = 8 * 224 * 16, I_2 = 8 * 32 * 56;
    int lane_ = F.lane(); asm volatile("" : "+v"(lane_));
    const int n = 4 * (lane_ & 7);
    for (int it = F.gw; it < I_1 + I_2; it += F.NGW) {
        int r = it;
        if (r < I_1) { const int e = r / 3584, q = r % 3584, nb = q / 16, kb = q % 16; const int v = nb * 32 + n; const int up = (v >> 2) & 1, j = (v >> 3) * 4 + (v & 3);
            cvt_item((up ? mu : mg) + (size_t)e * 1024 * DEX + j, DEX, WM1 + (size_t)e * 7168 * 1024, 1024, nb * 32, kb * 64, scr, lane_); continue; } r -= I_1;
        { const int e = r / 1792, q = r % 1792, nb = q / 56, kb = q % 56;
            cvt_item(md + (size_t)e * DEX * 1024 + nb * 32 + n, 1024, WM2 + (size_t)e * 1024 * DEX, DEX, nb * 32, kb * 64, scr, lane_); }
    }
    const unsigned* cnt = (const unsigned*)(a->ws + WS_CTL) + CW_CNT;
    const int* list = (const int*)(a->ws + WS_ROUTE + RT_LIST);
    const bf16_t* h2 = (const bf16_t*)(a->ws + WS_H2L1); bf16_t* hg = (bf16_t*)(a->ws + WS_HG);
    int roff[9]; { int o = 0;
#pragma unroll
        for (int e = 0; e < 8; ++e) { roff[e] = o; o += (((int)cnt[e] + 255) >> 8) << 8; } roff[8] = o; }
    for (int slot = F.gw; slot < roff[8]; slot += F.NGW) {
        int e = 0;
#pragma unroll
        for (int q = 1; q < 8; ++q) e += (slot >= roff[q]) ? 1 : 0;
        int base = 0, ce = 0;
#pragma unroll
        for (int q = 0; q < 8; ++q) if (q == e) { base = roff[q]; ce = (int)cnt[q]; }
        const int s = slot - base;
        pg8::u32x4 v0 = {0u, 0u, 0u, 0u}, v1 = {0u, 0u, 0u, 0u};
        if (s < ce) { const int src = list[e * M + s]; const pg8::u32x4* sp = (const pg8::u32x4*)(h2 + (size_t)src * D) + 2 * lane_; v0 = sp[0]; v1 = sp[1]; }
        pg8::u32x4* dp = (pg8::u32x4*)(hg + (size_t)slot * D) + 2 * lane_; dp[0] = v0; dp[1] = v1;
    }
}
template <int CTRL, int ROWMASK> __device__ __forceinline__ float dpp_mov(float old, float x) {
    return __builtin_bit_cast(float, __builtin_amdgcn_update_dpp(__builtin_bit_cast(int, old), __builtin_bit_cast(int, x), CTRL, ROWMASK, 0xF, false));
}
__device__ __forceinline__ float rdlane(float x, int l) { return __builtin_bit_cast(float, __builtin_amdgcn_readlane(__builtin_bit_cast(int, x), l)); }
__device__ __forceinline__ float wave_sum63(float x) {
    x += dpp_mov<0xB1, 0xF>(0.f, x);
    x += dpp_mov<0x4E, 0xF>(0.f, x);
    x += dpp_mov<0x141, 0xF>(0.f, x);
    x += dpp_mov<0x140, 0xF>(0.f, x);
    x += dpp_mov<0x142, 0xA>(0.f, x);
    x += dpp_mov<0x143, 0xC>(0.f, x);
    return x;
}
__device__ __forceinline__ float row16_sum(float x) {
    x += dpp_mov<0xB1, 0xF>(0.f, x); x += dpp_mov<0x4E, 0xF>(0.f, x); x += dpp_mov<0x141, 0xF>(0.f, x); x += dpp_mov<0x140, 0xF>(0.f, x);
    return x;
}
__device__ __forceinline__ pg8::f32x4 ld_bf16x4(const bf16_t* p) { const pg8::u32x2 w = *(const pg8::u32x2*)p;
    return (pg8::f32x4){__builtin_bit_cast(float, w.x << 16), __builtin_bit_cast(float, w.x & 0xffff0000u), __builtin_bit_cast(float, w.y << 16), __builtin_bit_cast(float, w.y & 0xffff0000u)}; }
__device__ __forceinline__ void st_bf16x4(bf16_t* p, pg8::f32x4 v) { pg8::u32x2 w; w.x = pk2(v[0], v[1]); w.y = pk2(v[2], v[3]); *(pg8::u32x2*)p = w; }

__device__ __forceinline__ void ph_conv(Frame& F, ArgsP a, int l) {
    const bf16_t* proj = (const bf16_t*)(a->ws + WS_PROJ); bf16_t* br = (bf16_t*)(a->ws + WS_HB);
    const float* cw = (const float*)a->in[15] + l * 31 * 256; const float* cb = (const float*)a->in[16] + l * 256; const float* lg = (const float*)a->in[17] + l * 256; const float* lb = (const float*)a->in[18] + l * 256;
    LAS float* u = (LAS float*)F.lds;
    int tid = F.wave * 64 + F.lane(); asm volatile("" : "+v"(tid)); const int lane = tid & 63;
    for (int it = blockIdx.x; it < M / 64; it += F.G) {
        const int row0 = it * 64, t0 = row0 % T;
        for (int idx = tid; idx < 94 * 32; idx += NTHR) { const int r = idx >> 5, c8 = (idx & 31) * 8; float uv[8];
#pragma unroll
            for (int e = 0; e < 8; ++e) uv[e] = 0.f;
            if (t0 - 30 + r >= 0) { const bf16_t* pr = proj + (size_t)(row0 - 30 + r) * PW;
                const pg8::f32x4 a0 = ld_bf16x4(pr + P_CA + c8), a1 = ld_bf16x4(pr + P_CA + c8 + 4), b0 = ld_bf16x4(pr + P_CB + c8), b1 = ld_bf16x4(pr + P_CB + c8 + 4);
#pragma unroll
                for (int e = 0; e < 4; ++e) { uv[e] = a0[e] * sigm(b0[e]); uv[4 + e] = a1[e] * sigm(b1[e]); } }
            *(LAS pg8::f32x4*)(u + r * 256 + c8) = (pg8::f32x4){uv[0], uv[1], uv[2], uv[3]}; *(LAS pg8::f32x4*)(u + r * 256 + c8 + 4) = (pg8::f32x4){uv[4], uv[5], uv[6], uv[7]}; }
        __syncthreads();
        const int c = tid & 255, half = tid >> 8;
        float acc[32];
        { float w[31], ur[62];
#pragma unroll
          for (int j = 0; j < 31; ++j) w[j] = cw[j * 256 + c];
#pragma unroll
          for (int q = 0; q < 62; ++q) ur[q] = u[(half * 32 + q) * 256 + c];
          const float bias = cb[c];
#pragma unroll
          for (int i = 0; i < 32; ++i) { float s = bias;
#pragma unroll
              for (int j = 0; j < 31; ++j) s += w[j] * ur[i + j];
              acc[i] = s; } }
        __syncthreads();
#pragma unroll
        for (int i = 0; i < 32; ++i) u[(half * 32 + i) * 256 + c] = acc[i];
        __syncthreads();
        const pg8::f32x4 g4 = *(const pg8::f32x4*)(lg + 4 * lane), b4 = *(const pg8::f32x4*)(lb + 4 * lane);
#pragma unroll 2
        for (int q = 0; q < 8; ++q) { const int t = F.wave * 8 + q; const pg8::f32x4 yv = *(const LAS pg8::f32x4*)(u + t * 256 + 4 * lane);
            const float mu = wave_sum((yv[0] + yv[1]) + (yv[2] + yv[3])) * (1.0f / 256.0f); const pg8::f32x4 d = yv - mu;
            const float var = wave_sum((d[0] * d[0] + d[1] * d[1]) + (d[2] * d[2] + d[3] * d[3])) * (1.0f / 256.0f);
            pg8::f32x4 o = d * rsqrtf(var + 1e-5f) * g4 + b4;
#pragma unroll
            for (int e = 0; e < 4; ++e) o[e] = siluf(o[e]);
            st_bf16x4(br + (size_t)(row0 + t) * D + 512 + 4 * lane, o); }
        __syncthreads();
    }
}

__device__ __forceinline__ void ph_rwkv_prep(Frame& F, ArgsP a, int l) {
    typedef float f32x16 __attribute__((ext_vector_type(16)));
    const bf16_t* proj = (const bf16_t*)(a->ws + WS_PROJ);
    const float* mu = (const float*)a->in[19] + l * 1024; const float* w0 = (const float*)a->in[20] + l * 256; const float* a0 = (const float*)a->in[22] + l * 256;
    const float* kkw = (const float*)a->in[25] + l * 256; const float* kaw = (const float*)a->in[26] + l * 256; const float* rkw = (const float*)a->in[27] + l * 256;
    const bf16_t* W2T = (const bf16_t*)(a->ws + WS_LR) + l * 256 * 64; const bf16_t* A2T = (const bf16_t*)(a->ws + WS_LR) + 2 * 256 * 64 + l * 256 * 64; const bf16_t* G2T = (const bf16_t*)(a->ws + WS_LR) + 4 * 256 * 64 + l * 256 * 128;
    float* VEC = (float*)(a->ws + SCR_VEC6); float* SC = (float*)(a->ws + SCR_SC); bf16_t* GR = (bf16_t*)(a->ws + SCR_GR);
    constexpr int RS = 72, RG = 136;
    LAS bf16_t* TZh = (LAS bf16_t*)F.lds; LAS bf16_t* TZl = TZh + 64 * RS; LAS bf16_t* ZA = TZl + 64 * RS; LAS bf16_t* SG = ZA + 64 * RS;
    int tid = F.wave * 64 + F.lane(); asm volatile("" : "+v"(tid));
    for (int it = blockIdx.x; it < M / 64; it += F.G) {
        const int row0 = it * 64, b = row0 / T, t0 = row0 % T;
#pragma unroll 4
        for (int i_ = 0; i_ < 32; ++i_) { const int idx = tid + i_ * NTHR; const int cc = idx & 255, tok = idx >> 8; const int col = 768 + cc;
            const bf16_t* pc = proj + (size_t)(row0 + tok) * PW + P_R + col; const float xc = bf2f(pc[0]); const float xp = (t0 + tok > 0) ? bf2f(pc[-PW]) : 0.f;
            const float xm = xc + (xp - xc) * mu[col];
            if (cc < 64) { const float tv = tanhf(xm); const unsigned hi = f2bf(tv); TZh[tok * RS + cc] = (bf16_t)hi; TZl[tok * RS + cc] = (bf16_t)f2bf(tv - __builtin_bit_cast(float, hi << 16)); }
            else if (cc < 128) ZA[tok * RS + cc - 64] = (bf16_t)f2bf(xm);
            else SG[tok * RG + cc - 128] = (bf16_t)f2bf(sigm(xm)); }
        __syncthreads();
        int tid2 = tid; asm volatile("" : "+v"(tid2));
        const int lane = tid2 & 63, r = lane & 31, hg = lane >> 5, h = (tid2 >> 6) & 3, th = tid2 >> 8;
        f32x16 accw[2], acca[2], accg[2];
#pragma unroll
        for (int nb = 0; nb < 2; ++nb)
#pragma unroll
            for (int e = 0; e < 16; ++e) { accw[nb][e] = 0.f; acca[nb][e] = 0.f; accg[nb][e] = 0.f; }
        const int arow = (th * 32 + r);
#pragma unroll
        for (int s = 0; s < 4; ++s) { const pg8::bf16x8 ah = *(const LAS pg8::bf16x8*)(TZh + arow * RS + 16 * s + 8 * hg), al = *(const LAS pg8::bf16x8*)(TZl + arow * RS + 16 * s + 8 * hg), az = *(const LAS pg8::bf16x8*)(ZA + arow * RS + 16 * s + 8 * hg);
#pragma unroll
            for (int nb = 0; nb < 2; ++nb) { const int n = h * 64 + nb * 32 + r;
                const pg8::bf16x8 bw = *(const pg8::bf16x8*)(W2T + n * 64 + 16 * s + 8 * hg), ba = *(const pg8::bf16x8*)(A2T + n * 64 + 16 * s + 8 * hg);
                accw[nb] = __builtin_amdgcn_mfma_f32_32x32x16_bf16(ah, bw, accw[nb], 0, 0, 0); accw[nb] = __builtin_amdgcn_mfma_f32_32x32x16_bf16(al, bw, accw[nb], 0, 0, 0);
                acca[nb] = __builtin_amdgcn_mfma_f32_32x32x16_bf16(az, ba, acca[nb], 0, 0, 0); } }
#pragma unroll
        for (int s = 0; s < 8; ++s) { const pg8::bf16x8 ag = *(const LAS pg8::bf16x8*)(SG + arow * RG + 16 * s + 8 * hg);
#pragma unroll
            for (int nb = 0; nb < 2; ++nb) { const int n = h * 64 + nb * 32 + r; const pg8::bf16x8 bg = *(const pg8::bf16x8*)(G2T + n * 128 + 16 * s + 8 * hg);
                accg[nb] = __builtin_amdgcn_mfma_f32_32x32x16_bf16(ag, bg, accg[nb], 0, 0, 0); } }
        int tid3 = tid; asm volatile("" : "+v"(tid3)); const int r3 = tid3 & 31, hg3 = (tid3 >> 5) & 1, h3 = (tid3 >> 6) & 3, th3 = tid3 >> 8;
        float pw0[2], pa0[2], pmr[2], pmk[2], pmv[2], pkk[2], pka[2], prk[2];
#pragma unroll
        for (int nb = 0; nb < 2; ++nb) { const int c = h3 * 64 + nb * 32 + r3; pw0[nb] = w0[c]; pa0[nb] = a0[c]; pmr[nb] = mu[c]; pmk[nb] = mu[256 + c]; pmv[nb] = mu[512 + c]; pkk[nb] = kkw[c]; pka[nb] = kaw[c]; prk[nb] = rkw[c]; }
#pragma unroll
        for (int e = 0; e < 16; ++e) { const int tok = th3 * 32 + (e & 3) + 8 * (e >> 2) + 4 * hg3, t = t0 + tok; const size_t row = (size_t)row0 + tok; const bool hp = t > 0;
            float dec[2], kkv[2], kka[2], k2[2], rv[2], vv[2], s_kk = 0.f, s_c1 = 0.f, s_c2 = 0.f, s_bn = 0.f;
#pragma unroll
            for (int nb = 0; nb < 2; ++nb) { const int c = h3 * 64 + nb * 32 + r3; const bf16_t* pc = proj + row * PW + P_R + c;
                const float rc = bf2f(pc[0]), kc = bf2f(pc[256]), vc = bf2f(pc[512]);
                const float rp = hp ? bf2f(pc[-PW]) : 0.f, kp = hp ? bf2f(pc[256 - PW]) : 0.f, vp = hp ? bf2f(pc[512 - PW]) : 0.f;
                const float rr = rc + (rp - rc) * pmr[nb], k = kc + (kp - kc) * pmk[nb]; vv[nb] = vc + (vp - vc) * pmv[nb]; rv[nb] = rr;
                const float wl = -softplusf(-(accw[nb][e] + pw0[nb])) - 0.5f; dec[nb] = __expf(-__expf(wl)); const float av = sigm(acca[nb][e] + pa0[nb]);
                kkv[nb] = k * pkk[nb]; k2[nb] = k * (1.0f + (av - 1.0f) * pka[nb]); kka[nb] = av;
                s_kk += kkv[nb] * kkv[nb]; s_c2 += k2[nb] * rr; s_bn += rr * k2[nb] * prk[nb];
                GR[row * 256 + c] = (bf16_t)f2bf(accg[nb][e]); }
            s_kk = row16_sum(s_kk); s_kk += __shfl_xor(s_kk, 16);
            const float inv = 1.0f / fmaxf(sqrtf(s_kk), 1e-12f);
#pragma unroll
            for (int nb = 0; nb < 2; ++nb) { kkv[nb] *= inv; kka[nb] *= kkv[nb]; s_c1 += kka[nb] * rv[nb]; }
            s_c1 = row16_sum(s_c1); s_c1 += __shfl_xor(s_c1, 16); s_c2 = row16_sum(s_c2); s_c2 += __shfl_xor(s_c2, 16); s_bn = row16_sum(s_bn); s_bn += __shfl_xor(s_bn, 16);
            const size_t st = ((size_t)(b * 4 + h3) * T + t);
#pragma unroll
            for (int nb = 0; nb < 2; ++nb) { float* vb = VEC + st * VSTEP + nb * 32 + r3;
                vb[0] = dec[nb]; vb[64] = -kkv[nb]; vb[128] = kka[nb]; vb[192] = k2[nb]; vb[256] = dec[nb] * rv[nb]; vb[320] = vv[nb]; }
            if (r3 == 0) { *(pg8::f32x4*)(SC + st * 4) = (pg8::f32x4){s_c1, s_c2, s_bn, 0.f}; *(pg8::f32x2*)(VEC + st * VSTEP + 384) = (pg8::f32x2){s_c1, s_c2}; }
            asm volatile("" ::: "memory"); }
        __syncthreads();
    }
}

__device__ __forceinline__ void ph_rwkv_scan(Frame& F, ArgsP a) {
    const float* VEC = (const float*)(a->ws + SCR_VEC6); float* YR = (float*)(a->ws + SCR_YR);
    int lane = F.lane(); asm volatile("" : "+v"(lane));
    constexpr int CH = 32, CHB = CH * VSTEP * 4, NP = CHB / 1024 / 4;
    const bool stager = F.wave >= 4;
    for (int it = blockIdx.x; it < 256; it += F.G) {
        const int bh = it >> 3, rg = it & 7, b = bh >> 2, h = bh & 3;
        const int sw = F.wave & 3, vrow = rg * 8 + 2 * sw;
        const char* src = (const char*)(VEC + (size_t)bh * T * VSTEP) + lane * 16;
#define RW_STAGE(cidx) do { _Pragma("unroll") for (int p_ = 0; p_ < NP; ++p_) \
            __builtin_amdgcn_global_load_lds((const unsigned*)(src + (size_t)(cidx) * CHB + (sw * NP + p_) * 1024), (LAS unsigned*)(F.lds + ((cidx) & 1) * CHB + (sw * NP + p_) * 1024), 16, 0, 0); } while (0)
        if (stager) { RW_STAGE(0); asm volatile("s_waitcnt vmcnt(0)" ::: "memory"); }
        __builtin_amdgcn_s_barrier(); asm volatile("" ::: "memory");
        float SA = 0.f, SB = 0.f;
        for (int c = 0; c < T / CH; ++c) {
            if (stager) { if (c + 1 < T / CH) { RW_STAGE(c + 1); asm volatile("s_waitcnt vmcnt(0)" ::: "memory"); } }
            else {
                const LAS float* bufl = (const LAS float*)(F.lds + (c & 1) * CHB) + lane;
                const LAS float* bufv = (const LAS float*)(F.lds + (c & 1) * CHB) + 320 + vrow;
                const LAS float* bufc = (const LAS float*)(F.lds + (c & 1) * CHB) + 384;
                float yaA = 0.f, yaB = 0.f;
                float nw = bufl[0], nnkk = bufl[64], nkka = bufl[128], nk2 = bufl[192], nwr = bufl[256]; pg8::f32x2 nv = *(const LAS pg8::f32x2*)bufv, ncc = *(const LAS pg8::f32x2*)bufc;
#pragma unroll 4
                for (int s = 0; s < CH; ++s) {
                    const float w_ = nw, nkk = nnkk, kka = nkka, k2 = nk2, wr = nwr; const pg8::f32x2 v = nv, cc = ncc;
                    { const int s1 = (s + 1 < CH ? s + 1 : s) * VSTEP;
                      nw = bufl[s1]; nnkk = bufl[s1 + 64]; nkka = bufl[s1 + 128]; nk2 = bufl[s1 + 192]; nwr = bufl[s1 + 256]; nv = *(const LAS pg8::f32x2*)(bufv + s1); ncc = *(const LAS pg8::f32x2*)(bufc + s1); }
                    const auto s0 = __builtin_amdgcn_permlane32_swap(__builtin_bit_cast(unsigned, SA * nkk), __builtin_bit_cast(unsigned, SA * wr), false, false);
                    const auto s1_ = __builtin_amdgcn_permlane32_swap(__builtin_bit_cast(unsigned, SB * nkk), __builtin_bit_cast(unsigned, SB * wr), false, false);
                    const float xA = __builtin_bit_cast(float, (unsigned)s0[0]) + __builtin_bit_cast(float, (unsigned)s0[1]);
                    const float xB = __builtin_bit_cast(float, (unsigned)s1_[0]) + __builtin_bit_cast(float, (unsigned)s1_[1]);
                    const auto s2 = __builtin_amdgcn_permlane16_swap(__builtin_bit_cast(unsigned, xA), __builtin_bit_cast(unsigned, xB), false, false);
                    float x = __builtin_bit_cast(float, (unsigned)s2[0]) + __builtin_bit_cast(float, (unsigned)s2[1]);
                    x += dpp_mov<0xB1, 0xF>(0.f, x); x += dpp_mov<0x4E, 0xF>(0.f, x); x += dpp_mov<0x141, 0xF>(0.f, x); x += dpp_mov<0x140, 0xF>(0.f, x);
                    const float saA = rdlane(x, 0), saB = rdlane(x, 16), zA = rdlane(x, 32), zB = rdlane(x, 48);
                    SA = SA * w_ + (saA * kka + v[0] * k2);
                    SB = SB * w_ + (saB * kka + v[1] * k2);
                    const float yA = zA + saA * cc[0] + v[0] * cc[1], yB = zB + saB * cc[0] + v[1] * cc[1];
                    yaA = (lane == s) ? yA : yaA; yaB = (lane == s) ? yB : yaB;
                }
                if (lane < CH) *(pg8::f32x2*)(YR + ((size_t)b * T + c * CH + lane) * 256 + h * 64 + vrow) = (pg8::f32x2){yaA, yaB};
            }
            __builtin_amdgcn_s_barrier(); asm volatile("" ::: "memory");
        }
#undef RW_STAGE
        asm volatile("s_waitcnt vmcnt(0)" ::: "memory"); __builtin_amdgcn_s_barrier(); asm volatile("" ::: "memory");
    }
}

__device__ __forceinline__ void ph_rwkv_post(Frame& F, ArgsP a, int l) {
    const float* VEC = (const float*)(a->ws + SCR_VEC6); const float* SC = (const float*)(a->ws + SCR_SC); const float* YR = (const float*)(a->ws + SCR_YR); const bf16_t* GR = (const bf16_t*)(a->ws + SCR_GR);
    const float* lng = (const float*)a->in[28] + l * 256; const float* lnb = (const float*)a->in[29] + l * 256;
    bf16_t* br = (bf16_t*)(a->ws + WS_HB);
    int lane = F.lane(); asm volatile("" : "+v"(lane));
    const int c = 4 * lane, h = lane >> 4;
    const pg8::f32x4 g4 = *(const pg8::f32x4*)(lng + c), b4 = *(const pg8::f32x4*)(lnb + c);
    for (int row = F.gw; row < M; row += F.NGW) {
        const int b = row / T, t = row % T; const size_t st = (size_t)(b * 4 + h) * T + t;
        const pg8::f32x4 y = *(const pg8::f32x4*)(YR + (size_t)row * 256 + c);
        const float mu = row16_sum((y[0] + y[1]) + (y[2] + y[3])) * (1.0f / 64.0f); const pg8::f32x4 d = y - mu;
        const float var = row16_sum((d[0] * d[0] + d[1] * d[1]) + (d[2] * d[2] + d[3] * d[3])) * (1.0f / 64.0f);
        const pg8::f32x4 yn = d * rsqrtf(var + 64e-5f) * g4 + b4;
        const float bonus = SC[st * 4 + 2];
        const pg8::f32x4 v = *(const pg8::f32x4*)(VEC + st * VSTEP + 320 + (c & 63));
        const pg8::f32x4 g = ld_bf16x4(GR + (size_t)row * 256 + c);
        st_bf16x4(br + (size_t)row * D + 768 + c, (yn + bonus * v) * g);
    }
}

__device__ __forceinline__ void ph_gla_p1(Frame& F, ArgsP a, int l) {
    const bf16_t* proj = (const bf16_t*)(a->ws + WS_PROJ); const float* w2 = (const float*)a->in[10] + l * 16 * 128; const float* gb = (const float*)a->in[11] + l * 128;
    float* EG = (float*)(a->ws + SCR_EG); float* CDp = EG + (size_t)M * 128; float* GU = (float*)(a->ws + SCR_GU);
    LAS float* el = (LAS float*)(F.lds + F.wave * 8192); LAS float* kl = el + 1024;
    int lane = F.lane(); asm volatile("" : "+v"(lane));
    const int d = lane & 31;
    for (int it = F.gw; it < 2048; it += F.NGW) {
        const int bh = it >> 6, n = it & 63, b = bh >> 2, h = bh & 3; const size_t row0 = (size_t)b * T + n * 32;
        float wc[16];
#pragma unroll
        for (int r = 0; r < 16; ++r) wc[r] = w2[r * 128 + h * 32 + d];
        const float gbv = gb[h * 32 + d];
#pragma unroll 4
        for (int i = 0; i < 16; ++i) { const int tok = 2 * i + (lane >> 5); const bf16_t* pr = proj + (row0 + tok) * PW;
            const pg8::f32x4 z0 = ld_bf16x4(pr + P_GZ), z1 = ld_bf16x4(pr + P_GZ + 4), z2 = ld_bf16x4(pr + P_GZ + 8), z3 = ld_bf16x4(pr + P_GZ + 12);
            float acc = gbv;
#pragma unroll
            for (int e = 0; e < 4; ++e) acc += z0[e] * wc[e] + z1[e] * wc[4 + e] + z2[e] * wc[8 + e] + z3[e] * wc[12 + e];
            const float ev = __expf(-softplusf(-acc) * (1.0f / 16.0f));
            el[tok * 32 + d] = ev; EG[(row0 + tok) * 128 + h * 32 + d] = ev;
            kl[tok * 32 + d] = bf2f(pr[P_GK + h * 32 + d]); }
        float S[32];
#pragma unroll
        for (int q = 0; q < 32; ++q) S[q] = 0.f;
        { const bf16_t* vp = proj + row0 * PW + P_GV + h * 64 + lane;
          float v0 = bf2f(vp[0]), v1 = bf2f(vp[(size_t)PW]), v2 = bf2f(vp[(size_t)2 * PW]), v3 = bf2f(vp[(size_t)3 * PW]);
#pragma unroll 1
          for (int tok = 0; tok < 32; ++tok) { const float vv = v0; v0 = v1; v1 = v2; v2 = v3; v3 = bf2f(vp[(size_t)(tok + 4 < 32 ? tok + 4 : 31) * PW]);
#pragma unroll
              for (int j = 0; j < 8; ++j) { const pg8::f32x4 e4 = *(const LAS pg8::f32x4*)(el + tok * 32 + 4 * j), k4 = *(const LAS pg8::f32x4*)(kl + tok * 32 + 4 * j);
#pragma unroll
                  for (int e = 0; e < 4; ++e) S[4 * j + e] = e4[e] * S[4 * j + e] + k4[e] * vv; } } }
#pragma unroll
        for (int q = 0; q < 32; ++q) GU[((size_t)it * 32 + q) * 64 + lane] = S[q];
        if (lane < 32) { float cd = 1.f; for (int tok = 0; tok < 32; ++tok) cd *= el[tok * 32 + lane]; CDp[it * 32 + lane] = cd; }
        asm volatile("s_waitcnt lgkmcnt(0)" ::: "memory");
    }
}
__device__ __forceinline__ void ph_gla_prefix(Frame& F, ArgsP a) {
    const float* CDp = (const float*)(a->ws + SCR_EG) + (size_t)M * 128; float* GU = (float*)(a->ws + SCR_GU);
    int lane = F.lane(); asm volatile("" : "+v"(lane));
    for (int it = F.gw; it < 1024; it += F.NGW) { const int bh = it >> 5, d = it & 31;
        float* gp = GU + ((size_t)bh * 64 * 32 + d) * 64 + lane; const float* cp = CDp + (size_t)bh * 64 * 32 + d;
        float u[64], cd[64];
#pragma unroll
        for (int n = 0; n < 64; ++n) { u[n] = gp[(size_t)n * 2048]; cd[n] = cp[n * 32]; }
        float S = 0.f;
#pragma unroll
        for (int n = 0; n < 64; ++n) { gp[(size_t)n * 2048] = S; S = cd[n] * S + u[n]; } }
}
__device__ __forceinline__ void ph_gla_p2(Frame& F, ArgsP a, int l) {
    const bf16_t* proj = (const bf16_t*)(a->ws + WS_PROJ); const float* gnorm = (const float*)a->in[12] + l * 64;
    const float* EG = (const float*)(a->ws + SCR_EG); const float* GS = (const float*)(a->ws + SCR_GS); bf16_t* br = (bf16_t*)(a->ws + WS_HB);
    LAS float* el = (LAS float*)(F.lds + F.wave * 12288); LAS float* kl = el + 1024; LAS float* ql = el + 2048;
    int lane = F.lane(); asm volatile("" : "+v"(lane));
    const int d = lane & 31; const float gn = gnorm[lane];
    for (int it = F.gw; it < 2048; it += F.NGW) {
        const int bh = it >> 6, n = it & 63, b = bh >> 2, h = bh & 3; const size_t row0 = (size_t)b * T + n * 32;
#pragma unroll 4
        for (int i = 0; i < 16; ++i) { const int tok = 2 * i + (lane >> 5); const bf16_t* pr = proj + (row0 + tok) * PW;
            el[tok * 32 + d] = EG[(row0 + tok) * 128 + h * 32 + d]; kl[tok * 32 + d] = bf2f(pr[P_GK + h * 32 + d]); ql[tok * 32 + d] = bf2f(pr[P_GQ + h * 32 + d]) * 0.17677669529663687f; }
        float S[32];
#pragma unroll
        for (int q = 0; q < 32; ++q) S[q] = GS[((size_t)it * 32 + q) * 64 + lane];
        { const bf16_t* vp = proj + row0 * PW + P_GV + h * 64 + lane; const bf16_t* op = proj + row0 * PW + P_GO + h * 64 + lane;
          float v0 = bf2f(vp[0]), v1 = bf2f(vp[(size_t)PW]), v2 = bf2f(vp[(size_t)2 * PW]), v3 = bf2f(vp[(size_t)3 * PW]);
          float o0 = bf2f(op[0]), o1 = bf2f(op[(size_t)PW]), o2 = bf2f(op[(size_t)2 * PW]), o3 = bf2f(op[(size_t)3 * PW]);
#pragma unroll 1
          for (int tok = 0; tok < 32; ++tok) { const float vv = v0, og = o0; v0 = v1; v1 = v2; v2 = v3; o0 = o1; o1 = o2; o2 = o3;
              { const size_t nx = (size_t)(tok + 4 < 32 ? tok + 4 : 31) * PW; v3 = bf2f(vp[nx]); o3 = bf2f(op[nx]); }
              float o = 0.f;
#pragma unroll
              for (int j = 0; j < 8; ++j) { const pg8::f32x4 e4 = *(const LAS pg8::f32x4*)(el + tok * 32 + 4 * j), k4 = *(const LAS pg8::f32x4*)(kl + tok * 32 + 4 * j), q4 = *(const LAS pg8::f32x4*)(ql + tok * 32 + 4 * j);
#pragma unroll
                  for (int e = 0; e < 4; ++e) { S[4 * j + e] = e4[e] * S[4 * j + e] + k4[e] * vv; o += q4[e] * S[4 * j + e]; } }
              const float ss = rdlane(wave_sum63(o * o), 63); const float rstd = rsqrtf(ss * (1.0f / 64.0f) + 1e-6f);
              br[(row0 + tok) * D + h * 64 + lane] = (bf16_t)f2bf(o * rstd * gn * siluf(og)); } }
        asm volatile("s_waitcnt lgkmcnt(0)" ::: "memory");
    }
}

typedef float f32x16 __attribute__((ext_vector_type(16)));
__device__ __forceinline__ void ph_attn_prep(Frame& F, ArgsP a) {
    const bf16_t* proj = (const bf16_t*)(a->ws + WS_PROJ); const int* pos = (const int*)a->in[2];
    bf16_t* QR = (bf16_t*)(a->ws + SCR_QK); bf16_t* KR = QR + (size_t)M * 256; bf16_t* VT = (bf16_t*)(a->ws + SCR_VT);
    int lane = F.lane(); asm volatile("" : "+v"(lane));
    for (int idx = F.gw * 64 + lane; idx < M * 8; idx += F.NGW * 64) { const int row = idx >> 3, hc = idx & 7; const float p = (float)pos[row];
        const bf16_t* qs = proj + (size_t)row * PW + P_DQ + hc * 32; const bf16_t* ks = proj + (size_t)row * PW + P_DK + hc * 32;
        float qv[32], kv[32];
#pragma unroll
        for (int j = 0; j < 8; ++j) { const pg8::f32x4 q4 = ld_bf16x4(qs + 4 * j), k4 = ld_bf16x4(ks + 4 * j);
#pragma unroll
            for (int e = 0; e < 4; ++e) { qv[4 * j + e] = q4[e]; kv[4 * j + e] = k4[e]; } }
        float qo[32], ko[32];
#pragma unroll
        for (int i = 0; i < 16; ++i) { const float inv = exp2f(-(float)i * 0.8304820237218406f);
            float sn, cs; sincosf(p * inv, &sn, &cs);
            qo[i] = qv[i] * cs - qv[i + 16] * sn; qo[i + 16] = qv[i] * sn + qv[i + 16] * cs;
            ko[i] = kv[i] * cs - kv[i + 16] * sn; ko[i + 16] = kv[i] * sn + kv[i + 16] * cs; }
        const float qsc = 0.17677669529663687f * 1.4426950408889634f;
        bf16_t* qd = QR + (size_t)row * 256 + hc * 32; bf16_t* kd = KR + (size_t)row * 256 + hc * 32;
#pragma unroll
        for (int j = 0; j < 8; ++j) { st_bf16x4(qd + 4 * j, (pg8::f32x4){qo[4 * j] * qsc, qo[4 * j + 1] * qsc, qo[4 * j + 2] * qsc, qo[4 * j + 3] * qsc});
            st_bf16x4(kd + 4 * j, (pg8::f32x4){ko[4 * j], ko[4 * j + 1], ko[4 * j + 2], ko[4 * j + 3]}); } }
    for (int it = F.gw; it < 1024; it += F.NGW) { const int bh = it >> 5, tt = it & 31, b = bh >> 2, h = bh & 3;
        const bf16_t* vs = proj + ((size_t)b * T + tt * 64 + lane) * PW + P_DV + h * 64;
        pg8::u32x4 v[8];
#pragma unroll
        for (int j = 0; j < 8; ++j) v[j] = *(const pg8::u32x4*)(vs + 8 * j);
        bf16_t* vd = VT + (size_t)bh * 64 * T + tt * 64 + lane;
#pragma unroll
        for (int j = 0; j < 8; ++j)
#pragma unroll
            for (int e = 0; e < 4; ++e) { const unsigned w = v[j][e]; vd[(size_t)(8 * j + 2 * e) * T] = (bf16_t)(w & 0xffffu); vd[(size_t)(8 * j + 2 * e + 1) * T] = (bf16_t)(w >> 16); } }
}
__device__ __forceinline__ void ph_attn(Frame& F, ArgsP a, int l) {
    const bf16_t* QR = (const bf16_t*)(a->ws + SCR_QK); const bf16_t* KR = QR + (size_t)M * 256; const bf16_t* VT = (const bf16_t*)(a->ws + SCR_VT);
    const float* lp = (const float*)a->in[13] + l * 128; const float* subln = (const float*)a->in[14] + l * 64; bf16_t* br = (bf16_t*)(a->ws + WS_HB);
    int tid = F.wave * 64 + F.lane(); asm volatile("" : "+v"(tid)); const int lane = tid & 63;
    const int r = lane & 31, hg = lane >> 5, comp = F.wave & 1, qs = F.wave >> 1;
    constexpr int RS = 72;
    LAS bf16_t* Kt = (LAS bf16_t*)F.lds;
    LAS bf16_t* Vt = Kt + 2 * 64 * RS;
    LAS float* Xl = (LAS float*)(F.lds + 4 * 64 * RS * 2);
    float lam, lam_init;
    { float d01 = 0.f, d23 = 0.f;
      for (int i = 0; i < 32; ++i) { d01 += lp[i] * lp[32 + i]; d23 += lp[64 + i] * lp[96 + i]; }
      lam_init = 0.8f - 0.6f * __expf(-0.3f * (float)l); lam = __expf(d01) - __expf(d23) + lam_init; }
    const int ldrow = tid >> 3, ldch = tid & 7;
    for (int pi = blockIdx.x; pi < 256; pi += F.G) {
#pragma unroll 1
        for (int half = 0; half < 2; ++half) {
            const int bh = pi >> 3, j = pi & 7, qb = half == 0 ? 15 - j : j, b = bh >> 2, h = bh & 3;
            const int q0 = qb * 128 + qs * 32, nkw = q0 / 64 + 1, nkb = 2 * qb + 2;
            const size_t rowb = (size_t)b * T;
            pg8::bf16x8 qf[2];
#pragma unroll
            for (int s = 0; s < 2; ++s) qf[s] = *(const pg8::bf16x8*)(QR + (rowb + q0 + r) * 256 + h * 64 + comp * 32 + 16 * s + 8 * hg);
            f32x16 ot[2];
#pragma unroll
            for (int e = 0; e < 16; ++e) { ot[0][e] = 0.f; ot[1][e] = 0.f; }
            float mrun = -1e30f, lrun = 0.f;
            const bf16_t* kg = KR + (rowb + ldrow) * 256 + h * 64 + ldch * 8; const bf16_t* vg = VT + ((size_t)bh * 64 + ldrow) * T + ldch * 8;
            pg8::u32x4 kreg = *(const pg8::u32x4*)kg, vreg = *(const pg8::u32x4*)vg;
            for (int kt = 0; kt < nkb; ++kt) {
                const int bo = (kt & 1) * 64 * RS;
                *(LAS pg8::u32x4*)(Kt + bo + ldrow * RS + ldch * 8) = kreg; *(LAS pg8::u32x4*)(Vt + bo + ldrow * RS + ldch * 8) = vreg;
                __syncthreads();
                if (kt + 1 < nkb) { kreg = *(const pg8::u32x4*)(kg + (size_t)(kt + 1) * 64 * 256); vreg = *(const pg8::u32x4*)(vg + (kt + 1) * 64); }
                if (kt < nkw) {
                    f32x16 st[2];
#pragma unroll
                    for (int kb = 0; kb < 2; ++kb) {
#pragma unroll
                        for (int e = 0; e < 16; ++e) st[kb][e] = 0.f;
#pragma unroll
                        for (int s = 0; s < 2; ++s) { const pg8::bf16x8 kf = *(const LAS pg8::bf16x8*)(Kt + bo + (kb * 32 + r) * RS + comp * 32 + 16 * s + 8 * hg);
                            st[kb] = __builtin_amdgcn_mfma_f32_32x32x16_bf16(kf, qf[s], st[kb], 0, 0, 0); } }
                    if (kt == nkw - 1) {
                        const int qi = q0 + r;
#pragma unroll
                        for (int kb = 0; kb < 2; ++kb)
#pragma unroll
                            for (int e = 0; e < 16; ++e) { const int ki = kt * 64 + kb * 32 + (e & 3) + 8 * (e >> 2) + 4 * hg; if (ki > qi) st[kb][e] = -1e30f; } }
                    float tm = st[0][0];
#pragma unroll
                    for (int e = 1; e < 16; ++e) tm = fmaxf(tm, st[0][e]);
#pragma unroll
                    for (int e = 0; e < 16; ++e) tm = fmaxf(tm, st[1][e]);
                    tm = fmaxf(tm, __shfl_xor(tm, 32));
                    const float mn = fmaxf(mrun, tm), alpha = exp2f(mrun - mn); mrun = mn;
                    float ps = 0.f;
#pragma unroll
                    for (int kb = 0; kb < 2; ++kb)
#pragma unroll
                        for (int e = 0; e < 16; ++e) { st[kb][e] = exp2f(st[kb][e] - mn); ps += st[kb][e]; }
                    lrun = lrun * alpha + ps;
#pragma unroll
                    for (int e = 0; e < 16; ++e) { ot[0][e] *= alpha; ot[1][e] *= alpha; }
#pragma unroll
                    for (int kb = 0; kb < 2; ++kb)
#pragma unroll
                        for (int s = 0; s < 2; ++s) {
                            pg8::u32x4 pw; pw.x = pk2(st[kb][8 * s], st[kb][8 * s + 1]); pw.y = pk2(st[kb][8 * s + 2], st[kb][8 * s + 3]); pw.z = pk2(st[kb][8 * s + 4], st[kb][8 * s + 5]); pw.w = pk2(st[kb][8 * s + 6], st[kb][8 * s + 7]);
                            const pg8::bf16x8 pf = __builtin_bit_cast(pg8::bf16x8, pw);
#pragma unroll
                            for (int dvb = 0; dvb < 2; ++dvb) { const LAS bf16_t* vp = Vt + bo + (dvb * 32 + r) * RS + kb * 32 + 16 * s + 4 * hg;
                                const pg8::u32x2 v0 = *(const LAS pg8::u32x2*)vp, v1 = *(const LAS pg8::u32x2*)(vp + 8);
                                pg8::u32x4 vw; vw.x = v0.x; vw.y = v0.y; vw.z = v1.x; vw.w = v1.y;
                                ot[dvb] = __builtin_amdgcn_mfma_f32_32x32x16_bf16(__builtin_bit_cast(pg8::bf16x8, vw), pf, ot[dvb], 0, 0, 0); } }
                }
            }
            const float ltot = lrun + __shfl_xor(lrun, 32); const float il = 1.0f / ltot;
            __syncthreads();
            if (comp == 1) {
#pragma unroll
                for (int dvb = 0; dvb < 2; ++dvb)
#pragma unroll
                    for (int e = 0; e < 16; ++e) Xl[(qs * 32 + dvb * 16 + e) * 64 + lane] = ot[dvb][e] * il; }
            __syncthreads();
            if (comp == 0) {
                float o[32]; float ss = 0.f;
#pragma unroll
                for (int dvb = 0; dvb < 2; ++dvb)
#pragma unroll
                    for (int e = 0; e < 16; ++e) { const float v = ot[dvb][e] * il - lam * Xl[(qs * 32 + dvb * 16 + e) * 64 + lane]; o[dvb * 16 + e] = v; ss += v * v; }
                ss += __shfl_xor(ss, 32);
                const float sc = rsqrtf(ss * (1.0f / 64.0f) + 1e-6f) * (1.0f - lam_init);
                bf16_t* od = br + (rowb + q0 + r) * D + 256 + h * 64;
#pragma unroll
                for (int dvb = 0; dvb < 2; ++dvb)
#pragma unroll
                    for (int g4 = 0; g4 < 4; ++g4) { const int dv0 = dvb * 32 + 8 * g4 + 4 * hg; const pg8::f32x4 sl = *(const pg8::f32x4*)(subln + dv0);
                        st_bf16x4(od + dv0, (pg8::f32x4){o[dvb * 16 + 4 * g4] * sc * sl[0], o[dvb * 16 + 4 * g4 + 1] * sc * sl[1], o[dvb * 16 + 4 * g4 + 2] * sc * sl[2], o[dvb * 16 + 4 * g4 + 3] * sc * sl[3]}); }
            }
            __syncthreads();
        }
    }
}
constexpr int RING_BYTES = 131072, LDSCTL_OFF = RING_BYTES, MISC_OFF = LDSCTL_OFF + 320, LDS_BYTES = 147456;
constexpr int PH_PRO = 0, PH_H0 = 1, PH_L0 = 2, PH_PER_LAYER = 12, PH_END = PH_L0 + 2 * PH_PER_LAYER;
constexpr int PL_PROJ = 0, PL_MIXA = 1, PL_MIXB = 2, PL_MIXC = 3, PL_BRANCH = 4, PL_OUT = 5, PL_ROWMIX = 6, PL_FFN1 = 7, PL_FFN2 = 8, PL_FFN3 = 9, PL_ROWFFN = 10;

#ifndef DUPMASK
#define DUPMASK 0
#endif
#define DUP(bit) for (int dup_ = 0; dup_ < (((DUPMASK) >> (bit)) & 1) + 1; ++dup_)
__global__ void __launch_bounds__(NTHR, 2) mk_fwd(Args a) {
    extern __shared__ __attribute__((aligned(16))) unsigned char lds_raw[];
    Frame F0;
    F0.lds = (LAS unsigned char*)lds_raw;
    F0.wave = __builtin_amdgcn_readfirstlane(threadIdx.x >> 6);
    F0.G = gridDim.x; F0.gw = blockIdx.x * NWAVES + F0.wave; F0.NGW = F0.G * NWAVES;
    volatile LAS unsigned* MISC = (volatile LAS unsigned*)(F0.lds + MISC_OFF);
    for (int u = threadIdx.x; u < (LDS_BYTES - LDSCTL_OFF) / 4; u += NTHR) ((LAS unsigned*)(F0.lds + LDSCTL_OFF))[u] = 0u;
    __syncthreads();
    unsigned* ctl = (unsigned*)(a.ws + WS_CTL);
    const int lo = a.ph_lo, hi = a.ph_hi;
    XcdBarrier bar; bar.bar = ctl + CW_BAR; bar.x = 0; bar.st = nullptr;
    if (hi - lo > 1) bar = xcd_barrier_post(ctl + CW_BAR, MISC + 8);
#define IN(k) (lo <= (k) && (k) < hi)
#define SEAM(k) do { if (IN(k) && IN((k) + 1)) xcd_barrier(bar); } while (0)
    if (IN(PH_PRO)) DUP(0) { ArgsP A = fresh_args(); Frame F = fresh(F0); p0_mod_items(F, (const float*)A->in[1], (const float*)A->in[3], (const float*)A->in[4], (float*)(A->ws + WS_MOD)); p0_convert(F, A); }
    SEAM(PH_PRO);
    if (IN(PH_H0)) DUP(9) { Frame F = fresh(F0); ph_h0(F, fresh_args()); }
    SEAM(PH_H0);
    for (int l = 0; l < NL; ++l) {
        const int base = PH_L0 + l * PH_PER_LAYER;
        if (IN(base + PL_PROJ)) DUP(1) { ArgsP A = fresh_args(); Frame F = fresh(F0); unsigned char* ws = A->ws;
            pg8::Gemm g{(const bf16_t*)(ws + WS_HB), (const bf16_t*)(ws + WS_WIN) + (size_t)l * PW * 1024, 1024, 1024, 1024, 0}; pg8::StaticOrder S; S.init(M, PW, F.G, (int)blockIdx.x);
            pg8::EpiBf16 E{(bf16_t*)(ws + WS_PROJ), PW, 29};
            pg8::gemm_phase<pg8::EpiBf16, pg8::StaticOrder, true>(F.lds, g, S, E, F.wave);
        }
        SEAM(base + PL_PROJ);
        if (IN(base + PL_MIXA)) { DUP(2) { Frame F = fresh(F0); ph_conv(F, fresh_args(), l); } DUP(6) { Frame F = fresh(F0); ph_rwkv_prep(F, fresh_args(), l); } DUP(7) { Frame F = fresh(F0); ph_gla_p1(F, fresh_args(), l); } DUP(8) { Frame F = fresh(F0); ph_attn_prep(F, fresh_args()); } }
        SEAM(base + PL_MIXA);
        if (IN(base + PL_MIXB)) { DUP(10) { Frame F = fresh(F0); ph_gla_prefix(F, fresh_args()); } DUP(3) { Frame F = fresh(F0); ph_rwkv_scan(F, fresh_args()); } DUP(4) { Frame F = fresh(F0); ph_attn(F, fresh_args(), l); } }
        SEAM(base + PL_MIXB);
        if (IN(base + PL_MIXC)) { DUP(5) { Frame F = fresh(F0); ph_rwkv_post(F, fresh_args(), l); } DUP(11) { Frame F = fresh(F0); ph_gla_p2(F, fresh_args(), l); } }
        SEAM(base + PL_MIXC);
        if (IN(base + PL_BRANCH)) DUP(1) { ArgsP A = fresh_args(); Frame F = fresh(F0); unsigned char* ws = A->ws;
            int Kb = 256; asm volatile("" : "+s"(Kb));
            pg8::Gemm g{(const bf16_t*)(ws + WS_HB), (const bf16_t*)(ws + WS_WB) + (size_t)l * 4096 * 256, 1024, 256, Kb, 0}; pg8::BranchOrder S{F.G, (int)blockIdx.x};
            pg8::EpiBranch E{(const bf16_t*)(ws + WS_PROJ), (float*)(ws + SCR_MP), (bf16_t*)(ws + SCR_MB)};
            pg8::gemm_phase<pg8::EpiBranch, pg8::BranchOrder, true>(F.lds, g, S, E, F.wave);
        }
        SEAM(base + PL_BRANCH);
        if (IN(base + PL_OUT)) DUP(1) { ArgsP A = fresh_args(); Frame F = fresh(F0); unsigned char* ws = A->ws;
            pg8::Gemm g{(const bf16_t*)(ws + SCR_MB), (const bf16_t*)(ws + WS_WO) + (size_t)l * 1024 * 1024, 1024, 1024, 1024, 0}; pg8::StaticOrder S; S.init(M, 1024, F.G, (int)blockIdx.x);
            pg8::EpiF32 E{(float*)(ws + SCR_Y), 1024, 4};
            pg8::gemm_phase<pg8::EpiF32, pg8::StaticOrder, false>(F.lds, g, S, E, F.wave);
        }
        SEAM(base + PL_OUT);
        if (IN(base + PL_ROWMIX)) { ArgsP A = fresh_args(); Frame F = fresh(F0); unsigned char* ws = A->ws; const float* modl = (const float*)(ws + WS_MOD) + (size_t)l * 8 * 6144;
            ph_row(F, A, l == 0 ? (const float*)A->in[0] : A->out, (const float*)(ws + SCR_Y), (const float*)A->in[6] + l * D, modl, 2048, (const float*)A->in[7] + l * D, modl, 3072, 4096, (bf16_t*)(ws + (l == 0 ? WS_HB : WS_H2L1)), l == 1); }
        SEAM(base + PL_ROWMIX);
        if (l == 0) {
            if (IN(base + PL_FFN1)) DUP(1) { ArgsP A = fresh_args(); Frame F = fresh(F0); unsigned char* ws = A->ws;
                pg8::Gemm g{(const bf16_t*)(ws + WS_HB), (const bf16_t*)(ws + WS_WF1), 1024, 1024, 1024, 0}; pg8::StaticOrder S; S.init(M, 2 * DFF, F.G, (int)blockIdx.x);
                pg8::EpiSwiglu E{(bf16_t*)(ws + WS_PROJ), DFF, 2 * DFF / 256};
                pg8::gemm_phase<pg8::EpiSwiglu, pg8::StaticOrder, true>(F.lds, g, S, E, F.wave);
            }
            SEAM(base + PL_FFN1);
            if (IN(base + PL_FFN2)) DUP(1) { ArgsP A = fresh_args(); Frame F = fresh(F0); unsigned char* ws = A->ws;
                pg8::Gemm g{(const bf16_t*)(ws + WS_PROJ), (const bf16_t*)(ws + WS_WF2), DFF, DFF, DFF, 0}; pg8::StaticOrder S; S.init(M, 1024, F.G, (int)blockIdx.x);
                pg8::EpiF32 E{(float*)(ws + SCR_Y), 1024, 4};
                pg8::gemm_phase<pg8::EpiF32, pg8::StaticOrder, false>(F.lds, g, S, E, F.wave);
            }
            SEAM(base + PL_FFN2);
        } else {
            if (IN(base + PL_FFN1)) DUP(0) { Frame F = fresh(F0); ph_moe_prep(F, fresh_args()); }
            SEAM(base + PL_FFN1);
            if (IN(base + PL_FFN2)) DUP(1) { ArgsP A = fresh_args(); Frame F = fresh(F0); unsigned char* ws = A->ws; const unsigned* cnt = (const unsigned*)(ws + WS_CTL) + CW_CNT;
                pg8::Gemm g{(const bf16_t*)(ws + WS_HG), (const bf16_t*)(ws + WS_WM1), 1024, 1024, 1024, 0}; pg8::MoeOrder S; S.init(cnt, F.G, (int)blockIdx.x, 28);
                pg8::EpiSwiglu E{(bf16_t*)(ws + WS_HID), DEX, 28};
                pg8::gemm_phase<pg8::EpiSwiglu, pg8::MoeOrder, true>(F.lds, g, S, E, F.wave);
            }
            SEAM(base + PL_FFN2);
            if (IN(base + PL_FFN3)) DUP(1) { ArgsP A = fresh_args(); Frame F = fresh(F0); unsigned char* ws = A->ws; const unsigned* cnt = (const unsigned*)(ws + WS_CTL) + CW_CNT;
                pg8::Gemm g{(const bf16_t*)(ws + WS_HID), (const bf16_t*)(ws + WS_WM2), DEX, DEX, DEX, 0}; pg8::MoeOrder S; S.init(cnt, F.G, (int)blockIdx.x, 4);
                pg8::EpiBf16 E{(bf16_t*)(ws + WS_HG), 1024, 4};
                pg8::gemm_phase<pg8::EpiBf16, pg8::MoeOrder, true>(F.lds, g, S, E, F.wave);
            }
            SEAM(base + PL_FFN3);
        }
        if (IN(base + PL_ROWFFN)) { ArgsP A = fresh_args(); Frame F = fresh(F0); unsigned char* ws = A->ws; const float* modl = (const float*)(ws + WS_MOD) + (size_t)l * 8 * 6144;
            const bool last = (l == NL - 1);
            ph_row(F, A, A->out, (const float*)(ws + SCR_Y), (const float*)A->in[8] + l * D, modl, 5120, last ? nullptr : (const float*)A->in[5] + (l + 1) * D, modl + 8 * 6144, 0, 1024, last ? nullptr : (bf16_t*)(ws + WS_HB), false, l == 0 ? nullptr : (const bf16_t*)(ws + WS_HG));
        }
        SEAM(base + PL_ROWFFN);
    }
#undef IN
#undef SEAM
}

extern "C" void kernel_launch(void* const* d_in, const int* in_sizes, int n_in, void* d_out, int out_size, void* d_ws, size_t ws_size, hipStream_t stream) {
    static int grid = 0;
    if (grid == 0) {
        if (n_in != 40 || ws_size < WS_END) { fprintf(stderr, "kernel_launch: need 40 inputs and >= %zu bytes of workspace (got %d, %zu)\n", (size_t)WS_END, n_in, ws_size); grid = -1; return; }
        int dev = 0, cus = 0, per_cu = 0;
        (void)hipGetDevice(&dev); (void)hipDeviceGetAttribute(&cus, hipDeviceAttributeMultiprocessorCount, dev);
        (void)hipFuncSetAttribute((const void*)mk_fwd, hipFuncAttributeMaxDynamicSharedMemorySize, LDS_BYTES);
        (void)hipOccupancyMaxActiveBlocksPerMultiprocessor(&per_cu, (const void*)mk_fwd, NTHR, LDS_BYTES);
        (void)hipGetLastError();
        grid = cus > 0 ? cus : 256;
        if (per_cu < 1) fprintf(stderr, "kernel_launch: occupancy query says %d blocks per CU\n", per_cu);
    }
    if (grid < 0) return;
    unsigned char* ws = (unsigned char*)d_ws;
    (void)hipMemsetAsync(ws + WS_CTL, 0, CTL_ZERO_BYTES, stream);
    Args a{};
    for (int i = 0; i < 40; ++i) a.in[i] = d_in[i];
    a.out = (float*)d_out; a.ws = ws;
    a.ph_lo = 0; a.ph_hi = PH_L0 + (NL - 1) * PH_PER_LAYER + PL_ROWFFN + 1;
    hipLaunchKernelGGL(mk_fwd, dim3(grid), dim3(NTHR), LDS_BYTES, stream, a);
}
```

```cpp
#include <hip/hip_runtime.h>
#include <hip/hip_bf16.h>
#include <cstdint>
#include <cstdio>

typedef __hip_bfloat16 bf16;
typedef unsigned short bf16_t;
#define GAS __attribute__((address_space(1)))
#define LAS __attribute__((address_space(3)))

constexpr int D = 1024, NB = 8, T = 2048, M = NB * T, NL = 2;
constexpr int NIN = 7184;
constexpr int PW = 7424;
constexpr int P_GQ = 0, P_GK = 128, P_GV = 256, P_GO = 512, P_DQ = 768, P_DK = 1024, P_DV = 1280, P_CA = 1536, P_CB = 1792, P_R = 2048, P_GATE = 3072, P_GZ = 7168;
constexpr int DFF = 2816, NE = 8, DEX = 3584;
constexpr int NWAVES = 8, NTHR = 512;
constexpr size_t MiB = 1u << 20;
constexpr size_t WS_CTL = 0;
constexpr size_t CTL_ZERO_BYTES = 64 * 1024;
constexpr size_t WS_MOD = 1 * MiB;
constexpr size_t WS_ROUTE = 1 * MiB + 512 * 1024;
constexpr size_t WS_LR = 3 * MiB;
constexpr size_t WS_WIN = 4 * MiB;
constexpr size_t WS_WB = 33 * MiB;
constexpr size_t WS_WO = 37 * MiB;
constexpr size_t WS_WF1 = 41 * MiB;
constexpr size_t WS_WF2 = 52 * MiB;
constexpr size_t WS_HB = 58 * MiB;
constexpr size_t WS_PROJ = 90 * MiB;
constexpr size_t WS_SCR = 322 * MiB;
constexpr size_t WS_H2L1 = 508 * MiB;
constexpr size_t WS_END = 540 * MiB;
constexpr size_t WS_HG = 4 * MiB;
constexpr size_t WS_WM1 = 72 * MiB;
constexpr size_t WS_WM2 = 184 * MiB;
constexpr size_t WS_HID = 240 * MiB;
static_assert(WS_HID + (size_t)34816 * 3584 * 2 <= WS_H2L1, "moe overlay");
constexpr size_t SCR_MP = WS_SCR;
constexpr size_t SCR_MB = WS_SCR + 64 * MiB;
constexpr size_t SCR_Y = WS_SCR + 96 * MiB;
constexpr size_t SCR_RW = WS_SCR;
constexpr size_t SCR_GK = WS_SCR + 112 * MiB;
constexpr size_t SCR_QR = WS_SCR + 120 * MiB;
constexpr size_t SCR_KR = WS_SCR + 136 * MiB;
constexpr size_t SCR_VEC6 = WS_SCR;
constexpr size_t SCR_SC = WS_SCR + 112 * MiB;
constexpr size_t SCR_YR = WS_SCR + 113 * MiB;
constexpr size_t SCR_GR = WS_SCR + 129 * MiB;
constexpr size_t SCR_VT = WS_SCR + 137 * MiB;
constexpr size_t SCR_GU = WS_SCR + 145 * MiB;
constexpr size_t SCR_GS = SCR_GU;
constexpr size_t SCR_QK = WS_SCR + 161 * MiB;
constexpr size_t SCR_EG = WS_SCR + 177 * MiB;
constexpr int VSTEP = 448;
constexpr int CW_TMO = 0;
constexpr int CW_BAR = 1024;
constexpr int CW_CNT = 8192;
constexpr size_t RT_LIST = 0;
constexpr size_t RT_TOKE = 512 * 1024;
constexpr size_t RT_TOKS = 640 * 1024;
constexpr size_t RT_TOKP = 768 * 1024;

__device__ __forceinline__ float sigm(float x) { return 1.0f / (1.0f + __expf(-x)); }
__device__ __forceinline__ float siluf(float x) { return x * sigm(x); }
__device__ __forceinline__ float softplusf(float x) { return fmaxf(x, 0.f) + log1pf(__expf(-fabsf(x))); }
__device__ __forceinline__ float wave_sum(float v) {
#pragma unroll
    for (int o = 32; o > 0; o >>= 1) v += __shfl_xor(v, o);
    return v;
}
__device__ __forceinline__ float wave_max(float v) {
#pragma unroll
    for (int o = 32; o > 0; o >>= 1) v = fmaxf(v, __shfl_xor(v, o));
    return v;
}
__device__ __forceinline__ float ldf(const float* p) { return *p; }
__device__ __forceinline__ float ldf(const bf16* p) { return __bfloat162float(*p); }
__device__ __forceinline__ float bf2f(bf16_t u) { return __builtin_bit_cast(float, (unsigned)u << 16); }
__device__ __forceinline__ unsigned f2bf(float f) { unsigned u = __builtin_bit_cast(unsigned, f); return (u + 0x7fffu + ((u >> 16) & 1u)) >> 16; }
__device__ __forceinline__ unsigned pk2(float lo, float hi) { return f2bf(lo) | (f2bf(hi) << 16); }
namespace pg8 {
#define PG8_LAS __attribute__((address_space(3)))
typedef short bf16x8 __attribute__((ext_vector_type(8)));
typedef float f32x4 __attribute__((ext_vector_type(4)));
typedef float f32x2 __attribute__((ext_vector_type(2)));
typedef unsigned u32x4 __attribute__((ext_vector_type(4)));
typedef unsigned u32x2 __attribute__((ext_vector_type(2)));
constexpr int BM = 256, BK = 64, HALF = 128, HTB = HALF * BK * 2  , STAGE_BYTES = 8 * HTB, NXCD = 8, WGM = 8;

__host__ __device__ __forceinline__ int lds_byte(int r, int c) { const int st = (r >> 4) * 2 + (c >> 5), rr = r & 15, cc = c & 31, ob = rr * 64 + cc * 2; return st * 1024 + (ob ^ (((ob >> 9) & 1) << 5)); }
__host__ __device__ __forceinline__ void stage_rc(int b, int& R, int& C) { const int st = b / 1024, sb = b % 1024, swz = sb ^ (((sb >> 9) & 1) << 5); R = (st >> 1) * 16 + swz / 64; C = (st & 1) * 32 + (swz % 64) / 2; }
__host__ __device__ __forceinline__ int perm32(int rho) { const int n = rho >> 4, i = rho & 15; return 8 * (i >> 2) + 4 * n + (i & 3); }

struct Unit { int pm, pn, aoff, tag; };
struct Gemm { const bf16_t* A; const bf16_t* Bt; int lda, ldb, K, pad; };

struct StaticOrder {
    int nM, nN, nwg, G, c;
    __host__ __device__ void init(int M_, int N_, int G_, int c_) { nM = M_ / BM; nN = N_ / BM; nwg = nM * nN; G = G_; c = c_; }
    __host__ __device__ bool next(int i, Unit& u) const {
        const long L = (long)i * G + c; if (L >= nwg) return false;
        int wgid = (int)L; { const int q = nwg / NXCD, r = nwg % NXCD, xcd = wgid % NXCD, off = wgid / NXCD; wgid = (xcd < r ? xcd * (q + 1) : r * (q + 1) + (xcd - r) * q) + off; }
        const int nig = WGM * nN, gid = wgid / nig, fm = gid * WGM, gsz = (nM - fm) < WGM ? (nM - fm) : WGM;
        u.pm = fm + ((wgid % nig) % gsz); u.pn = (wgid % nig) / gsz; u.aoff = 0; u.tag = 0; return true;
    }
};

__device__ __forceinline__ unsigned cvt_pk_bf16(float lo, float hi) { unsigned r; asm volatile("v_cvt_pk_bf16_f32 %0, %1, %2" : "=v"(r) : "v"(lo), "v"(hi)); return r; }


template <class Epi, class Sched, bool ALIGN_EPI>
__device__ __forceinline__ void gemm_phase(PG8_LAS unsigned char* lds, const Gemm g, const Sched& S, const Epi& E, int wave_s) {
    unsigned z_ = 0u; asm volatile("" : "+v"(z_));
    int tid_ = wave_s * 64 + (int)__builtin_amdgcn_mbcnt_hi(~0u, __builtin_amdgcn_mbcnt_lo(~0u, z_)); asm volatile("" : "+v"(tid_));
    const int tid = tid_, wid = __builtin_amdgcn_readfirstlane(tid >> 6), lane = tid & 63, wr = wid >> 2, wc = wid & 3, fr = lane & 15, fq = lane >> 4;
    const int K = g.K, nt = K / BK;
    unsigned voffA[2], voffB[2];
#pragma unroll
    for (int i = 0; i < 2; ++i) { int R, C; stage_rc(tid * 16 + i * 8192, R, C); const int Rb = Epi::PERM ? ((R & ~31) + perm32(R & 31)) : R;
        voffA[i] = (unsigned)(R * g.lda + C) * 2u; voffB[i] = (unsigned)(Rb * g.ldb + C) * 2u; }
    const size_t kstep = (size_t)(BK * 2);
    const size_t hstepA = (size_t)HALF * g.lda * 2, hstepB = (size_t)HALF * g.ldb * 2;
    const size_t tstepA = 2 * hstepA, tstepB = 2 * hstepB;
    const unsigned ldsw = (unsigned)wid * 1024u;
    const int aoff = lds_byte(wr * 64 + fr, fq * 8), boff = lds_byte(wc * 32 + fr, fq * 8);
#define PG8_SA(b, h) (((b) * 2 + (h)) * HTB)
#define PG8_SB(b, h) ((4 + (b) * 2 + (h)) * HTB)
#define PG8_STAGE(bufoff, gbase, voff) do { _Pragma("unroll") for (int _i = 0; _i < 2; ++_i) \
        __builtin_amdgcn_global_load_lds((const unsigned*)((const char*)(gbase) + (voff)[_i]), (PG8_LAS unsigned*)(lds + (bufoff) + ldsw + _i * 8192), 16, 0, 0); } while (0)
#define PG8_LDA(dst, b, h) do { _Pragma("unroll") for (int m = 0; m < 4; ++m) _Pragma("unroll") for (int k = 0; k < 2; ++k) dst[m][k] = *(const PG8_LAS bf16x8*)(lds + PG8_SA(b, h) + aoff + m * 2048 + k * 1024); } while (0)
#define PG8_LDB(dst, b, h) do { _Pragma("unroll") for (int n = 0; n < 2; ++n) _Pragma("unroll") for (int k = 0; k < 2; ++k) dst[n][k] = *(const PG8_LAS bf16x8*)(lds + PG8_SB(b, h) + boff + n * 2048 + k * 1024); } while (0)
#define PG8_MMA(ai, bj, At, Bt) do { __builtin_amdgcn_s_setprio(1); _Pragma("unroll") for (int m = 0; m < 4; ++m) _Pragma("unroll") for (int n = 0; n < 2; ++n) _Pragma("unroll") for (int k = 0; k < 2; ++k) \
        acc[ai][bj][m][n] = __builtin_amdgcn_mfma_f32_16x16x32_bf16(Bt[n][k], At[m][k], acc[ai][bj][m][n], 0, 0, 0); __builtin_amdgcn_s_setprio(0); } while (0)
#define PG8_WAIT_V(n) asm volatile("s_waitcnt vmcnt(" #n ")" ::: "memory")
#define PG8_WAIT_L(n) asm volatile("s_waitcnt lgkmcnt(" #n ")" ::: "memory")
#define PG8_BAR __builtin_amdgcn_s_barrier()
#define PG8_SCHED __builtin_amdgcn_sched_barrier(0)
    Unit cur, nxt; int ui = 0;
    if (!S.next(0, cur)) return;
    f32x4 acc[2][2][4][2];
#pragma unroll
    for (int a = 0; a < 2; ++a)
#pragma unroll
        for (int b = 0; b < 2; ++b)
#pragma unroll
            for (int m = 0; m < 4; ++m)
#pragma unroll
                for (int n = 0; n < 2; ++n) acc[a][b][m][n] = (f32x4){0.f, 0.f, 0.f, 0.f};
    bf16x8 At[4][2], B0[2][2], B1[2][2];
    const char* cA = (const char*)g.A + (size_t)cur.pm * tstepA + (size_t)cur.aoff * 2; const char* cB = (const char*)g.Bt + (size_t)cur.pn * tstepB;
    PG8_STAGE(PG8_SB(0, 0), cB, voffB); PG8_STAGE(PG8_SB(0, 1), cB + hstepB, voffB); PG8_STAGE(PG8_SA(0, 0), cA, voffA); PG8_STAGE(PG8_SA(0, 1), cA + hstepA, voffA);
    if (wr == 1) PG8_BAR;
    PG8_WAIT_V(2); PG8_BAR;
    PG8_STAGE(PG8_SB(1, 0), cB + kstep, voffB); PG8_STAGE(PG8_SA(1, 0), cA + kstep, voffA); PG8_STAGE(PG8_SB(1, 1), cB + hstepB + kstep, voffB);
    PG8_WAIT_V(6); PG8_BAR;
    for (;;) {
        const bool has_next = S.next(ui + 1, nxt);
        const char* nA = has_next ? (const char*)g.A + (size_t)nxt.pm * tstepA + (size_t)nxt.aoff * 2 : cA; const char* nB = has_next ? (const char*)g.Bt + (size_t)nxt.pn * tstepB : cB;
        for (int t = 0; t < nt; t += 2) {
            if constexpr (Epi::MIDK) { if (t != 0 && (t & 3) == 0) E.mid(acc, cur, t >> 2, wr, wc); }
            const bool last = (t == nt - 2);
            const char* a1 = cA + (size_t)(t + 1) * kstep;
            const char* a2 = last ? nA : cA + (size_t)(t + 2) * kstep; const char* b2 = last ? nB : cB + (size_t)(t + 2) * kstep;
            const char* a3 = a2 + kstep; const char* b3 = b2 + kstep;
            PG8_LDB(B0, 0, 0); PG8_LDB(B1, 0, 1); PG8_SCHED; PG8_LDA(At, 0, 0); PG8_STAGE(PG8_SA(1, 1), a1 + hstepA, voffA);
            PG8_WAIT_V(8); PG8_WAIT_L(0); PG8_BAR; PG8_MMA(0, 0, At, B0); PG8_MMA(0, 1, At, B1); PG8_BAR; PG8_SCHED;
            PG8_LDA(At, 0, 1); PG8_STAGE(PG8_SB(0, 0), b2, voffB); PG8_STAGE(PG8_SB(0, 1), b2 + hstepB, voffB); PG8_STAGE(PG8_SA(0, 0), a2, voffA);
            PG8_WAIT_V(8); PG8_WAIT_L(0); PG8_BAR; PG8_MMA(1, 0, At, B0); PG8_MMA(1, 1, At, B1); PG8_BAR; PG8_SCHED;
            PG8_LDB(B0, 1, 0); PG8_LDB(B1, 1, 1); PG8_SCHED; PG8_LDA(At, 1, 0); PG8_STAGE(PG8_SA(0, 1), a2 + hstepA, voffA);
            PG8_WAIT_V(8); PG8_WAIT_L(0); PG8_BAR; PG8_MMA(0, 0, At, B0); PG8_MMA(0, 1, At, B1); PG8_BAR; PG8_SCHED;
            PG8_LDA(At, 1, 1); PG8_STAGE(PG8_SB(1, 0), b3, voffB); PG8_STAGE(PG8_SB(1, 1), b3 + hstepB, voffB); PG8_STAGE(PG8_SA(1, 0), a3, voffA);
            PG8_WAIT_V(8); PG8_WAIT_L(0); PG8_BAR; PG8_MMA(1, 0, At, B0); PG8_MMA(1, 1, At, B1); PG8_BAR; PG8_SCHED;
        }
        if constexpr (ALIGN_EPI) { if (wr == 0) PG8_BAR; }
        { unsigned z2_ = 0u; asm volatile("" : "+v"(z2_)); const int l2_ = (int)__builtin_amdgcn_mbcnt_hi(~0u, __builtin_amdgcn_mbcnt_lo(~0u, z2_));
          E(acc, cur, wr, wc, l2_ & 15, l2_ >> 4); }
        if (!has_next) break;
#pragma unroll
        for (int a = 0; a < 2; ++a)
#pragma unroll
            for (int b = 0; b < 2; ++b)
#pragma unroll
                for (int m = 0; m < 4; ++m)
#pragma unroll
                    for (int n = 0; n < 2; ++n) acc[a][b][m][n] = (f32x4){0.f, 0.f, 0.f, 0.f};
        cur = nxt; cA = nA; cB = nB; ++ui;
        if constexpr (ALIGN_EPI) { if (wr == 1) PG8_BAR; }
    }
    PG8_WAIT_V(0);
    if constexpr (!ALIGN_EPI) { if (wr == 0) PG8_BAR; }
    PG8_BAR;
#undef PG8_SA
#undef PG8_SB
#undef PG8_STAGE
#undef PG8_LDA
#undef PG8_LDB
#undef PG8_MMA
#undef PG8_WAIT_V
#undef PG8_WAIT_L
#undef PG8_BAR
#undef PG8_SCHED
}

struct EpiBf16 {
    static constexpr bool PERM = true, MIDK = false;
    bf16_t* O; int ldc; int ntn;
    __device__ __forceinline__ void operator()(const f32x4 (&acc)[2][2][4][2], const Unit& u, int wr, int wc, int fr, int fq) const {
        const int row0 = u.pm * BM + wr * 64 + fr, col0 = (u.pn % ntn) * BM + wc * 32 + 8 * fq;
#pragma unroll
        for (int ai = 0; ai < 2; ++ai)
#pragma unroll
            for (int m = 0; m < 4; ++m) { bf16_t* rowp = O + (size_t)(row0 + ai * HALF + m * 16) * ldc + col0;
#pragma unroll
                for (int bj = 0; bj < 2; ++bj) { const f32x4 v0 = acc[ai][bj][m][0], v1 = acc[ai][bj][m][1];
                    u32x4 w; w.x = cvt_pk_bf16(v0[0], v0[1]); w.y = cvt_pk_bf16(v0[2], v0[3]); w.z = cvt_pk_bf16(v1[0], v1[1]); w.w = cvt_pk_bf16(v1[2], v1[3]);
                    *(u32x4*)(rowp + bj * HALF) = w; } }
    }
};
struct EpiF32 {
    static constexpr bool PERM = false, MIDK = false;
    float* C; int ldc; int ntn;
    __device__ __forceinline__ void operator()(const f32x4 (&acc)[2][2][4][2], const Unit& u, int wr, int wc, int fr, int fq) const {
        const int row0 = u.pm * BM + wr * 64 + fr, col0 = (u.pn % ntn) * BM + wc * 32 + 4 * fq;
#pragma unroll
        for (int ai = 0; ai < 2; ++ai)
#pragma unroll
            for (int m = 0; m < 4; ++m) { float* rowp = C + (size_t)(row0 + ai * HALF + m * 16) * ldc + col0;
#pragma unroll
                for (int bj = 0; bj < 2; ++bj)
#pragma unroll
                    for (int n = 0; n < 2; ++n) *(f32x4*)(rowp + bj * HALF + n * 16) = acc[ai][bj][m][n]; }
    }
};
struct EpiSwiglu {
    static constexpr bool PERM = true, MIDK = false;
    bf16_t* O; int ldc; int ntn;
    __device__ __forceinline__ void operator()(const f32x4 (&acc)[2][2][4][2], const Unit& u, int wr, int wc, int fr, int fq) const {
        const int row0 = u.pm * BM + wr * 64 + fr, col0 = (u.pn % ntn) * 128 + wc * 16 + 4 * fq;
#pragma unroll
        for (int ai = 0; ai < 2; ++ai)
#pragma unroll
            for (int m = 0; m < 4; ++m) { bf16_t* rowp = O + (size_t)(row0 + ai * HALF + m * 16) * ldc + col0;
#pragma unroll
                for (int bj = 0; bj < 2; ++bj) { const f32x4 gt = acc[ai][bj][m][0], up = acc[ai][bj][m][1];
                    float h[4];
#pragma unroll
                    for (int e = 0; e < 4; ++e) h[e] = gt[e] * __builtin_amdgcn_rcpf(1.0f + __expf(-gt[e])) * up[e];
                    u32x2 w; w.x = cvt_pk_bf16(h[0], h[1]); w.y = cvt_pk_bf16(h[2], h[3]);
                    *(u32x2*)(rowp + bj * 64) = w; } }
    }
};
struct EpiBranch {
    static constexpr bool PERM = true, MIDK = false;
    const bf16_t* proj; float* MP; bf16_t* MB;
    __device__ __forceinline__ void operator()(const f32x4 (&acc)[2][2][4][2], const Unit& u, int wr, int wc, int fr, int fq) const {
        const int g = u.tag; const int row0 = u.pm * BM + wr * 64 + fr, col0 = (u.pn & 3) * BM + wc * 32 + 8 * fq;
#pragma unroll
        for (int ai = 0; ai < 2; ++ai)
#pragma unroll
            for (int m = 0; m < 4; ++m) { const size_t row = (size_t)(row0 + ai * HALF + m * 16);
#pragma unroll
                for (int bj = 0; bj < 2; ++bj) { const int col = col0 + bj * HALF;
                    const u32x4 gw = *(const u32x4*)(proj + row * PW + P_GATE + g * 1024 + col);
                    float gv[8];
#pragma unroll
                    for (int e = 0; e < 4; ++e) { const unsigned w = gw[e]; gv[2 * e] = __builtin_bit_cast(float, w << 16); gv[2 * e + 1] = __builtin_bit_cast(float, w & 0xffff0000u); }
                    f32x4 v0 = acc[ai][bj][m][0], v1 = acc[ai][bj][m][1];
#pragma unroll
                    for (int e = 0; e < 4; ++e) { v0[e] *= __builtin_amdgcn_rcpf(1.0f + __expf(-gv[e])); v1[e] *= __builtin_amdgcn_rcpf(1.0f + __expf(-gv[4 + e])); }
                    float* mp = MP + row * D + col;
                    if (g > 0) { v0 += *(const f32x4*)mp; v1 += *(const f32x4*)(mp + 4); }
                    if (g < 3) { *(f32x4*)mp = v0; *(f32x4*)(mp + 4) = v1; }
                    else { u32x4 w; w.x = cvt_pk_bf16(v0[0], v0[1]); w.y = cvt_pk_bf16(v0[2], v0[3]); w.z = cvt_pk_bf16(v1[0], v1[1]); w.w = cvt_pk_bf16(v1[2], v1[3]);
                        *(u32x4*)(MB + row * D + col) = w; } } }
    }
};
struct EpiBranchK {
    static constexpr bool PERM = true, MIDK = true;
    const bf16_t* proj; bf16_t* MB;
    __device__ __forceinline__ static float em(float x) { return fminf(__expf(-x), 1e20f); }
    __device__ __forceinline__ void mid(f32x4 (&acc)[2][2][4][2], const Unit& u, int gnext, int wr, int wc) const {
        unsigned z_ = 0u; asm volatile("" : "+v"(z_)); const int l_ = (int)__builtin_amdgcn_mbcnt_hi(~0u, __builtin_amdgcn_mbcnt_lo(~0u, z_)); const int fr = l_ & 15, fq = l_ >> 4;
        const int row0 = u.pm * BM + wr * 64 + fr, col0 = u.pn * BM + wc * 32 + 8 * fq;
#pragma unroll
        for (int ai = 0; ai < 2; ++ai)
#pragma unroll
            for (int m = 0; m < 4; ++m) { const bf16_t* gp = proj + (size_t)(row0 + ai * HALF + m * 16) * PW + P_GATE + (gnext - 1) * 1024 + col0;
#pragma unroll
                for (int bj = 0; bj < 2; ++bj) { const u32x4 g0 = *(const u32x4*)(gp + bj * HALF), g1 = *(const u32x4*)(gp + 1024 + bj * HALF);
#pragma unroll
                    for (int e = 0; e < 4; ++e) { const unsigned a = g0[e], b = g1[e];
                        const float ra = (1.0f + em(__builtin_bit_cast(float, b << 16))) * __builtin_amdgcn_rcpf(1.0f + em(__builtin_bit_cast(float, a << 16)));
                        const float rb = (1.0f + em(__builtin_bit_cast(float, b & 0xffff0000u))) * __builtin_amdgcn_rcpf(1.0f + em(__builtin_bit_cast(float, a & 0xffff0000u)));
                        if (e < 2) { acc[ai][bj][m][0][2 * e] *= ra; acc[ai][bj][m][0][2 * e + 1] *= rb; } else { acc[ai][bj][m][1][2 * (e - 2)] *= ra; acc[ai][bj][m][1][2 * (e - 2) + 1] *= rb; } } } }
    }
    __device__ __forceinline__ void operator()(const f32x4 (&acc)[2][2][4][2], const Unit& u, int wr, int wc, int fr, int fq) const {
        const int row0 = u.pm * BM + wr * 64 + fr, col0 = u.pn * BM + wc * 32 + 8 * fq;
#pragma unroll
        for (int ai = 0; ai < 2; ++ai)
#pragma unroll
            for (int m = 0; m < 4; ++m) { const size_t row = (size_t)(row0 + ai * HALF + m * 16);
#pragma unroll
                for (int bj = 0; bj < 2; ++bj) { const u32x4 gw = *(const u32x4*)(proj + row * PW + P_GATE + 3 * 1024 + col0 + bj * HALF);
                    float sg[8];
#pragma unroll
                    for (int e = 0; e < 4; ++e) { sg[2 * e] = __builtin_amdgcn_rcpf(1.0f + em(__builtin_bit_cast(float, gw[e] << 16))); sg[2 * e + 1] = __builtin_amdgcn_rcpf(1.0f + em(__builtin_bit_cast(float, gw[e] & 0xffff0000u))); }
                    const f32x4 v0 = acc[ai][bj][m][0], v1 = acc[ai][bj][m][1];
                    u32x4 w; w.x = cvt_pk_bf16(v0[0] * sg[0], v0[1] * sg[1]); w.y = cvt_pk_bf16(v0[2] * sg[2], v0[3] * sg[3]); w.z = cvt_pk_bf16(v1[0] * sg[4], v1[1] * sg[5]); w.w = cvt_pk_bf16(v1[2] * sg[6], v1[3] * sg[7]);
                    *(u32x4*)(MB + row * D + col0 + bj * HALF) = w; } }
    }
};
struct BranchOrder {
    int G, c;
    __device__ bool next(int i, Unit& u) const {
        const int tile = (i >> 2) * G + c; if (tile >= 256) return false;
        const int g = i & 3; u.pm = tile >> 2; u.pn = g * 4 + (tile & 3); u.aoff = g * 256; u.tag = g; return true;
    }
};
struct MoeOrder {
    int G, c, ntiles, NT; int toff[9];
    __device__ void init(const unsigned* cnt, int G_, int c_, int NT_) { G = G_; c = c_; NT = NT_; int o = 0;
#pragma unroll
        for (int e = 0; e < 8; ++e) { toff[e] = o; o += ((int)cnt[e] + 255) >> 8; } toff[8] = o; ntiles = o; }
    __device__ bool next(int i, Unit& u) const {
        const int L = i * G + c; if (L >= ntiles * NT) return false;
        const int tau = L % ntiles, pn = L / ntiles; int e = 0;
#pragma unroll
        for (int q = 1; q < 8; ++q) e += (tau >= toff[q]) ? 1 : 0;
        u.pm = tau; u.pn = e * NT + pn; u.aoff = 0; u.tag = e; return true;
    }
};
}
typedef GAS unsigned gu32;
#define RLX_AGENT __ATOMIC_RELAXED, __HIP_MEMORY_SCOPE_AGENT
#define XB_TMO      128
#define XB_XCNT(j)  (256  + 64 * (j))
#define XB_XSUB(j)  (1280 + 64 * (j))
#define XB_XGEN(j)  (2304 + 64 * (j))
#define XB_TOP      3328
#define XB_TOPGEN   3392
#define XCD_BAR_WORDS 3456
#define XB_SPIN_CAP (1u << 18)

__device__ __forceinline__ unsigned xb_ld(unsigned* p)              { return __hip_atomic_load(p, __ATOMIC_RELAXED, __HIP_MEMORY_SCOPE_AGENT); }
__device__ __forceinline__ unsigned xb_add(unsigned* p, unsigned v) { return __hip_atomic_fetch_add(p, v, __ATOMIC_RELAXED, __HIP_MEMORY_SCOPE_AGENT); }
__device__ __forceinline__ unsigned xb_xcc_id() { return (unsigned)__builtin_amdgcn_s_getreg((3 << 11) | 20) & 0xFu; }
#define XB_SPIN(cond, bar) do { unsigned _sp = 0; while (cond) { __builtin_amdgcn_s_sleep(1); \
    if ((++_sp & 255u) == 0u) { if (xb_ld(&(bar)[XB_TMO])) break; if (_sp > XB_SPIN_CAP) { atomicAdd(&(bar)[XB_TMO], 1u); break; } } } } while (0)

struct XcdBarrier {
    unsigned* bar; unsigned x;
    volatile LAS unsigned* st;
};

__device__ __forceinline__ XcdBarrier xcd_barrier_post(unsigned* bar, volatile LAS unsigned* st) {
    XcdBarrier b; b.bar = bar; b.x = xb_xcc_id(); b.st = st;
    if (threadIdx.x == 0) (void)xb_add(&bar[XB_XCNT(b.x)], 1u);
    return b;
}
__device__ __forceinline__ void xcd_barrier_complete(unsigned* bar, unsigned x, unsigned& nloc, unsigned& nx) {
    const unsigned G = gridDim.x * gridDim.y * gridDim.z;
    unsigned sum, cnt, mine, sp = 0u;
    for (;;) {
        sum = 0u; cnt = 0u; mine = 0u;
#pragma unroll
        for (unsigned j = 0; j < 16; ++j) { const unsigned c = xb_ld(&bar[XB_XCNT(j)]); sum += c; cnt += (c > 0u) ? 1u : 0u; mine = (j == x) ? c : mine; }
        if (sum == G) break;
        __builtin_amdgcn_s_sleep(1);
        if ((++sp & 255u) == 0u) { if (xb_ld(&bar[XB_TMO])) break; if (sp > XB_SPIN_CAP) { atomicAdd(&bar[XB_TMO], 1u); break; } }
    }
    nloc = mine > 0u ? mine : 1u; nx = cnt > 0u ? cnt : 1u;
}

__device__ __forceinline__ void xcd_barrier(const XcdBarrier& b) {
    asm volatile("s_waitcnt vmcnt(0)" ::: "memory");
    __syncthreads();
    if (threadIdx.x == 0) {
        unsigned* bar = b.bar;
        __builtin_amdgcn_s_waitcnt(0);
        unsigned nloc = b.st[0], nx = b.st[1];
        if (nloc == 0u) { xcd_barrier_complete(bar, b.x, nloc, nx); b.st[0] = nloc; b.st[1] = nx; }
        const unsigned old = xb_add(&bar[XB_XSUB(b.x)], 1u);
        const unsigned gen = old / nloc;
        if (old + 1u == (gen + 1u) * nloc) {
            __builtin_amdgcn_fence(__ATOMIC_RELEASE, "agent");
            asm volatile("s_waitcnt vmcnt(0)" ::: "memory");
            const unsigned og = xb_add(&bar[XB_TOP], 1u);
            const unsigned tg = og / nx;
            if (og + 1u == (tg + 1u) * nx) xb_add(&bar[XB_TOPGEN], 1u);
            else XB_SPIN(xb_ld(&bar[XB_TOPGEN]) == tg, bar);
            __builtin_amdgcn_fence(__ATOMIC_ACQUIRE, "agent");
            xb_add(&bar[XB_XGEN(b.x)], 1u);
            asm volatile("s_waitcnt vmcnt(0)" ::: "memory");
        } else {
            XB_SPIN(xb_ld(&bar[XB_XGEN(b.x)]) == gen, bar);
            __builtin_amdgcn_fence(__ATOMIC_ACQUIRE, "agent");
            asm volatile("s_waitcnt vmcnt(0)" ::: "memory");
        }
    }
    __syncthreads();
}
struct Args { const void* in[40]; float* out; unsigned char* ws; int ph_lo, ph_hi; };
typedef const __attribute__((address_space(4))) Args* ArgsP;
__device__ __forceinline__ ArgsP fresh_args() { ArgsP p = (ArgsP)__builtin_amdgcn_kernarg_segment_ptr(); asm volatile("" : "+s"(p)); return p; }

struct Frame {
    LAS unsigned char* lds;
    int wave, G, gw, NGW;
    __device__ __forceinline__ int lane() const { unsigned z = 0u; asm volatile("" : "+v"(z)); return (int)__builtin_amdgcn_mbcnt_hi(~0u, __builtin_amdgcn_mbcnt_lo(~0u, z)); }
};

__device__ __forceinline__ Frame fresh(const Frame& F) { Frame R = F; asm volatile("" : "+s"(R.wave), "+s"(R.G), "+s"(R.gw), "+s"(R.NGW)); return R; }
#define LDS_WAIT() asm volatile("s_waitcnt lgkmcnt(0)" ::: "memory")

__device__ __forceinline__ void p0_mod_items(Frame& F, const float* c, const float* ada_w, const float* ada_b, float* mod) {
    LAS float* part = (LAS float*)F.lds;
    int tid_ = F.wave * 64 + F.lane(); asm volatile("" : "+v"(tid_)); const int lane_ = tid_ & 63;
    for (int it = blockIdx.x; it < 192; it += F.G) {
        const int l = it / 96, j0 = (it % 96) * 64;
        float acc[8];
#pragma unroll
        for (int b = 0; b < 8; ++b) acc[b] = 0.f;
        const float* w = ada_w + (size_t)l * 1024 * 6144 + j0 + lane_;
        const int k0 = F.wave * 128;
        for (int k = k0; k < k0 + 128; ++k) { const float wv = w[(size_t)k * 6144];
#pragma unroll
            for (int b = 0; b < 8; ++b) { const float cv = c[b * 1024 + k]; acc[b] += siluf(cv) * wv; } }
#pragma unroll
        for (int b = 0; b < 8; ++b) part[(F.wave * 8 + b) * 64 + lane_] = acc[b];
        __syncthreads();
        { const int b = tid_ >> 6, col = tid_ & 63; float s = 0.f;
#pragma unroll
          for (int w8 = 0; w8 < 8; ++w8) s += part[(w8 * 8 + b) * 64 + col];
          mod[(size_t)(l * 8 + b) * 6144 + j0 + col] = s + ada_b[l * 6144 + j0 + col]; }
        __syncthreads();
    }
}
struct CvtDesc { const float* colp; size_t Ns; bf16_t* WT; int Kd, n0, k0; };
__device__ __forceinline__ void cvt_load(const CvtDesc& d, pg8::f32x4 (&v)[8], int lane) {
    const int kr = lane >> 3;
#pragma unroll
    for (int i = 0; i < 8; ++i) v[i] = d.colp ? *(const pg8::f32x4*)(d.colp + (size_t)(d.k0 + 8 * i + kr) * d.Ns) : (pg8::f32x4){0.f, 0.f, 0.f, 0.f};
}
__device__ __forceinline__ void cvt_store(const CvtDesc& d, const pg8::f32x4 (&v)[8], LAS float* scr, int lane) {
    const int q4 = 4 * (lane & 7), kr = lane >> 3;
#pragma unroll
    for (int i = 0; i < 8; ++i)
#pragma unroll
        for (int e = 0; e < 4; ++e) scr[(8 * i + kr) * 33 + q4 + e] = v[i][e];
    LDS_WAIT(); asm volatile("" ::: "memory");
    const int cidx = lane & 7;
#pragma unroll
    for (int j = 0; j < 4; ++j) { const int n = (lane >> 3) + 8 * j; const LAS float* s = scr + (8 * cidx) * 33 + n;
        pg8::u32x4 o; o.x = pk2(s[0 * 33], s[1 * 33]); o.y = pk2(s[2 * 33], s[3 * 33]); o.z = pk2(s[4 * 33], s[5 * 33]); o.w = pk2(s[6 * 33], s[7 * 33]);
        *(pg8::u32x4*)(d.WT + (size_t)(d.n0 + n) * d.Kd + d.k0 + 8 * cidx) = o; }
    LDS_WAIT(); asm volatile("" ::: "memory");
}
__device__ __forceinline__ int win_src_col(int v) { return v < 768 ? v : (v < 7168 ? v + 16 : (v < 7184 ? v - 6400 : -1)); }

__device__ __forceinline__ CvtDesc p0_desc(ArgsP a, int it, int n) {
    const float* w_in = (const float*)a->in[9]; const float* w_branch = (const float*)a->in[30]; const float* w_out = (const float*)a->in[31];
    const float* wg = (const float*)a->in[32]; const float* wu = (const float*)a->in[33]; const float* wd = (const float*)a->in[34];
    bf16_t* WIN = (bf16_t*)(a->ws + WS_WIN); bf16_t* WB = (bf16_t*)(a->ws + WS_WB); bf16_t* WO = (bf16_t*)(a->ws + WS_WO); bf16_t* WF1 = (bf16_t*)(a->ws + WS_WF1); bf16_t* WF2 = (bf16_t*)(a->ws + WS_WF2);
    bf16_t* LR = (bf16_t*)(a->ws + WS_LR);
    constexpr int I_IN = 2 * 232 * 16, I_B = 2 * 4 * 32 * 4, I_O = 2 * 32 * 16, I_F1 = 176 * 16, I_F2 = 32 * 44;
    int r = it;
    if (r < I_IN) { const int l = r / (232 * 16), q = r % (232 * 16), nb = q / 16, kb = q % 16; const int sc = win_src_col(nb * 32 + n);
        return CvtDesc{sc >= 0 ? w_in + (size_t)l * 1024 * NIN + sc : nullptr, (size_t)NIN, WIN + (size_t)l * PW * 1024, 1024, nb * 32, kb * 64}; } r -= I_IN;
    if (r < I_B) { const int lg = r / 128, q = r % 128, nb = q / 4, kb = q % 4;
        const int g = lg & 3, l = lg >> 2;
        return CvtDesc{w_branch + (size_t)lg * 256 * 1024 + nb * 32 + n - (size_t)g * 256 * 1024, 1024, WB + (size_t)l * 1024 * 1024, 1024, nb * 32, g * 256 + kb * 64}; } r -= I_B;
    if (r < I_O) { const int l = r / 512, q = r % 512, nb = q / 16, kb = q % 16;
        return CvtDesc{w_out + (size_t)l * 1024 * 1024 + nb * 32 + n, 1024, WO + (size_t)l * 1024 * 1024, 1024, nb * 32, kb * 64}; } r -= I_O;
    if (r < I_F1) { const int nb = r / 16, kb = r % 16; const int v = nb * 32 + n; const int up = (v >> 2) & 1, j = (v >> 3) * 4 + (v & 3);
        return CvtDesc{(up ? wu : wg) + j, (size_t)DFF, WF1, 1024, nb * 32, kb * 64}; } r -= I_F1;
    if (r < I_F2) { const int nb = r / 44, kb = r % 44;
        return CvtDesc{wd + nb * 32 + n, 1024, WF2, DFF, nb * 32, kb * 64}; } r -= I_F2;
    if (r < 16) { const int l = r >> 3, nb = r & 7; return CvtDesc{(const float*)a->in[21] + l * 64 * 256 + nb * 32 + n, 256, LR + l * 256 * 64, 64, nb * 32, 0}; } r -= 16;
    if (r < 16) { const int l = r >> 3, nb = r & 7; return CvtDesc{(const float*)a->in[23] + l * 64 * 256 + nb * 32 + n, 256, LR + 2 * 256 * 64 + l * 256 * 64, 64, nb * 32, 0}; } r -= 16;
    { const int l = r >> 4, nb = (r >> 1) & 7, kb = r & 1; return CvtDesc{(const float*)a->in[24] + l * 128 * 256 + nb * 32 + n, 256, LR + 4 * 256 * 64 + l * 256 * 128, 128, nb * 32, kb * 64}; }
}
__device__ __forceinline__ void p0_convert(Frame& F, ArgsP a) {
    LAS float* scr = (LAS float*)(F.lds + 16384 + F.wave * 8704);
    constexpr int NITEMS = 2 * 232 * 16 + 2 * 4 * 32 * 4 + 2 * 32 * 16 + 176 * 16 + 32 * 44 + 64;
    int lane_ = F.lane(); asm volatile("" : "+v"(lane_));
    const int n = 4 * (lane_ & 7);
    int it = F.gw; if (it >= NITEMS) return;
    CvtDesc cur = p0_desc(a, it, n); pg8::f32x4 v[8]; cvt_load(cur, v, lane_);
    for (;;) { const int nx = it + F.NGW; const bool more = nx < NITEMS;
        CvtDesc nd = cur; pg8::f32x4 w[8];
        if (more) { nd = p0_desc(a, nx, n); cvt_load(nd, w, lane_); }
        cvt_store(cur, v, scr, lane_);
        if (!more) break;
#pragma unroll
        for (int i = 0; i < 8; ++i) v[i] = w[i];
        cur = nd; it = nx; }
}

__device__ __forceinline__ void row_load(const float* p, pg8::f32x4 (&v)[4], int lane) {
#pragma unroll
    for (int j = 0; j < 4; ++j) v[j] = *(const pg8::f32x4*)(p + 4 * lane + 256 * j);
}
__device__ __forceinline__ float row_ss(const pg8::f32x4 (&v)[4]) {
    float s = 0.f;
#pragma unroll
    for (int j = 0; j < 4; ++j) s += (v[j][0] * v[j][0] + v[j][1] * v[j][1]) + (v[j][2] * v[j][2] + v[j][3] * v[j][3]);
    return wave_sum(s);
}
__device__ __forceinline__ void row_normmod(const pg8::f32x4 (&x)[4], const float* g, const float* mb, int sh_off, int sc_off, bf16_t* hrow, pg8::f32x4 (&hv)[4], int lane) {
    const float rstd = rsqrtf(row_ss(x) * (1.0f / D) + 1e-6f);
#pragma unroll
    for (int j = 0; j < 4; ++j) { const int d = 4 * lane + 256 * j;
        const pg8::f32x4 gg = *(const pg8::f32x4*)(g + d), sc = *(const pg8::f32x4*)(mb + sc_off + d), sh = *(const pg8::f32x4*)(mb + sh_off + d);
        hv[j] = x[j] * rstd * gg * (1.0f + sc) + sh;
        pg8::u32x2 w; w.x = pk2(hv[j][0], hv[j][1]); w.y = pk2(hv[j][2], hv[j][3]);
        *(pg8::u32x2*)(hrow + d) = w; }
}
__device__ __forceinline__ void ph_h0(Frame& F, ArgsP a) {
    const float* x = (const float*)a->in[0]; const float* g = (const float*)a->in[5]; const float* mod = (const float*)(a->ws + WS_MOD); bf16_t* H = (bf16_t*)(a->ws + WS_HB);
    int row = F.gw; if (row >= M) return;
    int lane0 = F.lane(); asm volatile("" : "+v"(lane0));
    pg8::f32x4 xn[4]; row_load(x + (size_t)row * D, xn, lane0);
    for (;;) { int lane = lane0; asm volatile("" : "+v"(lane)); pg8::f32x4 xv[4], hv[4];
#pragma unroll
        for (int j = 0; j < 4; ++j) xv[j] = xn[j];
        const int nrow = row + F.NGW; if (nrow < M) row_load(x + (size_t)nrow * D, xn, lane);
        row_normmod(xv, g, mod + (size_t)(row / T) * 6144, 0, 1024, H + (size_t)row * D, hv, lane);
        if (nrow >= M) break; row = nrow; }
}
__device__ __forceinline__ void row_y_load(const bf16_t* y, const bf16_t* eout, const unsigned* cnt, const int* toke, const int* toks, int row, int lane, pg8::f32x4 (&yv)[4], pg8::u32x2 (&e1)[4], pg8::u32x2 (&e2)[4]) {
    if (eout) {
        int roff[8]; { int o = 0;
#pragma unroll
            for (int e = 0; e < 8; ++e) { roff[e] = o; o += (((int)cnt[e] + 255) >> 8) << 8; } }
        const int x1 = toke[row * 2], x2 = toke[row * 2 + 1]; int g1 = toks[row * 2], g2 = toks[row * 2 + 1];
#pragma unroll
        for (int q = 0; q < 8; ++q) { if (q == x1) g1 += roff[q]; if (q == x2) g2 += roff[q]; }
#pragma unroll
        for (int j = 0; j < 4; ++j) { e1[j] = *(const pg8::u32x2*)(eout + (size_t)g1 * D + 4 * lane + 256 * j); e2[j] = *(const pg8::u32x2*)(eout + (size_t)g2 * D + 4 * lane + 256 * j); }
    } else {
#pragma unroll
        for (int j = 0; j < 4; ++j) e1[j] = *(const pg8::u32x2*)(y + (size_t)row * D + 4 * lane + 256 * j); }
}
__device__ __forceinline__ void ph_row(Frame& F, ArgsP a, const float* xold, const bf16_t* y, const float* gpost, const float* modl, int gt_off,
                                       const float* gpre, const float* modn, int sh_off, int sc_off, bf16_t* hdst, bool route, const bf16_t* eout = nullptr) {
    float* out = a->out;
    const float* rw = (const float*)a->in[35]; const float* rb = (const float*)a->in[36];
    unsigned* cnt = (unsigned*)(a->ws + WS_CTL) + CW_CNT;
    int* list = (int*)(a->ws + WS_ROUTE + RT_LIST); int* toke = (int*)(a->ws + WS_ROUTE + RT_TOKE); int* toks = (int*)(a->ws + WS_ROUTE + RT_TOKS); float* tokp = (float*)(a->ws + WS_ROUTE + RT_TOKP);
    int row = F.gw; if (row >= M) return;
    int lane0 = F.lane(); asm volatile("" : "+v"(lane0));
    pg8::f32x4 yn[4], xn[4]; pg8::u32x2 e1n[4], e2n[4];
    row_y_load(y, eout, cnt, toke, toks, row, lane0, yn, e1n, e2n); row_load(xold + (size_t)row * D, xn, lane0);
    for (;;) {
        int lane = lane0; asm volatile("" : "+v"(lane));
        const int b = row / T; pg8::f32x4 yv[4], xv[4], hv[4];
        if (eout) { const float p1 = tokp[row * 2], p2 = tokp[row * 2 + 1];
#pragma unroll
            for (int j = 0; j < 4; ++j) { const pg8::u32x2 a1 = e1n[j], a2 = e2n[j];
                yv[j][0] = p1 * __builtin_bit_cast(float, a1.x << 16) + p2 * __builtin_bit_cast(float, a2.x << 16); yv[j][1] = p1 * __builtin_bit_cast(float, a1.x & 0xffff0000u) + p2 * __builtin_bit_cast(float, a2.x & 0xffff0000u);
                yv[j][2] = p1 * __builtin_bit_cast(float, a1.y << 16) + p2 * __builtin_bit_cast(float, a2.y << 16); yv[j][3] = p1 * __builtin_bit_cast(float, a1.y & 0xffff0000u) + p2 * __builtin_bit_cast(float, a2.y & 0xffff0000u); }
        } else {
#pragma unroll
            for (int j = 0; j < 4; ++j) { const pg8::u32x2 a1 = e1n[j]; yv[j][0] = __builtin_bit_cast(float, a1.x << 16); yv[j][1] = __builtin_bit_cast(float, a1.x & 0xffff0000u); yv[j][2] = __builtin_bit_cast(float, a1.y << 16); yv[j][3] = __builtin_bit_cast(float, a1.y & 0xffff0000u); } }
#pragma unroll
        for (int j = 0; j < 4; ++j) xv[j] = xn[j];
        const int nrow = row + F.NGW;
        if (nrow < M) { row_y_load(y, eout, cnt, toke, toks, nrow, lane, yn, e1n, e2n); row_load(xold + (size_t)nrow * D, xn, lane); }
        const float rstd = rsqrtf(row_ss(yv) * (1.0f / D) + 1e-6f);
        const float* mb = modl + (size_t)b * 6144;
#pragma unroll
        for (int j = 0; j < 4; ++j) { const int d = 4 * lane + 256 * j;
            const pg8::f32x4 gp = *(const pg8::f32x4*)(gpost + d), gt = *(const pg8::f32x4*)(mb + gt_off + d);
            xv[j] = xv[j] + gt * (yv[j] * rstd * gp);
            *(pg8::f32x4*)(out + (size_t)row * D + d) = xv[j]; }
        if (hdst) {
            row_normmod(xv, gpre, modn + (size_t)b * 6144, sh_off, sc_off, hdst + (size_t)row * D, hv, lane);
            if (route) {
                float lg[8];
#pragma unroll
                for (int e = 0; e < 8; ++e) lg[e] = 0.f;
#pragma unroll
                for (int j = 0; j < 4; ++j)
#pragma unroll
                    for (int q = 0; q < 4; ++q) { const int d = 4 * lane + 256 * j + q; const pg8::f32x4 w0 = *(const pg8::f32x4*)(rw + d * 8), w1 = *(const pg8::f32x4*)(rw + d * 8 + 4); const float hq = hv[j][q];
                        lg[0] += hq * w0[0]; lg[1] += hq * w0[1]; lg[2] += hq * w0[2]; lg[3] += hq * w0[3]; lg[4] += hq * w1[0]; lg[5] += hq * w1[1]; lg[6] += hq * w1[2]; lg[7] += hq * w1[3]; }
#pragma unroll
                for (int e = 0; e < 8; ++e) lg[e] = wave_sum(lg[e]) + rb[e];
                if (lane == 0) {
                    int e1 = 0; float v1 = lg[0];
#pragma unroll
                    for (int e = 1; e < 8; ++e) if (lg[e] > v1) { v1 = lg[e]; e1 = e; }
                    int e2 = -1; float v2 = -3.0e38f;
#pragma unroll
                    for (int e = 0; e < 8; ++e) if (e != e1 && lg[e] > v2) { v2 = lg[e]; e2 = e; }
                    const float p1 = 1.0f / (1.0f + __expf(v2 - v1)), p2 = 1.0f - p1;
                    const int s1 = (int)atomicAdd(&cnt[e1], 1u), s2 = (int)atomicAdd(&cnt[e2], 1u);
                    list[e1 * M + s1] = row; list[e2 * M + s2] = row;
                    toke[row * 2] = e1; toke[row * 2 + 1] = e2; toks[row * 2] = s1; toks[row * 2 + 1] = s2; tokp[row * 2] = p1; tokp[row * 2 + 1] = p2;
                }
            }
        }
        if (nrow >= M) break; row = nrow;
    }
}

__device__ __forceinline__ void ph_moe_prep(Frame& F, ArgsP a) {
    LAS float* scr = (LAS float*)(F.lds + F.wave * 8704);
    const float* mg = (const float*)a->in[37]; const float* mu = (const float*)a->in[38]; const float* md = (const float*)a->in[39];
    bf16_t* WM1 = (bf16_t*)(a->ws + WS_WM1); bf16_t* WM2 = (bf16_t*)(a->ws + WS_WM2);
    constexpr int I_1 = 8 * 224 * 16, I_2 = 8 * 32 * 56;
    int lane_ = F.lane(); asm volatile("" : "+v"(lane_));
    const int n = 4 * (lane_ & 7);
    auto desc = [&](int r) -> CvtDesc {
        if (r < I_1) { const int e = r / 3584, q = r % 3584, nb = q / 16, kb = q % 16; const int v = nb * 32 + n; const int up = (v >> 2) & 1, j = (v >> 3) * 4 + (v & 3);
            return CvtDesc{(up ? mu : mg) + (size_t)e * 1024 * DEX + j, (size_t)DEX, WM1 + (size_t)e * 7168 * 1024, 1024, nb * 32, kb * 64}; }
        r -= I_1; const int e = r / 1792, q = r % 1792, nb = q / 56, kb = q % 56;
        return CvtDesc{md + (size_t)e * DEX * 1024 + nb * 32 + n, 1024, WM2 + (size_t)e * 1024 * DEX, DEX, nb * 32, kb * 64}; };
    { int it = F.gw;
      if (it < I_1 + I_2) { CvtDesc cur = desc(it); pg8::f32x4 v[8]; cvt_load(cur, v, lane_);
        for (;;) { const int nx = it + F.NGW; const bool more = nx < I_1 + I_2; CvtDesc nd = cur; pg8::f32x4 w[8];
            if (more) { nd = desc(nx); cvt_load(nd, w, lane_); }
            cvt_store(cur, v, scr, lane_);
            if (!more) break;
#pragma unroll
            for (int i = 0; i < 8; ++i) v[i] = w[i];
            cur = nd; it = nx; } } }
    const unsigned* cnt = (const unsigned*)(a->ws + WS_CTL) + CW_CNT;
    const int* list = (const int*)(a->ws + WS_ROUTE + RT_LIST);
    const bf16_t* h2 = (const bf16_t*)(a->ws + WS_H2L1); bf16_t* hg = (bf16_t*)(a->ws + WS_HG);
    int roff[9]; { int o = 0;
#pragma unroll
        for (int e = 0; e < 8; ++e) { roff[e] = o; o += (((int)cnt[e] + 255) >> 8) << 8; } roff[8] = o; }
    for (int slot = F.gw; slot < roff[8]; slot += F.NGW) {
        int e = 0;
#pragma unroll
        for (int q = 1; q < 8; ++q) e += (slot >= roff[q]) ? 1 : 0;
        int base = 0, ce = 0;
#pragma unroll
        for (int q = 0; q < 8; ++q) if (q == e) { base = roff[q]; ce = (int)cnt[q]; }
        const int s = slot - base;
        pg8::u32x4 v0 = {0u, 0u, 0u, 0u}, v1 = {0u, 0u, 0u, 0u};
        if (s < ce) { const int src = list[e * M + s]; const pg8::u32x4* sp = (const pg8::u32x4*)(h2 + (size_t)src * D) + 2 * lane_; v0 = sp[0]; v1 = sp[1]; }
        pg8::u32x4* dp = (pg8::u32x4*)(hg + (size_t)slot * D) + 2 * lane_; dp[0] = v0; dp[1] = v1;
    }
}
template <int CTRL, int ROWMASK> __device__ __forceinline__ float dpp_mov(float old, float x) {
    return __builtin_bit_cast(float, __builtin_amdgcn_update_dpp(__builtin_bit_cast(int, old), __builtin_bit_cast(int, x), CTRL, ROWMASK, 0xF, false));
}
__device__ __forceinline__ float rdlane(float x, int l) { return __builtin_bit_cast(float, __builtin_amdgcn_readlane(__builtin_bit_cast(int, x), l)); }
__device__ __forceinline__ float wave_sum63(float x) {
    x += dpp_mov<0xB1, 0xF>(0.f, x);
    x += dpp_mov<0x4E, 0xF>(0.f, x);
    x += dpp_mov<0x141, 0xF>(0.f, x);
    x += dpp_mov<0x140, 0xF>(0.f, x);
    x += dpp_mov<0x142, 0xA>(0.f, x);
    x += dpp_mov<0x143, 0xC>(0.f, x);
    return x;
}
__device__ __forceinline__ float row16_sum(float x) {
    x += dpp_mov<0xB1, 0xF>(0.f, x); x += dpp_mov<0x4E, 0xF>(0.f, x); x += dpp_mov<0x141, 0xF>(0.f, x); x += dpp_mov<0x140, 0xF>(0.f, x);
    return x;
}
__device__ __forceinline__ pg8::f32x4 ld_bf16x4(const bf16_t* p) { const pg8::u32x2 w = *(const pg8::u32x2*)p;
    return (pg8::f32x4){__builtin_bit_cast(float, w.x << 16), __builtin_bit_cast(float, w.x & 0xffff0000u), __builtin_bit_cast(float, w.y << 16), __builtin_bit_cast(float, w.y & 0xffff0000u)}; }
__device__ __forceinline__ void st_bf16x4(bf16_t* p, pg8::f32x4 v) { pg8::u32x2 w; w.x = pk2(v[0], v[1]); w.y = pk2(v[2], v[3]); *(pg8::u32x2*)p = w; }

__device__ __forceinline__ void ph_conv(Frame& F, ArgsP a, int l) {
    const bf16_t* proj = (const bf16_t*)(a->ws + WS_PROJ); bf16_t* br = (bf16_t*)(a->ws + WS_HB);
    const float* cw = (const float*)a->in[15] + l * 31 * 256; const float* cb = (const float*)a->in[16] + l * 256; const float* lg = (const float*)a->in[17] + l * 256; const float* lb = (const float*)a->in[18] + l * 256;
    LAS float* u = (LAS float*)F.lds;
    int tid = F.wave * 64 + F.lane(); asm volatile("" : "+v"(tid)); const int lane = tid & 63;
    for (int it = blockIdx.x; it < M / 64; it += F.G) {
        const int row0 = it * 64, t0 = row0 % T;
        for (int idx = tid; idx < 94 * 32; idx += NTHR) { const int r = idx >> 5, c8 = (idx & 31) * 8; float uv[8];
#pragma unroll
            for (int e = 0; e < 8; ++e) uv[e] = 0.f;
            if (t0 - 30 + r >= 0) { const bf16_t* pr = proj + (size_t)(row0 - 30 + r) * PW;
                const pg8::f32x4 a0 = ld_bf16x4(pr + P_CA + c8), a1 = ld_bf16x4(pr + P_CA + c8 + 4), b0 = ld_bf16x4(pr + P_CB + c8), b1 = ld_bf16x4(pr + P_CB + c8 + 4);
#pragma unroll
                for (int e = 0; e < 4; ++e) { uv[e] = a0[e] * sigm(b0[e]); uv[4 + e] = a1[e] * sigm(b1[e]); } }
            *(LAS pg8::f32x4*)(u + r * 256 + c8) = (pg8::f32x4){uv[0], uv[1], uv[2], uv[3]}; *(LAS pg8::f32x4*)(u + r * 256 + c8 + 4) = (pg8::f32x4){uv[4], uv[5], uv[6], uv[7]}; }
        __syncthreads();
        const int c = tid & 255, half = tid >> 8;
        float acc[32];
        { float w[31], ur[62];
#pragma unroll
          for (int j = 0; j < 31; ++j) w[j] = cw[j * 256 + c];
#pragma unroll
          for (int q = 0; q < 62; ++q) ur[q] = u[(half * 32 + q) * 256 + c];
          const float bias = cb[c];
#pragma unroll
          for (int i = 0; i < 32; ++i) { float s = bias;
#pragma unroll
              for (int j = 0; j < 31; ++j) s += w[j] * ur[i + j];
              acc[i] = s; } }
        __syncthreads();
#pragma unroll
        for (int i = 0; i < 32; ++i) u[(half * 32 + i) * 256 + c] = acc[i];
        __syncthreads();
        const pg8::f32x4 g4 = *(const pg8::f32x4*)(lg + 4 * lane), b4 = *(const pg8::f32x4*)(lb + 4 * lane);
#pragma unroll 2
        for (int q = 0; q < 8; ++q) { const int t = F.wave * 8 + q; const pg8::f32x4 yv = *(const LAS pg8::f32x4*)(u + t * 256 + 4 * lane);
            const float mu = wave_sum((yv[0] + yv[1]) + (yv[2] + yv[3])) * (1.0f / 256.0f); const pg8::f32x4 d = yv - mu;
            const float var = wave_sum((d[0] * d[0] + d[1] * d[1]) + (d[2] * d[2] + d[3] * d[3])) * (1.0f / 256.0f);
            pg8::f32x4 o = d * rsqrtf(var + 1e-5f) * g4 + b4;
#pragma unroll
            for (int e = 0; e < 4; ++e) o[e] = siluf(o[e]);
            st_bf16x4(br + (size_t)(row0 + t) * D + 512 + 4 * lane, o); }
        __syncthreads();
    }
}

__device__ __forceinline__ void ph_rwkv_prep(Frame& F, ArgsP a, int l) {
    typedef float f32x16 __attribute__((ext_vector_type(16)));
    const bf16_t* proj = (const bf16_t*)(a->ws + WS_PROJ);
    const float* mu = (const float*)a->in[19] + l * 1024; const float* w0 = (const float*)a->in[20] + l * 256; const float* a0 = (const float*)a->in[22] + l * 256;
    const float* kkw = (const float*)a->in[25] + l * 256; const float* kaw = (const float*)a->in[26] + l * 256; const float* rkw = (const float*)a->in[27] + l * 256;
    const bf16_t* W2T = (const bf16_t*)(a->ws + WS_LR) + l * 256 * 64; const bf16_t* A2T = (const bf16_t*)(a->ws + WS_LR) + 2 * 256 * 64 + l * 256 * 64; const bf16_t* G2T = (const bf16_t*)(a->ws + WS_LR) + 4 * 256 * 64 + l * 256 * 128;
    float* VEC = (float*)(a->ws + SCR_VEC6); float* SC = (float*)(a->ws + SCR_SC); bf16_t* GR = (bf16_t*)(a->ws + SCR_GR);
    constexpr int RS = 72, RG = 136;
    LAS bf16_t* TZh = (LAS bf16_t*)F.lds; LAS bf16_t* TZl = TZh + 64 * RS; LAS bf16_t* ZA = TZl + 64 * RS; LAS bf16_t* SG = ZA + 64 * RS;
    int tid = F.wave * 64 + F.lane(); asm volatile("" : "+v"(tid));
    for (int it = blockIdx.x; it < M / 64; it += F.G) {
        const int row0 = it * 64, b = row0 / T, t0 = row0 % T;
#pragma unroll 4
        for (int i_ = 0; i_ < 32; ++i_) { const int idx = tid + i_ * NTHR; const int cc = idx & 255, tok = idx >> 8; const int col = 768 + cc;
            const bf16_t* pc = proj + (size_t)(row0 + tok) * PW + P_R + col; const float xc = bf2f(pc[0]); const float xp = (t0 + tok > 0) ? bf2f(pc[-PW]) : 0.f;
            const float xm = xc + (xp - xc) * mu[col];
            if (cc < 64) { const float tv = tanhf(xm); const unsigned hi = f2bf(tv); TZh[tok * RS + cc] = (bf16_t)hi; TZl[tok * RS + cc] = (bf16_t)f2bf(tv - __builtin_bit_cast(float, hi << 16)); }
            else if (cc < 128) ZA[tok * RS + cc - 64] = (bf16_t)f2bf(xm);
            else SG[tok * RG + cc - 128] = (bf16_t)f2bf(sigm(xm)); }
        __syncthreads();
        int tid2 = tid; asm volatile("" : "+v"(tid2));
        const int lane = tid2 & 63, r = lane & 31, hg = lane >> 5, h = (tid2 >> 6) & 3, th = tid2 >> 8;
        f32x16 accw[2], acca[2], accg[2];
#pragma unroll
        for (int nb = 0; nb < 2; ++nb)
#pragma unroll
            for (int e = 0; e < 16; ++e) { accw[nb][e] = 0.f; acca[nb][e] = 0.f; accg[nb][e] = 0.f; }
        const int arow = (th * 32 + r);
#pragma unroll
        for (int s = 0; s < 4; ++s) { const pg8::bf16x8 ah = *(const LAS pg8::bf16x8*)(TZh + arow * RS + 16 * s + 8 * hg), al = *(const LAS pg8::bf16x8*)(TZl + arow * RS + 16 * s + 8 * hg), az = *(const LAS pg8::bf16x8*)(ZA + arow * RS + 16 * s + 8 * hg);
#pragma unroll
            for (int nb = 0; nb < 2; ++nb) { const int n = h * 64 + nb * 32 + r;
                const pg8::bf16x8 bw = *(const pg8::bf16x8*)(W2T + n * 64 + 16 * s + 8 * hg), ba = *(const pg8::bf16x8*)(A2T + n * 64 + 16 * s + 8 * hg);
                accw[nb] = __builtin_amdgcn_mfma_f32_32x32x16_bf16(ah, bw, accw[nb], 0, 0, 0); accw[nb] = __builtin_amdgcn_mfma_f32_32x32x16_bf16(al, bw, accw[nb], 0, 0, 0);
                acca[nb] = __builtin_amdgcn_mfma_f32_32x32x16_bf16(az, ba, acca[nb], 0, 0, 0); } }
#pragma unroll
        for (int s = 0; s < 8; ++s) { const pg8::bf16x8 ag = *(const LAS pg8::bf16x8*)(SG + arow * RG + 16 * s + 8 * hg);
#pragma unroll
            for (int nb = 0; nb < 2; ++nb) { const int n = h * 64 + nb * 32 + r; const pg8::bf16x8 bg = *(const pg8::bf16x8*)(G2T + n * 128 + 16 * s + 8 * hg);
                accg[nb] = __builtin_amdgcn_mfma_f32_32x32x16_bf16(ag, bg, accg[nb], 0, 0, 0); } }
        int tid3 = tid; asm volatile("" : "+v"(tid3)); const int r3 = tid3 & 31, hg3 = (tid3 >> 5) & 1, h3 = (tid3 >> 6) & 3, th3 = tid3 >> 8;
        float pw0[2], pa0[2], pmr[2], pmk[2], pmv[2], pkk[2], pka[2], prk[2];
#pragma unroll
        for (int nb = 0; nb < 2; ++nb) { const int c = h3 * 64 + nb * 32 + r3; pw0[nb] = w0[c]; pa0[nb] = a0[c]; pmr[nb] = mu[c]; pmk[nb] = mu[256 + c]; pmv[nb] = mu[512 + c]; pkk[nb] = kkw[c]; pka[nb] = kaw[c]; prk[nb] = rkw[c]; }
#pragma unroll
        for (int e = 0; e < 16; ++e) { const int tok = th3 * 32 + (e & 3) + 8 * (e >> 2) + 4 * hg3, t = t0 + tok; const size_t row = (size_t)row0 + tok; const bool hp = t > 0;
            float dec[2], kkv[2], kka[2], k2[2], rv[2], vv[2], s_kk = 0.f, s_c1 = 0.f, s_c2 = 0.f, s_bn = 0.f;
#pragma unroll
            for (int nb = 0; nb < 2; ++nb) { const int c = h3 * 64 + nb * 32 + r3; const bf16_t* pc = proj + row * PW + P_R + c;
                const float rc = bf2f(pc[0]), kc = bf2f(pc[256]), vc = bf2f(pc[512]);
                const float rp = hp ? bf2f(pc[-PW]) : 0.f, kp = hp ? bf2f(pc[256 - PW]) : 0.f, vp = hp ? bf2f(pc[512 - PW]) : 0.f;
                const float rr = rc + (rp - rc) * pmr[nb], k = kc + (kp - kc) * pmk[nb]; vv[nb] = vc + (vp - vc) * pmv[nb]; rv[nb] = rr;
                const float wl = -softplusf(-(accw[nb][e] + pw0[nb])) - 0.5f; dec[nb] = __expf(-__expf(wl)); const float av = sigm(acca[nb][e] + pa0[nb]);
                kkv[nb] = k * pkk[nb]; k2[nb] = k * (1.0f + (av - 1.0f) * pka[nb]); kka[nb] = av;
                s_kk += kkv[nb] * kkv[nb]; s_c2 += k2[nb] * rr; s_bn += rr * k2[nb] * prk[nb];
                GR[row * 256 + c] = (bf16_t)f2bf(accg[nb][e]); }
            s_kk = row16_sum(s_kk); s_kk += __shfl_xor(s_kk, 16);
            const float inv = 1.0f / fmaxf(sqrtf(s_kk), 1e-12f);
#pragma unroll
            for (int nb = 0; nb < 2; ++nb) { kkv[nb] *= inv; kka[nb] *= kkv[nb]; s_c1 += kka[nb] * rv[nb]; }
            s_c1 = row16_sum(s_c1); s_c1 += __shfl_xor(s_c1, 16); s_c2 = row16_sum(s_c2); s_c2 += __shfl_xor(s_c2, 16); s_bn = row16_sum(s_bn); s_bn += __shfl_xor(s_bn, 16);
            const size_t st = ((size_t)(b * 4 + h3) * T + t);
#pragma unroll
            for (int nb = 0; nb < 2; ++nb) { float* vb = VEC + st * VSTEP + nb * 32 + r3;
                vb[0] = dec[nb]; vb[64] = -kkv[nb]; vb[128] = kka[nb]; vb[192] = k2[nb]; vb[256] = dec[nb] * rv[nb]; vb[320] = vv[nb]; }
            if (r3 == 0) { *(pg8::f32x4*)(SC + st * 4) = (pg8::f32x4){s_c1, s_c2, s_bn, 0.f}; *(pg8::f32x2*)(VEC + st * VSTEP + 384) = (pg8::f32x2){s_c1, s_c2}; }
            asm volatile("" ::: "memory"); }
        __syncthreads();
    }
}

__device__ __forceinline__ void ph_rwkv_scan(Frame& F, ArgsP a) {
    const float* VEC = (const float*)(a->ws + SCR_VEC6); float* YR = (float*)(a->ws + SCR_YR);
    int lane = F.lane(); asm volatile("" : "+v"(lane));
    constexpr int CH = 32, CHB = CH * VSTEP * 4, NP = CHB / 1024 / 4;
    const bool stager = F.wave >= 4;
    for (int it = blockIdx.x; it < 256; it += F.G) {
        const int bh = it >> 3, rg = it & 7, b = bh >> 2, h = bh & 3;
        const int sw = F.wave & 3, vrow = rg * 8 + 2 * sw;
        const char* src = (const char*)(VEC + (size_t)bh * T * VSTEP) + lane * 16;
#define RW_STAGE(cidx) do { _Pragma("unroll") for (int p_ = 0; p_ < NP; ++p_) \
            __builtin_amdgcn_global_load_lds((const unsigned*)(src + (size_t)(cidx) * CHB + (sw * NP + p_) * 1024), (LAS unsigned*)(F.lds + ((cidx) & 1) * CHB + (sw * NP + p_) * 1024), 16, 0, 0); } while (0)
        if (stager) { RW_STAGE(0); asm volatile("s_waitcnt vmcnt(0)" ::: "memory"); }
        __builtin_amdgcn_s_barrier(); asm volatile("" ::: "memory");
        float SA = 0.f, SB = 0.f;
        for (int c = 0; c < T / CH; ++c) {
            if (stager) { if (c + 1 < T / CH) { RW_STAGE(c + 1); asm volatile("s_waitcnt vmcnt(0)" ::: "memory"); } }
            else {
                const LAS float* bufl = (const LAS float*)(F.lds + (c & 1) * CHB) + lane;
                const LAS float* bufv = (const LAS float*)(F.lds + (c & 1) * CHB) + 320 + vrow;
                const LAS float* bufc = (const LAS float*)(F.lds + (c & 1) * CHB) + 384;
                float yaA = 0.f, yaB = 0.f;
                float nw = bufl[0], nnkk = bufl[64], nkka = bufl[128], nk2 = bufl[192], nwr = bufl[256]; pg8::f32x2 nv = *(const LAS pg8::f32x2*)bufv, ncc = *(const LAS pg8::f32x2*)bufc;
#pragma unroll 4
                for (int s = 0; s < CH; ++s) {
                    const float w_ = nw, nkk = nnkk, kka = nkka, k2 = nk2, wr = nwr; const pg8::f32x2 v = nv, cc = ncc;
                    { const int s1 = (s + 1 < CH ? s + 1 : s) * VSTEP;
                      nw = bufl[s1]; nnkk = bufl[s1 + 64]; nkka = bufl[s1 + 128]; nk2 = bufl[s1 + 192]; nwr = bufl[s1 + 256]; nv = *(const LAS pg8::f32x2*)(bufv + s1); ncc = *(const LAS pg8::f32x2*)(bufc + s1); }
                    const auto s0 = __builtin_amdgcn_permlane32_swap(__builtin_bit_cast(unsigned, SA * nkk), __builtin_bit_cast(unsigned, SA * wr), false, false);
                    const auto s1_ = __builtin_amdgcn_permlane32_swap(__builtin_bit_cast(unsigned, SB * nkk), __builtin_bit_cast(unsigned, SB * wr), false, false);
                    const float xA = __builtin_bit_cast(float, (unsigned)s0[0]) + __builtin_bit_cast(float, (unsigned)s0[1]);
                    const float xB = __builtin_bit_cast(float, (unsigned)s1_[0]) + __builtin_bit_cast(float, (unsigned)s1_[1]);
                    const auto s2 = __builtin_amdgcn_permlane16_swap(__builtin_bit_cast(unsigned, xA), __builtin_bit_cast(unsigned, xB), false, false);
                    float x = __builtin_bit_cast(float, (unsigned)s2[0]) + __builtin_bit_cast(float, (unsigned)s2[1]);
                    x += dpp_mov<0xB1, 0xF>(0.f, x); x += dpp_mov<0x4E, 0xF>(0.f, x); x += dpp_mov<0x141, 0xF>(0.f, x); x += dpp_mov<0x140, 0xF>(0.f, x);
                    const float saA = rdlane(x, 0), saB = rdlane(x, 16), zA = rdlane(x, 32), zB = rdlane(x, 48);
                    SA = SA * w_ + (saA * kka + v[0] * k2);
                    SB = SB * w_ + (saB * kka + v[1] * k2);
                    const float yA = zA + saA * cc[0] + v[0] * cc[1], yB = zB + saB * cc[0] + v[1] * cc[1];
                    yaA = (lane == s) ? yA : yaA; yaB = (lane == s) ? yB : yaB;
                }
                if (lane < CH) *(pg8::f32x2*)(YR + ((size_t)b * T + c * CH + lane) * 256 + h * 64 + vrow) = (pg8::f32x2){yaA, yaB};
            }
            __builtin_amdgcn_s_barrier(); asm volatile("" ::: "memory");
        }
#undef RW_STAGE
        asm volatile("s_waitcnt vmcnt(0)" ::: "memory"); __builtin_amdgcn_s_barrier(); asm volatile("" ::: "memory");
    }
}

__device__ __forceinline__ void ph_rwkv_post(Frame& F, ArgsP a, int l) {
    const float* VEC = (const float*)(a->ws + SCR_VEC6); const float* SC = (const float*)(a->ws + SCR_SC); const float* YR = (const float*)(a->ws + SCR_YR); const bf16_t* GR = (const bf16_t*)(a->ws + SCR_GR);
    const float* lng = (const float*)a->in[28] + l * 256; const float* lnb = (const float*)a->in[29] + l * 256;
    bf16_t* br = (bf16_t*)(a->ws + WS_HB);
    int lane = F.lane(); asm volatile("" : "+v"(lane));
    const int c = 4 * lane, h = lane >> 4;
    const pg8::f32x4 g4 = *(const pg8::f32x4*)(lng + c), b4 = *(const pg8::f32x4*)(lnb + c);
    for (int row = F.gw; row < M; row += F.NGW) {
        const int b = row / T, t = row % T; const size_t st = (size_t)(b * 4 + h) * T + t;
        const pg8::f32x4 y = *(const pg8::f32x4*)(YR + (size_t)row * 256 + c);
        const float mu = row16_sum((y[0] + y[1]) + (y[2] + y[3])) * (1.0f / 64.0f); const pg8::f32x4 d = y - mu;
        const float var = row16_sum((d[0] * d[0] + d[1] * d[1]) + (d[2] * d[2] + d[3] * d[3])) * (1.0f / 64.0f);
        const pg8::f32x4 yn = d * rsqrtf(var + 64e-5f) * g4 + b4;
        const float bonus = SC[st * 4 + 2];
        const pg8::f32x4 v = *(const pg8::f32x4*)(VEC + st * VSTEP + 320 + (c & 63));
        const pg8::f32x4 g = ld_bf16x4(GR + (size_t)row * 256 + c);
        st_bf16x4(br + (size_t)row * D + 768 + c, (yn + bonus * v) * g);
    }
}

__device__ __forceinline__ void ph_gla_p1(Frame& F, ArgsP a, int l) {
    const bf16_t* proj = (const bf16_t*)(a->ws + WS_PROJ); const float* w2 = (const float*)a->in[10] + l * 16 * 128; const float* gb = (const float*)a->in[11] + l * 128;
    float* EG = (float*)(a->ws + SCR_EG); float* CDp = EG + (size_t)M * 128; float* GU = (float*)(a->ws + SCR_GU);
    LAS float* el = (LAS float*)(F.lds + F.wave * 8192); LAS float* kl = el + 1024;
    int lane = F.lane(); asm volatile("" : "+v"(lane));
    const int d = lane & 31;
    for (int it = F.gw; it < 2048; it += F.NGW) {
        const int bh = it >> 6, n = it & 63, b = bh >> 2, h = bh & 3; const size_t row0 = (size_t)b * T + n * 32;
        float wc[16];
#pragma unroll
        for (int r = 0; r < 16; ++r) wc[r] = w2[r * 128 + h * 32 + d];
        const float gbv = gb[h * 32 + d];
#pragma unroll 4
        for (int i = 0; i < 16; ++i) { const int tok = 2 * i + (lane >> 5); const bf16_t* pr = proj + (row0 + tok) * PW;
            const pg8::f32x4 z0 = ld_bf16x4(pr + P_GZ), z1 = ld_bf16x4(pr + P_GZ + 4), z2 = ld_bf16x4(pr + P_GZ + 8), z3 = ld_bf16x4(pr + P_GZ + 12);
            float acc = gbv;
#pragma unroll
            for (int e = 0; e < 4; ++e) acc += z0[e] * wc[e] + z1[e] * wc[4 + e] + z2[e] * wc[8 + e] + z3[e] * wc[12 + e];
            const float ev = __expf(-softplusf(-acc) * (1.0f / 16.0f));
            el[tok * 32 + d] = ev; EG[(row0 + tok) * 128 + h * 32 + d] = ev;
            kl[tok * 32 + d] = bf2f(pr[P_GK + h * 32 + d]); }
        float S[32];
#pragma unroll
        for (int q = 0; q < 32; ++q) S[q] = 0.f;
        { const bf16_t* vp = proj + row0 * PW + P_GV + h * 64 + lane;
          float v0 = bf2f(vp[0]), v1 = bf2f(vp[(size_t)PW]), v2 = bf2f(vp[(size_t)2 * PW]), v3 = bf2f(vp[(size_t)3 * PW]);
#pragma unroll 1
          for (int tok = 0; tok < 32; ++tok) { const float vv = v0; v0 = v1; v1 = v2; v2 = v3; v3 = bf2f(vp[(size_t)(tok + 4 < 32 ? tok + 4 : 31) * PW]);
#pragma unroll
              for (int j = 0; j < 8; ++j) { const pg8::f32x4 e4 = *(const LAS pg8::f32x4*)(el + tok * 32 + 4 * j), k4 = *(const LAS pg8::f32x4*)(kl + tok * 32 + 4 * j);
#pragma unroll
                  for (int e = 0; e < 4; ++e) S[4 * j + e] = e4[e] * S[4 * j + e] + k4[e] * vv; } } }
#pragma unroll
        for (int q = 0; q < 32; ++q) GU[((size_t)it * 32 + q) * 64 + lane] = S[q];
        if (lane < 32) { float cd = 1.f; for (int tok = 0; tok < 32; ++tok) cd *= el[tok * 32 + lane]; CDp[it * 32 + lane] = cd; }
        asm volatile("s_waitcnt lgkmcnt(0)" ::: "memory");
    }
}
__device__ __forceinline__ void ph_gla_prefix(Frame& F, ArgsP a) {
    const float* CDp = (const float*)(a->ws + SCR_EG) + (size_t)M * 128; float* GU = (float*)(a->ws + SCR_GU);
    int lane = F.lane(); asm volatile("" : "+v"(lane));
    for (int it = F.gw; it < 1024; it += F.NGW) { const int bh = it >> 5, d = it & 31;
        float* gp = GU + ((size_t)bh * 64 * 32 + d) * 64 + lane; const float* cp = CDp + (size_t)bh * 64 * 32 + d;
        float u[64], cd[64];
#pragma unroll
        for (int n = 0; n < 64; ++n) { u[n] = gp[(size_t)n * 2048]; cd[n] = cp[n * 32]; }
        float S = 0.f;
#pragma unroll
        for (int n = 0; n < 64; ++n) { gp[(size_t)n * 2048] = S; S = cd[n] * S + u[n]; } }
}
__device__ __forceinline__ void ph_gla_p2(Frame& F, ArgsP a, int l) {
    const bf16_t* proj = (const bf16_t*)(a->ws + WS_PROJ); const float* gnorm = (const float*)a->in[12] + l * 64;
    const float* EG = (const float*)(a->ws + SCR_EG); const float* GS = (const float*)(a->ws + SCR_GS); bf16_t* br = (bf16_t*)(a->ws + WS_HB);
    LAS float* el = (LAS float*)(F.lds + F.wave * 12288); LAS float* kl = el + 1024; LAS float* ql = el + 2048;
    int lane = F.lane(); asm volatile("" : "+v"(lane));
    const int d = lane & 31; const float gn = gnorm[lane];
    for (int it = F.gw; it < 2048; it += F.NGW) {
        const int bh = it >> 6, n = it & 63, b = bh >> 2, h = bh & 3; const size_t row0 = (size_t)b * T + n * 32;
#pragma unroll 4
        for (int i = 0; i < 16; ++i) { const int tok = 2 * i + (lane >> 5); const bf16_t* pr = proj + (row0 + tok) * PW;
            el[tok * 32 + d] = EG[(row0 + tok) * 128 + h * 32 + d]; kl[tok * 32 + d] = bf2f(pr[P_GK + h * 32 + d]); ql[tok * 32 + d] = bf2f(pr[P_GQ + h * 32 + d]) * 0.17677669529663687f; }
        float S[32];
#pragma unroll
        for (int q = 0; q < 32; ++q) S[q] = GS[((size_t)it * 32 + q) * 64 + lane];
        { const bf16_t* vp = proj + row0 * PW + P_GV + h * 64 + lane; const bf16_t* op = proj + row0 * PW + P_GO + h * 64 + lane;
          float v0 = bf2f(vp[0]), v1 = bf2f(vp[(size_t)PW]), v2 = bf2f(vp[(size_t)2 * PW]), v3 = bf2f(vp[(size_t)3 * PW]);
          float o0 = bf2f(op[0]), o1 = bf2f(op[(size_t)PW]), o2 = bf2f(op[(size_t)2 * PW]), o3 = bf2f(op[(size_t)3 * PW]);
#pragma unroll 1
          for (int tok = 0; tok < 32; ++tok) { const float vv = v0, og = o0; v0 = v1; v1 = v2; v2 = v3; o0 = o1; o1 = o2; o2 = o3;
              { const size_t nx = (size_t)(tok + 4 < 32 ? tok + 4 : 31) * PW; v3 = bf2f(vp[nx]); o3 = bf2f(op[nx]); }
              float o = 0.f;
#pragma unroll
              for (int j = 0; j < 8; ++j) { const pg8::f32x4 e4 = *(const LAS pg8::f32x4*)(el + tok * 32 + 4 * j), k4 = *(const LAS pg8::f32x4*)(kl + tok * 32 + 4 * j), q4 = *(const LAS pg8::f32x4*)(ql + tok * 32 + 4 * j);
#pragma unroll
                  for (int e = 0; e < 4; ++e) { S[4 * j + e] = e4[e] * S[4 * j + e] + k4[e] * vv; o += q4[e] * S[4 * j + e]; } }
              const float ss = rdlane(wave_sum63(o * o), 63); const float rstd = rsqrtf(ss * (1.0f / 64.0f) + 1e-6f);
              br[(row0 + tok) * D + h * 64 + lane] = (bf16_t)f2bf(o * rstd * gn * siluf(og)); } }
        asm volatile("s_waitcnt lgkmcnt(0)" ::: "memory");
    }
}

typedef float f32x16 __attribute__((ext_vector_type(16)));
__device__ __forceinline__ void ph_attn_prep(Frame& F, ArgsP a) {
    const bf16_t* proj = (const bf16_t*)(a->ws + WS_PROJ); const int* pos = (const int*)a->in[2];
    bf16_t* QR = (bf16_t*)(a->ws + SCR_QK); bf16_t* KR = QR + (size_t)M * 256; bf16_t* VT = (bf16_t*)(a->ws + SCR_VT);
    int lane = F.lane(); asm volatile("" : "+v"(lane));
    for (int idx = F.gw * 64 + lane; idx < M * 8; idx += F.NGW * 64) { const int row = idx >> 3, hc = idx & 7; const float p = (float)pos[row];
        const bf16_t* qs = proj + (size_t)row * PW + P_DQ + hc * 32; const bf16_t* ks = proj + (size_t)row * PW + P_DK + hc * 32;
        float qv[32], kv[32];
#pragma unroll
        for (int j = 0; j < 8; ++j) { const pg8::f32x4 q4 = ld_bf16x4(qs + 4 * j), k4 = ld_bf16x4(ks + 4 * j);
#pragma unroll
            for (int e = 0; e < 4; ++e) { qv[4 * j + e] = q4[e]; kv[4 * j + e] = k4[e]; } }
        float qo[32], ko[32];
#pragma unroll
        for (int i = 0; i < 16; ++i) { const float inv = exp2f(-(float)i * 0.8304820237218406f);
            float sn, cs; sincosf(p * inv, &sn, &cs);
            qo[i] = qv[i] * cs - qv[i + 16] * sn; qo[i + 16] = qv[i] * sn + qv[i + 16] * cs;
            ko[i] = kv[i] * cs - kv[i + 16] * sn; ko[i + 16] = kv[i] * sn + kv[i + 16] * cs; }
        const float qsc = 0.17677669529663687f * 1.4426950408889634f;
        bf16_t* qd = QR + (size_t)row * 256 + hc * 32; bf16_t* kd = KR + (size_t)row * 256 + hc * 32;
#pragma unroll
        for (int j = 0; j < 8; ++j) { st_bf16x4(qd + 4 * j, (pg8::f32x4){qo[4 * j] * qsc, qo[4 * j + 1] * qsc, qo[4 * j + 2] * qsc, qo[4 * j + 3] * qsc});
            st_bf16x4(kd + 4 * j, (pg8::f32x4){ko[4 * j], ko[4 * j + 1], ko[4 * j + 2], ko[4 * j + 3]}); } }
    for (int it = F.gw; it < 1024; it += F.NGW) { const int bh = it >> 5, tt = it & 31, b = bh >> 2, h = bh & 3;
        const bf16_t* vs = proj + ((size_t)b * T + tt * 64 + lane) * PW + P_DV + h * 64;
        pg8::u32x4 v[8];
#pragma unroll
        for (int j = 0; j < 8; ++j) v[j] = *(const pg8::u32x4*)(vs + 8 * j);
        bf16_t* vd = VT + (size_t)bh * 64 * T + tt * 64 + lane;
#pragma unroll
        for (int j = 0; j < 8; ++j)
#pragma unroll
            for (int e = 0; e < 4; ++e) { const unsigned w = v[j][e]; vd[(size_t)(8 * j + 2 * e) * T] = (bf16_t)(w & 0xffffu); vd[(size_t)(8 * j + 2 * e + 1) * T] = (bf16_t)(w >> 16); } }
}
__device__ __forceinline__ void ph_attn(Frame& F, ArgsP a, int l) {
    const bf16_t* QR = (const bf16_t*)(a->ws + SCR_QK); const bf16_t* KR = QR + (size_t)M * 256; const bf16_t* VT = (const bf16_t*)(a->ws + SCR_VT);
    const float* lp = (const float*)a->in[13] + l * 128; const float* subln = (const float*)a->in[14] + l * 64; bf16_t* br = (bf16_t*)(a->ws + WS_HB);
    int tid = F.wave * 64 + F.lane(); asm volatile("" : "+v"(tid)); const int lane = tid & 63;
    const int r = lane & 31, hg = lane >> 5, comp = F.wave & 1, qs = F.wave >> 1;
    constexpr int RS = 72;
    LAS bf16_t* Kt = (LAS bf16_t*)F.lds;
    LAS bf16_t* Vt = Kt + 2 * 64 * RS;
    LAS float* Xl = (LAS float*)(F.lds + 4 * 64 * RS * 2);
    float lam, lam_init;
    { float d01 = 0.f, d23 = 0.f;
      for (int i = 0; i < 32; ++i) { d01 += lp[i] * lp[32 + i]; d23 += lp[64 + i] * lp[96 + i]; }
      lam_init = 0.8f - 0.6f * __expf(-0.3f * (float)l); lam = __expf(d01) - __expf(d23) + lam_init; }
    const int ldrow = tid >> 3, ldch = tid & 7;
    for (int pi = blockIdx.x; pi < 256; pi += F.G) {
#pragma unroll 1
        for (int half = 0; half < 2; ++half) {
            const int bh = pi >> 3, j = pi & 7, qb = half == 0 ? 15 - j : j, b = bh >> 2, h = bh & 3;
            const int q0 = qb * 128 + qs * 32, nkw = q0 / 64 + 1, nkb = 2 * qb + 2;
            const size_t rowb = (size_t)b * T;
            pg8::bf16x8 qf[2];
#pragma unroll
            for (int s = 0; s < 2; ++s) qf[s] = *(const pg8::bf16x8*)(QR + (rowb + q0 + r) * 256 + h * 64 + comp * 32 + 16 * s + 8 * hg);
            f32x16 ot[2];
#pragma unroll
            for (int e = 0; e < 16; ++e) { ot[0][e] = 0.f; ot[1][e] = 0.f; }
            float mrun = -1e30f, lrun = 0.f;
            const bf16_t* kg = KR + (rowb + ldrow) * 256 + h * 64 + ldch * 8; const bf16_t* vg = VT + ((size_t)bh * 64 + ldrow) * T + ldch * 8;
            pg8::u32x4 kreg = *(const pg8::u32x4*)kg, vreg = *(const pg8::u32x4*)vg;
            pg8::u32x4 kreg2 = kreg, vreg2 = vreg;
            if (nkb > 1) { kreg2 = *(const pg8::u32x4*)(kg + (size_t)64 * 256); vreg2 = *(const pg8::u32x4*)(vg + 64); }
            for (int kt = 0; kt < nkb; ++kt) {
                const int bo = (kt & 1) * 64 * RS;
                *(LAS pg8::u32x4*)(Kt + bo + ldrow * RS + ldch * 8) = kreg; *(LAS pg8::u32x4*)(Vt + bo + ldrow * RS + ldch * 8) = vreg;
                __syncthreads();
                kreg = kreg2; vreg = vreg2;
                if (kt + 2 < nkb) { kreg2 = *(const pg8::u32x4*)(kg + (size_t)(kt + 2) * 64 * 256); vreg2 = *(const pg8::u32x4*)(vg + (kt + 2) * 64); }
                if (kt < nkw) {
                    f32x16 st[2];
#pragma unroll
                    for (int kb = 0; kb < 2; ++kb) {
#pragma unroll
                        for (int e = 0; e < 16; ++e) st[kb][e] = 0.f;
#pragma unroll
                        for (int s = 0; s < 2; ++s) { const pg8::bf16x8 kf = *(const LAS pg8::bf16x8*)(Kt + bo + (kb * 32 + r) * RS + comp * 32 + 16 * s + 8 * hg);
                            st[kb] = __builtin_amdgcn_mfma_f32_32x32x16_bf16(kf, qf[s], st[kb], 0, 0, 0); } }
                    if (kt == nkw - 1) {
                        const int qi = q0 + r;
#pragma unroll
                        for (int kb = 0; kb < 2; ++kb)
#pragma unroll
                            for (int e = 0; e < 16; ++e) { const int ki = kt * 64 + kb * 32 + (e & 3) + 8 * (e >> 2) + 4 * hg; if (ki > qi) st[kb][e] = -1e30f; } }
                    float tm = st[0][0];
#pragma unroll
                    for (int e = 1; e < 16; ++e) tm = fmaxf(tm, st[0][e]);
#pragma unroll
                    for (int e = 0; e < 16; ++e) tm = fmaxf(tm, st[1][e]);
                    tm = fmaxf(tm, __shfl_xor(tm, 32));
                    const float mn = fmaxf(mrun, tm), alpha = exp2f(mrun - mn); mrun = mn;
                    float ps = 0.f;
#pragma unroll
                    for (int kb = 0; kb < 2; ++kb)
#pragma unroll
                        for (int e = 0; e < 16; ++e) { st[kb][e] = exp2f(st[kb][e] - mn); ps += st[kb][e]; }
                    lrun = lrun * alpha + ps;
#pragma unroll
                    for (int e = 0; e < 16; ++e) { ot[0][e] *= alpha; ot[1][e] *= alpha; }
#pragma unroll
                    for (int kb = 0; kb < 2; ++kb)
#pragma unroll
                        for (int s = 0; s < 2; ++s) {
                            pg8::u32x4 pw; pw.x = pk2(st[kb][8 * s], st[kb][8 * s + 1]); pw.y = pk2(st[kb][8 * s + 2], st[kb][8 * s + 3]); pw.z = pk2(st[kb][8 * s + 4], st[kb][8 * s + 5]); pw.w = pk2(st[kb][8 * s + 6], st[kb][8 * s + 7]);
                            const pg8::bf16x8 pf = __builtin_bit_cast(pg8::bf16x8, pw);
#pragma unroll
                            for (int dvb = 0; dvb < 2; ++dvb) { const LAS bf16_t* vp = Vt + bo + (dvb * 32 + r) * RS + kb * 32 + 16 * s + 4 * hg;
                                const pg8::u32x2 v0 = *(const LAS pg8::u32x2*)vp, v1 = *(const LAS pg8::u32x2*)(vp + 8);
                                pg8::u32x4 vw; vw.x = v0.x; vw.y = v0.y; vw.z = v1.x; vw.w = v1.y;
                                ot[dvb] = __builtin_amdgcn_mfma_f32_32x32x16_bf16(__builtin_bit_cast(pg8::bf16x8, vw), pf, ot[dvb], 0, 0, 0); } }
                }
            }
            const float ltot = lrun + __shfl_xor(lrun, 32); const float il = 1.0f / ltot;
            __syncthreads();
            if (comp == 1) {
#pragma unroll
                for (int dvb = 0; dvb < 2; ++dvb)
#pragma unroll
                    for (int e = 0; e < 16; ++e) Xl[(qs * 32 + dvb * 16 + e) * 64 + lane] = ot[dvb][e] * il; }
            __syncthreads();
            if (comp == 0) {
                float o[32]; float ss = 0.f;
#pragma unroll
                for (int dvb = 0; dvb < 2; ++dvb)
#pragma unroll
                    for (int e = 0; e < 16; ++e) { const float v = ot[dvb][e] * il - lam * Xl[(qs * 32 + dvb * 16 + e) * 64 + lane]; o[dvb * 16 + e] = v; ss += v * v; }
                ss += __shfl_xor(ss, 32);
                const float sc = rsqrtf(ss * (1.0f / 64.0f) + 1e-6f) * (1.0f - lam_init);
                bf16_t* od = br + (rowb + q0 + r) * D + 256 + h * 64;
#pragma unroll
                for (int dvb = 0; dvb < 2; ++dvb)
#pragma unroll
                    for (int g4 = 0; g4 < 4; ++g4) { const int dv0 = dvb * 32 + 8 * g4 + 4 * hg; const pg8::f32x4 sl = *(const pg8::f32x4*)(subln + dv0);
                        st_bf16x4(od + dv0, (pg8::f32x4){o[dvb * 16 + 4 * g4] * sc * sl[0], o[dvb * 16 + 4 * g4 + 1] * sc * sl[1], o[dvb * 16 + 4 * g4 + 2] * sc * sl[2], o[dvb * 16 + 4 * g4 + 3] * sc * sl[3]}); }
            }
            __syncthreads();
        }
    }
}

__device__ __forceinline__ void ph_branch(Frame& F, ArgsP a, int l) {
    const bf16_t* br = (const bf16_t*)(a->ws + WS_HB); const bf16_t* WB = (const bf16_t*)(a->ws + WS_WB) + (size_t)l * 4096 * 256;
    const bf16_t* proj = (const bf16_t*)(a->ws + WS_PROJ); bf16_t* MB = (bf16_t*)(a->ws + SCR_MB);
    int tid = F.wave * 64 + F.lane(); asm volatile("" : "+v"(tid)); const int lane = tid & 63;
    const int r = lane & 31, hg = lane >> 5, wt = (tid >> 6) & 3, wd = tid >> 8;
    constexpr int RS = 72, TB = 128 * RS;
    LAS bf16_t* Wl = (LAS bf16_t*)F.lds;
    LAS bf16_t* Bl = Wl + 2 * TB;
    const int ldr = tid >> 3, ldc = (tid & 7) * 8;
    for (int it = blockIdx.x; it < 1024; it += F.G) {
        const int tm = it >> 3, td = it & 7; const size_t row0 = (size_t)tm * 128; const int d0 = td * 128;
        f32x16 tot[2], acc[2];
#pragma unroll
        for (int e = 0; e < 16; ++e) { tot[0][e] = 0.f; tot[1][e] = 0.f; acc[0][e] = 0.f; acc[1][e] = 0.f; }
        pg8::u32x4 rw0, rw1, rb0, rb1;
#define BR_LOAD(st) do { const int g_ = (st) >> 2, kq_ = (st) & 3; const bf16_t* wp = WB + (size_t)(g_ * 1024 + d0 + ldr) * 256 + kq_ * 64 + ldc; const bf16_t* bp = br + (row0 + ldr) * D + g_ * 256 + kq_ * 64 + ldc; \
            rw0 = *(const pg8::u32x4*)wp; rw1 = *(const pg8::u32x4*)(wp + 64 * 256); rb0 = *(const pg8::u32x4*)bp; rb1 = *(const pg8::u32x4*)(bp + 64 * D); } while (0)
#define BR_WRITE(buf) do { *(LAS pg8::u32x4*)(Wl + (buf) * TB + ldr * RS + ldc) = rw0; *(LAS pg8::u32x4*)(Wl + (buf) * TB + (ldr + 64) * RS + ldc) = rw1; \
            *(LAS pg8::u32x4*)(Bl + (buf) * TB + ldr * RS + ldc) = rb0; *(LAS pg8::u32x4*)(Bl + (buf) * TB + (ldr + 64) * RS + ldc) = rb1; } while (0)
        BR_LOAD(0); BR_WRITE(0); __syncthreads(); BR_LOAD(1);
        pg8::u32x2 gt[2][4];
#pragma unroll 1
        for (int st = 0; st < 16; ++st) {
            const int buf = st & 1, g = st >> 2;
            if ((st & 3) == 0) {
                const bf16_t* gp = proj + (row0 + wt * 32 + r) * PW + P_GATE + g * 1024 + d0 + wd * 64 + 4 * hg;
#pragma unroll
                for (int db = 0; db < 2; ++db)
#pragma unroll
                    for (int q = 0; q < 4; ++q) gt[db][q] = *(const pg8::u32x2*)(gp + db * 32 + 8 * q); }
#pragma unroll
            for (int s = 0; s < 4; ++s) { const pg8::bf16x8 bf = *(const LAS pg8::bf16x8*)(Bl + buf * TB + (wt * 32 + r) * RS + 16 * s + 8 * hg);
#pragma unroll
                for (int db = 0; db < 2; ++db) { const pg8::bf16x8 af = *(const LAS pg8::bf16x8*)(Wl + buf * TB + (wd * 64 + db * 32 + r) * RS + 16 * s + 8 * hg);
                    acc[db] = __builtin_amdgcn_mfma_f32_32x32x16_bf16(af, bf, acc[db], 0, 0, 0); } }
            if (st + 1 < 16) BR_WRITE(buf ^ 1);
            if (st + 2 < 16) BR_LOAD(st + 2);
            if ((st & 3) == 3) {
#pragma unroll
                for (int db = 0; db < 2; ++db)
#pragma unroll
                    for (int q = 0; q < 4; ++q) { const pg8::u32x2 w = gt[db][q];
                        const float g0 = __builtin_bit_cast(float, w.x << 16), g1 = __builtin_bit_cast(float, w.x & 0xffff0000u), g2 = __builtin_bit_cast(float, w.y << 16), g3 = __builtin_bit_cast(float, w.y & 0xffff0000u);
                        tot[db][4 * q] += acc[db][4 * q] * sigm(g0); tot[db][4 * q + 1] += acc[db][4 * q + 1] * sigm(g1); tot[db][4 * q + 2] += acc[db][4 * q + 2] * sigm(g2); tot[db][4 * q + 3] += acc[db][4 * q + 3] * sigm(g3);
                        acc[db][4 * q] = 0.f; acc[db][4 * q + 1] = 0.f; acc[db][4 * q + 2] = 0.f; acc[db][4 * q + 3] = 0.f; } }
            __syncthreads();
        }
#undef BR_LOAD
#undef BR_WRITE
        bf16_t* mp = MB + (row0 + wt * 32 + r) * D + d0 + wd * 64 + 4 * hg;
#pragma unroll
        for (int db = 0; db < 2; ++db)
#pragma unroll
            for (int q = 0; q < 4; ++q) st_bf16x4(mp + db * 32 + 8 * q, (pg8::f32x4){tot[db][4 * q], tot[db][4 * q + 1], tot[db][4 * q + 2], tot[db][4 * q + 3]});
    }
}
constexpr int RING_BYTES = 131072, LDSCTL_OFF = RING_BYTES, MISC_OFF = LDSCTL_OFF + 320, LDS_BYTES = 147456;
constexpr int PH_PRO = 0, PH_H0 = 1, PH_L0 = 2, PH_PER_LAYER = 12, PH_END = PH_L0 + 2 * PH_PER_LAYER;
constexpr int PL_PROJ = 0, PL_MIXA = 1, PL_MIXB = 2, PL_MIXC = 3, PL_BRANCH = 4, PL_OUT = 5, PL_ROWMIX = 6, PL_FFN1 = 7, PL_FFN2 = 8, PL_FFN3 = 9, PL_ROWFFN = 10;

#ifndef DUPMASK
#define DUPMASK 0
#endif
#define DUP(bit) for (int dup_ = 0; dup_ < (((DUPMASK) >> (bit)) & 1) + 1; ++dup_)
__global__ void __launch_bounds__(NTHR, 2) mk_fwd(Args a) {
    extern __shared__ __attribute__((aligned(16))) unsigned char lds_raw[];
    Frame F0;
    F0.lds = (LAS unsigned char*)lds_raw;
    F0.wave = __builtin_amdgcn_readfirstlane(threadIdx.x >> 6);
    F0.G = gridDim.x; F0.gw = blockIdx.x * NWAVES + F0.wave; F0.NGW = F0.G * NWAVES;
    volatile LAS unsigned* MISC = (volatile LAS unsigned*)(F0.lds + MISC_OFF);
    for (int u = threadIdx.x; u < (LDS_BYTES - LDSCTL_OFF) / 4; u += NTHR) ((LAS unsigned*)(F0.lds + LDSCTL_OFF))[u] = 0u;
    __syncthreads();
    unsigned* ctl = (unsigned*)(a.ws + WS_CTL);
    const int lo = a.ph_lo, hi = a.ph_hi;
    XcdBarrier bar; bar.bar = ctl + CW_BAR; bar.x = 0; bar.st = nullptr;
    if (hi - lo > 1) bar = xcd_barrier_post(ctl + CW_BAR, MISC + 8);
#define IN(k) (lo <= (k) && (k) < hi)
#define SEAM(k) do { if (IN(k) && IN((k) + 1)) { xcd_barrier(bar); if ((DUPMASK >> 12) & 1) xcd_barrier(bar); } } while (0)
    if (IN(PH_PRO)) DUP(0) { ArgsP A = fresh_args(); Frame F = fresh(F0); p0_mod_items(F, (const float*)A->in[1], (const float*)A->in[3], (const float*)A->in[4], (float*)(A->ws + WS_MOD)); p0_convert(F, A); }
    SEAM(PH_PRO);
    if (IN(PH_H0)) DUP(9) { Frame F = fresh(F0); ph_h0(F, fresh_args()); }
    SEAM(PH_H0);
    for (int l = 0; l < NL; ++l) {
        const int base = PH_L0 + l * PH_PER_LAYER;
        if (IN(base + PL_PROJ)) DUP(13) { ArgsP A = fresh_args(); Frame F = fresh(F0); unsigned char* ws = A->ws;
            pg8::Gemm g{(const bf16_t*)(ws + WS_HB), (const bf16_t*)(ws + WS_WIN) + (size_t)l * PW * 1024, 1024, 1024, 1024, 0}; pg8::StaticOrder S; S.init(M, PW, F.G, (int)blockIdx.x);
            pg8::EpiBf16 E{(bf16_t*)(ws + WS_PROJ), PW, 29};
            pg8::gemm_phase<pg8::EpiBf16, pg8::StaticOrder, true>(F.lds, g, S, E, F.wave);
        }
        SEAM(base + PL_PROJ);
        if (IN(base + PL_MIXA)) { DUP(2) { Frame F = fresh(F0); ph_conv(F, fresh_args(), l); } DUP(6) { Frame F = fresh(F0); ph_rwkv_prep(F, fresh_args(), l); } DUP(7) { Frame F = fresh(F0); ph_gla_p1(F, fresh_args(), l); } DUP(8) { Frame F = fresh(F0); ph_attn_prep(F, fresh_args()); } }
        SEAM(base + PL_MIXA);
        if (IN(base + PL_MIXB)) { DUP(10) { Frame F = fresh(F0); ph_gla_prefix(F, fresh_args()); } DUP(3) { Frame F = fresh(F0); ph_rwkv_scan(F, fresh_args()); } DUP(4) { Frame F = fresh(F0); ph_attn(F, fresh_args(), l); } }
        SEAM(base + PL_MIXB);
        if (IN(base + PL_MIXC)) { DUP(5) { Frame F = fresh(F0); ph_rwkv_post(F, fresh_args(), l); } DUP(11) { Frame F = fresh(F0); ph_gla_p2(F, fresh_args(), l); } }
        SEAM(base + PL_MIXC);
        if (IN(base + PL_BRANCH)) DUP(14) { ArgsP A = fresh_args(); Frame F = fresh(F0); unsigned char* ws = A->ws;
            pg8::Gemm g{(const bf16_t*)(ws + WS_HB), (const bf16_t*)(ws + WS_WB) + (size_t)l * 1024 * 1024, 1024, 1024, 1024, 0}; pg8::StaticOrder S; S.init(M, 1024, F.G, (int)blockIdx.x);
            pg8::EpiBranchK E{(const bf16_t*)(ws + WS_PROJ), (bf16_t*)(ws + SCR_MB)};
            pg8::gemm_phase<pg8::EpiBranchK, pg8::StaticOrder, false>(F.lds, g, S, E, F.wave);
        }
        SEAM(base + PL_BRANCH);
        if (IN(base + PL_OUT)) DUP(1) { ArgsP A = fresh_args(); Frame F = fresh(F0); unsigned char* ws = A->ws;
            pg8::Gemm g{(const bf16_t*)(ws + SCR_MB), (const bf16_t*)(ws + WS_WO) + (size_t)l * 1024 * 1024, 1024, 1024, 1024, 0}; pg8::StaticOrder S; S.init(M, 1024, F.G, (int)blockIdx.x);
            pg8::EpiBf16 E{(bf16_t*)(ws + SCR_Y), 1024, 4};
            pg8::gemm_phase<pg8::EpiBf16, pg8::StaticOrder, false>(F.lds, g, S, E, F.wave);
        }
        SEAM(base + PL_OUT);
        if (IN(base + PL_ROWMIX)) { ArgsP A = fresh_args(); Frame F = fresh(F0); unsigned char* ws = A->ws; const float* modl = (const float*)(ws + WS_MOD) + (size_t)l * 8 * 6144;
            ph_row(F, A, l == 0 ? (const float*)A->in[0] : A->out, (const bf16_t*)(ws + SCR_Y), (const float*)A->in[6] + l * D, modl, 2048, (const float*)A->in[7] + l * D, modl, 3072, 4096, (bf16_t*)(ws + (l == 0 ? WS_HB : WS_H2L1)), l == 1); }
        SEAM(base + PL_ROWMIX);
        if (l == 0) {
            if (IN(base + PL_FFN1)) DUP(1) { ArgsP A = fresh_args(); Frame F = fresh(F0); unsigned char* ws = A->ws;
                pg8::Gemm g{(const bf16_t*)(ws + WS_HB), (const bf16_t*)(ws + WS_WF1), 1024, 1024, 1024, 0}; pg8::StaticOrder S; S.init(M, 2 * DFF, F.G, (int)blockIdx.x);
                pg8::EpiSwiglu E{(bf16_t*)(ws + WS_PROJ), DFF, 2 * DFF / 256};
                pg8::gemm_phase<pg8::EpiSwiglu, pg8::StaticOrder, true>(F.lds, g, S, E, F.wave);
            }
            SEAM(base + PL_FFN1);
            if (IN(base + PL_FFN2)) DUP(1) { ArgsP A = fresh_args(); Frame F = fresh(F0); unsigned char* ws = A->ws;
                pg8::Gemm g{(const bf16_t*)(ws + WS_PROJ), (const bf16_t*)(ws + WS_WF2), DFF, DFF, DFF, 0}; pg8::StaticOrder S; S.init(M, 1024, F.G, (int)blockIdx.x);
                pg8::EpiBf16 E{(bf16_t*)(ws + SCR_Y), 1024, 4};
                pg8::gemm_phase<pg8::EpiBf16, pg8::StaticOrder, false>(F.lds, g, S, E, F.wave);
            }
            SEAM(base + PL_FFN2);
        } else {
            if (IN(base + PL_FFN1)) DUP(0) { Frame F = fresh(F0); ph_moe_prep(F, fresh_args()); }
            SEAM(base + PL_FFN1);
            if (IN(base + PL_FFN2)) DUP(15) { ArgsP A = fresh_args(); Frame F = fresh(F0); unsigned char* ws = A->ws; const unsigned* cnt = (const unsigned*)(ws + WS_CTL) + CW_CNT;
                pg8::Gemm g{(const bf16_t*)(ws + WS_HG), (const bf16_t*)(ws + WS_WM1), 1024, 1024, 1024, 0}; pg8::MoeOrder S; S.init(cnt, F.G, (int)blockIdx.x, 28);
                pg8::EpiSwiglu E{(bf16_t*)(ws + WS_HID), DEX, 28};
                pg8::gemm_phase<pg8::EpiSwiglu, pg8::MoeOrder, true>(F.lds, g, S, E, F.wave);
            }
            SEAM(base + PL_FFN2);
            if (IN(base + PL_FFN3)) DUP(16) { ArgsP A = fresh_args(); Frame F = fresh(F0); unsigned char* ws = A->ws; const unsigned* cnt = (const unsigned*)(ws + WS_CTL) + CW_CNT;
                pg8::Gemm g{(const bf16_t*)(ws + WS_HID), (const bf16_t*)(ws + WS_WM2), DEX, DEX, DEX, 0}; pg8::MoeOrder S; S.init(cnt, F.G, (int)blockIdx.x, 4);
                pg8::EpiBf16 E{(bf16_t*)(ws + WS_HG), 1024, 4};
                pg8::gemm_phase<pg8::EpiBf16, pg8::MoeOrder, true>(F.lds, g, S, E, F.wave);
            }
            SEAM(base + PL_FFN3);
        }
        if (IN(base + PL_ROWFFN)) { ArgsP A = fresh_args(); Frame F = fresh(F0); unsigned char* ws = A->ws; const float* modl = (const float*)(ws + WS_MOD) + (size_t)l * 8 * 6144;
            const bool last = (l == NL - 1);
            if (l == 0) ph_row(F, A, A->out, (const bf16_t*)(ws + SCR_Y), (const float*)A->in[8], modl, 5120, (const float*)A->in[5] + D, modl + 8 * 6144, 0, 1024, (bf16_t*)(ws + WS_HB), false, nullptr);
            else ph_row(F, A, A->out, nullptr, (const float*)A->in[8] + D, modl, 5120, nullptr, nullptr, 0, 1024, nullptr, false, (const bf16_t*)(ws + WS_HG));
        }
        SEAM(base + PL_ROWFFN);
    }
#undef IN
#undef SEAM
}

extern "C" void kernel_launch(void* const* d_in, const int* in_sizes, int n_in, void* d_out, int out_size, void* d_ws, size_t ws_size, hipStream_t stream) {
    static int grid = 0;
    if (grid == 0) {
        if (n_in != 40 || ws_size < WS_END) { fprintf(stderr, "kernel_launch: need 40 inputs and >= %zu bytes of workspace (got %d, %zu)\n", (size_t)WS_END, n_in, ws_size); grid = -1; return; }
        int dev = 0, cus = 0, per_cu = 0;
        (void)hipGetDevice(&dev); (void)hipDeviceGetAttribute(&cus, hipDeviceAttributeMultiprocessorCount, dev);
        (void)hipFuncSetAttribute((const void*)mk_fwd, hipFuncAttributeMaxDynamicSharedMemorySize, LDS_BYTES);
        (void)hipOccupancyMaxActiveBlocksPerMultiprocessor(&per_cu, (const void*)mk_fwd, NTHR, LDS_BYTES);
        (void)hipGetLastError();
        grid = cus > 0 ? cus : 256;
        if (per_cu < 1) fprintf(stderr, "kernel_launch: occupancy query says %d blocks per CU\n", per_cu);
    }
    if (grid < 0) return;
    unsigned char* ws = (unsigned char*)d_ws;
    (void)hipMemsetAsync(ws + WS_CTL, 0, CTL_ZERO_BYTES, stream);
    Args a{};
    for (int i = 0; i < 40; ++i) a.in[i] = d_in[i];
    a.out = (float*)d_out; a.ws = ws;
    a.ph_lo = 0; a.ph_hi = PH_L0 + (NL - 1) * PH_PER_LAYER + PL_ROWFFN + 1;
    hipLaunchKernelGGL(mk_fwd, dim3(grid), dim3(NTHR), LDS_BYTES, stream, a);
}
```

```cpp
#include <hip/hip_runtime.h>
#include <hip/hip_bf16.h>
#include <cstdint>
#include <cstdio>

typedef __hip_bfloat16 bf16;
typedef unsigned short bf16_t;
#define GAS __attribute__((address_space(1)))
#define LAS __attribute__((address_space(3)))

constexpr int D = 1024, NB = 8, T = 2048, M = NB * T, NL = 2;
constexpr int NIN = 7184;
constexpr int PW = 7424;
constexpr int P_GQ = 0, P_GK = 128, P_GV = 256, P_GO = 512, P_DQ = 768, P_DK = 1024, P_DV = 1280, P_CA = 1536, P_CB = 1792, P_R = 2048, P_GATE = 3072, P_GZ = 7168;
constexpr int DFF = 2816, NE = 8, DEX = 3584;
constexpr int NWAVES = 8, NTHR = 512;
constexpr size_t MiB = 1u << 20;
constexpr size_t WS_CTL = 0;
constexpr size_t CTL_ZERO_BYTES = 64 * 1024;
constexpr size_t WS_MOD = 1 * MiB;
constexpr size_t WS_ROUTE = 1 * MiB + 512 * 1024;
constexpr size_t WS_GZ = 2 * MiB + 512 * 1024;
constexpr size_t WS_LR = 3 * MiB;
constexpr size_t WS_WIN = 4 * MiB;
constexpr size_t WS_WB = 33 * MiB;
constexpr size_t WS_WO = 37 * MiB;
constexpr size_t WS_WF1 = 41 * MiB;
constexpr size_t WS_WF2 = 52 * MiB;
constexpr size_t WS_HB = 58 * MiB;
constexpr size_t WS_PROJ = 90 * MiB;
constexpr size_t WS_SCR = 322 * MiB;
constexpr size_t WS_H2L1 = 508 * MiB;
constexpr size_t WS_END = 540 * MiB;
constexpr size_t WS_HG = 4 * MiB;
constexpr size_t WS_WM1 = 72 * MiB;
constexpr size_t WS_WM2 = 184 * MiB;
constexpr size_t WS_HID = 240 * MiB;
static_assert(WS_HID + (size_t)34816 * 3584 * 2 <= WS_H2L1, "moe overlay");
constexpr size_t SCR_MP = WS_SCR;
constexpr size_t SCR_MB = WS_SCR + 64 * MiB;
constexpr size_t SCR_Y = WS_SCR + 96 * MiB;
constexpr size_t SCR_RW = WS_SCR;
constexpr size_t SCR_GK = WS_SCR + 112 * MiB;
constexpr size_t SCR_QR = WS_SCR + 120 * MiB;
constexpr size_t SCR_KR = WS_SCR + 136 * MiB;
constexpr size_t SCR_VEC6 = WS_SCR;
constexpr size_t SCR_SC = WS_SCR + 112 * MiB;
constexpr size_t SCR_YR = WS_SCR + 113 * MiB;
constexpr size_t SCR_GR = WS_SCR + 129 * MiB;
constexpr size_t SCR_VT = WS_SCR + 137 * MiB;
constexpr size_t SCR_GU = WS_SCR + 145 * MiB;
constexpr size_t SCR_GS = SCR_GU;
constexpr size_t SCR_QK = WS_SCR + 161 * MiB;
constexpr size_t SCR_EG = WS_SCR + 177 * MiB;
constexpr size_t WS_GOI = WS_H2L1;
constexpr size_t WS_GST = WS_H2L1 + 16 * MiB;
constexpr int VSTEP = 448;
constexpr int CW_TMO = 0;
constexpr int CW_BAR = 1024;
constexpr int CW_CNT = 8192;
constexpr size_t RT_LIST = 0;
constexpr size_t RT_TOKE = 512 * 1024;
constexpr size_t RT_TOKS = 640 * 1024;
constexpr size_t RT_TOKP = 768 * 1024;

__device__ __forceinline__ float sigm(float x) { return 1.0f / (1.0f + __expf(-x)); }
__device__ __forceinline__ float siluf(float x) { return x * sigm(x); }
__device__ __forceinline__ float softplusf(float x) { return fmaxf(x, 0.f) + log1pf(__expf(-fabsf(x))); }
__device__ __forceinline__ float wave_sum(float v) {
#pragma unroll
    for (int o = 32; o > 0; o >>= 1) v += __shfl_xor(v, o);
    return v;
}
__device__ __forceinline__ float wave_max(float v) {
#pragma unroll
    for (int o = 32; o > 0; o >>= 1) v = fmaxf(v, __shfl_xor(v, o));
    return v;
}
__device__ __forceinline__ float ldf(const float* p) { return *p; }
__device__ __forceinline__ float ldf(const bf16* p) { return __bfloat162float(*p); }
__device__ __forceinline__ float bf2f(bf16_t u) { return __builtin_bit_cast(float, (unsigned)u << 16); }
__device__ __forceinline__ unsigned f2bf(float f) { unsigned u = __builtin_bit_cast(unsigned, f); return (u + 0x7fffu + ((u >> 16) & 1u)) >> 16; }
__device__ __forceinline__ unsigned pk2(float lo, float hi) { return f2bf(lo) | (f2bf(hi) << 16); }
namespace pg8 {
#define PG8_LAS __attribute__((address_space(3)))
typedef short bf16x8 __attribute__((ext_vector_type(8)));
typedef float f32x4 __attribute__((ext_vector_type(4)));
typedef float f32x2 __attribute__((ext_vector_type(2)));
typedef unsigned u32x4 __attribute__((ext_vector_type(4)));
typedef unsigned u32x2 __attribute__((ext_vector_type(2)));
constexpr int BM = 256, BK = 64, HALF = 128, HTB = HALF * BK * 2  , STAGE_BYTES = 8 * HTB, NXCD = 8, WGM = 8;

__host__ __device__ __forceinline__ int lds_byte(int r, int c) { const int st = (r >> 4) * 2 + (c >> 5), rr = r & 15, cc = c & 31, ob = rr * 64 + cc * 2; return st * 1024 + (ob ^ (((ob >> 9) & 1) << 5)); }
__host__ __device__ __forceinline__ void stage_rc(int b, int& R, int& C) { const int st = b / 1024, sb = b % 1024, swz = sb ^ (((sb >> 9) & 1) << 5); R = (st >> 1) * 16 + swz / 64; C = (st & 1) * 32 + (swz % 64) / 2; }
__host__ __device__ __forceinline__ int perm32(int rho) { const int n = rho >> 4, i = rho & 15; return 8 * (i >> 2) + 4 * n + (i & 3); }

struct Unit { int pm, pn, aoff, tag; };
struct Gemm { const bf16_t* A; const bf16_t* Bt; int lda, ldb, K, pad; };

struct StaticOrder {
    int nM, nN, nwg, G, c;
    __host__ __device__ void init(int M_, int N_, int G_, int c_) { nM = M_ / BM; nN = N_ / BM; nwg = nM * nN; G = G_; c = c_; }
    __host__ __device__ bool next(int i, Unit& u) const {
        const long L = (long)i * G + c; if (L >= nwg) return false;
        int wgid = (int)L; { const int q = nwg / NXCD, r = nwg % NXCD, xcd = wgid % NXCD, off = wgid / NXCD; wgid = (xcd < r ? xcd * (q + 1) : r * (q + 1) + (xcd - r) * q) + off; }
        const int nig = WGM * nN, gid = wgid / nig, fm = gid * WGM, gsz = (nM - fm) < WGM ? (nM - fm) : WGM;
        u.pm = fm + ((wgid % nig) % gsz); u.pn = (wgid % nig) / gsz; u.aoff = 0; u.tag = 0; return true;
    }
};

__device__ __forceinline__ unsigned cvt_pk_bf16(float lo, float hi) { unsigned r; asm volatile("v_cvt_pk_bf16_f32 %0, %1, %2" : "=v"(r) : "v"(lo), "v"(hi)); return r; }


template <class Epi, class Sched, bool ALIGN_EPI>
__device__ __forceinline__ void gemm_phase(PG8_LAS unsigned char* lds, const Gemm g, const Sched& S, const Epi& E, int wave_s) {
    unsigned z_ = 0u; asm volatile("" : "+v"(z_));
    int tid_ = wave_s * 64 + (int)__builtin_amdgcn_mbcnt_hi(~0u, __builtin_amdgcn_mbcnt_lo(~0u, z_)); asm volatile("" : "+v"(tid_));
    const int tid = tid_, wid = __builtin_amdgcn_readfirstlane(tid >> 6), lane = tid & 63, wr = wid >> 2, wc = wid & 3, fr = lane & 15, fq = lane >> 4;
    const int K = g.K, nt = K / BK;
    unsigned voffA[2], voffB[2];
#pragma unroll
    for (int i = 0; i < 2; ++i) { int R, C; stage_rc(tid * 16 + i * 8192, R, C); const int Rb = Epi::PERM ? ((R & ~31) + perm32(R & 31)) : R;
        voffA[i] = (unsigned)(R * g.lda + C) * 2u; voffB[i] = (unsigned)(Rb * g.ldb + C) * 2u; }
    const size_t kstep = (size_t)(BK * 2);
    const size_t hstepA = (size_t)HALF * g.lda * 2, hstepB = (size_t)HALF * g.ldb * 2;
    const size_t tstepA = 2 * hstepA, tstepB = 2 * hstepB;
    const unsigned ldsw = (unsigned)wid * 1024u;
    const int aoff = lds_byte(wr * 64 + fr, fq * 8), boff = lds_byte(wc * 32 + fr, fq * 8);
#define PG8_SA(b, h) (((b) * 2 + (h)) * HTB)
#define PG8_SB(b, h) ((4 + (b) * 2 + (h)) * HTB)
#define PG8_STAGE(bufoff, gbase, voff) do { _Pragma("unroll") for (int _i = 0; _i < 2; ++_i) \
        __builtin_amdgcn_global_load_lds((const unsigned*)((const char*)(gbase) + (voff)[_i]), (PG8_LAS unsigned*)(lds + (bufoff) + ldsw + _i * 8192), 16, 0, 0); } while (0)
#define PG8_LDA(dst, b, h) do { _Pragma("unroll") for (int m = 0; m < 4; ++m) _Pragma("unroll") for (int k = 0; k < 2; ++k) dst[m][k] = *(const PG8_LAS bf16x8*)(lds + PG8_SA(b, h) + aoff + m * 2048 + k * 1024); } while (0)
#define PG8_LDB(dst, b, h) do { _Pragma("unroll") for (int n = 0; n < 2; ++n) _Pragma("unroll") for (int k = 0; k < 2; ++k) dst[n][k] = *(const PG8_LAS bf16x8*)(lds + PG8_SB(b, h) + boff + n * 2048 + k * 1024); } while (0)
#define PG8_MMA(ai, bj, At, Bt) do { __builtin_amdgcn_s_setprio(1); _Pragma("unroll") for (int m = 0; m < 4; ++m) _Pragma("unroll") for (int n = 0; n < 2; ++n) _Pragma("unroll") for (int k = 0; k < 2; ++k) \
        acc[ai][bj][m][n] = __builtin_amdgcn_mfma_f32_16x16x32_bf16(Bt[n][k], At[m][k], acc[ai][bj][m][n], 0, 0, 0); __builtin_amdgcn_s_setprio(0); } while (0)
#define PG8_WAIT_V(n) asm volatile("s_waitcnt vmcnt(" #n ")" ::: "memory")
#define PG8_WAIT_L(n) asm volatile("s_waitcnt lgkmcnt(" #n ")" ::: "memory")
#define PG8_BAR __builtin_amdgcn_s_barrier()
#define PG8_SCHED __builtin_amdgcn_sched_barrier(0)
    Unit cur, nxt; int ui = 0;
    if (!S.next(0, cur)) return;
    f32x4 acc[2][2][4][2];
#pragma unroll
    for (int a = 0; a < 2; ++a)
#pragma unroll
        for (int b = 0; b < 2; ++b)
#pragma unroll
            for (int m = 0; m < 4; ++m)
#pragma unroll
                for (int n = 0; n < 2; ++n) acc[a][b][m][n] = (f32x4){0.f, 0.f, 0.f, 0.f};
    bf16x8 At[4][2], B0[2][2], B1[2][2];
    const char* cA = (const char*)g.A + (size_t)cur.pm * tstepA + (size_t)cur.aoff * 2; const char* cB = (const char*)g.Bt + (size_t)cur.pn * tstepB;
    PG8_STAGE(PG8_SB(0, 0), cB, voffB); PG8_STAGE(PG8_SB(0, 1), cB + hstepB, voffB); PG8_STAGE(PG8_SA(0, 0), cA, voffA); PG8_STAGE(PG8_SA(0, 1), cA + hstepA, voffA);
    if (wr == 1) PG8_BAR;
    PG8_WAIT_V(2); PG8_BAR;
    PG8_STAGE(PG8_SB(1, 0), cB + kstep, voffB); PG8_STAGE(PG8_SA(1, 0), cA + kstep, voffA); PG8_STAGE(PG8_SB(1, 1), cB + hstepB + kstep, voffB);
    PG8_WAIT_V(6); PG8_BAR;
    for (;;) {
        const bool has_next = S.next(ui + 1, nxt);
        const char* nA = has_next ? (const char*)g.A + (size_t)nxt.pm * tstepA + (size_t)nxt.aoff * 2 : cA; const char* nB = has_next ? (const char*)g.Bt + (size_t)nxt.pn * tstepB : cB;
        for (int t = 0; t < nt; t += 2) {
            if constexpr (Epi::MIDK) { if (t != 0 && (t & 3) == 0) E.mid(acc, cur, t >> 2, wr, wc); }
            const bool last = (t == nt - 2);
            const char* a1 = cA + (size_t)(t + 1) * kstep;
            const char* a2 = last ? nA : cA + (size_t)(t + 2) * kstep; const char* b2 = last ? nB : cB + (size_t)(t + 2) * kstep;
            const char* a3 = a2 + kstep; const char* b3 = b2 + kstep;
            PG8_LDB(B0, 0, 0); PG8_LDB(B1, 0, 1); PG8_SCHED; PG8_LDA(At, 0, 0); PG8_STAGE(PG8_SA(1, 1), a1 + hstepA, voffA);
            PG8_WAIT_V(8); PG8_WAIT_L(0); PG8_BAR; PG8_MMA(0, 0, At, B0); PG8_MMA(0, 1, At, B1); PG8_BAR; PG8_SCHED;
            PG8_LDA(At, 0, 1); PG8_STAGE(PG8_SB(0, 0), b2, voffB); PG8_STAGE(PG8_SB(0, 1), b2 + hstepB, voffB); PG8_STAGE(PG8_SA(0, 0), a2, voffA);
            PG8_WAIT_V(8); PG8_WAIT_L(0); PG8_BAR; PG8_MMA(1, 0, At, B0); PG8_MMA(1, 1, At, B1); PG8_BAR; PG8_SCHED;
            PG8_LDB(B0, 1, 0); PG8_LDB(B1, 1, 1); PG8_SCHED; PG8_LDA(At, 1, 0); PG8_STAGE(PG8_SA(0, 1), a2 + hstepA, voffA);
            PG8_WAIT_V(8); PG8_WAIT_L(0); PG8_BAR; PG8_MMA(0, 0, At, B0); PG8_MMA(0, 1, At, B1); PG8_BAR; PG8_SCHED;
            PG8_LDA(At, 1, 1); PG8_STAGE(PG8_SB(1, 0), b3, voffB); PG8_STAGE(PG8_SB(1, 1), b3 + hstepB, voffB); PG8_STAGE(PG8_SA(1, 0), a3, voffA);
            PG8_WAIT_V(8); PG8_WAIT_L(0); PG8_BAR; PG8_MMA(1, 0, At, B0); PG8_MMA(1, 1, At, B1); PG8_BAR; PG8_SCHED;
        }
        if constexpr (ALIGN_EPI) { if (wr == 0) PG8_BAR; }
        { unsigned z2_ = 0u; asm volatile("" : "+v"(z2_)); const int l2_ = (int)__builtin_amdgcn_mbcnt_hi(~0u, __builtin_amdgcn_mbcnt_lo(~0u, z2_));
          E(acc, cur, wr, wc, l2_ & 15, l2_ >> 4); }
        if (!has_next) break;
#pragma unroll
        for (int a = 0; a < 2; ++a)
#pragma unroll
            for (int b = 0; b < 2; ++b)
#pragma unroll
                for (int m = 0; m < 4; ++m)
#pragma unroll
                    for (int n = 0; n < 2; ++n) acc[a][b][m][n] = (f32x4){0.f, 0.f, 0.f, 0.f};
        cur = nxt; cA = nA; cB = nB; ++ui;
        if constexpr (ALIGN_EPI) { if (wr == 1) PG8_BAR; }
    }
    PG8_WAIT_V(0);
    if constexpr (!ALIGN_EPI) { if (wr == 0) PG8_BAR; }
    PG8_BAR;
#undef PG8_SA
#undef PG8_SB
#undef PG8_STAGE
#undef PG8_LDA
#undef PG8_LDB
#undef PG8_MMA
#undef PG8_WAIT_V
#undef PG8_WAIT_L
#undef PG8_BAR
#undef PG8_SCHED
}

struct EpiBf16 {
    static constexpr bool PERM = true, MIDK = false;
    bf16_t* O; int ldc; int ntn;
    __device__ __forceinline__ void operator()(const f32x4 (&acc)[2][2][4][2], const Unit& u, int wr, int wc, int fr, int fq) const {
        const int row0 = u.pm * BM + wr * 64 + fr, col0 = (u.pn % ntn) * BM + wc * 32 + 8 * fq;
#pragma unroll
        for (int ai = 0; ai < 2; ++ai)
#pragma unroll
            for (int m = 0; m < 4; ++m) { bf16_t* rowp = O + (size_t)(row0 + ai * HALF + m * 16) * ldc + col0;
#pragma unroll
                for (int bj = 0; bj < 2; ++bj) { const f32x4 v0 = acc[ai][bj][m][0], v1 = acc[ai][bj][m][1];
                    u32x4 w; w.x = cvt_pk_bf16(v0[0], v0[1]); w.y = cvt_pk_bf16(v0[2], v0[3]); w.z = cvt_pk_bf16(v1[0], v1[1]); w.w = cvt_pk_bf16(v1[2], v1[3]);
                    *(u32x4*)(rowp + bj * HALF) = w; } }
    }
};
struct EpiF32 {
    static constexpr bool PERM = false, MIDK = false;
    float* C; int ldc; int ntn;
    __device__ __forceinline__ void operator()(const f32x4 (&acc)[2][2][4][2], const Unit& u, int wr, int wc, int fr, int fq) const {
        const int row0 = u.pm * BM + wr * 64 + fr, col0 = (u.pn % ntn) * BM + wc * 32 + 4 * fq;
#pragma unroll
        for (int ai = 0; ai < 2; ++ai)
#pragma unroll
            for (int m = 0; m < 4; ++m) { float* rowp = C + (size_t)(row0 + ai * HALF + m * 16) * ldc + col0;
#pragma unroll
                for (int bj = 0; bj < 2; ++bj)
#pragma unroll
                    for (int n = 0; n < 2; ++n) *(f32x4*)(rowp + bj * HALF + n * 16) = acc[ai][bj][m][n]; }
    }
};
struct EpiSwiglu {
    static constexpr bool PERM = true, MIDK = false;
    bf16_t* O; int ldc; int ntn;
    __device__ __forceinline__ void operator()(const f32x4 (&acc)[2][2][4][2], const Unit& u, int wr, int wc, int fr, int fq) const {
        const int row0 = u.pm * BM + wr * 64 + fr, col0 = (u.pn % ntn) * 128 + wc * 16 + 4 * fq;
#pragma unroll
        for (int ai = 0; ai < 2; ++ai)
#pragma unroll
            for (int m = 0; m < 4; ++m) { bf16_t* rowp = O + (size_t)(row0 + ai * HALF + m * 16) * ldc + col0;
#pragma unroll
                for (int bj = 0; bj < 2; ++bj) { const f32x4 gt = acc[ai][bj][m][0], up = acc[ai][bj][m][1];
                    float h[4];
#pragma unroll
                    for (int e = 0; e < 4; ++e) h[e] = gt[e] * __builtin_amdgcn_rcpf(1.0f + __expf(-gt[e])) * up[e];
                    u32x2 w; w.x = cvt_pk_bf16(h[0], h[1]); w.y = cvt_pk_bf16(h[2], h[3]);
                    *(u32x2*)(rowp + bj * 64) = w; } }
    }
};
struct EpiBranch {
    static constexpr bool PERM = true, MIDK = false;
    const bf16_t* proj; float* MP; bf16_t* MB;
    __device__ __forceinline__ void operator()(const f32x4 (&acc)[2][2][4][2], const Unit& u, int wr, int wc, int fr, int fq) const {
        const int g = u.tag; const int row0 = u.pm * BM + wr * 64 + fr, col0 = (u.pn & 3) * BM + wc * 32 + 8 * fq;
#pragma unroll
        for (int ai = 0; ai < 2; ++ai)
#pragma unroll
            for (int m = 0; m < 4; ++m) { const size_t row = (size_t)(row0 + ai * HALF + m * 16);
#pragma unroll
                for (int bj = 0; bj < 2; ++bj) { const int col = col0 + bj * HALF;
                    const u32x4 gw = *(const u32x4*)(proj + row * PW + P_GATE + g * 1024 + col);
                    float gv[8];
#pragma unroll
                    for (int e = 0; e < 4; ++e) { const unsigned w = gw[e]; gv[2 * e] = __builtin_bit_cast(float, w << 16); gv[2 * e + 1] = __builtin_bit_cast(float, w & 0xffff0000u); }
                    f32x4 v0 = acc[ai][bj][m][0], v1 = acc[ai][bj][m][1];
#pragma unroll
                    for (int e = 0; e < 4; ++e) { v0[e] *= __builtin_amdgcn_rcpf(1.0f + __expf(-gv[e])); v1[e] *= __builtin_amdgcn_rcpf(1.0f + __expf(-gv[4 + e])); }
                    float* mp = MP + row * D + col;
                    if (g > 0) { v0 += *(const f32x4*)mp; v1 += *(const f32x4*)(mp + 4); }
                    if (g < 3) { *(f32x4*)mp = v0; *(f32x4*)(mp + 4) = v1; }
                    else { u32x4 w; w.x = cvt_pk_bf16(v0[0], v0[1]); w.y = cvt_pk_bf16(v0[2], v0[3]); w.z = cvt_pk_bf16(v1[0], v1[1]); w.w = cvt_pk_bf16(v1[2], v1[3]);
                        *(u32x4*)(MB + row * D + col) = w; } } }
    }
};
struct EpiBranchK {
    static constexpr bool PERM = true, MIDK = true;
    const bf16_t* proj; bf16_t* MB;
    __device__ __forceinline__ static float em(float x) { return fminf(__expf(-x), 1e20f); }
    __device__ __forceinline__ void mid(f32x4 (&acc)[2][2][4][2], const Unit& u, int gnext, int wr, int wc) const {
        unsigned z_ = 0u; asm volatile("" : "+v"(z_)); const int l_ = (int)__builtin_amdgcn_mbcnt_hi(~0u, __builtin_amdgcn_mbcnt_lo(~0u, z_)); const int fr = l_ & 15, fq = l_ >> 4;
        const int row0 = u.pm * BM + wr * 64 + fr, col0 = u.pn * BM + wc * 32 + 8 * fq;
#pragma unroll
        for (int ai = 0; ai < 2; ++ai)
#pragma unroll
            for (int m = 0; m < 4; ++m) { const bf16_t* gp = proj + (size_t)(row0 + ai * HALF + m * 16) * PW + P_GATE + (gnext - 1) * 1024 + col0;
#pragma unroll
                for (int bj = 0; bj < 2; ++bj) { const u32x4 g0 = *(const u32x4*)(gp + bj * HALF), g1 = *(const u32x4*)(gp + 1024 + bj * HALF);
#pragma unroll
                    for (int e = 0; e < 4; ++e) { const unsigned a = g0[e], b = g1[e];
                        const float ra = (1.0f + em(__builtin_bit_cast(float, b << 16))) * __builtin_amdgcn_rcpf(1.0f + em(__builtin_bit_cast(float, a << 16)));
                        const float rb = (1.0f + em(__builtin_bit_cast(float, b & 0xffff0000u))) * __builtin_amdgcn_rcpf(1.0f + em(__builtin_bit_cast(float, a & 0xffff0000u)));
                        if (e < 2) { acc[ai][bj][m][0][2 * e] *= ra; acc[ai][bj][m][0][2 * e + 1] *= rb; } else { acc[ai][bj][m][1][2 * (e - 2)] *= ra; acc[ai][bj][m][1][2 * (e - 2) + 1] *= rb; } } } }
    }
    __device__ __forceinline__ void operator()(const f32x4 (&acc)[2][2][4][2], const Unit& u, int wr, int wc, int fr, int fq) const {
        const int row0 = u.pm * BM + wr * 64 + fr, col0 = u.pn * BM + wc * 32 + 8 * fq;
#pragma unroll
        for (int ai = 0; ai < 2; ++ai)
#pragma unroll
            for (int m = 0; m < 4; ++m) { const size_t row = (size_t)(row0 + ai * HALF + m * 16);
#pragma unroll
                for (int bj = 0; bj < 2; ++bj) { const u32x4 gw = *(const u32x4*)(proj + row * PW + P_GATE + 3 * 1024 + col0 + bj * HALF);
                    float sg[8];
#pragma unroll
                    for (int e = 0; e < 4; ++e) { sg[2 * e] = __builtin_amdgcn_rcpf(1.0f + em(__builtin_bit_cast(float, gw[e] << 16))); sg[2 * e + 1] = __builtin_amdgcn_rcpf(1.0f + em(__builtin_bit_cast(float, gw[e] & 0xffff0000u))); }
                    const f32x4 v0 = acc[ai][bj][m][0], v1 = acc[ai][bj][m][1];
                    u32x4 w; w.x = cvt_pk_bf16(v0[0] * sg[0], v0[1] * sg[1]); w.y = cvt_pk_bf16(v0[2] * sg[2], v0[3] * sg[3]); w.z = cvt_pk_bf16(v1[0] * sg[4], v1[1] * sg[5]); w.w = cvt_pk_bf16(v1[2] * sg[6], v1[3] * sg[7]);
                    *(u32x4*)(MB + row * D + col0 + bj * HALF) = w; } }
    }
};
struct BranchOrder {
    int G, c;
    __device__ bool next(int i, Unit& u) const {
        const int tile = (i >> 2) * G + c; if (tile >= 256) return false;
        const int g = i & 3; u.pm = tile >> 2; u.pn = g * 4 + (tile & 3); u.aoff = g * 256; u.tag = g; return true;
    }
};
struct MoeOrder {
    int G, c, ntiles, NT; int toff[9];
    __device__ void init(const unsigned* cnt, int G_, int c_, int NT_) { G = G_; c = c_; NT = NT_; int o = 0;
#pragma unroll
        for (int e = 0; e < 8; ++e) { toff[e] = o; o += ((int)cnt[e] + 255) >> 8; } toff[8] = o; ntiles = o; }
    __device__ bool next(int i, Unit& u) const {
        const int L = i * G + c; if (L >= ntiles * NT) return false;
        const int tau = L % ntiles, pn = L / ntiles; int e = 0;
#pragma unroll
        for (int q = 1; q < 8; ++q) e += (tau >= toff[q]) ? 1 : 0;
        u.pm = tau; u.pn = e * NT + pn; u.aoff = 0; u.tag = e; return true;
    }
};
}
typedef GAS unsigned gu32;
#define RLX_AGENT __ATOMIC_RELAXED, __HIP_MEMORY_SCOPE_AGENT
#define XB_TMO      128
#define XB_XCNT(j)  (256  + 64 * (j))
#define XB_XSUB(j)  (1280 + 64 * (j))
#define XB_XGEN(j)  (2304 + 64 * (j))
#define XB_TOP      3328
#define XB_TOPGEN   3392
#define XCD_BAR_WORDS 3456
#define XB_SPIN_CAP (1u << 18)

__device__ __forceinline__ unsigned xb_ld(unsigned* p)              { return __hip_atomic_load(p, __ATOMIC_RELAXED, __HIP_MEMORY_SCOPE_AGENT); }
__device__ __forceinline__ unsigned xb_add(unsigned* p, unsigned v) { return __hip_atomic_fetch_add(p, v, __ATOMIC_RELAXED, __HIP_MEMORY_SCOPE_AGENT); }
__device__ __forceinline__ unsigned xb_xcc_id() { return (unsigned)__builtin_amdgcn_s_getreg((3 << 11) | 20) & 0xFu; }
#define XB_SPIN(cond, bar) do { unsigned _sp = 0; while (cond) { __builtin_amdgcn_s_sleep(1); \
    if ((++_sp & 255u) == 0u) { if (xb_ld(&(bar)[XB_TMO])) break; if (_sp > XB_SPIN_CAP) { atomicAdd(&(bar)[XB_TMO], 1u); break; } } } } while (0)

struct XcdBarrier {
    unsigned* bar; unsigned x;
    volatile LAS unsigned* st;
};

__device__ __forceinline__ XcdBarrier xcd_barrier_post(unsigned* bar, volatile LAS unsigned* st) {
    XcdBarrier b; b.bar = bar; b.x = xb_xcc_id(); b.st = st;
    if (threadIdx.x == 0) (void)xb_add(&bar[XB_XCNT(b.x)], 1u);
    return b;
}
__device__ __forceinline__ void xcd_barrier_complete(unsigned* bar, unsigned x, unsigned& nloc, unsigned& nx) {
    const unsigned G = gridDim.x * gridDim.y * gridDim.z;
    unsigned sum, cnt, mine, sp = 0u;
    for (;;) {
        sum = 0u; cnt = 0u; mine = 0u;
#pragma unroll
        for (unsigned j = 0; j < 16; ++j) { const unsigned c = xb_ld(&bar[XB_XCNT(j)]); sum += c; cnt += (c > 0u) ? 1u : 0u; mine = (j == x) ? c : mine; }
        if (sum == G) break;
        __builtin_amdgcn_s_sleep(1);
        if ((++sp & 255u) == 0u) { if (xb_ld(&bar[XB_TMO])) break; if (sp > XB_SPIN_CAP) { atomicAdd(&bar[XB_TMO], 1u); break; } }
    }
    nloc = mine > 0u ? mine : 1u; nx = cnt > 0u ? cnt : 1u;
}

__device__ __forceinline__ void xcd_barrier(const XcdBarrier& b) {
    asm volatile("s_waitcnt vmcnt(0)" ::: "memory");
    __syncthreads();
    if (threadIdx.x == 0) {
        unsigned* bar = b.bar;
        __builtin_amdgcn_s_waitcnt(0);
        unsigned nloc = b.st[0], nx = b.st[1];
        if (nloc == 0u) { xcd_barrier_complete(bar, b.x, nloc, nx); b.st[0] = nloc; b.st[1] = nx; }
        const unsigned old = xb_add(&bar[XB_XSUB(b.x)], 1u);
        const unsigned gen = old / nloc;
        if (old + 1u == (gen + 1u) * nloc) {
            __builtin_amdgcn_fence(__ATOMIC_RELEASE, "agent");
            asm volatile("s_waitcnt vmcnt(0)" ::: "memory");
            const unsigned og = xb_add(&bar[XB_TOP], 1u);
            const unsigned tg = og / nx;
            if (og + 1u == (tg + 1u) * nx) xb_add(&bar[XB_TOPGEN], 1u);
            else XB_SPIN(xb_ld(&bar[XB_TOPGEN]) == tg, bar);
            __builtin_amdgcn_fence(__ATOMIC_ACQUIRE, "agent");
            xb_add(&bar[XB_XGEN(b.x)], 1u);
            asm volatile("s_waitcnt vmcnt(0)" ::: "memory");
        } else {
            XB_SPIN(xb_ld(&bar[XB_XGEN(b.x)]) == gen, bar);
            __builtin_amdgcn_fence(__ATOMIC_ACQUIRE, "agent");
            asm volatile("s_waitcnt vmcnt(0)" ::: "memory");
        }
    }
    __syncthreads();
}
struct Args { const void* in[40]; float* out; unsigned char* ws; int ph_lo, ph_hi; };
typedef const __attribute__((address_space(4))) Args* ArgsP;
__device__ __forceinline__ ArgsP fresh_args() { ArgsP p = (ArgsP)__builtin_amdgcn_kernarg_segment_ptr(); asm volatile("" : "+s"(p)); return p; }

struct Frame {
    LAS unsigned char* lds;
    int wave, G, gw, NGW;
    __device__ __forceinline__ int lane() const { unsigned z = 0u; asm volatile("" : "+v"(z)); return (int)__builtin_amdgcn_mbcnt_hi(~0u, __builtin_amdgcn_mbcnt_lo(~0u, z)); }
};

__device__ __forceinline__ Frame fresh(const Frame& F) { Frame R = F; asm volatile("" : "+s"(R.wave), "+s"(R.G), "+s"(R.gw), "+s"(R.NGW)); return R; }
#define LDS_WAIT() asm volatile("s_waitcnt lgkmcnt(0)" ::: "memory")

__device__ __forceinline__ void p0_mod_items(Frame& F, const float* c, const float* ada_w, const float* ada_b, float* mod) {
    LAS float* part = (LAS float*)F.lds;
    LAS float* cs = (LAS float*)(F.lds + 98304);
    int tid_ = F.wave * 64 + F.lane(); asm volatile("" : "+v"(tid_)); const int lane_ = tid_ & 63;
    if ((int)blockIdx.x >= 192) return;
    for (int i = tid_; i < 8192; i += NTHR) cs[i] = siluf(c[i]);
    __syncthreads();
    for (int it = blockIdx.x; it < 192; it += F.G) {
        const int l = it / 96, j0 = (it % 96) * 64;
        float acc[8];
#pragma unroll
        for (int b = 0; b < 8; ++b) acc[b] = 0.f;
        const float* w = ada_w + (size_t)l * 1024 * 6144 + j0 + lane_;
        const int k0 = F.wave * 128;
#pragma unroll 1
        for (int kb = 0; kb < 128; kb += 16) { float wv[16];
#pragma unroll
            for (int q = 0; q < 16; ++q) wv[q] = w[(size_t)(k0 + kb + q) * 6144];
#pragma unroll
            for (int q4 = 0; q4 < 4; ++q4)
#pragma unroll
                for (int b = 0; b < 8; ++b) { const pg8::f32x4 cv = *(const LAS pg8::f32x4*)(cs + b * 1024 + k0 + kb + 4 * q4);
                    acc[b] += (cv[0] * wv[4 * q4] + cv[1] * wv[4 * q4 + 1]) + (cv[2] * wv[4 * q4 + 2] + cv[3] * wv[4 * q4 + 3]); } }
#pragma unroll
        for (int b = 0; b < 8; ++b) part[(F.wave * 8 + b) * 64 + lane_] = acc[b];
        __syncthreads();
        { const int b = tid_ >> 6, col = tid_ & 63; float s = 0.f;
#pragma unroll
          for (int w8 = 0; w8 < 8; ++w8) s += part[(w8 * 8 + b) * 64 + col];
          mod[(size_t)(l * 8 + b) * 6144 + j0 + col] = s + ada_b[l * 6144 + j0 + col]; }
        __syncthreads();
    }
}
struct CvtDesc { const float* colp; size_t Ns; bf16_t* WT; int Kd, n0, k0; };
__device__ __forceinline__ void cvt_load(const CvtDesc& d, pg8::f32x4 (&v)[8], int lane) {
    const int kr = lane >> 3;
#pragma unroll
    for (int i = 0; i < 8; ++i) v[i] = d.colp ? *(const pg8::f32x4*)(d.colp + (size_t)(d.k0 + 8 * i + kr) * d.Ns) : (pg8::f32x4){0.f, 0.f, 0.f, 0.f};
}
__device__ __forceinline__ void cvt_store(const CvtDesc& d, const pg8::f32x4 (&v)[8], LAS float* scr, int lane) {
    const int q4 = 4 * (lane & 7), kr = lane >> 3;
#pragma unroll
    for (int i = 0; i < 8; ++i)
#pragma unroll
        for (int e = 0; e < 4; ++e) scr[(8 * i + kr) * 33 + q4 + e] = v[i][e];
    LDS_WAIT(); asm volatile("" ::: "memory");
    const int cidx = lane & 7;
#pragma unroll
    for (int j = 0; j < 4; ++j) { const int n = (lane >> 3) + 8 * j; const LAS float* s = scr + (8 * cidx) * 33 + n;
        pg8::u32x4 o; o.x = pk2(s[0 * 33], s[1 * 33]); o.y = pk2(s[2 * 33], s[3 * 33]); o.z = pk2(s[4 * 33], s[5 * 33]); o.w = pk2(s[6 * 33], s[7 * 33]);
        *(pg8::u32x4*)(d.WT + (size_t)(d.n0 + n) * d.Kd + d.k0 + 8 * cidx) = o; }
    LDS_WAIT(); asm volatile("" ::: "memory");
}
__device__ __forceinline__ int win_src_col(int v) { return v < 768 ? v : (v < 7168 ? v + 16 : (v < 7184 ? v - 6400 : -1)); }

__device__ __forceinline__ CvtDesc p0_desc(ArgsP a, int it, int n) {
    const float* w_in = (const float*)a->in[9]; const float* w_branch = (const float*)a->in[30]; const float* w_out = (const float*)a->in[31];
    const float* wg = (const float*)a->in[32]; const float* wu = (const float*)a->in[33]; const float* wd = (const float*)a->in[34];
    bf16_t* WIN = (bf16_t*)(a->ws + WS_WIN); bf16_t* WB = (bf16_t*)(a->ws + WS_WB); bf16_t* WO = (bf16_t*)(a->ws + WS_WO); bf16_t* WF1 = (bf16_t*)(a->ws + WS_WF1); bf16_t* WF2 = (bf16_t*)(a->ws + WS_WF2);
    bf16_t* LR = (bf16_t*)(a->ws + WS_LR);
    constexpr int I_IN = 2 * 232 * 16, I_B = 2 * 4 * 32 * 4, I_O = 2 * 32 * 16, I_F1 = 176 * 16, I_F2 = 32 * 44;
    int r = it;
    if (r < I_IN) { const int l = r / (232 * 16), q = r % (232 * 16), nb = q / 16, kb = q % 16; const int sc = win_src_col(nb * 32 + n);
        return CvtDesc{sc >= 0 ? w_in + (size_t)l * 1024 * NIN + sc : nullptr, (size_t)NIN, WIN + (size_t)l * PW * 1024, 1024, nb * 32, kb * 64}; } r -= I_IN;
    if (r < I_B) { const int lg = r / 128, q = r % 128, nb = q / 4, kb = q % 4;
        const int g = lg & 3, l = lg >> 2;
        return CvtDesc{w_branch + (size_t)lg * 256 * 1024 + nb * 32 + n - (size_t)g * 256 * 1024, 1024, WB + (size_t)l * 1024 * 1024, 1024, nb * 32, g * 256 + kb * 64}; } r -= I_B;
    if (r < I_O) { const int l = r / 512, q = r % 512, nb = q / 16, kb = q % 16;
        return CvtDesc{w_out + (size_t)l * 1024 * 1024 + nb * 32 + n, 1024, WO + (size_t)l * 1024 * 1024, 1024, nb * 32, kb * 64}; } r -= I_O;
    if (r < I_F1) { const int nb = r / 16, kb = r % 16; const int v = nb * 32 + n; const int up = (v >> 2) & 1, j = (v >> 3) * 4 + (v & 3);
        return CvtDesc{(up ? wu : wg) + j, (size_t)DFF, WF1, 1024, nb * 32, kb * 64}; } r -= I_F1;
    if (r < I_F2) { const int nb = r / 44, kb = r % 44;
        return CvtDesc{wd + nb * 32 + n, 1024, WF2, DFF, nb * 32, kb * 64}; } r -= I_F2;
    if (r < 16) { const int l = r >> 3, nb = r & 7; return CvtDesc{(const float*)a->in[21] + l * 64 * 256 + nb * 32 + n, 256, LR + l * 256 * 64, 64, nb * 32, 0}; } r -= 16;
    if (r < 16) { const int l = r >> 3, nb = r & 7; return CvtDesc{(const float*)a->in[23] + l * 64 * 256 + nb * 32 + n, 256, LR + 2 * 256 * 64 + l * 256 * 64, 64, nb * 32, 0}; } r -= 16;
    { const int l = r >> 4, nb = (r >> 1) & 7, kb = r & 1; return CvtDesc{(const float*)a->in[24] + l * 128 * 256 + nb * 32 + n, 256, LR + 4 * 256 * 64 + l * 256 * 128, 128, nb * 32, kb * 64}; }
}
__device__ __forceinline__ void p0_convert(Frame& F, ArgsP a) {
    LAS float* scr = (LAS float*)(F.lds + 16384 + F.wave * 8704);
    constexpr int NITEMS = 2 * 232 * 16 + 2 * 4 * 32 * 4 + 2 * 32 * 16 + 176 * 16 + 32 * 44 + 64;
    int lane_ = F.lane(); asm volatile("" : "+v"(lane_));
    const int n = 4 * (lane_ & 7);
    int it = F.gw; if (it >= NITEMS) return;
    CvtDesc cur = p0_desc(a, it, n); pg8::f32x4 v[8]; cvt_load(cur, v, lane_);
    for (;;) { const int nx = it + F.NGW; const bool more = nx < NITEMS;
        CvtDesc nd = cur; pg8::f32x4 w[8];
        if (more) { nd = p0_desc(a, nx, n); cvt_load(nd, w, lane_); }
        cvt_store(cur, v, scr, lane_);
        if (!more) break;
#pragma unroll
        for (int i = 0; i < 8; ++i) v[i] = w[i];
        cur = nd; it = nx; }
}

__device__ __forceinline__ void row_load(const float* p, pg8::f32x4 (&v)[4], int lane) {
#pragma unroll
    for (int j = 0; j < 4; ++j) v[j] = *(const pg8::f32x4*)(p + 4 * lane + 256 * j);
}
__device__ __forceinline__ float row_ss(const pg8::f32x4 (&v)[4]) {
    float s = 0.f;
#pragma unroll
    for (int j = 0; j < 4; ++j) s += (v[j][0] * v[j][0] + v[j][1] * v[j][1]) + (v[j][2] * v[j][2] + v[j][3] * v[j][3]);
    return wave_sum(s);
}
__device__ __forceinline__ void row_normmod(const pg8::f32x4 (&x)[4], const float* g, const float* mb, int sh_off, int sc_off, bf16_t* hrow, pg8::f32x4 (&hv)[4], int lane) {
    const float rstd = rsqrtf(row_ss(x) * (1.0f / D) + 1e-6f);
#pragma unroll
    for (int j = 0; j < 4; ++j) { const int d = 4 * lane + 256 * j;
        const pg8::f32x4 gg = *(const pg8::f32x4*)(g + d), sc = *(const pg8::f32x4*)(mb + sc_off + d), sh = *(const pg8::f32x4*)(mb + sh_off + d);
        hv[j] = x[j] * rstd * gg * (1.0f + sc) + sh;
        pg8::u32x2 w; w.x = pk2(hv[j][0], hv[j][1]); w.y = pk2(hv[j][2], hv[j][3]);
        *(pg8::u32x2*)(hrow + d) = w; }
}
template <int CTRL, int ROWMASK> __device__ __forceinline__ float dpp_mov_p(float old, float x) {
    return __builtin_bit_cast(float, __builtin_amdgcn_update_dpp(__builtin_bit_cast(int, old), __builtin_bit_cast(int, x), CTRL, ROWMASK, 0xF, false)); }
__device__ __forceinline__ float wave_sum63p(float x) {
    x += dpp_mov_p<0xB1, 0xF>(0.f, x); x += dpp_mov_p<0x4E, 0xF>(0.f, x); x += dpp_mov_p<0x141, 0xF>(0.f, x); x += dpp_mov_p<0x140, 0xF>(0.f, x);
    x += dpp_mov_p<0x142, 0xA>(0.f, x); x += dpp_mov_p<0x143, 0xC>(0.f, x); return x; }
__device__ __forceinline__ void stage_wz(const float* w_in_l, LAS float* wz, int tid) {
    for (int i = tid; i < 1024 * 4; i += NTHR) { const int d = i >> 2, q = i & 3; const pg8::f32x4 w = *(const pg8::f32x4*)(w_in_l + (size_t)d * NIN + 768 + 4 * q);
        wz[(4 * q) * 1024 + d] = w[0]; wz[(4 * q + 1) * 1024 + d] = w[1]; wz[(4 * q + 2) * 1024 + d] = w[2]; wz[(4 * q + 3) * 1024 + d] = w[3]; }
    __syncthreads();
}
__device__ __forceinline__ void row_gz(const pg8::f32x4 (&hv)[4], const LAS float* wz, bf16_t* gzrow, int lane) {
    float mine = 0.f;
#pragma unroll
    for (int o = 0; o < 16; ++o) { float acc = 0.f;
#pragma unroll
        for (int j = 0; j < 4; ++j) { const pg8::f32x4 w = *(const LAS pg8::f32x4*)(wz + o * 1024 + 4 * lane + 256 * j); acc += (hv[j][0] * w[0] + hv[j][1] * w[1]) + (hv[j][2] * w[2] + hv[j][3] * w[3]); }
        const float s = __builtin_bit_cast(float, __builtin_amdgcn_readlane(__builtin_bit_cast(int, wave_sum63p(acc)), 63)); if (lane == o) mine = s; }
    if (lane < 16) gzrow[lane] = (bf16_t)f2bf(mine);
}
__device__ __forceinline__ void ph_h0(Frame& F, ArgsP a) {
    const float* x = (const float*)a->in[0]; const float* g = (const float*)a->in[5]; const float* mod = (const float*)(a->ws + WS_MOD); bf16_t* H = (bf16_t*)(a->ws + WS_HB);
    bf16_t* GZ = (bf16_t*)(a->ws + WS_GZ); LAS float* wz = (LAS float*)F.lds;
    int lane0 = F.lane(); asm volatile("" : "+v"(lane0));
    stage_wz((const float*)a->in[9], wz, F.wave * 64 + lane0);
    int row = F.gw; if (row >= M) return;
    pg8::f32x4 xn[4]; row_load(x + (size_t)row * D, xn, lane0);
    for (;;) { int lane = lane0; asm volatile("" : "+v"(lane)); pg8::f32x4 xv[4], hv[4];
#pragma unroll
        for (int j = 0; j < 4; ++j) xv[j] = xn[j];
        const int nrow = row + F.NGW; if (nrow < M) row_load(x + (size_t)nrow * D, xn, lane);
        row_normmod(xv, g, mod + (size_t)(row / T) * 6144, 0, 1024, H + (size_t)row * D, hv, lane);
        row_gz(hv, wz, GZ + (size_t)row * 16, lane);
        if (nrow >= M) break; row = nrow; }
}
__device__ __forceinline__ void row_y_load(const bf16_t* y, const bf16_t* eout, const unsigned* cnt, const int* toke, const int* toks, int row, int lane, pg8::f32x4 (&yv)[4], pg8::u32x2 (&e1)[4], pg8::u32x2 (&e2)[4]) {
    if (eout) {
        int roff[8]; { int o = 0;
#pragma unroll
            for (int e = 0; e < 8; ++e) { roff[e] = o; o += (((int)cnt[e] + 255) >> 8) << 8; } }
        const int x1 = toke[row * 2], x2 = toke[row * 2 + 1]; int g1 = toks[row * 2], g2 = toks[row * 2 + 1];
#pragma unroll
        for (int q = 0; q < 8; ++q) { if (q == x1) g1 += roff[q]; if (q == x2) g2 += roff[q]; }
#pragma unroll
        for (int j = 0; j < 4; ++j) { e1[j] = *(const pg8::u32x2*)(eout + (size_t)g1 * D + 4 * lane + 256 * j); e2[j] = *(const pg8::u32x2*)(eout + (size_t)g2 * D + 4 * lane + 256 * j); }
    } else {
#pragma unroll
        for (int j = 0; j < 4; ++j) e1[j] = *(const pg8::u32x2*)(y + (size_t)row * D + 4 * lane + 256 * j); }
}
__device__ __forceinline__ void ph_row(Frame& F, ArgsP a, const float* xold, const bf16_t* y, const float* gpost, const float* modl, int gt_off,
                                       const float* gpre, const float* modn, int sh_off, int sc_off, bf16_t* hdst, bool route, const bf16_t* eout = nullptr, const float* w_in_next = nullptr) {
    float* out = a->out;
    bf16_t* GZ = (bf16_t*)(a->ws + WS_GZ); LAS float* wz = (LAS float*)F.lds;
    if (w_in_next) { int t_ = F.wave * 64 + F.lane(); stage_wz(w_in_next, wz, t_); }
    const float* rw = (const float*)a->in[35]; const float* rb = (const float*)a->in[36];
    unsigned* cnt = (unsigned*)(a->ws + WS_CTL) + CW_CNT;
    int* list = (int*)(a->ws + WS_ROUTE + RT_LIST); int* toke = (int*)(a->ws + WS_ROUTE + RT_TOKE); int* toks = (int*)(a->ws + WS_ROUTE + RT_TOKS); float* tokp = (float*)(a->ws + WS_ROUTE + RT_TOKP);
    int row = F.gw; if (row >= M) return;
    int lane0 = F.lane(); asm volatile("" : "+v"(lane0));
    pg8::f32x4 yn[4], xn[4]; pg8::u32x2 e1n[4], e2n[4];
    row_y_load(y, eout, cnt, toke, toks, row, lane0, yn, e1n, e2n); row_load(xold + (size_t)row * D, xn, lane0);
    for (;;) {
        int lane = lane0; asm volatile("" : "+v"(lane));
        const int b = row / T; pg8::f32x4 yv[4], xv[4], hv[4];
        if (eout) { const float p1 = tokp[row * 2], p2 = tokp[row * 2 + 1];
#pragma unroll
            for (int j = 0; j < 4; ++j) { const pg8::u32x2 a1 = e1n[j], a2 = e2n[j];
                yv[j][0] = p1 * __builtin_bit_cast(float, a1.x << 16) + p2 * __builtin_bit_cast(float, a2.x << 16); yv[j][1] = p1 * __builtin_bit_cast(float, a1.x & 0xffff0000u) + p2 * __builtin_bit_cast(float, a2.x & 0xffff0000u);
                yv[j][2] = p1 * __builtin_bit_cast(float, a1.y << 16) + p2 * __builtin_bit_cast(float, a2.y << 16); yv[j][3] = p1 * __builtin_bit_cast(float, a1.y & 0xffff0000u) + p2 * __builtin_bit_cast(float, a2.y & 0xffff0000u); }
        } else {
#pragma unroll
            for (int j = 0; j < 4; ++j) { const pg8::u32x2 a1 = e1n[j]; yv[j][0] = __builtin_bit_cast(float, a1.x << 16); yv[j][1] = __builtin_bit_cast(float, a1.x & 0xffff0000u); yv[j][2] = __builtin_bit_cast(float, a1.y << 16); yv[j][3] = __builtin_bit_cast(float, a1.y & 0xffff0000u); } }
#pragma unroll
        for (int j = 0; j < 4; ++j) xv[j] = xn[j];
        const int nrow = row + F.NGW;
        if (nrow < M) { row_y_load(y, eout, cnt, toke, toks, nrow, lane, yn, e1n, e2n); row_load(xold + (size_t)nrow * D, xn, lane); }
        const float rstd = rsqrtf(row_ss(yv) * (1.0f / D) + 1e-6f);
        const float* mb = modl + (size_t)b * 6144;
#pragma unroll
        for (int j = 0; j < 4; ++j) { const int d = 4 * lane + 256 * j;
            const pg8::f32x4 gp = *(const pg8::f32x4*)(gpost + d), gt = *(const pg8::f32x4*)(mb + gt_off + d);
            xv[j] = xv[j] + gt * (yv[j] * rstd * gp);
            *(pg8::f32x4*)(out + (size_t)row * D + d) = xv[j]; }
        if (hdst) {
            row_normmod(xv, gpre, modn + (size_t)b * 6144, sh_off, sc_off, hdst + (size_t)row * D, hv, lane);
            if (w_in_next) row_gz(hv, wz, GZ + (size_t)row * 16, lane);
            if (route) {
                float lg[8];
#pragma unroll
                for (int e = 0; e < 8; ++e) lg[e] = 0.f;
#pragma unroll
                for (int j = 0; j < 4; ++j)
#pragma unroll
                    for (int q = 0; q < 4; ++q) { const int d = 4 * lane + 256 * j + q; const pg8::f32x4 w0 = *(const pg8::f32x4*)(rw + d * 8), w1 = *(const pg8::f32x4*)(rw + d * 8 + 4); const float hq = hv[j][q];
                        lg[0] += hq * w0[0]; lg[1] += hq * w0[1]; lg[2] += hq * w0[2]; lg[3] += hq * w0[3]; lg[4] += hq * w1[0]; lg[5] += hq * w1[1]; lg[6] += hq * w1[2]; lg[7] += hq * w1[3]; }
#pragma unroll
                for (int e = 0; e < 8; ++e) lg[e] = wave_sum(lg[e]) + rb[e];
                if (lane == 0) {
                    int e1 = 0; float v1 = lg[0];
#pragma unroll
                    for (int e = 1; e < 8; ++e) if (lg[e] > v1) { v1 = lg[e]; e1 = e; }
                    int e2 = -1; float v2 = -3.0e38f;
#pragma unroll
                    for (int e = 0; e < 8; ++e) if (e != e1 && lg[e] > v2) { v2 = lg[e]; e2 = e; }
                    const float p1 = 1.0f / (1.0f + __expf(v2 - v1)), p2 = 1.0f - p1;
                    const int s1 = (int)atomicAdd(&cnt[e1], 1u), s2 = (int)atomicAdd(&cnt[e2], 1u);
                    list[e1 * M + s1] = row; list[e2 * M + s2] = row;
                    toke[row * 2] = e1; toke[row * 2 + 1] = e2; toks[row * 2] = s1; toks[row * 2 + 1] = s2; tokp[row * 2] = p1; tokp[row * 2 + 1] = p2;
                }
            }
        }
        if (nrow >= M) break; row = nrow;
    }
}

__device__ __forceinline__ void ph_moe_prep(Frame& F, ArgsP a) {
    LAS float* scr = (LAS float*)(F.lds + F.wave * 8704);
    const float* mg = (const float*)a->in[37]; const float* mu = (const float*)a->in[38]; const float* md = (const float*)a->in[39];
    bf16_t* WM1 = (bf16_t*)(a->ws + WS_WM1); bf16_t* WM2 = (bf16_t*)(a->ws + WS_WM2);
    constexpr int I_1 = 8 * 224 * 16, I_2 = 8 * 32 * 56;
    int lane_ = F.lane(); asm volatile("" : "+v"(lane_));
    const int n = 4 * (lane_ & 7);
    auto desc = [&](int r) -> CvtDesc {
        if (r < I_1) { const int e = r / 3584, q = r % 3584, nb = q / 16, kb = q % 16; const int v = nb * 32 + n; const int up = (v >> 2) & 1, j = (v >> 3) * 4 + (v & 3);
            return CvtDesc{(up ? mu : mg) + (size_t)e * 1024 * DEX + j, (size_t)DEX, WM1 + (size_t)e * 7168 * 1024, 1024, nb * 32, kb * 64}; }
        r -= I_1; const int e = r / 1792, q = r % 1792, nb = q / 56, kb = q % 56;
        return CvtDesc{md + (size_t)e * DEX * 1024 + nb * 32 + n, 1024, WM2 + (size_t)e * 1024 * DEX, DEX, nb * 32, kb * 64}; };
    { int it = F.gw;
      if (it < I_1 + I_2) { CvtDesc cur = desc(it); pg8::f32x4 v[8]; cvt_load(cur, v, lane_);
        for (;;) { const int nx = it + F.NGW; const bool more = nx < I_1 + I_2; CvtDesc nd = cur; pg8::f32x4 w[8];
            if (more) { nd = desc(nx); cvt_load(nd, w, lane_); }
            cvt_store(cur, v, scr, lane_);
            if (!more) break;
#pragma unroll
            for (int i = 0; i < 8; ++i) v[i] = w[i];
            cur = nd; it = nx; } } }
    const unsigned* cnt = (const unsigned*)(a->ws + WS_CTL) + CW_CNT;
    const int* list = (const int*)(a->ws + WS_ROUTE + RT_LIST);
    const bf16_t* h2 = (const bf16_t*)(a->ws + WS_H2L1); bf16_t* hg = (bf16_t*)(a->ws + WS_HG);
    int roff[9]; { int o = 0;
#pragma unroll
        for (int e = 0; e < 8; ++e) { roff[e] = o; o += (((int)cnt[e] + 255) >> 8) << 8; } roff[8] = o; }
    for (int slot = F.gw; slot < roff[8]; slot += F.NGW) {
        int e = 0;
#pragma unroll
        for (int q = 1; q < 8; ++q) e += (slot >= roff[q]) ? 1 : 0;
        int base = 0, ce = 0;
#pragma unroll
        for (int q = 0; q < 8; ++q) if (q == e) { base = roff[q]; ce = (int)cnt[q]; }
        const int s = slot - base;
        pg8::u32x4 v0 = {0u, 0u, 0u, 0u}, v1 = {0u, 0u, 0u, 0u};
        if (s < ce) { const int src = list[e * M + s]; const pg8::u32x4* sp = (const pg8::u32x4*)(h2 + (size_t)src * D) + 2 * lane_; v0 = sp[0]; v1 = sp[1]; }
        pg8::u32x4* dp = (pg8::u32x4*)(hg + (size_t)slot * D) + 2 * lane_; dp[0] = v0; dp[1] = v1;
    }
}
typedef float f32x16 __attribute__((ext_vector_type(16)));
template <int CTRL, int ROWMASK> __device__ __forceinline__ float dpp_mov(float old, float x) {
    return __builtin_bit_cast(float, __builtin_amdgcn_update_dpp(__builtin_bit_cast(int, old), __builtin_bit_cast(int, x), CTRL, ROWMASK, 0xF, false));
}
__device__ __forceinline__ float rdlane(float x, int l) { return __builtin_bit_cast(float, __builtin_amdgcn_readlane(__builtin_bit_cast(int, x), l)); }
__device__ __forceinline__ float wave_sum63(float x) {
    x += dpp_mov<0xB1, 0xF>(0.f, x);
    x += dpp_mov<0x4E, 0xF>(0.f, x);
    x += dpp_mov<0x141, 0xF>(0.f, x);
    x += dpp_mov<0x140, 0xF>(0.f, x);
    x += dpp_mov<0x142, 0xA>(0.f, x);
    x += dpp_mov<0x143, 0xC>(0.f, x);
    return x;
}
__device__ __forceinline__ float row16_sum(float x) {
    x += dpp_mov<0xB1, 0xF>(0.f, x); x += dpp_mov<0x4E, 0xF>(0.f, x); x += dpp_mov<0x141, 0xF>(0.f, x); x += dpp_mov<0x140, 0xF>(0.f, x);
    return x;
}
__device__ __forceinline__ pg8::f32x4 ld_bf16x4(const bf16_t* p) { const pg8::u32x2 w = *(const pg8::u32x2*)p;
    return (pg8::f32x4){__builtin_bit_cast(float, w.x << 16), __builtin_bit_cast(float, w.x & 0xffff0000u), __builtin_bit_cast(float, w.y << 16), __builtin_bit_cast(float, w.y & 0xffff0000u)}; }
__device__ __forceinline__ void st_bf16x4(bf16_t* p, pg8::f32x4 v) { pg8::u32x2 w; w.x = pk2(v[0], v[1]); w.y = pk2(v[2], v[3]); *(pg8::u32x2*)p = w; }

__device__ __forceinline__ void ph_conv(Frame& F, ArgsP a, int l) {
    const bf16_t* proj = (const bf16_t*)(a->ws + WS_PROJ); bf16_t* br = (bf16_t*)(a->ws + WS_HB);
    const float* cw = (const float*)a->in[15] + l * 31 * 256; const float* cb = (const float*)a->in[16] + l * 256; const float* lg = (const float*)a->in[17] + l * 256; const float* lb = (const float*)a->in[18] + l * 256;
    LAS float* u = (LAS float*)F.lds;
    int tid = F.wave * 64 + F.lane(); asm volatile("" : "+v"(tid)); const int lane = tid & 63;
    for (int it = blockIdx.x; it < M / 64; it += F.G) {
        const int row0 = it * 64, t0 = row0 % T;
        for (int idx = tid; idx < 94 * 32; idx += NTHR) { const int r = idx >> 5, c8 = (idx & 31) * 8; float uv[8];
#pragma unroll
            for (int e = 0; e < 8; ++e) uv[e] = 0.f;
            if (t0 - 30 + r >= 0) { const bf16_t* pr = proj + (size_t)(row0 - 30 + r) * PW;
                const pg8::f32x4 a0 = ld_bf16x4(pr + P_CA + c8), a1 = ld_bf16x4(pr + P_CA + c8 + 4), b0 = ld_bf16x4(pr + P_CB + c8), b1 = ld_bf16x4(pr + P_CB + c8 + 4);
#pragma unroll
                for (int e = 0; e < 4; ++e) { uv[e] = a0[e] * sigm(b0[e]); uv[4 + e] = a1[e] * sigm(b1[e]); } }
            *(LAS pg8::f32x4*)(u + r * 256 + c8) = (pg8::f32x4){uv[0], uv[1], uv[2], uv[3]}; *(LAS pg8::f32x4*)(u + r * 256 + c8 + 4) = (pg8::f32x4){uv[4], uv[5], uv[6], uv[7]}; }
        __syncthreads();
        const int c = tid & 255, half = tid >> 8;
        float acc[32];
        { float w[31], ur[62];
#pragma unroll
          for (int j = 0; j < 31; ++j) w[j] = cw[j * 256 + c];
#pragma unroll
          for (int q = 0; q < 62; ++q) ur[q] = u[(half * 32 + q) * 256 + c];
          const float bias = cb[c];
#pragma unroll
          for (int i = 0; i < 32; ++i) { float s = bias;
#pragma unroll
              for (int j = 0; j < 31; ++j) s += w[j] * ur[i + j];
              acc[i] = s; } }
        __syncthreads();
#pragma unroll
        for (int i = 0; i < 32; ++i) u[(half * 32 + i) * 256 + c] = acc[i];
        __syncthreads();
        const pg8::f32x4 g4 = *(const pg8::f32x4*)(lg + 4 * lane), b4 = *(const pg8::f32x4*)(lb + 4 * lane);
#pragma unroll 2
        for (int q = 0; q < 8; ++q) { const int t = F.wave * 8 + q; const pg8::f32x4 yv = *(const LAS pg8::f32x4*)(u + t * 256 + 4 * lane);
            const float mu = wave_sum((yv[0] + yv[1]) + (yv[2] + yv[3])) * (1.0f / 256.0f); const pg8::f32x4 d = yv - mu;
            const float var = wave_sum((d[0] * d[0] + d[1] * d[1]) + (d[2] * d[2] + d[3] * d[3])) * (1.0f / 256.0f);
            pg8::f32x4 o = d * rsqrtf(var + 1e-5f) * g4 + b4;
#pragma unroll
            for (int e = 0; e < 4; ++e) o[e] = siluf(o[e]);
            st_bf16x4(br + (size_t)(row0 + t) * D + 512 + 4 * lane, o); }
        __syncthreads();
    }
}

__device__ __forceinline__ void ph_rwkv_prep(Frame& F, ArgsP a, int l) {
        const bf16_t* proj = (const bf16_t*)(a->ws + WS_PROJ);
    const float* mu = (const float*)a->in[19] + l * 1024; const float* w0 = (const float*)a->in[20] + l * 256; const float* a0 = (const float*)a->in[22] + l * 256;
    const float* kkw = (const float*)a->in[25] + l * 256; const float* kaw = (const float*)a->in[26] + l * 256; const float* rkw = (const float*)a->in[27] + l * 256;
    const bf16_t* W2T = (const bf16_t*)(a->ws + WS_LR) + l * 256 * 64; const bf16_t* A2T = (const bf16_t*)(a->ws + WS_LR) + 2 * 256 * 64 + l * 256 * 64; const bf16_t* G2T = (const bf16_t*)(a->ws + WS_LR) + 4 * 256 * 64 + l * 256 * 128;
    float* VEC = (float*)(a->ws + SCR_VEC6); float* SC = (float*)(a->ws + SCR_SC); bf16_t* GR = (bf16_t*)(a->ws + SCR_GR);
    constexpr int RS = 72, RG = 136;
    LAS bf16_t* TZh = (LAS bf16_t*)F.lds; LAS bf16_t* TZl = TZh + 64 * RS; LAS bf16_t* ZA = TZl + 64 * RS; LAS bf16_t* SG = ZA + 64 * RS;
    int tid = F.wave * 64 + F.lane(); asm volatile("" : "+v"(tid));
    for (int it = blockIdx.x; it < M / 64; it += F.G) {
        const int row0 = it * 64, b = row0 / T, t0 = row0 % T;
#pragma unroll 4
        for (int i_ = 0; i_ < 32; ++i_) { const int idx = tid + i_ * NTHR; const int cc = idx & 255, tok = idx >> 8; const int col = 768 + cc;
            const bf16_t* pc = proj + (size_t)(row0 + tok) * PW + P_R + col; const float xc = bf2f(pc[0]); const float xp = (t0 + tok > 0) ? bf2f(pc[-PW]) : 0.f;
            const float xm = xc + (xp - xc) * mu[col];
            if (cc < 64) { const float tv = tanhf(xm); const unsigned hi = f2bf(tv); TZh[tok * RS + cc] = (bf16_t)hi; TZl[tok * RS + cc] = (bf16_t)f2bf(tv - __builtin_bit_cast(float, hi << 16)); }
            else if (cc < 128) ZA[tok * RS + cc - 64] = (bf16_t)f2bf(xm);
            else SG[tok * RG + cc - 128] = (bf16_t)f2bf(sigm(xm)); }
        __syncthreads();
        int tid2 = tid; asm volatile("" : "+v"(tid2));
        const int lane = tid2 & 63, r = lane & 31, hg = lane >> 5, h = (tid2 >> 6) & 3, th = tid2 >> 8;
        f32x16 accw[2], acca[2], accg[2];
#pragma unroll
        for (int nb = 0; nb < 2; ++nb)
#pragma unroll
            for (int e = 0; e < 16; ++e) { accw[nb][e] = 0.f; acca[nb][e] = 0.f; accg[nb][e] = 0.f; }
        const int arow = (th * 32 + r);
#pragma unroll
        for (int s = 0; s < 4; ++s) { const pg8::bf16x8 ah = *(const LAS pg8::bf16x8*)(TZh + arow * RS + 16 * s + 8 * hg), al = *(const LAS pg8::bf16x8*)(TZl + arow * RS + 16 * s + 8 * hg), az = *(const LAS pg8::bf16x8*)(ZA + arow * RS + 16 * s + 8 * hg);
#pragma unroll
            for (int nb = 0; nb < 2; ++nb) { const int n = h * 64 + nb * 32 + r;
                const pg8::bf16x8 bw = *(const pg8::bf16x8*)(W2T + n * 64 + 16 * s + 8 * hg), ba = *(const pg8::bf16x8*)(A2T + n * 64 + 16 * s + 8 * hg);
                accw[nb] = __builtin_amdgcn_mfma_f32_32x32x16_bf16(ah, bw, accw[nb], 0, 0, 0); accw[nb] = __builtin_amdgcn_mfma_f32_32x32x16_bf16(al, bw, accw[nb], 0, 0, 0);
                acca[nb] = __builtin_amdgcn_mfma_f32_32x32x16_bf16(az, ba, acca[nb], 0, 0, 0); } }
#pragma unroll
        for (int s = 0; s < 8; ++s) { const pg8::bf16x8 ag = *(const LAS pg8::bf16x8*)(SG + arow * RG + 16 * s + 8 * hg);
#pragma unroll
            for (int nb = 0; nb < 2; ++nb) { const int n = h * 64 + nb * 32 + r; const pg8::bf16x8 bg = *(const pg8::bf16x8*)(G2T + n * 128 + 16 * s + 8 * hg);
                accg[nb] = __builtin_amdgcn_mfma_f32_32x32x16_bf16(ag, bg, accg[nb], 0, 0, 0); } }
        int tid3 = tid; asm volatile("" : "+v"(tid3)); const int r3 = tid3 & 31, hg3 = (tid3 >> 5) & 1, h3 = (tid3 >> 6) & 3, th3 = tid3 >> 8;
        float pw0[2], pa0[2], pmr[2], pmk[2], pmv[2], pkk[2], pka[2], prk[2];
#pragma unroll
        for (int nb = 0; nb < 2; ++nb) { const int c = h3 * 64 + nb * 32 + r3; pw0[nb] = w0[c]; pa0[nb] = a0[c]; pmr[nb] = mu[c]; pmk[nb] = mu[256 + c]; pmv[nb] = mu[512 + c]; pkk[nb] = kkw[c]; pka[nb] = kaw[c]; prk[nb] = rkw[c]; }
#pragma unroll
        for (int e = 0; e < 16; ++e) { const int tok = th3 * 32 + (e & 3) + 8 * (e >> 2) + 4 * hg3, t = t0 + tok; const size_t row = (size_t)row0 + tok; const bool hp = t > 0;
            float dec[2], kkv[2], kka[2], k2[2], rv[2], vv[2], s_kk = 0.f, s_c1 = 0.f, s_c2 = 0.f, s_bn = 0.f;
#pragma unroll
            for (int nb = 0; nb < 2; ++nb) { const int c = h3 * 64 + nb * 32 + r3; const bf16_t* pc = proj + row * PW + P_R + c;
                const float rc = bf2f(pc[0]), kc = bf2f(pc[256]), vc = bf2f(pc[512]);
                const float rp = hp ? bf2f(pc[-PW]) : 0.f, kp = hp ? bf2f(pc[256 - PW]) : 0.f, vp = hp ? bf2f(pc[512 - PW]) : 0.f;
                const float rr = rc + (rp - rc) * pmr[nb], k = kc + (kp - kc) * pmk[nb]; vv[nb] = vc + (vp - vc) * pmv[nb]; rv[nb] = rr;
                const float wl = -softplusf(-(accw[nb][e] + pw0[nb])) - 0.5f; dec[nb] = __expf(-__expf(wl)); const float av = sigm(acca[nb][e] + pa0[nb]);
                kkv[nb] = k * pkk[nb]; k2[nb] = k * (1.0f + (av - 1.0f) * pka[nb]); kka[nb] = av;
                s_kk += kkv[nb] * kkv[nb]; s_c2 += k2[nb] * rr; s_bn += rr * k2[nb] * prk[nb];
                GR[row * 256 + c] = (bf16_t)f2bf(accg[nb][e]); }
            s_kk = row16_sum(s_kk); s_kk += __shfl_xor(s_kk, 16);
            const float inv = 1.0f / fmaxf(sqrtf(s_kk), 1e-12f);
#pragma unroll
            for (int nb = 0; nb < 2; ++nb) { kkv[nb] *= inv; kka[nb] *= kkv[nb]; s_c1 += kka[nb] * rv[nb]; }
            s_c1 = row16_sum(s_c1); s_c1 += __shfl_xor(s_c1, 16); s_c2 = row16_sum(s_c2); s_c2 += __shfl_xor(s_c2, 16); s_bn = row16_sum(s_bn); s_bn += __shfl_xor(s_bn, 16);
            const size_t st = ((size_t)(b * 4 + h3) * T + t);
#pragma unroll
            for (int nb = 0; nb < 2; ++nb) { float* vb = VEC + st * VSTEP + nb * 32 + r3;
                vb[0] = dec[nb]; vb[64] = -kkv[nb]; vb[128] = kka[nb]; vb[192] = k2[nb]; vb[256] = dec[nb] * rv[nb]; vb[320] = vv[nb]; }
            if (r3 == 0) { *(pg8::f32x4*)(SC + st * 4) = (pg8::f32x4){s_c1, s_c2, s_bn, 0.f}; *(pg8::f32x2*)(VEC + st * VSTEP + 384) = (pg8::f32x2){s_c1, s_c2}; }
            asm volatile("" ::: "memory"); }
        __syncthreads();
    }
}

__device__ __forceinline__ void ph_rwkv_scan(Frame& F, ArgsP a) {
    const float* VEC = (const float*)(a->ws + SCR_VEC6); float* YR = (float*)(a->ws + SCR_YR);
    int lane = F.lane(); asm volatile("" : "+v"(lane));
    constexpr int CH = 32, CHB = CH * VSTEP * 4, NP = CHB / 1024 / 4;
    const bool stager = F.wave >= 4;
    for (int it = blockIdx.x; it < 256; it += F.G) {
        const int bh = it >> 3, rg = it & 7, b = bh >> 2, h = bh & 3;
        const int sw = F.wave & 3, vrow = rg * 8 + 2 * sw;
        const char* src = (const char*)(VEC + (size_t)bh * T * VSTEP) + lane * 16;
#define RW_STAGE(cidx) do { _Pragma("unroll") for (int p_ = 0; p_ < NP; ++p_) \
            __builtin_amdgcn_global_load_lds((const unsigned*)(src + (size_t)(cidx) * CHB + (sw * NP + p_) * 1024), (LAS unsigned*)(F.lds + ((cidx) & 1) * CHB + (sw * NP + p_) * 1024), 16, 0, 0); } while (0)
        if (stager) { RW_STAGE(0); asm volatile("s_waitcnt vmcnt(0)" ::: "memory"); }
        __builtin_amdgcn_s_barrier(); asm volatile("" ::: "memory");
        float SA = 0.f, SB = 0.f;
        for (int c = 0; c < T / CH; ++c) {
            if (stager) { if (c + 1 < T / CH) { RW_STAGE(c + 1); asm volatile("s_waitcnt vmcnt(0)" ::: "memory"); } }
            else {
                const LAS float* bufl = (const LAS float*)(F.lds + (c & 1) * CHB) + lane;
                const LAS float* bufv = (const LAS float*)(F.lds + (c & 1) * CHB) + 320 + vrow;
                const LAS float* bufc = (const LAS float*)(F.lds + (c & 1) * CHB) + 384;
                float yaA = 0.f, yaB = 0.f;
                float nw = bufl[0], nnkk = bufl[64], nkka = bufl[128], nk2 = bufl[192], nwr = bufl[256]; pg8::f32x2 nv = *(const LAS pg8::f32x2*)bufv, ncc = *(const LAS pg8::f32x2*)bufc;
#pragma unroll 4
                for (int s = 0; s < CH; ++s) {
                    const float w_ = nw, nkk = nnkk, kka = nkka, k2 = nk2, wr = nwr; const pg8::f32x2 v = nv, cc = ncc;
                    { const int s1 = (s + 1 < CH ? s + 1 : s) * VSTEP;
                      nw = bufl[s1]; nnkk = bufl[s1 + 64]; nkka = bufl[s1 + 128]; nk2 = bufl[s1 + 192]; nwr = bufl[s1 + 256]; nv = *(const LAS pg8::f32x2*)(bufv + s1); ncc = *(const LAS pg8::f32x2*)(bufc + s1); }
                    asm volatile("" ::: "memory");
                    const auto s0 = __builtin_amdgcn_permlane32_swap(__builtin_bit_cast(unsigned, SA * nkk), __builtin_bit_cast(unsigned, SA * wr), false, false);
                    const auto s1_ = __builtin_amdgcn_permlane32_swap(__builtin_bit_cast(unsigned, SB * nkk), __builtin_bit_cast(unsigned, SB * wr), false, false);
                    const float xA = __builtin_bit_cast(float, (unsigned)s0[0]) + __builtin_bit_cast(float, (unsigned)s0[1]);
                    const float xB = __builtin_bit_cast(float, (unsigned)s1_[0]) + __builtin_bit_cast(float, (unsigned)s1_[1]);
                    const auto s2 = __builtin_amdgcn_permlane16_swap(__builtin_bit_cast(unsigned, xA), __builtin_bit_cast(unsigned, xB), false, false);
                    float x = __builtin_bit_cast(float, (unsigned)s2[0]) + __builtin_bit_cast(float, (unsigned)s2[1]);
                    x += dpp_mov<0xB1, 0xF>(0.f, x); x += dpp_mov<0x4E, 0xF>(0.f, x); x += dpp_mov<0x141, 0xF>(0.f, x); x += dpp_mov<0x140, 0xF>(0.f, x);
                    const float saA = rdlane(x, 0), saB = rdlane(x, 16), zA = rdlane(x, 32), zB = rdlane(x, 48);
                    SA = SA * w_ + (saA * kka + v[0] * k2);
                    SB = SB * w_ + (saB * kka + v[1] * k2);
                    const float yA = zA + saA * cc[0] + v[0] * cc[1], yB = zB + saB * cc[0] + v[1] * cc[1];
                    yaA = (lane == s) ? yA : yaA; yaB = (lane == s) ? yB : yaB;
                }
                if (lane < CH) *(pg8::f32x2*)(YR + ((size_t)b * T + c * CH + lane) * 256 + h * 64 + vrow) = (pg8::f32x2){yaA, yaB};
            }
            __builtin_amdgcn_s_barrier(); asm volatile("" ::: "memory");
        }
#undef RW_STAGE
        asm volatile("s_waitcnt vmcnt(0)" ::: "memory"); __builtin_amdgcn_s_barrier(); asm volatile("" ::: "memory");
    }
}

__device__ __forceinline__ void ph_rwkv_post(Frame& F, ArgsP a, int l) {
    const float* VEC = (const float*)(a->ws + SCR_VEC6); const float* SC = (const float*)(a->ws + SCR_SC); const float* YR = (const float*)(a->ws + SCR_YR); const bf16_t* GR = (const bf16_t*)(a->ws + SCR_GR);
    const float* lng = (const float*)a->in[28] + l * 256; const float* lnb = (const float*)a->in[29] + l * 256;
    bf16_t* br = (bf16_t*)(a->ws + WS_HB);
    int lane = F.lane(); asm volatile("" : "+v"(lane));
    const int c = 4 * lane, h = lane >> 4;
    const pg8::f32x4 g4 = *(const pg8::f32x4*)(lng + c), b4 = *(const pg8::f32x4*)(lnb + c);
    for (int row = F.gw; row < M; row += F.NGW) {
        const int b = row / T, t = row % T; const size_t st = (size_t)(b * 4 + h) * T + t;
        const pg8::f32x4 y = *(const pg8::f32x4*)(YR + (size_t)row * 256 + c);
        const float mu = row16_sum((y[0] + y[1]) + (y[2] + y[3])) * (1.0f / 64.0f); const pg8::f32x4 d = y - mu;
        const float var = row16_sum((d[0] * d[0] + d[1] * d[1]) + (d[2] * d[2] + d[3] * d[3])) * (1.0f / 64.0f);
        const pg8::f32x4 yn = d * rsqrtf(var + 64e-5f) * g4 + b4;
        const float bonus = SC[st * 4 + 2];
        const pg8::f32x4 v = *(const pg8::f32x4*)(VEC + st * VSTEP + 320 + (c & 63));
        const pg8::f32x4 g = ld_bf16x4(GR + (size_t)row * 256 + c);
        st_bf16x4(br + (size_t)row * D + 768 + c, (yn + bonus * v) * g);
    }
}

__device__ __forceinline__ void ph_gla_p1(Frame& F, ArgsP a, int l) {
    const bf16_t* proj = (const bf16_t*)(a->ws + WS_PROJ); const float* w2 = (const float*)a->in[10] + l * 16 * 128; const float* gb = (const float*)a->in[11] + l * 128;
    bf16_t* QS = (bf16_t*)(a->ws + SCR_EG); float* CDp = (float*)(a->ws + SCR_EG) + (size_t)M * 128; float* GU = (float*)(a->ws + SCR_GU); float* OI = (float*)(a->ws + WS_GOI);
    const bf16_t* GZ = (const bf16_t*)(a->ws + WS_GZ);
    constexpr int RS = 40;
    LAS unsigned char* wl = F.lds + F.wave * 12800;
    LAS bf16_t* VTl = (LAS bf16_t*)wl; LAS bf16_t* Qs = (LAS bf16_t*)(wl + 5120); LAS bf16_t* Ks = (LAS bf16_t*)(wl + 7680); LAS bf16_t* KdT = (LAS bf16_t*)(wl + 10240);
    int lane = F.lane(); asm volatile("" : "+v"(lane));
    const int d = lane & 31, half = lane >> 5, r = lane & 31, hg = lane >> 5;
    for (int it = F.gw; it < 2048; it += F.NGW) {
        const int bh = it >> 6, n = it & 63, b = bh >> 2, h = bh & 3; const size_t row0 = (size_t)b * T + n * 32;
        float wc[16];
#pragma unroll
        for (int q = 0; q < 16; ++q) wc[q] = w2[q * 128 + h * 32 + d];
        const float gbv = gb[h * 32 + d];
        float g[16];
#pragma unroll
        for (int i = 0; i < 16; ++i) { const bf16_t* pr = GZ + (row0 + 16 * half + i) * 16;
            const pg8::f32x4 z0 = ld_bf16x4(pr), z1 = ld_bf16x4(pr + 4), z2 = ld_bf16x4(pr + 8), z3 = ld_bf16x4(pr + 12);
            float acc = gbv;
#pragma unroll
            for (int e = 0; e < 4; ++e) acc += z0[e] * wc[e] + z1[e] * wc[4 + e] + z2[e] * wc[8 + e] + z3[e] * wc[12 + e];
            g[i] = -softplusf(-acc) * (1.0f / 16.0f); }
#pragma unroll
        for (int i = 1; i < 16; ++i) g[i] += g[i - 1];
        const float other = __shfl(g[15], d);
        if (half) {
#pragma unroll
            for (int i = 0; i < 16; ++i) g[i] += other; }
        const float glast = __shfl(g[15], 32 + d);
#pragma unroll
        for (int i = 0; i < 16; ++i) { const int tok = 16 * half + i; const bf16_t* pr = proj + (row0 + tok) * PW;
            const float qv = bf2f(pr[P_GQ + h * 32 + d]), kv = bf2f(pr[P_GK + h * 32 + d]);
            const unsigned qb = f2bf(qv * 0.17677669529663687f * __expf(g[i]));
            Qs[tok * RS + d] = (bf16_t)qb; QS[((size_t)it * 32 + tok) * 32 + d] = (bf16_t)qb;
            Ks[tok * RS + d] = (bf16_t)f2bf(kv * __expf(-g[i])); KdT[d * RS + tok] = (bf16_t)f2bf(kv * __expf(glast - g[i])); }
        if (half) CDp[it * 32 + d] = __expf(glast);
        { const bf16_t* vp = proj + row0 * PW + P_GV + h * 64 + lane;
#pragma unroll
          for (int t2 = 0; t2 < 16; ++t2) { const unsigned lo = vp[(size_t)(2 * t2) * PW], hi = vp[(size_t)(2 * t2 + 1) * PW]; *(LAS unsigned*)(VTl + lane * RS + 2 * t2) = lo | (hi << 16); } }
        asm volatile("s_waitcnt lgkmcnt(0)" ::: "memory");
        f32x16 X;
#pragma unroll
        for (int e = 0; e < 16; ++e) X[e] = 0.f;
#pragma unroll
        for (int s = 0; s < 2; ++s) X = __builtin_amdgcn_mfma_f32_32x32x16_bf16(*(const LAS pg8::bf16x8*)(Ks + r * RS + 16 * s + 8 * hg), *(const LAS pg8::bf16x8*)(Qs + r * RS + 16 * s + 8 * hg), X, 0, 0, 0);
#pragma unroll
        for (int e = 0; e < 16; ++e) { const int jrow = (e & 3) + 8 * (e >> 2) + 4 * hg; if (jrow > r) X[e] = 0.f; }
        f32x16 oi[2], ut[2];
#pragma unroll
        for (int e = 0; e < 16; ++e) { oi[0][e] = 0.f; oi[1][e] = 0.f; ut[0][e] = 0.f; ut[1][e] = 0.f; }
#pragma unroll
        for (int s = 0; s < 2; ++s) {
            pg8::u32x4 pw; pw.x = pk2(X[8 * s], X[8 * s + 1]); pw.y = pk2(X[8 * s + 2], X[8 * s + 3]); pw.z = pk2(X[8 * s + 4], X[8 * s + 5]); pw.w = pk2(X[8 * s + 6], X[8 * s + 7]);
            const pg8::bf16x8 xf = __builtin_bit_cast(pg8::bf16x8, pw);
            const pg8::bf16x8 kdf = *(const LAS pg8::bf16x8*)(KdT + r * RS + 16 * s + 8 * hg);
#pragma unroll
            for (int db = 0; db < 2; ++db) { const LAS bf16_t* vp = VTl + (db * 32 + r) * RS + 16 * s;
                const pg8::u32x2 v0 = *(const LAS pg8::u32x2*)(vp + 4 * hg), v1 = *(const LAS pg8::u32x2*)(vp + 8 + 4 * hg);
                pg8::u32x4 vw; vw.x = v0.x; vw.y = v0.y; vw.z = v1.x; vw.w = v1.y;
                oi[db] = __builtin_amdgcn_mfma_f32_32x32x16_bf16(__builtin_bit_cast(pg8::bf16x8, vw), xf, oi[db], 0, 0, 0);
                ut[db] = __builtin_amdgcn_mfma_f32_32x32x16_bf16(*(const LAS pg8::bf16x8*)(vp + 8 * hg), kdf, ut[db], 0, 0, 0); } }
        float* op = OI + (size_t)it * 2048 + lane;
#pragma unroll
        for (int db = 0; db < 2; ++db)
#pragma unroll
            for (int e = 0; e < 16; ++e) op[(db * 16 + e) * 64] = oi[db][e];
        float* up = GU + ((size_t)it * 32 + r) * 64 + 4 * hg;
#pragma unroll
        for (int db = 0; db < 2; ++db)
#pragma unroll
            for (int q = 0; q < 4; ++q) *(pg8::f32x4*)(up + db * 32 + 8 * q) = (pg8::f32x4){ut[db][4 * q], ut[db][4 * q + 1], ut[db][4 * q + 2], ut[db][4 * q + 3]};
        asm volatile("s_waitcnt lgkmcnt(0)" ::: "memory");
    }
}
__device__ __forceinline__ void ph_gla_prefix(Frame& F, ArgsP a) {
    const float* CDp = (const float*)(a->ws + SCR_EG) + (size_t)M * 128; const float* GU = (const float*)(a->ws + SCR_GU); bf16_t* ST = (bf16_t*)(a->ws + WS_GST);
    int lane = F.lane(); asm volatile("" : "+v"(lane));
    for (int it = F.gw; it < 1024; it += F.NGW) { const int bh = it >> 5, d = it & 31;
        const float* gp = GU + ((size_t)bh * 64 * 32 + d) * 64 + lane; const float* cp = CDp + (size_t)bh * 64 * 32 + d;
        bf16_t* sp = ST + ((size_t)bh * 64 * 64 + lane) * 32 + d;
        float u[64], cd[64];
#pragma unroll
        for (int n = 0; n < 64; ++n) { u[n] = gp[(size_t)n * 2048]; cd[n] = cp[n * 32]; }
        float S = 0.f;
#pragma unroll
        for (int n = 0; n < 64; ++n) { sp[(size_t)n * 2048] = (bf16_t)f2bf(S); S = cd[n] * S + u[n]; } }
}
__device__ __forceinline__ void ph_gla_p2(Frame& F, ArgsP a, int l) {
    const bf16_t* proj = (const bf16_t*)(a->ws + WS_PROJ); const float* gnorm = (const float*)a->in[12] + l * 64;
    const bf16_t* QS = (const bf16_t*)(a->ws + SCR_EG); const bf16_t* ST = (const bf16_t*)(a->ws + WS_GST); const float* OI = (const float*)(a->ws + WS_GOI); bf16_t* br = (bf16_t*)(a->ws + WS_HB);
    int lane = F.lane(); asm volatile("" : "+v"(lane));
    const int r = lane & 31, hg = lane >> 5;
    for (int it = F.gw; it < 2048; it += F.NGW) {
        const int bh = it >> 6, n = it & 63, b = bh >> 2, h = bh & 3; const size_t row0 = (size_t)b * T + n * 32;
        f32x16 ot[2]; const float* op = OI + (size_t)it * 2048 + lane;
#pragma unroll
        for (int db = 0; db < 2; ++db)
#pragma unroll
            for (int e = 0; e < 16; ++e) ot[db][e] = op[(db * 16 + e) * 64];
#pragma unroll
        for (int s = 0; s < 2; ++s) { const pg8::bf16x8 qf = *(const pg8::bf16x8*)(QS + ((size_t)it * 32 + r) * 32 + 16 * s + 8 * hg);
#pragma unroll
            for (int db = 0; db < 2; ++db) ot[db] = __builtin_amdgcn_mfma_f32_32x32x16_bf16(*(const pg8::bf16x8*)(ST + ((size_t)it * 64 + db * 32 + r) * 32 + 16 * s + 8 * hg), qf, ot[db], 0, 0, 0); }
        float ss = 0.f;
#pragma unroll
        for (int db = 0; db < 2; ++db)
#pragma unroll
            for (int e = 0; e < 16; ++e) ss += ot[db][e] * ot[db][e];
        ss += __shfl_xor(ss, 32);
        const float rstd = rsqrtf(ss * (1.0f / 64.0f) + 1e-6f);
        const bf16_t* og = proj + (row0 + r) * PW + P_GO + h * 64 + 4 * hg; bf16_t* od = br + (row0 + r) * D + h * 64 + 4 * hg;
#pragma unroll
        for (int db = 0; db < 2; ++db)
#pragma unroll
            for (int q = 0; q < 4; ++q) { const int dv0 = db * 32 + 8 * q; const pg8::f32x4 gv = ld_bf16x4(og + dv0), gn = *(const pg8::f32x4*)(gnorm + dv0 + 4 * hg);
                st_bf16x4(od + dv0, (pg8::f32x4){ot[db][4 * q] * rstd * gn[0] * siluf(gv[0]), ot[db][4 * q + 1] * rstd * gn[1] * siluf(gv[1]), ot[db][4 * q + 2] * rstd * gn[2] * siluf(gv[2]), ot[db][4 * q + 3] * rstd * gn[3] * siluf(gv[3])}); }
    }
}

__device__ __forceinline__ void ph_attn_prep(Frame& F, ArgsP a) {
    const bf16_t* proj = (const bf16_t*)(a->ws + WS_PROJ); const int* pos = (const int*)a->in[2];
    bf16_t* QR = (bf16_t*)(a->ws + SCR_QK); bf16_t* KR = QR + (size_t)M * 256; bf16_t* VT = (bf16_t*)(a->ws + SCR_VT);
    int lane = F.lane(); asm volatile("" : "+v"(lane));
    for (int idx = F.gw * 64 + lane; idx < M * 8; idx += F.NGW * 64) { const int row = idx >> 3, hc = idx & 7; const float p = (float)pos[row];
        const bf16_t* qs = proj + (size_t)row * PW + P_DQ + hc * 32; const bf16_t* ks = proj + (size_t)row * PW + P_DK + hc * 32;
        float qv[32], kv[32];
#pragma unroll
        for (int j = 0; j < 8; ++j) { const pg8::f32x4 q4 = ld_bf16x4(qs + 4 * j), k4 = ld_bf16x4(ks + 4 * j);
#pragma unroll
            for (int e = 0; e < 4; ++e) { qv[4 * j + e] = q4[e]; kv[4 * j + e] = k4[e]; } }
        float qo[32], ko[32];
#pragma unroll
        for (int i = 0; i < 16; ++i) { const float inv = exp2f(-(float)i * 0.8304820237218406f);
            float sn, cs; sincosf(p * inv, &sn, &cs);
            qo[i] = qv[i] * cs - qv[i + 16] * sn; qo[i + 16] = qv[i] * sn + qv[i + 16] * cs;
            ko[i] = kv[i] * cs - kv[i + 16] * sn; ko[i + 16] = kv[i] * sn + kv[i + 16] * cs; }
        const float qsc = 0.17677669529663687f * 1.4426950408889634f;
        bf16_t* qd = QR + (size_t)row * 256 + hc * 32; bf16_t* kd = KR + (size_t)row * 256 + hc * 32;
#pragma unroll
        for (int j = 0; j < 8; ++j) { st_bf16x4(qd + 4 * j, (pg8::f32x4){qo[4 * j] * qsc, qo[4 * j + 1] * qsc, qo[4 * j + 2] * qsc, qo[4 * j + 3] * qsc});
            st_bf16x4(kd + 4 * j, (pg8::f32x4){ko[4 * j], ko[4 * j + 1], ko[4 * j + 2], ko[4 * j + 3]}); } }
    for (int it = F.gw; it < 1024; it += F.NGW) { const int bh = it >> 5, tt = it & 31, b = bh >> 2, h = bh & 3;
        const bf16_t* vs = proj + ((size_t)b * T + tt * 64 + lane) * PW + P_DV + h * 64;
        pg8::u32x4 v[8];
#pragma unroll
        for (int j = 0; j < 8; ++j) v[j] = *(const pg8::u32x4*)(vs + 8 * j);
        bf16_t* vd = VT + (size_t)bh * 64 * T + tt * 64 + lane;
#pragma unroll
        for (int j = 0; j < 8; ++j)
#pragma unroll
            for (int e = 0; e < 4; ++e) { const unsigned w = v[j][e]; vd[(size_t)(8 * j + 2 * e) * T] = (bf16_t)(w & 0xffffu); vd[(size_t)(8 * j + 2 * e + 1) * T] = (bf16_t)(w >> 16); } }
}
__device__ __forceinline__ void ph_attn(Frame& F, ArgsP a, int l) {
    const bf16_t* QR = (const bf16_t*)(a->ws + SCR_QK); const bf16_t* KR = QR + (size_t)M * 256; const bf16_t* VT = (const bf16_t*)(a->ws + SCR_VT);
    const float* lp = (const float*)a->in[13] + l * 128; const float* subln = (const float*)a->in[14] + l * 64; bf16_t* br = (bf16_t*)(a->ws + WS_HB);
    int tid = F.wave * 64 + F.lane(); asm volatile("" : "+v"(tid)); const int lane = tid & 63;
    const int r = lane & 31, hg = lane >> 5, comp = F.wave & 1, qs = F.wave >> 1;
    constexpr int RS = 72;
    LAS bf16_t* Kt = (LAS bf16_t*)F.lds;
    LAS bf16_t* Vt = Kt + 2 * 64 * RS;
    LAS float* Xl = (LAS float*)(F.lds + 4 * 64 * RS * 2);
    float lam, lam_init;
    { float d01 = 0.f, d23 = 0.f;
      for (int i = 0; i < 32; ++i) { d01 += lp[i] * lp[32 + i]; d23 += lp[64 + i] * lp[96 + i]; }
      lam_init = 0.8f - 0.6f * __expf(-0.3f * (float)l); lam = __expf(d01) - __expf(d23) + lam_init; }
    const int ldrow = tid >> 3, ldch = tid & 7;
    for (int pi = blockIdx.x; pi < 256; pi += F.G) {
#pragma unroll 1
        for (int half = 0; half < 2; ++half) {
            const int bh = pi >> 3, j = pi & 7, qb = half == 0 ? 15 - j : j, b = bh >> 2, h = bh & 3;
            const int q0 = qb * 128 + qs * 32, nkw = q0 / 64 + 1, nkb = 2 * qb + 2;
            const size_t rowb = (size_t)b * T;
            pg8::bf16x8 qf[2];
#pragma unroll
            for (int s = 0; s < 2; ++s) qf[s] = *(const pg8::bf16x8*)(QR + (rowb + q0 + r) * 256 + h * 64 + comp * 32 + 16 * s + 8 * hg);
            f32x16 ot[2];
#pragma unroll
            for (int e = 0; e < 16; ++e) { ot[0][e] = 0.f; ot[1][e] = 0.f; }
            float mrun = -1e30f, lrun = 0.f;
            const bf16_t* kg = KR + (rowb + ldrow) * 256 + h * 64 + ldch * 8; const bf16_t* vg = VT + ((size_t)bh * 64 + ldrow) * T + ldch * 8;
            pg8::u32x4 kreg = *(const pg8::u32x4*)kg, vreg = *(const pg8::u32x4*)vg;
            pg8::u32x4 kreg2 = kreg, vreg2 = vreg;
            if (nkb > 1) { kreg2 = *(const pg8::u32x4*)(kg + (size_t)64 * 256); vreg2 = *(const pg8::u32x4*)(vg + 64); }
            for (int kt = 0; kt < nkb; ++kt) {
                const int bo = (kt & 1) * 64 * RS;
                *(LAS pg8::u32x4*)(Kt + bo + ldrow * RS + ldch * 8) = kreg; *(LAS pg8::u32x4*)(Vt + bo + ldrow * RS + ldch * 8) = vreg;
                __syncthreads();
                kreg = kreg2; vreg = vreg2;
                if (kt + 2 < nkb) { kreg2 = *(const pg8::u32x4*)(kg + (size_t)(kt + 2) * 64 * 256); vreg2 = *(const pg8::u32x4*)(vg + (kt + 2) * 64); }
                if (kt < nkw) {
                    f32x16 st[2];
#pragma unroll
                    for (int kb = 0; kb < 2; ++kb) {
#pragma unroll
                        for (int e = 0; e < 16; ++e) st[kb][e] = 0.f;
#pragma unroll
                        for (int s = 0; s < 2; ++s) { const pg8::bf16x8 kf = *(const LAS pg8::bf16x8*)(Kt + bo + (kb * 32 + r) * RS + comp * 32 + 16 * s + 8 * hg);
                            st[kb] = __builtin_amdgcn_mfma_f32_32x32x16_bf16(kf, qf[s], st[kb], 0, 0, 0); } }
                    if (kt == nkw - 1) {
                        const int qi = q0 + r;
#pragma unroll
                        for (int kb = 0; kb < 2; ++kb)
#pragma unroll
                            for (int e = 0; e < 16; ++e) { const int ki = kt * 64 + kb * 32 + (e & 3) + 8 * (e >> 2) + 4 * hg; if (ki > qi) st[kb][e] = -1e30f; } }
                    float tm = st[0][0];
#pragma unroll
                    for (int e = 1; e < 16; ++e) tm = fmaxf(tm, st[0][e]);
#pragma unroll
                    for (int e = 0; e < 16; ++e) tm = fmaxf(tm, st[1][e]);
                    tm = fmaxf(tm, __shfl_xor(tm, 32));
                    const float mn = fmaxf(mrun, tm), alpha = exp2f(mrun - mn); mrun = mn;
                    float ps = 0.f;
#pragma unroll
                    for (int kb = 0; kb < 2; ++kb)
#pragma unroll
                        for (int e = 0; e < 16; ++e) { st[kb][e] = exp2f(st[kb][e] - mn); ps += st[kb][e]; }
                    lrun = lrun * alpha + ps;
#pragma unroll
                    for (int e = 0; e < 16; ++e) { ot[0][e] *= alpha; ot[1][e] *= alpha; }
#pragma unroll
                    for (int kb = 0; kb < 2; ++kb)
#pragma unroll
                        for (int s = 0; s < 2; ++s) {
                            pg8::u32x4 pw; pw.x = pk2(st[kb][8 * s], st[kb][8 * s + 1]); pw.y = pk2(st[kb][8 * s + 2], st[kb][8 * s + 3]); pw.z = pk2(st[kb][8 * s + 4], st[kb][8 * s + 5]); pw.w = pk2(st[kb][8 * s + 6], st[kb][8 * s + 7]);
                            const pg8::bf16x8 pf = __builtin_bit_cast(pg8::bf16x8, pw);
#pragma unroll
                            for (int dvb = 0; dvb < 2; ++dvb) { const LAS bf16_t* vp = Vt + bo + (dvb * 32 + r) * RS + kb * 32 + 16 * s + 4 * hg;
                                const pg8::u32x2 v0 = *(const LAS pg8::u32x2*)vp, v1 = *(const LAS pg8::u32x2*)(vp + 8);
                                pg8::u32x4 vw; vw.x = v0.x; vw.y = v0.y; vw.z = v1.x; vw.w = v1.y;
                                ot[dvb] = __builtin_amdgcn_mfma_f32_32x32x16_bf16(__builtin_bit_cast(pg8::bf16x8, vw), pf, ot[dvb], 0, 0, 0); } }
                }
            }
            const float ltot = lrun + __shfl_xor(lrun, 32); const float il = 1.0f / ltot;
            __syncthreads();
            if (comp == 1) {
#pragma unroll
                for (int dvb = 0; dvb < 2; ++dvb)
#pragma unroll
                    for (int e = 0; e < 16; ++e) Xl[(qs * 32 + dvb * 16 + e) * 64 + lane] = ot[dvb][e] * il; }
            __syncthreads();
            if (comp == 0) {
                float o[32]; float ss = 0.f;
#pragma unroll
                for (int dvb = 0; dvb < 2; ++dvb)
#pragma unroll
                    for (int e = 0; e < 16; ++e) { const float v = ot[dvb][e] * il - lam * Xl[(qs * 32 + dvb * 16 + e) * 64 + lane]; o[dvb * 16 + e] = v; ss += v * v; }
                ss += __shfl_xor(ss, 32);
                const float sc = rsqrtf(ss * (1.0f / 64.0f) + 1e-6f) * (1.0f - lam_init);
                bf16_t* od = br + (rowb + q0 + r) * D + 256 + h * 64;
#pragma unroll
                for (int dvb = 0; dvb < 2; ++dvb)
#pragma unroll
                    for (int g4 = 0; g4 < 4; ++g4) { const int dv0 = dvb * 32 + 8 * g4 + 4 * hg; const pg8::f32x4 sl = *(const pg8::f32x4*)(subln + dv0);
                        st_bf16x4(od + dv0, (pg8::f32x4){o[dvb * 16 + 4 * g4] * sc * sl[0], o[dvb * 16 + 4 * g4 + 1] * sc * sl[1], o[dvb * 16 + 4 * g4 + 2] * sc * sl[2], o[dvb * 16 + 4 * g4 + 3] * sc * sl[3]}); }
            }
            __syncthreads();
        }
    }
}

__device__ __forceinline__ void ph_branch(Frame& F, ArgsP a, int l) {
    const bf16_t* br = (const bf16_t*)(a->ws + WS_HB); const bf16_t* WB = (const bf16_t*)(a->ws + WS_WB) + (size_t)l * 4096 * 256;
    const bf16_t* proj = (const bf16_t*)(a->ws + WS_PROJ); bf16_t* MB = (bf16_t*)(a->ws + SCR_MB);
    int tid = F.wave * 64 + F.lane(); asm volatile("" : "+v"(tid)); const int lane = tid & 63;
    const int r = lane & 31, hg = lane >> 5, wt = (tid >> 6) & 3, wd = tid >> 8;
    constexpr int RS = 72, TB = 128 * RS;
    LAS bf16_t* Wl = (LAS bf16_t*)F.lds;
    LAS bf16_t* Bl = Wl + 2 * TB;
    const int ldr = tid >> 3, ldc = (tid & 7) * 8;
    for (int it = blockIdx.x; it < 1024; it += F.G) {
        const int tm = it >> 3, td = it & 7; const size_t row0 = (size_t)tm * 128; const int d0 = td * 128;
        f32x16 tot[2], acc[2];
#pragma unroll
        for (int e = 0; e < 16; ++e) { tot[0][e] = 0.f; tot[1][e] = 0.f; acc[0][e] = 0.f; acc[1][e] = 0.f; }
        pg8::u32x4 rw0, rw1, rb0, rb1;
#define BR_LOAD(st) do { const int g_ = (st) >> 2, kq_ = (st) & 3; const bf16_t* wp = WB + (size_t)(g_ * 1024 + d0 + ldr) * 256 + kq_ * 64 + ldc; const bf16_t* bp = br + (row0 + ldr) * D + g_ * 256 + kq_ * 64 + ldc; \
            rw0 = *(const pg8::u32x4*)wp; rw1 = *(const pg8::u32x4*)(wp + 64 * 256); rb0 = *(const pg8::u32x4*)bp; rb1 = *(const pg8::u32x4*)(bp + 64 * D); } while (0)
#define BR_WRITE(buf) do { *(LAS pg8::u32x4*)(Wl + (buf) * TB + ldr * RS + ldc) = rw0; *(LAS pg8::u32x4*)(Wl + (buf) * TB + (ldr + 64) * RS + ldc) = rw1; \
            *(LAS pg8::u32x4*)(Bl + (buf) * TB + ldr * RS + ldc) = rb0; *(LAS pg8::u32x4*)(Bl + (buf) * TB + (ldr + 64) * RS + ldc) = rb1; } while (0)
        BR_LOAD(0); BR_WRITE(0); __syncthreads(); BR_LOAD(1);
        pg8::u32x2 gt[2][4];
#pragma unroll 1
        for (int st = 0; st < 16; ++st) {
            const int buf = st & 1, g = st >> 2;
            if ((st & 3) == 0) {
                const bf16_t* gp = proj + (row0 + wt * 32 + r) * PW + P_GATE + g * 1024 + d0 + wd * 64 + 4 * hg;
#pragma unroll
                for (int db = 0; db < 2; ++db)
#pragma unroll
                    for (int q = 0; q < 4; ++q) gt[db][q] = *(const pg8::u32x2*)(gp + db * 32 + 8 * q); }
#pragma unroll
            for (int s = 0; s < 4; ++s) { const pg8::bf16x8 bf = *(const LAS pg8::bf16x8*)(Bl + buf * TB + (wt * 32 + r) * RS + 16 * s + 8 * hg);
#pragma unroll
                for (int db = 0; db < 2; ++db) { const pg8::bf16x8 af = *(const LAS pg8::bf16x8*)(Wl + buf * TB + (wd * 64 + db * 32 + r) * RS + 16 * s + 8 * hg);
                    acc[db] = __builtin_amdgcn_mfma_f32_32x32x16_bf16(af, bf, acc[db], 0, 0, 0); } }
            if (st + 1 < 16) BR_WRITE(buf ^ 1);
            if (st + 2 < 16) BR_LOAD(st + 2);
            if ((st & 3) == 3) {
#pragma unroll
                for (int db = 0; db < 2; ++db)
#pragma unroll
                    for (int q = 0; q < 4; ++q) { const pg8::u32x2 w = gt[db][q];
                        const float g0 = __builtin_bit_cast(float, w.x << 16), g1 = __builtin_bit_cast(float, w.x & 0xffff0000u), g2 = __builtin_bit_cast(float, w.y << 16), g3 = __builtin_bit_cast(float, w.y & 0xffff0000u);
                        tot[db][4 * q] += acc[db][4 * q] * sigm(g0); tot[db][4 * q + 1] += acc[db][4 * q + 1] * sigm(g1); tot[db][4 * q + 2] += acc[db][4 * q + 2] * sigm(g2); tot[db][4 * q + 3] += acc[db][4 * q + 3] * sigm(g3);
                        acc[db][4 * q] = 0.f; acc[db][4 * q + 1] = 0.f; acc[db][4 * q + 2] = 0.f; acc[db][4 * q + 3] = 0.f; } }
            __syncthreads();
        }
#undef BR_LOAD
#undef BR_WRITE
        bf16_t* mp = MB + (row0 + wt * 32 + r) * D + d0 + wd * 64 + 4 * hg;
#pragma unroll
        for (int db = 0; db < 2; ++db)
#pragma unroll
            for (int q = 0; q < 4; ++q) st_bf16x4(mp + db * 32 + 8 * q, (pg8::f32x4){tot[db][4 * q], tot[db][4 * q + 1], tot[db][4 * q + 2], tot[db][4 * q + 3]});
    }
}
constexpr int RING_BYTES = 131072, LDSCTL_OFF = RING_BYTES, MISC_OFF = LDSCTL_OFF + 320, LDS_BYTES = 147456;
constexpr int PH_PRO = 0, PH_H0 = 1, PH_L0 = 2, PH_PER_LAYER = 12, PH_END = PH_L0 + 2 * PH_PER_LAYER;
constexpr int PL_PROJ = 0, PL_MIXA = 1, PL_MIXB = 2, PL_MIXC = 3, PL_BRANCH = 4, PL_OUT = 5, PL_ROWMIX = 6, PL_FFN1 = 7, PL_FFN2 = 8, PL_FFN3 = 9, PL_ROWFFN = 10;

#ifndef DUPMASK
#define DUPMASK 0
#endif
#define DUP(bit) for (int dup_ = 0; dup_ < (((DUPMASK) >> (bit)) & 1) + 1; ++dup_)
__global__ void __launch_bounds__(NTHR, 2) mk_fwd(Args a) {
    extern __shared__ __attribute__((aligned(16))) unsigned char lds_raw[];
    Frame F0;
    F0.lds = (LAS unsigned char*)lds_raw;
    F0.wave = __builtin_amdgcn_readfirstlane(threadIdx.x >> 6);
    F0.G = gridDim.x; F0.gw = blockIdx.x * NWAVES + F0.wave; F0.NGW = F0.G * NWAVES;
    volatile LAS unsigned* MISC = (volatile LAS unsigned*)(F0.lds + MISC_OFF);
    for (int u = threadIdx.x; u < (LDS_BYTES - LDSCTL_OFF) / 4; u += NTHR) ((LAS unsigned*)(F0.lds + LDSCTL_OFF))[u] = 0u;
    __syncthreads();
    unsigned* ctl = (unsigned*)(a.ws + WS_CTL);
    const int lo = a.ph_lo, hi = a.ph_hi;
    XcdBarrier bar; bar.bar = ctl + CW_BAR; bar.x = 0; bar.st = nullptr;
    if (hi - lo > 1) bar = xcd_barrier_post(ctl + CW_BAR, MISC + 8);
#define IN(k) (lo <= (k) && (k) < hi)
#define SEAM(k) do { if (IN(k) && IN((k) + 1)) { xcd_barrier(bar); if ((DUPMASK >> 12) & 1) xcd_barrier(bar); } } while (0)
    if (IN(PH_PRO)) DUP(0) { ArgsP A = fresh_args(); Frame F = fresh(F0); p0_mod_items(F, (const float*)A->in[1], (const float*)A->in[3], (const float*)A->in[4], (float*)(A->ws + WS_MOD)); p0_convert(F, A); }
    SEAM(PH_PRO);
    if (IN(PH_H0)) DUP(9) { Frame F = fresh(F0); ph_h0(F, fresh_args()); }
    SEAM(PH_H0);
    for (int l = 0; l < NL; ++l) {
        const int base = PH_L0 + l * PH_PER_LAYER;
        if (IN(base + PL_PROJ)) DUP(13) { ArgsP A = fresh_args(); Frame F = fresh(F0); unsigned char* ws = A->ws;
            pg8::Gemm g{(const bf16_t*)(ws + WS_HB), (const bf16_t*)(ws + WS_WIN) + (size_t)l * PW * 1024, 1024, 1024, 1024, 0}; pg8::StaticOrder S; S.init(M, 7168, F.G, (int)blockIdx.x);
            pg8::EpiBf16 E{(bf16_t*)(ws + WS_PROJ), PW, 28};
            pg8::gemm_phase<pg8::EpiBf16, pg8::StaticOrder, true>(F.lds, g, S, E, F.wave);
        }
        SEAM(base + PL_PROJ);
        if (IN(base + PL_MIXA)) { DUP(2) { Frame F = fresh(F0); ph_conv(F, fresh_args(), l); } DUP(6) { Frame F = fresh(F0); ph_rwkv_prep(F, fresh_args(), l); } DUP(7) { Frame F = fresh(F0); ph_gla_p1(F, fresh_args(), l); } DUP(8) { Frame F = fresh(F0); ph_attn_prep(F, fresh_args()); } }
        SEAM(base + PL_MIXA);
        if (IN(base + PL_MIXB)) { DUP(10) { Frame F = fresh(F0); ph_gla_prefix(F, fresh_args()); } DUP(3) { Frame F = fresh(F0); ph_rwkv_scan(F, fresh_args()); } DUP(4) { Frame F = fresh(F0); ph_attn(F, fresh_args(), l); } }
        SEAM(base + PL_MIXB);
        if (IN(base + PL_MIXC)) { DUP(5) { Frame F = fresh(F0); ph_rwkv_post(F, fresh_args(), l); } DUP(11) { Frame F = fresh(F0); ph_gla_p2(F, fresh_args(), l); } }
        SEAM(base + PL_MIXC);
        if (IN(base + PL_BRANCH)) DUP(14) { ArgsP A = fresh_args(); Frame F = fresh(F0); unsigned char* ws = A->ws;
            pg8::Gemm g{(const bf16_t*)(ws + WS_HB), (const bf16_t*)(ws + WS_WB) + (size_t)l * 1024 * 1024, 1024, 1024, 1024, 0}; pg8::StaticOrder S; S.init(M, 1024, F.G, (int)blockIdx.x);
            pg8::EpiBranchK E{(const bf16_t*)(ws + WS_PROJ), (bf16_t*)(ws + SCR_MB)};
            pg8::gemm_phase<pg8::EpiBranchK, pg8::StaticOrder, false>(F.lds, g, S, E, F.wave);
        }
        SEAM(base + PL_BRANCH);
        if (IN(base + PL_OUT)) DUP(1) { ArgsP A = fresh_args(); Frame F = fresh(F0); unsigned char* ws = A->ws;
            pg8::Gemm g{(const bf16_t*)(ws + SCR_MB), (const bf16_t*)(ws + WS_WO) + (size_t)l * 1024 * 1024, 1024, 1024, 1024, 0}; pg8::StaticOrder S; S.init(M, 1024, F.G, (int)blockIdx.x);
            pg8::EpiBf16 E{(bf16_t*)(ws + SCR_Y), 1024, 4};
            pg8::gemm_phase<pg8::EpiBf16, pg8::StaticOrder, false>(F.lds, g, S, E, F.wave);
        }
        SEAM(base + PL_OUT);
        if (IN(base + PL_ROWMIX)) { ArgsP A = fresh_args(); Frame F = fresh(F0); unsigned char* ws = A->ws; const float* modl = (const float*)(ws + WS_MOD) + (size_t)l * 8 * 6144;
            ph_row(F, A, l == 0 ? (const float*)A->in[0] : A->out, (const bf16_t*)(ws + SCR_Y), (const float*)A->in[6] + l * D, modl, 2048, (const float*)A->in[7] + l * D, modl, 3072, 4096, (bf16_t*)(ws + (l == 0 ? WS_HB : WS_H2L1)), l == 1); }
        SEAM(base + PL_ROWMIX);
        if (l == 0) {
            if (IN(base + PL_FFN1)) DUP(1) { ArgsP A = fresh_args(); Frame F = fresh(F0); unsigned char* ws = A->ws;
                pg8::Gemm g{(const bf16_t*)(ws + WS_HB), (const bf16_t*)(ws + WS_WF1), 1024, 1024, 1024, 0}; pg8::StaticOrder S; S.init(M, 2 * DFF, F.G, (int)blockIdx.x);
                pg8::EpiSwiglu E{(bf16_t*)(ws + WS_PROJ), DFF, 2 * DFF / 256};
                pg8::gemm_phase<pg8::EpiSwiglu, pg8::StaticOrder, true>(F.lds, g, S, E, F.wave);
            }
            SEAM(base + PL_FFN1);
            if (IN(base + PL_FFN2)) DUP(1) { ArgsP A = fresh_args(); Frame F = fresh(F0); unsigned char* ws = A->ws;
                pg8::Gemm g{(const bf16_t*)(ws + WS_PROJ), (const bf16_t*)(ws + WS_WF2), DFF, DFF, DFF, 0}; pg8::StaticOrder S; S.init(M, 1024, F.G, (int)blockIdx.x);
                pg8::EpiBf16 E{(bf16_t*)(ws + SCR_Y), 1024, 4};
                pg8::gemm_phase<pg8::EpiBf16, pg8::StaticOrder, false>(F.lds, g, S, E, F.wave);
            }
            SEAM(base + PL_FFN2);
        } else {
            if (IN(base + PL_FFN1)) DUP(0) { Frame F = fresh(F0); ph_moe_prep(F, fresh_args()); }
            SEAM(base + PL_FFN1);
            if (IN(base + PL_FFN2)) DUP(15) { ArgsP A = fresh_args(); Frame F = fresh(F0); unsigned char* ws = A->ws; const unsigned* cnt = (const unsigned*)(ws + WS_CTL) + CW_CNT;
                pg8::Gemm g{(const bf16_t*)(ws + WS_HG), (const bf16_t*)(ws + WS_WM1), 1024, 1024, 1024, 0}; pg8::MoeOrder S; S.init(cnt, F.G, (int)blockIdx.x, 28);
                pg8::EpiSwiglu E{(bf16_t*)(ws + WS_HID), DEX, 28};
                pg8::gemm_phase<pg8::EpiSwiglu, pg8::MoeOrder, true>(F.lds, g, S, E, F.wave);
            }
            SEAM(base + PL_FFN2);
            if (IN(base + PL_FFN3)) DUP(16) { ArgsP A = fresh_args(); Frame F = fresh(F0); unsigned char* ws = A->ws; const unsigned* cnt = (const unsigned*)(ws + WS_CTL) + CW_CNT;
                pg8::Gemm g{(const bf16_t*)(ws + WS_HID), (const bf16_t*)(ws + WS_WM2), DEX, DEX, DEX, 0}; pg8::MoeOrder S; S.init(cnt, F.G, (int)blockIdx.x, 4);
                pg8::EpiBf16 E{(bf16_t*)(ws + WS_HG), 1024, 4};
                pg8::gemm_phase<pg8::EpiBf16, pg8::MoeOrder, true>(F.lds, g, S, E, F.wave);
            }
            SEAM(base + PL_FFN3);
        }
        if (IN(base + PL_ROWFFN)) { ArgsP A = fresh_args(); Frame F = fresh(F0); unsigned char* ws = A->ws; const float* modl = (const float*)(ws + WS_MOD) + (size_t)l * 8 * 6144;
            const bool last = (l == NL - 1);
            if (l == 0) ph_row(F, A, A->out, (const bf16_t*)(ws + SCR_Y), (const float*)A->in[8], modl, 5120, (const float*)A->in[5] + D, modl + 8 * 6144, 0, 1024, (bf16_t*)(ws + WS_HB), false, nullptr, (const float*)A->in[9] + (size_t)1024 * NIN);
            else ph_row(F, A, A->out, nullptr, (const float*)A->in[8] + D, modl, 5120, nullptr, nullptr, 0, 1024, nullptr, false, (const bf16_t*)(ws + WS_HG));
        }
        SEAM(base + PL_ROWFFN);
    }
#undef IN
#undef SEAM
}

extern "C" void kernel_launch(void* const* d_in, const int* in_sizes, int n_in, void* d_out, int out_size, void* d_ws, size_t ws_size, hipStream_t stream) {
    static int grid = 0;
    if (grid == 0) {
        if (n_in != 40 || ws_size < WS_END) { fprintf(stderr, "kernel_launch: need 40 inputs and >= %zu bytes of workspace (got %d, %zu)\n", (size_t)WS_END, n_in, ws_size); grid = -1; return; }
        int dev = 0, cus = 0, per_cu = 0;
        (void)hipGetDevice(&dev); (void)hipDeviceGetAttribute(&cus, hipDeviceAttributeMultiprocessorCount, dev);
        (void)hipFuncSetAttribute((const void*)mk_fwd, hipFuncAttributeMaxDynamicSharedMemorySize, LDS_BYTES);
        (void)hipOccupancyMaxActiveBlocksPerMultiprocessor(&per_cu, (const void*)mk_fwd, NTHR, LDS_BYTES);
        (void)hipGetLastError();
        grid = cus > 0 ? cus : 256;
        if (per_cu < 1) fprintf(stderr, "kernel_launch: occupancy query says %d blocks per CU\n", per_cu);
    }
    if (grid < 0) return;
    unsigned char* ws = (unsigned char*)d_ws;
    (void)hipMemsetAsync(ws + WS_CTL, 0, CTL_ZERO_BYTES, stream);
    Args a{};
    for (int i = 0; i < 40; ++i) a.in[i] = d_in[i];
    a.out = (float*)d_out; a.ws = ws;
    a.ph_lo = 0; a.ph_hi = PH_L0 + (NL - 1) * PH_PER_LAYER + PL_ROWFFN + 1;
    hipLaunchKernelGGL(mk_fwd, dim3(grid), dim3(NTHR), LDS_BYTES, stream, a);
}
```

```cpp
#include <hip/hip_runtime.h>
#include <hip/hip_bf16.h>
#include <cstdint>
#include <cstdio>

typedef __hip_bfloat16 bf16;
typedef unsigned short bf16_t;
#define GAS __attribute__((address_space(1)))
#define LAS __attribute__((address_space(3)))

constexpr int D = 1024, NB = 8, T = 2048, M = NB * T, NL = 2;
constexpr int NIN = 7184;
constexpr int PW = 7424;
constexpr int P_GQ = 0, P_GK = 128, P_GV = 256, P_GO = 512, P_DQ = 768, P_DK = 1024, P_DV = 1280, P_CA = 1536, P_CB = 1792, P_R = 2048, P_GATE = 3072, P_GZ = 7168;
constexpr int DFF = 2816, NE = 8, DEX = 3584;
constexpr int NWAVES = 8, NTHR = 512;
constexpr size_t MiB = 1u << 20;
constexpr size_t WS_CTL = 0;
constexpr size_t CTL_ZERO_BYTES = 64 * 1024;
constexpr size_t WS_MOD = 1 * MiB;
constexpr size_t WS_ROUTE = 1 * MiB + 512 * 1024;
constexpr size_t WS_GZ = 2 * MiB + 512 * 1024;
constexpr size_t WS_LR = 3 * MiB;
constexpr size_t WS_WIN = 4 * MiB;
constexpr size_t WS_WB = 33 * MiB;
constexpr size_t WS_WO = 37 * MiB;
constexpr size_t WS_WF1 = 41 * MiB;
constexpr size_t WS_WF2 = 52 * MiB;
constexpr size_t WS_HB = 58 * MiB;
constexpr size_t WS_PROJ = 90 * MiB;
constexpr size_t WS_SCR = 322 * MiB;
constexpr size_t WS_H2L1 = 508 * MiB;
constexpr size_t WS_END = 540 * MiB;
constexpr size_t WS_HG = 4 * MiB;
constexpr size_t WS_WM1 = 72 * MiB;
constexpr size_t WS_WM2 = 184 * MiB;
constexpr size_t WS_HID = 240 * MiB;
static_assert(WS_HID + (size_t)34816 * 3584 * 2 <= WS_H2L1, "moe overlay");
constexpr size_t SCR_MP = WS_SCR;
constexpr size_t SCR_MB = WS_SCR + 64 * MiB;
constexpr size_t SCR_Y = WS_SCR + 96 * MiB;
constexpr size_t SCR_RW = WS_SCR;
constexpr size_t SCR_GK = WS_SCR + 112 * MiB;
constexpr size_t SCR_QR = WS_SCR + 120 * MiB;
constexpr size_t SCR_KR = WS_SCR + 136 * MiB;
constexpr size_t SCR_VEC6 = WS_SCR;
constexpr size_t SCR_SC = WS_SCR + 112 * MiB;
constexpr size_t SCR_YR = WS_SCR + 113 * MiB;
constexpr size_t SCR_GR = WS_SCR + 129 * MiB;
constexpr size_t SCR_VT = WS_SCR + 137 * MiB;
constexpr size_t SCR_GU = WS_SCR + 145 * MiB;
constexpr size_t SCR_GS = SCR_GU;
constexpr size_t SCR_QK = WS_SCR + 161 * MiB;
constexpr size_t SCR_EG = WS_SCR + 177 * MiB;
constexpr size_t WS_GOI = WS_H2L1;
constexpr size_t WS_GST = WS_H2L1 + 16 * MiB;
constexpr int VSTEP = 448;
constexpr int CW_TMO = 0;
constexpr int CW_BAR = 1024;
constexpr int CW_CNT = 8192;
constexpr size_t RT_LIST = 0;
constexpr size_t RT_TOKE = 512 * 1024;
constexpr size_t RT_TOKS = 640 * 1024;
constexpr size_t RT_TOKP = 768 * 1024;

__device__ __forceinline__ float sigm(float x) { return 1.0f / (1.0f + __expf(-x)); }
__device__ __forceinline__ float siluf(float x) { return x * sigm(x); }
__device__ __forceinline__ float softplusf(float x) { return fmaxf(x, 0.f) + log1pf(__expf(-fabsf(x))); }
__device__ __forceinline__ float wave_sum(float v) {
#pragma unroll
    for (int o = 32; o > 0; o >>= 1) v += __shfl_xor(v, o);
    return v;
}
__device__ __forceinline__ float wave_max(float v) {
#pragma unroll
    for (int o = 32; o > 0; o >>= 1) v = fmaxf(v, __shfl_xor(v, o));
    return v;
}
__device__ __forceinline__ float ldf(const float* p) { return *p; }
__device__ __forceinline__ float ldf(const bf16* p) { return __bfloat162float(*p); }
__device__ __forceinline__ float bf2f(bf16_t u) { return __builtin_bit_cast(float, (unsigned)u << 16); }
__device__ __forceinline__ unsigned f2bf(float f) { unsigned u = __builtin_bit_cast(unsigned, f); return (u + 0x7fffu + ((u >> 16) & 1u)) >> 16; }
__device__ __forceinline__ unsigned pk2(float lo, float hi) { return f2bf(lo) | (f2bf(hi) << 16); }
namespace pg8 {
#define PG8_LAS __attribute__((address_space(3)))
typedef short bf16x8 __attribute__((ext_vector_type(8)));
typedef float f32x4 __attribute__((ext_vector_type(4)));
typedef float f32x2 __attribute__((ext_vector_type(2)));
typedef unsigned u32x4 __attribute__((ext_vector_type(4)));
typedef unsigned u32x2 __attribute__((ext_vector_type(2)));
constexpr int BM = 256, BK = 64, HALF = 128, HTB = HALF * BK * 2  , STAGE_BYTES = 8 * HTB, NXCD = 8, WGM = 8;

__host__ __device__ __forceinline__ int lds_byte(int r, int c) { const int st = (r >> 4) * 2 + (c >> 5), rr = r & 15, cc = c & 31, ob = rr * 64 + cc * 2; return st * 1024 + (ob ^ (((ob >> 9) & 1) << 5)); }
__host__ __device__ __forceinline__ void stage_rc(int b, int& R, int& C) { const int st = b / 1024, sb = b % 1024, swz = sb ^ (((sb >> 9) & 1) << 5); R = (st >> 1) * 16 + swz / 64; C = (st & 1) * 32 + (swz % 64) / 2; }
__host__ __device__ __forceinline__ int perm32(int rho) { const int n = rho >> 4, i = rho & 15; return 8 * (i >> 2) + 4 * n + (i & 3); }

struct Unit { int pm, pn, aoff, tag; };
struct Gemm { const bf16_t* A; const bf16_t* Bt; int lda, ldb, K, pad; };

struct StaticOrder {
    int nM, nN, nwg, G, c;
    __host__ __device__ void init(int M_, int N_, int G_, int c_) { nM = M_ / BM; nN = N_ / BM; nwg = nM * nN; G = G_; c = c_; }
    __host__ __device__ bool next(int i, Unit& u) const {
        const long L = (long)i * G + c; if (L >= nwg) return false;
        int wgid = (int)L; { const int q = nwg / NXCD, r = nwg % NXCD, xcd = wgid % NXCD, off = wgid / NXCD; wgid = (xcd < r ? xcd * (q + 1) : r * (q + 1) + (xcd - r) * q) + off; }
        const int nig = WGM * nN, gid = wgid / nig, fm = gid * WGM, gsz = (nM - fm) < WGM ? (nM - fm) : WGM;
        u.pm = fm + ((wgid % nig) % gsz); u.pn = (wgid % nig) / gsz; u.aoff = 0; u.tag = 0; return true;
    }
};

__device__ __forceinline__ unsigned cvt_pk_bf16(float lo, float hi) { unsigned r; asm volatile("v_cvt_pk_bf16_f32 %0, %1, %2" : "=v"(r) : "v"(lo), "v"(hi)); return r; }


template <class Epi, class Sched, bool ALIGN_EPI>
__device__ __forceinline__ void gemm_phase(PG8_LAS unsigned char* lds, const Gemm g, const Sched& S, const Epi& E, int wave_s) {
    unsigned z_ = 0u; asm volatile("" : "+v"(z_));
    int tid_ = wave_s * 64 + (int)__builtin_amdgcn_mbcnt_hi(~0u, __builtin_amdgcn_mbcnt_lo(~0u, z_)); asm volatile("" : "+v"(tid_));
    const int tid = tid_, wid = __builtin_amdgcn_readfirstlane(tid >> 6), lane = tid & 63, wr = wid >> 2, wc = wid & 3, fr = lane & 15, fq = lane >> 4;
    const int K = g.K, nt = K / BK;
    unsigned voffA[2], voffB[2];
#pragma unroll
    for (int i = 0; i < 2; ++i) { int R, C; stage_rc(tid * 16 + i * 8192, R, C); const int Rb = Epi::PERM ? ((R & ~31) + perm32(R & 31)) : R;
        voffA[i] = (unsigned)(R * g.lda + C) * 2u; voffB[i] = (unsigned)(Rb * g.ldb + C) * 2u; }
    const size_t kstep = (size_t)(BK * 2);
    const size_t hstepA = (size_t)HALF * g.lda * 2, hstepB = (size_t)HALF * g.ldb * 2;
    const size_t tstepA = 2 * hstepA, tstepB = 2 * hstepB;
    const unsigned ldsw = (unsigned)wid * 1024u;
    const int aoff = lds_byte(wr * 64 + fr, fq * 8), boff = lds_byte(wc * 32 + fr, fq * 8);
#define PG8_SA(b, h) (((b) * 2 + (h)) * HTB)
#define PG8_SB(b, h) ((4 + (b) * 2 + (h)) * HTB)
#define PG8_STAGE(bufoff, gbase, voff) do { _Pragma("unroll") for (int _i = 0; _i < 2; ++_i) \
        __builtin_amdgcn_global_load_lds((const unsigned*)((const char*)(gbase) + (voff)[_i]), (PG8_LAS unsigned*)(lds + (bufoff) + ldsw + _i * 8192), 16, 0, 0); } while (0)
#define PG8_LDA(dst, b, h) do { _Pragma("unroll") for (int m = 0; m < 4; ++m) _Pragma("unroll") for (int k = 0; k < 2; ++k) dst[m][k] = *(const PG8_LAS bf16x8*)(lds + PG8_SA(b, h) + aoff + m * 2048 + k * 1024); } while (0)
#define PG8_LDB(dst, b, h) do { _Pragma("unroll") for (int n = 0; n < 2; ++n) _Pragma("unroll") for (int k = 0; k < 2; ++k) dst[n][k] = *(const PG8_LAS bf16x8*)(lds + PG8_SB(b, h) + boff + n * 2048 + k * 1024); } while (0)
#define PG8_MMA(ai, bj, At, Bt) do { __builtin_amdgcn_s_setprio(1); _Pragma("unroll") for (int m = 0; m < 4; ++m) _Pragma("unroll") for (int n = 0; n < 2; ++n) _Pragma("unroll") for (int k = 0; k < 2; ++k) \
        acc[ai][bj][m][n] = __builtin_amdgcn_mfma_f32_16x16x32_bf16(Bt[n][k], At[m][k], acc[ai][bj][m][n], 0, 0, 0); __builtin_amdgcn_s_setprio(0); } while (0)
#define PG8_WAIT_V(n) asm volatile("s_waitcnt vmcnt(" #n ")" ::: "memory")
#define PG8_WAIT_L(n) asm volatile("s_waitcnt lgkmcnt(" #n ")" ::: "memory")
#define PG8_BAR __builtin_amdgcn_s_barrier()
#define PG8_SCHED __builtin_amdgcn_sched_barrier(0)
    Unit cur, nxt; int ui = 0;
    if (!S.next(0, cur)) return;
    f32x4 acc[2][2][4][2];
#pragma unroll
    for (int a = 0; a < 2; ++a)
#pragma unroll
        for (int b = 0; b < 2; ++b)
#pragma unroll
            for (int m = 0; m < 4; ++m)
#pragma unroll
                for (int n = 0; n < 2; ++n) acc[a][b][m][n] = (f32x4){0.f, 0.f, 0.f, 0.f};
    bf16x8 At[4][2], B0[2][2], B1[2][2];
    const char* cA = (const char*)g.A + (size_t)cur.pm * tstepA + (size_t)cur.aoff * 2; const char* cB = (const char*)g.Bt + (size_t)cur.pn * tstepB;
    PG8_STAGE(PG8_SB(0, 0), cB, voffB); PG8_STAGE(PG8_SB(0, 1), cB + hstepB, voffB); PG8_STAGE(PG8_SA(0, 0), cA, voffA); PG8_STAGE(PG8_SA(0, 1), cA + hstepA, voffA);
    if (wr == 1) PG8_BAR;
    PG8_WAIT_V(2); PG8_BAR;
    PG8_STAGE(PG8_SB(1, 0), cB + kstep, voffB); PG8_STAGE(PG8_SA(1, 0), cA + kstep, voffA); PG8_STAGE(PG8_SB(1, 1), cB + hstepB + kstep, voffB);
    PG8_WAIT_V(6); PG8_BAR;
    for (;;) {
        const bool has_next = S.next(ui + 1, nxt);
        const char* nA = has_next ? (const char*)g.A + (size_t)nxt.pm * tstepA + (size_t)nxt.aoff * 2 : cA; const char* nB = has_next ? (const char*)g.Bt + (size_t)nxt.pn * tstepB : cB;
        for (int t = 0; t < nt; t += 2) {
            if constexpr (Epi::MIDK) { if (t != 0 && (t & 3) == 0) E.mid(acc, cur, t >> 2, wr, wc); }
            const bool last = (t == nt - 2);
            const char* a1 = cA + (size_t)(t + 1) * kstep;
            const char* a2 = last ? nA : cA + (size_t)(t + 2) * kstep; const char* b2 = last ? nB : cB + (size_t)(t + 2) * kstep;
            const char* a3 = a2 + kstep; const char* b3 = b2 + kstep;
            PG8_LDB(B0, 0, 0); PG8_LDB(B1, 0, 1); PG8_SCHED; PG8_LDA(At, 0, 0); PG8_STAGE(PG8_SA(1, 1), a1 + hstepA, voffA);
            PG8_WAIT_V(8); PG8_WAIT_L(0); PG8_BAR; PG8_MMA(0, 0, At, B0); PG8_MMA(0, 1, At, B1); PG8_BAR; PG8_SCHED;
            PG8_LDA(At, 0, 1); PG8_STAGE(PG8_SB(0, 0), b2, voffB); PG8_STAGE(PG8_SB(0, 1), b2 + hstepB, voffB); PG8_STAGE(PG8_SA(0, 0), a2, voffA);
            PG8_WAIT_V(8); PG8_WAIT_L(0); PG8_BAR; PG8_MMA(1, 0, At, B0); PG8_MMA(1, 1, At, B1); PG8_BAR; PG8_SCHED;
            PG8_LDB(B0, 1, 0); PG8_LDB(B1, 1, 1); PG8_SCHED; PG8_LDA(At, 1, 0); PG8_STAGE(PG8_SA(0, 1), a2 + hstepA, voffA);
            PG8_WAIT_V(8); PG8_WAIT_L(0); PG8_BAR; PG8_MMA(0, 0, At, B0); PG8_MMA(0, 1, At, B1); PG8_BAR; PG8_SCHED;
            PG8_LDA(At, 1, 1); PG8_STAGE(PG8_SB(1, 0), b3, voffB); PG8_STAGE(PG8_SB(1, 1), b3 + hstepB, voffB); PG8_STAGE(PG8_SA(1, 0), a3, voffA);
            PG8_WAIT_V(8); PG8_WAIT_L(0); PG8_BAR; PG8_MMA(1, 0, At, B0); PG8_MMA(1, 1, At, B1); PG8_BAR; PG8_SCHED;
        }
        if constexpr (ALIGN_EPI) { if (wr == 0) PG8_BAR; }
        { unsigned z2_ = 0u; asm volatile("" : "+v"(z2_)); const int l2_ = (int)__builtin_amdgcn_mbcnt_hi(~0u, __builtin_amdgcn_mbcnt_lo(~0u, z2_));
          E(acc, cur, wr, wc, l2_ & 15, l2_ >> 4); }
        if (!has_next) break;
#pragma unroll
        for (int a = 0; a < 2; ++a)
#pragma unroll
            for (int b = 0; b < 2; ++b)
#pragma unroll
                for (int m = 0; m < 4; ++m)
#pragma unroll
                    for (int n = 0; n < 2; ++n) acc[a][b][m][n] = (f32x4){0.f, 0.f, 0.f, 0.f};
        cur = nxt; cA = nA; cB = nB; ++ui;
        if constexpr (ALIGN_EPI) { if (wr == 1) PG8_BAR; }
    }
    PG8_WAIT_V(0);
    if constexpr (!ALIGN_EPI) { if (wr == 0) PG8_BAR; }
    PG8_BAR;
#undef PG8_SA
#undef PG8_SB
#undef PG8_STAGE
#undef PG8_LDA
#undef PG8_LDB
#undef PG8_MMA
#undef PG8_WAIT_V
#undef PG8_WAIT_L
#undef PG8_BAR
#undef PG8_SCHED
}

struct EpiBf16 {
    static constexpr bool PERM = true, MIDK = false;
    bf16_t* O; int ldc; int ntn;
    __device__ __forceinline__ void operator()(const f32x4 (&acc)[2][2][4][2], const Unit& u, int wr, int wc, int fr, int fq) const {
        const int row0 = u.pm * BM + wr * 64 + fr, col0 = (u.pn % ntn) * BM + wc * 32 + 8 * fq;
#pragma unroll
        for (int ai = 0; ai < 2; ++ai)
#pragma unroll
            for (int m = 0; m < 4; ++m) { bf16_t* rowp = O + (size_t)(row0 + ai * HALF + m * 16) * ldc + col0;
#pragma unroll
                for (int bj = 0; bj < 2; ++bj) { const f32x4 v0 = acc[ai][bj][m][0], v1 = acc[ai][bj][m][1];
                    u32x4 w; w.x = cvt_pk_bf16(v0[0], v0[1]); w.y = cvt_pk_bf16(v0[2], v0[3]); w.z = cvt_pk_bf16(v1[0], v1[1]); w.w = cvt_pk_bf16(v1[2], v1[3]);
                    *(u32x4*)(rowp + bj * HALF) = w; } }
    }
};
struct EpiF32 {
    static constexpr bool PERM = false, MIDK = false;
    float* C; int ldc; int ntn;
    __device__ __forceinline__ void operator()(const f32x4 (&acc)[2][2][4][2], const Unit& u, int wr, int wc, int fr, int fq) const {
        const int row0 = u.pm * BM + wr * 64 + fr, col0 = (u.pn % ntn) * BM + wc * 32 + 4 * fq;
#pragma unroll
        for (int ai = 0; ai < 2; ++ai)
#pragma unroll
            for (int m = 0; m < 4; ++m) { float* rowp = C + (size_t)(row0 + ai * HALF + m * 16) * ldc + col0;
#pragma unroll
                for (int bj = 0; bj < 2; ++bj)
#pragma unroll
                    for (int n = 0; n < 2; ++n) *(f32x4*)(rowp + bj * HALF + n * 16) = acc[ai][bj][m][n]; }
    }
};
struct EpiSwiglu {
    static constexpr bool PERM = true, MIDK = false;
    bf16_t* O; int ldc; int ntn;
    __device__ __forceinline__ void operator()(const f32x4 (&acc)[2][2][4][2], const Unit& u, int wr, int wc, int fr, int fq) const {
        const int row0 = u.pm * BM + wr * 64 + fr, col0 = (u.pn % ntn) * 128 + wc * 16 + 4 * fq;
#pragma unroll
        for (int ai = 0; ai < 2; ++ai)
#pragma unroll
            for (int m = 0; m < 4; ++m) { bf16_t* rowp = O + (size_t)(row0 + ai * HALF + m * 16) * ldc + col0;
#pragma unroll
                for (int bj = 0; bj < 2; ++bj) { const f32x4 gt = acc[ai][bj][m][0], up = acc[ai][bj][m][1];
                    float h[4];
#pragma unroll
                    for (int e = 0; e < 4; ++e) h[e] = gt[e] * __builtin_amdgcn_rcpf(1.0f + __expf(-gt[e])) * up[e];
                    u32x2 w; w.x = cvt_pk_bf16(h[0], h[1]); w.y = cvt_pk_bf16(h[2], h[3]);
                    *(u32x2*)(rowp + bj * 64) = w; } }
    }
};
struct EpiBranch {
    static constexpr bool PERM = true, MIDK = false;
    const bf16_t* proj; float* MP; bf16_t* MB;
    __device__ __forceinline__ void operator()(const f32x4 (&acc)[2][2][4][2], const Unit& u, int wr, int wc, int fr, int fq) const {
        const int g = u.tag; const int row0 = u.pm * BM + wr * 64 + fr, col0 = (u.pn & 3) * BM + wc * 32 + 8 * fq;
#pragma unroll
        for (int ai = 0; ai < 2; ++ai)
#pragma unroll
            for (int m = 0; m < 4; ++m) { const size_t row = (size_t)(row0 + ai * HALF + m * 16);
#pragma unroll
                for (int bj = 0; bj < 2; ++bj) { const int col = col0 + bj * HALF;
                    const u32x4 gw = *(const u32x4*)(proj + row * PW + P_GATE + g * 1024 + col);
                    float gv[8];
#pragma unroll
                    for (int e = 0; e < 4; ++e) { const unsigned w = gw[e]; gv[2 * e] = __builtin_bit_cast(float, w << 16); gv[2 * e + 1] = __builtin_bit_cast(float, w & 0xffff0000u); }
                    f32x4 v0 = acc[ai][bj][m][0], v1 = acc[ai][bj][m][1];
#pragma unroll
                    for (int e = 0; e < 4; ++e) { v0[e] *= __builtin_amdgcn_rcpf(1.0f + __expf(-gv[e])); v1[e] *= __builtin_amdgcn_rcpf(1.0f + __expf(-gv[4 + e])); }
                    float* mp = MP + row * D + col;
                    if (g > 0) { v0 += *(const f32x4*)mp; v1 += *(const f32x4*)(mp + 4); }
                    if (g < 3) { *(f32x4*)mp = v0; *(f32x4*)(mp + 4) = v1; }
                    else { u32x4 w; w.x = cvt_pk_bf16(v0[0], v0[1]); w.y = cvt_pk_bf16(v0[2], v0[3]); w.z = cvt_pk_bf16(v1[0], v1[1]); w.w = cvt_pk_bf16(v1[2], v1[3]);
                        *(u32x4*)(MB + row * D + col) = w; } } }
    }
};
struct EpiBranchK {
    static constexpr bool PERM = true, MIDK = true;
    const bf16_t* proj; bf16_t* MB;
    __device__ __forceinline__ static float em(float x) { return fminf(__expf(-x), 1e20f); }
    __device__ __forceinline__ void mid(f32x4 (&acc)[2][2][4][2], const Unit& u, int gnext, int wr, int wc) const {
        unsigned z_ = 0u; asm volatile("" : "+v"(z_)); const int l_ = (int)__builtin_amdgcn_mbcnt_hi(~0u, __builtin_amdgcn_mbcnt_lo(~0u, z_)); const int fr = l_ & 15, fq = l_ >> 4;
        const int row0 = u.pm * BM + wr * 64 + fr, col0 = u.pn * BM + wc * 32 + 8 * fq;
#pragma unroll
        for (int ai = 0; ai < 2; ++ai)
#pragma unroll
            for (int m = 0; m < 4; ++m) { const bf16_t* gp = proj + (size_t)(row0 + ai * HALF + m * 16) * PW + P_GATE + (gnext - 1) * 1024 + col0;
#pragma unroll
                for (int bj = 0; bj < 2; ++bj) { const u32x4 g0 = *(const u32x4*)(gp + bj * HALF), g1 = *(const u32x4*)(gp + 1024 + bj * HALF);
#pragma unroll
                    for (int e = 0; e < 4; ++e) { const unsigned a = g0[e], b = g1[e];
                        const float ra = (1.0f + em(__builtin_bit_cast(float, b << 16))) * __builtin_amdgcn_rcpf(1.0f + em(__builtin_bit_cast(float, a << 16)));
                        const float rb = (1.0f + em(__builtin_bit_cast(float, b & 0xffff0000u))) * __builtin_amdgcn_rcpf(1.0f + em(__builtin_bit_cast(float, a & 0xffff0000u)));
                        if (e < 2) { acc[ai][bj][m][0][2 * e] *= ra; acc[ai][bj][m][0][2 * e + 1] *= rb; } else { acc[ai][bj][m][1][2 * (e - 2)] *= ra; acc[ai][bj][m][1][2 * (e - 2) + 1] *= rb; } } } }
    }
    __device__ __forceinline__ void operator()(const f32x4 (&acc)[2][2][4][2], const Unit& u, int wr, int wc, int fr, int fq) const {
        const int row0 = u.pm * BM + wr * 64 + fr, col0 = u.pn * BM + wc * 32 + 8 * fq;
#pragma unroll
        for (int ai = 0; ai < 2; ++ai)
#pragma unroll
            for (int m = 0; m < 4; ++m) { const size_t row = (size_t)(row0 + ai * HALF + m * 16);
#pragma unroll
                for (int bj = 0; bj < 2; ++bj) { const u32x4 gw = *(const u32x4*)(proj + row * PW + P_GATE + 3 * 1024 + col0 + bj * HALF);
                    float sg[8];
#pragma unroll
                    for (int e = 0; e < 4; ++e) { sg[2 * e] = __builtin_amdgcn_rcpf(1.0f + em(__builtin_bit_cast(float, gw[e] << 16))); sg[2 * e + 1] = __builtin_amdgcn_rcpf(1.0f + em(__builtin_bit_cast(float, gw[e] & 0xffff0000u))); }
                    const f32x4 v0 = acc[ai][bj][m][0], v1 = acc[ai][bj][m][1];
                    u32x4 w; w.x = cvt_pk_bf16(v0[0] * sg[0], v0[1] * sg[1]); w.y = cvt_pk_bf16(v0[2] * sg[2], v0[3] * sg[3]); w.z = cvt_pk_bf16(v1[0] * sg[4], v1[1] * sg[5]); w.w = cvt_pk_bf16(v1[2] * sg[6], v1[3] * sg[7]);
                    *(u32x4*)(MB + row * D + col0 + bj * HALF) = w; } }
    }
};
struct BranchOrder {
    int G, c;
    __device__ bool next(int i, Unit& u) const {
        const int tile = (i >> 2) * G + c; if (tile >= 256) return false;
        const int g = i & 3; u.pm = tile >> 2; u.pn = g * 4 + (tile & 3); u.aoff = g * 256; u.tag = g; return true;
    }
};
struct MoeOrder {
    int G, c, ntiles, NT; int toff[9];
    __device__ void init(const unsigned* cnt, int G_, int c_, int NT_) { G = G_; c = c_; NT = NT_; int o = 0;
#pragma unroll
        for (int e = 0; e < 8; ++e) { toff[e] = o; o += ((int)cnt[e] + 255) >> 8; } toff[8] = o; ntiles = o; }
    __device__ bool next(int i, Unit& u) const {
        const int L = i * G + c; if (L >= ntiles * NT) return false;
        const int tau = L % ntiles, pn = L / ntiles; int e = 0;
#pragma unroll
        for (int q = 1; q < 8; ++q) e += (tau >= toff[q]) ? 1 : 0;
        u.pm = tau; u.pn = e * NT + pn; u.aoff = 0; u.tag = e; return true;
    }
};
}
typedef GAS unsigned gu32;
#define RLX_AGENT __ATOMIC_RELAXED, __HIP_MEMORY_SCOPE_AGENT
#define XB_TMO      128
#define XB_XCNT(j)  (256  + 64 * (j))
#define XB_XSUB(j)  (1280 + 64 * (j))
#define XB_XGEN(j)  (2304 + 64 * (j))
#define XB_TOP      3328
#define XB_TOPGEN   3392
#define XCD_BAR_WORDS 3456
#define XB_SPIN_CAP (1u << 18)

__device__ __forceinline__ unsigned xb_ld(unsigned* p)              { return __hip_atomic_load(p, __ATOMIC_RELAXED, __HIP_MEMORY_SCOPE_AGENT); }
__device__ __forceinline__ unsigned xb_add(unsigned* p, unsigned v) { return __hip_atomic_fetch_add(p, v, __ATOMIC_RELAXED, __HIP_MEMORY_SCOPE_AGENT); }
__device__ __forceinline__ unsigned xb_xcc_id() { return (unsigned)__builtin_amdgcn_s_getreg((3 << 11) | 20) & 0xFu; }
#define XB_SPIN(cond, bar) do { unsigned _sp = 0; while (cond) { __builtin_amdgcn_s_sleep(1); \
    if ((++_sp & 255u) == 0u) { if (xb_ld(&(bar)[XB_TMO])) break; if (_sp > XB_SPIN_CAP) { atomicAdd(&(bar)[XB_TMO], 1u); break; } } } } while (0)

struct XcdBarrier {
    unsigned* bar; unsigned x;
    volatile LAS unsigned* st;
};

__device__ __forceinline__ XcdBarrier xcd_barrier_post(unsigned* bar, volatile LAS unsigned* st) {
    XcdBarrier b; b.bar = bar; b.x = xb_xcc_id(); b.st = st;
    if (threadIdx.x == 0) (void)xb_add(&bar[XB_XCNT(b.x)], 1u);
    return b;
}
__device__ __forceinline__ void xcd_barrier_complete(unsigned* bar, unsigned x, unsigned& nloc, unsigned& nx) {
    const unsigned G = gridDim.x * gridDim.y * gridDim.z;
    unsigned sum, cnt, mine, sp = 0u;
    for (;;) {
        sum = 0u; cnt = 0u; mine = 0u;
#pragma unroll
        for (unsigned j = 0; j < 16; ++j) { const unsigned c = xb_ld(&bar[XB_XCNT(j)]); sum += c; cnt += (c > 0u) ? 1u : 0u; mine = (j == x) ? c : mine; }
        if (sum == G) break;
        __builtin_amdgcn_s_sleep(1);
        if ((++sp & 255u) == 0u) { if (xb_ld(&bar[XB_TMO])) break; if (sp > XB_SPIN_CAP) { atomicAdd(&bar[XB_TMO], 1u); break; } }
    }
    nloc = mine > 0u ? mine : 1u; nx = cnt > 0u ? cnt : 1u;
}

__device__ __forceinline__ void xcd_barrier(const XcdBarrier& b) {
    asm volatile("s_waitcnt vmcnt(0)" ::: "memory");
    __syncthreads();
    if (threadIdx.x == 0) {
        unsigned* bar = b.bar;
        __builtin_amdgcn_s_waitcnt(0);
        unsigned nloc = b.st[0], nx = b.st[1];
        if (nloc == 0u) { xcd_barrier_complete(bar, b.x, nloc, nx); b.st[0] = nloc; b.st[1] = nx; }
        const unsigned old = xb_add(&bar[XB_XSUB(b.x)], 1u);
        const unsigned gen = old / nloc;
        if (old + 1u == (gen + 1u) * nloc) {
            __builtin_amdgcn_fence(__ATOMIC_RELEASE, "agent");
            asm volatile("s_waitcnt vmcnt(0)" ::: "memory");
            const unsigned og = xb_add(&bar[XB_TOP], 1u);
            const unsigned tg = og / nx;
            if (og + 1u == (tg + 1u) * nx) xb_add(&bar[XB_TOPGEN], 1u);
            else XB_SPIN(xb_ld(&bar[XB_TOPGEN]) == tg, bar);
            __builtin_amdgcn_fence(__ATOMIC_ACQUIRE, "agent");
            xb_add(&bar[XB_XGEN(b.x)], 1u);
            asm volatile("s_waitcnt vmcnt(0)" ::: "memory");
        } else {
            XB_SPIN(xb_ld(&bar[XB_XGEN(b.x)]) == gen, bar);
            __builtin_amdgcn_fence(__ATOMIC_ACQUIRE, "agent");
            asm volatile("s_waitcnt vmcnt(0)" ::: "memory");
        }
    }
    __syncthreads();
}
struct Args { const void* in[40]; float* out; unsigned char* ws; int ph_lo, ph_hi; };
typedef const __attribute__((address_space(4))) Args* ArgsP;
__device__ __forceinline__ ArgsP fresh_args() { ArgsP p = (ArgsP)__builtin_amdgcn_kernarg_segment_ptr(); asm volatile("" : "+s"(p)); return p; }

struct Frame {
    LAS unsigned char* lds;
    int wave, G, gw, NGW;
    __device__ __forceinline__ int lane() const { unsigned z = 0u; asm volatile("" : "+v"(z)); return (int)__builtin_amdgcn_mbcnt_hi(~0u, __builtin_amdgcn_mbcnt_lo(~0u, z)); }
};

__device__ __forceinline__ Frame fresh(const Frame& F) { Frame R = F; asm volatile("" : "+s"(R.wave), "+s"(R.G), "+s"(R.gw), "+s"(R.NGW)); return R; }
#define LDS_WAIT() asm volatile("s_waitcnt lgkmcnt(0)" ::: "memory")

__device__ __forceinline__ void p0_mod_items(Frame& F, const float* c, const float* ada_w, const float* ada_b, float* mod) {
    LAS float* part = (LAS float*)F.lds;
    LAS float* cs = (LAS float*)(F.lds + 98304);
    int tid_ = F.wave * 64 + F.lane(); asm volatile("" : "+v"(tid_)); const int lane_ = tid_ & 63;
    if ((int)blockIdx.x >= 192) return;
    for (int i = tid_; i < 8192; i += NTHR) cs[i] = siluf(c[i]);
    __syncthreads();
    for (int it = blockIdx.x; it < 192; it += F.G) {
        const int l = it / 96, j0 = (it % 96) * 64;
        float acc[8];
#pragma unroll
        for (int b = 0; b < 8; ++b) acc[b] = 0.f;
        const float* w = ada_w + (size_t)l * 1024 * 6144 + j0 + lane_;
        const int k0 = F.wave * 128;
#pragma unroll 1
        for (int kb = 0; kb < 128; kb += 16) { float wv[16];
#pragma unroll
            for (int q = 0; q < 16; ++q) wv[q] = w[(size_t)(k0 + kb + q) * 6144];
#pragma unroll
            for (int q4 = 0; q4 < 4; ++q4)
#pragma unroll
                for (int b = 0; b < 8; ++b) { const pg8::f32x4 cv = *(const LAS pg8::f32x4*)(cs + b * 1024 + k0 + kb + 4 * q4);
                    acc[b] += (cv[0] * wv[4 * q4] + cv[1] * wv[4 * q4 + 1]) + (cv[2] * wv[4 * q4 + 2] + cv[3] * wv[4 * q4 + 3]); } }
#pragma unroll
        for (int b = 0; b < 8; ++b) part[(F.wave * 8 + b) * 64 + lane_] = acc[b];
        __syncthreads();
        { const int b = tid_ >> 6, col = tid_ & 63; float s = 0.f;
#pragma unroll
          for (int w8 = 0; w8 < 8; ++w8) s += part[(w8 * 8 + b) * 64 + col];
          mod[(size_t)(l * 8 + b) * 6144 + j0 + col] = s + ada_b[l * 6144 + j0 + col]; }
        __syncthreads();
    }
}
struct CvtDesc { const float* colp; size_t Ns; bf16_t* WT; int Kd, n0, k0; };
__device__ __forceinline__ void cvt_load(const CvtDesc& d, pg8::f32x4 (&v)[8], int lane) {
    const int kr = lane >> 3;
#pragma unroll
    for (int i = 0; i < 8; ++i) v[i] = d.colp ? *(const pg8::f32x4*)(d.colp + (size_t)(d.k0 + 8 * i + kr) * d.Ns) : (pg8::f32x4){0.f, 0.f, 0.f, 0.f};
}
__device__ __forceinline__ void cvt_store(const CvtDesc& d, const pg8::f32x4 (&v)[8], LAS float* scr, int lane) {
    const int q4 = 4 * (lane & 7), kr = lane >> 3;
#pragma unroll
    for (int i = 0; i < 8; ++i)
#pragma unroll
        for (int e = 0; e < 4; ++e) scr[(8 * i + kr) * 33 + q4 + e] = v[i][e];
    LDS_WAIT(); asm volatile("" ::: "memory");
    const int cidx = lane & 7;
#pragma unroll
    for (int j = 0; j < 4; ++j) { const int n = (lane >> 3) + 8 * j; const LAS float* s = scr + (8 * cidx) * 33 + n;
        pg8::u32x4 o; o.x = pk2(s[0 * 33], s[1 * 33]); o.y = pk2(s[2 * 33], s[3 * 33]); o.z = pk2(s[4 * 33], s[5 * 33]); o.w = pk2(s[6 * 33], s[7 * 33]);
        *(pg8::u32x4*)(d.WT + (size_t)(d.n0 + n) * d.Kd + d.k0 + 8 * cidx) = o; }
    LDS_WAIT(); asm volatile("" ::: "memory");
}
__device__ __forceinline__ int win_src_col(int v) { return v < 768 ? v : (v < 7168 ? v + 16 : (v < 7184 ? v - 6400 : -1)); }

__device__ __forceinline__ CvtDesc p0_desc(ArgsP a, int it, int n) {
    const float* w_in = (const float*)a->in[9]; const float* w_branch = (const float*)a->in[30]; const float* w_out = (const float*)a->in[31];
    const float* wg = (const float*)a->in[32]; const float* wu = (const float*)a->in[33]; const float* wd = (const float*)a->in[34];
    bf16_t* WIN = (bf16_t*)(a->ws + WS_WIN); bf16_t* WB = (bf16_t*)(a->ws + WS_WB); bf16_t* WO = (bf16_t*)(a->ws + WS_WO); bf16_t* WF1 = (bf16_t*)(a->ws + WS_WF1); bf16_t* WF2 = (bf16_t*)(a->ws + WS_WF2);
    bf16_t* LR = (bf16_t*)(a->ws + WS_LR);
    constexpr int I_IN = 2 * 232 * 16, I_B = 2 * 4 * 32 * 4, I_O = 2 * 32 * 16, I_F1 = 176 * 16, I_F2 = 32 * 44;
    int r = it;
    if (r < I_IN) { const int l = r / (232 * 16), q = r % (232 * 16), nb = q / 16, kb = q % 16; const int sc = win_src_col(nb * 32 + n);
        return CvtDesc{sc >= 0 ? w_in + (size_t)l * 1024 * NIN + sc : nullptr, (size_t)NIN, WIN + (size_t)l * PW * 1024, 1024, nb * 32, kb * 64}; } r -= I_IN;
    if (r < I_B) { const int lg = r / 128, q = r % 128, nb = q / 4, kb = q % 4;
        const int g = lg & 3, l = lg >> 2;
        return CvtDesc{w_branch + (size_t)lg * 256 * 1024 + nb * 32 + n - (size_t)g * 256 * 1024, 1024, WB + (size_t)l * 1024 * 1024, 1024, nb * 32, g * 256 + kb * 64}; } r -= I_B;
    if (r < I_O) { const int l = r / 512, q = r % 512, nb = q / 16, kb = q % 16;
        return CvtDesc{w_out + (size_t)l * 1024 * 1024 + nb * 32 + n, 1024, WO + (size_t)l * 1024 * 1024, 1024, nb * 32, kb * 64}; } r -= I_O;
    if (r < I_F1) { const int nb = r / 16, kb = r % 16; const int v = nb * 32 + n; const int up = (v >> 2) & 1, j = (v >> 3) * 4 + (v & 3);
        return CvtDesc{(up ? wu : wg) + j, (size_t)DFF, WF1, 1024, nb * 32, kb * 64}; } r -= I_F1;
    if (r < I_F2) { const int nb = r / 44, kb = r % 44;
        return CvtDesc{wd + nb * 32 + n, 1024, WF2, DFF, nb * 32, kb * 64}; } r -= I_F2;
    if (r < 16) { const int l = r >> 3, nb = r & 7; return CvtDesc{(const float*)a->in[21] + l * 64 * 256 + nb * 32 + n, 256, LR + l * 256 * 64, 64, nb * 32, 0}; } r -= 16;
    if (r < 16) { const int l = r >> 3, nb = r & 7; return CvtDesc{(const float*)a->in[23] + l * 64 * 256 + nb * 32 + n, 256, LR + 2 * 256 * 64 + l * 256 * 64, 64, nb * 32, 0}; } r -= 16;
    { const int l = r >> 4, nb = (r >> 1) & 7, kb = r & 1; return CvtDesc{(const float*)a->in[24] + l * 128 * 256 + nb * 32 + n, 256, LR + 4 * 256 * 64 + l * 256 * 128, 128, nb * 32, kb * 64}; }
}
__device__ __forceinline__ void p0_convert(Frame& F, ArgsP a) {
    LAS float* scr = (LAS float*)(F.lds + 16384 + F.wave * 8704);
    constexpr int NITEMS = 2 * 232 * 16 + 2 * 4 * 32 * 4 + 2 * 32 * 16 + 176 * 16 + 32 * 44 + 64;
    int lane_ = F.lane(); asm volatile("" : "+v"(lane_));
    const int n = 4 * (lane_ & 7);
    int it = F.gw; if (it >= NITEMS) return;
    CvtDesc cur = p0_desc(a, it, n); pg8::f32x4 v[8]; cvt_load(cur, v, lane_);
    for (;;) { const int nx = it + F.NGW; const bool more = nx < NITEMS;
        CvtDesc nd = cur; pg8::f32x4 w[8];
        if (more) { nd = p0_desc(a, nx, n); cvt_load(nd, w, lane_); }
        cvt_store(cur, v, scr, lane_);
        if (!more) break;
#pragma unroll
        for (int i = 0; i < 8; ++i) v[i] = w[i];
        cur = nd; it = nx; }
}

__device__ __forceinline__ void row_load(const float* p, pg8::f32x4 (&v)[4], int lane) {
#pragma unroll
    for (int j = 0; j < 4; ++j) v[j] = *(const pg8::f32x4*)(p + 4 * lane + 256 * j);
}
__device__ __forceinline__ float row_ss(const pg8::f32x4 (&v)[4]) {
    float s = 0.f;
#pragma unroll
    for (int j = 0; j < 4; ++j) s += (v[j][0] * v[j][0] + v[j][1] * v[j][1]) + (v[j][2] * v[j][2] + v[j][3] * v[j][3]);
    return wave_sum(s);
}
__device__ __forceinline__ void row_normmod(const pg8::f32x4 (&x)[4], const float* g, const float* mb, int sh_off, int sc_off, bf16_t* hrow, pg8::f32x4 (&hv)[4], int lane) {
    const float rstd = rsqrtf(row_ss(x) * (1.0f / D) + 1e-6f);
#pragma unroll
    for (int j = 0; j < 4; ++j) { const int d = 4 * lane + 256 * j;
        const pg8::f32x4 gg = *(const pg8::f32x4*)(g + d), sc = *(const pg8::f32x4*)(mb + sc_off + d), sh = *(const pg8::f32x4*)(mb + sh_off + d);
        hv[j] = x[j] * rstd * gg * (1.0f + sc) + sh;
        pg8::u32x2 w; w.x = pk2(hv[j][0], hv[j][1]); w.y = pk2(hv[j][2], hv[j][3]);
        *(pg8::u32x2*)(hrow + d) = w; }
}
template <int CTRL, int ROWMASK> __device__ __forceinline__ float dpp_mov_p(float old, float x) {
    return __builtin_bit_cast(float, __builtin_amdgcn_update_dpp(__builtin_bit_cast(int, old), __builtin_bit_cast(int, x), CTRL, ROWMASK, 0xF, false)); }
__device__ __forceinline__ float wave_sum63p(float x) {
    x += dpp_mov_p<0xB1, 0xF>(0.f, x); x += dpp_mov_p<0x4E, 0xF>(0.f, x); x += dpp_mov_p<0x141, 0xF>(0.f, x); x += dpp_mov_p<0x140, 0xF>(0.f, x);
    x += dpp_mov_p<0x142, 0xA>(0.f, x); x += dpp_mov_p<0x143, 0xC>(0.f, x); return x; }
__device__ __forceinline__ void stage_wz(const float* w_in_l, LAS float* wz, int tid) {
    for (int i = tid; i < 1024 * 4; i += NTHR) { const int d = i >> 2, q = i & 3; const pg8::f32x4 w = *(const pg8::f32x4*)(w_in_l + (size_t)d * NIN + 768 + 4 * q);
        wz[(4 * q) * 1024 + d] = w[0]; wz[(4 * q + 1) * 1024 + d] = w[1]; wz[(4 * q + 2) * 1024 + d] = w[2]; wz[(4 * q + 3) * 1024 + d] = w[3]; }
    __syncthreads();
}
__device__ __forceinline__ void row_gz(const pg8::f32x4 (&hv)[4], const LAS float* wz, bf16_t* gzrow, int lane) {
    float mine = 0.f;
#pragma unroll
    for (int o = 0; o < 16; ++o) { float acc = 0.f;
#pragma unroll
        for (int j = 0; j < 4; ++j) { const pg8::f32x4 w = *(const LAS pg8::f32x4*)(wz + o * 1024 + 4 * lane + 256 * j); acc += (hv[j][0] * w[0] + hv[j][1] * w[1]) + (hv[j][2] * w[2] + hv[j][3] * w[3]); }
        const float s = __builtin_bit_cast(float, __builtin_amdgcn_readlane(__builtin_bit_cast(int, wave_sum63p(acc)), 63)); if (lane == o) mine = s; }
    if (lane < 16) gzrow[lane] = (bf16_t)f2bf(mine);
}
__device__ __forceinline__ void ph_h0(Frame& F, ArgsP a) {
    const float* x = (const float*)a->in[0]; const float* g = (const float*)a->in[5]; const float* mod = (const float*)(a->ws + WS_MOD); bf16_t* H = (bf16_t*)(a->ws + WS_HB);
    bf16_t* GZ = (bf16_t*)(a->ws + WS_GZ); LAS float* wz = (LAS float*)F.lds;
    int lane0 = F.lane(); asm volatile("" : "+v"(lane0));
    stage_wz((const float*)a->in[9], wz, F.wave * 64 + lane0);
    int row = F.gw; if (row >= M) return;
    pg8::f32x4 xn[4]; row_load(x + (size_t)row * D, xn, lane0);
    for (;;) { int lane = lane0; asm volatile("" : "+v"(lane)); pg8::f32x4 xv[4], hv[4];
#pragma unroll
        for (int j = 0; j < 4; ++j) xv[j] = xn[j];
        const int nrow = row + F.NGW; if (nrow < M) row_load(x + (size_t)nrow * D, xn, lane);
        row_normmod(xv, g, mod + (size_t)(row / T) * 6144, 0, 1024, H + (size_t)row * D, hv, lane);
        row_gz(hv, wz, GZ + (size_t)row * 16, lane);
        if (nrow >= M) break; row = nrow; }
}
__device__ __forceinline__ void row_y_load(const bf16_t* y, const bf16_t* eout, const unsigned* cnt, const int* toke, const int* toks, int row, int lane, pg8::f32x4 (&yv)[4], pg8::u32x2 (&e1)[4], pg8::u32x2 (&e2)[4]) {
    if (eout) {
        int roff[8]; { int o = 0;
#pragma unroll
            for (int e = 0; e < 8; ++e) { roff[e] = o; o += (((int)cnt[e] + 255) >> 8) << 8; } }
        const int x1 = toke[row * 2], x2 = toke[row * 2 + 1]; int g1 = toks[row * 2], g2 = toks[row * 2 + 1];
#pragma unroll
        for (int q = 0; q < 8; ++q) { if (q == x1) g1 += roff[q]; if (q == x2) g2 += roff[q]; }
#pragma unroll
        for (int j = 0; j < 4; ++j) { e1[j] = *(const pg8::u32x2*)(eout + (size_t)g1 * D + 4 * lane + 256 * j); e2[j] = *(const pg8::u32x2*)(eout + (size_t)g2 * D + 4 * lane + 256 * j); }
    } else {
#pragma unroll
        for (int j = 0; j < 4; ++j) e1[j] = *(const pg8::u32x2*)(y + (size_t)row * D + 4 * lane + 256 * j); }
}
__device__ __forceinline__ void ph_row(Frame& F, ArgsP a, const float* xold, const bf16_t* y, const float* gpost, const float* modl, int gt_off,
                                       const float* gpre, const float* modn, int sh_off, int sc_off, bf16_t* hdst, bool route, const bf16_t* eout = nullptr, const float* w_in_next = nullptr) {
    float* out = a->out;
    bf16_t* GZ = (bf16_t*)(a->ws + WS_GZ); LAS float* wz = (LAS float*)F.lds;
    if (w_in_next) { int t_ = F.wave * 64 + F.lane(); stage_wz(w_in_next, wz, t_); }
    const float* rw = (const float*)a->in[35]; const float* rb = (const float*)a->in[36];
    unsigned* cnt = (unsigned*)(a->ws + WS_CTL) + CW_CNT;
    int* list = (int*)(a->ws + WS_ROUTE + RT_LIST); int* toke = (int*)(a->ws + WS_ROUTE + RT_TOKE); int* toks = (int*)(a->ws + WS_ROUTE + RT_TOKS); float* tokp = (float*)(a->ws + WS_ROUTE + RT_TOKP);
    int row = F.gw; if (row >= M) return;
    int lane0 = F.lane(); asm volatile("" : "+v"(lane0));
    pg8::f32x4 yn[4], xn[4]; pg8::u32x2 e1n[4], e2n[4];
    row_y_load(y, eout, cnt, toke, toks, row, lane0, yn, e1n, e2n); row_load(xold + (size_t)row * D, xn, lane0);
    for (;;) {
        int lane = lane0; asm volatile("" : "+v"(lane));
        const int b = row / T; pg8::f32x4 yv[4], xv[4], hv[4];
        if (eout) { const float p1 = tokp[row * 2], p2 = tokp[row * 2 + 1];
#pragma unroll
            for (int j = 0; j < 4; ++j) { const pg8::u32x2 a1 = e1n[j], a2 = e2n[j];
                yv[j][0] = p1 * __builtin_bit_cast(float, a1.x << 16) + p2 * __builtin_bit_cast(float, a2.x << 16); yv[j][1] = p1 * __builtin_bit_cast(float, a1.x & 0xffff0000u) + p2 * __builtin_bit_cast(float, a2.x & 0xffff0000u);
                yv[j][2] = p1 * __builtin_bit_cast(float, a1.y << 16) + p2 * __builtin_bit_cast(float, a2.y << 16); yv[j][3] = p1 * __builtin_bit_cast(float, a1.y & 0xffff0000u) + p2 * __builtin_bit_cast(float, a2.y & 0xffff0000u); }
        } else {
#pragma unroll
            for (int j = 0; j < 4; ++j) { const pg8::u32x2 a1 = e1n[j]; yv[j][0] = __builtin_bit_cast(float, a1.x << 16); yv[j][1] = __builtin_bit_cast(float, a1.x & 0xffff0000u); yv[j][2] = __builtin_bit_cast(float, a1.y << 16); yv[j][3] = __builtin_bit_cast(float, a1.y & 0xffff0000u); } }
#pragma unroll
        for (int j = 0; j < 4; ++j) xv[j] = xn[j];
        const int nrow = row + F.NGW;
        if (nrow < M) { row_y_load(y, eout, cnt, toke, toks, nrow, lane, yn, e1n, e2n); row_load(xold + (size_t)nrow * D, xn, lane); }
        const float rstd = rsqrtf(row_ss(yv) * (1.0f / D) + 1e-6f);
        const float* mb = modl + (size_t)b * 6144;
#pragma unroll
        for (int j = 0; j < 4; ++j) { const int d = 4 * lane + 256 * j;
            const pg8::f32x4 gp = *(const pg8::f32x4*)(gpost + d), gt = *(const pg8::f32x4*)(mb + gt_off + d);
            xv[j] = xv[j] + gt * (yv[j] * rstd * gp);
            *(pg8::f32x4*)(out + (size_t)row * D + d) = xv[j]; }
        if (hdst) {
            row_normmod(xv, gpre, modn + (size_t)b * 6144, sh_off, sc_off, hdst + (size_t)row * D, hv, lane);
            if (w_in_next) row_gz(hv, wz, GZ + (size_t)row * 16, lane);
            if (route) {
                float lg[8];
#pragma unroll
                for (int e = 0; e < 8; ++e) lg[e] = 0.f;
#pragma unroll
                for (int j = 0; j < 4; ++j)
#pragma unroll
                    for (int q = 0; q < 4; ++q) { const int d = 4 * lane + 256 * j + q; const pg8::f32x4 w0 = *(const pg8::f32x4*)(rw + d * 8), w1 = *(const pg8::f32x4*)(rw + d * 8 + 4); const float hq = hv[j][q];
                        lg[0] += hq * w0[0]; lg[1] += hq * w0[1]; lg[2] += hq * w0[2]; lg[3] += hq * w0[3]; lg[4] += hq * w1[0]; lg[5] += hq * w1[1]; lg[6] += hq * w1[2]; lg[7] += hq * w1[3]; }
#pragma unroll
                for (int e = 0; e < 8; ++e) lg[e] = wave_sum(lg[e]) + rb[e];
                if (lane == 0) {
                    int e1 = 0; float v1 = lg[0];
#pragma unroll
                    for (int e = 1; e < 8; ++e) if (lg[e] > v1) { v1 = lg[e]; e1 = e; }
                    int e2 = -1; float v2 = -3.0e38f;
#pragma unroll
                    for (int e = 0; e < 8; ++e) if (e != e1 && lg[e] > v2) { v2 = lg[e]; e2 = e; }
                    const float p1 = 1.0f / (1.0f + __expf(v2 - v1)), p2 = 1.0f - p1;
                    const int s1 = (int)atomicAdd(&cnt[e1], 1u), s2 = (int)atomicAdd(&cnt[e2], 1u);
                    list[e1 * M + s1] = row; list[e2 * M + s2] = row;
                    toke[row * 2] = e1; toke[row * 2 + 1] = e2; toks[row * 2] = s1; toks[row * 2 + 1] = s2; tokp[row * 2] = p1; tokp[row * 2 + 1] = p2;
                }
            }
        }
        if (nrow >= M) break; row = nrow;
    }
}

__device__ __forceinline__ void ph_moe_prep(Frame& F, ArgsP a) {
    LAS float* scr = (LAS float*)(F.lds + F.wave * 8704);
    const float* mg = (const float*)a->in[37]; const float* mu = (const float*)a->in[38]; const float* md = (const float*)a->in[39];
    bf16_t* WM1 = (bf16_t*)(a->ws + WS_WM1); bf16_t* WM2 = (bf16_t*)(a->ws + WS_WM2);
    constexpr int I_1 = 8 * 224 * 16, I_2 = 8 * 32 * 56;
    int lane_ = F.lane(); asm volatile("" : "+v"(lane_));
    const int n = 4 * (lane_ & 7);
    auto desc = [&](int r) -> CvtDesc {
        if (r < I_1) { const int e = r / 3584, q = r % 3584, nb = q / 16, kb = q % 16; const int v = nb * 32 + n; const int up = (v >> 2) & 1, j = (v >> 3) * 4 + (v & 3);
            return CvtDesc{(up ? mu : mg) + (size_t)e * 1024 * DEX + j, (size_t)DEX, WM1 + (size_t)e * 7168 * 1024, 1024, nb * 32, kb * 64}; }
        r -= I_1; const int e = r / 1792, q = r % 1792, nb = q / 56, kb = q % 56;
        return CvtDesc{md + (size_t)e * DEX * 1024 + nb * 32 + n, 1024, WM2 + (size_t)e * 1024 * DEX, DEX, nb * 32, kb * 64}; };
    { int it = F.gw;
      if (it < I_1 + I_2) { CvtDesc cur = desc(it); pg8::f32x4 v[8]; cvt_load(cur, v, lane_);
        for (;;) { const int nx = it + F.NGW; const bool more = nx < I_1 + I_2; CvtDesc nd = cur; pg8::f32x4 w[8];
            if (more) { nd = desc(nx); cvt_load(nd, w, lane_); }
            cvt_store(cur, v, scr, lane_);
            if (!more) break;
#pragma unroll
            for (int i = 0; i < 8; ++i) v[i] = w[i];
            cur = nd; it = nx; } } }
    const unsigned* cnt = (const unsigned*)(a->ws + WS_CTL) + CW_CNT;
    const int* list = (const int*)(a->ws + WS_ROUTE + RT_LIST);
    const bf16_t* h2 = (const bf16_t*)(a->ws + WS_H2L1); bf16_t* hg = (bf16_t*)(a->ws + WS_HG);
    int roff[9]; { int o = 0;
#pragma unroll
        for (int e = 0; e < 8; ++e) { roff[e] = o; o += (((int)cnt[e] + 255) >> 8) << 8; } roff[8] = o; }
    for (int slot0 = F.gw * 4; slot0 < roff[8]; slot0 += F.NGW * 4) {
        int src[4];
#pragma unroll
        for (int u = 0; u < 4; ++u) { const int slot = slot0 + u; int e = 0;
#pragma unroll
            for (int q = 1; q < 8; ++q) e += (slot >= roff[q]) ? 1 : 0;
            int base = 0, ce = 0;
#pragma unroll
            for (int q = 0; q < 8; ++q) if (q == e) { base = roff[q]; ce = (int)cnt[q]; }
            const int s = slot - base;
            src[u] = (slot < roff[8] && s < ce) ? list[e * M + s] : -1; }
        pg8::u32x4 v0[4], v1[4];
#pragma unroll
        for (int u = 0; u < 4; ++u) { v0[u] = (pg8::u32x4){0u, 0u, 0u, 0u}; v1[u] = v0[u];
            if (src[u] >= 0) { const pg8::u32x4* sp = (const pg8::u32x4*)(h2 + (size_t)src[u] * D) + 2 * lane_; v0[u] = sp[0]; v1[u] = sp[1]; } }
#pragma unroll
        for (int u = 0; u < 4; ++u) if (slot0 + u < roff[8]) { pg8::u32x4* dp = (pg8::u32x4*)(hg + (size_t)(slot0 + u) * D) + 2 * lane_; dp[0] = v0[u]; dp[1] = v1[u]; }
    }
}
typedef float f32x16 __attribute__((ext_vector_type(16)));
template <int CTRL, int ROWMASK> __device__ __forceinline__ float dpp_mov(float old, float x) {
    return __builtin_bit_cast(float, __builtin_amdgcn_update_dpp(__builtin_bit_cast(int, old), __builtin_bit_cast(int, x), CTRL, ROWMASK, 0xF, false));
}
__device__ __forceinline__ float rdlane(float x, int l) { return __builtin_bit_cast(float, __builtin_amdgcn_readlane(__builtin_bit_cast(int, x), l)); }
__device__ __forceinline__ float wave_sum63(float x) {
    x += dpp_mov<0xB1, 0xF>(0.f, x);
    x += dpp_mov<0x4E, 0xF>(0.f, x);
    x += dpp_mov<0x141, 0xF>(0.f, x);
    x += dpp_mov<0x140, 0xF>(0.f, x);
    x += dpp_mov<0x142, 0xA>(0.f, x);
    x += dpp_mov<0x143, 0xC>(0.f, x);
    return x;
}
__device__ __forceinline__ float row16_sum(float x) {
    x += dpp_mov<0xB1, 0xF>(0.f, x); x += dpp_mov<0x4E, 0xF>(0.f, x); x += dpp_mov<0x141, 0xF>(0.f, x); x += dpp_mov<0x140, 0xF>(0.f, x);
    return x;
}
__device__ __forceinline__ pg8::f32x4 ld_bf16x4(const bf16_t* p) { const pg8::u32x2 w = *(const pg8::u32x2*)p;
    return (pg8::f32x4){__builtin_bit_cast(float, w.x << 16), __builtin_bit_cast(float, w.x & 0xffff0000u), __builtin_bit_cast(float, w.y << 16), __builtin_bit_cast(float, w.y & 0xffff0000u)}; }
__device__ __forceinline__ void st_bf16x4(bf16_t* p, pg8::f32x4 v) { pg8::u32x2 w; w.x = pk2(v[0], v[1]); w.y = pk2(v[2], v[3]); *(pg8::u32x2*)p = w; }

__device__ __forceinline__ void ph_conv(Frame& F, ArgsP a, int l) {
    const bf16_t* proj = (const bf16_t*)(a->ws + WS_PROJ); bf16_t* br = (bf16_t*)(a->ws + WS_HB);
    const float* cw = (const float*)a->in[15] + l * 31 * 256; const float* cb = (const float*)a->in[16] + l * 256; const float* lg = (const float*)a->in[17] + l * 256; const float* lb = (const float*)a->in[18] + l * 256;
    LAS float* u = (LAS float*)F.lds;
    int tid = F.wave * 64 + F.lane(); asm volatile("" : "+v"(tid)); const int lane = tid & 63;
    for (int it = blockIdx.x; it < M / 64; it += F.G) {
        const int row0 = it * 64, t0 = row0 % T;
#pragma unroll
        for (int i_ = 0; i_ < 6; ++i_) { const int idx = tid + i_ * NTHR; if (idx >= 94 * 32) break; const int r = idx >> 5, c8 = (idx & 31) * 8; float uv[8];
#pragma unroll
            for (int e = 0; e < 8; ++e) uv[e] = 0.f;
            if (t0 - 30 + r >= 0) { const bf16_t* pr = proj + (size_t)(row0 - 30 + r) * PW;
                const pg8::f32x4 a0 = ld_bf16x4(pr + P_CA + c8), a1 = ld_bf16x4(pr + P_CA + c8 + 4), b0 = ld_bf16x4(pr + P_CB + c8), b1 = ld_bf16x4(pr + P_CB + c8 + 4);
#pragma unroll
                for (int e = 0; e < 4; ++e) { uv[e] = a0[e] * sigm(b0[e]); uv[4 + e] = a1[e] * sigm(b1[e]); } }
            *(LAS pg8::f32x4*)(u + r * 256 + c8) = (pg8::f32x4){uv[0], uv[1], uv[2], uv[3]}; *(LAS pg8::f32x4*)(u + r * 256 + c8 + 4) = (pg8::f32x4){uv[4], uv[5], uv[6], uv[7]}; }
        __syncthreads();
        const int c = tid & 255, half = tid >> 8;
        float acc[32];
        { float w[31], ur[62];
#pragma unroll
          for (int j = 0; j < 31; ++j) w[j] = cw[j * 256 + c];
#pragma unroll
          for (int q = 0; q < 62; ++q) ur[q] = u[(half * 32 + q) * 256 + c];
          const float bias = cb[c];
#pragma unroll
          for (int i = 0; i < 32; ++i) { float s = bias;
#pragma unroll
              for (int j = 0; j < 31; ++j) s += w[j] * ur[i + j];
              acc[i] = s; } }
        __syncthreads();
#pragma unroll
        for (int i = 0; i < 32; ++i) u[(half * 32 + i) * 256 + c] = acc[i];
        __syncthreads();
        const pg8::f32x4 g4 = *(const pg8::f32x4*)(lg + 4 * lane), b4 = *(const pg8::f32x4*)(lb + 4 * lane);
#pragma unroll 2
        for (int q = 0; q < 8; ++q) { const int t = F.wave * 8 + q; const pg8::f32x4 yv = *(const LAS pg8::f32x4*)(u + t * 256 + 4 * lane);
            const float mu = wave_sum((yv[0] + yv[1]) + (yv[2] + yv[3])) * (1.0f / 256.0f); const pg8::f32x4 d = yv - mu;
            const float var = wave_sum((d[0] * d[0] + d[1] * d[1]) + (d[2] * d[2] + d[3] * d[3])) * (1.0f / 256.0f);
            pg8::f32x4 o = d * rsqrtf(var + 1e-5f) * g4 + b4;
#pragma unroll
            for (int e = 0; e < 4; ++e) o[e] = siluf(o[e]);
            st_bf16x4(br + (size_t)(row0 + t) * D + 512 + 4 * lane, o); }
        __syncthreads();
    }
}

__device__ __forceinline__ void ph_rwkv_prep(Frame& F, ArgsP a, int l) {
        const bf16_t* proj = (const bf16_t*)(a->ws + WS_PROJ);
    const float* mu = (const float*)a->in[19] + l * 1024; const float* w0 = (const float*)a->in[20] + l * 256; const float* a0 = (const float*)a->in[22] + l * 256;
    const float* kkw = (const float*)a->in[25] + l * 256; const float* kaw = (const float*)a->in[26] + l * 256; const float* rkw = (const float*)a->in[27] + l * 256;
    const bf16_t* W2T = (const bf16_t*)(a->ws + WS_LR) + l * 256 * 64; const bf16_t* A2T = (const bf16_t*)(a->ws + WS_LR) + 2 * 256 * 64 + l * 256 * 64; const bf16_t* G2T = (const bf16_t*)(a->ws + WS_LR) + 4 * 256 * 64 + l * 256 * 128;
    float* VEC = (float*)(a->ws + SCR_VEC6); float* SC = (float*)(a->ws + SCR_SC); bf16_t* GR = (bf16_t*)(a->ws + SCR_GR);
    constexpr int RS = 72, RG = 136;
    LAS bf16_t* TZh = (LAS bf16_t*)F.lds; LAS bf16_t* TZl = TZh + 64 * RS; LAS bf16_t* ZA = TZl + 64 * RS; LAS bf16_t* SG = ZA + 64 * RS;
    int tid = F.wave * 64 + F.lane(); asm volatile("" : "+v"(tid));
    for (int it = blockIdx.x; it < M / 64; it += F.G) {
        const int row0 = it * 64, b = row0 / T, t0 = row0 % T;
#pragma unroll 4
        for (int i_ = 0; i_ < 32; ++i_) { const int idx = tid + i_ * NTHR; const int cc = idx & 255, tok = idx >> 8; const int col = 768 + cc;
            const bf16_t* pc = proj + (size_t)(row0 + tok) * PW + P_R + col; const float xc = bf2f(pc[0]); const float xp = (t0 + tok > 0) ? bf2f(pc[-PW]) : 0.f;
            const float xm = xc + (xp - xc) * mu[col];
            if (cc < 64) { const float tv = tanhf(xm); const unsigned hi = f2bf(tv); TZh[tok * RS + cc] = (bf16_t)hi; TZl[tok * RS + cc] = (bf16_t)f2bf(tv - __builtin_bit_cast(float, hi << 16)); }
            else if (cc < 128) ZA[tok * RS + cc - 64] = (bf16_t)f2bf(xm);
            else SG[tok * RG + cc - 128] = (bf16_t)f2bf(sigm(xm)); }
        __syncthreads();
        int tid2 = tid; asm volatile("" : "+v"(tid2));
        const int lane = tid2 & 63, r = lane & 31, hg = lane >> 5, h = (tid2 >> 6) & 3, th = tid2 >> 8;
        f32x16 accw[2], acca[2], accg[2];
#pragma unroll
        for (int nb = 0; nb < 2; ++nb)
#pragma unroll
            for (int e = 0; e < 16; ++e) { accw[nb][e] = 0.f; acca[nb][e] = 0.f; accg[nb][e] = 0.f; }
        const int arow = (th * 32 + r);
#pragma unroll
        for (int s = 0; s < 4; ++s) { const pg8::bf16x8 ah = *(const LAS pg8::bf16x8*)(TZh + arow * RS + 16 * s + 8 * hg), al = *(const LAS pg8::bf16x8*)(TZl + arow * RS + 16 * s + 8 * hg), az = *(const LAS pg8::bf16x8*)(ZA + arow * RS + 16 * s + 8 * hg);
#pragma unroll
            for (int nb = 0; nb < 2; ++nb) { const int n = h * 64 + nb * 32 + r;
                const pg8::bf16x8 bw = *(const pg8::bf16x8*)(W2T + n * 64 + 16 * s + 8 * hg), ba = *(const pg8::bf16x8*)(A2T + n * 64 + 16 * s + 8 * hg);
                accw[nb] = __builtin_amdgcn_mfma_f32_32x32x16_bf16(ah, bw, accw[nb], 0, 0, 0); accw[nb] = __builtin_amdgcn_mfma_f32_32x32x16_bf16(al, bw, accw[nb], 0, 0, 0);
                acca[nb] = __builtin_amdgcn_mfma_f32_32x32x16_bf16(az, ba, acca[nb], 0, 0, 0); } }
#pragma unroll
        for (int s = 0; s < 8; ++s) { const pg8::bf16x8 ag = *(const LAS pg8::bf16x8*)(SG + arow * RG + 16 * s + 8 * hg);
#pragma unroll
            for (int nb = 0; nb < 2; ++nb) { const int n = h * 64 + nb * 32 + r; const pg8::bf16x8 bg = *(const pg8::bf16x8*)(G2T + n * 128 + 16 * s + 8 * hg);
                accg[nb] = __builtin_amdgcn_mfma_f32_32x32x16_bf16(ag, bg, accg[nb], 0, 0, 0); } }
        int tid3 = tid; asm volatile("" : "+v"(tid3)); const int r3 = tid3 & 31, hg3 = (tid3 >> 5) & 1, h3 = (tid3 >> 6) & 3, th3 = tid3 >> 8;
        float pw0[2], pa0[2], pmr[2], pmk[2], pmv[2], pkk[2], pka[2], prk[2];
#pragma unroll
        for (int nb = 0; nb < 2; ++nb) { const int c = h3 * 64 + nb * 32 + r3; pw0[nb] = w0[c]; pa0[nb] = a0[c]; pmr[nb] = mu[c]; pmk[nb] = mu[256 + c]; pmv[nb] = mu[512 + c]; pkk[nb] = kkw[c]; pka[nb] = kaw[c]; prk[nb] = rkw[c]; }
#pragma unroll
        for (int e = 0; e < 16; ++e) { const int tok = th3 * 32 + (e & 3) + 8 * (e >> 2) + 4 * hg3, t = t0 + tok; const size_t row = (size_t)row0 + tok; const bool hp = t > 0;
            float dec[2], kkv[2], kka[2], k2[2], rv[2], vv[2], s_kk = 0.f, s_c1 = 0.f, s_c2 = 0.f, s_bn = 0.f;
#pragma unroll
            for (int nb = 0; nb < 2; ++nb) { const int c = h3 * 64 + nb * 32 + r3; const bf16_t* pc = proj + row * PW + P_R + c;
                const float rc = bf2f(pc[0]), kc = bf2f(pc[256]), vc = bf2f(pc[512]);
                const float rp = hp ? bf2f(pc[-PW]) : 0.f, kp = hp ? bf2f(pc[256 - PW]) : 0.f, vp = hp ? bf2f(pc[512 - PW]) : 0.f;
                const float rr = rc + (rp - rc) * pmr[nb], k = kc + (kp - kc) * pmk[nb]; vv[nb] = vc + (vp - vc) * pmv[nb]; rv[nb] = rr;
                const float wl = -softplusf(-(accw[nb][e] + pw0[nb])) - 0.5f; dec[nb] = __expf(-__expf(wl)); const float av = sigm(acca[nb][e] + pa0[nb]);
                kkv[nb] = k * pkk[nb]; k2[nb] = k * (1.0f + (av - 1.0f) * pka[nb]); kka[nb] = av;
                s_kk += kkv[nb] * kkv[nb]; s_c2 += k2[nb] * rr; s_bn += rr * k2[nb] * prk[nb];
                GR[row * 256 + c] = (bf16_t)f2bf(accg[nb][e]); }
            s_kk = row16_sum(s_kk); s_kk += __shfl_xor(s_kk, 16);
            const float inv = 1.0f / fmaxf(sqrtf(s_kk), 1e-12f);
#pragma unroll
            for (int nb = 0; nb < 2; ++nb) { kkv[nb] *= inv; kka[nb] *= kkv[nb]; s_c1 += kka[nb] * rv[nb]; }
            s_c1 = row16_sum(s_c1); s_c1 += __shfl_xor(s_c1, 16); s_c2 = row16_sum(s_c2); s_c2 += __shfl_xor(s_c2, 16); s_bn = row16_sum(s_bn); s_bn += __shfl_xor(s_bn, 16);
            const size_t st = ((size_t)(b * 4 + h3) * T + t);
#pragma unroll
            for (int nb = 0; nb < 2; ++nb) { float* vb = VEC + st * VSTEP + nb * 32 + r3;
                vb[0] = dec[nb]; vb[64] = -kkv[nb]; vb[128] = kka[nb]; vb[192] = k2[nb]; vb[256] = dec[nb] * rv[nb]; vb[320] = vv[nb]; }
            if (r3 == 0) { *(pg8::f32x4*)(SC + st * 4) = (pg8::f32x4){s_c1, s_c2, s_bn, 0.f}; *(pg8::f32x2*)(VEC + st * VSTEP + 384) = (pg8::f32x2){s_c1, s_c2}; }
            asm volatile("" ::: "memory"); }
        __syncthreads();
    }
}

__device__ __forceinline__ void ph_rwkv_scan(Frame& F, ArgsP a) {
    const float* VEC = (const float*)(a->ws + SCR_VEC6); float* YR = (float*)(a->ws + SCR_YR);
    int lane = F.lane(); asm volatile("" : "+v"(lane));
    constexpr int CH = 32, CHB = CH * VSTEP * 4, NP = CHB / 1024 / 4;
    const bool stager = F.wave >= 4;
    for (int it = blockIdx.x; it < 256; it += F.G) {
        const int bh = it >> 3, rg = it & 7, b = bh >> 2, h = bh & 3;
        const int sw = F.wave & 3, vrow = rg * 8 + 2 * sw;
        const char* src = (const char*)(VEC + (size_t)bh * T * VSTEP) + lane * 16;
#define RW_STAGE(cidx) do { _Pragma("unroll") for (int p_ = 0; p_ < NP; ++p_) \
            __builtin_amdgcn_global_load_lds((const unsigned*)(src + (size_t)(cidx) * CHB + (sw * NP + p_) * 1024), (LAS unsigned*)(F.lds + ((cidx) & 1) * CHB + (sw * NP + p_) * 1024), 16, 0, 0); } while (0)
        if (stager) { RW_STAGE(0); asm volatile("s_waitcnt vmcnt(0)" ::: "memory"); }
        __builtin_amdgcn_s_barrier(); asm volatile("" ::: "memory");
        float SA = 0.f, SB = 0.f;
        for (int c = 0; c < T / CH; ++c) {
            if (stager) { if (c + 1 < T / CH) { RW_STAGE(c + 1); asm volatile("s_waitcnt vmcnt(0)" ::: "memory"); } }
            else {
                const LAS float* bufl = (const LAS float*)(F.lds + (c & 1) * CHB) + lane;
                const LAS float* bufv = (const LAS float*)(F.lds + (c & 1) * CHB) + 320 + vrow;
                const LAS float* bufc = (const LAS float*)(F.lds + (c & 1) * CHB) + 384;
                float zaA = 0.f, zaB = 0.f, saaA = 0.f, saaB = 0.f;
                float nw = bufl[0], nnkk = bufl[64], nkka = bufl[128], nk2 = bufl[192], nwr = bufl[256]; pg8::f32x2 nv = *(const LAS pg8::f32x2*)bufv;
#define RW_STEP(SI) do { \
                    const float w_ = nw, nkk = nnkk, kka = nkka, k2 = nk2, wr = nwr; const pg8::f32x2 v = nv; \
                    { const int s1 = ((SI) + 1 < CH ? (SI) + 1 : (SI)) * VSTEP; \
                      nw = bufl[s1]; nnkk = bufl[s1 + 64]; nkka = bufl[s1 + 128]; nk2 = bufl[s1 + 192]; nwr = bufl[s1 + 256]; nv = *(const LAS pg8::f32x2*)(bufv + s1); } \
                    asm volatile("" ::: "memory"); \
                    const auto s0 = __builtin_amdgcn_permlane32_swap(__builtin_bit_cast(unsigned, SA * nkk), __builtin_bit_cast(unsigned, SA * wr), false, false); \
                    const auto s1_ = __builtin_amdgcn_permlane32_swap(__builtin_bit_cast(unsigned, SB * nkk), __builtin_bit_cast(unsigned, SB * wr), false, false); \
                    const float xA = __builtin_bit_cast(float, (unsigned)s0[0]) + __builtin_bit_cast(float, (unsigned)s0[1]); \
                    const float xB = __builtin_bit_cast(float, (unsigned)s1_[0]) + __builtin_bit_cast(float, (unsigned)s1_[1]); \
                    const auto s2 = __builtin_amdgcn_permlane16_swap(__builtin_bit_cast(unsigned, xA), __builtin_bit_cast(unsigned, xB), false, false); \
                    float x = __builtin_bit_cast(float, (unsigned)s2[0]) + __builtin_bit_cast(float, (unsigned)s2[1]); \
                    x += dpp_mov<0xB1, 0xF>(0.f, x); x += dpp_mov<0x4E, 0xF>(0.f, x); x += dpp_mov<0x141, 0xF>(0.f, x); x += dpp_mov<0x140, 0xF>(0.f, x); \
                    const int isaA = __builtin_amdgcn_readlane(__builtin_bit_cast(int, x), 0), isaB = __builtin_amdgcn_readlane(__builtin_bit_cast(int, x), 16); \
                    const int izA = __builtin_amdgcn_readlane(__builtin_bit_cast(int, x), 32), izB = __builtin_amdgcn_readlane(__builtin_bit_cast(int, x), 48); \
                    const float saA = __builtin_bit_cast(float, isaA), saB = __builtin_bit_cast(float, isaB); \
                    SA = SA * w_ + (saA * kka + v[0] * k2); \
                    SB = SB * w_ + (saB * kka + v[1] * k2); \
                    asm volatile("v_writelane_b32 %0, %4, %8\n\tv_writelane_b32 %1, %5, %8\n\tv_writelane_b32 %2, %6, %8\n\tv_writelane_b32 %3, %7, %8" : "+v"(saaA), "+v"(saaB), "+v"(zaA), "+v"(zaB) : "s"(isaA), "s"(isaB), "s"(izA), "s"(izB), "n"(SI)); \
                } while (0)
                RW_STEP(0); RW_STEP(1); RW_STEP(2); RW_STEP(3); RW_STEP(4); RW_STEP(5); RW_STEP(6); RW_STEP(7); RW_STEP(8); RW_STEP(9); RW_STEP(10); RW_STEP(11); RW_STEP(12); RW_STEP(13); RW_STEP(14); RW_STEP(15); RW_STEP(16); RW_STEP(17); RW_STEP(18); RW_STEP(19); RW_STEP(20); RW_STEP(21); RW_STEP(22); RW_STEP(23); RW_STEP(24); RW_STEP(25); RW_STEP(26); RW_STEP(27); RW_STEP(28); RW_STEP(29); RW_STEP(30); RW_STEP(31);
#undef RW_STEP
                const int sl = (lane & 31) * VSTEP; const pg8::f32x2 vv = *(const LAS pg8::f32x2*)((const LAS float*)(F.lds + (c & 1) * CHB) + 320 + vrow + sl), cc = *(const LAS pg8::f32x2*)(bufc + sl);
                const float yaA = zaA + saaA * cc[0] + vv[0] * cc[1], yaB = zaB + saaB * cc[0] + vv[1] * cc[1];
                if (lane < CH) *(pg8::f32x2*)(YR + ((size_t)b * T + c * CH + lane) * 256 + h * 64 + vrow) = (pg8::f32x2){yaA, yaB};
            }
            __builtin_amdgcn_s_barrier(); asm volatile("" ::: "memory");
        }
#undef RW_STAGE
        asm volatile("s_waitcnt vmcnt(0)" ::: "memory"); __builtin_amdgcn_s_barrier(); asm volatile("" ::: "memory");
    }
}

__device__ __forceinline__ void ph_rwkv_post(Frame& F, ArgsP a, int l) {
    const float* VEC = (const float*)(a->ws + SCR_VEC6); const float* SC = (const float*)(a->ws + SCR_SC); const float* YR = (const float*)(a->ws + SCR_YR); const bf16_t* GR = (const bf16_t*)(a->ws + SCR_GR);
    const float* lng = (const float*)a->in[28] + l * 256; const float* lnb = (const float*)a->in[29] + l * 256;
    bf16_t* br = (bf16_t*)(a->ws + WS_HB);
    int lane = F.lane(); asm volatile("" : "+v"(lane));
    const int c = 4 * lane, h = lane >> 4;
    const pg8::f32x4 g4 = *(const pg8::f32x4*)(lng + c), b4 = *(const pg8::f32x4*)(lnb + c);
    for (int row = F.gw; row < M; row += F.NGW) {
        const int b = row / T, t = row % T; const size_t st = (size_t)(b * 4 + h) * T + t;
        const pg8::f32x4 y = *(const pg8::f32x4*)(YR + (size_t)row * 256 + c);
        const float mu = row16_sum((y[0] + y[1]) + (y[2] + y[3])) * (1.0f / 64.0f); const pg8::f32x4 d = y - mu;
        const float var = row16_sum((d[0] * d[0] + d[1] * d[1]) + (d[2] * d[2] + d[3] * d[3])) * (1.0f / 64.0f);
        const pg8::f32x4 yn = d * rsqrtf(var + 64e-5f) * g4 + b4;
        const float bonus = SC[st * 4 + 2];
        const pg8::f32x4 v = *(const pg8::f32x4*)(VEC + st * VSTEP + 320 + (c & 63));
        const pg8::f32x4 g = ld_bf16x4(GR + (size_t)row * 256 + c);
        st_bf16x4(br + (size_t)row * D + 768 + c, (yn + bonus * v) * g);
    }
}

__device__ __forceinline__ void ph_gla_p1(Frame& F, ArgsP a, int l) {
    const bf16_t* proj = (const bf16_t*)(a->ws + WS_PROJ); const float* w2 = (const float*)a->in[10] + l * 16 * 128; const float* gb = (const float*)a->in[11] + l * 128;
    bf16_t* QS = (bf16_t*)(a->ws + SCR_EG); float* CDp = (float*)(a->ws + SCR_EG) + (size_t)M * 128; float* GU = (float*)(a->ws + SCR_GU); float* OI = (float*)(a->ws + WS_GOI);
    const bf16_t* GZ = (const bf16_t*)(a->ws + WS_GZ);
    constexpr int RS = 40;
    LAS unsigned char* wl = F.lds + F.wave * 12800;
    LAS bf16_t* VTl = (LAS bf16_t*)wl; LAS bf16_t* Qs = (LAS bf16_t*)(wl + 5120); LAS bf16_t* Ks = (LAS bf16_t*)(wl + 7680); LAS bf16_t* KdT = (LAS bf16_t*)(wl + 10240);
    int lane = F.lane(); asm volatile("" : "+v"(lane));
    const int d = lane & 31, half = lane >> 5, r = lane & 31, hg = lane >> 5;
    for (int it = F.gw; it < 2048; it += F.NGW) {
        const int bh = it >> 6, n = it & 63, b = bh >> 2, h = bh & 3; const size_t row0 = (size_t)b * T + n * 32;
        float wc[16];
#pragma unroll
        for (int q = 0; q < 16; ++q) wc[q] = w2[q * 128 + h * 32 + d];
        const float gbv = gb[h * 32 + d];
        float g[16];
#pragma unroll
        for (int i = 0; i < 16; ++i) { const bf16_t* pr = GZ + (row0 + 16 * half + i) * 16;
            const pg8::f32x4 z0 = ld_bf16x4(pr), z1 = ld_bf16x4(pr + 4), z2 = ld_bf16x4(pr + 8), z3 = ld_bf16x4(pr + 12);
            float acc = gbv;
#pragma unroll
            for (int e = 0; e < 4; ++e) acc += z0[e] * wc[e] + z1[e] * wc[4 + e] + z2[e] * wc[8 + e] + z3[e] * wc[12 + e];
            g[i] = -softplusf(-acc) * (1.0f / 16.0f); }
#pragma unroll
        for (int i = 1; i < 16; ++i) g[i] += g[i - 1];
        const float other = __shfl(g[15], d);
        if (half) {
#pragma unroll
            for (int i = 0; i < 16; ++i) g[i] += other; }
        const float glast = __shfl(g[15], 32 + d);
#pragma unroll
        for (int i = 0; i < 16; ++i) { const int tok = 16 * half + i; const bf16_t* pr = proj + (row0 + tok) * PW;
            const float qv = bf2f(pr[P_GQ + h * 32 + d]), kv = bf2f(pr[P_GK + h * 32 + d]);
            const unsigned qb = f2bf(qv * 0.17677669529663687f * __expf(g[i]));
            Qs[tok * RS + d] = (bf16_t)qb; QS[((size_t)it * 32 + tok) * 32 + d] = (bf16_t)qb;
            Ks[tok * RS + d] = (bf16_t)f2bf(kv * __expf(-g[i])); KdT[d * RS + tok] = (bf16_t)f2bf(kv * __expf(glast - g[i])); }
        if (half) CDp[it * 32 + d] = __expf(glast);
        { const bf16_t* vp = proj + row0 * PW + P_GV + h * 64 + lane;
#pragma unroll
          for (int t2 = 0; t2 < 16; ++t2) { const unsigned lo = vp[(size_t)(2 * t2) * PW], hi = vp[(size_t)(2 * t2 + 1) * PW]; *(LAS unsigned*)(VTl + lane * RS + 2 * t2) = lo | (hi << 16); } }
        asm volatile("s_waitcnt lgkmcnt(0)" ::: "memory");
        f32x16 X;
#pragma unroll
        for (int e = 0; e < 16; ++e) X[e] = 0.f;
#pragma unroll
        for (int s = 0; s < 2; ++s) X = __builtin_amdgcn_mfma_f32_32x32x16_bf16(*(const LAS pg8::bf16x8*)(Ks + r * RS + 16 * s + 8 * hg), *(const LAS pg8::bf16x8*)(Qs + r * RS + 16 * s + 8 * hg), X, 0, 0, 0);
#pragma unroll
        for (int e = 0; e < 16; ++e) { const int jrow = (e & 3) + 8 * (e >> 2) + 4 * hg; if (jrow > r) X[e] = 0.f; }
        f32x16 oi[2], ut[2];
#pragma unroll
        for (int e = 0; e < 16; ++e) { oi[0][e] = 0.f; oi[1][e] = 0.f; ut[0][e] = 0.f; ut[1][e] = 0.f; }
#pragma unroll
        for (int s = 0; s < 2; ++s) {
            pg8::u32x4 pw; pw.x = pk2(X[8 * s], X[8 * s + 1]); pw.y = pk2(X[8 * s + 2], X[8 * s + 3]); pw.z = pk2(X[8 * s + 4], X[8 * s + 5]); pw.w = pk2(X[8 * s + 6], X[8 * s + 7]);
            const pg8::bf16x8 xf = __builtin_bit_cast(pg8::bf16x8, pw);
            const pg8::bf16x8 kdf = *(const LAS pg8::bf16x8*)(KdT + r * RS + 16 * s + 8 * hg);
#pragma unroll
            for (int db = 0; db < 2; ++db) { const LAS bf16_t* vp = VTl + (db * 32 + r) * RS + 16 * s;
                const pg8::u32x2 v0 = *(const LAS pg8::u32x2*)(vp + 4 * hg), v1 = *(const LAS pg8::u32x2*)(vp + 8 + 4 * hg);
                pg8::u32x4 vw; vw.x = v0.x; vw.y = v0.y; vw.z = v1.x; vw.w = v1.y;
                oi[db] = __builtin_amdgcn_mfma_f32_32x32x16_bf16(__builtin_bit_cast(pg8::bf16x8, vw), xf, oi[db], 0, 0, 0);
                ut[db] = __builtin_amdgcn_mfma_f32_32x32x16_bf16(*(const LAS pg8::bf16x8*)(vp + 8 * hg), kdf, ut[db], 0, 0, 0); } }
        float* op = OI + (size_t)it * 2048 + lane;
#pragma unroll
        for (int db = 0; db < 2; ++db)
#pragma unroll
            for (int e = 0; e < 16; ++e) op[(db * 16 + e) * 64] = oi[db][e];
        float* up = GU + ((size_t)it * 32 + r) * 64 + 4 * hg;
#pragma unroll
        for (int db = 0; db < 2; ++db)
#pragma unroll
            for (int q = 0; q < 4; ++q) *(pg8::f32x4*)(up + db * 32 + 8 * q) = (pg8::f32x4){ut[db][4 * q], ut[db][4 * q + 1], ut[db][4 * q + 2], ut[db][4 * q + 3]};
        asm volatile("s_waitcnt lgkmcnt(0)" ::: "memory");
    }
}
__device__ __forceinline__ void ph_gla_prefix(Frame& F, ArgsP a) {
    const float* CDp = (const float*)(a->ws + SCR_EG) + (size_t)M * 128; const float* GU = (const float*)(a->ws + SCR_GU); bf16_t* ST = (bf16_t*)(a->ws + WS_GST);
    int lane = F.lane(); asm volatile("" : "+v"(lane));
    for (int it = F.gw; it < 1024; it += F.NGW) { const int bh = it >> 5, d = it & 31;
        const float* gp = GU + ((size_t)bh * 64 * 32 + d) * 64 + lane; const float* cp = CDp + (size_t)bh * 64 * 32 + d;
        bf16_t* sp = ST + ((size_t)bh * 64 * 64 + lane) * 32 + d;
        float u[64], cd[64];
#pragma unroll
        for (int n = 0; n < 64; ++n) { u[n] = gp[(size_t)n * 2048]; cd[n] = cp[n * 32]; }
        float S = 0.f;
#pragma unroll
        for (int n = 0; n < 64; ++n) { sp[(size_t)n * 2048] = (bf16_t)f2bf(S); S = cd[n] * S + u[n]; } }
}
__device__ __forceinline__ void ph_gla_p2(Frame& F, ArgsP a, int l) {
    const bf16_t* proj = (const bf16_t*)(a->ws + WS_PROJ); const float* gnorm = (const float*)a->in[12] + l * 64;
    const bf16_t* QS = (const bf16_t*)(a->ws + SCR_EG); const bf16_t* ST = (const bf16_t*)(a->ws + WS_GST); const float* OI = (const float*)(a->ws + WS_GOI); bf16_t* br = (bf16_t*)(a->ws + WS_HB);
    int lane = F.lane(); asm volatile("" : "+v"(lane));
    const int r = lane & 31, hg = lane >> 5;
    for (int it = F.gw; it < 2048; it += F.NGW) {
        const int bh = it >> 6, n = it & 63, b = bh >> 2, h = bh & 3; const size_t row0 = (size_t)b * T + n * 32;
        f32x16 ot[2]; const float* op = OI + (size_t)it * 2048 + lane;
#pragma unroll
        for (int db = 0; db < 2; ++db)
#pragma unroll
            for (int e = 0; e < 16; ++e) ot[db][e] = op[(db * 16 + e) * 64];
#pragma unroll
        for (int s = 0; s < 2; ++s) { const pg8::bf16x8 qf = *(const pg8::bf16x8*)(QS + ((size_t)it * 32 + r) * 32 + 16 * s + 8 * hg);
#pragma unroll
            for (int db = 0; db < 2; ++db) ot[db] = __builtin_amdgcn_mfma_f32_32x32x16_bf16(*(const pg8::bf16x8*)(ST + ((size_t)it * 64 + db * 32 + r) * 32 + 16 * s + 8 * hg), qf, ot[db], 0, 0, 0); }
        float ss = 0.f;
#pragma unroll
        for (int db = 0; db < 2; ++db)
#pragma unroll
            for (int e = 0; e < 16; ++e) ss += ot[db][e] * ot[db][e];
        ss += __shfl_xor(ss, 32);
        const float rstd = rsqrtf(ss * (1.0f / 64.0f) + 1e-6f);
        const bf16_t* og = proj + (row0 + r) * PW + P_GO + h * 64 + 4 * hg; bf16_t* od = br + (row0 + r) * D + h * 64 + 4 * hg;
#pragma unroll
        for (int db = 0; db < 2; ++db)
#pragma unroll
            for (int q = 0; q < 4; ++q) { const int dv0 = db * 32 + 8 * q; const pg8::f32x4 gv = ld_bf16x4(og + dv0), gn = *(const pg8::f32x4*)(gnorm + dv0 + 4 * hg);
                st_bf16x4(od + dv0, (pg8::f32x4){ot[db][4 * q] * rstd * gn[0] * siluf(gv[0]), ot[db][4 * q + 1] * rstd * gn[1] * siluf(gv[1]), ot[db][4 * q + 2] * rstd * gn[2] * siluf(gv[2]), ot[db][4 * q + 3] * rstd * gn[3] * siluf(gv[3])}); }
    }
}

__device__ __forceinline__ void ph_attn_prep(Frame& F, ArgsP a) {
    const bf16_t* proj = (const bf16_t*)(a->ws + WS_PROJ); const int* pos = (const int*)a->in[2];
    bf16_t* QR = (bf16_t*)(a->ws + SCR_QK); bf16_t* KR = QR + (size_t)M * 256; bf16_t* VT = (bf16_t*)(a->ws + SCR_VT);
    int lane = F.lane(); asm volatile("" : "+v"(lane));
    for (int idx = F.gw * 64 + lane; idx < M * 8; idx += F.NGW * 64) { const int row = idx >> 3, hc = idx & 7; const float p = (float)pos[row];
        const bf16_t* qs = proj + (size_t)row * PW + P_DQ + hc * 32; const bf16_t* ks = proj + (size_t)row * PW + P_DK + hc * 32;
        float qv[32], kv[32];
#pragma unroll
        for (int j = 0; j < 8; ++j) { const pg8::f32x4 q4 = ld_bf16x4(qs + 4 * j), k4 = ld_bf16x4(ks + 4 * j);
#pragma unroll
            for (int e = 0; e < 4; ++e) { qv[4 * j + e] = q4[e]; kv[4 * j + e] = k4[e]; } }
        float qo[32], ko[32];
#pragma unroll
        for (int i = 0; i < 16; ++i) { const float inv = exp2f(-(float)i * 0.8304820237218406f);
            float sn, cs; sincosf(p * inv, &sn, &cs);
            qo[i] = qv[i] * cs - qv[i + 16] * sn; qo[i + 16] = qv[i] * sn + qv[i + 16] * cs;
            ko[i] = kv[i] * cs - kv[i + 16] * sn; ko[i + 16] = kv[i] * sn + kv[i + 16] * cs; }
        const float qsc = 0.17677669529663687f * 1.4426950408889634f;
        bf16_t* qd = QR + (size_t)row * 256 + hc * 32; bf16_t* kd = KR + (size_t)row * 256 + hc * 32;
#pragma unroll
        for (int j = 0; j < 8; ++j) { st_bf16x4(qd + 4 * j, (pg8::f32x4){qo[4 * j] * qsc, qo[4 * j + 1] * qsc, qo[4 * j + 2] * qsc, qo[4 * j + 3] * qsc});
            st_bf16x4(kd + 4 * j, (pg8::f32x4){ko[4 * j], ko[4 * j + 1], ko[4 * j + 2], ko[4 * j + 3]}); } }
    for (int it = F.gw; it < 1024; it += F.NGW) { const int bh = it >> 5, tt = it & 31, b = bh >> 2, h = bh & 3;
        const bf16_t* vs = proj + ((size_t)b * T + tt * 64 + lane) * PW + P_DV + h * 64;
        pg8::u32x4 v[8];
#pragma unroll
        for (int j = 0; j < 8; ++j) v[j] = *(const pg8::u32x4*)(vs + 8 * j);
        bf16_t* vd = VT + (size_t)bh * 64 * T + tt * 64 + lane;
#pragma unroll
        for (int j = 0; j < 8; ++j)
#pragma unroll
            for (int e = 0; e < 4; ++e) { const unsigned w = v[j][e]; vd[(size_t)(8 * j + 2 * e) * T] = (bf16_t)(w & 0xffffu); vd[(size_t)(8 * j + 2 * e + 1) * T] = (bf16_t)(w >> 16); } }
}
__device__ __forceinline__ void ph_attn(Frame& F, ArgsP a, int l) {
    const bf16_t* QR = (const bf16_t*)(a->ws + SCR_QK); const bf16_t* KR = QR + (size_t)M * 256; const bf16_t* VT = (const bf16_t*)(a->ws + SCR_VT);
    const float* lp = (const float*)a->in[13] + l * 128; const float* subln = (const float*)a->in[14] + l * 64; bf16_t* br = (bf16_t*)(a->ws + WS_HB);
    int tid = F.wave * 64 + F.lane(); asm volatile("" : "+v"(tid)); const int lane = tid & 63;
    const int r = lane & 31, hg = lane >> 5, comp = F.wave & 1, qs = F.wave >> 1;
    constexpr int RS = 72;
    LAS bf16_t* Kt = (LAS bf16_t*)F.lds;
    LAS bf16_t* Vt = Kt + 2 * 64 * RS;
    LAS float* Xl = (LAS float*)(F.lds + 4 * 64 * RS * 2);
    float lam, lam_init;
    { float d01 = 0.f, d23 = 0.f;
      for (int i = 0; i < 32; ++i) { d01 += lp[i] * lp[32 + i]; d23 += lp[64 + i] * lp[96 + i]; }
      lam_init = 0.8f - 0.6f * __expf(-0.3f * (float)l); lam = __expf(d01) - __expf(d23) + lam_init; }
    const int ldrow = tid >> 3, ldch = tid & 7;
    for (int pi = blockIdx.x; pi < 256; pi += F.G) {
#pragma unroll 1
        for (int half = 0; half < 2; ++half) {
            const int bh = pi >> 3, j = pi & 7, qb = half == 0 ? 15 - j : j, b = bh >> 2, h = bh & 3;
            const int q0 = qb * 128 + qs * 32, nkw = q0 / 64 + 1, nkb = 2 * qb + 2;
            const size_t rowb = (size_t)b * T;
            pg8::bf16x8 qf[2];
#pragma unroll
            for (int s = 0; s < 2; ++s) qf[s] = *(const pg8::bf16x8*)(QR + (rowb + q0 + r) * 256 + h * 64 + comp * 32 + 16 * s + 8 * hg);
            f32x16 ot[2];
#pragma unroll
            for (int e = 0; e < 16; ++e) { ot[0][e] = 0.f; ot[1][e] = 0.f; }
            float mrun = -1e30f, lrun = 0.f;
            const bf16_t* kg = KR + (rowb + ldrow) * 256 + h * 64 + ldch * 8; const bf16_t* vg = VT + ((size_t)bh * 64 + ldrow) * T + ldch * 8;
            pg8::u32x4 kreg = *(const pg8::u32x4*)kg, vreg = *(const pg8::u32x4*)vg;
            pg8::u32x4 kreg2 = kreg, vreg2 = vreg;
            if (nkb > 1) { kreg2 = *(const pg8::u32x4*)(kg + (size_t)64 * 256); vreg2 = *(const pg8::u32x4*)(vg + 64); }
            for (int kt = 0; kt < nkb; ++kt) {
                const int bo = (kt & 1) * 64 * RS;
                *(LAS pg8::u32x4*)(Kt + bo + ldrow * RS + ldch * 8) = kreg; *(LAS pg8::u32x4*)(Vt + bo + ldrow * RS + ldch * 8) = vreg;
                __syncthreads();
                kreg = kreg2; vreg = vreg2;
                if (kt + 2 < nkb) { kreg2 = *(const pg8::u32x4*)(kg + (size_t)(kt + 2) * 64 * 256); vreg2 = *(const pg8::u32x4*)(vg + (kt + 2) * 64); }
                if (kt < nkw) {
                    f32x16 st[2];
#pragma unroll
                    for (int kb = 0; kb < 2; ++kb) {
#pragma unroll
                        for (int e = 0; e < 16; ++e) st[kb][e] = 0.f;
#pragma unroll
                        for (int s = 0; s < 2; ++s) { const pg8::bf16x8 kf = *(const LAS pg8::bf16x8*)(Kt + bo + (kb * 32 + r) * RS + comp * 32 + 16 * s + 8 * hg);
                            st[kb] = __builtin_amdgcn_mfma_f32_32x32x16_bf16(kf, qf[s], st[kb], 0, 0, 0); } }
                    if (kt == nkw - 1) {
                        const int qi = q0 + r;
#pragma unroll
                        for (int kb = 0; kb < 2; ++kb)
#pragma unroll
                            for (int e = 0; e < 16; ++e) { const int ki = kt * 64 + kb * 32 + (e & 3) + 8 * (e >> 2) + 4 * hg; if (ki > qi) st[kb][e] = -1e30f; } }
                    float tm = st[0][0];
#pragma unroll
                    for (int e = 1; e < 16; ++e) tm = fmaxf(tm, st[0][e]);
#pragma unroll
                    for (int e = 0; e < 16; ++e) tm = fmaxf(tm, st[1][e]);
                    tm = fmaxf(tm, __shfl_xor(tm, 32));
                    const float mn = fmaxf(mrun, tm), alpha = exp2f(mrun - mn); mrun = mn;
                    float ps = 0.f;
#pragma unroll
                    for (int kb = 0; kb < 2; ++kb)
#pragma unroll
                        for (int e = 0; e < 16; ++e) { st[kb][e] = exp2f(st[kb][e] - mn); ps += st[kb][e]; }
                    lrun = lrun * alpha + ps;
#pragma unroll
                    for (int e = 0; e < 16; ++e) { ot[0][e] *= alpha; ot[1][e] *= alpha; }
#pragma unroll
                    for (int kb = 0; kb < 2; ++kb)
#pragma unroll
                        for (int s = 0; s < 2; ++s) {
                            pg8::u32x4 pw; pw.x = pk2(st[kb][8 * s], st[kb][8 * s + 1]); pw.y = pk2(st[kb][8 * s + 2], st[kb][8 * s + 3]); pw.z = pk2(st[kb][8 * s + 4], st[kb][8 * s + 5]); pw.w = pk2(st[kb][8 * s + 6], st[kb][8 * s + 7]);
                            const pg8::bf16x8 pf = __builtin_bit_cast(pg8::bf16x8, pw);
#pragma unroll
                            for (int dvb = 0; dvb < 2; ++dvb) { const LAS bf16_t* vp = Vt + bo + (dvb * 32 + r) * RS + kb * 32 + 16 * s + 4 * hg;
                                const pg8::u32x2 v0 = *(const LAS pg8::u32x2*)vp, v1 = *(const LAS pg8::u32x2*)(vp + 8);
                                pg8::u32x4 vw; vw.x = v0.x; vw.y = v0.y; vw.z = v1.x; vw.w = v1.y;
                                ot[dvb] = __builtin_amdgcn_mfma_f32_32x32x16_bf16(__builtin_bit_cast(pg8::bf16x8, vw), pf, ot[dvb], 0, 0, 0); } }
                }
            }
            const float ltot = lrun + __shfl_xor(lrun, 32); const float il = 1.0f / ltot;
            __syncthreads();
            if (comp == 1) {
#pragma unroll
                for (int dvb = 0; dvb < 2; ++dvb)
#pragma unroll
                    for (int e = 0; e < 16; ++e) Xl[(qs * 32 + dvb * 16 + e) * 64 + lane] = ot[dvb][e] * il; }
            __syncthreads();
            if (comp == 0) {
                float o[32]; float ss = 0.f;
#pragma unroll
                for (int dvb = 0; dvb < 2; ++dvb)
#pragma unroll
                    for (int e = 0; e < 16; ++e) { const float v = ot[dvb][e] * il - lam * Xl[(qs * 32 + dvb * 16 + e) * 64 + lane]; o[dvb * 16 + e] = v; ss += v * v; }
                ss += __shfl_xor(ss, 32);
                const float sc = rsqrtf(ss * (1.0f / 64.0f) + 1e-6f) * (1.0f - lam_init);
                bf16_t* od = br + (rowb + q0 + r) * D + 256 + h * 64;
#pragma unroll
                for (int dvb = 0; dvb < 2; ++dvb)
#pragma unroll
                    for (int g4 = 0; g4 < 4; ++g4) { const int dv0 = dvb * 32 + 8 * g4 + 4 * hg; const pg8::f32x4 sl = *(const pg8::f32x4*)(subln + dv0);
                        st_bf16x4(od + dv0, (pg8::f32x4){o[dvb * 16 + 4 * g4] * sc * sl[0], o[dvb * 16 + 4 * g4 + 1] * sc * sl[1], o[dvb * 16 + 4 * g4 + 2] * sc * sl[2], o[dvb * 16 + 4 * g4 + 3] * sc * sl[3]}); }
            }
            __syncthreads();
        }
    }
}

__device__ __forceinline__ void ph_branch(Frame& F, ArgsP a, int l) {
    const bf16_t* br = (const bf16_t*)(a->ws + WS_HB); const bf16_t* WB = (const bf16_t*)(a->ws + WS_WB) + (size_t)l * 4096 * 256;
    const bf16_t* proj = (const bf16_t*)(a->ws + WS_PROJ); bf16_t* MB = (bf16_t*)(a->ws + SCR_MB);
    int tid = F.wave * 64 + F.lane(); asm volatile("" : "+v"(tid)); const int lane = tid & 63;
    const int r = lane & 31, hg = lane >> 5, wt = (tid >> 6) & 3, wd = tid >> 8;
    constexpr int RS = 72, TB = 128 * RS;
    LAS bf16_t* Wl = (LAS bf16_t*)F.lds;
    LAS bf16_t* Bl = Wl + 2 * TB;
    const int ldr = tid >> 3, ldc = (tid & 7) * 8;
    for (int it = blockIdx.x; it < 1024; it += F.G) {
        const int tm = it >> 3, td = it & 7; const size_t row0 = (size_t)tm * 128; const int d0 = td * 128;
        f32x16 tot[2], acc[2];
#pragma unroll
        for (int e = 0; e < 16; ++e) { tot[0][e] = 0.f; tot[1][e] = 0.f; acc[0][e] = 0.f; acc[1][e] = 0.f; }
        pg8::u32x4 rw0, rw1, rb0, rb1;
#define BR_LOAD(st) do { const int g_ = (st) >> 2, kq_ = (st) & 3; const bf16_t* wp = WB + (size_t)(g_ * 1024 + d0 + ldr) * 256 + kq_ * 64 + ldc; const bf16_t* bp = br + (row0 + ldr) * D + g_ * 256 + kq_ * 64 + ldc; \
            rw0 = *(const pg8::u32x4*)wp; rw1 = *(const pg8::u32x4*)(wp + 64 * 256); rb0 = *(const pg8::u32x4*)bp; rb1 = *(const pg8::u32x4*)(bp + 64 * D); } while (0)
#define BR_WRITE(buf) do { *(LAS pg8::u32x4*)(Wl + (buf) * TB + ldr * RS + ldc) = rw0; *(LAS pg8::u32x4*)(Wl + (buf) * TB + (ldr + 64) * RS + ldc) = rw1; \
            *(LAS pg8::u32x4*)(Bl + (buf) * TB + ldr * RS + ldc) = rb0; *(LAS pg8::u32x4*)(Bl + (buf) * TB + (ldr + 64) * RS + ldc) = rb1; } while (0)
        BR_LOAD(0); BR_WRITE(0); __syncthreads(); BR_LOAD(1);
        pg8::u32x2 gt[2][4];
#pragma unroll 1
        for (int st = 0; st < 16; ++st) {
            const int buf = st & 1, g = st >> 2;
            if ((st & 3) == 0) {
                const bf16_t* gp = proj + (row0 + wt * 32 + r) * PW + P_GATE + g * 1024 + d0 + wd * 64 + 4 * hg;
#pragma unroll
                for (int db = 0; db < 2; ++db)
#pragma unroll
                    for (int q = 0; q < 4; ++q) gt[db][q] = *(const pg8::u32x2*)(gp + db * 32 + 8 * q); }
#pragma unroll
            for (int s = 0; s < 4; ++s) { const pg8::bf16x8 bf = *(const LAS pg8::bf16x8*)(Bl + buf * TB + (wt * 32 + r) * RS + 16 * s + 8 * hg);
#pragma unroll
                for (int db = 0; db < 2; ++db) { const pg8::bf16x8 af = *(const LAS pg8::bf16x8*)(Wl + buf * TB + (wd * 64 + db * 32 + r) * RS + 16 * s + 8 * hg);
                    acc[db] = __builtin_amdgcn_mfma_f32_32x32x16_bf16(af, bf, acc[db], 0, 0, 0); } }
            if (st + 1 < 16) BR_WRITE(buf ^ 1);
            if (st + 2 < 16) BR_LOAD(st + 2);
            if ((st & 3) == 3) {
#pragma unroll
                for (int db = 0; db < 2; ++db)
#pragma unroll
                    for (int q = 0; q < 4; ++q) { const pg8::u32x2 w = gt[db][q];
                        const float g0 = __builtin_bit_cast(float, w.x << 16), g1 = __builtin_bit_cast(float, w.x & 0xffff0000u), g2 = __builtin_bit_cast(float, w.y << 16), g3 = __builtin_bit_cast(float, w.y & 0xffff0000u);
                        tot[db][4 * q] += acc[db][4 * q] * sigm(g0); tot[db][4 * q + 1] += acc[db][4 * q + 1] * sigm(g1); tot[db][4 * q + 2] += acc[db][4 * q + 2] * sigm(g2); tot[db][4 * q + 3] += acc[db][4 * q + 3] * sigm(g3);
                        acc[db][4 * q] = 0.f; acc[db][4 * q + 1] = 0.f; acc[db][4 * q + 2] = 0.f; acc[db][4 * q + 3] = 0.f; } }
            __syncthreads();
        }
#undef BR_LOAD
#undef BR_WRITE
        bf16_t* mp = MB + (row0 + wt * 32 + r) * D + d0 + wd * 64 + 4 * hg;
#pragma unroll
        for (int db = 0; db < 2; ++db)
#pragma unroll
            for (int q = 0; q < 4; ++q) st_bf16x4(mp + db * 32 + 8 * q, (pg8::f32x4){tot[db][4 * q], tot[db][4 * q + 1], tot[db][4 * q + 2], tot[db][4 * q + 3]});
    }
}
constexpr int RING_BYTES = 131072, LDSCTL_OFF = RING_BYTES, MISC_OFF = LDSCTL_OFF + 320, LDS_BYTES = 147456;
constexpr int PH_PRO = 0, PH_H0 = 1, PH_L0 = 2, PH_PER_LAYER = 12, PH_END = PH_L0 + 2 * PH_PER_LAYER;
constexpr int PL_PROJ = 0, PL_MIXA = 1, PL_MIXB = 2, PL_MIXC = 3, PL_BRANCH = 4, PL_OUT = 5, PL_ROWMIX = 6, PL_FFN1 = 7, PL_FFN2 = 8, PL_FFN3 = 9, PL_ROWFFN = 10;

#ifndef DUPMASK
#define DUPMASK 0
#endif
#define DUP(bit) for (int dup_ = 0; dup_ < (((DUPMASK) >> (bit)) & 1) + 1; ++dup_)
__global__ void __launch_bounds__(NTHR, 2) mk_fwd(Args a) {
    extern __shared__ __attribute__((aligned(16))) unsigned char lds_raw[];
    Frame F0;
    F0.lds = (LAS unsigned char*)lds_raw;
    F0.wave = __builtin_amdgcn_readfirstlane(threadIdx.x >> 6);
    F0.G = gridDim.x; F0.gw = blockIdx.x * NWAVES + F0.wave; F0.NGW = F0.G * NWAVES;
    volatile LAS unsigned* MISC = (volatile LAS unsigned*)(F0.lds + MISC_OFF);
    for (int u = threadIdx.x; u < (LDS_BYTES - LDSCTL_OFF) / 4; u += NTHR) ((LAS unsigned*)(F0.lds + LDSCTL_OFF))[u] = 0u;
    __syncthreads();
    unsigned* ctl = (unsigned*)(a.ws + WS_CTL);
    const int lo = a.ph_lo, hi = a.ph_hi;
    XcdBarrier bar; bar.bar = ctl + CW_BAR; bar.x = 0; bar.st = nullptr;
    if (hi - lo > 1) bar = xcd_barrier_post(ctl + CW_BAR, MISC + 8);
#define IN(k) (lo <= (k) && (k) < hi)
#define SEAM(k) do { if (IN(k) && IN((k) + 1)) { xcd_barrier(bar); if ((DUPMASK >> 12) & 1) xcd_barrier(bar); } } while (0)
    if (IN(PH_PRO)) DUP(0) { ArgsP A = fresh_args(); Frame F = fresh(F0); p0_mod_items(F, (const float*)A->in[1], (const float*)A->in[3], (const float*)A->in[4], (float*)(A->ws + WS_MOD)); p0_convert(F, A); }
    SEAM(PH_PRO);
    if (IN(PH_H0)) DUP(9) { Frame F = fresh(F0); ph_h0(F, fresh_args()); }
    SEAM(PH_H0);
    for (int l = 0; l < NL; ++l) {
        const int base = PH_L0 + l * PH_PER_LAYER;
        if (IN(base + PL_PROJ)) DUP(13) { ArgsP A = fresh_args(); Frame F = fresh(F0); unsigned char* ws = A->ws;
            pg8::Gemm g{(const bf16_t*)(ws + WS_HB), (const bf16_t*)(ws + WS_WIN) + (size_t)l * PW * 1024, 1024, 1024, 1024, 0}; pg8::StaticOrder S; S.init(M, 7168, F.G, (int)blockIdx.x);
            pg8::EpiBf16 E{(bf16_t*)(ws + WS_PROJ), PW, 28};
            pg8::gemm_phase<pg8::EpiBf16, pg8::StaticOrder, true>(F.lds, g, S, E, F.wave);
        }
        SEAM(base + PL_PROJ);
        if (IN(base + PL_MIXA)) { DUP(2) { Frame F = fresh(F0); ph_conv(F, fresh_args(), l); } DUP(6) { Frame F = fresh(F0); ph_rwkv_prep(F, fresh_args(), l); } DUP(7) { Frame F = fresh(F0); ph_gla_p1(F, fresh_args(), l); } DUP(8) { Frame F = fresh(F0); ph_attn_prep(F, fresh_args()); } }
        SEAM(base + PL_MIXA);
        if (IN(base + PL_MIXB)) { DUP(10) { Frame F = fresh(F0); ph_gla_prefix(F, fresh_args()); } DUP(3) { Frame F = fresh(F0); ph_rwkv_scan(F, fresh_args()); } DUP(4) { Frame F = fresh(F0); ph_attn(F, fresh_args(), l); } }
        SEAM(base + PL_MIXB);
        if (IN(base + PL_MIXC)) { DUP(5) { Frame F = fresh(F0); ph_rwkv_post(F, fresh_args(), l); } DUP(11) { Frame F = fresh(F0); ph_gla_p2(F, fresh_args(), l); } }
        SEAM(base + PL_MIXC);
        if (IN(base + PL_BRANCH)) DUP(14) { ArgsP A = fresh_args(); Frame F = fresh(F0); unsigned char* ws = A->ws;
            pg8::Gemm g{(const bf16_t*)(ws + WS_HB), (const bf16_t*)(ws + WS_WB) + (size_t)l * 1024 * 1024, 1024, 1024, 1024, 0}; pg8::StaticOrder S; S.init(M, 1024, F.G, (int)blockIdx.x);
            pg8::EpiBranchK E{(const bf16_t*)(ws + WS_PROJ), (bf16_t*)(ws + SCR_MB)};
            pg8::gemm_phase<pg8::EpiBranchK, pg8::StaticOrder, false>(F.lds, g, S, E, F.wave);
        }
        SEAM(base + PL_BRANCH);
        if (IN(base + PL_OUT)) DUP(1) { ArgsP A = fresh_args(); Frame F = fresh(F0); unsigned char* ws = A->ws;
            pg8::Gemm g{(const bf16_t*)(ws + SCR_MB), (const bf16_t*)(ws + WS_WO) + (size_t)l * 1024 * 1024, 1024, 1024, 1024, 0}; pg8::StaticOrder S; S.init(M, 1024, F.G, (int)blockIdx.x);
            pg8::EpiBf16 E{(bf16_t*)(ws + SCR_Y), 1024, 4};
            pg8::gemm_phase<pg8::EpiBf16, pg8::StaticOrder, false>(F.lds, g, S, E, F.wave);
        }
        SEAM(base + PL_OUT);
        if (IN(base + PL_ROWMIX)) { ArgsP A = fresh_args(); Frame F = fresh(F0); unsigned char* ws = A->ws; const float* modl = (const float*)(ws + WS_MOD) + (size_t)l * 8 * 6144;
            ph_row(F, A, l == 0 ? (const float*)A->in[0] : A->out, (const bf16_t*)(ws + SCR_Y), (const float*)A->in[6] + l * D, modl, 2048, (const float*)A->in[7] + l * D, modl, 3072, 4096, (bf16_t*)(ws + (l == 0 ? WS_HB : WS_H2L1)), l == 1); }
        SEAM(base + PL_ROWMIX);
        if (l == 0) {
            if (IN(base + PL_FFN1)) DUP(1) { ArgsP A = fresh_args(); Frame F = fresh(F0); unsigned char* ws = A->ws;
                pg8::Gemm g{(const bf16_t*)(ws + WS_HB), (const bf16_t*)(ws + WS_WF1), 1024, 1024, 1024, 0}; pg8::StaticOrder S; S.init(M, 2 * DFF, F.G, (int)blockIdx.x);
                pg8::EpiSwiglu E{(bf16_t*)(ws + WS_PROJ), DFF, 2 * DFF / 256};
                pg8::gemm_phase<pg8::EpiSwiglu, pg8::StaticOrder, true>(F.lds, g, S, E, F.wave);
            }
            SEAM(base + PL_FFN1);
            if (IN(base + PL_FFN2)) DUP(1) { ArgsP A = fresh_args(); Frame F = fresh(F0); unsigned char* ws = A->ws;
                pg8::Gemm g{(const bf16_t*)(ws + WS_PROJ), (const bf16_t*)(ws + WS_WF2), DFF, DFF, DFF, 0}; pg8::StaticOrder S; S.init(M, 1024, F.G, (int)blockIdx.x);
                pg8::EpiBf16 E{(bf16_t*)(ws + SCR_Y), 1024, 4};
                pg8::gemm_phase<pg8::EpiBf16, pg8::StaticOrder, false>(F.lds, g, S, E, F.wave);
            }
            SEAM(base + PL_FFN2);
        } else {
            if (IN(base + PL_FFN1)) DUP(0) { Frame F = fresh(F0); ph_moe_prep(F, fresh_args()); }
            SEAM(base + PL_FFN1);
            if (IN(base + PL_FFN2)) DUP(15) { ArgsP A = fresh_args(); Frame F = fresh(F0); unsigned char* ws = A->ws; const unsigned* cnt = (const unsigned*)(ws + WS_CTL) + CW_CNT;
                pg8::Gemm g{(const bf16_t*)(ws + WS_HG), (const bf16_t*)(ws + WS_WM1), 1024, 1024, 1024, 0}; pg8::MoeOrder S; S.init(cnt, F.G, (int)blockIdx.x, 28);
                pg8::EpiSwiglu E{(bf16_t*)(ws + WS_HID), DEX, 28};
                pg8::gemm_phase<pg8::EpiSwiglu, pg8::MoeOrder, true>(F.lds, g, S, E, F.wave);
            }
            SEAM(base + PL_FFN2);
            if (IN(base + PL_FFN3)) DUP(16) { ArgsP A = fresh_args(); Frame F = fresh(F0); unsigned char* ws = A->ws; const unsigned* cnt = (const unsigned*)(ws + WS_CTL) + CW_CNT;
                pg8::Gemm g{(const bf16_t*)(ws + WS_HID), (const bf16_t*)(ws + WS_WM2), DEX, DEX, DEX, 0}; pg8::MoeOrder S; S.init(cnt, F.G, (int)blockIdx.x, 4);
                pg8::EpiBf16 E{(bf16_t*)(ws + WS_HG), 1024, 4};
                pg8::gemm_phase<pg8::EpiBf16, pg8::MoeOrder, true>(F.lds, g, S, E, F.wave);
            }
            SEAM(base + PL_FFN3);
        }
        if (IN(base + PL_ROWFFN)) { ArgsP A = fresh_args(); Frame F = fresh(F0); unsigned char* ws = A->ws; const float* modl = (const float*)(ws + WS_MOD) + (size_t)l * 8 * 6144;
            const bool last = (l == NL - 1);
            if (l == 0) ph_row(F, A, A->out, (const bf16_t*)(ws + SCR_Y), (const float*)A->in[8], modl, 5120, (const float*)A->in[5] + D, modl + 8 * 6144, 0, 1024, (bf16_t*)(ws + WS_HB), false, nullptr, (const float*)A->in[9] + (size_t)1024 * NIN);
            else ph_row(F, A, A->out, nullptr, (const float*)A->in[8] + D, modl, 5120, nullptr, nullptr, 0, 1024, nullptr, false, (const bf16_t*)(ws + WS_HG));
        }
        SEAM(base + PL_ROWFFN);
    }
#undef IN
#undef SEAM
}

extern "C" void kernel_launch(void* const* d_in, const int* in_sizes, int n_in, void* d_out, int out_size, void* d_ws, size_t ws_size, hipStream_t stream) {
    static int grid = 0;
    if (grid == 0) {
        if (n_in != 40 || ws_size < WS_END) { fprintf(stderr, "kernel_launch: need 40 inputs and >= %zu bytes of workspace (got %d, %zu)\n", (size_t)WS_END, n_in, ws_size); grid = -1; return; }
        int dev = 0, cus = 0, per_cu = 0;
        (void)hipGetDevice(&dev); (void)hipDeviceGetAttribute(&cus, hipDeviceAttributeMultiprocessorCount, dev);
        (void)hipFuncSetAttribute((const void*)mk_fwd, hipFuncAttributeMaxDynamicSharedMemorySize, LDS_BYTES);
        (void)hipOccupancyMaxActiveBlocksPerMultiprocessor(&per_cu, (const void*)mk_fwd, NTHR, LDS_BYTES);
        (void)hipGetLastError();
        grid = cus > 0 ? cus : 256;
        if (per_cu < 1) fprintf(stderr, "kernel_launch: occupancy query says %d blocks per CU\n", per_cu);
    }
    if (grid < 0) return;
    unsigned char* ws = (unsigned char*)d_ws;
    (void)hipMemsetAsync(ws + WS_CTL, 0, CTL_ZERO_BYTES, stream);
    Args a{};
    for (int i = 0; i < 40; ++i) a.in[i] = d_in[i];
    a.out = (float*)d_out; a.ws = ws;
    a.ph_lo = 0; a.ph_hi = PH_L0 + (NL - 1) * PH_PER_LAYER + PL_ROWFFN + 1;
    hipLaunchKernelGGL(mk_fwd, dim3(grid), dim3(NTHR), LDS_BYTES, stream, a);
}
```

```cpp
#include <hip/hip_runtime.h>
#include <hip/hip_bf16.h>
#include <cstdint>
#include <cstdio>

typedef __hip_bfloat16 bf16;
typedef unsigned short bf16_t;
#define GAS __attribute__((address_space(1)))
#define LAS __attribute__((address_space(3)))

constexpr int D = 1024, NB = 8, T = 2048, M = NB * T, NL = 2;
constexpr int NIN = 7184;
constexpr int PW = 7424;
constexpr int P_GQ = 0, P_GK = 128, P_GV = 256, P_GO = 512, P_DQ = 768, P_DK = 1024, P_DV = 1280, P_CA = 1536, P_CB = 1792, P_R = 2048, P_GATE = 3072, P_GZ = 7168;
constexpr int DFF = 2816, NE = 8, DEX = 3584;
constexpr int NWAVES = 8, NTHR = 512;
constexpr size_t MiB = 1u << 20;
constexpr size_t WS_CTL = 0;
constexpr size_t CTL_ZERO_BYTES = 64 * 1024;
constexpr size_t WS_MOD = 1 * MiB;
constexpr size_t WS_ROUTE = 1 * MiB + 512 * 1024;
constexpr size_t WS_GZ = 2 * MiB + 512 * 1024;
constexpr size_t WS_LR = 3 * MiB;
constexpr size_t WS_WIN = 4 * MiB;
constexpr size_t WS_WB = 33 * MiB;
constexpr size_t WS_WO = 37 * MiB;
constexpr size_t WS_WF1 = 41 * MiB;
constexpr size_t WS_WF2 = 52 * MiB;
constexpr size_t WS_HB = 58 * MiB;
constexpr size_t WS_PROJ = 90 * MiB;
constexpr size_t WS_SCR = 322 * MiB;
constexpr size_t WS_H2L1 = 508 * MiB;
constexpr size_t WS_END = 540 * MiB;
constexpr size_t WS_HG = 4 * MiB;
constexpr size_t WS_WM1 = 72 * MiB;
constexpr size_t WS_WM2 = 184 * MiB;
constexpr size_t WS_HID = 240 * MiB;
static_assert(WS_HID + (size_t)34816 * 3584 * 2 <= WS_H2L1, "moe overlay");
constexpr size_t SCR_MP = WS_SCR;
constexpr size_t SCR_MB = WS_SCR + 64 * MiB;
constexpr size_t SCR_Y = WS_SCR + 96 * MiB;
constexpr size_t SCR_RW = WS_SCR;
constexpr size_t SCR_GK = WS_SCR + 112 * MiB;
constexpr size_t SCR_QR = WS_SCR + 120 * MiB;
constexpr size_t SCR_KR = WS_SCR + 136 * MiB;
constexpr size_t SCR_VEC6 = WS_SCR;
constexpr size_t SCR_SC = WS_SCR + 112 * MiB;
constexpr size_t SCR_YR = WS_SCR + 113 * MiB;
constexpr size_t SCR_GR = WS_SCR + 129 * MiB;
constexpr size_t SCR_VT = WS_SCR + 137 * MiB;
constexpr size_t SCR_GU = WS_SCR + 145 * MiB;
constexpr size_t SCR_GS = SCR_GU;
constexpr size_t SCR_QK = WS_SCR + 161 * MiB;
constexpr size_t SCR_EG = WS_SCR + 177 * MiB;
constexpr size_t WS_GOI = WS_H2L1;
constexpr size_t WS_GST = WS_H2L1 + 16 * MiB;
constexpr int VSTEP = 448;
constexpr int CW_TMO = 0;
constexpr int CW_BAR = 1024;
constexpr int CW_CNT = 8192;
constexpr size_t RT_LIST = 0;
constexpr size_t RT_TOKE = 512 * 1024;
constexpr size_t RT_TOKS = 640 * 1024;
constexpr size_t RT_TOKP = 768 * 1024;

__device__ __forceinline__ float sigm(float x) { return __builtin_amdgcn_rcpf(1.0f + __expf(-x)); }
__device__ __forceinline__ float siluf(float x) { return x * sigm(x); }
__device__ __forceinline__ float softplusf(float x) { return fmaxf(x, 0.f) + __logf(1.0f + __expf(-fabsf(x))); }
__device__ __forceinline__ float tanh_fast(float x) { return 1.0f - 2.0f * __builtin_amdgcn_rcpf(1.0f + __expf(2.0f * x)); }
template <int CTRL, int ROWMASK> __device__ __forceinline__ float dpp_mov_h(float old, float x) {
    return __builtin_bit_cast(float, __builtin_amdgcn_update_dpp(__builtin_bit_cast(int, old), __builtin_bit_cast(int, x), CTRL, ROWMASK, 0xF, false)); }
__device__ __forceinline__ float wave_sum(float x) {
    x += dpp_mov_h<0xB1, 0xF>(0.f, x); x += dpp_mov_h<0x4E, 0xF>(0.f, x); x += dpp_mov_h<0x141, 0xF>(0.f, x); x += dpp_mov_h<0x140, 0xF>(0.f, x);
    x += dpp_mov_h<0x142, 0xA>(0.f, x); x += dpp_mov_h<0x143, 0xC>(0.f, x);
    return __builtin_bit_cast(float, __builtin_amdgcn_readlane(__builtin_bit_cast(int, x), 63));
}
__device__ __forceinline__ float wave_max(float v) {
#pragma unroll
    for (int o = 32; o > 0; o >>= 1) v = fmaxf(v, __shfl_xor(v, o));
    return v;
}
__device__ __forceinline__ float ldf(const float* p) { return *p; }
__device__ __forceinline__ float ldf(const bf16* p) { return __bfloat162float(*p); }
__device__ __forceinline__ float bf2f(bf16_t u) { return __builtin_bit_cast(float, (unsigned)u << 16); }
__device__ __forceinline__ unsigned f2bf(float f) { unsigned u = __builtin_bit_cast(unsigned, f); return (u + 0x7fffu + ((u >> 16) & 1u)) >> 16; }
typedef float f32x2_t_ __attribute__((ext_vector_type(2))); typedef __bf16 bf16x2_t_ __attribute__((ext_vector_type(2)));
__device__ __forceinline__ unsigned pk2(float lo, float hi) { const f32x2_t_ v = {lo, hi}; const bf16x2_t_ b = __builtin_convertvector(v, bf16x2_t_); return __builtin_bit_cast(unsigned, b); }
namespace pg8 {
#define PG8_LAS __attribute__((address_space(3)))
typedef short bf16x8 __attribute__((ext_vector_type(8)));
typedef float f32x4 __attribute__((ext_vector_type(4)));
typedef float f32x2 __attribute__((ext_vector_type(2)));
typedef unsigned u32x4 __attribute__((ext_vector_type(4)));
typedef unsigned u32x2 __attribute__((ext_vector_type(2)));
constexpr int BM = 256, BK = 64, HALF = 128, HTB = HALF * BK * 2  , STAGE_BYTES = 8 * HTB, NXCD = 8, WGM = 8;

__host__ __device__ __forceinline__ int lds_byte(int r, int c) { const int st = (r >> 4) * 2 + (c >> 5), rr = r & 15, cc = c & 31, ob = rr * 64 + cc * 2; return st * 1024 + (ob ^ (((ob >> 9) & 1) << 5)); }
__host__ __device__ __forceinline__ void stage_rc(int b, int& R, int& C) { const int st = b / 1024, sb = b % 1024, swz = sb ^ (((sb >> 9) & 1) << 5); R = (st >> 1) * 16 + swz / 64; C = (st & 1) * 32 + (swz % 64) / 2; }
__host__ __device__ __forceinline__ int perm32(int rho) { const int n = rho >> 4, i = rho & 15; return 8 * (i >> 2) + 4 * n + (i & 3); }

struct Unit { int pm, pn, aoff, tag; };
struct Gemm { const bf16_t* A; const bf16_t* Bt; int lda, ldb, K, pad; };

struct StaticOrder {
    int nM, nN, nwg, G, c;
    __host__ __device__ void init(int M_, int N_, int G_, int c_) { nM = M_ / BM; nN = N_ / BM; nwg = nM * nN; G = G_; c = c_; }
    __host__ __device__ bool next(int i, Unit& u) const {
        const long L = (long)i * G + c; if (L >= nwg) return false;
        int wgid = (int)L; { const int q = nwg / NXCD, r = nwg % NXCD, xcd = wgid % NXCD, off = wgid / NXCD; wgid = (xcd < r ? xcd * (q + 1) : r * (q + 1) + (xcd - r) * q) + off; }
        const int nig = WGM * nN, gid = wgid / nig, fm = gid * WGM, gsz = (nM - fm) < WGM ? (nM - fm) : WGM;
        u.pm = fm + ((wgid % nig) % gsz); u.pn = (wgid % nig) / gsz; u.aoff = 0; u.tag = 0; return true;
    }
};

__device__ __forceinline__ unsigned cvt_pk_bf16(float lo, float hi) { unsigned r; asm volatile("v_cvt_pk_bf16_f32 %0, %1, %2" : "=v"(r) : "v"(lo), "v"(hi)); return r; }


template <class Epi, class Sched, bool ALIGN_EPI>
__device__ __forceinline__ void gemm_phase(PG8_LAS unsigned char* lds, const Gemm g, const Sched& S, const Epi& E, int wave_s) {
    unsigned z_ = 0u; asm volatile("" : "+v"(z_));
    int tid_ = wave_s * 64 + (int)__builtin_amdgcn_mbcnt_hi(~0u, __builtin_amdgcn_mbcnt_lo(~0u, z_)); asm volatile("" : "+v"(tid_));
    const int tid = tid_, wid = __builtin_amdgcn_readfirstlane(tid >> 6), lane = tid & 63, wr = wid >> 2, wc = wid & 3, fr = lane & 15, fq = lane >> 4;
    const int K = g.K, nt = K / BK;
    unsigned voffA[2], voffB[2];
#pragma unroll
    for (int i = 0; i < 2; ++i) { int R, C; stage_rc(tid * 16 + i * 8192, R, C); const int Rb = Epi::PERM ? ((R & ~31) + perm32(R & 31)) : R;
        voffA[i] = (unsigned)(R * g.lda + C) * 2u; voffB[i] = (unsigned)(Rb * g.ldb + C) * 2u; }
    const size_t kstep = (size_t)(BK * 2);
    const size_t hstepA = (size_t)HALF * g.lda * 2, hstepB = (size_t)HALF * g.ldb * 2;
    const size_t tstepA = 2 * hstepA, tstepB = 2 * hstepB;
    const unsigned ldsw = (unsigned)wid * 1024u;
    const int aoff = lds_byte(wr * 64 + fr, fq * 8), boff = lds_byte(wc * 32 + fr, fq * 8);
#define PG8_SA(b, h) (((b) * 2 + (h)) * HTB)
#define PG8_SB(b, h) ((4 + (b) * 2 + (h)) * HTB)
#define PG8_STAGE(bufoff, gbase, voff) do { _Pragma("unroll") for (int _i = 0; _i < 2; ++_i) \
        __builtin_amdgcn_global_load_lds((const unsigned*)((const char*)(gbase) + (voff)[_i]), (PG8_LAS unsigned*)(lds + (bufoff) + ldsw + _i * 8192), 16, 0, 0); } while (0)
#define PG8_LDA(dst, b, h) do { _Pragma("unroll") for (int m = 0; m < 4; ++m) _Pragma("unroll") for (int k = 0; k < 2; ++k) dst[m][k] = *(const PG8_LAS bf16x8*)(lds + PG8_SA(b, h) + aoff + m * 2048 + k * 1024); } while (0)
#define PG8_LDB(dst, b, h) do { _Pragma("unroll") for (int n = 0; n < 2; ++n) _Pragma("unroll") for (int k = 0; k < 2; ++k) dst[n][k] = *(const PG8_LAS bf16x8*)(lds + PG8_SB(b, h) + boff + n * 2048 + k * 1024); } while (0)
#define PG8_MMA(ai, bj, At, Bt) do { __builtin_amdgcn_s_setprio(1); _Pragma("unroll") for (int m = 0; m < 4; ++m) _Pragma("unroll") for (int n = 0; n < 2; ++n) _Pragma("unroll") for (int k = 0; k < 2; ++k) \
        acc[ai][bj][m][n] = __builtin_amdgcn_mfma_f32_16x16x32_bf16(Bt[n][k], At[m][k], acc[ai][bj][m][n], 0, 0, 0); __builtin_amdgcn_s_setprio(0); } while (0)
#define PG8_WAIT_V(n) asm volatile("s_waitcnt vmcnt(" #n ")" ::: "memory")
#define PG8_WAIT_L(n) asm volatile("s_waitcnt lgkmcnt(" #n ")" ::: "memory")
#define PG8_BAR __builtin_amdgcn_s_barrier()
#define PG8_SCHED __builtin_amdgcn_sched_barrier(0)
    Unit cur, nxt; int ui = 0;
    if (!S.next(0, cur)) return;
    f32x4 acc[2][2][4][2];
#pragma unroll
    for (int a = 0; a < 2; ++a)
#pragma unroll
        for (int b = 0; b < 2; ++b)
#pragma unroll
            for (int m = 0; m < 4; ++m)
#pragma unroll
                for (int n = 0; n < 2; ++n) acc[a][b][m][n] = (f32x4){0.f, 0.f, 0.f, 0.f};
    bf16x8 At[4][2], B0[2][2], B1[2][2];
    const char* cA = (const char*)g.A + (size_t)cur.pm * tstepA + (size_t)cur.aoff * 2; const char* cB = (const char*)g.Bt + (size_t)cur.pn * tstepB;
    PG8_STAGE(PG8_SB(0, 0), cB, voffB); PG8_STAGE(PG8_SB(0, 1), cB + hstepB, voffB); PG8_STAGE(PG8_SA(0, 0), cA, voffA); PG8_STAGE(PG8_SA(0, 1), cA + hstepA, voffA);
    if (wr == 1) PG8_BAR;
    PG8_WAIT_V(2); PG8_BAR;
    PG8_STAGE(PG8_SB(1, 0), cB + kstep, voffB); PG8_STAGE(PG8_SA(1, 0), cA + kstep, voffA); PG8_STAGE(PG8_SB(1, 1), cB + hstepB + kstep, voffB);
    PG8_WAIT_V(6); PG8_BAR;
    for (;;) {
        const bool has_next = S.next(ui + 1, nxt);
        const char* nA = has_next ? (const char*)g.A + (size_t)nxt.pm * tstepA + (size_t)nxt.aoff * 2 : cA; const char* nB = has_next ? (const char*)g.Bt + (size_t)nxt.pn * tstepB : cB;
        for (int t = 0; t < nt; t += 2) {
            if constexpr (Epi::MIDK) { if (t != 0 && (t & 3) == 0) E.mid(acc, cur, t >> 2, wr, wc); }
            const bool last = (t == nt - 2);
            const char* a1 = cA + (size_t)(t + 1) * kstep;
            const char* a2 = last ? nA : cA + (size_t)(t + 2) * kstep; const char* b2 = last ? nB : cB + (size_t)(t + 2) * kstep;
            const char* a3 = a2 + kstep; const char* b3 = b2 + kstep;
            PG8_LDB(B0, 0, 0); PG8_LDB(B1, 0, 1); PG8_SCHED; PG8_LDA(At, 0, 0); PG8_STAGE(PG8_SA(1, 1), a1 + hstepA, voffA);
            PG8_WAIT_V(8); PG8_WAIT_L(0); PG8_BAR; PG8_MMA(0, 0, At, B0); PG8_MMA(0, 1, At, B1); PG8_BAR; PG8_SCHED;
            PG8_LDA(At, 0, 1); PG8_STAGE(PG8_SB(0, 0), b2, voffB); PG8_STAGE(PG8_SB(0, 1), b2 + hstepB, voffB); PG8_STAGE(PG8_SA(0, 0), a2, voffA);
            PG8_WAIT_V(8); PG8_WAIT_L(0); PG8_BAR; PG8_MMA(1, 0, At, B0); PG8_MMA(1, 1, At, B1); PG8_BAR; PG8_SCHED;
            PG8_LDB(B0, 1, 0); PG8_LDB(B1, 1, 1); PG8_SCHED; PG8_LDA(At, 1, 0); PG8_STAGE(PG8_SA(0, 1), a2 + hstepA, voffA);
            PG8_WAIT_V(8); PG8_WAIT_L(0); PG8_BAR; PG8_MMA(0, 0, At, B0); PG8_MMA(0, 1, At, B1); PG8_BAR; PG8_SCHED;
            PG8_LDA(At, 1, 1); PG8_STAGE(PG8_SB(1, 0), b3, voffB); PG8_STAGE(PG8_SB(1, 1), b3 + hstepB, voffB); PG8_STAGE(PG8_SA(1, 0), a3, voffA);
            PG8_WAIT_V(8); PG8_WAIT_L(0); PG8_BAR; PG8_MMA(1, 0, At, B0); PG8_MMA(1, 1, At, B1); PG8_BAR; PG8_SCHED;
        }
        if constexpr (ALIGN_EPI) { if (wr == 0) PG8_BAR; }
        { unsigned z2_ = 0u; asm volatile("" : "+v"(z2_)); const int l2_ = (int)__builtin_amdgcn_mbcnt_hi(~0u, __builtin_amdgcn_mbcnt_lo(~0u, z2_));
          E(acc, cur, wr, wc, l2_ & 15, l2_ >> 4); }
        if (!has_next) break;
#pragma unroll
        for (int a = 0; a < 2; ++a)
#pragma unroll
            for (int b = 0; b < 2; ++b)
#pragma unroll
                for (int m = 0; m < 4; ++m)
#pragma unroll
                    for (int n = 0; n < 2; ++n) acc[a][b][m][n] = (f32x4){0.f, 0.f, 0.f, 0.f};
        cur = nxt; cA = nA; cB = nB; ++ui;
        if constexpr (ALIGN_EPI) { if (wr == 1) PG8_BAR; }
    }
    PG8_WAIT_V(0);
    if constexpr (!ALIGN_EPI) { if (wr == 0) PG8_BAR; }
    PG8_BAR;
#undef PG8_SA
#undef PG8_SB
#undef PG8_STAGE
#undef PG8_LDA
#undef PG8_LDB
#undef PG8_MMA
#undef PG8_WAIT_V
#undef PG8_WAIT_L
#undef PG8_BAR
#undef PG8_SCHED
}

struct EpiBf16 {
    static constexpr bool PERM = true, MIDK = false;
    bf16_t* O; int ldc; int ntn;
    __device__ __forceinline__ void operator()(const f32x4 (&acc)[2][2][4][2], const Unit& u, int wr, int wc, int fr, int fq) const {
        const int row0 = u.pm * BM + wr * 64 + fr, col0 = (u.pn % ntn) * BM + wc * 32 + 8 * fq;
#pragma unroll
        for (int ai = 0; ai < 2; ++ai)
#pragma unroll
            for (int m = 0; m < 4; ++m) { bf16_t* rowp = O + (size_t)(row0 + ai * HALF + m * 16) * ldc + col0;
#pragma unroll
                for (int bj = 0; bj < 2; ++bj) { const f32x4 v0 = acc[ai][bj][m][0], v1 = acc[ai][bj][m][1];
                    u32x4 w; w.x = cvt_pk_bf16(v0[0], v0[1]); w.y = cvt_pk_bf16(v0[2], v0[3]); w.z = cvt_pk_bf16(v1[0], v1[1]); w.w = cvt_pk_bf16(v1[2], v1[3]);
                    *(u32x4*)(rowp + bj * HALF) = w; } }
    }
};
struct EpiF32 {
    static constexpr bool PERM = false, MIDK = false;
    float* C; int ldc; int ntn;
    __device__ __forceinline__ void operator()(const f32x4 (&acc)[2][2][4][2], const Unit& u, int wr, int wc, int fr, int fq) const {
        const int row0 = u.pm * BM + wr * 64 + fr, col0 = (u.pn % ntn) * BM + wc * 32 + 4 * fq;
#pragma unroll
        for (int ai = 0; ai < 2; ++ai)
#pragma unroll
            for (int m = 0; m < 4; ++m) { float* rowp = C + (size_t)(row0 + ai * HALF + m * 16) * ldc + col0;
#pragma unroll
                for (int bj = 0; bj < 2; ++bj)
#pragma unroll
                    for (int n = 0; n < 2; ++n) *(f32x4*)(rowp + bj * HALF + n * 16) = acc[ai][bj][m][n]; }
    }
};
struct EpiSwiglu {
    static constexpr bool PERM = true, MIDK = false;
    bf16_t* O; int ldc; int ntn;
    __device__ __forceinline__ void operator()(const f32x4 (&acc)[2][2][4][2], const Unit& u, int wr, int wc, int fr, int fq) const {
        const int row0 = u.pm * BM + wr * 64 + fr, col0 = (u.pn % ntn) * 128 + wc * 16 + 4 * fq;
#pragma unroll
        for (int ai = 0; ai < 2; ++ai)
#pragma unroll
            for (int m = 0; m < 4; ++m) { bf16_t* rowp = O + (size_t)(row0 + ai * HALF + m * 16) * ldc + col0;
#pragma unroll
                for (int bj = 0; bj < 2; ++bj) { const f32x4 gt = acc[ai][bj][m][0], up = acc[ai][bj][m][1];
                    float h[4];
#pragma unroll
                    for (int e = 0; e < 4; ++e) h[e] = gt[e] * __builtin_amdgcn_rcpf(1.0f + __expf(-gt[e])) * up[e];
                    u32x2 w; w.x = cvt_pk_bf16(h[0], h[1]); w.y = cvt_pk_bf16(h[2], h[3]);
                    *(u32x2*)(rowp + bj * 64) = w; } }
    }
};
struct EpiBranch {
    static constexpr bool PERM = true, MIDK = false;
    const bf16_t* proj; float* MP; bf16_t* MB;
    __device__ __forceinline__ void operator()(const f32x4 (&acc)[2][2][4][2], const Unit& u, int wr, int wc, int fr, int fq) const {
        const int g = u.tag; const int row0 = u.pm * BM + wr * 64 + fr, col0 = (u.pn & 3) * BM + wc * 32 + 8 * fq;
#pragma unroll
        for (int ai = 0; ai < 2; ++ai)
#pragma unroll
            for (int m = 0; m < 4; ++m) { const size_t row = (size_t)(row0 + ai * HALF + m * 16);
#pragma unroll
                for (int bj = 0; bj < 2; ++bj) { const int col = col0 + bj * HALF;
                    const u32x4 gw = *(const u32x4*)(proj + row * PW + P_GATE + g * 1024 + col);
                    float gv[8];
#pragma unroll
                    for (int e = 0; e < 4; ++e) { const unsigned w = gw[e]; gv[2 * e] = __builtin_bit_cast(float, w << 16); gv[2 * e + 1] = __builtin_bit_cast(float, w & 0xffff0000u); }
                    f32x4 v0 = acc[ai][bj][m][0], v1 = acc[ai][bj][m][1];
#pragma unroll
                    for (int e = 0; e < 4; ++e) { v0[e] *= __builtin_amdgcn_rcpf(1.0f + __expf(-gv[e])); v1[e] *= __builtin_amdgcn_rcpf(1.0f + __expf(-gv[4 + e])); }
                    float* mp = MP + row * D + col;
                    if (g > 0) { v0 += *(const f32x4*)mp; v1 += *(const f32x4*)(mp + 4); }
                    if (g < 3) { *(f32x4*)mp = v0; *(f32x4*)(mp + 4) = v1; }
                    else { u32x4 w; w.x = cvt_pk_bf16(v0[0], v0[1]); w.y = cvt_pk_bf16(v0[2], v0[3]); w.z = cvt_pk_bf16(v1[0], v1[1]); w.w = cvt_pk_bf16(v1[2], v1[3]);
                        *(u32x4*)(MB + row * D + col) = w; } } }
    }
};
struct EpiBranchK {
    static constexpr bool PERM = true, MIDK = true;
    const bf16_t* proj; bf16_t* MB;
    __device__ __forceinline__ static float em(float x) { return fminf(__expf(-x), 1e20f); }
    __device__ __forceinline__ void mid(f32x4 (&acc)[2][2][4][2], const Unit& u, int gnext, int wr, int wc) const {
        unsigned z_ = 0u; asm volatile("" : "+v"(z_)); const int l_ = (int)__builtin_amdgcn_mbcnt_hi(~0u, __builtin_amdgcn_mbcnt_lo(~0u, z_)); const int fr = l_ & 15, fq = l_ >> 4;
        const int row0 = u.pm * BM + wr * 64 + fr, col0 = u.pn * BM + wc * 32 + 8 * fq;
#pragma unroll
        for (int ai = 0; ai < 2; ++ai)
#pragma unroll
            for (int m = 0; m < 4; ++m) { const bf16_t* gp = proj + (size_t)(row0 + ai * HALF + m * 16) * PW + P_GATE + (gnext - 1) * 1024 + col0;
#pragma unroll
                for (int bj = 0; bj < 2; ++bj) { const u32x4 g0 = *(const u32x4*)(gp + bj * HALF), g1 = *(const u32x4*)(gp + 1024 + bj * HALF);
#pragma unroll
                    for (int e = 0; e < 4; ++e) { const unsigned a = g0[e], b = g1[e];
                        const float ra = (1.0f + em(__builtin_bit_cast(float, b << 16))) * __builtin_amdgcn_rcpf(1.0f + em(__builtin_bit_cast(float, a << 16)));
                        const float rb = (1.0f + em(__builtin_bit_cast(float, b & 0xffff0000u))) * __builtin_amdgcn_rcpf(1.0f + em(__builtin_bit_cast(float, a & 0xffff0000u)));
                        if (e < 2) { acc[ai][bj][m][0][2 * e] *= ra; acc[ai][bj][m][0][2 * e + 1] *= rb; } else { acc[ai][bj][m][1][2 * (e - 2)] *= ra; acc[ai][bj][m][1][2 * (e - 2) + 1] *= rb; } } } }
    }
    __device__ __forceinline__ void operator()(const f32x4 (&acc)[2][2][4][2], const Unit& u, int wr, int wc, int fr, int fq) const {
        const int row0 = u.pm * BM + wr * 64 + fr, col0 = u.pn * BM + wc * 32 + 8 * fq;
#pragma unroll
        for (int ai = 0; ai < 2; ++ai)
#pragma unroll
            for (int m = 0; m < 4; ++m) { const size_t row = (size_t)(row0 + ai * HALF + m * 16);
#pragma unroll
                for (int bj = 0; bj < 2; ++bj) { const u32x4 gw = *(const u32x4*)(proj + row * PW + P_GATE + 3 * 1024 + col0 + bj * HALF);
                    float sg[8];
#pragma unroll
                    for (int e = 0; e < 4; ++e) { sg[2 * e] = __builtin_amdgcn_rcpf(1.0f + em(__builtin_bit_cast(float, gw[e] << 16))); sg[2 * e + 1] = __builtin_amdgcn_rcpf(1.0f + em(__builtin_bit_cast(float, gw[e] & 0xffff0000u))); }
                    const f32x4 v0 = acc[ai][bj][m][0], v1 = acc[ai][bj][m][1];
                    u32x4 w; w.x = cvt_pk_bf16(v0[0] * sg[0], v0[1] * sg[1]); w.y = cvt_pk_bf16(v0[2] * sg[2], v0[3] * sg[3]); w.z = cvt_pk_bf16(v1[0] * sg[4], v1[1] * sg[5]); w.w = cvt_pk_bf16(v1[2] * sg[6], v1[3] * sg[7]);
                    *(u32x4*)(MB + row * D + col0 + bj * HALF) = w; } }
    }
};
struct BranchOrder {
    int G, c;
    __device__ bool next(int i, Unit& u) const {
        const int tile = (i >> 2) * G + c; if (tile >= 256) return false;
        const int g = i & 3; u.pm = tile >> 2; u.pn = g * 4 + (tile & 3); u.aoff = g * 256; u.tag = g; return true;
    }
};
struct MoeOrder {
    int G, c, ntiles, NT; int toff[9];
    __device__ void init(const unsigned* cnt, int G_, int c_, int NT_) { G = G_; c = c_; NT = NT_; int o = 0;
#pragma unroll
        for (int e = 0; e < 8; ++e) { toff[e] = o; o += ((int)cnt[e] + 255) >> 8; } toff[8] = o; ntiles = o; }
    __device__ bool next(int i, Unit& u) const {
        const int L = i * G + c; if (L >= ntiles * NT) return false;
        const int tau = L % ntiles, pn = L / ntiles; int e = 0;
#pragma unroll
        for (int q = 1; q < 8; ++q) e += (tau >= toff[q]) ? 1 : 0;
        u.pm = tau; u.pn = e * NT + pn; u.aoff = 0; u.tag = e; return true;
    }
};
}
typedef GAS unsigned gu32;
#define RLX_AGENT __ATOMIC_RELAXED, __HIP_MEMORY_SCOPE_AGENT
#define XB_TMO      128
#define XB_XCNT(j)  (256  + 64 * (j))
#define XB_XSUB(j)  (1280 + 64 * (j))
#define XB_XGEN(j)  (2304 + 64 * (j))
#define XB_TOP      3328
#define XB_TOPGEN   3392
#define XCD_BAR_WORDS 3456
#define XB_SPIN_CAP (1u << 18)

__device__ __forceinline__ unsigned xb_ld(unsigned* p)              { return __hip_atomic_load(p, __ATOMIC_RELAXED, __HIP_MEMORY_SCOPE_AGENT); }
__device__ __forceinline__ unsigned xb_add(unsigned* p, unsigned v) { return __hip_atomic_fetch_add(p, v, __ATOMIC_RELAXED, __HIP_MEMORY_SCOPE_AGENT); }
__device__ __forceinline__ unsigned xb_xcc_id() { return (unsigned)__builtin_amdgcn_s_getreg((3 << 11) | 20) & 0xFu; }
#define XB_SPIN(cond, bar) do { unsigned _sp = 0; while (cond) { __builtin_amdgcn_s_sleep(1); \
    if ((++_sp & 255u) == 0u) { if (xb_ld(&(bar)[XB_TMO])) break; if (_sp > XB_SPIN_CAP) { atomicAdd(&(bar)[XB_TMO], 1u); break; } } } } while (0)

struct XcdBarrier {
    unsigned* bar; unsigned x;
    volatile LAS unsigned* st;
};

__device__ __forceinline__ XcdBarrier xcd_barrier_post(unsigned* bar, volatile LAS unsigned* st) {
    XcdBarrier b; b.bar = bar; b.x = xb_xcc_id(); b.st = st;
    if (threadIdx.x == 0) (void)xb_add(&bar[XB_XCNT(b.x)], 1u);
    return b;
}
__device__ __forceinline__ void xcd_barrier_complete(unsigned* bar, unsigned x, unsigned& nloc, unsigned& nx) {
    const unsigned G = gridDim.x * gridDim.y * gridDim.z;
    unsigned sum, cnt, mine, sp = 0u;
    for (;;) {
        sum = 0u; cnt = 0u; mine = 0u;
#pragma unroll
        for (unsigned j = 0; j < 16; ++j) { const unsigned c = xb_ld(&bar[XB_XCNT(j)]); sum += c; cnt += (c > 0u) ? 1u : 0u; mine = (j == x) ? c : mine; }
        if (sum == G) break;
        __builtin_amdgcn_s_sleep(1);
        if ((++sp & 255u) == 0u) { if (xb_ld(&bar[XB_TMO])) break; if (sp > XB_SPIN_CAP) { atomicAdd(&bar[XB_TMO], 1u); break; } }
    }
    nloc = mine > 0u ? mine : 1u; nx = cnt > 0u ? cnt : 1u;
}

__device__ __forceinline__ void xcd_barrier(const XcdBarrier& b) {
    asm volatile("s_waitcnt vmcnt(0)" ::: "memory");
    __syncthreads();
    if (threadIdx.x == 0) {
        unsigned* bar = b.bar;
        __builtin_amdgcn_s_waitcnt(0);
        unsigned nloc = b.st[0], nx = b.st[1];
        if (nloc == 0u) { xcd_barrier_complete(bar, b.x, nloc, nx); b.st[0] = nloc; b.st[1] = nx; }
        const unsigned old = xb_add(&bar[XB_XSUB(b.x)], 1u);
        const unsigned gen = old / nloc;
        if (old + 1u == (gen + 1u) * nloc) {
            __builtin_amdgcn_fence(__ATOMIC_RELEASE, "agent");
            asm volatile("s_waitcnt vmcnt(0)" ::: "memory");
            const unsigned og = xb_add(&bar[XB_TOP], 1u);
            const unsigned tg = og / nx;
            if (og + 1u == (tg + 1u) * nx) xb_add(&bar[XB_TOPGEN], 1u);
            else XB_SPIN(xb_ld(&bar[XB_TOPGEN]) == tg, bar);
            __builtin_amdgcn_fence(__ATOMIC_ACQUIRE, "agent");
            xb_add(&bar[XB_XGEN(b.x)], 1u);
            asm volatile("s_waitcnt vmcnt(0)" ::: "memory");
        } else {
            XB_SPIN(xb_ld(&bar[XB_XGEN(b.x)]) == gen, bar);
            __builtin_amdgcn_fence(__ATOMIC_ACQUIRE, "agent");
            asm volatile("s_waitcnt vmcnt(0)" ::: "memory");
        }
    }
    __syncthreads();
}
struct Args { const void* in[40]; float* out; unsigned char* ws; int ph_lo, ph_hi; };
typedef const __attribute__((address_space(4))) Args* ArgsP;
__device__ __forceinline__ ArgsP fresh_args() { ArgsP p = (ArgsP)__builtin_amdgcn_kernarg_segment_ptr(); asm volatile("" : "+s"(p)); return p; }

struct Frame {
    LAS unsigned char* lds;
    int wave, G, gw, NGW;
    __device__ __forceinline__ int lane() const { unsigned z = 0u; asm volatile("" : "+v"(z)); return (int)__builtin_amdgcn_mbcnt_hi(~0u, __builtin_amdgcn_mbcnt_lo(~0u, z)); }
};

__device__ __forceinline__ Frame fresh(const Frame& F) { Frame R = F; asm volatile("" : "+s"(R.wave), "+s"(R.G), "+s"(R.gw), "+s"(R.NGW)); return R; }
#define LDS_WAIT() asm volatile("s_waitcnt lgkmcnt(0)" ::: "memory")

__device__ __forceinline__ void p0_mod_items(Frame& F, const float* c, const float* ada_w, const float* ada_b, float* mod) {
    LAS float* part = (LAS float*)F.lds;
    LAS float* cs = (LAS float*)(F.lds + 98304);
    int tid_ = F.wave * 64 + F.lane(); asm volatile("" : "+v"(tid_)); const int lane_ = tid_ & 63;
    if ((int)blockIdx.x >= 192) return;
    for (int i = tid_; i < 8192; i += NTHR) cs[i] = siluf(c[i]);
    __syncthreads();
    for (int it = blockIdx.x; it < 192; it += F.G) {
        const int l = it / 96, j0 = (it % 96) * 64;
        float acc[8];
#pragma unroll
        for (int b = 0; b < 8; ++b) acc[b] = 0.f;
        const float* w = ada_w + (size_t)l * 1024 * 6144 + j0 + lane_;
        const int k0 = F.wave * 128;
#pragma unroll 1
        for (int kb = 0; kb < 128; kb += 16) { float wv[16];
#pragma unroll
            for (int q = 0; q < 16; ++q) wv[q] = w[(size_t)(k0 + kb + q) * 6144];
#pragma unroll
            for (int q4 = 0; q4 < 4; ++q4)
#pragma unroll
                for (int b = 0; b < 8; ++b) { const pg8::f32x4 cv = *(const LAS pg8::f32x4*)(cs + b * 1024 + k0 + kb + 4 * q4);
                    acc[b] += (cv[0] * wv[4 * q4] + cv[1] * wv[4 * q4 + 1]) + (cv[2] * wv[4 * q4 + 2] + cv[3] * wv[4 * q4 + 3]); } }
#pragma unroll
        for (int b = 0; b < 8; ++b) part[(F.wave * 8 + b) * 64 + lane_] = acc[b];
        __syncthreads();
        { const int b = tid_ >> 6, col = tid_ & 63; float s = 0.f;
#pragma unroll
          for (int w8 = 0; w8 < 8; ++w8) s += part[(w8 * 8 + b) * 64 + col];
          mod[(size_t)(l * 8 + b) * 6144 + j0 + col] = s + ada_b[l * 6144 + j0 + col]; }
        __syncthreads();
    }
}
struct CvtDesc { const float* colp; size_t Ns; bf16_t* WT; int Kd, n0, k0; };
__device__ __forceinline__ void cvt_load(const CvtDesc& d, pg8::f32x4 (&v)[8], int lane) {
    const int kr = lane >> 3;
#pragma unroll
    for (int i = 0; i < 8; ++i) v[i] = d.colp ? *(const pg8::f32x4*)(d.colp + (size_t)(d.k0 + 8 * i + kr) * d.Ns) : (pg8::f32x4){0.f, 0.f, 0.f, 0.f};
}
__device__ __forceinline__ void cvt_store(const CvtDesc& d, const pg8::f32x4 (&v)[8], LAS float* scr, int lane) {
    const int q4 = 4 * (lane & 7), kr = lane >> 3;
#pragma unroll
    for (int i = 0; i < 8; ++i)
#pragma unroll
        for (int e = 0; e < 4; ++e) scr[(8 * i + kr) * 33 + q4 + e] = v[i][e];
    LDS_WAIT(); asm volatile("" ::: "memory");
    const int cidx = lane & 7;
#pragma unroll
    for (int j = 0; j < 4; ++j) { const int n = (lane >> 3) + 8 * j; const LAS float* s = scr + (8 * cidx) * 33 + n;
        pg8::u32x4 o; o.x = pk2(s[0 * 33], s[1 * 33]); o.y = pk2(s[2 * 33], s[3 * 33]); o.z = pk2(s[4 * 33], s[5 * 33]); o.w = pk2(s[6 * 33], s[7 * 33]);
        *(pg8::u32x4*)(d.WT + (size_t)(d.n0 + n) * d.Kd + d.k0 + 8 * cidx) = o; }
    LDS_WAIT(); asm volatile("" ::: "memory");
}
__device__ __forceinline__ int win_src_col(int v) { return v < 768 ? v : (v < 7168 ? v + 16 : (v < 7184 ? v - 6400 : -1)); }

__device__ __forceinline__ CvtDesc p0_desc(ArgsP a, int it, int n) {
    const float* w_in = (const float*)a->in[9]; const float* w_branch = (const float*)a->in[30]; const float* w_out = (const float*)a->in[31];
    const float* wg = (const float*)a->in[32]; const float* wu = (const float*)a->in[33]; const float* wd = (const float*)a->in[34];
    bf16_t* WIN = (bf16_t*)(a->ws + WS_WIN); bf16_t* WB = (bf16_t*)(a->ws + WS_WB); bf16_t* WO = (bf16_t*)(a->ws + WS_WO); bf16_t* WF1 = (bf16_t*)(a->ws + WS_WF1); bf16_t* WF2 = (bf16_t*)(a->ws + WS_WF2);
    bf16_t* LR = (bf16_t*)(a->ws + WS_LR);
    constexpr int I_IN = 2 * 232 * 16, I_B = 2 * 4 * 32 * 4, I_O = 2 * 32 * 16, I_F1 = 176 * 16, I_F2 = 32 * 44;
    int r = it;
    if (r < I_IN) { const int l = r / (232 * 16), q = r % (232 * 16), nb = q / 16, kb = q % 16; const int sc = win_src_col(nb * 32 + n);
        return CvtDesc{sc >= 0 ? w_in + (size_t)l * 1024 * NIN + sc : nullptr, (size_t)NIN, WIN + (size_t)l * PW * 1024, 1024, nb * 32, kb * 64}; } r -= I_IN;
    if (r < I_B) { const int lg = r / 128, q = r % 128, nb = q / 4, kb = q % 4;
        const int g = lg & 3, l = lg >> 2;
        return CvtDesc{w_branch + (size_t)lg * 256 * 1024 + nb * 32 + n - (size_t)g * 256 * 1024, 1024, WB + (size_t)l * 1024 * 1024, 1024, nb * 32, g * 256 + kb * 64}; } r -= I_B;
    if (r < I_O) { const int l = r / 512, q = r % 512, nb = q / 16, kb = q % 16;
        return CvtDesc{w_out + (size_t)l * 1024 * 1024 + nb * 32 + n, 1024, WO + (size_t)l * 1024 * 1024, 1024, nb * 32, kb * 64}; } r -= I_O;
    if (r < I_F1) { const int nb = r / 16, kb = r % 16; const int v = nb * 32 + n; const int up = (v >> 2) & 1, j = (v >> 3) * 4 + (v & 3);
        return CvtDesc{(up ? wu : wg) + j, (size_t)DFF, WF1, 1024, nb * 32, kb * 64}; } r -= I_F1;
    if (r < I_F2) { const int nb = r / 44, kb = r % 44;
        return CvtDesc{wd + nb * 32 + n, 1024, WF2, DFF, nb * 32, kb * 64}; } r -= I_F2;
    if (r < 16) { const int l = r >> 3, nb = r & 7; return CvtDesc{(const float*)a->in[21] + l * 64 * 256 + nb * 32 + n, 256, LR + l * 256 * 64, 64, nb * 32, 0}; } r -= 16;
    if (r < 16) { const int l = r >> 3, nb = r & 7; return CvtDesc{(const float*)a->in[23] + l * 64 * 256 + nb * 32 + n, 256, LR + 2 * 256 * 64 + l * 256 * 64, 64, nb * 32, 0}; } r -= 16;
    { const int l = r >> 4, nb = (r >> 1) & 7, kb = r & 1; return CvtDesc{(const float*)a->in[24] + l * 128 * 256 + nb * 32 + n, 256, LR + 4 * 256 * 64 + l * 256 * 128, 128, nb * 32, kb * 64}; }
}
__device__ __forceinline__ void p0_convert(Frame& F, ArgsP a) {
    LAS float* scr = (LAS float*)(F.lds + 16384 + F.wave * 8704);
    constexpr int NITEMS = 2 * 232 * 16 + 2 * 4 * 32 * 4 + 2 * 32 * 16 + 176 * 16 + 32 * 44 + 64;
    int lane_ = F.lane(); asm volatile("" : "+v"(lane_));
    const int n = 4 * (lane_ & 7);
    int it = F.gw; if (it >= NITEMS) return;
    CvtDesc cur = p0_desc(a, it, n); pg8::f32x4 v[8]; cvt_load(cur, v, lane_);
    for (;;) { const int nx = it + F.NGW; const bool more = nx < NITEMS;
        CvtDesc nd = cur; pg8::f32x4 w[8];
        if (more) { nd = p0_desc(a, nx, n); cvt_load(nd, w, lane_); }
        cvt_store(cur, v, scr, lane_);
        if (!more) break;
#pragma unroll
        for (int i = 0; i < 8; ++i) v[i] = w[i];
        cur = nd; it = nx; }
}

__device__ __forceinline__ void row_load(const float* p, pg8::f32x4 (&v)[4], int lane) {
#pragma unroll
    for (int j = 0; j < 4; ++j) v[j] = *(const pg8::f32x4*)(p + 4 * lane + 256 * j);
}
__device__ __forceinline__ float row_ss(const pg8::f32x4 (&v)[4]) {
    float s = 0.f;
#pragma unroll
    for (int j = 0; j < 4; ++j) s += (v[j][0] * v[j][0] + v[j][1] * v[j][1]) + (v[j][2] * v[j][2] + v[j][3] * v[j][3]);
    return wave_sum(s);
}
__device__ __forceinline__ void row_normmod(const pg8::f32x4 (&x)[4], const float* g, const float* mb, int sh_off, int sc_off, bf16_t* hrow, pg8::f32x4 (&hv)[4], int lane) {
    const float rstd = rsqrtf(row_ss(x) * (1.0f / D) + 1e-6f);
#pragma unroll
    for (int j = 0; j < 4; ++j) { const int d = 4 * lane + 256 * j;
        const pg8::f32x4 gg = *(const pg8::f32x4*)(g + d), sc = *(const pg8::f32x4*)(mb + sc_off + d), sh = *(const pg8::f32x4*)(mb + sh_off + d);
        hv[j] = x[j] * rstd * gg * (1.0f + sc) + sh;
        pg8::u32x2 w; w.x = pk2(hv[j][0], hv[j][1]); w.y = pk2(hv[j][2], hv[j][3]);
        *(pg8::u32x2*)(hrow + d) = w; }
}
template <int CTRL, int ROWMASK> __device__ __forceinline__ float dpp_mov_p(float old, float x) {
    return __builtin_bit_cast(float, __builtin_amdgcn_update_dpp(__builtin_bit_cast(int, old), __builtin_bit_cast(int, x), CTRL, ROWMASK, 0xF, false)); }
__device__ __forceinline__ float wave_sum63p(float x) {
    x += dpp_mov_p<0xB1, 0xF>(0.f, x); x += dpp_mov_p<0x4E, 0xF>(0.f, x); x += dpp_mov_p<0x141, 0xF>(0.f, x); x += dpp_mov_p<0x140, 0xF>(0.f, x);
    x += dpp_mov_p<0x142, 0xA>(0.f, x); x += dpp_mov_p<0x143, 0xC>(0.f, x); return x; }
__device__ __forceinline__ void stage_wz(const float* w_in_l, LAS float* wz, int tid) {
    for (int i = tid; i < 1024 * 4; i += NTHR) { const int d = i >> 2, q = i & 3; const pg8::f32x4 w = *(const pg8::f32x4*)(w_in_l + (size_t)d * NIN + 768 + 4 * q);
        wz[(4 * q) * 1024 + d] = w[0]; wz[(4 * q + 1) * 1024 + d] = w[1]; wz[(4 * q + 2) * 1024 + d] = w[2]; wz[(4 * q + 3) * 1024 + d] = w[3]; }
    __syncthreads();
}
__device__ __forceinline__ void row_gz(const pg8::f32x4 (&hv)[4], const LAS float* wz, bf16_t* gzrow, int lane) {
    float mine = 0.f;
#pragma unroll
    for (int o = 0; o < 16; ++o) { float acc = 0.f;
#pragma unroll
        for (int j = 0; j < 4; ++j) { const pg8::f32x4 w = *(const LAS pg8::f32x4*)(wz + o * 1024 + 4 * lane + 256 * j); acc += (hv[j][0] * w[0] + hv[j][1] * w[1]) + (hv[j][2] * w[2] + hv[j][3] * w[3]); }
        const float s = __builtin_bit_cast(float, __builtin_amdgcn_readlane(__builtin_bit_cast(int, wave_sum63p(acc)), 63)); if (lane == o) mine = s; }
    if (lane < 16) gzrow[lane] = (bf16_t)f2bf(mine);
}
__device__ __forceinline__ void ph_h0(Frame& F, ArgsP a) {
    const float* x = (const float*)a->in[0]; const float* g = (const float*)a->in[5]; const float* mod = (const float*)(a->ws + WS_MOD); bf16_t* H = (bf16_t*)(a->ws + WS_HB);
    bf16_t* GZ = (bf16_t*)(a->ws + WS_GZ); LAS float* wz = (LAS float*)F.lds;
    int lane0 = F.lane(); asm volatile("" : "+v"(lane0));
    stage_wz((const float*)a->in[9], wz, F.wave * 64 + lane0);
    int row = F.gw; if (row >= M) return;
    pg8::f32x4 xn[4]; row_load(x + (size_t)row * D, xn, lane0);
    for (;;) { int lane = lane0; asm volatile("" : "+v"(lane)); pg8::f32x4 xv[4], hv[4];
#pragma unroll
        for (int j = 0; j < 4; ++j) xv[j] = xn[j];
        const int nrow = row + F.NGW; if (nrow < M) row_load(x + (size_t)nrow * D, xn, lane);
        row_normmod(xv, g, mod + (size_t)(row / T) * 6144, 0, 1024, H + (size_t)row * D, hv, lane);
        row_gz(hv, wz, GZ + (size_t)row * 16, lane);
        if (nrow >= M) break; row = nrow; }
}
__device__ __forceinline__ void row_y_load(const bf16_t* y, const bf16_t* eout, const unsigned* cnt, const int* toke, const int* toks, int row, int lane, pg8::f32x4 (&yv)[4], pg8::u32x2 (&e1)[4], pg8::u32x2 (&e2)[4]) {
    if (eout) {
        int roff[8]; { int o = 0;
#pragma unroll
            for (int e = 0; e < 8; ++e) { roff[e] = o; o += (((int)cnt[e] + 255) >> 8) << 8; } }
        const int x1 = toke[row * 2], x2 = toke[row * 2 + 1]; int g1 = toks[row * 2], g2 = toks[row * 2 + 1];
#pragma unroll
        for (int q = 0; q < 8; ++q) { if (q == x1) g1 += roff[q]; if (q == x2) g2 += roff[q]; }
#pragma unroll
        for (int j = 0; j < 4; ++j) { e1[j] = *(const pg8::u32x2*)(eout + (size_t)g1 * D + 4 * lane + 256 * j); e2[j] = *(const pg8::u32x2*)(eout + (size_t)g2 * D + 4 * lane + 256 * j); }
    } else {
#pragma unroll
        for (int j = 0; j < 4; ++j) e1[j] = *(const pg8::u32x2*)(y + (size_t)row * D + 4 * lane + 256 * j); }
}
__device__ __forceinline__ void ph_row(Frame& F, ArgsP a, const float* xold, const bf16_t* y, const float* gpost, const float* modl, int gt_off,
                                       const float* gpre, const float* modn, int sh_off, int sc_off, bf16_t* hdst, bool route, const bf16_t* eout = nullptr, const float* w_in_next = nullptr) {
    float* out = a->out;
    bf16_t* GZ = (bf16_t*)(a->ws + WS_GZ); LAS float* wz = (LAS float*)F.lds;
    if (w_in_next) { int t_ = F.wave * 64 + F.lane(); stage_wz(w_in_next, wz, t_); }
    const float* rw = (const float*)a->in[35]; const float* rb = (const float*)a->in[36];
    unsigned* cnt = (unsigned*)(a->ws + WS_CTL) + CW_CNT;
    int* list = (int*)(a->ws + WS_ROUTE + RT_LIST); int* toke = (int*)(a->ws + WS_ROUTE + RT_TOKE); int* toks = (int*)(a->ws + WS_ROUTE + RT_TOKS); float* tokp = (float*)(a->ws + WS_ROUTE + RT_TOKP);
    int row = F.gw; if (row >= M) return;
    int lane0 = F.lane(); asm volatile("" : "+v"(lane0));
    pg8::f32x4 yn[4], xn[4]; pg8::u32x2 e1n[4], e2n[4];
    row_y_load(y, eout, cnt, toke, toks, row, lane0, yn, e1n, e2n); row_load(xold + (size_t)row * D, xn, lane0);
    for (;;) {
        int lane = lane0; asm volatile("" : "+v"(lane));
        const int b = row / T; pg8::f32x4 yv[4], xv[4], hv[4];
        if (eout) { const float p1 = tokp[row * 2], p2 = tokp[row * 2 + 1];
#pragma unroll
            for (int j = 0; j < 4; ++j) { const pg8::u32x2 a1 = e1n[j], a2 = e2n[j];
                yv[j][0] = p1 * __builtin_bit_cast(float, a1.x << 16) + p2 * __builtin_bit_cast(float, a2.x << 16); yv[j][1] = p1 * __builtin_bit_cast(float, a1.x & 0xffff0000u) + p2 * __builtin_bit_cast(float, a2.x & 0xffff0000u);
                yv[j][2] = p1 * __builtin_bit_cast(float, a1.y << 16) + p2 * __builtin_bit_cast(float, a2.y << 16); yv[j][3] = p1 * __builtin_bit_cast(float, a1.y & 0xffff0000u) + p2 * __builtin_bit_cast(float, a2.y & 0xffff0000u); }
        } else {
#pragma unroll
            for (int j = 0; j < 4; ++j) { const pg8::u32x2 a1 = e1n[j]; yv[j][0] = __builtin_bit_cast(float, a1.x << 16); yv[j][1] = __builtin_bit_cast(float, a1.x & 0xffff0000u); yv[j][2] = __builtin_bit_cast(float, a1.y << 16); yv[j][3] = __builtin_bit_cast(float, a1.y & 0xffff0000u); } }
#pragma unroll
        for (int j = 0; j < 4; ++j) xv[j] = xn[j];
        const int nrow = row + F.NGW;
        if (nrow < M) { row_y_load(y, eout, cnt, toke, toks, nrow, lane, yn, e1n, e2n); row_load(xold + (size_t)nrow * D, xn, lane); }
        const float rstd = rsqrtf(row_ss(yv) * (1.0f / D) + 1e-6f);
        const float* mb = modl + (size_t)b * 6144;
#pragma unroll
        for (int j = 0; j < 4; ++j) { const int d = 4 * lane + 256 * j;
            const pg8::f32x4 gp = *(const pg8::f32x4*)(gpost + d), gt = *(const pg8::f32x4*)(mb + gt_off + d);
            xv[j] = xv[j] + gt * (yv[j] * rstd * gp);
            *(pg8::f32x4*)(out + (size_t)row * D + d) = xv[j]; }
        if (hdst) {
            row_normmod(xv, gpre, modn + (size_t)b * 6144, sh_off, sc_off, hdst + (size_t)row * D, hv, lane);
            if (w_in_next) row_gz(hv, wz, GZ + (size_t)row * 16, lane);
            if (route) {
                float lg[8];
#pragma unroll
                for (int e = 0; e < 8; ++e) lg[e] = 0.f;
#pragma unroll
                for (int j = 0; j < 4; ++j)
#pragma unroll
                    for (int q = 0; q < 4; ++q) { const int d = 4 * lane + 256 * j + q; const pg8::f32x4 w0 = *(const pg8::f32x4*)(rw + d * 8), w1 = *(const pg8::f32x4*)(rw + d * 8 + 4); const float hq = hv[j][q];
                        lg[0] += hq * w0[0]; lg[1] += hq * w0[1]; lg[2] += hq * w0[2]; lg[3] += hq * w0[3]; lg[4] += hq * w1[0]; lg[5] += hq * w1[1]; lg[6] += hq * w1[2]; lg[7] += hq * w1[3]; }
#pragma unroll
                for (int e = 0; e < 8; ++e) lg[e] = wave_sum(lg[e]) + rb[e];
                if (lane == 0) {
                    int e1 = 0; float v1 = lg[0];
#pragma unroll
                    for (int e = 1; e < 8; ++e) if (lg[e] > v1) { v1 = lg[e]; e1 = e; }
                    int e2 = -1; float v2 = -3.0e38f;
#pragma unroll
                    for (int e = 0; e < 8; ++e) if (e != e1 && lg[e] > v2) { v2 = lg[e]; e2 = e; }
                    const float p1 = 1.0f / (1.0f + __expf(v2 - v1)), p2 = 1.0f - p1;
                    const int s1 = (int)atomicAdd(&cnt[e1], 1u), s2 = (int)atomicAdd(&cnt[e2], 1u);
                    list[e1 * M + s1] = row; list[e2 * M + s2] = row;
                    toke[row * 2] = e1; toke[row * 2 + 1] = e2; toks[row * 2] = s1; toks[row * 2 + 1] = s2; tokp[row * 2] = p1; tokp[row * 2 + 1] = p2;
                }
            }
        }
        if (nrow >= M) break; row = nrow;
    }
}

__device__ __forceinline__ void ph_moe_prep(Frame& F, ArgsP a) {
    LAS float* scr = (LAS float*)(F.lds + F.wave * 8704);
    const float* mg = (const float*)a->in[37]; const float* mu = (const float*)a->in[38]; const float* md = (const float*)a->in[39];
    bf16_t* WM1 = (bf16_t*)(a->ws + WS_WM1); bf16_t* WM2 = (bf16_t*)(a->ws + WS_WM2);
    constexpr int I_1 = 8 * 224 * 16, I_2 = 8 * 32 * 56;
    int lane_ = F.lane(); asm volatile("" : "+v"(lane_));
    const int n = 4 * (lane_ & 7);
    auto desc = [&](int r) -> CvtDesc {
        if (r < I_1) { const int e = r / 3584, q = r % 3584, nb = q / 16, kb = q % 16; const int v = nb * 32 + n; const int up = (v >> 2) & 1, j = (v >> 3) * 4 + (v & 3);
            return CvtDesc{(up ? mu : mg) + (size_t)e * 1024 * DEX + j, (size_t)DEX, WM1 + (size_t)e * 7168 * 1024, 1024, nb * 32, kb * 64}; }
        r -= I_1; const int e = r / 1792, q = r % 1792, nb = q / 56, kb = q % 56;
        return CvtDesc{md + (size_t)e * DEX * 1024 + nb * 32 + n, 1024, WM2 + (size_t)e * 1024 * DEX, DEX, nb * 32, kb * 64}; };
    { int it = F.gw;
      if (it < I_1 + I_2) { CvtDesc cur = desc(it); pg8::f32x4 v[8]; cvt_load(cur, v, lane_);
        for (;;) { const int nx = it + F.NGW; const bool more = nx < I_1 + I_2; CvtDesc nd = cur; pg8::f32x4 w[8];
            if (more) { nd = desc(nx); cvt_load(nd, w, lane_); }
            cvt_store(cur, v, scr, lane_);
            if (!more) break;
#pragma unroll
            for (int i = 0; i < 8; ++i) v[i] = w[i];
            cur = nd; it = nx; } } }
    const unsigned* cnt = (const unsigned*)(a->ws + WS_CTL) + CW_CNT;
    const int* list = (const int*)(a->ws + WS_ROUTE + RT_LIST);
    const bf16_t* h2 = (const bf16_t*)(a->ws + WS_H2L1); bf16_t* hg = (bf16_t*)(a->ws + WS_HG);
    int roff[9]; { int o = 0;
#pragma unroll
        for (int e = 0; e < 8; ++e) { roff[e] = o; o += (((int)cnt[e] + 255) >> 8) << 8; } roff[8] = o; }
    for (int slot0 = F.gw * 4; slot0 < roff[8]; slot0 += F.NGW * 4) {
        int src[4];
#pragma unroll
        for (int u = 0; u < 4; ++u) { const int slot = slot0 + u; int e = 0;
#pragma unroll
            for (int q = 1; q < 8; ++q) e += (slot >= roff[q]) ? 1 : 0;
            int base = 0, ce = 0;
#pragma unroll
            for (int q = 0; q < 8; ++q) if (q == e) { base = roff[q]; ce = (int)cnt[q]; }
            const int s = slot - base;
            src[u] = (slot < roff[8] && s < ce) ? list[e * M + s] : -1; }
        pg8::u32x4 v0[4], v1[4];
#pragma unroll
        for (int u = 0; u < 4; ++u) { v0[u] = (pg8::u32x4){0u, 0u, 0u, 0u}; v1[u] = v0[u];
            if (src[u] >= 0) { const pg8::u32x4* sp = (const pg8::u32x4*)(h2 + (size_t)src[u] * D) + 2 * lane_; v0[u] = sp[0]; v1[u] = sp[1]; } }
#pragma unroll
        for (int u = 0; u < 4; ++u) if (slot0 + u < roff[8]) { pg8::u32x4* dp = (pg8::u32x4*)(hg + (size_t)(slot0 + u) * D) + 2 * lane_; dp[0] = v0[u]; dp[1] = v1[u]; }
    }
}
typedef float f32x16 __attribute__((ext_vector_type(16)));
template <int CTRL, int ROWMASK> __device__ __forceinline__ float dpp_mov(float old, float x) {
    return __builtin_bit_cast(float, __builtin_amdgcn_update_dpp(__builtin_bit_cast(int, old), __builtin_bit_cast(int, x), CTRL, ROWMASK, 0xF, false));
}
__device__ __forceinline__ float rdlane(float x, int l) { return __builtin_bit_cast(float, __builtin_amdgcn_readlane(__builtin_bit_cast(int, x), l)); }
__device__ __forceinline__ float wave_sum63(float x) {
    x += dpp_mov<0xB1, 0xF>(0.f, x);
    x += dpp_mov<0x4E, 0xF>(0.f, x);
    x += dpp_mov<0x141, 0xF>(0.f, x);
    x += dpp_mov<0x140, 0xF>(0.f, x);
    x += dpp_mov<0x142, 0xA>(0.f, x);
    x += dpp_mov<0x143, 0xC>(0.f, x);
    return x;
}
__device__ __forceinline__ float row16_sum(float x) {
    x += dpp_mov<0xB1, 0xF>(0.f, x); x += dpp_mov<0x4E, 0xF>(0.f, x); x += dpp_mov<0x141, 0xF>(0.f, x); x += dpp_mov<0x140, 0xF>(0.f, x);
    return x;
}
__device__ __forceinline__ pg8::f32x4 ld_bf16x4(const bf16_t* p) { const pg8::u32x2 w = *(const pg8::u32x2*)p;
    return (pg8::f32x4){__builtin_bit_cast(float, w.x << 16), __builtin_bit_cast(float, w.x & 0xffff0000u), __builtin_bit_cast(float, w.y << 16), __builtin_bit_cast(float, w.y & 0xffff0000u)}; }
__device__ __forceinline__ void st_bf16x4(bf16_t* p, pg8::f32x4 v) { pg8::u32x2 w; w.x = pk2(v[0], v[1]); w.y = pk2(v[2], v[3]); *(pg8::u32x2*)p = w; }

__device__ __forceinline__ void ph_conv(Frame& F, ArgsP a, int l) {
    const bf16_t* proj = (const bf16_t*)(a->ws + WS_PROJ); bf16_t* br = (bf16_t*)(a->ws + WS_HB);
    const float* cw = (const float*)a->in[15] + l * 31 * 256; const float* cb = (const float*)a->in[16] + l * 256; const float* lg = (const float*)a->in[17] + l * 256; const float* lb = (const float*)a->in[18] + l * 256;
    LAS float* u = (LAS float*)F.lds;
    int tid = F.wave * 64 + F.lane(); asm volatile("" : "+v"(tid)); const int lane = tid & 63;
    for (int it = blockIdx.x; it < M / 64; it += F.G) {
        const int row0 = it * 64, t0 = row0 % T;
#pragma unroll
        for (int i_ = 0; i_ < 6; ++i_) { const int idx = tid + i_ * NTHR; if (idx >= 94 * 32) break; const int r = idx >> 5, c8 = (idx & 31) * 8; float uv[8];
#pragma unroll
            for (int e = 0; e < 8; ++e) uv[e] = 0.f;
            if (t0 - 30 + r >= 0) { const bf16_t* pr = proj + (size_t)(row0 - 30 + r) * PW;
                const pg8::f32x4 a0 = ld_bf16x4(pr + P_CA + c8), a1 = ld_bf16x4(pr + P_CA + c8 + 4), b0 = ld_bf16x4(pr + P_CB + c8), b1 = ld_bf16x4(pr + P_CB + c8 + 4);
#pragma unroll
                for (int e = 0; e < 4; ++e) { uv[e] = a0[e] * sigm(b0[e]); uv[4 + e] = a1[e] * sigm(b1[e]); } }
            *(LAS pg8::f32x4*)(u + r * 256 + c8) = (pg8::f32x4){uv[0], uv[1], uv[2], uv[3]}; *(LAS pg8::f32x4*)(u + r * 256 + c8 + 4) = (pg8::f32x4){uv[4], uv[5], uv[6], uv[7]}; }
        __syncthreads();
        const int c = tid & 255, half = tid >> 8;
        float acc[32];
        { float w[31], ur[62];
#pragma unroll
          for (int j = 0; j < 31; ++j) w[j] = cw[j * 256 + c];
#pragma unroll
          for (int q = 0; q < 62; ++q) ur[q] = u[(half * 32 + q) * 256 + c];
          const float bias = cb[c];
#pragma unroll
          for (int i = 0; i < 32; ++i) { float s = bias;
#pragma unroll
              for (int j = 0; j < 31; ++j) s += w[j] * ur[i + j];
              acc[i] = s; } }
        __syncthreads();
#pragma unroll
        for (int i = 0; i < 32; ++i) u[(half * 32 + i) * 256 + c] = acc[i];
        __syncthreads();
        const pg8::f32x4 g4 = *(const pg8::f32x4*)(lg + 4 * lane), b4 = *(const pg8::f32x4*)(lb + 4 * lane);
#pragma unroll 2
        for (int q = 0; q < 8; ++q) { const int t = F.wave * 8 + q; const pg8::f32x4 yv = *(const LAS pg8::f32x4*)(u + t * 256 + 4 * lane);
            const float mu = wave_sum((yv[0] + yv[1]) + (yv[2] + yv[3])) * (1.0f / 256.0f); const pg8::f32x4 d = yv - mu;
            const float var = wave_sum((d[0] * d[0] + d[1] * d[1]) + (d[2] * d[2] + d[3] * d[3])) * (1.0f / 256.0f);
            pg8::f32x4 o = d * rsqrtf(var + 1e-5f) * g4 + b4;
#pragma unroll
            for (int e = 0; e < 4; ++e) o[e] = siluf(o[e]);
            st_bf16x4(br + (size_t)(row0 + t) * D + 512 + 4 * lane, o); }
        __syncthreads();
    }
}

__device__ __forceinline__ void ph_rwkv_prep(Frame& F, ArgsP a, int l) {
        const bf16_t* proj = (const bf16_t*)(a->ws + WS_PROJ);
    const float* mu = (const float*)a->in[19] + l * 1024; const float* w0 = (const float*)a->in[20] + l * 256; const float* a0 = (const float*)a->in[22] + l * 256;
    const float* kkw = (const float*)a->in[25] + l * 256; const float* kaw = (const float*)a->in[26] + l * 256; const float* rkw = (const float*)a->in[27] + l * 256;
    const bf16_t* W2T = (const bf16_t*)(a->ws + WS_LR) + l * 256 * 64; const bf16_t* A2T = (const bf16_t*)(a->ws + WS_LR) + 2 * 256 * 64 + l * 256 * 64; const bf16_t* G2T = (const bf16_t*)(a->ws + WS_LR) + 4 * 256 * 64 + l * 256 * 128;
    float* VEC = (float*)(a->ws + SCR_VEC6); float* SC = (float*)(a->ws + SCR_SC); bf16_t* GR = (bf16_t*)(a->ws + SCR_GR);
    constexpr int RS = 72, RG = 136;
    LAS bf16_t* TZh = (LAS bf16_t*)F.lds; LAS bf16_t* TZl = TZh + 64 * RS; LAS bf16_t* ZA = TZl + 64 * RS; LAS bf16_t* SG = ZA + 64 * RS;
    int tid = F.wave * 64 + F.lane(); asm volatile("" : "+v"(tid));
    for (int it = blockIdx.x; it < M / 64; it += F.G) {
        const int row0 = it * 64, b = row0 / T, t0 = row0 % T;
#pragma unroll 4
        for (int i_ = 0; i_ < 32; ++i_) { const int idx = tid + i_ * NTHR; const int cc = idx & 255, tok = idx >> 8; const int col = 768 + cc;
            const bf16_t* pc = proj + (size_t)(row0 + tok) * PW + P_R + col; const float xc = bf2f(pc[0]); const float xp = (t0 + tok > 0) ? bf2f(pc[-PW]) : 0.f;
            const float xm = xc + (xp - xc) * mu[col];
            if (cc < 64) { const float tv = tanh_fast(xm); const unsigned hi = f2bf(tv); TZh[tok * RS + cc] = (bf16_t)hi; TZl[tok * RS + cc] = (bf16_t)f2bf(tv - __builtin_bit_cast(float, hi << 16)); }
            else if (cc < 128) ZA[tok * RS + cc - 64] = (bf16_t)f2bf(xm);
            else SG[tok * RG + cc - 128] = (bf16_t)f2bf(sigm(xm)); }
        __syncthreads();
        int tid2 = tid; asm volatile("" : "+v"(tid2));
        const int lane = tid2 & 63, r = lane & 31, hg = lane >> 5, h = (tid2 >> 6) & 3, th = tid2 >> 8;
        f32x16 accw[2], acca[2], accg[2];
#pragma unroll
        for (int nb = 0; nb < 2; ++nb)
#pragma unroll
            for (int e = 0; e < 16; ++e) { accw[nb][e] = 0.f; acca[nb][e] = 0.f; accg[nb][e] = 0.f; }
        const int arow = (th * 32 + r);
#pragma unroll
        for (int s = 0; s < 4; ++s) { const pg8::bf16x8 ah = *(const LAS pg8::bf16x8*)(TZh + arow * RS + 16 * s + 8 * hg), al = *(const LAS pg8::bf16x8*)(TZl + arow * RS + 16 * s + 8 * hg), az = *(const LAS pg8::bf16x8*)(ZA + arow * RS + 16 * s + 8 * hg);
#pragma unroll
            for (int nb = 0; nb < 2; ++nb) { const int n = h * 64 + nb * 32 + r;
                const pg8::bf16x8 bw = *(const pg8::bf16x8*)(W2T + n * 64 + 16 * s + 8 * hg), ba = *(const pg8::bf16x8*)(A2T + n * 64 + 16 * s + 8 * hg);
                accw[nb] = __builtin_amdgcn_mfma_f32_32x32x16_bf16(ah, bw, accw[nb], 0, 0, 0); accw[nb] = __builtin_amdgcn_mfma_f32_32x32x16_bf16(al, bw, accw[nb], 0, 0, 0);
                acca[nb] = __builtin_amdgcn_mfma_f32_32x32x16_bf16(az, ba, acca[nb], 0, 0, 0); } }
#pragma unroll
        for (int s = 0; s < 8; ++s) { const pg8::bf16x8 ag = *(const LAS pg8::bf16x8*)(SG + arow * RG + 16 * s + 8 * hg);
#pragma unroll
            for (int nb = 0; nb < 2; ++nb) { const int n = h * 64 + nb * 32 + r; const pg8::bf16x8 bg = *(const pg8::bf16x8*)(G2T + n * 128 + 16 * s + 8 * hg);
                accg[nb] = __builtin_amdgcn_mfma_f32_32x32x16_bf16(ag, bg, accg[nb], 0, 0, 0); } }
        int tid3 = tid; asm volatile("" : "+v"(tid3)); const int r3 = tid3 & 31, hg3 = (tid3 >> 5) & 1, h3 = (tid3 >> 6) & 3, th3 = tid3 >> 8;
        float pw0[2], pa0[2], pmr[2], pmk[2], pmv[2], pkk[2], pka[2], prk[2];
#pragma unroll
        for (int nb = 0; nb < 2; ++nb) { const int c = h3 * 64 + nb * 32 + r3; pw0[nb] = w0[c]; pa0[nb] = a0[c]; pmr[nb] = mu[c]; pmk[nb] = mu[256 + c]; pmv[nb] = mu[512 + c]; pkk[nb] = kkw[c]; pka[nb] = kaw[c]; prk[nb] = rkw[c]; }
#pragma unroll
        for (int e = 0; e < 16; ++e) { const int tok = th3 * 32 + (e & 3) + 8 * (e >> 2) + 4 * hg3, t = t0 + tok; const size_t row = (size_t)row0 + tok; const bool hp = t > 0;
            float dec[2], kkv[2], kka[2], k2[2], rv[2], vv[2], s_kk = 0.f, s_c1 = 0.f, s_c2 = 0.f, s_bn = 0.f;
#pragma unroll
            for (int nb = 0; nb < 2; ++nb) { const int c = h3 * 64 + nb * 32 + r3; const bf16_t* pc = proj + row * PW + P_R + c;
                const float rc = bf2f(pc[0]), kc = bf2f(pc[256]), vc = bf2f(pc[512]);
                const float rp = hp ? bf2f(pc[-PW]) : 0.f, kp = hp ? bf2f(pc[256 - PW]) : 0.f, vp = hp ? bf2f(pc[512 - PW]) : 0.f;
                const float rr = rc + (rp - rc) * pmr[nb], k = kc + (kp - kc) * pmk[nb]; vv[nb] = vc + (vp - vc) * pmv[nb]; rv[nb] = rr;
                const float wl = -softplusf(-(accw[nb][e] + pw0[nb])) - 0.5f; dec[nb] = __expf(-__expf(wl)); const float av = sigm(acca[nb][e] + pa0[nb]);
                kkv[nb] = k * pkk[nb]; k2[nb] = k * (1.0f + (av - 1.0f) * pka[nb]); kka[nb] = av;
                s_kk += kkv[nb] * kkv[nb]; s_c2 += k2[nb] * rr; s_bn += rr * k2[nb] * prk[nb];
                GR[row * 256 + c] = (bf16_t)f2bf(accg[nb][e]); }
            s_kk = row16_sum(s_kk); s_kk += __shfl_xor(s_kk, 16);
            const float inv = 1.0f / fmaxf(sqrtf(s_kk), 1e-12f);
#pragma unroll
            for (int nb = 0; nb < 2; ++nb) { kkv[nb] *= inv; kka[nb] *= kkv[nb]; s_c1 += kka[nb] * rv[nb]; }
            s_c1 = row16_sum(s_c1); s_c1 += __shfl_xor(s_c1, 16); s_c2 = row16_sum(s_c2); s_c2 += __shfl_xor(s_c2, 16); s_bn = row16_sum(s_bn); s_bn += __shfl_xor(s_bn, 16);
            const size_t st = ((size_t)(b * 4 + h3) * T + t);
#pragma unroll
            for (int nb = 0; nb < 2; ++nb) { float* vb = VEC + st * VSTEP + nb * 32 + r3;
                vb[0] = dec[nb]; vb[64] = -kkv[nb]; vb[128] = kka[nb]; vb[192] = k2[nb]; vb[256] = dec[nb] * rv[nb]; vb[320] = vv[nb]; }
            if (r3 == 0) { *(pg8::f32x4*)(SC + st * 4) = (pg8::f32x4){s_c1, s_c2, s_bn, 0.f}; *(pg8::f32x2*)(VEC + st * VSTEP + 384) = (pg8::f32x2){s_c1, s_c2}; }
            asm volatile("" ::: "memory"); }
        __syncthreads();
    }
}

__device__ __forceinline__ void ph_rwkv_scan(Frame& F, ArgsP a) {
    const float* VEC = (const float*)(a->ws + SCR_VEC6); float* YR = (float*)(a->ws + SCR_YR);
    int lane = F.lane(); asm volatile("" : "+v"(lane));
    constexpr int CH = 32, CHB = CH * VSTEP * 4, NP = CHB / 1024 / 4;
    const bool stager = F.wave >= 4;
    for (int it = blockIdx.x; it < 256; it += F.G) {
        const int bh = it >> 3, rg = it & 7, b = bh >> 2, h = bh & 3;
        const int sw = F.wave & 3, vrow = rg * 8 + 2 * sw;
        const char* src = (const char*)(VEC + (size_t)bh * T * VSTEP) + lane * 16;
#define RW_STAGE(cidx) do { _Pragma("unroll") for (int p_ = 0; p_ < NP; ++p_) \
            __builtin_amdgcn_global_load_lds((const unsigned*)(src + (size_t)(cidx) * CHB + (sw * NP + p_) * 1024), (LAS unsigned*)(F.lds + ((cidx) & 1) * CHB + (sw * NP + p_) * 1024), 16, 0, 0); } while (0)
        if (stager) { RW_STAGE(0); asm volatile("s_waitcnt vmcnt(0)" ::: "memory"); }
        __builtin_amdgcn_s_barrier(); asm volatile("" ::: "memory");
        float SA = 0.f, SB = 0.f;
        for (int c = 0; c < T / CH; ++c) {
            if (stager) { if (c + 1 < T / CH) { RW_STAGE(c + 1); asm volatile("s_waitcnt vmcnt(0)" ::: "memory"); } }
            else {
                const LAS float* bufl = (const LAS float*)(F.lds + (c & 1) * CHB) + lane;
                const LAS float* bufv = (const LAS float*)(F.lds + (c & 1) * CHB) + 320 + vrow;
                const LAS float* bufc = (const LAS float*)(F.lds + (c & 1) * CHB) + 384;
                float zaA = 0.f, zaB = 0.f, saaA = 0.f, saaB = 0.f;
                float nw = bufl[0], nnkk = bufl[64], nkka = bufl[128], nk2 = bufl[192], nwr = bufl[256]; pg8::f32x2 nv = *(const LAS pg8::f32x2*)bufv;
#define RW_STEP(SI) do { \
                    const float w_ = nw, nkk = nnkk, kka = nkka, k2 = nk2, wr = nwr; const pg8::f32x2 v = nv; \
                    { const int s1 = ((SI) + 1 < CH ? (SI) + 1 : (SI)) * VSTEP; \
                      nw = bufl[s1]; nnkk = bufl[s1 + 64]; nkka = bufl[s1 + 128]; nk2 = bufl[s1 + 192]; nwr = bufl[s1 + 256]; nv = *(const LAS pg8::f32x2*)(bufv + s1); } \
                    asm volatile("" ::: "memory"); \
                    const auto s0 = __builtin_amdgcn_permlane32_swap(__builtin_bit_cast(unsigned, SA * nkk), __builtin_bit_cast(unsigned, SA * wr), false, false); \
                    const auto s1_ = __builtin_amdgcn_permlane32_swap(__builtin_bit_cast(unsigned, SB * nkk), __builtin_bit_cast(unsigned, SB * wr), false, false); \
                    const float xA = __builtin_bit_cast(float, (unsigned)s0[0]) + __builtin_bit_cast(float, (unsigned)s0[1]); \
                    const float xB = __builtin_bit_cast(float, (unsigned)s1_[0]) + __builtin_bit_cast(float, (unsigned)s1_[1]); \
                    const auto s2 = __builtin_amdgcn_permlane16_swap(__builtin_bit_cast(unsigned, xA), __builtin_bit_cast(unsigned, xB), false, false); \
                    float x = __builtin_bit_cast(float, (unsigned)s2[0]) + __builtin_bit_cast(float, (unsigned)s2[1]); \
                    x += dpp_mov<0xB1, 0xF>(0.f, x); x += dpp_mov<0x4E, 0xF>(0.f, x); x += dpp_mov<0x141, 0xF>(0.f, x); x += dpp_mov<0x140, 0xF>(0.f, x); \
                    const int isaA = __builtin_amdgcn_readlane(__builtin_bit_cast(int, x), 0), isaB = __builtin_amdgcn_readlane(__builtin_bit_cast(int, x), 16); \
                    const int izA = __builtin_amdgcn_readlane(__builtin_bit_cast(int, x), 32), izB = __builtin_amdgcn_readlane(__builtin_bit_cast(int, x), 48); \
                    const float saA = __builtin_bit_cast(float, isaA), saB = __builtin_bit_cast(float, isaB); \
                    SA = SA * w_ + (saA * kka + v[0] * k2); \
                    SB = SB * w_ + (saB * kka + v[1] * k2); \
                    asm volatile("v_writelane_b32 %0, %4, %8\n\tv_writelane_b32 %1, %5, %8\n\tv_writelane_b32 %2, %6, %8\n\tv_writelane_b32 %3, %7, %8" : "+v"(saaA), "+v"(saaB), "+v"(zaA), "+v"(zaB) : "s"(isaA), "s"(isaB), "s"(izA), "s"(izB), "n"(SI)); \
                } while (0)
                RW_STEP(0); RW_STEP(1); RW_STEP(2); RW_STEP(3); RW_STEP(4); RW_STEP(5); RW_STEP(6); RW_STEP(7); RW_STEP(8); RW_STEP(9); RW_STEP(10); RW_STEP(11); RW_STEP(12); RW_STEP(13); RW_STEP(14); RW_STEP(15); RW_STEP(16); RW_STEP(17); RW_STEP(18); RW_STEP(19); RW_STEP(20); RW_STEP(21); RW_STEP(22); RW_STEP(23); RW_STEP(24); RW_STEP(25); RW_STEP(26); RW_STEP(27); RW_STEP(28); RW_STEP(29); RW_STEP(30); RW_STEP(31);
#undef RW_STEP
                const int sl = (lane & 31) * VSTEP; const pg8::f32x2 vv = *(const LAS pg8::f32x2*)((const LAS float*)(F.lds + (c & 1) * CHB) + 320 + vrow + sl), cc = *(const LAS pg8::f32x2*)(bufc + sl);
                const float yaA = zaA + saaA * cc[0] + vv[0] * cc[1], yaB = zaB + saaB * cc[0] + vv[1] * cc[1];
                if (lane < CH) *(pg8::f32x2*)(YR + ((size_t)b * T + c * CH + lane) * 256 + h * 64 + vrow) = (pg8::f32x2){yaA, yaB};
            }
            __builtin_amdgcn_s_barrier(); asm volatile("" ::: "memory");
        }
#undef RW_STAGE
        asm volatile("s_waitcnt vmcnt(0)" ::: "memory"); __builtin_amdgcn_s_barrier(); asm volatile("" ::: "memory");
    }
}

__device__ __forceinline__ void ph_rwkv_post(Frame& F, ArgsP a, int l) {
    const float* VEC = (const float*)(a->ws + SCR_VEC6); const float* SC = (const float*)(a->ws + SCR_SC); const float* YR = (const float*)(a->ws + SCR_YR); const bf16_t* GR = (const bf16_t*)(a->ws + SCR_GR);
    const float* lng = (const float*)a->in[28] + l * 256; const float* lnb = (const float*)a->in[29] + l * 256;
    bf16_t* br = (bf16_t*)(a->ws + WS_HB);
    int lane = F.lane(); asm volatile("" : "+v"(lane));
    const int c = 4 * lane, h = lane >> 4;
    const pg8::f32x4 g4 = *(const pg8::f32x4*)(lng + c), b4 = *(const pg8::f32x4*)(lnb + c);
    for (int row = F.gw; row < M; row += F.NGW) {
        const int b = row / T, t = row % T; const size_t st = (size_t)(b * 4 + h) * T + t;
        const pg8::f32x4 y = *(const pg8::f32x4*)(YR + (size_t)row * 256 + c);
        const float mu = row16_sum((y[0] + y[1]) + (y[2] + y[3])) * (1.0f / 64.0f); const pg8::f32x4 d = y - mu;
        const float var = row16_sum((d[0] * d[0] + d[1] * d[1]) + (d[2] * d[2] + d[3] * d[3])) * (1.0f / 64.0f);
        const pg8::f32x4 yn = d * rsqrtf(var + 64e-5f) * g4 + b4;
        const float bonus = SC[st * 4 + 2];
        const pg8::f32x4 v = *(const pg8::f32x4*)(VEC + st * VSTEP + 320 + (c & 63));
        const pg8::f32x4 g = ld_bf16x4(GR + (size_t)row * 256 + c);
        st_bf16x4(br + (size_t)row * D + 768 + c, (yn + bonus * v) * g);
    }
}

__device__ __forceinline__ void ph_gla_p1(Frame& F, ArgsP a, int l) {
    const bf16_t* proj = (const bf16_t*)(a->ws + WS_PROJ); const float* w2 = (const float*)a->in[10] + l * 16 * 128; const float* gb = (const float*)a->in[11] + l * 128;
    bf16_t* QS = (bf16_t*)(a->ws + SCR_EG); float* CDp = (float*)(a->ws + SCR_EG) + (size_t)M * 128; float* GU = (float*)(a->ws + SCR_GU); float* OI = (float*)(a->ws + WS_GOI);
    const bf16_t* GZ = (const bf16_t*)(a->ws + WS_GZ);
    constexpr int RS = 40;
    LAS unsigned char* wl = F.lds + F.wave * 12800;
    LAS bf16_t* VTl = (LAS bf16_t*)wl; LAS bf16_t* Qs = (LAS bf16_t*)(wl + 5120); LAS bf16_t* Ks = (LAS bf16_t*)(wl + 7680); LAS bf16_t* KdT = (LAS bf16_t*)(wl + 10240);
    int lane = F.lane(); asm volatile("" : "+v"(lane));
    const int d = lane & 31, half = lane >> 5, r = lane & 31, hg = lane >> 5;
    for (int it = F.gw; it < 2048; it += F.NGW) {
        const int bh = it >> 6, n = it & 63, b = bh >> 2, h = bh & 3; const size_t row0 = (size_t)b * T + n * 32;
        float wc[16];
#pragma unroll
        for (int q = 0; q < 16; ++q) wc[q] = w2[q * 128 + h * 32 + d];
        const float gbv = gb[h * 32 + d];
        float g[16];
#pragma unroll
        for (int i = 0; i < 16; ++i) { const bf16_t* pr = GZ + (row0 + 16 * half + i) * 16;
            const pg8::f32x4 z0 = ld_bf16x4(pr), z1 = ld_bf16x4(pr + 4), z2 = ld_bf16x4(pr + 8), z3 = ld_bf16x4(pr + 12);
            float acc = gbv;
#pragma unroll
            for (int e = 0; e < 4; ++e) acc += z0[e] * wc[e] + z1[e] * wc[4 + e] + z2[e] * wc[8 + e] + z3[e] * wc[12 + e];
            g[i] = -softplusf(-acc) * (1.0f / 16.0f); }
#pragma unroll
        for (int i = 1; i < 16; ++i) g[i] += g[i - 1];
        const float other = __shfl(g[15], d);
        if (half) {
#pragma unroll
            for (int i = 0; i < 16; ++i) g[i] += other; }
        const float glast = __shfl(g[15], 32 + d);
#pragma unroll
        for (int i = 0; i < 16; ++i) { const int tok = 16 * half + i; const bf16_t* pr = proj + (row0 + tok) * PW;
            const float qv = bf2f(pr[P_GQ + h * 32 + d]), kv = bf2f(pr[P_GK + h * 32 + d]);
            const unsigned qb = f2bf(qv * 0.17677669529663687f * __expf(g[i]));
            Qs[tok * RS + d] = (bf16_t)qb; QS[((size_t)it * 32 + tok) * 32 + d] = (bf16_t)qb;
            Ks[tok * RS + d] = (bf16_t)f2bf(kv * __expf(-g[i])); KdT[d * RS + tok] = (bf16_t)f2bf(kv * __expf(glast - g[i])); }
        if (half) CDp[it * 32 + d] = __expf(glast);
        { const bf16_t* vp = proj + row0 * PW + P_GV + h * 64 + lane;
#pragma unroll
          for (int t2 = 0; t2 < 16; ++t2) { const unsigned lo = vp[(size_t)(2 * t2) * PW], hi = vp[(size_t)(2 * t2 + 1) * PW]; *(LAS unsigned*)(VTl + lane * RS + 2 * t2) = lo | (hi << 16); } }
        asm volatile("s_waitcnt lgkmcnt(0)" ::: "memory");
        f32x16 X;
#pragma unroll
        for (int e = 0; e < 16; ++e) X[e] = 0.f;
#pragma unroll
        for (int s = 0; s < 2; ++s) X = __builtin_amdgcn_mfma_f32_32x32x16_bf16(*(const LAS pg8::bf16x8*)(Ks + r * RS + 16 * s + 8 * hg), *(const LAS pg8::bf16x8*)(Qs + r * RS + 16 * s + 8 * hg), X, 0, 0, 0);
#pragma unroll
        for (int e = 0; e < 16; ++e) { const int jrow = (e & 3) + 8 * (e >> 2) + 4 * hg; if (jrow > r) X[e] = 0.f; }
        f32x16 oi[2], ut[2];
#pragma unroll
        for (int e = 0; e < 16; ++e) { oi[0][e] = 0.f; oi[1][e] = 0.f; ut[0][e] = 0.f; ut[1][e] = 0.f; }
#pragma unroll
        for (int s = 0; s < 2; ++s) {
            pg8::u32x4 pw; pw.x = pk2(X[8 * s], X[8 * s + 1]); pw.y = pk2(X[8 * s + 2], X[8 * s + 3]); pw.z = pk2(X[8 * s + 4], X[8 * s + 5]); pw.w = pk2(X[8 * s + 6], X[8 * s + 7]);
            const pg8::bf16x8 xf = __builtin_bit_cast(pg8::bf16x8, pw);
            const pg8::bf16x8 kdf = *(const LAS pg8::bf16x8*)(KdT + r * RS + 16 * s + 8 * hg);
#pragma unroll
            for (int db = 0; db < 2; ++db) { const LAS bf16_t* vp = VTl + (db * 32 + r) * RS + 16 * s;
                const pg8::u32x2 v0 = *(const LAS pg8::u32x2*)(vp + 4 * hg), v1 = *(const LAS pg8::u32x2*)(vp + 8 + 4 * hg);
                pg8::u32x4 vw; vw.x = v0.x; vw.y = v0.y; vw.z = v1.x; vw.w = v1.y;
                oi[db] = __builtin_amdgcn_mfma_f32_32x32x16_bf16(__builtin_bit_cast(pg8::bf16x8, vw), xf, oi[db], 0, 0, 0);
                ut[db] = __builtin_amdgcn_mfma_f32_32x32x16_bf16(*(const LAS pg8::bf16x8*)(vp + 8 * hg), kdf, ut[db], 0, 0, 0); } }
        float* op = OI + (size_t)it * 2048 + lane;
#pragma unroll
        for (int db = 0; db < 2; ++db)
#pragma unroll
            for (int e = 0; e < 16; ++e) op[(db * 16 + e) * 64] = oi[db][e];
        float* up = GU + ((size_t)it * 32 + r) * 64 + 4 * hg;
#pragma unroll
        for (int db = 0; db < 2; ++db)
#pragma unroll
            for (int q = 0; q < 4; ++q) *(pg8::f32x4*)(up + db * 32 + 8 * q) = (pg8::f32x4){ut[db][4 * q], ut[db][4 * q + 1], ut[db][4 * q + 2], ut[db][4 * q + 3]};
        asm volatile("s_waitcnt lgkmcnt(0)" ::: "memory");
    }
}
__device__ __forceinline__ void ph_gla_prefix(Frame& F, ArgsP a) {
    const float* CDp = (const float*)(a->ws + SCR_EG) + (size_t)M * 128; const float* GU = (const float*)(a->ws + SCR_GU); bf16_t* ST = (bf16_t*)(a->ws + WS_GST);
    int lane = F.lane(); asm volatile("" : "+v"(lane));
    for (int it = F.gw; it < 1024; it += F.NGW) { const int bh = it >> 5, d = it & 31;
        const float* gp = GU + ((size_t)bh * 64 * 32 + d) * 64 + lane; const float* cp = CDp + (size_t)bh * 64 * 32 + d;
        bf16_t* sp = ST + ((size_t)bh * 64 * 64 + lane) * 32 + d;
        float u[64], cd[64];
#pragma unroll
        for (int n = 0; n < 64; ++n) { u[n] = gp[(size_t)n * 2048]; cd[n] = cp[n * 32]; }
        float S = 0.f;
#pragma unroll
        for (int n = 0; n < 64; ++n) { sp[(size_t)n * 2048] = (bf16_t)f2bf(S); S = cd[n] * S + u[n]; } }
}
__device__ __forceinline__ void ph_gla_p2(Frame& F, ArgsP a, int l) {
    const bf16_t* proj = (const bf16_t*)(a->ws + WS_PROJ); const float* gnorm = (const float*)a->in[12] + l * 64;
    const bf16_t* QS = (const bf16_t*)(a->ws + SCR_EG); const bf16_t* ST = (const bf16_t*)(a->ws + WS_GST); const float* OI = (const float*)(a->ws + WS_GOI); bf16_t* br = (bf16_t*)(a->ws + WS_HB);
    int lane = F.lane(); asm volatile("" : "+v"(lane));
    const int r = lane & 31, hg = lane >> 5;
    for (int it = F.gw; it < 2048; it += F.NGW) {
        const int bh = it >> 6, n = it & 63, b = bh >> 2, h = bh & 3; const size_t row0 = (size_t)b * T + n * 32;
        f32x16 ot[2]; const float* op = OI + (size_t)it * 2048 + lane;
#pragma unroll
        for (int db = 0; db < 2; ++db)
#pragma unroll
            for (int e = 0; e < 16; ++e) ot[db][e] = op[(db * 16 + e) * 64];
#pragma unroll
        for (int s = 0; s < 2; ++s) { const pg8::bf16x8 qf = *(const pg8::bf16x8*)(QS + ((size_t)it * 32 + r) * 32 + 16 * s + 8 * hg);
#pragma unroll
            for (int db = 0; db < 2; ++db) ot[db] = __builtin_amdgcn_mfma_f32_32x32x16_bf16(*(const pg8::bf16x8*)(ST + ((size_t)it * 64 + db * 32 + r) * 32 + 16 * s + 8 * hg), qf, ot[db], 0, 0, 0); }
        float ss = 0.f;
#pragma unroll
        for (int db = 0; db < 2; ++db)
#pragma unroll
            for (int e = 0; e < 16; ++e) ss += ot[db][e] * ot[db][e];
        ss += __shfl_xor(ss, 32);
        const float rstd = rsqrtf(ss * (1.0f / 64.0f) + 1e-6f);
        const bf16_t* og = proj + (row0 + r) * PW + P_GO + h * 64 + 4 * hg; bf16_t* od = br + (row0 + r) * D + h * 64 + 4 * hg;
#pragma unroll
        for (int db = 0; db < 2; ++db)
#pragma unroll
            for (int q = 0; q < 4; ++q) { const int dv0 = db * 32 + 8 * q; const pg8::f32x4 gv = ld_bf16x4(og + dv0), gn = *(const pg8::f32x4*)(gnorm + dv0 + 4 * hg);
                st_bf16x4(od + dv0, (pg8::f32x4){ot[db][4 * q] * rstd * gn[0] * siluf(gv[0]), ot[db][4 * q + 1] * rstd * gn[1] * siluf(gv[1]), ot[db][4 * q + 2] * rstd * gn[2] * siluf(gv[2]), ot[db][4 * q + 3] * rstd * gn[3] * siluf(gv[3])}); }
    }
}

__device__ __forceinline__ void ph_attn_prep(Frame& F, ArgsP a) {
    const bf16_t* proj = (const bf16_t*)(a->ws + WS_PROJ); const int* pos = (const int*)a->in[2];
    bf16_t* QR = (bf16_t*)(a->ws + SCR_QK); bf16_t* KR = QR + (size_t)M * 256; bf16_t* VT = (bf16_t*)(a->ws + SCR_VT);
    int lane = F.lane(); asm volatile("" : "+v"(lane));
    for (int idx = F.gw * 64 + lane; idx < M * 8; idx += F.NGW * 64) { const int row = idx >> 3, hc = idx & 7; const float p = (float)pos[row];
        const bf16_t* qs = proj + (size_t)row * PW + P_DQ + hc * 32; const bf16_t* ks = proj + (size_t)row * PW + P_DK + hc * 32;
        float qv[32], kv[32];
#pragma unroll
        for (int j = 0; j < 8; ++j) { const pg8::f32x4 q4 = ld_bf16x4(qs + 4 * j), k4 = ld_bf16x4(ks + 4 * j);
#pragma unroll
            for (int e = 0; e < 4; ++e) { qv[4 * j + e] = q4[e]; kv[4 * j + e] = k4[e]; } }
        float qo[32], ko[32];
#pragma unroll
        for (int i = 0; i < 16; ++i) { const float inv = exp2f(-(float)i * 0.8304820237218406f);
            float sn, cs; sincosf(p * inv, &sn, &cs);
            qo[i] = qv[i] * cs - qv[i + 16] * sn; qo[i + 16] = qv[i] * sn + qv[i + 16] * cs;
            ko[i] = kv[i] * cs - kv[i + 16] * sn; ko[i + 16] = kv[i] * sn + kv[i + 16] * cs; }
        const float qsc = 0.17677669529663687f * 1.4426950408889634f;
        bf16_t* qd = QR + (size_t)row * 256 + hc * 32; bf16_t* kd = KR + (size_t)row * 256 + hc * 32;
#pragma unroll
        for (int j = 0; j < 8; ++j) { st_bf16x4(qd + 4 * j, (pg8::f32x4){qo[4 * j] * qsc, qo[4 * j + 1] * qsc, qo[4 * j + 2] * qsc, qo[4 * j + 3] * qsc});
            st_bf16x4(kd + 4 * j, (pg8::f32x4){ko[4 * j], ko[4 * j + 1], ko[4 * j + 2], ko[4 * j + 3]}); } }
    for (int it = F.gw; it < 1024; it += F.NGW) { const int bh = it >> 5, tt = it & 31, b = bh >> 2, h = bh & 3;
        const bf16_t* vs = proj + ((size_t)b * T + tt * 64 + lane) * PW + P_DV + h * 64;
        pg8::u32x4 v[8];
#pragma unroll
        for (int j = 0; j < 8; ++j) v[j] = *(const pg8::u32x4*)(vs + 8 * j);
        bf16_t* vd = VT + (size_t)bh * 64 * T + tt * 64 + lane;
#pragma unroll
        for (int j = 0; j < 8; ++j)
#pragma unroll
            for (int e = 0; e < 4; ++e) { const unsigned w = v[j][e]; vd[(size_t)(8 * j + 2 * e) * T] = (bf16_t)(w & 0xffffu); vd[(size_t)(8 * j + 2 * e + 1) * T] = (bf16_t)(w >> 16); } }
}
__device__ __forceinline__ void ph_attn(Frame& F, ArgsP a, int l) {
    const bf16_t* QR = (const bf16_t*)(a->ws + SCR_QK); const bf16_t* KR = QR + (size_t)M * 256; const bf16_t* VT = (const bf16_t*)(a->ws + SCR_VT);
    const float* lp = (const float*)a->in[13] + l * 128; const float* subln = (const float*)a->in[14] + l * 64; bf16_t* br = (bf16_t*)(a->ws + WS_HB);
    int tid = F.wave * 64 + F.lane(); asm volatile("" : "+v"(tid)); const int lane = tid & 63;
    const int r = lane & 31, hg = lane >> 5, comp = F.wave & 1, qs = F.wave >> 1;
    constexpr int RS = 72;
    LAS bf16_t* Kt = (LAS bf16_t*)F.lds;
    LAS bf16_t* Vt = Kt + 2 * 64 * RS;
    LAS float* Xl = (LAS float*)(F.lds + 4 * 64 * RS * 2);
    float lam, lam_init;
    { float d01 = 0.f, d23 = 0.f;
      for (int i = 0; i < 32; ++i) { d01 += lp[i] * lp[32 + i]; d23 += lp[64 + i] * lp[96 + i]; }
      lam_init = 0.8f - 0.6f * __expf(-0.3f * (float)l); lam = __expf(d01) - __expf(d23) + lam_init; }
    const int ldrow = tid >> 3, ldch = tid & 7;
    for (int pi = blockIdx.x; pi < 256; pi += F.G) {
#pragma unroll 1
        for (int half = 0; half < 2; ++half) {
            const int bh = pi >> 3, j = pi & 7, qb = half == 0 ? 15 - j : j, b = bh >> 2, h = bh & 3;
            const int q0 = qb * 128 + qs * 32, nkw = q0 / 64 + 1, nkb = 2 * qb + 2;
            const size_t rowb = (size_t)b * T;
            pg8::bf16x8 qf[2];
#pragma unroll
            for (int s = 0; s < 2; ++s) qf[s] = *(const pg8::bf16x8*)(QR + (rowb + q0 + r) * 256 + h * 64 + comp * 32 + 16 * s + 8 * hg);
            f32x16 ot[2];
#pragma unroll
            for (int e = 0; e < 16; ++e) { ot[0][e] = 0.f; ot[1][e] = 0.f; }
            float mrun = -1e30f, lrun = 0.f;
            const bf16_t* kg = KR + (rowb + ldrow) * 256 + h * 64 + ldch * 8; const bf16_t* vg = VT + ((size_t)bh * 64 + ldrow) * T + ldch * 8;
            pg8::u32x4 kreg = *(const pg8::u32x4*)kg, vreg = *(const pg8::u32x4*)vg;
            pg8::u32x4 kreg2 = kreg, vreg2 = vreg;
            if (nkb > 1) { kreg2 = *(const pg8::u32x4*)(kg + (size_t)64 * 256); vreg2 = *(const pg8::u32x4*)(vg + 64); }
            for (int kt = 0; kt < nkb; ++kt) {
                const int bo = (kt & 1) * 64 * RS;
                *(LAS pg8::u32x4*)(Kt + bo + ldrow * RS + ldch * 8) = kreg; *(LAS pg8::u32x4*)(Vt + bo + ldrow * RS + ldch * 8) = vreg;
                __syncthreads();
                kreg = kreg2; vreg = vreg2;
                if (kt + 2 < nkb) { kreg2 = *(const pg8::u32x4*)(kg + (size_t)(kt + 2) * 64 * 256); vreg2 = *(const pg8::u32x4*)(vg + (kt + 2) * 64); }
                if (kt < nkw) {
                    f32x16 st[2];
#pragma unroll
                    for (int kb = 0; kb < 2; ++kb) {
#pragma unroll
                        for (int e = 0; e < 16; ++e) st[kb][e] = 0.f;
#pragma unroll
                        for (int s = 0; s < 2; ++s) { const pg8::bf16x8 kf = *(const LAS pg8::bf16x8*)(Kt + bo + (kb * 32 + r) * RS + comp * 32 + 16 * s + 8 * hg);
                            st[kb] = __builtin_amdgcn_mfma_f32_32x32x16_bf16(kf, qf[s], st[kb], 0, 0, 0); } }
                    if (kt == nkw - 1) {
                        const int qi = q0 + r;
#pragma unroll
                        for (int kb = 0; kb < 2; ++kb)
#pragma unroll
                            for (int e = 0; e < 16; ++e) { const int ki = kt * 64 + kb * 32 + (e & 3) + 8 * (e >> 2) + 4 * hg; if (ki > qi) st[kb][e] = -1e30f; } }
                    float tm = st[0][0];
#pragma unroll
                    for (int e = 1; e < 16; ++e) tm = fmaxf(tm, st[0][e]);
#pragma unroll
                    for (int e = 0; e < 16; ++e) tm = fmaxf(tm, st[1][e]);
                    { const auto sw = __builtin_amdgcn_permlane32_swap(__builtin_bit_cast(unsigned, tm), __builtin_bit_cast(unsigned, tm), false, false); tm = fmaxf(__builtin_bit_cast(float, (unsigned)sw[0]), __builtin_bit_cast(float, (unsigned)sw[1])); }
                    const float mn = fmaxf(mrun, tm), alpha = __builtin_amdgcn_exp2f(mrun - mn); mrun = mn;
                    float ps = 0.f;
#pragma unroll
                    for (int kb = 0; kb < 2; ++kb)
#pragma unroll
                        for (int e = 0; e < 16; ++e) { st[kb][e] = __builtin_amdgcn_exp2f(st[kb][e] - mn); ps += st[kb][e]; }
                    lrun = lrun * alpha + ps;
#pragma unroll
                    for (int e = 0; e < 16; ++e) { ot[0][e] *= alpha; ot[1][e] *= alpha; }
#pragma unroll
                    for (int kb = 0; kb < 2; ++kb)
#pragma unroll
                        for (int s = 0; s < 2; ++s) {
                            pg8::u32x4 pw; pw.x = pk2(st[kb][8 * s], st[kb][8 * s + 1]); pw.y = pk2(st[kb][8 * s + 2], st[kb][8 * s + 3]); pw.z = pk2(st[kb][8 * s + 4], st[kb][8 * s + 5]); pw.w = pk2(st[kb][8 * s + 6], st[kb][8 * s + 7]);
                            const pg8::bf16x8 pf = __builtin_bit_cast(pg8::bf16x8, pw);
#pragma unroll
                            for (int dvb = 0; dvb < 2; ++dvb) { const LAS bf16_t* vp = Vt + bo + (dvb * 32 + r) * RS + kb * 32 + 16 * s + 4 * hg;
                                const pg8::u32x2 v0 = *(const LAS pg8::u32x2*)vp, v1 = *(const LAS pg8::u32x2*)(vp + 8);
                                pg8::u32x4 vw; vw.x = v0.x; vw.y = v0.y; vw.z = v1.x; vw.w = v1.y;
                                ot[dvb] = __builtin_amdgcn_mfma_f32_32x32x16_bf16(__builtin_bit_cast(pg8::bf16x8, vw), pf, ot[dvb], 0, 0, 0); } }
                }
            }
            const float ltot = lrun + __shfl_xor(lrun, 32); const float il = 1.0f / ltot;
            __syncthreads();
            if (comp == 1) {
#pragma unroll
                for (int dvb = 0; dvb < 2; ++dvb)
#pragma unroll
                    for (int e = 0; e < 16; ++e) Xl[(qs * 32 + dvb * 16 + e) * 64 + lane] = ot[dvb][e] * il; }
            __syncthreads();
            if (comp == 0) {
                float o[32]; float ss = 0.f;
#pragma unroll
                for (int dvb = 0; dvb < 2; ++dvb)
#pragma unroll
                    for (int e = 0; e < 16; ++e) { const float v = ot[dvb][e] * il - lam * Xl[(qs * 32 + dvb * 16 + e) * 64 + lane]; o[dvb * 16 + e] = v; ss += v * v; }
                ss += __shfl_xor(ss, 32);
                const float sc = rsqrtf(ss * (1.0f / 64.0f) + 1e-6f) * (1.0f - lam_init);
                bf16_t* od = br + (rowb + q0 + r) * D + 256 + h * 64;
#pragma unroll
                for (int dvb = 0; dvb < 2; ++dvb)
#pragma unroll
                    for (int g4 = 0; g4 < 4; ++g4) { const int dv0 = dvb * 32 + 8 * g4 + 4 * hg; const pg8::f32x4 sl = *(const pg8::f32x4*)(subln + dv0);
                        st_bf16x4(od + dv0, (pg8::f32x4){o[dvb * 16 + 4 * g4] * sc * sl[0], o[dvb * 16 + 4 * g4 + 1] * sc * sl[1], o[dvb * 16 + 4 * g4 + 2] * sc * sl[2], o[dvb * 16 + 4 * g4 + 3] * sc * sl[3]}); }
            }
            __syncthreads();
        }
    }
}

__device__ __forceinline__ void ph_branch(Frame& F, ArgsP a, int l) {
    const bf16_t* br = (const bf16_t*)(a->ws + WS_HB); const bf16_t* WB = (const bf16_t*)(a->ws + WS_WB) + (size_t)l * 4096 * 256;
    const bf16_t* proj = (const bf16_t*)(a->ws + WS_PROJ); bf16_t* MB = (bf16_t*)(a->ws + SCR_MB);
    int tid = F.wave * 64 + F.lane(); asm volatile("" : "+v"(tid)); const int lane = tid & 63;
    const int r = lane & 31, hg = lane >> 5, wt = (tid >> 6) & 3, wd = tid >> 8;
    constexpr int RS = 72, TB = 128 * RS;
    LAS bf16_t* Wl = (LAS bf16_t*)F.lds;
    LAS bf16_t* Bl = Wl + 2 * TB;
    const int ldr = tid >> 3, ldc = (tid & 7) * 8;
    for (int it = blockIdx.x; it < 1024; it += F.G) {
        const int tm = it >> 3, td = it & 7; const size_t row0 = (size_t)tm * 128; const int d0 = td * 128;
        f32x16 tot[2], acc[2];
#pragma unroll
        for (int e = 0; e < 16; ++e) { tot[0][e] = 0.f; tot[1][e] = 0.f; acc[0][e] = 0.f; acc[1][e] = 0.f; }
        pg8::u32x4 rw0, rw1, rb0, rb1;
#define BR_LOAD(st) do { const int g_ = (st) >> 2, kq_ = (st) & 3; const bf16_t* wp = WB + (size_t)(g_ * 1024 + d0 + ldr) * 256 + kq_ * 64 + ldc; const bf16_t* bp = br + (row0 + ldr) * D + g_ * 256 + kq_ * 64 + ldc; \
            rw0 = *(const pg8::u32x4*)wp; rw1 = *(const pg8::u32x4*)(wp + 64 * 256); rb0 = *(const pg8::u32x4*)bp; rb1 = *(const pg8::u32x4*)(bp + 64 * D); } while (0)
#define BR_WRITE(buf) do { *(LAS pg8::u32x4*)(Wl + (buf) * TB + ldr * RS + ldc) = rw0; *(LAS pg8::u32x4*)(Wl + (buf) * TB + (ldr + 64) * RS + ldc) = rw1; \
            *(LAS pg8::u32x4*)(Bl + (buf) * TB + ldr * RS + ldc) = rb0; *(LAS pg8::u32x4*)(Bl + (buf) * TB + (ldr + 64) * RS + ldc) = rb1; } while (0)
        BR_LOAD(0); BR_WRITE(0); __syncthreads(); BR_LOAD(1);
        pg8::u32x2 gt[2][4];
#pragma unroll 1
        for (int st = 0; st < 16; ++st) {
            const int buf = st & 1, g = st >> 2;
            if ((st & 3) == 0) {
                const bf16_t* gp = proj + (row0 + wt * 32 + r) * PW + P_GATE + g * 1024 + d0 + wd * 64 + 4 * hg;
#pragma unroll
                for (int db = 0; db < 2; ++db)
#pragma unroll
                    for (int q = 0; q < 4; ++q) gt[db][q] = *(const pg8::u32x2*)(gp + db * 32 + 8 * q); }
#pragma unroll
            for (int s = 0; s < 4; ++s) { const pg8::bf16x8 bf = *(const LAS pg8::bf16x8*)(Bl + buf * TB + (wt * 32 + r) * RS + 16 * s + 8 * hg);
#pragma unroll
                for (int db = 0; db < 2; ++db) { const pg8::bf16x8 af = *(const LAS pg8::bf16x8*)(Wl + buf * TB + (wd * 64 + db * 32 + r) * RS + 16 * s + 8 * hg);
                    acc[db] = __builtin_amdgcn_mfma_f32_32x32x16_bf16(af, bf, acc[db], 0, 0, 0); } }
            if (st + 1 < 16) BR_WRITE(buf ^ 1);
            if (st + 2 < 16) BR_LOAD(st + 2);
            if ((st & 3) == 3) {
#pragma unroll
                for (int db = 0; db < 2; ++db)
#pragma unroll
                    for (int q = 0; q < 4; ++q) { const pg8::u32x2 w = gt[db][q];
                        const float g0 = __builtin_bit_cast(float, w.x << 16), g1 = __builtin_bit_cast(float, w.x & 0xffff0000u), g2 = __builtin_bit_cast(float, w.y << 16), g3 = __builtin_bit_cast(float, w.y & 0xffff0000u);
                        tot[db][4 * q] += acc[db][4 * q] * sigm(g0); tot[db][4 * q + 1] += acc[db][4 * q + 1] * sigm(g1); tot[db][4 * q + 2] += acc[db][4 * q + 2] * sigm(g2); tot[db][4 * q + 3] += acc[db][4 * q + 3] * sigm(g3);
                        acc[db][4 * q] = 0.f; acc[db][4 * q + 1] = 0.f; acc[db][4 * q + 2] = 0.f; acc[db][4 * q + 3] = 0.f; } }
            __syncthreads();
        }
#undef BR_LOAD
#undef BR_WRITE
        bf16_t* mp = MB + (row0 + wt * 32 + r) * D + d0 + wd * 64 + 4 * hg;
#pragma unroll
        for (int db = 0; db < 2; ++db)
#pragma unroll
            for (int q = 0; q < 4; ++q) st_bf16x4(mp + db * 32 + 8 * q, (pg8::f32x4){tot[db][4 * q], tot[db][4 * q + 1], tot[db][4 * q + 2], tot[db][4 * q + 3]});
    }
}
constexpr int RING_BYTES = 131072, LDSCTL_OFF = RING_BYTES, MISC_OFF = LDSCTL_OFF + 320, LDS_BYTES = 147456;
constexpr int PH_PRO = 0, PH_H0 = 1, PH_L0 = 2, PH_PER_LAYER = 12, PH_END = PH_L0 + 2 * PH_PER_LAYER;
constexpr int PL_PROJ = 0, PL_MIXA = 1, PL_MIXB = 2, PL_MIXC = 3, PL_BRANCH = 4, PL_OUT = 5, PL_ROWMIX = 6, PL_FFN1 = 7, PL_FFN2 = 8, PL_FFN3 = 9, PL_ROWFFN = 10;

#ifndef DUPMASK
#define DUPMASK 0
#endif
#define DUP(bit) for (int dup_ = 0; dup_ < (((DUPMASK) >> (bit)) & 1) + 1; ++dup_)
__global__ void __launch_bounds__(NTHR, 2) mk_fwd(Args a) {
    extern __shared__ __attribute__((aligned(16))) unsigned char lds_raw[];
    Frame F0;
    F0.lds = (LAS unsigned char*)lds_raw;
    F0.wave = __builtin_amdgcn_readfirstlane(threadIdx.x >> 6);
    F0.G = gridDim.x; F0.gw = blockIdx.x * NWAVES + F0.wave; F0.NGW = F0.G * NWAVES;
    volatile LAS unsigned* MISC = (volatile LAS unsigned*)(F0.lds + MISC_OFF);
    for (int u = threadIdx.x; u < (LDS_BYTES - LDSCTL_OFF) / 4; u += NTHR) ((LAS unsigned*)(F0.lds + LDSCTL_OFF))[u] = 0u;
    __syncthreads();
    unsigned* ctl = (unsigned*)(a.ws + WS_CTL);
    const int lo = a.ph_lo, hi = a.ph_hi;
    XcdBarrier bar; bar.bar = ctl + CW_BAR; bar.x = 0; bar.st = nullptr;
    if (hi - lo > 1) bar = xcd_barrier_post(ctl + CW_BAR, MISC + 8);
#define IN(k) (lo <= (k) && (k) < hi)
#define SEAM(k) do { if (IN(k) && IN((k) + 1)) { xcd_barrier(bar); if ((DUPMASK >> 12) & 1) xcd_barrier(bar); } } while (0)
    if (IN(PH_PRO)) DUP(0) { ArgsP A = fresh_args(); Frame F = fresh(F0); p0_mod_items(F, (const float*)A->in[1], (const float*)A->in[3], (const float*)A->in[4], (float*)(A->ws + WS_MOD)); p0_convert(F, A); }
    SEAM(PH_PRO);
    if (IN(PH_H0)) DUP(9) { Frame F = fresh(F0); ph_h0(F, fresh_args()); }
    SEAM(PH_H0);
    for (int l = 0; l < NL; ++l) {
        const int base = PH_L0 + l * PH_PER_LAYER;
        if (IN(base + PL_PROJ)) DUP(13) { ArgsP A = fresh_args(); Frame F = fresh(F0); unsigned char* ws = A->ws;
            pg8::Gemm g{(const bf16_t*)(ws + WS_HB), (const bf16_t*)(ws + WS_WIN) + (size_t)l * PW * 1024, 1024, 1024, 1024, 0}; pg8::StaticOrder S; S.init(M, 7168, F.G, (int)blockIdx.x);
            pg8::EpiBf16 E{(bf16_t*)(ws + WS_PROJ), PW, 28};
            pg8::gemm_phase<pg8::EpiBf16, pg8::StaticOrder, true>(F.lds, g, S, E, F.wave);
        }
        SEAM(base + PL_PROJ);
        if (IN(base + PL_MIXA)) { DUP(2) { Frame F = fresh(F0); ph_conv(F, fresh_args(), l); } DUP(6) { Frame F = fresh(F0); ph_rwkv_prep(F, fresh_args(), l); } DUP(7) { Frame F = fresh(F0); ph_gla_p1(F, fresh_args(), l); } DUP(8) { Frame F = fresh(F0); ph_attn_prep(F, fresh_args()); } }
        SEAM(base + PL_MIXA);
        if (IN(base + PL_MIXB)) { DUP(10) { Frame F = fresh(F0); ph_gla_prefix(F, fresh_args()); } DUP(3) { Frame F = fresh(F0); ph_rwkv_scan(F, fresh_args()); } DUP(4) { Frame F = fresh(F0); ph_attn(F, fresh_args(), l); } }
        SEAM(base + PL_MIXB);
        if (IN(base + PL_MIXC)) { DUP(5) { Frame F = fresh(F0); ph_rwkv_post(F, fresh_args(), l); } DUP(11) { Frame F = fresh(F0); ph_gla_p2(F, fresh_args(), l); } }
        SEAM(base + PL_MIXC);
        if (IN(base + PL_BRANCH)) DUP(14) { ArgsP A = fresh_args(); Frame F = fresh(F0); unsigned char* ws = A->ws;
            pg8::Gemm g{(const bf16_t*)(ws + WS_HB), (const bf16_t*)(ws + WS_WB) + (size_t)l * 1024 * 1024, 1024, 1024, 1024, 0}; pg8::StaticOrder S; S.init(M, 1024, F.G, (int)blockIdx.x);
            pg8::EpiBranchK E{(const bf16_t*)(ws + WS_PROJ), (bf16_t*)(ws + SCR_MB)};
            pg8::gemm_phase<pg8::EpiBranchK, pg8::StaticOrder, false>(F.lds, g, S, E, F.wave);
        }
        SEAM(base + PL_BRANCH);
        if (IN(base + PL_OUT)) DUP(1) { ArgsP A = fresh_args(); Frame F = fresh(F0); unsigned char* ws = A->ws;
            pg8::Gemm g{(const bf16_t*)(ws + SCR_MB), (const bf16_t*)(ws + WS_WO) + (size_t)l * 1024 * 1024, 1024, 1024, 1024, 0}; pg8::StaticOrder S; S.init(M, 1024, F.G, (int)blockIdx.x);
            pg8::EpiBf16 E{(bf16_t*)(ws + SCR_Y), 1024, 4};
            pg8::gemm_phase<pg8::EpiBf16, pg8::StaticOrder, false>(F.lds, g, S, E, F.wave);
        }
        SEAM(base + PL_OUT);
        if (IN(base + PL_ROWMIX)) { ArgsP A = fresh_args(); Frame F = fresh(F0); unsigned char* ws = A->ws; const float* modl = (const float*)(ws + WS_MOD) + (size_t)l * 8 * 6144;
            ph_row(F, A, l == 0 ? (const float*)A->in[0] : A->out, (const bf16_t*)(ws + SCR_Y), (const float*)A->in[6] + l * D, modl, 2048, (const float*)A->in[7] + l * D, modl, 3072, 4096, (bf16_t*)(ws + (l == 0 ? WS_HB : WS_H2L1)), l == 1); }
        SEAM(base + PL_ROWMIX);
        if (l == 0) {
            if (IN(base + PL_FFN1)) DUP(1) { ArgsP A = fresh_args(); Frame F = fresh(F0); unsigned char* ws = A->ws;
                pg8::Gemm g{(const bf16_t*)(ws + WS_HB), (const bf16_t*)(ws + WS_WF1), 1024, 1024, 1024, 0}; pg8::StaticOrder S; S.init(M, 2 * DFF, F.G, (int)blockIdx.x);
                pg8::EpiSwiglu E{(bf16_t*)(ws + WS_PROJ), DFF, 2 * DFF / 256};
                pg8::gemm_phase<pg8::EpiSwiglu, pg8::StaticOrder, true>(F.lds, g, S, E, F.wave);
            }
            SEAM(base + PL_FFN1);
            if (IN(base + PL_FFN2)) DUP(1) { ArgsP A = fresh_args(); Frame F = fresh(F0); unsigned char* ws = A->ws;
                pg8::Gemm g{(const bf16_t*)(ws + WS_PROJ), (const bf16_t*)(ws + WS_WF2), DFF, DFF, DFF, 0}; pg8::StaticOrder S; S.init(M, 1024, F.G, (int)blockIdx.x);
                pg8::EpiBf16 E{(bf16_t*)(ws + SCR_Y), 1024, 4};
                pg8::gemm_phase<pg8::EpiBf16, pg8::StaticOrder, false>(F.lds, g, S, E, F.wave);
            }
            SEAM(base + PL_FFN2);
        } else {
            if (IN(base + PL_FFN1)) DUP(0) { Frame F = fresh(F0); ph_moe_prep(F, fresh_args()); }
            SEAM(base + PL_FFN1);
            if (IN(base + PL_FFN2)) DUP(15) { ArgsP A = fresh_args(); Frame F = fresh(F0); unsigned char* ws = A->ws; const unsigned* cnt = (const unsigned*)(ws + WS_CTL) + CW_CNT;
                pg8::Gemm g{(const bf16_t*)(ws + WS_HG), (const bf16_t*)(ws + WS_WM1), 1024, 1024, 1024, 0}; pg8::MoeOrder S; S.init(cnt, F.G, (int)blockIdx.x, 28);
                pg8::EpiSwiglu E{(bf16_t*)(ws + WS_HID), DEX, 28};
                pg8::gemm_phase<pg8::EpiSwiglu, pg8::MoeOrder, true>(F.lds, g, S, E, F.wave);
            }
            SEAM(base + PL_FFN2);
            if (IN(base + PL_FFN3)) DUP(16) { ArgsP A = fresh_args(); Frame F = fresh(F0); unsigned char* ws = A->ws; const unsigned* cnt = (const unsigned*)(ws + WS_CTL) + CW_CNT;
                pg8::Gemm g{(const bf16_t*)(ws + WS_HID), (const bf16_t*)(ws + WS_WM2), DEX, DEX, DEX, 0}; pg8::MoeOrder S; S.init(cnt, F.G, (int)blockIdx.x, 4);
                pg8::EpiBf16 E{(bf16_t*)(ws + WS_HG), 1024, 4};
                pg8::gemm_phase<pg8::EpiBf16, pg8::MoeOrder, true>(F.lds, g, S, E, F.wave);
            }
            SEAM(base + PL_FFN3);
        }
        if (IN(base + PL_ROWFFN)) { ArgsP A = fresh_args(); Frame F = fresh(F0); unsigned char* ws = A->ws; const float* modl = (const float*)(ws + WS_MOD) + (size_t)l * 8 * 6144;
            const bool last = (l == NL - 1);
            if (l == 0) ph_row(F, A, A->out, (const bf16_t*)(ws + SCR_Y), (const float*)A->in[8], modl, 5120, (const float*)A->in[5] + D, modl + 8 * 6144, 0, 1024, (bf16_t*)(ws + WS_HB), false, nullptr, (const float*)A->in[9] + (size_t)1024 * NIN);
            else ph_row(F, A, A->out, nullptr, (const float*)A->in[8] + D, modl, 5120, nullptr, nullptr, 0, 1024, nullptr, false, (const bf16_t*)(ws + WS_HG));
        }
        SEAM(base + PL_ROWFFN);
    }
#undef IN
#undef SEAM
}

extern "C" void kernel_launch(void* const* d_in, const int* in_sizes, int n_in, void* d_out, int out_size, void* d_ws, size_t ws_size, hipStream_t stream) {
    static int grid = 0;
    if (grid == 0) {
        if (n_in != 40 || ws_size < WS_END) { fprintf(stderr, "kernel_launch: need 40 inputs and >= %zu bytes of workspace (got %d, %zu)\n", (size_t)WS_END, n_in, ws_size); grid = -1; return; }
        int dev = 0, cus = 0, per_cu = 0;
        (void)hipGetDevice(&dev); (void)hipDeviceGetAttribute(&cus, hipDeviceAttributeMultiprocessorCount, dev);
        (void)hipFuncSetAttribute((const void*)mk_fwd, hipFuncAttributeMaxDynamicSharedMemorySize, LDS_BYTES);
        (void)hipOccupancyMaxActiveBlocksPerMultiprocessor(&per_cu, (const void*)mk_fwd, NTHR, LDS_BYTES);
        (void)hipGetLastError();
        grid = cus > 0 ? cus : 256;
        if (per_cu < 1) fprintf(stderr, "kernel_launch: occupancy query says %d blocks per CU\n", per_cu);
    }
    if (grid < 0) return;
    unsigned char* ws = (unsigned char*)d_ws;
    (void)hipMemsetAsync(ws + WS_CTL, 0, CTL_ZERO_BYTES, stream);
    Args a{};
    for (int i = 0; i < 40; ++i) a.in[i] = d_in[i];
    a.out = (float*)d_out; a.ws = ws;
    a.ph_lo = 0; a.ph_hi = PH_L0 + (NL - 1) * PH_PER_LAYER + PL_ROWFFN + 1;
    hipLaunchKernelGGL(mk_fwd, dim3(grid), dim3(NTHR), LDS_BYTES, stream, a);
}
```

```cpp
#include <hip/hip_runtime.h>
#include <hip/hip_bf16.h>
#include <cstdint>
#include <cstdio>

typedef __hip_bfloat16 bf16;
typedef unsigned short bf16_t;
#define GAS __attribute__((address_space(1)))
#define LAS __attribute__((address_space(3)))

constexpr int D = 1024, NB = 8, T = 2048, M = NB * T, NL = 2;
constexpr int NIN = 7184;
constexpr int PW = 7424;
constexpr int P_GQ = 0, P_GK = 128, P_GV = 256, P_GO = 512, P_DQ = 768, P_DK = 1024, P_DV = 1280, P_CA = 1536, P_CB = 1792, P_R = 2048, P_GATE = 3072, P_GZ = 7168;
constexpr int DFF = 2816, NE = 8, DEX = 3584;
constexpr int NWAVES = 8, NTHR = 512;
constexpr size_t MiB = 1u << 20;
constexpr size_t WS_CTL = 0;
constexpr size_t CTL_ZERO_BYTES = 64 * 1024;
constexpr size_t WS_MOD = 1 * MiB;
constexpr size_t WS_ROUTE = 1 * MiB + 512 * 1024;
constexpr size_t WS_GZ = 2 * MiB + 512 * 1024;
constexpr size_t WS_LR = 3 * MiB;
constexpr size_t WS_WIN = 4 * MiB;
constexpr size_t WS_WB = 33 * MiB;
constexpr size_t WS_WO = 37 * MiB;
constexpr size_t WS_WF1 = 41 * MiB;
constexpr size_t WS_WF2 = 52 * MiB;
constexpr size_t WS_HB = 58 * MiB;
constexpr size_t WS_PROJ = 90 * MiB;
constexpr size_t WS_SCR = 322 * MiB;
constexpr size_t WS_H2L1 = 508 * MiB;
constexpr size_t WS_END = 540 * MiB;
constexpr size_t WS_HG = 4 * MiB;
constexpr size_t WS_WM1 = 72 * MiB;
constexpr size_t WS_WM2 = 184 * MiB;
constexpr size_t WS_HID = 240 * MiB;
static_assert(WS_HID + (size_t)34816 * 3584 * 2 <= WS_H2L1, "moe overlay");
constexpr size_t SCR_MP = WS_SCR;
constexpr size_t SCR_MB = WS_SCR + 64 * MiB;
constexpr size_t SCR_Y = WS_SCR + 96 * MiB;
constexpr size_t SCR_RW = WS_SCR;
constexpr size_t SCR_GK = WS_SCR + 112 * MiB;
constexpr size_t SCR_QR = WS_SCR + 120 * MiB;
constexpr size_t SCR_KR = WS_SCR + 136 * MiB;
constexpr size_t SCR_VEC6 = WS_SCR;
constexpr size_t SCR_SC = WS_SCR + 112 * MiB;
constexpr size_t SCR_YR = WS_SCR + 113 * MiB;
constexpr size_t SCR_GR = WS_SCR + 129 * MiB;
constexpr size_t SCR_VT = WS_SCR + 137 * MiB;
constexpr size_t SCR_GU = WS_SCR + 145 * MiB;
constexpr size_t SCR_GS = SCR_GU;
constexpr size_t SCR_QK = WS_SCR + 161 * MiB;
constexpr size_t SCR_EG = WS_SCR + 177 * MiB;
constexpr size_t WS_GOI = WS_H2L1;
constexpr size_t WS_GST = WS_H2L1 + 16 * MiB;
constexpr int VSTEP = 448;
constexpr int CW_TMO = 0;
constexpr int CW_BAR = 1024;
constexpr int CW_CNT = 8192;
constexpr size_t RT_LIST = 0;
constexpr size_t RT_TOKE = 512 * 1024;
constexpr size_t RT_TOKS = 640 * 1024;
constexpr size_t RT_TOKP = 768 * 1024;

__device__ __forceinline__ float sigm(float x) { return __builtin_amdgcn_rcpf(1.0f + __expf(-x)); }
__device__ __forceinline__ float siluf(float x) { return x * sigm(x); }
__device__ __forceinline__ float softplusf(float x) { return fmaxf(x, 0.f) + __logf(1.0f + __expf(-fabsf(x))); }
__device__ __forceinline__ float tanh_fast(float x) { return 1.0f - 2.0f * __builtin_amdgcn_rcpf(1.0f + __expf(2.0f * x)); }
template <int CTRL, int ROWMASK> __device__ __forceinline__ float dpp_mov_h(float old, float x) {
    return __builtin_bit_cast(float, __builtin_amdgcn_update_dpp(__builtin_bit_cast(int, old), __builtin_bit_cast(int, x), CTRL, ROWMASK, 0xF, false)); }
__device__ __forceinline__ float wave_sum(float x) {
    x += dpp_mov_h<0xB1, 0xF>(0.f, x); x += dpp_mov_h<0x4E, 0xF>(0.f, x); x += dpp_mov_h<0x141, 0xF>(0.f, x); x += dpp_mov_h<0x140, 0xF>(0.f, x);
    x += dpp_mov_h<0x142, 0xA>(0.f, x); x += dpp_mov_h<0x143, 0xC>(0.f, x);
    return __builtin_bit_cast(float, __builtin_amdgcn_readlane(__builtin_bit_cast(int, x), 63));
}
__device__ __forceinline__ float wave_max(float v) {
#pragma unroll
    for (int o = 32; o > 0; o >>= 1) v = fmaxf(v, __shfl_xor(v, o));
    return v;
}
__device__ __forceinline__ float ldf(const float* p) { return *p; }
__device__ __forceinline__ float ldf(const bf16* p) { return __bfloat162float(*p); }
__device__ __forceinline__ float bf2f(bf16_t u) { return __builtin_bit_cast(float, (unsigned)u << 16); }
__device__ __forceinline__ unsigned f2bf(float f) { unsigned u = __builtin_bit_cast(unsigned, f); return (u + 0x7fffu + ((u >> 16) & 1u)) >> 16; }
typedef float f32x2_t_ __attribute__((ext_vector_type(2))); typedef __bf16 bf16x2_t_ __attribute__((ext_vector_type(2)));
__device__ __forceinline__ unsigned pk2(float lo, float hi) { const f32x2_t_ v = {lo, hi}; const bf16x2_t_ b = __builtin_convertvector(v, bf16x2_t_); return __builtin_bit_cast(unsigned, b); }
namespace pg8 {
#define PG8_LAS __attribute__((address_space(3)))
typedef short bf16x8 __attribute__((ext_vector_type(8)));
typedef float f32x4 __attribute__((ext_vector_type(4)));
typedef float f32x2 __attribute__((ext_vector_type(2)));
typedef unsigned u32x4 __attribute__((ext_vector_type(4)));
typedef unsigned u32x2 __attribute__((ext_vector_type(2)));
constexpr int BM = 256, BK = 64, HALF = 128, HTB = HALF * BK * 2  , STAGE_BYTES = 8 * HTB, NXCD = 8, WGM = 8;

__host__ __device__ __forceinline__ int lds_byte(int r, int c) { const int st = (r >> 4) * 2 + (c >> 5), rr = r & 15, cc = c & 31, ob = rr * 64 + cc * 2; return st * 1024 + (ob ^ (((ob >> 9) & 1) << 5)); }
__host__ __device__ __forceinline__ void stage_rc(int b, int& R, int& C) { const int st = b / 1024, sb = b % 1024, swz = sb ^ (((sb >> 9) & 1) << 5); R = (st >> 1) * 16 + swz / 64; C = (st & 1) * 32 + (swz % 64) / 2; }
__host__ __device__ __forceinline__ int perm32(int rho) { const int n = rho >> 4, i = rho & 15; return 8 * (i >> 2) + 4 * n + (i & 3); }

struct Unit { int pm, pn, aoff, tag; };
struct Gemm { const bf16_t* A; const bf16_t* Bt; int lda, ldb, K, pad; };

struct StaticOrder {
    int nM, nN, nwg, G, c;
    __host__ __device__ void init(int M_, int N_, int G_, int c_) { nM = M_ / BM; nN = N_ / BM; nwg = nM * nN; G = G_; c = c_; }
    __host__ __device__ bool next(int i, Unit& u) const {
        const long L = (long)i * G + c; if (L >= nwg) return false;
        int wgid = (int)L; { const int q = nwg / NXCD, r = nwg % NXCD, xcd = wgid % NXCD, off = wgid / NXCD; wgid = (xcd < r ? xcd * (q + 1) : r * (q + 1) + (xcd - r) * q) + off; }
        const int nig = WGM * nN, gid = wgid / nig, fm = gid * WGM, gsz = (nM - fm) < WGM ? (nM - fm) : WGM;
        u.pm = fm + ((wgid % nig) % gsz); u.pn = (wgid % nig) / gsz; u.aoff = 0; u.tag = 0; return true;
    }
};

__device__ __forceinline__ unsigned cvt_pk_bf16(float lo, float hi) { unsigned r; asm volatile("v_cvt_pk_bf16_f32 %0, %1, %2" : "=v"(r) : "v"(lo), "v"(hi)); return r; }


template <class Epi, class Sched, bool ALIGN_EPI>
__device__ __forceinline__ void gemm_phase(PG8_LAS unsigned char* lds, const Gemm g, const Sched& S, const Epi& E, int wave_s) {
    unsigned z_ = 0u; asm volatile("" : "+v"(z_));
    int tid_ = wave_s * 64 + (int)__builtin_amdgcn_mbcnt_hi(~0u, __builtin_amdgcn_mbcnt_lo(~0u, z_)); asm volatile("" : "+v"(tid_));
    const int tid = tid_, wid = __builtin_amdgcn_readfirstlane(tid >> 6), lane = tid & 63, wr = wid >> 2, wc = wid & 3, fr = lane & 15, fq = lane >> 4;
    const int K = g.K, nt = K / BK;
    unsigned voffA[2], voffB[2];
#pragma unroll
    for (int i = 0; i < 2; ++i) { int R, C; stage_rc(tid * 16 + i * 8192, R, C); const int Rb = Epi::PERM ? ((R & ~31) + perm32(R & 31)) : R;
        voffA[i] = (unsigned)(R * g.lda + C) * 2u; voffB[i] = (unsigned)(Rb * g.ldb + C) * 2u; }
    const size_t kstep = (size_t)(BK * 2);
    const size_t hstepA = (size_t)HALF * g.lda * 2, hstepB = (size_t)HALF * g.ldb * 2;
    const size_t tstepA = 2 * hstepA, tstepB = 2 * hstepB;
    const unsigned ldsw = (unsigned)wid * 1024u;
    const int aoff = lds_byte(wr * 64 + fr, fq * 8), boff = lds_byte(wc * 32 + fr, fq * 8);
#define PG8_SA(b, h) (((b) * 2 + (h)) * HTB)
#define PG8_SB(b, h) ((4 + (b) * 2 + (h)) * HTB)
#define PG8_STAGE(bufoff, gbase, voff) do { _Pragma("unroll") for (int _i = 0; _i < 2; ++_i) \
        __builtin_amdgcn_global_load_lds((const unsigned*)((const char*)(gbase) + (voff)[_i]), (PG8_LAS unsigned*)(lds + (bufoff) + ldsw + _i * 8192), 16, 0, 0); } while (0)
#define PG8_LDA(dst, b, h) do { _Pragma("unroll") for (int m = 0; m < 4; ++m) _Pragma("unroll") for (int k = 0; k < 2; ++k) dst[m][k] = *(const PG8_LAS bf16x8*)(lds + PG8_SA(b, h) + aoff + m * 2048 + k * 1024); } while (0)
#define PG8_LDB(dst, b, h) do { _Pragma("unroll") for (int n = 0; n < 2; ++n) _Pragma("unroll") for (int k = 0; k < 2; ++k) dst[n][k] = *(const PG8_LAS bf16x8*)(lds + PG8_SB(b, h) + boff + n * 2048 + k * 1024); } while (0)
#define PG8_MMA(ai, bj, At, Bt) do { __builtin_amdgcn_s_setprio(1); _Pragma("unroll") for (int m = 0; m < 4; ++m) _Pragma("unroll") for (int n = 0; n < 2; ++n) _Pragma("unroll") for (int k = 0; k < 2; ++k) \
        acc[ai][bj][m][n] = __builtin_amdgcn_mfma_f32_16x16x32_bf16(Bt[n][k], At[m][k], acc[ai][bj][m][n], 0, 0, 0); __builtin_amdgcn_s_setprio(0); } while (0)
#define PG8_WAIT_V(n) asm volatile("s_waitcnt vmcnt(" #n ")" ::: "memory")
#define PG8_WAIT_L(n) asm volatile("s_waitcnt lgkmcnt(" #n ")" ::: "memory")
#define PG8_BAR __builtin_amdgcn_s_barrier()
#define PG8_SCHED __builtin_amdgcn_sched_barrier(0)
    Unit cur, nxt; int ui = 0;
    if (!S.next(0, cur)) return;
    f32x4 acc[2][2][4][2];
#pragma unroll
    for (int a = 0; a < 2; ++a)
#pragma unroll
        for (int b = 0; b < 2; ++b)
#pragma unroll
            for (int m = 0; m < 4; ++m)
#pragma unroll
                for (int n = 0; n < 2; ++n) acc[a][b][m][n] = (f32x4){0.f, 0.f, 0.f, 0.f};
    bf16x8 At[4][2], B0[2][2], B1[2][2];
    const char* cA = (const char*)g.A + (size_t)cur.pm * tstepA + (size_t)cur.aoff * 2; const char* cB = (const char*)g.Bt + (size_t)cur.pn * tstepB;
    PG8_STAGE(PG8_SB(0, 0), cB, voffB); PG8_STAGE(PG8_SB(0, 1), cB + hstepB, voffB); PG8_STAGE(PG8_SA(0, 0), cA, voffA); PG8_STAGE(PG8_SA(0, 1), cA + hstepA, voffA);
    if (wr == 1) PG8_BAR;
    PG8_WAIT_V(2); PG8_BAR;
    PG8_STAGE(PG8_SB(1, 0), cB + kstep, voffB); PG8_STAGE(PG8_SA(1, 0), cA + kstep, voffA); PG8_STAGE(PG8_SB(1, 1), cB + hstepB + kstep, voffB);
    PG8_WAIT_V(6); PG8_BAR;
    for (;;) {
        const bool has_next = S.next(ui + 1, nxt);
        const char* nA = has_next ? (const char*)g.A + (size_t)nxt.pm * tstepA + (size_t)nxt.aoff * 2 : cA; const char* nB = has_next ? (const char*)g.Bt + (size_t)nxt.pn * tstepB : cB;
        for (int t = 0; t < nt; t += 2) {
            if constexpr (Epi::MIDK) { if (t != 0 && (t & 3) == 0) E.mid(acc, cur, t >> 2, wr, wc); }
            const bool last = (t == nt - 2);
            const char* a1 = cA + (size_t)(t + 1) * kstep;
            const char* a2 = last ? nA : cA + (size_t)(t + 2) * kstep; const char* b2 = last ? nB : cB + (size_t)(t + 2) * kstep;
            const char* a3 = a2 + kstep; const char* b3 = b2 + kstep;
            PG8_LDB(B0, 0, 0); PG8_LDB(B1, 0, 1); PG8_SCHED; PG8_LDA(At, 0, 0); PG8_STAGE(PG8_SA(1, 1), a1 + hstepA, voffA);
            PG8_WAIT_V(8); PG8_WAIT_L(0); PG8_BAR; PG8_MMA(0, 0, At, B0); PG8_MMA(0, 1, At, B1); PG8_BAR; PG8_SCHED;
            PG8_LDA(At, 0, 1); PG8_STAGE(PG8_SB(0, 0), b2, voffB); PG8_STAGE(PG8_SB(0, 1), b2 + hstepB, voffB); PG8_STAGE(PG8_SA(0, 0), a2, voffA);
            PG8_WAIT_V(8); PG8_WAIT_L(0); PG8_BAR; PG8_MMA(1, 0, At, B0); PG8_MMA(1, 1, At, B1); PG8_BAR; PG8_SCHED;
            PG8_LDB(B0, 1, 0); PG8_LDB(B1, 1, 1); PG8_SCHED; PG8_LDA(At, 1, 0); PG8_STAGE(PG8_SA(0, 1), a2 + hstepA, voffA);
            PG8_WAIT_V(8); PG8_WAIT_L(0); PG8_BAR; PG8_MMA(0, 0, At, B0); PG8_MMA(0, 1, At, B1); PG8_BAR; PG8_SCHED;
            PG8_LDA(At, 1, 1); PG8_STAGE(PG8_SB(1, 0), b3, voffB); PG8_STAGE(PG8_SB(1, 1), b3 + hstepB, voffB); PG8_STAGE(PG8_SA(1, 0), a3, voffA);
            PG8_WAIT_V(8); PG8_WAIT_L(0); PG8_BAR; PG8_MMA(1, 0, At, B0); PG8_MMA(1, 1, At, B1); PG8_BAR; PG8_SCHED;
        }
        if constexpr (ALIGN_EPI) { if (wr == 0) PG8_BAR; }
        { unsigned z2_ = 0u; asm volatile("" : "+v"(z2_)); const int l2_ = (int)__builtin_amdgcn_mbcnt_hi(~0u, __builtin_amdgcn_mbcnt_lo(~0u, z2_));
          E(acc, cur, wr, wc, l2_ & 15, l2_ >> 4); }
        if (!has_next) break;
#pragma unroll
        for (int a = 0; a < 2; ++a)
#pragma unroll
            for (int b = 0; b < 2; ++b)
#pragma unroll
                for (int m = 0; m < 4; ++m)
#pragma unroll
                    for (int n = 0; n < 2; ++n) acc[a][b][m][n] = (f32x4){0.f, 0.f, 0.f, 0.f};
        cur = nxt; cA = nA; cB = nB; ++ui;
        if constexpr (ALIGN_EPI) { if (wr == 1) PG8_BAR; }
    }
    PG8_WAIT_V(0);
    if constexpr (!ALIGN_EPI) { if (wr == 0) PG8_BAR; }
    PG8_BAR;
#undef PG8_SA
#undef PG8_SB
#undef PG8_STAGE
#undef PG8_LDA
#undef PG8_LDB
#undef PG8_MMA
#undef PG8_WAIT_V
#undef PG8_WAIT_L
#undef PG8_BAR
#undef PG8_SCHED
}

struct EpiBf16 {
    static constexpr bool PERM = true, MIDK = false;
    bf16_t* O; int ldc; int ntn;
    __device__ __forceinline__ void operator()(const f32x4 (&acc)[2][2][4][2], const Unit& u, int wr, int wc, int fr, int fq) const {
        const int row0 = u.pm * BM + wr * 64 + fr, col0 = (u.pn % ntn) * BM + wc * 32 + 8 * fq;
#pragma unroll
        for (int ai = 0; ai < 2; ++ai)
#pragma unroll
            for (int m = 0; m < 4; ++m) { bf16_t* rowp = O + (size_t)(row0 + ai * HALF + m * 16) * ldc + col0;
#pragma unroll
                for (int bj = 0; bj < 2; ++bj) { const f32x4 v0 = acc[ai][bj][m][0], v1 = acc[ai][bj][m][1];
                    u32x4 w; w.x = cvt_pk_bf16(v0[0], v0[1]); w.y = cvt_pk_bf16(v0[2], v0[3]); w.z = cvt_pk_bf16(v1[0], v1[1]); w.w = cvt_pk_bf16(v1[2], v1[3]);
                    *(u32x4*)(rowp + bj * HALF) = w; } }
    }
};
struct EpiF32 {
    static constexpr bool PERM = false, MIDK = false;
    float* C; int ldc; int ntn;
    __device__ __forceinline__ void operator()(const f32x4 (&acc)[2][2][4][2], const Unit& u, int wr, int wc, int fr, int fq) const {
        const int row0 = u.pm * BM + wr * 64 + fr, col0 = (u.pn % ntn) * BM + wc * 32 + 4 * fq;
#pragma unroll
        for (int ai = 0; ai < 2; ++ai)
#pragma unroll
            for (int m = 0; m < 4; ++m) { float* rowp = C + (size_t)(row0 + ai * HALF + m * 16) * ldc + col0;
#pragma unroll
                for (int bj = 0; bj < 2; ++bj)
#pragma unroll
                    for (int n = 0; n < 2; ++n) *(f32x4*)(rowp + bj * HALF + n * 16) = acc[ai][bj][m][n]; }
    }
};
struct EpiSwiglu {
    static constexpr bool PERM = true, MIDK = false;
    bf16_t* O; int ldc; int ntn;
    __device__ __forceinline__ void operator()(const f32x4 (&acc)[2][2][4][2], const Unit& u, int wr, int wc, int fr, int fq) const {
        const int row0 = u.pm * BM + wr * 64 + fr, col0 = (u.pn % ntn) * 128 + wc * 16 + 4 * fq;
#pragma unroll
        for (int ai = 0; ai < 2; ++ai)
#pragma unroll
            for (int m = 0; m < 4; ++m) { bf16_t* rowp = O + (size_t)(row0 + ai * HALF + m * 16) * ldc + col0;
#pragma unroll
                for (int bj = 0; bj < 2; ++bj) { const f32x4 gt = acc[ai][bj][m][0], up = acc[ai][bj][m][1];
                    float h[4];
#pragma unroll
                    for (int e = 0; e < 4; ++e) h[e] = gt[e] * __builtin_amdgcn_rcpf(1.0f + __expf(-gt[e])) * up[e];
                    u32x2 w; w.x = cvt_pk_bf16(h[0], h[1]); w.y = cvt_pk_bf16(h[2], h[3]);
                    *(u32x2*)(rowp + bj * 64) = w; } }
    }
};
struct EpiBranch {
    static constexpr bool PERM = true, MIDK = false;
    const bf16_t* proj; float* MP; bf16_t* MB;
    __device__ __forceinline__ void operator()(const f32x4 (&acc)[2][2][4][2], const Unit& u, int wr, int wc, int fr, int fq) const {
        const int g = u.tag; const int row0 = u.pm * BM + wr * 64 + fr, col0 = (u.pn & 3) * BM + wc * 32 + 8 * fq;
#pragma unroll
        for (int ai = 0; ai < 2; ++ai)
#pragma unroll
            for (int m = 0; m < 4; ++m) { const size_t row = (size_t)(row0 + ai * HALF + m * 16);
#pragma unroll
                for (int bj = 0; bj < 2; ++bj) { const int col = col0 + bj * HALF;
                    const u32x4 gw = *(const u32x4*)(proj + row * PW + P_GATE + g * 1024 + col);
                    float gv[8];
#pragma unroll
                    for (int e = 0; e < 4; ++e) { const unsigned w = gw[e]; gv[2 * e] = __builtin_bit_cast(float, w << 16); gv[2 * e + 1] = __builtin_bit_cast(float, w & 0xffff0000u); }
                    f32x4 v0 = acc[ai][bj][m][0], v1 = acc[ai][bj][m][1];
#pragma unroll
                    for (int e = 0; e < 4; ++e) { v0[e] *= __builtin_amdgcn_rcpf(1.0f + __expf(-gv[e])); v1[e] *= __builtin_amdgcn_rcpf(1.0f + __expf(-gv[4 + e])); }
                    float* mp = MP + row * D + col;
                    if (g > 0) { v0 += *(const f32x4*)mp; v1 += *(const f32x4*)(mp + 4); }
                    if (g < 3) { *(f32x4*)mp = v0; *(f32x4*)(mp + 4) = v1; }
                    else { u32x4 w; w.x = cvt_pk_bf16(v0[0], v0[1]); w.y = cvt_pk_bf16(v0[2], v0[3]); w.z = cvt_pk_bf16(v1[0], v1[1]); w.w = cvt_pk_bf16(v1[2], v1[3]);
                        *(u32x4*)(MB + row * D + col) = w; } } }
    }
};
struct EpiBranchK {
    static constexpr bool PERM = true, MIDK = true;
    const bf16_t* proj; bf16_t* MB;
    __device__ __forceinline__ static float em(float x) { return fminf(__expf(-x), 1e20f); }
    __device__ __forceinline__ void mid(f32x4 (&acc)[2][2][4][2], const Unit& u, int gnext, int wr, int wc) const {
        unsigned z_ = 0u; asm volatile("" : "+v"(z_)); const int l_ = (int)__builtin_amdgcn_mbcnt_hi(~0u, __builtin_amdgcn_mbcnt_lo(~0u, z_)); const int fr = l_ & 15, fq = l_ >> 4;
        const int row0 = u.pm * BM + wr * 64 + fr, col0 = u.pn * BM + wc * 32 + 8 * fq;
#pragma unroll
        for (int ai = 0; ai < 2; ++ai)
#pragma unroll
            for (int m = 0; m < 4; ++m) { const bf16_t* gp = proj + (size_t)(row0 + ai * HALF + m * 16) * PW + P_GATE + (gnext - 1) * 1024 + col0;
#pragma unroll
                for (int bj = 0; bj < 2; ++bj) { const u32x4 g0 = *(const u32x4*)(gp + bj * HALF), g1 = *(const u32x4*)(gp + 1024 + bj * HALF);
#pragma unroll
                    for (int e = 0; e < 4; ++e) { const unsigned a = g0[e], b = g1[e];
                        const float ra = (1.0f + em(__builtin_bit_cast(float, b << 16))) * __builtin_amdgcn_rcpf(1.0f + em(__builtin_bit_cast(float, a << 16)));
                        const float rb = (1.0f + em(__builtin_bit_cast(float, b & 0xffff0000u))) * __builtin_amdgcn_rcpf(1.0f + em(__builtin_bit_cast(float, a & 0xffff0000u)));
                        if (e < 2) { acc[ai][bj][m][0][2 * e] *= ra; acc[ai][bj][m][0][2 * e + 1] *= rb; } else { acc[ai][bj][m][1][2 * (e - 2)] *= ra; acc[ai][bj][m][1][2 * (e - 2) + 1] *= rb; } } } }
    }
    __device__ __forceinline__ void operator()(const f32x4 (&acc)[2][2][4][2], const Unit& u, int wr, int wc, int fr, int fq) const {
        const int row0 = u.pm * BM + wr * 64 + fr, col0 = u.pn * BM + wc * 32 + 8 * fq;
#pragma unroll
        for (int ai = 0; ai < 2; ++ai)
#pragma unroll
            for (int m = 0; m < 4; ++m) { const size_t row = (size_t)(row0 + ai * HALF + m * 16);
#pragma unroll
                for (int bj = 0; bj < 2; ++bj) { const u32x4 gw = *(const u32x4*)(proj + row * PW + P_GATE + 3 * 1024 + col0 + bj * HALF);
                    float sg[8];
#pragma unroll
                    for (int e = 0; e < 4; ++e) { sg[2 * e] = __builtin_amdgcn_rcpf(1.0f + em(__builtin_bit_cast(float, gw[e] << 16))); sg[2 * e + 1] = __builtin_amdgcn_rcpf(1.0f + em(__builtin_bit_cast(float, gw[e] & 0xffff0000u))); }
                    const f32x4 v0 = acc[ai][bj][m][0], v1 = acc[ai][bj][m][1];
                    u32x4 w; w.x = cvt_pk_bf16(v0[0] * sg[0], v0[1] * sg[1]); w.y = cvt_pk_bf16(v0[2] * sg[2], v0[3] * sg[3]); w.z = cvt_pk_bf16(v1[0] * sg[4], v1[1] * sg[5]); w.w = cvt_pk_bf16(v1[2] * sg[6], v1[3] * sg[7]);
                    *(u32x4*)(MB + row * D + col0 + bj * HALF) = w; } }
    }
};
struct BranchOrder {
    int G, c;
    __device__ bool next(int i, Unit& u) const {
        const int tile = (i >> 2) * G + c; if (tile >= 256) return false;
        const int g = i & 3; u.pm = tile >> 2; u.pn = g * 4 + (tile & 3); u.aoff = g * 256; u.tag = g; return true;
    }
};
template <int NTC> struct MoeOrder {
    static constexpr int NT = NTC; int G, c, ntiles; int t1, t2, t3, t4, t5, t6, t7;
    __device__ __forceinline__ void init(const unsigned* cnt, int G_, int c_) { G = G_; c = (G_ % 8 == 0) ? (c_ % 8) * (G_ / 8) + c_ / 8 : c_;
        int o = ((int)cnt[0] + 255) >> 8; t1 = o; o += ((int)cnt[1] + 255) >> 8; t2 = o; o += ((int)cnt[2] + 255) >> 8; t3 = o; o += ((int)cnt[3] + 255) >> 8; t4 = o;
        o += ((int)cnt[4] + 255) >> 8; t5 = o; o += ((int)cnt[5] + 255) >> 8; t6 = o; o += ((int)cnt[6] + 255) >> 8; t7 = o; o += ((int)cnt[7] + 255) >> 8; ntiles = o; }
    __device__ __forceinline__ bool next(int i, Unit& u) const {
        const int L = i * G + c; if (L >= ntiles * NT) return false;
        const int tau = L / NT, pn = L % NT;
        const int e = (tau >= t1) + (tau >= t2) + (tau >= t3) + (tau >= t4) + (tau >= t5) + (tau >= t6) + (tau >= t7);
        u.pm = tau; u.pn = e * NT + pn; u.aoff = 0; u.tag = e; return true;
    }
};
}
typedef GAS unsigned gu32;
#define RLX_AGENT __ATOMIC_RELAXED, __HIP_MEMORY_SCOPE_AGENT
#define XB_TMO      128
#define XB_XCNT(j)  (256  + 64 * (j))
#define XB_XSUB(j)  (1280 + 64 * (j))
#define XB_XGEN(j)  (2304 + 64 * (j))
#define XB_TOP      3328
#define XB_TOPGEN   3392
#define XCD_BAR_WORDS 3456
#define XB_SPIN_CAP (1u << 18)

__device__ __forceinline__ unsigned xb_ld(unsigned* p)              { return __hip_atomic_load(p, __ATOMIC_RELAXED, __HIP_MEMORY_SCOPE_AGENT); }
__device__ __forceinline__ unsigned xb_add(unsigned* p, unsigned v) { return __hip_atomic_fetch_add(p, v, __ATOMIC_RELAXED, __HIP_MEMORY_SCOPE_AGENT); }
__device__ __forceinline__ unsigned xb_xcc_id() { return (unsigned)__builtin_amdgcn_s_getreg((3 << 11) | 20) & 0xFu; }
#define XB_SPIN(cond, bar) do { unsigned _sp = 0; while (cond) { __builtin_amdgcn_s_sleep(1); \
    if ((++_sp & 255u) == 0u) { if (xb_ld(&(bar)[XB_TMO])) break; if (_sp > XB_SPIN_CAP) { atomicAdd(&(bar)[XB_TMO], 1u); break; } } } } while (0)

struct XcdBarrier {
    unsigned* bar; unsigned x;
    volatile LAS unsigned* st;
};

__device__ __forceinline__ XcdBarrier xcd_barrier_post(unsigned* bar, volatile LAS unsigned* st) {
    XcdBarrier b; b.bar = bar; b.x = xb_xcc_id(); b.st = st;
    if (threadIdx.x == 0) (void)xb_add(&bar[XB_XCNT(b.x)], 1u);
    return b;
}
__device__ __forceinline__ void xcd_barrier_complete(unsigned* bar, unsigned x, unsigned& nloc, unsigned& nx) {
    const unsigned G = gridDim.x * gridDim.y * gridDim.z;
    unsigned sum, cnt, mine, sp = 0u;
    for (;;) {
        sum = 0u; cnt = 0u; mine = 0u;
#pragma unroll
        for (unsigned j = 0; j < 16; ++j) { const unsigned c = xb_ld(&bar[XB_XCNT(j)]); sum += c; cnt += (c > 0u) ? 1u : 0u; mine = (j == x) ? c : mine; }
        if (sum == G) break;
        __builtin_amdgcn_s_sleep(1);
        if ((++sp & 255u) == 0u) { if (xb_ld(&bar[XB_TMO])) break; if (sp > XB_SPIN_CAP) { atomicAdd(&bar[XB_TMO], 1u); break; } }
    }
    nloc = mine > 0u ? mine : 1u; nx = cnt > 0u ? cnt : 1u;
}

__device__ __forceinline__ void xcd_barrier(const XcdBarrier& b) {
    asm volatile("s_waitcnt vmcnt(0)" ::: "memory");
    __syncthreads();
    if (threadIdx.x == 0) {
        unsigned* bar = b.bar;
        __builtin_amdgcn_s_waitcnt(0);
        unsigned nloc = b.st[0], nx = b.st[1];
        if (nloc == 0u) { xcd_barrier_complete(bar, b.x, nloc, nx); b.st[0] = nloc; b.st[1] = nx; }
        const unsigned old = xb_add(&bar[XB_XSUB(b.x)], 1u);
        const unsigned gen = old / nloc;
        if (old + 1u == (gen + 1u) * nloc) {
            __builtin_amdgcn_fence(__ATOMIC_RELEASE, "agent");
            asm volatile("s_waitcnt vmcnt(0)" ::: "memory");
            const unsigned og = xb_add(&bar[XB_TOP], 1u);
            const unsigned tg = og / nx;
            if (og + 1u == (tg + 1u) * nx) xb_add(&bar[XB_TOPGEN], 1u);
            else XB_SPIN(xb_ld(&bar[XB_TOPGEN]) == tg, bar);
            __builtin_amdgcn_fence(__ATOMIC_ACQUIRE, "agent");
            xb_add(&bar[XB_XGEN(b.x)], 1u);
            asm volatile("s_waitcnt vmcnt(0)" ::: "memory");
        } else {
            XB_SPIN(xb_ld(&bar[XB_XGEN(b.x)]) == gen, bar);
            __builtin_amdgcn_fence(__ATOMIC_ACQUIRE, "agent");
            asm volatile("s_waitcnt vmcnt(0)" ::: "memory");
        }
    }
    __syncthreads();
}
struct Args { const void* in[40]; float* out; unsigned char* ws; int ph_lo, ph_hi; };
typedef const __attribute__((address_space(4))) Args* ArgsP;
__device__ __forceinline__ ArgsP fresh_args() { ArgsP p = (ArgsP)__builtin_amdgcn_kernarg_segment_ptr(); asm volatile("" : "+s"(p)); return p; }

struct Frame {
    LAS unsigned char* lds;
    int wave, G, gw, NGW;
    __device__ __forceinline__ int lane() const { unsigned z = 0u; asm volatile("" : "+v"(z)); return (int)__builtin_amdgcn_mbcnt_hi(~0u, __builtin_amdgcn_mbcnt_lo(~0u, z)); }
};

__device__ __forceinline__ Frame fresh(const Frame& F) { Frame R = F; asm volatile("" : "+s"(R.wave), "+s"(R.G), "+s"(R.gw), "+s"(R.NGW)); return R; }
#define LDS_WAIT() asm volatile("s_waitcnt lgkmcnt(0)" ::: "memory")

__device__ __forceinline__ void p0_mod_items(Frame& F, const float* c, const float* ada_w, const float* ada_b, float* mod) {
    LAS float* part = (LAS float*)F.lds;
    LAS float* cs = (LAS float*)(F.lds + 98304);
    int tid_ = F.wave * 64 + F.lane(); asm volatile("" : "+v"(tid_)); const int lane_ = tid_ & 63;
    if ((int)blockIdx.x >= 192) return;
    for (int i = tid_; i < 8192; i += NTHR) cs[i] = siluf(c[i]);
    __syncthreads();
    for (int it = blockIdx.x; it < 192; it += F.G) {
        const int l = it / 96, j0 = (it % 96) * 64;
        float acc[8];
#pragma unroll
        for (int b = 0; b < 8; ++b) acc[b] = 0.f;
        const float* w = ada_w + (size_t)l * 1024 * 6144 + j0 + lane_;
        const int k0 = F.wave * 128;
#pragma unroll 1
        for (int kb = 0; kb < 128; kb += 16) { float wv[16];
#pragma unroll
            for (int q = 0; q < 16; ++q) wv[q] = w[(size_t)(k0 + kb + q) * 6144];
#pragma unroll
            for (int q4 = 0; q4 < 4; ++q4)
#pragma unroll
                for (int b = 0; b < 8; ++b) { const pg8::f32x4 cv = *(const LAS pg8::f32x4*)(cs + b * 1024 + k0 + kb + 4 * q4);
                    acc[b] += (cv[0] * wv[4 * q4] + cv[1] * wv[4 * q4 + 1]) + (cv[2] * wv[4 * q4 + 2] + cv[3] * wv[4 * q4 + 3]); } }
#pragma unroll
        for (int b = 0; b < 8; ++b) part[(F.wave * 8 + b) * 64 + lane_] = acc[b];
        __syncthreads();
        { const int b = tid_ >> 6, col = tid_ & 63; float s = 0.f;
#pragma unroll
          for (int w8 = 0; w8 < 8; ++w8) s += part[(w8 * 8 + b) * 64 + col];
          mod[(size_t)(l * 8 + b) * 6144 + j0 + col] = s + ada_b[l * 6144 + j0 + col]; }
        __syncthreads();
    }
}
struct CvtDesc { const float* colp; size_t Ns; bf16_t* WT; int Kd, n0, k0; };
__device__ __forceinline__ void cvt_load(const CvtDesc& d, pg8::f32x4 (&v)[8], int lane) {
    const int kr = lane >> 3;
#pragma unroll
    for (int i = 0; i < 8; ++i) v[i] = d.colp ? *(const pg8::f32x4*)(d.colp + (size_t)(d.k0 + 8 * i + kr) * d.Ns) : (pg8::f32x4){0.f, 0.f, 0.f, 0.f};
}
__device__ __forceinline__ void cvt_store(const CvtDesc& d, const pg8::f32x4 (&v)[8], LAS float* scr, int lane) {
    const int q4 = 4 * (lane & 7), kr = lane >> 3;
#pragma unroll
    for (int i = 0; i < 8; ++i)
#pragma unroll
        for (int e = 0; e < 4; ++e) scr[(8 * i + kr) * 33 + q4 + e] = v[i][e];
    LDS_WAIT(); asm volatile("" ::: "memory");
    const int cidx = lane & 7;
#pragma unroll
    for (int j = 0; j < 4; ++j) { const int n = (lane >> 3) + 8 * j; const LAS float* s = scr + (8 * cidx) * 33 + n;
        pg8::u32x4 o; o.x = pk2(s[0 * 33], s[1 * 33]); o.y = pk2(s[2 * 33], s[3 * 33]); o.z = pk2(s[4 * 33], s[5 * 33]); o.w = pk2(s[6 * 33], s[7 * 33]);
        *(pg8::u32x4*)(d.WT + (size_t)(d.n0 + n) * d.Kd + d.k0 + 8 * cidx) = o; }
    LDS_WAIT(); asm volatile("" ::: "memory");
}
__device__ __forceinline__ int win_src_col(int v) { return v < 768 ? v : (v < 7168 ? v + 16 : (v < 7184 ? v - 6400 : -1)); }

__device__ __forceinline__ CvtDesc p0_desc(ArgsP a, int it, int n) {
    const float* w_in = (const float*)a->in[9]; const float* w_branch = (const float*)a->in[30]; const float* w_out = (const float*)a->in[31];
    const float* wg = (const float*)a->in[32]; const float* wu = (const float*)a->in[33]; const float* wd = (const float*)a->in[34];
    bf16_t* WIN = (bf16_t*)(a->ws + WS_WIN); bf16_t* WB = (bf16_t*)(a->ws + WS_WB); bf16_t* WO = (bf16_t*)(a->ws + WS_WO); bf16_t* WF1 = (bf16_t*)(a->ws + WS_WF1); bf16_t* WF2 = (bf16_t*)(a->ws + WS_WF2);
    bf16_t* LR = (bf16_t*)(a->ws + WS_LR);
    constexpr int I_IN = 2 * 232 * 16, I_B = 2 * 4 * 32 * 4, I_O = 2 * 32 * 16, I_F1 = 176 * 16, I_F2 = 32 * 44;
    int r = it;
    if (r < I_IN) { const int l = r / (232 * 16), q = r % (232 * 16), nb = q / 16, kb = q % 16; const int sc = win_src_col(nb * 32 + n);
        return CvtDesc{sc >= 0 ? w_in + (size_t)l * 1024 * NIN + sc : nullptr, (size_t)NIN, WIN + (size_t)l * PW * 1024, 1024, nb * 32, kb * 64}; } r -= I_IN;
    if (r < I_B) { const int lg = r / 128, q = r % 128, nb = q / 4, kb = q % 4;
        const int g = lg & 3, l = lg >> 2;
        return CvtDesc{w_branch + (size_t)lg * 256 * 1024 + nb * 32 + n - (size_t)g * 256 * 1024, 1024, WB + (size_t)l * 1024 * 1024, 1024, nb * 32, g * 256 + kb * 64}; } r -= I_B;
    if (r < I_O) { const int l = r / 512, q = r % 512, nb = q / 16, kb = q % 16;
        return CvtDesc{w_out + (size_t)l * 1024 * 1024 + nb * 32 + n, 1024, WO + (size_t)l * 1024 * 1024, 1024, nb * 32, kb * 64}; } r -= I_O;
    if (r < I_F1) { const int nb = r / 16, kb = r % 16; const int v = nb * 32 + n; const int up = (v >> 2) & 1, j = (v >> 3) * 4 + (v & 3);
        return CvtDesc{(up ? wu : wg) + j, (size_t)DFF, WF1, 1024, nb * 32, kb * 64}; } r -= I_F1;
    if (r < I_F2) { const int nb = r / 44, kb = r % 44;
        return CvtDesc{wd + nb * 32 + n, 1024, WF2, DFF, nb * 32, kb * 64}; } r -= I_F2;
    if (r < 16) { const int l = r >> 3, nb = r & 7; return CvtDesc{(const float*)a->in[21] + l * 64 * 256 + nb * 32 + n, 256, LR + l * 256 * 64, 64, nb * 32, 0}; } r -= 16;
    if (r < 16) { const int l = r >> 3, nb = r & 7; return CvtDesc{(const float*)a->in[23] + l * 64 * 256 + nb * 32 + n, 256, LR + 2 * 256 * 64 + l * 256 * 64, 64, nb * 32, 0}; } r -= 16;
    { const int l = r >> 4, nb = (r >> 1) & 7, kb = r & 1; return CvtDesc{(const float*)a->in[24] + l * 128 * 256 + nb * 32 + n, 256, LR + 4 * 256 * 64 + l * 256 * 128, 128, nb * 32, kb * 64}; }
}
__device__ __forceinline__ void p0_convert(Frame& F, ArgsP a) {
    LAS float* scr = (LAS float*)(F.lds + 16384 + F.wave * 8704);
    constexpr int NITEMS = 2 * 232 * 16 + 2 * 4 * 32 * 4 + 2 * 32 * 16 + 176 * 16 + 32 * 44 + 64;
    int lane_ = F.lane(); asm volatile("" : "+v"(lane_));
    const int n = 4 * (lane_ & 7);
    int it = F.gw; if (it >= NITEMS) return;
    CvtDesc cur = p0_desc(a, it, n); pg8::f32x4 v[8]; cvt_load(cur, v, lane_);
    for (;;) { const int nx = it + F.NGW; const bool more = nx < NITEMS;
        CvtDesc nd = cur; pg8::f32x4 w[8];
        if (more) { nd = p0_desc(a, nx, n); cvt_load(nd, w, lane_); }
        cvt_store(cur, v, scr, lane_);
        if (!more) break;
#pragma unroll
        for (int i = 0; i < 8; ++i) v[i] = w[i];
        cur = nd; it = nx; }
}

__device__ __forceinline__ void row_load(const float* p, pg8::f32x4 (&v)[4], int lane) {
#pragma unroll
    for (int j = 0; j < 4; ++j) v[j] = *(const pg8::f32x4*)(p + 4 * lane + 256 * j);
}
__device__ __forceinline__ float row_ss(const pg8::f32x4 (&v)[4]) {
    float s = 0.f;
#pragma unroll
    for (int j = 0; j < 4; ++j) s += (v[j][0] * v[j][0] + v[j][1] * v[j][1]) + (v[j][2] * v[j][2] + v[j][3] * v[j][3]);
    return wave_sum(s);
}
__device__ __forceinline__ void row_normmod(const pg8::f32x4 (&x)[4], const float* g, const float* mb, int sh_off, int sc_off, bf16_t* hrow, pg8::f32x4 (&hv)[4], int lane) {
    const float rstd = rsqrtf(row_ss(x) * (1.0f / D) + 1e-6f);
#pragma unroll
    for (int j = 0; j < 4; ++j) { const int d = 4 * lane + 256 * j;
        const pg8::f32x4 gg = *(const pg8::f32x4*)(g + d), sc = *(const pg8::f32x4*)(mb + sc_off + d), sh = *(const pg8::f32x4*)(mb + sh_off + d);
        hv[j] = x[j] * rstd * gg * (1.0f + sc) + sh;
        pg8::u32x2 w; w.x = pk2(hv[j][0], hv[j][1]); w.y = pk2(hv[j][2], hv[j][3]);
        *(pg8::u32x2*)(hrow + d) = w; }
}
template <int CTRL, int ROWMASK> __device__ __forceinline__ float dpp_mov_p(float old, float x) {
    return __builtin_bit_cast(float, __builtin_amdgcn_update_dpp(__builtin_bit_cast(int, old), __builtin_bit_cast(int, x), CTRL, ROWMASK, 0xF, false)); }
__device__ __forceinline__ float wave_sum63p(float x) {
    x += dpp_mov_p<0xB1, 0xF>(0.f, x); x += dpp_mov_p<0x4E, 0xF>(0.f, x); x += dpp_mov_p<0x141, 0xF>(0.f, x); x += dpp_mov_p<0x140, 0xF>(0.f, x);
    x += dpp_mov_p<0x142, 0xA>(0.f, x); x += dpp_mov_p<0x143, 0xC>(0.f, x); return x; }
__device__ __forceinline__ void stage_wz(const float* w_in_l, LAS float* wz, int tid) {
    for (int i = tid; i < 1024 * 4; i += NTHR) { const int d = i >> 2, q = i & 3; const pg8::f32x4 w = *(const pg8::f32x4*)(w_in_l + (size_t)d * NIN + 768 + 4 * q);
        wz[(4 * q) * 1024 + d] = w[0]; wz[(4 * q + 1) * 1024 + d] = w[1]; wz[(4 * q + 2) * 1024 + d] = w[2]; wz[(4 * q + 3) * 1024 + d] = w[3]; }
    __syncthreads();
}
__device__ __forceinline__ void row_gz(const pg8::f32x4 (&hv)[4], const LAS float* wz, bf16_t* gzrow, int lane) {
    float mine = 0.f;
#pragma unroll
    for (int o = 0; o < 16; ++o) { float acc = 0.f;
#pragma unroll
        for (int j = 0; j < 4; ++j) { const pg8::f32x4 w = *(const LAS pg8::f32x4*)(wz + o * 1024 + 4 * lane + 256 * j); acc += (hv[j][0] * w[0] + hv[j][1] * w[1]) + (hv[j][2] * w[2] + hv[j][3] * w[3]); }
        const float s = __builtin_bit_cast(float, __builtin_amdgcn_readlane(__builtin_bit_cast(int, wave_sum63p(acc)), 63)); if (lane == o) mine = s; }
    if (lane < 16) gzrow[lane] = (bf16_t)f2bf(mine);
}
__device__ __forceinline__ void ph_h0(Frame& F, ArgsP a) {
    const float* x = (const float*)a->in[0]; const float* g = (const float*)a->in[5]; const float* mod = (const float*)(a->ws + WS_MOD); bf16_t* H = (bf16_t*)(a->ws + WS_HB);
    bf16_t* GZ = (bf16_t*)(a->ws + WS_GZ); LAS float* wz = (LAS float*)F.lds;
    int lane0 = F.lane(); asm volatile("" : "+v"(lane0));
    stage_wz((const float*)a->in[9], wz, F.wave * 64 + lane0);
    int row = F.gw; if (row >= M) return;
    pg8::f32x4 xn[4]; row_load(x + (size_t)row * D, xn, lane0);
    for (;;) { int lane = lane0; asm volatile("" : "+v"(lane)); pg8::f32x4 xv[4], hv[4];
#pragma unroll
        for (int j = 0; j < 4; ++j) xv[j] = xn[j];
        const int nrow = row + F.NGW; if (nrow < M) row_load(x + (size_t)nrow * D, xn, lane);
        row_normmod(xv, g, mod + (size_t)(row / T) * 6144, 0, 1024, H + (size_t)row * D, hv, lane);
        row_gz(hv, wz, GZ + (size_t)row * 16, lane);
        if (nrow >= M) break; row = nrow; }
}
__device__ __forceinline__ void row_y_load(const bf16_t* y, const bf16_t* eout, const unsigned* cnt, const int* toke, const int* toks, int row, int lane, pg8::f32x4 (&yv)[4], pg8::u32x2 (&e1)[4], pg8::u32x2 (&e2)[4]) {
    if (eout) {
        int roff[8]; { int o = 0;
#pragma unroll
            for (int e = 0; e < 8; ++e) { roff[e] = o; o += (((int)cnt[e] + 255) >> 8) << 8; } }
        const int x1 = toke[row * 2], x2 = toke[row * 2 + 1]; int g1 = toks[row * 2], g2 = toks[row * 2 + 1];
#pragma unroll
        for (int q = 0; q < 8; ++q) { if (q == x1) g1 += roff[q]; if (q == x2) g2 += roff[q]; }
#pragma unroll
        for (int j = 0; j < 4; ++j) { e1[j] = *(const pg8::u32x2*)(eout + (size_t)g1 * D + 4 * lane + 256 * j); e2[j] = *(const pg8::u32x2*)(eout + (size_t)g2 * D + 4 * lane + 256 * j); }
    } else {
#pragma unroll
        for (int j = 0; j < 4; ++j) e1[j] = *(const pg8::u32x2*)(y + (size_t)row * D + 4 * lane + 256 * j); }
}
__device__ __forceinline__ void ph_row(Frame& F, ArgsP a, const float* xold, const bf16_t* y, const float* gpost, const float* modl, int gt_off,
                                       const float* gpre, const float* modn, int sh_off, int sc_off, bf16_t* hdst, bool route, const bf16_t* eout = nullptr, const float* w_in_next = nullptr) {
    float* out = a->out;
    bf16_t* GZ = (bf16_t*)(a->ws + WS_GZ); LAS float* wz = (LAS float*)F.lds;
    if (w_in_next) { int t_ = F.wave * 64 + F.lane(); stage_wz(w_in_next, wz, t_); }
    const float* rw = (const float*)a->in[35]; const float* rb = (const float*)a->in[36];
    unsigned* cnt = (unsigned*)(a->ws + WS_CTL) + CW_CNT;
    int* list = (int*)(a->ws + WS_ROUTE + RT_LIST); int* toke = (int*)(a->ws + WS_ROUTE + RT_TOKE); int* toks = (int*)(a->ws + WS_ROUTE + RT_TOKS); float* tokp = (float*)(a->ws + WS_ROUTE + RT_TOKP);
    int row = F.gw; if (row >= M) return;
    int lane0 = F.lane(); asm volatile("" : "+v"(lane0));
    pg8::f32x4 yn[4], xn[4]; pg8::u32x2 e1n[4], e2n[4];
    row_y_load(y, eout, cnt, toke, toks, row, lane0, yn, e1n, e2n); row_load(xold + (size_t)row * D, xn, lane0);
    for (;;) {
        int lane = lane0; asm volatile("" : "+v"(lane));
        const int b = row / T; pg8::f32x4 yv[4], xv[4], hv[4];
        if (eout) { const float p1 = tokp[row * 2], p2 = tokp[row * 2 + 1];
#pragma unroll
            for (int j = 0; j < 4; ++j) { const pg8::u32x2 a1 = e1n[j], a2 = e2n[j];
                yv[j][0] = p1 * __builtin_bit_cast(float, a1.x << 16) + p2 * __builtin_bit_cast(float, a2.x << 16); yv[j][1] = p1 * __builtin_bit_cast(float, a1.x & 0xffff0000u) + p2 * __builtin_bit_cast(float, a2.x & 0xffff0000u);
                yv[j][2] = p1 * __builtin_bit_cast(float, a1.y << 16) + p2 * __builtin_bit_cast(float, a2.y << 16); yv[j][3] = p1 * __builtin_bit_cast(float, a1.y & 0xffff0000u) + p2 * __builtin_bit_cast(float, a2.y & 0xffff0000u); }
        } else {
#pragma unroll
            for (int j = 0; j < 4; ++j) { const pg8::u32x2 a1 = e1n[j]; yv[j][0] = __builtin_bit_cast(float, a1.x << 16); yv[j][1] = __builtin_bit_cast(float, a1.x & 0xffff0000u); yv[j][2] = __builtin_bit_cast(float, a1.y << 16); yv[j][3] = __builtin_bit_cast(float, a1.y & 0xffff0000u); } }
#pragma unroll
        for (int j = 0; j < 4; ++j) xv[j] = xn[j];
        const int nrow = row + F.NGW;
        if (nrow < M) { row_y_load(y, eout, cnt, toke, toks, nrow, lane, yn, e1n, e2n); row_load(xold + (size_t)nrow * D, xn, lane); }
        const float rstd = rsqrtf(row_ss(yv) * (1.0f / D) + 1e-6f);
        const float* mb = modl + (size_t)b * 6144;
#pragma unroll
        for (int j = 0; j < 4; ++j) { const int d = 4 * lane + 256 * j;
            const pg8::f32x4 gp = *(const pg8::f32x4*)(gpost + d), gt = *(const pg8::f32x4*)(mb + gt_off + d);
            xv[j] = xv[j] + gt * (yv[j] * rstd * gp);
            *(pg8::f32x4*)(out + (size_t)row * D + d) = xv[j]; }
        if (hdst) {
            row_normmod(xv, gpre, modn + (size_t)b * 6144, sh_off, sc_off, hdst + (size_t)row * D, hv, lane);
            if (w_in_next) row_gz(hv, wz, GZ + (size_t)row * 16, lane);
            if (route) {
                float lg[8];
#pragma unroll
                for (int e = 0; e < 8; ++e) lg[e] = 0.f;
#pragma unroll
                for (int j = 0; j < 4; ++j)
#pragma unroll
                    for (int q = 0; q < 4; ++q) { const int d = 4 * lane + 256 * j + q; const pg8::f32x4 w0 = *(const pg8::f32x4*)(rw + d * 8), w1 = *(const pg8::f32x4*)(rw + d * 8 + 4); const float hq = hv[j][q];
                        lg[0] += hq * w0[0]; lg[1] += hq * w0[1]; lg[2] += hq * w0[2]; lg[3] += hq * w0[3]; lg[4] += hq * w1[0]; lg[5] += hq * w1[1]; lg[6] += hq * w1[2]; lg[7] += hq * w1[3]; }
#pragma unroll
                for (int e = 0; e < 8; ++e) lg[e] = wave_sum(lg[e]) + rb[e];
                if (lane == 0) {
                    int e1 = 0; float v1 = lg[0];
#pragma unroll
                    for (int e = 1; e < 8; ++e) if (lg[e] > v1) { v1 = lg[e]; e1 = e; }
                    int e2 = -1; float v2 = -3.0e38f;
#pragma unroll
                    for (int e = 0; e < 8; ++e) if (e != e1 && lg[e] > v2) { v2 = lg[e]; e2 = e; }
                    const float p1 = 1.0f / (1.0f + __expf(v2 - v1)), p2 = 1.0f - p1;
                    const int s1 = (int)atomicAdd(&cnt[e1], 1u), s2 = (int)atomicAdd(&cnt[e2], 1u);
                    list[e1 * M + s1] = row; list[e2 * M + s2] = row;
                    toke[row * 2] = e1; toke[row * 2 + 1] = e2; toks[row * 2] = s1; toks[row * 2 + 1] = s2; tokp[row * 2] = p1; tokp[row * 2 + 1] = p2;
                }
            }
        }
        if (nrow >= M) break; row = nrow;
    }
}

__device__ __forceinline__ void ph_moe_prep(Frame& F, ArgsP a) {
    LAS float* scr = (LAS float*)(F.lds + F.wave * 8704);
    const float* mg = (const float*)a->in[37]; const float* mu = (const float*)a->in[38]; const float* md = (const float*)a->in[39];
    bf16_t* WM1 = (bf16_t*)(a->ws + WS_WM1); bf16_t* WM2 = (bf16_t*)(a->ws + WS_WM2);
    constexpr int I_1 = 8 * 224 * 16, I_2 = 8 * 32 * 56;
    int lane_ = F.lane(); asm volatile("" : "+v"(lane_));
    const int n = 4 * (lane_ & 7);
    auto desc = [&](int r) -> CvtDesc {
        if (r < I_1) { const int e = r / 3584, q = r % 3584, nb = q / 16, kb = q % 16; const int v = nb * 32 + n; const int up = (v >> 2) & 1, j = (v >> 3) * 4 + (v & 3);
            return CvtDesc{(up ? mu : mg) + (size_t)e * 1024 * DEX + j, (size_t)DEX, WM1 + (size_t)e * 7168 * 1024, 1024, nb * 32, kb * 64}; }
        r -= I_1; const int e = r / 1792, q = r % 1792, nb = q / 56, kb = q % 56;
        return CvtDesc{md + (size_t)e * DEX * 1024 + nb * 32 + n, 1024, WM2 + (size_t)e * 1024 * DEX, DEX, nb * 32, kb * 64}; };
    { int it = F.gw;
      if (it < I_1 + I_2) { CvtDesc cur = desc(it); pg8::f32x4 v[8]; cvt_load(cur, v, lane_);
        for (;;) { const int nx = it + F.NGW; const bool more = nx < I_1 + I_2; CvtDesc nd = cur; pg8::f32x4 w[8];
            if (more) { nd = desc(nx); cvt_load(nd, w, lane_); }
            cvt_store(cur, v, scr, lane_);
            if (!more) break;
#pragma unroll
            for (int i = 0; i < 8; ++i) v[i] = w[i];
            cur = nd; it = nx; } } }
    const unsigned* cnt = (const unsigned*)(a->ws + WS_CTL) + CW_CNT;
    const int* list = (const int*)(a->ws + WS_ROUTE + RT_LIST);
    const bf16_t* h2 = (const bf16_t*)(a->ws + WS_H2L1); bf16_t* hg = (bf16_t*)(a->ws + WS_HG);
    int roff[9]; { int o = 0;
#pragma unroll
        for (int e = 0; e < 8; ++e) { roff[e] = o; o += (((int)cnt[e] + 255) >> 8) << 8; } roff[8] = o; }
    for (int slot0 = F.gw * 4; slot0 < roff[8]; slot0 += F.NGW * 4) {
        int src[4];
#pragma unroll
        for (int u = 0; u < 4; ++u) { const int slot = slot0 + u; int e = 0;
#pragma unroll
            for (int q = 1; q < 8; ++q) e += (slot >= roff[q]) ? 1 : 0;
            int base = 0, ce = 0;
#pragma unroll
            for (int q = 0; q < 8; ++q) if (q == e) { base = roff[q]; ce = (int)cnt[q]; }
            const int s = slot - base;
            src[u] = (slot < roff[8] && s < ce) ? list[e * M + s] : -1; }
        pg8::u32x4 v0[4], v1[4];
#pragma unroll
        for (int u = 0; u < 4; ++u) { v0[u] = (pg8::u32x4){0u, 0u, 0u, 0u}; v1[u] = v0[u];
            if (src[u] >= 0) { const pg8::u32x4* sp = (const pg8::u32x4*)(h2 + (size_t)src[u] * D) + 2 * lane_; v0[u] = sp[0]; v1[u] = sp[1]; } }
#pragma unroll
        for (int u = 0; u < 4; ++u) if (slot0 + u < roff[8]) { pg8::u32x4* dp = (pg8::u32x4*)(hg + (size_t)(slot0 + u) * D) + 2 * lane_; dp[0] = v0[u]; dp[1] = v1[u]; }
    }
}
typedef float f32x16 __attribute__((ext_vector_type(16)));
template <int CTRL, int ROWMASK> __device__ __forceinline__ float dpp_mov(float old, float x) {
    return __builtin_bit_cast(float, __builtin_amdgcn_update_dpp(__builtin_bit_cast(int, old), __builtin_bit_cast(int, x), CTRL, ROWMASK, 0xF, false));
}
__device__ __forceinline__ float rdlane(float x, int l) { return __builtin_bit_cast(float, __builtin_amdgcn_readlane(__builtin_bit_cast(int, x), l)); }
__device__ __forceinline__ float wave_sum63(float x) {
    x += dpp_mov<0xB1, 0xF>(0.f, x);
    x += dpp_mov<0x4E, 0xF>(0.f, x);
    x += dpp_mov<0x141, 0xF>(0.f, x);
    x += dpp_mov<0x140, 0xF>(0.f, x);
    x += dpp_mov<0x142, 0xA>(0.f, x);
    x += dpp_mov<0x143, 0xC>(0.f, x);
    return x;
}
__device__ __forceinline__ float row16_sum(float x) {
    x += dpp_mov<0xB1, 0xF>(0.f, x); x += dpp_mov<0x4E, 0xF>(0.f, x); x += dpp_mov<0x141, 0xF>(0.f, x); x += dpp_mov<0x140, 0xF>(0.f, x);
    return x;
}
__device__ __forceinline__ pg8::f32x4 ld_bf16x4(const bf16_t* p) { const pg8::u32x2 w = *(const pg8::u32x2*)p;
    return (pg8::f32x4){__builtin_bit_cast(float, w.x << 16), __builtin_bit_cast(float, w.x & 0xffff0000u), __builtin_bit_cast(float, w.y << 16), __builtin_bit_cast(float, w.y & 0xffff0000u)}; }
__device__ __forceinline__ void st_bf16x4(bf16_t* p, pg8::f32x4 v) { pg8::u32x2 w; w.x = pk2(v[0], v[1]); w.y = pk2(v[2], v[3]); *(pg8::u32x2*)p = w; }

__device__ __forceinline__ void ph_conv(Frame& F, ArgsP a, int l) {
    const bf16_t* proj = (const bf16_t*)(a->ws + WS_PROJ); bf16_t* br = (bf16_t*)(a->ws + WS_HB);
    const float* cw = (const float*)a->in[15] + l * 31 * 256; const float* cb = (const float*)a->in[16] + l * 256; const float* lg = (const float*)a->in[17] + l * 256; const float* lb = (const float*)a->in[18] + l * 256;
    LAS float* u = (LAS float*)F.lds;
    int tid = F.wave * 64 + F.lane(); asm volatile("" : "+v"(tid)); const int lane = tid & 63;
    for (int it = blockIdx.x; it < M / 64; it += F.G) {
        const int row0 = it * 64, t0 = row0 % T;
#pragma unroll
        for (int i_ = 0; i_ < 6; ++i_) { const int idx = tid + i_ * NTHR; if (idx >= 94 * 32) break; const int r = idx >> 5, c8 = (idx & 31) * 8; float uv[8];
#pragma unroll
            for (int e = 0; e < 8; ++e) uv[e] = 0.f;
            if (t0 - 30 + r >= 0) { const bf16_t* pr = proj + (size_t)(row0 - 30 + r) * PW;
                const pg8::f32x4 a0 = ld_bf16x4(pr + P_CA + c8), a1 = ld_bf16x4(pr + P_CA + c8 + 4), b0 = ld_bf16x4(pr + P_CB + c8), b1 = ld_bf16x4(pr + P_CB + c8 + 4);
#pragma unroll
                for (int e = 0; e < 4; ++e) { uv[e] = a0[e] * sigm(b0[e]); uv[4 + e] = a1[e] * sigm(b1[e]); } }
            *(LAS pg8::f32x4*)(u + r * 256 + c8) = (pg8::f32x4){uv[0], uv[1], uv[2], uv[3]}; *(LAS pg8::f32x4*)(u + r * 256 + c8 + 4) = (pg8::f32x4){uv[4], uv[5], uv[6], uv[7]}; }
        __syncthreads();
        const int c = tid & 255, half = tid >> 8;
        float acc[32];
        { float w[31], ur[62];
#pragma unroll
          for (int j = 0; j < 31; ++j) w[j] = cw[j * 256 + c];
#pragma unroll
          for (int q = 0; q < 62; ++q) ur[q] = u[(half * 32 + q) * 256 + c];
          const float bias = cb[c];
#pragma unroll
          for (int i = 0; i < 32; ++i) { float s = bias;
#pragma unroll
              for (int j = 0; j < 31; ++j) s += w[j] * ur[i + j];
              acc[i] = s; } }
        __syncthreads();
#pragma unroll
        for (int i = 0; i < 32; ++i) u[(half * 32 + i) * 256 + c] = acc[i];
        __syncthreads();
        const pg8::f32x4 g4 = *(const pg8::f32x4*)(lg + 4 * lane), b4 = *(const pg8::f32x4*)(lb + 4 * lane);
#pragma unroll 2
        for (int q = 0; q < 8; ++q) { const int t = F.wave * 8 + q; const pg8::f32x4 yv = *(const LAS pg8::f32x4*)(u + t * 256 + 4 * lane);
            const float mu = wave_sum((yv[0] + yv[1]) + (yv[2] + yv[3])) * (1.0f / 256.0f); const pg8::f32x4 d = yv - mu;
            const float var = wave_sum((d[0] * d[0] + d[1] * d[1]) + (d[2] * d[2] + d[3] * d[3])) * (1.0f / 256.0f);
            pg8::f32x4 o = d * rsqrtf(var + 1e-5f) * g4 + b4;
#pragma unroll
            for (int e = 0; e < 4; ++e) o[e] = siluf(o[e]);
            st_bf16x4(br + (size_t)(row0 + t) * D + 512 + 4 * lane, o); }
        __syncthreads();
    }
}

__device__ __forceinline__ void ph_rwkv_prep(Frame& F, ArgsP a, int l) {
        const bf16_t* proj = (const bf16_t*)(a->ws + WS_PROJ);
    const float* mu = (const float*)a->in[19] + l * 1024; const float* w0 = (const float*)a->in[20] + l * 256; const float* a0 = (const float*)a->in[22] + l * 256;
    const float* kkw = (const float*)a->in[25] + l * 256; const float* kaw = (const float*)a->in[26] + l * 256; const float* rkw = (const float*)a->in[27] + l * 256;
    const bf16_t* W2T = (const bf16_t*)(a->ws + WS_LR) + l * 256 * 64; const bf16_t* A2T = (const bf16_t*)(a->ws + WS_LR) + 2 * 256 * 64 + l * 256 * 64; const bf16_t* G2T = (const bf16_t*)(a->ws + WS_LR) + 4 * 256 * 64 + l * 256 * 128;
    float* VEC = (float*)(a->ws + SCR_VEC6); float* SC = (float*)(a->ws + SCR_SC); bf16_t* GR = (bf16_t*)(a->ws + SCR_GR);
    constexpr int RS = 72, RG = 136;
    LAS bf16_t* TZh = (LAS bf16_t*)F.lds; LAS bf16_t* TZl = TZh + 64 * RS; LAS bf16_t* ZA = TZl + 64 * RS; LAS bf16_t* SG = ZA + 64 * RS;
    int tid = F.wave * 64 + F.lane(); asm volatile("" : "+v"(tid));
    for (int it = blockIdx.x; it < M / 64; it += F.G) {
        const int row0 = it * 64, b = row0 / T, t0 = row0 % T;
#pragma unroll 4
        for (int i_ = 0; i_ < 32; ++i_) { const int idx = tid + i_ * NTHR; const int cc = idx & 255, tok = idx >> 8; const int col = 768 + cc;
            const bf16_t* pc = proj + (size_t)(row0 + tok) * PW + P_R + col; const float xc = bf2f(pc[0]); const float xp = (t0 + tok > 0) ? bf2f(pc[-PW]) : 0.f;
            const float xm = xc + (xp - xc) * mu[col];
            if (cc < 64) { const float tv = tanh_fast(xm); const unsigned hi = f2bf(tv); TZh[tok * RS + cc] = (bf16_t)hi; TZl[tok * RS + cc] = (bf16_t)f2bf(tv - __builtin_bit_cast(float, hi << 16)); }
            else if (cc < 128) ZA[tok * RS + cc - 64] = (bf16_t)f2bf(xm);
            else SG[tok * RG + cc - 128] = (bf16_t)f2bf(sigm(xm)); }
        __syncthreads();
        int tid2 = tid; asm volatile("" : "+v"(tid2));
        const int lane = tid2 & 63, r = lane & 31, hg = lane >> 5, h = (tid2 >> 6) & 3, th = tid2 >> 8;
        f32x16 accw[2], acca[2], accg[2];
#pragma unroll
        for (int nb = 0; nb < 2; ++nb)
#pragma unroll
            for (int e = 0; e < 16; ++e) { accw[nb][e] = 0.f; acca[nb][e] = 0.f; accg[nb][e] = 0.f; }
        const int arow = (th * 32 + r);
#pragma unroll
        for (int s = 0; s < 4; ++s) { const pg8::bf16x8 ah = *(const LAS pg8::bf16x8*)(TZh + arow * RS + 16 * s + 8 * hg), al = *(const LAS pg8::bf16x8*)(TZl + arow * RS + 16 * s + 8 * hg), az = *(const LAS pg8::bf16x8*)(ZA + arow * RS + 16 * s + 8 * hg);
#pragma unroll
            for (int nb = 0; nb < 2; ++nb) { const int n = h * 64 + nb * 32 + r;
                const pg8::bf16x8 bw = *(const pg8::bf16x8*)(W2T + n * 64 + 16 * s + 8 * hg), ba = *(const pg8::bf16x8*)(A2T + n * 64 + 16 * s + 8 * hg);
                accw[nb] = __builtin_amdgcn_mfma_f32_32x32x16_bf16(ah, bw, accw[nb], 0, 0, 0); accw[nb] = __builtin_amdgcn_mfma_f32_32x32x16_bf16(al, bw, accw[nb], 0, 0, 0);
                acca[nb] = __builtin_amdgcn_mfma_f32_32x32x16_bf16(az, ba, acca[nb], 0, 0, 0); } }
#pragma unroll
        for (int s = 0; s < 8; ++s) { const pg8::bf16x8 ag = *(const LAS pg8::bf16x8*)(SG + arow * RG + 16 * s + 8 * hg);
#pragma unroll
            for (int nb = 0; nb < 2; ++nb) { const int n = h * 64 + nb * 32 + r; const pg8::bf16x8 bg = *(const pg8::bf16x8*)(G2T + n * 128 + 16 * s + 8 * hg);
                accg[nb] = __builtin_amdgcn_mfma_f32_32x32x16_bf16(ag, bg, accg[nb], 0, 0, 0); } }
        int tid3 = tid; asm volatile("" : "+v"(tid3)); const int r3 = tid3 & 31, hg3 = (tid3 >> 5) & 1, h3 = (tid3 >> 6) & 3, th3 = tid3 >> 8;
        float pw0[2], pa0[2], pmr[2], pmk[2], pmv[2], pkk[2], pka[2], prk[2];
#pragma unroll
        for (int nb = 0; nb < 2; ++nb) { const int c = h3 * 64 + nb * 32 + r3; pw0[nb] = w0[c]; pa0[nb] = a0[c]; pmr[nb] = mu[c]; pmk[nb] = mu[256 + c]; pmv[nb] = mu[512 + c]; pkk[nb] = kkw[c]; pka[nb] = kaw[c]; prk[nb] = rkw[c]; }
#pragma unroll
        for (int e = 0; e < 16; ++e) { const int tok = th3 * 32 + (e & 3) + 8 * (e >> 2) + 4 * hg3, t = t0 + tok; const size_t row = (size_t)row0 + tok; const bool hp = t > 0;
            float dec[2], kkv[2], kka[2], k2[2], rv[2], vv[2], s_kk = 0.f, s_c1 = 0.f, s_c2 = 0.f, s_bn = 0.f;
#pragma unroll
            for (int nb = 0; nb < 2; ++nb) { const int c = h3 * 64 + nb * 32 + r3; const bf16_t* pc = proj + row * PW + P_R + c;
                const float rc = bf2f(pc[0]), kc = bf2f(pc[256]), vc = bf2f(pc[512]);
                const float rp = hp ? bf2f(pc[-PW]) : 0.f, kp = hp ? bf2f(pc[256 - PW]) : 0.f, vp = hp ? bf2f(pc[512 - PW]) : 0.f;
                const float rr = rc + (rp - rc) * pmr[nb], k = kc + (kp - kc) * pmk[nb]; vv[nb] = vc + (vp - vc) * pmv[nb]; rv[nb] = rr;
                const float wl = -softplusf(-(accw[nb][e] + pw0[nb])) - 0.5f; dec[nb] = __expf(-__expf(wl)); const float av = sigm(acca[nb][e] + pa0[nb]);
                kkv[nb] = k * pkk[nb]; k2[nb] = k * (1.0f + (av - 1.0f) * pka[nb]); kka[nb] = av;
                s_kk += kkv[nb] * kkv[nb]; s_c2 += k2[nb] * rr; s_bn += rr * k2[nb] * prk[nb];
                GR[row * 256 + c] = (bf16_t)f2bf(accg[nb][e]); }
            s_kk = row16_sum(s_kk); s_kk += __shfl_xor(s_kk, 16);
            const float inv = 1.0f / fmaxf(sqrtf(s_kk), 1e-12f);
#pragma unroll
            for (int nb = 0; nb < 2; ++nb) { kkv[nb] *= inv; kka[nb] *= kkv[nb]; s_c1 += kka[nb] * rv[nb]; }
            s_c1 = row16_sum(s_c1); s_c1 += __shfl_xor(s_c1, 16); s_c2 = row16_sum(s_c2); s_c2 += __shfl_xor(s_c2, 16); s_bn = row16_sum(s_bn); s_bn += __shfl_xor(s_bn, 16);
            const size_t st = ((size_t)(b * 4 + h3) * T + t);
#pragma unroll
            for (int nb = 0; nb < 2; ++nb) { float* vb = VEC + st * VSTEP + nb * 32 + r3;
                vb[0] = dec[nb]; vb[64] = -kkv[nb]; vb[128] = kka[nb]; vb[192] = k2[nb]; vb[256] = dec[nb] * rv[nb]; vb[320] = vv[nb]; }
            if (r3 == 0) { *(pg8::f32x4*)(SC + st * 4) = (pg8::f32x4){s_c1, s_c2, s_bn, 0.f}; *(pg8::f32x2*)(VEC + st * VSTEP + 384) = (pg8::f32x2){s_c1, s_c2}; }
            asm volatile("" ::: "memory"); }
        __syncthreads();
    }
}

__device__ __forceinline__ void ph_rwkv_scan(Frame& F, ArgsP a) {
    const float* VEC = (const float*)(a->ws + SCR_VEC6); float* YR = (float*)(a->ws + SCR_YR);
    int lane = F.lane(); asm volatile("" : "+v"(lane));
    constexpr int CH = 32, CHB = CH * VSTEP * 4, NP = CHB / 1024 / 4;
    const bool stager = F.wave >= 4;
    for (int it = blockIdx.x; it < 256; it += F.G) {
        const int bh = it >> 3, rg = it & 7, b = bh >> 2, h = bh & 3;
        const int sw = F.wave & 3, vrow = rg * 8 + 2 * sw;
        const char* src = (const char*)(VEC + (size_t)bh * T * VSTEP) + lane * 16;
#define RW_STAGE(cidx) do { _Pragma("unroll") for (int p_ = 0; p_ < NP; ++p_) \
            __builtin_amdgcn_global_load_lds((const unsigned*)(src + (size_t)(cidx) * CHB + (sw * NP + p_) * 1024), (LAS unsigned*)(F.lds + ((cidx) & 1) * CHB + (sw * NP + p_) * 1024), 16, 0, 0); } while (0)
        if (stager) { RW_STAGE(0); asm volatile("s_waitcnt vmcnt(0)" ::: "memory"); }
        __builtin_amdgcn_s_barrier(); asm volatile("" ::: "memory");
        float SA = 0.f, SB = 0.f;
        for (int c = 0; c < T / CH; ++c) {
            if (stager) { if (c + 1 < T / CH) { RW_STAGE(c + 1); asm volatile("s_waitcnt vmcnt(0)" ::: "memory"); } }
            else {
                const LAS float* bufl = (const LAS float*)(F.lds + (c & 1) * CHB) + lane;
                const LAS float* bufv = (const LAS float*)(F.lds + (c & 1) * CHB) + 320 + vrow;
                const LAS float* bufc = (const LAS float*)(F.lds + (c & 1) * CHB) + 384;
                float zaA = 0.f, zaB = 0.f, saaA = 0.f, saaB = 0.f;
                float nw = bufl[0], nnkk = bufl[64], nkka = bufl[128], nk2 = bufl[192], nwr = bufl[256]; pg8::f32x2 nv = *(const LAS pg8::f32x2*)bufv;
#define RW_STEP(SI) do { \
                    const float w_ = nw, nkk = nnkk, kka = nkka, k2 = nk2, wr = nwr; const pg8::f32x2 v = nv; \
                    { const int s1 = ((SI) + 1 < CH ? (SI) + 1 : (SI)) * VSTEP; \
                      nw = bufl[s1]; nnkk = bufl[s1 + 64]; nkka = bufl[s1 + 128]; nk2 = bufl[s1 + 192]; nwr = bufl[s1 + 256]; nv = *(const LAS pg8::f32x2*)(bufv + s1); } \
                    asm volatile("" ::: "memory"); \
                    const auto s0 = __builtin_amdgcn_permlane32_swap(__builtin_bit_cast(unsigned, SA * nkk), __builtin_bit_cast(unsigned, SA * wr), false, false); \
                    const auto s1_ = __builtin_amdgcn_permlane32_swap(__builtin_bit_cast(unsigned, SB * nkk), __builtin_bit_cast(unsigned, SB * wr), false, false); \
                    const float xA = __builtin_bit_cast(float, (unsigned)s0[0]) + __builtin_bit_cast(float, (unsigned)s0[1]); \
                    const float xB = __builtin_bit_cast(float, (unsigned)s1_[0]) + __builtin_bit_cast(float, (unsigned)s1_[1]); \
                    const auto s2 = __builtin_amdgcn_permlane16_swap(__builtin_bit_cast(unsigned, xA), __builtin_bit_cast(unsigned, xB), false, false); \
                    float x = __builtin_bit_cast(float, (unsigned)s2[0]) + __builtin_bit_cast(float, (unsigned)s2[1]); \
                    x += dpp_mov<0xB1, 0xF>(0.f, x); x += dpp_mov<0x4E, 0xF>(0.f, x); x += dpp_mov<0x141, 0xF>(0.f, x); x += dpp_mov<0x140, 0xF>(0.f, x); \
                    const int isaA = __builtin_amdgcn_readlane(__builtin_bit_cast(int, x), 0), isaB = __builtin_amdgcn_readlane(__builtin_bit_cast(int, x), 16); \
                    const int izA = __builtin_amdgcn_readlane(__builtin_bit_cast(int, x), 32), izB = __builtin_amdgcn_readlane(__builtin_bit_cast(int, x), 48); \
                    const float saA = __builtin_bit_cast(float, isaA), saB = __builtin_bit_cast(float, isaB); \
                    SA = SA * w_ + (saA * kka + v[0] * k2); \
                    SB = SB * w_ + (saB * kka + v[1] * k2); \
                    asm volatile("v_writelane_b32 %0, %4, %8\n\tv_writelane_b32 %1, %5, %8\n\tv_writelane_b32 %2, %6, %8\n\tv_writelane_b32 %3, %7, %8" : "+v"(saaA), "+v"(saaB), "+v"(zaA), "+v"(zaB) : "s"(isaA), "s"(isaB), "s"(izA), "s"(izB), "n"(SI)); \
                } while (0)
                RW_STEP(0); RW_STEP(1); RW_STEP(2); RW_STEP(3); RW_STEP(4); RW_STEP(5); RW_STEP(6); RW_STEP(7); RW_STEP(8); RW_STEP(9); RW_STEP(10); RW_STEP(11); RW_STEP(12); RW_STEP(13); RW_STEP(14); RW_STEP(15); RW_STEP(16); RW_STEP(17); RW_STEP(18); RW_STEP(19); RW_STEP(20); RW_STEP(21); RW_STEP(22); RW_STEP(23); RW_STEP(24); RW_STEP(25); RW_STEP(26); RW_STEP(27); RW_STEP(28); RW_STEP(29); RW_STEP(30); RW_STEP(31);
#undef RW_STEP
                const int sl = (lane & 31) * VSTEP; const pg8::f32x2 vv = *(const LAS pg8::f32x2*)((const LAS float*)(F.lds + (c & 1) * CHB) + 320 + vrow + sl), cc = *(const LAS pg8::f32x2*)(bufc + sl);
                const float yaA = zaA + saaA * cc[0] + vv[0] * cc[1], yaB = zaB + saaB * cc[0] + vv[1] * cc[1];
                if (lane < CH) *(pg8::f32x2*)(YR + ((size_t)b * T + c * CH + lane) * 256 + h * 64 + vrow) = (pg8::f32x2){yaA, yaB};
            }
            __builtin_amdgcn_s_barrier(); asm volatile("" ::: "memory");
        }
#undef RW_STAGE
        asm volatile("s_waitcnt vmcnt(0)" ::: "memory"); __builtin_amdgcn_s_barrier(); asm volatile("" ::: "memory");
    }
}

__device__ __forceinline__ void ph_rwkv_post(Frame& F, ArgsP a, int l) {
    const float* VEC = (const float*)(a->ws + SCR_VEC6); const float* SC = (const float*)(a->ws + SCR_SC); const float* YR = (const float*)(a->ws + SCR_YR); const bf16_t* GR = (const bf16_t*)(a->ws + SCR_GR);
    const float* lng = (const float*)a->in[28] + l * 256; const float* lnb = (const float*)a->in[29] + l * 256;
    bf16_t* br = (bf16_t*)(a->ws + WS_HB);
    int lane = F.lane(); asm volatile("" : "+v"(lane));
    const int c = 4 * lane, h = lane >> 4;
    const pg8::f32x4 g4 = *(const pg8::f32x4*)(lng + c), b4 = *(const pg8::f32x4*)(lnb + c);
    for (int row = F.gw; row < M; row += F.NGW) {
        const int b = row / T, t = row % T; const size_t st = (size_t)(b * 4 + h) * T + t;
        const pg8::f32x4 y = *(const pg8::f32x4*)(YR + (size_t)row * 256 + c);
        const float mu = row16_sum((y[0] + y[1]) + (y[2] + y[3])) * (1.0f / 64.0f); const pg8::f32x4 d = y - mu;
        const float var = row16_sum((d[0] * d[0] + d[1] * d[1]) + (d[2] * d[2] + d[3] * d[3])) * (1.0f / 64.0f);
        const pg8::f32x4 yn = d * rsqrtf(var + 64e-5f) * g4 + b4;
        const float bonus = SC[st * 4 + 2];
        const pg8::f32x4 v = *(const pg8::f32x4*)(VEC + st * VSTEP + 320 + (c & 63));
        const pg8::f32x4 g = ld_bf16x4(GR + (size_t)row * 256 + c);
        st_bf16x4(br + (size_t)row * D + 768 + c, (yn + bonus * v) * g);
    }
}

__device__ __forceinline__ void ph_gla_p1(Frame& F, ArgsP a, int l) {
    const bf16_t* proj = (const bf16_t*)(a->ws + WS_PROJ); const float* w2 = (const float*)a->in[10] + l * 16 * 128; const float* gb = (const float*)a->in[11] + l * 128;
    bf16_t* QS = (bf16_t*)(a->ws + SCR_EG); float* CDp = (float*)(a->ws + SCR_EG) + (size_t)M * 128; float* GU = (float*)(a->ws + SCR_GU); float* OI = (float*)(a->ws + WS_GOI);
    const bf16_t* GZ = (const bf16_t*)(a->ws + WS_GZ);
    constexpr int RS = 40;
    LAS unsigned char* wl = F.lds + F.wave * 12800;
    LAS bf16_t* VTl = (LAS bf16_t*)wl; LAS bf16_t* Qs = (LAS bf16_t*)(wl + 5120); LAS bf16_t* Ks = (LAS bf16_t*)(wl + 7680); LAS bf16_t* KdT = (LAS bf16_t*)(wl + 10240);
    int lane = F.lane(); asm volatile("" : "+v"(lane));
    const int d = lane & 31, half = lane >> 5, r = lane & 31, hg = lane >> 5;
    for (int it = F.gw; it < 2048; it += F.NGW) {
        const int bh = it >> 6, n = it & 63, b = bh >> 2, h = bh & 3; const size_t row0 = (size_t)b * T + n * 32;
        float wc[16];
#pragma unroll
        for (int q = 0; q < 16; ++q) wc[q] = w2[q * 128 + h * 32 + d];
        const float gbv = gb[h * 32 + d];
        float g[16];
#pragma unroll
        for (int i = 0; i < 16; ++i) { const bf16_t* pr = GZ + (row0 + 16 * half + i) * 16;
            const pg8::f32x4 z0 = ld_bf16x4(pr), z1 = ld_bf16x4(pr + 4), z2 = ld_bf16x4(pr + 8), z3 = ld_bf16x4(pr + 12);
            float acc = gbv;
#pragma unroll
            for (int e = 0; e < 4; ++e) acc += z0[e] * wc[e] + z1[e] * wc[4 + e] + z2[e] * wc[8 + e] + z3[e] * wc[12 + e];
            g[i] = -softplusf(-acc) * (1.0f / 16.0f); }
#pragma unroll
        for (int i = 1; i < 16; ++i) g[i] += g[i - 1];
        const float other = __shfl(g[15], d);
        if (half) {
#pragma unroll
            for (int i = 0; i < 16; ++i) g[i] += other; }
        const float glast = __shfl(g[15], 32 + d);
#pragma unroll
        for (int i = 0; i < 16; ++i) { const int tok = 16 * half + i; const bf16_t* pr = proj + (row0 + tok) * PW;
            const float qv = bf2f(pr[P_GQ + h * 32 + d]), kv = bf2f(pr[P_GK + h * 32 + d]);
            const unsigned qb = f2bf(qv * 0.17677669529663687f * __expf(g[i]));
            Qs[tok * RS + d] = (bf16_t)qb; QS[((size_t)it * 32 + tok) * 32 + d] = (bf16_t)qb;
            Ks[tok * RS + d] = (bf16_t)f2bf(kv * __expf(-g[i])); KdT[d * RS + tok] = (bf16_t)f2bf(kv * __expf(glast - g[i])); }
        if (half) CDp[it * 32 + d] = __expf(glast);
        { const bf16_t* vp = proj + row0 * PW + P_GV + h * 64 + lane;
#pragma unroll
          for (int t2 = 0; t2 < 16; ++t2) { const unsigned lo = vp[(size_t)(2 * t2) * PW], hi = vp[(size_t)(2 * t2 + 1) * PW]; *(LAS unsigned*)(VTl + lane * RS + 2 * t2) = lo | (hi << 16); } }
        asm volatile("s_waitcnt lgkmcnt(0)" ::: "memory");
        f32x16 X;
#pragma unroll
        for (int e = 0; e < 16; ++e) X[e] = 0.f;
#pragma unroll
        for (int s = 0; s < 2; ++s) X = __builtin_amdgcn_mfma_f32_32x32x16_bf16(*(const LAS pg8::bf16x8*)(Ks + r * RS + 16 * s + 8 * hg), *(const LAS pg8::bf16x8*)(Qs + r * RS + 16 * s + 8 * hg), X, 0, 0, 0);
#pragma unroll
        for (int e = 0; e < 16; ++e) { const int jrow = (e & 3) + 8 * (e >> 2) + 4 * hg; if (jrow > r) X[e] = 0.f; }
        f32x16 oi[2], ut[2];
#pragma unroll
        for (int e = 0; e < 16; ++e) { oi[0][e] = 0.f; oi[1][e] = 0.f; ut[0][e] = 0.f; ut[1][e] = 0.f; }
#pragma unroll
        for (int s = 0; s < 2; ++s) {
            pg8::u32x4 pw; pw.x = pk2(X[8 * s], X[8 * s + 1]); pw.y = pk2(X[8 * s + 2], X[8 * s + 3]); pw.z = pk2(X[8 * s + 4], X[8 * s + 5]); pw.w = pk2(X[8 * s + 6], X[8 * s + 7]);
            const pg8::bf16x8 xf = __builtin_bit_cast(pg8::bf16x8, pw);
            const pg8::bf16x8 kdf = *(const LAS pg8::bf16x8*)(KdT + r * RS + 16 * s + 8 * hg);
#pragma unroll
            for (int db = 0; db < 2; ++db) { const LAS bf16_t* vp = VTl + (db * 32 + r) * RS + 16 * s;
                const pg8::u32x2 v0 = *(const LAS pg8::u32x2*)(vp + 4 * hg), v1 = *(const LAS pg8::u32x2*)(vp + 8 + 4 * hg);
                pg8::u32x4 vw; vw.x = v0.x; vw.y = v0.y; vw.z = v1.x; vw.w = v1.y;
                oi[db] = __builtin_amdgcn_mfma_f32_32x32x16_bf16(__builtin_bit_cast(pg8::bf16x8, vw), xf, oi[db], 0, 0, 0);
                ut[db] = __builtin_amdgcn_mfma_f32_32x32x16_bf16(*(const LAS pg8::bf16x8*)(vp + 8 * hg), kdf, ut[db], 0, 0, 0); } }
        float* op = OI + (size_t)it * 2048 + lane;
#pragma unroll
        for (int db = 0; db < 2; ++db)
#pragma unroll
            for (int e = 0; e < 16; ++e) op[(db * 16 + e) * 64] = oi[db][e];
        float* up = GU + ((size_t)it * 32 + r) * 64 + 4 * hg;
#pragma unroll
        for (int db = 0; db < 2; ++db)
#pragma unroll
            for (int q = 0; q < 4; ++q) *(pg8::f32x4*)(up + db * 32 + 8 * q) = (pg8::f32x4){ut[db][4 * q], ut[db][4 * q + 1], ut[db][4 * q + 2], ut[db][4 * q + 3]};
        asm volatile("s_waitcnt lgkmcnt(0)" ::: "memory");
    }
}
__device__ __forceinline__ void ph_gla_prefix(Frame& F, ArgsP a) {
    const float* CDp = (const float*)(a->ws + SCR_EG) + (size_t)M * 128; const float* GU = (const float*)(a->ws + SCR_GU); bf16_t* ST = (bf16_t*)(a->ws + WS_GST);
    int lane = F.lane(); asm volatile("" : "+v"(lane));
    for (int it = F.gw; it < 1024; it += F.NGW) { const int bh = it >> 5, d = it & 31;
        const float* gp = GU + ((size_t)bh * 64 * 32 + d) * 64 + lane; const float* cp = CDp + (size_t)bh * 64 * 32 + d;
        bf16_t* sp = ST + ((size_t)bh * 64 * 64 + lane) * 32 + d;
        float u[64], cd[64];
#pragma unroll
        for (int n = 0; n < 64; ++n) { u[n] = gp[(size_t)n * 2048]; cd[n] = cp[n * 32]; }
        float S = 0.f;
#pragma unroll
        for (int n = 0; n < 64; ++n) { sp[(size_t)n * 2048] = (bf16_t)f2bf(S); S = cd[n] * S + u[n]; } }
}
__device__ __forceinline__ void ph_gla_p2(Frame& F, ArgsP a, int l) {
    const bf16_t* proj = (const bf16_t*)(a->ws + WS_PROJ); const float* gnorm = (const float*)a->in[12] + l * 64;
    const bf16_t* QS = (const bf16_t*)(a->ws + SCR_EG); const bf16_t* ST = (const bf16_t*)(a->ws + WS_GST); const float* OI = (const float*)(a->ws + WS_GOI); bf16_t* br = (bf16_t*)(a->ws + WS_HB);
    int lane = F.lane(); asm volatile("" : "+v"(lane));
    const int r = lane & 31, hg = lane >> 5;
    for (int it = F.gw; it < 2048; it += F.NGW) {
        const int bh = it >> 6, n = it & 63, b = bh >> 2, h = bh & 3; const size_t row0 = (size_t)b * T + n * 32;
        f32x16 ot[2]; const float* op = OI + (size_t)it * 2048 + lane;
#pragma unroll
        for (int db = 0; db < 2; ++db)
#pragma unroll
            for (int e = 0; e < 16; ++e) ot[db][e] = op[(db * 16 + e) * 64];
#pragma unroll
        for (int s = 0; s < 2; ++s) { const pg8::bf16x8 qf = *(const pg8::bf16x8*)(QS + ((size_t)it * 32 + r) * 32 + 16 * s + 8 * hg);
#pragma unroll
            for (int db = 0; db < 2; ++db) ot[db] = __builtin_amdgcn_mfma_f32_32x32x16_bf16(*(const pg8::bf16x8*)(ST + ((size_t)it * 64 + db * 32 + r) * 32 + 16 * s + 8 * hg), qf, ot[db], 0, 0, 0); }
        float ss = 0.f;
#pragma unroll
        for (int db = 0; db < 2; ++db)
#pragma unroll
            for (int e = 0; e < 16; ++e) ss += ot[db][e] * ot[db][e];
        ss += __shfl_xor(ss, 32);
        const float rstd = rsqrtf(ss * (1.0f / 64.0f) + 1e-6f);
        const bf16_t* og = proj + (row0 + r) * PW + P_GO + h * 64 + 4 * hg; bf16_t* od = br + (row0 + r) * D + h * 64 + 4 * hg;
#pragma unroll
        for (int db = 0; db < 2; ++db)
#pragma unroll
            for (int q = 0; q < 4; ++q) { const int dv0 = db * 32 + 8 * q; const pg8::f32x4 gv = ld_bf16x4(og + dv0), gn = *(const pg8::f32x4*)(gnorm + dv0 + 4 * hg);
                st_bf16x4(od + dv0, (pg8::f32x4){ot[db][4 * q] * rstd * gn[0] * siluf(gv[0]), ot[db][4 * q + 1] * rstd * gn[1] * siluf(gv[1]), ot[db][4 * q + 2] * rstd * gn[2] * siluf(gv[2]), ot[db][4 * q + 3] * rstd * gn[3] * siluf(gv[3])}); }
    }
}

__device__ __forceinline__ void ph_attn_prep(Frame& F, ArgsP a) {
    const bf16_t* proj = (const bf16_t*)(a->ws + WS_PROJ); const int* pos = (const int*)a->in[2];
    bf16_t* QR = (bf16_t*)(a->ws + SCR_QK); bf16_t* KR = QR + (size_t)M * 256; bf16_t* VT = (bf16_t*)(a->ws + SCR_VT);
    int lane = F.lane(); asm volatile("" : "+v"(lane));
    for (int idx = F.gw * 64 + lane; idx < M * 8; idx += F.NGW * 64) { const int row = idx >> 3, hc = idx & 7; const float p = (float)pos[row];
        const bf16_t* qs = proj + (size_t)row * PW + P_DQ + hc * 32; const bf16_t* ks = proj + (size_t)row * PW + P_DK + hc * 32;
        float qv[32], kv[32];
#pragma unroll
        for (int j = 0; j < 8; ++j) { const pg8::f32x4 q4 = ld_bf16x4(qs + 4 * j), k4 = ld_bf16x4(ks + 4 * j);
#pragma unroll
            for (int e = 0; e < 4; ++e) { qv[4 * j + e] = q4[e]; kv[4 * j + e] = k4[e]; } }
        float qo[32], ko[32];
#pragma unroll
        for (int i = 0; i < 16; ++i) { const float inv = exp2f(-(float)i * 0.8304820237218406f);
            float sn, cs; sincosf(p * inv, &sn, &cs);
            qo[i] = qv[i] * cs - qv[i + 16] * sn; qo[i + 16] = qv[i] * sn + qv[i + 16] * cs;
            ko[i] = kv[i] * cs - kv[i + 16] * sn; ko[i + 16] = kv[i] * sn + kv[i + 16] * cs; }
        const float qsc = 0.17677669529663687f * 1.4426950408889634f;
        bf16_t* qd = QR + (size_t)row * 256 + hc * 32; bf16_t* kd = KR + (size_t)row * 256 + hc * 32;
#pragma unroll
        for (int j = 0; j < 8; ++j) { st_bf16x4(qd + 4 * j, (pg8::f32x4){qo[4 * j] * qsc, qo[4 * j + 1] * qsc, qo[4 * j + 2] * qsc, qo[4 * j + 3] * qsc});
            st_bf16x4(kd + 4 * j, (pg8::f32x4){ko[4 * j], ko[4 * j + 1], ko[4 * j + 2], ko[4 * j + 3]}); } }
    for (int it = F.gw; it < 1024; it += F.NGW) { const int bh = it >> 5, tt = it & 31, b = bh >> 2, h = bh & 3;
        const bf16_t* vs = proj + ((size_t)b * T + tt * 64 + lane) * PW + P_DV + h * 64;
        pg8::u32x4 v[8];
#pragma unroll
        for (int j = 0; j < 8; ++j) v[j] = *(const pg8::u32x4*)(vs + 8 * j);
        bf16_t* vd = VT + (size_t)bh * 64 * T + tt * 64 + lane;
#pragma unroll
        for (int j = 0; j < 8; ++j)
#pragma unroll
            for (int e = 0; e < 4; ++e) { const unsigned w = v[j][e]; vd[(size_t)(8 * j + 2 * e) * T] = (bf16_t)(w & 0xffffu); vd[(size_t)(8 * j + 2 * e + 1) * T] = (bf16_t)(w >> 16); } }
}
__device__ __forceinline__ void ph_attn(Frame& F, ArgsP a, int l) {
    const bf16_t* QR = (const bf16_t*)(a->ws + SCR_QK); const bf16_t* KR = QR + (size_t)M * 256; const bf16_t* VT = (const bf16_t*)(a->ws + SCR_VT);
    const float* lp = (const float*)a->in[13] + l * 128; const float* subln = (const float*)a->in[14] + l * 64; bf16_t* br = (bf16_t*)(a->ws + WS_HB);
    int tid = F.wave * 64 + F.lane(); asm volatile("" : "+v"(tid)); const int lane = tid & 63;
    const int r = lane & 31, hg = lane >> 5, comp = F.wave & 1, qs = F.wave >> 1;
    constexpr int RS = 72;
    LAS bf16_t* Kt = (LAS bf16_t*)F.lds;
    LAS bf16_t* Vt = Kt + 2 * 64 * RS;
    LAS float* Xl = (LAS float*)(F.lds + 4 * 64 * RS * 2);
    float lam, lam_init;
    { float d01 = 0.f, d23 = 0.f;
      for (int i = 0; i < 32; ++i) { d01 += lp[i] * lp[32 + i]; d23 += lp[64 + i] * lp[96 + i]; }
      lam_init = 0.8f - 0.6f * __expf(-0.3f * (float)l); lam = __expf(d01) - __expf(d23) + lam_init; }
    const int ldrow = tid >> 3, ldch = tid & 7;
    for (int pi = blockIdx.x; pi < 256; pi += F.G) {
#pragma unroll 1
        for (int half = 0; half < 2; ++half) {
            const int bh = pi >> 3, j = pi & 7, qb = half == 0 ? 15 - j : j, b = bh >> 2, h = bh & 3;
            const int q0 = qb * 128 + qs * 32, nkw = q0 / 64 + 1, nkb = 2 * qb + 2;
            const size_t rowb = (size_t)b * T;
            pg8::bf16x8 qf[2];
#pragma unroll
            for (int s = 0; s < 2; ++s) qf[s] = *(const pg8::bf16x8*)(QR + (rowb + q0 + r) * 256 + h * 64 + comp * 32 + 16 * s + 8 * hg);
            f32x16 ot[2];
#pragma unroll
            for (int e = 0; e < 16; ++e) { ot[0][e] = 0.f; ot[1][e] = 0.f; }
            float mrun = -1e30f, lrun = 0.f;
            const bf16_t* kg = KR + (rowb + ldrow) * 256 + h * 64 + ldch * 8; const bf16_t* vg = VT + ((size_t)bh * 64 + ldrow) * T + ldch * 8;
            pg8::u32x4 kreg = *(const pg8::u32x4*)kg, vreg = *(const pg8::u32x4*)vg;
            pg8::u32x4 kreg2 = kreg, vreg2 = vreg;
            if (nkb > 1) { kreg2 = *(const pg8::u32x4*)(kg + (size_t)64 * 256); vreg2 = *(const pg8::u32x4*)(vg + 64); }
            for (int kt = 0; kt < nkb; ++kt) {
                const int bo = (kt & 1) * 64 * RS;
                *(LAS pg8::u32x4*)(Kt + bo + ldrow * RS + ldch * 8) = kreg; *(LAS pg8::u32x4*)(Vt + bo + ldrow * RS + ldch * 8) = vreg;
                __syncthreads();
                kreg = kreg2; vreg = vreg2;
                if (kt + 2 < nkb) { kreg2 = *(const pg8::u32x4*)(kg + (size_t)(kt + 2) * 64 * 256); vreg2 = *(const pg8::u32x4*)(vg + (kt + 2) * 64); }
                if (kt < nkw) {
                    f32x16 st[2];
#pragma unroll
                    for (int kb = 0; kb < 2; ++kb) {
#pragma unroll
                        for (int e = 0; e < 16; ++e) st[kb][e] = 0.f;
#pragma unroll
                        for (int s = 0; s < 2; ++s) { const pg8::bf16x8 kf = *(const LAS pg8::bf16x8*)(Kt + bo + (kb * 32 + r) * RS + comp * 32 + 16 * s + 8 * hg);
                            st[kb] = __builtin_amdgcn_mfma_f32_32x32x16_bf16(kf, qf[s], st[kb], 0, 0, 0); } }
                    if (kt == nkw - 1) {
                        const int qi = q0 + r;
#pragma unroll
                        for (int kb = 0; kb < 2; ++kb)
#pragma unroll
                            for (int e = 0; e < 16; ++e) { const int ki = kt * 64 + kb * 32 + (e & 3) + 8 * (e >> 2) + 4 * hg; if (ki > qi) st[kb][e] = -1e30f; } }
                    float tm = st[0][0];
#pragma unroll
                    for (int e = 1; e < 16; ++e) tm = fmaxf(tm, st[0][e]);
#pragma unroll
                    for (int e = 0; e < 16; ++e) tm = fmaxf(tm, st[1][e]);
                    { const auto sw = __builtin_amdgcn_permlane32_swap(__builtin_bit_cast(unsigned, tm), __builtin_bit_cast(unsigned, tm), false, false); tm = fmaxf(__builtin_bit_cast(float, (unsigned)sw[0]), __builtin_bit_cast(float, (unsigned)sw[1])); }
                    const float mn = fmaxf(mrun, tm), alpha = __builtin_amdgcn_exp2f(mrun - mn); mrun = mn;
                    float ps = 0.f;
#pragma unroll
                    for (int kb = 0; kb < 2; ++kb)
#pragma unroll
                        for (int e = 0; e < 16; ++e) { st[kb][e] = __builtin_amdgcn_exp2f(st[kb][e] - mn); ps += st[kb][e]; }
                    lrun = lrun * alpha + ps;
#pragma unroll
                    for (int e = 0; e < 16; ++e) { ot[0][e] *= alpha; ot[1][e] *= alpha; }
#pragma unroll
                    for (int kb = 0; kb < 2; ++kb)
#pragma unroll
                        for (int s = 0; s < 2; ++s) {
                            pg8::u32x4 pw; pw.x = pk2(st[kb][8 * s], st[kb][8 * s + 1]); pw.y = pk2(st[kb][8 * s + 2], st[kb][8 * s + 3]); pw.z = pk2(st[kb][8 * s + 4], st[kb][8 * s + 5]); pw.w = pk2(st[kb][8 * s + 6], st[kb][8 * s + 7]);
                            const pg8::bf16x8 pf = __builtin_bit_cast(pg8::bf16x8, pw);
#pragma unroll
                            for (int dvb = 0; dvb < 2; ++dvb) { const LAS bf16_t* vp = Vt + bo + (dvb * 32 + r) * RS + kb * 32 + 16 * s + 4 * hg;
                                const pg8::u32x2 v0 = *(const LAS pg8::u32x2*)vp, v1 = *(const LAS pg8::u32x2*)(vp + 8);
                                pg8::u32x4 vw; vw.x = v0.x; vw.y = v0.y; vw.z = v1.x; vw.w = v1.y;
                                ot[dvb] = __builtin_amdgcn_mfma_f32_32x32x16_bf16(__builtin_bit_cast(pg8::bf16x8, vw), pf, ot[dvb], 0, 0, 0); } }
                }
            }
            const float ltot = lrun + __shfl_xor(lrun, 32); const float il = 1.0f / ltot;
            __syncthreads();
            if (comp == 1) {
#pragma unroll
                for (int dvb = 0; dvb < 2; ++dvb)
#pragma unroll
                    for (int e = 0; e < 16; ++e) Xl[(qs * 32 + dvb * 16 + e) * 64 + lane] = ot[dvb][e] * il; }
            __syncthreads();
            if (comp == 0) {
                float o[32]; float ss = 0.f;
#pragma unroll
                for (int dvb = 0; dvb < 2; ++dvb)
#pragma unroll
                    for (int e = 0; e < 16; ++e) { const float v = ot[dvb][e] * il - lam * Xl[(qs * 32 + dvb * 16 + e) * 64 + lane]; o[dvb * 16 + e] = v; ss += v * v; }
                ss += __shfl_xor(ss, 32);
                const float sc = rsqrtf(ss * (1.0f / 64.0f) + 1e-6f) * (1.0f - lam_init);
                bf16_t* od = br + (rowb + q0 + r) * D + 256 + h * 64;
#pragma unroll
                for (int dvb = 0; dvb < 2; ++dvb)
#pragma unroll
                    for (int g4 = 0; g4 < 4; ++g4) { const int dv0 = dvb * 32 + 8 * g4 + 4 * hg; const pg8::f32x4 sl = *(const pg8::f32x4*)(subln + dv0);
                        st_bf16x4(od + dv0, (pg8::f32x4){o[dvb * 16 + 4 * g4] * sc * sl[0], o[dvb * 16 + 4 * g4 + 1] * sc * sl[1], o[dvb * 16 + 4 * g4 + 2] * sc * sl[2], o[dvb * 16 + 4 * g4 + 3] * sc * sl[3]}); }
            }
            __syncthreads();
        }
    }
}

__device__ __forceinline__ void ph_branch(Frame& F, ArgsP a, int l) {
    const bf16_t* br = (const bf16_t*)(a->ws + WS_HB); const bf16_t* WB = (const bf16_t*)(a->ws + WS_WB) + (size_t)l * 4096 * 256;
    const bf16_t* proj = (const bf16_t*)(a->ws + WS_PROJ); bf16_t* MB = (bf16_t*)(a->ws + SCR_MB);
    int tid = F.wave * 64 + F.lane(); asm volatile("" : "+v"(tid)); const int lane = tid & 63;
    const int r = lane & 31, hg = lane >> 5, wt = (tid >> 6) & 3, wd = tid >> 8;
    constexpr int RS = 72, TB = 128 * RS;
    LAS bf16_t* Wl = (LAS bf16_t*)F.lds;
    LAS bf16_t* Bl = Wl + 2 * TB;
    const int ldr = tid >> 3, ldc = (tid & 7) * 8;
    for (int it = blockIdx.x; it < 1024; it += F.G) {
        const int tm = it >> 3, td = it & 7; const size_t row0 = (size_t)tm * 128; const int d0 = td * 128;
        f32x16 tot[2], acc[2];
#pragma unroll
        for (int e = 0; e < 16; ++e) { tot[0][e] = 0.f; tot[1][e] = 0.f; acc[0][e] = 0.f; acc[1][e] = 0.f; }
        pg8::u32x4 rw0, rw1, rb0, rb1;
#define BR_LOAD(st) do { const int g_ = (st) >> 2, kq_ = (st) & 3; const bf16_t* wp = WB + (size_t)(g_ * 1024 + d0 + ldr) * 256 + kq_ * 64 + ldc; const bf16_t* bp = br + (row0 + ldr) * D + g_ * 256 + kq_ * 64 + ldc; \
            rw0 = *(const pg8::u32x4*)wp; rw1 = *(const pg8::u32x4*)(wp + 64 * 256); rb0 = *(const pg8::u32x4*)bp; rb1 = *(const pg8::u32x4*)(bp + 64 * D); } while (0)
#define BR_WRITE(buf) do { *(LAS pg8::u32x4*)(Wl + (buf) * TB + ldr * RS + ldc) = rw0; *(LAS pg8::u32x4*)(Wl + (buf) * TB + (ldr + 64) * RS + ldc) = rw1; \
            *(LAS pg8::u32x4*)(Bl + (buf) * TB + ldr * RS + ldc) = rb0; *(LAS pg8::u32x4*)(Bl + (buf) * TB + (ldr + 64) * RS + ldc) = rb1; } while (0)
        BR_LOAD(0); BR_WRITE(0); __syncthreads(); BR_LOAD(1);
        pg8::u32x2 gt[2][4];
#pragma unroll 1
        for (int st = 0; st < 16; ++st) {
            const int buf = st & 1, g = st >> 2;
            if ((st & 3) == 0) {
                const bf16_t* gp = proj + (row0 + wt * 32 + r) * PW + P_GATE + g * 1024 + d0 + wd * 64 + 4 * hg;
#pragma unroll
                for (int db = 0; db < 2; ++db)
#pragma unroll
                    for (int q = 0; q < 4; ++q) gt[db][q] = *(const pg8::u32x2*)(gp + db * 32 + 8 * q); }
#pragma unroll
            for (int s = 0; s < 4; ++s) { const pg8::bf16x8 bf = *(const LAS pg8::bf16x8*)(Bl + buf * TB + (wt * 32 + r) * RS + 16 * s + 8 * hg);
#pragma unroll
                for (int db = 0; db < 2; ++db) { const pg8::bf16x8 af = *(const LAS pg8::bf16x8*)(Wl + buf * TB + (wd * 64 + db * 32 + r) * RS + 16 * s + 8 * hg);
                    acc[db] = __builtin_amdgcn_mfma_f32_32x32x16_bf16(af, bf, acc[db], 0, 0, 0); } }
            if (st + 1 < 16) BR_WRITE(buf ^ 1);
            if (st + 2 < 16) BR_LOAD(st + 2);
            if ((st & 3) == 3) {
#pragma unroll
                for (int db = 0; db < 2; ++db)
#pragma unroll
                    for (int q = 0; q < 4; ++q) { const pg8::u32x2 w = gt[db][q];
                        const float g0 = __builtin_bit_cast(float, w.x << 16), g1 = __builtin_bit_cast(float, w.x & 0xffff0000u), g2 = __builtin_bit_cast(float, w.y << 16), g3 = __builtin_bit_cast(float, w.y & 0xffff0000u);
                        tot[db][4 * q] += acc[db][4 * q] * sigm(g0); tot[db][4 * q + 1] += acc[db][4 * q + 1] * sigm(g1); tot[db][4 * q + 2] += acc[db][4 * q + 2] * sigm(g2); tot[db][4 * q + 3] += acc[db][4 * q + 3] * sigm(g3);
                        acc[db][4 * q] = 0.f; acc[db][4 * q + 1] = 0.f; acc[db][4 * q + 2] = 0.f; acc[db][4 * q + 3] = 0.f; } }
            __syncthreads();
        }
#undef BR_LOAD
#undef BR_WRITE
        bf16_t* mp = MB + (row0 + wt * 32 + r) * D + d0 + wd * 64 + 4 * hg;
#pragma unroll
        for (int db = 0; db < 2; ++db)
#pragma unroll
            for (int q = 0; q < 4; ++q) st_bf16x4(mp + db * 32 + 8 * q, (pg8::f32x4){tot[db][4 * q], tot[db][4 * q + 1], tot[db][4 * q + 2], tot[db][4 * q + 3]});
    }
}
constexpr int RING_BYTES = 131072, LDSCTL_OFF = RING_BYTES, MISC_OFF = LDSCTL_OFF + 320, LDS_BYTES = 147456;
constexpr int PH_PRO = 0, PH_H0 = 1, PH_L0 = 2, PH_PER_LAYER = 12, PH_END = PH_L0 + 2 * PH_PER_LAYER;
constexpr int PL_PROJ = 0, PL_MIXA = 1, PL_MIXB = 2, PL_MIXC = 3, PL_BRANCH = 4, PL_OUT = 5, PL_ROWMIX = 6, PL_FFN1 = 7, PL_FFN2 = 8, PL_FFN3 = 9, PL_ROWFFN = 10;

#ifndef DUPMASK
#define DUPMASK 0
#endif
#define DUP(bit) for (int dup_ = 0; dup_ < (((DUPMASK) >> (bit)) & 1) + 1; ++dup_)
__global__ void __launch_bounds__(NTHR, 2) mk_fwd(Args a) {
    extern __shared__ __attribute__((aligned(16))) unsigned char lds_raw[];
    Frame F0;
    F0.lds = (LAS unsigned char*)lds_raw;
    F0.wave = __builtin_amdgcn_readfirstlane(threadIdx.x >> 6);
    F0.G = gridDim.x; F0.gw = blockIdx.x * NWAVES + F0.wave; F0.NGW = F0.G * NWAVES;
    volatile LAS unsigned* MISC = (volatile LAS unsigned*)(F0.lds + MISC_OFF);
    for (int u = threadIdx.x; u < (LDS_BYTES - LDSCTL_OFF) / 4; u += NTHR) ((LAS unsigned*)(F0.lds + LDSCTL_OFF))[u] = 0u;
    __syncthreads();
    unsigned* ctl = (unsigned*)(a.ws + WS_CTL);
    const int lo = a.ph_lo, hi = a.ph_hi;
    XcdBarrier bar; bar.bar = ctl + CW_BAR; bar.x = 0; bar.st = nullptr;
    if (hi - lo > 1) bar = xcd_barrier_post(ctl + CW_BAR, MISC + 8);
#define IN(k) (lo <= (k) && (k) < hi)
#define SEAM(k) do { if (IN(k) && IN((k) + 1)) { xcd_barrier(bar); if ((DUPMASK >> 12) & 1) xcd_barrier(bar); } } while (0)
    if (IN(PH_PRO)) DUP(0) { ArgsP A = fresh_args(); Frame F = fresh(F0); p0_mod_items(F, (const float*)A->in[1], (const float*)A->in[3], (const float*)A->in[4], (float*)(A->ws + WS_MOD)); p0_convert(F, A); }
    SEAM(PH_PRO);
    if (IN(PH_H0)) DUP(9) { Frame F = fresh(F0); ph_h0(F, fresh_args()); }
    SEAM(PH_H0);
    for (int l = 0; l < NL; ++l) {
        const int base = PH_L0 + l * PH_PER_LAYER;
        if (IN(base + PL_PROJ)) DUP(13) { ArgsP A = fresh_args(); Frame F = fresh(F0); unsigned char* ws = A->ws;
            pg8::Gemm g{(const bf16_t*)(ws + WS_HB), (const bf16_t*)(ws + WS_WIN) + (size_t)l * PW * 1024, 1024, 1024, 1024, 0}; pg8::StaticOrder S; S.init(M, 7168, F.G, (int)blockIdx.x);
            pg8::EpiBf16 E{(bf16_t*)(ws + WS_PROJ), PW, 28};
            pg8::gemm_phase<pg8::EpiBf16, pg8::StaticOrder, true>(F.lds, g, S, E, F.wave);
        }
        SEAM(base + PL_PROJ);
        if (IN(base + PL_MIXA)) { DUP(2) { Frame F = fresh(F0); ph_conv(F, fresh_args(), l); } DUP(6) { Frame F = fresh(F0); ph_rwkv_prep(F, fresh_args(), l); } DUP(7) { Frame F = fresh(F0); ph_gla_p1(F, fresh_args(), l); } DUP(8) { Frame F = fresh(F0); ph_attn_prep(F, fresh_args()); } }
        SEAM(base + PL_MIXA);
        if (IN(base + PL_MIXB)) { DUP(10) { Frame F = fresh(F0); ph_gla_prefix(F, fresh_args()); } DUP(3) { Frame F = fresh(F0); ph_rwkv_scan(F, fresh_args()); } DUP(4) { Frame F = fresh(F0); ph_attn(F, fresh_args(), l); } }
        SEAM(base + PL_MIXB);
        if (IN(base + PL_MIXC)) { DUP(5) { Frame F = fresh(F0); ph_rwkv_post(F, fresh_args(), l); } DUP(11) { Frame F = fresh(F0); ph_gla_p2(F, fresh_args(), l); } }
        SEAM(base + PL_MIXC);
        if (IN(base + PL_BRANCH)) DUP(14) { ArgsP A = fresh_args(); Frame F = fresh(F0); unsigned char* ws = A->ws;
            pg8::Gemm g{(const bf16_t*)(ws + WS_HB), (const bf16_t*)(ws + WS_WB) + (size_t)l * 1024 * 1024, 1024, 1024, 1024, 0}; pg8::StaticOrder S; S.init(M, 1024, F.G, (int)blockIdx.x);
            pg8::EpiBranchK E{(const bf16_t*)(ws + WS_PROJ), (bf16_t*)(ws + SCR_MB)};
            pg8::gemm_phase<pg8::EpiBranchK, pg8::StaticOrder, false>(F.lds, g, S, E, F.wave);
        }
        SEAM(base + PL_BRANCH);
        if (IN(base + PL_OUT)) DUP(1) { ArgsP A = fresh_args(); Frame F = fresh(F0); unsigned char* ws = A->ws;
            pg8::Gemm g{(const bf16_t*)(ws + SCR_MB), (const bf16_t*)(ws + WS_WO) + (size_t)l * 1024 * 1024, 1024, 1024, 1024, 0}; pg8::StaticOrder S; S.init(M, 1024, F.G, (int)blockIdx.x);
            pg8::EpiBf16 E{(bf16_t*)(ws + SCR_Y), 1024, 4};
            pg8::gemm_phase<pg8::EpiBf16, pg8::StaticOrder, false>(F.lds, g, S, E, F.wave);
        }
        SEAM(base + PL_OUT);
        if (IN(base + PL_ROWMIX)) { ArgsP A = fresh_args(); Frame F = fresh(F0); unsigned char* ws = A->ws; const float* modl = (const float*)(ws + WS_MOD) + (size_t)l * 8 * 6144;
            ph_row(F, A, l == 0 ? (const float*)A->in[0] : A->out, (const bf16_t*)(ws + SCR_Y), (const float*)A->in[6] + l * D, modl, 2048, (const float*)A->in[7] + l * D, modl, 3072, 4096, (bf16_t*)(ws + (l == 0 ? WS_HB : WS_H2L1)), l == 1); }
        SEAM(base + PL_ROWMIX);
        if (l == 0) {
            if (IN(base + PL_FFN1)) DUP(1) { ArgsP A = fresh_args(); Frame F = fresh(F0); unsigned char* ws = A->ws;
                pg8::Gemm g{(const bf16_t*)(ws + WS_HB), (const bf16_t*)(ws + WS_WF1), 1024, 1024, 1024, 0}; pg8::StaticOrder S; S.init(M, 2 * DFF, F.G, (int)blockIdx.x);
                pg8::EpiSwiglu E{(bf16_t*)(ws + WS_PROJ), DFF, 2 * DFF / 256};
                pg8::gemm_phase<pg8::EpiSwiglu, pg8::StaticOrder, true>(F.lds, g, S, E, F.wave);
            }
            SEAM(base + PL_FFN1);
            if (IN(base + PL_FFN2)) DUP(1) { ArgsP A = fresh_args(); Frame F = fresh(F0); unsigned char* ws = A->ws;
                pg8::Gemm g{(const bf16_t*)(ws + WS_PROJ), (const bf16_t*)(ws + WS_WF2), DFF, DFF, DFF, 0}; pg8::StaticOrder S; S.init(M, 1024, F.G, (int)blockIdx.x);
                pg8::EpiBf16 E{(bf16_t*)(ws + SCR_Y), 1024, 4};
                pg8::gemm_phase<pg8::EpiBf16, pg8::StaticOrder, false>(F.lds, g, S, E, F.wave);
            }
            SEAM(base + PL_FFN2);
        } else {
            if (IN(base + PL_FFN1)) DUP(0) { Frame F = fresh(F0); ph_moe_prep(F, fresh_args()); }
            SEAM(base + PL_FFN1);
            if (IN(base + PL_FFN2)) DUP(15) { ArgsP A = fresh_args(); Frame F = fresh(F0); unsigned char* ws = A->ws; const unsigned* cnt = (const unsigned*)(ws + WS_CTL) + CW_CNT;
                pg8::Gemm g{(const bf16_t*)(ws + WS_HG), (const bf16_t*)(ws + WS_WM1), 1024, 1024, 1024, 0}; pg8::MoeOrder<28> S; S.init(cnt, F.G, (int)blockIdx.x);
                pg8::EpiSwiglu E{(bf16_t*)(ws + WS_HID), DEX, 28};
                pg8::gemm_phase<pg8::EpiSwiglu, pg8::MoeOrder<28>, true>(F.lds, g, S, E, F.wave);
            }
            SEAM(base + PL_FFN2);
            if (IN(base + PL_FFN3)) DUP(16) { ArgsP A = fresh_args(); Frame F = fresh(F0); unsigned char* ws = A->ws; const unsigned* cnt = (const unsigned*)(ws + WS_CTL) + CW_CNT;
                pg8::Gemm g{(const bf16_t*)(ws + WS_HID), (const bf16_t*)(ws + WS_WM2), DEX, DEX, DEX, 0}; pg8::MoeOrder<4> S; S.init(cnt, F.G, (int)blockIdx.x);
                pg8::EpiBf16 E{(bf16_t*)(ws + WS_HG), 1024, 4};
                pg8::gemm_phase<pg8::EpiBf16, pg8::MoeOrder<4>, true>(F.lds, g, S, E, F.wave);
            }
            SEAM(base + PL_FFN3);
        }
        if (IN(base + PL_ROWFFN)) { ArgsP A = fresh_args(); Frame F = fresh(F0); unsigned char* ws = A->ws; const float* modl = (const float*)(ws + WS_MOD) + (size_t)l * 8 * 6144;
            const bool last = (l == NL - 1);
            if (l == 0) ph_row(F, A, A->out, (const bf16_t*)(ws + SCR_Y), (const float*)A->in[8], modl, 5120, (const float*)A->in[5] + D, modl + 8 * 6144, 0, 1024, (bf16_t*)(ws + WS_HB), false, nullptr, (const float*)A->in[9] + (size_t)1024 * NIN);
            else ph_row(F, A, A->out, nullptr, (const float*)A->in[8] + D, modl, 5120, nullptr, nullptr, 0, 1024, nullptr, false, (const bf16_t*)(ws + WS_HG));
        }
        SEAM(base + PL_ROWFFN);
    }
#undef IN
#undef SEAM
}

extern "C" void kernel_launch(void* const* d_in, const int* in_sizes, int n_in, void* d_out, int out_size, void* d_ws, size_t ws_size, hipStream_t stream) {
    static int grid = 0;
    if (grid == 0) {
        if (n_in != 40 || ws_size < WS_END) { fprintf(stderr, "kernel_launch: need 40 inputs and >= %zu bytes of workspace (got %d, %zu)\n", (size_t)WS_END, n_in, ws_size); grid = -1; return; }
        int dev = 0, cus = 0, per_cu = 0;
        (void)hipGetDevice(&dev); (void)hipDeviceGetAttribute(&cus, hipDeviceAttributeMultiprocessorCount, dev);
        (void)hipFuncSetAttribute((const void*)mk_fwd, hipFuncAttributeMaxDynamicSharedMemorySize, LDS_BYTES);
        (void)hipOccupancyMaxActiveBlocksPerMultiprocessor(&per_cu, (const void*)mk_fwd, NTHR, LDS_BYTES);
        (void)hipGetLastError();
        grid = cus > 0 ? cus : 256;
        if (per_cu < 1) fprintf(stderr, "kernel_launch: occupancy query says %d blocks per CU\n", per_cu);
    }
    if (grid < 0) return;
    unsigned char* ws = (unsigned char*)d_ws;
    (void)hipMemsetAsync(ws + WS_CTL, 0, CTL_ZERO_BYTES, stream);
    Args a{};
    for (int i = 0; i < 40; ++i) a.in[i] = d_in[i];
    a.out = (float*)d_out; a.ws = ws;
    a.ph_lo = 0; a.ph_hi = PH_L0 + (NL - 1) * PH_PER_LAYER + PL_ROWFFN + 1;
    hipLaunchKernelGGL(mk_fwd, dim3(grid), dim3(NTHR), LDS_BYTES, stream, a);
}
```

```cpp
#include <hip/hip_runtime.h>
#include <hip/hip_bf16.h>
#include <cstdint>
#include <cstdio>

typedef __hip_bfloat16 bf16;
typedef unsigned short bf16_t;
#define GAS __attribute__((address_space(1)))
#define LAS __attribute__((address_space(3)))

constexpr int D = 1024, NB = 8, T = 2048, M = NB * T, NL = 2;
constexpr int NIN = 7184;
constexpr int PW = 7424;
constexpr int P_GQ = 0, P_GK = 128, P_GV = 256, P_GO = 512, P_DQ = 768, P_DK = 1024, P_DV = 1280, P_CA = 1536, P_CB = 1792, P_R = 2048, P_GATE = 3072, P_GZ = 7168;
constexpr int DFF = 2816, NE = 8, DEX = 3584;
constexpr int NWAVES = 8, NTHR = 512;
constexpr size_t MiB = 1u << 20;
constexpr size_t WS_CTL = 0;
constexpr size_t CTL_ZERO_BYTES = 64 * 1024;
constexpr size_t WS_MOD = 1 * MiB;
constexpr size_t WS_ROUTE = 1 * MiB + 512 * 1024;
constexpr size_t WS_GZ = 2 * MiB + 512 * 1024;
constexpr size_t WS_LR = 3 * MiB;
constexpr size_t WS_WIN = 4 * MiB;
constexpr size_t WS_WB = 33 * MiB;
constexpr size_t WS_WO = 37 * MiB;
constexpr size_t WS_WF1 = 41 * MiB;
constexpr size_t WS_WF2 = 52 * MiB;
constexpr size_t WS_HB = 58 * MiB;
constexpr size_t WS_PROJ = 90 * MiB;
constexpr size_t WS_SCR = 322 * MiB;
constexpr size_t WS_H2L1 = 508 * MiB;
constexpr size_t WS_END = 540 * MiB;
constexpr size_t WS_HG = 4 * MiB;
constexpr size_t WS_WM1 = 72 * MiB;
constexpr size_t WS_WM2 = 184 * MiB;
constexpr size_t WS_HID = 240 * MiB;
static_assert(WS_HID + (size_t)34816 * 3584 * 2 <= WS_H2L1, "moe overlay");
constexpr size_t SCR_MP = WS_SCR;
constexpr size_t SCR_MB = WS_SCR + 64 * MiB;
constexpr size_t SCR_Y = WS_SCR + 96 * MiB;
constexpr size_t SCR_RW = WS_SCR;
constexpr size_t SCR_GK = WS_SCR + 112 * MiB;
constexpr size_t SCR_QR = WS_SCR + 120 * MiB;
constexpr size_t SCR_KR = WS_SCR + 136 * MiB;
constexpr size_t SCR_VEC6 = WS_SCR;
constexpr size_t SCR_SC = WS_SCR + 112 * MiB;
constexpr size_t SCR_YR = WS_SCR + 113 * MiB;
constexpr size_t SCR_GR = WS_SCR + 129 * MiB;
constexpr size_t SCR_VT = WS_SCR + 137 * MiB;
constexpr size_t SCR_GU = WS_SCR + 145 * MiB;
constexpr size_t SCR_GS = SCR_GU;
constexpr size_t SCR_QK = WS_SCR + 161 * MiB;
constexpr size_t SCR_EG = WS_SCR + 177 * MiB;
constexpr size_t WS_GOI = WS_H2L1;
constexpr size_t WS_GST = WS_H2L1 + 16 * MiB;
constexpr int VSTEP = 448;
constexpr int CW_TMO = 0;
constexpr int CW_BAR = 1024;
constexpr int CW_CNT = 8192;
constexpr size_t RT_LIST = 0;
constexpr size_t RT_TOKE = 512 * 1024;
constexpr size_t RT_TOKS = 640 * 1024;
constexpr size_t RT_TOKP = 768 * 1024;

__device__ __forceinline__ float sigm(float x) { return __builtin_amdgcn_rcpf(1.0f + __expf(-x)); }
__device__ __forceinline__ float siluf(float x) { return x * sigm(x); }
__device__ __forceinline__ float softplusf(float x) { return fmaxf(x, 0.f) + __logf(1.0f + __expf(-fabsf(x))); }
__device__ __forceinline__ float tanh_fast(float x) { return 1.0f - 2.0f * __builtin_amdgcn_rcpf(1.0f + __expf(2.0f * x)); }
template <int CTRL, int ROWMASK> __device__ __forceinline__ float dpp_mov_h(float old, float x) {
    return __builtin_bit_cast(float, __builtin_amdgcn_update_dpp(__builtin_bit_cast(int, old), __builtin_bit_cast(int, x), CTRL, ROWMASK, 0xF, false)); }
__device__ __forceinline__ float wave_sum(float x) {
    x += dpp_mov_h<0xB1, 0xF>(0.f, x); x += dpp_mov_h<0x4E, 0xF>(0.f, x); x += dpp_mov_h<0x141, 0xF>(0.f, x); x += dpp_mov_h<0x140, 0xF>(0.f, x);
    x += dpp_mov_h<0x142, 0xA>(0.f, x); x += dpp_mov_h<0x143, 0xC>(0.f, x);
    return __builtin_bit_cast(float, __builtin_amdgcn_readlane(__builtin_bit_cast(int, x), 63));
}
__device__ __forceinline__ float wave_max(float v) {
#pragma unroll
    for (int o = 32; o > 0; o >>= 1) v = fmaxf(v, __shfl_xor(v, o));
    return v;
}
__device__ __forceinline__ float ldf(const float* p) { return *p; }
__device__ __forceinline__ float ldf(const bf16* p) { return __bfloat162float(*p); }
__device__ __forceinline__ float bf2f(bf16_t u) { return __builtin_bit_cast(float, (unsigned)u << 16); }
__device__ __forceinline__ unsigned f2bf(float f) { unsigned u = __builtin_bit_cast(unsigned, f); return (u + 0x7fffu + ((u >> 16) & 1u)) >> 16; }
typedef float f32x2_t_ __attribute__((ext_vector_type(2))); typedef __bf16 bf16x2_t_ __attribute__((ext_vector_type(2)));
__device__ __forceinline__ unsigned pk2(float lo, float hi) { const f32x2_t_ v = {lo, hi}; const bf16x2_t_ b = __builtin_convertvector(v, bf16x2_t_); return __builtin_bit_cast(unsigned, b); }
namespace pg8 {
#define PG8_LAS __attribute__((address_space(3)))
typedef short bf16x8 __attribute__((ext_vector_type(8)));
typedef float f32x4 __attribute__((ext_vector_type(4)));
typedef float f32x2 __attribute__((ext_vector_type(2)));
typedef unsigned u32x4 __attribute__((ext_vector_type(4)));
typedef unsigned u32x2 __attribute__((ext_vector_type(2)));
constexpr int BM = 256, BK = 64, HALF = 128, HTB = HALF * BK * 2  , STAGE_BYTES = 8 * HTB, NXCD = 8, WGM = 8;

__host__ __device__ __forceinline__ int lds_byte(int r, int c) { const int st = (r >> 4) * 2 + (c >> 5), rr = r & 15, cc = c & 31, ob = rr * 64 + cc * 2; return st * 1024 + (ob ^ (((ob >> 9) & 1) << 5)); }
__host__ __device__ __forceinline__ void stage_rc(int b, int& R, int& C) { const int st = b / 1024, sb = b % 1024, swz = sb ^ (((sb >> 9) & 1) << 5); R = (st >> 1) * 16 + swz / 64; C = (st & 1) * 32 + (swz % 64) / 2; }
__host__ __device__ __forceinline__ int perm32(int rho) { const int n = rho >> 4, i = rho & 15; return 8 * (i >> 2) + 4 * n + (i & 3); }

struct Unit { int pm, pn, aoff, tag; };
struct Gemm { const bf16_t* A; const bf16_t* Bt; int lda, ldb, K, pad; };

struct StaticOrder {
    int nM, nN, nwg, G, c;
    __host__ __device__ void init(int M_, int N_, int G_, int c_) { nM = M_ / BM; nN = N_ / BM; nwg = nM * nN; G = G_; c = c_; }
    __host__ __device__ bool next(int i, Unit& u) const {
        const long L = (long)i * G + c; if (L >= nwg) return false;
        int wgid = (int)L; { const int q = nwg / NXCD, r = nwg % NXCD, xcd = wgid % NXCD, off = wgid / NXCD; wgid = (xcd < r ? xcd * (q + 1) : r * (q + 1) + (xcd - r) * q) + off; }
        const int nig = WGM * nN, gid = wgid / nig, fm = gid * WGM, gsz = (nM - fm) < WGM ? (nM - fm) : WGM;
        u.pm = fm + ((wgid % nig) % gsz); u.pn = (wgid % nig) / gsz; u.aoff = 0; u.tag = 0; return true;
    }
};

__device__ __forceinline__ unsigned cvt_pk_bf16(float lo, float hi) { unsigned r; asm volatile("v_cvt_pk_bf16_f32 %0, %1, %2" : "=v"(r) : "v"(lo), "v"(hi)); return r; }


template <class Epi, class Sched, bool ALIGN_EPI>
__device__ __forceinline__ void gemm_phase(PG8_LAS unsigned char* lds, const Gemm g, const Sched& S, const Epi& E, int wave_s) {
    unsigned z_ = 0u; asm volatile("" : "+v"(z_));
    int tid_ = wave_s * 64 + (int)__builtin_amdgcn_mbcnt_hi(~0u, __builtin_amdgcn_mbcnt_lo(~0u, z_)); asm volatile("" : "+v"(tid_));
    const int tid = tid_, wid = __builtin_amdgcn_readfirstlane(tid >> 6), lane = tid & 63, wr = wid >> 2, wc = wid & 3, fr = lane & 15, fq = lane >> 4;
    const int K = g.K, nt = K / BK;
    unsigned voffA[2], voffB[2];
#pragma unroll
    for (int i = 0; i < 2; ++i) { int R, C; stage_rc(tid * 16 + i * 8192, R, C); const int Rb = Epi::PERM ? ((R & ~31) + perm32(R & 31)) : R;
        voffA[i] = (unsigned)(R * g.lda + C) * 2u; voffB[i] = (unsigned)(Rb * g.ldb + C) * 2u; }
    const size_t kstep = (size_t)(BK * 2);
    const size_t hstepA = (size_t)HALF * g.lda * 2, hstepB = (size_t)HALF * g.ldb * 2;
    const size_t tstepA = 2 * hstepA, tstepB = 2 * hstepB;
    const unsigned ldsw = (unsigned)wid * 1024u;
    const int aoff = lds_byte(wr * 64 + fr, fq * 8), boff = lds_byte(wc * 32 + fr, fq * 8);
#define PG8_SA(b, h) (((b) * 2 + (h)) * HTB)
#define PG8_SB(b, h) ((4 + (b) * 2 + (h)) * HTB)
#define PG8_STAGE(bufoff, gbase, voff) do { _Pragma("unroll") for (int _i = 0; _i < 2; ++_i) \
        __builtin_amdgcn_global_load_lds((const unsigned*)((const char*)(gbase) + (voff)[_i]), (PG8_LAS unsigned*)(lds + (bufoff) + ldsw + _i * 8192), 16, 0, 0); } while (0)
#define PG8_LDA(dst, b, h) do { _Pragma("unroll") for (int m = 0; m < 4; ++m) _Pragma("unroll") for (int k = 0; k < 2; ++k) dst[m][k] = *(const PG8_LAS bf16x8*)(lds + PG8_SA(b, h) + aoff + m * 2048 + k * 1024); } while (0)
#define PG8_LDB(dst, b, h) do { _Pragma("unroll") for (int n = 0; n < 2; ++n) _Pragma("unroll") for (int k = 0; k < 2; ++k) dst[n][k] = *(const PG8_LAS bf16x8*)(lds + PG8_SB(b, h) + boff + n * 2048 + k * 1024); } while (0)
#define PG8_MMA(ai, bj, At, Bt) do { __builtin_amdgcn_s_setprio(1); _Pragma("unroll") for (int m = 0; m < 4; ++m) _Pragma("unroll") for (int n = 0; n < 2; ++n) _Pragma("unroll") for (int k = 0; k < 2; ++k) \
        acc[ai][bj][m][n] = __builtin_amdgcn_mfma_f32_16x16x32_bf16(Bt[n][k], At[m][k], acc[ai][bj][m][n], 0, 0, 0); __builtin_amdgcn_s_setprio(0); } while (0)
#define PG8_WAIT_V(n) asm volatile("s_waitcnt vmcnt(" #n ")" ::: "memory")
#define PG8_WAIT_L(n) asm volatile("s_waitcnt lgkmcnt(" #n ")" ::: "memory")
#define PG8_BAR __builtin_amdgcn_s_barrier()
#define PG8_SCHED __builtin_amdgcn_sched_barrier(0)
    Unit cur, nxt; int ui = 0;
    if (!S.next(0, cur)) return;
    f32x4 acc[2][2][4][2];
#pragma unroll
    for (int a = 0; a < 2; ++a)
#pragma unroll
        for (int b = 0; b < 2; ++b)
#pragma unroll
            for (int m = 0; m < 4; ++m)
#pragma unroll
                for (int n = 0; n < 2; ++n) acc[a][b][m][n] = (f32x4){0.f, 0.f, 0.f, 0.f};
    bf16x8 At[4][2], B0[2][2], B1[2][2];
    const char* cA = (const char*)g.A + (size_t)cur.pm * tstepA + (size_t)cur.aoff * 2; const char* cB = (const char*)g.Bt + (size_t)cur.pn * tstepB;
    PG8_STAGE(PG8_SB(0, 0), cB, voffB); PG8_STAGE(PG8_SB(0, 1), cB + hstepB, voffB); PG8_STAGE(PG8_SA(0, 0), cA, voffA); PG8_STAGE(PG8_SA(0, 1), cA + hstepA, voffA);
    if (wr == 1) PG8_BAR;
    PG8_WAIT_V(2); PG8_BAR;
    PG8_STAGE(PG8_SB(1, 0), cB + kstep, voffB); PG8_STAGE(PG8_SA(1, 0), cA + kstep, voffA); PG8_STAGE(PG8_SB(1, 1), cB + hstepB + kstep, voffB);
    PG8_WAIT_V(6); PG8_BAR;
    for (;;) {
        const bool has_next = S.next(ui + 1, nxt);
        const char* nA = has_next ? (const char*)g.A + (size_t)nxt.pm * tstepA + (size_t)nxt.aoff * 2 : cA; const char* nB = has_next ? (const char*)g.Bt + (size_t)nxt.pn * tstepB : cB;
        for (int t = 0; t < nt; t += 2) {
            if constexpr (Epi::MIDK) { if (t != 0 && (t & 3) == 0) E.mid(acc, cur, t >> 2, wr, wc); }
            const bool last = (t == nt - 2);
            const char* a1 = cA + (size_t)(t + 1) * kstep;
            const char* a2 = last ? nA : cA + (size_t)(t + 2) * kstep; const char* b2 = last ? nB : cB + (size_t)(t + 2) * kstep;
            const char* a3 = a2 + kstep; const char* b3 = b2 + kstep;
            PG8_LDB(B0, 0, 0); PG8_LDB(B1, 0, 1); PG8_SCHED; PG8_LDA(At, 0, 0); PG8_STAGE(PG8_SA(1, 1), a1 + hstepA, voffA);
            PG8_WAIT_V(8); PG8_WAIT_L(0); PG8_BAR; PG8_MMA(0, 0, At, B0); PG8_MMA(0, 1, At, B1); PG8_BAR; PG8_SCHED;
            PG8_LDA(At, 0, 1); PG8_STAGE(PG8_SB(0, 0), b2, voffB); PG8_STAGE(PG8_SB(0, 1), b2 + hstepB, voffB); PG8_STAGE(PG8_SA(0, 0), a2, voffA);
            PG8_WAIT_V(8); PG8_WAIT_L(0); PG8_BAR; PG8_MMA(1, 0, At, B0); PG8_MMA(1, 1, At, B1); PG8_BAR; PG8_SCHED;
            PG8_LDB(B0, 1, 0); PG8_LDB(B1, 1, 1); PG8_SCHED; PG8_LDA(At, 1, 0); PG8_STAGE(PG8_SA(0, 1), a2 + hstepA, voffA);
            PG8_WAIT_V(8); PG8_WAIT_L(0); PG8_BAR; PG8_MMA(0, 0, At, B0); PG8_MMA(0, 1, At, B1); PG8_BAR; PG8_SCHED;
            PG8_LDA(At, 1, 1); PG8_STAGE(PG8_SB(1, 0), b3, voffB); PG8_STAGE(PG8_SB(1, 1), b3 + hstepB, voffB); PG8_STAGE(PG8_SA(1, 0), a3, voffA);
            PG8_WAIT_V(8); PG8_WAIT_L(0); PG8_BAR; PG8_MMA(1, 0, At, B0); PG8_MMA(1, 1, At, B1); PG8_BAR; PG8_SCHED;
        }
        if constexpr (ALIGN_EPI) { if (wr == 0) PG8_BAR; }
        { unsigned z2_ = 0u; asm volatile("" : "+v"(z2_)); const int l2_ = (int)__builtin_amdgcn_mbcnt_hi(~0u, __builtin_amdgcn_mbcnt_lo(~0u, z2_));
          E(acc, cur, wr, wc, l2_ & 15, l2_ >> 4); }
        if (!has_next) break;
#pragma unroll
        for (int a = 0; a < 2; ++a)
#pragma unroll
            for (int b = 0; b < 2; ++b)
#pragma unroll
                for (int m = 0; m < 4; ++m)
#pragma unroll
                    for (int n = 0; n < 2; ++n) acc[a][b][m][n] = (f32x4){0.f, 0.f, 0.f, 0.f};
        cur = nxt; cA = nA; cB = nB; ++ui;
        if constexpr (ALIGN_EPI) { if (wr == 1) PG8_BAR; }
    }
    PG8_WAIT_V(0);
    if constexpr (!ALIGN_EPI) { if (wr == 0) PG8_BAR; }
    PG8_BAR;
#undef PG8_SA
#undef PG8_SB
#undef PG8_STAGE
#undef PG8_LDA
#undef PG8_LDB
#undef PG8_MMA
#undef PG8_WAIT_V
#undef PG8_WAIT_L
#undef PG8_BAR
#undef PG8_SCHED
}

struct EpiBf16 {
    static constexpr bool PERM = true, MIDK = false;
    bf16_t* O; int ldc; int ntn;
    __device__ __forceinline__ void operator()(const f32x4 (&acc)[2][2][4][2], const Unit& u, int wr, int wc, int fr, int fq) const {
        const int row0 = u.pm * BM + wr * 64 + fr, col0 = (u.pn % ntn) * BM + wc * 32 + 8 * fq;
#pragma unroll
        for (int ai = 0; ai < 2; ++ai)
#pragma unroll
            for (int m = 0; m < 4; ++m) { bf16_t* rowp = O + (size_t)(row0 + ai * HALF + m * 16) * ldc + col0;
#pragma unroll
                for (int bj = 0; bj < 2; ++bj) { const f32x4 v0 = acc[ai][bj][m][0], v1 = acc[ai][bj][m][1];
                    u32x4 w; w.x = cvt_pk_bf16(v0[0], v0[1]); w.y = cvt_pk_bf16(v0[2], v0[3]); w.z = cvt_pk_bf16(v1[0], v1[1]); w.w = cvt_pk_bf16(v1[2], v1[3]);
                    *(u32x4*)(rowp + bj * HALF) = w; } }
    }
};
struct EpiF32 {
    static constexpr bool PERM = false, MIDK = false;
    float* C; int ldc; int ntn;
    __device__ __forceinline__ void operator()(const f32x4 (&acc)[2][2][4][2], const Unit& u, int wr, int wc, int fr, int fq) const {
        const int row0 = u.pm * BM + wr * 64 + fr, col0 = (u.pn % ntn) * BM + wc * 32 + 4 * fq;
#pragma unroll
        for (int ai = 0; ai < 2; ++ai)
#pragma unroll
            for (int m = 0; m < 4; ++m) { float* rowp = C + (size_t)(row0 + ai * HALF + m * 16) * ldc + col0;
#pragma unroll
                for (int bj = 0; bj < 2; ++bj)
#pragma unroll
                    for (int n = 0; n < 2; ++n) *(f32x4*)(rowp + bj * HALF + n * 16) = acc[ai][bj][m][n]; }
    }
};
struct EpiSwiglu {
    static constexpr bool PERM = true, MIDK = false;
    bf16_t* O; int ldc; int ntn;
    __device__ __forceinline__ void operator()(const f32x4 (&acc)[2][2][4][2], const Unit& u, int wr, int wc, int fr, int fq) const {
        const int row0 = u.pm * BM + wr * 64 + fr, col0 = (u.pn % ntn) * 128 + wc * 16 + 4 * fq;
#pragma unroll
        for (int ai = 0; ai < 2; ++ai)
#pragma unroll
            for (int m = 0; m < 4; ++m) { bf16_t* rowp = O + (size_t)(row0 + ai * HALF + m * 16) * ldc + col0;
#pragma unroll
                for (int bj = 0; bj < 2; ++bj) { const f32x4 gt = acc[ai][bj][m][0], up = acc[ai][bj][m][1];
                    float h[4];
#pragma unroll
                    for (int e = 0; e < 4; ++e) h[e] = gt[e] * __builtin_amdgcn_rcpf(1.0f + __expf(-gt[e])) * up[e];
                    u32x2 w; w.x = cvt_pk_bf16(h[0], h[1]); w.y = cvt_pk_bf16(h[2], h[3]);
                    *(u32x2*)(rowp + bj * 64) = w; } }
    }
};
struct EpiBranch {
    static constexpr bool PERM = true, MIDK = false;
    const bf16_t* proj; float* MP; bf16_t* MB;
    __device__ __forceinline__ void operator()(const f32x4 (&acc)[2][2][4][2], const Unit& u, int wr, int wc, int fr, int fq) const {
        const int g = u.tag; const int row0 = u.pm * BM + wr * 64 + fr, col0 = (u.pn & 3) * BM + wc * 32 + 8 * fq;
#pragma unroll
        for (int ai = 0; ai < 2; ++ai)
#pragma unroll
            for (int m = 0; m < 4; ++m) { const size_t row = (size_t)(row0 + ai * HALF + m * 16);
#pragma unroll
                for (int bj = 0; bj < 2; ++bj) { const int col = col0 + bj * HALF;
                    const u32x4 gw = *(const u32x4*)(proj + row * PW + P_GATE + g * 1024 + col);
                    float gv[8];
#pragma unroll
                    for (int e = 0; e < 4; ++e) { const unsigned w = gw[e]; gv[2 * e] = __builtin_bit_cast(float, w << 16); gv[2 * e + 1] = __builtin_bit_cast(float, w & 0xffff0000u); }
                    f32x4 v0 = acc[ai][bj][m][0], v1 = acc[ai][bj][m][1];
#pragma unroll
                    for (int e = 0; e < 4; ++e) { v0[e] *= __builtin_amdgcn_rcpf(1.0f + __expf(-gv[e])); v1[e] *= __builtin_amdgcn_rcpf(1.0f + __expf(-gv[4 + e])); }
                    float* mp = MP + row * D + col;
                    if (g > 0) { v0 += *(const f32x4*)mp; v1 += *(const f32x4*)(mp + 4); }
                    if (g < 3) { *(f32x4*)mp = v0; *(f32x4*)(mp + 4) = v1; }
                    else { u32x4 w; w.x = cvt_pk_bf16(v0[0], v0[1]); w.y = cvt_pk_bf16(v0[2], v0[3]); w.z = cvt_pk_bf16(v1[0], v1[1]); w.w = cvt_pk_bf16(v1[2], v1[3]);
                        *(u32x4*)(MB + row * D + col) = w; } } }
    }
};
struct EpiBranchK {
    static constexpr bool PERM = true, MIDK = true;
    const bf16_t* proj; bf16_t* MB;
    __device__ __forceinline__ static float em(float x) { return fminf(__expf(-x), 1e20f); }
    __device__ __forceinline__ void mid(f32x4 (&acc)[2][2][4][2], const Unit& u, int gnext, int wr, int wc) const {
        unsigned z_ = 0u; asm volatile("" : "+v"(z_)); const int l_ = (int)__builtin_amdgcn_mbcnt_hi(~0u, __builtin_amdgcn_mbcnt_lo(~0u, z_)); const int fr = l_ & 15, fq = l_ >> 4;
        const int row0 = u.pm * BM + wr * 64 + fr, col0 = u.pn * BM + wc * 32 + 8 * fq;
#pragma unroll
        for (int ai = 0; ai < 2; ++ai)
#pragma unroll
            for (int m = 0; m < 4; ++m) { const bf16_t* gp = proj + (size_t)(row0 + ai * HALF + m * 16) * PW + P_GATE + (gnext - 1) * 1024 + col0;
#pragma unroll
                for (int bj = 0; bj < 2; ++bj) { const u32x4 g0 = *(const u32x4*)(gp + bj * HALF), g1 = *(const u32x4*)(gp + 1024 + bj * HALF);
#pragma unroll
                    for (int e = 0; e < 4; ++e) { const unsigned a = g0[e], b = g1[e];
                        const float ra = (1.0f + em(__builtin_bit_cast(float, b << 16))) * __builtin_amdgcn_rcpf(1.0f + em(__builtin_bit_cast(float, a << 16)));
                        const float rb = (1.0f + em(__builtin_bit_cast(float, b & 0xffff0000u))) * __builtin_amdgcn_rcpf(1.0f + em(__builtin_bit_cast(float, a & 0xffff0000u)));
                        if (e < 2) { acc[ai][bj][m][0][2 * e] *= ra; acc[ai][bj][m][0][2 * e + 1] *= rb; } else { acc[ai][bj][m][1][2 * (e - 2)] *= ra; acc[ai][bj][m][1][2 * (e - 2) + 1] *= rb; } } } }
    }
    __device__ __forceinline__ void operator()(const f32x4 (&acc)[2][2][4][2], const Unit& u, int wr, int wc, int fr, int fq) const {
        const int row0 = u.pm * BM + wr * 64 + fr, col0 = u.pn * BM + wc * 32 + 8 * fq;
#pragma unroll
        for (int ai = 0; ai < 2; ++ai)
#pragma unroll
            for (int m = 0; m < 4; ++m) { const size_t row = (size_t)(row0 + ai * HALF + m * 16);
#pragma unroll
                for (int bj = 0; bj < 2; ++bj) { const u32x4 gw = *(const u32x4*)(proj + row * PW + P_GATE + 3 * 1024 + col0 + bj * HALF);
                    float sg[8];
#pragma unroll
                    for (int e = 0; e < 4; ++e) { sg[2 * e] = __builtin_amdgcn_rcpf(1.0f + em(__builtin_bit_cast(float, gw[e] << 16))); sg[2 * e + 1] = __builtin_amdgcn_rcpf(1.0f + em(__builtin_bit_cast(float, gw[e] & 0xffff0000u))); }
                    const f32x4 v0 = acc[ai][bj][m][0], v1 = acc[ai][bj][m][1];
                    u32x4 w; w.x = cvt_pk_bf16(v0[0] * sg[0], v0[1] * sg[1]); w.y = cvt_pk_bf16(v0[2] * sg[2], v0[3] * sg[3]); w.z = cvt_pk_bf16(v1[0] * sg[4], v1[1] * sg[5]); w.w = cvt_pk_bf16(v1[2] * sg[6], v1[3] * sg[7]);
                    *(u32x4*)(MB + row * D + col0 + bj * HALF) = w; } }
    }
};
struct BranchOrder {
    int G, c;
    __device__ bool next(int i, Unit& u) const {
        const int tile = (i >> 2) * G + c; if (tile >= 256) return false;
        const int g = i & 3; u.pm = tile >> 2; u.pn = g * 4 + (tile & 3); u.aoff = g * 256; u.tag = g; return true;
    }
};
template <int NTC> struct MoeOrder {
    static constexpr int NT = NTC; int G, c, ntiles; int t1, t2, t3, t4, t5, t6, t7;
    __device__ __forceinline__ void init(const unsigned* cnt, int G_, int c_) { G = G_; c = (G_ % 8 == 0) ? (c_ % 8) * (G_ / 8) + c_ / 8 : c_;
        int o = ((int)cnt[0] + 255) >> 8; t1 = o; o += ((int)cnt[1] + 255) >> 8; t2 = o; o += ((int)cnt[2] + 255) >> 8; t3 = o; o += ((int)cnt[3] + 255) >> 8; t4 = o;
        o += ((int)cnt[4] + 255) >> 8; t5 = o; o += ((int)cnt[5] + 255) >> 8; t6 = o; o += ((int)cnt[6] + 255) >> 8; t7 = o; o += ((int)cnt[7] + 255) >> 8; ntiles = o; }
    __device__ __forceinline__ bool next(int i, Unit& u) const {
        const int L = i * G + c; if (L >= ntiles * NT) return false;
        const int tau = L / NT, pn = L % NT;
        const int e = (tau >= t1) + (tau >= t2) + (tau >= t3) + (tau >= t4) + (tau >= t5) + (tau >= t6) + (tau >= t7);
        u.pm = tau; u.pn = e * NT + pn; u.aoff = 0; u.tag = e; return true;
    }
};
}
typedef GAS unsigned gu32;
#define RLX_AGENT __ATOMIC_RELAXED, __HIP_MEMORY_SCOPE_AGENT
#define XB_TMO      128
#define XB_XCNT(j)  (256  + 64 * (j))
#define XB_XSUB(j)  (1280 + 64 * (j))
#define XB_XGEN(j)  (2304 + 64 * (j))
#define XB_TOP      3328
#define XB_TOPGEN   3392
#define XCD_BAR_WORDS 3456
#define XB_SPIN_CAP (1u << 18)

__device__ __forceinline__ unsigned xb_ld(unsigned* p)              { return __hip_atomic_load(p, __ATOMIC_RELAXED, __HIP_MEMORY_SCOPE_AGENT); }
__device__ __forceinline__ unsigned xb_add(unsigned* p, unsigned v) { return __hip_atomic_fetch_add(p, v, __ATOMIC_RELAXED, __HIP_MEMORY_SCOPE_AGENT); }
__device__ __forceinline__ unsigned xb_xcc_id() { return (unsigned)__builtin_amdgcn_s_getreg((3 << 11) | 20) & 0xFu; }
#define XB_SPIN(cond, bar) do { unsigned _sp = 0; while (cond) { __builtin_amdgcn_s_sleep(1); \
    if ((++_sp & 255u) == 0u) { if (xb_ld(&(bar)[XB_TMO])) break; if (_sp > XB_SPIN_CAP) { atomicAdd(&(bar)[XB_TMO], 1u); break; } } } } while (0)

struct XcdBarrier {
    unsigned* bar; unsigned x;
    volatile LAS unsigned* st;
};

__device__ __forceinline__ XcdBarrier xcd_barrier_post(unsigned* bar, volatile LAS unsigned* st) {
    XcdBarrier b; b.bar = bar; b.x = xb_xcc_id(); b.st = st;
    if (threadIdx.x == 0) (void)xb_add(&bar[XB_XCNT(b.x)], 1u);
    return b;
}
__device__ __forceinline__ void xcd_barrier_complete(unsigned* bar, unsigned x, unsigned& nloc, unsigned& nx) {
    const unsigned G = gridDim.x * gridDim.y * gridDim.z;
    unsigned sum, cnt, mine, sp = 0u;
    for (;;) {
        sum = 0u; cnt = 0u; mine = 0u;
#pragma unroll
        for (unsigned j = 0; j < 16; ++j) { const unsigned c = xb_ld(&bar[XB_XCNT(j)]); sum += c; cnt += (c > 0u) ? 1u : 0u; mine = (j == x) ? c : mine; }
        if (sum == G) break;
        __builtin_amdgcn_s_sleep(1);
        if ((++sp & 255u) == 0u) { if (xb_ld(&bar[XB_TMO])) break; if (sp > XB_SPIN_CAP) { atomicAdd(&bar[XB_TMO], 1u); break; } }
    }
    nloc = mine > 0u ? mine : 1u; nx = cnt > 0u ? cnt : 1u;
}

__device__ __forceinline__ void xcd_barrier(const XcdBarrier& b) {
    asm volatile("s_waitcnt vmcnt(0)" ::: "memory");
    __syncthreads();
    if (threadIdx.x == 0) {
        unsigned* bar = b.bar;
        __builtin_amdgcn_s_waitcnt(0);
        unsigned nloc = b.st[0], nx = b.st[1];
        if (nloc == 0u) { xcd_barrier_complete(bar, b.x, nloc, nx); b.st[0] = nloc; b.st[1] = nx; }
        const unsigned old = xb_add(&bar[XB_XSUB(b.x)], 1u);
        const unsigned gen = old / nloc;
        if (old + 1u == (gen + 1u) * nloc) {
            __builtin_amdgcn_fence(__ATOMIC_RELEASE, "agent");
            asm volatile("s_waitcnt vmcnt(0)" ::: "memory");
            const unsigned og = xb_add(&bar[XB_TOP], 1u);
            const unsigned tg = og / nx;
            if (og + 1u == (tg + 1u) * nx) xb_add(&bar[XB_TOPGEN], 1u);
            else XB_SPIN(xb_ld(&bar[XB_TOPGEN]) == tg, bar);
            __builtin_amdgcn_fence(__ATOMIC_ACQUIRE, "agent");
            xb_add(&bar[XB_XGEN(b.x)], 1u);
            asm volatile("s_waitcnt vmcnt(0)" ::: "memory");
        } else {
            XB_SPIN(xb_ld(&bar[XB_XGEN(b.x)]) == gen, bar);
            __builtin_amdgcn_fence(__ATOMIC_ACQUIRE, "agent");
            asm volatile("s_waitcnt vmcnt(0)" ::: "memory");
        }
    }
    __syncthreads();
}
struct Args { const void* in[40]; float* out; unsigned char* ws; int ph_lo, ph_hi; };
typedef const __attribute__((address_space(4))) Args* ArgsP;
__device__ __forceinline__ ArgsP fresh_args() { ArgsP p = (ArgsP)__builtin_amdgcn_kernarg_segment_ptr(); asm volatile("" : "+s"(p)); return p; }

struct Frame {
    LAS unsigned char* lds;
    int wave, G, gw, NGW;
    __device__ __forceinline__ int lane() const { unsigned z = 0u; asm volatile("" : "+v"(z)); return (int)__builtin_amdgcn_mbcnt_hi(~0u, __builtin_amdgcn_mbcnt_lo(~0u, z)); }
};

__device__ __forceinline__ Frame fresh(const Frame& F) { Frame R = F; asm volatile("" : "+s"(R.wave), "+s"(R.G), "+s"(R.gw), "+s"(R.NGW)); return R; }
#define LDS_WAIT() asm volatile("s_waitcnt lgkmcnt(0)" ::: "memory")

__device__ __forceinline__ void p0_mod_items(Frame& F, const float* c, const float* ada_w, const float* ada_b, float* mod) {
    LAS float* part = (LAS float*)F.lds;
    LAS float* cs = (LAS float*)(F.lds + 98304);
    int tid_ = F.wave * 64 + F.lane(); asm volatile("" : "+v"(tid_)); const int lane_ = tid_ & 63;
    if ((int)blockIdx.x >= 192) return;
    for (int i = tid_; i < 8192; i += NTHR) cs[i] = siluf(c[i]);
    __syncthreads();
    for (int it = blockIdx.x; it < 192; it += F.G) {
        const int l = it / 96, j0 = (it % 96) * 64;
        float acc[8];
#pragma unroll
        for (int b = 0; b < 8; ++b) acc[b] = 0.f;
        const float* w = ada_w + (size_t)l * 1024 * 6144 + j0 + lane_;
        const int k0 = F.wave * 128;
#pragma unroll 1
        for (int kb = 0; kb < 128; kb += 16) { float wv[16];
#pragma unroll
            for (int q = 0; q < 16; ++q) wv[q] = w[(size_t)(k0 + kb + q) * 6144];
#pragma unroll
            for (int q4 = 0; q4 < 4; ++q4)
#pragma unroll
                for (int b = 0; b < 8; ++b) { const pg8::f32x4 cv = *(const LAS pg8::f32x4*)(cs + b * 1024 + k0 + kb + 4 * q4);
                    acc[b] += (cv[0] * wv[4 * q4] + cv[1] * wv[4 * q4 + 1]) + (cv[2] * wv[4 * q4 + 2] + cv[3] * wv[4 * q4 + 3]); } }
#pragma unroll
        for (int b = 0; b < 8; ++b) part[(F.wave * 8 + b) * 64 + lane_] = acc[b];
        __syncthreads();
        { const int b = tid_ >> 6, col = tid_ & 63; float s = 0.f;
#pragma unroll
          for (int w8 = 0; w8 < 8; ++w8) s += part[(w8 * 8 + b) * 64 + col];
          mod[(size_t)(l * 8 + b) * 6144 + j0 + col] = s + ada_b[l * 6144 + j0 + col]; }
        __syncthreads();
    }
}
struct CvtDesc { const float* colp; size_t Ns; bf16_t* WT; int Kd, n0, k0; };
__device__ __forceinline__ void cvt_load(const CvtDesc& d, pg8::f32x4 (&v)[8], int lane) {
    const int kr = lane >> 3;
#pragma unroll
    for (int i = 0; i < 8; ++i) v[i] = d.colp ? *(const pg8::f32x4*)(d.colp + (size_t)(d.k0 + 8 * i + kr) * d.Ns) : (pg8::f32x4){0.f, 0.f, 0.f, 0.f};
}
__device__ __forceinline__ void cvt_store(const CvtDesc& d, const pg8::f32x4 (&v)[8], LAS float* scr, int lane) {
    const int q4 = 4 * (lane & 7), kr = lane >> 3;
#pragma unroll
    for (int i = 0; i < 8; ++i)
#pragma unroll
        for (int e = 0; e < 4; ++e) scr[(8 * i + kr) * 33 + q4 + e] = v[i][e];
    LDS_WAIT(); asm volatile("" ::: "memory");
    const int cidx = lane & 7;
#pragma unroll
    for (int j = 0; j < 4; ++j) { const int n = (lane >> 3) + 8 * j; const LAS float* s = scr + (8 * cidx) * 33 + n;
        pg8::u32x4 o; o.x = pk2(s[0 * 33], s[1 * 33]); o.y = pk2(s[2 * 33], s[3 * 33]); o.z = pk2(s[4 * 33], s[5 * 33]); o.w = pk2(s[6 * 33], s[7 * 33]);
        *(pg8::u32x4*)(d.WT + (size_t)(d.n0 + n) * d.Kd + d.k0 + 8 * cidx) = o; }
    LDS_WAIT(); asm volatile("" ::: "memory");
}
__device__ __forceinline__ int win_src_col(int v) { return v < 768 ? v : (v < 7168 ? v + 16 : (v < 7184 ? v - 6400 : -1)); }

__device__ __forceinline__ CvtDesc p0_desc(ArgsP a, int it, int n) {
    const float* w_in = (const float*)a->in[9]; const float* w_branch = (const float*)a->in[30]; const float* w_out = (const float*)a->in[31];
    const float* wg = (const float*)a->in[32]; const float* wu = (const float*)a->in[33]; const float* wd = (const float*)a->in[34];
    bf16_t* WIN = (bf16_t*)(a->ws + WS_WIN); bf16_t* WB = (bf16_t*)(a->ws + WS_WB); bf16_t* WO = (bf16_t*)(a->ws + WS_WO); bf16_t* WF1 = (bf16_t*)(a->ws + WS_WF1); bf16_t* WF2 = (bf16_t*)(a->ws + WS_WF2);
    bf16_t* LR = (bf16_t*)(a->ws + WS_LR);
    constexpr int I_IN = 2 * 232 * 16, I_B = 2 * 4 * 32 * 4, I_O = 2 * 32 * 16, I_F1 = 176 * 16, I_F2 = 32 * 44;
    int r = it;
    if (r < I_IN) { const int l = r / (232 * 16), q = r % (232 * 16), nb = q / 16, kb = q % 16; const int sc = win_src_col(nb * 32 + n);
        return CvtDesc{sc >= 0 ? w_in + (size_t)l * 1024 * NIN + sc : nullptr, (size_t)NIN, WIN + (size_t)l * PW * 1024, 1024, nb * 32, kb * 64}; } r -= I_IN;
    if (r < I_B) { const int lg = r / 128, q = r % 128, nb = q / 4, kb = q % 4;
        const int g = lg & 3, l = lg >> 2;
        return CvtDesc{w_branch + (size_t)lg * 256 * 1024 + nb * 32 + n - (size_t)g * 256 * 1024, 1024, WB + (size_t)l * 1024 * 1024, 1024, nb * 32, g * 256 + kb * 64}; } r -= I_B;
    if (r < I_O) { const int l = r / 512, q = r % 512, nb = q / 16, kb = q % 16;
        return CvtDesc{w_out + (size_t)l * 1024 * 1024 + nb * 32 + n, 1024, WO + (size_t)l * 1024 * 1024, 1024, nb * 32, kb * 64}; } r -= I_O;
    if (r < I_F1) { const int nb = r / 16, kb = r % 16; const int v = nb * 32 + n; const int up = (v >> 2) & 1, j = (v >> 3) * 4 + (v & 3);
        return CvtDesc{(up ? wu : wg) + j, (size_t)DFF, WF1, 1024, nb * 32, kb * 64}; } r -= I_F1;
    if (r < I_F2) { const int nb = r / 44, kb = r % 44;
        return CvtDesc{wd + nb * 32 + n, 1024, WF2, DFF, nb * 32, kb * 64}; } r -= I_F2;
    if (r < 16) { const int l = r >> 3, nb = r & 7; return CvtDesc{(const float*)a->in[21] + l * 64 * 256 + nb * 32 + n, 256, LR + l * 256 * 64, 64, nb * 32, 0}; } r -= 16;
    if (r < 16) { const int l = r >> 3, nb = r & 7; return CvtDesc{(const float*)a->in[23] + l * 64 * 256 + nb * 32 + n, 256, LR + 2 * 256 * 64 + l * 256 * 64, 64, nb * 32, 0}; } r -= 16;
    { const int l = r >> 4, nb = (r >> 1) & 7, kb = r & 1; return CvtDesc{(const float*)a->in[24] + l * 128 * 256 + nb * 32 + n, 256, LR + 4 * 256 * 64 + l * 256 * 128, 128, nb * 32, kb * 64}; }
}
__device__ __forceinline__ void p0_convert(Frame& F, ArgsP a) {
    LAS float* scr = (LAS float*)(F.lds + 16384 + F.wave * 8704);
    constexpr int NITEMS = 2 * 232 * 16 + 2 * 4 * 32 * 4 + 2 * 32 * 16 + 176 * 16 + 32 * 44 + 64;
    int lane_ = F.lane(); asm volatile("" : "+v"(lane_));
    const int n = 4 * (lane_ & 7);
    int it = F.gw; if (it >= NITEMS) return;
    CvtDesc cur = p0_desc(a, it, n); pg8::f32x4 v[8]; cvt_load(cur, v, lane_);
    for (;;) { const int nx = it + F.NGW; const bool more = nx < NITEMS;
        CvtDesc nd = cur; pg8::f32x4 w[8];
        if (more) { nd = p0_desc(a, nx, n); cvt_load(nd, w, lane_); }
        cvt_store(cur, v, scr, lane_);
        if (!more) break;
#pragma unroll
        for (int i = 0; i < 8; ++i) v[i] = w[i];
        cur = nd; it = nx; }
}

__device__ __forceinline__ void row_load(const float* p, pg8::f32x4 (&v)[4], int lane) {
#pragma unroll
    for (int j = 0; j < 4; ++j) v[j] = *(const pg8::f32x4*)(p + 4 * lane + 256 * j);
}
__device__ __forceinline__ float row_ss(const pg8::f32x4 (&v)[4]) {
    float s = 0.f;
#pragma unroll
    for (int j = 0; j < 4; ++j) s += (v[j][0] * v[j][0] + v[j][1] * v[j][1]) + (v[j][2] * v[j][2] + v[j][3] * v[j][3]);
    return wave_sum(s);
}
__device__ __forceinline__ void row_normmod(const pg8::f32x4 (&x)[4], const float* g, const float* mb, int sh_off, int sc_off, bf16_t* hrow, pg8::f32x4 (&hv)[4], int lane) {
    const float rstd = rsqrtf(row_ss(x) * (1.0f / D) + 1e-6f);
#pragma unroll
    for (int j = 0; j < 4; ++j) { const int d = 4 * lane + 256 * j;
        const pg8::f32x4 gg = *(const pg8::f32x4*)(g + d), sc = *(const pg8::f32x4*)(mb + sc_off + d), sh = *(const pg8::f32x4*)(mb + sh_off + d);
        hv[j] = x[j] * rstd * gg * (1.0f + sc) + sh;
        pg8::u32x2 w; w.x = pk2(hv[j][0], hv[j][1]); w.y = pk2(hv[j][2], hv[j][3]);
        *(pg8::u32x2*)(hrow + d) = w; }
}
template <int CTRL, int ROWMASK> __device__ __forceinline__ float dpp_mov_p(float old, float x) {
    return __builtin_bit_cast(float, __builtin_amdgcn_update_dpp(__builtin_bit_cast(int, old), __builtin_bit_cast(int, x), CTRL, ROWMASK, 0xF, false)); }
__device__ __forceinline__ float wave_sum63p(float x) {
    x += dpp_mov_p<0xB1, 0xF>(0.f, x); x += dpp_mov_p<0x4E, 0xF>(0.f, x); x += dpp_mov_p<0x141, 0xF>(0.f, x); x += dpp_mov_p<0x140, 0xF>(0.f, x);
    x += dpp_mov_p<0x142, 0xA>(0.f, x); x += dpp_mov_p<0x143, 0xC>(0.f, x); return x; }
__device__ __forceinline__ void stage_wz(const float* w_in_l, LAS float* wz, int tid) {
    for (int i = tid; i < 1024 * 4; i += NTHR) { const int d = i >> 2, q = i & 3; const pg8::f32x4 w = *(const pg8::f32x4*)(w_in_l + (size_t)d * NIN + 768 + 4 * q);
        wz[(4 * q) * 1024 + d] = w[0]; wz[(4 * q + 1) * 1024 + d] = w[1]; wz[(4 * q + 2) * 1024 + d] = w[2]; wz[(4 * q + 3) * 1024 + d] = w[3]; }
    __syncthreads();
}
__device__ __forceinline__ void row_gz(const pg8::f32x4 (&hv)[4], const LAS float* wz, bf16_t* gzrow, int lane) {
    float mine = 0.f;
#pragma unroll
    for (int o = 0; o < 16; ++o) { float acc = 0.f;
#pragma unroll
        for (int j = 0; j < 4; ++j) { const pg8::f32x4 w = *(const LAS pg8::f32x4*)(wz + o * 1024 + 4 * lane + 256 * j); acc += (hv[j][0] * w[0] + hv[j][1] * w[1]) + (hv[j][2] * w[2] + hv[j][3] * w[3]); }
        const float s = __builtin_bit_cast(float, __builtin_amdgcn_readlane(__builtin_bit_cast(int, wave_sum63p(acc)), 63)); if (lane == o) mine = s; }
    if (lane < 16) gzrow[lane] = (bf16_t)f2bf(mine);
}
__device__ __forceinline__ void ph_h0(Frame& F, ArgsP a) {
    const float* x = (const float*)a->in[0]; const float* g = (const float*)a->in[5]; const float* mod = (const float*)(a->ws + WS_MOD); bf16_t* H = (bf16_t*)(a->ws + WS_HB);
    bf16_t* GZ = (bf16_t*)(a->ws + WS_GZ); LAS float* wz = (LAS float*)F.lds;
    int lane0 = F.lane(); asm volatile("" : "+v"(lane0));
    stage_wz((const float*)a->in[9], wz, F.wave * 64 + lane0);
    int row = F.gw; if (row >= M) return;
    pg8::f32x4 xn[4]; row_load(x + (size_t)row * D, xn, lane0);
    for (;;) { int lane = lane0; asm volatile("" : "+v"(lane)); pg8::f32x4 xv[4], hv[4];
#pragma unroll
        for (int j = 0; j < 4; ++j) xv[j] = xn[j];
        const int nrow = row + F.NGW; if (nrow < M) row_load(x + (size_t)nrow * D, xn, lane);
        row_normmod(xv, g, mod + (size_t)(row / T) * 6144, 0, 1024, H + (size_t)row * D, hv, lane);
        row_gz(hv, wz, GZ + (size_t)row * 16, lane);
        if (nrow >= M) break; row = nrow; }
}
__device__ __forceinline__ void row_y_load(const bf16_t* y, const bf16_t* eout, const unsigned* cnt, const int* toke, const int* toks, int row, int lane, pg8::f32x4 (&yv)[4], pg8::u32x2 (&e1)[4], pg8::u32x2 (&e2)[4]) {
    if (eout) {
        int roff[8]; { int o = 0;
#pragma unroll
            for (int e = 0; e < 8; ++e) { roff[e] = o; o += (((int)cnt[e] + 255) >> 8) << 8; } }
        const int x1 = toke[row * 2], x2 = toke[row * 2 + 1]; int g1 = toks[row * 2], g2 = toks[row * 2 + 1];
#pragma unroll
        for (int q = 0; q < 8; ++q) { if (q == x1) g1 += roff[q]; if (q == x2) g2 += roff[q]; }
#pragma unroll
        for (int j = 0; j < 4; ++j) { e1[j] = *(const pg8::u32x2*)(eout + (size_t)g1 * D + 4 * lane + 256 * j); e2[j] = *(const pg8::u32x2*)(eout + (size_t)g2 * D + 4 * lane + 256 * j); }
    } else {
#pragma unroll
        for (int j = 0; j < 4; ++j) e1[j] = *(const pg8::u32x2*)(y + (size_t)row * D + 4 * lane + 256 * j); }
}
__device__ __forceinline__ void ph_row(Frame& F, ArgsP a, const float* xold, const bf16_t* y, const float* gpost, const float* modl, int gt_off,
                                       const float* gpre, const float* modn, int sh_off, int sc_off, bf16_t* hdst, bool route, const bf16_t* eout = nullptr, const float* w_in_next = nullptr) {
    float* out = a->out;
    bf16_t* GZ = (bf16_t*)(a->ws + WS_GZ); LAS float* wz = (LAS float*)F.lds;
    if (w_in_next) { int t_ = F.wave * 64 + F.lane(); stage_wz(w_in_next, wz, t_); }
    const float* rw = (const float*)a->in[35]; const float* rb = (const float*)a->in[36];
    unsigned* cnt = (unsigned*)(a->ws + WS_CTL) + CW_CNT;
    int* list = (int*)(a->ws + WS_ROUTE + RT_LIST); int* toke = (int*)(a->ws + WS_ROUTE + RT_TOKE); int* toks = (int*)(a->ws + WS_ROUTE + RT_TOKS); float* tokp = (float*)(a->ws + WS_ROUTE + RT_TOKP);
    int row = F.gw; if (row >= M) return;
    int lane0 = F.lane(); asm volatile("" : "+v"(lane0));
    pg8::f32x4 yn[4], xn[4]; pg8::u32x2 e1n[4], e2n[4];
    row_y_load(y, eout, cnt, toke, toks, row, lane0, yn, e1n, e2n); row_load(xold + (size_t)row * D, xn, lane0);
    for (;;) {
        int lane = lane0; asm volatile("" : "+v"(lane));
        const int b = row / T; pg8::f32x4 yv[4], xv[4], hv[4];
        if (eout) { const float p1 = tokp[row * 2], p2 = tokp[row * 2 + 1];
#pragma unroll
            for (int j = 0; j < 4; ++j) { const pg8::u32x2 a1 = e1n[j], a2 = e2n[j];
                yv[j][0] = p1 * __builtin_bit_cast(float, a1.x << 16) + p2 * __builtin_bit_cast(float, a2.x << 16); yv[j][1] = p1 * __builtin_bit_cast(float, a1.x & 0xffff0000u) + p2 * __builtin_bit_cast(float, a2.x & 0xffff0000u);
                yv[j][2] = p1 * __builtin_bit_cast(float, a1.y << 16) + p2 * __builtin_bit_cast(float, a2.y << 16); yv[j][3] = p1 * __builtin_bit_cast(float, a1.y & 0xffff0000u) + p2 * __builtin_bit_cast(float, a2.y & 0xffff0000u); }
        } else {
#pragma unroll
            for (int j = 0; j < 4; ++j) { const pg8::u32x2 a1 = e1n[j]; yv[j][0] = __builtin_bit_cast(float, a1.x << 16); yv[j][1] = __builtin_bit_cast(float, a1.x & 0xffff0000u); yv[j][2] = __builtin_bit_cast(float, a1.y << 16); yv[j][3] = __builtin_bit_cast(float, a1.y & 0xffff0000u); } }
#pragma unroll
        for (int j = 0; j < 4; ++j) xv[j] = xn[j];
        const int nrow = row + F.NGW;
        if (nrow < M) { row_y_load(y, eout, cnt, toke, toks, nrow, lane, yn, e1n, e2n); row_load(xold + (size_t)nrow * D, xn, lane); }
        const float rstd = rsqrtf(row_ss(yv) * (1.0f / D) + 1e-6f);
        const float* mb = modl + (size_t)b * 6144;
#pragma unroll
        for (int j = 0; j < 4; ++j) { const int d = 4 * lane + 256 * j;
            const pg8::f32x4 gp = *(const pg8::f32x4*)(gpost + d), gt = *(const pg8::f32x4*)(mb + gt_off + d);
            xv[j] = xv[j] + gt * (yv[j] * rstd * gp);
            *(pg8::f32x4*)(out + (size_t)row * D + d) = xv[j]; }
        if (hdst) {
            row_normmod(xv, gpre, modn + (size_t)b * 6144, sh_off, sc_off, hdst + (size_t)row * D, hv, lane);
            if (w_in_next) row_gz(hv, wz, GZ + (size_t)row * 16, lane);
            if (route) {
                float lg[8];
#pragma unroll
                for (int e = 0; e < 8; ++e) lg[e] = 0.f;
#pragma unroll
                for (int j = 0; j < 4; ++j)
#pragma unroll
                    for (int q = 0; q < 4; ++q) { const int d = 4 * lane + 256 * j + q; const pg8::f32x4 w0 = *(const pg8::f32x4*)(rw + d * 8), w1 = *(const pg8::f32x4*)(rw + d * 8 + 4); const float hq = hv[j][q];
                        lg[0] += hq * w0[0]; lg[1] += hq * w0[1]; lg[2] += hq * w0[2]; lg[3] += hq * w0[3]; lg[4] += hq * w1[0]; lg[5] += hq * w1[1]; lg[6] += hq * w1[2]; lg[7] += hq * w1[3]; }
#pragma unroll
                for (int e = 0; e < 8; ++e) lg[e] = wave_sum(lg[e]) + rb[e];
                if (lane == 0) {
                    int e1 = 0; float v1 = lg[0];
#pragma unroll
                    for (int e = 1; e < 8; ++e) if (lg[e] > v1) { v1 = lg[e]; e1 = e; }
                    int e2 = -1; float v2 = -3.0e38f;
#pragma unroll
                    for (int e = 0; e < 8; ++e) if (e != e1 && lg[e] > v2) { v2 = lg[e]; e2 = e; }
                    const float p1 = 1.0f / (1.0f + __expf(v2 - v1)), p2 = 1.0f - p1;
                    const int s1 = (int)atomicAdd(&cnt[e1], 1u), s2 = (int)atomicAdd(&cnt[e2], 1u);
                    list[e1 * M + s1] = row; list[e2 * M + s2] = row;
                    toke[row * 2] = e1; toke[row * 2 + 1] = e2; toks[row * 2] = s1; toks[row * 2 + 1] = s2; tokp[row * 2] = p1; tokp[row * 2 + 1] = p2;
                }
            }
        }
        if (nrow >= M) break; row = nrow;
    }
}

__device__ __forceinline__ void ph_moe_prep(Frame& F, ArgsP a) {
    LAS float* scr = (LAS float*)(F.lds + F.wave * 8704);
    const float* mg = (const float*)a->in[37]; const float* mu = (const float*)a->in[38]; const float* md = (const float*)a->in[39];
    bf16_t* WM1 = (bf16_t*)(a->ws + WS_WM1); bf16_t* WM2 = (bf16_t*)(a->ws + WS_WM2);
    constexpr int I_1 = 8 * 224 * 16, I_2 = 8 * 32 * 56;
    int lane_ = F.lane(); asm volatile("" : "+v"(lane_));
    const int n = 4 * (lane_ & 7);
    auto desc = [&](int r) -> CvtDesc {
        if (r < I_1) { const int e = r / 3584, q = r % 3584, nb = q / 16, kb = q % 16; const int v = nb * 32 + n; const int up = (v >> 2) & 1, j = (v >> 3) * 4 + (v & 3);
            return CvtDesc{(up ? mu : mg) + (size_t)e * 1024 * DEX + j, (size_t)DEX, WM1 + (size_t)e * 7168 * 1024, 1024, nb * 32, kb * 64}; }
        r -= I_1; const int e = r / 1792, q = r % 1792, nb = q / 56, kb = q % 56;
        return CvtDesc{md + (size_t)e * DEX * 1024 + nb * 32 + n, 1024, WM2 + (size_t)e * 1024 * DEX, DEX, nb * 32, kb * 64}; };
    { int it = F.gw;
      if (it < I_1 + I_2) { CvtDesc cur = desc(it); pg8::f32x4 v[8]; cvt_load(cur, v, lane_);
        for (;;) { const int nx = it + F.NGW; const bool more = nx < I_1 + I_2; CvtDesc nd = cur; pg8::f32x4 w[8];
            if (more) { nd = desc(nx); cvt_load(nd, w, lane_); }
            cvt_store(cur, v, scr, lane_);
            if (!more) break;
#pragma unroll
            for (int i = 0; i < 8; ++i) v[i] = w[i];
            cur = nd; it = nx; } } }
    const unsigned* cnt = (const unsigned*)(a->ws + WS_CTL) + CW_CNT;
    const int* list = (const int*)(a->ws + WS_ROUTE + RT_LIST);
    const bf16_t* h2 = (const bf16_t*)(a->ws + WS_H2L1); bf16_t* hg = (bf16_t*)(a->ws + WS_HG);
    int roff[9]; { int o = 0;
#pragma unroll
        for (int e = 0; e < 8; ++e) { roff[e] = o; o += (((int)cnt[e] + 255) >> 8) << 8; } roff[8] = o; }
    for (int slot0 = F.gw * 4; slot0 < roff[8]; slot0 += F.NGW * 4) {
        int src[4];
#pragma unroll
        for (int u = 0; u < 4; ++u) { const int slot = slot0 + u; int e = 0;
#pragma unroll
            for (int q = 1; q < 8; ++q) e += (slot >= roff[q]) ? 1 : 0;
            int base = 0, ce = 0;
#pragma unroll
            for (int q = 0; q < 8; ++q) if (q == e) { base = roff[q]; ce = (int)cnt[q]; }
            const int s = slot - base;
            src[u] = (slot < roff[8] && s < ce) ? list[e * M + s] : -1; }
        pg8::u32x4 v0[4], v1[4];
#pragma unroll
        for (int u = 0; u < 4; ++u) { v0[u] = (pg8::u32x4){0u, 0u, 0u, 0u}; v1[u] = v0[u];
            if (src[u] >= 0) { const pg8::u32x4* sp = (const pg8::u32x4*)(h2 + (size_t)src[u] * D) + 2 * lane_; v0[u] = sp[0]; v1[u] = sp[1]; } }
#pragma unroll
        for (int u = 0; u < 4; ++u) if (slot0 + u < roff[8]) { pg8::u32x4* dp = (pg8::u32x4*)(hg + (size_t)(slot0 + u) * D) + 2 * lane_; dp[0] = v0[u]; dp[1] = v1[u]; }
    }
}
typedef float f32x16 __attribute__((ext_vector_type(16)));
template <int CTRL, int ROWMASK> __device__ __forceinline__ float dpp_mov(float old, float x) {
    return __builtin_bit_cast(float, __builtin_amdgcn_update_dpp(__builtin_bit_cast(int, old), __builtin_bit_cast(int, x), CTRL, ROWMASK, 0xF, false));
}
__device__ __forceinline__ float rdlane(float x, int l) { return __builtin_bit_cast(float, __builtin_amdgcn_readlane(__builtin_bit_cast(int, x), l)); }
__device__ __forceinline__ float wave_sum63(float x) {
    x += dpp_mov<0xB1, 0xF>(0.f, x);
    x += dpp_mov<0x4E, 0xF>(0.f, x);
    x += dpp_mov<0x141, 0xF>(0.f, x);
    x += dpp_mov<0x140, 0xF>(0.f, x);
    x += dpp_mov<0x142, 0xA>(0.f, x);
    x += dpp_mov<0x143, 0xC>(0.f, x);
    return x;
}
__device__ __forceinline__ float row16_sum(float x) {
    x += dpp_mov<0xB1, 0xF>(0.f, x); x += dpp_mov<0x4E, 0xF>(0.f, x); x += dpp_mov<0x141, 0xF>(0.f, x); x += dpp_mov<0x140, 0xF>(0.f, x);
    return x;
}
__device__ __forceinline__ pg8::f32x4 ld_bf16x4(const bf16_t* p) { const pg8::u32x2 w = *(const pg8::u32x2*)p;
    return (pg8::f32x4){__builtin_bit_cast(float, w.x << 16), __builtin_bit_cast(float, w.x & 0xffff0000u), __builtin_bit_cast(float, w.y << 16), __builtin_bit_cast(float, w.y & 0xffff0000u)}; }
__device__ __forceinline__ void st_bf16x4(bf16_t* p, pg8::f32x4 v) { pg8::u32x2 w; w.x = pk2(v[0], v[1]); w.y = pk2(v[2], v[3]); *(pg8::u32x2*)p = w; }

__device__ __forceinline__ void ph_conv(Frame& F, ArgsP a, int l) {
    const bf16_t* proj = (const bf16_t*)(a->ws + WS_PROJ); bf16_t* br = (bf16_t*)(a->ws + WS_HB);
    const float* cw = (const float*)a->in[15] + l * 31 * 256; const float* cb = (const float*)a->in[16] + l * 256; const float* lg = (const float*)a->in[17] + l * 256; const float* lb = (const float*)a->in[18] + l * 256;
    LAS float* u = (LAS float*)F.lds;
    int tid = F.wave * 64 + F.lane(); asm volatile("" : "+v"(tid)); const int lane = tid & 63;
    for (int it = blockIdx.x; it < M / 64; it += F.G) {
        const int row0 = it * 64, t0 = row0 % T;
#pragma unroll
        for (int i_ = 0; i_ < 6; ++i_) { const int idx = tid + i_ * NTHR; if (idx >= 94 * 32) break; const int r = idx >> 5, c8 = (idx & 31) * 8; float uv[8];
#pragma unroll
            for (int e = 0; e < 8; ++e) uv[e] = 0.f;
            if (t0 - 30 + r >= 0) { const bf16_t* pr = proj + (size_t)(row0 - 30 + r) * PW;
                const pg8::f32x4 a0 = ld_bf16x4(pr + P_CA + c8), a1 = ld_bf16x4(pr + P_CA + c8 + 4), b0 = ld_bf16x4(pr + P_CB + c8), b1 = ld_bf16x4(pr + P_CB + c8 + 4);
#pragma unroll
                for (int e = 0; e < 4; ++e) { uv[e] = a0[e] * sigm(b0[e]); uv[4 + e] = a1[e] * sigm(b1[e]); } }
            *(LAS pg8::f32x4*)(u + r * 256 + c8) = (pg8::f32x4){uv[0], uv[1], uv[2], uv[3]}; *(LAS pg8::f32x4*)(u + r * 256 + c8 + 4) = (pg8::f32x4){uv[4], uv[5], uv[6], uv[7]}; }
        __syncthreads();
        const int c = tid & 255, half = tid >> 8;
        float acc[32];
        { float w[31], ur[62];
#pragma unroll
          for (int j = 0; j < 31; ++j) w[j] = cw[j * 256 + c];
#pragma unroll
          for (int q = 0; q < 62; ++q) ur[q] = u[(half * 32 + q) * 256 + c];
          const float bias = cb[c];
#pragma unroll
          for (int i = 0; i < 32; ++i) { float s = bias;
#pragma unroll
              for (int j = 0; j < 31; ++j) s += w[j] * ur[i + j];
              acc[i] = s; } }
        __syncthreads();
#pragma unroll
        for (int i = 0; i < 32; ++i) u[(half * 32 + i) * 256 + c] = acc[i];
        __syncthreads();
        const pg8::f32x4 g4 = *(const pg8::f32x4*)(lg + 4 * lane), b4 = *(const pg8::f32x4*)(lb + 4 * lane);
#pragma unroll 2
        for (int q = 0; q < 8; ++q) { const int t = F.wave * 8 + q; const pg8::f32x4 yv = *(const LAS pg8::f32x4*)(u + t * 256 + 4 * lane);
            const float mu = wave_sum((yv[0] + yv[1]) + (yv[2] + yv[3])) * (1.0f / 256.0f); const pg8::f32x4 d = yv - mu;
            const float var = wave_sum((d[0] * d[0] + d[1] * d[1]) + (d[2] * d[2] + d[3] * d[3])) * (1.0f / 256.0f);
            pg8::f32x4 o = d * rsqrtf(var + 1e-5f) * g4 + b4;
#pragma unroll
            for (int e = 0; e < 4; ++e) o[e] = siluf(o[e]);
            st_bf16x4(br + (size_t)(row0 + t) * D + 512 + 4 * lane, o); }
        __syncthreads();
    }
}

__device__ __forceinline__ void ph_rwkv_prep(Frame& F, ArgsP a, int l) {
        const bf16_t* proj = (const bf16_t*)(a->ws + WS_PROJ);
    const float* mu = (const float*)a->in[19] + l * 1024; const float* w0 = (const float*)a->in[20] + l * 256; const float* a0 = (const float*)a->in[22] + l * 256;
    const float* kkw = (const float*)a->in[25] + l * 256; const float* kaw = (const float*)a->in[26] + l * 256; const float* rkw = (const float*)a->in[27] + l * 256;
    const bf16_t* W2T = (const bf16_t*)(a->ws + WS_LR) + l * 256 * 64; const bf16_t* A2T = (const bf16_t*)(a->ws + WS_LR) + 2 * 256 * 64 + l * 256 * 64; const bf16_t* G2T = (const bf16_t*)(a->ws + WS_LR) + 4 * 256 * 64 + l * 256 * 128;
    float* VEC = (float*)(a->ws + SCR_VEC6); float* SC = (float*)(a->ws + SCR_SC); bf16_t* GR = (bf16_t*)(a->ws + SCR_GR);
    constexpr int RS = 72, RG = 136;
    LAS bf16_t* TZh = (LAS bf16_t*)F.lds; LAS bf16_t* TZl = TZh + 64 * RS; LAS bf16_t* ZA = TZl + 64 * RS; LAS bf16_t* SG = ZA + 64 * RS;
    int tid = F.wave * 64 + F.lane(); asm volatile("" : "+v"(tid));
    for (int it = blockIdx.x; it < M / 64; it += F.G) {
        const int row0 = it * 64, b = row0 / T, t0 = row0 % T;
#pragma unroll 4
        for (int i_ = 0; i_ < 32; ++i_) { const int idx = tid + i_ * NTHR; const int cc = idx & 255, tok = idx >> 8; const int col = 768 + cc;
            const bf16_t* pc = proj + (size_t)(row0 + tok) * PW + P_R + col; const float xc = bf2f(pc[0]); const float xp = (t0 + tok > 0) ? bf2f(pc[-PW]) : 0.f;
            const float xm = xc + (xp - xc) * mu[col];
            if (cc < 64) { const float tv = tanh_fast(xm); const unsigned hi = f2bf(tv); TZh[tok * RS + cc] = (bf16_t)hi; TZl[tok * RS + cc] = (bf16_t)f2bf(tv - __builtin_bit_cast(float, hi << 16)); }
            else if (cc < 128) ZA[tok * RS + cc - 64] = (bf16_t)f2bf(xm);
            else SG[tok * RG + cc - 128] = (bf16_t)f2bf(sigm(xm)); }
        __syncthreads();
        int tid2 = tid; asm volatile("" : "+v"(tid2));
        const int lane = tid2 & 63, r = lane & 31, hg = lane >> 5, h = (tid2 >> 6) & 3, th = tid2 >> 8;
        f32x16 accw[2], acca[2], accg[2];
#pragma unroll
        for (int nb = 0; nb < 2; ++nb)
#pragma unroll
            for (int e = 0; e < 16; ++e) { accw[nb][e] = 0.f; acca[nb][e] = 0.f; accg[nb][e] = 0.f; }
        const int arow = (th * 32 + r);
#pragma unroll
        for (int s = 0; s < 4; ++s) { const pg8::bf16x8 ah = *(const LAS pg8::bf16x8*)(TZh + arow * RS + 16 * s + 8 * hg), al = *(const LAS pg8::bf16x8*)(TZl + arow * RS + 16 * s + 8 * hg), az = *(const LAS pg8::bf16x8*)(ZA + arow * RS + 16 * s + 8 * hg);
#pragma unroll
            for (int nb = 0; nb < 2; ++nb) { const int n = h * 64 + nb * 32 + r;
                const pg8::bf16x8 bw = *(const pg8::bf16x8*)(W2T + n * 64 + 16 * s + 8 * hg), ba = *(const pg8::bf16x8*)(A2T + n * 64 + 16 * s + 8 * hg);
                accw[nb] = __builtin_amdgcn_mfma_f32_32x32x16_bf16(ah, bw, accw[nb], 0, 0, 0); accw[nb] = __builtin_amdgcn_mfma_f32_32x32x16_bf16(al, bw, accw[nb], 0, 0, 0);
                acca[nb] = __builtin_amdgcn_mfma_f32_32x32x16_bf16(az, ba, acca[nb], 0, 0, 0); } }
#pragma unroll
        for (int s = 0; s < 8; ++s) { const pg8::bf16x8 ag = *(const LAS pg8::bf16x8*)(SG + arow * RG + 16 * s + 8 * hg);
#pragma unroll
            for (int nb = 0; nb < 2; ++nb) { const int n = h * 64 + nb * 32 + r; const pg8::bf16x8 bg = *(const pg8::bf16x8*)(G2T + n * 128 + 16 * s + 8 * hg);
                accg[nb] = __builtin_amdgcn_mfma_f32_32x32x16_bf16(ag, bg, accg[nb], 0, 0, 0); } }
        int tid3 = tid; asm volatile("" : "+v"(tid3)); const int r3 = tid3 & 31, hg3 = (tid3 >> 5) & 1, h3 = (tid3 >> 6) & 3, th3 = tid3 >> 8;
        float pw0[2], pa0[2], pmr[2], pmk[2], pmv[2], pkk[2], pka[2], prk[2];
#pragma unroll
        for (int nb = 0; nb < 2; ++nb) { const int c = h3 * 64 + nb * 32 + r3; pw0[nb] = w0[c]; pa0[nb] = a0[c]; pmr[nb] = mu[c]; pmk[nb] = mu[256 + c]; pmv[nb] = mu[512 + c]; pkk[nb] = kkw[c]; pka[nb] = kaw[c]; prk[nb] = rkw[c]; }
#pragma unroll
        for (int e = 0; e < 16; ++e) { const int tok = th3 * 32 + (e & 3) + 8 * (e >> 2) + 4 * hg3, t = t0 + tok; const size_t row = (size_t)row0 + tok; const bool hp = t > 0;
            float dec[2], kkv[2], kka[2], k2[2], rv[2], vv[2], s_kk = 0.f, s_c1 = 0.f, s_c2 = 0.f, s_bn = 0.f;
#pragma unroll
            for (int nb = 0; nb < 2; ++nb) { const int c = h3 * 64 + nb * 32 + r3; const bf16_t* pc = proj + row * PW + P_R + c;
                const float rc = bf2f(pc[0]), kc = bf2f(pc[256]), vc = bf2f(pc[512]);
                const float rp = hp ? bf2f(pc[-PW]) : 0.f, kp = hp ? bf2f(pc[256 - PW]) : 0.f, vp = hp ? bf2f(pc[512 - PW]) : 0.f;
                const float rr = rc + (rp - rc) * pmr[nb], k = kc + (kp - kc) * pmk[nb]; vv[nb] = vc + (vp - vc) * pmv[nb]; rv[nb] = rr;
                const float wl = -softplusf(-(accw[nb][e] + pw0[nb])) - 0.5f; dec[nb] = __expf(-__expf(wl)); const float av = sigm(acca[nb][e] + pa0[nb]);
                kkv[nb] = k * pkk[nb]; k2[nb] = k * (1.0f + (av - 1.0f) * pka[nb]); kka[nb] = av;
                s_kk += kkv[nb] * kkv[nb]; s_c2 += k2[nb] * rr; s_bn += rr * k2[nb] * prk[nb];
                GR[row * 256 + c] = (bf16_t)f2bf(accg[nb][e]); }
            s_kk = row16_sum(s_kk); s_kk += __shfl_xor(s_kk, 16);
            const float inv = 1.0f / fmaxf(sqrtf(s_kk), 1e-12f);
#pragma unroll
            for (int nb = 0; nb < 2; ++nb) { kkv[nb] *= inv; kka[nb] *= kkv[nb]; s_c1 += kka[nb] * rv[nb]; }
            s_c1 = row16_sum(s_c1); s_c1 += __shfl_xor(s_c1, 16); s_c2 = row16_sum(s_c2); s_c2 += __shfl_xor(s_c2, 16); s_bn = row16_sum(s_bn); s_bn += __shfl_xor(s_bn, 16);
            const size_t st = ((size_t)(b * 4 + h3) * T + t);
#pragma unroll
            for (int nb = 0; nb < 2; ++nb) { float* vb = VEC + st * VSTEP + nb * 32 + r3;
                vb[0] = dec[nb]; vb[64] = -kkv[nb]; vb[128] = kka[nb]; vb[192] = k2[nb]; vb[256] = dec[nb] * rv[nb]; vb[320] = vv[nb]; }
            if (r3 == 0) { *(pg8::f32x4*)(SC + st * 4) = (pg8::f32x4){s_c1, s_c2, s_bn, 0.f}; *(pg8::f32x2*)(VEC + st * VSTEP + 384) = (pg8::f32x2){s_c1, s_c2}; }
            asm volatile("" ::: "memory"); }
        __syncthreads();
    }
}

__device__ __forceinline__ void ph_rwkv_scan(Frame& F, ArgsP a) {
    const float* VEC = (const float*)(a->ws + SCR_VEC6); float* YR = (float*)(a->ws + SCR_YR);
    int lane = F.lane(); asm volatile("" : "+v"(lane));
    constexpr int CH = 32, CHB = CH * VSTEP * 4, NP = CHB / 1024 / 4;
    const bool stager = F.wave >= 4;
    const int vcu = (F.G % 8 == 0) ? ((int)blockIdx.x % 8) * (F.G / 8) + (int)blockIdx.x / 8 : (int)blockIdx.x;
    for (int it = vcu; it < 256; it += F.G) {
        const int bh = it >> 3, rg = it & 7, b = bh >> 2, h = bh & 3;
        const int sw = F.wave & 3, vrow = rg * 8 + 2 * sw;
        const char* src = (const char*)(VEC + (size_t)bh * T * VSTEP) + lane * 16;
#define RW_STAGE(cidx) do { _Pragma("unroll") for (int p_ = 0; p_ < NP; ++p_) \
            __builtin_amdgcn_global_load_lds((const unsigned*)(src + (size_t)(cidx) * CHB + (sw * NP + p_) * 1024), (LAS unsigned*)(F.lds + ((cidx) & 1) * CHB + (sw * NP + p_) * 1024), 16, 0, 0); } while (0)
        if (stager) { RW_STAGE(0); asm volatile("s_waitcnt vmcnt(0)" ::: "memory"); }
        __builtin_amdgcn_s_barrier(); asm volatile("" ::: "memory");
        float SA = 0.f, SB = 0.f;
        for (int c = 0; c < T / CH; ++c) {
            if (stager) { if (c + 1 < T / CH) { RW_STAGE(c + 1); asm volatile("s_waitcnt vmcnt(0)" ::: "memory"); } }
            else {
                const LAS float* bufl = (const LAS float*)(F.lds + (c & 1) * CHB) + lane;
                const LAS float* bufv = (const LAS float*)(F.lds + (c & 1) * CHB) + 320 + vrow;
                const LAS float* bufc = (const LAS float*)(F.lds + (c & 1) * CHB) + 384;
                float zaA = 0.f, zaB = 0.f, saaA = 0.f, saaB = 0.f;
                float nw = bufl[0], nnkk = bufl[64], nkka = bufl[128], nk2 = bufl[192], nwr = bufl[256]; pg8::f32x2 nv = *(const LAS pg8::f32x2*)bufv;
#define RW_STEP(SI) do { \
                    const float w_ = nw, nkk = nnkk, kka = nkka, k2 = nk2, wr = nwr; const pg8::f32x2 v = nv; \
                    { const int s1 = ((SI) + 1 < CH ? (SI) + 1 : (SI)) * VSTEP; \
                      nw = bufl[s1]; nnkk = bufl[s1 + 64]; nkka = bufl[s1 + 128]; nk2 = bufl[s1 + 192]; nwr = bufl[s1 + 256]; nv = *(const LAS pg8::f32x2*)(bufv + s1); } \
                    asm volatile("" ::: "memory"); \
                    const auto s0 = __builtin_amdgcn_permlane32_swap(__builtin_bit_cast(unsigned, SA * nkk), __builtin_bit_cast(unsigned, SA * wr), false, false); \
                    const auto s1_ = __builtin_amdgcn_permlane32_swap(__builtin_bit_cast(unsigned, SB * nkk), __builtin_bit_cast(unsigned, SB * wr), false, false); \
                    const float xA = __builtin_bit_cast(float, (unsigned)s0[0]) + __builtin_bit_cast(float, (unsigned)s0[1]); \
                    const float xB = __builtin_bit_cast(float, (unsigned)s1_[0]) + __builtin_bit_cast(float, (unsigned)s1_[1]); \
                    const auto s2 = __builtin_amdgcn_permlane16_swap(__builtin_bit_cast(unsigned, xA), __builtin_bit_cast(unsigned, xB), false, false); \
                    float x = __builtin_bit_cast(float, (unsigned)s2[0]) + __builtin_bit_cast(float, (unsigned)s2[1]); \
                    x += dpp_mov<0xB1, 0xF>(0.f, x); x += dpp_mov<0x4E, 0xF>(0.f, x); x += dpp_mov<0x141, 0xF>(0.f, x); x += dpp_mov<0x140, 0xF>(0.f, x); \
                    const int isaA = __builtin_amdgcn_readlane(__builtin_bit_cast(int, x), 0), isaB = __builtin_amdgcn_readlane(__builtin_bit_cast(int, x), 16); \
                    const int izA = __builtin_amdgcn_readlane(__builtin_bit_cast(int, x), 32), izB = __builtin_amdgcn_readlane(__builtin_bit_cast(int, x), 48); \
                    const float saA = __builtin_bit_cast(float, isaA), saB = __builtin_bit_cast(float, isaB); \
                    SA = SA * w_ + (saA * kka + v[0] * k2); \
                    SB = SB * w_ + (saB * kka + v[1] * k2); \
                    asm volatile("v_writelane_b32 %0, %4, %8\n\tv_writelane_b32 %1, %5, %8\n\tv_writelane_b32 %2, %6, %8\n\tv_writelane_b32 %3, %7, %8" : "+v"(saaA), "+v"(saaB), "+v"(zaA), "+v"(zaB) : "s"(isaA), "s"(isaB), "s"(izA), "s"(izB), "n"(SI)); \
                } while (0)
                RW_STEP(0); RW_STEP(1); RW_STEP(2); RW_STEP(3); RW_STEP(4); RW_STEP(5); RW_STEP(6); RW_STEP(7); RW_STEP(8); RW_STEP(9); RW_STEP(10); RW_STEP(11); RW_STEP(12); RW_STEP(13); RW_STEP(14); RW_STEP(15); RW_STEP(16); RW_STEP(17); RW_STEP(18); RW_STEP(19); RW_STEP(20); RW_STEP(21); RW_STEP(22); RW_STEP(23); RW_STEP(24); RW_STEP(25); RW_STEP(26); RW_STEP(27); RW_STEP(28); RW_STEP(29); RW_STEP(30); RW_STEP(31);
#undef RW_STEP
                const int sl = (lane & 31) * VSTEP; const pg8::f32x2 vv = *(const LAS pg8::f32x2*)((const LAS float*)(F.lds + (c & 1) * CHB) + 320 + vrow + sl), cc = *(const LAS pg8::f32x2*)(bufc + sl);
                const float yaA = zaA + saaA * cc[0] + vv[0] * cc[1], yaB = zaB + saaB * cc[0] + vv[1] * cc[1];
                if (lane < CH) *(pg8::f32x2*)(YR + ((size_t)b * T + c * CH + lane) * 256 + h * 64 + vrow) = (pg8::f32x2){yaA, yaB};
            }
            __builtin_amdgcn_s_barrier(); asm volatile("" ::: "memory");
        }
#undef RW_STAGE
        asm volatile("s_waitcnt vmcnt(0)" ::: "memory"); __builtin_amdgcn_s_barrier(); asm volatile("" ::: "memory");
    }
}

__device__ __forceinline__ void ph_rwkv_post(Frame& F, ArgsP a, int l) {
    const float* VEC = (const float*)(a->ws + SCR_VEC6); const float* SC = (const float*)(a->ws + SCR_SC); const float* YR = (const float*)(a->ws + SCR_YR); const bf16_t* GR = (const bf16_t*)(a->ws + SCR_GR);
    const float* lng = (const float*)a->in[28] + l * 256; const float* lnb = (const float*)a->in[29] + l * 256;
    bf16_t* br = (bf16_t*)(a->ws + WS_HB);
    int lane = F.lane(); asm volatile("" : "+v"(lane));
    const int c = 4 * lane, h = lane >> 4;
    const pg8::f32x4 g4 = *(const pg8::f32x4*)(lng + c), b4 = *(const pg8::f32x4*)(lnb + c);
    for (int row = F.gw; row < M; row += F.NGW) {
        const int b = row / T, t = row % T; const size_t st = (size_t)(b * 4 + h) * T + t;
        const pg8::f32x4 y = *(const pg8::f32x4*)(YR + (size_t)row * 256 + c);
        const float mu = row16_sum((y[0] + y[1]) + (y[2] + y[3])) * (1.0f / 64.0f); const pg8::f32x4 d = y - mu;
        const float var = row16_sum((d[0] * d[0] + d[1] * d[1]) + (d[2] * d[2] + d[3] * d[3])) * (1.0f / 64.0f);
        const pg8::f32x4 yn = d * rsqrtf(var + 64e-5f) * g4 + b4;
        const float bonus = SC[st * 4 + 2];
        const pg8::f32x4 v = *(const pg8::f32x4*)(VEC + st * VSTEP + 320 + (c & 63));
        const pg8::f32x4 g = ld_bf16x4(GR + (size_t)row * 256 + c);
        st_bf16x4(br + (size_t)row * D + 768 + c, (yn + bonus * v) * g);
    }
}

__device__ __forceinline__ void ph_gla_p1(Frame& F, ArgsP a, int l) {
    const bf16_t* proj = (const bf16_t*)(a->ws + WS_PROJ); const float* w2 = (const float*)a->in[10] + l * 16 * 128; const float* gb = (const float*)a->in[11] + l * 128;
    bf16_t* QS = (bf16_t*)(a->ws + SCR_EG); float* CDp = (float*)(a->ws + SCR_EG) + (size_t)M * 128; float* GU = (float*)(a->ws + SCR_GU); float* OI = (float*)(a->ws + WS_GOI);
    const bf16_t* GZ = (const bf16_t*)(a->ws + WS_GZ);
    constexpr int RS = 40;
    LAS unsigned char* wl = F.lds + F.wave * 12800;
    LAS bf16_t* VTl = (LAS bf16_t*)wl; LAS bf16_t* Qs = (LAS bf16_t*)(wl + 5120); LAS bf16_t* Ks = (LAS bf16_t*)(wl + 7680); LAS bf16_t* KdT = (LAS bf16_t*)(wl + 10240);
    int lane = F.lane(); asm volatile("" : "+v"(lane));
    const int d = lane & 31, half = lane >> 5, r = lane & 31, hg = lane >> 5;
    for (int it = F.gw; it < 2048; it += F.NGW) {
        const int bh = it >> 6, n = it & 63, b = bh >> 2, h = bh & 3; const size_t row0 = (size_t)b * T + n * 32;
        float wc[16];
#pragma unroll
        for (int q = 0; q < 16; ++q) wc[q] = w2[q * 128 + h * 32 + d];
        const float gbv = gb[h * 32 + d];
        float g[16];
#pragma unroll
        for (int i = 0; i < 16; ++i) { const bf16_t* pr = GZ + (row0 + 16 * half + i) * 16;
            const pg8::f32x4 z0 = ld_bf16x4(pr), z1 = ld_bf16x4(pr + 4), z2 = ld_bf16x4(pr + 8), z3 = ld_bf16x4(pr + 12);
            float acc = gbv;
#pragma unroll
            for (int e = 0; e < 4; ++e) acc += z0[e] * wc[e] + z1[e] * wc[4 + e] + z2[e] * wc[8 + e] + z3[e] * wc[12 + e];
            g[i] = -softplusf(-acc) * (1.0f / 16.0f); }
#pragma unroll
        for (int i = 1; i < 16; ++i) g[i] += g[i - 1];
        const float other = __shfl(g[15], d);
        if (half) {
#pragma unroll
            for (int i = 0; i < 16; ++i) g[i] += other; }
        const float glast = __shfl(g[15], 32 + d);
#pragma unroll
        for (int i = 0; i < 16; ++i) { const int tok = 16 * half + i; const bf16_t* pr = proj + (row0 + tok) * PW;
            const float qv = bf2f(pr[P_GQ + h * 32 + d]), kv = bf2f(pr[P_GK + h * 32 + d]);
            const unsigned qb = f2bf(qv * 0.17677669529663687f * __expf(g[i]));
            Qs[tok * RS + d] = (bf16_t)qb; QS[((size_t)it * 32 + tok) * 32 + d] = (bf16_t)qb;
            Ks[tok * RS + d] = (bf16_t)f2bf(kv * __expf(-g[i])); KdT[d * RS + tok] = (bf16_t)f2bf(kv * __expf(glast - g[i])); }
        if (half) CDp[it * 32 + d] = __expf(glast);
        { const bf16_t* vp = proj + row0 * PW + P_GV + h * 64 + lane;
#pragma unroll
          for (int t2 = 0; t2 < 16; ++t2) { const unsigned lo = vp[(size_t)(2 * t2) * PW], hi = vp[(size_t)(2 * t2 + 1) * PW]; *(LAS unsigned*)(VTl + lane * RS + 2 * t2) = lo | (hi << 16); } }
        asm volatile("s_waitcnt lgkmcnt(0)" ::: "memory");
        f32x16 X;
#pragma unroll
        for (int e = 0; e < 16; ++e) X[e] = 0.f;
#pragma unroll
        for (int s = 0; s < 2; ++s) X = __builtin_amdgcn_mfma_f32_32x32x16_bf16(*(const LAS pg8::bf16x8*)(Ks + r * RS + 16 * s + 8 * hg), *(const LAS pg8::bf16x8*)(Qs + r * RS + 16 * s + 8 * hg), X, 0, 0, 0);
#pragma unroll
        for (int e = 0; e < 16; ++e) { const int jrow = (e & 3) + 8 * (e >> 2) + 4 * hg; if (jrow > r) X[e] = 0.f; }
        f32x16 oi[2], ut[2];
#pragma unroll
        for (int e = 0; e < 16; ++e) { oi[0][e] = 0.f; oi[1][e] = 0.f; ut[0][e] = 0.f; ut[1][e] = 0.f; }
#pragma unroll
        for (int s = 0; s < 2; ++s) {
            pg8::u32x4 pw; pw.x = pk2(X[8 * s], X[8 * s + 1]); pw.y = pk2(X[8 * s + 2], X[8 * s + 3]); pw.z = pk2(X[8 * s + 4], X[8 * s + 5]); pw.w = pk2(X[8 * s + 6], X[8 * s + 7]);
            const pg8::bf16x8 xf = __builtin_bit_cast(pg8::bf16x8, pw);
            const pg8::bf16x8 kdf = *(const LAS pg8::bf16x8*)(KdT + r * RS + 16 * s + 8 * hg);
#pragma unroll
            for (int db = 0; db < 2; ++db) { const LAS bf16_t* vp = VTl + (db * 32 + r) * RS + 16 * s;
                const pg8::u32x2 v0 = *(const LAS pg8::u32x2*)(vp + 4 * hg), v1 = *(const LAS pg8::u32x2*)(vp + 8 + 4 * hg);
                pg8::u32x4 vw; vw.x = v0.x; vw.y = v0.y; vw.z = v1.x; vw.w = v1.y;
                oi[db] = __builtin_amdgcn_mfma_f32_32x32x16_bf16(__builtin_bit_cast(pg8::bf16x8, vw), xf, oi[db], 0, 0, 0);
                ut[db] = __builtin_amdgcn_mfma_f32_32x32x16_bf16(*(const LAS pg8::bf16x8*)(vp + 8 * hg), kdf, ut[db], 0, 0, 0); } }
        float* op = OI + (size_t)it * 2048 + lane;
#pragma unroll
        for (int db = 0; db < 2; ++db)
#pragma unroll
            for (int e = 0; e < 16; ++e) op[(db * 16 + e) * 64] = oi[db][e];
        float* up = GU + ((size_t)it * 32 + r) * 64 + 4 * hg;
#pragma unroll
        for (int db = 0; db < 2; ++db)
#pragma unroll
            for (int q = 0; q < 4; ++q) *(pg8::f32x4*)(up + db * 32 + 8 * q) = (pg8::f32x4){ut[db][4 * q], ut[db][4 * q + 1], ut[db][4 * q + 2], ut[db][4 * q + 3]};
        asm volatile("s_waitcnt lgkmcnt(0)" ::: "memory");
    }
}
__device__ __forceinline__ void ph_gla_prefix(Frame& F, ArgsP a) {
    const float* CDp = (const float*)(a->ws + SCR_EG) + (size_t)M * 128; const float* GU = (const float*)(a->ws + SCR_GU); bf16_t* ST = (bf16_t*)(a->ws + WS_GST);
    int lane = F.lane(); asm volatile("" : "+v"(lane));
    for (int it = F.gw; it < 1024; it += F.NGW) { const int bh = it >> 5, d = it & 31;
        const float* gp = GU + ((size_t)bh * 64 * 32 + d) * 64 + lane; const float* cp = CDp + (size_t)bh * 64 * 32 + d;
        bf16_t* sp = ST + ((size_t)bh * 64 * 64 + lane) * 32 + d;
        float u[64], cd[64];
#pragma unroll
        for (int n = 0; n < 64; ++n) { u[n] = gp[(size_t)n * 2048]; cd[n] = cp[n * 32]; }
        float S = 0.f;
#pragma unroll
        for (int n = 0; n < 64; ++n) { sp[(size_t)n * 2048] = (bf16_t)f2bf(S); S = cd[n] * S + u[n]; } }
}
__device__ __forceinline__ void ph_gla_p2(Frame& F, ArgsP a, int l) {
    const bf16_t* proj = (const bf16_t*)(a->ws + WS_PROJ); const float* gnorm = (const float*)a->in[12] + l * 64;
    const bf16_t* QS = (const bf16_t*)(a->ws + SCR_EG); const bf16_t* ST = (const bf16_t*)(a->ws + WS_GST); const float* OI = (const float*)(a->ws + WS_GOI); bf16_t* br = (bf16_t*)(a->ws + WS_HB);
    int lane = F.lane(); asm volatile("" : "+v"(lane));
    const int r = lane & 31, hg = lane >> 5;
    for (int it = F.gw; it < 2048; it += F.NGW) {
        const int bh = it >> 6, n = it & 63, b = bh >> 2, h = bh & 3; const size_t row0 = (size_t)b * T + n * 32;
        f32x16 ot[2]; const float* op = OI + (size_t)it * 2048 + lane;
#pragma unroll
        for (int db = 0; db < 2; ++db)
#pragma unroll
            for (int e = 0; e < 16; ++e) ot[db][e] = op[(db * 16 + e) * 64];
#pragma unroll
        for (int s = 0; s < 2; ++s) { const pg8::bf16x8 qf = *(const pg8::bf16x8*)(QS + ((size_t)it * 32 + r) * 32 + 16 * s + 8 * hg);
#pragma unroll
            for (int db = 0; db < 2; ++db) ot[db] = __builtin_amdgcn_mfma_f32_32x32x16_bf16(*(const pg8::bf16x8*)(ST + ((size_t)it * 64 + db * 32 + r) * 32 + 16 * s + 8 * hg), qf, ot[db], 0, 0, 0); }
        float ss = 0.f;
#pragma unroll
        for (int db = 0; db < 2; ++db)
#pragma unroll
            for (int e = 0; e < 16; ++e) ss += ot[db][e] * ot[db][e];
        ss += __shfl_xor(ss, 32);
        const float rstd = rsqrtf(ss * (1.0f / 64.0f) + 1e-6f);
        const bf16_t* og = proj + (row0 + r) * PW + P_GO + h * 64 + 4 * hg; bf16_t* od = br + (row0 + r) * D + h * 64 + 4 * hg;
#pragma unroll
        for (int db = 0; db < 2; ++db)
#pragma unroll
            for (int q = 0; q < 4; ++q) { const int dv0 = db * 32 + 8 * q; const pg8::f32x4 gv = ld_bf16x4(og + dv0), gn = *(const pg8::f32x4*)(gnorm + dv0 + 4 * hg);
                st_bf16x4(od + dv0, (pg8::f32x4){ot[db][4 * q] * rstd * gn[0] * siluf(gv[0]), ot[db][4 * q + 1] * rstd * gn[1] * siluf(gv[1]), ot[db][4 * q + 2] * rstd * gn[2] * siluf(gv[2]), ot[db][4 * q + 3] * rstd * gn[3] * siluf(gv[3])}); }
    }
}

__device__ __forceinline__ void ph_attn_prep(Frame& F, ArgsP a) {
    const bf16_t* proj = (const bf16_t*)(a->ws + WS_PROJ); const int* pos = (const int*)a->in[2];
    bf16_t* QR = (bf16_t*)(a->ws + SCR_QK); bf16_t* KR = QR + (size_t)M * 256; bf16_t* VT = (bf16_t*)(a->ws + SCR_VT);
    int lane = F.lane(); asm volatile("" : "+v"(lane));
    for (int idx = F.gw * 64 + lane; idx < M * 8; idx += F.NGW * 64) { const int row = idx >> 3, hc = idx & 7; const float p = (float)pos[row];
        const bf16_t* qs = proj + (size_t)row * PW + P_DQ + hc * 32; const bf16_t* ks = proj + (size_t)row * PW + P_DK + hc * 32;
        float qv[32], kv[32];
#pragma unroll
        for (int j = 0; j < 8; ++j) { const pg8::f32x4 q4 = ld_bf16x4(qs + 4 * j), k4 = ld_bf16x4(ks + 4 * j);
#pragma unroll
            for (int e = 0; e < 4; ++e) { qv[4 * j + e] = q4[e]; kv[4 * j + e] = k4[e]; } }
        float qo[32], ko[32];
#pragma unroll
        for (int i = 0; i < 16; ++i) { const float inv = exp2f(-(float)i * 0.8304820237218406f);
            float sn, cs; sincosf(p * inv, &sn, &cs);
            qo[i] = qv[i] * cs - qv[i + 16] * sn; qo[i + 16] = qv[i] * sn + qv[i + 16] * cs;
            ko[i] = kv[i] * cs - kv[i + 16] * sn; ko[i + 16] = kv[i] * sn + kv[i + 16] * cs; }
        const float qsc = 0.17677669529663687f * 1.4426950408889634f;
        bf16_t* qd = QR + (size_t)row * 256 + hc * 32; bf16_t* kd = KR + (size_t)row * 256 + hc * 32;
#pragma unroll
        for (int j = 0; j < 8; ++j) { st_bf16x4(qd + 4 * j, (pg8::f32x4){qo[4 * j] * qsc, qo[4 * j + 1] * qsc, qo[4 * j + 2] * qsc, qo[4 * j + 3] * qsc});
            st_bf16x4(kd + 4 * j, (pg8::f32x4){ko[4 * j], ko[4 * j + 1], ko[4 * j + 2], ko[4 * j + 3]}); } }
    for (int it = F.gw; it < 1024; it += F.NGW) { const int bh = it >> 5, tt = it & 31, b = bh >> 2, h = bh & 3;
        const bf16_t* vs = proj + ((size_t)b * T + tt * 64 + lane) * PW + P_DV + h * 64;
        pg8::u32x4 v[8];
#pragma unroll
        for (int j = 0; j < 8; ++j) v[j] = *(const pg8::u32x4*)(vs + 8 * j);
        bf16_t* vd = VT + (size_t)bh * 64 * T + tt * 64 + lane;
#pragma unroll
        for (int j = 0; j < 8; ++j)
#pragma unroll
            for (int e = 0; e < 4; ++e) { const unsigned w = v[j][e]; vd[(size_t)(8 * j + 2 * e) * T] = (bf16_t)(w & 0xffffu); vd[(size_t)(8 * j + 2 * e + 1) * T] = (bf16_t)(w >> 16); } }
}
__device__ __forceinline__ void ph_attn(Frame& F, ArgsP a, int l) {
    const bf16_t* QR = (const bf16_t*)(a->ws + SCR_QK); const bf16_t* KR = QR + (size_t)M * 256; const bf16_t* VT = (const bf16_t*)(a->ws + SCR_VT);
    const float* lp = (const float*)a->in[13] + l * 128; const float* subln = (const float*)a->in[14] + l * 64; bf16_t* br = (bf16_t*)(a->ws + WS_HB);
    int tid = F.wave * 64 + F.lane(); asm volatile("" : "+v"(tid)); const int lane = tid & 63;
    const int r = lane & 31, hg = lane >> 5, comp = F.wave & 1, qs = F.wave >> 1;
    constexpr int RS = 72;
    LAS bf16_t* Kt = (LAS bf16_t*)F.lds;
    LAS bf16_t* Vt = Kt + 2 * 64 * RS;
    LAS float* Xl = (LAS float*)(F.lds + 4 * 64 * RS * 2);
    float lam, lam_init;
    { float d01 = 0.f, d23 = 0.f;
      for (int i = 0; i < 32; ++i) { d01 += lp[i] * lp[32 + i]; d23 += lp[64 + i] * lp[96 + i]; }
      lam_init = 0.8f - 0.6f * __expf(-0.3f * (float)l); lam = __expf(d01) - __expf(d23) + lam_init; }
    const int ldrow = tid >> 3, ldch = tid & 7;
    const int vcu = (F.G % 8 == 0) ? ((int)blockIdx.x % 8) * (F.G / 8) + (int)blockIdx.x / 8 : (int)blockIdx.x;
    for (int pi = vcu; pi < 256; pi += F.G) {
#pragma unroll 1
        for (int half = 0; half < 2; ++half) {
            const int bh = pi >> 3, j = pi & 7, qb = half == 0 ? 15 - j : j, b = bh >> 2, h = bh & 3;
            const int q0 = qb * 128 + qs * 32, nkw = q0 / 64 + 1, nkb = 2 * qb + 2;
            const size_t rowb = (size_t)b * T;
            pg8::bf16x8 qf[2];
#pragma unroll
            for (int s = 0; s < 2; ++s) qf[s] = *(const pg8::bf16x8*)(QR + (rowb + q0 + r) * 256 + h * 64 + comp * 32 + 16 * s + 8 * hg);
            f32x16 ot[2];
#pragma unroll
            for (int e = 0; e < 16; ++e) { ot[0][e] = 0.f; ot[1][e] = 0.f; }
            float mrun = -1e30f, lrun = 0.f;
            const bf16_t* kg = KR + (rowb + ldrow) * 256 + h * 64 + ldch * 8; const bf16_t* vg = VT + ((size_t)bh * 64 + ldrow) * T + ldch * 8;
            pg8::u32x4 kreg = *(const pg8::u32x4*)kg, vreg = *(const pg8::u32x4*)vg;
            pg8::u32x4 kreg2 = kreg, vreg2 = vreg;
            if (nkb > 1) { kreg2 = *(const pg8::u32x4*)(kg + (size_t)64 * 256); vreg2 = *(const pg8::u32x4*)(vg + 64); }
            for (int kt = 0; kt < nkb; ++kt) {
                const int bo = (kt & 1) * 64 * RS;
                *(LAS pg8::u32x4*)(Kt + bo + ldrow * RS + ldch * 8) = kreg; *(LAS pg8::u32x4*)(Vt + bo + ldrow * RS + ldch * 8) = vreg;
                __syncthreads();
                kreg = kreg2; vreg = vreg2;
                if (kt + 2 < nkb) { kreg2 = *(const pg8::u32x4*)(kg + (size_t)(kt + 2) * 64 * 256); vreg2 = *(const pg8::u32x4*)(vg + (kt + 2) * 64); }
                if (kt < nkw) {
                    f32x16 st[2];
#pragma unroll
                    for (int kb = 0; kb < 2; ++kb) {
#pragma unroll
                        for (int e = 0; e < 16; ++e) st[kb][e] = 0.f;
#pragma unroll
                        for (int s = 0; s < 2; ++s) { const pg8::bf16x8 kf = *(const LAS pg8::bf16x8*)(Kt + bo + (kb * 32 + r) * RS + comp * 32 + 16 * s + 8 * hg);
                            st[kb] = __builtin_amdgcn_mfma_f32_32x32x16_bf16(kf, qf[s], st[kb], 0, 0, 0); } }
                    if (kt == nkw - 1) {
                        const int qi = q0 + r;
#pragma unroll
                        for (int kb = 0; kb < 2; ++kb)
#pragma unroll
                            for (int e = 0; e < 16; ++e) { const int ki = kt * 64 + kb * 32 + (e & 3) + 8 * (e >> 2) + 4 * hg; if (ki > qi) st[kb][e] = -1e30f; } }
                    float tm = st[0][0];
#pragma unroll
                    for (int e = 1; e < 16; ++e) tm = fmaxf(tm, st[0][e]);
#pragma unroll
                    for (int e = 0; e < 16; ++e) tm = fmaxf(tm, st[1][e]);
                    { const auto sw = __builtin_amdgcn_permlane32_swap(__builtin_bit_cast(unsigned, tm), __builtin_bit_cast(unsigned, tm), false, false); tm = fmaxf(__builtin_bit_cast(float, (unsigned)sw[0]), __builtin_bit_cast(float, (unsigned)sw[1])); }
                    const float mn = fmaxf(mrun, tm), alpha = __builtin_amdgcn_exp2f(mrun - mn); mrun = mn;
                    float ps = 0.f;
#pragma unroll
                    for (int kb = 0; kb < 2; ++kb)
#pragma unroll
                        for (int e = 0; e < 16; ++e) { st[kb][e] = __builtin_amdgcn_exp2f(st[kb][e] - mn); ps += st[kb][e]; }
                    lrun = lrun * alpha + ps;
#pragma unroll
                    for (int e = 0; e < 16; ++e) { ot[0][e] *= alpha; ot[1][e] *= alpha; }
#pragma unroll
                    for (int kb = 0; kb < 2; ++kb)
#pragma unroll
                        for (int s = 0; s < 2; ++s) {
                            pg8::u32x4 pw; pw.x = pk2(st[kb][8 * s], st[kb][8 * s + 1]); pw.y = pk2(st[kb][8 * s + 2], st[kb][8 * s + 3]); pw.z = pk2(st[kb][8 * s + 4], st[kb][8 * s + 5]); pw.w = pk2(st[kb][8 * s + 6], st[kb][8 * s + 7]);
                            const pg8::bf16x8 pf = __builtin_bit_cast(pg8::bf16x8, pw);
#pragma unroll
                            for (int dvb = 0; dvb < 2; ++dvb) { const LAS bf16_t* vp = Vt + bo + (dvb * 32 + r) * RS + kb * 32 + 16 * s + 4 * hg;
                                const pg8::u32x2 v0 = *(const LAS pg8::u32x2*)vp, v1 = *(const LAS pg8::u32x2*)(vp + 8);
                                pg8::u32x4 vw; vw.x = v0.x; vw.y = v0.y; vw.z = v1.x; vw.w = v1.y;
                                ot[dvb] = __builtin_amdgcn_mfma_f32_32x32x16_bf16(__builtin_bit_cast(pg8::bf16x8, vw), pf, ot[dvb], 0, 0, 0); } }
                }
            }
            const float ltot = lrun + __shfl_xor(lrun, 32); const float il = 1.0f / ltot;
            __syncthreads();
            if (comp == 1) {
#pragma unroll
                for (int dvb = 0; dvb < 2; ++dvb)
#pragma unroll
                    for (int e = 0; e < 16; ++e) Xl[(qs * 32 + dvb * 16 + e) * 64 + lane] = ot[dvb][e] * il; }
            __syncthreads();
            if (comp == 0) {
                float o[32]; float ss = 0.f;
#pragma unroll
                for (int dvb = 0; dvb < 2; ++dvb)
#pragma unroll
                    for (int e = 0; e < 16; ++e) { const float v = ot[dvb][e] * il - lam * Xl[(qs * 32 + dvb * 16 + e) * 64 + lane]; o[dvb * 16 + e] = v; ss += v * v; }
                ss += __shfl_xor(ss, 32);
                const float sc = rsqrtf(ss * (1.0f / 64.0f) + 1e-6f) * (1.0f - lam_init);
                bf16_t* od = br + (rowb + q0 + r) * D + 256 + h * 64;
#pragma unroll
                for (int dvb = 0; dvb < 2; ++dvb)
#pragma unroll
                    for (int g4 = 0; g4 < 4; ++g4) { const int dv0 = dvb * 32 + 8 * g4 + 4 * hg; const pg8::f32x4 sl = *(const pg8::f32x4*)(subln + dv0);
                        st_bf16x4(od + dv0, (pg8::f32x4){o[dvb * 16 + 4 * g4] * sc * sl[0], o[dvb * 16 + 4 * g4 + 1] * sc * sl[1], o[dvb * 16 + 4 * g4 + 2] * sc * sl[2], o[dvb * 16 + 4 * g4 + 3] * sc * sl[3]}); }
            }
            __syncthreads();
        }
    }
}

__device__ __forceinline__ void ph_branch(Frame& F, ArgsP a, int l) {
    const bf16_t* br = (const bf16_t*)(a->ws + WS_HB); const bf16_t* WB = (const bf16_t*)(a->ws + WS_WB) + (size_t)l * 4096 * 256;
    const bf16_t* proj = (const bf16_t*)(a->ws + WS_PROJ); bf16_t* MB = (bf16_t*)(a->ws + SCR_MB);
    int tid = F.wave * 64 + F.lane(); asm volatile("" : "+v"(tid)); const int lane = tid & 63;
    const int r = lane & 31, hg = lane >> 5, wt = (tid >> 6) & 3, wd = tid >> 8;
    constexpr int RS = 72, TB = 128 * RS;
    LAS bf16_t* Wl = (LAS bf16_t*)F.lds;
    LAS bf16_t* Bl = Wl + 2 * TB;
    const int ldr = tid >> 3, ldc = (tid & 7) * 8;
    for (int it = blockIdx.x; it < 1024; it += F.G) {
        const int tm = it >> 3, td = it & 7; const size_t row0 = (size_t)tm * 128; const int d0 = td * 128;
        f32x16 tot[2], acc[2];
#pragma unroll
        for (int e = 0; e < 16; ++e) { tot[0][e] = 0.f; tot[1][e] = 0.f; acc[0][e] = 0.f; acc[1][e] = 0.f; }
        pg8::u32x4 rw0, rw1, rb0, rb1;
#define BR_LOAD(st) do { const int g_ = (st) >> 2, kq_ = (st) & 3; const bf16_t* wp = WB + (size_t)(g_ * 1024 + d0 + ldr) * 256 + kq_ * 64 + ldc; const bf16_t* bp = br + (row0 + ldr) * D + g_ * 256 + kq_ * 64 + ldc; \
            rw0 = *(const pg8::u32x4*)wp; rw1 = *(const pg8::u32x4*)(wp + 64 * 256); rb0 = *(const pg8::u32x4*)bp; rb1 = *(const pg8::u32x4*)(bp + 64 * D); } while (0)
#define BR_WRITE(buf) do { *(LAS pg8::u32x4*)(Wl + (buf) * TB + ldr * RS + ldc) = rw0; *(LAS pg8::u32x4*)(Wl + (buf) * TB + (ldr + 64) * RS + ldc) = rw1; \
            *(LAS pg8::u32x4*)(Bl + (buf) * TB + ldr * RS + ldc) = rb0; *(LAS pg8::u32x4*)(Bl + (buf) * TB + (ldr + 64) * RS + ldc) = rb1; } while (0)
        BR_LOAD(0); BR_WRITE(0); __syncthreads(); BR_LOAD(1);
        pg8::u32x2 gt[2][4];
#pragma unroll 1
        for (int st = 0; st < 16; ++st) {
            const int buf = st & 1, g = st >> 2;
            if ((st & 3) == 0) {
                const bf16_t* gp = proj + (row0 + wt * 32 + r) * PW + P_GATE + g * 1024 + d0 + wd * 64 + 4 * hg;
#pragma unroll
                for (int db = 0; db < 2; ++db)
#pragma unroll
                    for (int q = 0; q < 4; ++q) gt[db][q] = *(const pg8::u32x2*)(gp + db * 32 + 8 * q); }
#pragma unroll
            for (int s = 0; s < 4; ++s) { const pg8::bf16x8 bf = *(const LAS pg8::bf16x8*)(Bl + buf * TB + (wt * 32 + r) * RS + 16 * s + 8 * hg);
#pragma unroll
                for (int db = 0; db < 2; ++db) { const pg8::bf16x8 af = *(const LAS pg8::bf16x8*)(Wl + buf * TB + (wd * 64 + db * 32 + r) * RS + 16 * s + 8 * hg);
                    acc[db] = __builtin_amdgcn_mfma_f32_32x32x16_bf16(af, bf, acc[db], 0, 0, 0); } }
            if (st + 1 < 16) BR_WRITE(buf ^ 1);
            if (st + 2 < 16) BR_LOAD(st + 2);
            if ((st & 3) == 3) {
#pragma unroll
                for (int db = 0; db < 2; ++db)
#pragma unroll
                    for (int q = 0; q < 4; ++q) { const pg8::u32x2 w = gt[db][q];
                        const float g0 = __builtin_bit_cast(float, w.x << 16), g1 = __builtin_bit_cast(float, w.x & 0xffff0000u), g2 = __builtin_bit_cast(float, w.y << 16), g3 = __builtin_bit_cast(float, w.y & 0xffff0000u);
                        tot[db][4 * q] += acc[db][4 * q] * sigm(g0); tot[db][4 * q + 1] += acc[db][4 * q + 1] * sigm(g1); tot[db][4 * q + 2] += acc[db][4 * q + 2] * sigm(g2); tot[db][4 * q + 3] += acc[db][4 * q + 3] * sigm(g3);
                        acc[db][4 * q] = 0.f; acc[db][4 * q + 1] = 0.f; acc[db][4 * q + 2] = 0.f; acc[db][4 * q + 3] = 0.f; } }
            __syncthreads();
        }
#undef BR_LOAD
#undef BR_WRITE
        bf16_t* mp = MB + (row0 + wt * 32 + r) * D + d0 + wd * 64 + 4 * hg;
#pragma unroll
        for (int db = 0; db < 2; ++db)
#pragma unroll
            for (int q = 0; q < 4; ++q) st_bf16x4(mp + db * 32 + 8 * q, (pg8::f32x4){tot[db][4 * q], tot[db][4 * q + 1], tot[db][4 * q + 2], tot[db][4 * q + 3]});
    }
}
constexpr int RING_BYTES = 131072, LDSCTL_OFF = RING_BYTES, MISC_OFF = LDSCTL_OFF + 320, LDS_BYTES = 147456;
constexpr int PH_PRO = 0, PH_H0 = 1, PH_L0 = 2, PH_PER_LAYER = 12, PH_END = PH_L0 + 2 * PH_PER_LAYER;
constexpr int PL_PROJ = 0, PL_MIXA = 1, PL_MIXB = 2, PL_MIXC = 3, PL_BRANCH = 4, PL_OUT = 5, PL_ROWMIX = 6, PL_FFN1 = 7, PL_FFN2 = 8, PL_FFN3 = 9, PL_ROWFFN = 10;

#ifndef DUPMASK
#define DUPMASK 0
#endif
#define DUP(bit) for (int dup_ = 0; dup_ < (((DUPMASK) >> (bit)) & 1) + 1; ++dup_)
__global__ void __launch_bounds__(NTHR, 2) mk_fwd(Args a) {
    extern __shared__ __attribute__((aligned(16))) unsigned char lds_raw[];
    Frame F0;
    F0.lds = (LAS unsigned char*)lds_raw;
    F0.wave = __builtin_amdgcn_readfirstlane(threadIdx.x >> 6);
    F0.G = gridDim.x; F0.gw = blockIdx.x * NWAVES + F0.wave; F0.NGW = F0.G * NWAVES;
    volatile LAS unsigned* MISC = (volatile LAS unsigned*)(F0.lds + MISC_OFF);
    for (int u = threadIdx.x; u < (LDS_BYTES - LDSCTL_OFF) / 4; u += NTHR) ((LAS unsigned*)(F0.lds + LDSCTL_OFF))[u] = 0u;
    __syncthreads();
    unsigned* ctl = (unsigned*)(a.ws + WS_CTL);
    const int lo = a.ph_lo, hi = a.ph_hi;
    XcdBarrier bar; bar.bar = ctl + CW_BAR; bar.x = 0; bar.st = nullptr;
    if (hi - lo > 1) bar = xcd_barrier_post(ctl + CW_BAR, MISC + 8);
#define IN(k) (lo <= (k) && (k) < hi)
#define SEAM(k) do { if (IN(k) && IN((k) + 1)) { xcd_barrier(bar); if ((DUPMASK >> 12) & 1) xcd_barrier(bar); } } while (0)
    if (IN(PH_PRO)) DUP(0) { ArgsP A = fresh_args(); Frame F = fresh(F0); p0_mod_items(F, (const float*)A->in[1], (const float*)A->in[3], (const float*)A->in[4], (float*)(A->ws + WS_MOD)); p0_convert(F, A); }
    SEAM(PH_PRO);
    if (IN(PH_H0)) DUP(9) { Frame F = fresh(F0); ph_h0(F, fresh_args()); }
    SEAM(PH_H0);
    for (int l = 0; l < NL; ++l) {
        const int base = PH_L0 + l * PH_PER_LAYER;
        if (IN(base + PL_PROJ)) DUP(13) { ArgsP A = fresh_args(); Frame F = fresh(F0); unsigned char* ws = A->ws;
            pg8::Gemm g{(const bf16_t*)(ws + WS_HB), (const bf16_t*)(ws + WS_WIN) + (size_t)l * PW * 1024, 1024, 1024, 1024, 0}; pg8::StaticOrder S; S.init(M, 7168, F.G, (int)blockIdx.x);
            pg8::EpiBf16 E{(bf16_t*)(ws + WS_PROJ), PW, 28};
            pg8::gemm_phase<pg8::EpiBf16, pg8::StaticOrder, true>(F.lds, g, S, E, F.wave);
        }
        SEAM(base + PL_PROJ);
        if (IN(base + PL_MIXA)) { DUP(2) { Frame F = fresh(F0); ph_conv(F, fresh_args(), l); } DUP(6) { Frame F = fresh(F0); ph_rwkv_prep(F, fresh_args(), l); } DUP(7) { Frame F = fresh(F0); ph_gla_p1(F, fresh_args(), l); } DUP(8) { Frame F = fresh(F0); ph_attn_prep(F, fresh_args()); } }
        SEAM(base + PL_MIXA);
        if (IN(base + PL_MIXB)) { DUP(10) { Frame F = fresh(F0); ph_gla_prefix(F, fresh_args()); } DUP(3) { Frame F = fresh(F0); ph_rwkv_scan(F, fresh_args()); } DUP(4) { Frame F = fresh(F0); ph_attn(F, fresh_args(), l); } }
        SEAM(base + PL_MIXB);
        if (IN(base + PL_MIXC)) { DUP(5) { Frame F = fresh(F0); ph_rwkv_post(F, fresh_args(), l); } DUP(11) { Frame F = fresh(F0); ph_gla_p2(F, fresh_args(), l); } }
        SEAM(base + PL_MIXC);
        if (IN(base + PL_BRANCH)) DUP(14) { ArgsP A = fresh_args(); Frame F = fresh(F0); unsigned char* ws = A->ws;
            pg8::Gemm g{(const bf16_t*)(ws + WS_HB), (const bf16_t*)(ws + WS_WB) + (size_t)l * 1024 * 1024, 1024, 1024, 1024, 0}; pg8::StaticOrder S; S.init(M, 1024, F.G, (int)blockIdx.x);
            pg8::EpiBranchK E{(const bf16_t*)(ws + WS_PROJ), (bf16_t*)(ws + SCR_MB)};
            pg8::gemm_phase<pg8::EpiBranchK, pg8::StaticOrder, false>(F.lds, g, S, E, F.wave);
        }
        SEAM(base + PL_BRANCH);
        if (IN(base + PL_OUT)) DUP(1) { ArgsP A = fresh_args(); Frame F = fresh(F0); unsigned char* ws = A->ws;
            pg8::Gemm g{(const bf16_t*)(ws + SCR_MB), (const bf16_t*)(ws + WS_WO) + (size_t)l * 1024 * 1024, 1024, 1024, 1024, 0}; pg8::StaticOrder S; S.init(M, 1024, F.G, (int)blockIdx.x);
            pg8::EpiBf16 E{(bf16_t*)(ws + SCR_Y), 1024, 4};
            pg8::gemm_phase<pg8::EpiBf16, pg8::StaticOrder, false>(F.lds, g, S, E, F.wave);
        }
        SEAM(base + PL_OUT);
        if (IN(base + PL_ROWMIX)) { ArgsP A = fresh_args(); Frame F = fresh(F0); unsigned char* ws = A->ws; const float* modl = (const float*)(ws + WS_MOD) + (size_t)l * 8 * 6144;
            ph_row(F, A, l == 0 ? (const float*)A->in[0] : A->out, (const bf16_t*)(ws + SCR_Y), (const float*)A->in[6] + l * D, modl, 2048, (const float*)A->in[7] + l * D, modl, 3072, 4096, (bf16_t*)(ws + (l == 0 ? WS_HB : WS_H2L1)), l == 1); }
        SEAM(base + PL_ROWMIX);
        if (l == 0) {
            if (IN(base + PL_FFN1)) DUP(1) { ArgsP A = fresh_args(); Frame F = fresh(F0); unsigned char* ws = A->ws;
                pg8::Gemm g{(const bf16_t*)(ws + WS_HB), (const bf16_t*)(ws + WS_WF1), 1024, 1024, 1024, 0}; pg8::StaticOrder S; S.init(M, 2 * DFF, F.G, (int)blockIdx.x);
                pg8::EpiSwiglu E{(bf16_t*)(ws + WS_PROJ), DFF, 2 * DFF / 256};
                pg8::gemm_phase<pg8::EpiSwiglu, pg8::StaticOrder, true>(F.lds, g, S, E, F.wave);
            }
            SEAM(base + PL_FFN1);
            if (IN(base + PL_FFN2)) DUP(1) { ArgsP A = fresh_args(); Frame F = fresh(F0); unsigned char* ws = A->ws;
                pg8::Gemm g{(const bf16_t*)(ws + WS_PROJ), (const bf16_t*)(ws + WS_WF2), DFF, DFF, DFF, 0}; pg8::StaticOrder S; S.init(M, 1024, F.G, (int)blockIdx.x);
                pg8::EpiBf16 E{(bf16_t*)(ws + SCR_Y), 1024, 4};
                pg8::gemm_phase<pg8::EpiBf16, pg8::StaticOrder, false>(F.lds, g, S, E, F.wave);
            }
            SEAM(base + PL_FFN2);
        } else {
            if (IN(base + PL_FFN1)) DUP(0) { Frame F = fresh(F0); ph_moe_prep(F, fresh_args()); }
            SEAM(base + PL_FFN1);
            if (IN(base + PL_FFN2)) DUP(15) { ArgsP A = fresh_args(); Frame F = fresh(F0); unsigned char* ws = A->ws; const unsigned* cnt = (const unsigned*)(ws + WS_CTL) + CW_CNT;
                pg8::Gemm g{(const bf16_t*)(ws + WS_HG), (const bf16_t*)(ws + WS_WM1), 1024, 1024, 1024, 0}; pg8::MoeOrder<28> S; S.init(cnt, F.G, (int)blockIdx.x);
                pg8::EpiSwiglu E{(bf16_t*)(ws + WS_HID), DEX, 28};
                pg8::gemm_phase<pg8::EpiSwiglu, pg8::MoeOrder<28>, true>(F.lds, g, S, E, F.wave);
            }
            SEAM(base + PL_FFN2);
            if (IN(base + PL_FFN3)) DUP(16) { ArgsP A = fresh_args(); Frame F = fresh(F0); unsigned char* ws = A->ws; const unsigned* cnt = (const unsigned*)(ws + WS_CTL) + CW_CNT;
                pg8::Gemm g{(const bf16_t*)(ws + WS_HID), (const bf16_t*)(ws + WS_WM2), DEX, DEX, DEX, 0}; pg8::MoeOrder<4> S; S.init(cnt, F.G, (int)blockIdx.x);
                pg8::EpiBf16 E{(bf16_t*)(ws + WS_HG), 1024, 4};
                pg8::gemm_phase<pg8::EpiBf16, pg8::MoeOrder<4>, true>(F.lds, g, S, E, F.wave);
            }
            SEAM(base + PL_FFN3);
        }
        if (IN(base + PL_ROWFFN)) { ArgsP A = fresh_args(); Frame F = fresh(F0); unsigned char* ws = A->ws; const float* modl = (const float*)(ws + WS_MOD) + (size_t)l * 8 * 6144;
            const bool last = (l == NL - 1);
            if (l == 0) ph_row(F, A, A->out, (const bf16_t*)(ws + SCR_Y), (const float*)A->in[8], modl, 5120, (const float*)A->in[5] + D, modl + 8 * 6144, 0, 1024, (bf16_t*)(ws + WS_HB), false, nullptr, (const float*)A->in[9] + (size_t)1024 * NIN);
            else ph_row(F, A, A->out, nullptr, (const float*)A->in[8] + D, modl, 5120, nullptr, nullptr, 0, 1024, nullptr, false, (const bf16_t*)(ws + WS_HG));
        }
        SEAM(base + PL_ROWFFN);
    }
#undef IN
#undef SEAM
}

extern "C" void kernel_launch(void* const* d_in, const int* in_sizes, int n_in, void* d_out, int out_size, void* d_ws, size_t ws_size, hipStream_t stream) {
    static int grid = 0;
    if (grid == 0) {
        if (n_in != 40 || ws_size < WS_END) { fprintf(stderr, "kernel_launch: need 40 inputs and >= %zu bytes of workspace (got %d, %zu)\n", (size_t)WS_END, n_in, ws_size); grid = -1; return; }
        int dev = 0, cus = 0, per_cu = 0;
        (void)hipGetDevice(&dev); (void)hipDeviceGetAttribute(&cus, hipDeviceAttributeMultiprocessorCount, dev);
        (void)hipFuncSetAttribute((const void*)mk_fwd, hipFuncAttributeMaxDynamicSharedMemorySize, LDS_BYTES);
        (void)hipOccupancyMaxActiveBlocksPerMultiprocessor(&per_cu, (const void*)mk_fwd, NTHR, LDS_BYTES);
        (void)hipGetLastError();
        grid = cus > 0 ? cus : 256;
        if (per_cu < 1) fprintf(stderr, "kernel_launch: occupancy query says %d blocks per CU\n", per_cu);
    }
    if (grid < 0) return;
    unsigned char* ws = (unsigned char*)d_ws;
    (void)hipMemsetAsync(ws + WS_CTL, 0, CTL_ZERO_BYTES, stream);
    Args a{};
    for (int i = 0; i < 40; ++i) a.in[i] = d_in[i];
    a.out = (float*)d_out; a.ws = ws;
    a.ph_lo = 0; a.ph_hi = PH_L0 + (NL - 1) * PH_PER_LAYER + PL_ROWFFN + 1;
    hipLaunchKernelGGL(mk_fwd, dim3(grid), dim3(NTHR), LDS_BYTES, stream, a);
}
```

```cpp
#include <hip/hip_runtime.h>
#include <hip/hip_bf16.h>
#include <cstdint>
#include <cstdio>

typedef __hip_bfloat16 bf16;
typedef unsigned short bf16_t;
#define GAS __attribute__((address_space(1)))
#define LAS __attribute__((address_space(3)))

constexpr int D = 1024, NB = 8, T = 2048, M = NB * T, NL = 2;
constexpr int NIN = 7184;
constexpr int PW = 7424;
constexpr int P_GQ = 0, P_GK = 128, P_GV = 256, P_GO = 512, P_DQ = 768, P_DK = 1024, P_DV = 1280, P_CA = 1536, P_CB = 1792, P_R = 2048, P_GATE = 3072, P_GZ = 7168;
constexpr int DFF = 2816, NE = 8, DEX = 3584;
constexpr int NWAVES = 8, NTHR = 512;
constexpr size_t MiB = 1u << 20;
constexpr size_t WS_CTL = 0;
constexpr size_t CTL_ZERO_BYTES = 64 * 1024;
constexpr size_t WS_MOD = 1 * MiB;
constexpr size_t WS_ROUTE = 1 * MiB + 512 * 1024;
constexpr size_t WS_GZ = 2 * MiB + 512 * 1024;
constexpr size_t WS_LR = 3 * MiB;
constexpr size_t WS_WIN = 4 * MiB;
constexpr size_t WS_WB = 33 * MiB;
constexpr size_t WS_WO = 37 * MiB;
constexpr size_t WS_WF1 = 41 * MiB;
constexpr size_t WS_WF2 = 52 * MiB;
constexpr size_t WS_HB = 58 * MiB;
constexpr size_t WS_PROJ = 90 * MiB;
constexpr size_t WS_SCR = 322 * MiB;
constexpr size_t WS_H2L1 = 508 * MiB;
constexpr size_t WS_END = 540 * MiB;
constexpr size_t WS_HG = 4 * MiB;
constexpr size_t WS_WM1 = 72 * MiB;
constexpr size_t WS_WM2 = 184 * MiB;
constexpr size_t WS_HID = 240 * MiB;
static_assert(WS_HID + (size_t)34816 * 3584 * 2 <= WS_H2L1, "moe overlay");
constexpr size_t SCR_MP = WS_SCR;
constexpr size_t SCR_MB = WS_SCR + 64 * MiB;
constexpr size_t SCR_Y = WS_SCR + 96 * MiB;
constexpr size_t SCR_RW = WS_SCR;
constexpr size_t SCR_GK = WS_SCR + 112 * MiB;
constexpr size_t SCR_QR = WS_SCR + 120 * MiB;
constexpr size_t SCR_KR = WS_SCR + 136 * MiB;
constexpr size_t SCR_VEC6 = WS_SCR;
constexpr size_t SCR_SC = WS_SCR + 56 * MiB;
constexpr size_t SCR_STM = WS_SCR + 57 * MiB;
constexpr size_t SCR_GR = WS_SCR + 73 * MiB;
constexpr size_t SCR_VT = WS_SCR + 81 * MiB;
constexpr size_t SCR_GU = WS_SCR + 89 * MiB;
constexpr size_t SCR_GS = SCR_GU;
constexpr size_t SCR_QK = WS_SCR + 105 * MiB;
constexpr size_t SCR_EG = WS_SCR + 121 * MiB;
constexpr size_t SCR_QE = WS_SCR + 130 * MiB;
constexpr size_t SCR_AY = WS_SCR + 138 * MiB;
constexpr size_t SCR_VTC = WS_SCR + 142 * MiB;
constexpr size_t SCR_GMF = WS_SCR + 150 * MiB;
constexpr size_t SCR_ZB = WS_SCR + 166 * MiB;
constexpr size_t SCR_YR = WS_SCR + 166 * MiB;
constexpr int RECB = 896;
constexpr size_t WS_GOI = WS_H2L1;
constexpr size_t WS_GST = WS_H2L1 + 16 * MiB;
constexpr int CW_TMO = 0;
constexpr int CW_BAR = 1024;
constexpr int CW_CNT = 8192;
constexpr size_t RT_LIST = 0;
constexpr size_t RT_TOKE = 512 * 1024;
constexpr size_t RT_TOKS = 640 * 1024;
constexpr size_t RT_TOKP = 768 * 1024;

__device__ __forceinline__ float sigm(float x) { return __builtin_amdgcn_rcpf(1.0f + __expf(-x)); }
__device__ __forceinline__ float siluf(float x) { return x * sigm(x); }
__device__ __forceinline__ float softplusf(float x) { return fmaxf(x, 0.f) + __logf(1.0f + __expf(-fabsf(x))); }
__device__ __forceinline__ float tanh_fast(float x) { return 1.0f - 2.0f * __builtin_amdgcn_rcpf(1.0f + __expf(2.0f * x)); }
template <int CTRL, int ROWMASK> __device__ __forceinline__ float dpp_mov_h(float old, float x) {
    return __builtin_bit_cast(float, __builtin_amdgcn_update_dpp(__builtin_bit_cast(int, old), __builtin_bit_cast(int, x), CTRL, ROWMASK, 0xF, false)); }
__device__ __forceinline__ float wave_sum(float x) {
    x += dpp_mov_h<0xB1, 0xF>(0.f, x); x += dpp_mov_h<0x4E, 0xF>(0.f, x); x += dpp_mov_h<0x141, 0xF>(0.f, x); x += dpp_mov_h<0x140, 0xF>(0.f, x);
    x += dpp_mov_h<0x142, 0xA>(0.f, x); x += dpp_mov_h<0x143, 0xC>(0.f, x);
    return __builtin_bit_cast(float, __builtin_amdgcn_readlane(__builtin_bit_cast(int, x), 63));
}
__device__ __forceinline__ float wave_max(float v) {
#pragma unroll
    for (int o = 32; o > 0; o >>= 1) v = fmaxf(v, __shfl_xor(v, o));
    return v;
}
__device__ __forceinline__ float ldf(const float* p) { return *p; }
__device__ __forceinline__ float ldf(const bf16* p) { return __bfloat162float(*p); }
__device__ __forceinline__ float bf2f(bf16_t u) { return __builtin_bit_cast(float, (unsigned)u << 16); }
__device__ __forceinline__ unsigned f2bf(float f) { unsigned u = __builtin_bit_cast(unsigned, f); return (u + 0x7fffu + ((u >> 16) & 1u)) >> 16; }
typedef float f32x2_t_ __attribute__((ext_vector_type(2))); typedef __bf16 bf16x2_t_ __attribute__((ext_vector_type(2)));
__device__ __forceinline__ unsigned pk2(float lo, float hi) { const f32x2_t_ v = {lo, hi}; const bf16x2_t_ b = __builtin_convertvector(v, bf16x2_t_); return __builtin_bit_cast(unsigned, b); }
namespace pg8 {
#define PG8_LAS __attribute__((address_space(3)))
typedef short bf16x8 __attribute__((ext_vector_type(8)));
typedef float f32x4 __attribute__((ext_vector_type(4)));
typedef float f32x2 __attribute__((ext_vector_type(2)));
typedef unsigned u32x4 __attribute__((ext_vector_type(4)));
typedef unsigned u32x2 __attribute__((ext_vector_type(2)));
constexpr int BM = 256, BK = 64, HALF = 128, HTB = HALF * BK * 2  , STAGE_BYTES = 8 * HTB, NXCD = 8, WGM = 8;

__host__ __device__ __forceinline__ int lds_byte(int r, int c) { const int st = (r >> 4) * 2 + (c >> 5), rr = r & 15, cc = c & 31, ob = rr * 64 + cc * 2; return st * 1024 + (ob ^ (((ob >> 9) & 1) << 5)); }
__host__ __device__ __forceinline__ void stage_rc(int b, int& R, int& C) { const int st = b / 1024, sb = b % 1024, swz = sb ^ (((sb >> 9) & 1) << 5); R = (st >> 1) * 16 + swz / 64; C = (st & 1) * 32 + (swz % 64) / 2; }
__host__ __device__ __forceinline__ int perm32(int rho) { const int n = rho >> 4, i = rho & 15; return 8 * (i >> 2) + 4 * n + (i & 3); }

struct Unit { int pm, pn, aoff, tag; };
struct Gemm { const bf16_t* A; const bf16_t* Bt; int lda, ldb, K, pad; };

struct StaticOrder {
    int nM, nN, nwg, G, c;
    __host__ __device__ void init(int M_, int N_, int G_, int c_) { nM = M_ / BM; nN = N_ / BM; nwg = nM * nN; G = G_; c = c_; }
    __host__ __device__ bool next(int i, Unit& u) const {
        const long L = (long)i * G + c; if (L >= nwg) return false;
        int wgid = (int)L; { const int q = nwg / NXCD, r = nwg % NXCD, xcd = wgid % NXCD, off = wgid / NXCD; wgid = (xcd < r ? xcd * (q + 1) : r * (q + 1) + (xcd - r) * q) + off; }
        const int nig = WGM * nN, gid = wgid / nig, fm = gid * WGM, gsz = (nM - fm) < WGM ? (nM - fm) : WGM;
        u.pm = fm + ((wgid % nig) % gsz); u.pn = (wgid % nig) / gsz; u.aoff = 0; u.tag = 0; return true;
    }
};

__device__ __forceinline__ unsigned cvt_pk_bf16(float lo, float hi) { unsigned r; asm volatile("v_cvt_pk_bf16_f32 %0, %1, %2" : "=v"(r) : "v"(lo), "v"(hi)); return r; }


template <class Epi, class Sched, bool ALIGN_EPI>
__device__ __forceinline__ void gemm_phase(PG8_LAS unsigned char* lds, const Gemm g, const Sched& S, const Epi& E, int wave_s) {
    unsigned z_ = 0u; asm volatile("" : "+v"(z_));
    int tid_ = wave_s * 64 + (int)__builtin_amdgcn_mbcnt_hi(~0u, __builtin_amdgcn_mbcnt_lo(~0u, z_)); asm volatile("" : "+v"(tid_));
    const int tid = tid_, wid = __builtin_amdgcn_readfirstlane(tid >> 6), lane = tid & 63, wr = wid >> 2, wc = wid & 3, fr = lane & 15, fq = lane >> 4;
    const int K = g.K, nt = K / BK;
    unsigned voffA[2], voffB[2];
#pragma unroll
    for (int i = 0; i < 2; ++i) { int R, C; stage_rc(tid * 16 + i * 8192, R, C); const int Rb = Epi::PERM ? ((R & ~31) + perm32(R & 31)) : R;
        voffA[i] = (unsigned)(R * g.lda + C) * 2u; voffB[i] = (unsigned)(Rb * g.ldb + C) * 2u; }
    const size_t kstep = (size_t)(BK * 2);
    const size_t hstepA = (size_t)HALF * g.lda * 2, hstepB = (size_t)HALF * g.ldb * 2;
    const size_t tstepA = 2 * hstepA, tstepB = 2 * hstepB;
    const unsigned ldsw = (unsigned)wid * 1024u;
    const int aoff = lds_byte(wr * 64 + fr, fq * 8), boff = lds_byte(wc * 32 + fr, fq * 8);
#define PG8_SA(b, h) (((b) * 2 + (h)) * HTB)
#define PG8_SB(b, h) ((4 + (b) * 2 + (h)) * HTB)
#define PG8_STAGE(bufoff, gbase, voff) do { _Pragma("unroll") for (int _i = 0; _i < 2; ++_i) \
        __builtin_amdgcn_global_load_lds((const unsigned*)((const char*)(gbase) + (voff)[_i]), (PG8_LAS unsigned*)(lds + (bufoff) + ldsw + _i * 8192), 16, 0, 0); } while (0)
#define PG8_LDA(dst, b, h) do { _Pragma("unroll") for (int m = 0; m < 4; ++m) _Pragma("unroll") for (int k = 0; k < 2; ++k) dst[m][k] = *(const PG8_LAS bf16x8*)(lds + PG8_SA(b, h) + aoff + m * 2048 + k * 1024); } while (0)
#define PG8_LDB(dst, b, h) do { _Pragma("unroll") for (int n = 0; n < 2; ++n) _Pragma("unroll") for (int k = 0; k < 2; ++k) dst[n][k] = *(const PG8_LAS bf16x8*)(lds + PG8_SB(b, h) + boff + n * 2048 + k * 1024); } while (0)
#define PG8_MMA(ai, bj, At, Bt) do { __builtin_amdgcn_s_setprio(1); _Pragma("unroll") for (int m = 0; m < 4; ++m) _Pragma("unroll") for (int n = 0; n < 2; ++n) _Pragma("unroll") for (int k = 0; k < 2; ++k) \
        acc[ai][bj][m][n] = __builtin_amdgcn_mfma_f32_16x16x32_bf16(Bt[n][k], At[m][k], acc[ai][bj][m][n], 0, 0, 0); __builtin_amdgcn_s_setprio(0); } while (0)
#define PG8_WAIT_V(n) asm volatile("s_waitcnt vmcnt(" #n ")" ::: "memory")
#define PG8_WAIT_L(n) asm volatile("s_waitcnt lgkmcnt(" #n ")" ::: "memory")
#define PG8_BAR __builtin_amdgcn_s_barrier()
#define PG8_SCHED __builtin_amdgcn_sched_barrier(0)
    Unit cur, nxt; int ui = 0;
    if (!S.next(0, cur)) return;
    f32x4 acc[2][2][4][2];
#pragma unroll
    for (int a = 0; a < 2; ++a)
#pragma unroll
        for (int b = 0; b < 2; ++b)
#pragma unroll
            for (int m = 0; m < 4; ++m)
#pragma unroll
                for (int n = 0; n < 2; ++n) acc[a][b][m][n] = (f32x4){0.f, 0.f, 0.f, 0.f};
    bf16x8 At[4][2], B0[2][2], B1[2][2];
    const char* cA = (const char*)g.A + (size_t)cur.pm * tstepA + (size_t)cur.aoff * 2; const char* cB = (const char*)g.Bt + (size_t)cur.pn * tstepB;
    PG8_STAGE(PG8_SB(0, 0), cB, voffB); PG8_STAGE(PG8_SB(0, 1), cB + hstepB, voffB); PG8_STAGE(PG8_SA(0, 0), cA, voffA); PG8_STAGE(PG8_SA(0, 1), cA + hstepA, voffA);
    if (wr == 1) PG8_BAR;
    PG8_WAIT_V(2); PG8_BAR;
    PG8_STAGE(PG8_SB(1, 0), cB + kstep, voffB); PG8_STAGE(PG8_SA(1, 0), cA + kstep, voffA); PG8_STAGE(PG8_SB(1, 1), cB + hstepB + kstep, voffB);
    PG8_WAIT_V(6); PG8_BAR;
    for (;;) {
        const bool has_next = S.next(ui + 1, nxt);
        const char* nA = has_next ? (const char*)g.A + (size_t)nxt.pm * tstepA + (size_t)nxt.aoff * 2 : cA; const char* nB = has_next ? (const char*)g.Bt + (size_t)nxt.pn * tstepB : cB;
        for (int t = 0; t < nt; t += 2) {
            if constexpr (Epi::MIDK) { if (t != 0 && (t & 3) == 0) E.mid(acc, cur, t >> 2, wr, wc); }
            const bool last = (t == nt - 2);
            const char* a1 = cA + (size_t)(t + 1) * kstep;
            const char* a2 = last ? nA : cA + (size_t)(t + 2) * kstep; const char* b2 = last ? nB : cB + (size_t)(t + 2) * kstep;
            const char* a3 = a2 + kstep; const char* b3 = b2 + kstep;
            PG8_LDB(B0, 0, 0); PG8_LDB(B1, 0, 1); PG8_SCHED; PG8_LDA(At, 0, 0); PG8_STAGE(PG8_SA(1, 1), a1 + hstepA, voffA);
            PG8_WAIT_V(8); PG8_WAIT_L(0); PG8_BAR; PG8_MMA(0, 0, At, B0); PG8_MMA(0, 1, At, B1); PG8_BAR; PG8_SCHED;
            PG8_LDA(At, 0, 1); PG8_STAGE(PG8_SB(0, 0), b2, voffB); PG8_STAGE(PG8_SB(0, 1), b2 + hstepB, voffB); PG8_STAGE(PG8_SA(0, 0), a2, voffA);
            PG8_WAIT_V(8); PG8_WAIT_L(0); PG8_BAR; PG8_MMA(1, 0, At, B0); PG8_MMA(1, 1, At, B1); PG8_BAR; PG8_SCHED;
            PG8_LDB(B0, 1, 0); PG8_LDB(B1, 1, 1); PG8_SCHED; PG8_LDA(At, 1, 0); PG8_STAGE(PG8_SA(0, 1), a2 + hstepA, voffA);
            PG8_WAIT_V(8); PG8_WAIT_L(0); PG8_BAR; PG8_MMA(0, 0, At, B0); PG8_MMA(0, 1, At, B1); PG8_BAR; PG8_SCHED;
            PG8_LDA(At, 1, 1); PG8_STAGE(PG8_SB(1, 0), b3, voffB); PG8_STAGE(PG8_SB(1, 1), b3 + hstepB, voffB); PG8_STAGE(PG8_SA(1, 0), a3, voffA);
            PG8_WAIT_V(8); PG8_WAIT_L(0); PG8_BAR; PG8_MMA(1, 0, At, B0); PG8_MMA(1, 1, At, B1); PG8_BAR; PG8_SCHED;
        }
        if constexpr (ALIGN_EPI) { if (wr == 0) PG8_BAR; }
        { unsigned z2_ = 0u; asm volatile("" : "+v"(z2_)); const int l2_ = (int)__builtin_amdgcn_mbcnt_hi(~0u, __builtin_amdgcn_mbcnt_lo(~0u, z2_));
          E(acc, cur, wr, wc, l2_ & 15, l2_ >> 4); }
        if (!has_next) break;
#pragma unroll
        for (int a = 0; a < 2; ++a)
#pragma unroll
            for (int b = 0; b < 2; ++b)
#pragma unroll
                for (int m = 0; m < 4; ++m)
#pragma unroll
                    for (int n = 0; n < 2; ++n) acc[a][b][m][n] = (f32x4){0.f, 0.f, 0.f, 0.f};
        cur = nxt; cA = nA; cB = nB; ++ui;
        if constexpr (ALIGN_EPI) { if (wr == 1) PG8_BAR; }
    }
    PG8_WAIT_V(0);
    if constexpr (!ALIGN_EPI) { if (wr == 0) PG8_BAR; }
    PG8_BAR;
#undef PG8_SA
#undef PG8_SB
#undef PG8_STAGE
#undef PG8_LDA
#undef PG8_LDB
#undef PG8_MMA
#undef PG8_WAIT_V
#undef PG8_WAIT_L
#undef PG8_BAR
#undef PG8_SCHED
}

struct EpiBf16 {
    static constexpr bool PERM = true, MIDK = false;
    bf16_t* O; int ldc; int ntn;
    __device__ __forceinline__ void operator()(const f32x4 (&acc)[2][2][4][2], const Unit& u, int wr, int wc, int fr, int fq) const {
        const int row0 = u.pm * BM + wr * 64 + fr, col0 = (u.pn % ntn) * BM + wc * 32 + 8 * fq;
#pragma unroll
        for (int ai = 0; ai < 2; ++ai)
#pragma unroll
            for (int m = 0; m < 4; ++m) { bf16_t* rowp = O + (size_t)(row0 + ai * HALF + m * 16) * ldc + col0;
#pragma unroll
                for (int bj = 0; bj < 2; ++bj) { const f32x4 v0 = acc[ai][bj][m][0], v1 = acc[ai][bj][m][1];
                    u32x4 w; w.x = cvt_pk_bf16(v0[0], v0[1]); w.y = cvt_pk_bf16(v0[2], v0[3]); w.z = cvt_pk_bf16(v1[0], v1[1]); w.w = cvt_pk_bf16(v1[2], v1[3]);
                    *(u32x4*)(rowp + bj * HALF) = w; } }
    }
};
struct EpiF32 {
    static constexpr bool PERM = false, MIDK = false;
    float* C; int ldc; int ntn;
    __device__ __forceinline__ void operator()(const f32x4 (&acc)[2][2][4][2], const Unit& u, int wr, int wc, int fr, int fq) const {
        const int row0 = u.pm * BM + wr * 64 + fr, col0 = (u.pn % ntn) * BM + wc * 32 + 4 * fq;
#pragma unroll
        for (int ai = 0; ai < 2; ++ai)
#pragma unroll
            for (int m = 0; m < 4; ++m) { float* rowp = C + (size_t)(row0 + ai * HALF + m * 16) * ldc + col0;
#pragma unroll
                for (int bj = 0; bj < 2; ++bj)
#pragma unroll
                    for (int n = 0; n < 2; ++n) *(f32x4*)(rowp + bj * HALF + n * 16) = acc[ai][bj][m][n]; }
    }
};
struct EpiSwiglu {
    static constexpr bool PERM = true, MIDK = false;
    bf16_t* O; int ldc; int ntn;
    __device__ __forceinline__ void operator()(const f32x4 (&acc)[2][2][4][2], const Unit& u, int wr, int wc, int fr, int fq) const {
        const int row0 = u.pm * BM + wr * 64 + fr, col0 = (u.pn % ntn) * 128 + wc * 16 + 4 * fq;
#pragma unroll
        for (int ai = 0; ai < 2; ++ai)
#pragma unroll
            for (int m = 0; m < 4; ++m) { bf16_t* rowp = O + (size_t)(row0 + ai * HALF + m * 16) * ldc + col0;
#pragma unroll
                for (int bj = 0; bj < 2; ++bj) { const f32x4 gt = acc[ai][bj][m][0], up = acc[ai][bj][m][1];
                    float h[4];
#pragma unroll
                    for (int e = 0; e < 4; ++e) h[e] = gt[e] * __builtin_amdgcn_rcpf(1.0f + __expf(-gt[e])) * up[e];
                    u32x2 w; w.x = cvt_pk_bf16(h[0], h[1]); w.y = cvt_pk_bf16(h[2], h[3]);
                    *(u32x2*)(rowp + bj * 64) = w; } }
    }
};
struct EpiBranch {
    static constexpr bool PERM = true, MIDK = false;
    const bf16_t* proj; float* MP; bf16_t* MB;
    __device__ __forceinline__ void operator()(const f32x4 (&acc)[2][2][4][2], const Unit& u, int wr, int wc, int fr, int fq) const {
        const int g = u.tag; const int row0 = u.pm * BM + wr * 64 + fr, col0 = (u.pn & 3) * BM + wc * 32 + 8 * fq;
#pragma unroll
        for (int ai = 0; ai < 2; ++ai)
#pragma unroll
            for (int m = 0; m < 4; ++m) { const size_t row = (size_t)(row0 + ai * HALF + m * 16);
#pragma unroll
                for (int bj = 0; bj < 2; ++bj) { const int col = col0 + bj * HALF;
                    const u32x4 gw = *(const u32x4*)(proj + row * PW + P_GATE + g * 1024 + col);
                    float gv[8];
#pragma unroll
                    for (int e = 0; e < 4; ++e) { const unsigned w = gw[e]; gv[2 * e] = __builtin_bit_cast(float, w << 16); gv[2 * e + 1] = __builtin_bit_cast(float, w & 0xffff0000u); }
                    f32x4 v0 = acc[ai][bj][m][0], v1 = acc[ai][bj][m][1];
#pragma unroll
                    for (int e = 0; e < 4; ++e) { v0[e] *= __builtin_amdgcn_rcpf(1.0f + __expf(-gv[e])); v1[e] *= __builtin_amdgcn_rcpf(1.0f + __expf(-gv[4 + e])); }
                    float* mp = MP + row * D + col;
                    if (g > 0) { v0 += *(const f32x4*)mp; v1 += *(const f32x4*)(mp + 4); }
                    if (g < 3) { *(f32x4*)mp = v0; *(f32x4*)(mp + 4) = v1; }
                    else { u32x4 w; w.x = cvt_pk_bf16(v0[0], v0[1]); w.y = cvt_pk_bf16(v0[2], v0[3]); w.z = cvt_pk_bf16(v1[0], v1[1]); w.w = cvt_pk_bf16(v1[2], v1[3]);
                        *(u32x4*)(MB + row * D + col) = w; } } }
    }
};
struct EpiBranchK {
    static constexpr bool PERM = true, MIDK = true;
    const bf16_t* proj; bf16_t* MB;
    __device__ __forceinline__ static float em(float x) { return fminf(__expf(-x), 1e20f); }
    __device__ __forceinline__ void mid(f32x4 (&acc)[2][2][4][2], const Unit& u, int gnext, int wr, int wc) const {
        unsigned z_ = 0u; asm volatile("" : "+v"(z_)); const int l_ = (int)__builtin_amdgcn_mbcnt_hi(~0u, __builtin_amdgcn_mbcnt_lo(~0u, z_)); const int fr = l_ & 15, fq = l_ >> 4;
        const int row0 = u.pm * BM + wr * 64 + fr, col0 = u.pn * BM + wc * 32 + 8 * fq;
#pragma unroll
        for (int ai = 0; ai < 2; ++ai)
#pragma unroll
            for (int m = 0; m < 4; ++m) { const bf16_t* gp = proj + (size_t)(row0 + ai * HALF + m * 16) * PW + P_GATE + (gnext - 1) * 1024 + col0;
#pragma unroll
                for (int bj = 0; bj < 2; ++bj) { const u32x4 g0 = *(const u32x4*)(gp + bj * HALF), g1 = *(const u32x4*)(gp + 1024 + bj * HALF);
#pragma unroll
                    for (int e = 0; e < 4; ++e) { const unsigned a = g0[e], b = g1[e];
                        const float ra = (1.0f + em(__builtin_bit_cast(float, b << 16))) * __builtin_amdgcn_rcpf(1.0f + em(__builtin_bit_cast(float, a << 16)));
                        const float rb = (1.0f + em(__builtin_bit_cast(float, b & 0xffff0000u))) * __builtin_amdgcn_rcpf(1.0f + em(__builtin_bit_cast(float, a & 0xffff0000u)));
                        if (e < 2) { acc[ai][bj][m][0][2 * e] *= ra; acc[ai][bj][m][0][2 * e + 1] *= rb; } else { acc[ai][bj][m][1][2 * (e - 2)] *= ra; acc[ai][bj][m][1][2 * (e - 2) + 1] *= rb; } } } }
    }
    __device__ __forceinline__ void operator()(const f32x4 (&acc)[2][2][4][2], const Unit& u, int wr, int wc, int fr, int fq) const {
        const int row0 = u.pm * BM + wr * 64 + fr, col0 = u.pn * BM + wc * 32 + 8 * fq;
#pragma unroll
        for (int ai = 0; ai < 2; ++ai)
#pragma unroll
            for (int m = 0; m < 4; ++m) { const size_t row = (size_t)(row0 + ai * HALF + m * 16);
#pragma unroll
                for (int bj = 0; bj < 2; ++bj) { const u32x4 gw = *(const u32x4*)(proj + row * PW + P_GATE + 3 * 1024 + col0 + bj * HALF);
                    float sg[8];
#pragma unroll
                    for (int e = 0; e < 4; ++e) { sg[2 * e] = __builtin_amdgcn_rcpf(1.0f + em(__builtin_bit_cast(float, gw[e] << 16))); sg[2 * e + 1] = __builtin_amdgcn_rcpf(1.0f + em(__builtin_bit_cast(float, gw[e] & 0xffff0000u))); }
                    const f32x4 v0 = acc[ai][bj][m][0], v1 = acc[ai][bj][m][1];
                    u32x4 w; w.x = cvt_pk_bf16(v0[0] * sg[0], v0[1] * sg[1]); w.y = cvt_pk_bf16(v0[2] * sg[2], v0[3] * sg[3]); w.z = cvt_pk_bf16(v1[0] * sg[4], v1[1] * sg[5]); w.w = cvt_pk_bf16(v1[2] * sg[6], v1[3] * sg[7]);
                    *(u32x4*)(MB + row * D + col0 + bj * HALF) = w; } }
    }
};
struct BranchOrder {
    int G, c;
    __device__ bool next(int i, Unit& u) const {
        const int tile = (i >> 2) * G + c; if (tile >= 256) return false;
        const int g = i & 3; u.pm = tile >> 2; u.pn = g * 4 + (tile & 3); u.aoff = g * 256; u.tag = g; return true;
    }
};
template <int NTC> struct MoeOrder {
    static constexpr int NT = NTC; int G, c, ntiles; int t1, t2, t3, t4, t5, t6, t7;
    __device__ __forceinline__ void init(const unsigned* cnt, int G_, int c_) { G = G_; c = (G_ % 8 == 0) ? (c_ % 8) * (G_ / 8) + c_ / 8 : c_;
        int o = ((int)cnt[0] + 255) >> 8; t1 = o; o += ((int)cnt[1] + 255) >> 8; t2 = o; o += ((int)cnt[2] + 255) >> 8; t3 = o; o += ((int)cnt[3] + 255) >> 8; t4 = o;
        o += ((int)cnt[4] + 255) >> 8; t5 = o; o += ((int)cnt[5] + 255) >> 8; t6 = o; o += ((int)cnt[6] + 255) >> 8; t7 = o; o += ((int)cnt[7] + 255) >> 8; ntiles = o; }
    __device__ __forceinline__ bool next(int i, Unit& u) const {
        const int L = i * G + c; if (L >= ntiles * NT) return false;
        const int tau = L / NT, pn = L % NT;
        const int e = (tau >= t1) + (tau >= t2) + (tau >= t3) + (tau >= t4) + (tau >= t5) + (tau >= t6) + (tau >= t7);
        u.pm = tau; u.pn = e * NT + pn; u.aoff = 0; u.tag = e; return true;
    }
};
}
typedef GAS unsigned gu32;
#define RLX_AGENT __ATOMIC_RELAXED, __HIP_MEMORY_SCOPE_AGENT
#define XB_TMO      128
#define XB_XCNT(j)  (256  + 64 * (j))
#define XB_XSUB(j)  (1280 + 64 * (j))
#define XB_XGEN(j)  (2304 + 64 * (j))
#define XB_TOP      3328
#define XB_TOPGEN   3392
#define XCD_BAR_WORDS 3456
#define XB_SPIN_CAP (1u << 18)

__device__ __forceinline__ unsigned xb_ld(unsigned* p)              { return __hip_atomic_load(p, __ATOMIC_RELAXED, __HIP_MEMORY_SCOPE_AGENT); }
__device__ __forceinline__ unsigned xb_add(unsigned* p, unsigned v) { return __hip_atomic_fetch_add(p, v, __ATOMIC_RELAXED, __HIP_MEMORY_SCOPE_AGENT); }
__device__ __forceinline__ unsigned xb_xcc_id() { return (unsigned)__builtin_amdgcn_s_getreg((3 << 11) | 20) & 0xFu; }
#define XB_SPIN(cond, bar) do { unsigned _sp = 0; while (cond) { __builtin_amdgcn_s_sleep(1); \
    if ((++_sp & 255u) == 0u) { if (xb_ld(&(bar)[XB_TMO])) break; if (_sp > XB_SPIN_CAP) { atomicAdd(&(bar)[XB_TMO], 1u); break; } } } } while (0)

struct XcdBarrier {
    unsigned* bar; unsigned x;
    volatile LAS unsigned* st;
};

__device__ __forceinline__ XcdBarrier xcd_barrier_post(unsigned* bar, volatile LAS unsigned* st) {
    XcdBarrier b; b.bar = bar; b.x = xb_xcc_id(); b.st = st;
    if (threadIdx.x == 0) (void)xb_add(&bar[XB_XCNT(b.x)], 1u);
    return b;
}
__device__ __forceinline__ void xcd_barrier_complete(unsigned* bar, unsigned x, unsigned& nloc, unsigned& nx) {
    const unsigned G = gridDim.x * gridDim.y * gridDim.z;
    unsigned sum, cnt, mine, sp = 0u;
    for (;;) {
        sum = 0u; cnt = 0u; mine = 0u;
#pragma unroll
        for (unsigned j = 0; j < 16; ++j) { const unsigned c = xb_ld(&bar[XB_XCNT(j)]); sum += c; cnt += (c > 0u) ? 1u : 0u; mine = (j == x) ? c : mine; }
        if (sum == G) break;
        __builtin_amdgcn_s_sleep(1);
        if ((++sp & 255u) == 0u) { if (xb_ld(&bar[XB_TMO])) break; if (sp > XB_SPIN_CAP) { atomicAdd(&bar[XB_TMO], 1u); break; } }
    }
    nloc = mine > 0u ? mine : 1u; nx = cnt > 0u ? cnt : 1u;
}

__device__ __forceinline__ void xcd_barrier(const XcdBarrier& b) {
    asm volatile("s_waitcnt vmcnt(0)" ::: "memory");
    __syncthreads();
    if (threadIdx.x == 0) {
        unsigned* bar = b.bar;
        __builtin_amdgcn_s_waitcnt(0);
        unsigned nloc = b.st[0], nx = b.st[1];
        if (nloc == 0u) { xcd_barrier_complete(bar, b.x, nloc, nx); b.st[0] = nloc; b.st[1] = nx; }
        const unsigned old = xb_add(&bar[XB_XSUB(b.x)], 1u);
        const unsigned gen = old / nloc;
        if (old + 1u == (gen + 1u) * nloc) {
            __builtin_amdgcn_fence(__ATOMIC_RELEASE, "agent");
            asm volatile("s_waitcnt vmcnt(0)" ::: "memory");
            const unsigned og = xb_add(&bar[XB_TOP], 1u);
            const unsigned tg = og / nx;
            if (og + 1u == (tg + 1u) * nx) xb_add(&bar[XB_TOPGEN], 1u);
            else XB_SPIN(xb_ld(&bar[XB_TOPGEN]) == tg, bar);
            __builtin_amdgcn_fence(__ATOMIC_ACQUIRE, "agent");
            xb_add(&bar[XB_XGEN(b.x)], 1u);
            asm volatile("s_waitcnt vmcnt(0)" ::: "memory");
        } else {
            XB_SPIN(xb_ld(&bar[XB_XGEN(b.x)]) == gen, bar);
            __builtin_amdgcn_fence(__ATOMIC_ACQUIRE, "agent");
            asm volatile("s_waitcnt vmcnt(0)" ::: "memory");
        }
    }
    __syncthreads();
}
struct Args { const void* in[40]; float* out; unsigned char* ws; int ph_lo, ph_hi; };
typedef const __attribute__((address_space(4))) Args* ArgsP;
__device__ __forceinline__ ArgsP fresh_args() { ArgsP p = (ArgsP)__builtin_amdgcn_kernarg_segment_ptr(); asm volatile("" : "+s"(p)); return p; }

struct Frame {
    LAS unsigned char* lds;
    int wave, G, gw, NGW;
    __device__ __forceinline__ int lane() const { unsigned z = 0u; asm volatile("" : "+v"(z)); return (int)__builtin_amdgcn_mbcnt_hi(~0u, __builtin_amdgcn_mbcnt_lo(~0u, z)); }
};

__device__ __forceinline__ Frame fresh(const Frame& F) { Frame R = F; asm volatile("" : "+s"(R.wave), "+s"(R.G), "+s"(R.gw), "+s"(R.NGW)); return R; }
#define LDS_WAIT() asm volatile("s_waitcnt lgkmcnt(0)" ::: "memory")

__device__ __forceinline__ void p0_mod_items(Frame& F, const float* c, const float* ada_w, const float* ada_b, float* mod) {
    LAS float* part = (LAS float*)F.lds;
    LAS float* cs = (LAS float*)(F.lds + 98304);
    int tid_ = F.wave * 64 + F.lane(); asm volatile("" : "+v"(tid_)); const int lane_ = tid_ & 63;
    if ((int)blockIdx.x >= 192) return;
    for (int i = tid_; i < 8192; i += NTHR) cs[i] = siluf(c[i]);
    __syncthreads();
    for (int it = blockIdx.x; it < 192; it += F.G) {
        const int l = it / 96, j0 = (it % 96) * 64;
        float acc[8];
#pragma unroll
        for (int b = 0; b < 8; ++b) acc[b] = 0.f;
        const float* w = ada_w + (size_t)l * 1024 * 6144 + j0 + lane_;
        const int k0 = F.wave * 128;
#pragma unroll 1
        for (int kb = 0; kb < 128; kb += 16) { float wv[16];
#pragma unroll
            for (int q = 0; q < 16; ++q) wv[q] = w[(size_t)(k0 + kb + q) * 6144];
#pragma unroll
            for (int q4 = 0; q4 < 4; ++q4)
#pragma unroll
                for (int b = 0; b < 8; ++b) { const pg8::f32x4 cv = *(const LAS pg8::f32x4*)(cs + b * 1024 + k0 + kb + 4 * q4);
                    acc[b] += (cv[0] * wv[4 * q4] + cv[1] * wv[4 * q4 + 1]) + (cv[2] * wv[4 * q4 + 2] + cv[3] * wv[4 * q4 + 3]); } }
#pragma unroll
        for (int b = 0; b < 8; ++b) part[(F.wave * 8 + b) * 64 + lane_] = acc[b];
        __syncthreads();
        { const int b = tid_ >> 6, col = tid_ & 63; float s = 0.f;
#pragma unroll
          for (int w8 = 0; w8 < 8; ++w8) s += part[(w8 * 8 + b) * 64 + col];
          mod[(size_t)(l * 8 + b) * 6144 + j0 + col] = s + ada_b[l * 6144 + j0 + col]; }
        __syncthreads();
    }
}
struct CvtDesc { const float* colp; size_t Ns; bf16_t* WT; int Kd, n0, k0; };
__device__ __forceinline__ void cvt_load(const CvtDesc& d, pg8::f32x4 (&v)[8], int lane) {
    const int kr = lane >> 3;
#pragma unroll
    for (int i = 0; i < 8; ++i) v[i] = d.colp ? *(const pg8::f32x4*)(d.colp + (size_t)(d.k0 + 8 * i + kr) * d.Ns) : (pg8::f32x4){0.f, 0.f, 0.f, 0.f};
}
__device__ __forceinline__ void cvt_store(const CvtDesc& d, const pg8::f32x4 (&v)[8], LAS float* scr, int lane) {
    const int q4 = 4 * (lane & 7), kr = lane >> 3;
#pragma unroll
    for (int i = 0; i < 8; ++i)
#pragma unroll
        for (int e = 0; e < 4; ++e) scr[(8 * i + kr) * 33 + q4 + e] = v[i][e];
    LDS_WAIT(); asm volatile("" ::: "memory");
    const int cidx = lane & 7;
#pragma unroll
    for (int j = 0; j < 4; ++j) { const int n = (lane >> 3) + 8 * j; const LAS float* s = scr + (8 * cidx) * 33 + n;
        pg8::u32x4 o; o.x = pk2(s[0 * 33], s[1 * 33]); o.y = pk2(s[2 * 33], s[3 * 33]); o.z = pk2(s[4 * 33], s[5 * 33]); o.w = pk2(s[6 * 33], s[7 * 33]);
        *(pg8::u32x4*)(d.WT + (size_t)(d.n0 + n) * d.Kd + d.k0 + 8 * cidx) = o; }
    LDS_WAIT(); asm volatile("" ::: "memory");
}
__device__ __forceinline__ int win_src_col(int v) { return v < 768 ? v : (v < 7168 ? v + 16 : (v < 7184 ? v - 6400 : -1)); }

__device__ __forceinline__ CvtDesc p0_desc(ArgsP a, int it, int n) {
    const float* w_in = (const float*)a->in[9]; const float* w_branch = (const float*)a->in[30]; const float* w_out = (const float*)a->in[31];
    const float* wg = (const float*)a->in[32]; const float* wu = (const float*)a->in[33]; const float* wd = (const float*)a->in[34];
    bf16_t* WIN = (bf16_t*)(a->ws + WS_WIN); bf16_t* WB = (bf16_t*)(a->ws + WS_WB); bf16_t* WO = (bf16_t*)(a->ws + WS_WO); bf16_t* WF1 = (bf16_t*)(a->ws + WS_WF1); bf16_t* WF2 = (bf16_t*)(a->ws + WS_WF2);
    bf16_t* LR = (bf16_t*)(a->ws + WS_LR);
    constexpr int I_IN = 2 * 232 * 16, I_B = 2 * 4 * 32 * 4, I_O = 2 * 32 * 16, I_F1 = 176 * 16, I_F2 = 32 * 44;
    int r = it;
    if (r < I_IN) { const int l = r / (232 * 16), q = r % (232 * 16), nb = q / 16, kb = q % 16; const int sc = win_src_col(nb * 32 + n);
        return CvtDesc{sc >= 0 ? w_in + (size_t)l * 1024 * NIN + sc : nullptr, (size_t)NIN, WIN + (size_t)l * PW * 1024, 1024, nb * 32, kb * 64}; } r -= I_IN;
    if (r < I_B) { const int lg = r / 128, q = r % 128, nb = q / 4, kb = q % 4;
        const int g = lg & 3, l = lg >> 2;
        return CvtDesc{w_branch + (size_t)lg * 256 * 1024 + nb * 32 + n - (size_t)g * 256 * 1024, 1024, WB + (size_t)l * 1024 * 1024, 1024, nb * 32, g * 256 + kb * 64}; } r -= I_B;
    if (r < I_O) { const int l = r / 512, q = r % 512, nb = q / 16, kb = q % 16;
        return CvtDesc{w_out + (size_t)l * 1024 * 1024 + nb * 32 + n, 1024, WO + (size_t)l * 1024 * 1024, 1024, nb * 32, kb * 64}; } r -= I_O;
    if (r < I_F1) { const int nb = r / 16, kb = r % 16; const int v = nb * 32 + n; const int up = (v >> 2) & 1, j = (v >> 3) * 4 + (v & 3);
        return CvtDesc{(up ? wu : wg) + j, (size_t)DFF, WF1, 1024, nb * 32, kb * 64}; } r -= I_F1;
    if (r < I_F2) { const int nb = r / 44, kb = r % 44;
        return CvtDesc{wd + nb * 32 + n, 1024, WF2, DFF, nb * 32, kb * 64}; } r -= I_F2;
    if (r < 16) { const int l = r >> 3, nb = r & 7; return CvtDesc{(const float*)a->in[21] + l * 64 * 256 + nb * 32 + n, 256, LR + l * 256 * 64, 64, nb * 32, 0}; } r -= 16;
    if (r < 16) { const int l = r >> 3, nb = r & 7; return CvtDesc{(const float*)a->in[23] + l * 64 * 256 + nb * 32 + n, 256, LR + 2 * 256 * 64 + l * 256 * 64, 64, nb * 32, 0}; } r -= 16;
    { const int l = r >> 4, nb = (r >> 1) & 7, kb = r & 1; return CvtDesc{(const float*)a->in[24] + l * 128 * 256 + nb * 32 + n, 256, LR + 4 * 256 * 64 + l * 256 * 128, 128, nb * 32, kb * 64}; }
}
__device__ __forceinline__ void p0_convert(Frame& F, ArgsP a) {
    LAS float* scr = (LAS float*)(F.lds + 16384 + F.wave * 8704);
    constexpr int NITEMS = 2 * 232 * 16 + 2 * 4 * 32 * 4 + 2 * 32 * 16 + 176 * 16 + 32 * 44 + 64;
    int lane_ = F.lane(); asm volatile("" : "+v"(lane_));
    const int n = 4 * (lane_ & 7);
    int it = F.gw; if (it >= NITEMS) return;
    CvtDesc cur = p0_desc(a, it, n); pg8::f32x4 v[8]; cvt_load(cur, v, lane_);
    for (;;) { const int nx = it + F.NGW; const bool more = nx < NITEMS;
        CvtDesc nd = cur; pg8::f32x4 w[8];
        if (more) { nd = p0_desc(a, nx, n); cvt_load(nd, w, lane_); }
        cvt_store(cur, v, scr, lane_);
        if (!more) break;
#pragma unroll
        for (int i = 0; i < 8; ++i) v[i] = w[i];
        cur = nd; it = nx; }
}

__device__ __forceinline__ void row_load(const float* p, pg8::f32x4 (&v)[4], int lane) {
#pragma unroll
    for (int j = 0; j < 4; ++j) v[j] = *(const pg8::f32x4*)(p + 4 * lane + 256 * j);
}
__device__ __forceinline__ float row_ss(const pg8::f32x4 (&v)[4]) {
    float s = 0.f;
#pragma unroll
    for (int j = 0; j < 4; ++j) s += (v[j][0] * v[j][0] + v[j][1] * v[j][1]) + (v[j][2] * v[j][2] + v[j][3] * v[j][3]);
    return wave_sum(s);
}
__device__ __forceinline__ void row_normmod(const pg8::f32x4 (&x)[4], const float* g, const float* mb, int sh_off, int sc_off, bf16_t* hrow, pg8::f32x4 (&hv)[4], int lane) {
    const float rstd = rsqrtf(row_ss(x) * (1.0f / D) + 1e-6f);
#pragma unroll
    for (int j = 0; j < 4; ++j) { const int d = 4 * lane + 256 * j;
        const pg8::f32x4 gg = *(const pg8::f32x4*)(g + d), sc = *(const pg8::f32x4*)(mb + sc_off + d), sh = *(const pg8::f32x4*)(mb + sh_off + d);
        hv[j] = x[j] * rstd * gg * (1.0f + sc) + sh;
        pg8::u32x2 w; w.x = pk2(hv[j][0], hv[j][1]); w.y = pk2(hv[j][2], hv[j][3]);
        *(pg8::u32x2*)(hrow + d) = w; }
}
template <int CTRL, int ROWMASK> __device__ __forceinline__ float dpp_mov_p(float old, float x) {
    return __builtin_bit_cast(float, __builtin_amdgcn_update_dpp(__builtin_bit_cast(int, old), __builtin_bit_cast(int, x), CTRL, ROWMASK, 0xF, false)); }
__device__ __forceinline__ float wave_sum63p(float x) {
    x += dpp_mov_p<0xB1, 0xF>(0.f, x); x += dpp_mov_p<0x4E, 0xF>(0.f, x); x += dpp_mov_p<0x141, 0xF>(0.f, x); x += dpp_mov_p<0x140, 0xF>(0.f, x);
    x += dpp_mov_p<0x142, 0xA>(0.f, x); x += dpp_mov_p<0x143, 0xC>(0.f, x); return x; }
__device__ __forceinline__ void stage_wz(const float* w_in_l, LAS float* wz, int tid) {
    for (int i = tid; i < 1024 * 4; i += NTHR) { const int d = i >> 2, q = i & 3; const pg8::f32x4 w = *(const pg8::f32x4*)(w_in_l + (size_t)d * NIN + 768 + 4 * q);
        wz[(4 * q) * 1024 + d] = w[0]; wz[(4 * q + 1) * 1024 + d] = w[1]; wz[(4 * q + 2) * 1024 + d] = w[2]; wz[(4 * q + 3) * 1024 + d] = w[3]; }
    __syncthreads();
}
__device__ __forceinline__ void row_gz(const pg8::f32x4 (&hv)[4], const LAS float* wz, bf16_t* gzrow, int lane) {
    float mine = 0.f;
#pragma unroll
    for (int o = 0; o < 16; ++o) { float acc = 0.f;
#pragma unroll
        for (int j = 0; j < 4; ++j) { const pg8::f32x4 w = *(const LAS pg8::f32x4*)(wz + o * 1024 + 4 * lane + 256 * j); acc += (hv[j][0] * w[0] + hv[j][1] * w[1]) + (hv[j][2] * w[2] + hv[j][3] * w[3]); }
        const float s = __builtin_bit_cast(float, __builtin_amdgcn_readlane(__builtin_bit_cast(int, wave_sum63p(acc)), 63)); if (lane == o) mine = s; }
    if (lane < 16) gzrow[lane] = (bf16_t)f2bf(mine);
}
__device__ __forceinline__ void ph_h0(Frame& F, ArgsP a) {
    const float* x = (const float*)a->in[0]; const float* g = (const float*)a->in[5]; const float* mod = (const float*)(a->ws + WS_MOD); bf16_t* H = (bf16_t*)(a->ws + WS_HB);
    bf16_t* GZ = (bf16_t*)(a->ws + WS_GZ); LAS float* wz = (LAS float*)F.lds;
    int lane0 = F.lane(); asm volatile("" : "+v"(lane0));
    stage_wz((const float*)a->in[9], wz, F.wave * 64 + lane0);
    int row = F.gw; if (row >= M) return;
    pg8::f32x4 xn[4]; row_load(x + (size_t)row * D, xn, lane0);
    for (;;) { int lane = lane0; asm volatile("" : "+v"(lane)); pg8::f32x4 xv[4], hv[4];
#pragma unroll
        for (int j = 0; j < 4; ++j) xv[j] = xn[j];
        const int nrow = row + F.NGW; if (nrow < M) row_load(x + (size_t)nrow * D, xn, lane);
        row_normmod(xv, g, mod + (size_t)(row / T) * 6144, 0, 1024, H + (size_t)row * D, hv, lane);
        row_gz(hv, wz, GZ + (size_t)row * 16, lane);
        if (nrow >= M) break; row = nrow; }
}
__device__ __forceinline__ void row_y_load(const bf16_t* y, const bf16_t* eout, const unsigned* cnt, const int* toke, const int* toks, int row, int lane, pg8::f32x4 (&yv)[4], pg8::u32x2 (&e1)[4], pg8::u32x2 (&e2)[4]) {
    if (eout) {
        int roff[8]; { int o = 0;
#pragma unroll
            for (int e = 0; e < 8; ++e) { roff[e] = o; o += (((int)cnt[e] + 255) >> 8) << 8; } }
        const int x1 = toke[row * 2], x2 = toke[row * 2 + 1]; int g1 = toks[row * 2], g2 = toks[row * 2 + 1];
#pragma unroll
        for (int q = 0; q < 8; ++q) { if (q == x1) g1 += roff[q]; if (q == x2) g2 += roff[q]; }
#pragma unroll
        for (int j = 0; j < 4; ++j) { e1[j] = *(const pg8::u32x2*)(eout + (size_t)g1 * D + 4 * lane + 256 * j); e2[j] = *(const pg8::u32x2*)(eout + (size_t)g2 * D + 4 * lane + 256 * j); }
    } else {
#pragma unroll
        for (int j = 0; j < 4; ++j) e1[j] = *(const pg8::u32x2*)(y + (size_t)row * D + 4 * lane + 256 * j); }
}
__device__ __forceinline__ void ph_row(Frame& F, ArgsP a, const float* xold, const bf16_t* y, const float* gpost, const float* modl, int gt_off,
                                       const float* gpre, const float* modn, int sh_off, int sc_off, bf16_t* hdst, bool route, const bf16_t* eout = nullptr, const float* w_in_next = nullptr) {
    float* out = a->out;
    bf16_t* GZ = (bf16_t*)(a->ws + WS_GZ); LAS float* wz = (LAS float*)F.lds;
    if (w_in_next) { int t_ = F.wave * 64 + F.lane(); stage_wz(w_in_next, wz, t_); }
    const float* rw = (const float*)a->in[35]; const float* rb = (const float*)a->in[36];
    unsigned* cnt = (unsigned*)(a->ws + WS_CTL) + CW_CNT;
    int* list = (int*)(a->ws + WS_ROUTE + RT_LIST); int* toke = (int*)(a->ws + WS_ROUTE + RT_TOKE); int* toks = (int*)(a->ws + WS_ROUTE + RT_TOKS); float* tokp = (float*)(a->ws + WS_ROUTE + RT_TOKP);
    int row = F.gw; if (row >= M) return;
    int lane0 = F.lane(); asm volatile("" : "+v"(lane0));
    pg8::f32x4 yn[4], xn[4]; pg8::u32x2 e1n[4], e2n[4];
    row_y_load(y, eout, cnt, toke, toks, row, lane0, yn, e1n, e2n); row_load(xold + (size_t)row * D, xn, lane0);
    for (;;) {
        int lane = lane0; asm volatile("" : "+v"(lane));
        const int b = row / T; pg8::f32x4 yv[4], xv[4], hv[4];
        if (eout) { const float p1 = tokp[row * 2], p2 = tokp[row * 2 + 1];
#pragma unroll
            for (int j = 0; j < 4; ++j) { const pg8::u32x2 a1 = e1n[j], a2 = e2n[j];
                yv[j][0] = p1 * __builtin_bit_cast(float, a1.x << 16) + p2 * __builtin_bit_cast(float, a2.x << 16); yv[j][1] = p1 * __builtin_bit_cast(float, a1.x & 0xffff0000u) + p2 * __builtin_bit_cast(float, a2.x & 0xffff0000u);
                yv[j][2] = p1 * __builtin_bit_cast(float, a1.y << 16) + p2 * __builtin_bit_cast(float, a2.y << 16); yv[j][3] = p1 * __builtin_bit_cast(float, a1.y & 0xffff0000u) + p2 * __builtin_bit_cast(float, a2.y & 0xffff0000u); }
        } else {
#pragma unroll
            for (int j = 0; j < 4; ++j) { const pg8::u32x2 a1 = e1n[j]; yv[j][0] = __builtin_bit_cast(float, a1.x << 16); yv[j][1] = __builtin_bit_cast(float, a1.x & 0xffff0000u); yv[j][2] = __builtin_bit_cast(float, a1.y << 16); yv[j][3] = __builtin_bit_cast(float, a1.y & 0xffff0000u); } }
#pragma unroll
        for (int j = 0; j < 4; ++j) xv[j] = xn[j];
        const int nrow = row + F.NGW;
        if (nrow < M) { row_y_load(y, eout, cnt, toke, toks, nrow, lane, yn, e1n, e2n); row_load(xold + (size_t)nrow * D, xn, lane); }
        const float rstd = rsqrtf(row_ss(yv) * (1.0f / D) + 1e-6f);
        const float* mb = modl + (size_t)b * 6144;
#pragma unroll
        for (int j = 0; j < 4; ++j) { const int d = 4 * lane + 256 * j;
            const pg8::f32x4 gp = *(const pg8::f32x4*)(gpost + d), gt = *(const pg8::f32x4*)(mb + gt_off + d);
            xv[j] = xv[j] + gt * (yv[j] * rstd * gp);
            *(pg8::f32x4*)(out + (size_t)row * D + d) = xv[j]; }
        if (hdst) {
            row_normmod(xv, gpre, modn + (size_t)b * 6144, sh_off, sc_off, hdst + (size_t)row * D, hv, lane);
            if (w_in_next) row_gz(hv, wz, GZ + (size_t)row * 16, lane);
            if (route) {
                float lg[8];
#pragma unroll
                for (int e = 0; e < 8; ++e) lg[e] = 0.f;
#pragma unroll
                for (int j = 0; j < 4; ++j)
#pragma unroll
                    for (int q = 0; q < 4; ++q) { const int d = 4 * lane + 256 * j + q; const pg8::f32x4 w0 = *(const pg8::f32x4*)(rw + d * 8), w1 = *(const pg8::f32x4*)(rw + d * 8 + 4); const float hq = hv[j][q];
                        lg[0] += hq * w0[0]; lg[1] += hq * w0[1]; lg[2] += hq * w0[2]; lg[3] += hq * w0[3]; lg[4] += hq * w1[0]; lg[5] += hq * w1[1]; lg[6] += hq * w1[2]; lg[7] += hq * w1[3]; }
#pragma unroll
                for (int e = 0; e < 8; ++e) lg[e] = wave_sum(lg[e]) + rb[e];
                if (lane == 0) {
                    int e1 = 0; float v1 = lg[0];
#pragma unroll
                    for (int e = 1; e < 8; ++e) if (lg[e] > v1) { v1 = lg[e]; e1 = e; }
                    int e2 = -1; float v2 = -3.0e38f;
#pragma unroll
                    for (int e = 0; e < 8; ++e) if (e != e1 && lg[e] > v2) { v2 = lg[e]; e2 = e; }
                    const float p1 = 1.0f / (1.0f + __expf(v2 - v1)), p2 = 1.0f - p1;
                    const int s1 = (int)atomicAdd(&cnt[e1], 1u), s2 = (int)atomicAdd(&cnt[e2], 1u);
                    list[e1 * M + s1] = row; list[e2 * M + s2] = row;
                    toke[row * 2] = e1; toke[row * 2 + 1] = e2; toks[row * 2] = s1; toks[row * 2 + 1] = s2; tokp[row * 2] = p1; tokp[row * 2 + 1] = p2;
                }
            }
        }
        if (nrow >= M) break; row = nrow;
    }
}

__device__ __forceinline__ void ph_moe_prep(Frame& F, ArgsP a) {
    LAS float* scr = (LAS float*)(F.lds + F.wave * 8704);
    const float* mg = (const float*)a->in[37]; const float* mu = (const float*)a->in[38]; const float* md = (const float*)a->in[39];
    bf16_t* WM1 = (bf16_t*)(a->ws + WS_WM1); bf16_t* WM2 = (bf16_t*)(a->ws + WS_WM2);
    constexpr int I_1 = 8 * 224 * 16, I_2 = 8 * 32 * 56;
    int lane_ = F.lane(); asm volatile("" : "+v"(lane_));
    const int n = 4 * (lane_ & 7);
    auto desc = [&](int r) -> CvtDesc {
        if (r < I_1) { const int e = r / 3584, q = r % 3584, nb = q / 16, kb = q % 16; const int v = nb * 32 + n; const int up = (v >> 2) & 1, j = (v >> 3) * 4 + (v & 3);
            return CvtDesc{(up ? mu : mg) + (size_t)e * 1024 * DEX + j, (size_t)DEX, WM1 + (size_t)e * 7168 * 1024, 1024, nb * 32, kb * 64}; }
        r -= I_1; const int e = r / 1792, q = r % 1792, nb = q / 56, kb = q % 56;
        return CvtDesc{md + (size_t)e * DEX * 1024 + nb * 32 + n, 1024, WM2 + (size_t)e * 1024 * DEX, DEX, nb * 32, kb * 64}; };
    { int it = F.gw;
      if (it < I_1 + I_2) { CvtDesc cur = desc(it); pg8::f32x4 v[8]; cvt_load(cur, v, lane_);
        for (;;) { const int nx = it + F.NGW; const bool more = nx < I_1 + I_2; CvtDesc nd = cur; pg8::f32x4 w[8];
            if (more) { nd = desc(nx); cvt_load(nd, w, lane_); }
            cvt_store(cur, v, scr, lane_);
            if (!more) break;
#pragma unroll
            for (int i = 0; i < 8; ++i) v[i] = w[i];
            cur = nd; it = nx; } } }
    const unsigned* cnt = (const unsigned*)(a->ws + WS_CTL) + CW_CNT;
    const int* list = (const int*)(a->ws + WS_ROUTE + RT_LIST);
    const bf16_t* h2 = (const bf16_t*)(a->ws + WS_H2L1); bf16_t* hg = (bf16_t*)(a->ws + WS_HG);
    int roff[9]; { int o = 0;
#pragma unroll
        for (int e = 0; e < 8; ++e) { roff[e] = o; o += (((int)cnt[e] + 255) >> 8) << 8; } roff[8] = o; }
    for (int slot0 = F.gw * 4; slot0 < roff[8]; slot0 += F.NGW * 4) {
        int src[4];
#pragma unroll
        for (int u = 0; u < 4; ++u) { const int slot = slot0 + u; int e = 0;
#pragma unroll
            for (int q = 1; q < 8; ++q) e += (slot >= roff[q]) ? 1 : 0;
            int base = 0, ce = 0;
#pragma unroll
            for (int q = 0; q < 8; ++q) if (q == e) { base = roff[q]; ce = (int)cnt[q]; }
            const int s = slot - base;
            src[u] = (slot < roff[8] && s < ce) ? list[e * M + s] : -1; }
        pg8::u32x4 v0[4], v1[4];
#pragma unroll
        for (int u = 0; u < 4; ++u) { v0[u] = (pg8::u32x4){0u, 0u, 0u, 0u}; v1[u] = v0[u];
            if (src[u] >= 0) { const pg8::u32x4* sp = (const pg8::u32x4*)(h2 + (size_t)src[u] * D) + 2 * lane_; v0[u] = sp[0]; v1[u] = sp[1]; } }
#pragma unroll
        for (int u = 0; u < 4; ++u) if (slot0 + u < roff[8]) { pg8::u32x4* dp = (pg8::u32x4*)(hg + (size_t)(slot0 + u) * D) + 2 * lane_; dp[0] = v0[u]; dp[1] = v1[u]; }
    }
}
typedef float f32x16 __attribute__((ext_vector_type(16)));
template <int CTRL, int ROWMASK> __device__ __forceinline__ float dpp_mov(float old, float x) {
    return __builtin_bit_cast(float, __builtin_amdgcn_update_dpp(__builtin_bit_cast(int, old), __builtin_bit_cast(int, x), CTRL, ROWMASK, 0xF, false));
}
__device__ __forceinline__ float rdlane(float x, int l) { return __builtin_bit_cast(float, __builtin_amdgcn_readlane(__builtin_bit_cast(int, x), l)); }
__device__ __forceinline__ float wave_sum63(float x) {
    x += dpp_mov<0xB1, 0xF>(0.f, x);
    x += dpp_mov<0x4E, 0xF>(0.f, x);
    x += dpp_mov<0x141, 0xF>(0.f, x);
    x += dpp_mov<0x140, 0xF>(0.f, x);
    x += dpp_mov<0x142, 0xA>(0.f, x);
    x += dpp_mov<0x143, 0xC>(0.f, x);
    return x;
}
__device__ __forceinline__ float row16_sum(float x) {
    x += dpp_mov<0xB1, 0xF>(0.f, x); x += dpp_mov<0x4E, 0xF>(0.f, x); x += dpp_mov<0x141, 0xF>(0.f, x); x += dpp_mov<0x140, 0xF>(0.f, x);
    return x;
}
__device__ __forceinline__ pg8::f32x4 ld_bf16x4(const bf16_t* p) { const pg8::u32x2 w = *(const pg8::u32x2*)p;
    return (pg8::f32x4){__builtin_bit_cast(float, w.x << 16), __builtin_bit_cast(float, w.x & 0xffff0000u), __builtin_bit_cast(float, w.y << 16), __builtin_bit_cast(float, w.y & 0xffff0000u)}; }
__device__ __forceinline__ void st_bf16x4(bf16_t* p, pg8::f32x4 v) { pg8::u32x2 w; w.x = pk2(v[0], v[1]); w.y = pk2(v[2], v[3]); *(pg8::u32x2*)p = w; }

__device__ __forceinline__ void ph_conv(Frame& F, ArgsP a, int l) {
    const bf16_t* proj = (const bf16_t*)(a->ws + WS_PROJ); bf16_t* br = (bf16_t*)(a->ws + WS_HB);
    const float* cw = (const float*)a->in[15] + l * 31 * 256; const float* cb = (const float*)a->in[16] + l * 256; const float* lg = (const float*)a->in[17] + l * 256; const float* lb = (const float*)a->in[18] + l * 256;
    LAS float* u = (LAS float*)F.lds;
    int tid = F.wave * 64 + F.lane(); asm volatile("" : "+v"(tid)); const int lane = tid & 63;
    for (int it = blockIdx.x; it < M / 64; it += F.G) {
        const int row0 = it * 64, t0 = row0 % T;
#pragma unroll
        for (int i_ = 0; i_ < 6; ++i_) { const int idx = tid + i_ * NTHR; if (idx >= 94 * 32) break; const int r = idx >> 5, c8 = (idx & 31) * 8; float uv[8];
#pragma unroll
            for (int e = 0; e < 8; ++e) uv[e] = 0.f;
            if (t0 - 30 + r >= 0) { const bf16_t* pr = proj + (size_t)(row0 - 30 + r) * PW;
                const pg8::f32x4 a0 = ld_bf16x4(pr + P_CA + c8), a1 = ld_bf16x4(pr + P_CA + c8 + 4), b0 = ld_bf16x4(pr + P_CB + c8), b1 = ld_bf16x4(pr + P_CB + c8 + 4);
#pragma unroll
                for (int e = 0; e < 4; ++e) { uv[e] = a0[e] * sigm(b0[e]); uv[4 + e] = a1[e] * sigm(b1[e]); } }
            *(LAS pg8::f32x4*)(u + r * 256 + c8) = (pg8::f32x4){uv[0], uv[1], uv[2], uv[3]}; *(LAS pg8::f32x4*)(u + r * 256 + c8 + 4) = (pg8::f32x4){uv[4], uv[5], uv[6], uv[7]}; }
        __syncthreads();
        const int c = tid & 255, half = tid >> 8;
        float acc[32];
        { float w[31], ur[62];
#pragma unroll
          for (int j = 0; j < 31; ++j) w[j] = cw[j * 256 + c];
#pragma unroll
          for (int q = 0; q < 62; ++q) ur[q] = u[(half * 32 + q) * 256 + c];
          const float bias = cb[c];
#pragma unroll
          for (int i = 0; i < 32; ++i) { float s = bias;
#pragma unroll
              for (int j = 0; j < 31; ++j) s += w[j] * ur[i + j];
              acc[i] = s; } }
        __syncthreads();
#pragma unroll
        for (int i = 0; i < 32; ++i) u[(half * 32 + i) * 256 + c] = acc[i];
        __syncthreads();
        const pg8::f32x4 g4 = *(const pg8::f32x4*)(lg + 4 * lane), b4 = *(const pg8::f32x4*)(lb + 4 * lane);
#pragma unroll 2
        for (int q = 0; q < 8; ++q) { const int t = F.wave * 8 + q; const pg8::f32x4 yv = *(const LAS pg8::f32x4*)(u + t * 256 + 4 * lane);
            const float mu = wave_sum((yv[0] + yv[1]) + (yv[2] + yv[3])) * (1.0f / 256.0f); const pg8::f32x4 d = yv - mu;
            const float var = wave_sum((d[0] * d[0] + d[1] * d[1]) + (d[2] * d[2] + d[3] * d[3])) * (1.0f / 256.0f);
            pg8::f32x4 o = d * rsqrtf(var + 1e-5f) * g4 + b4;
#pragma unroll
            for (int e = 0; e < 4; ++e) o[e] = siluf(o[e]);
            st_bf16x4(br + (size_t)(row0 + t) * D + 512 + 4 * lane, o); }
        __syncthreads();
    }
}

__device__ __forceinline__ void ph_rwkv_prep(Frame& F, ArgsP a, int l) {
        const bf16_t* proj = (const bf16_t*)(a->ws + WS_PROJ);
    const float* mu = (const float*)a->in[19] + l * 1024; const float* w0 = (const float*)a->in[20] + l * 256; const float* a0 = (const float*)a->in[22] + l * 256;
    const float* kkw = (const float*)a->in[25] + l * 256; const float* kaw = (const float*)a->in[26] + l * 256; const float* rkw = (const float*)a->in[27] + l * 256;
    const bf16_t* W2T = (const bf16_t*)(a->ws + WS_LR) + l * 256 * 64; const bf16_t* A2T = (const bf16_t*)(a->ws + WS_LR) + 2 * 256 * 64 + l * 256 * 64; const bf16_t* G2T = (const bf16_t*)(a->ws + WS_LR) + 4 * 256 * 64 + l * 256 * 128;
    unsigned char* VEC = a->ws + SCR_VEC6; float* SC = (float*)(a->ws + SCR_SC); bf16_t* GR = (bf16_t*)(a->ws + SCR_GR);
    constexpr int RS = 72, RG = 136;
    LAS bf16_t* TZh = (LAS bf16_t*)F.lds; LAS bf16_t* TZl = TZh + 64 * RS; LAS bf16_t* ZA = TZl + 64 * RS; LAS bf16_t* SG = ZA + 64 * RS;
    int tid = F.wave * 64 + F.lane(); asm volatile("" : "+v"(tid));
    for (int it = blockIdx.x; it < M / 64; it += F.G) {
        const int row0 = it * 64, b = row0 / T, t0 = row0 % T;
#pragma unroll 4
        for (int i_ = 0; i_ < 32; ++i_) { const int idx = tid + i_ * NTHR; const int cc = idx & 255, tok = idx >> 8; const int col = 768 + cc;
            const bf16_t* pc = proj + (size_t)(row0 + tok) * PW + P_R + col; const float xc = bf2f(pc[0]); const float xp = (t0 + tok > 0) ? bf2f(pc[-PW]) : 0.f;
            const float xm = xc + (xp - xc) * mu[col];
            if (cc < 64) { const float tv = tanh_fast(xm); const unsigned hi = f2bf(tv); TZh[tok * RS + cc] = (bf16_t)hi; TZl[tok * RS + cc] = (bf16_t)f2bf(tv - __builtin_bit_cast(float, hi << 16)); }
            else if (cc < 128) ZA[tok * RS + cc - 64] = (bf16_t)f2bf(xm);
            else SG[tok * RG + cc - 128] = (bf16_t)f2bf(sigm(xm)); }
        __syncthreads();
        int tid2 = tid; asm volatile("" : "+v"(tid2));
        const int lane = tid2 & 63, r = lane & 31, hg = lane >> 5, h = (tid2 >> 6) & 3, th = tid2 >> 8;
        f32x16 accw[2], acca[2], accg[2];
#pragma unroll
        for (int nb = 0; nb < 2; ++nb)
#pragma unroll
            for (int e = 0; e < 16; ++e) { accw[nb][e] = 0.f; acca[nb][e] = 0.f; accg[nb][e] = 0.f; }
        const int arow = (th * 32 + r);
#pragma unroll
        for (int s = 0; s < 4; ++s) { const pg8::bf16x8 ah = *(const LAS pg8::bf16x8*)(TZh + arow * RS + 16 * s + 8 * hg), al = *(const LAS pg8::bf16x8*)(TZl + arow * RS + 16 * s + 8 * hg), az = *(const LAS pg8::bf16x8*)(ZA + arow * RS + 16 * s + 8 * hg);
#pragma unroll
            for (int nb = 0; nb < 2; ++nb) { const int n = h * 64 + nb * 32 + r;
                const pg8::bf16x8 bw = *(const pg8::bf16x8*)(W2T + n * 64 + 16 * s + 8 * hg), ba = *(const pg8::bf16x8*)(A2T + n * 64 + 16 * s + 8 * hg);
                accw[nb] = __builtin_amdgcn_mfma_f32_32x32x16_bf16(ah, bw, accw[nb], 0, 0, 0); accw[nb] = __builtin_amdgcn_mfma_f32_32x32x16_bf16(al, bw, accw[nb], 0, 0, 0);
                acca[nb] = __builtin_amdgcn_mfma_f32_32x32x16_bf16(az, ba, acca[nb], 0, 0, 0); } }
#pragma unroll
        for (int s = 0; s < 8; ++s) { const pg8::bf16x8 ag = *(const LAS pg8::bf16x8*)(SG + arow * RG + 16 * s + 8 * hg);
#pragma unroll
            for (int nb = 0; nb < 2; ++nb) { const int n = h * 64 + nb * 32 + r; const pg8::bf16x8 bg = *(const pg8::bf16x8*)(G2T + n * 128 + 16 * s + 8 * hg);
                accg[nb] = __builtin_amdgcn_mfma_f32_32x32x16_bf16(ag, bg, accg[nb], 0, 0, 0); } }
        int tid3 = tid; asm volatile("" : "+v"(tid3)); const int r3 = tid3 & 31, hg3 = (tid3 >> 5) & 1, h3 = (tid3 >> 6) & 3, th3 = tid3 >> 8;
        float pw0[2], pa0[2], pmr[2], pmk[2], pmv[2], pkk[2], pka[2], prk[2];
#pragma unroll
        for (int nb = 0; nb < 2; ++nb) { const int c = h3 * 64 + nb * 32 + r3; pw0[nb] = w0[c]; pa0[nb] = a0[c]; pmr[nb] = mu[c]; pmk[nb] = mu[256 + c]; pmv[nb] = mu[512 + c]; pkk[nb] = kkw[c]; pka[nb] = kaw[c]; prk[nb] = rkw[c]; }
#pragma unroll
        for (int e = 0; e < 16; ++e) { const int tok = th3 * 32 + (e & 3) + 8 * (e >> 2) + 4 * hg3, t = t0 + tok; const size_t row = (size_t)row0 + tok; const bool hp = t > 0;
            float dec[2], kkv[2], kka[2], k2[2], rv[2], vv[2], s_kk = 0.f, s_c1 = 0.f, s_c2 = 0.f, s_bn = 0.f;
#pragma unroll
            for (int nb = 0; nb < 2; ++nb) { const int c = h3 * 64 + nb * 32 + r3; const bf16_t* pc = proj + row * PW + P_R + c;
                const float rc = bf2f(pc[0]), kc = bf2f(pc[256]), vc = bf2f(pc[512]);
                const float rp = hp ? bf2f(pc[-PW]) : 0.f, kp = hp ? bf2f(pc[256 - PW]) : 0.f, vp = hp ? bf2f(pc[512 - PW]) : 0.f;
                const float rr = rc + (rp - rc) * pmr[nb], k = kc + (kp - kc) * pmk[nb]; vv[nb] = vc + (vp - vc) * pmv[nb]; rv[nb] = rr;
                const float wl = -softplusf(-(accw[nb][e] + pw0[nb])) - 0.5f; dec[nb] = -__expf(wl); const float av        = sigm(acca[nb][e] + pa0[nb]);
                kkv[nb] = k * pkk[nb]; k2[nb] = k * (1.0f + (av - 1.0f) * pka[nb]); kka[nb] = av;
                s_kk += kkv[nb] * kkv[nb]; s_c2 += k2[nb] * rr; s_bn += rr * k2[nb] * prk[nb];
                GR[row * 256 + c] = (bf16_t)f2bf(accg[nb][e]); }
            s_kk = row16_sum(s_kk); s_kk += __shfl_xor(s_kk, 16);
            const float inv = 1.0f / fmaxf(sqrtf(s_kk), 1e-12f);
#pragma unroll
            for (int nb = 0; nb < 2; ++nb) { kkv[nb] *= inv; kka[nb] *= kkv[nb]; s_c1 += kka[nb] * rv[nb]; }
            s_c1 = row16_sum(s_c1); s_c1 += __shfl_xor(s_c1, 16); s_c2 = row16_sum(s_c2); s_c2 += __shfl_xor(s_c2, 16); s_bn = row16_sum(s_bn); s_bn += __shfl_xor(s_bn, 16);
            const size_t st = ((size_t)(b * 4 + h3) * T + t);
#pragma unroll
            for (int nb = 0; nb < 2; ++nb) { unsigned char* rb = VEC + st * RECB; const int kx = nb * 32 + r3;
                *(float*)(rb + kx * 4) = dec[nb]; *(bf16_t*)(rb + 256 + kx * 2) = (bf16_t)f2bf(-kkv[nb]); *(bf16_t*)(rb + 384 + kx * 2) = (bf16_t)f2bf(kka[nb]);
                *(bf16_t*)(rb + 512 + kx * 2) = (bf16_t)f2bf(k2[nb]); *(bf16_t*)(rb + 640 + kx * 2) = (bf16_t)f2bf(rv[nb]); *(bf16_t*)(rb + 768 + kx * 2) = (bf16_t)f2bf(vv[nb]); }
            if (r3 == 0) *(pg8::f32x4*)(SC + st * 4) = (pg8::f32x4){s_c1, s_c2, s_bn, 0.f};
            asm volatile("" ::: "memory"); }
        __syncthreads();
    }
}

__device__ __forceinline__ void ph_rwkv_scan(Frame& F, ArgsP a) {
    const unsigned char* VEC = a->ws + SCR_VEC6; float* YR = (float*)(a->ws + SCR_YR); const float* SC = (const float*)(a->ws + SCR_SC); bf16_t* STM = (bf16_t*)(a->ws + SCR_STM);
    int lane = F.lane(); asm volatile("" : "+v"(lane));
    constexpr int CH = 32, CHB = CH * RECB, NP = CHB / 1024 / 4;
    const bool stager = F.wave >= 4;
    const int vcu = (F.G % 8 == 0) ? ((int)blockIdx.x % 8) * (F.G / 8) + (int)blockIdx.x / 8 : (int)blockIdx.x;
    for (int it = vcu; it < 256; it += F.G) {
        const int bh = it >> 3, rg = it & 7, b = bh >> 2, h = bh & 3;
        const int sw = F.wave & 3, vrow = rg * 8 + 2 * sw;
        const char* src = (const char*)(VEC + (size_t)bh * T * RECB) + lane * 16;
#define RW_STAGE(cidx) do { _Pragma("unroll") for (int p_ = 0; p_ < NP; ++p_) \
            __builtin_amdgcn_global_load_lds((const unsigned*)(src + (size_t)(cidx) * CHB + (sw * NP + p_) * 1024), (LAS unsigned*)(F.lds + ((cidx) & 1) * CHB + (sw * NP + p_) * 1024), 16, 0, 0); } while (0)
        if (stager) { RW_STAGE(0); asm volatile("s_waitcnt vmcnt(0)" ::: "memory"); }
        __builtin_amdgcn_s_barrier(); asm volatile("" ::: "memory");
        float SA = 0.f, SB = 0.f;
        for (int c = 0; c < T / CH; ++c) {
            if (stager) { if (c + 1 < T / CH) { RW_STAGE(c + 1); asm volatile("s_waitcnt vmcnt(0)" ::: "memory"); } }
            else {
                const LAS unsigned char* bufb = F.lds + (c & 1) * CHB;
                STM[(((size_t)bh * 64 + c) * 64 + vrow) * 64 + lane] = (bf16_t)f2bf(SA); STM[(((size_t)bh * 64 + c) * 64 + vrow + 1) * 64 + lane] = (bf16_t)f2bf(SB);
                float zaA = 0.f, zaB = 0.f, saaA = 0.f, saaB = 0.f;
#define RW_LD(S1, nw, nnkk, nkka, nk2, nr, nvp) do { const LAS unsigned char* rec_ = bufb + (S1) * RECB; nw = *(const LAS float*)(rec_ + lane * 4); nnkk = bf2f(*(const LAS bf16_t*)(rec_ + 256 + lane * 2)); \
                    nkka = bf2f(*(const LAS bf16_t*)(rec_ + 384 + lane * 2)); nk2 = bf2f(*(const LAS bf16_t*)(rec_ + 512 + lane * 2)); nr = bf2f(*(const LAS bf16_t*)(rec_ + 640 + lane * 2)); nvp = *(const LAS unsigned*)(rec_ + 768 + vrow * 2); } while (0)
                float nw, nnkk, nkka, nk2, nr; unsigned nvp; RW_LD(0, nw, nnkk, nkka, nk2, nr, nvp);
#define RW_STEP(SI) do { \
                    const float w_ = __expf(nw), nkk = nnkk, kka = nkka, k2 = nk2, wr = w_ * nr; const pg8::f32x2 v = {__builtin_bit_cast(float, nvp << 16), __builtin_bit_cast(float, nvp & 0xffff0000u)}; \
                    RW_LD(((SI) + 1 < CH ? (SI) + 1 : (SI)), nw, nnkk, nkka, nk2, nr, nvp); \
                    asm volatile("" ::: "memory"); \
                    const auto s0 = __builtin_amdgcn_permlane32_swap(__builtin_bit_cast(unsigned, SA * nkk), __builtin_bit_cast(unsigned, SA * wr), false, false); \
                    const auto s1_ = __builtin_amdgcn_permlane32_swap(__builtin_bit_cast(unsigned, SB * nkk), __builtin_bit_cast(unsigned, SB * wr), false, false); \
                    const float xA = __builtin_bit_cast(float, (unsigned)s0[0]) + __builtin_bit_cast(float, (unsigned)s0[1]); \
                    const float xB = __builtin_bit_cast(float, (unsigned)s1_[0]) + __builtin_bit_cast(float, (unsigned)s1_[1]); \
                    const auto s2 = __builtin_amdgcn_permlane16_swap(__builtin_bit_cast(unsigned, xA), __builtin_bit_cast(unsigned, xB), false, false); \
                    float x = __builtin_bit_cast(float, (unsigned)s2[0]) + __builtin_bit_cast(float, (unsigned)s2[1]); \
                    x += dpp_mov<0xB1, 0xF>(0.f, x); x += dpp_mov<0x4E, 0xF>(0.f, x); x += dpp_mov<0x141, 0xF>(0.f, x); x += dpp_mov<0x140, 0xF>(0.f, x); \
                    const int isaA = __builtin_amdgcn_readlane(__builtin_bit_cast(int, x), 0), isaB = __builtin_amdgcn_readlane(__builtin_bit_cast(int, x), 16); \
                    const int izA = __builtin_amdgcn_readlane(__builtin_bit_cast(int, x), 32), izB = __builtin_amdgcn_readlane(__builtin_bit_cast(int, x), 48); \
                    const float saA = __builtin_bit_cast(float, isaA), saB = __builtin_bit_cast(float, isaB); \
                    SA = SA * w_ + (saA * kka + v[0] * k2); \
                    SB = SB * w_ + (saB * kka + v[1] * k2); \
                    asm volatile("v_writelane_b32 %0, %4, %8\n\tv_writelane_b32 %1, %5, %8\n\tv_writelane_b32 %2, %6, %8\n\tv_writelane_b32 %3, %7, %8" : "+v"(saaA), "+v"(saaB), "+v"(zaA), "+v"(zaB) : "s"(isaA), "s"(isaB), "s"(izA), "s"(izB), "n"(SI)); \
                } while (0)
                RW_STEP(0); RW_STEP(1); RW_STEP(2); RW_STEP(3); RW_STEP(4); RW_STEP(5); RW_STEP(6); RW_STEP(7); RW_STEP(8); RW_STEP(9); RW_STEP(10); RW_STEP(11); RW_STEP(12); RW_STEP(13); RW_STEP(14); RW_STEP(15); RW_STEP(16); RW_STEP(17); RW_STEP(18); RW_STEP(19); RW_STEP(20); RW_STEP(21); RW_STEP(22); RW_STEP(23); RW_STEP(24); RW_STEP(25); RW_STEP(26); RW_STEP(27); RW_STEP(28); RW_STEP(29); RW_STEP(30); RW_STEP(31);
#undef RW_STEP
#undef RW_LD
                const unsigned vp_ = *(const LAS unsigned*)(bufb + (lane & 31) * RECB + 768 + vrow * 2); const pg8::f32x2 vv = {__builtin_bit_cast(float, vp_ << 16), __builtin_bit_cast(float, vp_ & 0xffff0000u)};
                const pg8::f32x2 cc = *(const pg8::f32x2*)(SC + ((size_t)bh * T + c * CH + (lane & 31)) * 4);
                const float yaA = zaA + saaA * cc[0] + vv[0] * cc[1], yaB = zaB + saaB * cc[0] + vv[1] * cc[1];
                if (lane < CH) *(pg8::f32x2*)(YR + ((size_t)b * T + c * CH + lane) * 256 + h * 64 + vrow) = (pg8::f32x2){yaA, yaB};
            }
            __builtin_amdgcn_s_barrier(); asm volatile("" ::: "memory");
        }
#undef RW_STAGE
        asm volatile("s_waitcnt vmcnt(0)" ::: "memory"); __builtin_amdgcn_s_barrier(); asm volatile("" ::: "memory");
    }
}

__device__ __forceinline__ void ph_rwkv_post(Frame& F, ArgsP a, int l) {
    const unsigned char* VEC = a->ws + SCR_VEC6; const float* SC = (const float*)(a->ws + SCR_SC); const float* YR = (const float*)(a->ws + SCR_YR); const bf16_t* GR = (const bf16_t*)(a->ws + SCR_GR);
    const float* lng = (const float*)a->in[28] + l * 256; const float* lnb = (const float*)a->in[29] + l * 256;
    bf16_t* br = (bf16_t*)(a->ws + WS_HB);
    int lane = F.lane(); asm volatile("" : "+v"(lane));
    const int c = 4 * lane, h = lane >> 4;
    const pg8::f32x4 g4 = *(const pg8::f32x4*)(lng + c), b4 = *(const pg8::f32x4*)(lnb + c);
    for (int row = F.gw; row < M; row += F.NGW) {
        const int b = row / T, t = row % T; const size_t st = (size_t)(b * 4 + h) * T + t;
        const pg8::f32x4 y = *(const pg8::f32x4*)(YR + (size_t)row * 256 + c);
        const float mu = row16_sum((y[0] + y[1]) + (y[2] + y[3])) * (1.0f / 64.0f); const pg8::f32x4 d = y - mu;
        const float var = row16_sum((d[0] * d[0] + d[1] * d[1]) + (d[2] * d[2] + d[3] * d[3])) * (1.0f / 64.0f);
        const pg8::f32x4 yn = d * rsqrtf(var + 64e-5f) * g4 + b4;
        const float bonus = SC[st * 4 + 2];
        const pg8::f32x4 v = ld_bf16x4((const bf16_t*)(VEC + st * RECB + 768) + (c & 63));
        const pg8::f32x4 g = ld_bf16x4(GR + (size_t)row * 256 + c);
        st_bf16x4(br + (size_t)row * D + 768 + c, (yn + bonus * v) * g);
    }
}

__device__ __forceinline__ void ph_gla_p1(Frame& F, ArgsP a, int l) {
    const bf16_t* proj = (const bf16_t*)(a->ws + WS_PROJ); const float* w2 = (const float*)a->in[10] + l * 16 * 128; const float* gb = (const float*)a->in[11] + l * 128;
    bf16_t* QS = (bf16_t*)(a->ws + SCR_EG); float* CDp = (float*)(a->ws + SCR_EG) + (size_t)M * 128; float* GU = (float*)(a->ws + SCR_GU); float* OI = (float*)(a->ws + WS_GOI);
    const bf16_t* GZ = (const bf16_t*)(a->ws + WS_GZ);
    constexpr int RS = 40;
    LAS unsigned char* wl = F.lds + F.wave * 12800;
    LAS bf16_t* VTl = (LAS bf16_t*)wl; LAS bf16_t* Qs = (LAS bf16_t*)(wl + 5120); LAS bf16_t* Ks = (LAS bf16_t*)(wl + 7680); LAS bf16_t* KdT = (LAS bf16_t*)(wl + 10240);
    int lane = F.lane(); asm volatile("" : "+v"(lane));
    const int d = lane & 31, half = lane >> 5, r = lane & 31, hg = lane >> 5;
    for (int it = F.gw; it < 2048; it += F.NGW) {
        const int bh = it >> 6, n = it & 63, b = bh >> 2, h = bh & 3; const size_t row0 = (size_t)b * T + n * 32;
        float wc[16];
#pragma unroll
        for (int q = 0; q < 16; ++q) wc[q] = w2[q * 128 + h * 32 + d];
        const float gbv = gb[h * 32 + d];
        float g[16];
#pragma unroll
        for (int i = 0; i < 16; ++i) { const bf16_t* pr = GZ + (row0 + 16 * half + i) * 16;
            const pg8::f32x4 z0 = ld_bf16x4(pr), z1 = ld_bf16x4(pr + 4), z2 = ld_bf16x4(pr + 8), z3 = ld_bf16x4(pr + 12);
            float acc = gbv;
#pragma unroll
            for (int e = 0; e < 4; ++e) acc += z0[e] * wc[e] + z1[e] * wc[4 + e] + z2[e] * wc[8 + e] + z3[e] * wc[12 + e];
            g[i] = -softplusf(-acc) * (1.0f / 16.0f); }
#pragma unroll
        for (int i = 1; i < 16; ++i) g[i] += g[i - 1];
        const float other = __shfl(g[15], d);
        if (half) {
#pragma unroll
            for (int i = 0; i < 16; ++i) g[i] += other; }
        const float glast = __shfl(g[15], 32 + d);
#pragma unroll
        for (int i = 0; i < 16; ++i) { const int tok = 16 * half + i; const bf16_t* pr = proj + (row0 + tok) * PW;
            const float qv = bf2f(pr[P_GQ + h * 32 + d]), kv = bf2f(pr[P_GK + h * 32 + d]);
            const unsigned qb = f2bf(qv * 0.17677669529663687f * __expf(g[i]));
            Qs[tok * RS + d] = (bf16_t)qb; QS[((size_t)it * 32 + tok) * 32 + d] = (bf16_t)qb;
            Ks[tok * RS + d] = (bf16_t)f2bf(kv * __expf(-g[i])); KdT[d * RS + tok] = (bf16_t)f2bf(kv * __expf(glast - g[i])); }
        if (half) CDp[it * 32 + d] = __expf(glast);
        { const bf16_t* vp = proj + row0 * PW + P_GV + h * 64 + lane;
#pragma unroll
          for (int t2 = 0; t2 < 16; ++t2) { const unsigned lo = vp[(size_t)(2 * t2) * PW], hi = vp[(size_t)(2 * t2 + 1) * PW]; *(LAS unsigned*)(VTl + lane * RS + 2 * t2) = lo | (hi << 16); } }
        asm volatile("s_waitcnt lgkmcnt(0)" ::: "memory");
        f32x16 X;
#pragma unroll
        for (int e = 0; e < 16; ++e) X[e] = 0.f;
#pragma unroll
        for (int s = 0; s < 2; ++s) X = __builtin_amdgcn_mfma_f32_32x32x16_bf16(*(const LAS pg8::bf16x8*)(Ks + r * RS + 16 * s + 8 * hg), *(const LAS pg8::bf16x8*)(Qs + r * RS + 16 * s + 8 * hg), X, 0, 0, 0);
#pragma unroll
        for (int e = 0; e < 16; ++e) { const int jrow = (e & 3) + 8 * (e >> 2) + 4 * hg; if (jrow > r) X[e] = 0.f; }
        f32x16 oi[2], ut[2];
#pragma unroll
        for (int e = 0; e < 16; ++e) { oi[0][e] = 0.f; oi[1][e] = 0.f; ut[0][e] = 0.f; ut[1][e] = 0.f; }
#pragma unroll
        for (int s = 0; s < 2; ++s) {
            pg8::u32x4 pw; pw.x = pk2(X[8 * s], X[8 * s + 1]); pw.y = pk2(X[8 * s + 2], X[8 * s + 3]); pw.z = pk2(X[8 * s + 4], X[8 * s + 5]); pw.w = pk2(X[8 * s + 6], X[8 * s + 7]);
            const pg8::bf16x8 xf = __builtin_bit_cast(pg8::bf16x8, pw);
            const pg8::bf16x8 kdf = *(const LAS pg8::bf16x8*)(KdT + r * RS + 16 * s + 8 * hg);
#pragma unroll
            for (int db = 0; db < 2; ++db) { const LAS bf16_t* vp = VTl + (db * 32 + r) * RS + 16 * s;
                const pg8::u32x2 v0 = *(const LAS pg8::u32x2*)(vp + 4 * hg), v1 = *(const LAS pg8::u32x2*)(vp + 8 + 4 * hg);
                pg8::u32x4 vw; vw.x = v0.x; vw.y = v0.y; vw.z = v1.x; vw.w = v1.y;
                oi[db] = __builtin_amdgcn_mfma_f32_32x32x16_bf16(__builtin_bit_cast(pg8::bf16x8, vw), xf, oi[db], 0, 0, 0);
                ut[db] = __builtin_amdgcn_mfma_f32_32x32x16_bf16(*(const LAS pg8::bf16x8*)(vp + 8 * hg), kdf, ut[db], 0, 0, 0); } }
        float* op = OI + (size_t)it * 2048 + lane;
#pragma unroll
        for (int db = 0; db < 2; ++db)
#pragma unroll
            for (int e = 0; e < 16; ++e) op[(db * 16 + e) * 64] = oi[db][e];
        float* up = GU + ((size_t)it * 32 + r) * 64 + 4 * hg;
#pragma unroll
        for (int db = 0; db < 2; ++db)
#pragma unroll
            for (int q = 0; q < 4; ++q) *(pg8::f32x4*)(up + db * 32 + 8 * q) = (pg8::f32x4){ut[db][4 * q], ut[db][4 * q + 1], ut[db][4 * q + 2], ut[db][4 * q + 3]};
        asm volatile("s_waitcnt lgkmcnt(0)" ::: "memory");
    }
}
__device__ __forceinline__ void ph_gla_prefix(Frame& F, ArgsP a) {
    const float* CDp = (const float*)(a->ws + SCR_EG) + (size_t)M * 128; const float* GU = (const float*)(a->ws + SCR_GU); bf16_t* ST = (bf16_t*)(a->ws + WS_GST);
    int lane = F.lane(); asm volatile("" : "+v"(lane));
    for (int it = F.gw; it < 1024; it += F.NGW) { const int bh = it >> 5, d = it & 31;
        const float* gp = GU + ((size_t)bh * 64 * 32 + d) * 64 + lane; const float* cp = CDp + (size_t)bh * 64 * 32 + d;
        bf16_t* sp = ST + ((size_t)bh * 64 * 64 + lane) * 32 + d;
        float u[64], cd[64];
#pragma unroll
        for (int n = 0; n < 64; ++n) { u[n] = gp[(size_t)n * 2048]; cd[n] = cp[n * 32]; }
        float S = 0.f;
#pragma unroll
        for (int n = 0; n < 64; ++n) { sp[(size_t)n * 2048] = (bf16_t)f2bf(S); S = cd[n] * S + u[n]; } }
}
__device__ __forceinline__ void ph_gla_p2(Frame& F, ArgsP a, int l) {
    const bf16_t* proj = (const bf16_t*)(a->ws + WS_PROJ); const float* gnorm = (const float*)a->in[12] + l * 64;
    const bf16_t* QS = (const bf16_t*)(a->ws + SCR_EG); const bf16_t* ST = (const bf16_t*)(a->ws + WS_GST); const float* OI = (const float*)(a->ws + WS_GOI); bf16_t* br = (bf16_t*)(a->ws + WS_HB);
    int lane = F.lane(); asm volatile("" : "+v"(lane));
    const int r = lane & 31, hg = lane >> 5;
    for (int it = F.gw; it < 2048; it += F.NGW) {
        const int bh = it >> 6, n = it & 63, b = bh >> 2, h = bh & 3; const size_t row0 = (size_t)b * T + n * 32;
        f32x16 ot[2]; const float* op = OI + (size_t)it * 2048 + lane;
#pragma unroll
        for (int db = 0; db < 2; ++db)
#pragma unroll
            for (int e = 0; e < 16; ++e) ot[db][e] = op[(db * 16 + e) * 64];
#pragma unroll
        for (int s = 0; s < 2; ++s) { const pg8::bf16x8 qf = *(const pg8::bf16x8*)(QS + ((size_t)it * 32 + r) * 32 + 16 * s + 8 * hg);
#pragma unroll
            for (int db = 0; db < 2; ++db) ot[db] = __builtin_amdgcn_mfma_f32_32x32x16_bf16(*(const pg8::bf16x8*)(ST + ((size_t)it * 64 + db * 32 + r) * 32 + 16 * s + 8 * hg), qf, ot[db], 0, 0, 0); }
        float ss = 0.f;
#pragma unroll
        for (int db = 0; db < 2; ++db)
#pragma unroll
            for (int e = 0; e < 16; ++e) ss += ot[db][e] * ot[db][e];
        ss += __shfl_xor(ss, 32);
        const float rstd = rsqrtf(ss * (1.0f / 64.0f) + 1e-6f);
        const bf16_t* og = proj + (row0 + r) * PW + P_GO + h * 64 + 4 * hg; bf16_t* od = br + (row0 + r) * D + h * 64 + 4 * hg;
#pragma unroll
        for (int db = 0; db < 2; ++db)
#pragma unroll
            for (int q = 0; q < 4; ++q) { const int dv0 = db * 32 + 8 * q; const pg8::f32x4 gv = ld_bf16x4(og + dv0), gn = *(const pg8::f32x4*)(gnorm + dv0 + 4 * hg);
                st_bf16x4(od + dv0, (pg8::f32x4){ot[db][4 * q] * rstd * gn[0] * siluf(gv[0]), ot[db][4 * q + 1] * rstd * gn[1] * siluf(gv[1]), ot[db][4 * q + 2] * rstd * gn[2] * siluf(gv[2]), ot[db][4 * q + 3] * rstd * gn[3] * siluf(gv[3])}); }
    }
}

__device__ __forceinline__ void ph_attn_prep(Frame& F, ArgsP a) {
    const bf16_t* proj = (const bf16_t*)(a->ws + WS_PROJ); const int* pos = (const int*)a->in[2];
    bf16_t* QR = (bf16_t*)(a->ws + SCR_QK); bf16_t* KR = QR + (size_t)M * 256; bf16_t* VT = (bf16_t*)(a->ws + SCR_VT);
    int lane = F.lane(); asm volatile("" : "+v"(lane));
    for (int idx = F.gw * 64 + lane; idx < M * 8; idx += F.NGW * 64) { const int row = idx >> 3, hc = idx & 7; const float p = (float)pos[row];
        const bf16_t* qs = proj + (size_t)row * PW + P_DQ + hc * 32; const bf16_t* ks = proj + (size_t)row * PW + P_DK + hc * 32;
        float qv[32], kv[32];
#pragma unroll
        for (int j = 0; j < 8; ++j) { const pg8::f32x4 q4 = ld_bf16x4(qs + 4 * j), k4 = ld_bf16x4(ks + 4 * j);
#pragma unroll
            for (int e = 0; e < 4; ++e) { qv[4 * j + e] = q4[e]; kv[4 * j + e] = k4[e]; } }
        float qo[32], ko[32];
#pragma unroll
        for (int i = 0; i < 16; ++i) { const float inv = exp2f(-(float)i * 0.8304820237218406f);
            float sn, cs; sincosf(p * inv, &sn, &cs);
            qo[i] = qv[i] * cs - qv[i + 16] * sn; qo[i + 16] = qv[i] * sn + qv[i + 16] * cs;
            ko[i] = kv[i] * cs - kv[i + 16] * sn; ko[i + 16] = kv[i] * sn + kv[i + 16] * cs; }
        const float qsc = 0.17677669529663687f * 1.4426950408889634f;
        bf16_t* qd = QR + (size_t)row * 256 + hc * 32; bf16_t* kd = KR + (size_t)row * 256 + hc * 32;
#pragma unroll
        for (int j = 0; j < 8; ++j) { st_bf16x4(qd + 4 * j, (pg8::f32x4){qo[4 * j] * qsc, qo[4 * j + 1] * qsc, qo[4 * j + 2] * qsc, qo[4 * j + 3] * qsc});
            st_bf16x4(kd + 4 * j, (pg8::f32x4){ko[4 * j], ko[4 * j + 1], ko[4 * j + 2], ko[4 * j + 3]}); } }
    for (int it = F.gw; it < 1024; it += F.NGW) { const int bh = it >> 5, tt = it & 31, b = bh >> 2, h = bh & 3;
        const bf16_t* vs = proj + ((size_t)b * T + tt * 64 + lane) * PW + P_DV + h * 64;
        pg8::u32x4 v[8];
#pragma unroll
        for (int j = 0; j < 8; ++j) v[j] = *(const pg8::u32x4*)(vs + 8 * j);
        bf16_t* vd = VT + (size_t)bh * 64 * T + tt * 64 + lane;
#pragma unroll
        for (int j = 0; j < 8; ++j)
#pragma unroll
            for (int e = 0; e < 4; ++e) { const unsigned w = v[j][e]; vd[(size_t)(8 * j + 2 * e) * T] = (bf16_t)(w & 0xffffu); vd[(size_t)(8 * j + 2 * e + 1) * T] = (bf16_t)(w >> 16); } }
}
__device__ __forceinline__ void ph_attn(Frame& F, ArgsP a, int l) {
    const bf16_t* QR = (const bf16_t*)(a->ws + SCR_QK); const bf16_t* KR = QR + (size_t)M * 256; const bf16_t* VT = (const bf16_t*)(a->ws + SCR_VT);
    const float* lp = (const float*)a->in[13] + l * 128; const float* subln = (const float*)a->in[14] + l * 64; bf16_t* br = (bf16_t*)(a->ws + WS_HB);
    int tid = F.wave * 64 + F.lane(); asm volatile("" : "+v"(tid)); const int lane = tid & 63;
    const int r = lane & 31, hg = lane >> 5, comp = F.wave & 1, qs = F.wave >> 1;
    constexpr int RS = 72;
    LAS bf16_t* Kt = (LAS bf16_t*)F.lds;
    LAS bf16_t* Vt = Kt + 2 * 64 * RS;
    LAS float* Xl = (LAS float*)(F.lds + 4 * 64 * RS * 2);
    float lam, lam_init;
    { float d01 = 0.f, d23 = 0.f;
      for (int i = 0; i < 32; ++i) { d01 += lp[i] * lp[32 + i]; d23 += lp[64 + i] * lp[96 + i]; }
      lam_init = 0.8f - 0.6f * __expf(-0.3f * (float)l); lam = __expf(d01) - __expf(d23) + lam_init; }
    const int ldrow = tid >> 3, ldch = tid & 7;
    const int vcu = (F.G % 8 == 0) ? ((int)blockIdx.x % 8) * (F.G / 8) + (int)blockIdx.x / 8 : (int)blockIdx.x;
    for (int pi = vcu; pi < 256; pi += F.G) {
#pragma unroll 1
        for (int half = 0; half < 2; ++half) {
            const int bh = pi >> 3, j = pi & 7, qb = half == 0 ? 15 - j : j, b = bh >> 2, h = bh & 3;
            const int q0 = qb * 128 + qs * 32, nkw = q0 / 64 + 1, nkb = 2 * qb + 2;
            const size_t rowb = (size_t)b * T;
            pg8::bf16x8 qf[2];
#pragma unroll
            for (int s = 0; s < 2; ++s) qf[s] = *(const pg8::bf16x8*)(QR + (rowb + q0 + r) * 256 + h * 64 + comp * 32 + 16 * s + 8 * hg);
            f32x16 ot[2];
#pragma unroll
            for (int e = 0; e < 16; ++e) { ot[0][e] = 0.f; ot[1][e] = 0.f; }
            float mrun = -1e30f, lrun = 0.f;
            const bf16_t* kg = KR + (rowb + ldrow) * 256 + h * 64 + ldch * 8; const bf16_t* vg = VT + ((size_t)bh * 64 + ldrow) * T + ldch * 8;
            pg8::u32x4 kreg = *(const pg8::u32x4*)kg, vreg = *(const pg8::u32x4*)vg;
            pg8::u32x4 kreg2 = kreg, vreg2 = vreg;
            if (nkb > 1) { kreg2 = *(const pg8::u32x4*)(kg + (size_t)64 * 256); vreg2 = *(const pg8::u32x4*)(vg + 64); }
            for (int kt = 0; kt < nkb; ++kt) {
                const int bo = (kt & 1) * 64 * RS;
                *(LAS pg8::u32x4*)(Kt + bo + ldrow * RS + ldch * 8) = kreg; *(LAS pg8::u32x4*)(Vt + bo + ldrow * RS + ldch * 8) = vreg;
                __syncthreads();
                kreg = kreg2; vreg = vreg2;
                if (kt + 2 < nkb) { kreg2 = *(const pg8::u32x4*)(kg + (size_t)(kt + 2) * 64 * 256); vreg2 = *(const pg8::u32x4*)(vg + (kt + 2) * 64); }
                if (kt < nkw) {
                    f32x16 st[2];
#pragma unroll
                    for (int kb = 0; kb < 2; ++kb) {
#pragma unroll
                        for (int e = 0; e < 16; ++e) st[kb][e] = 0.f;
#pragma unroll
                        for (int s = 0; s < 2; ++s) { const pg8::bf16x8 kf = *(const LAS pg8::bf16x8*)(Kt + bo + (kb * 32 + r) * RS + comp * 32 + 16 * s + 8 * hg);
                            st[kb] = __builtin_amdgcn_mfma_f32_32x32x16_bf16(kf, qf[s], st[kb], 0, 0, 0); } }
                    if (kt == nkw - 1) {
                        const int qi = q0 + r;
#pragma unroll
                        for (int kb = 0; kb < 2; ++kb)
#pragma unroll
                            for (int e = 0; e < 16; ++e) { const int ki = kt * 64 + kb * 32 + (e & 3) + 8 * (e >> 2) + 4 * hg; if (ki > qi) st[kb][e] = -1e30f; } }
                    float tm = st[0][0];
#pragma unroll
                    for (int e = 1; e < 16; ++e) tm = fmaxf(tm, st[0][e]);
#pragma unroll
                    for (int e = 0; e < 16; ++e) tm = fmaxf(tm, st[1][e]);
                    { const auto sw = __builtin_amdgcn_permlane32_swap(__builtin_bit_cast(unsigned, tm), __builtin_bit_cast(unsigned, tm), false, false); tm = fmaxf(__builtin_bit_cast(float, (unsigned)sw[0]), __builtin_bit_cast(float, (unsigned)sw[1])); }
                    const float mn = fmaxf(mrun, tm), alpha = __builtin_amdgcn_exp2f(mrun - mn); mrun = mn;
                    float ps = 0.f;
#pragma unroll
                    for (int kb = 0; kb < 2; ++kb)
#pragma unroll
                        for (int e = 0; e < 16; ++e) { st[kb][e] = __builtin_amdgcn_exp2f(st[kb][e] - mn); ps += st[kb][e]; }
                    lrun = lrun * alpha + ps;
#pragma unroll
                    for (int e = 0; e < 16; ++e) { ot[0][e] *= alpha; ot[1][e] *= alpha; }
#pragma unroll
                    for (int kb = 0; kb < 2; ++kb)
#pragma unroll
                        for (int s = 0; s < 2; ++s) {
                            pg8::u32x4 pw; pw.x = pk2(st[kb][8 * s], st[kb][8 * s + 1]); pw.y = pk2(st[kb][8 * s + 2], st[kb][8 * s + 3]); pw.z = pk2(st[kb][8 * s + 4], st[kb][8 * s + 5]); pw.w = pk2(st[kb][8 * s + 6], st[kb][8 * s + 7]);
                            const pg8::bf16x8 pf = __builtin_bit_cast(pg8::bf16x8, pw);
#pragma unroll
                            for (int dvb = 0; dvb < 2; ++dvb) { const LAS bf16_t* vp = Vt + bo + (dvb * 32 + r) * RS + kb * 32 + 16 * s + 4 * hg;
                                const pg8::u32x2 v0 = *(const LAS pg8::u32x2*)vp, v1 = *(const LAS pg8::u32x2*)(vp + 8);
                                pg8::u32x4 vw; vw.x = v0.x; vw.y = v0.y; vw.z = v1.x; vw.w = v1.y;
                                ot[dvb] = __builtin_amdgcn_mfma_f32_32x32x16_bf16(__builtin_bit_cast(pg8::bf16x8, vw), pf, ot[dvb], 0, 0, 0); } }
                }
            }
            const float ltot = lrun + __shfl_xor(lrun, 32); const float il = 1.0f / ltot;
            __syncthreads();
            if (comp == 1) {
#pragma unroll
                for (int dvb = 0; dvb < 2; ++dvb)
#pragma unroll
                    for (int e = 0; e < 16; ++e) Xl[(qs * 32 + dvb * 16 + e) * 64 + lane] = ot[dvb][e] * il; }
            __syncthreads();
            if (comp == 0) {
                float o[32]; float ss = 0.f;
#pragma unroll
                for (int dvb = 0; dvb < 2; ++dvb)
#pragma unroll
                    for (int e = 0; e < 16; ++e) { const float v = ot[dvb][e] * il - lam * Xl[(qs * 32 + dvb * 16 + e) * 64 + lane]; o[dvb * 16 + e] = v; ss += v * v; }
                ss += __shfl_xor(ss, 32);
                const float sc = rsqrtf(ss * (1.0f / 64.0f) + 1e-6f) * (1.0f - lam_init);
                bf16_t* od = br + (rowb + q0 + r) * D + 256 + h * 64;
#pragma unroll
                for (int dvb = 0; dvb < 2; ++dvb)
#pragma unroll
                    for (int g4 = 0; g4 < 4; ++g4) { const int dv0 = dvb * 32 + 8 * g4 + 4 * hg; const pg8::f32x4 sl = *(const pg8::f32x4*)(subln + dv0);
                        st_bf16x4(od + dv0, (pg8::f32x4){o[dvb * 16 + 4 * g4] * sc * sl[0], o[dvb * 16 + 4 * g4 + 1] * sc * sl[1], o[dvb * 16 + 4 * g4 + 2] * sc * sl[2], o[dvb * 16 + 4 * g4 + 3] * sc * sl[3]}); }
            }
            __syncthreads();
        }
    }
}

__device__ __forceinline__ void ph_branch(Frame& F, ArgsP a, int l) {
    const bf16_t* br = (const bf16_t*)(a->ws + WS_HB); const bf16_t* WB = (const bf16_t*)(a->ws + WS_WB) + (size_t)l * 4096 * 256;
    const bf16_t* proj = (const bf16_t*)(a->ws + WS_PROJ); bf16_t* MB = (bf16_t*)(a->ws + SCR_MB);
    int tid = F.wave * 64 + F.lane(); asm volatile("" : "+v"(tid)); const int lane = tid & 63;
    const int r = lane & 31, hg = lane >> 5, wt = (tid >> 6) & 3, wd = tid >> 8;
    constexpr int RS = 72, TB = 128 * RS;
    LAS bf16_t* Wl = (LAS bf16_t*)F.lds;
    LAS bf16_t* Bl = Wl + 2 * TB;
    const int ldr = tid >> 3, ldc = (tid & 7) * 8;
    for (int it = blockIdx.x; it < 1024; it += F.G) {
        const int tm = it >> 3, td = it & 7; const size_t row0 = (size_t)tm * 128; const int d0 = td * 128;
        f32x16 tot[2], acc[2];
#pragma unroll
        for (int e = 0; e < 16; ++e) { tot[0][e] = 0.f; tot[1][e] = 0.f; acc[0][e] = 0.f; acc[1][e] = 0.f; }
        pg8::u32x4 rw0, rw1, rb0, rb1;
#define BR_LOAD(st) do { const int g_ = (st) >> 2, kq_ = (st) & 3; const bf16_t* wp = WB + (size_t)(g_ * 1024 + d0 + ldr) * 256 + kq_ * 64 + ldc; const bf16_t* bp = br + (row0 + ldr) * D + g_ * 256 + kq_ * 64 + ldc; \
            rw0 = *(const pg8::u32x4*)wp; rw1 = *(const pg8::u32x4*)(wp + 64 * 256); rb0 = *(const pg8::u32x4*)bp; rb1 = *(const pg8::u32x4*)(bp + 64 * D); } while (0)
#define BR_WRITE(buf) do { *(LAS pg8::u32x4*)(Wl + (buf) * TB + ldr * RS + ldc) = rw0; *(LAS pg8::u32x4*)(Wl + (buf) * TB + (ldr + 64) * RS + ldc) = rw1; \
            *(LAS pg8::u32x4*)(Bl + (buf) * TB + ldr * RS + ldc) = rb0; *(LAS pg8::u32x4*)(Bl + (buf) * TB + (ldr + 64) * RS + ldc) = rb1; } while (0)
        BR_LOAD(0); BR_WRITE(0); __syncthreads(); BR_LOAD(1);
        pg8::u32x2 gt[2][4];
#pragma unroll 1
        for (int st = 0; st < 16; ++st) {
            const int buf = st & 1, g = st >> 2;
            if ((st & 3) == 0) {
                const bf16_t* gp = proj + (row0 + wt * 32 + r) * PW + P_GATE + g * 1024 + d0 + wd * 64 + 4 * hg;
#pragma unroll
                for (int db = 0; db < 2; ++db)
#pragma unroll
                    for (int q = 0; q < 4; ++q) gt[db][q] = *(const pg8::u32x2*)(gp + db * 32 + 8 * q); }
#pragma unroll
            for (int s = 0; s < 4; ++s) { const pg8::bf16x8 bf = *(const LAS pg8::bf16x8*)(Bl + buf * TB + (wt * 32 + r) * RS + 16 * s + 8 * hg);
#pragma unroll
                for (int db = 0; db < 2; ++db) { const pg8::bf16x8 af = *(const LAS pg8::bf16x8*)(Wl + buf * TB + (wd * 64 + db * 32 + r) * RS + 16 * s + 8 * hg);
                    acc[db] = __builtin_amdgcn_mfma_f32_32x32x16_bf16(af, bf, acc[db], 0, 0, 0); } }
            if (st + 1 < 16) BR_WRITE(buf ^ 1);
            if (st + 2 < 16) BR_LOAD(st + 2);
            if ((st & 3) == 3) {
#pragma unroll
                for (int db = 0; db < 2; ++db)
#pragma unroll
                    for (int q = 0; q < 4; ++q) { const pg8::u32x2 w = gt[db][q];
                        const float g0 = __builtin_bit_cast(float, w.x << 16), g1 = __builtin_bit_cast(float, w.x & 0xffff0000u), g2 = __builtin_bit_cast(float, w.y << 16), g3 = __builtin_bit_cast(float, w.y & 0xffff0000u);
                        tot[db][4 * q] += acc[db][4 * q] * sigm(g0); tot[db][4 * q + 1] += acc[db][4 * q + 1] * sigm(g1); tot[db][4 * q + 2] += acc[db][4 * q + 2] * sigm(g2); tot[db][4 * q + 3] += acc[db][4 * q + 3] * sigm(g3);
                        acc[db][4 * q] = 0.f; acc[db][4 * q + 1] = 0.f; acc[db][4 * q + 2] = 0.f; acc[db][4 * q + 3] = 0.f; } }
            __syncthreads();
        }
#undef BR_LOAD
#undef BR_WRITE
        bf16_t* mp = MB + (row0 + wt * 32 + r) * D + d0 + wd * 64 + 4 * hg;
#pragma unroll
        for (int db = 0; db < 2; ++db)
#pragma unroll
            for (int q = 0; q < 4; ++q) st_bf16x4(mp + db * 32 + 8 * q, (pg8::f32x4){tot[db][4 * q], tot[db][4 * q + 1], tot[db][4 * q + 2], tot[db][4 * q + 3]});
    }
}

__device__ __forceinline__ int crow(int e, int hg) { return (e & 3) + 8 * (e >> 2) + 4 * hg; }
__device__ __forceinline__ void ph_rk_p1(Frame& F, ArgsP a) {
    if (F.wave >= 4) return;
    const unsigned char* VEC = a->ws + SCR_VEC6;
    bf16_t* QE = (bf16_t*)(a->ws + SCR_QE); bf16_t* AY = (bf16_t*)(a->ws + SCR_AY); bf16_t* VTC = (bf16_t*)(a->ws + SCR_VTC); bf16_t* GMF = (bf16_t*)(a->ws + SCR_GMF); bf16_t* ZB = (bf16_t*)(a->ws + SCR_ZB);
    LAS unsigned char* wl = F.lds + F.wave * 40448;
    LAS bf16_t* TA = (LAS bf16_t*)wl;
    LAS bf16_t* TK = (LAS bf16_t*)(wl + 4608);
    LAS bf16_t* TR = (LAS bf16_t*)(wl + 9216);
    LAS bf16_t* TB = (LAS bf16_t*)(wl + 13824);
    LAS bf16_t* TBT = (LAS bf16_t*)(wl + 18432);
    LAS bf16_t* TKT = (LAS bf16_t*)(wl + 23552);
    LAS bf16_t* TVT = (LAS bf16_t*)(wl + 28672);
    LAS bf16_t* MRB = (LAS bf16_t*)(wl + 33792);
    LAS bf16_t* W2T = (LAS bf16_t*)(wl + 36352);
    LAS float* GC = (LAS float*)(wl + 38912);
    LAS float* LabF = (LAS float*)(wl + 4608); LAS float* LakF = (LAS float*)(wl + 13824); LAS bf16_t* W1T = (LAS bf16_t*)wl; LAS bf16_t* GST = (LAS bf16_t*)(wl + 9216); LAS bf16_t* HM = TKT;
    int lane0 = F.lane(); asm volatile("" : "+v"(lane0));
#define RK_LANES() int lane = lane0; asm volatile("" : "+v"(lane)); const int r = lane & 31, hg = lane >> 5; (void)r; (void)hg
    for (int it = (int)blockIdx.x * 4 + F.wave; it < 2048; it += F.G * 4) {
        const unsigned char* rec0 = VEC + (size_t)it * 32 * RECB;
        f32x16 mrk;
        {
            RK_LANES();
        { float G = 0.f, gprev = 1.f;
#pragma unroll 4
          for (int t = 0; t < 32; ++t) { const unsigned char* rp = rec0 + t * RECB;
              const float lw = *(const float*)(rp + lane * 4); const float av = bf2f(*(const bf16_t*)(rp + 256 + lane * 2)), bv = bf2f(*(const bf16_t*)(rp + 384 + lane * 2)), kv = bf2f(*(const bf16_t*)(rp + 512 + lane * 2)), rv = bf2f(*(const bf16_t*)(rp + 640 + lane * 2));
              const bf16_t vraw = *(const bf16_t*)(rp + 768 + lane * 2);
              G += lw; const float gam = __expf(G), inv = __builtin_amdgcn_rcpf(gam);
              const bf16_t bt = (bf16_t)f2bf(bv * inv), kt = (bf16_t)f2bf(kv * inv);
              TA[t * 72 + lane] = (bf16_t)f2bf(av * gprev); TR[t * 72 + lane] = (bf16_t)f2bf(rv * gam); TB[t * 72 + lane] = bt; TK[t * 72 + lane] = kt;
              TBT[lane * 40 + t] = bt; TKT[lane * 40 + t] = kt; TVT[lane * 40 + t] = vraw; gprev = gam; }
          GC[lane] = gprev; }
        asm volatile("s_waitcnt lgkmcnt(0)" ::: "memory");
#pragma unroll
        for (int q = 0; q < 4; ++q) *(pg8::u32x4*)(VTC + ((size_t)it * 64 + lane) * 32 + 8 * q) = *(const LAS pg8::u32x4*)(TVT + lane * 40 + 8 * q);
        }
        {
            RK_LANES();
        f32x16 lab, lak, mrb;
#pragma unroll
        for (int e = 0; e < 16; ++e) { lab[e] = 0.f; lak[e] = 0.f; mrb[e] = 0.f; mrk[e] = 0.f; }
#pragma unroll
        for (int s = 0; s < 4; ++s) { const int o = r * 72 + 16 * s + 8 * hg;
            const pg8::bf16x8 fa = *(const LAS pg8::bf16x8*)(TA + o), fr = *(const LAS pg8::bf16x8*)(TR + o), fb = *(const LAS pg8::bf16x8*)(TB + o), fk = *(const LAS pg8::bf16x8*)(TK + o);
            lab = __builtin_amdgcn_mfma_f32_32x32x16_bf16(fa, fb, lab, 0, 0, 0); lak = __builtin_amdgcn_mfma_f32_32x32x16_bf16(fa, fk, lak, 0, 0, 0);
            mrb = __builtin_amdgcn_mfma_f32_32x32x16_bf16(fr, fb, mrb, 0, 0, 0); mrk = __builtin_amdgcn_mfma_f32_32x32x16_bf16(fr, fk, mrk, 0, 0, 0); }
#pragma unroll
        for (int e = 0; e < 16; ++e) { const int t = crow(e, hg);
            LabF[t * 36 + r] = (r < t) ? lab[e] : 0.f; LakF[t * 36 + r] = (r < t) ? lak[e] : 0.f;
            MRB[t * 40 + r] = (bf16_t)f2bf((r <= t) ? mrb[e] : 0.f); mrk[e] = (r <= t) ? mrk[e] : 0.f; }
        asm volatile("s_waitcnt lgkmcnt(0)" ::: "memory");
        }
        {
            RK_LANES();
        { float W1[32], W2[32];
          W1[0] = bf2f(TA[lane]); W2[0] = LakF[r];
          unsigned dep = 0u;
#pragma unroll
          for (int t = 1; t < 32; ++t) { asm volatile("" : "+v"(dep) : "v"(W1[t - 1]), "v"(W2[t - 1]));
              const LAS float* Lr = LabF + t * 36 + dep;
              float s1 = bf2f(TA[t * 72 + lane + dep]), s2 = LakF[t * 36 + r + dep];
#pragma unroll
              for (int j4 = 0; j4 < (t + 3) / 4; ++j4) { const pg8::f32x4 L4 = *(const LAS pg8::f32x4*)(Lr + 4 * j4);
#pragma unroll
                  for (int q = 0; q < 4; ++q) if (4 * j4 + q < t) { s1 = __builtin_fmaf(L4[q], W1[4 * j4 + q], s1); s2 = __builtin_fmaf(L4[q], W2[4 * j4 + q], s2); } }
              W1[t] = s1; W2[t] = s2; }
          asm volatile("s_waitcnt lgkmcnt(0)" ::: "memory");
#pragma unroll
          for (int q = 0; q < 4; ++q) { *(LAS pg8::u32x4*)(W1T + lane * 40 + 8 * q) = (pg8::u32x4){pk2(W1[8 * q], W1[8 * q + 1]), pk2(W1[8 * q + 2], W1[8 * q + 3]), pk2(W1[8 * q + 4], W1[8 * q + 5]), pk2(W1[8 * q + 6], W1[8 * q + 7])};
              if (lane < 32) *(LAS pg8::u32x4*)(W2T + lane * 40 + 8 * q) = (pg8::u32x4){pk2(W2[8 * q], W2[8 * q + 1]), pk2(W2[8 * q + 2], W2[8 * q + 3]), pk2(W2[8 * q + 4], W2[8 * q + 5]), pk2(W2[8 * q + 6], W2[8 * q + 7])}; } }
        asm volatile("s_waitcnt lgkmcnt(0)" ::: "memory");
        }
        {
            RK_LANES();
#pragma unroll
        for (int kb = 0; kb < 2; ++kb) { f32x16 acc;
#pragma unroll
            for (int e = 0; e < 16; ++e) acc[e] = bf2f(TR[crow(e, hg) * 72 + kb * 32 + r]);
#pragma unroll
            for (int s = 0; s < 2; ++s) acc = __builtin_amdgcn_mfma_f32_32x32x16_bf16(*(const LAS pg8::bf16x8*)(MRB + r * 40 + 16 * s + 8 * hg), *(const LAS pg8::bf16x8*)(W1T + (kb * 32 + r) * 40 + 16 * s + 8 * hg), acc, 0, 0, 0);
#pragma unroll
            for (int e = 0; e < 16; ++e) QE[((size_t)it * 32 + crow(e, hg)) * 64 + kb * 32 + r] = (bf16_t)f2bf(acc[e]); }
        }
        {
            RK_LANES();
        { f32x16 acc = mrk;
#pragma unroll
          for (int s = 0; s < 2; ++s) acc = __builtin_amdgcn_mfma_f32_32x32x16_bf16(*(const LAS pg8::bf16x8*)(MRB + r * 40 + 16 * s + 8 * hg), *(const LAS pg8::bf16x8*)(W2T + r * 40 + 16 * s + 8 * hg), acc, 0, 0, 0);
#pragma unroll
          for (int e = 0; e < 16; ++e) AY[((size_t)it * 32 + crow(e, hg)) * 32 + r] = (bf16_t)f2bf(acc[e]); }
        asm volatile("s_waitcnt lgkmcnt(0)" ::: "memory");
        }
        {
            RK_LANES();
#pragma unroll
        for (int kbr = 0; kbr < 2; ++kbr)
#pragma unroll
            for (int kb = 0; kb < 2; ++kb) { f32x16 acc;
#pragma unroll
                for (int e = 0; e < 16; ++e) acc[e] = 0.f;
#pragma unroll
                for (int s = 0; s < 2; ++s) acc = __builtin_amdgcn_mfma_f32_32x32x16_bf16(*(const LAS pg8::bf16x8*)(TBT + (kbr * 32 + r) * 40 + 16 * s + 8 * hg), *(const LAS pg8::bf16x8*)(W1T + (kb * 32 + r) * 40 + 16 * s + 8 * hg), acc, 0, 0, 0);
#pragma unroll
                for (int e = 0; e < 16; ++e) { const int kr = kbr * 32 + crow(e, hg); const float dl = (kbr == kb && crow(e, hg) == r) ? 1.f : 0.f;
                    GST[kr * 72 + kb * 32 + r] = (bf16_t)f2bf(GC[kr] * (acc[e] + dl)); } }
        asm volatile("s_waitcnt lgkmcnt(0)" ::: "memory");
#pragma unroll
        for (int kbr = 0; kbr < 2; ++kbr)
#pragma unroll
            for (int kb = 0; kb < 2; ++kb)
#pragma unroll
                for (int s = 0; s < 2; ++s) { const LAS bf16_t* p = GST + (kbr * 32 + r) * 72 + kb * 32 + 16 * s;
                    const pg8::u32x2 v0 = *(const LAS pg8::u32x2*)(p + 4 * hg), v1 = *(const LAS pg8::u32x2*)(p + 8 + 4 * hg);
                    *(pg8::u32x4*)(GMF + (((size_t)it * 8 + (kbr * 2 + kb) * 2 + s) * 64 + lane) * 8) = (pg8::u32x4){v0.x, v0.y, v1.x, v1.y}; }
        }
        {
            RK_LANES();
#pragma unroll
        for (int kbr = 0; kbr < 2; ++kbr) { f32x16 acc;
#pragma unroll
            for (int e = 0; e < 16; ++e) acc[e] = bf2f(TKT[(kbr * 32 + crow(e, hg)) * 40 + r]);
#pragma unroll
            for (int s = 0; s < 2; ++s) acc = __builtin_amdgcn_mfma_f32_32x32x16_bf16(*(const LAS pg8::bf16x8*)(TBT + (kbr * 32 + r) * 40 + 16 * s + 8 * hg), *(const LAS pg8::bf16x8*)(W2T + r * 40 + 16 * s + 8 * hg), acc, 0, 0, 0);
            asm volatile("s_waitcnt lgkmcnt(0)" ::: "memory");
#pragma unroll
            for (int e = 0; e < 16; ++e) { const int kr = kbr * 32 + crow(e, hg); HM[kr * 40 + r] = (bf16_t)f2bf(GC[kr] * acc[e]); } }
        asm volatile("s_waitcnt lgkmcnt(0)" ::: "memory");
        }
        {
            RK_LANES();
#pragma unroll
        for (int vb = 0; vb < 2; ++vb)
#pragma unroll
            for (int kbr = 0; kbr < 2; ++kbr) { f32x16 acc;
#pragma unroll
                for (int e = 0; e < 16; ++e) acc[e] = 0.f;
#pragma unroll
                for (int s = 0; s < 2; ++s) acc = __builtin_amdgcn_mfma_f32_32x32x16_bf16(*(const LAS pg8::bf16x8*)(HM + (kbr * 32 + r) * 40 + 16 * s + 8 * hg), *(const LAS pg8::bf16x8*)(TVT + (vb * 32 + r) * 40 + 16 * s + 8 * hg), acc, 0, 0, 0);
                pg8::u32x4* zp = (pg8::u32x4*)(ZB + ((((size_t)it * 2 + vb) * 2 + kbr) * 64 + lane) * 16);
                zp[0] = (pg8::u32x4){pk2(acc[0], acc[1]), pk2(acc[2], acc[3]), pk2(acc[4], acc[5]), pk2(acc[6], acc[7])}; zp[1] = (pg8::u32x4){pk2(acc[8], acc[9]), pk2(acc[10], acc[11]), pk2(acc[12], acc[13]), pk2(acc[14], acc[15])}; }
        }
        asm volatile("s_waitcnt lgkmcnt(0)" ::: "memory");
    }
}
#undef RK_LANES
__device__ __forceinline__ void ph_rk_p2(Frame& F, ArgsP a) {
    if (F.wave != 0 || (int)blockIdx.x >= 64) return;
    const bf16_t* GMF = (const bf16_t*)(a->ws + SCR_GMF); const bf16_t* ZB = (const bf16_t*)(a->ws + SCR_ZB); bf16_t* STM = (bf16_t*)(a->ws + SCR_STM);
    int lane = F.lane(); asm volatile("" : "+v"(lane));
    const int r = lane & 31, hg = lane >> 5;
    const int bh = (int)blockIdx.x >> 1, vb = (int)blockIdx.x & 1;
    f32x16 st[2];
#pragma unroll
    for (int e = 0; e < 16; ++e) { st[0][e] = 0.f; st[1][e] = 0.f; }
    pg8::u32x4 gn[8], zn[4];
    { const size_t ch = (size_t)bh * 64;
#pragma unroll
      for (int f = 0; f < 8; ++f) gn[f] = *(const pg8::u32x4*)(GMF + ((ch * 8 + f) * 64 + lane) * 8);
#pragma unroll
      for (int q = 0; q < 4; ++q) zn[q] = *(const pg8::u32x4*)(ZB + (((ch * 2 + vb) * 2 + (q >> 1)) * 64 + lane) * 16 + 8 * (q & 1)); }
#pragma unroll 1
    for (int n = 0; n < 64; ++n) {
        const size_t ch = (size_t)bh * 64 + n;
        pg8::u32x4 gc[8], zc[4];
#pragma unroll
        for (int f = 0; f < 8; ++f) gc[f] = gn[f];
#pragma unroll
        for (int q = 0; q < 4; ++q) zc[q] = zn[q];
        if (n + 1 < 64) {
#pragma unroll
            for (int f = 0; f < 8; ++f) gn[f] = *(const pg8::u32x4*)(GMF + (((ch + 1) * 8 + f) * 64 + lane) * 8);
#pragma unroll
            for (int q = 0; q < 4; ++q) zn[q] = *(const pg8::u32x4*)(ZB + ((((ch + 1) * 2 + vb) * 2 + (q >> 1)) * 64 + lane) * 16 + 8 * (q & 1)); }
        bf16_t* sp = STM + (ch * 64 + vb * 32 + r) * 64 + 4 * hg;
        pg8::bf16x8 pf[2][2];
#pragma unroll
        for (int kb = 0; kb < 2; ++kb) {
#pragma unroll
            for (int q = 0; q < 4; ++q) st_bf16x4(sp + kb * 32 + 8 * q, (pg8::f32x4){st[kb][4 * q], st[kb][4 * q + 1], st[kb][4 * q + 2], st[kb][4 * q + 3]});
#pragma unroll
            for (int s = 0; s < 2; ++s) { pg8::u32x4 pw; pw.x = pk2(st[kb][8 * s], st[kb][8 * s + 1]); pw.y = pk2(st[kb][8 * s + 2], st[kb][8 * s + 3]); pw.z = pk2(st[kb][8 * s + 4], st[kb][8 * s + 5]); pw.w = pk2(st[kb][8 * s + 6], st[kb][8 * s + 7]);
                pf[kb][s] = __builtin_bit_cast(pg8::bf16x8, pw); } }
        f32x16 nw[2];
#pragma unroll
        for (int kbr = 0; kbr < 2; ++kbr) {
#pragma unroll
            for (int q = 0; q < 2; ++q) { const pg8::u32x4 z = zc[kbr * 2 + q];
#pragma unroll
                for (int i = 0; i < 4; ++i) { nw[kbr][8 * q + 2 * i] = __builtin_bit_cast(float, z[i] << 16); nw[kbr][8 * q + 2 * i + 1] = __builtin_bit_cast(float, z[i] & 0xffff0000u); } }
#pragma unroll
            for (int kb = 0; kb < 2; ++kb)
#pragma unroll
                for (int s = 0; s < 2; ++s) nw[kbr] = __builtin_amdgcn_mfma_f32_32x32x16_bf16(__builtin_bit_cast(pg8::bf16x8, gc[(kbr * 2 + kb) * 2 + s]), pf[kb][s], nw[kbr], 0, 0, 0); }
        st[0] = nw[0]; st[1] = nw[1];
    }
}
__device__ __forceinline__ void ph_rk_p3(Frame& F, ArgsP a, int l) {
    const unsigned char* VEC = a->ws + SCR_VEC6; const float* SC = (const float*)(a->ws + SCR_SC); const bf16_t* GR = (const bf16_t*)(a->ws + SCR_GR);
    const bf16_t* QE = (const bf16_t*)(a->ws + SCR_QE); const bf16_t* AY = (const bf16_t*)(a->ws + SCR_AY); const bf16_t* VTC = (const bf16_t*)(a->ws + SCR_VTC); const bf16_t* STM = (const bf16_t*)(a->ws + SCR_STM);
    const float* lng = (const float*)a->in[28] + l * 256; const float* lnb = (const float*)a->in[29] + l * 256; bf16_t* br = (bf16_t*)(a->ws + WS_HB);
    int lane = F.lane(); asm volatile("" : "+v"(lane));
    const int r = lane & 31, hg = lane >> 5;
    for (int it = F.gw; it < 2048; it += F.NGW) {
        const int bh = it >> 6, n = it & 63, b = bh >> 2, h = bh & 3;
        f32x16 acc[2];
#pragma unroll
        for (int e = 0; e < 16; ++e) { acc[0][e] = 0.f; acc[1][e] = 0.f; }
#pragma unroll
        for (int s = 0; s < 4; ++s) { const pg8::bf16x8 qf = *(const pg8::bf16x8*)(QE + ((size_t)it * 32 + r) * 64 + 16 * s + 8 * hg);
#pragma unroll
            for (int vb = 0; vb < 2; ++vb) acc[vb] = __builtin_amdgcn_mfma_f32_32x32x16_bf16(*(const pg8::bf16x8*)(STM + ((size_t)it * 64 + vb * 32 + r) * 64 + 16 * s + 8 * hg), qf, acc[vb], 0, 0, 0); }
#pragma unroll
        for (int s = 0; s < 2; ++s) { const pg8::bf16x8 af = *(const pg8::bf16x8*)(AY + ((size_t)it * 32 + r) * 32 + 16 * s + 8 * hg);
#pragma unroll
            for (int vb = 0; vb < 2; ++vb) acc[vb] = __builtin_amdgcn_mfma_f32_32x32x16_bf16(*(const pg8::bf16x8*)(VTC + ((size_t)it * 64 + vb * 32 + r) * 32 + 16 * s + 8 * hg), af, acc[vb], 0, 0, 0); }
        float sm = 0.f;
#pragma unroll
        for (int e = 0; e < 16; ++e) sm += acc[0][e] + acc[1][e];
        { const auto sw = __builtin_amdgcn_permlane32_swap(__builtin_bit_cast(unsigned, sm), __builtin_bit_cast(unsigned, sm), false, false); sm = __builtin_bit_cast(float, (unsigned)sw[0]) + __builtin_bit_cast(float, (unsigned)sw[1]); }
        const float mu = sm * (1.0f / 64.0f); float sq = 0.f;
#pragma unroll
        for (int e = 0; e < 16; ++e) { const float d0 = acc[0][e] - mu, d1 = acc[1][e] - mu; sq += d0 * d0 + d1 * d1; }
        { const auto sw = __builtin_amdgcn_permlane32_swap(__builtin_bit_cast(unsigned, sq), __builtin_bit_cast(unsigned, sq), false, false); sq = __builtin_bit_cast(float, (unsigned)sw[0]) + __builtin_bit_cast(float, (unsigned)sw[1]); }
        const float rstd = rsqrtf(sq * (1.0f / 64.0f) + 64e-5f);
        const int t = n * 32 + r; const size_t row = (size_t)b * T + t; const size_t st = (size_t)bh * T + t;
        const float bonus = SC[st * 4 + 2];
        const bf16_t* vrec = (const bf16_t*)(VEC + st * RECB + 768);
#pragma unroll
        for (int vb = 0; vb < 2; ++vb)
#pragma unroll
            for (int q = 0; q < 4; ++q) { const int v0 = vb * 32 + 8 * q + 4 * hg;
                const pg8::f32x4 vv = ld_bf16x4(vrec + v0), gg = ld_bf16x4(GR + row * 256 + h * 64 + v0), g4 = *(const pg8::f32x4*)(lng + h * 64 + v0), b4 = *(const pg8::f32x4*)(lnb + h * 64 + v0);
                pg8::f32x4 o;
#pragma unroll
                for (int i = 0; i < 4; ++i) o[i] = ((acc[vb][4 * q + i] - mu) * rstd * g4[i] + b4[i] + bonus * vv[i]) * gg[i];
                st_bf16x4(br + row * D + 768 + h * 64 + v0, o); }
    }
}
constexpr int RING_BYTES = 131072, LDS_BYTES = 163840, LDSCTL_OFF = LDS_BYTES - 1024, MISC_OFF = LDSCTL_OFF + 320;
constexpr int PH_PRO = 0, PH_H0 = 1, PH_L0 = 2, PH_PER_LAYER = 12, PH_END = PH_L0 + 2 * PH_PER_LAYER;
constexpr int PL_PROJ = 0, PL_MIXA = 1, PL_MIXB = 2, PL_MIXC = 3, PL_MIXD = 4, PL_BRANCH = 5, PL_OUT = 6, PL_ROWMIX = 7, PL_FFN1 = 8, PL_FFN2 = 9, PL_FFN3 = 10, PL_ROWFFN = 11;

#ifndef DUPMASK
#define DUPMASK 0
#endif
#define DUP(bit) for (int dup_ = 0; dup_ < (((DUPMASK) >> (bit)) & 1) + 1; ++dup_)
__global__ void __launch_bounds__(NTHR, 2) mk_fwd(Args a) {
    extern __shared__ __attribute__((aligned(16))) unsigned char lds_raw[];
    Frame F0;
    F0.lds = (LAS unsigned char*)lds_raw;
    F0.wave = __builtin_amdgcn_readfirstlane(threadIdx.x >> 6);
    F0.G = gridDim.x; F0.gw = blockIdx.x * NWAVES + F0.wave; F0.NGW = F0.G * NWAVES;
    volatile LAS unsigned* MISC = (volatile LAS unsigned*)(F0.lds + MISC_OFF);
    for (int u = threadIdx.x; u < (LDS_BYTES - LDSCTL_OFF) / 4; u += NTHR) ((LAS unsigned*)(F0.lds + LDSCTL_OFF))[u] = 0u;
    __syncthreads();
    unsigned* ctl = (unsigned*)(a.ws + WS_CTL);
    const int lo = a.ph_lo, hi = a.ph_hi;
    XcdBarrier bar; bar.bar = ctl + CW_BAR; bar.x = 0; bar.st = nullptr;
    if (hi - lo > 1) bar = xcd_barrier_post(ctl + CW_BAR, MISC + 8);
#define IN(k) (lo <= (k) && (k) < hi)
#define SEAM(k) do { if (IN(k) && IN((k) + 1)) { xcd_barrier(bar); if ((DUPMASK >> 12) & 1) xcd_barrier(bar); } } while (0)
    if (IN(PH_PRO)) DUP(0) { ArgsP A = fresh_args(); Frame F = fresh(F0); p0_mod_items(F, (const float*)A->in[1], (const float*)A->in[3], (const float*)A->in[4], (float*)(A->ws + WS_MOD)); p0_convert(F, A); }
    SEAM(PH_PRO);
    if (IN(PH_H0)) DUP(9) { Frame F = fresh(F0); ph_h0(F, fresh_args()); }
    SEAM(PH_H0);
    for (int l = 0; l < NL; ++l) {
        const int base = PH_L0 + l * PH_PER_LAYER;
        if (IN(base + PL_PROJ)) DUP(13) { ArgsP A = fresh_args(); Frame F = fresh(F0); unsigned char* ws = A->ws;
            pg8::Gemm g{(const bf16_t*)(ws + WS_HB), (const bf16_t*)(ws + WS_WIN) + (size_t)l * PW * 1024, 1024, 1024, 1024, 0}; pg8::StaticOrder S; S.init(M, 7168, F.G, (int)blockIdx.x);
            pg8::EpiBf16 E{(bf16_t*)(ws + WS_PROJ), PW, 28};
            pg8::gemm_phase<pg8::EpiBf16, pg8::StaticOrder, true>(F.lds, g, S, E, F.wave);
        }
        SEAM(base + PL_PROJ);
        if (IN(base + PL_MIXA)) { DUP(2) { Frame F = fresh(F0); ph_conv(F, fresh_args(), l); } DUP(6) { Frame F = fresh(F0); ph_rwkv_prep(F, fresh_args(), l); } DUP(7) { Frame F = fresh(F0); ph_gla_p1(F, fresh_args(), l); } DUP(8) { Frame F = fresh(F0); ph_attn_prep(F, fresh_args()); } }
        SEAM(base + PL_MIXA);
        if (IN(base + PL_MIXB)) { DUP(10) { Frame F = fresh(F0); ph_gla_prefix(F, fresh_args()); } DUP(4) { Frame F = fresh(F0); ph_attn(F, fresh_args(), l); } DUP(3) { Frame F = fresh(F0); ph_rk_p1(F, fresh_args()); } }
        SEAM(base + PL_MIXB);
        if (IN(base + PL_MIXC)) { { Frame F = fresh(F0); ph_rk_p2(F, fresh_args()); } DUP(11) { Frame F = fresh(F0); ph_gla_p2(F, fresh_args(), l); } }
        SEAM(base + PL_MIXC);
        if (IN(base + PL_MIXD)) { DUP(5) { Frame F = fresh(F0); ph_rk_p3(F, fresh_args(), l); } }
        SEAM(base + PL_MIXD);
        if (IN(base + PL_BRANCH)) DUP(14) { ArgsP A = fresh_args(); Frame F = fresh(F0); unsigned char* ws = A->ws;
            pg8::Gemm g{(const bf16_t*)(ws + WS_HB), (const bf16_t*)(ws + WS_WB) + (size_t)l * 1024 * 1024, 1024, 1024, 1024, 0}; pg8::StaticOrder S; S.init(M, 1024, F.G, (int)blockIdx.x);
            pg8::EpiBranchK E{(const bf16_t*)(ws + WS_PROJ), (bf16_t*)(ws + SCR_MB)};
            pg8::gemm_phase<pg8::EpiBranchK, pg8::StaticOrder, false>(F.lds, g, S, E, F.wave);
        }
        SEAM(base + PL_BRANCH);
        if (IN(base + PL_OUT)) DUP(1) { ArgsP A = fresh_args(); Frame F = fresh(F0); unsigned char* ws = A->ws;
            pg8::Gemm g{(const bf16_t*)(ws + SCR_MB), (const bf16_t*)(ws + WS_WO) + (size_t)l * 1024 * 1024, 1024, 1024, 1024, 0}; pg8::StaticOrder S; S.init(M, 1024, F.G, (int)blockIdx.x);
            pg8::EpiBf16 E{(bf16_t*)(ws + SCR_Y), 1024, 4};
            pg8::gemm_phase<pg8::EpiBf16, pg8::StaticOrder, false>(F.lds, g, S, E, F.wave);
        }
        SEAM(base + PL_OUT);
        if (IN(base + PL_ROWMIX)) { ArgsP A = fresh_args(); Frame F = fresh(F0); unsigned char* ws = A->ws; const float* modl = (const float*)(ws + WS_MOD) + (size_t)l * 8 * 6144;
            ph_row(F, A, l == 0 ? (const float*)A->in[0] : A->out, (const bf16_t*)(ws + SCR_Y), (const float*)A->in[6] + l * D, modl, 2048, (const float*)A->in[7] + l * D, modl, 3072, 4096, (bf16_t*)(ws + (l == 0 ? WS_HB : WS_H2L1)), l == 1); }
        SEAM(base + PL_ROWMIX);
        if (l == 0) {
            if (IN(base + PL_FFN1)) DUP(1) { ArgsP A = fresh_args(); Frame F = fresh(F0); unsigned char* ws = A->ws;
                pg8::Gemm g{(const bf16_t*)(ws + WS_HB), (const bf16_t*)(ws + WS_WF1), 1024, 1024, 1024, 0}; pg8::StaticOrder S; S.init(M, 2 * DFF, F.G, (int)blockIdx.x);
                pg8::EpiSwiglu E{(bf16_t*)(ws + WS_PROJ), DFF, 2 * DFF / 256};
                pg8::gemm_phase<pg8::EpiSwiglu, pg8::StaticOrder, true>(F.lds, g, S, E, F.wave);
            }
            SEAM(base + PL_FFN1);
            if (IN(base + PL_FFN2)) DUP(1) { ArgsP A = fresh_args(); Frame F = fresh(F0); unsigned char* ws = A->ws;
                pg8::Gemm g{(const bf16_t*)(ws + WS_PROJ), (const bf16_t*)(ws + WS_WF2), DFF, DFF, DFF, 0}; pg8::StaticOrder S; S.init(M, 1024, F.G, (int)blockIdx.x);
                pg8::EpiBf16 E{(bf16_t*)(ws + SCR_Y), 1024, 4};
                pg8::gemm_phase<pg8::EpiBf16, pg8::StaticOrder, false>(F.lds, g, S, E, F.wave);
            }
            SEAM(base + PL_FFN2);
        } else {
            if (IN(base + PL_FFN1)) DUP(0) { Frame F = fresh(F0); ph_moe_prep(F, fresh_args()); }
            SEAM(base + PL_FFN1);
            if (IN(base + PL_FFN2)) DUP(15) { ArgsP A = fresh_args(); Frame F = fresh(F0); unsigned char* ws = A->ws; const unsigned* cnt = (const unsigned*)(ws + WS_CTL) + CW_CNT;
                pg8::Gemm g{(const bf16_t*)(ws + WS_HG), (const bf16_t*)(ws + WS_WM1), 1024, 1024, 1024, 0}; pg8::MoeOrder<28> S; S.init(cnt, F.G, (int)blockIdx.x);
                pg8::EpiSwiglu E{(bf16_t*)(ws + WS_HID), DEX, 28};
                pg8::gemm_phase<pg8::EpiSwiglu, pg8::MoeOrder<28>, true>(F.lds, g, S, E, F.wave);
            }
            SEAM(base + PL_FFN2);
            if (IN(base + PL_FFN3)) DUP(16) { ArgsP A = fresh_args(); Frame F = fresh(F0); unsigned char* ws = A->ws; const unsigned* cnt = (const unsigned*)(ws + WS_CTL) + CW_CNT;
                pg8::Gemm g{(const bf16_t*)(ws + WS_HID), (const bf16_t*)(ws + WS_WM2), DEX, DEX, DEX, 0}; pg8::MoeOrder<4> S; S.init(cnt, F.G, (int)blockIdx.x);
                pg8::EpiBf16 E{(bf16_t*)(ws + WS_HG), 1024, 4};
                pg8::gemm_phase<pg8::EpiBf16, pg8::MoeOrder<4>, true>(F.lds, g, S, E, F.wave);
            }
            SEAM(base + PL_FFN3);
        }
        if (IN(base + PL_ROWFFN)) { ArgsP A = fresh_args(); Frame F = fresh(F0); unsigned char* ws = A->ws; const float* modl = (const float*)(ws + WS_MOD) + (size_t)l * 8 * 6144;
            const bool last = (l == NL - 1);
            if (l == 0) ph_row(F, A, A->out, (const bf16_t*)(ws + SCR_Y), (const float*)A->in[8], modl, 5120, (const float*)A->in[5] + D, modl + 8 * 6144, 0, 1024, (bf16_t*)(ws + WS_HB), false, nullptr, (const float*)A->in[9] + (size_t)1024 * NIN);
            else ph_row(F, A, A->out, nullptr, (const float*)A->in[8] + D, modl, 5120, nullptr, nullptr, 0, 1024, nullptr, false, (const bf16_t*)(ws + WS_HG));
        }
        SEAM(base + PL_ROWFFN);
    }
#undef IN
#undef SEAM
}

extern "C" void kernel_launch(void* const* d_in, const int* in_sizes, int n_in, void* d_out, int out_size, void* d_ws, size_t ws_size, hipStream_t stream) {
    static int grid = 0;
    if (grid == 0) {
        if (n_in != 40 || ws_size < WS_END) { fprintf(stderr, "kernel_launch: need 40 inputs and >= %zu bytes of workspace (got %d, %zu)\n", (size_t)WS_END, n_in, ws_size); grid = -1; return; }
        int dev = 0, cus = 0, per_cu = 0;
        (void)hipGetDevice(&dev); (void)hipDeviceGetAttribute(&cus, hipDeviceAttributeMultiprocessorCount, dev);
        (void)hipFuncSetAttribute((const void*)mk_fwd, hipFuncAttributeMaxDynamicSharedMemorySize, LDS_BYTES);
        (void)hipOccupancyMaxActiveBlocksPerMultiprocessor(&per_cu, (const void*)mk_fwd, NTHR, LDS_BYTES);
        (void)hipGetLastError();
        grid = cus > 0 ? cus : 256;
        if (per_cu < 1) fprintf(stderr, "kernel_launch: occupancy query says %d blocks per CU\n", per_cu);
    }
    if (grid < 0) return;
    unsigned char* ws = (unsigned char*)d_ws;
    (void)hipMemsetAsync(ws + WS_CTL, 0, CTL_ZERO_BYTES, stream);
    Args a{};
    for (int i = 0; i < 40; ++i) a.in[i] = d_in[i];
    a.out = (float*)d_out; a.ws = ws;
    a.ph_lo = 0; a.ph_hi = PH_L0 + (NL - 1) * PH_PER_LAYER + PL_ROWFFN + 1;
    hipLaunchKernelGGL(mk_fwd, dim3(grid), dim3(NTHR), LDS_BYTES, stream, a);
}
```

```cpp
#include <hip/hip_runtime.h>
#include <hip/hip_bf16.h>
#include <cstdint>
#include <cstdio>

typedef __hip_bfloat16 bf16;
typedef unsigned short bf16_t;
#define GAS __attribute__((address_space(1)))
#define LAS __attribute__((address_space(3)))

constexpr int D = 1024, NB = 8, T = 2048, M = NB * T, NL = 2;
constexpr int NIN = 7184;
constexpr int PW = 7424;
constexpr int P_GQ = 0, P_GK = 128, P_GV = 256, P_GO = 512, P_DQ = 768, P_DK = 1024, P_DV = 1280, P_CA = 1536, P_CB = 1792, P_R = 2048, P_GATE = 3072, P_GZ = 7168;
constexpr int DFF = 2816, NE = 8, DEX = 3584;
constexpr int NWAVES = 8, NTHR = 512;
constexpr size_t MiB = 1u << 20;
constexpr size_t WS_CTL = 0;
constexpr size_t CTL_ZERO_BYTES = 64 * 1024;
constexpr size_t WS_MOD = 1 * MiB;
constexpr size_t WS_ROUTE = 1 * MiB + 512 * 1024;
constexpr size_t WS_GZ = 2 * MiB + 512 * 1024;
constexpr size_t WS_LR = 3 * MiB;
constexpr size_t WS_WIN = 4 * MiB;
constexpr size_t WS_WB = 33 * MiB;
constexpr size_t WS_WO = 37 * MiB;
constexpr size_t WS_WF1 = 41 * MiB;
constexpr size_t WS_WF2 = 52 * MiB;
constexpr size_t WS_HB = 58 * MiB;
constexpr size_t WS_PROJ = 90 * MiB;
constexpr size_t WS_SCR = 322 * MiB;
constexpr size_t WS_H2L1 = 508 * MiB;
constexpr size_t WS_END = 540 * MiB;
constexpr size_t WS_HG = 4 * MiB;
constexpr size_t WS_WM1 = 72 * MiB;
constexpr size_t WS_WM2 = 184 * MiB;
constexpr size_t WS_HID = 240 * MiB;
static_assert(WS_HID + (size_t)34816 * 3584 * 2 <= WS_H2L1, "moe overlay");
constexpr size_t SCR_MP = WS_SCR;
constexpr size_t SCR_MB = WS_SCR + 64 * MiB;
constexpr size_t SCR_Y = WS_SCR + 96 * MiB;
constexpr size_t SCR_RW = WS_SCR;
constexpr size_t SCR_GK = WS_SCR + 112 * MiB;
constexpr size_t SCR_QR = WS_SCR + 120 * MiB;
constexpr size_t SCR_KR = WS_SCR + 136 * MiB;
constexpr size_t SCR_VEC6 = WS_SCR;
constexpr size_t SCR_SC = WS_SCR + 56 * MiB;
constexpr size_t SCR_STM = WS_SCR + 57 * MiB;
constexpr size_t SCR_GR = WS_SCR + 73 * MiB;
constexpr size_t SCR_VT = WS_SCR + 81 * MiB;
constexpr size_t SCR_GU = WS_SCR + 89 * MiB;
constexpr size_t SCR_GS = SCR_GU;
constexpr size_t SCR_QK = WS_SCR + 105 * MiB;
constexpr size_t SCR_EG = WS_SCR + 121 * MiB;
constexpr size_t SCR_QE = WS_SCR + 130 * MiB;
constexpr size_t SCR_AY = WS_SCR + 138 * MiB;
constexpr size_t SCR_VTC = WS_SCR + 142 * MiB;
constexpr size_t SCR_GMF = WS_SCR + 150 * MiB;
constexpr size_t SCR_ZB = WS_SCR + 166 * MiB;
constexpr size_t SCR_YR = WS_SCR + 166 * MiB;
constexpr int RECB = 896;
constexpr size_t WS_GOI = WS_H2L1;
constexpr size_t WS_GST = WS_H2L1 + 16 * MiB;
constexpr int CW_TMO = 0;
constexpr int CW_BAR = 1024;
constexpr int CW_CNT = 8192;
constexpr size_t RT_LIST = 0;
constexpr size_t RT_TOKE = 512 * 1024;
constexpr size_t RT_TOKS = 640 * 1024;
constexpr size_t RT_TOKP = 768 * 1024;

__device__ __forceinline__ float sigm(float x) { return __builtin_amdgcn_rcpf(1.0f + __expf(-x)); }
__device__ __forceinline__ float siluf(float x) { return x * sigm(x); }
__device__ __forceinline__ float softplusf(float x) { return fmaxf(x, 0.f) + __logf(1.0f + __expf(-fabsf(x))); }
__device__ __forceinline__ float tanh_fast(float x) { return 1.0f - 2.0f * __builtin_amdgcn_rcpf(1.0f + __expf(2.0f * x)); }
template <int CTRL, int ROWMASK> __device__ __forceinline__ float dpp_mov_h(float old, float x) {
    return __builtin_bit_cast(float, __builtin_amdgcn_update_dpp(__builtin_bit_cast(int, old), __builtin_bit_cast(int, x), CTRL, ROWMASK, 0xF, false)); }
__device__ __forceinline__ float wave_sum(float x) {
    x += dpp_mov_h<0xB1, 0xF>(0.f, x); x += dpp_mov_h<0x4E, 0xF>(0.f, x); x += dpp_mov_h<0x141, 0xF>(0.f, x); x += dpp_mov_h<0x140, 0xF>(0.f, x);
    x += dpp_mov_h<0x142, 0xA>(0.f, x); x += dpp_mov_h<0x143, 0xC>(0.f, x);
    return __builtin_bit_cast(float, __builtin_amdgcn_readlane(__builtin_bit_cast(int, x), 63));
}
__device__ __forceinline__ float wave_max(float v) {
#pragma unroll
    for (int o = 32; o > 0; o >>= 1) v = fmaxf(v, __shfl_xor(v, o));
    return v;
}
__device__ __forceinline__ float ldf(const float* p) { return *p; }
__device__ __forceinline__ float ldf(const bf16* p) { return __bfloat162float(*p); }
__device__ __forceinline__ float bf2f(bf16_t u) { return __builtin_bit_cast(float, (unsigned)u << 16); }
__device__ __forceinline__ unsigned f2bf(float f) { unsigned u = __builtin_bit_cast(unsigned, f); return (u + 0x7fffu + ((u >> 16) & 1u)) >> 16; }
typedef float f32x2_t_ __attribute__((ext_vector_type(2))); typedef __bf16 bf16x2_t_ __attribute__((ext_vector_type(2)));
__device__ __forceinline__ unsigned pk2(float lo, float hi) { const f32x2_t_ v = {lo, hi}; const bf16x2_t_ b = __builtin_convertvector(v, bf16x2_t_); return __builtin_bit_cast(unsigned, b); }
namespace pg8 {
#define PG8_LAS __attribute__((address_space(3)))
typedef short bf16x8 __attribute__((ext_vector_type(8)));
typedef float f32x4 __attribute__((ext_vector_type(4)));
typedef float f32x2 __attribute__((ext_vector_type(2)));
typedef unsigned u32x4 __attribute__((ext_vector_type(4)));
typedef unsigned u32x2 __attribute__((ext_vector_type(2)));
constexpr int BM = 256, BK = 64, HALF = 128, HTB = HALF * BK * 2  , STAGE_BYTES = 8 * HTB, NXCD = 8, WGM = 8;

__host__ __device__ __forceinline__ int lds_byte(int r, int c) { const int st = (r >> 4) * 2 + (c >> 5), rr = r & 15, cc = c & 31, ob = rr * 64 + cc * 2; return st * 1024 + (ob ^ (((ob >> 9) & 1) << 5)); }
__host__ __device__ __forceinline__ void stage_rc(int b, int& R, int& C) { const int st = b / 1024, sb = b % 1024, swz = sb ^ (((sb >> 9) & 1) << 5); R = (st >> 1) * 16 + swz / 64; C = (st & 1) * 32 + (swz % 64) / 2; }
__host__ __device__ __forceinline__ int perm32(int rho) { const int n = rho >> 4, i = rho & 15; return 8 * (i >> 2) + 4 * n + (i & 3); }

struct Unit { int pm, pn, aoff, tag; };
struct Gemm { const bf16_t* A; const bf16_t* Bt; int lda, ldb, K, pad; };

struct StaticOrder {
    static constexpr bool VARK = false;
    int nM, nN, nwg, G, c;
    __host__ __device__ void init(int M_, int N_, int G_, int c_) { nM = M_ / BM; nN = N_ / BM; nwg = nM * nN; G = G_; c = c_; }
    __host__ __device__ bool next(int i, Unit& u) const {
        const long L = (long)i * G + c; if (L >= nwg) return false;
        int wgid = (int)L; { const int q = nwg / NXCD, r = nwg % NXCD, xcd = wgid % NXCD, off = wgid / NXCD; wgid = (xcd < r ? xcd * (q + 1) : r * (q + 1) + (xcd - r) * q) + off; }
        const int nig = WGM * nN, gid = wgid / nig, fm = gid * WGM, gsz = (nM - fm) < WGM ? (nM - fm) : WGM;
        u.pm = fm + ((wgid % nig) % gsz); u.pn = (wgid % nig) / gsz; u.aoff = 0; u.tag = 0; return true;
    }
};

__device__ __forceinline__ unsigned cvt_pk_bf16(float lo, float hi) { unsigned r; asm volatile("v_cvt_pk_bf16_f32 %0, %1, %2" : "=v"(r) : "v"(lo), "v"(hi)); return r; }


template <class Epi, class Sched, bool ALIGN_EPI>
__device__ __forceinline__ void gemm_phase(PG8_LAS unsigned char* lds, const Gemm g, const Sched& S, const Epi& E, int wave_s) {
    unsigned z_ = 0u; asm volatile("" : "+v"(z_));
    int tid_ = wave_s * 64 + (int)__builtin_amdgcn_mbcnt_hi(~0u, __builtin_amdgcn_mbcnt_lo(~0u, z_)); asm volatile("" : "+v"(tid_));
    const int tid = tid_, wid = __builtin_amdgcn_readfirstlane(tid >> 6), lane = tid & 63, wr = wid >> 2, wc = wid & 3, fr = lane & 15, fq = lane >> 4;
    const int K = g.K, nt = K / BK;
    unsigned voffA[2], voffB[2];
#pragma unroll
    for (int i = 0; i < 2; ++i) { int R, C; stage_rc(tid * 16 + i * 8192, R, C); const int Rb = Epi::PERM ? ((R & ~31) + perm32(R & 31)) : R;
        voffA[i] = (unsigned)(R * g.lda + C) * 2u; voffB[i] = (unsigned)(Rb * g.ldb + C) * 2u; }
    const size_t kstep = (size_t)(BK * 2);
    const size_t hstepA = (size_t)HALF * g.lda * 2, hstepB = (size_t)HALF * g.ldb * 2;
    const size_t tstepA = 2 * hstepA, tstepB = 2 * hstepB;
    const unsigned ldsw = (unsigned)wid * 1024u;
    const int aoff = lds_byte(wr * 64 + fr, fq * 8), boff = lds_byte(wc * 32 + fr, fq * 8);
#define PG8_SA(b, h) (((b) * 2 + (h)) * HTB)
#define PG8_SB(b, h) ((4 + (b) * 2 + (h)) * HTB)
#define PG8_STAGE(bufoff, gbase, voff) do { _Pragma("unroll") for (int _i = 0; _i < 2; ++_i) \
        __builtin_amdgcn_global_load_lds((const unsigned*)((const char*)(gbase) + (voff)[_i]), (PG8_LAS unsigned*)(lds + (bufoff) + ldsw + _i * 8192), 16, 0, 0); } while (0)
#define PG8_LDA(dst, b, h) do { _Pragma("unroll") for (int m = 0; m < 4; ++m) _Pragma("unroll") for (int k = 0; k < 2; ++k) dst[m][k] = *(const PG8_LAS bf16x8*)(lds + PG8_SA(b, h) + aoff + m * 2048 + k * 1024); } while (0)
#define PG8_LDB(dst, b, h) do { _Pragma("unroll") for (int n = 0; n < 2; ++n) _Pragma("unroll") for (int k = 0; k < 2; ++k) dst[n][k] = *(const PG8_LAS bf16x8*)(lds + PG8_SB(b, h) + boff + n * 2048 + k * 1024); } while (0)
#define PG8_MMA(ai, bj, At, Bt) do { __builtin_amdgcn_s_setprio(1); _Pragma("unroll") for (int m = 0; m < 4; ++m) _Pragma("unroll") for (int n = 0; n < 2; ++n) _Pragma("unroll") for (int k = 0; k < 2; ++k) \
        acc[ai][bj][m][n] = __builtin_amdgcn_mfma_f32_16x16x32_bf16(Bt[n][k], At[m][k], acc[ai][bj][m][n], 0, 0, 0); __builtin_amdgcn_s_setprio(0); } while (0)
#define PG8_WAIT_V(n) asm volatile("s_waitcnt vmcnt(" #n ")" ::: "memory")
#define PG8_WAIT_L(n) asm volatile("s_waitcnt lgkmcnt(" #n ")" ::: "memory")
#define PG8_BAR __builtin_amdgcn_s_barrier()
#define PG8_SCHED __builtin_amdgcn_sched_barrier(0)
    Unit cur, nxt; int ui = 0;
    if (!S.next(0, cur)) return;
    f32x4 acc[2][2][4][2];
#pragma unroll
    for (int a = 0; a < 2; ++a)
#pragma unroll
        for (int b = 0; b < 2; ++b)
#pragma unroll
            for (int m = 0; m < 4; ++m)
#pragma unroll
                for (int n = 0; n < 2; ++n) acc[a][b][m][n] = (f32x4){0.f, 0.f, 0.f, 0.f};
    bf16x8 At[4][2], B0[2][2], B1[2][2];
    const char* cA = (const char*)g.A + (size_t)cur.pm * tstepA + (size_t)cur.aoff * 2; const char* cB = (const char*)g.Bt + (size_t)cur.pn * tstepB + (Sched::VARK ? (size_t)cur.aoff * 2 : (size_t)0);
    PG8_STAGE(PG8_SB(0, 0), cB, voffB); PG8_STAGE(PG8_SB(0, 1), cB + hstepB, voffB); PG8_STAGE(PG8_SA(0, 0), cA, voffA); PG8_STAGE(PG8_SA(0, 1), cA + hstepA, voffA);
    if (wr == 1) PG8_BAR;
    PG8_WAIT_V(2); PG8_BAR;
    PG8_STAGE(PG8_SB(1, 0), cB + kstep, voffB); PG8_STAGE(PG8_SA(1, 0), cA + kstep, voffA); PG8_STAGE(PG8_SB(1, 1), cB + hstepB + kstep, voffB);
    PG8_WAIT_V(6); PG8_BAR;
    for (;;) {
        const bool has_next = S.next(ui + 1, nxt);
        const char* nA = has_next ? (const char*)g.A + (size_t)nxt.pm * tstepA + (size_t)nxt.aoff * 2 : cA; const char* nB = has_next ? (const char*)g.Bt + (size_t)nxt.pn * tstepB + (Sched::VARK ? (size_t)nxt.aoff * 2 : (size_t)0) : cB;
        int ntc = nt; if constexpr (Sched::VARK) ntc = S.nt_of(cur);
        for (int t = 0; t < ntc; t += 2) {
            if constexpr (Epi::MIDK) { if (t != 0 && (t & 3) == 0) E.mid(acc, cur, t >> 2, wr, wc); }
            const bool last = (t == ntc - 2);
            const char* a1 = cA + (size_t)(t + 1) * kstep;
            const char* a2 = last ? nA : cA + (size_t)(t + 2) * kstep; const char* b2 = last ? nB : cB + (size_t)(t + 2) * kstep;
            const char* a3 = a2 + kstep; const char* b3 = b2 + kstep;
            PG8_LDB(B0, 0, 0); PG8_LDB(B1, 0, 1); PG8_SCHED; PG8_LDA(At, 0, 0); PG8_STAGE(PG8_SA(1, 1), a1 + hstepA, voffA);
            PG8_WAIT_V(8); PG8_WAIT_L(0); PG8_BAR; PG8_MMA(0, 0, At, B0); PG8_MMA(0, 1, At, B1); PG8_BAR; PG8_SCHED;
            PG8_LDA(At, 0, 1); PG8_STAGE(PG8_SB(0, 0), b2, voffB); PG8_STAGE(PG8_SB(0, 1), b2 + hstepB, voffB); PG8_STAGE(PG8_SA(0, 0), a2, voffA);
            PG8_WAIT_V(8); PG8_WAIT_L(0); PG8_BAR; PG8_MMA(1, 0, At, B0); PG8_MMA(1, 1, At, B1); PG8_BAR; PG8_SCHED;
            PG8_LDB(B0, 1, 0); PG8_LDB(B1, 1, 1); PG8_SCHED; PG8_LDA(At, 1, 0); PG8_STAGE(PG8_SA(0, 1), a2 + hstepA, voffA);
            PG8_WAIT_V(8); PG8_WAIT_L(0); PG8_BAR; PG8_MMA(0, 0, At, B0); PG8_MMA(0, 1, At, B1); PG8_BAR; PG8_SCHED;
            PG8_LDA(At, 1, 1); PG8_STAGE(PG8_SB(1, 0), b3, voffB); PG8_STAGE(PG8_SB(1, 1), b3 + hstepB, voffB); PG8_STAGE(PG8_SA(1, 0), a3, voffA);
            PG8_WAIT_V(8); PG8_WAIT_L(0); PG8_BAR; PG8_MMA(1, 0, At, B0); PG8_MMA(1, 1, At, B1); PG8_BAR; PG8_SCHED;
        }
        if constexpr (ALIGN_EPI) { if (wr == 0) PG8_BAR; }
        { unsigned z2_ = 0u; asm volatile("" : "+v"(z2_)); const int l2_ = (int)__builtin_amdgcn_mbcnt_hi(~0u, __builtin_amdgcn_mbcnt_lo(~0u, z2_));
          E(acc, cur, wr, wc, l2_ & 15, l2_ >> 4); }
        if (!has_next) break;
#pragma unroll
        for (int a = 0; a < 2; ++a)
#pragma unroll
            for (int b = 0; b < 2; ++b)
#pragma unroll
                for (int m = 0; m < 4; ++m)
#pragma unroll
                    for (int n = 0; n < 2; ++n) acc[a][b][m][n] = (f32x4){0.f, 0.f, 0.f, 0.f};
        cur = nxt; cA = nA; cB = nB; ++ui;
        if constexpr (ALIGN_EPI) { if (wr == 1) PG8_BAR; }
    }
    PG8_WAIT_V(0);
    if constexpr (!ALIGN_EPI) { if (wr == 0) PG8_BAR; }
    PG8_BAR;
#undef PG8_SA
#undef PG8_SB
#undef PG8_STAGE
#undef PG8_LDA
#undef PG8_LDB
#undef PG8_MMA
#undef PG8_WAIT_V
#undef PG8_WAIT_L
#undef PG8_BAR
#undef PG8_SCHED
}

struct EpiBf16 {
    static constexpr bool PERM = true, MIDK = false;
    bf16_t* O; int ldc; int ntn;
    __device__ __forceinline__ void operator()(const f32x4 (&acc)[2][2][4][2], const Unit& u, int wr, int wc, int fr, int fq) const {
        const int row0 = u.pm * BM + wr * 64 + fr, col0 = (u.pn % ntn) * BM + wc * 32 + 8 * fq;
#pragma unroll
        for (int ai = 0; ai < 2; ++ai)
#pragma unroll
            for (int m = 0; m < 4; ++m) { bf16_t* rowp = O + (size_t)(row0 + ai * HALF + m * 16) * ldc + col0;
#pragma unroll
                for (int bj = 0; bj < 2; ++bj) { const f32x4 v0 = acc[ai][bj][m][0], v1 = acc[ai][bj][m][1];
                    u32x4 w; w.x = cvt_pk_bf16(v0[0], v0[1]); w.y = cvt_pk_bf16(v0[2], v0[3]); w.z = cvt_pk_bf16(v1[0], v1[1]); w.w = cvt_pk_bf16(v1[2], v1[3]);
                    *(u32x4*)(rowp + bj * HALF) = w; } }
    }
};
struct EpiF32 {
    static constexpr bool PERM = false, MIDK = false;
    float* C; int ldc; int ntn;
    __device__ __forceinline__ void operator()(const f32x4 (&acc)[2][2][4][2], const Unit& u, int wr, int wc, int fr, int fq) const {
        const int row0 = u.pm * BM + wr * 64 + fr, col0 = (u.pn % ntn) * BM + wc * 32 + 4 * fq;
#pragma unroll
        for (int ai = 0; ai < 2; ++ai)
#pragma unroll
            for (int m = 0; m < 4; ++m) { float* rowp = C + (size_t)(row0 + ai * HALF + m * 16) * ldc + col0;
#pragma unroll
                for (int bj = 0; bj < 2; ++bj)
#pragma unroll
                    for (int n = 0; n < 2; ++n) *(f32x4*)(rowp + bj * HALF + n * 16) = acc[ai][bj][m][n]; }
    }
};
struct EpiSwiglu {
    static constexpr bool PERM = true, MIDK = false;
    bf16_t* O; int ldc; int ntn;
    __device__ __forceinline__ void operator()(const f32x4 (&acc)[2][2][4][2], const Unit& u, int wr, int wc, int fr, int fq) const {
        const int row0 = u.pm * BM + wr * 64 + fr, col0 = (u.pn % ntn) * 128 + wc * 16 + 4 * fq;
#pragma unroll
        for (int ai = 0; ai < 2; ++ai)
#pragma unroll
            for (int m = 0; m < 4; ++m) { bf16_t* rowp = O + (size_t)(row0 + ai * HALF + m * 16) * ldc + col0;
#pragma unroll
                for (int bj = 0; bj < 2; ++bj) { const f32x4 gt = acc[ai][bj][m][0], up = acc[ai][bj][m][1];
                    float h[4];
#pragma unroll
                    for (int e = 0; e < 4; ++e) h[e] = gt[e] * __builtin_amdgcn_rcpf(1.0f + __expf(-gt[e])) * up[e];
                    u32x2 w; w.x = cvt_pk_bf16(h[0], h[1]); w.y = cvt_pk_bf16(h[2], h[3]);
                    *(u32x2*)(rowp + bj * 64) = w; } }
    }
};
struct EpiBranch {
    static constexpr bool PERM = true, MIDK = false;
    const bf16_t* proj; float* MP; bf16_t* MB;
    __device__ __forceinline__ void operator()(const f32x4 (&acc)[2][2][4][2], const Unit& u, int wr, int wc, int fr, int fq) const {
        const int g = u.tag; const int row0 = u.pm * BM + wr * 64 + fr, col0 = (u.pn & 3) * BM + wc * 32 + 8 * fq;
#pragma unroll
        for (int ai = 0; ai < 2; ++ai)
#pragma unroll
            for (int m = 0; m < 4; ++m) { const size_t row = (size_t)(row0 + ai * HALF + m * 16);
#pragma unroll
                for (int bj = 0; bj < 2; ++bj) { const int col = col0 + bj * HALF;
                    const u32x4 gw = *(const u32x4*)(proj + row * PW + P_GATE + g * 1024 + col);
                    float gv[8];
#pragma unroll
                    for (int e = 0; e < 4; ++e) { const unsigned w = gw[e]; gv[2 * e] = __builtin_bit_cast(float, w << 16); gv[2 * e + 1] = __builtin_bit_cast(float, w & 0xffff0000u); }
                    f32x4 v0 = acc[ai][bj][m][0], v1 = acc[ai][bj][m][1];
#pragma unroll
                    for (int e = 0; e < 4; ++e) { v0[e] *= __builtin_amdgcn_rcpf(1.0f + __expf(-gv[e])); v1[e] *= __builtin_amdgcn_rcpf(1.0f + __expf(-gv[4 + e])); }
                    float* mp = MP + row * D + col;
                    if (g > 0) { v0 += *(const f32x4*)mp; v1 += *(const f32x4*)(mp + 4); }
                    if (g < 3) { *(f32x4*)mp = v0; *(f32x4*)(mp + 4) = v1; }
                    else { u32x4 w; w.x = cvt_pk_bf16(v0[0], v0[1]); w.y = cvt_pk_bf16(v0[2], v0[3]); w.z = cvt_pk_bf16(v1[0], v1[1]); w.w = cvt_pk_bf16(v1[2], v1[3]);
                        *(u32x4*)(MB + row * D + col) = w; } } }
    }
};
struct EpiBranchK {
    static constexpr bool PERM = true, MIDK = true;
    const bf16_t* proj; bf16_t* MB;
    __device__ __forceinline__ static float em(float x) { return fminf(__expf(-x), 1e20f); }
    __device__ __forceinline__ void mid(f32x4 (&acc)[2][2][4][2], const Unit& u, int gnext, int wr, int wc) const {
        unsigned z_ = 0u; asm volatile("" : "+v"(z_)); const int l_ = (int)__builtin_amdgcn_mbcnt_hi(~0u, __builtin_amdgcn_mbcnt_lo(~0u, z_)); const int fr = l_ & 15, fq = l_ >> 4;
        const int row0 = u.pm * BM + wr * 64 + fr, col0 = u.pn * BM + wc * 32 + 8 * fq;
#pragma unroll
        for (int ai = 0; ai < 2; ++ai)
#pragma unroll
            for (int m = 0; m < 4; ++m) { const bf16_t* gp = proj + (size_t)(row0 + ai * HALF + m * 16) * PW + P_GATE + (gnext - 1) * 1024 + col0;
#pragma unroll
                for (int bj = 0; bj < 2; ++bj) { const u32x4 g0 = *(const u32x4*)(gp + bj * HALF), g1 = *(const u32x4*)(gp + 1024 + bj * HALF);
#pragma unroll
                    for (int e = 0; e < 4; ++e) { const unsigned a = g0[e], b = g1[e];
                        const float ra = (1.0f + em(__builtin_bit_cast(float, b << 16))) * __builtin_amdgcn_rcpf(1.0f + em(__builtin_bit_cast(float, a << 16)));
                        const float rb = (1.0f + em(__builtin_bit_cast(float, b & 0xffff0000u))) * __builtin_amdgcn_rcpf(1.0f + em(__builtin_bit_cast(float, a & 0xffff0000u)));
                        if (e < 2) { acc[ai][bj][m][0][2 * e] *= ra; acc[ai][bj][m][0][2 * e + 1] *= rb; } else { acc[ai][bj][m][1][2 * (e - 2)] *= ra; acc[ai][bj][m][1][2 * (e - 2) + 1] *= rb; } } } }
    }
    __device__ __forceinline__ void operator()(const f32x4 (&acc)[2][2][4][2], const Unit& u, int wr, int wc, int fr, int fq) const {
        const int row0 = u.pm * BM + wr * 64 + fr, col0 = u.pn * BM + wc * 32 + 8 * fq;
#pragma unroll
        for (int ai = 0; ai < 2; ++ai)
#pragma unroll
            for (int m = 0; m < 4; ++m) { const size_t row = (size_t)(row0 + ai * HALF + m * 16);
#pragma unroll
                for (int bj = 0; bj < 2; ++bj) { const u32x4 gw = *(const u32x4*)(proj + row * PW + P_GATE + 3 * 1024 + col0 + bj * HALF);
                    float sg[8];
#pragma unroll
                    for (int e = 0; e < 4; ++e) { sg[2 * e] = __builtin_amdgcn_rcpf(1.0f + em(__builtin_bit_cast(float, gw[e] << 16))); sg[2 * e + 1] = __builtin_amdgcn_rcpf(1.0f + em(__builtin_bit_cast(float, gw[e] & 0xffff0000u))); }
                    const f32x4 v0 = acc[ai][bj][m][0], v1 = acc[ai][bj][m][1];
                    u32x4 w; w.x = cvt_pk_bf16(v0[0] * sg[0], v0[1] * sg[1]); w.y = cvt_pk_bf16(v0[2] * sg[2], v0[3] * sg[3]); w.z = cvt_pk_bf16(v1[0] * sg[4], v1[1] * sg[5]); w.w = cvt_pk_bf16(v1[2] * sg[6], v1[3] * sg[7]);
                    *(u32x4*)(MB + row * D + col0 + bj * HALF) = w; } }
    }
};
struct BranchOrder {
    static constexpr bool VARK = false;
    int G, c;
    __device__ bool next(int i, Unit& u) const {
        const int tile = (i >> 2) * G + c; if (tile >= 256) return false;
        const int g = i & 3; u.pm = tile >> 2; u.pn = g * 4 + (tile & 3); u.aoff = g * 256; u.tag = g; return true;
    }
};
template <int NTC> struct MoeOrder {
    static constexpr bool VARK = false;
    static constexpr int NT = NTC; int G, c, ntiles; int t1, t2, t3, t4, t5, t6, t7;
    __device__ __forceinline__ void init(const unsigned* cnt, int G_, int c_) { G = G_; c = (G_ % 8 == 0) ? (c_ % 8) * (G_ / 8) + c_ / 8 : c_;
        int o = ((int)cnt[0] + 255) >> 8; t1 = o; o += ((int)cnt[1] + 255) >> 8; t2 = o; o += ((int)cnt[2] + 255) >> 8; t3 = o; o += ((int)cnt[3] + 255) >> 8; t4 = o;
        o += ((int)cnt[4] + 255) >> 8; t5 = o; o += ((int)cnt[5] + 255) >> 8; t6 = o; o += ((int)cnt[6] + 255) >> 8; t7 = o; o += ((int)cnt[7] + 255) >> 8; ntiles = o; }
    __device__ __forceinline__ bool next(int i, Unit& u) const {
        const int L = i * G + c; if (L >= ntiles * NT) return false;
        const int tau = L / NT, pn = L % NT;
        const int e = (tau >= t1) + (tau >= t2) + (tau >= t3) + (tau >= t4) + (tau >= t5) + (tau >= t6) + (tau >= t7);
        u.pm = tau; u.pn = e * NT + pn; u.aoff = 0; u.tag = e; return true;
    }
};
struct MoeSplit { int tau0, nrt, s; };
__device__ __forceinline__ MoeSplit moe_split(const unsigned* cnt, int G) {
    int o = 0;
#pragma unroll
    for (int e = 0; e < 8; ++e) o += ((int)cnt[e] + 255) >> 8;
    const int U = o * 4, nfull = (U / G) * G, rem = U - nfull; MoeSplit r; r.tau0 = o; r.nrt = 0; r.s = 1;
    if ((nfull & 3) == 0 && rem > 0 && rem * 2 <= G) { r.s = (rem * 7 <= G) ? 7 : (rem * 4 <= G) ? 4 : 2; r.tau0 = nfull >> 2; r.nrt = o - r.tau0; }
    return r;
}
struct MoeOrderSplit {
    static constexpr bool VARK = true;
    static constexpr int NT = 4, KT = 56; int G, c, ntiles; int t1, t2, t3, t4, t5, t6, t7; int nfull, rem, s;
    __device__ __forceinline__ void init(const unsigned* cnt, int G_, int c_) { G = G_; c = (G_ % 8 == 0) ? (c_ % 8) * (G_ / 8) + c_ / 8 : c_;
        int o = ((int)cnt[0] + 255) >> 8; t1 = o; o += ((int)cnt[1] + 255) >> 8; t2 = o; o += ((int)cnt[2] + 255) >> 8; t3 = o; o += ((int)cnt[3] + 255) >> 8; t4 = o;
        o += ((int)cnt[4] + 255) >> 8; t5 = o; o += ((int)cnt[5] + 255) >> 8; t6 = o; o += ((int)cnt[6] + 255) >> 8; t7 = o; o += ((int)cnt[7] + 255) >> 8; ntiles = o;
        const MoeSplit sp = moe_split(cnt, G_); s = sp.s; nfull = (s > 1) ? sp.tau0 * 4 : ntiles * 4; rem = ntiles * 4 - nfull; }
    __device__ __forceinline__ bool next(int i, Unit& u) const {
        const int L = i * G + c; int tl = L, kp = 0;
        if (L >= nfull) { const int j = L - nfull; if (j >= rem * s) return false; tl = nfull + j / s; kp = j % s + 1; }
        const int tau = tl >> 2, pn = tl & 3;
        const int e = (tau >= t1) + (tau >= t2) + (tau >= t3) + (tau >= t4) + (tau >= t5) + (tau >= t6) + (tau >= t7);
        u.pm = tau; u.pn = e * NT + pn; u.aoff = kp ? (kp - 1) * ((KT * BK) / s) : 0; u.tag = e | (kp << 8); return true;
    }
    __device__ __forceinline__ int nt_of(const Unit& u) const { return (u.tag >> 8) ? KT / s : KT; }
};
struct EpiBf16Split {
    static constexpr bool PERM = true, MIDK = false;
    bf16_t* O; bf16_t* P; int tau0, nrt;
    __device__ __forceinline__ void operator()(const f32x4 (&acc)[2][2][4][2], const Unit& u, int wr, int wc, int fr, int fq) const {
        const int kp = u.tag >> 8;
        bf16_t* base = kp ? P + (size_t)((kp - 1) * nrt + (u.pm - tau0)) * BM * 1024 : O + (size_t)u.pm * BM * 1024;
        const int row0 = wr * 64 + fr, col0 = (u.pn & 3) * BM + wc * 32 + 8 * fq;
#pragma unroll
        for (int ai = 0; ai < 2; ++ai)
#pragma unroll
            for (int m = 0; m < 4; ++m) { bf16_t* rowp = base + (size_t)(row0 + ai * HALF + m * 16) * 1024 + col0;
#pragma unroll
                for (int bj = 0; bj < 2; ++bj) { const f32x4 v0 = acc[ai][bj][m][0], v1 = acc[ai][bj][m][1];
                    u32x4 w; w.x = cvt_pk_bf16(v0[0], v0[1]); w.y = cvt_pk_bf16(v0[2], v0[3]); w.z = cvt_pk_bf16(v1[0], v1[1]); w.w = cvt_pk_bf16(v1[2], v1[3]);
                    *(u32x4*)(rowp + bj * HALF) = w; } }
    }
};
}
typedef GAS unsigned gu32;
#define RLX_AGENT __ATOMIC_RELAXED, __HIP_MEMORY_SCOPE_AGENT
#define XB_TMO      128
#define XB_XCNT(j)  (256  + 64 * (j))
#define XB_XSUB(j)  (1280 + 64 * (j))
#define XB_XGEN(j)  (2304 + 64 * (j))
#define XB_TOP      3328
#define XB_TOPGEN   3392
#define XCD_BAR_WORDS 3456
#define XB_SPIN_CAP (1u << 18)

__device__ __forceinline__ unsigned xb_ld(unsigned* p)              { return __hip_atomic_load(p, __ATOMIC_RELAXED, __HIP_MEMORY_SCOPE_AGENT); }
__device__ __forceinline__ unsigned xb_add(unsigned* p, unsigned v) { return __hip_atomic_fetch_add(p, v, __ATOMIC_RELAXED, __HIP_MEMORY_SCOPE_AGENT); }
__device__ __forceinline__ unsigned xb_xcc_id() { return (unsigned)__builtin_amdgcn_s_getreg((3 << 11) | 20) & 0xFu; }
#define XB_SPIN(cond, bar) do { unsigned _sp = 0; while (cond) { __builtin_amdgcn_s_sleep(1); \
    if ((++_sp & 255u) == 0u) { if (xb_ld(&(bar)[XB_TMO])) break; if (_sp > XB_SPIN_CAP) { atomicAdd(&(bar)[XB_TMO], 1u); break; } } } } while (0)

struct XcdBarrier {
    unsigned* bar; unsigned x;
    volatile LAS unsigned* st;
};

__device__ __forceinline__ XcdBarrier xcd_barrier_post(unsigned* bar, volatile LAS unsigned* st) {
    XcdBarrier b; b.bar = bar; b.x = xb_xcc_id(); b.st = st;
    if (threadIdx.x == 0) (void)xb_add(&bar[XB_XCNT(b.x)], 1u);
    return b;
}
__device__ __forceinline__ void xcd_barrier_complete(unsigned* bar, unsigned x, unsigned& nloc, unsigned& nx) {
    const unsigned G = gridDim.x * gridDim.y * gridDim.z;
    unsigned sum, cnt, mine, sp = 0u;
    for (;;) {
        sum = 0u; cnt = 0u; mine = 0u;
#pragma unroll
        for (unsigned j = 0; j < 16; ++j) { const unsigned c = xb_ld(&bar[XB_XCNT(j)]); sum += c; cnt += (c > 0u) ? 1u : 0u; mine = (j == x) ? c : mine; }
        if (sum == G) break;
        __builtin_amdgcn_s_sleep(1);
        if ((++sp & 255u) == 0u) { if (xb_ld(&bar[XB_TMO])) break; if (sp > XB_SPIN_CAP) { atomicAdd(&bar[XB_TMO], 1u); break; } }
    }
    nloc = mine > 0u ? mine : 1u; nx = cnt > 0u ? cnt : 1u;
}

__device__ __forceinline__ void xcd_barrier(const XcdBarrier& b) {
    asm volatile("s_waitcnt vmcnt(0)" ::: "memory");
    __syncthreads();
    if (threadIdx.x == 0) {
        unsigned* bar = b.bar;
        __builtin_amdgcn_s_waitcnt(0);
        unsigned nloc = b.st[0], nx = b.st[1];
        if (nloc == 0u) { xcd_barrier_complete(bar, b.x, nloc, nx); b.st[0] = nloc; b.st[1] = nx; }
        const unsigned old = xb_add(&bar[XB_XSUB(b.x)], 1u);
        const unsigned gen = old / nloc;
        if (old + 1u == (gen + 1u) * nloc) {
            __builtin_amdgcn_fence(__ATOMIC_RELEASE, "agent");
            asm volatile("s_waitcnt vmcnt(0)" ::: "memory");
            const unsigned og = xb_add(&bar[XB_TOP], 1u);
            const unsigned tg = og / nx;
            if (og + 1u == (tg + 1u) * nx) xb_add(&bar[XB_TOPGEN], 1u);
            else XB_SPIN(xb_ld(&bar[XB_TOPGEN]) == tg, bar);
            __builtin_amdgcn_fence(__ATOMIC_ACQUIRE, "agent");
            xb_add(&bar[XB_XGEN(b.x)], 1u);
            asm volatile("s_waitcnt vmcnt(0)" ::: "memory");
        } else {
            XB_SPIN(xb_ld(&bar[XB_XGEN(b.x)]) == gen, bar);
            __builtin_amdgcn_fence(__ATOMIC_ACQUIRE, "agent");
            asm volatile("s_waitcnt vmcnt(0)" ::: "memory");
        }
    }
    __syncthreads();
}
struct Args { const void* in[40]; float* out; unsigned char* ws; int ph_lo, ph_hi; };
typedef const __attribute__((address_space(4))) Args* ArgsP;
__device__ __forceinline__ ArgsP fresh_args() { ArgsP p = (ArgsP)__builtin_amdgcn_kernarg_segment_ptr(); asm volatile("" : "+s"(p)); return p; }

struct Frame {
    LAS unsigned char* lds;
    int wave, G, gw, NGW;
    __device__ __forceinline__ int lane() const { unsigned z = 0u; asm volatile("" : "+v"(z)); return (int)__builtin_amdgcn_mbcnt_hi(~0u, __builtin_amdgcn_mbcnt_lo(~0u, z)); }
};

__device__ __forceinline__ Frame fresh(const Frame& F) { Frame R = F; asm volatile("" : "+s"(R.wave), "+s"(R.G), "+s"(R.gw), "+s"(R.NGW)); return R; }
#define LDS_WAIT() asm volatile("s_waitcnt lgkmcnt(0)" ::: "memory")

__device__ __forceinline__ void p0_mod_items(Frame& F, const float* c, const float* ada_w, const float* ada_b, float* mod) {
    LAS float* part = (LAS float*)F.lds;
    LAS float* cs = (LAS float*)(F.lds + 98304);
    int tid_ = F.wave * 64 + F.lane(); asm volatile("" : "+v"(tid_)); const int lane_ = tid_ & 63;
    if ((int)blockIdx.x >= 192) return;
    for (int i = tid_; i < 8192; i += NTHR) cs[i] = siluf(c[i]);
    __syncthreads();
    for (int it = blockIdx.x; it < 192; it += F.G) {
        const int l = it / 96, j0 = (it % 96) * 64;
        float acc[8];
#pragma unroll
        for (int b = 0; b < 8; ++b) acc[b] = 0.f;
        const float* w = ada_w + (size_t)l * 1024 * 6144 + j0 + lane_;
        const int k0 = F.wave * 128;
#pragma unroll 1
        for (int kb = 0; kb < 128; kb += 16) { float wv[16];
#pragma unroll
            for (int q = 0; q < 16; ++q) wv[q] = w[(size_t)(k0 + kb + q) * 6144];
#pragma unroll
            for (int q4 = 0; q4 < 4; ++q4)
#pragma unroll
                for (int b = 0; b < 8; ++b) { const pg8::f32x4 cv = *(const LAS pg8::f32x4*)(cs + b * 1024 + k0 + kb + 4 * q4);
                    acc[b] += (cv[0] * wv[4 * q4] + cv[1] * wv[4 * q4 + 1]) + (cv[2] * wv[4 * q4 + 2] + cv[3] * wv[4 * q4 + 3]); } }
#pragma unroll
        for (int b = 0; b < 8; ++b) part[(F.wave * 8 + b) * 64 + lane_] = acc[b];
        __syncthreads();
        { const int b = tid_ >> 6, col = tid_ & 63; float s = 0.f;
#pragma unroll
          for (int w8 = 0; w8 < 8; ++w8) s += part[(w8 * 8 + b) * 64 + col];
          mod[(size_t)(l * 8 + b) * 6144 + j0 + col] = s + ada_b[l * 6144 + j0 + col]; }
        __syncthreads();
    }
}
struct CvtDesc { const float* colp; size_t Ns; bf16_t* WT; int Kd, n0, k0; };
__device__ __forceinline__ void cvt_load(const CvtDesc& d, pg8::f32x4 (&v)[8], int lane) {
    const int kr = lane >> 3;
#pragma unroll
    for (int i = 0; i < 8; ++i) v[i] = d.colp ? *(const pg8::f32x4*)(d.colp + (size_t)(d.k0 + 8 * i + kr) * d.Ns) : (pg8::f32x4){0.f, 0.f, 0.f, 0.f};
}
__device__ __forceinline__ void cvt_store(const CvtDesc& d, const pg8::f32x4 (&v)[8], LAS float* scr, int lane) {
    const int q4 = 4 * (lane & 7), kr = lane >> 3;
#pragma unroll
    for (int i = 0; i < 8; ++i)
#pragma unroll
        for (int e = 0; e < 4; ++e) scr[(8 * i + kr) * 33 + q4 + e] = v[i][e];
    LDS_WAIT(); asm volatile("" ::: "memory");
    const int cidx = lane & 7;
#pragma unroll
    for (int j = 0; j < 4; ++j) { const int n = (lane >> 3) + 8 * j; const LAS float* s = scr + (8 * cidx) * 33 + n;
        pg8::u32x4 o; o.x = pk2(s[0 * 33], s[1 * 33]); o.y = pk2(s[2 * 33], s[3 * 33]); o.z = pk2(s[4 * 33], s[5 * 33]); o.w = pk2(s[6 * 33], s[7 * 33]);
        *(pg8::u32x4*)(d.WT + (size_t)(d.n0 + n) * d.Kd + d.k0 + 8 * cidx) = o; }
    LDS_WAIT(); asm volatile("" ::: "memory");
}
__device__ __forceinline__ int win_src_col(int v) { return v < 768 ? v : (v < 7168 ? v + 16 : (v < 7184 ? v - 6400 : -1)); }

__device__ __forceinline__ CvtDesc p0_desc(ArgsP a, int it, int n) {
    const float* w_in = (const float*)a->in[9]; const float* w_branch = (const float*)a->in[30]; const float* w_out = (const float*)a->in[31];
    const float* wg = (const float*)a->in[32]; const float* wu = (const float*)a->in[33]; const float* wd = (const float*)a->in[34];
    bf16_t* WIN = (bf16_t*)(a->ws + WS_WIN); bf16_t* WB = (bf16_t*)(a->ws + WS_WB); bf16_t* WO = (bf16_t*)(a->ws + WS_WO); bf16_t* WF1 = (bf16_t*)(a->ws + WS_WF1); bf16_t* WF2 = (bf16_t*)(a->ws + WS_WF2);
    bf16_t* LR = (bf16_t*)(a->ws + WS_LR);
    constexpr int I_IN = 2 * 232 * 16, I_B = 2 * 4 * 32 * 4, I_O = 2 * 32 * 16, I_F1 = 176 * 16, I_F2 = 32 * 44;
    int r = it;
    if (r < I_IN) { const int l = r / (232 * 16), q = r % (232 * 16), nb = q / 16, kb = q % 16; const int sc = win_src_col(nb * 32 + n);
        return CvtDesc{sc >= 0 ? w_in + (size_t)l * 1024 * NIN + sc : nullptr, (size_t)NIN, WIN + (size_t)l * PW * 1024, 1024, nb * 32, kb * 64}; } r -= I_IN;
    if (r < I_B) { const int lg = r / 128, q = r % 128, nb = q / 4, kb = q % 4;
        const int g = lg & 3, l = lg >> 2;
        return CvtDesc{w_branch + (size_t)lg * 256 * 1024 + nb * 32 + n - (size_t)g * 256 * 1024, 1024, WB + (size_t)l * 1024 * 1024, 1024, nb * 32, g * 256 + kb * 64}; } r -= I_B;
    if (r < I_O) { const int l = r / 512, q = r % 512, nb = q / 16, kb = q % 16;
        return CvtDesc{w_out + (size_t)l * 1024 * 1024 + nb * 32 + n, 1024, WO + (size_t)l * 1024 * 1024, 1024, nb * 32, kb * 64}; } r -= I_O;
    if (r < I_F1) { const int nb = r / 16, kb = r % 16; const int v = nb * 32 + n; const int up = (v >> 2) & 1, j = (v >> 3) * 4 + (v & 3);
        return CvtDesc{(up ? wu : wg) + j, (size_t)DFF, WF1, 1024, nb * 32, kb * 64}; } r -= I_F1;
    if (r < I_F2) { const int nb = r / 44, kb = r % 44;
        return CvtDesc{wd + nb * 32 + n, 1024, WF2, DFF, nb * 32, kb * 64}; } r -= I_F2;
    if (r < 16) { const int l = r >> 3, nb = r & 7; return CvtDesc{(const float*)a->in[21] + l * 64 * 256 + nb * 32 + n, 256, LR + l * 256 * 64, 64, nb * 32, 0}; } r -= 16;
    if (r < 16) { const int l = r >> 3, nb = r & 7; return CvtDesc{(const float*)a->in[23] + l * 64 * 256 + nb * 32 + n, 256, LR + 2 * 256 * 64 + l * 256 * 64, 64, nb * 32, 0}; } r -= 16;
    { const int l = r >> 4, nb = (r >> 1) & 7, kb = r & 1; return CvtDesc{(const float*)a->in[24] + l * 128 * 256 + nb * 32 + n, 256, LR + 4 * 256 * 64 + l * 256 * 128, 128, nb * 32, kb * 64}; }
}
__device__ __forceinline__ void p0_convert(Frame& F, ArgsP a) {
    LAS float* scr = (LAS float*)(F.lds + 16384 + F.wave * 8704);
    constexpr int NITEMS = 2 * 232 * 16 + 2 * 4 * 32 * 4 + 2 * 32 * 16 + 176 * 16 + 32 * 44 + 64;
    int lane_ = F.lane(); asm volatile("" : "+v"(lane_));
    const int n = 4 * (lane_ & 7);
    int it = F.gw; if (it >= NITEMS) return;
    CvtDesc cur = p0_desc(a, it, n); pg8::f32x4 v[8]; cvt_load(cur, v, lane_);
    for (;;) { const int nx = it + F.NGW; const bool more = nx < NITEMS;
        CvtDesc nd = cur; pg8::f32x4 w[8];
        if (more) { nd = p0_desc(a, nx, n); cvt_load(nd, w, lane_); }
        cvt_store(cur, v, scr, lane_);
        if (!more) break;
#pragma unroll
        for (int i = 0; i < 8; ++i) v[i] = w[i];
        cur = nd; it = nx; }
}

__device__ __forceinline__ void row_load(const float* p, pg8::f32x4 (&v)[4], int lane) {
#pragma unroll
    for (int j = 0; j < 4; ++j) v[j] = *(const pg8::f32x4*)(p + 4 * lane + 256 * j);
}
__device__ __forceinline__ float row_ss(const pg8::f32x4 (&v)[4]) {
    float s = 0.f;
#pragma unroll
    for (int j = 0; j < 4; ++j) s += (v[j][0] * v[j][0] + v[j][1] * v[j][1]) + (v[j][2] * v[j][2] + v[j][3] * v[j][3]);
    return wave_sum(s);
}
__device__ __forceinline__ void row_normmod(const pg8::f32x4 (&x)[4], const float* g, const float* mb, int sh_off, int sc_off, bf16_t* hrow, pg8::f32x4 (&hv)[4], int lane) {
    const float rstd = rsqrtf(row_ss(x) * (1.0f / D) + 1e-6f);
#pragma unroll
    for (int j = 0; j < 4; ++j) { const int d = 4 * lane + 256 * j;
        const pg8::f32x4 gg = *(const pg8::f32x4*)(g + d), sc = *(const pg8::f32x4*)(mb + sc_off + d), sh = *(const pg8::f32x4*)(mb + sh_off + d);
        hv[j] = x[j] * rstd * gg * (1.0f + sc) + sh;
        pg8::u32x2 w; w.x = pk2(hv[j][0], hv[j][1]); w.y = pk2(hv[j][2], hv[j][3]);
        *(pg8::u32x2*)(hrow + d) = w; }
}
template <int CTRL, int ROWMASK> __device__ __forceinline__ float dpp_mov_p(float old, float x) {
    return __builtin_bit_cast(float, __builtin_amdgcn_update_dpp(__builtin_bit_cast(int, old), __builtin_bit_cast(int, x), CTRL, ROWMASK, 0xF, false)); }
__device__ __forceinline__ float wave_sum63p(float x) {
    x += dpp_mov_p<0xB1, 0xF>(0.f, x); x += dpp_mov_p<0x4E, 0xF>(0.f, x); x += dpp_mov_p<0x141, 0xF>(0.f, x); x += dpp_mov_p<0x140, 0xF>(0.f, x);
    x += dpp_mov_p<0x142, 0xA>(0.f, x); x += dpp_mov_p<0x143, 0xC>(0.f, x); return x; }
__device__ __forceinline__ void stage_wz(const float* w_in_l, LAS float* wz, int tid) {
    for (int i = tid; i < 1024 * 4; i += NTHR) { const int d = i >> 2, q = i & 3; const pg8::f32x4 w = *(const pg8::f32x4*)(w_in_l + (size_t)d * NIN + 768 + 4 * q);
        wz[(4 * q) * 1024 + d] = w[0]; wz[(4 * q + 1) * 1024 + d] = w[1]; wz[(4 * q + 2) * 1024 + d] = w[2]; wz[(4 * q + 3) * 1024 + d] = w[3]; }
    __syncthreads();
}
__device__ __forceinline__ void row_gz(const pg8::f32x4 (&hv)[4], const LAS float* wz, bf16_t* gzrow, int lane) {
    float mine = 0.f;
#pragma unroll
    for (int o = 0; o < 16; ++o) { float acc = 0.f;
#pragma unroll
        for (int j = 0; j < 4; ++j) { const pg8::f32x4 w = *(const LAS pg8::f32x4*)(wz + o * 1024 + 4 * lane + 256 * j); acc += (hv[j][0] * w[0] + hv[j][1] * w[1]) + (hv[j][2] * w[2] + hv[j][3] * w[3]); }
        const float s = __builtin_bit_cast(float, __builtin_amdgcn_readlane(__builtin_bit_cast(int, wave_sum63p(acc)), 63)); if (lane == o) mine = s; }
    if (lane < 16) gzrow[lane] = (bf16_t)f2bf(mine);
}
__device__ __forceinline__ void ph_h0(Frame& F, ArgsP a) {
    const float* x = (const float*)a->in[0]; const float* g = (const float*)a->in[5]; const float* mod = (const float*)(a->ws + WS_MOD); bf16_t* H = (bf16_t*)(a->ws + WS_HB);
    bf16_t* GZ = (bf16_t*)(a->ws + WS_GZ); LAS float* wz = (LAS float*)F.lds;
    int lane0 = F.lane(); asm volatile("" : "+v"(lane0));
    stage_wz((const float*)a->in[9], wz, F.wave * 64 + lane0);
    int row = F.gw; if (row >= M) return;
    pg8::f32x4 xn[4]; row_load(x + (size_t)row * D, xn, lane0);
    for (;;) { int lane = lane0; asm volatile("" : "+v"(lane)); pg8::f32x4 xv[4], hv[4];
#pragma unroll
        for (int j = 0; j < 4; ++j) xv[j] = xn[j];
        const int nrow = row + F.NGW; if (nrow < M) row_load(x + (size_t)nrow * D, xn, lane);
        row_normmod(xv, g, mod + (size_t)(row / T) * 6144, 0, 1024, H + (size_t)row * D, hv, lane);
        row_gz(hv, wz, GZ + (size_t)row * 16, lane);
        if (nrow >= M) break; row = nrow; }
}
__device__ __forceinline__ void moe_slot_load(const bf16_t* eout, const bf16_t* part, const pg8::MoeSplit sp, int g, int lane, pg8::u32x2 (&e)[4]) {
    const int tau = g >> 8;
    if (sp.s > 1 && tau >= sp.tau0) {
        const bf16_t* p = part + ((size_t)(tau - sp.tau0) * 256 + (g & 255)) * D + 4 * lane; const size_t ps = (size_t)sp.nrt * 256 * D;
        float ac[16];
#pragma unroll
        for (int i = 0; i < 16; ++i) ac[i] = 0.f;
        if (sp.s == 7) { pg8::u32x2 w[7][4];
#pragma unroll
            for (int k = 0; k < 7; ++k)
#pragma unroll
                for (int j = 0; j < 4; ++j) w[k][j] = *(const pg8::u32x2*)(p + k * ps + 256 * j);
#pragma unroll
            for (int k = 0; k < 7; ++k)
#pragma unroll
                for (int j = 0; j < 4; ++j) { ac[4 * j] += __builtin_bit_cast(float, w[k][j].x << 16); ac[4 * j + 1] += __builtin_bit_cast(float, w[k][j].x & 0xffff0000u); ac[4 * j + 2] += __builtin_bit_cast(float, w[k][j].y << 16); ac[4 * j + 3] += __builtin_bit_cast(float, w[k][j].y & 0xffff0000u); }
        } else {
#pragma unroll 1
            for (int k = 0; k < sp.s; ++k)
#pragma unroll
                for (int j = 0; j < 4; ++j) { const pg8::u32x2 w = *(const pg8::u32x2*)(p + k * ps + 256 * j);
                    ac[4 * j] += __builtin_bit_cast(float, w.x << 16); ac[4 * j + 1] += __builtin_bit_cast(float, w.x & 0xffff0000u); ac[4 * j + 2] += __builtin_bit_cast(float, w.y << 16); ac[4 * j + 3] += __builtin_bit_cast(float, w.y & 0xffff0000u); }
        }
#pragma unroll
        for (int j = 0; j < 4; ++j) { e[j].x = pk2(ac[4 * j], ac[4 * j + 1]); e[j].y = pk2(ac[4 * j + 2], ac[4 * j + 3]); }
    } else {
#pragma unroll
        for (int j = 0; j < 4; ++j) e[j] = *(const pg8::u32x2*)(eout + (size_t)g * D + 4 * lane + 256 * j);
    }
}
__device__ __forceinline__ void row_y_load(const bf16_t* y, const bf16_t* eout, const unsigned* cnt, const int* toke, const int* toks, int row, int lane, pg8::f32x4 (&yv)[4], pg8::u32x2 (&e1)[4], pg8::u32x2 (&e2)[4], const bf16_t* part, const pg8::MoeSplit sp) {
    if (eout) {
        int roff[8]; { int o = 0;
#pragma unroll
            for (int e = 0; e < 8; ++e) { roff[e] = o; o += (((int)cnt[e] + 255) >> 8) << 8; } }
        const int x1 = toke[row * 2], x2 = toke[row * 2 + 1]; int g1 = toks[row * 2], g2 = toks[row * 2 + 1];
#pragma unroll
        for (int q = 0; q < 8; ++q) { if (q == x1) g1 += roff[q]; if (q == x2) g2 += roff[q]; }
        moe_slot_load(eout, part, sp, g1, lane, e1); moe_slot_load(eout, part, sp, g2, lane, e2);
    } else {
#pragma unroll
        for (int j = 0; j < 4; ++j) e1[j] = *(const pg8::u32x2*)(y + (size_t)row * D + 4 * lane + 256 * j); }
}
__device__ __forceinline__ void ph_row(Frame& F, ArgsP a, const float* xold, const bf16_t* y, const float* gpost, const float* modl, int gt_off,
                                       const float* gpre, const float* modn, int sh_off, int sc_off, bf16_t* hdst, bool route, const bf16_t* eout = nullptr, const float* w_in_next = nullptr) {
    float* out = a->out;
    bf16_t* GZ = (bf16_t*)(a->ws + WS_GZ); LAS float* wz = (LAS float*)F.lds;
    if (w_in_next) { int t_ = F.wave * 64 + F.lane(); stage_wz(w_in_next, wz, t_); }
    const float* rw = (const float*)a->in[35]; const float* rb = (const float*)a->in[36];
    unsigned* cnt = (unsigned*)(a->ws + WS_CTL) + CW_CNT;
    int* list = (int*)(a->ws + WS_ROUTE + RT_LIST); int* toke = (int*)(a->ws + WS_ROUTE + RT_TOKE); int* toks = (int*)(a->ws + WS_ROUTE + RT_TOKS); float* tokp = (float*)(a->ws + WS_ROUTE + RT_TOKP);
    int row = F.gw; if (row >= M) return;
    int lane0 = F.lane(); asm volatile("" : "+v"(lane0));
    pg8::f32x4 yn[4], xn[4]; pg8::u32x2 e1n[4], e2n[4];
    pg8::MoeSplit sp{0, 0, 1}; if (eout) sp = pg8::moe_split(cnt, F.G); const bf16_t* part = (const bf16_t*)(a->ws + WS_WM1);
    row_y_load(y, eout, cnt, toke, toks, row, lane0, yn, e1n, e2n, part, sp); row_load(xold + (size_t)row * D, xn, lane0);
    for (;;) {
        int lane = lane0; asm volatile("" : "+v"(lane));
        const int b = row / T; pg8::f32x4 yv[4], xv[4], hv[4];
        if (eout) { const float p1 = tokp[row * 2], p2 = tokp[row * 2 + 1];
#pragma unroll
            for (int j = 0; j < 4; ++j) { const pg8::u32x2 a1 = e1n[j], a2 = e2n[j];
                yv[j][0] = p1 * __builtin_bit_cast(float, a1.x << 16) + p2 * __builtin_bit_cast(float, a2.x << 16); yv[j][1] = p1 * __builtin_bit_cast(float, a1.x & 0xffff0000u) + p2 * __builtin_bit_cast(float, a2.x & 0xffff0000u);
                yv[j][2] = p1 * __builtin_bit_cast(float, a1.y << 16) + p2 * __builtin_bit_cast(float, a2.y << 16); yv[j][3] = p1 * __builtin_bit_cast(float, a1.y & 0xffff0000u) + p2 * __builtin_bit_cast(float, a2.y & 0xffff0000u); }
        } else {
#pragma unroll
            for (int j = 0; j < 4; ++j) { const pg8::u32x2 a1 = e1n[j]; yv[j][0] = __builtin_bit_cast(float, a1.x << 16); yv[j][1] = __builtin_bit_cast(float, a1.x & 0xffff0000u); yv[j][2] = __builtin_bit_cast(float, a1.y << 16); yv[j][3] = __builtin_bit_cast(float, a1.y & 0xffff0000u); } }
#pragma unroll
        for (int j = 0; j < 4; ++j) xv[j] = xn[j];
        const int nrow = row + F.NGW;
        if (nrow < M) { row_y_load(y, eout, cnt, toke, toks, nrow, lane, yn, e1n, e2n, part, sp); row_load(xold + (size_t)nrow * D, xn, lane); }
        const float rstd = rsqrtf(row_ss(yv) * (1.0f / D) + 1e-6f);
        const float* mb = modl + (size_t)b * 6144;
#pragma unroll
        for (int j = 0; j < 4; ++j) { const int d = 4 * lane + 256 * j;
            const pg8::f32x4 gp = *(const pg8::f32x4*)(gpost + d), gt = *(const pg8::f32x4*)(mb + gt_off + d);
            xv[j] = xv[j] + gt * (yv[j] * rstd * gp);
            *(pg8::f32x4*)(out + (size_t)row * D + d) = xv[j]; }
        if (hdst) {
            row_normmod(xv, gpre, modn + (size_t)b * 6144, sh_off, sc_off, hdst + (size_t)row * D, hv, lane);
            if (w_in_next) row_gz(hv, wz, GZ + (size_t)row * 16, lane);
            if (route) {
                float lg[8];
#pragma unroll
                for (int e = 0; e < 8; ++e) lg[e] = 0.f;
#pragma unroll
                for (int j = 0; j < 4; ++j)
#pragma unroll
                    for (int q = 0; q < 4; ++q) { const int d = 4 * lane + 256 * j + q; const pg8::f32x4 w0 = *(const pg8::f32x4*)(rw + d * 8), w1 = *(const pg8::f32x4*)(rw + d * 8 + 4); const float hq = hv[j][q];
                        lg[0] += hq * w0[0]; lg[1] += hq * w0[1]; lg[2] += hq * w0[2]; lg[3] += hq * w0[3]; lg[4] += hq * w1[0]; lg[5] += hq * w1[1]; lg[6] += hq * w1[2]; lg[7] += hq * w1[3]; }
#pragma unroll
                for (int e = 0; e < 8; ++e) lg[e] = wave_sum(lg[e]) + rb[e];
                if (lane == 0) {
                    int e1 = 0; float v1 = lg[0];
#pragma unroll
                    for (int e = 1; e < 8; ++e) if (lg[e] > v1) { v1 = lg[e]; e1 = e; }
                    int e2 = -1; float v2 = -3.0e38f;
#pragma unroll
                    for (int e = 0; e < 8; ++e) if (e != e1 && lg[e] > v2) { v2 = lg[e]; e2 = e; }
                    const float p1 = 1.0f / (1.0f + __expf(v2 - v1)), p2 = 1.0f - p1;
                    const int s1 = (int)atomicAdd(&cnt[e1], 1u), s2 = (int)atomicAdd(&cnt[e2], 1u);
                    list[e1 * M + s1] = row; list[e2 * M + s2] = row;
                    toke[row * 2] = e1; toke[row * 2 + 1] = e2; toks[row * 2] = s1; toks[row * 2 + 1] = s2; tokp[row * 2] = p1; tokp[row * 2 + 1] = p2;
                }
            }
        }
        if (nrow >= M) break; row = nrow;
    }
}

__device__ __forceinline__ void ph_moe_prep(Frame& F, ArgsP a) {
    LAS float* scr = (LAS float*)(F.lds + F.wave * 8704);
    const float* mg = (const float*)a->in[37]; const float* mu = (const float*)a->in[38]; const float* md = (const float*)a->in[39];
    bf16_t* WM1 = (bf16_t*)(a->ws + WS_WM1); bf16_t* WM2 = (bf16_t*)(a->ws + WS_WM2);
    constexpr int I_1 = 8 * 224 * 16, I_2 = 8 * 32 * 56;
    int lane_ = F.lane(); asm volatile("" : "+v"(lane_));
    const int n = 4 * (lane_ & 7);
    auto desc = [&](int r) -> CvtDesc {
        if (r < I_1) { const int e = r / 3584, q = r % 3584, nb = q / 16, kb = q % 16; const int v = nb * 32 + n; const int up = (v >> 2) & 1, j = (v >> 3) * 4 + (v & 3);
            return CvtDesc{(up ? mu : mg) + (size_t)e * 1024 * DEX + j, (size_t)DEX, WM1 + (size_t)e * 7168 * 1024, 1024, nb * 32, kb * 64}; }
        r -= I_1; const int e = r / 1792, q = r % 1792, nb = q / 56, kb = q % 56;
        return CvtDesc{md + (size_t)e * DEX * 1024 + nb * 32 + n, 1024, WM2 + (size_t)e * 1024 * DEX, DEX, nb * 32, kb * 64}; };
    { int it = F.gw;
      if (it < I_1 + I_2) { CvtDesc cur = desc(it); pg8::f32x4 v[8]; cvt_load(cur, v, lane_);
        for (;;) { const int nx = it + F.NGW; const bool more = nx < I_1 + I_2; CvtDesc nd = cur; pg8::f32x4 w[8];
            if (more) { nd = desc(nx); cvt_load(nd, w, lane_); }
            cvt_store(cur, v, scr, lane_);
            if (!more) break;
#pragma unroll
            for (int i = 0; i < 8; ++i) v[i] = w[i];
            cur = nd; it = nx; } } }
    const unsigned* cnt = (const unsigned*)(a->ws + WS_CTL) + CW_CNT;
    const int* list = (const int*)(a->ws + WS_ROUTE + RT_LIST);
    const bf16_t* h2 = (const bf16_t*)(a->ws + WS_H2L1); bf16_t* hg = (bf16_t*)(a->ws + WS_HG);
    int roff[9]; { int o = 0;
#pragma unroll
        for (int e = 0; e < 8; ++e) { roff[e] = o; o += (((int)cnt[e] + 255) >> 8) << 8; } roff[8] = o; }
    for (int slot0 = F.gw * 4; slot0 < roff[8]; slot0 += F.NGW * 4) {
        int src[4];
#pragma unroll
        for (int u = 0; u < 4; ++u) { const int slot = slot0 + u; int e = 0;
#pragma unroll
            for (int q = 1; q < 8; ++q) e += (slot >= roff[q]) ? 1 : 0;
            int base = 0, ce = 0;
#pragma unroll
            for (int q = 0; q < 8; ++q) if (q == e) { base = roff[q]; ce = (int)cnt[q]; }
            const int s = slot - base;
            src[u] = (slot < roff[8] && s < ce) ? list[e * M + s] : -1; }
        pg8::u32x4 v0[4], v1[4];
#pragma unroll
        for (int u = 0; u < 4; ++u) { v0[u] = (pg8::u32x4){0u, 0u, 0u, 0u}; v1[u] = v0[u];
            if (src[u] >= 0) { const pg8::u32x4* sp = (const pg8::u32x4*)(h2 + (size_t)src[u] * D) + 2 * lane_; v0[u] = sp[0]; v1[u] = sp[1]; } }
#pragma unroll
        for (int u = 0; u < 4; ++u) if (slot0 + u < roff[8]) { pg8::u32x4* dp = (pg8::u32x4*)(hg + (size_t)(slot0 + u) * D) + 2 * lane_; dp[0] = v0[u]; dp[1] = v1[u]; }
    }
}
typedef float f32x16 __attribute__((ext_vector_type(16)));
template <int CTRL, int ROWMASK> __device__ __forceinline__ float dpp_mov(float old, float x) {
    return __builtin_bit_cast(float, __builtin_amdgcn_update_dpp(__builtin_bit_cast(int, old), __builtin_bit_cast(int, x), CTRL, ROWMASK, 0xF, false));
}
__device__ __forceinline__ float rdlane(float x, int l) { return __builtin_bit_cast(float, __builtin_amdgcn_readlane(__builtin_bit_cast(int, x), l)); }
__device__ __forceinline__ float wave_sum63(float x) {
    x += dpp_mov<0xB1, 0xF>(0.f, x);
    x += dpp_mov<0x4E, 0xF>(0.f, x);
    x += dpp_mov<0x141, 0xF>(0.f, x);
    x += dpp_mov<0x140, 0xF>(0.f, x);
    x += dpp_mov<0x142, 0xA>(0.f, x);
    x += dpp_mov<0x143, 0xC>(0.f, x);
    return x;
}
__device__ __forceinline__ float row16_sum(float x) {
    x += dpp_mov<0xB1, 0xF>(0.f, x); x += dpp_mov<0x4E, 0xF>(0.f, x); x += dpp_mov<0x141, 0xF>(0.f, x); x += dpp_mov<0x140, 0xF>(0.f, x);
    return x;
}
__device__ __forceinline__ pg8::f32x4 ld_bf16x4(const bf16_t* p) { const pg8::u32x2 w = *(const pg8::u32x2*)p;
    return (pg8::f32x4){__builtin_bit_cast(float, w.x << 16), __builtin_bit_cast(float, w.x & 0xffff0000u), __builtin_bit_cast(float, w.y << 16), __builtin_bit_cast(float, w.y & 0xffff0000u)}; }
__device__ __forceinline__ void st_bf16x4(bf16_t* p, pg8::f32x4 v) { pg8::u32x2 w; w.x = pk2(v[0], v[1]); w.y = pk2(v[2], v[3]); *(pg8::u32x2*)p = w; }

__device__ __forceinline__ void ph_conv(Frame& F, ArgsP a, int l) {
    const bf16_t* proj = (const bf16_t*)(a->ws + WS_PROJ); bf16_t* br = (bf16_t*)(a->ws + WS_HB);
    const float* cw = (const float*)a->in[15] + l * 31 * 256; const float* cb = (const float*)a->in[16] + l * 256; const float* lg = (const float*)a->in[17] + l * 256; const float* lb = (const float*)a->in[18] + l * 256;
    LAS float* u = (LAS float*)F.lds;
    int tid = F.wave * 64 + F.lane(); asm volatile("" : "+v"(tid)); const int lane = tid & 63;
    for (int it = blockIdx.x; it < M / 64; it += F.G) {
        const int row0 = it * 64, t0 = row0 % T;
#pragma unroll
        for (int i_ = 0; i_ < 6; ++i_) { const int idx = tid + i_ * NTHR; if (idx >= 94 * 32) break; const int r = idx >> 5, c8 = (idx & 31) * 8; float uv[8];
#pragma unroll
            for (int e = 0; e < 8; ++e) uv[e] = 0.f;
            if (t0 - 30 + r >= 0) { const bf16_t* pr = proj + (size_t)(row0 - 30 + r) * PW;
                const pg8::f32x4 a0 = ld_bf16x4(pr + P_CA + c8), a1 = ld_bf16x4(pr + P_CA + c8 + 4), b0 = ld_bf16x4(pr + P_CB + c8), b1 = ld_bf16x4(pr + P_CB + c8 + 4);
#pragma unroll
                for (int e = 0; e < 4; ++e) { uv[e] = a0[e] * sigm(b0[e]); uv[4 + e] = a1[e] * sigm(b1[e]); } }
            *(LAS pg8::f32x4*)(u + r * 256 + c8) = (pg8::f32x4){uv[0], uv[1], uv[2], uv[3]}; *(LAS pg8::f32x4*)(u + r * 256 + c8 + 4) = (pg8::f32x4){uv[4], uv[5], uv[6], uv[7]}; }
        __syncthreads();
        const int c = tid & 255, half = tid >> 8;
        float acc[32];
        { float w[31], ur[62];
#pragma unroll
          for (int j = 0; j < 31; ++j) w[j] = cw[j * 256 + c];
#pragma unroll
          for (int q = 0; q < 62; ++q) ur[q] = u[(half * 32 + q) * 256 + c];
          const float bias = cb[c];
#pragma unroll
          for (int i = 0; i < 32; ++i) { float s = bias;
#pragma unroll
              for (int j = 0; j < 31; ++j) s += w[j] * ur[i + j];
              acc[i] = s; } }
        __syncthreads();
#pragma unroll
        for (int i = 0; i < 32; ++i) u[(half * 32 + i) * 256 + c] = acc[i];
        __syncthreads();
        const pg8::f32x4 g4 = *(const pg8::f32x4*)(lg + 4 * lane), b4 = *(const pg8::f32x4*)(lb + 4 * lane);
#pragma unroll 2
        for (int q = 0; q < 8; ++q) { const int t = F.wave * 8 + q; const pg8::f32x4 yv = *(const LAS pg8::f32x4*)(u + t * 256 + 4 * lane);
            const float mu = wave_sum((yv[0] + yv[1]) + (yv[2] + yv[3])) * (1.0f / 256.0f); const pg8::f32x4 d = yv - mu;
            const float var = wave_sum((d[0] * d[0] + d[1] * d[1]) + (d[2] * d[2] + d[3] * d[3])) * (1.0f / 256.0f);
            pg8::f32x4 o = d * rsqrtf(var + 1e-5f) * g4 + b4;
#pragma unroll
            for (int e = 0; e < 4; ++e) o[e] = siluf(o[e]);
            st_bf16x4(br + (size_t)(row0 + t) * D + 512 + 4 * lane, o); }
        __syncthreads();
    }
}

__device__ __forceinline__ void ph_rwkv_prep(Frame& F, ArgsP a, int l) {
        const bf16_t* proj = (const bf16_t*)(a->ws + WS_PROJ);
    const float* mu = (const float*)a->in[19] + l * 1024; const float* w0 = (const float*)a->in[20] + l * 256; const float* a0 = (const float*)a->in[22] + l * 256;
    const float* kkw = (const float*)a->in[25] + l * 256; const float* kaw = (const float*)a->in[26] + l * 256; const float* rkw = (const float*)a->in[27] + l * 256;
    const bf16_t* W2T = (const bf16_t*)(a->ws + WS_LR) + l * 256 * 64; const bf16_t* A2T = (const bf16_t*)(a->ws + WS_LR) + 2 * 256 * 64 + l * 256 * 64; const bf16_t* G2T = (const bf16_t*)(a->ws + WS_LR) + 4 * 256 * 64 + l * 256 * 128;
    unsigned char* VEC = a->ws + SCR_VEC6; float* SC = (float*)(a->ws + SCR_SC); bf16_t* GR = (bf16_t*)(a->ws + SCR_GR);
    constexpr int RS = 72, RG = 136;
    LAS bf16_t* TZh = (LAS bf16_t*)F.lds; LAS bf16_t* TZl = TZh + 64 * RS; LAS bf16_t* ZA = TZl + 64 * RS; LAS bf16_t* SG = ZA + 64 * RS;
    int tid = F.wave * 64 + F.lane(); asm volatile("" : "+v"(tid));
    for (int it = blockIdx.x; it < M / 64; it += F.G) {
        const int row0 = it * 64, b = row0 / T, t0 = row0 % T;
#pragma unroll 4
        for (int i_ = 0; i_ < 32; ++i_) { const int idx = tid + i_ * NTHR; const int cc = idx & 255, tok = idx >> 8; const int col = 768 + cc;
            const bf16_t* pc = proj + (size_t)(row0 + tok) * PW + P_R + col; const float xc = bf2f(pc[0]); const float xp = (t0 + tok > 0) ? bf2f(pc[-PW]) : 0.f;
            const float xm = xc + (xp - xc) * mu[col];
            if (cc < 64) { const float tv = tanh_fast(xm); const unsigned hi = f2bf(tv); TZh[tok * RS + cc] = (bf16_t)hi; TZl[tok * RS + cc] = (bf16_t)f2bf(tv - __builtin_bit_cast(float, hi << 16)); }
            else if (cc < 128) ZA[tok * RS + cc - 64] = (bf16_t)f2bf(xm);
            else SG[tok * RG + cc - 128] = (bf16_t)f2bf(sigm(xm)); }
        __syncthreads();
        int tid2 = tid; asm volatile("" : "+v"(tid2));
        const int lane = tid2 & 63, r = lane & 31, hg = lane >> 5, h = (tid2 >> 6) & 3, th = tid2 >> 8;
        f32x16 accw[2], acca[2], accg[2];
#pragma unroll
        for (int nb = 0; nb < 2; ++nb)
#pragma unroll
            for (int e = 0; e < 16; ++e) { accw[nb][e] = 0.f; acca[nb][e] = 0.f; accg[nb][e] = 0.f; }
        const int arow = (th * 32 + r);
#pragma unroll
        for (int s = 0; s < 4; ++s) { const pg8::bf16x8 ah = *(const LAS pg8::bf16x8*)(TZh + arow * RS + 16 * s + 8 * hg), al = *(const LAS pg8::bf16x8*)(TZl + arow * RS + 16 * s + 8 * hg), az = *(const LAS pg8::bf16x8*)(ZA + arow * RS + 16 * s + 8 * hg);
#pragma unroll
            for (int nb = 0; nb < 2; ++nb) { const int n = h * 64 + nb * 32 + r;
                const pg8::bf16x8 bw = *(const pg8::bf16x8*)(W2T + n * 64 + 16 * s + 8 * hg), ba = *(const pg8::bf16x8*)(A2T + n * 64 + 16 * s + 8 * hg);
                accw[nb] = __builtin_amdgcn_mfma_f32_32x32x16_bf16(ah, bw, accw[nb], 0, 0, 0); accw[nb] = __builtin_amdgcn_mfma_f32_32x32x16_bf16(al, bw, accw[nb], 0, 0, 0);
                acca[nb] = __builtin_amdgcn_mfma_f32_32x32x16_bf16(az, ba, acca[nb], 0, 0, 0); } }
#pragma unroll
        for (int s = 0; s < 8; ++s) { const pg8::bf16x8 ag = *(const LAS pg8::bf16x8*)(SG + arow * RG + 16 * s + 8 * hg);
#pragma unroll
            for (int nb = 0; nb < 2; ++nb) { const int n = h * 64 + nb * 32 + r; const pg8::bf16x8 bg = *(const pg8::bf16x8*)(G2T + n * 128 + 16 * s + 8 * hg);
                accg[nb] = __builtin_amdgcn_mfma_f32_32x32x16_bf16(ag, bg, accg[nb], 0, 0, 0); } }
        int tid3 = tid; asm volatile("" : "+v"(tid3)); const int r3 = tid3 & 31, hg3 = (tid3 >> 5) & 1, h3 = (tid3 >> 6) & 3, th3 = tid3 >> 8;
        float pw0[2], pa0[2], pmr[2], pmk[2], pmv[2], pkk[2], pka[2], prk[2];
#pragma unroll
        for (int nb = 0; nb < 2; ++nb) { const int c = h3 * 64 + nb * 32 + r3; pw0[nb] = w0[c]; pa0[nb] = a0[c]; pmr[nb] = mu[c]; pmk[nb] = mu[256 + c]; pmv[nb] = mu[512 + c]; pkk[nb] = kkw[c]; pka[nb] = kaw[c]; prk[nb] = rkw[c]; }
#pragma unroll
        for (int e = 0; e < 16; ++e) { const int tok = th3 * 32 + (e & 3) + 8 * (e >> 2) + 4 * hg3, t = t0 + tok; const size_t row = (size_t)row0 + tok; const bool hp = t > 0;
            float dec[2], kkv[2], kka[2], k2[2], rv[2], vv[2], s_kk = 0.f, s_c1 = 0.f, s_c2 = 0.f, s_bn = 0.f;
#pragma unroll
            for (int nb = 0; nb < 2; ++nb) { const int c = h3 * 64 + nb * 32 + r3; const bf16_t* pc = proj + row * PW + P_R + c;
                const float rc = bf2f(pc[0]), kc = bf2f(pc[256]), vc = bf2f(pc[512]);
                const float rp = hp ? bf2f(pc[-PW]) : 0.f, kp = hp ? bf2f(pc[256 - PW]) : 0.f, vp = hp ? bf2f(pc[512 - PW]) : 0.f;
                const float rr = rc + (rp - rc) * pmr[nb], k = kc + (kp - kc) * pmk[nb]; vv[nb] = vc + (vp - vc) * pmv[nb]; rv[nb] = rr;
                const float wl = -softplusf(-(accw[nb][e] + pw0[nb])) - 0.5f; dec[nb] = -__expf(wl); const float av        = sigm(acca[nb][e] + pa0[nb]);
                kkv[nb] = k * pkk[nb]; k2[nb] = k * (1.0f + (av - 1.0f) * pka[nb]); kka[nb] = av;
                s_kk += kkv[nb] * kkv[nb]; s_c2 += k2[nb] * rr; s_bn += rr * k2[nb] * prk[nb];
                GR[row * 256 + c] = (bf16_t)f2bf(accg[nb][e]); }
            s_kk = row16_sum(s_kk); s_kk += __shfl_xor(s_kk, 16);
            const float inv = 1.0f / fmaxf(sqrtf(s_kk), 1e-12f);
#pragma unroll
            for (int nb = 0; nb < 2; ++nb) { kkv[nb] *= inv; kka[nb] *= kkv[nb]; s_c1 += kka[nb] * rv[nb]; }
            s_c1 = row16_sum(s_c1); s_c1 += __shfl_xor(s_c1, 16); s_c2 = row16_sum(s_c2); s_c2 += __shfl_xor(s_c2, 16); s_bn = row16_sum(s_bn); s_bn += __shfl_xor(s_bn, 16);
            const size_t st = ((size_t)(b * 4 + h3) * T + t);
#pragma unroll
            for (int nb = 0; nb < 2; ++nb) { unsigned char* rb = VEC + st * RECB; const int kx = nb * 32 + r3;
                *(float*)(rb + kx * 4) = dec[nb]; *(bf16_t*)(rb + 256 + kx * 2) = (bf16_t)f2bf(-kkv[nb]); *(bf16_t*)(rb + 384 + kx * 2) = (bf16_t)f2bf(kka[nb]);
                *(bf16_t*)(rb + 512 + kx * 2) = (bf16_t)f2bf(k2[nb]); *(bf16_t*)(rb + 640 + kx * 2) = (bf16_t)f2bf(rv[nb]); *(bf16_t*)(rb + 768 + kx * 2) = (bf16_t)f2bf(vv[nb]); }
            if (r3 == 0) *(pg8::f32x4*)(SC + st * 4) = (pg8::f32x4){s_c1, s_c2, s_bn, 0.f};
            asm volatile("" ::: "memory"); }
        __syncthreads();
    }
}

__device__ __forceinline__ void ph_rwkv_scan(Frame& F, ArgsP a) {
    const unsigned char* VEC = a->ws + SCR_VEC6; float* YR = (float*)(a->ws + SCR_YR); const float* SC = (const float*)(a->ws + SCR_SC); bf16_t* STM = (bf16_t*)(a->ws + SCR_STM);
    int lane = F.lane(); asm volatile("" : "+v"(lane));
    constexpr int CH = 32, CHB = CH * RECB, NP = CHB / 1024 / 4;
    const bool stager = F.wave >= 4;
    const int vcu = (F.G % 8 == 0) ? ((int)blockIdx.x % 8) * (F.G / 8) + (int)blockIdx.x / 8 : (int)blockIdx.x;
    for (int it = vcu; it < 256; it += F.G) {
        const int bh = it >> 3, rg = it & 7, b = bh >> 2, h = bh & 3;
        const int sw = F.wave & 3, vrow = rg * 8 + 2 * sw;
        const char* src = (const char*)(VEC + (size_t)bh * T * RECB) + lane * 16;
#define RW_STAGE(cidx) do { _Pragma("unroll") for (int p_ = 0; p_ < NP; ++p_) \
            __builtin_amdgcn_global_load_lds((const unsigned*)(src + (size_t)(cidx) * CHB + (sw * NP + p_) * 1024), (LAS unsigned*)(F.lds + ((cidx) & 1) * CHB + (sw * NP + p_) * 1024), 16, 0, 0); } while (0)
        if (stager) { RW_STAGE(0); asm volatile("s_waitcnt vmcnt(0)" ::: "memory"); }
        __builtin_amdgcn_s_barrier(); asm volatile("" ::: "memory");
        float SA = 0.f, SB = 0.f;
        for (int c = 0; c < T / CH; ++c) {
            if (stager) { if (c + 1 < T / CH) { RW_STAGE(c + 1); asm volatile("s_waitcnt vmcnt(0)" ::: "memory"); } }
            else {
                const LAS unsigned char* bufb = F.lds + (c & 1) * CHB;
                STM[(((size_t)bh * 64 + c) * 64 + vrow) * 64 + lane] = (bf16_t)f2bf(SA); STM[(((size_t)bh * 64 + c) * 64 + vrow + 1) * 64 + lane] = (bf16_t)f2bf(SB);
                float zaA = 0.f, zaB = 0.f, saaA = 0.f, saaB = 0.f;
#define RW_LD(S1, nw, nnkk, nkka, nk2, nr, nvp) do { const LAS unsigned char* rec_ = bufb + (S1) * RECB; nw = *(const LAS float*)(rec_ + lane * 4); nnkk = bf2f(*(const LAS bf16_t*)(rec_ + 256 + lane * 2)); \
                    nkka = bf2f(*(const LAS bf16_t*)(rec_ + 384 + lane * 2)); nk2 = bf2f(*(const LAS bf16_t*)(rec_ + 512 + lane * 2)); nr = bf2f(*(const LAS bf16_t*)(rec_ + 640 + lane * 2)); nvp = *(const LAS unsigned*)(rec_ + 768 + vrow * 2); } while (0)
                float nw, nnkk, nkka, nk2, nr; unsigned nvp; RW_LD(0, nw, nnkk, nkka, nk2, nr, nvp);
#define RW_STEP(SI) do { \
                    const float w_ = __expf(nw), nkk = nnkk, kka = nkka, k2 = nk2, wr = w_ * nr; const pg8::f32x2 v = {__builtin_bit_cast(float, nvp << 16), __builtin_bit_cast(float, nvp & 0xffff0000u)}; \
                    RW_LD(((SI) + 1 < CH ? (SI) + 1 : (SI)), nw, nnkk, nkka, nk2, nr, nvp); \
                    asm volatile("" ::: "memory"); \
                    const auto s0 = __builtin_amdgcn_permlane32_swap(__builtin_bit_cast(unsigned, SA * nkk), __builtin_bit_cast(unsigned, SA * wr), false, false); \
                    const auto s1_ = __builtin_amdgcn_permlane32_swap(__builtin_bit_cast(unsigned, SB * nkk), __builtin_bit_cast(unsigned, SB * wr), false, false); \
                    const float xA = __builtin_bit_cast(float, (unsigned)s0[0]) + __builtin_bit_cast(float, (unsigned)s0[1]); \
                    const float xB = __builtin_bit_cast(float, (unsigned)s1_[0]) + __builtin_bit_cast(float, (unsigned)s1_[1]); \
                    const auto s2 = __builtin_amdgcn_permlane16_swap(__builtin_bit_cast(unsigned, xA), __builtin_bit_cast(unsigned, xB), false, false); \
                    float x = __builtin_bit_cast(float, (unsigned)s2[0]) + __builtin_bit_cast(float, (unsigned)s2[1]); \
                    x += dpp_mov<0xB1, 0xF>(0.f, x); x += dpp_mov<0x4E, 0xF>(0.f, x); x += dpp_mov<0x141, 0xF>(0.f, x); x += dpp_mov<0x140, 0xF>(0.f, x); \
                    const int isaA = __builtin_amdgcn_readlane(__builtin_bit_cast(int, x), 0), isaB = __builtin_amdgcn_readlane(__builtin_bit_cast(int, x), 16); \
                    const int izA = __builtin_amdgcn_readlane(__builtin_bit_cast(int, x), 32), izB = __builtin_amdgcn_readlane(__builtin_bit_cast(int, x), 48); \
                    const float saA = __builtin_bit_cast(float, isaA), saB = __builtin_bit_cast(float, isaB); \
                    SA = SA * w_ + (saA * kka + v[0] * k2); \
                    SB = SB * w_ + (saB * kka + v[1] * k2); \
                    asm volatile("v_writelane_b32 %0, %4, %8\n\tv_writelane_b32 %1, %5, %8\n\tv_writelane_b32 %2, %6, %8\n\tv_writelane_b32 %3, %7, %8" : "+v"(saaA), "+v"(saaB), "+v"(zaA), "+v"(zaB) : "s"(isaA), "s"(isaB), "s"(izA), "s"(izB), "n"(SI)); \
                } while (0)
                RW_STEP(0); RW_STEP(1); RW_STEP(2); RW_STEP(3); RW_STEP(4); RW_STEP(5); RW_STEP(6); RW_STEP(7); RW_STEP(8); RW_STEP(9); RW_STEP(10); RW_STEP(11); RW_STEP(12); RW_STEP(13); RW_STEP(14); RW_STEP(15); RW_STEP(16); RW_STEP(17); RW_STEP(18); RW_STEP(19); RW_STEP(20); RW_STEP(21); RW_STEP(22); RW_STEP(23); RW_STEP(24); RW_STEP(25); RW_STEP(26); RW_STEP(27); RW_STEP(28); RW_STEP(29); RW_STEP(30); RW_STEP(31);
#undef RW_STEP
#undef RW_LD
                const unsigned vp_ = *(const LAS unsigned*)(bufb + (lane & 31) * RECB + 768 + vrow * 2); const pg8::f32x2 vv = {__builtin_bit_cast(float, vp_ << 16), __builtin_bit_cast(float, vp_ & 0xffff0000u)};
                const pg8::f32x2 cc = *(const pg8::f32x2*)(SC + ((size_t)bh * T + c * CH + (lane & 31)) * 4);
                const float yaA = zaA + saaA * cc[0] + vv[0] * cc[1], yaB = zaB + saaB * cc[0] + vv[1] * cc[1];
                if (lane < CH) *(pg8::f32x2*)(YR + ((size_t)b * T + c * CH + lane) * 256 + h * 64 + vrow) = (pg8::f32x2){yaA, yaB};
            }
            __builtin_amdgcn_s_barrier(); asm volatile("" ::: "memory");
        }
#undef RW_STAGE
        asm volatile("s_waitcnt vmcnt(0)" ::: "memory"); __builtin_amdgcn_s_barrier(); asm volatile("" ::: "memory");
    }
}

__device__ __forceinline__ void ph_rwkv_post(Frame& F, ArgsP a, int l) {
    const unsigned char* VEC = a->ws + SCR_VEC6; const float* SC = (const float*)(a->ws + SCR_SC); const float* YR = (const float*)(a->ws + SCR_YR); const bf16_t* GR = (const bf16_t*)(a->ws + SCR_GR);
    const float* lng = (const float*)a->in[28] + l * 256; const float* lnb = (const float*)a->in[29] + l * 256;
    bf16_t* br = (bf16_t*)(a->ws + WS_HB);
    int lane = F.lane(); asm volatile("" : "+v"(lane));
    const int c = 4 * lane, h = lane >> 4;
    const pg8::f32x4 g4 = *(const pg8::f32x4*)(lng + c), b4 = *(const pg8::f32x4*)(lnb + c);
    for (int row = F.gw; row < M; row += F.NGW) {
        const int b = row / T, t = row % T; const size_t st = (size_t)(b * 4 + h) * T + t;
        const pg8::f32x4 y = *(const pg8::f32x4*)(YR + (size_t)row * 256 + c);
        const float mu = row16_sum((y[0] + y[1]) + (y[2] + y[3])) * (1.0f / 64.0f); const pg8::f32x4 d = y - mu;
        const float var = row16_sum((d[0] * d[0] + d[1] * d[1]) + (d[2] * d[2] + d[3] * d[3])) * (1.0f / 64.0f);
        const pg8::f32x4 yn = d * rsqrtf(var + 64e-5f) * g4 + b4;
        const float bonus = SC[st * 4 + 2];
        const pg8::f32x4 v = ld_bf16x4((const bf16_t*)(VEC + st * RECB + 768) + (c & 63));
        const pg8::f32x4 g = ld_bf16x4(GR + (size_t)row * 256 + c);
        st_bf16x4(br + (size_t)row * D + 768 + c, (yn + bonus * v) * g);
    }
}

__device__ __forceinline__ void ph_gla_p1(Frame& F, ArgsP a, int l) {
    const bf16_t* proj = (const bf16_t*)(a->ws + WS_PROJ); const float* w2 = (const float*)a->in[10] + l * 16 * 128; const float* gb = (const float*)a->in[11] + l * 128;
    bf16_t* QS = (bf16_t*)(a->ws + SCR_EG); float* CDp = (float*)(a->ws + SCR_EG) + (size_t)M * 128; float* GU = (float*)(a->ws + SCR_GU); float* OI = (float*)(a->ws + WS_GOI);
    const bf16_t* GZ = (const bf16_t*)(a->ws + WS_GZ);
    constexpr int RS = 40;
    LAS unsigned char* wl = F.lds + F.wave * 12800;
    LAS bf16_t* VTl = (LAS bf16_t*)wl; LAS bf16_t* Qs = (LAS bf16_t*)(wl + 5120); LAS bf16_t* Ks = (LAS bf16_t*)(wl + 7680); LAS bf16_t* KdT = (LAS bf16_t*)(wl + 10240);
    int lane = F.lane(); asm volatile("" : "+v"(lane));
    const int d = lane & 31, half = lane >> 5, r = lane & 31, hg = lane >> 5;
    for (int it = F.gw; it < 2048; it += F.NGW) {
        const int bh = it >> 6, n = it & 63, b = bh >> 2, h = bh & 3; const size_t row0 = (size_t)b * T + n * 32;
        float wc[16];
#pragma unroll
        for (int q = 0; q < 16; ++q) wc[q] = w2[q * 128 + h * 32 + d];
        const float gbv = gb[h * 32 + d];
        float g[16];
#pragma unroll
        for (int i = 0; i < 16; ++i) { const bf16_t* pr = GZ + (row0 + 16 * half + i) * 16;
            const pg8::f32x4 z0 = ld_bf16x4(pr), z1 = ld_bf16x4(pr + 4), z2 = ld_bf16x4(pr + 8), z3 = ld_bf16x4(pr + 12);
            float acc = gbv;
#pragma unroll
            for (int e = 0; e < 4; ++e) acc += z0[e] * wc[e] + z1[e] * wc[4 + e] + z2[e] * wc[8 + e] + z3[e] * wc[12 + e];
            g[i] = -softplusf(-acc) * (1.0f / 16.0f); }
#pragma unroll
        for (int i = 1; i < 16; ++i) g[i] += g[i - 1];
        const float other = __shfl(g[15], d);
        if (half) {
#pragma unroll
            for (int i = 0; i < 16; ++i) g[i] += other; }
        const float glast = __shfl(g[15], 32 + d);
#pragma unroll
        for (int i = 0; i < 16; ++i) { const int tok = 16 * half + i; const bf16_t* pr = proj + (row0 + tok) * PW;
            const float qv = bf2f(pr[P_GQ + h * 32 + d]), kv = bf2f(pr[P_GK + h * 32 + d]);
            const unsigned qb = f2bf(qv * 0.17677669529663687f * __expf(g[i]));
            Qs[tok * RS + d] = (bf16_t)qb; QS[((size_t)it * 32 + tok) * 32 + d] = (bf16_t)qb;
            Ks[tok * RS + d] = (bf16_t)f2bf(kv * __expf(-g[i])); KdT[d * RS + tok] = (bf16_t)f2bf(kv * __expf(glast - g[i])); }
        if (half) CDp[it * 32 + d] = __expf(glast);
        { const bf16_t* vp = proj + row0 * PW + P_GV + h * 64 + lane;
#pragma unroll
          for (int t2 = 0; t2 < 16; ++t2) { const unsigned lo = vp[(size_t)(2 * t2) * PW], hi = vp[(size_t)(2 * t2 + 1) * PW]; *(LAS unsigned*)(VTl + lane * RS + 2 * t2) = lo | (hi << 16); } }
        asm volatile("s_waitcnt lgkmcnt(0)" ::: "memory");
        f32x16 X;
#pragma unroll
        for (int e = 0; e < 16; ++e) X[e] = 0.f;
#pragma unroll
        for (int s = 0; s < 2; ++s) X = __builtin_amdgcn_mfma_f32_32x32x16_bf16(*(const LAS pg8::bf16x8*)(Ks + r * RS + 16 * s + 8 * hg), *(const LAS pg8::bf16x8*)(Qs + r * RS + 16 * s + 8 * hg), X, 0, 0, 0);
#pragma unroll
        for (int e = 0; e < 16; ++e) { const int jrow = (e & 3) + 8 * (e >> 2) + 4 * hg; if (jrow > r) X[e] = 0.f; }
        f32x16 oi[2], ut[2];
#pragma unroll
        for (int e = 0; e < 16; ++e) { oi[0][e] = 0.f; oi[1][e] = 0.f; ut[0][e] = 0.f; ut[1][e] = 0.f; }
#pragma unroll
        for (int s = 0; s < 2; ++s) {
            pg8::u32x4 pw; pw.x = pk2(X[8 * s], X[8 * s + 1]); pw.y = pk2(X[8 * s + 2], X[8 * s + 3]); pw.z = pk2(X[8 * s + 4], X[8 * s + 5]); pw.w = pk2(X[8 * s + 6], X[8 * s + 7]);
            const pg8::bf16x8 xf = __builtin_bit_cast(pg8::bf16x8, pw);
            const pg8::bf16x8 kdf = *(const LAS pg8::bf16x8*)(KdT + r * RS + 16 * s + 8 * hg);
#pragma unroll
            for (int db = 0; db < 2; ++db) { const LAS bf16_t* vp = VTl + (db * 32 + r) * RS + 16 * s;
                const pg8::u32x2 v0 = *(const LAS pg8::u32x2*)(vp + 4 * hg), v1 = *(const LAS pg8::u32x2*)(vp + 8 + 4 * hg);
                pg8::u32x4 vw; vw.x = v0.x; vw.y = v0.y; vw.z = v1.x; vw.w = v1.y;
                oi[db] = __builtin_amdgcn_mfma_f32_32x32x16_bf16(__builtin_bit_cast(pg8::bf16x8, vw), xf, oi[db], 0, 0, 0);
                ut[db] = __builtin_amdgcn_mfma_f32_32x32x16_bf16(*(const LAS pg8::bf16x8*)(vp + 8 * hg), kdf, ut[db], 0, 0, 0); } }
        float* op = OI + (size_t)it * 2048 + lane;
#pragma unroll
        for (int db = 0; db < 2; ++db)
#pragma unroll
            for (int e = 0; e < 16; ++e) op[(db * 16 + e) * 64] = oi[db][e];
        float* up = GU + ((size_t)it * 32 + r) * 64 + 4 * hg;
#pragma unroll
        for (int db = 0; db < 2; ++db)
#pragma unroll
            for (int q = 0; q < 4; ++q) *(pg8::f32x4*)(up + db * 32 + 8 * q) = (pg8::f32x4){ut[db][4 * q], ut[db][4 * q + 1], ut[db][4 * q + 2], ut[db][4 * q + 3]};
        asm volatile("s_waitcnt lgkmcnt(0)" ::: "memory");
    }
}
__device__ __forceinline__ void ph_gla_prefix(Frame& F, ArgsP a) {
    const float* CDp = (const float*)(a->ws + SCR_EG) + (size_t)M * 128; const float* GU = (const float*)(a->ws + SCR_GU); bf16_t* ST = (bf16_t*)(a->ws + WS_GST);
    int lane = F.lane(); asm volatile("" : "+v"(lane));
    for (int it = F.gw; it < 1024; it += F.NGW) { const int bh = it >> 5, d = it & 31;
        const float* gp = GU + ((size_t)bh * 64 * 32 + d) * 64 + lane; const float* cp = CDp + (size_t)bh * 64 * 32 + d;
        bf16_t* sp = ST + ((size_t)bh * 64 * 64 + lane) * 32 + d;
        float u[64], cd[64];
#pragma unroll
        for (int n = 0; n < 64; ++n) { u[n] = gp[(size_t)n * 2048]; cd[n] = cp[n * 32]; }
        float S = 0.f;
#pragma unroll
        for (int n = 0; n < 64; ++n) { sp[(size_t)n * 2048] = (bf16_t)f2bf(S); S = cd[n] * S + u[n]; } }
}
__device__ __forceinline__ void ph_gla_p2(Frame& F, ArgsP a, int l) {
    const bf16_t* proj = (const bf16_t*)(a->ws + WS_PROJ); const float* gnorm = (const float*)a->in[12] + l * 64;
    const bf16_t* QS = (const bf16_t*)(a->ws + SCR_EG); const bf16_t* ST = (const bf16_t*)(a->ws + WS_GST); const float* OI = (const float*)(a->ws + WS_GOI); bf16_t* br = (bf16_t*)(a->ws + WS_HB);
    int lane = F.lane(); asm volatile("" : "+v"(lane));
    const int r = lane & 31, hg = lane >> 5;
    for (int it = F.gw; it < 2048; it += F.NGW) {
        const int bh = it >> 6, n = it & 63, b = bh >> 2, h = bh & 3; const size_t row0 = (size_t)b * T + n * 32;
        f32x16 ot[2]; const float* op = OI + (size_t)it * 2048 + lane;
#pragma unroll
        for (int db = 0; db < 2; ++db)
#pragma unroll
            for (int e = 0; e < 16; ++e) ot[db][e] = op[(db * 16 + e) * 64];
#pragma unroll
        for (int s = 0; s < 2; ++s) { const pg8::bf16x8 qf = *(const pg8::bf16x8*)(QS + ((size_t)it * 32 + r) * 32 + 16 * s + 8 * hg);
#pragma unroll
            for (int db = 0; db < 2; ++db) ot[db] = __builtin_amdgcn_mfma_f32_32x32x16_bf16(*(const pg8::bf16x8*)(ST + ((size_t)it * 64 + db * 32 + r) * 32 + 16 * s + 8 * hg), qf, ot[db], 0, 0, 0); }
        float ss = 0.f;
#pragma unroll
        for (int db = 0; db < 2; ++db)
#pragma unroll
            for (int e = 0; e < 16; ++e) ss += ot[db][e] * ot[db][e];
        ss += __shfl_xor(ss, 32);
        const float rstd = rsqrtf(ss * (1.0f / 64.0f) + 1e-6f);
        const bf16_t* og = proj + (row0 + r) * PW + P_GO + h * 64 + 4 * hg; bf16_t* od = br + (row0 + r) * D + h * 64 + 4 * hg;
#pragma unroll
        for (int db = 0; db < 2; ++db)
#pragma unroll
            for (int q = 0; q < 4; ++q) { const int dv0 = db * 32 + 8 * q; const pg8::f32x4 gv = ld_bf16x4(og + dv0), gn = *(const pg8::f32x4*)(gnorm + dv0 + 4 * hg);
                st_bf16x4(od + dv0, (pg8::f32x4){ot[db][4 * q] * rstd * gn[0] * siluf(gv[0]), ot[db][4 * q + 1] * rstd * gn[1] * siluf(gv[1]), ot[db][4 * q + 2] * rstd * gn[2] * siluf(gv[2]), ot[db][4 * q + 3] * rstd * gn[3] * siluf(gv[3])}); }
    }
}

__device__ __forceinline__ void ph_attn_prep(Frame& F, ArgsP a) {
    const bf16_t* proj = (const bf16_t*)(a->ws + WS_PROJ); const int* pos = (const int*)a->in[2];
    bf16_t* QR = (bf16_t*)(a->ws + SCR_QK); bf16_t* KR = QR + (size_t)M * 256; bf16_t* VT = (bf16_t*)(a->ws + SCR_VT);
    int lane = F.lane(); asm volatile("" : "+v"(lane));
    for (int idx = F.gw * 64 + lane; idx < M * 8; idx += F.NGW * 64) { const int row = idx >> 3, hc = idx & 7; const float p = (float)pos[row];
        const bf16_t* qs = proj + (size_t)row * PW + P_DQ + hc * 32; const bf16_t* ks = proj + (size_t)row * PW + P_DK + hc * 32;
        float qv[32], kv[32];
#pragma unroll
        for (int j = 0; j < 8; ++j) { const pg8::f32x4 q4 = ld_bf16x4(qs + 4 * j), k4 = ld_bf16x4(ks + 4 * j);
#pragma unroll
            for (int e = 0; e < 4; ++e) { qv[4 * j + e] = q4[e]; kv[4 * j + e] = k4[e]; } }
        float qo[32], ko[32];
#pragma unroll
        for (int i = 0; i < 16; ++i) { const float inv = exp2f(-(float)i * 0.8304820237218406f);
            float sn, cs; sincosf(p * inv, &sn, &cs);
            qo[i] = qv[i] * cs - qv[i + 16] * sn; qo[i + 16] = qv[i] * sn + qv[i + 16] * cs;
            ko[i] = kv[i] * cs - kv[i + 16] * sn; ko[i + 16] = kv[i] * sn + kv[i + 16] * cs; }
        const float qsc = 0.17677669529663687f * 1.4426950408889634f;
        bf16_t* qd = QR + (size_t)row * 256 + hc * 32; bf16_t* kd = KR + (size_t)row * 256 + hc * 32;
#pragma unroll
        for (int j = 0; j < 8; ++j) { st_bf16x4(qd + 4 * j, (pg8::f32x4){qo[4 * j] * qsc, qo[4 * j + 1] * qsc, qo[4 * j + 2] * qsc, qo[4 * j + 3] * qsc});
            st_bf16x4(kd + 4 * j, (pg8::f32x4){ko[4 * j], ko[4 * j + 1], ko[4 * j + 2], ko[4 * j + 3]}); } }
    for (int it = F.gw; it < 1024; it += F.NGW) { const int bh = it >> 5, tt = it & 31, b = bh >> 2, h = bh & 3;
        const bf16_t* vs = proj + ((size_t)b * T + tt * 64 + lane) * PW + P_DV + h * 64;
        pg8::u32x4 v[8];
#pragma unroll
        for (int j = 0; j < 8; ++j) v[j] = *(const pg8::u32x4*)(vs + 8 * j);
        bf16_t* vd = VT + (size_t)bh * 64 * T + tt * 64 + lane;
#pragma unroll
        for (int j = 0; j < 8; ++j)
#pragma unroll
            for (int e = 0; e < 4; ++e) { const unsigned w = v[j][e]; vd[(size_t)(8 * j + 2 * e) * T] = (bf16_t)(w & 0xffffu); vd[(size_t)(8 * j + 2 * e + 1) * T] = (bf16_t)(w >> 16); } }
}
__device__ __forceinline__ void ph_attn(Frame& F, ArgsP a, int l) {
    const bf16_t* QR = (const bf16_t*)(a->ws + SCR_QK); const bf16_t* KR = QR + (size_t)M * 256; const bf16_t* VT = (const bf16_t*)(a->ws + SCR_VT);
    const float* lp = (const float*)a->in[13] + l * 128; const float* subln = (const float*)a->in[14] + l * 64; bf16_t* br = (bf16_t*)(a->ws + WS_HB);
    int tid = F.wave * 64 + F.lane(); asm volatile("" : "+v"(tid)); const int lane = tid & 63;
    const int r = lane & 31, hg = lane >> 5, comp = F.wave & 1, qs = F.wave >> 1;
    constexpr int RS = 72;
    LAS bf16_t* Kt = (LAS bf16_t*)F.lds;
    LAS bf16_t* Vt = Kt + 2 * 64 * RS;
    LAS float* Xl = (LAS float*)(F.lds + 4 * 64 * RS * 2);
    float lam, lam_init;
    { float d01 = 0.f, d23 = 0.f;
      for (int i = 0; i < 32; ++i) { d01 += lp[i] * lp[32 + i]; d23 += lp[64 + i] * lp[96 + i]; }
      lam_init = 0.8f - 0.6f * __expf(-0.3f * (float)l); lam = __expf(d01) - __expf(d23) + lam_init; }
    const int ldrow = tid >> 3, ldch = tid & 7;
    const int vcu = (F.G % 8 == 0) ? ((int)blockIdx.x % 8) * (F.G / 8) + (int)blockIdx.x / 8 : (int)blockIdx.x;
    for (int pi = vcu; pi < 256; pi += F.G) {
#pragma unroll 1
        for (int half = 0; half < 2; ++half) {
            const int bh = pi >> 3, j = pi & 7, qb = half == 0 ? 15 - j : j, b = bh >> 2, h = bh & 3;
            const int q0 = qb * 128 + qs * 32, nkw = q0 / 64 + 1, nkb = 2 * qb + 2;
            const size_t rowb = (size_t)b * T;
            pg8::bf16x8 qf[2];
#pragma unroll
            for (int s = 0; s < 2; ++s) qf[s] = *(const pg8::bf16x8*)(QR + (rowb + q0 + r) * 256 + h * 64 + comp * 32 + 16 * s + 8 * hg);
            f32x16 ot[2];
#pragma unroll
            for (int e = 0; e < 16; ++e) { ot[0][e] = 0.f; ot[1][e] = 0.f; }
            float mrun = -1e30f, lrun = 0.f;
            const bf16_t* kg = KR + (rowb + ldrow) * 256 + h * 64 + ldch * 8; const bf16_t* vg = VT + ((size_t)bh * 64 + ldrow) * T + ldch * 8;
            pg8::u32x4 kreg = *(const pg8::u32x4*)kg, vreg = *(const pg8::u32x4*)vg;
            pg8::u32x4 kreg2 = kreg, vreg2 = vreg;
            if (nkb > 1) { kreg2 = *(const pg8::u32x4*)(kg + (size_t)64 * 256); vreg2 = *(const pg8::u32x4*)(vg + 64); }
            for (int kt = 0; kt < nkb; ++kt) {
                const int bo = (kt & 1) * 64 * RS;
                *(LAS pg8::u32x4*)(Kt + bo + ldrow * RS + ldch * 8) = kreg; *(LAS pg8::u32x4*)(Vt + bo + ldrow * RS + ldch * 8) = vreg;
                __syncthreads();
                kreg = kreg2; vreg = vreg2;
                if (kt + 2 < nkb) { kreg2 = *(const pg8::u32x4*)(kg + (size_t)(kt + 2) * 64 * 256); vreg2 = *(const pg8::u32x4*)(vg + (kt + 2) * 64); }
                if (kt < nkw) {
                    f32x16 st[2];
#pragma unroll
                    for (int kb = 0; kb < 2; ++kb) {
#pragma unroll
                        for (int e = 0; e < 16; ++e) st[kb][e] = 0.f;
#pragma unroll
                        for (int s = 0; s < 2; ++s) { const pg8::bf16x8 kf = *(const LAS pg8::bf16x8*)(Kt + bo + (kb * 32 + r) * RS + comp * 32 + 16 * s + 8 * hg);
                            st[kb] = __builtin_amdgcn_mfma_f32_32x32x16_bf16(kf, qf[s], st[kb], 0, 0, 0); } }
                    if (kt == nkw - 1) {
                        const int qi = q0 + r;
#pragma unroll
                        for (int kb = 0; kb < 2; ++kb)
#pragma unroll
                            for (int e = 0; e < 16; ++e) { const int ki = kt * 64 + kb * 32 + (e & 3) + 8 * (e >> 2) + 4 * hg; if (ki > qi) st[kb][e] = -1e30f; } }
                    float tm = st[0][0];
#pragma unroll
                    for (int e = 1; e < 16; ++e) tm = fmaxf(tm, st[0][e]);
#pragma unroll
                    for (int e = 0; e < 16; ++e) tm = fmaxf(tm, st[1][e]);
                    { const auto sw = __builtin_amdgcn_permlane32_swap(__builtin_bit_cast(unsigned, tm), __builtin_bit_cast(unsigned, tm), false, false); tm = fmaxf(__builtin_bit_cast(float, (unsigned)sw[0]), __builtin_bit_cast(float, (unsigned)sw[1])); }
                    const float mn = fmaxf(mrun, tm), alpha = __builtin_amdgcn_exp2f(mrun - mn); mrun = mn;
                    float ps = 0.f;
#pragma unroll
                    for (int kb = 0; kb < 2; ++kb)
#pragma unroll
                        for (int e = 0; e < 16; ++e) { st[kb][e] = __builtin_amdgcn_exp2f(st[kb][e] - mn); ps += st[kb][e]; }
                    lrun = lrun * alpha + ps;
#pragma unroll
                    for (int e = 0; e < 16; ++e) { ot[0][e] *= alpha; ot[1][e] *= alpha; }
#pragma unroll
                    for (int kb = 0; kb < 2; ++kb)
#pragma unroll
                        for (int s = 0; s < 2; ++s) {
                            pg8::u32x4 pw; pw.x = pk2(st[kb][8 * s], st[kb][8 * s + 1]); pw.y = pk2(st[kb][8 * s + 2], st[kb][8 * s + 3]); pw.z = pk2(st[kb][8 * s + 4], st[kb][8 * s + 5]); pw.w = pk2(st[kb][8 * s + 6], st[kb][8 * s + 7]);
                            const pg8::bf16x8 pf = __builtin_bit_cast(pg8::bf16x8, pw);
#pragma unroll
                            for (int dvb = 0; dvb < 2; ++dvb) { const LAS bf16_t* vp = Vt + bo + (dvb * 32 + r) * RS + kb * 32 + 16 * s + 4 * hg;
                                const pg8::u32x2 v0 = *(const LAS pg8::u32x2*)vp, v1 = *(const LAS pg8::u32x2*)(vp + 8);
                                pg8::u32x4 vw; vw.x = v0.x; vw.y = v0.y; vw.z = v1.x; vw.w = v1.y;
                                ot[dvb] = __builtin_amdgcn_mfma_f32_32x32x16_bf16(__builtin_bit_cast(pg8::bf16x8, vw), pf, ot[dvb], 0, 0, 0); } }
                }
            }
            const float ltot = lrun + __shfl_xor(lrun, 32); const float il = 1.0f / ltot;
            __syncthreads();
            if (comp == 1) {
#pragma unroll
                for (int dvb = 0; dvb < 2; ++dvb)
#pragma unroll
                    for (int e = 0; e < 16; ++e) Xl[(qs * 32 + dvb * 16 + e) * 64 + lane] = ot[dvb][e] * il; }
            __syncthreads();
            if (comp == 0) {
                float o[32]; float ss = 0.f;
#pragma unroll
                for (int dvb = 0; dvb < 2; ++dvb)
#pragma unroll
                    for (int e = 0; e < 16; ++e) { const float v = ot[dvb][e] * il - lam * Xl[(qs * 32 + dvb * 16 + e) * 64 + lane]; o[dvb * 16 + e] = v; ss += v * v; }
                ss += __shfl_xor(ss, 32);
                const float sc = rsqrtf(ss * (1.0f / 64.0f) + 1e-6f) * (1.0f - lam_init);
                bf16_t* od = br + (rowb + q0 + r) * D + 256 + h * 64;
#pragma unroll
                for (int dvb = 0; dvb < 2; ++dvb)
#pragma unroll
                    for (int g4 = 0; g4 < 4; ++g4) { const int dv0 = dvb * 32 + 8 * g4 + 4 * hg; const pg8::f32x4 sl = *(const pg8::f32x4*)(subln + dv0);
                        st_bf16x4(od + dv0, (pg8::f32x4){o[dvb * 16 + 4 * g4] * sc * sl[0], o[dvb * 16 + 4 * g4 + 1] * sc * sl[1], o[dvb * 16 + 4 * g4 + 2] * sc * sl[2], o[dvb * 16 + 4 * g4 + 3] * sc * sl[3]}); }
            }
            __syncthreads();
        }
    }
}

__device__ __forceinline__ void ph_branch(Frame& F, ArgsP a, int l) {
    const bf16_t* br = (const bf16_t*)(a->ws + WS_HB); const bf16_t* WB = (const bf16_t*)(a->ws + WS_WB) + (size_t)l * 4096 * 256;
    const bf16_t* proj = (const bf16_t*)(a->ws + WS_PROJ); bf16_t* MB = (bf16_t*)(a->ws + SCR_MB);
    int tid = F.wave * 64 + F.lane(); asm volatile("" : "+v"(tid)); const int lane = tid & 63;
    const int r = lane & 31, hg = lane >> 5, wt = (tid >> 6) & 3, wd = tid >> 8;
    constexpr int RS = 72, TB = 128 * RS;
    LAS bf16_t* Wl = (LAS bf16_t*)F.lds;
    LAS bf16_t* Bl = Wl + 2 * TB;
    const int ldr = tid >> 3, ldc = (tid & 7) * 8;
    for (int it = blockIdx.x; it < 1024; it += F.G) {
        const int tm = it >> 3, td = it & 7; const size_t row0 = (size_t)tm * 128; const int d0 = td * 128;
        f32x16 tot[2], acc[2];
#pragma unroll
        for (int e = 0; e < 16; ++e) { tot[0][e] = 0.f; tot[1][e] = 0.f; acc[0][e] = 0.f; acc[1][e] = 0.f; }
        pg8::u32x4 rw0, rw1, rb0, rb1;
#define BR_LOAD(st) do { const int g_ = (st) >> 2, kq_ = (st) & 3; const bf16_t* wp = WB + (size_t)(g_ * 1024 + d0 + ldr) * 256 + kq_ * 64 + ldc; const bf16_t* bp = br + (row0 + ldr) * D + g_ * 256 + kq_ * 64 + ldc; \
            rw0 = *(const pg8::u32x4*)wp; rw1 = *(const pg8::u32x4*)(wp + 64 * 256); rb0 = *(const pg8::u32x4*)bp; rb1 = *(const pg8::u32x4*)(bp + 64 * D); } while (0)
#define BR_WRITE(buf) do { *(LAS pg8::u32x4*)(Wl + (buf) * TB + ldr * RS + ldc) = rw0; *(LAS pg8::u32x4*)(Wl + (buf) * TB + (ldr + 64) * RS + ldc) = rw1; \
            *(LAS pg8::u32x4*)(Bl + (buf) * TB + ldr * RS + ldc) = rb0; *(LAS pg8::u32x4*)(Bl + (buf) * TB + (ldr + 64) * RS + ldc) = rb1; } while (0)
        BR_LOAD(0); BR_WRITE(0); __syncthreads(); BR_LOAD(1);
        pg8::u32x2 gt[2][4];
#pragma unroll 1
        for (int st = 0; st < 16; ++st) {
            const int buf = st & 1, g = st >> 2;
            if ((st & 3) == 0) {
                const bf16_t* gp = proj + (row0 + wt * 32 + r) * PW + P_GATE + g * 1024 + d0 + wd * 64 + 4 * hg;
#pragma unroll
                for (int db = 0; db < 2; ++db)
#pragma unroll
                    for (int q = 0; q < 4; ++q) gt[db][q] = *(const pg8::u32x2*)(gp + db * 32 + 8 * q); }
#pragma unroll
            for (int s = 0; s < 4; ++s) { const pg8::bf16x8 bf = *(const LAS pg8::bf16x8*)(Bl + buf * TB + (wt * 32 + r) * RS + 16 * s + 8 * hg);
#pragma unroll
                for (int db = 0; db < 2; ++db) { const pg8::bf16x8 af = *(const LAS pg8::bf16x8*)(Wl + buf * TB + (wd * 64 + db * 32 + r) * RS + 16 * s + 8 * hg);
                    acc[db] = __builtin_amdgcn_mfma_f32_32x32x16_bf16(af, bf, acc[db], 0, 0, 0); } }
            if (st + 1 < 16) BR_WRITE(buf ^ 1);
            if (st + 2 < 16) BR_LOAD(st + 2);
            if ((st & 3) == 3) {
#pragma unroll
                for (int db = 0; db < 2; ++db)
#pragma unroll
                    for (int q = 0; q < 4; ++q) { const pg8::u32x2 w = gt[db][q];
                        const float g0 = __builtin_bit_cast(float, w.x << 16), g1 = __builtin_bit_cast(float, w.x & 0xffff0000u), g2 = __builtin_bit_cast(float, w.y << 16), g3 = __builtin_bit_cast(float, w.y & 0xffff0000u);
                        tot[db][4 * q] += acc[db][4 * q] * sigm(g0); tot[db][4 * q + 1] += acc[db][4 * q + 1] * sigm(g1); tot[db][4 * q + 2] += acc[db][4 * q + 2] * sigm(g2); tot[db][4 * q + 3] += acc[db][4 * q + 3] * sigm(g3);
                        acc[db][4 * q] = 0.f; acc[db][4 * q + 1] = 0.f; acc[db][4 * q + 2] = 0.f; acc[db][4 * q + 3] = 0.f; } }
            __syncthreads();
        }
#undef BR_LOAD
#undef BR_WRITE
        bf16_t* mp = MB + (row0 + wt * 32 + r) * D + d0 + wd * 64 + 4 * hg;
#pragma unroll
        for (int db = 0; db < 2; ++db)
#pragma unroll
            for (int q = 0; q < 4; ++q) st_bf16x4(mp + db * 32 + 8 * q, (pg8::f32x4){tot[db][4 * q], tot[db][4 * q + 1], tot[db][4 * q + 2], tot[db][4 * q + 3]});
    }
}

__device__ __forceinline__ int crow(int e, int hg) { return (e & 3) + 8 * (e >> 2) + 4 * hg; }
__device__ __forceinline__ void ph_rk_p1(Frame& F, ArgsP a) {
    if (F.wave >= 4) return;
    const unsigned char* VEC = a->ws + SCR_VEC6;
    bf16_t* QE = (bf16_t*)(a->ws + SCR_QE); bf16_t* AY = (bf16_t*)(a->ws + SCR_AY); bf16_t* VTC = (bf16_t*)(a->ws + SCR_VTC); bf16_t* GMF = (bf16_t*)(a->ws + SCR_GMF); bf16_t* ZB = (bf16_t*)(a->ws + SCR_ZB);
    LAS unsigned char* wl = F.lds + F.wave * 40448;
    LAS bf16_t* TA = (LAS bf16_t*)wl;
    LAS bf16_t* TK = (LAS bf16_t*)(wl + 4608);
    LAS bf16_t* TR = (LAS bf16_t*)(wl + 9216);
    LAS bf16_t* TB = (LAS bf16_t*)(wl + 13824);
    LAS bf16_t* TBT = (LAS bf16_t*)(wl + 18432);
    LAS bf16_t* TKT = (LAS bf16_t*)(wl + 23552);
    LAS bf16_t* TVT = (LAS bf16_t*)(wl + 28672);
    LAS bf16_t* MRB = (LAS bf16_t*)(wl + 33792);
    LAS bf16_t* W2T = (LAS bf16_t*)(wl + 36352);
    LAS float* GC = (LAS float*)(wl + 38912);
    LAS float* LabF = (LAS float*)(wl + 4608); LAS float* LakF = (LAS float*)(wl + 13824); LAS bf16_t* W1T = (LAS bf16_t*)wl; LAS bf16_t* GST = (LAS bf16_t*)(wl + 9216); LAS bf16_t* HM = TKT;
    int lane0 = F.lane(); asm volatile("" : "+v"(lane0));
#define RK_LANES() int lane = lane0; asm volatile("" : "+v"(lane)); const int r = lane & 31, hg = lane >> 5; (void)r; (void)hg
    for (int it = (int)blockIdx.x * 4 + F.wave; it < 2048; it += F.G * 4) {
        const unsigned char* rec0 = VEC + (size_t)it * 32 * RECB;
        f32x16 mrk;
        {
            RK_LANES();
        { float G = 0.f, gprev = 1.f;
#pragma unroll 16
          for (int t = 0; t < 32; ++t) { const unsigned char* rp = rec0 + t * RECB;
              const float lw = *(const float*)(rp + lane * 4); const float av = bf2f(*(const bf16_t*)(rp + 256 + lane * 2)), bv = bf2f(*(const bf16_t*)(rp + 384 + lane * 2)), kv = bf2f(*(const bf16_t*)(rp + 512 + lane * 2)), rv = bf2f(*(const bf16_t*)(rp + 640 + lane * 2));
              const bf16_t vraw = *(const bf16_t*)(rp + 768 + lane * 2);
              G += lw; const float gam = __expf(G), inv = __builtin_amdgcn_rcpf(gam);
              const bf16_t bt = (bf16_t)f2bf(bv * inv), kt = (bf16_t)f2bf(kv * inv);
              TA[t * 72 + lane] = (bf16_t)f2bf(av * gprev); TR[t * 72 + lane] = (bf16_t)f2bf(rv * gam); TB[t * 72 + lane] = bt; TK[t * 72 + lane] = kt;
              TBT[lane * 40 + t] = bt; TKT[lane * 40 + t] = kt; TVT[lane * 40 + t] = vraw; gprev = gam; }
          GC[lane] = gprev; }
        asm volatile("s_waitcnt lgkmcnt(0)" ::: "memory");
#pragma unroll
        for (int q = 0; q < 4; ++q) *(pg8::u32x4*)(VTC + ((size_t)it * 64 + lane) * 32 + 8 * q) = *(const LAS pg8::u32x4*)(TVT + lane * 40 + 8 * q);
        }
        {
            RK_LANES();
        f32x16 lab, lak, mrb;
#pragma unroll
        for (int e = 0; e < 16; ++e) { lab[e] = 0.f; lak[e] = 0.f; mrb[e] = 0.f; mrk[e] = 0.f; }
#pragma unroll
        for (int s = 0; s < 4; ++s) { const int o = r * 72 + 16 * s + 8 * hg;
            const pg8::bf16x8 fa = *(const LAS pg8::bf16x8*)(TA + o), fr = *(const LAS pg8::bf16x8*)(TR + o), fb = *(const LAS pg8::bf16x8*)(TB + o), fk = *(const LAS pg8::bf16x8*)(TK + o);
            lab = __builtin_amdgcn_mfma_f32_32x32x16_bf16(fa, fb, lab, 0, 0, 0); lak = __builtin_amdgcn_mfma_f32_32x32x16_bf16(fa, fk, lak, 0, 0, 0);
            mrb = __builtin_amdgcn_mfma_f32_32x32x16_bf16(fr, fb, mrb, 0, 0, 0); mrk = __builtin_amdgcn_mfma_f32_32x32x16_bf16(fr, fk, mrk, 0, 0, 0); }
#pragma unroll
        for (int e = 0; e < 16; ++e) { const int t = crow(e, hg);
            LabF[t * 36 + r] = (r < t) ? lab[e] : 0.f; LakF[t * 36 + r] = (r < t) ? lak[e] : 0.f;
            MRB[t * 40 + r] = (bf16_t)f2bf((r <= t) ? mrb[e] : 0.f); mrk[e] = (r <= t) ? mrk[e] : 0.f; }
        asm volatile("s_waitcnt lgkmcnt(0)" ::: "memory");
        }
        {
            RK_LANES();
        { float W1[32], W2[32];
          W1[0] = bf2f(TA[lane]); W2[0] = LakF[r];
          unsigned dep = 0u;
#pragma unroll
          for (int t = 1; t < 32; ++t) { asm volatile("" : "+v"(dep) : "v"(W1[t - 1]), "v"(W2[t - 1]));
              const LAS float* Lr = LabF + t * 36 + dep;
              float s1 = bf2f(TA[t * 72 + lane + dep]), s2 = LakF[t * 36 + r + dep];
#pragma unroll
              for (int j4 = 0; j4 < (t + 3) / 4; ++j4) { const pg8::f32x4 L4 = *(const LAS pg8::f32x4*)(Lr + 4 * j4);
#pragma unroll
                  for (int q = 0; q < 4; ++q) if (4 * j4 + q < t) { s1 = __builtin_fmaf(L4[q], W1[4 * j4 + q], s1); s2 = __builtin_fmaf(L4[q], W2[4 * j4 + q], s2); } }
              W1[t] = s1; W2[t] = s2; }
          asm volatile("s_waitcnt lgkmcnt(0)" ::: "memory");
#pragma unroll
          for (int q = 0; q < 4; ++q) { *(LAS pg8::u32x4*)(W1T + lane * 40 + 8 * q) = (pg8::u32x4){pk2(W1[8 * q], W1[8 * q + 1]), pk2(W1[8 * q + 2], W1[8 * q + 3]), pk2(W1[8 * q + 4], W1[8 * q + 5]), pk2(W1[8 * q + 6], W1[8 * q + 7])};
              if (lane < 32) *(LAS pg8::u32x4*)(W2T + lane * 40 + 8 * q) = (pg8::u32x4){pk2(W2[8 * q], W2[8 * q + 1]), pk2(W2[8 * q + 2], W2[8 * q + 3]), pk2(W2[8 * q + 4], W2[8 * q + 5]), pk2(W2[8 * q + 6], W2[8 * q + 7])}; } }
        asm volatile("s_waitcnt lgkmcnt(0)" ::: "memory");
        }
        {
            RK_LANES();
#pragma unroll
        for (int kb = 0; kb < 2; ++kb) { f32x16 acc;
#pragma unroll
            for (int e = 0; e < 16; ++e) acc[e] = bf2f(TR[crow(e, hg) * 72 + kb * 32 + r]);
#pragma unroll
            for (int s = 0; s < 2; ++s) acc = __builtin_amdgcn_mfma_f32_32x32x16_bf16(*(const LAS pg8::bf16x8*)(MRB + r * 40 + 16 * s + 8 * hg), *(const LAS pg8::bf16x8*)(W1T + (kb * 32 + r) * 40 + 16 * s + 8 * hg), acc, 0, 0, 0);
#pragma unroll
            for (int e = 0; e < 16; ++e) QE[((size_t)it * 32 + crow(e, hg)) * 64 + kb * 32 + r] = (bf16_t)f2bf(acc[e]); }
        }
        {
            RK_LANES();
        { f32x16 acc = mrk;
#pragma unroll
          for (int s = 0; s < 2; ++s) acc = __builtin_amdgcn_mfma_f32_32x32x16_bf16(*(const LAS pg8::bf16x8*)(MRB + r * 40 + 16 * s + 8 * hg), *(const LAS pg8::bf16x8*)(W2T + r * 40 + 16 * s + 8 * hg), acc, 0, 0, 0);
#pragma unroll
          for (int e = 0; e < 16; ++e) AY[((size_t)it * 32 + crow(e, hg)) * 32 + r] = (bf16_t)f2bf(acc[e]); }
        asm volatile("s_waitcnt lgkmcnt(0)" ::: "memory");
        }
        {
            RK_LANES();
#pragma unroll
        for (int kbr = 0; kbr < 2; ++kbr)
#pragma unroll
            for (int kb = 0; kb < 2; ++kb) { f32x16 acc;
#pragma unroll
                for (int e = 0; e < 16; ++e) acc[e] = 0.f;
#pragma unroll
                for (int s = 0; s < 2; ++s) acc = __builtin_amdgcn_mfma_f32_32x32x16_bf16(*(const LAS pg8::bf16x8*)(TBT + (kbr * 32 + r) * 40 + 16 * s + 8 * hg), *(const LAS pg8::bf16x8*)(W1T + (kb * 32 + r) * 40 + 16 * s + 8 * hg), acc, 0, 0, 0);
#pragma unroll
                for (int e = 0; e < 16; ++e) { const int kr = kbr * 32 + crow(e, hg); const float dl = (kbr == kb && crow(e, hg) == r) ? 1.f : 0.f;
                    GST[kr * 72 + kb * 32 + r] = (bf16_t)f2bf(GC[kr] * (acc[e] + dl)); } }
        asm volatile("s_waitcnt lgkmcnt(0)" ::: "memory");
#pragma unroll
        for (int kbr = 0; kbr < 2; ++kbr)
#pragma unroll
            for (int kb = 0; kb < 2; ++kb)
#pragma unroll
                for (int s = 0; s < 2; ++s) { const LAS bf16_t* p = GST + (kbr * 32 + r) * 72 + kb * 32 + 16 * s;
                    const pg8::u32x2 v0 = *(const LAS pg8::u32x2*)(p + 4 * hg), v1 = *(const LAS pg8::u32x2*)(p + 8 + 4 * hg);
                    *(pg8::u32x4*)(GMF + (((size_t)it * 8 + (kbr * 2 + kb) * 2 + s) * 64 + lane) * 8) = (pg8::u32x4){v0.x, v0.y, v1.x, v1.y}; }
        }
        {
            RK_LANES();
#pragma unroll
        for (int kbr = 0; kbr < 2; ++kbr) { f32x16 acc;
#pragma unroll
            for (int e = 0; e < 16; ++e) acc[e] = bf2f(TKT[(kbr * 32 + crow(e, hg)) * 40 + r]);
#pragma unroll
            for (int s = 0; s < 2; ++s) acc = __builtin_amdgcn_mfma_f32_32x32x16_bf16(*(const LAS pg8::bf16x8*)(TBT + (kbr * 32 + r) * 40 + 16 * s + 8 * hg), *(const LAS pg8::bf16x8*)(W2T + r * 40 + 16 * s + 8 * hg), acc, 0, 0, 0);
            asm volatile("s_waitcnt lgkmcnt(0)" ::: "memory");
#pragma unroll
            for (int e = 0; e < 16; ++e) { const int kr = kbr * 32 + crow(e, hg); HM[kr * 40 + r] = (bf16_t)f2bf(GC[kr] * acc[e]); } }
        asm volatile("s_waitcnt lgkmcnt(0)" ::: "memory");
        }
        {
            RK_LANES();
#pragma unroll
        for (int vb = 0; vb < 2; ++vb)
#pragma unroll
            for (int kbr = 0; kbr < 2; ++kbr) { f32x16 acc;
#pragma unroll
                for (int e = 0; e < 16; ++e) acc[e] = 0.f;
#pragma unroll
                for (int s = 0; s < 2; ++s) acc = __builtin_amdgcn_mfma_f32_32x32x16_bf16(*(const LAS pg8::bf16x8*)(HM + (kbr * 32 + r) * 40 + 16 * s + 8 * hg), *(const LAS pg8::bf16x8*)(TVT + (vb * 32 + r) * 40 + 16 * s + 8 * hg), acc, 0, 0, 0);
                pg8::u32x4* zp = (pg8::u32x4*)(ZB + ((((size_t)it * 2 + vb) * 2 + kbr) * 64 + lane) * 16);
                zp[0] = (pg8::u32x4){pk2(acc[0], acc[1]), pk2(acc[2], acc[3]), pk2(acc[4], acc[5]), pk2(acc[6], acc[7])}; zp[1] = (pg8::u32x4){pk2(acc[8], acc[9]), pk2(acc[10], acc[11]), pk2(acc[12], acc[13]), pk2(acc[14], acc[15])}; }
        }
        asm volatile("s_waitcnt lgkmcnt(0)" ::: "memory");
    }
}
#undef RK_LANES
__device__ __forceinline__ void ph_rk_p2(Frame& F, ArgsP a) {
    if (F.wave != 0 || (int)blockIdx.x >= 64) return;
    const bf16_t* GMF = (const bf16_t*)(a->ws + SCR_GMF); const bf16_t* ZB = (const bf16_t*)(a->ws + SCR_ZB); bf16_t* STM = (bf16_t*)(a->ws + SCR_STM);
    int lane = F.lane(); asm volatile("" : "+v"(lane));
    const int r = lane & 31, hg = lane >> 5;
    const int bh = (int)blockIdx.x >> 1, vb = (int)blockIdx.x & 1;
    f32x16 st[2];
#pragma unroll
    for (int e = 0; e < 16; ++e) { st[0][e] = 0.f; st[1][e] = 0.f; }
    const char* gsrc = (const char*)(GMF + (size_t)bh * 64 * 8 * 64 * 8) + lane * 16;
    const char* zsrc = (const char*)(ZB + ((size_t)bh * 64 * 2 + vb) * 2 * 64 * 16) + lane * 16;
#define P2_STAGE(n_) do { LAS unsigned char* sl_ = F.lds + ((n_) % 5) * 12288; _Pragma("unroll") for (int f_ = 0; f_ < 8; ++f_) \
        __builtin_amdgcn_global_load_lds((const unsigned*)(gsrc + (size_t)(n_) * 8192 + f_ * 1024), (LAS unsigned*)(sl_ + f_ * 1024), 16, 0, 0); \
        _Pragma("unroll") for (int f_ = 0; f_ < 4; ++f_) __builtin_amdgcn_global_load_lds((const unsigned*)(zsrc + (size_t)(n_) * 8192 + f_ * 1024), (LAS unsigned*)(sl_ + 8192 + f_ * 1024), 16, 0, 0); } while (0)
    P2_STAGE(0); P2_STAGE(1); P2_STAGE(2); P2_STAGE(3);
#pragma unroll 1
    for (int n = 0; n < 64; ++n) {
        const size_t ch = (size_t)bh * 64 + n;
        if (n == 0) asm volatile("s_waitcnt vmcnt(36)" ::: "memory"); else if (n == 1) asm volatile("s_waitcnt vmcnt(44)" ::: "memory"); else if (n == 2) asm volatile("s_waitcnt vmcnt(52)" ::: "memory");
        else if (n < 61) asm volatile("s_waitcnt vmcnt(60)" ::: "memory"); else asm volatile("s_waitcnt vmcnt(0)" ::: "memory");
        const LAS unsigned char* sl = F.lds + (n % 5) * 12288;
        bf16_t* sp = STM + (ch * 64 + vb * 32 + r) * 64 + 4 * hg;
        pg8::bf16x8 pf[2][2];
#pragma unroll
        for (int kb = 0; kb < 2; ++kb) {
#pragma unroll
            for (int q = 0; q < 4; ++q) st_bf16x4(sp + kb * 32 + 8 * q, (pg8::f32x4){st[kb][4 * q], st[kb][4 * q + 1], st[kb][4 * q + 2], st[kb][4 * q + 3]});
#pragma unroll
            for (int s = 0; s < 2; ++s) { pg8::u32x4 pw; pw.x = pk2(st[kb][8 * s], st[kb][8 * s + 1]); pw.y = pk2(st[kb][8 * s + 2], st[kb][8 * s + 3]); pw.z = pk2(st[kb][8 * s + 4], st[kb][8 * s + 5]); pw.w = pk2(st[kb][8 * s + 6], st[kb][8 * s + 7]);
                pf[kb][s] = __builtin_bit_cast(pg8::bf16x8, pw); } }
        if (n + 4 < 64) P2_STAGE(n + 4);
        f32x16 nw[2];
#pragma unroll
        for (int kbr = 0; kbr < 2; ++kbr) {
#pragma unroll
            for (int q = 0; q < 2; ++q) { const pg8::u32x4 z = *(const LAS pg8::u32x4*)(sl + 8192 + (kbr * 2048) + lane * 32 + q * 16);
#pragma unroll
                for (int i = 0; i < 4; ++i) { nw[kbr][8 * q + 2 * i] = __builtin_bit_cast(float, z[i] << 16); nw[kbr][8 * q + 2 * i + 1] = __builtin_bit_cast(float, z[i] & 0xffff0000u); } }
#pragma unroll
            for (int kb = 0; kb < 2; ++kb)
#pragma unroll
                for (int s = 0; s < 2; ++s) nw[kbr] = __builtin_amdgcn_mfma_f32_32x32x16_bf16(*(const LAS pg8::bf16x8*)(sl + ((kbr * 2 + kb) * 2 + s) * 1024 + lane * 16), pf[kb][s], nw[kbr], 0, 0, 0); }
        st[0] = nw[0]; st[1] = nw[1];
    }
#undef P2_STAGE
    asm volatile("s_waitcnt vmcnt(0)" ::: "memory");
}
__device__ __forceinline__ void ph_rk_p3(Frame& F, ArgsP a, int l) {
    const unsigned char* VEC = a->ws + SCR_VEC6; const float* SC = (const float*)(a->ws + SCR_SC); const bf16_t* GR = (const bf16_t*)(a->ws + SCR_GR);
    const bf16_t* QE = (const bf16_t*)(a->ws + SCR_QE); const bf16_t* AY = (const bf16_t*)(a->ws + SCR_AY); const bf16_t* VTC = (const bf16_t*)(a->ws + SCR_VTC); const bf16_t* STM = (const bf16_t*)(a->ws + SCR_STM);
    const float* lng = (const float*)a->in[28] + l * 256; const float* lnb = (const float*)a->in[29] + l * 256; bf16_t* br = (bf16_t*)(a->ws + WS_HB);
    int lane = F.lane(); asm volatile("" : "+v"(lane));
    const int r = lane & 31, hg = lane >> 5;
    for (int it = F.gw; it < 2048; it += F.NGW) {
        const int bh = it >> 6, n = it & 63, b = bh >> 2, h = bh & 3;
        f32x16 acc[2];
#pragma unroll
        for (int e = 0; e < 16; ++e) { acc[0][e] = 0.f; acc[1][e] = 0.f; }
#pragma unroll
        for (int s = 0; s < 4; ++s) { const pg8::bf16x8 qf = *(const pg8::bf16x8*)(QE + ((size_t)it * 32 + r) * 64 + 16 * s + 8 * hg);
#pragma unroll
            for (int vb = 0; vb < 2; ++vb) acc[vb] = __builtin_amdgcn_mfma_f32_32x32x16_bf16(*(const pg8::bf16x8*)(STM + ((size_t)it * 64 + vb * 32 + r) * 64 + 16 * s + 8 * hg), qf, acc[vb], 0, 0, 0); }
#pragma unroll
        for (int s = 0; s < 2; ++s) { const pg8::bf16x8 af = *(const pg8::bf16x8*)(AY + ((size_t)it * 32 + r) * 32 + 16 * s + 8 * hg);
#pragma unroll
            for (int vb = 0; vb < 2; ++vb) acc[vb] = __builtin_amdgcn_mfma_f32_32x32x16_bf16(*(const pg8::bf16x8*)(VTC + ((size_t)it * 64 + vb * 32 + r) * 32 + 16 * s + 8 * hg), af, acc[vb], 0, 0, 0); }
        float sm = 0.f;
#pragma unroll
        for (int e = 0; e < 16; ++e) sm += acc[0][e] + acc[1][e];
        { const auto sw = __builtin_amdgcn_permlane32_swap(__builtin_bit_cast(unsigned, sm), __builtin_bit_cast(unsigned, sm), false, false); sm = __builtin_bit_cast(float, (unsigned)sw[0]) + __builtin_bit_cast(float, (unsigned)sw[1]); }
        const float mu = sm * (1.0f / 64.0f); float sq = 0.f;
#pragma unroll
        for (int e = 0; e < 16; ++e) { const float d0 = acc[0][e] - mu, d1 = acc[1][e] - mu; sq += d0 * d0 + d1 * d1; }
        { const auto sw = __builtin_amdgcn_permlane32_swap(__builtin_bit_cast(unsigned, sq), __builtin_bit_cast(unsigned, sq), false, false); sq = __builtin_bit_cast(float, (unsigned)sw[0]) + __builtin_bit_cast(float, (unsigned)sw[1]); }
        const float rstd = rsqrtf(sq * (1.0f / 64.0f) + 64e-5f);
        const int t = n * 32 + r; const size_t row = (size_t)b * T + t; const size_t st = (size_t)bh * T + t;
        const float bonus = SC[st * 4 + 2];
        const bf16_t* vrec = (const bf16_t*)(VEC + st * RECB + 768);
#pragma unroll
        for (int vb = 0; vb < 2; ++vb)
#pragma unroll
            for (int q = 0; q < 4; ++q) { const int v0 = vb * 32 + 8 * q + 4 * hg;
                const pg8::f32x4 vv = ld_bf16x4(vrec + v0), gg = ld_bf16x4(GR + row * 256 + h * 64 + v0), g4 = *(const pg8::f32x4*)(lng + h * 64 + v0), b4 = *(const pg8::f32x4*)(lnb + h * 64 + v0);
                pg8::f32x4 o;
#pragma unroll
                for (int i = 0; i < 4; ++i) o[i] = ((acc[vb][4 * q + i] - mu) * rstd * g4[i] + b4[i] + bonus * vv[i]) * gg[i];
                st_bf16x4(br + row * D + 768 + h * 64 + v0, o); }
    }
}
constexpr int RING_BYTES = 131072, LDS_BYTES = 163840, LDSCTL_OFF = LDS_BYTES - 1024, MISC_OFF = LDSCTL_OFF + 320;
constexpr int PH_PRO = 0, PH_H0 = 1, PH_L0 = 2, PH_PER_LAYER = 12, PH_END = PH_L0 + 2 * PH_PER_LAYER;
constexpr int PL_PROJ = 0, PL_MIXA = 1, PL_MIXB = 2, PL_MIXC = 3, PL_MIXD = 4, PL_BRANCH = 5, PL_OUT = 6, PL_ROWMIX = 7, PL_FFN1 = 8, PL_FFN2 = 9, PL_FFN3 = 10, PL_ROWFFN = 11;

#ifndef DUPMASK
#define DUPMASK 0
#endif
#define DUP(bit) for (int dup_ = 0; dup_ < (((DUPMASK) >> (bit)) & 1) + 1; ++dup_)
__global__ void __launch_bounds__(NTHR, 2) mk_fwd(Args a) {
    extern __shared__ __attribute__((aligned(16))) unsigned char lds_raw[];
    Frame F0;
    F0.lds = (LAS unsigned char*)lds_raw;
    F0.wave = __builtin_amdgcn_readfirstlane(threadIdx.x >> 6);
    F0.G = gridDim.x; F0.gw = blockIdx.x * NWAVES + F0.wave; F0.NGW = F0.G * NWAVES;
    volatile LAS unsigned* MISC = (volatile LAS unsigned*)(F0.lds + MISC_OFF);
    for (int u = threadIdx.x; u < (LDS_BYTES - LDSCTL_OFF) / 4; u += NTHR) ((LAS unsigned*)(F0.lds + LDSCTL_OFF))[u] = 0u;
    __syncthreads();
    unsigned* ctl = (unsigned*)(a.ws + WS_CTL);
    const int lo = a.ph_lo, hi = a.ph_hi;
    XcdBarrier bar; bar.bar = ctl + CW_BAR; bar.x = 0; bar.st = nullptr;
    if (hi - lo > 1) bar = xcd_barrier_post(ctl + CW_BAR, MISC + 8);
#define IN(k) (lo <= (k) && (k) < hi)
#define SEAM(k) do { if (IN(k) && IN((k) + 1)) { xcd_barrier(bar); if ((DUPMASK >> 12) & 1) xcd_barrier(bar); } } while (0)
    if (IN(PH_PRO)) DUP(0) { ArgsP A = fresh_args(); Frame F = fresh(F0); p0_mod_items(F, (const float*)A->in[1], (const float*)A->in[3], (const float*)A->in[4], (float*)(A->ws + WS_MOD)); p0_convert(F, A); }
    SEAM(PH_PRO);
    if (IN(PH_H0)) DUP(9) { Frame F = fresh(F0); ph_h0(F, fresh_args()); }
    SEAM(PH_H0);
    for (int l = 0; l < NL; ++l) {
        const int base = PH_L0 + l * PH_PER_LAYER;
        if (IN(base + PL_PROJ)) DUP(13) { ArgsP A = fresh_args(); Frame F = fresh(F0); unsigned char* ws = A->ws;
            pg8::Gemm g{(const bf16_t*)(ws + WS_HB), (const bf16_t*)(ws + WS_WIN) + (size_t)l * PW * 1024, 1024, 1024, 1024, 0}; pg8::StaticOrder S; S.init(M, 7168, F.G, (int)blockIdx.x);
            pg8::EpiBf16 E{(bf16_t*)(ws + WS_PROJ), PW, 28};
            pg8::gemm_phase<pg8::EpiBf16, pg8::StaticOrder, true>(F.lds, g, S, E, F.wave);
        }
        SEAM(base + PL_PROJ);
        if (IN(base + PL_MIXA)) { DUP(2) { Frame F = fresh(F0); ph_conv(F, fresh_args(), l); } DUP(6) { Frame F = fresh(F0); ph_rwkv_prep(F, fresh_args(), l); } DUP(7) { Frame F = fresh(F0); ph_gla_p1(F, fresh_args(), l); } DUP(8) { Frame F = fresh(F0); ph_attn_prep(F, fresh_args()); } }
        SEAM(base + PL_MIXA);
        if (IN(base + PL_MIXB)) { DUP(10) { Frame F = fresh(F0); ph_gla_prefix(F, fresh_args()); } DUP(4) { Frame F = fresh(F0); ph_attn(F, fresh_args(), l); } DUP(3) { Frame F = fresh(F0); ph_rk_p1(F, fresh_args()); } }
        SEAM(base + PL_MIXB);
        if (IN(base + PL_MIXC)) { DUP(17) { Frame F = fresh(F0); ph_rk_p2(F, fresh_args()); } DUP(11) { Frame F = fresh(F0); ph_gla_p2(F, fresh_args(), l); } }
        SEAM(base + PL_MIXC);
        if (IN(base + PL_MIXD)) { DUP(5) { Frame F = fresh(F0); ph_rk_p3(F, fresh_args(), l); } }
        SEAM(base + PL_MIXD);
        if (IN(base + PL_BRANCH)) DUP(14) { ArgsP A = fresh_args(); Frame F = fresh(F0); unsigned char* ws = A->ws;
            pg8::Gemm g{(const bf16_t*)(ws + WS_HB), (const bf16_t*)(ws + WS_WB) + (size_t)l * 1024 * 1024, 1024, 1024, 1024, 0}; pg8::StaticOrder S; S.init(M, 1024, F.G, (int)blockIdx.x);
            pg8::EpiBranchK E{(const bf16_t*)(ws + WS_PROJ), (bf16_t*)(ws + SCR_MB)};
            pg8::gemm_phase<pg8::EpiBranchK, pg8::StaticOrder, false>(F.lds, g, S, E, F.wave);
        }
        SEAM(base + PL_BRANCH);
        if (IN(base + PL_OUT)) DUP(1) { ArgsP A = fresh_args(); Frame F = fresh(F0); unsigned char* ws = A->ws;
            pg8::Gemm g{(const bf16_t*)(ws + SCR_MB), (const bf16_t*)(ws + WS_WO) + (size_t)l * 1024 * 1024, 1024, 1024, 1024, 0}; pg8::StaticOrder S; S.init(M, 1024, F.G, (int)blockIdx.x);
            pg8::EpiBf16 E{(bf16_t*)(ws + SCR_Y), 1024, 4};
            pg8::gemm_phase<pg8::EpiBf16, pg8::StaticOrder, false>(F.lds, g, S, E, F.wave);
        }
        SEAM(base + PL_OUT);
        if (IN(base + PL_ROWMIX)) { ArgsP A = fresh_args(); Frame F = fresh(F0); unsigned char* ws = A->ws; const float* modl = (const float*)(ws + WS_MOD) + (size_t)l * 8 * 6144;
            ph_row(F, A, l == 0 ? (const float*)A->in[0] : A->out, (const bf16_t*)(ws + SCR_Y), (const float*)A->in[6] + l * D, modl, 2048, (const float*)A->in[7] + l * D, modl, 3072, 4096, (bf16_t*)(ws + (l == 0 ? WS_HB : WS_H2L1)), l == 1); }
        SEAM(base + PL_ROWMIX);
        if (l == 0) {
            if (IN(base + PL_FFN1)) DUP(1) { ArgsP A = fresh_args(); Frame F = fresh(F0); unsigned char* ws = A->ws;
                pg8::Gemm g{(const bf16_t*)(ws + WS_HB), (const bf16_t*)(ws + WS_WF1), 1024, 1024, 1024, 0}; pg8::StaticOrder S; S.init(M, 2 * DFF, F.G, (int)blockIdx.x);
                pg8::EpiSwiglu E{(bf16_t*)(ws + WS_PROJ), DFF, 2 * DFF / 256};
                pg8::gemm_phase<pg8::EpiSwiglu, pg8::StaticOrder, true>(F.lds, g, S, E, F.wave);
            }
            SEAM(base + PL_FFN1);
            if (IN(base + PL_FFN2)) DUP(1) { ArgsP A = fresh_args(); Frame F = fresh(F0); unsigned char* ws = A->ws;
                pg8::Gemm g{(const bf16_t*)(ws + WS_PROJ), (const bf16_t*)(ws + WS_WF2), DFF, DFF, DFF, 0}; pg8::StaticOrder S; S.init(M, 1024, F.G, (int)blockIdx.x);
                pg8::EpiBf16 E{(bf16_t*)(ws + SCR_Y), 1024, 4};
                pg8::gemm_phase<pg8::EpiBf16, pg8::StaticOrder, false>(F.lds, g, S, E, F.wave);
            }
            SEAM(base + PL_FFN2);
        } else {
            if (IN(base + PL_FFN1)) DUP(0) { Frame F = fresh(F0); ph_moe_prep(F, fresh_args()); }
            SEAM(base + PL_FFN1);
            if (IN(base + PL_FFN2)) DUP(15) { ArgsP A = fresh_args(); Frame F = fresh(F0); unsigned char* ws = A->ws; const unsigned* cnt = (const unsigned*)(ws + WS_CTL) + CW_CNT;
                pg8::Gemm g{(const bf16_t*)(ws + WS_HG), (const bf16_t*)(ws + WS_WM1), 1024, 1024, 1024, 0}; pg8::MoeOrder<28> S; S.init(cnt, F.G, (int)blockIdx.x);
                pg8::EpiSwiglu E{(bf16_t*)(ws + WS_HID), DEX, 28};
                pg8::gemm_phase<pg8::EpiSwiglu, pg8::MoeOrder<28>, true>(F.lds, g, S, E, F.wave);
            }
            SEAM(base + PL_FFN2);
            if (IN(base + PL_FFN3)) DUP(16) { ArgsP A = fresh_args(); Frame F = fresh(F0); unsigned char* ws = A->ws; const unsigned* cnt = (const unsigned*)(ws + WS_CTL) + CW_CNT;
                pg8::Gemm g{(const bf16_t*)(ws + WS_HID), (const bf16_t*)(ws + WS_WM2), DEX, DEX, DEX, 0}; pg8::MoeOrderSplit S; S.init(cnt, F.G, (int)blockIdx.x);
                const pg8::MoeSplit sp = pg8::moe_split(cnt, F.G);
                pg8::EpiBf16Split E{(bf16_t*)(ws + WS_HG), (bf16_t*)(ws + WS_WM1), sp.tau0, sp.nrt};
                pg8::gemm_phase<pg8::EpiBf16Split, pg8::MoeOrderSplit, true>(F.lds, g, S, E, F.wave);
            }
            SEAM(base + PL_FFN3);
        }
        if (IN(base + PL_ROWFFN)) { ArgsP A = fresh_args(); Frame F = fresh(F0); unsigned char* ws = A->ws; const float* modl = (const float*)(ws + WS_MOD) + (size_t)l * 8 * 6144;
            const bool last = (l == NL - 1);
            if (l == 0) ph_row(F, A, A->out, (const bf16_t*)(ws + SCR_Y), (const float*)A->in[8], modl, 5120, (const float*)A->in[5] + D, modl + 8 * 6144, 0, 1024, (bf16_t*)(ws + WS_HB), false, nullptr, (const float*)A->in[9] + (size_t)1024 * NIN);
            else ph_row(F, A, A->out, nullptr, (const float*)A->in[8] + D, modl, 5120, nullptr, nullptr, 0, 1024, nullptr, false, (const bf16_t*)(ws + WS_HG));
        }
        SEAM(base + PL_ROWFFN);
    }
#undef IN
#undef SEAM
}

extern "C" void kernel_launch(void* const* d_in, const int* in_sizes, int n_in, void* d_out, int out_size, void* d_ws, size_t ws_size, hipStream_t stream) {
    static int grid = 0;
    if (grid == 0) {
        if (n_in != 40 || ws_size < WS_END) { fprintf(stderr, "kernel_launch: need 40 inputs and >= %zu bytes of workspace (got %d, %zu)\n", (size_t)WS_END, n_in, ws_size); grid = -1; return; }
        int dev = 0, cus = 0, per_cu = 0;
        (void)hipGetDevice(&dev); (void)hipDeviceGetAttribute(&cus, hipDeviceAttributeMultiprocessorCount, dev);
        (void)hipFuncSetAttribute((const void*)mk_fwd, hipFuncAttributeMaxDynamicSharedMemorySize, LDS_BYTES);
        (void)hipOccupancyMaxActiveBlocksPerMultiprocessor(&per_cu, (const void*)mk_fwd, NTHR, LDS_BYTES);
        (void)hipGetLastError();
        grid = cus > 0 ? cus : 256;
        if (per_cu < 1) fprintf(stderr, "kernel_launch: occupancy query says %d blocks per CU\n", per_cu);
    }
    if (grid < 0) return;
    unsigned char* ws = (unsigned char*)d_ws;
    (void)hipMemsetAsync(ws + WS_CTL, 0, CTL_ZERO_BYTES, stream);
    Args a{};
    for (int i = 0; i < 40; ++i) a.in[i] = d_in[i];
    a.out = (float*)d_out; a.ws = ws;
    a.ph_lo = 0; a.ph_hi = PH_L0 + (NL - 1) * PH_PER_LAYER + PL_ROWFFN + 1;
    hipLaunchKernelGGL(mk_fwd, dim3(grid), dim3(NTHR), LDS_BYTES, stream, a);
}
```

```cpp
#include <hip/hip_runtime.h>
#include <hip/hip_bf16.h>
#include <cstdint>
#include <cstdio>

typedef __hip_bfloat16 bf16;
typedef unsigned short bf16_t;
#define GAS __attribute__((address_space(1)))
#define LAS __attribute__((address_space(3)))

constexpr int D = 1024, NB = 8, T = 2048, M = NB * T, NL = 2;
constexpr int NIN = 7184;
constexpr int PW = 7424;
constexpr int P_GQ = 0, P_GK = 128, P_GV = 256, P_GO = 512, P_DQ = 768, P_DK = 1024, P_DV = 1280, P_CA = 1536, P_CB = 1792, P_R = 2048, P_GATE = 3072, P_GZ = 7168;
constexpr int DFF = 2816, NE = 8, DEX = 3584;
constexpr int NWAVES = 8, NTHR = 512;
constexpr size_t MiB = 1u << 20;
constexpr size_t WS_CTL = 0;
constexpr size_t CTL_ZERO_BYTES = 64 * 1024;
constexpr size_t WS_MOD = 1 * MiB;
constexpr size_t WS_ROUTE = 1 * MiB + 512 * 1024;
constexpr size_t WS_GZ = 2 * MiB + 512 * 1024;
constexpr size_t WS_LR = 3 * MiB;
constexpr size_t WS_WIN = 4 * MiB;
constexpr size_t WS_WB = 33 * MiB;
constexpr size_t WS_WO = 37 * MiB;
constexpr size_t WS_WF1 = 41 * MiB;
constexpr size_t WS_WF2 = 52 * MiB;
constexpr size_t WS_HB = 58 * MiB;
constexpr size_t WS_PROJ = 90 * MiB;
constexpr size_t WS_SCR = 322 * MiB;
constexpr size_t WS_H2L1 = 508 * MiB;
constexpr size_t WS_END = 540 * MiB;
constexpr size_t WS_HG = 4 * MiB;
constexpr size_t WS_WM1 = 72 * MiB;
constexpr size_t WS_WM2 = 184 * MiB;
constexpr size_t WS_HID = 240 * MiB;
static_assert(WS_HID + (size_t)34816 * 3584 * 2 <= WS_H2L1, "moe overlay");
constexpr size_t SCR_MP = WS_SCR;
constexpr size_t SCR_MB = WS_SCR + 64 * MiB;
constexpr size_t SCR_Y = WS_SCR + 96 * MiB;
constexpr size_t SCR_RW = WS_SCR;
constexpr size_t SCR_GK = WS_SCR + 112 * MiB;
constexpr size_t SCR_QR = WS_SCR + 120 * MiB;
constexpr size_t SCR_KR = WS_SCR + 136 * MiB;
constexpr size_t SCR_VEC6 = WS_SCR;
constexpr size_t SCR_SC = WS_SCR + 56 * MiB;
constexpr size_t SCR_STM = WS_SCR + 57 * MiB;
constexpr size_t SCR_GR = WS_SCR + 73 * MiB;
constexpr size_t SCR_VT = WS_SCR + 81 * MiB;
constexpr size_t SCR_GU = WS_SCR + 89 * MiB;
constexpr size_t SCR_GS = SCR_GU;
constexpr size_t SCR_QK = WS_SCR + 105 * MiB;
constexpr size_t SCR_EG = WS_SCR + 121 * MiB;
constexpr size_t SCR_QE = WS_SCR + 130 * MiB;
constexpr size_t SCR_AY = WS_SCR + 138 * MiB;
constexpr size_t SCR_VTC = WS_SCR + 142 * MiB;
constexpr size_t SCR_GMF = WS_SCR + 150 * MiB;
constexpr size_t SCR_ZB = WS_SCR + 166 * MiB;
constexpr size_t SCR_YR = WS_SCR + 166 * MiB;
constexpr int RECB = 896;
constexpr size_t WS_GOI = WS_H2L1;
constexpr size_t WS_GST = WS_H2L1 + 16 * MiB;
constexpr int CW_TMO = 0;
constexpr int CW_BAR = 1024;
constexpr int CW_CNT = 8192;
constexpr size_t RT_BCNT = 0;
constexpr size_t RT_TOKE = 512 * 1024;
constexpr size_t RT_TOKS = 640 * 1024;
constexpr size_t RT_TOKP = 768 * 1024;

__device__ __forceinline__ float sigm(float x) { return __builtin_amdgcn_rcpf(1.0f + __expf(-x)); }
__device__ __forceinline__ float siluf(float x) { return x * sigm(x); }
__device__ __forceinline__ float softplusf(float x) { return fmaxf(x, 0.f) + __logf(1.0f + __expf(-fabsf(x))); }
__device__ __forceinline__ float tanh_fast(float x) { return 1.0f - 2.0f * __builtin_amdgcn_rcpf(1.0f + __expf(2.0f * x)); }
template <int CTRL, int ROWMASK> __device__ __forceinline__ float dpp_mov_h(float old, float x) {
    return __builtin_bit_cast(float, __builtin_amdgcn_update_dpp(__builtin_bit_cast(int, old), __builtin_bit_cast(int, x), CTRL, ROWMASK, 0xF, false)); }
__device__ __forceinline__ float wave_sum(float x) {
    x += dpp_mov_h<0xB1, 0xF>(0.f, x); x += dpp_mov_h<0x4E, 0xF>(0.f, x); x += dpp_mov_h<0x141, 0xF>(0.f, x); x += dpp_mov_h<0x140, 0xF>(0.f, x);
    x += dpp_mov_h<0x142, 0xA>(0.f, x); x += dpp_mov_h<0x143, 0xC>(0.f, x);
    return __builtin_bit_cast(float, __builtin_amdgcn_readlane(__builtin_bit_cast(int, x), 63));
}
__device__ __forceinline__ float wave_max(float v) {
#pragma unroll
    for (int o = 32; o > 0; o >>= 1) v = fmaxf(v, __shfl_xor(v, o));
    return v;
}
__device__ __forceinline__ float ldf(const float* p) { return *p; }
__device__ __forceinline__ float ldf(const bf16* p) { return __bfloat162float(*p); }
__device__ __forceinline__ float bf2f(bf16_t u) { return __builtin_bit_cast(float, (unsigned)u << 16); }
__device__ __forceinline__ unsigned f2bf(float f) { unsigned u = __builtin_bit_cast(unsigned, f); return (u + 0x7fffu + ((u >> 16) & 1u)) >> 16; }
typedef float f32x2_t_ __attribute__((ext_vector_type(2))); typedef __bf16 bf16x2_t_ __attribute__((ext_vector_type(2)));
__device__ __forceinline__ unsigned pk2(float lo, float hi) { const f32x2_t_ v = {lo, hi}; const bf16x2_t_ b = __builtin_convertvector(v, bf16x2_t_); return __builtin_bit_cast(unsigned, b); }
namespace pg8 {
#define PG8_LAS __attribute__((address_space(3)))
typedef short bf16x8 __attribute__((ext_vector_type(8)));
typedef float f32x4 __attribute__((ext_vector_type(4)));
typedef float f32x2 __attribute__((ext_vector_type(2)));
typedef unsigned u32x4 __attribute__((ext_vector_type(4)));
typedef unsigned u32x2 __attribute__((ext_vector_type(2)));
constexpr int BM = 256, BK = 64, HALF = 128, HTB = HALF * BK * 2  , STAGE_BYTES = 8 * HTB, NXCD = 8, WGM = 8;

__host__ __device__ __forceinline__ int lds_byte(int r, int c) { const int st = (r >> 4) * 2 + (c >> 5), rr = r & 15, cc = c & 31, ob = rr * 64 + cc * 2; return st * 1024 + (ob ^ (((ob >> 9) & 1) << 5)); }
__host__ __device__ __forceinline__ void stage_rc(int b, int& R, int& C) { const int st = b / 1024, sb = b % 1024, swz = sb ^ (((sb >> 9) & 1) << 5); R = (st >> 1) * 16 + swz / 64; C = (st & 1) * 32 + (swz % 64) / 2; }
__host__ __device__ __forceinline__ int perm32(int rho) { const int n = rho >> 4, i = rho & 15; return 8 * (i >> 2) + 4 * n + (i & 3); }

struct Unit { int pm, pn, aoff, tag; };
struct Gemm { const bf16_t* A; const bf16_t* Bt; int lda, ldb, K, pad; };

struct StaticOrder {
    static constexpr bool VARK = false;
    int nM, nN, nwg, G, c;
    __host__ __device__ void init(int M_, int N_, int G_, int c_) { nM = M_ / BM; nN = N_ / BM; nwg = nM * nN; G = G_; c = c_; }
    __host__ __device__ bool next(int i, Unit& u) const {
        const long L = (long)i * G + c; if (L >= nwg) return false;
        int wgid = (int)L; { const int q = nwg / NXCD, r = nwg % NXCD, xcd = wgid % NXCD, off = wgid / NXCD; wgid = (xcd < r ? xcd * (q + 1) : r * (q + 1) + (xcd - r) * q) + off; }
        const int nig = WGM * nN, gid = wgid / nig, fm = gid * WGM, gsz = (nM - fm) < WGM ? (nM - fm) : WGM;
        u.pm = fm + ((wgid % nig) % gsz); u.pn = (wgid % nig) / gsz; u.aoff = 0; u.tag = 0; return true;
    }
};

__device__ __forceinline__ unsigned cvt_pk_bf16(float lo, float hi) { unsigned r; asm volatile("v_cvt_pk_bf16_f32 %0, %1, %2" : "=v"(r) : "v"(lo), "v"(hi)); return r; }


template <class Epi, class Sched, bool ALIGN_EPI>
__device__ __forceinline__ void gemm_phase(PG8_LAS unsigned char* lds, const Gemm g, const Sched& S, const Epi& E, int wave_s) {
    unsigned z_ = 0u; asm volatile("" : "+v"(z_));
    int tid_ = wave_s * 64 + (int)__builtin_amdgcn_mbcnt_hi(~0u, __builtin_amdgcn_mbcnt_lo(~0u, z_)); asm volatile("" : "+v"(tid_));
    const int tid = tid_, wid = __builtin_amdgcn_readfirstlane(tid >> 6), lane = tid & 63, wr = wid >> 2, wc = wid & 3, fr = lane & 15, fq = lane >> 4;
    const int K = g.K, nt = K / BK;
    unsigned voffA[2], voffB[2];
#pragma unroll
    for (int i = 0; i < 2; ++i) { int R, C; stage_rc(tid * 16 + i * 8192, R, C); const int Rb = Epi::PERM ? ((R & ~31) + perm32(R & 31)) : R;
        voffA[i] = (unsigned)(R * g.lda + C) * 2u; voffB[i] = (unsigned)(Rb * g.ldb + C) * 2u; }
    const size_t kstep = (size_t)(BK * 2);
    const size_t hstepA = (size_t)HALF * g.lda * 2, hstepB = (size_t)HALF * g.ldb * 2;
    const size_t tstepA = 2 * hstepA, tstepB = 2 * hstepB;
    const unsigned ldsw = (unsigned)wid * 1024u;
    const int aoff = lds_byte(wr * 64 + fr, fq * 8), boff = lds_byte(wc * 32 + fr, fq * 8);
#define PG8_SA(b, h) (((b) * 2 + (h)) * HTB)
#define PG8_SB(b, h) ((4 + (b) * 2 + (h)) * HTB)
#define PG8_STAGE(bufoff, gbase, voff) do { _Pragma("unroll") for (int _i = 0; _i < 2; ++_i) \
        __builtin_amdgcn_global_load_lds((const unsigned*)((const char*)(gbase) + (voff)[_i]), (PG8_LAS unsigned*)(lds + (bufoff) + ldsw + _i * 8192), 16, 0, 0); } while (0)
#define PG8_LDA(dst, b, h) do { _Pragma("unroll") for (int m = 0; m < 4; ++m) _Pragma("unroll") for (int k = 0; k < 2; ++k) dst[m][k] = *(const PG8_LAS bf16x8*)(lds + PG8_SA(b, h) + aoff + m * 2048 + k * 1024); } while (0)
#define PG8_LDB(dst, b, h) do { _Pragma("unroll") for (int n = 0; n < 2; ++n) _Pragma("unroll") for (int k = 0; k < 2; ++k) dst[n][k] = *(const PG8_LAS bf16x8*)(lds + PG8_SB(b, h) + boff + n * 2048 + k * 1024); } while (0)
#define PG8_MMA(ai, bj, At, Bt) do { __builtin_amdgcn_s_setprio(1); _Pragma("unroll") for (int m = 0; m < 4; ++m) _Pragma("unroll") for (int n = 0; n < 2; ++n) _Pragma("unroll") for (int k = 0; k < 2; ++k) \
        acc[ai][bj][m][n] = __builtin_amdgcn_mfma_f32_16x16x32_bf16(Bt[n][k], At[m][k], acc[ai][bj][m][n], 0, 0, 0); __builtin_amdgcn_s_setprio(0); } while (0)
#define PG8_WAIT_V(n) asm volatile("s_waitcnt vmcnt(" #n ")" ::: "memory")
#define PG8_WAIT_L(n) asm volatile("s_waitcnt lgkmcnt(" #n ")" ::: "memory")
#define PG8_BAR __builtin_amdgcn_s_barrier()
#define PG8_SCHED __builtin_amdgcn_sched_barrier(0)
    Unit cur, nxt; int ui = 0;
    if (!S.next(0, cur)) return;
    f32x4 acc[2][2][4][2];
#pragma unroll
    for (int a = 0; a < 2; ++a)
#pragma unroll
        for (int b = 0; b < 2; ++b)
#pragma unroll
            for (int m = 0; m < 4; ++m)
#pragma unroll
                for (int n = 0; n < 2; ++n) acc[a][b][m][n] = (f32x4){0.f, 0.f, 0.f, 0.f};
    bf16x8 At[4][2], B0[2][2], B1[2][2];
    const char* cA = (const char*)g.A + (size_t)cur.pm * tstepA + (size_t)cur.aoff * 2; const char* cB = (const char*)g.Bt + (size_t)cur.pn * tstepB + (Sched::VARK ? (size_t)cur.aoff * 2 : (size_t)0);
    PG8_STAGE(PG8_SB(0, 0), cB, voffB); PG8_STAGE(PG8_SB(0, 1), cB + hstepB, voffB); PG8_STAGE(PG8_SA(0, 0), cA, voffA); PG8_STAGE(PG8_SA(0, 1), cA + hstepA, voffA);
    if (wr == 1) PG8_BAR;
    PG8_WAIT_V(2); PG8_BAR;
    PG8_STAGE(PG8_SB(1, 0), cB + kstep, voffB); PG8_STAGE(PG8_SA(1, 0), cA + kstep, voffA); PG8_STAGE(PG8_SB(1, 1), cB + hstepB + kstep, voffB);
    PG8_WAIT_V(6); PG8_BAR;
    for (;;) {
        const bool has_next = S.next(ui + 1, nxt);
        const char* nA = has_next ? (const char*)g.A + (size_t)nxt.pm * tstepA + (size_t)nxt.aoff * 2 : cA; const char* nB = has_next ? (const char*)g.Bt + (size_t)nxt.pn * tstepB + (Sched::VARK ? (size_t)nxt.aoff * 2 : (size_t)0) : cB;
        int ntc = nt; if constexpr (Sched::VARK) ntc = S.nt_of(cur);
        for (int t = 0; t < ntc; t += 2) {
            if constexpr (Epi::MIDK) { if (t != 0 && (t & 3) == 0) E.mid(acc, cur, t >> 2, wr, wc); }
            const bool last = (t == ntc - 2);
            const char* a1 = cA + (size_t)(t + 1) * kstep;
            const char* a2 = last ? nA : cA + (size_t)(t + 2) * kstep; const char* b2 = last ? nB : cB + (size_t)(t + 2) * kstep;
            const char* a3 = a2 + kstep; const char* b3 = b2 + kstep;
            PG8_LDB(B0, 0, 0); PG8_LDB(B1, 0, 1); PG8_SCHED; PG8_LDA(At, 0, 0); PG8_STAGE(PG8_SA(1, 1), a1 + hstepA, voffA);
            PG8_WAIT_V(8); PG8_WAIT_L(0); PG8_BAR; PG8_MMA(0, 0, At, B0); PG8_MMA(0, 1, At, B1); PG8_BAR; PG8_SCHED;
            PG8_LDA(At, 0, 1); PG8_STAGE(PG8_SB(0, 0), b2, voffB); PG8_STAGE(PG8_SB(0, 1), b2 + hstepB, voffB); PG8_STAGE(PG8_SA(0, 0), a2, voffA);
            PG8_WAIT_V(8); PG8_WAIT_L(0); PG8_BAR; PG8_MMA(1, 0, At, B0); PG8_MMA(1, 1, At, B1); PG8_BAR; PG8_SCHED;
            PG8_LDB(B0, 1, 0); PG8_LDB(B1, 1, 1); PG8_SCHED; PG8_LDA(At, 1, 0); PG8_STAGE(PG8_SA(0, 1), a2 + hstepA, voffA);
            PG8_WAIT_V(8); PG8_WAIT_L(0); PG8_BAR; PG8_MMA(0, 0, At, B0); PG8_MMA(0, 1, At, B1); PG8_BAR; PG8_SCHED;
            PG8_LDA(At, 1, 1); PG8_STAGE(PG8_SB(1, 0), b3, voffB); PG8_STAGE(PG8_SB(1, 1), b3 + hstepB, voffB); PG8_STAGE(PG8_SA(1, 0), a3, voffA);
            PG8_WAIT_V(8); PG8_WAIT_L(0); PG8_BAR; PG8_MMA(1, 0, At, B0); PG8_MMA(1, 1, At, B1); PG8_BAR; PG8_SCHED;
        }
        if constexpr (ALIGN_EPI) { if (wr == 0) PG8_BAR; }
        { unsigned z2_ = 0u; asm volatile("" : "+v"(z2_)); const int l2_ = (int)__builtin_amdgcn_mbcnt_hi(~0u, __builtin_amdgcn_mbcnt_lo(~0u, z2_));
          E(acc, cur, wr, wc, l2_ & 15, l2_ >> 4); }
        if (!has_next) break;
#pragma unroll
        for (int a = 0; a < 2; ++a)
#pragma unroll
            for (int b = 0; b < 2; ++b)
#pragma unroll
                for (int m = 0; m < 4; ++m)
#pragma unroll
                    for (int n = 0; n < 2; ++n) acc[a][b][m][n] = (f32x4){0.f, 0.f, 0.f, 0.f};
        cur = nxt; cA = nA; cB = nB; ++ui;
        if constexpr (ALIGN_EPI) { if (wr == 1) PG8_BAR; }
    }
    PG8_WAIT_V(0);
    if constexpr (!ALIGN_EPI) { if (wr == 0) PG8_BAR; }
    PG8_BAR;
#undef PG8_SA
#undef PG8_SB
#undef PG8_STAGE
#undef PG8_LDA
#undef PG8_LDB
#undef PG8_MMA
#undef PG8_WAIT_V
#undef PG8_WAIT_L
#undef PG8_BAR
#undef PG8_SCHED
}

struct EpiBf16 {
    static constexpr bool PERM = true, MIDK = false;
    bf16_t* O; int ldc; int ntn;
    __device__ __forceinline__ void operator()(const f32x4 (&acc)[2][2][4][2], const Unit& u, int wr, int wc, int fr, int fq) const {
        const int row0 = u.pm * BM + wr * 64 + fr, col0 = (u.pn % ntn) * BM + wc * 32 + 8 * fq;
#pragma unroll
        for (int ai = 0; ai < 2; ++ai)
#pragma unroll
            for (int m = 0; m < 4; ++m) { bf16_t* rowp = O + (size_t)(row0 + ai * HALF + m * 16) * ldc + col0;
#pragma unroll
                for (int bj = 0; bj < 2; ++bj) { const f32x4 v0 = acc[ai][bj][m][0], v1 = acc[ai][bj][m][1];
                    u32x4 w; w.x = cvt_pk_bf16(v0[0], v0[1]); w.y = cvt_pk_bf16(v0[2], v0[3]); w.z = cvt_pk_bf16(v1[0], v1[1]); w.w = cvt_pk_bf16(v1[2], v1[3]);
                    *(u32x4*)(rowp + bj * HALF) = w; } }
    }
};
struct EpiF32 {
    static constexpr bool PERM = false, MIDK = false;
    float* C; int ldc; int ntn;
    __device__ __forceinline__ void operator()(const f32x4 (&acc)[2][2][4][2], const Unit& u, int wr, int wc, int fr, int fq) const {
        const int row0 = u.pm * BM + wr * 64 + fr, col0 = (u.pn % ntn) * BM + wc * 32 + 4 * fq;
#pragma unroll
        for (int ai = 0; ai < 2; ++ai)
#pragma unroll
            for (int m = 0; m < 4; ++m) { float* rowp = C + (size_t)(row0 + ai * HALF + m * 16) * ldc + col0;
#pragma unroll
                for (int bj = 0; bj < 2; ++bj)
#pragma unroll
                    for (int n = 0; n < 2; ++n) *(f32x4*)(rowp + bj * HALF + n * 16) = acc[ai][bj][m][n]; }
    }
};
struct EpiSwiglu {
    static constexpr bool PERM = true, MIDK = false;
    bf16_t* O; int ldc; int ntn;
    __device__ __forceinline__ void operator()(const f32x4 (&acc)[2][2][4][2], const Unit& u, int wr, int wc, int fr, int fq) const {
        const int row0 = u.pm * BM + wr * 64 + fr, col0 = (u.pn % ntn) * 128 + wc * 16 + 4 * fq;
#pragma unroll
        for (int ai = 0; ai < 2; ++ai)
#pragma unroll
            for (int m = 0; m < 4; ++m) { bf16_t* rowp = O + (size_t)(row0 + ai * HALF + m * 16) * ldc + col0;
#pragma unroll
                for (int bj = 0; bj < 2; ++bj) { const f32x4 gt = acc[ai][bj][m][0], up = acc[ai][bj][m][1];
                    float h[4];
#pragma unroll
                    for (int e = 0; e < 4; ++e) h[e] = gt[e] * __builtin_amdgcn_rcpf(1.0f + __expf(-gt[e])) * up[e];
                    u32x2 w; w.x = cvt_pk_bf16(h[0], h[1]); w.y = cvt_pk_bf16(h[2], h[3]);
                    *(u32x2*)(rowp + bj * 64) = w; } }
    }
};
struct EpiBranch {
    static constexpr bool PERM = true, MIDK = false;
    const bf16_t* proj; float* MP; bf16_t* MB;
    __device__ __forceinline__ void operator()(const f32x4 (&acc)[2][2][4][2], const Unit& u, int wr, int wc, int fr, int fq) const {
        const int g = u.tag; const int row0 = u.pm * BM + wr * 64 + fr, col0 = (u.pn & 3) * BM + wc * 32 + 8 * fq;
#pragma unroll
        for (int ai = 0; ai < 2; ++ai)
#pragma unroll
            for (int m = 0; m < 4; ++m) { const size_t row = (size_t)(row0 + ai * HALF + m * 16);
#pragma unroll
                for (int bj = 0; bj < 2; ++bj) { const int col = col0 + bj * HALF;
                    const u32x4 gw = *(const u32x4*)(proj + row * PW + P_GATE + g * 1024 + col);
                    float gv[8];
#pragma unroll
                    for (int e = 0; e < 4; ++e) { const unsigned w = gw[e]; gv[2 * e] = __builtin_bit_cast(float, w << 16); gv[2 * e + 1] = __builtin_bit_cast(float, w & 0xffff0000u); }
                    f32x4 v0 = acc[ai][bj][m][0], v1 = acc[ai][bj][m][1];
#pragma unroll
                    for (int e = 0; e < 4; ++e) { v0[e] *= __builtin_amdgcn_rcpf(1.0f + __expf(-gv[e])); v1[e] *= __builtin_amdgcn_rcpf(1.0f + __expf(-gv[4 + e])); }
                    float* mp = MP + row * D + col;
                    if (g > 0) { v0 += *(const f32x4*)mp; v1 += *(const f32x4*)(mp + 4); }
                    if (g < 3) { *(f32x4*)mp = v0; *(f32x4*)(mp + 4) = v1; }
                    else { u32x4 w; w.x = cvt_pk_bf16(v0[0], v0[1]); w.y = cvt_pk_bf16(v0[2], v0[3]); w.z = cvt_pk_bf16(v1[0], v1[1]); w.w = cvt_pk_bf16(v1[2], v1[3]);
                        *(u32x4*)(MB + row * D + col) = w; } } }
    }
};
struct EpiBranchK {
    static constexpr bool PERM = true, MIDK = true;
    const bf16_t* proj; bf16_t* MB;
    __device__ __forceinline__ static float em(float x) { return fminf(__expf(-x), 1e20f); }
    __device__ __forceinline__ void mid(f32x4 (&acc)[2][2][4][2], const Unit& u, int gnext, int wr, int wc) const {
        unsigned z_ = 0u; asm volatile("" : "+v"(z_)); const int l_ = (int)__builtin_amdgcn_mbcnt_hi(~0u, __builtin_amdgcn_mbcnt_lo(~0u, z_)); const int fr = l_ & 15, fq = l_ >> 4;
        const int row0 = u.pm * BM + wr * 64 + fr, col0 = u.pn * BM + wc * 32 + 8 * fq;
#pragma unroll
        for (int ai = 0; ai < 2; ++ai)
#pragma unroll
            for (int m = 0; m < 4; ++m) { const bf16_t* gp = proj + (size_t)(row0 + ai * HALF + m * 16) * PW + P_GATE + (gnext - 1) * 1024 + col0;
#pragma unroll
                for (int bj = 0; bj < 2; ++bj) { const u32x4 g0 = *(const u32x4*)(gp + bj * HALF), g1 = *(const u32x4*)(gp + 1024 + bj * HALF);
#pragma unroll
                    for (int e = 0; e < 4; ++e) { const unsigned a = g0[e], b = g1[e];
                        const float ra = (1.0f + em(__builtin_bit_cast(float, b << 16))) * __builtin_amdgcn_rcpf(1.0f + em(__builtin_bit_cast(float, a << 16)));
                        const float rb = (1.0f + em(__builtin_bit_cast(float, b & 0xffff0000u))) * __builtin_amdgcn_rcpf(1.0f + em(__builtin_bit_cast(float, a & 0xffff0000u)));
                        if (e < 2) { acc[ai][bj][m][0][2 * e] *= ra; acc[ai][bj][m][0][2 * e + 1] *= rb; } else { acc[ai][bj][m][1][2 * (e - 2)] *= ra; acc[ai][bj][m][1][2 * (e - 2) + 1] *= rb; } } } }
    }
    __device__ __forceinline__ void operator()(const f32x4 (&acc)[2][2][4][2], const Unit& u, int wr, int wc, int fr, int fq) const {
        const int row0 = u.pm * BM + wr * 64 + fr, col0 = u.pn * BM + wc * 32 + 8 * fq;
#pragma unroll
        for (int ai = 0; ai < 2; ++ai)
#pragma unroll
            for (int m = 0; m < 4; ++m) { const size_t row = (size_t)(row0 + ai * HALF + m * 16);
#pragma unroll
                for (int bj = 0; bj < 2; ++bj) { const u32x4 gw = *(const u32x4*)(proj + row * PW + P_GATE + 3 * 1024 + col0 + bj * HALF);
                    float sg[8];
#pragma unroll
                    for (int e = 0; e < 4; ++e) { sg[2 * e] = __builtin_amdgcn_rcpf(1.0f + em(__builtin_bit_cast(float, gw[e] << 16))); sg[2 * e + 1] = __builtin_amdgcn_rcpf(1.0f + em(__builtin_bit_cast(float, gw[e] & 0xffff0000u))); }
                    const f32x4 v0 = acc[ai][bj][m][0], v1 = acc[ai][bj][m][1];
                    u32x4 w; w.x = cvt_pk_bf16(v0[0] * sg[0], v0[1] * sg[1]); w.y = cvt_pk_bf16(v0[2] * sg[2], v0[3] * sg[3]); w.z = cvt_pk_bf16(v1[0] * sg[4], v1[1] * sg[5]); w.w = cvt_pk_bf16(v1[2] * sg[6], v1[3] * sg[7]);
                    *(u32x4*)(MB + row * D + col0 + bj * HALF) = w; } }
    }
};
struct BranchOrder {
    static constexpr bool VARK = false;
    int G, c;
    __device__ bool next(int i, Unit& u) const {
        const int tile = (i >> 2) * G + c; if (tile >= 256) return false;
        const int g = i & 3; u.pm = tile >> 2; u.pn = g * 4 + (tile & 3); u.aoff = g * 256; u.tag = g; return true;
    }
};
template <int NTC> struct MoeOrder {
    static constexpr bool VARK = false;
    static constexpr int NT = NTC; int G, c, ntiles; int t1, t2, t3, t4, t5, t6, t7;
    __device__ __forceinline__ void init(const unsigned* cnt, int G_, int c_) { G = G_; c = (G_ % 8 == 0) ? (c_ % 8) * (G_ / 8) + c_ / 8 : c_;
        int o = ((int)cnt[0] + 255) >> 8; t1 = o; o += ((int)cnt[1] + 255) >> 8; t2 = o; o += ((int)cnt[2] + 255) >> 8; t3 = o; o += ((int)cnt[3] + 255) >> 8; t4 = o;
        o += ((int)cnt[4] + 255) >> 8; t5 = o; o += ((int)cnt[5] + 255) >> 8; t6 = o; o += ((int)cnt[6] + 255) >> 8; t7 = o; o += ((int)cnt[7] + 255) >> 8; ntiles = o; }
    __device__ __forceinline__ bool next(int i, Unit& u) const {
        const int L = i * G + c; if (L >= ntiles * NT) return false;
        const int tau = L / NT, pn = L % NT;
        const int e = (tau >= t1) + (tau >= t2) + (tau >= t3) + (tau >= t4) + (tau >= t5) + (tau >= t6) + (tau >= t7);
        u.pm = tau; u.pn = e * NT + pn; u.aoff = 0; u.tag = e; return true;
    }
};
struct MoeSplit { int tau0, nrt, s; };
__device__ __forceinline__ MoeSplit moe_split(const unsigned* cnt, int G) {
    int o = 0;
#pragma unroll
    for (int e = 0; e < 8; ++e) o += ((int)cnt[e] + 255) >> 8;
    const int U = o * 4, nfull = (U / G) * G, rem = U - nfull; MoeSplit r; r.tau0 = o; r.nrt = 0; r.s = 1;
    if ((nfull & 3) == 0 && rem > 0 && rem * 2 <= G) { r.s = (rem * 7 <= G) ? 7 : (rem * 4 <= G) ? 4 : 2; r.tau0 = nfull >> 2; r.nrt = o - r.tau0; }
    return r;
}
struct MoeOrderSplit {
    static constexpr bool VARK = true;
    static constexpr int NT = 4, KT = 56; int G, c, ntiles; int t1, t2, t3, t4, t5, t6, t7; int nfull, rem, s;
    __device__ __forceinline__ void init(const unsigned* cnt, int G_, int c_) { G = G_; c = (G_ % 8 == 0) ? (c_ % 8) * (G_ / 8) + c_ / 8 : c_;
        int o = ((int)cnt[0] + 255) >> 8; t1 = o; o += ((int)cnt[1] + 255) >> 8; t2 = o; o += ((int)cnt[2] + 255) >> 8; t3 = o; o += ((int)cnt[3] + 255) >> 8; t4 = o;
        o += ((int)cnt[4] + 255) >> 8; t5 = o; o += ((int)cnt[5] + 255) >> 8; t6 = o; o += ((int)cnt[6] + 255) >> 8; t7 = o; o += ((int)cnt[7] + 255) >> 8; ntiles = o;
        const MoeSplit sp = moe_split(cnt, G_); s = sp.s; nfull = (s > 1) ? sp.tau0 * 4 : ntiles * 4; rem = ntiles * 4 - nfull; }
    __device__ __forceinline__ bool next(int i, Unit& u) const {
        const int L = i * G + c; int tl = L, kp = 0;
        if (L >= nfull) { const int j = L - nfull; if (j >= rem * s) return false; tl = nfull + j / s; kp = j % s + 1; }
        const int tau = tl >> 2, pn = tl & 3;
        const int e = (tau >= t1) + (tau >= t2) + (tau >= t3) + (tau >= t4) + (tau >= t5) + (tau >= t6) + (tau >= t7);
        u.pm = tau; u.pn = e * NT + pn; u.aoff = kp ? (kp - 1) * ((KT * BK) / s) : 0; u.tag = e | (kp << 8); return true;
    }
    __device__ __forceinline__ int nt_of(const Unit& u) const { return (u.tag >> 8) ? KT / s : KT; }
};
struct EpiBf16Split {
    static constexpr bool PERM = true, MIDK = false;
    bf16_t* O; bf16_t* P; int tau0, nrt;
    __device__ __forceinline__ void operator()(const f32x4 (&acc)[2][2][4][2], const Unit& u, int wr, int wc, int fr, int fq) const {
        const int kp = u.tag >> 8;
        bf16_t* base = kp ? P + (size_t)((kp - 1) * nrt + (u.pm - tau0)) * BM * 1024 : O + (size_t)u.pm * BM * 1024;
        const int row0 = wr * 64 + fr, col0 = (u.pn & 3) * BM + wc * 32 + 8 * fq;
#pragma unroll
        for (int ai = 0; ai < 2; ++ai)
#pragma unroll
            for (int m = 0; m < 4; ++m) { bf16_t* rowp = base + (size_t)(row0 + ai * HALF + m * 16) * 1024 + col0;
#pragma unroll
                for (int bj = 0; bj < 2; ++bj) { const f32x4 v0 = acc[ai][bj][m][0], v1 = acc[ai][bj][m][1];
                    u32x4 w; w.x = cvt_pk_bf16(v0[0], v0[1]); w.y = cvt_pk_bf16(v0[2], v0[3]); w.z = cvt_pk_bf16(v1[0], v1[1]); w.w = cvt_pk_bf16(v1[2], v1[3]);
                    *(u32x4*)(rowp + bj * HALF) = w; } }
    }
};
}
typedef GAS unsigned gu32;
#define RLX_AGENT __ATOMIC_RELAXED, __HIP_MEMORY_SCOPE_AGENT
#define XB_TMO      128
#define XB_XCNT(j)  (256  + 64 * (j))
#define XB_XSUB(j)  (1280 + 64 * (j))
#define XB_XGEN(j)  (2304 + 64 * (j))
#define XB_TOP      3328
#define XB_TOPGEN   3392
#define XCD_BAR_WORDS 3456
#define XB_SPIN_CAP (1u << 18)

__device__ __forceinline__ unsigned xb_ld(unsigned* p)              { return __hip_atomic_load(p, __ATOMIC_RELAXED, __HIP_MEMORY_SCOPE_AGENT); }
__device__ __forceinline__ unsigned xb_add(unsigned* p, unsigned v) { return __hip_atomic_fetch_add(p, v, __ATOMIC_RELAXED, __HIP_MEMORY_SCOPE_AGENT); }
__device__ __forceinline__ unsigned xb_xcc_id() { return (unsigned)__builtin_amdgcn_s_getreg((3 << 11) | 20) & 0xFu; }
#define XB_SPIN(cond, bar) do { unsigned _sp = 0; while (cond) { __builtin_amdgcn_s_sleep(1); \
    if ((++_sp & 255u) == 0u) { if (xb_ld(&(bar)[XB_TMO])) break; if (_sp > XB_SPIN_CAP) { atomicAdd(&(bar)[XB_TMO], 1u); break; } } } } while (0)

struct XcdBarrier {
    unsigned* bar; unsigned x;
    volatile LAS unsigned* st;
};

__device__ __forceinline__ XcdBarrier xcd_barrier_post(unsigned* bar, volatile LAS unsigned* st) {
    XcdBarrier b; b.bar = bar; b.x = xb_xcc_id(); b.st = st;
    if (threadIdx.x == 0) (void)xb_add(&bar[XB_XCNT(b.x)], 1u);
    return b;
}
__device__ __forceinline__ void xcd_barrier_complete(unsigned* bar, unsigned x, unsigned& nloc, unsigned& nx) {
    const unsigned G = gridDim.x * gridDim.y * gridDim.z;
    unsigned sum, cnt, mine, sp = 0u;
    for (;;) {
        sum = 0u; cnt = 0u; mine = 0u;
#pragma unroll
        for (unsigned j = 0; j < 16; ++j) { const unsigned c = xb_ld(&bar[XB_XCNT(j)]); sum += c; cnt += (c > 0u) ? 1u : 0u; mine = (j == x) ? c : mine; }
        if (sum == G) break;
        __builtin_amdgcn_s_sleep(1);
        if ((++sp & 255u) == 0u) { if (xb_ld(&bar[XB_TMO])) break; if (sp > XB_SPIN_CAP) { atomicAdd(&bar[XB_TMO], 1u); break; } }
    }
    nloc = mine > 0u ? mine : 1u; nx = cnt > 0u ? cnt : 1u;
}

__device__ __forceinline__ void xcd_barrier(const XcdBarrier& b) {
    asm volatile("s_waitcnt vmcnt(0)" ::: "memory");
    __syncthreads();
    if (threadIdx.x == 0) {
        unsigned* bar = b.bar;
        __builtin_amdgcn_s_waitcnt(0);
        unsigned nloc = b.st[0], nx = b.st[1];
        if (nloc == 0u) { xcd_barrier_complete(bar, b.x, nloc, nx); b.st[0] = nloc; b.st[1] = nx; }
        const unsigned old = xb_add(&bar[XB_XSUB(b.x)], 1u);
        const unsigned gen = old / nloc;
        if (old + 1u == (gen + 1u) * nloc) {
            __builtin_amdgcn_fence(__ATOMIC_RELEASE, "agent");
            asm volatile("s_waitcnt vmcnt(0)" ::: "memory");
            const unsigned og = xb_add(&bar[XB_TOP], 1u);
            const unsigned tg = og / nx;
            if (og + 1u == (tg + 1u) * nx) xb_add(&bar[XB_TOPGEN], 1u);
            else XB_SPIN(xb_ld(&bar[XB_TOPGEN]) == tg, bar);
            __builtin_amdgcn_fence(__ATOMIC_ACQUIRE, "agent");
            xb_add(&bar[XB_XGEN(b.x)], 1u);
            asm volatile("s_waitcnt vmcnt(0)" ::: "memory");
        } else {
            XB_SPIN(xb_ld(&bar[XB_XGEN(b.x)]) == gen, bar);
            __builtin_amdgcn_fence(__ATOMIC_ACQUIRE, "agent");
            asm volatile("s_waitcnt vmcnt(0)" ::: "memory");
        }
    }
    __syncthreads();
}
struct Args { const void* in[40]; float* out; unsigned char* ws; int ph_lo, ph_hi; };
typedef const __attribute__((address_space(4))) Args* ArgsP;
__device__ __forceinline__ ArgsP fresh_args() { ArgsP p = (ArgsP)__builtin_amdgcn_kernarg_segment_ptr(); asm volatile("" : "+s"(p)); return p; }

struct Frame {
    LAS unsigned char* lds;
    int wave, G, gw, NGW;
    __device__ __forceinline__ int lane() const { unsigned z = 0u; asm volatile("" : "+v"(z)); return (int)__builtin_amdgcn_mbcnt_hi(~0u, __builtin_amdgcn_mbcnt_lo(~0u, z)); }
};

__device__ __forceinline__ Frame fresh(const Frame& F) { Frame R = F; asm volatile("" : "+s"(R.wave), "+s"(R.G), "+s"(R.gw), "+s"(R.NGW)); return R; }
#define LDS_WAIT() asm volatile("s_waitcnt lgkmcnt(0)" ::: "memory")

__device__ __forceinline__ void p0_mod_items(Frame& F, const float* c, const float* ada_w, const float* ada_b, float* mod) {
    LAS float* part = (LAS float*)F.lds;
    LAS float* cs = (LAS float*)(F.lds + 98304);
    int tid_ = F.wave * 64 + F.lane(); asm volatile("" : "+v"(tid_)); const int lane_ = tid_ & 63;
    if ((int)blockIdx.x >= 192) return;
    for (int i = tid_; i < 8192; i += NTHR) cs[i] = siluf(c[i]);
    __syncthreads();
    for (int it = blockIdx.x; it < 192; it += F.G) {
        const int l = it / 96, j0 = (it % 96) * 64;
        float acc[8];
#pragma unroll
        for (int b = 0; b < 8; ++b) acc[b] = 0.f;
        const float* w = ada_w + (size_t)l * 1024 * 6144 + j0 + lane_;
        const int k0 = F.wave * 128;
#pragma unroll 1
        for (int kb = 0; kb < 128; kb += 16) { float wv[16];
#pragma unroll
            for (int q = 0; q < 16; ++q) wv[q] = w[(size_t)(k0 + kb + q) * 6144];
#pragma unroll
            for (int q4 = 0; q4 < 4; ++q4)
#pragma unroll
                for (int b = 0; b < 8; ++b) { const pg8::f32x4 cv = *(const LAS pg8::f32x4*)(cs + b * 1024 + k0 + kb + 4 * q4);
                    acc[b] += (cv[0] * wv[4 * q4] + cv[1] * wv[4 * q4 + 1]) + (cv[2] * wv[4 * q4 + 2] + cv[3] * wv[4 * q4 + 3]); } }
#pragma unroll
        for (int b = 0; b < 8; ++b) part[(F.wave * 8 + b) * 64 + lane_] = acc[b];
        __syncthreads();
        { const int b = tid_ >> 6, col = tid_ & 63; float s = 0.f;
#pragma unroll
          for (int w8 = 0; w8 < 8; ++w8) s += part[(w8 * 8 + b) * 64 + col];
          mod[(size_t)(l * 8 + b) * 6144 + j0 + col] = s + ada_b[l * 6144 + j0 + col]; }
        __syncthreads();
    }
}
struct CvtDesc { const float* colp; size_t Ns; bf16_t* WT; int Kd, n0, k0; };
__device__ __forceinline__ void cvt_load(const CvtDesc& d, pg8::f32x4 (&v)[8], int lane) {
    const int kr = lane >> 3;
#pragma unroll
    for (int i = 0; i < 8; ++i) v[i] = d.colp ? *(const pg8::f32x4*)(d.colp + (size_t)(d.k0 + 8 * i + kr) * d.Ns) : (pg8::f32x4){0.f, 0.f, 0.f, 0.f};
}
__device__ __forceinline__ void cvt_store(const CvtDesc& d, const pg8::f32x4 (&v)[8], LAS float* scr, int lane) {
    const int q4 = 4 * (lane & 7), kr = lane >> 3;
#pragma unroll
    for (int i = 0; i < 8; ++i)
#pragma unroll
        for (int e = 0; e < 4; ++e) scr[(8 * i + kr) * 33 + q4 + e] = v[i][e];
    LDS_WAIT(); asm volatile("" ::: "memory");
    const int cidx = lane & 7;
#pragma unroll
    for (int j = 0; j < 4; ++j) { const int n = (lane >> 3) + 8 * j; const LAS float* s = scr + (8 * cidx) * 33 + n;
        pg8::u32x4 o; o.x = pk2(s[0 * 33], s[1 * 33]); o.y = pk2(s[2 * 33], s[3 * 33]); o.z = pk2(s[4 * 33], s[5 * 33]); o.w = pk2(s[6 * 33], s[7 * 33]);
        *(pg8::u32x4*)(d.WT + (size_t)(d.n0 + n) * d.Kd + d.k0 + 8 * cidx) = o; }
    LDS_WAIT(); asm volatile("" ::: "memory");
}
__device__ __forceinline__ int win_src_col(int v) { return v < 768 ? v : (v < 7168 ? v + 16 : (v < 7184 ? v - 6400 : -1)); }

__device__ __forceinline__ CvtDesc p0_desc(ArgsP a, int it, int n) {
    const float* w_in = (const float*)a->in[9]; const float* w_branch = (const float*)a->in[30]; const float* w_out = (const float*)a->in[31];
    const float* wg = (const float*)a->in[32]; const float* wu = (const float*)a->in[33]; const float* wd = (const float*)a->in[34];
    bf16_t* WIN = (bf16_t*)(a->ws + WS_WIN); bf16_t* WB = (bf16_t*)(a->ws + WS_WB); bf16_t* WO = (bf16_t*)(a->ws + WS_WO); bf16_t* WF1 = (bf16_t*)(a->ws + WS_WF1); bf16_t* WF2 = (bf16_t*)(a->ws + WS_WF2);
    bf16_t* LR = (bf16_t*)(a->ws + WS_LR);
    constexpr int I_IN = 2 * 232 * 16, I_B = 2 * 4 * 32 * 4, I_O = 2 * 32 * 16, I_F1 = 176 * 16, I_F2 = 32 * 44;
    int r = it;
    if (r < I_IN) { const int l = r / (232 * 16), q = r % (232 * 16), nb = q / 16, kb = q % 16; const int sc = win_src_col(nb * 32 + n);
        return CvtDesc{sc >= 0 ? w_in + (size_t)l * 1024 * NIN + sc : nullptr, (size_t)NIN, WIN + (size_t)l * PW * 1024, 1024, nb * 32, kb * 64}; } r -= I_IN;
    if (r < I_B) { const int lg = r / 128, q = r % 128, nb = q / 4, kb = q % 4;
        const int g = lg & 3, l = lg >> 2;
        return CvtDesc{w_branch + (size_t)lg * 256 * 1024 + nb * 32 + n - (size_t)g * 256 * 1024, 1024, WB + (size_t)l * 1024 * 1024, 1024, nb * 32, g * 256 + kb * 64}; } r -= I_B;
    if (r < I_O) { const int l = r / 512, q = r % 512, nb = q / 16, kb = q % 16;
        return CvtDesc{w_out + (size_t)l * 1024 * 1024 + nb * 32 + n, 1024, WO + (size_t)l * 1024 * 1024, 1024, nb * 32, kb * 64}; } r -= I_O;
    if (r < I_F1) { const int nb = r / 16, kb = r % 16; const int v = nb * 32 + n; const int up = (v >> 2) & 1, j = (v >> 3) * 4 + (v & 3);
        return CvtDesc{(up ? wu : wg) + j, (size_t)DFF, WF1, 1024, nb * 32, kb * 64}; } r -= I_F1;
    if (r < I_F2) { const int nb = r / 44, kb = r % 44;
        return CvtDesc{wd + nb * 32 + n, 1024, WF2, DFF, nb * 32, kb * 64}; } r -= I_F2;
    if (r < 16) { const int l = r >> 3, nb = r & 7; return CvtDesc{(const float*)a->in[21] + l * 64 * 256 + nb * 32 + n, 256, LR + l * 256 * 64, 64, nb * 32, 0}; } r -= 16;
    if (r < 16) { const int l = r >> 3, nb = r & 7; return CvtDesc{(const float*)a->in[23] + l * 64 * 256 + nb * 32 + n, 256, LR + 2 * 256 * 64 + l * 256 * 64, 64, nb * 32, 0}; } r -= 16;
    { const int l = r >> 4, nb = (r >> 1) & 7, kb = r & 1; return CvtDesc{(const float*)a->in[24] + l * 128 * 256 + nb * 32 + n, 256, LR + 4 * 256 * 64 + l * 256 * 128, 128, nb * 32, kb * 64}; }
}
__device__ __forceinline__ void p0_convert(Frame& F, ArgsP a) {
    LAS float* scr = (LAS float*)(F.lds + 16384 + F.wave * 8704);
    constexpr int NITEMS = 2 * 232 * 16 + 2 * 4 * 32 * 4 + 2 * 32 * 16 + 176 * 16 + 32 * 44 + 64;
    int lane_ = F.lane(); asm volatile("" : "+v"(lane_));
    const int n = 4 * (lane_ & 7);
    int it = F.gw; if (it >= NITEMS) return;
    CvtDesc cur = p0_desc(a, it, n); pg8::f32x4 v[8]; cvt_load(cur, v, lane_);
    for (;;) { const int nx = it + F.NGW; const bool more = nx < NITEMS;
        CvtDesc nd = cur; pg8::f32x4 w[8];
        if (more) { nd = p0_desc(a, nx, n); cvt_load(nd, w, lane_); }
        cvt_store(cur, v, scr, lane_);
        if (!more) break;
#pragma unroll
        for (int i = 0; i < 8; ++i) v[i] = w[i];
        cur = nd; it = nx; }
}

__device__ __forceinline__ void row_load(const float* p, pg8::f32x4 (&v)[4], int lane) {
#pragma unroll
    for (int j = 0; j < 4; ++j) v[j] = *(const pg8::f32x4*)(p + 4 * lane + 256 * j);
}
__device__ __forceinline__ float row_ss(const pg8::f32x4 (&v)[4]) {
    float s = 0.f;
#pragma unroll
    for (int j = 0; j < 4; ++j) s += (v[j][0] * v[j][0] + v[j][1] * v[j][1]) + (v[j][2] * v[j][2] + v[j][3] * v[j][3]);
    return wave_sum(s);
}
__device__ __forceinline__ void row_normmod(const pg8::f32x4 (&x)[4], const float* g, const float* mb, int sh_off, int sc_off, bf16_t* hrow, pg8::f32x4 (&hv)[4], int lane) {
    const float rstd = rsqrtf(row_ss(x) * (1.0f / D) + 1e-6f);
#pragma unroll
    for (int j = 0; j < 4; ++j) { const int d = 4 * lane + 256 * j;
        const pg8::f32x4 gg = *(const pg8::f32x4*)(g + d), sc = *(const pg8::f32x4*)(mb + sc_off + d), sh = *(const pg8::f32x4*)(mb + sh_off + d);
        hv[j] = x[j] * rstd * gg * (1.0f + sc) + sh;
        pg8::u32x2 w; w.x = pk2(hv[j][0], hv[j][1]); w.y = pk2(hv[j][2], hv[j][3]);
        *(pg8::u32x2*)(hrow + d) = w; }
}
template <int CTRL, int ROWMASK> __device__ __forceinline__ float dpp_mov_p(float old, float x) {
    return __builtin_bit_cast(float, __builtin_amdgcn_update_dpp(__builtin_bit_cast(int, old), __builtin_bit_cast(int, x), CTRL, ROWMASK, 0xF, false)); }
__device__ __forceinline__ float wave_sum63p(float x) {
    x += dpp_mov_p<0xB1, 0xF>(0.f, x); x += dpp_mov_p<0x4E, 0xF>(0.f, x); x += dpp_mov_p<0x141, 0xF>(0.f, x); x += dpp_mov_p<0x140, 0xF>(0.f, x);
    x += dpp_mov_p<0x142, 0xA>(0.f, x); x += dpp_mov_p<0x143, 0xC>(0.f, x); return x; }
__device__ __forceinline__ void stage_wz(const float* w_in_l, LAS float* wz, int tid) {
    for (int i = tid; i < 1024 * 4; i += NTHR) { const int d = i >> 2, q = i & 3; const pg8::f32x4 w = *(const pg8::f32x4*)(w_in_l + (size_t)d * NIN + 768 + 4 * q);
        wz[(4 * q) * 1024 + d] = w[0]; wz[(4 * q + 1) * 1024 + d] = w[1]; wz[(4 * q + 2) * 1024 + d] = w[2]; wz[(4 * q + 3) * 1024 + d] = w[3]; }
    __syncthreads();
}
__device__ __forceinline__ void row_gz(const pg8::f32x4 (&hv)[4], const LAS float* wz, bf16_t* gzrow, int lane) {
    float mine = 0.f;
#pragma unroll
    for (int o = 0; o < 16; ++o) { float acc = 0.f;
#pragma unroll
        for (int j = 0; j < 4; ++j) { const pg8::f32x4 w = *(const LAS pg8::f32x4*)(wz + o * 1024 + 4 * lane + 256 * j); acc += (hv[j][0] * w[0] + hv[j][1] * w[1]) + (hv[j][2] * w[2] + hv[j][3] * w[3]); }
        const float s = __builtin_bit_cast(float, __builtin_amdgcn_readlane(__builtin_bit_cast(int, wave_sum63p(acc)), 63)); if (lane == o) mine = s; }
    if (lane < 16) gzrow[lane] = (bf16_t)f2bf(mine);
}
__device__ __forceinline__ void ph_h0(Frame& F, ArgsP a) {
    const float* x = (const float*)a->in[0]; const float* g = (const float*)a->in[5]; const float* mod = (const float*)(a->ws + WS_MOD); bf16_t* H = (bf16_t*)(a->ws + WS_HB);
    bf16_t* GZ = (bf16_t*)(a->ws + WS_GZ); LAS float* wz = (LAS float*)F.lds;
    int lane0 = F.lane(); asm volatile("" : "+v"(lane0));
    stage_wz((const float*)a->in[9], wz, F.wave * 64 + lane0);
    int row = F.gw; if (row >= M) return;
    pg8::f32x4 xn[4]; row_load(x + (size_t)row * D, xn, lane0);
    for (;;) { int lane = lane0; asm volatile("" : "+v"(lane)); pg8::f32x4 xv[4], hv[4];
#pragma unroll
        for (int j = 0; j < 4; ++j) xv[j] = xn[j];
        const int nrow = row + F.NGW; if (nrow < M) row_load(x + (size_t)nrow * D, xn, lane);
        row_normmod(xv, g, mod + (size_t)(row / T) * 6144, 0, 1024, H + (size_t)row * D, hv, lane);
        row_gz(hv, wz, GZ + (size_t)row * 16, lane);
        if (nrow >= M) break; row = nrow; }
}
__device__ __forceinline__ void moe_slot_load(const bf16_t* eout, const bf16_t* part, const pg8::MoeSplit sp, int g, int lane, pg8::u32x2 (&e)[4]) {
    const int tau = g >> 8;
    if (sp.s > 1 && tau >= sp.tau0) {
        const bf16_t* p = part + ((size_t)(tau - sp.tau0) * 256 + (g & 255)) * D + 4 * lane; const size_t ps = (size_t)sp.nrt * 256 * D;
        float ac[16];
#pragma unroll
        for (int i = 0; i < 16; ++i) ac[i] = 0.f;
        if (sp.s == 7) { pg8::u32x2 w[7][4];
#pragma unroll
            for (int k = 0; k < 7; ++k)
#pragma unroll
                for (int j = 0; j < 4; ++j) w[k][j] = *(const pg8::u32x2*)(p + k * ps + 256 * j);
#pragma unroll
            for (int k = 0; k < 7; ++k)
#pragma unroll
                for (int j = 0; j < 4; ++j) { ac[4 * j] += __builtin_bit_cast(float, w[k][j].x << 16); ac[4 * j + 1] += __builtin_bit_cast(float, w[k][j].x & 0xffff0000u); ac[4 * j + 2] += __builtin_bit_cast(float, w[k][j].y << 16); ac[4 * j + 3] += __builtin_bit_cast(float, w[k][j].y & 0xffff0000u); }
        } else {
#pragma unroll 1
            for (int k = 0; k < sp.s; ++k)
#pragma unroll
                for (int j = 0; j < 4; ++j) { const pg8::u32x2 w = *(const pg8::u32x2*)(p + k * ps + 256 * j);
                    ac[4 * j] += __builtin_bit_cast(float, w.x << 16); ac[4 * j + 1] += __builtin_bit_cast(float, w.x & 0xffff0000u); ac[4 * j + 2] += __builtin_bit_cast(float, w.y << 16); ac[4 * j + 3] += __builtin_bit_cast(float, w.y & 0xffff0000u); }
        }
#pragma unroll
        for (int j = 0; j < 4; ++j) { e[j].x = pk2(ac[4 * j], ac[4 * j + 1]); e[j].y = pk2(ac[4 * j + 2], ac[4 * j + 3]); }
    } else {
#pragma unroll
        for (int j = 0; j < 4; ++j) e[j] = *(const pg8::u32x2*)(eout + (size_t)g * D + 4 * lane + 256 * j);
    }
}
__device__ __forceinline__ void row_y_load(const bf16_t* y, const bf16_t* eout, const int* toks, int row, int lane, pg8::f32x4 (&yv)[4], pg8::u32x2 (&e1)[4], pg8::u32x2 (&e2)[4], const bf16_t* part, const pg8::MoeSplit sp) {
    if (eout) {
        const int g1 = toks[row * 2], g2 = toks[row * 2 + 1];
        moe_slot_load(eout, part, sp, g1, lane, e1); moe_slot_load(eout, part, sp, g2, lane, e2);
    } else {
#pragma unroll
        for (int j = 0; j < 4; ++j) e1[j] = *(const pg8::u32x2*)(y + (size_t)row * D + 4 * lane + 256 * j); }
}
__device__ __forceinline__ void ph_row(Frame& F, ArgsP a, const float* xold, const bf16_t* y, const float* gpost, const float* modl, int gt_off,
                                       const float* gpre, const float* modn, int sh_off, int sc_off, bf16_t* hdst, bool route, const bf16_t* eout = nullptr, const float* w_in_next = nullptr) {
    float* out = a->out;
    bf16_t* GZ = (bf16_t*)(a->ws + WS_GZ); LAS float* wz = (LAS float*)F.lds;
    if (w_in_next) { int t_ = F.wave * 64 + F.lane(); stage_wz(w_in_next, wz, t_); }
    const float* rw = (const float*)a->in[35]; const float* rb = (const float*)a->in[36];
    const unsigned* cnt = (const unsigned*)(a->ws + WS_CTL) + CW_CNT;
    int* bcnt = (int*)(a->ws + WS_ROUTE + RT_BCNT); int* toke = (int*)(a->ws + WS_ROUTE + RT_TOKE); int* toks = (int*)(a->ws + WS_ROUTE + RT_TOKS); float* tokp = (float*)(a->ws + WS_ROUTE + RT_TOKP);
    LAS int* ENTE = (LAS int*)(F.lds + 65536); LAS float* ENTP = (LAS float*)(F.lds + 65536 + 2048); LAS float* RWL = (LAS float*)(F.lds + 69632);
    if (route) { int t_ = F.wave * 64 + F.lane(); asm volatile("" : "+v"(t_));
#pragma unroll
        for (int i = 0; i < 2; ++i) { const int d = t_ + i * NTHR; const pg8::f32x4 w0 = *(const pg8::f32x4*)(rw + d * 8), w1 = *(const pg8::f32x4*)(rw + d * 8 + 4);
            LAS float* dp = RWL + (((d >> 8) * 4 + (d & 3)) * 64 + ((d & 255) >> 2)) * 8; *(LAS pg8::f32x4*)dp = w0; *(LAS pg8::f32x4*)(dp + 4) = w1; }
        __syncthreads(); }
    int row = F.gw;
    if (row < M) {
    int lane0 = F.lane(); asm volatile("" : "+v"(lane0));
    pg8::f32x4 yn[4], xn[4]; pg8::u32x2 e1n[4], e2n[4];
    pg8::MoeSplit sp{0, 0, 1}; if (eout) sp = pg8::moe_split(cnt, F.G); const bf16_t* part = (const bf16_t*)(a->ws + WS_WM1);
    row_y_load(y, eout, toks, row, lane0, yn, e1n, e2n, part, sp); row_load(xold + (size_t)row * D, xn, lane0);
    for (int kit = 0;; ++kit) {
        int lane = lane0; asm volatile("" : "+v"(lane));
        const int b = row / T; pg8::f32x4 yv[4], xv[4], hv[4];
        if (eout) { const float p1 = tokp[row * 2], p2 = tokp[row * 2 + 1];
#pragma unroll
            for (int j = 0; j < 4; ++j) { const pg8::u32x2 a1 = e1n[j], a2 = e2n[j];
                yv[j][0] = p1 * __builtin_bit_cast(float, a1.x << 16) + p2 * __builtin_bit_cast(float, a2.x << 16); yv[j][1] = p1 * __builtin_bit_cast(float, a1.x & 0xffff0000u) + p2 * __builtin_bit_cast(float, a2.x & 0xffff0000u);
                yv[j][2] = p1 * __builtin_bit_cast(float, a1.y << 16) + p2 * __builtin_bit_cast(float, a2.y << 16); yv[j][3] = p1 * __builtin_bit_cast(float, a1.y & 0xffff0000u) + p2 * __builtin_bit_cast(float, a2.y & 0xffff0000u); }
        } else {
#pragma unroll
            for (int j = 0; j < 4; ++j) { const pg8::u32x2 a1 = e1n[j]; yv[j][0] = __builtin_bit_cast(float, a1.x << 16); yv[j][1] = __builtin_bit_cast(float, a1.x & 0xffff0000u); yv[j][2] = __builtin_bit_cast(float, a1.y << 16); yv[j][3] = __builtin_bit_cast(float, a1.y & 0xffff0000u); } }
#pragma unroll
        for (int j = 0; j < 4; ++j) xv[j] = xn[j];
        const int nrow = row + F.NGW;
        if (nrow < M) { row_y_load(y, eout, toks, nrow, lane, yn, e1n, e2n, part, sp); row_load(xold + (size_t)nrow * D, xn, lane); }
        const float rstd = rsqrtf(row_ss(yv) * (1.0f / D) + 1e-6f);
        const float* mb = modl + (size_t)b * 6144;
#pragma unroll
        for (int j = 0; j < 4; ++j) { const int d = 4 * lane + 256 * j;
            const pg8::f32x4 gp = *(const pg8::f32x4*)(gpost + d), gt = *(const pg8::f32x4*)(mb + gt_off + d);
            xv[j] = xv[j] + gt * (yv[j] * rstd * gp);
            *(pg8::f32x4*)(out + (size_t)row * D + d) = xv[j]; }
        if (hdst) {
            row_normmod(xv, gpre, modn + (size_t)b * 6144, sh_off, sc_off, hdst + (size_t)row * D, hv, lane);
            if (w_in_next) row_gz(hv, wz, GZ + (size_t)row * 16, lane);
            if (route) {
                float lg[8];
#pragma unroll
                for (int e = 0; e < 8; ++e) lg[e] = 0.f;
#pragma unroll
                for (int j = 0; j < 4; ++j)
#pragma unroll
                    for (int q = 0; q < 4; ++q) { const LAS float* wp = RWL + ((j * 4 + q) * 64 + lane) * 8; const pg8::f32x4 w0 = *(const LAS pg8::f32x4*)wp, w1 = *(const LAS pg8::f32x4*)(wp + 4); const float hq = hv[j][q];
                        lg[0] += hq * w0[0]; lg[1] += hq * w0[1]; lg[2] += hq * w0[2]; lg[3] += hq * w0[3]; lg[4] += hq * w1[0]; lg[5] += hq * w1[1]; lg[6] += hq * w1[2]; lg[7] += hq * w1[3]; }
#pragma unroll
                for (int e = 0; e < 8; ++e) lg[e] = wave_sum(lg[e]) + rb[e];
                if (lane == 0) {
                    int e1 = 0; float v1 = lg[0];
#pragma unroll
                    for (int e = 1; e < 8; ++e) if (lg[e] > v1) { v1 = lg[e]; e1 = e; }
                    int e2 = -1; float v2 = -3.0e38f;
#pragma unroll
                    for (int e = 0; e < 8; ++e) if (e != e1 && lg[e] > v2) { v2 = lg[e]; e2 = e; }
                    const float p1 = 1.0f / (1.0f + __expf(v2 - v1));
                    ENTE[kit * 8 + F.wave] = e1 | (e2 << 8); ENTP[kit * 8 + F.wave] = p1;
                }
            }
        }
        if (nrow >= M) break; row = nrow;
    }
    }
    if (route) {
        __syncthreads();
        if (F.wave == 0) {
            int lane = F.lane(); asm volatile("" : "+v"(lane));
            const unsigned long long ltm = (1ull << lane) - 1ull;
            const int r0 = (int)blockIdx.x * NWAVES; const int nent = (r0 < M) ? ((M - 1 - r0) / F.NGW + 1) * NWAVES : 0;
            int run[8];
#pragma unroll
            for (int e = 0; e < 8; ++e) run[e] = 0;
            for (int g0 = 0; g0 < nent; g0 += 64) { const int idx = g0 + lane; const int rr = r0 + (idx & 7) + (idx >> 3) * F.NGW; const bool valid = idx < nent && rr < M;
                const int ee = valid ? ENTE[idx] : 0xffff; const float p1 = valid ? ENTP[idx] : 0.f; const int x1 = ee & 255, x2 = ee >> 8; int l1 = 0, l2 = 0;
#pragma unroll
                for (int e = 0; e < 8; ++e) { const unsigned long long m1 = __ballot(x1 == e), m2 = __ballot(x2 == e); const int c1 = __popcll(m1);
                    if (x1 == e) l1 = run[e] + __popcll(m1 & ltm); if (x2 == e) l2 = run[e] + c1 + __popcll(m2 & ltm); run[e] += c1 + __popcll(m2); }
                if (valid) { *(pg8::u32x2*)(toke + rr * 2) = (pg8::u32x2){(unsigned)x1, (unsigned)x2}; *(pg8::u32x2*)(toks + rr * 2) = (pg8::u32x2){(unsigned)l1, (unsigned)l2}; *(pg8::f32x2*)(tokp + rr * 2) = (pg8::f32x2){p1, 1.0f - p1}; } }
            int mine = 0;
#pragma unroll
            for (int e = 0; e < 8; ++e) if (lane == e) mine = run[e];
            if (lane < 8) bcnt[(int)blockIdx.x * 8 + lane] = mine;
        }
    }
}

__device__ __forceinline__ void ph_moe_prep(Frame& F, ArgsP a) {
    LAS float* scr = (LAS float*)(F.lds + F.wave * 8704);
    const float* mg = (const float*)a->in[37]; const float* mu = (const float*)a->in[38]; const float* md = (const float*)a->in[39];
    bf16_t* WM1 = (bf16_t*)(a->ws + WS_WM1); bf16_t* WM2 = (bf16_t*)(a->ws + WS_WM2);
    constexpr int I_1 = 8 * 224 * 16, I_2 = 8 * 32 * 56;
    int lane_ = F.lane(); asm volatile("" : "+v"(lane_));
    const int n = 4 * (lane_ & 7);
    auto desc = [&](int r) -> CvtDesc {
        if (r < I_1) { const int e = r / 3584, q = r % 3584, nb = q / 16, kb = q % 16; const int v = nb * 32 + n; const int up = (v >> 2) & 1, j = (v >> 3) * 4 + (v & 3);
            return CvtDesc{(up ? mu : mg) + (size_t)e * 1024 * DEX + j, (size_t)DEX, WM1 + (size_t)e * 7168 * 1024, 1024, nb * 32, kb * 64}; }
        r -= I_1; const int e = r / 1792, q = r % 1792, nb = q / 56, kb = q % 56;
        return CvtDesc{md + (size_t)e * DEX * 1024 + nb * 32 + n, 1024, WM2 + (size_t)e * 1024 * DEX, DEX, nb * 32, kb * 64}; };
    { int it = F.gw;
      if (it < I_1 + I_2) { CvtDesc cur = desc(it); pg8::f32x4 v[8]; cvt_load(cur, v, lane_);
        for (;;) { const int nx = it + F.NGW; const bool more = nx < I_1 + I_2; CvtDesc nd = cur; pg8::f32x4 w[8];
            if (more) { nd = desc(nx); cvt_load(nd, w, lane_); }
            cvt_store(cur, v, scr, lane_);
            if (!more) break;
#pragma unroll
            for (int i = 0; i < 8; ++i) v[i] = w[i];
            cur = nd; it = nx; } } }
    unsigned* cnt = (unsigned*)(a->ws + WS_CTL) + CW_CNT; const int* bcnt = (const int*)(a->ws + WS_ROUTE + RT_BCNT);
    const int* toke = (const int*)(a->ws + WS_ROUTE + RT_TOKE); int* toks = (int*)(a->ws + WS_ROUTE + RT_TOKS);
    const bf16_t* h2 = (const bf16_t*)(a->ws + WS_H2L1); bf16_t* hg = (bf16_t*)(a->ws + WS_HG);
    LAS int* SB = (LAS int*)(F.lds + 8 * 8704);
    if (F.wave == 0) { float tot[8], pre[8];
#pragma unroll
        for (int e = 0; e < 8; ++e) { tot[e] = 0.f; pre[e] = 0.f; }
        for (int b = lane_; b < F.G; b += 64) { const pg8::u32x4 c0 = *(const pg8::u32x4*)(bcnt + b * 8), c1 = *(const pg8::u32x4*)(bcnt + b * 8 + 4); const float m = (b < (int)blockIdx.x) ? 1.f : 0.f;
#pragma unroll
            for (int e = 0; e < 4; ++e) { tot[e] += (float)c0[e]; pre[e] += m * (float)c0[e]; tot[4 + e] += (float)c1[e]; pre[4 + e] += m * (float)c1[e]; } }
#pragma unroll
        for (int e = 0; e < 8; ++e) { tot[e] = wave_sum(tot[e]); pre[e] = wave_sum(pre[e]); }
        if (lane_ == 0) { int o = 0;
#pragma unroll
            for (int e = 0; e < 8; ++e) { const int te = (int)tot[e]; SB[e] = o + (int)pre[e]; SB[8 + e] = te; SB[16 + e] = o; o += ((te + 255) >> 8) << 8; if (blockIdx.x == 0) cnt[e] = (unsigned)te; }
            SB[24] = o; } }
    __syncthreads();
    for (int r0 = F.gw; r0 < M; r0 += 4 * F.NGW) {
        int d1[4], d2[4]; pg8::u32x4 v0[4], v1[4];
#pragma unroll
        for (int u = 0; u < 4; ++u) { const int rr = r0 + u * F.NGW; d1[u] = -1; d2[u] = -1;
            if (rr < M) { const pg8::u32x2 ee = *(const pg8::u32x2*)(toke + rr * 2), ll = *(const pg8::u32x2*)(toks + rr * 2); d1[u] = SB[ee.x] + (int)ll.x; d2[u] = SB[ee.y] + (int)ll.y;
                const pg8::u32x4* sp = (const pg8::u32x4*)(h2 + (size_t)rr * D) + 2 * lane_; v0[u] = sp[0]; v1[u] = sp[1]; } }
#pragma unroll
        for (int u = 0; u < 4; ++u) { const int rr = r0 + u * F.NGW;
            if (rr < M) { pg8::u32x4* q1 = (pg8::u32x4*)(hg + (size_t)d1[u] * D) + 2 * lane_; pg8::u32x4* q2 = (pg8::u32x4*)(hg + (size_t)d2[u] * D) + 2 * lane_; q1[0] = v0[u]; q1[1] = v1[u]; q2[0] = v0[u]; q2[1] = v1[u];
                if (lane_ == 0) *(pg8::u32x2*)(toks + rr * 2) = (pg8::u32x2){(unsigned)d1[u], (unsigned)d2[u]}; } }
    }
    { int npad[8], ptot = 0;
#pragma unroll
      for (int e = 0; e < 8; ++e) { npad[e] = (256 - (SB[8 + e] & 255)) & 255; ptot += npad[e]; }
      for (int pi = F.gw; pi < ptot; pi += F.NGW) { int rem = pi, dst = 0; bool found = false;
#pragma unroll
          for (int e = 0; e < 8; ++e) { if (!found && rem < npad[e]) { dst = SB[16 + e] + SB[8 + e] + rem; found = true; } if (!found) rem -= npad[e]; }
          pg8::u32x4* q = (pg8::u32x4*)(hg + (size_t)dst * D) + 2 * lane_; q[0] = (pg8::u32x4){0u, 0u, 0u, 0u}; q[1] = (pg8::u32x4){0u, 0u, 0u, 0u}; } }
}
typedef float f32x16 __attribute__((ext_vector_type(16)));
template <int CTRL, int ROWMASK> __device__ __forceinline__ float dpp_mov(float old, float x) {
    return __builtin_bit_cast(float, __builtin_amdgcn_update_dpp(__builtin_bit_cast(int, old), __builtin_bit_cast(int, x), CTRL, ROWMASK, 0xF, false));
}
__device__ __forceinline__ float rdlane(float x, int l) { return __builtin_bit_cast(float, __builtin_amdgcn_readlane(__builtin_bit_cast(int, x), l)); }
__device__ __forceinline__ float wave_sum63(float x) {
    x += dpp_mov<0xB1, 0xF>(0.f, x);
    x += dpp_mov<0x4E, 0xF>(0.f, x);
    x += dpp_mov<0x141, 0xF>(0.f, x);
    x += dpp_mov<0x140, 0xF>(0.f, x);
    x += dpp_mov<0x142, 0xA>(0.f, x);
    x += dpp_mov<0x143, 0xC>(0.f, x);
    return x;
}
__device__ __forceinline__ float row16_sum(float x) {
    x += dpp_mov<0xB1, 0xF>(0.f, x); x += dpp_mov<0x4E, 0xF>(0.f, x); x += dpp_mov<0x141, 0xF>(0.f, x); x += dpp_mov<0x140, 0xF>(0.f, x);
    return x;
}
__device__ __forceinline__ pg8::f32x4 ld_bf16x4(const bf16_t* p) { const pg8::u32x2 w = *(const pg8::u32x2*)p;
    return (pg8::f32x4){__builtin_bit_cast(float, w.x << 16), __builtin_bit_cast(float, w.x & 0xffff0000u), __builtin_bit_cast(float, w.y << 16), __builtin_bit_cast(float, w.y & 0xffff0000u)}; }
__device__ __forceinline__ void st_bf16x4(bf16_t* p, pg8::f32x4 v) { pg8::u32x2 w; w.x = pk2(v[0], v[1]); w.y = pk2(v[2], v[3]); *(pg8::u32x2*)p = w; }

__device__ __forceinline__ void ph_conv(Frame& F, ArgsP a, int l) {
    const bf16_t* proj = (const bf16_t*)(a->ws + WS_PROJ); bf16_t* br = (bf16_t*)(a->ws + WS_HB);
    const float* cw = (const float*)a->in[15] + l * 31 * 256; const float* cb = (const float*)a->in[16] + l * 256; const float* lg = (const float*)a->in[17] + l * 256; const float* lb = (const float*)a->in[18] + l * 256;
    LAS float* u = (LAS float*)F.lds;
    int tid = F.wave * 64 + F.lane(); asm volatile("" : "+v"(tid)); const int lane = tid & 63;
    for (int it = blockIdx.x; it < M / 64; it += F.G) {
        const int row0 = it * 64, t0 = row0 % T;
#pragma unroll
        for (int i_ = 0; i_ < 6; ++i_) { const int idx = tid + i_ * NTHR; if (idx >= 94 * 32) break; const int r = idx >> 5, c8 = (idx & 31) * 8; float uv[8];
#pragma unroll
            for (int e = 0; e < 8; ++e) uv[e] = 0.f;
            if (t0 - 30 + r >= 0) { const bf16_t* pr = proj + (size_t)(row0 - 30 + r) * PW;
                const pg8::f32x4 a0 = ld_bf16x4(pr + P_CA + c8), a1 = ld_bf16x4(pr + P_CA + c8 + 4), b0 = ld_bf16x4(pr + P_CB + c8), b1 = ld_bf16x4(pr + P_CB + c8 + 4);
#pragma unroll
                for (int e = 0; e < 4; ++e) { uv[e] = a0[e] * sigm(b0[e]); uv[4 + e] = a1[e] * sigm(b1[e]); } }
            *(LAS pg8::f32x4*)(u + r * 256 + c8) = (pg8::f32x4){uv[0], uv[1], uv[2], uv[3]}; *(LAS pg8::f32x4*)(u + r * 256 + c8 + 4) = (pg8::f32x4){uv[4], uv[5], uv[6], uv[7]}; }
        __syncthreads();
        const int c = tid & 255, half = tid >> 8;
        float acc[32];
        { float w[31], ur[62];
#pragma unroll
          for (int j = 0; j < 31; ++j) w[j] = cw[j * 256 + c];
#pragma unroll
          for (int q = 0; q < 62; ++q) ur[q] = u[(half * 32 + q) * 256 + c];
          const float bias = cb[c];
#pragma unroll
          for (int i = 0; i < 32; ++i) { float s = bias;
#pragma unroll
              for (int j = 0; j < 31; ++j) s += w[j] * ur[i + j];
              acc[i] = s; } }
        __syncthreads();
#pragma unroll
        for (int i = 0; i < 32; ++i) u[(half * 32 + i) * 256 + c] = acc[i];
        __syncthreads();
        const pg8::f32x4 g4 = *(const pg8::f32x4*)(lg + 4 * lane), b4 = *(const pg8::f32x4*)(lb + 4 * lane);
#pragma unroll 2
        for (int q = 0; q < 8; ++q) { const int t = F.wave * 8 + q; const pg8::f32x4 yv = *(const LAS pg8::f32x4*)(u + t * 256 + 4 * lane);
            const float mu = wave_sum((yv[0] + yv[1]) + (yv[2] + yv[3])) * (1.0f / 256.0f); const pg8::f32x4 d = yv - mu;
            const float var = wave_sum((d[0] * d[0] + d[1] * d[1]) + (d[2] * d[2] + d[3] * d[3])) * (1.0f / 256.0f);
            pg8::f32x4 o = d * rsqrtf(var + 1e-5f) * g4 + b4;
#pragma unroll
            for (int e = 0; e < 4; ++e) o[e] = siluf(o[e]);
            st_bf16x4(br + (size_t)(row0 + t) * D + 512 + 4 * lane, o); }
        __syncthreads();
    }
}

__device__ __forceinline__ void ph_rwkv_prep(Frame& F, ArgsP a, int l) {
        const bf16_t* proj = (const bf16_t*)(a->ws + WS_PROJ);
    const float* mu = (const float*)a->in[19] + l * 1024; const float* w0 = (const float*)a->in[20] + l * 256; const float* a0 = (const float*)a->in[22] + l * 256;
    const float* kkw = (const float*)a->in[25] + l * 256; const float* kaw = (const float*)a->in[26] + l * 256; const float* rkw = (const float*)a->in[27] + l * 256;
    const bf16_t* W2T = (const bf16_t*)(a->ws + WS_LR) + l * 256 * 64; const bf16_t* A2T = (const bf16_t*)(a->ws + WS_LR) + 2 * 256 * 64 + l * 256 * 64; const bf16_t* G2T = (const bf16_t*)(a->ws + WS_LR) + 4 * 256 * 64 + l * 256 * 128;
    unsigned char* VEC = a->ws + SCR_VEC6; float* SC = (float*)(a->ws + SCR_SC); bf16_t* GR = (bf16_t*)(a->ws + SCR_GR);
    constexpr int RS = 72, RG = 136;
    LAS bf16_t* TZh = (LAS bf16_t*)F.lds; LAS bf16_t* TZl = TZh + 64 * RS; LAS bf16_t* ZA = TZl + 64 * RS; LAS bf16_t* SG = ZA + 64 * RS;
    int tid = F.wave * 64 + F.lane(); asm volatile("" : "+v"(tid));
    for (int it = blockIdx.x; it < M / 64; it += F.G) {
        const int row0 = it * 64, b = row0 / T, t0 = row0 % T;
#pragma unroll 4
        for (int i_ = 0; i_ < 32; ++i_) { const int idx = tid + i_ * NTHR; const int cc = idx & 255, tok = idx >> 8; const int col = 768 + cc;
            const bf16_t* pc = proj + (size_t)(row0 + tok) * PW + P_R + col; const float xc = bf2f(pc[0]); const float xp = (t0 + tok > 0) ? bf2f(pc[-PW]) : 0.f;
            const float xm = xc + (xp - xc) * mu[col];
            if (cc < 64) { const float tv = tanh_fast(xm); const unsigned hi = f2bf(tv); TZh[tok * RS + cc] = (bf16_t)hi; TZl[tok * RS + cc] = (bf16_t)f2bf(tv - __builtin_bit_cast(float, hi << 16)); }
            else if (cc < 128) ZA[tok * RS + cc - 64] = (bf16_t)f2bf(xm);
            else SG[tok * RG + cc - 128] = (bf16_t)f2bf(sigm(xm)); }
        __syncthreads();
        int tid2 = tid; asm volatile("" : "+v"(tid2));
        const int lane = tid2 & 63, r = lane & 31, hg = lane >> 5, h = (tid2 >> 6) & 3, th = tid2 >> 8;
        f32x16 accw[2], acca[2], accg[2];
#pragma unroll
        for (int nb = 0; nb < 2; ++nb)
#pragma unroll
            for (int e = 0; e < 16; ++e) { accw[nb][e] = 0.f; acca[nb][e] = 0.f; accg[nb][e] = 0.f; }
        const int arow = (th * 32 + r);
#pragma unroll
        for (int s = 0; s < 4; ++s) { const pg8::bf16x8 ah = *(const LAS pg8::bf16x8*)(TZh + arow * RS + 16 * s + 8 * hg), al = *(const LAS pg8::bf16x8*)(TZl + arow * RS + 16 * s + 8 * hg), az = *(const LAS pg8::bf16x8*)(ZA + arow * RS + 16 * s + 8 * hg);
#pragma unroll
            for (int nb = 0; nb < 2; ++nb) { const int n = h * 64 + nb * 32 + r;
                const pg8::bf16x8 bw = *(const pg8::bf16x8*)(W2T + n * 64 + 16 * s + 8 * hg), ba = *(const pg8::bf16x8*)(A2T + n * 64 + 16 * s + 8 * hg);
                accw[nb] = __builtin_amdgcn_mfma_f32_32x32x16_bf16(ah, bw, accw[nb], 0, 0, 0); accw[nb] = __builtin_amdgcn_mfma_f32_32x32x16_bf16(al, bw, accw[nb], 0, 0, 0);
                acca[nb] = __builtin_amdgcn_mfma_f32_32x32x16_bf16(az, ba, acca[nb], 0, 0, 0); } }
#pragma unroll
        for (int s = 0; s < 8; ++s) { const pg8::bf16x8 ag = *(const LAS pg8::bf16x8*)(SG + arow * RG + 16 * s + 8 * hg);
#pragma unroll
            for (int nb = 0; nb < 2; ++nb) { const int n = h * 64 + nb * 32 + r; const pg8::bf16x8 bg = *(const pg8::bf16x8*)(G2T + n * 128 + 16 * s + 8 * hg);
                accg[nb] = __builtin_amdgcn_mfma_f32_32x32x16_bf16(ag, bg, accg[nb], 0, 0, 0); } }
        int tid3 = tid; asm volatile("" : "+v"(tid3)); const int r3 = tid3 & 31, hg3 = (tid3 >> 5) & 1, h3 = (tid3 >> 6) & 3, th3 = tid3 >> 8;
        float pw0[2], pa0[2], pmr[2], pmk[2], pmv[2], pkk[2], pka[2], prk[2];
#pragma unroll
        for (int nb = 0; nb < 2; ++nb) { const int c = h3 * 64 + nb * 32 + r3; pw0[nb] = w0[c]; pa0[nb] = a0[c]; pmr[nb] = mu[c]; pmk[nb] = mu[256 + c]; pmv[nb] = mu[512 + c]; pkk[nb] = kkw[c]; pka[nb] = kaw[c]; prk[nb] = rkw[c]; }
#pragma unroll
        for (int e = 0; e < 16; ++e) { const int tok = th3 * 32 + (e & 3) + 8 * (e >> 2) + 4 * hg3, t = t0 + tok; const size_t row = (size_t)row0 + tok; const bool hp = t > 0;
            float dec[2], kkv[2], kka[2], k2[2], rv[2], vv[2], s_kk = 0.f, s_c1 = 0.f, s_c2 = 0.f, s_bn = 0.f;
#pragma unroll
            for (int nb = 0; nb < 2; ++nb) { const int c = h3 * 64 + nb * 32 + r3; const bf16_t* pc = proj + row * PW + P_R + c;
                const float rc = bf2f(pc[0]), kc = bf2f(pc[256]), vc = bf2f(pc[512]);
                const float rp = hp ? bf2f(pc[-PW]) : 0.f, kp = hp ? bf2f(pc[256 - PW]) : 0.f, vp = hp ? bf2f(pc[512 - PW]) : 0.f;
                const float rr = rc + (rp - rc) * pmr[nb], k = kc + (kp - kc) * pmk[nb]; vv[nb] = vc + (vp - vc) * pmv[nb]; rv[nb] = rr;
                const float wl = -softplusf(-(accw[nb][e] + pw0[nb])) - 0.5f; dec[nb] = -__expf(wl); const float av        = sigm(acca[nb][e] + pa0[nb]);
                kkv[nb] = k * pkk[nb]; k2[nb] = k * (1.0f + (av - 1.0f) * pka[nb]); kka[nb] = av;
                s_kk += kkv[nb] * kkv[nb]; s_c2 += k2[nb] * rr; s_bn += rr * k2[nb] * prk[nb];
                GR[row * 256 + c] = (bf16_t)f2bf(accg[nb][e]); }
            s_kk = row16_sum(s_kk); s_kk += __shfl_xor(s_kk, 16);
            const float inv = 1.0f / fmaxf(sqrtf(s_kk), 1e-12f);
#pragma unroll
            for (int nb = 0; nb < 2; ++nb) { kkv[nb] *= inv; kka[nb] *= kkv[nb]; s_c1 += kka[nb] * rv[nb]; }
            s_c1 = row16_sum(s_c1); s_c1 += __shfl_xor(s_c1, 16); s_c2 = row16_sum(s_c2); s_c2 += __shfl_xor(s_c2, 16); s_bn = row16_sum(s_bn); s_bn += __shfl_xor(s_bn, 16);
            const size_t st = ((size_t)(b * 4 + h3) * T + t);
#pragma unroll
            for (int nb = 0; nb < 2; ++nb) { unsigned char* rb = VEC + st * RECB; const int kx = nb * 32 + r3;
                *(float*)(rb + kx * 4) = dec[nb]; *(bf16_t*)(rb + 256 + kx * 2) = (bf16_t)f2bf(-kkv[nb]); *(bf16_t*)(rb + 384 + kx * 2) = (bf16_t)f2bf(kka[nb]);
                *(bf16_t*)(rb + 512 + kx * 2) = (bf16_t)f2bf(k2[nb]); *(bf16_t*)(rb + 640 + kx * 2) = (bf16_t)f2bf(rv[nb]); *(bf16_t*)(rb + 768 + kx * 2) = (bf16_t)f2bf(vv[nb]); }
            if (r3 == 0) *(pg8::f32x4*)(SC + st * 4) = (pg8::f32x4){s_c1, s_c2, s_bn, 0.f};
            asm volatile("" ::: "memory"); }
        __syncthreads();
    }
}

__device__ __forceinline__ void ph_rwkv_scan(Frame& F, ArgsP a) {
    const unsigned char* VEC = a->ws + SCR_VEC6; float* YR = (float*)(a->ws + SCR_YR); const float* SC = (const float*)(a->ws + SCR_SC); bf16_t* STM = (bf16_t*)(a->ws + SCR_STM);
    int lane = F.lane(); asm volatile("" : "+v"(lane));
    constexpr int CH = 32, CHB = CH * RECB, NP = CHB / 1024 / 4;
    const bool stager = F.wave >= 4;
    const int vcu = (F.G % 8 == 0) ? ((int)blockIdx.x % 8) * (F.G / 8) + (int)blockIdx.x / 8 : (int)blockIdx.x;
    for (int it = vcu; it < 256; it += F.G) {
        const int bh = it >> 3, rg = it & 7, b = bh >> 2, h = bh & 3;
        const int sw = F.wave & 3, vrow = rg * 8 + 2 * sw;
        const char* src = (const char*)(VEC + (size_t)bh * T * RECB) + lane * 16;
#define RW_STAGE(cidx) do { _Pragma("unroll") for (int p_ = 0; p_ < NP; ++p_) \
            __builtin_amdgcn_global_load_lds((const unsigned*)(src + (size_t)(cidx) * CHB + (sw * NP + p_) * 1024), (LAS unsigned*)(F.lds + ((cidx) & 1) * CHB + (sw * NP + p_) * 1024), 16, 0, 0); } while (0)
        if (stager) { RW_STAGE(0); asm volatile("s_waitcnt vmcnt(0)" ::: "memory"); }
        __builtin_amdgcn_s_barrier(); asm volatile("" ::: "memory");
        float SA = 0.f, SB = 0.f;
        for (int c = 0; c < T / CH; ++c) {
            if (stager) { if (c + 1 < T / CH) { RW_STAGE(c + 1); asm volatile("s_waitcnt vmcnt(0)" ::: "memory"); } }
            else {
                const LAS unsigned char* bufb = F.lds + (c & 1) * CHB;
                STM[(((size_t)bh * 64 + c) * 64 + vrow) * 64 + lane] = (bf16_t)f2bf(SA); STM[(((size_t)bh * 64 + c) * 64 + vrow + 1) * 64 + lane] = (bf16_t)f2bf(SB);
                float zaA = 0.f, zaB = 0.f, saaA = 0.f, saaB = 0.f;
#define RW_LD(S1, nw, nnkk, nkka, nk2, nr, nvp) do { const LAS unsigned char* rec_ = bufb + (S1) * RECB; nw = *(const LAS float*)(rec_ + lane * 4); nnkk = bf2f(*(const LAS bf16_t*)(rec_ + 256 + lane * 2)); \
                    nkka = bf2f(*(const LAS bf16_t*)(rec_ + 384 + lane * 2)); nk2 = bf2f(*(const LAS bf16_t*)(rec_ + 512 + lane * 2)); nr = bf2f(*(const LAS bf16_t*)(rec_ + 640 + lane * 2)); nvp = *(const LAS unsigned*)(rec_ + 768 + vrow * 2); } while (0)
                float nw, nnkk, nkka, nk2, nr; unsigned nvp; RW_LD(0, nw, nnkk, nkka, nk2, nr, nvp);
#define RW_STEP(SI) do { \
                    const float w_ = __expf(nw), nkk = nnkk, kka = nkka, k2 = nk2, wr = w_ * nr; const pg8::f32x2 v = {__builtin_bit_cast(float, nvp << 16), __builtin_bit_cast(float, nvp & 0xffff0000u)}; \
                    RW_LD(((SI) + 1 < CH ? (SI) + 1 : (SI)), nw, nnkk, nkka, nk2, nr, nvp); \
                    asm volatile("" ::: "memory"); \
                    const auto s0 = __builtin_amdgcn_permlane32_swap(__builtin_bit_cast(unsigned, SA * nkk), __builtin_bit_cast(unsigned, SA * wr), false, false); \
                    const auto s1_ = __builtin_amdgcn_permlane32_swap(__builtin_bit_cast(unsigned, SB * nkk), __builtin_bit_cast(unsigned, SB * wr), false, false); \
                    const float xA = __builtin_bit_cast(float, (unsigned)s0[0]) + __builtin_bit_cast(float, (unsigned)s0[1]); \
                    const float xB = __builtin_bit_cast(float, (unsigned)s1_[0]) + __builtin_bit_cast(float, (unsigned)s1_[1]); \
                    const auto s2 = __builtin_amdgcn_permlane16_swap(__builtin_bit_cast(unsigned, xA), __builtin_bit_cast(unsigned, xB), false, false); \
                    float x = __builtin_bit_cast(float, (unsigned)s2[0]) + __builtin_bit_cast(float, (unsigned)s2[1]); \
                    x += dpp_mov<0xB1, 0xF>(0.f, x); x += dpp_mov<0x4E, 0xF>(0.f, x); x += dpp_mov<0x141, 0xF>(0.f, x); x += dpp_mov<0x140, 0xF>(0.f, x); \
                    const int isaA = __builtin_amdgcn_readlane(__builtin_bit_cast(int, x), 0), isaB = __builtin_amdgcn_readlane(__builtin_bit_cast(int, x), 16); \
                    const int izA = __builtin_amdgcn_readlane(__builtin_bit_cast(int, x), 32), izB = __builtin_amdgcn_readlane(__builtin_bit_cast(int, x), 48); \
                    const float saA = __builtin_bit_cast(float, isaA), saB = __builtin_bit_cast(float, isaB); \
                    SA = SA * w_ + (saA * kka + v[0] * k2); \
                    SB = SB * w_ + (saB * kka + v[1] * k2); \
                    asm volatile("v_writelane_b32 %0, %4, %8\n\tv_writelane_b32 %1, %5, %8\n\tv_writelane_b32 %2, %6, %8\n\tv_writelane_b32 %3, %7, %8" : "+v"(saaA), "+v"(saaB), "+v"(zaA), "+v"(zaB) : "s"(isaA), "s"(isaB), "s"(izA), "s"(izB), "n"(SI)); \
                } while (0)
                RW_STEP(0); RW_STEP(1); RW_STEP(2); RW_STEP(3); RW_STEP(4); RW_STEP(5); RW_STEP(6); RW_STEP(7); RW_STEP(8); RW_STEP(9); RW_STEP(10); RW_STEP(11); RW_STEP(12); RW_STEP(13); RW_STEP(14); RW_STEP(15); RW_STEP(16); RW_STEP(17); RW_STEP(18); RW_STEP(19); RW_STEP(20); RW_STEP(21); RW_STEP(22); RW_STEP(23); RW_STEP(24); RW_STEP(25); RW_STEP(26); RW_STEP(27); RW_STEP(28); RW_STEP(29); RW_STEP(30); RW_STEP(31);
#undef RW_STEP
#undef RW_LD
                const unsigned vp_ = *(const LAS unsigned*)(bufb + (lane & 31) * RECB + 768 + vrow * 2); const pg8::f32x2 vv = {__builtin_bit_cast(float, vp_ << 16), __builtin_bit_cast(float, vp_ & 0xffff0000u)};
                const pg8::f32x2 cc = *(const pg8::f32x2*)(SC + ((size_t)bh * T + c * CH + (lane & 31)) * 4);
                const float yaA = zaA + saaA * cc[0] + vv[0] * cc[1], yaB = zaB + saaB * cc[0] + vv[1] * cc[1];
                if (lane < CH) *(pg8::f32x2*)(YR + ((size_t)b * T + c * CH + lane) * 256 + h * 64 + vrow) = (pg8::f32x2){yaA, yaB};
            }
            __builtin_amdgcn_s_barrier(); asm volatile("" ::: "memory");
        }
#undef RW_STAGE
        asm volatile("s_waitcnt vmcnt(0)" ::: "memory"); __builtin_amdgcn_s_barrier(); asm volatile("" ::: "memory");
    }
}

__device__ __forceinline__ void ph_rwkv_post(Frame& F, ArgsP a, int l) {
    const unsigned char* VEC = a->ws + SCR_VEC6; const float* SC = (const float*)(a->ws + SCR_SC); const float* YR = (const float*)(a->ws + SCR_YR); const bf16_t* GR = (const bf16_t*)(a->ws + SCR_GR);
    const float* lng = (const float*)a->in[28] + l * 256; const float* lnb = (const float*)a->in[29] + l * 256;
    bf16_t* br = (bf16_t*)(a->ws + WS_HB);
    int lane = F.lane(); asm volatile("" : "+v"(lane));
    const int c = 4 * lane, h = lane >> 4;
    const pg8::f32x4 g4 = *(const pg8::f32x4*)(lng + c), b4 = *(const pg8::f32x4*)(lnb + c);
    for (int row = F.gw; row < M; row += F.NGW) {
        const int b = row / T, t = row % T; const size_t st = (size_t)(b * 4 + h) * T + t;
        const pg8::f32x4 y = *(const pg8::f32x4*)(YR + (size_t)row * 256 + c);
        const float mu = row16_sum((y[0] + y[1]) + (y[2] + y[3])) * (1.0f / 64.0f); const pg8::f32x4 d = y - mu;
        const float var = row16_sum((d[0] * d[0] + d[1] * d[1]) + (d[2] * d[2] + d[3] * d[3])) * (1.0f / 64.0f);
        const pg8::f32x4 yn = d * rsqrtf(var + 64e-5f) * g4 + b4;
        const float bonus = SC[st * 4 + 2];
        const pg8::f32x4 v = ld_bf16x4((const bf16_t*)(VEC + st * RECB + 768) + (c & 63));
        const pg8::f32x4 g = ld_bf16x4(GR + (size_t)row * 256 + c);
        st_bf16x4(br + (size_t)row * D + 768 + c, (yn + bonus * v) * g);
    }
}

__device__ __forceinline__ void ph_gla_p1(Frame& F, ArgsP a, int l) {
    const bf16_t* proj = (const bf16_t*)(a->ws + WS_PROJ); const float* w2 = (const float*)a->in[10] + l * 16 * 128; const float* gb = (const float*)a->in[11] + l * 128;
    bf16_t* QS = (bf16_t*)(a->ws + SCR_EG); float* CDp = (float*)(a->ws + SCR_EG) + (size_t)M * 128; float* GU = (float*)(a->ws + SCR_GU); float* OI = (float*)(a->ws + WS_GOI);
    const bf16_t* GZ = (const bf16_t*)(a->ws + WS_GZ);
    constexpr int RS = 40;
    LAS unsigned char* wl = F.lds + F.wave * 12800;
    LAS bf16_t* VTl = (LAS bf16_t*)wl; LAS bf16_t* Qs = (LAS bf16_t*)(wl + 5120); LAS bf16_t* Ks = (LAS bf16_t*)(wl + 7680); LAS bf16_t* KdT = (LAS bf16_t*)(wl + 10240);
    int lane = F.lane(); asm volatile("" : "+v"(lane));
    const int d = lane & 31, half = lane >> 5, r = lane & 31, hg = lane >> 5;
    for (int it = F.gw; it < 2048; it += F.NGW) {
        const int bh = it >> 6, n = it & 63, b = bh >> 2, h = bh & 3; const size_t row0 = (size_t)b * T + n * 32;
        float wc[16];
#pragma unroll
        for (int q = 0; q < 16; ++q) wc[q] = w2[q * 128 + h * 32 + d];
        const float gbv = gb[h * 32 + d];
        float g[16];
#pragma unroll
        for (int i = 0; i < 16; ++i) { const bf16_t* pr = GZ + (row0 + 16 * half + i) * 16;
            const pg8::f32x4 z0 = ld_bf16x4(pr), z1 = ld_bf16x4(pr + 4), z2 = ld_bf16x4(pr + 8), z3 = ld_bf16x4(pr + 12);
            float acc = gbv;
#pragma unroll
            for (int e = 0; e < 4; ++e) acc += z0[e] * wc[e] + z1[e] * wc[4 + e] + z2[e] * wc[8 + e] + z3[e] * wc[12 + e];
            g[i] = -softplusf(-acc) * (1.0f / 16.0f); }
#pragma unroll
        for (int i = 1; i < 16; ++i) g[i] += g[i - 1];
        const float other = __shfl(g[15], d);
        if (half) {
#pragma unroll
            for (int i = 0; i < 16; ++i) g[i] += other; }
        const float glast = __shfl(g[15], 32 + d);
#pragma unroll
        for (int i = 0; i < 16; ++i) { const int tok = 16 * half + i; const bf16_t* pr = proj + (row0 + tok) * PW;
            const float qv = bf2f(pr[P_GQ + h * 32 + d]), kv = bf2f(pr[P_GK + h * 32 + d]);
            const unsigned qb = f2bf(qv * 0.17677669529663687f * __expf(g[i]));
            Qs[tok * RS + d] = (bf16_t)qb; QS[((size_t)it * 32 + tok) * 32 + d] = (bf16_t)qb;
            Ks[tok * RS + d] = (bf16_t)f2bf(kv * __expf(-g[i])); KdT[d * RS + tok] = (bf16_t)f2bf(kv * __expf(glast - g[i])); }
        if (half) CDp[it * 32 + d] = __expf(glast);
        { const bf16_t* vp = proj + row0 * PW + P_GV + h * 64 + lane;
#pragma unroll
          for (int t2 = 0; t2 < 16; ++t2) { const unsigned lo = vp[(size_t)(2 * t2) * PW], hi = vp[(size_t)(2 * t2 + 1) * PW]; *(LAS unsigned*)(VTl + lane * RS + 2 * t2) = lo | (hi << 16); } }
        asm volatile("s_waitcnt lgkmcnt(0)" ::: "memory");
        f32x16 X;
#pragma unroll
        for (int e = 0; e < 16; ++e) X[e] = 0.f;
#pragma unroll
        for (int s = 0; s < 2; ++s) X = __builtin_amdgcn_mfma_f32_32x32x16_bf16(*(const LAS pg8::bf16x8*)(Ks + r * RS + 16 * s + 8 * hg), *(const LAS pg8::bf16x8*)(Qs + r * RS + 16 * s + 8 * hg), X, 0, 0, 0);
#pragma unroll
        for (int e = 0; e < 16; ++e) { const int jrow = (e & 3) + 8 * (e >> 2) + 4 * hg; if (jrow > r) X[e] = 0.f; }
        f32x16 oi[2], ut[2];
#pragma unroll
        for (int e = 0; e < 16; ++e) { oi[0][e] = 0.f; oi[1][e] = 0.f; ut[0][e] = 0.f; ut[1][e] = 0.f; }
#pragma unroll
        for (int s = 0; s < 2; ++s) {
            pg8::u32x4 pw; pw.x = pk2(X[8 * s], X[8 * s + 1]); pw.y = pk2(X[8 * s + 2], X[8 * s + 3]); pw.z = pk2(X[8 * s + 4], X[8 * s + 5]); pw.w = pk2(X[8 * s + 6], X[8 * s + 7]);
            const pg8::bf16x8 xf = __builtin_bit_cast(pg8::bf16x8, pw);
            const pg8::bf16x8 kdf = *(const LAS pg8::bf16x8*)(KdT + r * RS + 16 * s + 8 * hg);
#pragma unroll
            for (int db = 0; db < 2; ++db) { const LAS bf16_t* vp = VTl + (db * 32 + r) * RS + 16 * s;
                const pg8::u32x2 v0 = *(const LAS pg8::u32x2*)(vp + 4 * hg), v1 = *(const LAS pg8::u32x2*)(vp + 8 + 4 * hg);
                pg8::u32x4 vw; vw.x = v0.x; vw.y = v0.y; vw.z = v1.x; vw.w = v1.y;
                oi[db] = __builtin_amdgcn_mfma_f32_32x32x16_bf16(__builtin_bit_cast(pg8::bf16x8, vw), xf, oi[db], 0, 0, 0);
                ut[db] = __builtin_amdgcn_mfma_f32_32x32x16_bf16(*(const LAS pg8::bf16x8*)(vp + 8 * hg), kdf, ut[db], 0, 0, 0); } }
        float* op = OI + (size_t)it * 2048 + lane;
#pragma unroll
        for (int db = 0; db < 2; ++db)
#pragma unroll
            for (int e = 0; e < 16; ++e) op[(db * 16 + e) * 64] = oi[db][e];
        float* up = GU + ((size_t)it * 32 + r) * 64 + 4 * hg;
#pragma unroll
        for (int db = 0; db < 2; ++db)
#pragma unroll
            for (int q = 0; q < 4; ++q) *(pg8::f32x4*)(up + db * 32 + 8 * q) = (pg8::f32x4){ut[db][4 * q], ut[db][4 * q + 1], ut[db][4 * q + 2], ut[db][4 * q + 3]};
        asm volatile("s_waitcnt lgkmcnt(0)" ::: "memory");
    }
}
__device__ __forceinline__ void ph_gla_prefix(Frame& F, ArgsP a) {
    const float* CDp = (const float*)(a->ws + SCR_EG) + (size_t)M * 128; const float* GU = (const float*)(a->ws + SCR_GU); bf16_t* ST = (bf16_t*)(a->ws + WS_GST);
    int lane = F.lane(); asm volatile("" : "+v"(lane));
    for (int it = F.gw; it < 1024; it += F.NGW) { const int bh = it >> 5, d = it & 31;
        const float* gp = GU + ((size_t)bh * 64 * 32 + d) * 64 + lane; const float* cp = CDp + (size_t)bh * 64 * 32 + d;
        bf16_t* sp = ST + ((size_t)bh * 64 * 64 + lane) * 32 + d;
        float u[64], cd[64];
#pragma unroll
        for (int n = 0; n < 64; ++n) { u[n] = gp[(size_t)n * 2048]; cd[n] = cp[n * 32]; }
        float S = 0.f;
#pragma unroll
        for (int n = 0; n < 64; ++n) { sp[(size_t)n * 2048] = (bf16_t)f2bf(S); S = cd[n] * S + u[n]; } }
}
__device__ __forceinline__ void ph_gla_p2(Frame& F, ArgsP a, int l) {
    const bf16_t* proj = (const bf16_t*)(a->ws + WS_PROJ); const float* gnorm = (const float*)a->in[12] + l * 64;
    const bf16_t* QS = (const bf16_t*)(a->ws + SCR_EG); const bf16_t* ST = (const bf16_t*)(a->ws + WS_GST); const float* OI = (const float*)(a->ws + WS_GOI); bf16_t* br = (bf16_t*)(a->ws + WS_HB);
    int lane = F.lane(); asm volatile("" : "+v"(lane));
    const int r = lane & 31, hg = lane >> 5;
    for (int it = F.gw; it < 2048; it += F.NGW) {
        const int bh = it >> 6, n = it & 63, b = bh >> 2, h = bh & 3; const size_t row0 = (size_t)b * T + n * 32;
        f32x16 ot[2]; const float* op = OI + (size_t)it * 2048 + lane;
#pragma unroll
        for (int db = 0; db < 2; ++db)
#pragma unroll
            for (int e = 0; e < 16; ++e) ot[db][e] = op[(db * 16 + e) * 64];
#pragma unroll
        for (int s = 0; s < 2; ++s) { const pg8::bf16x8 qf = *(const pg8::bf16x8*)(QS + ((size_t)it * 32 + r) * 32 + 16 * s + 8 * hg);
#pragma unroll
            for (int db = 0; db < 2; ++db) ot[db] = __builtin_amdgcn_mfma_f32_32x32x16_bf16(*(const pg8::bf16x8*)(ST + ((size_t)it * 64 + db * 32 + r) * 32 + 16 * s + 8 * hg), qf, ot[db], 0, 0, 0); }
        float ss = 0.f;
#pragma unroll
        for (int db = 0; db < 2; ++db)
#pragma unroll
            for (int e = 0; e < 16; ++e) ss += ot[db][e] * ot[db][e];
        ss += __shfl_xor(ss, 32);
        const float rstd = rsqrtf(ss * (1.0f / 64.0f) + 1e-6f);
        const bf16_t* og = proj + (row0 + r) * PW + P_GO + h * 64 + 4 * hg; bf16_t* od = br + (row0 + r) * D + h * 64 + 4 * hg;
#pragma unroll
        for (int db = 0; db < 2; ++db)
#pragma unroll
            for (int q = 0; q < 4; ++q) { const int dv0 = db * 32 + 8 * q; const pg8::f32x4 gv = ld_bf16x4(og + dv0), gn = *(const pg8::f32x4*)(gnorm + dv0 + 4 * hg);
                st_bf16x4(od + dv0, (pg8::f32x4){ot[db][4 * q] * rstd * gn[0] * siluf(gv[0]), ot[db][4 * q + 1] * rstd * gn[1] * siluf(gv[1]), ot[db][4 * q + 2] * rstd * gn[2] * siluf(gv[2]), ot[db][4 * q + 3] * rstd * gn[3] * siluf(gv[3])}); }
    }
}

__device__ __forceinline__ void ph_attn_prep(Frame& F, ArgsP a) {
    const bf16_t* proj = (const bf16_t*)(a->ws + WS_PROJ); const int* pos = (const int*)a->in[2];
    bf16_t* QR = (bf16_t*)(a->ws + SCR_QK); bf16_t* KR = QR + (size_t)M * 256; bf16_t* VT = (bf16_t*)(a->ws + SCR_VT);
    int lane = F.lane(); asm volatile("" : "+v"(lane));
    for (int idx = F.gw * 64 + lane; idx < M * 8; idx += F.NGW * 64) { const int row = idx >> 3, hc = idx & 7; const float p = (float)pos[row];
        const bf16_t* qs = proj + (size_t)row * PW + P_DQ + hc * 32; const bf16_t* ks = proj + (size_t)row * PW + P_DK + hc * 32;
        float qv[32], kv[32];
#pragma unroll
        for (int j = 0; j < 8; ++j) { const pg8::f32x4 q4 = ld_bf16x4(qs + 4 * j), k4 = ld_bf16x4(ks + 4 * j);
#pragma unroll
            for (int e = 0; e < 4; ++e) { qv[4 * j + e] = q4[e]; kv[4 * j + e] = k4[e]; } }
        float qo[32], ko[32];
#pragma unroll
        for (int i = 0; i < 16; ++i) { const float inv = exp2f(-(float)i * 0.8304820237218406f);
            float sn, cs; sincosf(p * inv, &sn, &cs);
            qo[i] = qv[i] * cs - qv[i + 16] * sn; qo[i + 16] = qv[i] * sn + qv[i + 16] * cs;
            ko[i] = kv[i] * cs - kv[i + 16] * sn; ko[i + 16] = kv[i] * sn + kv[i + 16] * cs; }
        const float qsc = 0.17677669529663687f * 1.4426950408889634f;
        bf16_t* qd = QR + (size_t)row * 256 + hc * 32; bf16_t* kd = KR + (size_t)row * 256 + hc * 32;
#pragma unroll
        for (int j = 0; j < 8; ++j) { st_bf16x4(qd + 4 * j, (pg8::f32x4){qo[4 * j] * qsc, qo[4 * j + 1] * qsc, qo[4 * j + 2] * qsc, qo[4 * j + 3] * qsc});
            st_bf16x4(kd + 4 * j, (pg8::f32x4){ko[4 * j], ko[4 * j + 1], ko[4 * j + 2], ko[4 * j + 3]}); } }
    for (int it = F.gw; it < 1024; it += F.NGW) { const int bh = it >> 5, tt = it & 31, b = bh >> 2, h = bh & 3;
        const bf16_t* vs = proj + ((size_t)b * T + tt * 64 + lane) * PW + P_DV + h * 64;
        pg8::u32x4 v[8];
#pragma unroll
        for (int j = 0; j < 8; ++j) v[j] = *(const pg8::u32x4*)(vs + 8 * j);
        bf16_t* vd = VT + (size_t)bh * 64 * T + tt * 64 + lane;
#pragma unroll
        for (int j = 0; j < 8; ++j)
#pragma unroll
            for (int e = 0; e < 4; ++e) { const unsigned w = v[j][e]; vd[(size_t)(8 * j + 2 * e) * T] = (bf16_t)(w & 0xffffu); vd[(size_t)(8 * j + 2 * e + 1) * T] = (bf16_t)(w >> 16); } }
}
__device__ __forceinline__ void ph_attn(Frame& F, ArgsP a, int l) {
    const bf16_t* QR = (const bf16_t*)(a->ws + SCR_QK); const bf16_t* KR = QR + (size_t)M * 256; const bf16_t* VT = (const bf16_t*)(a->ws + SCR_VT);
    const float* lp = (const float*)a->in[13] + l * 128; const float* subln = (const float*)a->in[14] + l * 64; bf16_t* br = (bf16_t*)(a->ws + WS_HB);
    int tid = F.wave * 64 + F.lane(); asm volatile("" : "+v"(tid)); const int lane = tid & 63;
    const int r = lane & 31, hg = lane >> 5, comp = F.wave & 1, qs = F.wave >> 1;
    constexpr int RS = 72;
    LAS bf16_t* Kt = (LAS bf16_t*)F.lds;
    LAS bf16_t* Vt = Kt + 2 * 64 * RS;
    LAS float* Xl = (LAS float*)(F.lds + 4 * 64 * RS * 2);
    float lam, lam_init;
    { float d01 = 0.f, d23 = 0.f;
      for (int i = 0; i < 32; ++i) { d01 += lp[i] * lp[32 + i]; d23 += lp[64 + i] * lp[96 + i]; }
      lam_init = 0.8f - 0.6f * __expf(-0.3f * (float)l); lam = __expf(d01) - __expf(d23) + lam_init; }
    const int ldrow = tid >> 3, ldch = tid & 7;
    const int vcu = (F.G % 8 == 0) ? ((int)blockIdx.x % 8) * (F.G / 8) + (int)blockIdx.x / 8 : (int)blockIdx.x;
    for (int pi = vcu; pi < 256; pi += F.G) {
#pragma unroll 1
        for (int half = 0; half < 2; ++half) {
            const int bh = pi >> 3, j = pi & 7, qb = half == 0 ? 15 - j : j, b = bh >> 2, h = bh & 3;
            const int q0 = qb * 128 + qs * 32, nkw = q0 / 64 + 1, nkb = 2 * qb + 2;
            const size_t rowb = (size_t)b * T;
            pg8::bf16x8 qf[2];
#pragma unroll
            for (int s = 0; s < 2; ++s) qf[s] = *(const pg8::bf16x8*)(QR + (rowb + q0 + r) * 256 + h * 64 + comp * 32 + 16 * s + 8 * hg);
            f32x16 ot[2];
#pragma unroll
            for (int e = 0; e < 16; ++e) { ot[0][e] = 0.f; ot[1][e] = 0.f; }
            float mrun = -1e30f, lrun = 0.f;
            const bf16_t* kg = KR + (rowb + ldrow) * 256 + h * 64 + ldch * 8; const bf16_t* vg = VT + ((size_t)bh * 64 + ldrow) * T + ldch * 8;
            pg8::u32x4 kreg = *(const pg8::u32x4*)kg, vreg = *(const pg8::u32x4*)vg;
            pg8::u32x4 kreg2 = kreg, vreg2 = vreg;
            if (nkb > 1) { kreg2 = *(const pg8::u32x4*)(kg + (size_t)64 * 256); vreg2 = *(const pg8::u32x4*)(vg + 64); }
            for (int kt = 0; kt < nkb; ++kt) {
                const int bo = (kt & 1) * 64 * RS;
                *(LAS pg8::u32x4*)(Kt + bo + ldrow * RS + ldch * 8) = kreg; *(LAS pg8::u32x4*)(Vt + bo + ldrow * RS + ldch * 8) = vreg;
                __syncthreads();
                kreg = kreg2; vreg = vreg2;
                if (kt + 2 < nkb) { kreg2 = *(const pg8::u32x4*)(kg + (size_t)(kt + 2) * 64 * 256); vreg2 = *(const pg8::u32x4*)(vg + (kt + 2) * 64); }
                if (kt < nkw) {
                    f32x16 st[2];
#pragma unroll
                    for (int kb = 0; kb < 2; ++kb) {
#pragma unroll
                        for (int e = 0; e < 16; ++e) st[kb][e] = 0.f;
#pragma unroll
                        for (int s = 0; s < 2; ++s) { const pg8::bf16x8 kf = *(const LAS pg8::bf16x8*)(Kt + bo + (kb * 32 + r) * RS + comp * 32 + 16 * s + 8 * hg);
                            st[kb] = __builtin_amdgcn_mfma_f32_32x32x16_bf16(kf, qf[s], st[kb], 0, 0, 0); } }
                    if (kt == nkw - 1) {
                        const int qi = q0 + r;
#pragma unroll
                        for (int kb = 0; kb < 2; ++kb)
#pragma unroll
                            for (int e = 0; e < 16; ++e) { const int ki = kt * 64 + kb * 32 + (e & 3) + 8 * (e >> 2) + 4 * hg; if (ki > qi) st[kb][e] = -1e30f; } }
                    float tm = st[0][0];
#pragma unroll
                    for (int e = 1; e < 16; ++e) tm = fmaxf(tm, st[0][e]);
#pragma unroll
                    for (int e = 0; e < 16; ++e) tm = fmaxf(tm, st[1][e]);
                    { const auto sw = __builtin_amdgcn_permlane32_swap(__builtin_bit_cast(unsigned, tm), __builtin_bit_cast(unsigned, tm), false, false); tm = fmaxf(__builtin_bit_cast(float, (unsigned)sw[0]), __builtin_bit_cast(float, (unsigned)sw[1])); }
                    const float mn = fmaxf(mrun, tm), alpha = __builtin_amdgcn_exp2f(mrun - mn); mrun = mn;
                    float ps = 0.f;
#pragma unroll
                    for (int kb = 0; kb < 2; ++kb)
#pragma unroll
                        for (int e = 0; e < 16; ++e) { st[kb][e] = __builtin_amdgcn_exp2f(st[kb][e] - mn); ps += st[kb][e]; }
                    lrun = lrun * alpha + ps;
#pragma unroll
                    for (int e = 0; e < 16; ++e) { ot[0][e] *= alpha; ot[1][e] *= alpha; }
#pragma unroll
                    for (int kb = 0; kb < 2; ++kb)
#pragma unroll
                        for (int s = 0; s < 2; ++s) {
                            pg8::u32x4 pw; pw.x = pk2(st[kb][8 * s], st[kb][8 * s + 1]); pw.y = pk2(st[kb][8 * s + 2], st[kb][8 * s + 3]); pw.z = pk2(st[kb][8 * s + 4], st[kb][8 * s + 5]); pw.w = pk2(st[kb][8 * s + 6], st[kb][8 * s + 7]);
                            const pg8::bf16x8 pf = __builtin_bit_cast(pg8::bf16x8, pw);
#pragma unroll
                            for (int dvb = 0; dvb < 2; ++dvb) { const LAS bf16_t* vp = Vt + bo + (dvb * 32 + r) * RS + kb * 32 + 16 * s + 4 * hg;
                                const pg8::u32x2 v0 = *(const LAS pg8::u32x2*)vp, v1 = *(const LAS pg8::u32x2*)(vp + 8);
                                pg8::u32x4 vw; vw.x = v0.x; vw.y = v0.y; vw.z = v1.x; vw.w = v1.y;
                                ot[dvb] = __builtin_amdgcn_mfma_f32_32x32x16_bf16(__builtin_bit_cast(pg8::bf16x8, vw), pf, ot[dvb], 0, 0, 0); } }
                }
            }
            const float ltot = lrun + __shfl_xor(lrun, 32); const float il = 1.0f / ltot;
            __syncthreads();
            if (comp == 1) {
#pragma unroll
                for (int dvb = 0; dvb < 2; ++dvb)
#pragma unroll
                    for (int e = 0; e < 16; ++e) Xl[(qs * 32 + dvb * 16 + e) * 64 + lane] = ot[dvb][e] * il; }
            __syncthreads();
            if (comp == 0) {
                float o[32]; float ss = 0.f;
#pragma unroll
                for (int dvb = 0; dvb < 2; ++dvb)
#pragma unroll
                    for (int e = 0; e < 16; ++e) { const float v = ot[dvb][e] * il - lam * Xl[(qs * 32 + dvb * 16 + e) * 64 + lane]; o[dvb * 16 + e] = v; ss += v * v; }
                ss += __shfl_xor(ss, 32);
                const float sc = rsqrtf(ss * (1.0f / 64.0f) + 1e-6f) * (1.0f - lam_init);
                bf16_t* od = br + (rowb + q0 + r) * D + 256 + h * 64;
#pragma unroll
                for (int dvb = 0; dvb < 2; ++dvb)
#pragma unroll
                    for (int g4 = 0; g4 < 4; ++g4) { const int dv0 = dvb * 32 + 8 * g4 + 4 * hg; const pg8::f32x4 sl = *(const pg8::f32x4*)(subln + dv0);
                        st_bf16x4(od + dv0, (pg8::f32x4){o[dvb * 16 + 4 * g4] * sc * sl[0], o[dvb * 16 + 4 * g4 + 1] * sc * sl[1], o[dvb * 16 + 4 * g4 + 2] * sc * sl[2], o[dvb * 16 + 4 * g4 + 3] * sc * sl[3]}); }
            }
            __syncthreads();
        }
    }
}

__device__ __forceinline__ void ph_branch(Frame& F, ArgsP a, int l) {
    const bf16_t* br = (const bf16_t*)(a->ws + WS_HB); const bf16_t* WB = (const bf16_t*)(a->ws + WS_WB) + (size_t)l * 4096 * 256;
    const bf16_t* proj = (const bf16_t*)(a->ws + WS_PROJ); bf16_t* MB = (bf16_t*)(a->ws + SCR_MB);
    int tid = F.wave * 64 + F.lane(); asm volatile("" : "+v"(tid)); const int lane = tid & 63;
    const int r = lane & 31, hg = lane >> 5, wt = (tid >> 6) & 3, wd = tid >> 8;
    constexpr int RS = 72, TB = 128 * RS;
    LAS bf16_t* Wl = (LAS bf16_t*)F.lds;
    LAS bf16_t* Bl = Wl + 2 * TB;
    const int ldr = tid >> 3, ldc = (tid & 7) * 8;
    for (int it = blockIdx.x; it < 1024; it += F.G) {
        const int tm = it >> 3, td = it & 7; const size_t row0 = (size_t)tm * 128; const int d0 = td * 128;
        f32x16 tot[2], acc[2];
#pragma unroll
        for (int e = 0; e < 16; ++e) { tot[0][e] = 0.f; tot[1][e] = 0.f; acc[0][e] = 0.f; acc[1][e] = 0.f; }
        pg8::u32x4 rw0, rw1, rb0, rb1;
#define BR_LOAD(st) do { const int g_ = (st) >> 2, kq_ = (st) & 3; const bf16_t* wp = WB + (size_t)(g_ * 1024 + d0 + ldr) * 256 + kq_ * 64 + ldc; const bf16_t* bp = br + (row0 + ldr) * D + g_ * 256 + kq_ * 64 + ldc; \
            rw0 = *(const pg8::u32x4*)wp; rw1 = *(const pg8::u32x4*)(wp + 64 * 256); rb0 = *(const pg8::u32x4*)bp; rb1 = *(const pg8::u32x4*)(bp + 64 * D); } while (0)
#define BR_WRITE(buf) do { *(LAS pg8::u32x4*)(Wl + (buf) * TB + ldr * RS + ldc) = rw0; *(LAS pg8::u32x4*)(Wl + (buf) * TB + (ldr + 64) * RS + ldc) = rw1; \
            *(LAS pg8::u32x4*)(Bl + (buf) * TB + ldr * RS + ldc) = rb0; *(LAS pg8::u32x4*)(Bl + (buf) * TB + (ldr + 64) * RS + ldc) = rb1; } while (0)
        BR_LOAD(0); BR_WRITE(0); __syncthreads(); BR_LOAD(1);
        pg8::u32x2 gt[2][4];
#pragma unroll 1
        for (int st = 0; st < 16; ++st) {
            const int buf = st & 1, g = st >> 2;
            if ((st & 3) == 0) {
                const bf16_t* gp = proj + (row0 + wt * 32 + r) * PW + P_GATE + g * 1024 + d0 + wd * 64 + 4 * hg;
#pragma unroll
                for (int db = 0; db < 2; ++db)
#pragma unroll
                    for (int q = 0; q < 4; ++q) gt[db][q] = *(const pg8::u32x2*)(gp + db * 32 + 8 * q); }
#pragma unroll
            for (int s = 0; s < 4; ++s) { const pg8::bf16x8 bf = *(const LAS pg8::bf16x8*)(Bl + buf * TB + (wt * 32 + r) * RS + 16 * s + 8 * hg);
#pragma unroll
                for (int db = 0; db < 2; ++db) { const pg8::bf16x8 af = *(const LAS pg8::bf16x8*)(Wl + buf * TB + (wd * 64 + db * 32 + r) * RS + 16 * s + 8 * hg);
                    acc[db] = __builtin_amdgcn_mfma_f32_32x32x16_bf16(af, bf, acc[db], 0, 0, 0); } }
            if (st + 1 < 16) BR_WRITE(buf ^ 1);
            if (st + 2 < 16) BR_LOAD(st + 2);
            if ((st & 3) == 3) {
#pragma unroll
                for (int db = 0; db < 2; ++db)
#pragma unroll
                    for (int q = 0; q < 4; ++q) { const pg8::u32x2 w = gt[db][q];
                        const float g0 = __builtin_bit_cast(float, w.x << 16), g1 = __builtin_bit_cast(float, w.x & 0xffff0000u), g2 = __builtin_bit_cast(float, w.y << 16), g3 = __builtin_bit_cast(float, w.y & 0xffff0000u);
                        tot[db][4 * q] += acc[db][4 * q] * sigm(g0); tot[db][4 * q + 1] += acc[db][4 * q + 1] * sigm(g1); tot[db][4 * q + 2] += acc[db][4 * q + 2] * sigm(g2); tot[db][4 * q + 3] += acc[db][4 * q + 3] * sigm(g3);
                        acc[db][4 * q] = 0.f; acc[db][4 * q + 1] = 0.f; acc[db][4 * q + 2] = 0.f; acc[db][4 * q + 3] = 0.f; } }
            __syncthreads();
        }
#undef BR_LOAD
#undef BR_WRITE
        bf16_t* mp = MB + (row0 + wt * 32 + r) * D + d0 + wd * 64 + 4 * hg;
#pragma unroll
        for (int db = 0; db < 2; ++db)
#pragma unroll
            for (int q = 0; q < 4; ++q) st_bf16x4(mp + db * 32 + 8 * q, (pg8::f32x4){tot[db][4 * q], tot[db][4 * q + 1], tot[db][4 * q + 2], tot[db][4 * q + 3]});
    }
}

__device__ __forceinline__ int crow(int e, int hg) { return (e & 3) + 8 * (e >> 2) + 4 * hg; }
__device__ __forceinline__ void ph_rk_p1(Frame& F, ArgsP a) {
    if (F.wave >= 4) return;
    const unsigned char* VEC = a->ws + SCR_VEC6;
    bf16_t* QE = (bf16_t*)(a->ws + SCR_QE); bf16_t* AY = (bf16_t*)(a->ws + SCR_AY); bf16_t* VTC = (bf16_t*)(a->ws + SCR_VTC); bf16_t* GMF = (bf16_t*)(a->ws + SCR_GMF); bf16_t* ZB = (bf16_t*)(a->ws + SCR_ZB);
    LAS unsigned char* wl = F.lds + F.wave * 40448;
    LAS bf16_t* TA = (LAS bf16_t*)wl;
    LAS bf16_t* TK = (LAS bf16_t*)(wl + 4608);
    LAS bf16_t* TR = (LAS bf16_t*)(wl + 9216);
    LAS bf16_t* TB = (LAS bf16_t*)(wl + 13824);
    LAS bf16_t* TBT = (LAS bf16_t*)(wl + 18432);
    LAS bf16_t* TKT = (LAS bf16_t*)(wl + 23552);
    LAS bf16_t* TVT = (LAS bf16_t*)(wl + 28672);
    LAS bf16_t* MRB = (LAS bf16_t*)(wl + 33792);
    LAS bf16_t* W2T = (LAS bf16_t*)(wl + 36352);
    LAS float* GC = (LAS float*)(wl + 38912);
    LAS float* LabF = (LAS float*)(wl + 4608); LAS float* LakF = (LAS float*)(wl + 13824); LAS bf16_t* W1T = (LAS bf16_t*)wl; LAS bf16_t* GST = (LAS bf16_t*)(wl + 9216); LAS bf16_t* HM = TKT;
    int lane0 = F.lane(); asm volatile("" : "+v"(lane0));
#define RK_LANES() int lane = lane0; asm volatile("" : "+v"(lane)); const int r = lane & 31, hg = lane >> 5; (void)r; (void)hg
    for (int it = (int)blockIdx.x * 4 + F.wave; it < 2048; it += F.G * 4) {
        const unsigned char* rec0 = VEC + (size_t)it * 32 * RECB;
        f32x16 mrk;
        {
            RK_LANES();
        { float G = 0.f, gprev = 1.f;
#pragma unroll 16
          for (int t = 0; t < 32; ++t) { const unsigned char* rp = rec0 + t * RECB;
              const float lw = *(const float*)(rp + lane * 4); const float av = bf2f(*(const bf16_t*)(rp + 256 + lane * 2)), bv = bf2f(*(const bf16_t*)(rp + 384 + lane * 2)), kv = bf2f(*(const bf16_t*)(rp + 512 + lane * 2)), rv = bf2f(*(const bf16_t*)(rp + 640 + lane * 2));
              const bf16_t vraw = *(const bf16_t*)(rp + 768 + lane * 2);
              G += lw; const float gam = __expf(G), inv = __builtin_amdgcn_rcpf(gam);
              const bf16_t bt = (bf16_t)f2bf(bv * inv), kt = (bf16_t)f2bf(kv * inv);
              TA[t * 72 + lane] = (bf16_t)f2bf(av * gprev); TR[t * 72 + lane] = (bf16_t)f2bf(rv * gam); TB[t * 72 + lane] = bt; TK[t * 72 + lane] = kt;
              TBT[lane * 40 + t] = bt; TKT[lane * 40 + t] = kt; TVT[lane * 40 + t] = vraw; gprev = gam; }
          GC[lane] = gprev; }
        asm volatile("s_waitcnt lgkmcnt(0)" ::: "memory");
#pragma unroll
        for (int q = 0; q < 4; ++q) *(pg8::u32x4*)(VTC + ((size_t)it * 64 + lane) * 32 + 8 * q) = *(const LAS pg8::u32x4*)(TVT + lane * 40 + 8 * q);
        }
        {
            RK_LANES();
        f32x16 lab, lak, mrb;
#pragma unroll
        for (int e = 0; e < 16; ++e) { lab[e] = 0.f; lak[e] = 0.f; mrb[e] = 0.f; mrk[e] = 0.f; }
#pragma unroll
        for (int s = 0; s < 4; ++s) { const int o = r * 72 + 16 * s + 8 * hg;
            const pg8::bf16x8 fa = *(const LAS pg8::bf16x8*)(TA + o), fr = *(const LAS pg8::bf16x8*)(TR + o), fb = *(const LAS pg8::bf16x8*)(TB + o), fk = *(const LAS pg8::bf16x8*)(TK + o);
            lab = __builtin_amdgcn_mfma_f32_32x32x16_bf16(fa, fb, lab, 0, 0, 0); lak = __builtin_amdgcn_mfma_f32_32x32x16_bf16(fa, fk, lak, 0, 0, 0);
            mrb = __builtin_amdgcn_mfma_f32_32x32x16_bf16(fr, fb, mrb, 0, 0, 0); mrk = __builtin_amdgcn_mfma_f32_32x32x16_bf16(fr, fk, mrk, 0, 0, 0); }
#pragma unroll
        for (int e = 0; e < 16; ++e) { const int t = crow(e, hg);
            LabF[t * 36 + r] = (r < t) ? lab[e] : 0.f; LakF[t * 36 + r] = (r < t) ? lak[e] : 0.f;
            MRB[t * 40 + r] = (bf16_t)f2bf((r <= t) ? mrb[e] : 0.f); mrk[e] = (r <= t) ? mrk[e] : 0.f; }
        asm volatile("s_waitcnt lgkmcnt(0)" ::: "memory");
        }
        {
            RK_LANES();
        { float W1[32], W2[32];
          W1[0] = bf2f(TA[lane]); W2[0] = LakF[r];
          unsigned dep = 0u;
#pragma unroll
          for (int t = 1; t < 32; ++t) { asm volatile("" : "+v"(dep) : "v"(W1[t - 1]), "v"(W2[t - 1]));
              const LAS float* Lr = LabF + t * 36 + dep;
              float s1 = bf2f(TA[t * 72 + lane + dep]), s2 = LakF[t * 36 + r + dep];
#pragma unroll
              for (int j4 = 0; j4 < (t + 3) / 4; ++j4) { const pg8::f32x4 L4 = *(const LAS pg8::f32x4*)(Lr + 4 * j4);
#pragma unroll
                  for (int q = 0; q < 4; ++q) if (4 * j4 + q < t) { s1 = __builtin_fmaf(L4[q], W1[4 * j4 + q], s1); s2 = __builtin_fmaf(L4[q], W2[4 * j4 + q], s2); } }
              W1[t] = s1; W2[t] = s2; }
          asm volatile("s_waitcnt lgkmcnt(0)" ::: "memory");
#pragma unroll
          for (int q = 0; q < 4; ++q) { *(LAS pg8::u32x4*)(W1T + lane * 40 + 8 * q) = (pg8::u32x4){pk2(W1[8 * q], W1[8 * q + 1]), pk2(W1[8 * q + 2], W1[8 * q + 3]), pk2(W1[8 * q + 4], W1[8 * q + 5]), pk2(W1[8 * q + 6], W1[8 * q + 7])};
              if (lane < 32) *(LAS pg8::u32x4*)(W2T + lane * 40 + 8 * q) = (pg8::u32x4){pk2(W2[8 * q], W2[8 * q + 1]), pk2(W2[8 * q + 2], W2[8 * q + 3]), pk2(W2[8 * q + 4], W2[8 * q + 5]), pk2(W2[8 * q + 6], W2[8 * q + 7])}; } }
        asm volatile("s_waitcnt lgkmcnt(0)" ::: "memory");
        }
        {
            RK_LANES();
#pragma unroll
        for (int kb = 0; kb < 2; ++kb) { f32x16 acc;
#pragma unroll
            for (int e = 0; e < 16; ++e) acc[e] = bf2f(TR[crow(e, hg) * 72 + kb * 32 + r]);
#pragma unroll
            for (int s = 0; s < 2; ++s) acc = __builtin_amdgcn_mfma_f32_32x32x16_bf16(*(const LAS pg8::bf16x8*)(MRB + r * 40 + 16 * s + 8 * hg), *(const LAS pg8::bf16x8*)(W1T + (kb * 32 + r) * 40 + 16 * s + 8 * hg), acc, 0, 0, 0);
#pragma unroll
            for (int e = 0; e < 16; ++e) QE[((size_t)it * 32 + crow(e, hg)) * 64 + kb * 32 + r] = (bf16_t)f2bf(acc[e]); }
        }
        {
            RK_LANES();
        { f32x16 acc = mrk;
#pragma unroll
          for (int s = 0; s < 2; ++s) acc = __builtin_amdgcn_mfma_f32_32x32x16_bf16(*(const LAS pg8::bf16x8*)(MRB + r * 40 + 16 * s + 8 * hg), *(const LAS pg8::bf16x8*)(W2T + r * 40 + 16 * s + 8 * hg), acc, 0, 0, 0);
#pragma unroll
          for (int e = 0; e < 16; ++e) AY[((size_t)it * 32 + crow(e, hg)) * 32 + r] = (bf16_t)f2bf(acc[e]); }
        asm volatile("s_waitcnt lgkmcnt(0)" ::: "memory");
        }
        {
            RK_LANES();
#pragma unroll
        for (int kbr = 0; kbr < 2; ++kbr)
#pragma unroll
            for (int kb = 0; kb < 2; ++kb) { f32x16 acc;
#pragma unroll
                for (int e = 0; e < 16; ++e) acc[e] = 0.f;
#pragma unroll
                for (int s = 0; s < 2; ++s) acc = __builtin_amdgcn_mfma_f32_32x32x16_bf16(*(const LAS pg8::bf16x8*)(TBT + (kbr * 32 + r) * 40 + 16 * s + 8 * hg), *(const LAS pg8::bf16x8*)(W1T + (kb * 32 + r) * 40 + 16 * s + 8 * hg), acc, 0, 0, 0);
#pragma unroll
                for (int e = 0; e < 16; ++e) { const int kr = kbr * 32 + crow(e, hg); const float dl = (kbr == kb && crow(e, hg) == r) ? 1.f : 0.f;
                    GST[kr * 72 + kb * 32 + r] = (bf16_t)f2bf(GC[kr] * (acc[e] + dl)); } }
        asm volatile("s_waitcnt lgkmcnt(0)" ::: "memory");
#pragma unroll
        for (int kbr = 0; kbr < 2; ++kbr)
#pragma unroll
            for (int kb = 0; kb < 2; ++kb)
#pragma unroll
                for (int s = 0; s < 2; ++s) { const LAS bf16_t* p = GST + (kbr * 32 + r) * 72 + kb * 32 + 16 * s;
                    const pg8::u32x2 v0 = *(const LAS pg8::u32x2*)(p + 4 * hg), v1 = *(const LAS pg8::u32x2*)(p + 8 + 4 * hg);
                    *(pg8::u32x4*)(GMF + (((size_t)it * 8 + (kbr * 2 + kb) * 2 + s) * 64 + lane) * 8) = (pg8::u32x4){v0.x, v0.y, v1.x, v1.y}; }
        }
        {
            RK_LANES();
#pragma unroll
        for (int kbr = 0; kbr < 2; ++kbr) { f32x16 acc;
#pragma unroll
            for (int e = 0; e < 16; ++e) acc[e] = bf2f(TKT[(kbr * 32 + crow(e, hg)) * 40 + r]);
#pragma unroll
            for (int s = 0; s < 2; ++s) acc = __builtin_amdgcn_mfma_f32_32x32x16_bf16(*(const LAS pg8::bf16x8*)(TBT + (kbr * 32 + r) * 40 + 16 * s + 8 * hg), *(const LAS pg8::bf16x8*)(W2T + r * 40 + 16 * s + 8 * hg), acc, 0, 0, 0);
            asm volatile("s_waitcnt lgkmcnt(0)" ::: "memory");
#pragma unroll
            for (int e = 0; e < 16; ++e) { const int kr = kbr * 32 + crow(e, hg); HM[kr * 40 + r] = (bf16_t)f2bf(GC[kr] * acc[e]); } }
        asm volatile("s_waitcnt lgkmcnt(0)" ::: "memory");
        }
        {
            RK_LANES();
#pragma unroll
        for (int vb = 0; vb < 2; ++vb)
#pragma unroll
            for (int kbr = 0; kbr < 2; ++kbr) { f32x16 acc;
#pragma unroll
                for (int e = 0; e < 16; ++e) acc[e] = 0.f;
#pragma unroll
                for (int s = 0; s < 2; ++s) acc = __builtin_amdgcn_mfma_f32_32x32x16_bf16(*(const LAS pg8::bf16x8*)(HM + (kbr * 32 + r) * 40 + 16 * s + 8 * hg), *(const LAS pg8::bf16x8*)(TVT + (vb * 32 + r) * 40 + 16 * s + 8 * hg), acc, 0, 0, 0);
                pg8::u32x4* zp = (pg8::u32x4*)(ZB + ((((size_t)it * 2 + vb) * 2 + kbr) * 64 + lane) * 16);
                zp[0] = (pg8::u32x4){pk2(acc[0], acc[1]), pk2(acc[2], acc[3]), pk2(acc[4], acc[5]), pk2(acc[6], acc[7])}; zp[1] = (pg8::u32x4){pk2(acc[8], acc[9]), pk2(acc[10], acc[11]), pk2(acc[12], acc[13]), pk2(acc[14], acc[15])}; }
        }
        asm volatile("s_waitcnt lgkmcnt(0)" ::: "memory");
    }
}
#undef RK_LANES
__device__ __forceinline__ void ph_rk_p2(Frame& F, ArgsP a) {
    if (F.wave != 0 || (int)blockIdx.x >= 64) return;
    const bf16_t* GMF = (const bf16_t*)(a->ws + SCR_GMF); const bf16_t* ZB = (const bf16_t*)(a->ws + SCR_ZB); bf16_t* STM = (bf16_t*)(a->ws + SCR_STM);
    int lane = F.lane(); asm volatile("" : "+v"(lane));
    const int r = lane & 31, hg = lane >> 5;
    const int bh = (int)blockIdx.x >> 1, vb = (int)blockIdx.x & 1;
    f32x16 st[2];
#pragma unroll
    for (int e = 0; e < 16; ++e) { st[0][e] = 0.f; st[1][e] = 0.f; }
    const char* gsrc = (const char*)(GMF + (size_t)bh * 64 * 8 * 64 * 8) + lane * 16;
    const char* zsrc = (const char*)(ZB + ((size_t)bh * 64 * 2 + vb) * 2 * 64 * 16) + lane * 16;
#define P2_STAGE(n_) do { LAS unsigned char* sl_ = F.lds + ((n_) % 5) * 12288; _Pragma("unroll") for (int f_ = 0; f_ < 8; ++f_) \
        __builtin_amdgcn_global_load_lds((const unsigned*)(gsrc + (size_t)(n_) * 8192 + f_ * 1024), (LAS unsigned*)(sl_ + f_ * 1024), 16, 0, 0); \
        _Pragma("unroll") for (int f_ = 0; f_ < 4; ++f_) __builtin_amdgcn_global_load_lds((const unsigned*)(zsrc + (size_t)(n_) * 8192 + f_ * 1024), (LAS unsigned*)(sl_ + 8192 + f_ * 1024), 16, 0, 0); } while (0)
    P2_STAGE(0); P2_STAGE(1); P2_STAGE(2); P2_STAGE(3);
#pragma unroll 1
    for (int n = 0; n < 64; ++n) {
        const size_t ch = (size_t)bh * 64 + n;
        if (n == 0) asm volatile("s_waitcnt vmcnt(36)" ::: "memory"); else if (n == 1) asm volatile("s_waitcnt vmcnt(44)" ::: "memory"); else if (n == 2) asm volatile("s_waitcnt vmcnt(52)" ::: "memory");
        else if (n < 61) asm volatile("s_waitcnt vmcnt(60)" ::: "memory"); else asm volatile("s_waitcnt vmcnt(0)" ::: "memory");
        const LAS unsigned char* sl = F.lds + (n % 5) * 12288;
        bf16_t* sp = STM + (ch * 64 + vb * 32 + r) * 64 + 4 * hg;
        pg8::bf16x8 pf[2][2];
#pragma unroll
        for (int kb = 0; kb < 2; ++kb) {
#pragma unroll
            for (int q = 0; q < 4; ++q) st_bf16x4(sp + kb * 32 + 8 * q, (pg8::f32x4){st[kb][4 * q], st[kb][4 * q + 1], st[kb][4 * q + 2], st[kb][4 * q + 3]});
#pragma unroll
            for (int s = 0; s < 2; ++s) { pg8::u32x4 pw; pw.x = pk2(st[kb][8 * s], st[kb][8 * s + 1]); pw.y = pk2(st[kb][8 * s + 2], st[kb][8 * s + 3]); pw.z = pk2(st[kb][8 * s + 4], st[kb][8 * s + 5]); pw.w = pk2(st[kb][8 * s + 6], st[kb][8 * s + 7]);
                pf[kb][s] = __builtin_bit_cast(pg8::bf16x8, pw); } }
        if (n + 4 < 64) P2_STAGE(n + 4);
        f32x16 nw[2];
#pragma unroll
        for (int kbr = 0; kbr < 2; ++kbr) {
#pragma unroll
            for (int q = 0; q < 2; ++q) { const pg8::u32x4 z = *(const LAS pg8::u32x4*)(sl + 8192 + (kbr * 2048) + lane * 32 + q * 16);
#pragma unroll
                for (int i = 0; i < 4; ++i) { nw[kbr][8 * q + 2 * i] = __builtin_bit_cast(float, z[i] << 16); nw[kbr][8 * q + 2 * i + 1] = __builtin_bit_cast(float, z[i] & 0xffff0000u); } }
#pragma unroll
            for (int kb = 0; kb < 2; ++kb)
#pragma unroll
                for (int s = 0; s < 2; ++s) nw[kbr] = __builtin_amdgcn_mfma_f32_32x32x16_bf16(*(const LAS pg8::bf16x8*)(sl + ((kbr * 2 + kb) * 2 + s) * 1024 + lane * 16), pf[kb][s], nw[kbr], 0, 0, 0); }
        st[0] = nw[0]; st[1] = nw[1];
    }
#undef P2_STAGE
    asm volatile("s_waitcnt vmcnt(0)" ::: "memory");
}
__device__ __forceinline__ void ph_rk_p3(Frame& F, ArgsP a, int l) {
    const unsigned char* VEC = a->ws + SCR_VEC6; const float* SC = (const float*)(a->ws + SCR_SC); const bf16_t* GR = (const bf16_t*)(a->ws + SCR_GR);
    const bf16_t* QE = (const bf16_t*)(a->ws + SCR_QE); const bf16_t* AY = (const bf16_t*)(a->ws + SCR_AY); const bf16_t* VTC = (const bf16_t*)(a->ws + SCR_VTC); const bf16_t* STM = (const bf16_t*)(a->ws + SCR_STM);
    const float* lng = (const float*)a->in[28] + l * 256; const float* lnb = (const float*)a->in[29] + l * 256; bf16_t* br = (bf16_t*)(a->ws + WS_HB);
    int lane = F.lane(); asm volatile("" : "+v"(lane));
    const int r = lane & 31, hg = lane >> 5;
    for (int it = F.gw; it < 2048; it += F.NGW) {
        const int bh = it >> 6, n = it & 63, b = bh >> 2, h = bh & 3;
        f32x16 acc[2];
#pragma unroll
        for (int e = 0; e < 16; ++e) { acc[0][e] = 0.f; acc[1][e] = 0.f; }
#pragma unroll
        for (int s = 0; s < 4; ++s) { const pg8::bf16x8 qf = *(const pg8::bf16x8*)(QE + ((size_t)it * 32 + r) * 64 + 16 * s + 8 * hg);
#pragma unroll
            for (int vb = 0; vb < 2; ++vb) acc[vb] = __builtin_amdgcn_mfma_f32_32x32x16_bf16(*(const pg8::bf16x8*)(STM + ((size_t)it * 64 + vb * 32 + r) * 64 + 16 * s + 8 * hg), qf, acc[vb], 0, 0, 0); }
#pragma unroll
        for (int s = 0; s < 2; ++s) { const pg8::bf16x8 af = *(const pg8::bf16x8*)(AY + ((size_t)it * 32 + r) * 32 + 16 * s + 8 * hg);
#pragma unroll
            for (int vb = 0; vb < 2; ++vb) acc[vb] = __builtin_amdgcn_mfma_f32_32x32x16_bf16(*(const pg8::bf16x8*)(VTC + ((size_t)it * 64 + vb * 32 + r) * 32 + 16 * s + 8 * hg), af, acc[vb], 0, 0, 0); }
        float sm = 0.f;
#pragma unroll
        for (int e = 0; e < 16; ++e) sm += acc[0][e] + acc[1][e];
        { const auto sw = __builtin_amdgcn_permlane32_swap(__builtin_bit_cast(unsigned, sm), __builtin_bit_cast(unsigned, sm), false, false); sm = __builtin_bit_cast(float, (unsigned)sw[0]) + __builtin_bit_cast(float, (unsigned)sw[1]); }
        const float mu = sm * (1.0f / 64.0f); float sq = 0.f;
#pragma unroll
        for (int e = 0; e < 16; ++e) { const float d0 = acc[0][e] - mu, d1 = acc[1][e] - mu; sq += d0 * d0 + d1 * d1; }
        { const auto sw = __builtin_amdgcn_permlane32_swap(__builtin_bit_cast(unsigned, sq), __builtin_bit_cast(unsigned, sq), false, false); sq = __builtin_bit_cast(float, (unsigned)sw[0]) + __builtin_bit_cast(float, (unsigned)sw[1]); }
        const float rstd = rsqrtf(sq * (1.0f / 64.0f) + 64e-5f);
        const int t = n * 32 + r; const size_t row = (size_t)b * T + t; const size_t st = (size_t)bh * T + t;
        const float bonus = SC[st * 4 + 2];
        const bf16_t* vrec = (const bf16_t*)(VEC + st * RECB + 768);
#pragma unroll
        for (int vb = 0; vb < 2; ++vb)
#pragma unroll
            for (int q = 0; q < 4; ++q) { const int v0 = vb * 32 + 8 * q + 4 * hg;
                const pg8::f32x4 vv = ld_bf16x4(vrec + v0), gg = ld_bf16x4(GR + row * 256 + h * 64 + v0), g4 = *(const pg8::f32x4*)(lng + h * 64 + v0), b4 = *(const pg8::f32x4*)(lnb + h * 64 + v0);
                pg8::f32x4 o;
#pragma unroll
                for (int i = 0; i < 4; ++i) o[i] = ((acc[vb][4 * q + i] - mu) * rstd * g4[i] + b4[i] + bonus * vv[i]) * gg[i];
                st_bf16x4(br + row * D + 768 + h * 64 + v0, o); }
    }
}
constexpr int RING_BYTES = 131072, LDS_BYTES = 163840, LDSCTL_OFF = LDS_BYTES - 1024, MISC_OFF = LDSCTL_OFF + 320;
constexpr int PH_PRO = 0, PH_H0 = 1, PH_L0 = 2, PH_PER_LAYER = 12, PH_END = PH_L0 + 2 * PH_PER_LAYER;
constexpr int PL_PROJ = 0, PL_MIXA = 1, PL_MIXB = 2, PL_MIXC = 3, PL_MIXD = 4, PL_BRANCH = 5, PL_OUT = 6, PL_ROWMIX = 7, PL_FFN1 = 8, PL_FFN2 = 9, PL_FFN3 = 10, PL_ROWFFN = 11;

#ifndef DUPMASK
#define DUPMASK 0
#endif
#define DUP(bit) for (int dup_ = 0; dup_ < (((DUPMASK) >> (bit)) & 1) + 1; ++dup_)
__global__ void __launch_bounds__(NTHR, 2) mk_fwd(Args a) {
    extern __shared__ __attribute__((aligned(16))) unsigned char lds_raw[];
    Frame F0;
    F0.lds = (LAS unsigned char*)lds_raw;
    F0.wave = __builtin_amdgcn_readfirstlane(threadIdx.x >> 6);
    F0.G = gridDim.x; F0.gw = blockIdx.x * NWAVES + F0.wave; F0.NGW = F0.G * NWAVES;
    volatile LAS unsigned* MISC = (volatile LAS unsigned*)(F0.lds + MISC_OFF);
    for (int u = threadIdx.x; u < (LDS_BYTES - LDSCTL_OFF) / 4; u += NTHR) ((LAS unsigned*)(F0.lds + LDSCTL_OFF))[u] = 0u;
    __syncthreads();
    unsigned* ctl = (unsigned*)(a.ws + WS_CTL);
    const int lo = a.ph_lo, hi = a.ph_hi;
    XcdBarrier bar; bar.bar = ctl + CW_BAR; bar.x = 0; bar.st = nullptr;
    if (hi - lo > 1) bar = xcd_barrier_post(ctl + CW_BAR, MISC + 8);
#define IN(k) (lo <= (k) && (k) < hi)
#define SEAM(k) do { if (IN(k) && IN((k) + 1)) { xcd_barrier(bar); if ((DUPMASK >> 12) & 1) xcd_barrier(bar); } } while (0)
    if (IN(PH_PRO)) DUP(0) { ArgsP A = fresh_args(); Frame F = fresh(F0); p0_mod_items(F, (const float*)A->in[1], (const float*)A->in[3], (const float*)A->in[4], (float*)(A->ws + WS_MOD)); p0_convert(F, A); }
    SEAM(PH_PRO);
    if (IN(PH_H0)) DUP(9) { Frame F = fresh(F0); ph_h0(F, fresh_args()); }
    SEAM(PH_H0);
    for (int l = 0; l < NL; ++l) {
        const int base = PH_L0 + l * PH_PER_LAYER;
        if (IN(base + PL_PROJ)) DUP(13) { ArgsP A = fresh_args(); Frame F = fresh(F0); unsigned char* ws = A->ws;
            pg8::Gemm g{(const bf16_t*)(ws + WS_HB), (const bf16_t*)(ws + WS_WIN) + (size_t)l * PW * 1024, 1024, 1024, 1024, 0}; pg8::StaticOrder S; S.init(M, 7168, F.G, (int)blockIdx.x);
            pg8::EpiBf16 E{(bf16_t*)(ws + WS_PROJ), PW, 28};
            pg8::gemm_phase<pg8::EpiBf16, pg8::StaticOrder, true>(F.lds, g, S, E, F.wave);
        }
        SEAM(base + PL_PROJ);
        if (IN(base + PL_MIXA)) { DUP(2) { Frame F = fresh(F0); ph_conv(F, fresh_args(), l); } DUP(6) { Frame F = fresh(F0); ph_rwkv_prep(F, fresh_args(), l); } DUP(7) { Frame F = fresh(F0); ph_gla_p1(F, fresh_args(), l); } DUP(8) { Frame F = fresh(F0); ph_attn_prep(F, fresh_args()); } }
        SEAM(base + PL_MIXA);
        if (IN(base + PL_MIXB)) { DUP(10) { Frame F = fresh(F0); ph_gla_prefix(F, fresh_args()); } DUP(4) { Frame F = fresh(F0); ph_attn(F, fresh_args(), l); } DUP(3) { Frame F = fresh(F0); ph_rk_p1(F, fresh_args()); } }
        SEAM(base + PL_MIXB);
        if (IN(base + PL_MIXC)) { DUP(17) { Frame F = fresh(F0); ph_rk_p2(F, fresh_args()); } DUP(11) { Frame F = fresh(F0); ph_gla_p2(F, fresh_args(), l); } }
        SEAM(base + PL_MIXC);
        if (IN(base + PL_MIXD)) { DUP(5) { Frame F = fresh(F0); ph_rk_p3(F, fresh_args(), l); } }
        SEAM(base + PL_MIXD);
        if (IN(base + PL_BRANCH)) DUP(14) { ArgsP A = fresh_args(); Frame F = fresh(F0); unsigned char* ws = A->ws;
            pg8::Gemm g{(const bf16_t*)(ws + WS_HB), (const bf16_t*)(ws + WS_WB) + (size_t)l * 1024 * 1024, 1024, 1024, 1024, 0}; pg8::StaticOrder S; S.init(M, 1024, F.G, (int)blockIdx.x);
            pg8::EpiBranchK E{(const bf16_t*)(ws + WS_PROJ), (bf16_t*)(ws + SCR_MB)};
            pg8::gemm_phase<pg8::EpiBranchK, pg8::StaticOrder, false>(F.lds, g, S, E, F.wave);
        }
        SEAM(base + PL_BRANCH);
        if (IN(base + PL_OUT)) DUP(1) { ArgsP A = fresh_args(); Frame F = fresh(F0); unsigned char* ws = A->ws;
            pg8::Gemm g{(const bf16_t*)(ws + SCR_MB), (const bf16_t*)(ws + WS_WO) + (size_t)l * 1024 * 1024, 1024, 1024, 1024, 0}; pg8::StaticOrder S; S.init(M, 1024, F.G, (int)blockIdx.x);
            pg8::EpiBf16 E{(bf16_t*)(ws + SCR_Y), 1024, 4};
            pg8::gemm_phase<pg8::EpiBf16, pg8::StaticOrder, false>(F.lds, g, S, E, F.wave);
        }
        SEAM(base + PL_OUT);
        if (IN(base + PL_ROWMIX)) { ArgsP A = fresh_args(); Frame F = fresh(F0); unsigned char* ws = A->ws; const float* modl = (const float*)(ws + WS_MOD) + (size_t)l * 8 * 6144;
            ph_row(F, A, l == 0 ? (const float*)A->in[0] : A->out, (const bf16_t*)(ws + SCR_Y), (const float*)A->in[6] + l * D, modl, 2048, (const float*)A->in[7] + l * D, modl, 3072, 4096, (bf16_t*)(ws + (l == 0 ? WS_HB : WS_H2L1)), l == 1); }
        SEAM(base + PL_ROWMIX);
        if (l == 0) {
            if (IN(base + PL_FFN1)) DUP(1) { ArgsP A = fresh_args(); Frame F = fresh(F0); unsigned char* ws = A->ws;
                pg8::Gemm g{(const bf16_t*)(ws + WS_HB), (const bf16_t*)(ws + WS_WF1), 1024, 1024, 1024, 0}; pg8::StaticOrder S; S.init(M, 2 * DFF, F.G, (int)blockIdx.x);
                pg8::EpiSwiglu E{(bf16_t*)(ws + WS_PROJ), DFF, 2 * DFF / 256};
                pg8::gemm_phase<pg8::EpiSwiglu, pg8::StaticOrder, true>(F.lds, g, S, E, F.wave);
            }
            SEAM(base + PL_FFN1);
            if (IN(base + PL_FFN2)) DUP(1) { ArgsP A = fresh_args(); Frame F = fresh(F0); unsigned char* ws = A->ws;
                pg8::Gemm g{(const bf16_t*)(ws + WS_PROJ), (const bf16_t*)(ws + WS_WF2), DFF, DFF, DFF, 0}; pg8::StaticOrder S; S.init(M, 1024, F.G, (int)blockIdx.x);
                pg8::EpiBf16 E{(bf16_t*)(ws + SCR_Y), 1024, 4};
                pg8::gemm_phase<pg8::EpiBf16, pg8::StaticOrder, false>(F.lds, g, S, E, F.wave);
            }
            SEAM(base + PL_FFN2);
        } else {
            if (IN(base + PL_FFN1)) DUP(0) { Frame F = fresh(F0); ph_moe_prep(F, fresh_args()); }
            SEAM(base + PL_FFN1);
            if (IN(base + PL_FFN2)) DUP(15) { ArgsP A = fresh_args(); Frame F = fresh(F0); unsigned char* ws = A->ws; const unsigned* cnt = (const unsigned*)(ws + WS_CTL) + CW_CNT;
                pg8::Gemm g{(const bf16_t*)(ws + WS_HG), (const bf16_t*)(ws + WS_WM1), 1024, 1024, 1024, 0}; pg8::MoeOrder<28> S; S.init(cnt, F.G, (int)blockIdx.x);
                pg8::EpiSwiglu E{(bf16_t*)(ws + WS_HID), DEX, 28};
                pg8::gemm_phase<pg8::EpiSwiglu, pg8::MoeOrder<28>, true>(F.lds, g, S, E, F.wave);
            }
            SEAM(base + PL_FFN2);
            if (IN(base + PL_FFN3)) DUP(16) { ArgsP A = fresh_args(); Frame F = fresh(F0); unsigned char* ws = A->ws; const unsigned* cnt = (const unsigned*)(ws + WS_CTL) + CW_CNT;
                pg8::Gemm g{(const bf16_t*)(ws + WS_HID), (const bf16_t*)(ws + WS_WM2), DEX, DEX, DEX, 0}; pg8::MoeOrderSplit S; S.init(cnt, F.G, (int)blockIdx.x);
                const pg8::MoeSplit sp = pg8::moe_split(cnt, F.G);
                pg8::EpiBf16Split E{(bf16_t*)(ws + WS_HG), (bf16_t*)(ws + WS_WM1), sp.tau0, sp.nrt};
                pg8::gemm_phase<pg8::EpiBf16Split, pg8::MoeOrderSplit, true>(F.lds, g, S, E, F.wave);
            }
            SEAM(base + PL_FFN3);
        }
        if (IN(base + PL_ROWFFN)) { ArgsP A = fresh_args(); Frame F = fresh(F0); unsigned char* ws = A->ws; const float* modl = (const float*)(ws + WS_MOD) + (size_t)l * 8 * 6144;
            const bool last = (l == NL - 1);
            if (l == 0) ph_row(F, A, A->out, (const bf16_t*)(ws + SCR_Y), (const float*)A->in[8], modl, 5120, (const float*)A->in[5] + D, modl + 8 * 6144, 0, 1024, (bf16_t*)(ws + WS_HB), false, nullptr, (const float*)A->in[9] + (size_t)1024 * NIN);
            else ph_row(F, A, A->out, nullptr, (const float*)A->in[8] + D, modl, 5120, nullptr, nullptr, 0, 1024, nullptr, false, (const bf16_t*)(ws + WS_HG));
        }
        SEAM(base + PL_ROWFFN);
    }
#undef IN
#undef SEAM
}

extern "C" void kernel_launch(void* const* d_in, const int* in_sizes, int n_in, void* d_out, int out_size, void* d_ws, size_t ws_size, hipStream_t stream) {
    static int grid = 0;
    if (grid == 0) {
        if (n_in != 40 || ws_size < WS_END) { fprintf(stderr, "kernel_launch: need 40 inputs and >= %zu bytes of workspace (got %d, %zu)\n", (size_t)WS_END, n_in, ws_size); grid = -1; return; }
        int dev = 0, cus = 0, per_cu = 0;
        (void)hipGetDevice(&dev); (void)hipDeviceGetAttribute(&cus, hipDeviceAttributeMultiprocessorCount, dev);
        (void)hipFuncSetAttribute((const void*)mk_fwd, hipFuncAttributeMaxDynamicSharedMemorySize, LDS_BYTES);
        (void)hipOccupancyMaxActiveBlocksPerMultiprocessor(&per_cu, (const void*)mk_fwd, NTHR, LDS_BYTES);
        (void)hipGetLastError();
        grid = cus > 0 ? cus : 256;
        if (per_cu < 1) fprintf(stderr, "kernel_launch: occupancy query says %d blocks per CU\n", per_cu);
    }
    if (grid < 0) return;
    unsigned char* ws = (unsigned char*)d_ws;
    (void)hipMemsetAsync(ws + WS_CTL, 0, CTL_ZERO_BYTES, stream);
    Args a{};
    for (int i = 0; i < 40; ++i) a.in[i] = d_in[i];
    a.out = (float*)d_out; a.ws = ws;
#if defined(PREFIX)
    a.ph_lo = 0; a.ph_hi = PREFIX;
    hipLaunchKernelGGL(mk_fwd, dim3(grid), dim3(NTHR), LDS_BYTES, stream, a);
    (void)hipMemsetAsync(ws + WS_CTL, 0, CTL_ZERO_BYTES, stream);
#endif
    a.ph_lo = 0; a.ph_hi = PH_L0 + (NL - 1) * PH_PER_LAYER + PL_ROWFFN + 1;
    hipLaunchKernelGGL(mk_fwd, dim3(grid), dim3(NTHR), LDS_BYTES, stream, a);
}
```

```cpp
#include <hip/hip_runtime.h>
#include <hip/hip_bf16.h>
#include <cstdint>
#include <cstdio>

typedef __hip_bfloat16 bf16;
typedef unsigned short bf16_t;
#define GAS __attribute__((address_space(1)))
#define LAS __attribute__((address_space(3)))

constexpr int D = 1024, NB = 8, T = 2048, M = NB * T, NL = 2;
constexpr int NIN = 7184;
constexpr int PW = 7424;
constexpr int P_GQ = 0, P_GK = 128, P_GV = 256, P_GO = 512, P_DQ = 768, P_DK = 1024, P_DV = 1280, P_CA = 1536, P_CB = 1792, P_R = 2048, P_GATE = 3072, P_GZ = 7168;
constexpr int DFF = 2816, NE = 8, DEX = 3584;
constexpr int DEXP = 3648;
constexpr int NWAVES = 8, NTHR = 512;
constexpr size_t MiB = 1u << 20;
constexpr size_t WS_CTL = 0;
constexpr size_t CTL_ZERO_BYTES = 64 * 1024;
constexpr size_t WS_MOD = 1 * MiB;
constexpr size_t WS_ROUTE = 1 * MiB + 512 * 1024;
constexpr size_t WS_GZ = 2 * MiB + 512 * 1024;
constexpr size_t WS_LR = 3 * MiB;
constexpr size_t WS_WIN = 4 * MiB;
constexpr size_t WS_WB = 33 * MiB;
constexpr size_t WS_WO = 37 * MiB;
constexpr size_t WS_WF1 = 41 * MiB;
constexpr size_t WS_WF2 = 52 * MiB;
constexpr size_t WS_HB = 58 * MiB;
constexpr size_t WS_PROJ = 90 * MiB;
constexpr size_t WS_SCR = 322 * MiB;
constexpr size_t WS_H2L1 = 508 * MiB;
constexpr size_t WS_END = 540 * MiB;
constexpr size_t WS_HG = 4 * MiB;
constexpr size_t WS_WM1 = 72 * MiB;
constexpr size_t WS_WM2 = 184 * MiB;
constexpr size_t WS_HID = 242 * MiB;
static_assert(WS_HID + (size_t)34816 * DEXP * 2 <= WS_H2L1 && WS_WM2 + (size_t)8 * 1024 * DEXP * 2 <= WS_HID, "moe overlay");
constexpr size_t SCR_MP = WS_SCR;
constexpr size_t SCR_MB = WS_SCR + 64 * MiB;
constexpr size_t SCR_Y = WS_SCR + 96 * MiB;
constexpr size_t SCR_RW = WS_SCR;
constexpr size_t SCR_GK = WS_SCR + 112 * MiB;
constexpr size_t SCR_QR = WS_SCR + 120 * MiB;
constexpr size_t SCR_KR = WS_SCR + 136 * MiB;
constexpr size_t SCR_VEC6 = WS_SCR;
constexpr size_t SCR_SC = WS_SCR + 56 * MiB;
constexpr size_t SCR_STM = WS_SCR + 57 * MiB;
constexpr size_t SCR_GR = WS_SCR + 73 * MiB;
constexpr size_t SCR_VT = WS_SCR + 81 * MiB;
constexpr size_t SCR_GU = WS_SCR + 89 * MiB;
constexpr size_t SCR_GS = SCR_GU;
constexpr size_t SCR_QK = WS_SCR + 105 * MiB;
constexpr size_t SCR_EG = WS_SCR + 121 * MiB;
constexpr size_t SCR_QE = WS_SCR + 130 * MiB;
constexpr size_t SCR_AY = WS_SCR + 138 * MiB;
constexpr size_t SCR_VTC = WS_SCR + 142 * MiB;
constexpr size_t SCR_GMF = WS_SCR + 150 * MiB;
constexpr size_t SCR_ZB = WS_SCR + 166 * MiB;
constexpr size_t SCR_YR = WS_SCR + 166 * MiB;
constexpr int RECB = 896;
constexpr size_t WS_GOI = WS_H2L1;
constexpr size_t WS_GST = WS_H2L1 + 16 * MiB;
constexpr int CW_TMO = 0;
constexpr int CW_BAR = 1024;
constexpr int CW_CNT = 8192;
constexpr size_t RT_BCNT = 0;
constexpr size_t RT_TOKE = 512 * 1024;
constexpr size_t RT_TOKS = 640 * 1024;
constexpr size_t RT_TOKP = 768 * 1024;

__device__ __forceinline__ float sigm(float x) { return __builtin_amdgcn_rcpf(1.0f + __expf(-x)); }
__device__ __forceinline__ float siluf(float x) { return x * sigm(x); }
__device__ __forceinline__ float softplusf(float x) { return fmaxf(x, 0.f) + __logf(1.0f + __expf(-fabsf(x))); }
__device__ __forceinline__ float tanh_fast(float x) { return 1.0f - 2.0f * __builtin_amdgcn_rcpf(1.0f + __expf(2.0f * x)); }
template <int CTRL, int ROWMASK> __device__ __forceinline__ float dpp_mov_h(float old, float x) {
    return __builtin_bit_cast(float, __builtin_amdgcn_update_dpp(__builtin_bit_cast(int, old), __builtin_bit_cast(int, x), CTRL, ROWMASK, 0xF, false)); }
__device__ __forceinline__ float wave_sum(float x) {
    x += dpp_mov_h<0xB1, 0xF>(0.f, x); x += dpp_mov_h<0x4E, 0xF>(0.f, x); x += dpp_mov_h<0x141, 0xF>(0.f, x); x += dpp_mov_h<0x140, 0xF>(0.f, x);
    x += dpp_mov_h<0x142, 0xA>(0.f, x); x += dpp_mov_h<0x143, 0xC>(0.f, x);
    return __builtin_bit_cast(float, __builtin_amdgcn_readlane(__builtin_bit_cast(int, x), 63));
}
__device__ __forceinline__ float wave_max(float v) {
#pragma unroll
    for (int o = 32; o > 0; o >>= 1) v = fmaxf(v, __shfl_xor(v, o));
    return v;
}
__device__ __forceinline__ float ldf(const float* p) { return *p; }
__device__ __forceinline__ float ldf(const bf16* p) { return __bfloat162float(*p); }
__device__ __forceinline__ float bf2f(bf16_t u) { return __builtin_bit_cast(float, (unsigned)u << 16); }
__device__ __forceinline__ unsigned f2bf(float f) { unsigned u = __builtin_bit_cast(unsigned, f); return (u + 0x7fffu + ((u >> 16) & 1u)) >> 16; }
typedef float f32x2_t_ __attribute__((ext_vector_type(2))); typedef __bf16 bf16x2_t_ __attribute__((ext_vector_type(2)));
__device__ __forceinline__ unsigned pk2(float lo, float hi) { const f32x2_t_ v = {lo, hi}; const bf16x2_t_ b = __builtin_convertvector(v, bf16x2_t_); return __builtin_bit_cast(unsigned, b); }
namespace pg8 {
#define PG8_LAS __attribute__((address_space(3)))
typedef short bf16x8 __attribute__((ext_vector_type(8)));
typedef float f32x4 __attribute__((ext_vector_type(4)));
typedef float f32x2 __attribute__((ext_vector_type(2)));
typedef unsigned u32x4 __attribute__((ext_vector_type(4)));
typedef unsigned u32x2 __attribute__((ext_vector_type(2)));
constexpr int BM = 256, BK = 64, HALF = 128, HTB = HALF * BK * 2  , STAGE_BYTES = 8 * HTB, NXCD = 8, WGM = 8;

__host__ __device__ __forceinline__ int lds_byte(int r, int c) { const int st = (r >> 4) * 2 + (c >> 5), rr = r & 15, cc = c & 31, ob = rr * 64 + cc * 2; return st * 1024 + (ob ^ (((ob >> 9) & 1) << 5)); }
__host__ __device__ __forceinline__ void stage_rc(int b, int& R, int& C) { const int st = b / 1024, sb = b % 1024, swz = sb ^ (((sb >> 9) & 1) << 5); R = (st >> 1) * 16 + swz / 64; C = (st & 1) * 32 + (swz % 64) / 2; }
__host__ __device__ __forceinline__ int perm32(int rho) { const int n = rho >> 4, i = rho & 15; return 8 * (i >> 2) + 4 * n + (i & 3); }

struct Unit { int pm, pn, aoff, tag; };
struct Gemm { const bf16_t* A; const bf16_t* Bt; int lda, ldb, K, pad; };

struct StaticOrder {
    static constexpr bool VARK = false;
    int nM, nN, nwg, G, c;
    __host__ __device__ void init(int M_, int N_, int G_, int c_) { nM = M_ / BM; nN = N_ / BM; nwg = nM * nN; G = G_; c = c_; }
    __host__ __device__ bool next(int i, Unit& u) const {
        const long L = (long)i * G + c; if (L >= nwg) return false;
        int wgid = (int)L; { const int q = nwg / NXCD, r = nwg % NXCD, xcd = wgid % NXCD, off = wgid / NXCD; wgid = (xcd < r ? xcd * (q + 1) : r * (q + 1) + (xcd - r) * q) + off; }
        const int nig = WGM * nN, gid = wgid / nig, fm = gid * WGM, gsz = (nM - fm) < WGM ? (nM - fm) : WGM;
        u.pm = fm + ((wgid % nig) % gsz); u.pn = (wgid % nig) / gsz; u.aoff = 0; u.tag = 0; return true;
    }
};

__device__ __forceinline__ unsigned cvt_pk_bf16(float lo, float hi) { unsigned r; asm volatile("v_cvt_pk_bf16_f32 %0, %1, %2" : "=v"(r) : "v"(lo), "v"(hi)); return r; }


template <class Epi, class Sched, bool ALIGN_EPI>
__device__ __forceinline__ void gemm_phase(PG8_LAS unsigned char* lds, const Gemm g, const Sched& S, const Epi& E, int wave_s) {
    unsigned z_ = 0u; asm volatile("" : "+v"(z_));
    int tid_ = wave_s * 64 + (int)__builtin_amdgcn_mbcnt_hi(~0u, __builtin_amdgcn_mbcnt_lo(~0u, z_)); asm volatile("" : "+v"(tid_));
    const int tid = tid_, wid = __builtin_amdgcn_readfirstlane(tid >> 6), lane = tid & 63, wr = wid >> 2, wc = wid & 3, fr = lane & 15, fq = lane >> 4;
    const int K = g.K, nt = K / BK;
    unsigned voffA[2], voffB[2];
#pragma unroll
    for (int i = 0; i < 2; ++i) { int R, C; stage_rc(tid * 16 + i * 8192, R, C); const int Rb = Epi::PERM ? ((R & ~31) + perm32(R & 31)) : R;
        voffA[i] = (unsigned)(R * g.lda + C) * 2u; voffB[i] = (unsigned)(Rb * g.ldb + C) * 2u; }
    const size_t kstep = (size_t)(BK * 2);
    const size_t hstepA = (size_t)HALF * g.lda * 2, hstepB = (size_t)HALF * g.ldb * 2;
    const size_t tstepA = 2 * hstepA, tstepB = 2 * hstepB;
    const unsigned ldsw = (unsigned)wid * 1024u;
    const int aoff = lds_byte(wr * 64 + fr, fq * 8), boff = lds_byte(wc * 32 + fr, fq * 8);
#define PG8_SA(b, h) (((b) * 2 + (h)) * HTB)
#define PG8_SB(b, h) ((4 + (b) * 2 + (h)) * HTB)
#define PG8_STAGE(bufoff, gbase, voff) do { _Pragma("unroll") for (int _i = 0; _i < 2; ++_i) \
        __builtin_amdgcn_global_load_lds((const unsigned*)((const char*)(gbase) + (voff)[_i]), (PG8_LAS unsigned*)(lds + (bufoff) + ldsw + _i * 8192), 16, 0, 0); } while (0)
#define PG8_LDA(dst, b, h) do { _Pragma("unroll") for (int m = 0; m < 4; ++m) _Pragma("unroll") for (int k = 0; k < 2; ++k) dst[m][k] = *(const PG8_LAS bf16x8*)(lds + PG8_SA(b, h) + aoff + m * 2048 + k * 1024); } while (0)
#define PG8_LDB(dst, b, h) do { _Pragma("unroll") for (int n = 0; n < 2; ++n) _Pragma("unroll") for (int k = 0; k < 2; ++k) dst[n][k] = *(const PG8_LAS bf16x8*)(lds + PG8_SB(b, h) + boff + n * 2048 + k * 1024); } while (0)
#define PG8_MMA(ai, bj, At, Bt) do { __builtin_amdgcn_s_setprio(1); _Pragma("unroll") for (int m = 0; m < 4; ++m) _Pragma("unroll") for (int n = 0; n < 2; ++n) _Pragma("unroll") for (int k = 0; k < 2; ++k) \
        acc[ai][bj][m][n] = __builtin_amdgcn_mfma_f32_16x16x32_bf16(Bt[n][k], At[m][k], acc[ai][bj][m][n], 0, 0, 0); __builtin_amdgcn_s_setprio(0); } while (0)
#define PG8_WAIT_V(n) asm volatile("s_waitcnt vmcnt(" #n ")" ::: "memory")
#define PG8_WAIT_L(n) asm volatile("s_waitcnt lgkmcnt(" #n ")" ::: "memory")
#define PG8_BAR __builtin_amdgcn_s_barrier()
#define PG8_SCHED __builtin_amdgcn_sched_barrier(0)
    Unit cur, nxt; int ui = 0;
    if (!S.next(0, cur)) return;
    f32x4 acc[2][2][4][2];
#pragma unroll
    for (int a = 0; a < 2; ++a)
#pragma unroll
        for (int b = 0; b < 2; ++b)
#pragma unroll
            for (int m = 0; m < 4; ++m)
#pragma unroll
                for (int n = 0; n < 2; ++n) acc[a][b][m][n] = (f32x4){0.f, 0.f, 0.f, 0.f};
    bf16x8 At[4][2], B0[2][2], B1[2][2];
    const char* cA = (const char*)g.A + (size_t)cur.pm * tstepA + (size_t)cur.aoff * 2; const char* cB = (const char*)g.Bt + (size_t)cur.pn * tstepB + (Sched::VARK ? (size_t)cur.aoff * 2 : (size_t)0);
    PG8_STAGE(PG8_SB(0, 0), cB, voffB); PG8_STAGE(PG8_SB(0, 1), cB + hstepB, voffB); PG8_STAGE(PG8_SA(0, 0), cA, voffA); PG8_STAGE(PG8_SA(0, 1), cA + hstepA, voffA);
    if (wr == 1) PG8_BAR;
    PG8_WAIT_V(2); PG8_BAR;
    PG8_STAGE(PG8_SB(1, 0), cB + kstep, voffB); PG8_STAGE(PG8_SA(1, 0), cA + kstep, voffA); PG8_STAGE(PG8_SB(1, 1), cB + hstepB + kstep, voffB);
    PG8_WAIT_V(6); PG8_BAR;
    for (;;) {
        const bool has_next = S.next(ui + 1, nxt);
        const char* nA = has_next ? (const char*)g.A + (size_t)nxt.pm * tstepA + (size_t)nxt.aoff * 2 : cA; const char* nB = has_next ? (const char*)g.Bt + (size_t)nxt.pn * tstepB + (Sched::VARK ? (size_t)nxt.aoff * 2 : (size_t)0) : cB;
        int ntc = nt; if constexpr (Sched::VARK) ntc = S.nt_of(cur);
        for (int t = 0; t < ntc; t += 2) {
            if constexpr (Epi::MIDK) { if (t != 0 && (t & 3) == 0) E.mid(acc, cur, t >> 2, wr, wc); }
            const bool last = (t == ntc - 2);
            const char* a1 = cA + (size_t)(t + 1) * kstep;
            const char* a2 = last ? nA : cA + (size_t)(t + 2) * kstep; const char* b2 = last ? nB : cB + (size_t)(t + 2) * kstep;
            const char* a3 = a2 + kstep; const char* b3 = b2 + kstep;
            PG8_LDB(B0, 0, 0); PG8_LDB(B1, 0, 1); PG8_SCHED; PG8_LDA(At, 0, 0); PG8_STAGE(PG8_SA(1, 1), a1 + hstepA, voffA);
            PG8_WAIT_V(8); PG8_WAIT_L(0); PG8_BAR; PG8_MMA(0, 0, At, B0); PG8_MMA(0, 1, At, B1); PG8_BAR; PG8_SCHED;
            PG8_LDA(At, 0, 1); PG8_STAGE(PG8_SB(0, 0), b2, voffB); PG8_STAGE(PG8_SB(0, 1), b2 + hstepB, voffB); PG8_STAGE(PG8_SA(0, 0), a2, voffA);
            PG8_WAIT_V(8); PG8_WAIT_L(0); PG8_BAR; PG8_MMA(1, 0, At, B0); PG8_MMA(1, 1, At, B1); PG8_BAR; PG8_SCHED;
            PG8_LDB(B0, 1, 0); PG8_LDB(B1, 1, 1); PG8_SCHED; PG8_LDA(At, 1, 0); PG8_STAGE(PG8_SA(0, 1), a2 + hstepA, voffA);
            PG8_WAIT_V(8); PG8_WAIT_L(0); PG8_BAR; PG8_MMA(0, 0, At, B0); PG8_MMA(0, 1, At, B1); PG8_BAR; PG8_SCHED;
            PG8_LDA(At, 1, 1); PG8_STAGE(PG8_SB(1, 0), b3, voffB); PG8_STAGE(PG8_SB(1, 1), b3 + hstepB, voffB); PG8_STAGE(PG8_SA(1, 0), a3, voffA);
            PG8_WAIT_V(8); PG8_WAIT_L(0); PG8_BAR; PG8_MMA(1, 0, At, B0); PG8_MMA(1, 1, At, B1); PG8_BAR; PG8_SCHED;
        }
        if constexpr (ALIGN_EPI) { if (wr == 0) PG8_BAR; }
        { unsigned z2_ = 0u; asm volatile("" : "+v"(z2_)); const int l2_ = (int)__builtin_amdgcn_mbcnt_hi(~0u, __builtin_amdgcn_mbcnt_lo(~0u, z2_));
          E(acc, cur, wr, wc, l2_ & 15, l2_ >> 4); }
        if (!has_next) break;
#pragma unroll
        for (int a = 0; a < 2; ++a)
#pragma unroll
            for (int b = 0; b < 2; ++b)
#pragma unroll
                for (int m = 0; m < 4; ++m)
#pragma unroll
                    for (int n = 0; n < 2; ++n) acc[a][b][m][n] = (f32x4){0.f, 0.f, 0.f, 0.f};
        cur = nxt; cA = nA; cB = nB; ++ui;
        if constexpr (ALIGN_EPI) { if (wr == 1) PG8_BAR; }
    }
    PG8_WAIT_V(0);
    if constexpr (!ALIGN_EPI) { if (wr == 0) PG8_BAR; }
    PG8_BAR;
#undef PG8_SA
#undef PG8_SB
#undef PG8_STAGE
#undef PG8_LDA
#undef PG8_LDB
#undef PG8_MMA
#undef PG8_WAIT_V
#undef PG8_WAIT_L
#undef PG8_BAR
#undef PG8_SCHED
}

struct EpiBf16 {
    static constexpr bool PERM = true, MIDK = false;
    bf16_t* O; int ldc; int ntn;
    __device__ __forceinline__ void operator()(const f32x4 (&acc)[2][2][4][2], const Unit& u, int wr, int wc, int fr, int fq) const {
        const int row0 = u.pm * BM + wr * 64 + fr, col0 = (u.pn % ntn) * BM + wc * 32 + 8 * fq;
#pragma unroll
        for (int ai = 0; ai < 2; ++ai)
#pragma unroll
            for (int m = 0; m < 4; ++m) { bf16_t* rowp = O + (size_t)(row0 + ai * HALF + m * 16) * ldc + col0;
#pragma unroll
                for (int bj = 0; bj < 2; ++bj) { const f32x4 v0 = acc[ai][bj][m][0], v1 = acc[ai][bj][m][1];
                    u32x4 w; w.x = cvt_pk_bf16(v0[0], v0[1]); w.y = cvt_pk_bf16(v0[2], v0[3]); w.z = cvt_pk_bf16(v1[0], v1[1]); w.w = cvt_pk_bf16(v1[2], v1[3]);
                    *(u32x4*)(rowp + bj * HALF) = w; } }
    }
};
struct EpiF32 {
    static constexpr bool PERM = false, MIDK = false;
    float* C; int ldc; int ntn;
    __device__ __forceinline__ void operator()(const f32x4 (&acc)[2][2][4][2], const Unit& u, int wr, int wc, int fr, int fq) const {
        const int row0 = u.pm * BM + wr * 64 + fr, col0 = (u.pn % ntn) * BM + wc * 32 + 4 * fq;
#pragma unroll
        for (int ai = 0; ai < 2; ++ai)
#pragma unroll
            for (int m = 0; m < 4; ++m) { float* rowp = C + (size_t)(row0 + ai * HALF + m * 16) * ldc + col0;
#pragma unroll
                for (int bj = 0; bj < 2; ++bj)
#pragma unroll
                    for (int n = 0; n < 2; ++n) *(f32x4*)(rowp + bj * HALF + n * 16) = acc[ai][bj][m][n]; }
    }
};
struct EpiSwiglu {
    static constexpr bool PERM = true, MIDK = false;
    bf16_t* O; int ldc; int ntn;
    __device__ __forceinline__ void operator()(const f32x4 (&acc)[2][2][4][2], const Unit& u, int wr, int wc, int fr, int fq) const {
        const int row0 = u.pm * BM + wr * 64 + fr, col0 = (u.pn % ntn) * 128 + wc * 16 + 4 * fq;
#pragma unroll
        for (int ai = 0; ai < 2; ++ai)
#pragma unroll
            for (int m = 0; m < 4; ++m) { bf16_t* rowp = O + (size_t)(row0 + ai * HALF + m * 16) * ldc + col0;
#pragma unroll
                for (int bj = 0; bj < 2; ++bj) { const f32x4 gt = acc[ai][bj][m][0], up = acc[ai][bj][m][1];
                    float h[4];
#pragma unroll
                    for (int e = 0; e < 4; ++e) h[e] = gt[e] * __builtin_amdgcn_rcpf(1.0f + __expf(-gt[e])) * up[e];
                    u32x2 w; w.x = cvt_pk_bf16(h[0], h[1]); w.y = cvt_pk_bf16(h[2], h[3]);
                    *(u32x2*)(rowp + bj * 64) = w; } }
    }
};
struct EpiBranch {
    static constexpr bool PERM = true, MIDK = false;
    const bf16_t* proj; float* MP; bf16_t* MB;
    __device__ __forceinline__ void operator()(const f32x4 (&acc)[2][2][4][2], const Unit& u, int wr, int wc, int fr, int fq) const {
        const int g = u.tag; const int row0 = u.pm * BM + wr * 64 + fr, col0 = (u.pn & 3) * BM + wc * 32 + 8 * fq;
#pragma unroll
        for (int ai = 0; ai < 2; ++ai)
#pragma unroll
            for (int m = 0; m < 4; ++m) { const size_t row = (size_t)(row0 + ai * HALF + m * 16);
#pragma unroll
                for (int bj = 0; bj < 2; ++bj) { const int col = col0 + bj * HALF;
                    const u32x4 gw = *(const u32x4*)(proj + row * PW + P_GATE + g * 1024 + col);
                    float gv[8];
#pragma unroll
                    for (int e = 0; e < 4; ++e) { const unsigned w = gw[e]; gv[2 * e] = __builtin_bit_cast(float, w << 16); gv[2 * e + 1] = __builtin_bit_cast(float, w & 0xffff0000u); }
                    f32x4 v0 = acc[ai][bj][m][0], v1 = acc[ai][bj][m][1];
#pragma unroll
                    for (int e = 0; e < 4; ++e) { v0[e] *= __builtin_amdgcn_rcpf(1.0f + __expf(-gv[e])); v1[e] *= __builtin_amdgcn_rcpf(1.0f + __expf(-gv[4 + e])); }
                    float* mp = MP + row * D + col;
                    if (g > 0) { v0 += *(const f32x4*)mp; v1 += *(const f32x4*)(mp + 4); }
                    if (g < 3) { *(f32x4*)mp = v0; *(f32x4*)(mp + 4) = v1; }
                    else { u32x4 w; w.x = cvt_pk_bf16(v0[0], v0[1]); w.y = cvt_pk_bf16(v0[2], v0[3]); w.z = cvt_pk_bf16(v1[0], v1[1]); w.w = cvt_pk_bf16(v1[2], v1[3]);
                        *(u32x4*)(MB + row * D + col) = w; } } }
    }
};
struct EpiBranchK {
    static constexpr bool PERM = true, MIDK = true;
    const bf16_t* proj; bf16_t* MB;
    __device__ __forceinline__ static float em(float x) { return fminf(__expf(-x), 1e20f); }
    __device__ __forceinline__ void mid(f32x4 (&acc)[2][2][4][2], const Unit& u, int gnext, int wr, int wc) const {
        unsigned z_ = 0u; asm volatile("" : "+v"(z_)); const int l_ = (int)__builtin_amdgcn_mbcnt_hi(~0u, __builtin_amdgcn_mbcnt_lo(~0u, z_)); const int fr = l_ & 15, fq = l_ >> 4;
        const int row0 = u.pm * BM + wr * 64 + fr, col0 = u.pn * BM + wc * 32 + 8 * fq;
#pragma unroll
        for (int ai = 0; ai < 2; ++ai)
#pragma unroll
            for (int m = 0; m < 4; ++m) { const bf16_t* gp = proj + (size_t)(row0 + ai * HALF + m * 16) * PW + P_GATE + (gnext - 1) * 1024 + col0;
#pragma unroll
                for (int bj = 0; bj < 2; ++bj) { const u32x4 g0 = *(const u32x4*)(gp + bj * HALF), g1 = *(const u32x4*)(gp + 1024 + bj * HALF);
#pragma unroll
                    for (int e = 0; e < 4; ++e) { const unsigned a = g0[e], b = g1[e];
                        const float ra = (1.0f + em(__builtin_bit_cast(float, b << 16))) * __builtin_amdgcn_rcpf(1.0f + em(__builtin_bit_cast(float, a << 16)));
                        const float rb = (1.0f + em(__builtin_bit_cast(float, b & 0xffff0000u))) * __builtin_amdgcn_rcpf(1.0f + em(__builtin_bit_cast(float, a & 0xffff0000u)));
                        if (e < 2) { acc[ai][bj][m][0][2 * e] *= ra; acc[ai][bj][m][0][2 * e + 1] *= rb; } else { acc[ai][bj][m][1][2 * (e - 2)] *= ra; acc[ai][bj][m][1][2 * (e - 2) + 1] *= rb; } } } }
    }
    __device__ __forceinline__ void operator()(const f32x4 (&acc)[2][2][4][2], const Unit& u, int wr, int wc, int fr, int fq) const {
        const int row0 = u.pm * BM + wr * 64 + fr, col0 = u.pn * BM + wc * 32 + 8 * fq;
#pragma unroll
        for (int ai = 0; ai < 2; ++ai)
#pragma unroll
            for (int m = 0; m < 4; ++m) { const size_t row = (size_t)(row0 + ai * HALF + m * 16);
#pragma unroll
                for (int bj = 0; bj < 2; ++bj) { const u32x4 gw = *(const u32x4*)(proj + row * PW + P_GATE + 3 * 1024 + col0 + bj * HALF);
                    float sg[8];
#pragma unroll
                    for (int e = 0; e < 4; ++e) { sg[2 * e] = __builtin_amdgcn_rcpf(1.0f + em(__builtin_bit_cast(float, gw[e] << 16))); sg[2 * e + 1] = __builtin_amdgcn_rcpf(1.0f + em(__builtin_bit_cast(float, gw[e] & 0xffff0000u))); }
                    const f32x4 v0 = acc[ai][bj][m][0], v1 = acc[ai][bj][m][1];
                    u32x4 w; w.x = cvt_pk_bf16(v0[0] * sg[0], v0[1] * sg[1]); w.y = cvt_pk_bf16(v0[2] * sg[2], v0[3] * sg[3]); w.z = cvt_pk_bf16(v1[0] * sg[4], v1[1] * sg[5]); w.w = cvt_pk_bf16(v1[2] * sg[6], v1[3] * sg[7]);
                    *(u32x4*)(MB + row * D + col0 + bj * HALF) = w; } }
    }
};
struct BranchOrder {
    static constexpr bool VARK = false;
    int G, c;
    __device__ bool next(int i, Unit& u) const {
        const int tile = (i >> 2) * G + c; if (tile >= 256) return false;
        const int g = i & 3; u.pm = tile >> 2; u.pn = g * 4 + (tile & 3); u.aoff = g * 256; u.tag = g; return true;
    }
};
template <int NTC> struct MoeOrder {
    static constexpr bool VARK = false;
    static constexpr int NT = NTC; int G, c, ntiles; int t1, t2, t3, t4, t5, t6, t7;
    __device__ __forceinline__ void init(const unsigned* cnt, int G_, int c_) { G = G_; c = (G_ % 8 == 0) ? (c_ % 8) * (G_ / 8) + c_ / 8 : c_;
        int o = ((int)cnt[0] + 255) >> 8; t1 = o; o += ((int)cnt[1] + 255) >> 8; t2 = o; o += ((int)cnt[2] + 255) >> 8; t3 = o; o += ((int)cnt[3] + 255) >> 8; t4 = o;
        o += ((int)cnt[4] + 255) >> 8; t5 = o; o += ((int)cnt[5] + 255) >> 8; t6 = o; o += ((int)cnt[6] + 255) >> 8; t7 = o; o += ((int)cnt[7] + 255) >> 8; ntiles = o; }
    __device__ __forceinline__ bool next(int i, Unit& u) const {
        const int L = i * G + c; if (L >= ntiles * NT) return false;
        const int tau = L / NT, pn = L % NT;
        const int e = (tau >= t1) + (tau >= t2) + (tau >= t3) + (tau >= t4) + (tau >= t5) + (tau >= t6) + (tau >= t7);
        u.pm = tau; u.pn = e * NT + pn; u.aoff = 0; u.tag = e; return true;
    }
};
struct MoeSplit { int tau0, nrt, s; };
__device__ __forceinline__ MoeSplit moe_split(const unsigned* cnt, int G) {
    int o = 0;
#pragma unroll
    for (int e = 0; e < 8; ++e) o += ((int)cnt[e] + 255) >> 8;
    const int U = o * 4, nfull = (U / G) * G, rem = U - nfull; MoeSplit r; r.tau0 = o; r.nrt = 0; r.s = 1;
    if ((nfull & 3) == 0 && rem > 0 && rem * 2 <= G) { r.s = (rem * 7 <= G) ? 7 : (rem * 4 <= G) ? 4 : 2; r.tau0 = nfull >> 2; r.nrt = o - r.tau0; }
    return r;
}
struct MoeOrderSplit {
    static constexpr bool VARK = true;
    static constexpr int NT = 4, KT = 56; int G, c, ntiles; int t1, t2, t3, t4, t5, t6, t7; int nfull, rem, s;
    __device__ __forceinline__ void init(const unsigned* cnt, int G_, int c_) { G = G_; c = (G_ % 8 == 0) ? (c_ % 8) * (G_ / 8) + c_ / 8 : c_;
        int o = ((int)cnt[0] + 255) >> 8; t1 = o; o += ((int)cnt[1] + 255) >> 8; t2 = o; o += ((int)cnt[2] + 255) >> 8; t3 = o; o += ((int)cnt[3] + 255) >> 8; t4 = o;
        o += ((int)cnt[4] + 255) >> 8; t5 = o; o += ((int)cnt[5] + 255) >> 8; t6 = o; o += ((int)cnt[6] + 255) >> 8; t7 = o; o += ((int)cnt[7] + 255) >> 8; ntiles = o;
        const MoeSplit sp = moe_split(cnt, G_); s = sp.s; nfull = (s > 1) ? sp.tau0 * 4 : ntiles * 4; rem = ntiles * 4 - nfull; }
    __device__ __forceinline__ bool next(int i, Unit& u) const {
        const int L = i * G + c; int tl = L, kp = 0;
        if (L >= nfull) { const int j = L - nfull; if (j >= rem * s) return false; tl = nfull + j / s; kp = j % s + 1; }
        const int tau = tl >> 2, pn = tl & 3;
        const int e = (tau >= t1) + (tau >= t2) + (tau >= t3) + (tau >= t4) + (tau >= t5) + (tau >= t6) + (tau >= t7);
        u.pm = tau; u.pn = e * NT + pn; u.aoff = kp ? (kp - 1) * ((KT * BK) / s) : 0; u.tag = e | (kp << 8); return true;
    }
    __device__ __forceinline__ int nt_of(const Unit& u) const { return (u.tag >> 8) ? KT / s : KT; }
};
struct EpiBf16Split {
    static constexpr bool PERM = true, MIDK = false;
    bf16_t* O; bf16_t* P; int tau0, nrt;
    __device__ __forceinline__ void operator()(const f32x4 (&acc)[2][2][4][2], const Unit& u, int wr, int wc, int fr, int fq) const {
        const int kp = u.tag >> 8;
        bf16_t* base = kp ? P + (size_t)((kp - 1) * nrt + (u.pm - tau0)) * BM * 1024 : O + (size_t)u.pm * BM * 1024;
        const int row0 = wr * 64 + fr, col0 = (u.pn & 3) * BM + wc * 32 + 8 * fq;
#pragma unroll
        for (int ai = 0; ai < 2; ++ai)
#pragma unroll
            for (int m = 0; m < 4; ++m) { bf16_t* rowp = base + (size_t)(row0 + ai * HALF + m * 16) * 1024 + col0;
#pragma unroll
                for (int bj = 0; bj < 2; ++bj) { const f32x4 v0 = acc[ai][bj][m][0], v1 = acc[ai][bj][m][1];
                    u32x4 w; w.x = cvt_pk_bf16(v0[0], v0[1]); w.y = cvt_pk_bf16(v0[2], v0[3]); w.z = cvt_pk_bf16(v1[0], v1[1]); w.w = cvt_pk_bf16(v1[2], v1[3]);
                    *(u32x4*)(rowp + bj * HALF) = w; } }
    }
};
}
typedef GAS unsigned gu32;
#define RLX_AGENT __ATOMIC_RELAXED, __HIP_MEMORY_SCOPE_AGENT
#define XB_TMO      128
#define XB_XCNT(j)  (256  + 64 * (j))
#define XB_XSUB(j)  (1280 + 64 * (j))
#define XB_XGEN(j)  (2304 + 64 * (j))
#define XB_TOP      3328
#define XB_TOPGEN   3392
#define XCD_BAR_WORDS 3456
#define XB_SPIN_CAP (1u << 18)

__device__ __forceinline__ unsigned xb_ld(unsigned* p)              { return __hip_atomic_load(p, __ATOMIC_RELAXED, __HIP_MEMORY_SCOPE_AGENT); }
__device__ __forceinline__ unsigned xb_add(unsigned* p, unsigned v) { return __hip_atomic_fetch_add(p, v, __ATOMIC_RELAXED, __HIP_MEMORY_SCOPE_AGENT); }
__device__ __forceinline__ unsigned xb_xcc_id() { return (unsigned)__builtin_amdgcn_s_getreg((3 << 11) | 20) & 0xFu; }
#define XB_SPIN(cond, bar) do { unsigned _sp = 0; while (cond) { __builtin_amdgcn_s_sleep(1); \
    if ((++_sp & 255u) == 0u) { if (xb_ld(&(bar)[XB_TMO])) break; if (_sp > XB_SPIN_CAP) { atomicAdd(&(bar)[XB_TMO], 1u); break; } } } } while (0)

struct XcdBarrier {
    unsigned* bar; unsigned x;
    volatile LAS unsigned* st;
};

__device__ __forceinline__ XcdBarrier xcd_barrier_post(unsigned* bar, volatile LAS unsigned* st) {
    XcdBarrier b; b.bar = bar; b.x = xb_xcc_id(); b.st = st;
    if (threadIdx.x == 0) (void)xb_add(&bar[XB_XCNT(b.x)], 1u);
    return b;
}
__device__ __forceinline__ void xcd_barrier_complete(unsigned* bar, unsigned x, unsigned& nloc, unsigned& nx) {
    const unsigned G = gridDim.x * gridDim.y * gridDim.z;
    unsigned sum, cnt, mine, sp = 0u;
    for (;;) {
        sum = 0u; cnt = 0u; mine = 0u;
#pragma unroll
        for (unsigned j = 0; j < 16; ++j) { const unsigned c = xb_ld(&bar[XB_XCNT(j)]); sum += c; cnt += (c > 0u) ? 1u : 0u; mine = (j == x) ? c : mine; }
        if (sum == G) break;
        __builtin_amdgcn_s_sleep(1);
        if ((++sp & 255u) == 0u) { if (xb_ld(&bar[XB_TMO])) break; if (sp > XB_SPIN_CAP) { atomicAdd(&bar[XB_TMO], 1u); break; } }
    }
    nloc = mine > 0u ? mine : 1u; nx = cnt > 0u ? cnt : 1u;
}

__device__ __forceinline__ void xcd_barrier(const XcdBarrier& b) {
    asm volatile("s_waitcnt vmcnt(0)" ::: "memory");
    __syncthreads();
    if (threadIdx.x == 0) {
        unsigned* bar = b.bar;
        __builtin_amdgcn_s_waitcnt(0);
        unsigned nloc = b.st[0], nx = b.st[1];
        if (nloc == 0u) { xcd_barrier_complete(bar, b.x, nloc, nx); b.st[0] = nloc; b.st[1] = nx; }
        const unsigned old = xb_add(&bar[XB_XSUB(b.x)], 1u);
        const unsigned gen = old / nloc;
        if (old + 1u == (gen + 1u) * nloc) {
            __builtin_amdgcn_fence(__ATOMIC_RELEASE, "agent");
            asm volatile("s_waitcnt vmcnt(0)" ::: "memory");
            const unsigned og = xb_add(&bar[XB_TOP], 1u);
            const unsigned tg = og / nx;
            if (og + 1u == (tg + 1u) * nx) xb_add(&bar[XB_TOPGEN], 1u);
            else XB_SPIN(xb_ld(&bar[XB_TOPGEN]) == tg, bar);
            __builtin_amdgcn_fence(__ATOMIC_ACQUIRE, "agent");
            xb_add(&bar[XB_XGEN(b.x)], 1u);
            asm volatile("s_waitcnt vmcnt(0)" ::: "memory");
        } else {
            XB_SPIN(xb_ld(&bar[XB_XGEN(b.x)]) == gen, bar);
            __builtin_amdgcn_fence(__ATOMIC_ACQUIRE, "agent");
            asm volatile("s_waitcnt vmcnt(0)" ::: "memory");
        }
    }
    __syncthreads();
}
struct Args { const void* in[40]; float* out; unsigned char* ws; int ph_lo, ph_hi; };
typedef const __attribute__((address_space(4))) Args* ArgsP;
__device__ __forceinline__ ArgsP fresh_args() { ArgsP p = (ArgsP)__builtin_amdgcn_kernarg_segment_ptr(); asm volatile("" : "+s"(p)); return p; }

struct Frame {
    LAS unsigned char* lds;
    int wave, G, gw, NGW;
    __device__ __forceinline__ int lane() const { unsigned z = 0u; asm volatile("" : "+v"(z)); return (int)__builtin_amdgcn_mbcnt_hi(~0u, __builtin_amdgcn_mbcnt_lo(~0u, z)); }
};

__device__ __forceinline__ Frame fresh(const Frame& F) { Frame R = F; asm volatile("" : "+s"(R.wave), "+s"(R.G), "+s"(R.gw), "+s"(R.NGW)); return R; }
#define LDS_WAIT() asm volatile("s_waitcnt lgkmcnt(0)" ::: "memory")

__device__ __forceinline__ void p0_mod_items(Frame& F, const float* c, const float* ada_w, const float* ada_b, float* mod) {
    LAS float* part = (LAS float*)F.lds;
    LAS float* cs = (LAS float*)(F.lds + 98304);
    int tid_ = F.wave * 64 + F.lane(); asm volatile("" : "+v"(tid_)); const int lane_ = tid_ & 63;
    if ((int)blockIdx.x >= 192) return;
    for (int i = tid_; i < 8192; i += NTHR) cs[i] = siluf(c[i]);
    __syncthreads();
    for (int it = blockIdx.x; it < 192; it += F.G) {
        const int l = it / 96, j0 = (it % 96) * 64;
        float acc[8];
#pragma unroll
        for (int b = 0; b < 8; ++b) acc[b] = 0.f;
        const float* w = ada_w + (size_t)l * 1024 * 6144 + j0 + lane_;
        const int k0 = F.wave * 128;
#pragma unroll 1
        for (int kb = 0; kb < 128; kb += 16) { float wv[16];
#pragma unroll
            for (int q = 0; q < 16; ++q) wv[q] = w[(size_t)(k0 + kb + q) * 6144];
#pragma unroll
            for (int q4 = 0; q4 < 4; ++q4)
#pragma unroll
                for (int b = 0; b < 8; ++b) { const pg8::f32x4 cv = *(const LAS pg8::f32x4*)(cs + b * 1024 + k0 + kb + 4 * q4);
                    acc[b] += (cv[0] * wv[4 * q4] + cv[1] * wv[4 * q4 + 1]) + (cv[2] * wv[4 * q4 + 2] + cv[3] * wv[4 * q4 + 3]); } }
#pragma unroll
        for (int b = 0; b < 8; ++b) part[(F.wave * 8 + b) * 64 + lane_] = acc[b];
        __syncthreads();
        { const int b = tid_ >> 6, col = tid_ & 63; float s = 0.f;
#pragma unroll
          for (int w8 = 0; w8 < 8; ++w8) s += part[(w8 * 8 + b) * 64 + col];
          mod[(size_t)(l * 8 + b) * 6144 + j0 + col] = s + ada_b[l * 6144 + j0 + col]; }
        __syncthreads();
    }
}
struct CvtDesc { const float* colp; size_t Ns; bf16_t* WT; int Kd, n0, k0; };
__device__ __forceinline__ void cvt_load(const CvtDesc& d, pg8::f32x4 (&v)[8], int lane) {
    const int kr = lane >> 3;
#pragma unroll
    for (int i = 0; i < 8; ++i) v[i] = d.colp ? *(const pg8::f32x4*)(d.colp + (size_t)(d.k0 + 8 * i + kr) * d.Ns) : (pg8::f32x4){0.f, 0.f, 0.f, 0.f};
}
__device__ __forceinline__ void cvt_store(const CvtDesc& d, const pg8::f32x4 (&v)[8], LAS float* scr, int lane) {
    const int q4 = 4 * (lane & 7), kr = lane >> 3;
#pragma unroll
    for (int i = 0; i < 8; ++i)
#pragma unroll
        for (int e = 0; e < 4; ++e) scr[(8 * i + kr) * 33 + q4 + e] = v[i][e];
    LDS_WAIT(); asm volatile("" ::: "memory");
    const int cidx = lane & 7;
#pragma unroll
    for (int j = 0; j < 4; ++j) { const int n = (lane >> 3) + 8 * j; const LAS float* s = scr + (8 * cidx) * 33 + n;
        pg8::u32x4 o; o.x = pk2(s[0 * 33], s[1 * 33]); o.y = pk2(s[2 * 33], s[3 * 33]); o.z = pk2(s[4 * 33], s[5 * 33]); o.w = pk2(s[6 * 33], s[7 * 33]);
        *(pg8::u32x4*)(d.WT + (size_t)(d.n0 + n) * d.Kd + d.k0 + 8 * cidx) = o; }
    LDS_WAIT(); asm volatile("" ::: "memory");
}
__device__ __forceinline__ int win_src_col(int v) { return v < 768 ? v : (v < 7168 ? v + 16 : (v < 7184 ? v - 6400 : -1)); }

__device__ __forceinline__ CvtDesc p0_desc(ArgsP a, int it, int n) {
    const float* w_in = (const float*)a->in[9]; const float* w_branch = (const float*)a->in[30]; const float* w_out = (const float*)a->in[31];
    const float* wg = (const float*)a->in[32]; const float* wu = (const float*)a->in[33]; const float* wd = (const float*)a->in[34];
    bf16_t* WIN = (bf16_t*)(a->ws + WS_WIN); bf16_t* WB = (bf16_t*)(a->ws + WS_WB); bf16_t* WO = (bf16_t*)(a->ws + WS_WO); bf16_t* WF1 = (bf16_t*)(a->ws + WS_WF1); bf16_t* WF2 = (bf16_t*)(a->ws + WS_WF2);
    bf16_t* LR = (bf16_t*)(a->ws + WS_LR);
    constexpr int I_IN = 2 * 232 * 16, I_B = 2 * 4 * 32 * 4, I_O = 2 * 32 * 16, I_F1 = 176 * 16, I_F2 = 32 * 44;
    int r = it;
    if (r < I_IN) { const int l = r / (232 * 16), q = r % (232 * 16), nb = q / 16, kb = q % 16; const int sc = win_src_col(nb * 32 + n);
        return CvtDesc{sc >= 0 ? w_in + (size_t)l * 1024 * NIN + sc : nullptr, (size_t)NIN, WIN + (size_t)l * PW * 1024, 1024, nb * 32, kb * 64}; } r -= I_IN;
    if (r < I_B) { const int lg = r / 128, q = r % 128, nb = q / 4, kb = q % 4;
        const int g = lg & 3, l = lg >> 2;
        return CvtDesc{w_branch + (size_t)lg * 256 * 1024 + nb * 32 + n - (size_t)g * 256 * 1024, 1024, WB + (size_t)l * 1024 * 1024, 1024, nb * 32, g * 256 + kb * 64}; } r -= I_B;
    if (r < I_O) { const int l = r / 512, q = r % 512, nb = q / 16, kb = q % 16;
        return CvtDesc{w_out + (size_t)l * 1024 * 1024 + nb * 32 + n, 1024, WO + (size_t)l * 1024 * 1024, 1024, nb * 32, kb * 64}; } r -= I_O;
    if (r < I_F1) { const int nb = r / 16, kb = r % 16; const int v = nb * 32 + n; const int up = (v >> 2) & 1, j = (v >> 3) * 4 + (v & 3);
        return CvtDesc{(up ? wu : wg) + j, (size_t)DFF, WF1, 1024, nb * 32, kb * 64}; } r -= I_F1;
    if (r < I_F2) { const int nb = r / 44, kb = r % 44;
        return CvtDesc{wd + nb * 32 + n, 1024, WF2, DFF, nb * 32, kb * 64}; } r -= I_F2;
    if (r < 16) { const int l = r >> 3, nb = r & 7; return CvtDesc{(const float*)a->in[21] + l * 64 * 256 + nb * 32 + n, 256, LR + l * 256 * 64, 64, nb * 32, 0}; } r -= 16;
    if (r < 16) { const int l = r >> 3, nb = r & 7; return CvtDesc{(const float*)a->in[23] + l * 64 * 256 + nb * 32 + n, 256, LR + 2 * 256 * 64 + l * 256 * 64, 64, nb * 32, 0}; } r -= 16;
    { const int l = r >> 4, nb = (r >> 1) & 7, kb = r & 1; return CvtDesc{(const float*)a->in[24] + l * 128 * 256 + nb * 32 + n, 256, LR + 4 * 256 * 64 + l * 256 * 128, 128, nb * 32, kb * 64}; }
}
__device__ __forceinline__ void p0_convert(Frame& F, ArgsP a) {
    LAS float* scr = (LAS float*)(F.lds + 16384 + F.wave * 8704);
    constexpr int NITEMS = 2 * 232 * 16 + 2 * 4 * 32 * 4 + 2 * 32 * 16 + 176 * 16 + 32 * 44 + 64;
    int lane_ = F.lane(); asm volatile("" : "+v"(lane_));
    const int n = 4 * (lane_ & 7);
    int it = F.gw; if (it >= NITEMS) return;
    CvtDesc cur = p0_desc(a, it, n); pg8::f32x4 v[8]; cvt_load(cur, v, lane_);
    for (;;) { const int nx = it + F.NGW; const bool more = nx < NITEMS;
        CvtDesc nd = cur; pg8::f32x4 w[8];
        if (more) { nd = p0_desc(a, nx, n); cvt_load(nd, w, lane_); }
        cvt_store(cur, v, scr, lane_);
        if (!more) break;
#pragma unroll
        for (int i = 0; i < 8; ++i) v[i] = w[i];
        cur = nd; it = nx; }
}

__device__ __forceinline__ void row_load(const float* p, pg8::f32x4 (&v)[4], int lane) {
#pragma unroll
    for (int j = 0; j < 4; ++j) v[j] = *(const pg8::f32x4*)(p + 4 * lane + 256 * j);
}
__device__ __forceinline__ float row_ss(const pg8::f32x4 (&v)[4]) {
    float s = 0.f;
#pragma unroll
    for (int j = 0; j < 4; ++j) s += (v[j][0] * v[j][0] + v[j][1] * v[j][1]) + (v[j][2] * v[j][2] + v[j][3] * v[j][3]);
    return wave_sum(s);
}
__device__ __forceinline__ void row_normmod(const pg8::f32x4 (&x)[4], const float* g, const float* mb, int sh_off, int sc_off, bf16_t* hrow, pg8::f32x4 (&hv)[4], int lane) {
    const float rstd = rsqrtf(row_ss(x) * (1.0f / D) + 1e-6f);
#pragma unroll
    for (int j = 0; j < 4; ++j) { const int d = 4 * lane + 256 * j;
        const pg8::f32x4 gg = *(const pg8::f32x4*)(g + d), sc = *(const pg8::f32x4*)(mb + sc_off + d), sh = *(const pg8::f32x4*)(mb + sh_off + d);
        hv[j] = x[j] * rstd * gg * (1.0f + sc) + sh;
        pg8::u32x2 w; w.x = pk2(hv[j][0], hv[j][1]); w.y = pk2(hv[j][2], hv[j][3]);
        *(pg8::u32x2*)(hrow + d) = w; }
}
template <int CTRL, int ROWMASK> __device__ __forceinline__ float dpp_mov_p(float old, float x) {
    return __builtin_bit_cast(float, __builtin_amdgcn_update_dpp(__builtin_bit_cast(int, old), __builtin_bit_cast(int, x), CTRL, ROWMASK, 0xF, false)); }
__device__ __forceinline__ float wave_sum63p(float x) {
    x += dpp_mov_p<0xB1, 0xF>(0.f, x); x += dpp_mov_p<0x4E, 0xF>(0.f, x); x += dpp_mov_p<0x141, 0xF>(0.f, x); x += dpp_mov_p<0x140, 0xF>(0.f, x);
    x += dpp_mov_p<0x142, 0xA>(0.f, x); x += dpp_mov_p<0x143, 0xC>(0.f, x); return x; }
__device__ __forceinline__ void stage_wz(const float* w_in_l, LAS float* wz, int tid) {
    for (int i = tid; i < 1024 * 4; i += NTHR) { const int d = i >> 2, q = i & 3; const pg8::f32x4 w = *(const pg8::f32x4*)(w_in_l + (size_t)d * NIN + 768 + 4 * q);
        wz[(4 * q) * 1024 + d] = w[0]; wz[(4 * q + 1) * 1024 + d] = w[1]; wz[(4 * q + 2) * 1024 + d] = w[2]; wz[(4 * q + 3) * 1024 + d] = w[3]; }
    __syncthreads();
}
__device__ __forceinline__ void row_gz(const pg8::f32x4 (&hv)[4], const LAS float* wz, bf16_t* gzrow, int lane) {
    float mine = 0.f;
#pragma unroll
    for (int o = 0; o < 16; ++o) { float acc = 0.f;
#pragma unroll
        for (int j = 0; j < 4; ++j) { const pg8::f32x4 w = *(const LAS pg8::f32x4*)(wz + o * 1024 + 4 * lane + 256 * j); acc += (hv[j][0] * w[0] + hv[j][1] * w[1]) + (hv[j][2] * w[2] + hv[j][3] * w[3]); }
        const float s = __builtin_bit_cast(float, __builtin_amdgcn_readlane(__builtin_bit_cast(int, wave_sum63p(acc)), 63)); if (lane == o) mine = s; }
    if (lane < 16) gzrow[lane] = (bf16_t)f2bf(mine);
}
__device__ __forceinline__ void ph_h0(Frame& F, ArgsP a) {
    const float* x = (const float*)a->in[0]; const float* g = (const float*)a->in[5]; const float* mod = (const float*)(a->ws + WS_MOD); bf16_t* H = (bf16_t*)(a->ws + WS_HB);
    bf16_t* GZ = (bf16_t*)(a->ws + WS_GZ); LAS float* wz = (LAS float*)F.lds;
    int lane0 = F.lane(); asm volatile("" : "+v"(lane0));
    stage_wz((const float*)a->in[9], wz, F.wave * 64 + lane0);
    int row = F.gw; if (row >= M) return;
    pg8::f32x4 xn[4]; row_load(x + (size_t)row * D, xn, lane0);
    for (;;) { int lane = lane0; asm volatile("" : "+v"(lane)); pg8::f32x4 xv[4], hv[4];
#pragma unroll
        for (int j = 0; j < 4; ++j) xv[j] = xn[j];
        const int nrow = row + F.NGW; if (nrow < M) row_load(x + (size_t)nrow * D, xn, lane);
        row_normmod(xv, g, mod + (size_t)(row / T) * 6144, 0, 1024, H + (size_t)row * D, hv, lane);
        row_gz(hv, wz, GZ + (size_t)row * 16, lane);
        if (nrow >= M) break; row = nrow; }
}
__device__ __forceinline__ void moe_slot_load(const bf16_t* eout, const bf16_t* part, const pg8::MoeSplit sp, int g, int lane, pg8::u32x2 (&e)[4]) {
    const int tau = g >> 8;
    if (sp.s > 1 && tau >= sp.tau0) {
        const bf16_t* p = part + ((size_t)(tau - sp.tau0) * 256 + (g & 255)) * D + 4 * lane; const size_t ps = (size_t)sp.nrt * 256 * D;
        float ac[16];
#pragma unroll
        for (int i = 0; i < 16; ++i) ac[i] = 0.f;
        if (sp.s == 7) { pg8::u32x2 w[7][4];
#pragma unroll
            for (int k = 0; k < 7; ++k)
#pragma unroll
                for (int j = 0; j < 4; ++j) w[k][j] = *(const pg8::u32x2*)(p + k * ps + 256 * j);
#pragma unroll
            for (int k = 0; k < 7; ++k)
#pragma unroll
                for (int j = 0; j < 4; ++j) { ac[4 * j] += __builtin_bit_cast(float, w[k][j].x << 16); ac[4 * j + 1] += __builtin_bit_cast(float, w[k][j].x & 0xffff0000u); ac[4 * j + 2] += __builtin_bit_cast(float, w[k][j].y << 16); ac[4 * j + 3] += __builtin_bit_cast(float, w[k][j].y & 0xffff0000u); }
        } else {
#pragma unroll 1
            for (int k = 0; k < sp.s; ++k)
#pragma unroll
                for (int j = 0; j < 4; ++j) { const pg8::u32x2 w = *(const pg8::u32x2*)(p + k * ps + 256 * j);
                    ac[4 * j] += __builtin_bit_cast(float, w.x << 16); ac[4 * j + 1] += __builtin_bit_cast(float, w.x & 0xffff0000u); ac[4 * j + 2] += __builtin_bit_cast(float, w.y << 16); ac[4 * j + 3] += __builtin_bit_cast(float, w.y & 0xffff0000u); }
        }
#pragma unroll
        for (int j = 0; j < 4; ++j) { e[j].x = pk2(ac[4 * j], ac[4 * j + 1]); e[j].y = pk2(ac[4 * j + 2], ac[4 * j + 3]); }
    } else {
#pragma unroll
        for (int j = 0; j < 4; ++j) e[j] = *(const pg8::u32x2*)(eout + (size_t)g * D + 4 * lane + 256 * j);
    }
}
__device__ __forceinline__ void row_y_load(const bf16_t* y, const bf16_t* eout, const int* toks, int row, int lane, pg8::f32x4 (&yv)[4], pg8::u32x2 (&e1)[4], pg8::u32x2 (&e2)[4], const bf16_t* part, const pg8::MoeSplit sp) {
    if (eout) {
        const int g1 = toks[row * 2], g2 = toks[row * 2 + 1];
        moe_slot_load(eout, part, sp, g1, lane, e1); moe_slot_load(eout, part, sp, g2, lane, e2);
    } else {
#pragma unroll
        for (int j = 0; j < 4; ++j) e1[j] = *(const pg8::u32x2*)(y + (size_t)row * D + 4 * lane + 256 * j); }
}
__device__ __forceinline__ void ph_row(Frame& F, ArgsP a, const float* xold, const bf16_t* y, const float* gpost, const float* modl, int gt_off,
                                       const float* gpre, const float* modn, int sh_off, int sc_off, bf16_t* hdst, bool route, const bf16_t* eout = nullptr, const float* w_in_next = nullptr) {
    float* out = a->out;
    bf16_t* GZ = (bf16_t*)(a->ws + WS_GZ); LAS float* wz = (LAS float*)F.lds;
    if (w_in_next) { int t_ = F.wave * 64 + F.lane(); stage_wz(w_in_next, wz, t_); }
    const float* rw = (const float*)a->in[35]; const float* rb = (const float*)a->in[36];
    const unsigned* cnt = (const unsigned*)(a->ws + WS_CTL) + CW_CNT;
    int* bcnt = (int*)(a->ws + WS_ROUTE + RT_BCNT); int* toke = (int*)(a->ws + WS_ROUTE + RT_TOKE); int* toks = (int*)(a->ws + WS_ROUTE + RT_TOKS); float* tokp = (float*)(a->ws + WS_ROUTE + RT_TOKP);
    LAS int* ENTE = (LAS int*)(F.lds + 65536); LAS float* ENTP = (LAS float*)(F.lds + 65536 + 2048); LAS float* RWL = (LAS float*)(F.lds + 69632);
    if (route) { int t_ = F.wave * 64 + F.lane(); asm volatile("" : "+v"(t_));
#pragma unroll
        for (int i = 0; i < 2; ++i) { const int d = t_ + i * NTHR; const pg8::f32x4 w0 = *(const pg8::f32x4*)(rw + d * 8), w1 = *(const pg8::f32x4*)(rw + d * 8 + 4);
            LAS float* dp = RWL + (((d >> 8) * 4 + (d & 3)) * 64 + ((d & 255) >> 2)) * 8; *(LAS pg8::f32x4*)dp = w0; *(LAS pg8::f32x4*)(dp + 4) = w1; }
        __syncthreads(); }
    int row = F.gw;
    if (row < M) {
    int lane0 = F.lane(); asm volatile("" : "+v"(lane0));
    pg8::f32x4 yn[4], xn[4]; pg8::u32x2 e1n[4], e2n[4];
    pg8::MoeSplit sp{0, 0, 1}; if (eout) sp = pg8::moe_split(cnt, F.G); const bf16_t* part = (const bf16_t*)(a->ws + WS_WM1);
    row_y_load(y, eout, toks, row, lane0, yn, e1n, e2n, part, sp); row_load(xold + (size_t)row * D, xn, lane0);
    for (int kit = 0;; ++kit) {
        int lane = lane0; asm volatile("" : "+v"(lane));
        const int b = row / T; pg8::f32x4 yv[4], xv[4], hv[4];
        if (eout) { const float p1 = tokp[row * 2], p2 = tokp[row * 2 + 1];
#pragma unroll
            for (int j = 0; j < 4; ++j) { const pg8::u32x2 a1 = e1n[j], a2 = e2n[j];
                yv[j][0] = p1 * __builtin_bit_cast(float, a1.x << 16) + p2 * __builtin_bit_cast(float, a2.x << 16); yv[j][1] = p1 * __builtin_bit_cast(float, a1.x & 0xffff0000u) + p2 * __builtin_bit_cast(float, a2.x & 0xffff0000u);
                yv[j][2] = p1 * __builtin_bit_cast(float, a1.y << 16) + p2 * __builtin_bit_cast(float, a2.y << 16); yv[j][3] = p1 * __builtin_bit_cast(float, a1.y & 0xffff0000u) + p2 * __builtin_bit_cast(float, a2.y & 0xffff0000u); }
        } else {
#pragma unroll
            for (int j = 0; j < 4; ++j) { const pg8::u32x2 a1 = e1n[j]; yv[j][0] = __builtin_bit_cast(float, a1.x << 16); yv[j][1] = __builtin_bit_cast(float, a1.x & 0xffff0000u); yv[j][2] = __builtin_bit_cast(float, a1.y << 16); yv[j][3] = __builtin_bit_cast(float, a1.y & 0xffff0000u); } }
#pragma unroll
        for (int j = 0; j < 4; ++j) xv[j] = xn[j];
        const int nrow = row + F.NGW;
        if (nrow < M) { row_y_load(y, eout, toks, nrow, lane, yn, e1n, e2n, part, sp); row_load(xold + (size_t)nrow * D, xn, lane); }
        const float rstd = rsqrtf(row_ss(yv) * (1.0f / D) + 1e-6f);
        const float* mb = modl + (size_t)b * 6144;
#pragma unroll
        for (int j = 0; j < 4; ++j) { const int d = 4 * lane + 256 * j;
            const pg8::f32x4 gp = *(const pg8::f32x4*)(gpost + d), gt = *(const pg8::f32x4*)(mb + gt_off + d);
            xv[j] = xv[j] + gt * (yv[j] * rstd * gp);
            *(pg8::f32x4*)(out + (size_t)row * D + d) = xv[j]; }
        if (hdst) {
            row_normmod(xv, gpre, modn + (size_t)b * 6144, sh_off, sc_off, hdst + (size_t)row * D, hv, lane);
            if (w_in_next) row_gz(hv, wz, GZ + (size_t)row * 16, lane);
            if (route) {
                float lg[8];
#pragma unroll
                for (int e = 0; e < 8; ++e) lg[e] = 0.f;
#pragma unroll
                for (int j = 0; j < 4; ++j)
#pragma unroll
                    for (int q = 0; q < 4; ++q) { const LAS float* wp = RWL + ((j * 4 + q) * 64 + lane) * 8; const pg8::f32x4 w0 = *(const LAS pg8::f32x4*)wp, w1 = *(const LAS pg8::f32x4*)(wp + 4); const float hq = hv[j][q];
                        lg[0] += hq * w0[0]; lg[1] += hq * w0[1]; lg[2] += hq * w0[2]; lg[3] += hq * w0[3]; lg[4] += hq * w1[0]; lg[5] += hq * w1[1]; lg[6] += hq * w1[2]; lg[7] += hq * w1[3]; }
#pragma unroll
                for (int e = 0; e < 8; ++e) lg[e] = wave_sum(lg[e]) + rb[e];
                if (lane == 0) {
                    int e1 = 0; float v1 = lg[0];
#pragma unroll
                    for (int e = 1; e < 8; ++e) if (lg[e] > v1) { v1 = lg[e]; e1 = e; }
                    int e2 = -1; float v2 = -3.0e38f;
#pragma unroll
                    for (int e = 0; e < 8; ++e) if (e != e1 && lg[e] > v2) { v2 = lg[e]; e2 = e; }
                    const float p1 = 1.0f / (1.0f + __expf(v2 - v1));
                    ENTE[kit * 8 + F.wave] = e1 | (e2 << 8); ENTP[kit * 8 + F.wave] = p1;
                }
            }
        }
        if (nrow >= M) break; row = nrow;
    }
    }
    if (route) {
        __syncthreads();
        if (F.wave == 0) {
            int lane = F.lane(); asm volatile("" : "+v"(lane));
            const unsigned long long ltm = (1ull << lane) - 1ull;
            const int r0 = (int)blockIdx.x * NWAVES; const int nent = (r0 < M) ? ((M - 1 - r0) / F.NGW + 1) * NWAVES : 0;
            int run[8];
#pragma unroll
            for (int e = 0; e < 8; ++e) run[e] = 0;
            for (int g0 = 0; g0 < nent; g0 += 64) { const int idx = g0 + lane; const int rr = r0 + (idx & 7) + (idx >> 3) * F.NGW; const bool valid = idx < nent && rr < M;
                const int ee = valid ? ENTE[idx] : 0xffff; const float p1 = valid ? ENTP[idx] : 0.f; const int x1 = ee & 255, x2 = ee >> 8; int l1 = 0, l2 = 0;
#pragma unroll
                for (int e = 0; e < 8; ++e) { const unsigned long long m1 = __ballot(x1 == e), m2 = __ballot(x2 == e); const int c1 = __popcll(m1);
                    if (x1 == e) l1 = run[e] + __popcll(m1 & ltm); if (x2 == e) l2 = run[e] + c1 + __popcll(m2 & ltm); run[e] += c1 + __popcll(m2); }
                if (valid) { *(pg8::u32x2*)(toke + rr * 2) = (pg8::u32x2){(unsigned)x1, (unsigned)x2}; *(pg8::u32x2*)(toks + rr * 2) = (pg8::u32x2){(unsigned)l1, (unsigned)l2}; *(pg8::f32x2*)(tokp + rr * 2) = (pg8::f32x2){p1, 1.0f - p1}; } }
            int mine = 0;
#pragma unroll
            for (int e = 0; e < 8; ++e) if (lane == e) mine = run[e];
            if (lane < 8) bcnt[(int)blockIdx.x * 8 + lane] = mine;
        }
    }
}

__device__ __forceinline__ void ph_moe_prep(Frame& F, ArgsP a) {
    LAS float* scr = (LAS float*)(F.lds + F.wave * 8704);
    const float* mg = (const float*)a->in[37]; const float* mu = (const float*)a->in[38]; const float* md = (const float*)a->in[39];
    bf16_t* WM1 = (bf16_t*)(a->ws + WS_WM1); bf16_t* WM2 = (bf16_t*)(a->ws + WS_WM2);
    constexpr int I_1 = 8 * 224 * 16, I_2 = 8 * 32 * 56;
    int lane_ = F.lane(); asm volatile("" : "+v"(lane_));
    const int n = 4 * (lane_ & 7);
    auto desc = [&](int r) -> CvtDesc {
        if (r < I_1) { const int e = r / 3584, q = r % 3584, nb = q / 16, kb = q % 16; const int v = nb * 32 + n; const int up = (v >> 2) & 1, j = (v >> 3) * 4 + (v & 3);
            return CvtDesc{(up ? mu : mg) + (size_t)e * 1024 * DEX + j, (size_t)DEX, WM1 + (size_t)e * 7168 * 1024, 1024, nb * 32, kb * 64}; }
        r -= I_1; const int e = r / 1792, q = r % 1792, nb = q / 56, kb = q % 56;
        return CvtDesc{md + (size_t)e * DEX * 1024 + nb * 32 + n, 1024, WM2 + (size_t)e * 1024 * DEXP, DEXP, nb * 32, kb * 64}; };
    { int it = F.gw;
      if (it < I_1 + I_2) { CvtDesc cur = desc(it); pg8::f32x4 v[8]; cvt_load(cur, v, lane_);
        for (;;) { const int nx = it + F.NGW; const bool more = nx < I_1 + I_2; CvtDesc nd = cur; pg8::f32x4 w[8];
            if (more) { nd = desc(nx); cvt_load(nd, w, lane_); }
            cvt_store(cur, v, scr, lane_);
            if (!more) break;
#pragma unroll
            for (int i = 0; i < 8; ++i) v[i] = w[i];
            cur = nd; it = nx; } } }
    unsigned* cnt = (unsigned*)(a->ws + WS_CTL) + CW_CNT; const int* bcnt = (const int*)(a->ws + WS_ROUTE + RT_BCNT);
    const int* toke = (const int*)(a->ws + WS_ROUTE + RT_TOKE); int* toks = (int*)(a->ws + WS_ROUTE + RT_TOKS);
    const bf16_t* h2 = (const bf16_t*)(a->ws + WS_H2L1); bf16_t* hg = (bf16_t*)(a->ws + WS_HG);
    LAS int* SB = (LAS int*)(F.lds + 8 * 8704);
    if (F.wave == 0) { float tot[8], pre[8];
#pragma unroll
        for (int e = 0; e < 8; ++e) { tot[e] = 0.f; pre[e] = 0.f; }
        for (int b = lane_; b < F.G; b += 64) { const pg8::u32x4 c0 = *(const pg8::u32x4*)(bcnt + b * 8), c1 = *(const pg8::u32x4*)(bcnt + b * 8 + 4); const float m = (b < (int)blockIdx.x) ? 1.f : 0.f;
#pragma unroll
            for (int e = 0; e < 4; ++e) { tot[e] += (float)c0[e]; pre[e] += m * (float)c0[e]; tot[4 + e] += (float)c1[e]; pre[4 + e] += m * (float)c1[e]; } }
#pragma unroll
        for (int e = 0; e < 8; ++e) { tot[e] = wave_sum(tot[e]); pre[e] = wave_sum(pre[e]); }
        if (lane_ == 0) { int o = 0;
#pragma unroll
            for (int e = 0; e < 8; ++e) { const int te = (int)tot[e]; SB[e] = o + (int)pre[e]; SB[8 + e] = te; SB[16 + e] = o; o += ((te + 255) >> 8) << 8; if (blockIdx.x == 0) cnt[e] = (unsigned)te; }
            SB[24] = o; } }
    __syncthreads();
    for (int r0 = F.gw; r0 < M; r0 += 4 * F.NGW) {
        int d1[4], d2[4]; pg8::u32x4 v0[4], v1[4];
#pragma unroll
        for (int u = 0; u < 4; ++u) { const int rr = r0 + u * F.NGW; d1[u] = -1; d2[u] = -1;
            if (rr < M) { const pg8::u32x2 ee = *(const pg8::u32x2*)(toke + rr * 2), ll = *(const pg8::u32x2*)(toks + rr * 2); d1[u] = SB[ee.x] + (int)ll.x; d2[u] = SB[ee.y] + (int)ll.y;
                const pg8::u32x4* sp = (const pg8::u32x4*)(h2 + (size_t)rr * D) + 2 * lane_; v0[u] = sp[0]; v1[u] = sp[1]; } }
#pragma unroll
        for (int u = 0; u < 4; ++u) { const int rr = r0 + u * F.NGW;
            if (rr < M) { pg8::u32x4* q1 = (pg8::u32x4*)(hg + (size_t)d1[u] * D) + 2 * lane_; pg8::u32x4* q2 = (pg8::u32x4*)(hg + (size_t)d2[u] * D) + 2 * lane_; q1[0] = v0[u]; q1[1] = v1[u]; q2[0] = v0[u]; q2[1] = v1[u];
                if (lane_ == 0) *(pg8::u32x2*)(toks + rr * 2) = (pg8::u32x2){(unsigned)d1[u], (unsigned)d2[u]}; } }
    }
    { int npad[8], ptot = 0;
#pragma unroll
      for (int e = 0; e < 8; ++e) { npad[e] = (256 - (SB[8 + e] & 255)) & 255; ptot += npad[e]; }
      for (int pi = F.gw; pi < ptot; pi += F.NGW) { int rem = pi, dst = 0; bool found = false;
#pragma unroll
          for (int e = 0; e < 8; ++e) { if (!found && rem < npad[e]) { dst = SB[16 + e] + SB[8 + e] + rem; found = true; } if (!found) rem -= npad[e]; }
          pg8::u32x4* q = (pg8::u32x4*)(hg + (size_t)dst * D) + 2 * lane_; q[0] = (pg8::u32x4){0u, 0u, 0u, 0u}; q[1] = (pg8::u32x4){0u, 0u, 0u, 0u}; } }
}
typedef float f32x16 __attribute__((ext_vector_type(16)));
template <int CTRL, int ROWMASK> __device__ __forceinline__ float dpp_mov(float old, float x) {
    return __builtin_bit_cast(float, __builtin_amdgcn_update_dpp(__builtin_bit_cast(int, old), __builtin_bit_cast(int, x), CTRL, ROWMASK, 0xF, false));
}
__device__ __forceinline__ float rdlane(float x, int l) { return __builtin_bit_cast(float, __builtin_amdgcn_readlane(__builtin_bit_cast(int, x), l)); }
__device__ __forceinline__ float wave_sum63(float x) {
    x += dpp_mov<0xB1, 0xF>(0.f, x);
    x += dpp_mov<0x4E, 0xF>(0.f, x);
    x += dpp_mov<0x141, 0xF>(0.f, x);
    x += dpp_mov<0x140, 0xF>(0.f, x);
    x += dpp_mov<0x142, 0xA>(0.f, x);
    x += dpp_mov<0x143, 0xC>(0.f, x);
    return x;
}
__device__ __forceinline__ float row16_sum(float x) {
    x += dpp_mov<0xB1, 0xF>(0.f, x); x += dpp_mov<0x4E, 0xF>(0.f, x); x += dpp_mov<0x141, 0xF>(0.f, x); x += dpp_mov<0x140, 0xF>(0.f, x);
    return x;
}
__device__ __forceinline__ pg8::f32x4 ld_bf16x4(const bf16_t* p) { const pg8::u32x2 w = *(const pg8::u32x2*)p;
    return (pg8::f32x4){__builtin_bit_cast(float, w.x << 16), __builtin_bit_cast(float, w.x & 0xffff0000u), __builtin_bit_cast(float, w.y << 16), __builtin_bit_cast(float, w.y & 0xffff0000u)}; }
__device__ __forceinline__ void st_bf16x4(bf16_t* p, pg8::f32x4 v) { pg8::u32x2 w; w.x = pk2(v[0], v[1]); w.y = pk2(v[2], v[3]); *(pg8::u32x2*)p = w; }

__device__ __forceinline__ void ph_conv(Frame& F, ArgsP a, int l) {
    const bf16_t* proj = (const bf16_t*)(a->ws + WS_PROJ); bf16_t* br = (bf16_t*)(a->ws + WS_HB);
    const float* cw = (const float*)a->in[15] + l * 31 * 256; const float* cb = (const float*)a->in[16] + l * 256; const float* lg = (const float*)a->in[17] + l * 256; const float* lb = (const float*)a->in[18] + l * 256;
    LAS float* u = (LAS float*)F.lds;
    int tid = F.wave * 64 + F.lane(); asm volatile("" : "+v"(tid)); const int lane = tid & 63;
    for (int it = blockIdx.x; it < M / 64; it += F.G) {
        const int row0 = it * 64, t0 = row0 % T;
#pragma unroll
        for (int i_ = 0; i_ < 6; ++i_) { const int idx = tid + i_ * NTHR; if (idx >= 94 * 32) break; const int r = idx >> 5, c8 = (idx & 31) * 8; float uv[8];
#pragma unroll
            for (int e = 0; e < 8; ++e) uv[e] = 0.f;
            if (t0 - 30 + r >= 0) { const bf16_t* pr = proj + (size_t)(row0 - 30 + r) * PW;
                const pg8::f32x4 a0 = ld_bf16x4(pr + P_CA + c8), a1 = ld_bf16x4(pr + P_CA + c8 + 4), b0 = ld_bf16x4(pr + P_CB + c8), b1 = ld_bf16x4(pr + P_CB + c8 + 4);
#pragma unroll
                for (int e = 0; e < 4; ++e) { uv[e] = a0[e] * sigm(b0[e]); uv[4 + e] = a1[e] * sigm(b1[e]); } }
            *(LAS pg8::f32x4*)(u + r * 256 + c8) = (pg8::f32x4){uv[0], uv[1], uv[2], uv[3]}; *(LAS pg8::f32x4*)(u + r * 256 + c8 + 4) = (pg8::f32x4){uv[4], uv[5], uv[6], uv[7]}; }
        __syncthreads();
        const int c = tid & 255, half = tid >> 8;
        float acc[32];
        { float w[31], ur[62];
#pragma unroll
          for (int j = 0; j < 31; ++j) w[j] = cw[j * 256 + c];
#pragma unroll
          for (int q = 0; q < 62; ++q) ur[q] = u[(half * 32 + q) * 256 + c];
          const float bias = cb[c];
#pragma unroll
          for (int i = 0; i < 32; ++i) { float s = bias;
#pragma unroll
              for (int j = 0; j < 31; ++j) s += w[j] * ur[i + j];
              acc[i] = s; } }
        __syncthreads();
#pragma unroll
        for (int i = 0; i < 32; ++i) u[(half * 32 + i) * 256 + c] = acc[i];
        __syncthreads();
        const pg8::f32x4 g4 = *(const pg8::f32x4*)(lg + 4 * lane), b4 = *(const pg8::f32x4*)(lb + 4 * lane);
#pragma unroll 2
        for (int q = 0; q < 8; ++q) { const int t = F.wave * 8 + q; const pg8::f32x4 yv = *(const LAS pg8::f32x4*)(u + t * 256 + 4 * lane);
            const float mu = wave_sum((yv[0] + yv[1]) + (yv[2] + yv[3])) * (1.0f / 256.0f); const pg8::f32x4 d = yv - mu;
            const float var = wave_sum((d[0] * d[0] + d[1] * d[1]) + (d[2] * d[2] + d[3] * d[3])) * (1.0f / 256.0f);
            pg8::f32x4 o = d * rsqrtf(var + 1e-5f) * g4 + b4;
#pragma unroll
            for (int e = 0; e < 4; ++e) o[e] = siluf(o[e]);
            st_bf16x4(br + (size_t)(row0 + t) * D + 512 + 4 * lane, o); }
        __syncthreads();
    }
}

__device__ __forceinline__ void ph_rwkv_prep(Frame& F, ArgsP a, int l) {
        const bf16_t* proj = (const bf16_t*)(a->ws + WS_PROJ);
    const float* mu = (const float*)a->in[19] + l * 1024; const float* w0 = (const float*)a->in[20] + l * 256; const float* a0 = (const float*)a->in[22] + l * 256;
    const float* kkw = (const float*)a->in[25] + l * 256; const float* kaw = (const float*)a->in[26] + l * 256; const float* rkw = (const float*)a->in[27] + l * 256;
    const bf16_t* W2T = (const bf16_t*)(a->ws + WS_LR) + l * 256 * 64; const bf16_t* A2T = (const bf16_t*)(a->ws + WS_LR) + 2 * 256 * 64 + l * 256 * 64; const bf16_t* G2T = (const bf16_t*)(a->ws + WS_LR) + 4 * 256 * 64 + l * 256 * 128;
    unsigned char* VEC = a->ws + SCR_VEC6; float* SC = (float*)(a->ws + SCR_SC); bf16_t* GR = (bf16_t*)(a->ws + SCR_GR);
    constexpr int RS = 72, RG = 136;
    LAS bf16_t* TZh = (LAS bf16_t*)F.lds; LAS bf16_t* TZl = TZh + 64 * RS; LAS bf16_t* ZA = TZl + 64 * RS; LAS bf16_t* SG = ZA + 64 * RS;
    int tid = F.wave * 64 + F.lane(); asm volatile("" : "+v"(tid));
    for (int it = blockIdx.x; it < M / 64; it += F.G) {
        const int row0 = it * 64, b = row0 / T, t0 = row0 % T;
#pragma unroll 4
        for (int i_ = 0; i_ < 32; ++i_) { const int idx = tid + i_ * NTHR; const int cc = idx & 255, tok = idx >> 8; const int col = 768 + cc;
            const bf16_t* pc = proj + (size_t)(row0 + tok) * PW + P_R + col; const float xc = bf2f(pc[0]); const float xp = (t0 + tok > 0) ? bf2f(pc[-PW]) : 0.f;
            const float xm = xc + (xp - xc) * mu[col];
            if (cc < 64) { const float tv = tanh_fast(xm); const unsigned hi = f2bf(tv); TZh[tok * RS + cc] = (bf16_t)hi; TZl[tok * RS + cc] = (bf16_t)f2bf(tv - __builtin_bit_cast(float, hi << 16)); }
            else if (cc < 128) ZA[tok * RS + cc - 64] = (bf16_t)f2bf(xm);
            else SG[tok * RG + cc - 128] = (bf16_t)f2bf(sigm(xm)); }
        __syncthreads();
        int tid2 = tid; asm volatile("" : "+v"(tid2));
        const int lane = tid2 & 63, r = lane & 31, hg = lane >> 5, h = (tid2 >> 6) & 3, th = tid2 >> 8;
        f32x16 accw[2], acca[2], accg[2];
#pragma unroll
        for (int nb = 0; nb < 2; ++nb)
#pragma unroll
            for (int e = 0; e < 16; ++e) { accw[nb][e] = 0.f; acca[nb][e] = 0.f; accg[nb][e] = 0.f; }
        const int arow = (th * 32 + r);
#pragma unroll
        for (int s = 0; s < 4; ++s) { const pg8::bf16x8 ah = *(const LAS pg8::bf16x8*)(TZh + arow * RS + 16 * s + 8 * hg), al = *(const LAS pg8::bf16x8*)(TZl + arow * RS + 16 * s + 8 * hg), az = *(const LAS pg8::bf16x8*)(ZA + arow * RS + 16 * s + 8 * hg);
#pragma unroll
            for (int nb = 0; nb < 2; ++nb) { const int n = h * 64 + nb * 32 + r;
                const pg8::bf16x8 bw = *(const pg8::bf16x8*)(W2T + n * 64 + 16 * s + 8 * hg), ba = *(const pg8::bf16x8*)(A2T + n * 64 + 16 * s + 8 * hg);
                accw[nb] = __builtin_amdgcn_mfma_f32_32x32x16_bf16(ah, bw, accw[nb], 0, 0, 0); accw[nb] = __builtin_amdgcn_mfma_f32_32x32x16_bf16(al, bw, accw[nb], 0, 0, 0);
                acca[nb] = __builtin_amdgcn_mfma_f32_32x32x16_bf16(az, ba, acca[nb], 0, 0, 0); } }
#pragma unroll
        for (int s = 0; s < 8; ++s) { const pg8::bf16x8 ag = *(const LAS pg8::bf16x8*)(SG + arow * RG + 16 * s + 8 * hg);
#pragma unroll
            for (int nb = 0; nb < 2; ++nb) { const int n = h * 64 + nb * 32 + r; const pg8::bf16x8 bg = *(const pg8::bf16x8*)(G2T + n * 128 + 16 * s + 8 * hg);
                accg[nb] = __builtin_amdgcn_mfma_f32_32x32x16_bf16(ag, bg, accg[nb], 0, 0, 0); } }
        int tid3 = tid; asm volatile("" : "+v"(tid3)); const int r3 = tid3 & 31, hg3 = (tid3 >> 5) & 1, h3 = (tid3 >> 6) & 3, th3 = tid3 >> 8;
        float pw0[2], pa0[2], pmr[2], pmk[2], pmv[2], pkk[2], pka[2], prk[2];
#pragma unroll
        for (int nb = 0; nb < 2; ++nb) { const int c = h3 * 64 + nb * 32 + r3; pw0[nb] = w0[c]; pa0[nb] = a0[c]; pmr[nb] = mu[c]; pmk[nb] = mu[256 + c]; pmv[nb] = mu[512 + c]; pkk[nb] = kkw[c]; pka[nb] = kaw[c]; prk[nb] = rkw[c]; }
#pragma unroll
        for (int e = 0; e < 16; ++e) { const int tok = th3 * 32 + (e & 3) + 8 * (e >> 2) + 4 * hg3, t = t0 + tok; const size_t row = (size_t)row0 + tok; const bool hp = t > 0;
            float dec[2], kkv[2], kka[2], k2[2], rv[2], vv[2], s_kk = 0.f, s_c1 = 0.f, s_c2 = 0.f, s_bn = 0.f;
#pragma unroll
            for (int nb = 0; nb < 2; ++nb) { const int c = h3 * 64 + nb * 32 + r3; const bf16_t* pc = proj + row * PW + P_R + c;
                const float rc = bf2f(pc[0]), kc = bf2f(pc[256]), vc = bf2f(pc[512]);
                const float rp = hp ? bf2f(pc[-PW]) : 0.f, kp = hp ? bf2f(pc[256 - PW]) : 0.f, vp = hp ? bf2f(pc[512 - PW]) : 0.f;
                const float rr = rc + (rp - rc) * pmr[nb], k = kc + (kp - kc) * pmk[nb]; vv[nb] = vc + (vp - vc) * pmv[nb]; rv[nb] = rr;
                const float wl = -softplusf(-(accw[nb][e] + pw0[nb])) - 0.5f; dec[nb] = -__expf(wl); const float av        = sigm(acca[nb][e] + pa0[nb]);
                kkv[nb] = k * pkk[nb]; k2[nb] = k * (1.0f + (av - 1.0f) * pka[nb]); kka[nb] = av;
                s_kk += kkv[nb] * kkv[nb]; s_c2 += k2[nb] * rr; s_bn += rr * k2[nb] * prk[nb];
                GR[row * 256 + c] = (bf16_t)f2bf(accg[nb][e]); }
            s_kk = row16_sum(s_kk); s_kk += __shfl_xor(s_kk, 16);
            const float inv = 1.0f / fmaxf(sqrtf(s_kk), 1e-12f);
#pragma unroll
            for (int nb = 0; nb < 2; ++nb) { kkv[nb] *= inv; kka[nb] *= kkv[nb]; s_c1 += kka[nb] * rv[nb]; }
            s_c1 = row16_sum(s_c1); s_c1 += __shfl_xor(s_c1, 16); s_c2 = row16_sum(s_c2); s_c2 += __shfl_xor(s_c2, 16); s_bn = row16_sum(s_bn); s_bn += __shfl_xor(s_bn, 16);
            const size_t st = ((size_t)(b * 4 + h3) * T + t);
#pragma unroll
            for (int nb = 0; nb < 2; ++nb) { unsigned char* rb = VEC + st * RECB; const int kx = nb * 32 + r3;
                *(float*)(rb + kx * 4) = dec[nb]; *(bf16_t*)(rb + 256 + kx * 2) = (bf16_t)f2bf(-kkv[nb]); *(bf16_t*)(rb + 384 + kx * 2) = (bf16_t)f2bf(kka[nb]);
                *(bf16_t*)(rb + 512 + kx * 2) = (bf16_t)f2bf(k2[nb]); *(bf16_t*)(rb + 640 + kx * 2) = (bf16_t)f2bf(rv[nb]); *(bf16_t*)(rb + 768 + kx * 2) = (bf16_t)f2bf(vv[nb]); }
            if (r3 == 0) *(pg8::f32x4*)(SC + st * 4) = (pg8::f32x4){s_c1, s_c2, s_bn, 0.f};
            asm volatile("" ::: "memory"); }
        __syncthreads();
    }
}

__device__ __forceinline__ void ph_rwkv_scan(Frame& F, ArgsP a) {
    const unsigned char* VEC = a->ws + SCR_VEC6; float* YR = (float*)(a->ws + SCR_YR); const float* SC = (const float*)(a->ws + SCR_SC); bf16_t* STM = (bf16_t*)(a->ws + SCR_STM);
    int lane = F.lane(); asm volatile("" : "+v"(lane));
    constexpr int CH = 32, CHB = CH * RECB, NP = CHB / 1024 / 4;
    const bool stager = F.wave >= 4;
    const int vcu = (F.G % 8 == 0) ? ((int)blockIdx.x % 8) * (F.G / 8) + (int)blockIdx.x / 8 : (int)blockIdx.x;
    for (int it = vcu; it < 256; it += F.G) {
        const int bh = it >> 3, rg = it & 7, b = bh >> 2, h = bh & 3;
        const int sw = F.wave & 3, vrow = rg * 8 + 2 * sw;
        const char* src = (const char*)(VEC + (size_t)bh * T * RECB) + lane * 16;
#define RW_STAGE(cidx) do { _Pragma("unroll") for (int p_ = 0; p_ < NP; ++p_) \
            __builtin_amdgcn_global_load_lds((const unsigned*)(src + (size_t)(cidx) * CHB + (sw * NP + p_) * 1024), (LAS unsigned*)(F.lds + ((cidx) & 1) * CHB + (sw * NP + p_) * 1024), 16, 0, 0); } while (0)
        if (stager) { RW_STAGE(0); asm volatile("s_waitcnt vmcnt(0)" ::: "memory"); }
        __builtin_amdgcn_s_barrier(); asm volatile("" ::: "memory");
        float SA = 0.f, SB = 0.f;
        for (int c = 0; c < T / CH; ++c) {
            if (stager) { if (c + 1 < T / CH) { RW_STAGE(c + 1); asm volatile("s_waitcnt vmcnt(0)" ::: "memory"); } }
            else {
                const LAS unsigned char* bufb = F.lds + (c & 1) * CHB;
                STM[(((size_t)bh * 64 + c) * 64 + vrow) * 64 + lane] = (bf16_t)f2bf(SA); STM[(((size_t)bh * 64 + c) * 64 + vrow + 1) * 64 + lane] = (bf16_t)f2bf(SB);
                float zaA = 0.f, zaB = 0.f, saaA = 0.f, saaB = 0.f;
#define RW_LD(S1, nw, nnkk, nkka, nk2, nr, nvp) do { const LAS unsigned char* rec_ = bufb + (S1) * RECB; nw = *(const LAS float*)(rec_ + lane * 4); nnkk = bf2f(*(const LAS bf16_t*)(rec_ + 256 + lane * 2)); \
                    nkka = bf2f(*(const LAS bf16_t*)(rec_ + 384 + lane * 2)); nk2 = bf2f(*(const LAS bf16_t*)(rec_ + 512 + lane * 2)); nr = bf2f(*(const LAS bf16_t*)(rec_ + 640 + lane * 2)); nvp = *(const LAS unsigned*)(rec_ + 768 + vrow * 2); } while (0)
                float nw, nnkk, nkka, nk2, nr; unsigned nvp; RW_LD(0, nw, nnkk, nkka, nk2, nr, nvp);
#define RW_STEP(SI) do { \
                    const float w_ = __expf(nw), nkk = nnkk, kka = nkka, k2 = nk2, wr = w_ * nr; const pg8::f32x2 v = {__builtin_bit_cast(float, nvp << 16), __builtin_bit_cast(float, nvp & 0xffff0000u)}; \
                    RW_LD(((SI) + 1 < CH ? (SI) + 1 : (SI)), nw, nnkk, nkka, nk2, nr, nvp); \
                    asm volatile("" ::: "memory"); \
                    const auto s0 = __builtin_amdgcn_permlane32_swap(__builtin_bit_cast(unsigned, SA * nkk), __builtin_bit_cast(unsigned, SA * wr), false, false); \
                    const auto s1_ = __builtin_amdgcn_permlane32_swap(__builtin_bit_cast(unsigned, SB * nkk), __builtin_bit_cast(unsigned, SB * wr), false, false); \
                    const float xA = __builtin_bit_cast(float, (unsigned)s0[0]) + __builtin_bit_cast(float, (unsigned)s0[1]); \
                    const float xB = __builtin_bit_cast(float, (unsigned)s1_[0]) + __builtin_bit_cast(float, (unsigned)s1_[1]); \
                    const auto s2 = __builtin_amdgcn_permlane16_swap(__builtin_bit_cast(unsigned, xA), __builtin_bit_cast(unsigned, xB), false, false); \
                    float x = __builtin_bit_cast(float, (unsigned)s2[0]) + __builtin_bit_cast(float, (unsigned)s2[1]); \
                    x += dpp_mov<0xB1, 0xF>(0.f, x); x += dpp_mov<0x4E, 0xF>(0.f, x); x += dpp_mov<0x141, 0xF>(0.f, x); x += dpp_mov<0x140, 0xF>(0.f, x); \
                    const int isaA = __builtin_amdgcn_readlane(__builtin_bit_cast(int, x), 0), isaB = __builtin_amdgcn_readlane(__builtin_bit_cast(int, x), 16); \
                    const int izA = __builtin_amdgcn_readlane(__builtin_bit_cast(int, x), 32), izB = __builtin_amdgcn_readlane(__builtin_bit_cast(int, x), 48); \
                    const float saA = __builtin_bit_cast(float, isaA), saB = __builtin_bit_cast(float, isaB); \
                    SA = SA * w_ + (saA * kka + v[0] * k2); \
                    SB = SB * w_ + (saB * kka + v[1] * k2); \
                    asm volatile("v_writelane_b32 %0, %4, %8\n\tv_writelane_b32 %1, %5, %8\n\tv_writelane_b32 %2, %6, %8\n\tv_writelane_b32 %3, %7, %8" : "+v"(saaA), "+v"(saaB), "+v"(zaA), "+v"(zaB) : "s"(isaA), "s"(isaB), "s"(izA), "s"(izB), "n"(SI)); \
                } while (0)
                RW_STEP(0); RW_STEP(1); RW_STEP(2); RW_STEP(3); RW_STEP(4); RW_STEP(5); RW_STEP(6); RW_STEP(7); RW_STEP(8); RW_STEP(9); RW_STEP(10); RW_STEP(11); RW_STEP(12); RW_STEP(13); RW_STEP(14); RW_STEP(15); RW_STEP(16); RW_STEP(17); RW_STEP(18); RW_STEP(19); RW_STEP(20); RW_STEP(21); RW_STEP(22); RW_STEP(23); RW_STEP(24); RW_STEP(25); RW_STEP(26); RW_STEP(27); RW_STEP(28); RW_STEP(29); RW_STEP(30); RW_STEP(31);
#undef RW_STEP
#undef RW_LD
                const unsigned vp_ = *(const LAS unsigned*)(bufb + (lane & 31) * RECB + 768 + vrow * 2); const pg8::f32x2 vv = {__builtin_bit_cast(float, vp_ << 16), __builtin_bit_cast(float, vp_ & 0xffff0000u)};
                const pg8::f32x2 cc = *(const pg8::f32x2*)(SC + ((size_t)bh * T + c * CH + (lane & 31)) * 4);
                const float yaA = zaA + saaA * cc[0] + vv[0] * cc[1], yaB = zaB + saaB * cc[0] + vv[1] * cc[1];
                if (lane < CH) *(pg8::f32x2*)(YR + ((size_t)b * T + c * CH + lane) * 256 + h * 64 + vrow) = (pg8::f32x2){yaA, yaB};
            }
            __builtin_amdgcn_s_barrier(); asm volatile("" ::: "memory");
        }
#undef RW_STAGE
        asm volatile("s_waitcnt vmcnt(0)" ::: "memory"); __builtin_amdgcn_s_barrier(); asm volatile("" ::: "memory");
    }
}

__device__ __forceinline__ void ph_rwkv_post(Frame& F, ArgsP a, int l) {
    const unsigned char* VEC = a->ws + SCR_VEC6; const float* SC = (const float*)(a->ws + SCR_SC); const float* YR = (const float*)(a->ws + SCR_YR); const bf16_t* GR = (const bf16_t*)(a->ws + SCR_GR);
    const float* lng = (const float*)a->in[28] + l * 256; const float* lnb = (const float*)a->in[29] + l * 256;
    bf16_t* br = (bf16_t*)(a->ws + WS_HB);
    int lane = F.lane(); asm volatile("" : "+v"(lane));
    const int c = 4 * lane, h = lane >> 4;
    const pg8::f32x4 g4 = *(const pg8::f32x4*)(lng + c), b4 = *(const pg8::f32x4*)(lnb + c);
    for (int row = F.gw; row < M; row += F.NGW) {
        const int b = row / T, t = row % T; const size_t st = (size_t)(b * 4 + h) * T + t;
        const pg8::f32x4 y = *(const pg8::f32x4*)(YR + (size_t)row * 256 + c);
        const float mu = row16_sum((y[0] + y[1]) + (y[2] + y[3])) * (1.0f / 64.0f); const pg8::f32x4 d = y - mu;
        const float var = row16_sum((d[0] * d[0] + d[1] * d[1]) + (d[2] * d[2] + d[3] * d[3])) * (1.0f / 64.0f);
        const pg8::f32x4 yn = d * rsqrtf(var + 64e-5f) * g4 + b4;
        const float bonus = SC[st * 4 + 2];
        const pg8::f32x4 v = ld_bf16x4((const bf16_t*)(VEC + st * RECB + 768) + (c & 63));
        const pg8::f32x4 g = ld_bf16x4(GR + (size_t)row * 256 + c);
        st_bf16x4(br + (size_t)row * D + 768 + c, (yn + bonus * v) * g);
    }
}

__device__ __forceinline__ void ph_gla_p1(Frame& F, ArgsP a, int l) {
    const bf16_t* proj = (const bf16_t*)(a->ws + WS_PROJ); const float* w2 = (const float*)a->in[10] + l * 16 * 128; const float* gb = (const float*)a->in[11] + l * 128;
    bf16_t* QS = (bf16_t*)(a->ws + SCR_EG); float* CDp = (float*)(a->ws + SCR_EG) + (size_t)M * 128; float* GU = (float*)(a->ws + SCR_GU); float* OI = (float*)(a->ws + WS_GOI);
    const bf16_t* GZ = (const bf16_t*)(a->ws + WS_GZ);
    constexpr int RS = 40;
    LAS unsigned char* wl = F.lds + F.wave * 12800;
    LAS bf16_t* VTl = (LAS bf16_t*)wl; LAS bf16_t* Qs = (LAS bf16_t*)(wl + 5120); LAS bf16_t* Ks = (LAS bf16_t*)(wl + 7680); LAS bf16_t* KdT = (LAS bf16_t*)(wl + 10240);
    int lane = F.lane(); asm volatile("" : "+v"(lane));
    const int d = lane & 31, half = lane >> 5, r = lane & 31, hg = lane >> 5;
    for (int it = F.gw; it < 2048; it += F.NGW) {
        const int bh = it >> 6, n = it & 63, b = bh >> 2, h = bh & 3; const size_t row0 = (size_t)b * T + n * 32;
        float wc[16];
#pragma unroll
        for (int q = 0; q < 16; ++q) wc[q] = w2[q * 128 + h * 32 + d];
        const float gbv = gb[h * 32 + d];
        float g[16];
#pragma unroll
        for (int i = 0; i < 16; ++i) { const bf16_t* pr = GZ + (row0 + 16 * half + i) * 16;
            const pg8::f32x4 z0 = ld_bf16x4(pr), z1 = ld_bf16x4(pr + 4), z2 = ld_bf16x4(pr + 8), z3 = ld_bf16x4(pr + 12);
            float acc = gbv;
#pragma unroll
            for (int e = 0; e < 4; ++e) acc += z0[e] * wc[e] + z1[e] * wc[4 + e] + z2[e] * wc[8 + e] + z3[e] * wc[12 + e];
            g[i] = -softplusf(-acc) * (1.0f / 16.0f); }
#pragma unroll
        for (int i = 1; i < 16; ++i) g[i] += g[i - 1];
        const float other = __shfl(g[15], d);
        if (half) {
#pragma unroll
            for (int i = 0; i < 16; ++i) g[i] += other; }
        const float glast = __shfl(g[15], 32 + d);
#pragma unroll
        for (int i = 0; i < 16; ++i) { const int tok = 16 * half + i; const bf16_t* pr = proj + (row0 + tok) * PW;
            const float qv = bf2f(pr[P_GQ + h * 32 + d]), kv = bf2f(pr[P_GK + h * 32 + d]);
            const unsigned qb = f2bf(qv * 0.17677669529663687f * __expf(g[i]));
            Qs[tok * RS + d] = (bf16_t)qb; QS[((size_t)it * 32 + tok) * 32 + d] = (bf16_t)qb;
            Ks[tok * RS + d] = (bf16_t)f2bf(kv * __expf(-g[i])); KdT[d * RS + tok] = (bf16_t)f2bf(kv * __expf(glast - g[i])); }
        if (half) CDp[it * 32 + d] = __expf(glast);
        { const bf16_t* vp = proj + row0 * PW + P_GV + h * 64 + lane;
#pragma unroll
          for (int t2 = 0; t2 < 16; ++t2) { const unsigned lo = vp[(size_t)(2 * t2) * PW], hi = vp[(size_t)(2 * t2 + 1) * PW]; *(LAS unsigned*)(VTl + lane * RS + 2 * t2) = lo | (hi << 16); } }
        asm volatile("s_waitcnt lgkmcnt(0)" ::: "memory");
        f32x16 X;
#pragma unroll
        for (int e = 0; e < 16; ++e) X[e] = 0.f;
#pragma unroll
        for (int s = 0; s < 2; ++s) X = __builtin_amdgcn_mfma_f32_32x32x16_bf16(*(const LAS pg8::bf16x8*)(Ks + r * RS + 16 * s + 8 * hg), *(const LAS pg8::bf16x8*)(Qs + r * RS + 16 * s + 8 * hg), X, 0, 0, 0);
#pragma unroll
        for (int e = 0; e < 16; ++e) { const int jrow = (e & 3) + 8 * (e >> 2) + 4 * hg; if (jrow > r) X[e] = 0.f; }
        f32x16 oi[2], ut[2];
#pragma unroll
        for (int e = 0; e < 16; ++e) { oi[0][e] = 0.f; oi[1][e] = 0.f; ut[0][e] = 0.f; ut[1][e] = 0.f; }
#pragma unroll
        for (int s = 0; s < 2; ++s) {
            pg8::u32x4 pw; pw.x = pk2(X[8 * s], X[8 * s + 1]); pw.y = pk2(X[8 * s + 2], X[8 * s + 3]); pw.z = pk2(X[8 * s + 4], X[8 * s + 5]); pw.w = pk2(X[8 * s + 6], X[8 * s + 7]);
            const pg8::bf16x8 xf = __builtin_bit_cast(pg8::bf16x8, pw);
            const pg8::bf16x8 kdf = *(const LAS pg8::bf16x8*)(KdT + r * RS + 16 * s + 8 * hg);
#pragma unroll
            for (int db = 0; db < 2; ++db) { const LAS bf16_t* vp = VTl + (db * 32 + r) * RS + 16 * s;
                const pg8::u32x2 v0 = *(const LAS pg8::u32x2*)(vp + 4 * hg), v1 = *(const LAS pg8::u32x2*)(vp + 8 + 4 * hg);
                pg8::u32x4 vw; vw.x = v0.x; vw.y = v0.y; vw.z = v1.x; vw.w = v1.y;
                oi[db] = __builtin_amdgcn_mfma_f32_32x32x16_bf16(__builtin_bit_cast(pg8::bf16x8, vw), xf, oi[db], 0, 0, 0);
                ut[db] = __builtin_amdgcn_mfma_f32_32x32x16_bf16(*(const LAS pg8::bf16x8*)(vp + 8 * hg), kdf, ut[db], 0, 0, 0); } }
        float* op = OI + (size_t)it * 2048 + lane;
#pragma unroll
        for (int db = 0; db < 2; ++db)
#pragma unroll
            for (int e = 0; e < 16; ++e) op[(db * 16 + e) * 64] = oi[db][e];
        float* up = GU + ((size_t)it * 32 + r) * 64 + 4 * hg;
#pragma unroll
        for (int db = 0; db < 2; ++db)
#pragma unroll
            for (int q = 0; q < 4; ++q) *(pg8::f32x4*)(up + db * 32 + 8 * q) = (pg8::f32x4){ut[db][4 * q], ut[db][4 * q + 1], ut[db][4 * q + 2], ut[db][4 * q + 3]};
        asm volatile("s_waitcnt lgkmcnt(0)" ::: "memory");
    }
}
__device__ __forceinline__ void ph_gla_prefix(Frame& F, ArgsP a) {
    const float* CDp = (const float*)(a->ws + SCR_EG) + (size_t)M * 128; const float* GU = (const float*)(a->ws + SCR_GU); bf16_t* ST = (bf16_t*)(a->ws + WS_GST);
    int lane = F.lane(); asm volatile("" : "+v"(lane));
    for (int it = F.gw; it < 1024; it += F.NGW) { const int bh = it >> 5, d = it & 31;
        const float* gp = GU + ((size_t)bh * 64 * 32 + d) * 64 + lane; const float* cp = CDp + (size_t)bh * 64 * 32 + d;
        bf16_t* sp = ST + ((size_t)bh * 64 * 64 + lane) * 32 + d;
        float u[64], cd[64];
#pragma unroll
        for (int n = 0; n < 64; ++n) { u[n] = gp[(size_t)n * 2048]; cd[n] = cp[n * 32]; }
        float S = 0.f;
#pragma unroll
        for (int n = 0; n < 64; ++n) { sp[(size_t)n * 2048] = (bf16_t)f2bf(S); S = cd[n] * S + u[n]; } }
}
__device__ __forceinline__ void ph_gla_p2(Frame& F, ArgsP a, int l) {
    const bf16_t* proj = (const bf16_t*)(a->ws + WS_PROJ); const float* gnorm = (const float*)a->in[12] + l * 64;
    const bf16_t* QS = (const bf16_t*)(a->ws + SCR_EG); const bf16_t* ST = (const bf16_t*)(a->ws + WS_GST); const float* OI = (const float*)(a->ws + WS_GOI); bf16_t* br = (bf16_t*)(a->ws + WS_HB);
    int lane = F.lane(); asm volatile("" : "+v"(lane));
    const int r = lane & 31, hg = lane >> 5;
    const bool p2blk = (int)blockIdx.x < 128;
    if (p2blk && F.wave == 0) return;
    const int nseq = (p2blk && F.wave == 1) ? 2 : 1;
    for (int sq = 0; sq < nseq; ++sq)
    for (int it = F.gw - sq; it < 2048; it += F.NGW) {
        const int bh = it >> 6, n = it & 63, b = bh >> 2, h = bh & 3; const size_t row0 = (size_t)b * T + n * 32;
        f32x16 ot[2]; const float* op = OI + (size_t)it * 2048 + lane;
#pragma unroll
        for (int db = 0; db < 2; ++db)
#pragma unroll
            for (int e = 0; e < 16; ++e) ot[db][e] = op[(db * 16 + e) * 64];
#pragma unroll
        for (int s = 0; s < 2; ++s) { const pg8::bf16x8 qf = *(const pg8::bf16x8*)(QS + ((size_t)it * 32 + r) * 32 + 16 * s + 8 * hg);
#pragma unroll
            for (int db = 0; db < 2; ++db) ot[db] = __builtin_amdgcn_mfma_f32_32x32x16_bf16(*(const pg8::bf16x8*)(ST + ((size_t)it * 64 + db * 32 + r) * 32 + 16 * s + 8 * hg), qf, ot[db], 0, 0, 0); }
        float ss = 0.f;
#pragma unroll
        for (int db = 0; db < 2; ++db)
#pragma unroll
            for (int e = 0; e < 16; ++e) ss += ot[db][e] * ot[db][e];
        ss += __shfl_xor(ss, 32);
        const float rstd = rsqrtf(ss * (1.0f / 64.0f) + 1e-6f);
        const bf16_t* og = proj + (row0 + r) * PW + P_GO + h * 64 + 4 * hg; bf16_t* od = br + (row0 + r) * D + h * 64 + 4 * hg;
#pragma unroll
        for (int db = 0; db < 2; ++db)
#pragma unroll
            for (int q = 0; q < 4; ++q) { const int dv0 = db * 32 + 8 * q; const pg8::f32x4 gv = ld_bf16x4(og + dv0), gn = *(const pg8::f32x4*)(gnorm + dv0 + 4 * hg);
                st_bf16x4(od + dv0, (pg8::f32x4){ot[db][4 * q] * rstd * gn[0] * siluf(gv[0]), ot[db][4 * q + 1] * rstd * gn[1] * siluf(gv[1]), ot[db][4 * q + 2] * rstd * gn[2] * siluf(gv[2]), ot[db][4 * q + 3] * rstd * gn[3] * siluf(gv[3])}); }
    }
}

__device__ __forceinline__ void ph_attn_prep(Frame& F, ArgsP a) {
    const bf16_t* proj = (const bf16_t*)(a->ws + WS_PROJ); const int* pos = (const int*)a->in[2];
    bf16_t* QR = (bf16_t*)(a->ws + SCR_QK); bf16_t* KR = QR + (size_t)M * 256; bf16_t* VT = (bf16_t*)(a->ws + SCR_VT);
    int lane = F.lane(); asm volatile("" : "+v"(lane));
    for (int idx = F.gw * 64 + lane; idx < M * 8; idx += F.NGW * 64) { const int row = idx >> 3, hc = idx & 7; const float p = (float)pos[row];
        const bf16_t* qs = proj + (size_t)row * PW + P_DQ + hc * 32; const bf16_t* ks = proj + (size_t)row * PW + P_DK + hc * 32;
        float qv[32], kv[32];
#pragma unroll
        for (int j = 0; j < 8; ++j) { const pg8::f32x4 q4 = ld_bf16x4(qs + 4 * j), k4 = ld_bf16x4(ks + 4 * j);
#pragma unroll
            for (int e = 0; e < 4; ++e) { qv[4 * j + e] = q4[e]; kv[4 * j + e] = k4[e]; } }
        float qo[32], ko[32];
#pragma unroll
        for (int i = 0; i < 16; ++i) { const float inv = exp2f(-(float)i * 0.8304820237218406f);
            float sn, cs; sincosf(p * inv, &sn, &cs);
            qo[i] = qv[i] * cs - qv[i + 16] * sn; qo[i + 16] = qv[i] * sn + qv[i + 16] * cs;
            ko[i] = kv[i] * cs - kv[i + 16] * sn; ko[i + 16] = kv[i] * sn + kv[i + 16] * cs; }
        const float qsc = 0.17677669529663687f * 1.4426950408889634f;
        bf16_t* qd = QR + (size_t)row * 256 + hc * 32; bf16_t* kd = KR + (size_t)row * 256 + hc * 32;
#pragma unroll
        for (int j = 0; j < 8; ++j) { st_bf16x4(qd + 4 * j, (pg8::f32x4){qo[4 * j] * qsc, qo[4 * j + 1] * qsc, qo[4 * j + 2] * qsc, qo[4 * j + 3] * qsc});
            st_bf16x4(kd + 4 * j, (pg8::f32x4){ko[4 * j], ko[4 * j + 1], ko[4 * j + 2], ko[4 * j + 3]}); } }
    for (int it = F.gw; it < 1024; it += F.NGW) { const int bh = it >> 5, tt = it & 31, b = bh >> 2, h = bh & 3;
        const bf16_t* vs = proj + ((size_t)b * T + tt * 64 + lane) * PW + P_DV + h * 64;
        pg8::u32x4 v[8];
#pragma unroll
        for (int j = 0; j < 8; ++j) v[j] = *(const pg8::u32x4*)(vs + 8 * j);
        bf16_t* vd = VT + (size_t)bh * 64 * T + tt * 64 + lane;
#pragma unroll
        for (int j = 0; j < 8; ++j)
#pragma unroll
            for (int e = 0; e < 4; ++e) { const unsigned w = v[j][e]; vd[(size_t)(8 * j + 2 * e) * T] = (bf16_t)(w & 0xffffu); vd[(size_t)(8 * j + 2 * e + 1) * T] = (bf16_t)(w >> 16); } }
}
__device__ __forceinline__ void ph_attn(Frame& F, ArgsP a, int l) {
    const bf16_t* QR = (const bf16_t*)(a->ws + SCR_QK); const bf16_t* KR = QR + (size_t)M * 256; const bf16_t* VT = (const bf16_t*)(a->ws + SCR_VT);
    const float* lp = (const float*)a->in[13] + l * 128; const float* subln = (const float*)a->in[14] + l * 64; bf16_t* br = (bf16_t*)(a->ws + WS_HB);
    int tid = F.wave * 64 + F.lane(); asm volatile("" : "+v"(tid)); const int lane = tid & 63;
    const int r = lane & 31, hg = lane >> 5, comp = F.wave & 1, qs = F.wave >> 1;
    constexpr int RS = 72;
    LAS bf16_t* Kt = (LAS bf16_t*)F.lds;
    LAS bf16_t* Vt = Kt + 2 * 64 * RS;
    LAS float* Xl = (LAS float*)(F.lds + 4 * 64 * RS * 2);
    float lam, lam_init;
    { float d01 = 0.f, d23 = 0.f;
      for (int i = 0; i < 32; ++i) { d01 += lp[i] * lp[32 + i]; d23 += lp[64 + i] * lp[96 + i]; }
      lam_init = 0.8f - 0.6f * __expf(-0.3f * (float)l); lam = __expf(d01) - __expf(d23) + lam_init; }
    const int ldrow = tid >> 3, ldch = tid & 7;
    const int vcu = (F.G % 8 == 0) ? ((int)blockIdx.x % 8) * (F.G / 8) + (int)blockIdx.x / 8 : (int)blockIdx.x;
    for (int pi = vcu; pi < 256; pi += F.G) {
#pragma unroll 1
        for (int half = 0; half < 2; ++half) {
            const int bh = pi >> 3, j = pi & 7, qb = half == 0 ? 15 - j : j, b = bh >> 2, h = bh & 3;
            const int q0 = qb * 128 + qs * 32, nkw = q0 / 64 + 1, nkb = 2 * qb + 2;
            const size_t rowb = (size_t)b * T;
            pg8::bf16x8 qf[2];
#pragma unroll
            for (int s = 0; s < 2; ++s) qf[s] = *(const pg8::bf16x8*)(QR + (rowb + q0 + r) * 256 + h * 64 + comp * 32 + 16 * s + 8 * hg);
            f32x16 ot[2];
#pragma unroll
            for (int e = 0; e < 16; ++e) { ot[0][e] = 0.f; ot[1][e] = 0.f; }
            float mrun = -1e30f, lrun = 0.f;
            const bf16_t* kg = KR + (rowb + ldrow) * 256 + h * 64 + ldch * 8; const bf16_t* vg = VT + ((size_t)bh * 64 + ldrow) * T + ldch * 8;
            pg8::u32x4 kreg = *(const pg8::u32x4*)kg, vreg = *(const pg8::u32x4*)vg;
            pg8::u32x4 kreg2 = kreg, vreg2 = vreg;
            if (nkb > 1) { kreg2 = *(const pg8::u32x4*)(kg + (size_t)64 * 256); vreg2 = *(const pg8::u32x4*)(vg + 64); }
            for (int kt = 0; kt < nkb; ++kt) {
                const int bo = (kt & 1) * 64 * RS;
                *(LAS pg8::u32x4*)(Kt + bo + ldrow * RS + ldch * 8) = kreg; *(LAS pg8::u32x4*)(Vt + bo + ldrow * RS + ldch * 8) = vreg;
                __syncthreads();
                kreg = kreg2; vreg = vreg2;
                if (kt + 2 < nkb) { kreg2 = *(const pg8::u32x4*)(kg + (size_t)(kt + 2) * 64 * 256); vreg2 = *(const pg8::u32x4*)(vg + (kt + 2) * 64); }
                if (kt < nkw) {
                    f32x16 st[2];
#pragma unroll
                    for (int kb = 0; kb < 2; ++kb) {
#pragma unroll
                        for (int e = 0; e < 16; ++e) st[kb][e] = 0.f;
#pragma unroll
                        for (int s = 0; s < 2; ++s) { const pg8::bf16x8 kf = *(const LAS pg8::bf16x8*)(Kt + bo + (kb * 32 + r) * RS + comp * 32 + 16 * s + 8 * hg);
                            st[kb] = __builtin_amdgcn_mfma_f32_32x32x16_bf16(kf, qf[s], st[kb], 0, 0, 0); } }
                    if (kt == nkw - 1) {
                        const int qi = q0 + r;
#pragma unroll
                        for (int kb = 0; kb < 2; ++kb)
#pragma unroll
                            for (int e = 0; e < 16; ++e) { const int ki = kt * 64 + kb * 32 + (e & 3) + 8 * (e >> 2) + 4 * hg; if (ki > qi) st[kb][e] = -1e30f; } }
                    float tm = st[0][0];
#pragma unroll
                    for (int e = 1; e < 16; ++e) tm = fmaxf(tm, st[0][e]);
#pragma unroll
                    for (int e = 0; e < 16; ++e) tm = fmaxf(tm, st[1][e]);
                    { const auto sw = __builtin_amdgcn_permlane32_swap(__builtin_bit_cast(unsigned, tm), __builtin_bit_cast(unsigned, tm), false, false); tm = fmaxf(__builtin_bit_cast(float, (unsigned)sw[0]), __builtin_bit_cast(float, (unsigned)sw[1])); }
                    const float mn = fmaxf(mrun, tm), alpha = __builtin_amdgcn_exp2f(mrun - mn); mrun = mn;
                    float ps = 0.f;
#pragma unroll
                    for (int kb = 0; kb < 2; ++kb)
#pragma unroll
                        for (int e = 0; e < 16; ++e) { st[kb][e] = __builtin_amdgcn_exp2f(st[kb][e] - mn); ps += st[kb][e]; }
                    lrun = lrun * alpha + ps;
#pragma unroll
                    for (int e = 0; e < 16; ++e) { ot[0][e] *= alpha; ot[1][e] *= alpha; }
#pragma unroll
                    for (int kb = 0; kb < 2; ++kb)
#pragma unroll
                        for (int s = 0; s < 2; ++s) {
                            pg8::u32x4 pw; pw.x = pk2(st[kb][8 * s], st[kb][8 * s + 1]); pw.y = pk2(st[kb][8 * s + 2], st[kb][8 * s + 3]); pw.z = pk2(st[kb][8 * s + 4], st[kb][8 * s + 5]); pw.w = pk2(st[kb][8 * s + 6], st[kb][8 * s + 7]);
                            const pg8::bf16x8 pf = __builtin_bit_cast(pg8::bf16x8, pw);
#pragma unroll
                            for (int dvb = 0; dvb < 2; ++dvb) { const LAS bf16_t* vp = Vt + bo + (dvb * 32 + r) * RS + kb * 32 + 16 * s + 4 * hg;
                                const pg8::u32x2 v0 = *(const LAS pg8::u32x2*)vp, v1 = *(const LAS pg8::u32x2*)(vp + 8);
                                pg8::u32x4 vw; vw.x = v0.x; vw.y = v0.y; vw.z = v1.x; vw.w = v1.y;
                                ot[dvb] = __builtin_amdgcn_mfma_f32_32x32x16_bf16(__builtin_bit_cast(pg8::bf16x8, vw), pf, ot[dvb], 0, 0, 0); } }
                }
            }
            const float ltot = lrun + __shfl_xor(lrun, 32); const float il = 1.0f / ltot;
            __syncthreads();
            if (comp == 1) {
#pragma unroll
                for (int dvb = 0; dvb < 2; ++dvb)
#pragma unroll
                    for (int e = 0; e < 16; ++e) Xl[(qs * 32 + dvb * 16 + e) * 64 + lane] = ot[dvb][e] * il; }
            __syncthreads();
            if (comp == 0) {
                float o[32]; float ss = 0.f;
#pragma unroll
                for (int dvb = 0; dvb < 2; ++dvb)
#pragma unroll
                    for (int e = 0; e < 16; ++e) { const float v = ot[dvb][e] * il - lam * Xl[(qs * 32 + dvb * 16 + e) * 64 + lane]; o[dvb * 16 + e] = v; ss += v * v; }
                ss += __shfl_xor(ss, 32);
                const float sc = rsqrtf(ss * (1.0f / 64.0f) + 1e-6f) * (1.0f - lam_init);
                bf16_t* od = br + (rowb + q0 + r) * D + 256 + h * 64;
#pragma unroll
                for (int dvb = 0; dvb < 2; ++dvb)
#pragma unroll
                    for (int g4 = 0; g4 < 4; ++g4) { const int dv0 = dvb * 32 + 8 * g4 + 4 * hg; const pg8::f32x4 sl = *(const pg8::f32x4*)(subln + dv0);
                        st_bf16x4(od + dv0, (pg8::f32x4){o[dvb * 16 + 4 * g4] * sc * sl[0], o[dvb * 16 + 4 * g4 + 1] * sc * sl[1], o[dvb * 16 + 4 * g4 + 2] * sc * sl[2], o[dvb * 16 + 4 * g4 + 3] * sc * sl[3]}); }
            }
            __syncthreads();
        }
    }
}

__device__ __forceinline__ void ph_branch(Frame& F, ArgsP a, int l) {
    const bf16_t* br = (const bf16_t*)(a->ws + WS_HB); const bf16_t* WB = (const bf16_t*)(a->ws + WS_WB) + (size_t)l * 4096 * 256;
    const bf16_t* proj = (const bf16_t*)(a->ws + WS_PROJ); bf16_t* MB = (bf16_t*)(a->ws + SCR_MB);
    int tid = F.wave * 64 + F.lane(); asm volatile("" : "+v"(tid)); const int lane = tid & 63;
    const int r = lane & 31, hg = lane >> 5, wt = (tid >> 6) & 3, wd = tid >> 8;
    constexpr int RS = 72, TB = 128 * RS;
    LAS bf16_t* Wl = (LAS bf16_t*)F.lds;
    LAS bf16_t* Bl = Wl + 2 * TB;
    const int ldr = tid >> 3, ldc = (tid & 7) * 8;
    for (int it = blockIdx.x; it < 1024; it += F.G) {
        const int tm = it >> 3, td = it & 7; const size_t row0 = (size_t)tm * 128; const int d0 = td * 128;
        f32x16 tot[2], acc[2];
#pragma unroll
        for (int e = 0; e < 16; ++e) { tot[0][e] = 0.f; tot[1][e] = 0.f; acc[0][e] = 0.f; acc[1][e] = 0.f; }
        pg8::u32x4 rw0, rw1, rb0, rb1;
#define BR_LOAD(st) do { const int g_ = (st) >> 2, kq_ = (st) & 3; const bf16_t* wp = WB + (size_t)(g_ * 1024 + d0 + ldr) * 256 + kq_ * 64 + ldc; const bf16_t* bp = br + (row0 + ldr) * D + g_ * 256 + kq_ * 64 + ldc; \
            rw0 = *(const pg8::u32x4*)wp; rw1 = *(const pg8::u32x4*)(wp + 64 * 256); rb0 = *(const pg8::u32x4*)bp; rb1 = *(const pg8::u32x4*)(bp + 64 * D); } while (0)
#define BR_WRITE(buf) do { *(LAS pg8::u32x4*)(Wl + (buf) * TB + ldr * RS + ldc) = rw0; *(LAS pg8::u32x4*)(Wl + (buf) * TB + (ldr + 64) * RS + ldc) = rw1; \
            *(LAS pg8::u32x4*)(Bl + (buf) * TB + ldr * RS + ldc) = rb0; *(LAS pg8::u32x4*)(Bl + (buf) * TB + (ldr + 64) * RS + ldc) = rb1; } while (0)
        BR_LOAD(0); BR_WRITE(0); __syncthreads(); BR_LOAD(1);
        pg8::u32x2 gt[2][4];
#pragma unroll 1
        for (int st = 0; st < 16; ++st) {
            const int buf = st & 1, g = st >> 2;
            if ((st & 3) == 0) {
                const bf16_t* gp = proj + (row0 + wt * 32 + r) * PW + P_GATE + g * 1024 + d0 + wd * 64 + 4 * hg;
#pragma unroll
                for (int db = 0; db < 2; ++db)
#pragma unroll
                    for (int q = 0; q < 4; ++q) gt[db][q] = *(const pg8::u32x2*)(gp + db * 32 + 8 * q); }
#pragma unroll
            for (int s = 0; s < 4; ++s) { const pg8::bf16x8 bf = *(const LAS pg8::bf16x8*)(Bl + buf * TB + (wt * 32 + r) * RS + 16 * s + 8 * hg);
#pragma unroll
                for (int db = 0; db < 2; ++db) { const pg8::bf16x8 af = *(const LAS pg8::bf16x8*)(Wl + buf * TB + (wd * 64 + db * 32 + r) * RS + 16 * s + 8 * hg);
                    acc[db] = __builtin_amdgcn_mfma_f32_32x32x16_bf16(af, bf, acc[db], 0, 0, 0); } }
            if (st + 1 < 16) BR_WRITE(buf ^ 1);
            if (st + 2 < 16) BR_LOAD(st + 2);
            if ((st & 3) == 3) {
#pragma unroll
                for (int db = 0; db < 2; ++db)
#pragma unroll
                    for (int q = 0; q < 4; ++q) { const pg8::u32x2 w = gt[db][q];
                        const float g0 = __builtin_bit_cast(float, w.x << 16), g1 = __builtin_bit_cast(float, w.x & 0xffff0000u), g2 = __builtin_bit_cast(float, w.y << 16), g3 = __builtin_bit_cast(float, w.y & 0xffff0000u);
                        tot[db][4 * q] += acc[db][4 * q] * sigm(g0); tot[db][4 * q + 1] += acc[db][4 * q + 1] * sigm(g1); tot[db][4 * q + 2] += acc[db][4 * q + 2] * sigm(g2); tot[db][4 * q + 3] += acc[db][4 * q + 3] * sigm(g3);
                        acc[db][4 * q] = 0.f; acc[db][4 * q + 1] = 0.f; acc[db][4 * q + 2] = 0.f; acc[db][4 * q + 3] = 0.f; } }
            __syncthreads();
        }
#undef BR_LOAD
#undef BR_WRITE
        bf16_t* mp = MB + (row0 + wt * 32 + r) * D + d0 + wd * 64 + 4 * hg;
#pragma unroll
        for (int db = 0; db < 2; ++db)
#pragma unroll
            for (int q = 0; q < 4; ++q) st_bf16x4(mp + db * 32 + 8 * q, (pg8::f32x4){tot[db][4 * q], tot[db][4 * q + 1], tot[db][4 * q + 2], tot[db][4 * q + 3]});
    }
}

__device__ __forceinline__ int crow(int e, int hg) { return (e & 3) + 8 * (e >> 2) + 4 * hg; }
__device__ __forceinline__ void ph_rk_p1(Frame& F, ArgsP a) {
    if (F.wave >= 4) return;
    const unsigned char* VEC = a->ws + SCR_VEC6;
    bf16_t* QE = (bf16_t*)(a->ws + SCR_QE); bf16_t* AY = (bf16_t*)(a->ws + SCR_AY); bf16_t* VTC = (bf16_t*)(a->ws + SCR_VTC); bf16_t* GMF = (bf16_t*)(a->ws + SCR_GMF); bf16_t* ZB = (bf16_t*)(a->ws + SCR_ZB);
    LAS unsigned char* wl = F.lds + F.wave * 40448;
    LAS bf16_t* TA = (LAS bf16_t*)wl;
    LAS bf16_t* TK = (LAS bf16_t*)(wl + 4608);
    LAS bf16_t* TR = (LAS bf16_t*)(wl + 9216);
    LAS bf16_t* TB = (LAS bf16_t*)(wl + 13824);
    LAS bf16_t* TBT = (LAS bf16_t*)(wl + 18432);
    LAS bf16_t* TKT = (LAS bf16_t*)(wl + 23552);
    LAS bf16_t* TVT = (LAS bf16_t*)(wl + 28672);
    LAS bf16_t* MRB = (LAS bf16_t*)(wl + 33792);
    LAS bf16_t* W2T = (LAS bf16_t*)(wl + 36352);
    LAS float* GC = (LAS float*)(wl + 38912);
    LAS float* LabF = (LAS float*)(wl + 4608); LAS float* LakF = (LAS float*)(wl + 13824); LAS bf16_t* W1T = (LAS bf16_t*)wl; LAS bf16_t* GST = (LAS bf16_t*)(wl + 9216); LAS bf16_t* HM = TKT;
    int lane0 = F.lane(); asm volatile("" : "+v"(lane0));
#define RK_LANES() int lane = lane0; asm volatile("" : "+v"(lane)); const int r = lane & 31, hg = lane >> 5; (void)r; (void)hg
    for (int it = (int)blockIdx.x * 4 + F.wave; it < 2048; it += F.G * 4) {
        const unsigned char* rec0 = VEC + (size_t)it * 32 * RECB;
        f32x16 mrk;
        {
            RK_LANES();
        { float G = 0.f, gprev = 1.f;
#pragma unroll 16
          for (int t = 0; t < 32; ++t) { const unsigned char* rp = rec0 + t * RECB;
              const float lw = *(const float*)(rp + lane * 4); const float av = bf2f(*(const bf16_t*)(rp + 256 + lane * 2)), bv = bf2f(*(const bf16_t*)(rp + 384 + lane * 2)), kv = bf2f(*(const bf16_t*)(rp + 512 + lane * 2)), rv = bf2f(*(const bf16_t*)(rp + 640 + lane * 2));
              const bf16_t vraw = *(const bf16_t*)(rp + 768 + lane * 2);
              G += lw; const float gam = __expf(G), inv = __builtin_amdgcn_rcpf(gam);
              const bf16_t bt = (bf16_t)f2bf(bv * inv), kt = (bf16_t)f2bf(kv * inv);
              TA[t * 72 + lane] = (bf16_t)f2bf(av * gprev); TR[t * 72 + lane] = (bf16_t)f2bf(rv * gam); TB[t * 72 + lane] = bt; TK[t * 72 + lane] = kt;
              TBT[lane * 40 + t] = bt; TKT[lane * 40 + t] = kt; TVT[lane * 40 + t] = vraw; gprev = gam; }
          GC[lane] = gprev; }
        asm volatile("s_waitcnt lgkmcnt(0)" ::: "memory");
#pragma unroll
        for (int q = 0; q < 4; ++q) *(pg8::u32x4*)(VTC + ((size_t)it * 64 + lane) * 32 + 8 * q) = *(const LAS pg8::u32x4*)(TVT + lane * 40 + 8 * q);
        }
        {
            RK_LANES();
        f32x16 lab, lak, mrb;
#pragma unroll
        for (int e = 0; e < 16; ++e) { lab[e] = 0.f; lak[e] = 0.f; mrb[e] = 0.f; mrk[e] = 0.f; }
#pragma unroll
        for (int s = 0; s < 4; ++s) { const int o = r * 72 + 16 * s + 8 * hg;
            const pg8::bf16x8 fa = *(const LAS pg8::bf16x8*)(TA + o), fr = *(const LAS pg8::bf16x8*)(TR + o), fb = *(const LAS pg8::bf16x8*)(TB + o), fk = *(const LAS pg8::bf16x8*)(TK + o);
            lab = __builtin_amdgcn_mfma_f32_32x32x16_bf16(fa, fb, lab, 0, 0, 0); lak = __builtin_amdgcn_mfma_f32_32x32x16_bf16(fa, fk, lak, 0, 0, 0);
            mrb = __builtin_amdgcn_mfma_f32_32x32x16_bf16(fr, fb, mrb, 0, 0, 0); mrk = __builtin_amdgcn_mfma_f32_32x32x16_bf16(fr, fk, mrk, 0, 0, 0); }
#pragma unroll
        for (int e = 0; e < 16; ++e) { const int t = crow(e, hg);
            LabF[t * 36 + r] = (r < t) ? lab[e] : 0.f; LakF[t * 36 + r] = (r < t) ? lak[e] : 0.f;
            MRB[t * 40 + r] = (bf16_t)f2bf((r <= t) ? mrb[e] : 0.f); mrk[e] = (r <= t) ? mrk[e] : 0.f; }
        asm volatile("s_waitcnt lgkmcnt(0)" ::: "memory");
        }
        {
            RK_LANES();
        { float W1[32], W2[32];
          W1[0] = bf2f(TA[lane]); W2[0] = LakF[r];
          unsigned dep = 0u;
#pragma unroll
          for (int t = 1; t < 32; ++t) { asm volatile("" : "+v"(dep) : "v"(W1[t - 1]), "v"(W2[t - 1]));
              const LAS float* Lr = LabF + t * 36 + dep;
              float s1 = bf2f(TA[t * 72 + lane + dep]), s2 = LakF[t * 36 + r + dep];
#pragma unroll
              for (int j4 = 0; j4 < (t + 3) / 4; ++j4) { const pg8::f32x4 L4 = *(const LAS pg8::f32x4*)(Lr + 4 * j4);
#pragma unroll
                  for (int q = 0; q < 4; ++q) if (4 * j4 + q < t) { s1 = __builtin_fmaf(L4[q], W1[4 * j4 + q], s1); s2 = __builtin_fmaf(L4[q], W2[4 * j4 + q], s2); } }
              W1[t] = s1; W2[t] = s2; }
          asm volatile("s_waitcnt lgkmcnt(0)" ::: "memory");
#pragma unroll
          for (int q = 0; q < 4; ++q) { *(LAS pg8::u32x4*)(W1T + lane * 40 + 8 * q) = (pg8::u32x4){pk2(W1[8 * q], W1[8 * q + 1]), pk2(W1[8 * q + 2], W1[8 * q + 3]), pk2(W1[8 * q + 4], W1[8 * q + 5]), pk2(W1[8 * q + 6], W1[8 * q + 7])};
              if (lane < 32) *(LAS pg8::u32x4*)(W2T + lane * 40 + 8 * q) = (pg8::u32x4){pk2(W2[8 * q], W2[8 * q + 1]), pk2(W2[8 * q + 2], W2[8 * q + 3]), pk2(W2[8 * q + 4], W2[8 * q + 5]), pk2(W2[8 * q + 6], W2[8 * q + 7])}; } }
        asm volatile("s_waitcnt lgkmcnt(0)" ::: "memory");
        }
        {
            RK_LANES();
#pragma unroll
        for (int kb = 0; kb < 2; ++kb) { f32x16 acc;
#pragma unroll
            for (int e = 0; e < 16; ++e) acc[e] = bf2f(TR[crow(e, hg) * 72 + kb * 32 + r]);
#pragma unroll
            for (int s = 0; s < 2; ++s) acc = __builtin_amdgcn_mfma_f32_32x32x16_bf16(*(const LAS pg8::bf16x8*)(MRB + r * 40 + 16 * s + 8 * hg), *(const LAS pg8::bf16x8*)(W1T + (kb * 32 + r) * 40 + 16 * s + 8 * hg), acc, 0, 0, 0);
#pragma unroll
            for (int e = 0; e < 16; ++e) QE[((size_t)it * 32 + crow(e, hg)) * 64 + kb * 32 + r] = (bf16_t)f2bf(acc[e]); }
        }
        {
            RK_LANES();
        { f32x16 acc = mrk;
#pragma unroll
          for (int s = 0; s < 2; ++s) acc = __builtin_amdgcn_mfma_f32_32x32x16_bf16(*(const LAS pg8::bf16x8*)(MRB + r * 40 + 16 * s + 8 * hg), *(const LAS pg8::bf16x8*)(W2T + r * 40 + 16 * s + 8 * hg), acc, 0, 0, 0);
#pragma unroll
          for (int e = 0; e < 16; ++e) AY[((size_t)it * 32 + crow(e, hg)) * 32 + r] = (bf16_t)f2bf(acc[e]); }
        asm volatile("s_waitcnt lgkmcnt(0)" ::: "memory");
        }
        {
            RK_LANES();
#pragma unroll
        for (int kbr = 0; kbr < 2; ++kbr)
#pragma unroll
            for (int kb = 0; kb < 2; ++kb) { f32x16 acc;
#pragma unroll
                for (int e = 0; e < 16; ++e) acc[e] = 0.f;
#pragma unroll
                for (int s = 0; s < 2; ++s) acc = __builtin_amdgcn_mfma_f32_32x32x16_bf16(*(const LAS pg8::bf16x8*)(TBT + (kbr * 32 + r) * 40 + 16 * s + 8 * hg), *(const LAS pg8::bf16x8*)(W1T + (kb * 32 + r) * 40 + 16 * s + 8 * hg), acc, 0, 0, 0);
#pragma unroll
                for (int e = 0; e < 16; ++e) { const int kr = kbr * 32 + crow(e, hg); const float dl = (kbr == kb && crow(e, hg) == r) ? 1.f : 0.f;
                    GST[kr * 72 + kb * 32 + r] = (bf16_t)f2bf(GC[kr] * (acc[e] + dl)); } }
        asm volatile("s_waitcnt lgkmcnt(0)" ::: "memory");
        { const int m16 = lane & 15, kg = lane >> 4;
#pragma unroll
        for (int rt = 0; rt < 4; ++rt)
#pragma unroll
            for (int s = 0; s < 2; ++s) { const LAS bf16_t* p = GST + (rt * 16 + m16) * 72 + 32 * s;
                const pg8::u32x2 v0 = *(const LAS pg8::u32x2*)(p + 4 * kg), v1 = *(const LAS pg8::u32x2*)(p + 16 + 4 * kg);
                *(pg8::u32x4*)(GMF + (((size_t)it * 8 + rt * 2 + s) * 64 + lane) * 8) = (pg8::u32x4){v0.x, v0.y, v1.x, v1.y}; } }
        }
        {
            RK_LANES();
#pragma unroll
        for (int kbr = 0; kbr < 2; ++kbr) { f32x16 acc;
#pragma unroll
            for (int e = 0; e < 16; ++e) acc[e] = bf2f(TKT[(kbr * 32 + crow(e, hg)) * 40 + r]);
#pragma unroll
            for (int s = 0; s < 2; ++s) acc = __builtin_amdgcn_mfma_f32_32x32x16_bf16(*(const LAS pg8::bf16x8*)(TBT + (kbr * 32 + r) * 40 + 16 * s + 8 * hg), *(const LAS pg8::bf16x8*)(W2T + r * 40 + 16 * s + 8 * hg), acc, 0, 0, 0);
            asm volatile("s_waitcnt lgkmcnt(0)" ::: "memory");
#pragma unroll
            for (int e = 0; e < 16; ++e) { const int kr = kbr * 32 + crow(e, hg); HM[kr * 40 + r] = (bf16_t)f2bf(GC[kr] * acc[e]); } }
        asm volatile("s_waitcnt lgkmcnt(0)" ::: "memory");
        }
        {
            RK_LANES();
#pragma unroll
        for (int vb = 0; vb < 2; ++vb)
#pragma unroll
            for (int kbr = 0; kbr < 2; ++kbr) { f32x16 acc;
#pragma unroll
                for (int e = 0; e < 16; ++e) acc[e] = 0.f;
#pragma unroll
                for (int s = 0; s < 2; ++s) acc = __builtin_amdgcn_mfma_f32_32x32x16_bf16(*(const LAS pg8::bf16x8*)(HM + (kbr * 32 + r) * 40 + 16 * s + 8 * hg), *(const LAS pg8::bf16x8*)(TVT + (vb * 32 + r) * 40 + 16 * s + 8 * hg), acc, 0, 0, 0);
#pragma unroll
                for (int q = 0; q < 4; ++q) { const int rt = 2 * kbr + (q >> 1), lp = (r & 15) + 16 * (2 * (q & 1) + hg), cc = 2 * vb + (r >> 4);
                    *(pg8::u32x2*)(ZB + (((size_t)it * 4 + cc) * 64 + lp) * 16 + rt * 4) = (pg8::u32x2){pk2(acc[4 * q], acc[4 * q + 1]), pk2(acc[4 * q + 2], acc[4 * q + 3])}; } }
        }
        asm volatile("s_waitcnt lgkmcnt(0)" ::: "memory");
    }
}
#undef RK_LANES
__device__ __forceinline__ void ph_rk_p2(Frame& F, ArgsP a) {
    if (F.wave != 0 || (int)blockIdx.x >= 128) return;
    const bf16_t* GMF = (const bf16_t*)(a->ws + SCR_GMF); const bf16_t* ZB = (const bf16_t*)(a->ws + SCR_ZB); bf16_t* STM = (bf16_t*)(a->ws + SCR_STM);
    int lane = F.lane(); asm volatile("" : "+v"(lane));
    const int n16 = lane & 15, rg = lane >> 4;
    const int bh = (int)blockIdx.x >> 2, cs = (int)blockIdx.x & 3;
    pg8::f32x4 st[4];
#pragma unroll
    for (int rt = 0; rt < 4; ++rt) st[rt] = (pg8::f32x4){0.f, 0.f, 0.f, 0.f};
    const char* gsrc = (const char*)GMF + (size_t)bh * 64 * 8192 + lane * 16;
    const char* zsrc = (const char*)ZB + ((size_t)bh * 64 * 4 + cs) * 2048 + lane * 32;
    bf16_t* sp0 = STM + ((size_t)bh * 64 * 64 + cs * 16 + n16) * 64 + 4 * rg;
#define P2_STAGE(n_) do { const int c_ = (n_) < 64 ? (n_) : 63; LAS unsigned char* sl_ = F.lds + ((n_) % 6) * 10240; _Pragma("unroll") for (int f_ = 0; f_ < 8; ++f_) \
        __builtin_amdgcn_global_load_lds((const unsigned*)(gsrc + (size_t)c_ * 8192 + f_ * 1024), (LAS unsigned*)(sl_ + f_ * 1024), 16, 0, 0); \
        _Pragma("unroll") for (int f_ = 0; f_ < 2; ++f_) __builtin_amdgcn_global_load_lds((const unsigned*)(zsrc + (size_t)c_ * 8192 + f_ * 16), (LAS unsigned*)(sl_ + 8192 + f_ * 1024), 16, 0, 0); } while (0)
#define P2_READ(n_, A_, Z_) do { const LAS unsigned char* sl_ = F.lds + ((n_) % 6) * 10240 + lane * 16; _Pragma("unroll") for (int f_ = 0; f_ < 8; ++f_) A_[f_] = *(const LAS pg8::bf16x8*)(sl_ + f_ * 1024); \
        Z_[0] = *(const LAS pg8::u32x4*)(sl_ + 8192); Z_[1] = *(const LAS pg8::u32x4*)(sl_ + 9216); } while (0)
#define P2_TRIP(n_, AC, ZC, AN, ZN) do { \
        bf16_t* sp_ = sp0 + (size_t)(n_) * 4096; unsigned pk_[4][2]; \
        _Pragma("unroll") for (int rt = 0; rt < 4; ++rt) { pk_[rt][0] = pk2(st[rt][0], st[rt][1]); pk_[rt][1] = pk2(st[rt][2], st[rt][3]); *(pg8::u32x2*)(sp_ + 16 * rt) = (pg8::u32x2){pk_[rt][0], pk_[rt][1]}; } \
        pg8::bf16x8 pf_[2]; _Pragma("unroll") for (int s = 0; s < 2; ++s) pf_[s] = __builtin_bit_cast(pg8::bf16x8, (pg8::u32x4){pk_[2 * s][0], pk_[2 * s][1], pk_[2 * s + 1][0], pk_[2 * s + 1][1]}); \
        P2_STAGE((n_) + 5); \
        if ((n_) == 0) asm volatile("s_waitcnt vmcnt(44)" ::: "memory"); else if ((n_) == 1) asm volatile("s_waitcnt vmcnt(48)" ::: "memory"); else if ((n_) == 2) asm volatile("s_waitcnt vmcnt(52)" ::: "memory"); \
        else asm volatile("s_waitcnt vmcnt(56)" ::: "memory"); \
        P2_READ((n_) + 1, AN, ZN); \
        pg8::f32x4 nw_[4]; \
        _Pragma("unroll") for (int rt = 0; rt < 4; ++rt) { const unsigned w0_ = ZC[rt >> 1][(rt & 1) * 2], w1_ = ZC[rt >> 1][(rt & 1) * 2 + 1]; \
            nw_[rt] = (pg8::f32x4){__builtin_bit_cast(float, w0_ << 16), __builtin_bit_cast(float, w0_ & 0xffff0000u), __builtin_bit_cast(float, w1_ << 16), __builtin_bit_cast(float, w1_ & 0xffff0000u)}; } \
        _Pragma("unroll") for (int s = 0; s < 2; ++s) _Pragma("unroll") for (int rt = 0; rt < 4; ++rt) nw_[rt] = __builtin_amdgcn_mfma_f32_16x16x32_bf16(AC[rt * 2 + s], pf_[s], nw_[rt], 0, 0, 0); \
        _Pragma("unroll") for (int rt = 0; rt < 4; ++rt) st[rt] = nw_[rt]; } while (0)
    P2_STAGE(0); P2_STAGE(1); P2_STAGE(2); P2_STAGE(3); P2_STAGE(4);
    asm volatile("s_waitcnt vmcnt(40)" ::: "memory");
    pg8::bf16x8 A0[8], A1[8]; pg8::u32x4 Z0[2], Z1[2];
    P2_READ(0, A0, Z0);
#pragma unroll 1
    for (int n = 0; n < 64; n += 2) { P2_TRIP(n, A0, Z0, A1, Z1); P2_TRIP(n + 1, A1, Z1, A0, Z0); }
#undef P2_TRIP
#undef P2_READ
#undef P2_STAGE
    asm volatile("s_waitcnt vmcnt(0)" ::: "memory");
}
__device__ __forceinline__ void ph_rk_p3(Frame& F, ArgsP a, int l) {
    const unsigned char* VEC = a->ws + SCR_VEC6; const float* SC = (const float*)(a->ws + SCR_SC); const bf16_t* GR = (const bf16_t*)(a->ws + SCR_GR);
    const bf16_t* QE = (const bf16_t*)(a->ws + SCR_QE); const bf16_t* AY = (const bf16_t*)(a->ws + SCR_AY); const bf16_t* VTC = (const bf16_t*)(a->ws + SCR_VTC); const bf16_t* STM = (const bf16_t*)(a->ws + SCR_STM);
    const float* lng = (const float*)a->in[28] + l * 256; const float* lnb = (const float*)a->in[29] + l * 256; bf16_t* br = (bf16_t*)(a->ws + WS_HB);
    int lane = F.lane(); asm volatile("" : "+v"(lane));
    const int r = lane & 31, hg = lane >> 5;
    for (int it = F.gw; it < 2048; it += F.NGW) {
        const int bh = it >> 6, n = it & 63, b = bh >> 2, h = bh & 3;
        f32x16 acc[2];
#pragma unroll
        for (int e = 0; e < 16; ++e) { acc[0][e] = 0.f; acc[1][e] = 0.f; }
#pragma unroll
        for (int s = 0; s < 4; ++s) { const pg8::bf16x8 qf = *(const pg8::bf16x8*)(QE + ((size_t)it * 32 + r) * 64 + 16 * s + 8 * hg);
#pragma unroll
            for (int vb = 0; vb < 2; ++vb) acc[vb] = __builtin_amdgcn_mfma_f32_32x32x16_bf16(*(const pg8::bf16x8*)(STM + ((size_t)it * 64 + vb * 32 + r) * 64 + 16 * s + 8 * hg), qf, acc[vb], 0, 0, 0); }
#pragma unroll
        for (int s = 0; s < 2; ++s) { const pg8::bf16x8 af = *(const pg8::bf16x8*)(AY + ((size_t)it * 32 + r) * 32 + 16 * s + 8 * hg);
#pragma unroll
            for (int vb = 0; vb < 2; ++vb) acc[vb] = __builtin_amdgcn_mfma_f32_32x32x16_bf16(*(const pg8::bf16x8*)(VTC + ((size_t)it * 64 + vb * 32 + r) * 32 + 16 * s + 8 * hg), af, acc[vb], 0, 0, 0); }
        float sm = 0.f;
#pragma unroll
        for (int e = 0; e < 16; ++e) sm += acc[0][e] + acc[1][e];
        { const auto sw = __builtin_amdgcn_permlane32_swap(__builtin_bit_cast(unsigned, sm), __builtin_bit_cast(unsigned, sm), false, false); sm = __builtin_bit_cast(float, (unsigned)sw[0]) + __builtin_bit_cast(float, (unsigned)sw[1]); }
        const float mu = sm * (1.0f / 64.0f); float sq = 0.f;
#pragma unroll
        for (int e = 0; e < 16; ++e) { const float d0 = acc[0][e] - mu, d1 = acc[1][e] - mu; sq += d0 * d0 + d1 * d1; }
        { const auto sw = __builtin_amdgcn_permlane32_swap(__builtin_bit_cast(unsigned, sq), __builtin_bit_cast(unsigned, sq), false, false); sq = __builtin_bit_cast(float, (unsigned)sw[0]) + __builtin_bit_cast(float, (unsigned)sw[1]); }
        const float rstd = rsqrtf(sq * (1.0f / 64.0f) + 64e-5f);
        const int t = n * 32 + r; const size_t row = (size_t)b * T + t; const size_t st = (size_t)bh * T + t;
        const float bonus = SC[st * 4 + 2];
        const bf16_t* vrec = (const bf16_t*)(VEC + st * RECB + 768);
#pragma unroll
        for (int vb = 0; vb < 2; ++vb)
#pragma unroll
            for (int q = 0; q < 4; ++q) { const int v0 = vb * 32 + 8 * q + 4 * hg;
                const pg8::f32x4 vv = ld_bf16x4(vrec + v0), gg = ld_bf16x4(GR + row * 256 + h * 64 + v0), g4 = *(const pg8::f32x4*)(lng + h * 64 + v0), b4 = *(const pg8::f32x4*)(lnb + h * 64 + v0);
                pg8::f32x4 o;
#pragma unroll
                for (int i = 0; i < 4; ++i) o[i] = ((acc[vb][4 * q + i] - mu) * rstd * g4[i] + b4[i] + bonus * vv[i]) * gg[i];
                st_bf16x4(br + row * D + 768 + h * 64 + v0, o); }
    }
}
constexpr int RING_BYTES = 131072, LDS_BYTES = 163840, LDSCTL_OFF = LDS_BYTES - 1024, MISC_OFF = LDSCTL_OFF + 320;
constexpr int PH_PRO = 0, PH_H0 = 1, PH_L0 = 2, PH_PER_LAYER = 12, PH_END = PH_L0 + 2 * PH_PER_LAYER;
constexpr int PL_PROJ = 0, PL_MIXA = 1, PL_MIXB = 2, PL_MIXC = 3, PL_MIXD = 4, PL_BRANCH = 5, PL_OUT = 6, PL_ROWMIX = 7, PL_FFN1 = 8, PL_FFN2 = 9, PL_FFN3 = 10, PL_ROWFFN = 11;

#ifndef DUPMASK
#define DUPMASK 0
#endif
#ifndef DUPN
#define DUPN 1
#endif
#define DUP(bit) for (int dup_ = 0; dup_ < (((DUPMASK) >> (bit)) & 1) * (DUPN) + 1; ++dup_)
__global__ void __launch_bounds__(NTHR, 2) mk_fwd(Args a) {
    extern __shared__ __attribute__((aligned(16))) unsigned char lds_raw[];
    Frame F0;
    F0.lds = (LAS unsigned char*)lds_raw;
    F0.wave = __builtin_amdgcn_readfirstlane(threadIdx.x >> 6);
    F0.G = gridDim.x; F0.gw = blockIdx.x * NWAVES + F0.wave; F0.NGW = F0.G * NWAVES;
    volatile LAS unsigned* MISC = (volatile LAS unsigned*)(F0.lds + MISC_OFF);
    for (int u = threadIdx.x; u < (LDS_BYTES - LDSCTL_OFF) / 4; u += NTHR) ((LAS unsigned*)(F0.lds + LDSCTL_OFF))[u] = 0u;
    __syncthreads();
    unsigned* ctl = (unsigned*)(a.ws + WS_CTL);
    const int lo = a.ph_lo, hi = a.ph_hi;
    XcdBarrier bar; bar.bar = ctl + CW_BAR; bar.x = 0; bar.st = nullptr;
    if (hi - lo > 1) bar = xcd_barrier_post(ctl + CW_BAR, MISC + 8);
#define IN(k) (lo <= (k) && (k) < hi)
#define SEAM(k) do { if (IN(k) && IN((k) + 1)) { xcd_barrier(bar); if ((DUPMASK >> 12) & 1) xcd_barrier(bar); } } while (0)
    if (IN(PH_PRO)) DUP(0) { ArgsP A = fresh_args(); Frame F = fresh(F0); p0_mod_items(F, (const float*)A->in[1], (const float*)A->in[3], (const float*)A->in[4], (float*)(A->ws + WS_MOD)); p0_convert(F, A); }
    SEAM(PH_PRO);
    if (IN(PH_H0)) DUP(9) { Frame F = fresh(F0); ph_h0(F, fresh_args()); }
    SEAM(PH_H0);
    for (int l = 0; l < NL; ++l) {
        const int base = PH_L0 + l * PH_PER_LAYER;
        if (IN(base + PL_PROJ)) DUP(13) { ArgsP A = fresh_args(); Frame F = fresh(F0); unsigned char* ws = A->ws;
            pg8::Gemm g{(const bf16_t*)(ws + WS_HB), (const bf16_t*)(ws + WS_WIN) + (size_t)l * PW * 1024, 1024, 1024, 1024, 0}; pg8::StaticOrder S; S.init(M, 7168, F.G, (int)blockIdx.x);
            pg8::EpiBf16 E{(bf16_t*)(ws + WS_PROJ), PW, 28};
            pg8::gemm_phase<pg8::EpiBf16, pg8::StaticOrder, true>(F.lds, g, S, E, F.wave);
        }
        SEAM(base + PL_PROJ);
        if (IN(base + PL_MIXA)) { DUP(2) { Frame F = fresh(F0); ph_conv(F, fresh_args(), l); } DUP(6) { Frame F = fresh(F0); ph_rwkv_prep(F, fresh_args(), l); } DUP(7) { Frame F = fresh(F0); ph_gla_p1(F, fresh_args(), l); } DUP(8) { Frame F = fresh(F0); ph_attn_prep(F, fresh_args()); } }
        SEAM(base + PL_MIXA);
        if (IN(base + PL_MIXB)) { DUP(10) { Frame F = fresh(F0); ph_gla_prefix(F, fresh_args()); } DUP(4) { Frame F = fresh(F0); ph_attn(F, fresh_args(), l); } DUP(3) { Frame F = fresh(F0); ph_rk_p1(F, fresh_args()); } }
        SEAM(base + PL_MIXB);
        if (IN(base + PL_MIXC)) { DUP(17) { Frame F = fresh(F0); ph_rk_p2(F, fresh_args()); } DUP(11) { Frame F = fresh(F0); ph_gla_p2(F, fresh_args(), l); } }
        SEAM(base + PL_MIXC);
        if (IN(base + PL_MIXD)) { DUP(5) { Frame F = fresh(F0); ph_rk_p3(F, fresh_args(), l); } }
        SEAM(base + PL_MIXD);
        if (IN(base + PL_BRANCH)) DUP(14) { ArgsP A = fresh_args(); Frame F = fresh(F0); unsigned char* ws = A->ws;
            pg8::Gemm g{(const bf16_t*)(ws + WS_HB), (const bf16_t*)(ws + WS_WB) + (size_t)l * 1024 * 1024, 1024, 1024, 1024, 0}; pg8::StaticOrder S; S.init(M, 1024, F.G, (int)blockIdx.x);
            pg8::EpiBranchK E{(const bf16_t*)(ws + WS_PROJ), (bf16_t*)(ws + SCR_MB)};
            pg8::gemm_phase<pg8::EpiBranchK, pg8::StaticOrder, false>(F.lds, g, S, E, F.wave);
        }
        SEAM(base + PL_BRANCH);
        if (IN(base + PL_OUT)) DUP(1) { ArgsP A = fresh_args(); Frame F = fresh(F0); unsigned char* ws = A->ws;
            pg8::Gemm g{(const bf16_t*)(ws + SCR_MB), (const bf16_t*)(ws + WS_WO) + (size_t)l * 1024 * 1024, 1024, 1024, 1024, 0}; pg8::StaticOrder S; S.init(M, 1024, F.G, (int)blockIdx.x);
            pg8::EpiBf16 E{(bf16_t*)(ws + SCR_Y), 1024, 4};
            pg8::gemm_phase<pg8::EpiBf16, pg8::StaticOrder, false>(F.lds, g, S, E, F.wave);
        }
        SEAM(base + PL_OUT);
        if (IN(base + PL_ROWMIX)) { ArgsP A = fresh_args(); Frame F = fresh(F0); unsigned char* ws = A->ws; const float* modl = (const float*)(ws + WS_MOD) + (size_t)l * 8 * 6144;
            ph_row(F, A, l == 0 ? (const float*)A->in[0] : A->out, (const bf16_t*)(ws + SCR_Y), (const float*)A->in[6] + l * D, modl, 2048, (const float*)A->in[7] + l * D, modl, 3072, 4096, (bf16_t*)(ws + (l == 0 ? WS_HB : WS_H2L1)), l == 1); }
        SEAM(base + PL_ROWMIX);
        if (l == 0) {
            if (IN(base + PL_FFN1)) DUP(1) { ArgsP A = fresh_args(); Frame F = fresh(F0); unsigned char* ws = A->ws;
                pg8::Gemm g{(const bf16_t*)(ws + WS_HB), (const bf16_t*)(ws + WS_WF1), 1024, 1024, 1024, 0}; pg8::StaticOrder S; S.init(M, 2 * DFF, F.G, (int)blockIdx.x);
                pg8::EpiSwiglu E{(bf16_t*)(ws + WS_PROJ), DFF, 2 * DFF / 256};
                pg8::gemm_phase<pg8::EpiSwiglu, pg8::StaticOrder, true>(F.lds, g, S, E, F.wave);
            }
            SEAM(base + PL_FFN1);
            if (IN(base + PL_FFN2)) DUP(1) { ArgsP A = fresh_args(); Frame F = fresh(F0); unsigned char* ws = A->ws;
                pg8::Gemm g{(const bf16_t*)(ws + WS_PROJ), (const bf16_t*)(ws + WS_WF2), DFF, DFF, DFF, 0}; pg8::StaticOrder S; S.init(M, 1024, F.G, (int)blockIdx.x);
                pg8::EpiBf16 E{(bf16_t*)(ws + SCR_Y), 1024, 4};
                pg8::gemm_phase<pg8::EpiBf16, pg8::StaticOrder, false>(F.lds, g, S, E, F.wave);
            }
            SEAM(base + PL_FFN2);
        } else {
            if (IN(base + PL_FFN1)) DUP(0) { Frame F = fresh(F0); ph_moe_prep(F, fresh_args()); }
            SEAM(base + PL_FFN1);
            if (IN(base + PL_FFN2)) DUP(15) { ArgsP A = fresh_args(); Frame F = fresh(F0); unsigned char* ws = A->ws; const unsigned* cnt = (const unsigned*)(ws + WS_CTL) + CW_CNT;
                pg8::Gemm g{(const bf16_t*)(ws + WS_HG), (const bf16_t*)(ws + WS_WM1), 1024, 1024, 1024, 0}; pg8::MoeOrder<28> S; S.init(cnt, F.G, (int)blockIdx.x);
                pg8::EpiSwiglu E{(bf16_t*)(ws + WS_HID), DEXP, 28};
                pg8::gemm_phase<pg8::EpiSwiglu, pg8::MoeOrder<28>, true>(F.lds, g, S, E, F.wave);
            }
            SEAM(base + PL_FFN2);
            if (IN(base + PL_FFN3)) DUP(16) { ArgsP A = fresh_args(); Frame F = fresh(F0); unsigned char* ws = A->ws; const unsigned* cnt = (const unsigned*)(ws + WS_CTL) + CW_CNT;
                pg8::Gemm g{(const bf16_t*)(ws + WS_HID), (const bf16_t*)(ws + WS_WM2), DEXP, DEXP, DEX, 0}; pg8::MoeOrderSplit S; S.init(cnt, F.G, (int)blockIdx.x);
                const pg8::MoeSplit sp = pg8::moe_split(cnt, F.G);
                pg8::EpiBf16Split E{(bf16_t*)(ws + WS_HG), (bf16_t*)(ws + WS_WM1), sp.tau0, sp.nrt};
                pg8::gemm_phase<pg8::EpiBf16Split, pg8::MoeOrderSplit, true>(F.lds, g, S, E, F.wave);
            }
            SEAM(base + PL_FFN3);
        }
        if (IN(base + PL_ROWFFN)) { ArgsP A = fresh_args(); Frame F = fresh(F0); unsigned char* ws = A->ws; const float* modl = (const float*)(ws + WS_MOD) + (size_t)l * 8 * 6144;
            const bool last = (l == NL - 1);
            if (l == 0) ph_row(F, A, A->out, (const bf16_t*)(ws + SCR_Y), (const float*)A->in[8], modl, 5120, (const float*)A->in[5] + D, modl + 8 * 6144, 0, 1024, (bf16_t*)(ws + WS_HB), false, nullptr, (const float*)A->in[9] + (size_t)1024 * NIN);
            else ph_row(F, A, A->out, nullptr, (const float*)A->in[8] + D, modl, 5120, nullptr, nullptr, 0, 1024, nullptr, false, (const bf16_t*)(ws + WS_HG));
        }
        SEAM(base + PL_ROWFFN);
    }
#undef IN
#undef SEAM
}

extern "C" void kernel_launch(void* const* d_in, const int* in_sizes, int n_in, void* d_out, int out_size, void* d_ws, size_t ws_size, hipStream_t stream) {
    static int grid = 0;
    if (grid == 0) {
        if (n_in != 40 || ws_size < WS_END) { fprintf(stderr, "kernel_launch: need 40 inputs and >= %zu bytes of workspace (got %d, %zu)\n", (size_t)WS_END, n_in, ws_size); grid = -1; return; }
        int dev = 0, cus = 0, per_cu = 0;
        (void)hipGetDevice(&dev); (void)hipDeviceGetAttribute(&cus, hipDeviceAttributeMultiprocessorCount, dev);
        (void)hipFuncSetAttribute((const void*)mk_fwd, hipFuncAttributeMaxDynamicSharedMemorySize, LDS_BYTES);
        (void)hipOccupancyMaxActiveBlocksPerMultiprocessor(&per_cu, (const void*)mk_fwd, NTHR, LDS_BYTES);
        (void)hipGetLastError();
        grid = cus > 0 ? cus : 256;
        if (per_cu < 1) fprintf(stderr, "kernel_launch: occupancy query says %d blocks per CU\n", per_cu);
    }
    if (grid < 0) return;
    unsigned char* ws = (unsigned char*)d_ws;
    (void)hipMemsetAsync(ws + WS_CTL, 0, CTL_ZERO_BYTES, stream);
    Args a{};
    for (int i = 0; i < 40; ++i) a.in[i] = d_in[i];
    a.out = (float*)d_out; a.ws = ws;
#if defined(PREFIX)
    a.ph_lo = 0; a.ph_hi = PREFIX;
    hipLaunchKernelGGL(mk_fwd, dim3(grid), dim3(NTHR), LDS_BYTES, stream, a);
    (void)hipMemsetAsync(ws + WS_CTL, 0, CTL_ZERO_BYTES, stream);
#endif
    a.ph_lo = 0; a.ph_hi = PH_L0 + (NL - 1) * PH_PER_LAYER + PL_ROWFFN + 1;
    hipLaunchKernelGGL(mk_fwd, dim3(grid), dim3(NTHR), LDS_BYTES, stream, a);
}
```
